# Optimizing an MI355X kernel written in HIP

```python
import math
import jax
import jax.numpy as jnp
from jax import lax
import numpy as np

D_MODEL = 1024
BATCH = 16
SEQ = 2048
DEPTH = 2

MEM_LEN = 256
HEAD_DIM = 64
D_MIX = D_MODEL
RET_WIDTH = 3 * D_MIX // 8
SSD_WIDTH = 3 * D_MIX // 8
LRU_WIDTH = D_MIX - RET_WIDTH - SSD_WIDTH
RET_HEADS = RET_WIDTH // HEAD_DIM
SSD_HEADS = SSD_WIDTH // HEAD_DIM
SSD_GROUPS = 2
SSD_HEADS_PER_GROUP = SSD_HEADS // SSD_GROUPS
SSD_STATE = 128
SSD_CONV_DIM = SSD_WIDTH + 2 * SSD_GROUPS * SSD_STATE
LRU_BLOCKS = LRU_WIDTH // HEAD_DIM
LRU_C = 8.0
CONV_WIDTH = 4
CHUNK = 128
ROPE_BASE = 10000.0
CA_HEADS = 4
CA_HEAD_DIM = D_MODEL // CA_HEADS
N_GROUPS = 4
EXPERTS_PER_GROUP = 8
N_EXPERTS = N_GROUPS * EXPERTS_PER_GROUP
TOP_K = 2
D_EXPERT = D_MODEL // 2
MOE_BLOCK = 128
EPS = 1e-6
IN_SPLITS = (RET_WIDTH, RET_WIDTH, RET_WIDTH, RET_WIDTH, SSD_WIDTH, SSD_CONV_DIM, SSD_HEADS, LRU_WIDTH, LRU_WIDTH)
D_IN = sum(IN_SPLITS)
SPLIT_POINTS = tuple(int(p) for p in np.cumsum(IN_SPLITS)[:-1])

kernel_name = 'hybrid_ret_ssd_rglru_xattn_hmoe_encoder'


def rms_norm(x, g):
    xf = x.astype(jnp.float32)
    y = xf * lax.rsqrt(jnp.mean(xf * xf, axis=-1, keepdims=True) + EPS)
    return (y * g.astype(jnp.float32)).astype(x.dtype)


def _rev(t):
    return jnp.flip(t, axis=1)


def centred_dwconv(x, w, b):
    k = w.shape[0]
    left = k // 2
    y = lax.conv_general_dilated(x, w[:, None, :].astype(x.dtype), window_strides=(1,),
                                 padding=[(left, k - 1 - left)],
                                 dimension_numbers=('NWC', 'WIO', 'NWC'),
                                 feature_group_count=x.shape[-1])
    return y + b.astype(y.dtype)


def rotary(x):
    s, dh = x.shape[1], x.shape[-1]
    half = dh // 2
    inv = ROPE_BASE ** (-jnp.arange(half, dtype=jnp.float32) / half)
    ang = jnp.arange(s, dtype=jnp.float32)[:, None] * inv[None, :]
    cos = jnp.cos(ang)[:, None, :]
    sin = jnp.sin(ang)[:, None, :]
    x1 = x[..., :half].astype(jnp.float32)
    x2 = x[..., half:].astype(jnp.float32)
    return jnp.concatenate([x1 * cos - x2 * sin, x1 * sin + x2 * cos], axis=-1)


def _retention_causal(q, k, v, log_gamma, strict):
    b, s, h, dh = q.shape
    n = s // CHUNK
    q = q.reshape(b, n, CHUNK, h, dh)
    k = k.reshape(b, n, CHUNK, h, dh)
    v = v.reshape(b, n, CHUNK, h, v.shape[-1])
    idx = jnp.arange(CHUNK)
    diff = (idx[:, None] - idx[None, :]).astype(jnp.float32)
    mask = diff > 0 if strict else diff >= 0
    decay = jnp.where(mask, jnp.exp(jnp.where(mask, diff, 0.0)[None] * log_gamma[:, None, None]), 0.0)
    scores = jnp.einsum('bnihd,bnjhd->bnhij', q, k) * decay
    inner = jnp.einsum('bnhij,bnjhe->bnihe', scores, v)
    pos = idx.astype(jnp.float32)[:, None]
    zeta = jnp.exp((CHUNK - 1 - pos) * log_gamma)
    xi = jnp.exp((pos + 1) * log_gamma)
    states = jnp.einsum('bnjhd,jh,bnjhe->bnhde', k, zeta, v)
    chunk_decay = jnp.exp(CHUNK * log_gamma)[:, None, None]

    def step(r, st):
        return r * chunk_decay + st, r

    _, r_prev = lax.scan(step, jnp.zeros_like(states[:, 0]), jnp.moveaxis(states, 1, 0))
    r_prev = jnp.moveaxis(r_prev, 0, 1)
    cross = jnp.einsum('bnihd,bnhde->bnihe', q, r_prev) * xi[None, None, :, :, None]
    return (inner + cross).reshape(b, s, h, -1)


def retention_mixer(q, k, v, g):
    b, s, _ = q.shape
    shp = (b, s, RET_HEADS, HEAD_DIM)
    q = rotary(q.reshape(shp))
    k = rotary(k.reshape(shp)) * HEAD_DIM ** -0.5
    v = v.reshape(shp).astype(jnp.float32)
    log_gamma = jnp.log1p(-jnp.exp2(-5.0 - jnp.arange(RET_HEADS, dtype=jnp.float32)))
    o = _retention_causal(q, k, v, log_gamma, strict=False)
    o = o + _rev(_retention_causal(_rev(q), _rev(k), _rev(v), log_gamma, strict=True))
    o = o * lax.rsqrt(jnp.mean(o * o, axis=-1, keepdims=True) + EPS)
    return jax.nn.silu(g.astype(jnp.float32)) * o.reshape(b, s, RET_WIDTH)


def _ssd_causal(x, dt, log_a, bm, cm, strict):
    b, s, g, r, p = x.shape
    n = s // CHUNK
    x = x.reshape(b, n, CHUNK, g, r, p)
    dt = dt.reshape(b, n, CHUNK, g, r)
    log_a = log_a.reshape(b, n, CHUNK, g, r)
    bm = bm.reshape(b, n, CHUNK, g, -1)
    cm = cm.reshape(b, n, CHUNK, g, -1)
    a_cum = jnp.cumsum(log_a, axis=2)
    idx = jnp.arange(CHUNK)
    mask = (idx[:, None] > idx[None, :]) if strict else (idx[:, None] >= idx[None, :])
    mask = mask[None, None, :, :, None, None]
    seg = a_cum[:, :, :, None] - a_cum[:, :, None, :]
    lmat = jnp.where(mask, jnp.exp(jnp.where(mask, seg, 0.0)), 0.0)
    xdt = x * dt[..., None]
    cb = jnp.einsum('bnigs,bnjgs->bnijg', cm, bm)
    y_diag = jnp.einsum('bnijgr,bnjgrp->bnigrp', cb[..., None] * lmat, xdt)
    decay_states = jnp.exp(a_cum[:, :, -1:] - a_cum)
    states = jnp.einsum('bnlgs,bnlgr,bnlgrp->bngrps', bm, decay_states, xdt)
    chunk_decay = jnp.exp(a_cum[:, :, -1])

    def step(hst, inp):
        st, d = inp
        return hst * d[..., None, None] + st, hst

    _, h_prev = lax.scan(step, jnp.zeros_like(states[:, 0]),
                         (jnp.moveaxis(states, 1, 0), jnp.moveaxis(chunk_decay, 1, 0)))
    h_prev = jnp.moveaxis(h_prev, 0, 1)
    y_off = jnp.einsum('bnigs,bngrps,bnigr->bnigrp', cm, h_prev, jnp.exp(a_cum))
    return (y_diag + y_off).reshape(b, s, g, r, p)


def ssd_mixer(z, xbc, dt_raw, conv_w, conv_b, dt_bias, a_log, d_skip, norm_w):
    b, s, _ = z.shape
    f32 = jnp.float32
    xbc = jax.nn.silu(centred_dwconv(xbc, conv_w, conv_b).astype(f32))
    xs, bm, cm = jnp.split(xbc, [SSD_WIDTH, SSD_WIDTH + SSD_GROUPS * SSD_STATE], axis=-1)
    xs = xs.reshape(b, s, SSD_GROUPS, SSD_HEADS_PER_GROUP, HEAD_DIM)
    bm = bm.reshape(b, s, SSD_GROUPS, SSD_STATE)
    cm = cm.reshape(b, s, SSD_GROUPS, SSD_STATE)
    hs = (SSD_GROUPS, SSD_HEADS_PER_GROUP)
    dt_raw = dt_raw.astype(f32)
    dt_f = jax.nn.softplus(dt_raw + dt_bias[0].astype(f32)).reshape(b, s, *hs)
    dt_b = jax.nn.softplus(dt_raw + dt_bias[1].astype(f32)).reshape(b, s, *hs)
    la_f = -dt_f * jnp.exp(a_log[0].astype(f32)).reshape(hs)
    la_b = -dt_b * jnp.exp(a_log[1].astype(f32)).reshape(hs)
    y_f = _ssd_causal(xs, dt_f, la_f, bm, cm, strict=False)
    y_b = _rev(_ssd_causal(_rev(xs), _rev(dt_b), _rev(la_b), _rev(bm), _rev(cm), strict=True))
    y = y_f + y_b + d_skip.astype(f32).reshape(hs)[..., None] * xs
    y = y.reshape(b, s, SSD_WIDTH) * jax.nn.silu(z.astype(f32))
    y = y.reshape(b, s, SSD_GROUPS, SSD_WIDTH // SSD_GROUPS)
    y = y * lax.rsqrt(jnp.mean(y * y, axis=-1, keepdims=True) + EPS)
    return y.reshape(b, s, SSD_WIDTH) * norm_w.astype(f32)


def _linear_scan(a, u, reverse):
    def combine(lhs, rhs):
        a_l, u_l = lhs
        a_r, u_r = rhs
        return a_l * a_r, a_r * u_l + u_r

    _, h = lax.associative_scan(combine, (a, u), axis=1, reverse=reverse)
    return h


def _rglru_direction(xc, lam, wa, ba, wx, bx, reverse):
    b, s, _ = xc.shape
    f32 = jnp.float32
    xh = xc.reshape(b, s, LRU_BLOCKS, HEAD_DIM)
    r_gate = jax.nn.sigmoid(jnp.einsum('bshi,hij->bshj', xh, wa.astype(f32)).reshape(b, s, LRU_WIDTH) + ba.astype(f32))
    i_gate = jax.nn.sigmoid(jnp.einsum('bshi,hij->bshj', xh, wx.astype(f32)).reshape(b, s, LRU_WIDTH) + bx.astype(f32))
    log_a = -LRU_C * r_gate * jax.nn.softplus(-lam.astype(f32))
    a = jnp.exp(log_a)
    u = jnp.sqrt(-jnp.expm1(2.0 * log_a)) * (i_gate * xc)
    return _linear_scan(a, u, reverse)


def lru_mixer(xr, gate, conv_w, conv_b, lam, wa, ba, wx, bx):
    xc = centred_dwconv(xr, conv_w, conv_b).astype(jnp.float32)
    h = _rglru_direction(xc, lam[0], wa[0], ba[0], wx[0], bx[0], reverse=False)
    h = h + _rglru_direction(xc, lam[1], wa[1], ba[1], wx[1], bx[1], reverse=True)
    return h * jax.nn.gelu(gate.astype(jnp.float32))


def hybrid_mixer(xn, w_in, w_out, ssd_conv_w, ssd_conv_b, ssd_dt_bias, ssd_a_log, ssd_d, ssd_norm,
                 lru_conv_w, lru_conv_b, lru_lambda, lru_wa, lru_ba, lru_wx, lru_bx):
    proj = xn @ w_in
    q, k, v, g, z, xbc, dt_raw, xr, gate = jnp.split(proj, SPLIT_POINTS, axis=-1)
    o_ret = retention_mixer(q, k, v, g)
    o_ssd = ssd_mixer(z, xbc, dt_raw, ssd_conv_w, ssd_conv_b, ssd_dt_bias, ssd_a_log, ssd_d, ssd_norm)
    o_lru = lru_mixer(xr, gate, lru_conv_w, lru_conv_b, lru_lambda, lru_wa, lru_ba, lru_wx, lru_bx)
    o = jnp.concatenate([o_ret, o_ssd, o_lru], axis=-1).astype(xn.dtype)
    return o @ w_out


def memory_cross_attention(xn, mn, wq, wkv, wo):
    b, s, d = xn.shape
    m = mn.shape[1]
    q = (xn @ wq).reshape(b, s, CA_HEADS, CA_HEAD_DIM)
    k, v = jnp.split(mn @ wkv, 2, axis=-1)
    k = k.reshape(b, m, CA_HEADS, CA_HEAD_DIM)
    v = v.reshape(b, m, CA_HEADS, CA_HEAD_DIM)
    scores = jnp.einsum('bshd,bmhd->bhsm', q, k).astype(jnp.float32) * CA_HEAD_DIM ** -0.5
    p = jax.nn.softmax(scores, axis=-1).astype(v.dtype)
    o = jnp.einsum('bhsm,bmhd->bshd', p, v).reshape(b, s, d)
    return o @ wo


def _expert_dispatch(xt, expert_id, gates, w1, w3, w2):
    t, d = xt.shape
    n_assign = t * TOP_K
    e = expert_id.reshape(n_assign).astype(jnp.int32)
    tok = jnp.repeat(jnp.arange(t, dtype=jnp.int32), TOP_K)
    wts = gates.reshape(n_assign)
    order = jnp.argsort(e)
    e_s, tok_s, w_s = e[order], tok[order], wts[order]
    counts = jnp.zeros((N_EXPERTS,), jnp.int32).at[e].add(1)
    padded = (counts + MOE_BLOCK - 1) // MOE_BLOCK * MOE_BLOCK
    start = jnp.cumsum(counts) - counts
    pad_end = jnp.cumsum(padded)
    pad_start = pad_end - padded
    dest = pad_start[e_s] + jnp.arange(n_assign, dtype=jnp.int32) - start[e_s]
    n_blocks = -(-n_assign // MOE_BLOCK) + N_EXPERTS
    slots = n_blocks * MOE_BLOCK
    buf_tok = jnp.zeros((slots,), jnp.int32).at[dest].set(tok_s)
    buf_w = jnp.zeros((slots,), wts.dtype).at[dest].set(w_s)
    block_start = jnp.arange(n_blocks, dtype=jnp.int32) * MOE_BLOCK
    block_e = jnp.minimum(jnp.searchsorted(pad_end, block_start, side='right'), N_EXPERTS - 1)
    xb = xt[buf_tok].reshape(n_blocks, MOE_BLOCK, d)

    def expert_block(args):
        xblk, eid = args
        hid = jax.nn.silu(xblk @ w1[eid]) * (xblk @ w3[eid])
        return hid @ w2[eid]

    yb = lax.map(expert_block, (xb, block_e)).reshape(slots, d)
    return jnp.zeros_like(xt).at[buf_tok].add(yb * buf_w[:, None])


def hierarchical_moe(xn, wg, bg, we, be, w1, w3, w2):
    b, s, d = xn.shape
    xt = xn.reshape(b * s, d)
    t = xt.shape[0]
    group_p = jax.nn.softmax((xt @ wg).astype(jnp.float32) + bg.astype(jnp.float32), axis=-1)
    gp, gi = lax.top_k(group_p, 1)
    e_logits = ((xt @ we).astype(jnp.float32) + be.astype(jnp.float32)).reshape(t, N_GROUPS, EXPERTS_PER_GROUP)
    e_logits = jnp.take_along_axis(e_logits, gi[:, :, None], axis=1)[:, 0]
    ep, ei = lax.top_k(jax.nn.softmax(e_logits, axis=-1), TOP_K)
    gates = gp * ep / jnp.sum(ep, axis=-1, keepdims=True)
    expert_id = gi * EXPERTS_PER_GROUP + ei
    y = _expert_dispatch(xt, expert_id, gates.astype(xt.dtype), w1, w3, w2)
    return y.reshape(b, s, d)


def setup_inputs(seed: int = 0) -> dict:
    key = jax.random.key(seed)
    keys = iter(jax.random.split(key, 48))
    f32 = jnp.float32
    L = DEPTH

    def normal(shape, scale):
        return jax.random.normal(next(keys), shape, f32) * scale

    def uniform(shape, lo, hi):
        return jax.random.uniform(next(keys), shape, f32, lo, hi)

    def gain(shape):
        return 1.0 + normal(shape, 0.02)

    x = normal((BATCH, SEQ, D_MODEL), 1.0)
    mem = normal((BATCH, MEM_LEN, D_MODEL), 1.0)
    g_mix = gain((L, D_MODEL))
    w_in = normal((L, D_MODEL, D_IN), D_MODEL ** -0.5)
    w_out = normal((L, D_MIX, D_MODEL), D_MIX ** -0.5)
    ssd_conv_w = normal((L, CONV_WIDTH, SSD_CONV_DIM), CONV_WIDTH ** -0.5)
    ssd_conv_b = normal((L, SSD_CONV_DIM), 0.02)
    dt0 = jnp.exp(uniform((L, 2, SSD_HEADS), math.log(1e-3), math.log(1e-1)))
    ssd_dt_bias = dt0 + jnp.log(-jnp.expm1(-dt0))
    ssd_a_log = jnp.log(uniform((L, 2, SSD_HEADS), 1.0, 16.0))
    ssd_d = 1.0 + normal((L, SSD_HEADS), 0.1)
    ssd_norm = gain((L, SSD_WIDTH))
    lru_conv_w = normal((L, CONV_WIDTH, LRU_WIDTH), CONV_WIDTH ** -0.5)
    lru_conv_b = normal((L, LRU_WIDTH), 0.02)
    a_root = uniform((L, 2, LRU_WIDTH), 0.9, 0.999) ** (1.0 / LRU_C)
    lru_lambda = jnp.log(a_root) - jnp.log1p(-a_root)
    lru_wa = normal((L, 2, LRU_BLOCKS, HEAD_DIM, HEAD_DIM), HEAD_DIM ** -0.5)
    lru_ba = normal((L, 2, LRU_WIDTH), 0.02)
    lru_wx = normal((L, 2, LRU_BLOCKS, HEAD_DIM, HEAD_DIM), HEAD_DIM ** -0.5)
    lru_bx = normal((L, 2, LRU_WIDTH), 0.02)
    g_ca = gain((L, D_MODEL))
    g_mem = gain((L, D_MODEL))
    ca_wq = normal((L, D_MODEL, D_MODEL), D_MODEL ** -0.5)
    ca_wkv = normal((L, D_MODEL, 2 * D_MODEL), D_MODEL ** -0.5)
    ca_wo = normal((L, D_MODEL, D_MODEL), D_MODEL ** -0.5)
    g_moe = gain((L, D_MODEL))
    moe_wg = normal((L, D_MODEL, N_GROUPS), D_MODEL ** -0.5)
    moe_bg = normal((L, N_GROUPS), 0.01)
    moe_we = normal((L, D_MODEL, N_EXPERTS), D_MODEL ** -0.5)
    moe_be = normal((L, N_EXPERTS), 0.01)
    moe_w1 = normal((L, N_EXPERTS, D_MODEL, D_EXPERT), D_MODEL ** -0.5)
    moe_w3 = normal((L, N_EXPERTS, D_MODEL, D_EXPERT), D_MODEL ** -0.5)
    moe_w2 = normal((L, N_EXPERTS, D_EXPERT, D_MODEL), D_EXPERT ** -0.5)
    g_final = gain((D_MODEL,))
    return {'x': x, 'mem': mem, 'g_mix': g_mix, 'w_in': w_in, 'w_out': w_out,
            'ssd_conv_w': ssd_conv_w, 'ssd_conv_b': ssd_conv_b, 'ssd_dt_bias': ssd_dt_bias,
            'ssd_a_log': ssd_a_log, 'ssd_d': ssd_d, 'ssd_norm': ssd_norm,
            'lru_conv_w': lru_conv_w, 'lru_conv_b': lru_conv_b, 'lru_lambda': lru_lambda,
            'lru_wa': lru_wa, 'lru_ba': lru_ba, 'lru_wx': lru_wx, 'lru_bx': lru_bx,
            'g_ca': g_ca, 'g_mem': g_mem, 'ca_wq': ca_wq, 'ca_wkv': ca_wkv, 'ca_wo': ca_wo,
            'g_moe': g_moe, 'moe_wg': moe_wg, 'moe_bg': moe_bg, 'moe_we': moe_we, 'moe_be': moe_be,
            'moe_w1': moe_w1, 'moe_w3': moe_w3, 'moe_w2': moe_w2, 'g_final': g_final}


def reference(x, mem, g_mix, w_in, w_out, ssd_conv_w, ssd_conv_b, ssd_dt_bias, ssd_a_log, ssd_d, ssd_norm,
              lru_conv_w, lru_conv_b, lru_lambda, lru_wa, lru_ba, lru_wx, lru_bx,
              g_ca, g_mem, ca_wq, ca_wkv, ca_wo,
              g_moe, moe_wg, moe_bg, moe_we, moe_be, moe_w1, moe_w3, moe_w2, g_final):
    h = x
    for l in range(DEPTH):
        h = h + hybrid_mixer(rms_norm(h, g_mix[l]), w_in[l], w_out[l],
                             ssd_conv_w[l], ssd_conv_b[l], ssd_dt_bias[l], ssd_a_log[l], ssd_d[l], ssd_norm[l],
                             lru_conv_w[l], lru_conv_b[l], lru_lambda[l], lru_wa[l], lru_ba[l], lru_wx[l], lru_bx[l])
        h = h + memory_cross_attention(rms_norm(h, g_ca[l]), rms_norm(mem, g_mem[l]), ca_wq[l], ca_wkv[l], ca_wo[l])
        h = h + hierarchical_moe(rms_norm(h, g_moe[l]), moe_wg[l], moe_bg[l], moe_we[l], moe_be[l],
                                 moe_w1[l], moe_w3[l], moe_w2[l])
    return rms_norm(h, g_final)
```

```cpp
#include <hip/hip_runtime.h>
#include <cstdio>
#include <cstdint>

#ifndef MK_SINGLE
#define MK_SINGLE 0
#endif

typedef _Float16 h16;
typedef _Float16 h16x2 __attribute__((ext_vector_type(2)));
typedef _Float16 h16x4 __attribute__((ext_vector_type(4)));
typedef _Float16 h16x8 __attribute__((ext_vector_type(8)));
typedef float f32x2 __attribute__((ext_vector_type(2)));
typedef float f32x4 __attribute__((ext_vector_type(4)));
typedef unsigned u32x2 __attribute__((ext_vector_type(2)));
typedef unsigned u32x4 __attribute__((ext_vector_type(4)));
#define LAS __attribute__((address_space(3)))
#define PIN() do { asm volatile("" ::: "memory"); __builtin_amdgcn_sched_barrier(0); } while (0)
#define PINV(x) asm volatile("" : "+v"(x) :: "memory")
#define MFMA16(a, b, c) __builtin_amdgcn_mfma_f32_16x16x32_f16((a), (b), (c), 0, 0, 0)

constexpr int NB = 16, SEQ = 2048, DM = 1024, NT = NB * SEQ, MEML = 256, NTM = NB * MEML, NLAYER = 2;
constexpr int NPJ = 3584;
constexpr int CQ = 0, CK = 384, CV = 768, CG = 1152, CZ = 1536, CXS = 1920, CBM = 2304, CCM = 2560, CXR = 2816, CGT = 3072, CDT = 3328;
constexpr int DIN = 3334, NCH = 16, MAXSLOT = 73728;
constexpr float EPS = 1e-6f;
constexpr int NPH = 14;
constexpr int NPHASES = NLAYER * NPH;

constexpr size_t MiB = (size_t)1 << 20;
constexpr size_t WS_CTL = 0, CTL_ZERO_BYTES = 64 * 1024;
constexpr size_t WS_WIN = 1 * MiB, WS_WOUT = 8 * MiB, WS_WQ = 10 * MiB, WS_WKV = 12 * MiB, WS_WO = 16 * MiB, WS_W13 = 18 * MiB, WS_W2 = 82 * MiB, WS_LRUW = 114 * MiB;
constexpr size_t WS_HB = 115 * MiB;
constexpr size_t WS_R1 = 179 * MiB;
constexpr size_t WS_R2 = 403 * MiB;
constexpr size_t WS_KV = 547 * MiB, WS_MEM16 = 563 * MiB, WS_SSQ = 571 * MiB, WS_MISC = 573 * MiB, WS_END = 577 * MiB;
constexpr size_t OFF_QCA = WS_R1, OFF_OATT = WS_R1 + 64 * MiB, OFF_XP = WS_R1, OFF_HP = WS_R1 + 144 * MiB;
constexpr size_t OFF_OMIX = WS_R2, OFF_RST = WS_R2 + 64 * MiB, OFF_SST = WS_R2 + 88 * MiB, OFF_LSUM = WS_R2 + 136 * MiB, OFF_SDEC = WS_R2 + 137 * MiB, OFF_LCAR = WS_R2 + 138 * MiB, OFF_YP = WS_R2;
constexpr size_t OFF_KB = WS_KV, OFF_VT = WS_KV + 8 * MiB;
constexpr size_t OFF_ROPE = WS_MISC, OFF_MSSQ = WS_MISC + 512 * 1024, OFF_EID = WS_MISC + 768 * 1024, OFF_GATE = WS_MISC + 1024 * 1024, OFF_TSLOT = WS_MISC + 1280 * 1024,
                 OFF_RSTDT = WS_MISC + 1536 * 1024, OFF_SRSTD = WS_MISC + 1664 * 1024, OFF_TILEE = WS_MISC + 2000 * 1024;
constexpr int CW_COUNTS = 64, CW_CURSOR = 192, CW_NTILES = 320, CW_BAR = 4096;

constexpr int LDS_BYTES = 152 * 1024;
constexpr int LDS_MISC = 150 * 1024;

struct Prm { const float* in[32]; float* out; unsigned char* ws; int ph_lo, ph_hi; };

#define XB_TMO      128
#define XB_XCNT(j)  (256  + 64 * (j))
#define XB_XSUB(j)  (1280 + 64 * (j))
#define XB_XGEN(j)  (2304 + 64 * (j))
#define XB_TOP      3328
#define XB_TOPGEN   3392
#define XCD_BAR_WORDS 3456
#define XB_SPIN_CAP (1u << 18)
__device__ __forceinline__ unsigned xb_ld(unsigned* p)              { return __hip_atomic_load(p, __ATOMIC_RELAXED, __HIP_MEMORY_SCOPE_AGENT); }
__device__ __forceinline__ unsigned xb_add(unsigned* p, unsigned v) { return __hip_atomic_fetch_add(p, v, __ATOMIC_RELAXED, __HIP_MEMORY_SCOPE_AGENT); }
__device__ __forceinline__ unsigned xb_xcc_id() { return (unsigned)__builtin_amdgcn_s_getreg((3 << 11) | 20) & 0xFu; }
#define XB_SPIN(cond, bar) do { unsigned _sp = 0; while (cond) { __builtin_amdgcn_s_sleep(1); \
    if ((++_sp & 255u) == 0u) { if (xb_ld(&(bar)[XB_TMO])) break; if (_sp > XB_SPIN_CAP) { atomicAdd(&(bar)[XB_TMO], 1u); break; } } } } while (0)
struct XcdBarrier { unsigned* bar; unsigned x; volatile LAS unsigned* st; };
__device__ __forceinline__ XcdBarrier xcd_barrier_post(unsigned* bar, volatile LAS unsigned* st) {
    XcdBarrier b; b.bar = bar; b.x = xb_xcc_id(); b.st = st;
    if (threadIdx.x == 0) (void)xb_add(&bar[XB_XCNT(b.x)], 1u);
    return b;
}
__device__ __forceinline__ void xcd_barrier_complete(unsigned* bar, unsigned x, unsigned& nloc, unsigned& nx) {
    const unsigned G = gridDim.x * gridDim.y * gridDim.z;
    unsigned sum, cnt, mine, sp = 0u;
    for (;;) {
        sum = 0u; cnt = 0u; mine = 0u;
#pragma unroll
        for (unsigned j = 0; j < 16; ++j) { const unsigned c = xb_ld(&bar[XB_XCNT(j)]); sum += c; cnt += (c > 0u) ? 1u : 0u; mine = (j == x) ? c : mine; }
        if (sum == G) break;
        __builtin_amdgcn_s_sleep(1);
        if ((++sp & 255u) == 0u) { if (xb_ld(&bar[XB_TMO])) break; if (sp > XB_SPIN_CAP) { atomicAdd(&bar[XB_TMO], 1u); break; } }
    }
    nloc = mine > 0u ? mine : 1u; nx = cnt > 0u ? cnt : 1u;
}
__device__ __forceinline__ void xcd_barrier(const XcdBarrier& b) {
    asm volatile("s_waitcnt vmcnt(0)" ::: "memory");
    __syncthreads();
    if (threadIdx.x == 0) {
        unsigned* bar = b.bar;
        __builtin_amdgcn_s_waitcnt(0);
        unsigned nloc = b.st[0], nx = b.st[1];
        if (nloc == 0u) { xcd_barrier_complete(bar, b.x, nloc, nx); b.st[0] = nloc; b.st[1] = nx; }
        const unsigned old = xb_add(&bar[XB_XSUB(b.x)], 1u);
        const unsigned gen = old / nloc;
        if (old + 1u == (gen + 1u) * nloc) {
            __builtin_amdgcn_fence(__ATOMIC_RELEASE, "agent");
            asm volatile("s_waitcnt vmcnt(0)" ::: "memory");
            const unsigned og = xb_add(&bar[XB_TOP], 1u);
            const unsigned tg = og / nx;
            if (og + 1u == (tg + 1u) * nx) xb_add(&bar[XB_TOPGEN], 1u);
            else XB_SPIN(xb_ld(&bar[XB_TOPGEN]) == tg, bar);
            __builtin_amdgcn_fence(__ATOMIC_ACQUIRE, "agent");
            xb_add(&bar[XB_XGEN(b.x)], 1u);
            asm volatile("s_waitcnt vmcnt(0)" ::: "memory");
        } else {
            XB_SPIN(xb_ld(&bar[XB_XGEN(b.x)]) == gen, bar);
            __builtin_amdgcn_fence(__ATOMIC_ACQUIRE, "agent");
            asm volatile("s_waitcnt vmcnt(0)" ::: "memory");
        }
    }
    __syncthreads();
}

__device__ __forceinline__ float wave_sum(float v) {
#pragma unroll
    for (int o = 1; o < 64; o <<= 1) v += __shfl_xor(v, o);
    return v;
}
__device__ __forceinline__ float sigmoidf_(float x) { return 1.0f / (1.0f + __expf(-x)); }
__device__ __forceinline__ float siluf_(float x) { return x / (1.0f + __expf(-x)); }
__device__ __forceinline__ float softplusf_(float x) { return x > 20.f ? x : log1pf(__expf(x)); }
__device__ __forceinline__ float gelu_tanh_(float x) { const float y = 0.7978845608028654f * (x + 0.044715f * x * x * x); const float t = 1.0f - 2.0f / (__expf(2.0f * y) + 1.0f); return 0.5f * x * (1.0f + t); }
__device__ __forceinline__ h16x8 pack8(const f32x4 a, const f32x4 b) { h16x8 r; r[0] = (h16)a[0]; r[1] = (h16)a[1]; r[2] = (h16)a[2]; r[3] = (h16)a[3]; r[4] = (h16)b[0]; r[5] = (h16)b[1]; r[6] = (h16)b[2]; r[7] = (h16)b[3]; return r; }
__device__ __forceinline__ h16x4 pack4(const f32x4 a) { h16x4 r; r[0] = (h16)a[0]; r[1] = (h16)a[1]; r[2] = (h16)a[2]; r[3] = (h16)a[3]; return r; }
__device__ __forceinline__ h16x8 ldsfrag(LAS const h16* p) { return *(LAS const h16x8*)p; }
__device__ __forceinline__ h16x8 ldsfrag2(LAS const h16* p0, LAS const h16* p1) { const h16x4 a = *(LAS const h16x4*)p0, b = *(LAS const h16x4*)p1; return __builtin_shufflevector(a, b, 0, 1, 2, 3, 4, 5, 6, 7); }
__device__ __forceinline__ h16x8 scalefrag(const h16x8 f, float s) { const h16 hs = (h16)s; h16x8 v;
#pragma unroll
    for (int j = 0; j < 8; ++j) v[j] = hs; return f * v; }
__device__ __forceinline__ float row_rstd(const float* ssq16) {
    const f32x4 a = *(const f32x4*)ssq16, b = *(const f32x4*)(ssq16 + 4), c = *(const f32x4*)(ssq16 + 8), d = *(const f32x4*)(ssq16 + 12);
    const float s = ((a[0] + a[1]) + (a[2] + a[3])) + ((b[0] + b[1]) + (b[2] + b[3])) + ((c[0] + c[1]) + (c[2] + c[3])) + ((d[0] + d[1]) + (d[2] + d[3]));
    return 1.0f / sqrtf(s * (1.0f / DM) + EPS);
}

namespace pg8 {
constexpr int BM = 256, BK = 64, HALF = 128, HTB = HALF * BK * 2, STAGE_BYTES = 8 * HTB, NXCD = 8, WGM = 8;
__host__ __device__ __forceinline__ int lds_byte(int r, int c) { const int st = (r >> 4) * 2 + (c >> 5), rr = r & 15, cc = c & 31, ob = rr * 64 + cc * 2; return st * 1024 + (ob ^ (((ob >> 9) & 1) << 5)); }
__host__ __device__ __forceinline__ void stage_rc(int b, int& R, int& C) { const int st = b / 1024, sb = b % 1024, swz = sb ^ (((sb >> 9) & 1) << 5); R = (st >> 1) * 16 + swz / 64; C = (st & 1) * 32 + (swz % 64) / 2; }
__host__ __device__ __forceinline__ int perm32(int rho) { const int n = rho >> 4, i = rho & 15; return 8 * (i >> 2) + 4 * n + (i & 3); }
struct Unit { int pm, pn; };
struct Gemm { const h16* A; const h16* Bt; int lda, ldb, K; };
struct StaticOrder {
    int nM, nN, nwg, G, c;
    __device__ void init(int M, int N, int G_, int c_) { nM = M / BM; nN = N / BM; nwg = nM * nN; G = G_; c = c_; }
    __device__ bool next(int i, Unit& u) const {
        const long L = (long)i * G + c; if (L >= nwg) return false;
        int wgid = (int)L; { const int q = nwg / NXCD, r = nwg % NXCD, xcd = wgid % NXCD, off = wgid / NXCD; wgid = (xcd < r ? xcd * (q + 1) : r * (q + 1) + (xcd - r) * q) + off; }
        const int nig = WGM * nN, gid = wgid / nig, fm = gid * WGM, gsz = (nM - fm) < WGM ? (nM - fm) : WGM;
        u.pm = fm + ((wgid % nig) % gsz); u.pn = (wgid % nig) / gsz; return true;
    }
};
struct GroupOrder {
    const int* tile_e; int ntiles, G, vcu;
    __device__ bool next(int i, Unit& u) const {
        const int L = i * G + vcu, tile = L >> 2; if (tile >= ntiles) return false;
        u.pm = tile; u.pn = __builtin_amdgcn_readfirstlane(tile_e[tile]) * 4 + (L & 3); return true;
    }
};

struct EpiScale16 {
    static constexpr bool PERM = true;
    h16* O; int ldc; const float* ssq;
    __device__ __forceinline__ void operator()(const f32x4 (&acc)[2][2][4][2], const Unit& u, int wr, int wc, int fr, int fq) const {
        const int row0 = u.pm * BM + wr * 64 + fr, col0 = u.pn * BM + wc * 32 + 8 * fq;
#pragma unroll
        for (int ai = 0; ai < 2; ++ai)
#pragma unroll
            for (int m = 0; m < 4; ++m) { const int row = row0 + ai * HALF + m * 16; const float rs = row_rstd(ssq + (size_t)row * 16); h16* rowp = O + (size_t)row * ldc + col0;
#pragma unroll
                for (int bj = 0; bj < 2; ++bj) *(h16x8*)(rowp + bj * HALF) = pack8(acc[ai][bj][m][0] * rs, acc[ai][bj][m][1] * rs); }
    }
};
struct EpiKV {
    static constexpr bool PERM = true;
    h16* KB; h16* VT; const float* ssq;
    __device__ __forceinline__ void operator()(const f32x4 (&acc)[2][2][4][2], const Unit& u, int wr, int wc, int fr, int fq) const {
        const int row0 = u.pm * BM + wr * 64 + fr;
#pragma unroll
        for (int ai = 0; ai < 2; ++ai)
#pragma unroll
            for (int m = 0; m < 4; ++m) { const int row = row0 + ai * HALF + m * 16; const float rs = row_rstd(ssq + (size_t)row * 16);
                h16x8 pk[2];
#pragma unroll
                for (int bj = 0; bj < 2; ++bj) pk[bj] = pack8(acc[ai][bj][m][0] * rs, acc[ai][bj][m][1] * rs);
                if (u.pn < 4) { h16* rowp = KB + (size_t)row * DM + u.pn * BM + wc * 32 + 8 * fq;
                    *(h16x8*)rowp = pk[0]; *(h16x8*)(rowp + HALF) = pk[1];
                } else { const int b = row >> 8, key = row & 255, hd = u.pn - 4; h16* base = VT + ((size_t)(b * 4 + hd) * 256 + wc * 32 + 8 * fq) * 256 + key;
#pragma unroll
                    for (int bj = 0; bj < 2; ++bj)
#pragma unroll
                        for (int j = 0; j < 8; ++j) base[(bj * HALF + j) * 256] = pk[bj][j]; }
                PIN();
            }
    }
};
struct EpiResid {
    static constexpr bool PERM = false;
    const float* base; float* out; h16* hb; float* ssq;
    __device__ __forceinline__ void operator()(const f32x4 (&acc)[2][2][4][2], const Unit& u, int wr, int wc, int fr, int fq) const {
        const int row0 = u.pm * BM + wr * 64 + fr, col0 = u.pn * BM + wc * 32 + 4 * fq;
#pragma unroll
        for (int ai = 0; ai < 2; ++ai)
#pragma unroll
            for (int m = 0; m < 4; ++m) { const int row = row0 + ai * HALF + m * 16; const size_t off = (size_t)row * DM + col0; float s = 0.f;
#pragma unroll
                for (int bj = 0; bj < 2; ++bj)
#pragma unroll
                    for (int n = 0; n < 2; ++n) { const f32x4 v = *(const f32x4*)(base + off + bj * HALF + n * 16) + acc[ai][bj][m][n];
                        *(f32x4*)(out + off + bj * HALF + n * 16) = v; *(h16x4*)(hb + off + bj * HALF + n * 16) = pack4(v);
                        s += (v[0] * v[0] + v[1] * v[1]) + (v[2] * v[2] + v[3] * v[3]); }
                s += __shfl_xor(s, 16); s += __shfl_xor(s, 32);
                if (fq == 0) ssq[(size_t)row * 16 + u.pn * 4 + wc] = s; }
    }
};
struct EpiGated {
    static constexpr bool PERM = true;
    h16* O; const float* srstd;
    __device__ __forceinline__ void operator()(const f32x4 (&acc)[2][2][4][2], const Unit& u, int wr, int wc, int fr, int fq) const {
        const int row0 = u.pm * BM + wr * 64 + fr, col0 = (u.pn & 3) * HALF + wc * 32 + 8 * fq;
#pragma unroll
        for (int ai = 0; ai < 2; ++ai)
#pragma unroll
            for (int m = 0; m < 4; ++m) { const int row = row0 + ai * HALF + m * 16; const float rs = srstd[row]; f32x4 o[2];
#pragma unroll
                for (int n = 0; n < 2; ++n)
#pragma unroll
                    for (int j = 0; j < 4; ++j) { const float a = acc[ai][0][m][n][j] * rs, b = acc[ai][1][m][n][j] * rs; o[n][j] = siluf_(a) * b; }
                *(h16x8*)(O + (size_t)row * 512 + col0) = pack8(o[0], o[1]); }
    }
};
struct EpiPlain16 {
    static constexpr bool PERM = true;
    h16* O;
    __device__ __forceinline__ void operator()(const f32x4 (&acc)[2][2][4][2], const Unit& u, int wr, int wc, int fr, int fq) const {
        const int row0 = u.pm * BM + wr * 64 + fr, col0 = (u.pn & 3) * BM + wc * 32 + 8 * fq;
#pragma unroll
        for (int ai = 0; ai < 2; ++ai)
#pragma unroll
            for (int m = 0; m < 4; ++m) { h16* rowp = O + (size_t)(row0 + ai * HALF + m * 16) * DM + col0;
#pragma unroll
                for (int bj = 0; bj < 2; ++bj) *(h16x8*)(rowp + bj * HALF) = pack8(acc[ai][bj][m][0], acc[ai][bj][m][1]); }
    }
};

template <class Epi, class Sched>
__device__ __forceinline__ void gemm_phase(LAS unsigned char* lds, const int tid, const Gemm g, const Sched& S, const Epi& E) {
    const int wid = __builtin_amdgcn_readfirstlane(tid >> 6), lane = tid & 63, wr = wid >> 2, wc = wid & 3, fr = lane & 15, fq = lane >> 4;
    const int K = g.K, nt = K / BK;
    unsigned voffA[2], voffB[2];
#pragma unroll
    for (int i = 0; i < 2; ++i) { int R, C; stage_rc(tid * 16 + i * 8192, R, C); const int Rb = Epi::PERM ? ((R & ~31) + perm32(R & 31)) : R;
        voffA[i] = (unsigned)(R * g.lda + C) * 2u; voffB[i] = (unsigned)(Rb * g.ldb + C) * 2u; }
    const size_t kstep = (size_t)(BK * 2);
    const size_t hstepA = (size_t)HALF * g.lda * 2, hstepB = (size_t)HALF * g.ldb * 2;
    const size_t tstepA = 2 * hstepA, tstepB = 2 * hstepB;
    const unsigned ldsw = (unsigned)wid * 1024u;
    const int aoff = lds_byte(wr * 64 + fr, fq * 8), boff = lds_byte(wc * 32 + fr, fq * 8);
#define PG8_SA(b, h) (((b) * 2 + (h)) * HTB)
#define PG8_SB(b, h) ((4 + (b) * 2 + (h)) * HTB)
#define PG8_STAGE(bufoff, gbase, voff) do { _Pragma("unroll") for (int _i = 0; _i < 2; ++_i) \
        __builtin_amdgcn_global_load_lds((const unsigned*)((const char*)(gbase) + (voff)[_i]), (LAS unsigned*)(lds + (bufoff) + ldsw + _i * 8192), 16, 0, 0); } while (0)
#define PG8_LDA(dst, b, h) do { _Pragma("unroll") for (int m = 0; m < 4; ++m) _Pragma("unroll") for (int k = 0; k < 2; ++k) dst[m][k] = *(const LAS h16x8*)(lds + PG8_SA(b, h) + aoff + m * 2048 + k * 1024); } while (0)
#define PG8_LDB(dst, b, h) do { _Pragma("unroll") for (int n = 0; n < 2; ++n) _Pragma("unroll") for (int k = 0; k < 2; ++k) dst[n][k] = *(const LAS h16x8*)(lds + PG8_SB(b, h) + boff + n * 2048 + k * 1024); } while (0)
#define PG8_MMA(ai, bj, At, Bt) do { __builtin_amdgcn_s_setprio(1); _Pragma("unroll") for (int m = 0; m < 4; ++m) _Pragma("unroll") for (int n = 0; n < 2; ++n) _Pragma("unroll") for (int k = 0; k < 2; ++k) \
        acc[ai][bj][m][n] = __builtin_amdgcn_mfma_f32_16x16x32_f16(Bt[n][k], At[m][k], acc[ai][bj][m][n], 0, 0, 0); __builtin_amdgcn_s_setprio(0); } while (0)
#define PG8_WAIT_V(n) asm volatile("s_waitcnt vmcnt(" #n ")" ::: "memory")
#define PG8_WAIT_L(n) asm volatile("s_waitcnt lgkmcnt(" #n ")" ::: "memory")
#define PG8_BAR __builtin_amdgcn_s_barrier()
#define PG8_SCHED __builtin_amdgcn_sched_barrier(0)
    Unit cur, nxt; int ui = 0;
    if (!S.next(0, cur)) return;
    f32x4 acc[2][2][4][2];
#pragma unroll
    for (int a = 0; a < 2; ++a)
#pragma unroll
        for (int b = 0; b < 2; ++b)
#pragma unroll
            for (int m = 0; m < 4; ++m)
#pragma unroll
                for (int n = 0; n < 2; ++n) acc[a][b][m][n] = (f32x4){0.f, 0.f, 0.f, 0.f};
    h16x8 At[4][2], B0[2][2], B1[2][2];
    const char* cA = (const char*)g.A + (size_t)cur.pm * tstepA; const char* cB = (const char*)g.Bt + (size_t)cur.pn * tstepB;
    PG8_STAGE(PG8_SB(0, 0), cB, voffB); PG8_STAGE(PG8_SB(0, 1), cB + hstepB, voffB); PG8_STAGE(PG8_SA(0, 0), cA, voffA); PG8_STAGE(PG8_SA(0, 1), cA + hstepA, voffA);
    if (wr == 1) PG8_BAR;
    PG8_WAIT_V(2); PG8_BAR;
    PG8_STAGE(PG8_SB(1, 0), cB + kstep, voffB); PG8_STAGE(PG8_SA(1, 0), cA + kstep, voffA); PG8_STAGE(PG8_SB(1, 1), cB + hstepB + kstep, voffB);
    PG8_WAIT_V(6); PG8_BAR;
    for (;;) {
        const bool has_next = S.next(ui + 1, nxt);
        const char* nA = has_next ? (const char*)g.A + (size_t)nxt.pm * tstepA : cA; const char* nB = has_next ? (const char*)g.Bt + (size_t)nxt.pn * tstepB : cB;
        for (int t = 0; t < nt; t += 2) {
            const bool last = (t == nt - 2);
            const char* a1 = cA + (size_t)(t + 1) * kstep;
            const char* a2 = last ? nA : cA + (size_t)(t + 2) * kstep; const char* b2 = last ? nB : cB + (size_t)(t + 2) * kstep;
            const char* a3 = a2 + kstep; const char* b3 = b2 + kstep;
            PG8_LDB(B0, 0, 0); PG8_LDB(B1, 0, 1); PG8_SCHED; PG8_LDA(At, 0, 0); PG8_STAGE(PG8_SA(1, 1), a1 + hstepA, voffA);
            PG8_WAIT_V(8); PG8_WAIT_L(0); PG8_BAR; PG8_MMA(0, 0, At, B0); PG8_MMA(0, 1, At, B1); PG8_BAR; PG8_SCHED;
            PG8_LDA(At, 0, 1); PG8_STAGE(PG8_SB(0, 0), b2, voffB); PG8_STAGE(PG8_SB(0, 1), b2 + hstepB, voffB); PG8_STAGE(PG8_SA(0, 0), a2, voffA);
            PG8_WAIT_V(8); PG8_WAIT_L(0); PG8_BAR; PG8_MMA(1, 0, At, B0); PG8_MMA(1, 1, At, B1); PG8_BAR; PG8_SCHED;
            PG8_LDB(B0, 1, 0); PG8_LDB(B1, 1, 1); PG8_SCHED; PG8_LDA(At, 1, 0); PG8_STAGE(PG8_SA(0, 1), a2 + hstepA, voffA);
            PG8_WAIT_V(8); PG8_WAIT_L(0); PG8_BAR; PG8_MMA(0, 0, At, B0); PG8_MMA(0, 1, At, B1); PG8_BAR; PG8_SCHED;
            PG8_LDA(At, 1, 1); PG8_STAGE(PG8_SB(1, 0), b3, voffB); PG8_STAGE(PG8_SB(1, 1), b3 + hstepB, voffB); PG8_STAGE(PG8_SA(1, 0), a3, voffA);
            PG8_WAIT_V(8); PG8_WAIT_L(0); PG8_BAR; PG8_MMA(1, 0, At, B0); PG8_MMA(1, 1, At, B1); PG8_BAR; PG8_SCHED;
        }
        if (wr == 0) PG8_BAR;
        E(acc, cur, wr, wc, fr, fq);
        if (!has_next) break;
#pragma unroll
        for (int a = 0; a < 2; ++a)
#pragma unroll
            for (int b = 0; b < 2; ++b)
#pragma unroll
                for (int m = 0; m < 4; ++m)
#pragma unroll
                    for (int n = 0; n < 2; ++n) acc[a][b][m][n] = (f32x4){0.f, 0.f, 0.f, 0.f};
        cur = nxt; cA = nA; cB = nB; ++ui;
        if (wr == 1) PG8_BAR;
    }
    PG8_WAIT_V(0);
    PG8_BAR;
#undef PG8_SA
#undef PG8_SB
#undef PG8_STAGE
#undef PG8_LDA
#undef PG8_LDB
#undef PG8_MMA
#undef PG8_WAIT_V
#undef PG8_WAIT_L
#undef PG8_BAR
#undef PG8_SCHED
}
}

struct Frame {
    LAS unsigned char* lds;
    unsigned char* ws;
    int tid, lane, wave, G, vcu;
};
#define WSP(T, off) ((T*)(F.ws + (off)))
__device__ __forceinline__ void launder(Frame& F) {
    int wv = F.wave; asm volatile("" : "+s"(wv)); F.wave = wv;
    int t = wv * 64 + (int)__builtin_amdgcn_mbcnt_hi(~0u, __builtin_amdgcn_mbcnt_lo(~0u, 0u)); asm volatile("" : "+v"(t)); F.tid = t; F.lane = t & 63;
    const unsigned long long w = (unsigned long long)F.ws; unsigned wl = __builtin_amdgcn_readfirstlane((unsigned)w), wh = __builtin_amdgcn_readfirstlane((unsigned)(w >> 32));
    asm volatile("" : "+s"(wl), "+s"(wh)); F.ws = (unsigned char*)(((unsigned long long)wh << 32) | wl);
    unsigned lo = __builtin_amdgcn_readfirstlane((unsigned)(uintptr_t)F.lds); asm volatile("" : "+s"(lo)); F.lds = (LAS unsigned char*)(uintptr_t)lo;
    int v = __builtin_amdgcn_readfirstlane(F.vcu); asm volatile("" : "+s"(v)); F.vcu = v;
}

__device__ __forceinline__ void tr_item(const float* W, int ldw, int sc, int nvalid, const float* g, float mul, h16* Wt, int ldt, int d0, int k0, LAS float* scr, int lane) {
    const int n = lane & 31;
#pragma unroll 8
    for (int i = 0; i < 32; ++i) { const int kk = 2 * i + (lane >> 5); float v = 0.f;
        if (n < nvalid) { v = W[(size_t)(k0 + kk) * ldw + sc + n] * mul; if (g) v *= g[k0 + kk]; }
        scr[kk * 33 + n] = v; }
    asm volatile("s_waitcnt lgkmcnt(0)" ::: "memory");
    const int c = lane & 7;
#pragma unroll
    for (int j = 0; j < 4; ++j) { const int nn = (lane >> 3) + 8 * j; const LAS float* s = scr + (8 * c) * 33 + nn;
        h16x8 o;
#pragma unroll
        for (int e = 0; e < 8; ++e) o[e] = (h16)s[e * 33];
        *(h16x8*)(Wt + (size_t)(d0 + nn) * ldt + k0 + 8 * c) = o; }
    asm volatile("s_waitcnt lgkmcnt(0)" ::: "memory");
}
__device__ __forceinline__ void phase_convert(const Frame& F, const Prm& p, int l) {
    LAS float* scr = (LAS float*)(F.lds + F.wave * 16384);
    const int gw = F.vcu * 8 + F.wave, NGW = F.G * 8;
    constexpr int I_IN = 112 * 16, I_OUT = 512, I_Q = 512, I_KV = 1024, I_O = 512, I_13 = 32 * 32 * 16, I_2 = 32 * 32 * 8, I_L = 32;
    constexpr int NITEMS = I_IN + I_OUT + I_Q + I_KV + I_O + I_13 + I_2 + I_L;
    for (int it = gw; it < NITEMS; it += NGW) {
        int r = it;
        if (r < I_IN) { const int db = r / 16, kb = r % 16, d0 = 32 * db; int sc, nv;
            if (d0 < 2816) { sc = d0; nv = 32; } else if (d0 < 3328) { sc = d0 + 6; nv = 32; } else if (d0 == 3328) { sc = 2816; nv = 6; } else { sc = 0; nv = 0; }
            tr_item(p.in[3] + (size_t)l * DM * DIN, DIN, sc, nv, p.in[2] + l * DM, 1.f, WSP(h16, WS_WIN), DM, d0, 64 * kb, scr, F.lane); continue; } r -= I_IN;
        if (r < I_OUT) { tr_item(p.in[4] + (size_t)l * DM * DM, DM, 32 * (r / 16), 32, nullptr, 1.f, WSP(h16, WS_WOUT), DM, 32 * (r / 16), 64 * (r % 16), scr, F.lane); continue; } r -= I_OUT;
        if (r < I_Q) { tr_item(p.in[20] + (size_t)l * DM * DM, DM, 32 * (r / 16), 32, p.in[18] + l * DM, 0.0625f, WSP(h16, WS_WQ), DM, 32 * (r / 16), 64 * (r % 16), scr, F.lane); continue; } r -= I_Q;
        if (r < I_KV) { tr_item(p.in[21] + (size_t)l * DM * 2048, 2048, 32 * (r / 16), 32, p.in[19] + l * DM, 1.f, WSP(h16, WS_WKV), DM, 32 * (r / 16), 64 * (r % 16), scr, F.lane); continue; } r -= I_KV;
        if (r < I_O) { tr_item(p.in[22] + (size_t)l * DM * DM, DM, 32 * (r / 16), 32, nullptr, 1.f, WSP(h16, WS_WO), DM, 32 * (r / 16), 64 * (r % 16), scr, F.lane); continue; } r -= I_O;
        if (r < I_13) { const int e = r / 512, q = r % 512, db = q / 16, kb = q % 16, d0 = 32 * db, grp = d0 >> 8, rr = d0 & 255;
            const float* src = (rr < 128 ? p.in[28] : p.in[29]) + (size_t)(l * 32 + e) * DM * 512;
            tr_item(src, 512, grp * 128 + (rr & 127), 32, p.in[23] + l * DM, 1.f, WSP(h16, WS_W13) + (size_t)e * DM * DM, DM, d0, 64 * kb, scr, F.lane); continue; } r -= I_13;
        if (r < I_2) { const int e = r / 256, q = r % 256, db = q / 8, kb = q % 8;
            tr_item(p.in[30] + (size_t)(l * 32 + e) * 512 * DM, DM, 32 * db, 32, nullptr, 1.f, WSP(h16, WS_W2) + (size_t)e * DM * 512, 512, 32 * db, 64 * kb, scr, F.lane); continue; } r -= I_2;
        { const int db = r & 1, q = r >> 1, blk = q & 3, gate = (q >> 2) & 1, dir = q >> 3;
            const float* src = (gate ? p.in[16] : p.in[14]) + (size_t)((l * 2 + dir) * 4 + blk) * 4096;
            tr_item(src, 64, 32 * db, 32, nullptr, 1.f, WSP(h16, WS_LRUW) + (size_t)((dir * 2 + gate) * 4 + blk) * 4096, 64, 32 * db, 0, scr, F.lane); }
    }
    if (l == 0) {
        for (int m = gw; m < NT + NTM; m += NGW) {
            const bool isx = m < NT; const int row = isx ? m : m - NT;
            const float* src = (isx ? p.in[0] : p.in[1]) + (size_t)row * DM; h16* dst = (isx ? WSP(h16, WS_HB) : WSP(h16, WS_MEM16)) + (size_t)row * DM;
            float* sq = (isx ? WSP(float, WS_SSQ) : WSP(float, OFF_MSSQ)) + (size_t)row * 16;
            float s = 0.f;
#pragma unroll
            for (int j = 0; j < 4; ++j) { const f32x4 v = *(const f32x4*)(src + 4 * F.lane + 256 * j); *(h16x4*)(dst + 4 * F.lane + 256 * j) = pack4(v); s += (v[0] * v[0] + v[1] * v[1]) + (v[2] * v[2] + v[3] * v[3]); }
            s = wave_sum(s);
            if (F.lane < 16) sq[F.lane] = (F.lane == 0) ? s : 0.f;
        }
        float* rope = WSP(float, OFF_ROPE);
        for (int i = F.vcu * 512 + F.tid; i < SEQ * 32; i += F.G * 512) {
            const int pos = i >> 5, fi = i & 31; double th = 1.0;
            for (int k = 0; k < fi; ++k) th *= 0.74989420933245582730;
            const double rev = (double)pos * th * 0.15915494309189533577;
            const double fr = rev - floor(rev);
            const double r = (fr - 0.5) * 6.28318530717958647692;
            const double r2 = r * r; double sn = 1.0, cs = 1.0;
            for (int k = 14; k >= 1; --k) { sn = 1.0 - r2 / (double)((2 * k) * (2 * k + 1)) * sn; cs = 1.0 - r2 / (double)((2 * k - 1) * (2 * k)) * cs; }
            sn *= r;
            rope[pos * 64 + fi] = (float)(-cs); rope[pos * 64 + 32 + fi] = (float)(-sn);
        }
    }
}

__device__ __forceinline__ void conv8(const h16* projcol, long tbase, int n, int row, const float* cw, int cdim, const float* cb, float (&o)[8]) {
    const f32x4 b0 = *(const f32x4*)cb, b1 = *(const f32x4*)(cb + 4);
    o[0] = b0[0]; o[1] = b0[1]; o[2] = b0[2]; o[3] = b0[3]; o[4] = b1[0]; o[5] = b1[1]; o[6] = b1[2]; o[7] = b1[3];
#pragma unroll
    for (int k = 0; k < 4; ++k) { const int pos = n * 128 + row - 2 + k;
        if (pos >= 0 && pos < SEQ) { const h16x8 x = *(const h16x8*)(projcol + (size_t)(tbase + row - 2 + k) * NPJ);
            const f32x4 w0 = *(const f32x4*)(cw + k * cdim), w1 = *(const f32x4*)(cw + k * cdim + 4);
#pragma unroll
            for (int e = 0; e < 4; ++e) { o[e] += w0[e] * (float)x[e]; o[4 + e] += w1[e] * (float)x[4 + e]; } } }
}

__device__ __forceinline__ void ret_states_unit(const Frame& F, int u) {
    const int h = u % 6, bn = u / 6, n = bn % NCH, b = bn / NCH; const long t0 = (long)b * SEQ + n * 128;
    const h16* proj = WSP(const h16, WS_R1); const float* rope = WSP(const float, OFF_ROPE);
    LAS h16* KT = (LAS h16*)F.lds; LAS h16* VT = KT + 64 * 136;
    { const int r = F.tid >> 2, c = F.tid & 3; const h16* rowp = proj + (size_t)(t0 + r) * NPJ; const float* cs = rope + (size_t)(n * 128 + r) * 64 + 8 * c;
        const h16x8 k1 = *(const h16x8*)(rowp + CK + h * 64 + 8 * c), k2 = *(const h16x8*)(rowp + CK + h * 64 + 32 + 8 * c);
        const f32x4 c0 = *(const f32x4*)cs, c1 = *(const f32x4*)(cs + 4), s0 = *(const f32x4*)(cs + 32), s1 = *(const f32x4*)(cs + 36);
#pragma unroll
        for (int e = 0; e < 8; ++e) { const float x1 = (float)k1[e], x2 = (float)k2[e], co = e < 4 ? c0[e] : c1[e - 4], si = e < 4 ? s0[e] : s1[e - 4];
            KT[(8 * c + e) * 136 + r] = (h16)((x1 * co - x2 * si) * 0.125f); KT[(32 + 8 * c + e) * 136 + r] = (h16)((x1 * si + x2 * co) * 0.125f); }
        const h16x8 v1 = *(const h16x8*)(rowp + CV + h * 64 + 16 * c), v2 = *(const h16x8*)(rowp + CV + h * 64 + 16 * c + 8);
#pragma unroll
        for (int e = 0; e < 8; ++e) { VT[(16 * c + e) * 136 + r] = v1[e]; VT[(16 * c + 8 + e) * 136 + r] = v2[e]; } }
    __syncthreads();
    const int dir = F.wave >> 2, dt = F.wave & 3, fr = F.lane & 15, fq = F.lane >> 4;
    const float l2g = log1pf(-exp2f(-5.0f - (float)h)) * 1.4426950408889634f;
    h16x8 xw[4];
#pragma unroll
    for (int ks = 0; ks < 4; ++ks) { const h16x8 f = ldsfrag(KT + (16 * dt + fr) * 136 + 32 * ks + 8 * fq); h16x8 w;
#pragma unroll
        for (int jj = 0; jj < 8; ++jj) { const int j = 32 * ks + 8 * fq + jj; w[jj] = (h16)exp2f(l2g * (float)(dir == 0 ? 127 - j : j)); }
        xw[ks] = f * w; }
    h16* rst = WSP(h16, OFF_RST) + ((size_t)((dir * NB + b) * NCH + n) * 6 + h) * 4096;
#pragma unroll
    for (int et = 0; et < 4; ++et) { f32x4 acc = {0.f, 0.f, 0.f, 0.f};
#pragma unroll
        for (int ks = 0; ks < 4; ++ks) acc = MFMA16(xw[ks], ldsfrag(VT + (16 * et + fr) * 136 + 32 * ks + 8 * fq), acc);
        *(h16x4*)(rst + (16 * et + fr) * 64 + 16 * dt + 4 * fq) = pack4(acc); }
    __syncthreads();
}
__device__ __forceinline__ void ret_scan_unit(const Frame& F, int u) {
    const int h = u % 6, b = (u / 6) % NB, dir = u / (6 * NB);
    const float gC = exp2f(128.0f * log1pf(-exp2f(-5.0f - (float)h)) * 1.4426950408889634f);
    float acc[8];
#pragma unroll
    for (int e = 0; e < 8; ++e) acc[e] = 0.f;
    for (int i = 0; i < NCH; ++i) { const int n = dir == 0 ? i : NCH - 1 - i;
        h16* pp = WSP(h16, OFF_RST) + ((size_t)((dir * NB + b) * NCH + n) * 6 + h) * 4096 + F.tid * 8;
        const h16x8 s = *(const h16x8*)pp; h16x8 o;
#pragma unroll
        for (int e = 0; e < 8; ++e) { o[e] = (h16)acc[e]; acc[e] = acc[e] * gC + (float)s[e]; }
        *(h16x8*)pp = o; }
}
__device__ __forceinline__ void ret_out_unit(const Frame& F, int u) {
    const int h = u % 6, bn = u / 6, n = bn % NCH, b = bn / NCH; const long t0 = (long)b * SEQ + n * 128;
    const h16* proj = WSP(const h16, WS_R1); const float* rope = WSP(const float, OFF_ROPE);
    LAS h16* Qt = (LAS h16*)F.lds; LAS h16* Kt = Qt + 128 * 72; LAS h16* VT = Kt + 128 * 72; LAS h16* Ff = VT + 64 * 136; LAS h16* Fb = Ff + 64 * 72;
    { const int r = F.tid >> 2, c = F.tid & 3; const h16* rowp = proj + (size_t)(t0 + r) * NPJ; const float* cs = rope + (size_t)(n * 128 + r) * 64 + 8 * c;
        const f32x4 c0 = *(const f32x4*)cs, c1 = *(const f32x4*)(cs + 4), s0 = *(const f32x4*)(cs + 32), s1 = *(const f32x4*)(cs + 36);
        const h16x8 q1 = *(const h16x8*)(rowp + CQ + h * 64 + 8 * c), q2 = *(const h16x8*)(rowp + CQ + h * 64 + 32 + 8 * c);
        const h16x8 k1 = *(const h16x8*)(rowp + CK + h * 64 + 8 * c), k2 = *(const h16x8*)(rowp + CK + h * 64 + 32 + 8 * c);
        h16x8 qa, qb, ka, kb;
#pragma unroll
        for (int e = 0; e < 8; ++e) { const float co = e < 4 ? c0[e] : c1[e - 4], si = e < 4 ? s0[e] : s1[e - 4];
            float x1 = (float)q1[e], x2 = (float)q2[e]; qa[e] = (h16)(x1 * co - x2 * si); qb[e] = (h16)(x1 * si + x2 * co);
            x1 = (float)k1[e]; x2 = (float)k2[e]; ka[e] = (h16)((x1 * co - x2 * si) * 0.125f); kb[e] = (h16)((x1 * si + x2 * co) * 0.125f); }
        *(LAS h16x8*)(Qt + r * 72 + 8 * c) = qa; *(LAS h16x8*)(Qt + r * 72 + 32 + 8 * c) = qb;
        *(LAS h16x8*)(Kt + r * 72 + 8 * c) = ka; *(LAS h16x8*)(Kt + r * 72 + 32 + 8 * c) = kb;
        const h16x8 v1 = *(const h16x8*)(rowp + CV + h * 64 + 16 * c), v2 = *(const h16x8*)(rowp + CV + h * 64 + 16 * c + 8);
#pragma unroll
        for (int e = 0; e < 8; ++e) { VT[(16 * c + e) * 136 + r] = v1[e]; VT[(16 * c + 8 + e) * 136 + r] = v2[e]; }
        const int er = F.tid >> 3, d0 = (F.tid & 7) * 8;
        const h16* sf = WSP(const h16, OFF_RST) + ((size_t)((0 * NB + b) * NCH + n) * 6 + h) * 4096;
        const h16* sb = WSP(const h16, OFF_RST) + ((size_t)((1 * NB + b) * NCH + n) * 6 + h) * 4096;
        *(LAS h16x8*)(Ff + er * 72 + d0) = *(const h16x8*)(sf + F.tid * 8); *(LAS h16x8*)(Fb + er * 72 + d0) = *(const h16x8*)(sb + F.tid * 8); }
    __syncthreads();
    const int w = F.wave, fr = F.lane & 15, fq = F.lane >> 4, il = 16 * w + fr;
    const float l2g = log1pf(-exp2f(-5.0f - (float)h)) * 1.4426950408889634f;
    h16x8 qf[2];
#pragma unroll
    for (int ks = 0; ks < 2; ++ks) qf[ks] = ldsfrag(Qt + il * 72 + 32 * ks + 8 * fq);
    f32x4 s[8];
#pragma unroll
    for (int jt = 0; jt < 8; ++jt) { f32x4 a = {0.f, 0.f, 0.f, 0.f};
#pragma unroll
        for (int ks = 0; ks < 2; ++ks) a = MFMA16(ldsfrag(Kt + (16 * jt + fr) * 72 + 32 * ks + 8 * fq), qf[ks], a);
#pragma unroll
        for (int r = 0; r < 4; ++r) { const int j = 16 * jt + 4 * fq + r; const int dd = il > j ? il - j : j - il; a[r] *= exp2f(l2g * (float)dd); }
        PINV(a); s[jt] = a; }
    f32x4 o[4];
#pragma unroll
    for (int et = 0; et < 4; ++et) o[et] = (f32x4){0.f, 0.f, 0.f, 0.f};
#pragma unroll
    for (int kp = 0; kp < 4; ++kp) { const h16x8 pf = pack8(s[2 * kp], s[2 * kp + 1]);
#pragma unroll
        for (int et = 0; et < 4; ++et) o[et] = MFMA16(ldsfrag2(VT + (16 * et + fr) * 136 + 32 * kp + 4 * fq, VT + (16 * et + fr) * 136 + 32 * kp + 16 + 4 * fq), pf, o[et]); }
    const float gf = exp2f(l2g * (float)(il + 1)), gb = exp2f(l2g * (float)(128 - il));
#pragma unroll
    for (int ks = 0; ks < 2; ++ks) { const h16x8 qff = scalefrag(qf[ks], gf), qfb = scalefrag(qf[ks], gb);
#pragma unroll
        for (int et = 0; et < 4; ++et) { o[et] = MFMA16(ldsfrag(Ff + (16 * et + fr) * 72 + 32 * ks + 8 * fq), qff, o[et]); o[et] = MFMA16(ldsfrag(Fb + (16 * et + fr) * 72 + 32 * ks + 8 * fq), qfb, o[et]); } }
    float ss = 0.f;
#pragma unroll
    for (int et = 0; et < 4; ++et) ss += (o[et][0] * o[et][0] + o[et][1] * o[et][1]) + (o[et][2] * o[et][2] + o[et][3] * o[et][3]);
    ss += __shfl_xor(ss, 16); ss += __shfl_xor(ss, 32);
    const float rs = 1.0f / sqrtf(ss * (1.0f / 64.0f) + EPS);
    const h16* grow = proj + (size_t)(t0 + il) * NPJ + CG + h * 64; h16* orow = WSP(h16, OFF_OMIX) + (size_t)(t0 + il) * DM + h * 64;
#pragma unroll
    for (int et = 0; et < 4; ++et) { const h16x4 gv = *(const h16x4*)(grow + 16 * et + 4 * fq); f32x4 r;
#pragma unroll
        for (int e = 0; e < 4; ++e) r[e] = o[et][e] * rs * siluf_((float)gv[e]);
        *(h16x4*)(orow + 16 * et + 4 * fq) = pack4(r); }
    __syncthreads();
}

__device__ __forceinline__ void ssd_stage_dt(const Frame& F, const Prm& p, int l, int g, long t0, LAS float* LA, LAS float* DTS) {
    if (F.tid < 128) { const h16* dp = WSP(const h16, WS_R1) + (size_t)(t0 + F.tid) * NPJ + CDT + g * 3;
#pragma unroll
        for (int r = 0; r < 3; ++r) { const float raw = (float)dp[r];
#pragma unroll
            for (int dir = 0; dir < 2; ++dir) { const float dt = softplusf_(raw + p.in[7][(l * 2 + dir) * 6 + g * 3 + r]); const float la = -dt * __expf(p.in[8][(l * 2 + dir) * 6 + g * 3 + r]);
                DTS[(dir * 3 + r) * 128 + F.tid] = dt; LA[(dir * 3 + r) * 128 + F.tid] = la; } } }
}
__device__ __forceinline__ void ssd_cumsum(const Frame& F, LAS const float* LAq, float& v0, float& v1, float& c0, float& c1, float& tot) {
    v0 = LAq[2 * F.lane]; v1 = LAq[2 * F.lane + 1]; float s = v0 + v1;
#pragma unroll
    for (int o = 1; o < 64; o <<= 1) { const float t = __shfl_up(s, o); if (F.lane >= o) s += t; }
    c1 = s; c0 = s - v1; tot = __shfl(s, 63);
}
__device__ __forceinline__ void ssd_states_unit(const Frame& F, const Prm& p, int l, int u) {
    const int g = u & 1, bn = u >> 1, n = bn % NCH, b = bn / NCH; const long t0 = (long)b * SEQ + n * 128;
    const h16* proj = WSP(const h16, WS_R1);
    LAS h16* XT = (LAS h16*)F.lds; LAS h16* BT = XT + 3 * 64 * 136; LAS float* LA = (LAS float*)(BT + 128 * 136); LAS float* DTS = LA + 6 * 128; LAS float* WW = DTS + 6 * 128;
    ssd_stage_dt(F, p, l, g, t0, LA, DTS);
    const float* cw = p.in[5] + (size_t)l * 4 * 896; const float* cb = p.in[6] + (size_t)l * 896;
    for (int it = F.tid; it < 128 * 40; it += 512) { const int row = it / 40, cg = it % 40; float o[8];
        if (cg < 24) { conv8(proj + CXS + g * 192 + 8 * cg, t0, n, row, cw + g * 192 + 8 * cg, 896, cb + g * 192 + 8 * cg, o);
            LAS h16* d = XT + (cg >> 3) * 64 * 136 + ((cg & 7) * 8) * 136 + row;
#pragma unroll
            for (int e = 0; e < 8; ++e) d[e * 136] = (h16)siluf_(o[e]);
        } else { const int cb8 = cg - 24; conv8(proj + CBM + g * 128 + 8 * cb8, t0, n, row, cw + 384 + g * 128 + 8 * cb8, 896, cb + 384 + g * 128 + 8 * cb8, o);
            LAS h16* d = BT + (8 * cb8) * 136 + row;
#pragma unroll
            for (int e = 0; e < 8; ++e) d[e * 136] = (h16)siluf_(o[e]); } }
    __syncthreads();
    if (F.wave < 6) { const int q = F.wave, dir = q / 3, r = q % 3; float v0, v1, c0, c1, tot; ssd_cumsum(F, LA + q * 128, v0, v1, c0, c1, tot);
        const float d0 = DTS[q * 128 + 2 * F.lane], d1 = DTS[q * 128 + 2 * F.lane + 1];
        if (dir == 0) { WW[q * 128 + 2 * F.lane] = __expf(tot - c0) * d0 * 256.f; WW[q * 128 + 2 * F.lane + 1] = __expf(tot - c1) * d1 * 256.f; }
        else { WW[q * 128 + 2 * F.lane] = __expf(c0 - v0) * d0 * 256.f; WW[q * 128 + 2 * F.lane + 1] = __expf(c1 - v1) * d1 * 256.f; }
        if (F.lane == 0) WSP(float, OFF_SDEC)[((size_t)(b * NCH + n) * 6 + g * 3 + r) * 2 + dir] = tot; }
    __syncthreads();
    const int w = F.wave, fr = F.lane & 15, fq = F.lane >> 4;
    h16x8 xb[4];
#pragma unroll
    for (int ks = 0; ks < 4; ++ks) xb[ks] = ldsfrag(BT + (16 * w + fr) * 136 + 32 * ks + 8 * fq);
    for (int q = 0; q < 6; ++q) { const int dir = q / 3, r = q % 3;
        h16x8 wf[4];
#pragma unroll
        for (int ks = 0; ks < 4; ++ks) { const f32x4 a = *(LAS const f32x4*)(WW + q * 128 + 32 * ks + 8 * fq), c = *(LAS const f32x4*)(WW + q * 128 + 32 * ks + 8 * fq + 4); wf[ks] = pack8(a, c); }
        h16* sst = WSP(h16, OFF_SST) + ((size_t)((dir * NB + b) * NCH + n) * 6 + g * 3 + r) * 8192;
#pragma unroll
        for (int pt = 0; pt < 4; ++pt) { f32x4 acc = {0.f, 0.f, 0.f, 0.f};
#pragma unroll
            for (int ks = 0; ks < 4; ++ks) acc = MFMA16(xb[ks], ldsfrag(XT + r * 64 * 136 + (16 * pt + fr) * 136 + 32 * ks + 8 * fq) * wf[ks], acc);
            *(h16x4*)(sst + (16 * pt + fr) * 128 + 16 * w + 4 * fq) = pack4(acc * (1.0f / 256.f)); } }
    __syncthreads();
}
__device__ __forceinline__ void ssd_scan_unit(const Frame& F, int u) {
    const int hd = u % 6, b = (u / 6) % NB, dir = u / (6 * NB);
    float acc[16];
#pragma unroll
    for (int e = 0; e < 16; ++e) acc[e] = 0.f;
    for (int i = 0; i < NCH; ++i) { const int n = dir == 0 ? i : NCH - 1 - i;
        h16* pp = WSP(h16, OFF_SST) + ((size_t)((dir * NB + b) * NCH + n) * 6 + hd) * 8192 + F.tid * 16;
        const float dec = __expf(WSP(const float, OFF_SDEC)[((size_t)(b * NCH + n) * 6 + hd) * 2 + dir]);
        const h16x8 s0 = *(const h16x8*)pp, s1 = *(const h16x8*)(pp + 8); h16x8 o0, o1;
#pragma unroll
        for (int e = 0; e < 8; ++e) { o0[e] = (h16)acc[e]; o1[e] = (h16)acc[8 + e]; acc[e] = acc[e] * dec + (float)s0[e]; acc[8 + e] = acc[8 + e] * dec + (float)s1[e]; }
        *(h16x8*)pp = o0; *(h16x8*)(pp + 8) = o1; }
}
__device__ __forceinline__ void ssd_out_unit(const Frame& F, const Prm& p, int l, int u) {
    const int g = u & 1, bn = u >> 1, n = bn % NCH, b = bn / NCH; const long t0 = (long)b * SEQ + n * 128;
    const h16* proj = WSP(const h16, WS_R1);
    LAS h16* XT = (LAS h16*)F.lds; LAS h16* Bt = XT + 3 * 64 * 136; LAS h16* Ct = Bt + 128 * 136; LAS float* LA = (LAS float*)(Ct + 128 * 136); LAS float* DTS = LA + 6 * 128;
    LAS float* CE = DTS + 6 * 128;
    LAS float* TOTB = CE + 6 * 128;
    ssd_stage_dt(F, p, l, g, t0, LA, DTS);
    const float* cw = p.in[5] + (size_t)l * 4 * 896; const float* cb = p.in[6] + (size_t)l * 896;
    for (int it = F.tid; it < 128 * 56; it += 512) { const int row = it / 56, cg = it % 56; float o[8];
        if (cg < 24) { conv8(proj + CXS + g * 192 + 8 * cg, t0, n, row, cw + g * 192 + 8 * cg, 896, cb + g * 192 + 8 * cg, o);
            LAS h16* d = XT + (cg >> 3) * 64 * 136 + ((cg & 7) * 8) * 136 + row;
#pragma unroll
            for (int e = 0; e < 8; ++e) d[e * 136] = (h16)siluf_(o[e]);
        } else { const int c8 = (cg - 24) & 15; const bool isB = cg < 40; const int col = (isB ? CBM : CCM) + g * 128 + 8 * c8, ci = (isB ? 384 : 640) + g * 128 + 8 * c8;
            conv8(proj + col, t0, n, row, cw + ci, 896, cb + ci, o); h16x8 v;
#pragma unroll
            for (int e = 0; e < 8; ++e) v[e] = (h16)siluf_(o[e]);
            *(LAS h16x8*)((isB ? Bt : Ct) + row * 136 + 8 * c8) = v; } }
    __syncthreads();
    if (F.wave < 6) { const int q = F.wave; float v0, v1, c0, c1, tot; ssd_cumsum(F, LA + q * 128, v0, v1, c0, c1, tot);
        if (q < 3) { CE[q * 128 + 2 * F.lane] = c0; CE[q * 128 + 2 * F.lane + 1] = c1; }
        else { CE[q * 128 + 2 * F.lane] = c0 - v0; CE[q * 128 + 2 * F.lane + 1] = c1 - v1; if (F.lane == 0) TOTB[q - 3] = tot; } }
    __syncthreads();
    const int w = F.wave, fr = F.lane & 15, fq = F.lane >> 4, il = 16 * w + fr;
    h16x8 cf[4];
#pragma unroll
    for (int ks = 0; ks < 4; ++ks) cf[ks] = ldsfrag(Ct + il * 136 + 32 * ks + 8 * fq);
    f32x4 gT[8];
#pragma unroll
    for (int jt = 0; jt < 8; ++jt) { f32x4 a = {0.f, 0.f, 0.f, 0.f};
#pragma unroll
        for (int ks = 0; ks < 4; ++ks) a = MFMA16(ldsfrag(Bt + (16 * jt + fr) * 136 + 32 * ks + 8 * fq), cf[ks], a);
        PINV(a); gT[jt] = a; }
    const float* dsk = p.in[9] + l * 6 + g * 3;
    h16* orow = WSP(h16, OFF_OMIX) + (size_t)(t0 + il) * DM + 384 + g * 192;
    float ss = 0.f;
#pragma unroll 1
    for (int r = 0; r < 3; ++r) {
        f32x4 y[1][4];
        const int hd = g * 3 + r;
        const float cfi = CE[r * 128 + il], ebi = CE[(3 + r) * 128 + il], totb = TOTB[r];
#pragma unroll
        for (int pt = 0; pt < 4; ++pt) y[0][pt] = (f32x4){0.f, 0.f, 0.f, 0.f};
#pragma unroll
        for (int kp = 0; kp < 4; ++kp) { f32x4 pv[2];
#pragma unroll
            for (int jh = 0; jh < 2; ++jh) { const int jt = 2 * kp + jh, j0 = 16 * jt + 4 * fq;
                const f32x4 cfj = *(LAS const f32x4*)(CE + r * 128 + j0), ebj = *(LAS const f32x4*)(CE + (3 + r) * 128 + j0), dfj = *(LAS const f32x4*)(DTS + r * 128 + j0), dbj = *(LAS const f32x4*)(DTS + (3 + r) * 128 + j0);
#pragma unroll
                for (int e = 0; e < 4; ++e) { const int j = j0 + e; const float val = (il >= j) ? __expf(cfi - cfj[e]) * dfj[e] : __expf(ebj[e] - ebi) * dbj[e]; pv[jh][e] = gT[jt][e] * val * 256.f; } }
            const h16x8 pf = pack8(pv[0], pv[1]);
#pragma unroll
            for (int pt = 0; pt < 4; ++pt) { LAS const h16* xr = XT + r * 64 * 136 + (16 * pt + fr) * 136 + 32 * kp + 4 * fq; y[0][pt] = MFMA16(ldsfrag2(xr, xr + 16), pf, y[0][pt]); }
            PINV(y[0][0]); PINV(y[0][1]); PINV(y[0][2]); PINV(y[0][3]); }
        const float ef = __expf(cfi) * 256.f, eb = __expf(totb - ebi) * 256.f;
        const h16* hf = WSP(const h16, OFF_SST) + ((size_t)((0 * NB + b) * NCH + n) * 6 + hd) * 8192;
        const h16* hb = WSP(const h16, OFF_SST) + ((size_t)((1 * NB + b) * NCH + n) * 6 + hd) * 8192;
#pragma unroll
        for (int ks = 0; ks < 4; ++ks) { const h16x8 cff = scalefrag(cf[ks], ef), cfb = scalefrag(cf[ks], eb);
#pragma unroll
            for (int pt = 0; pt < 4; ++pt) { y[0][pt] = MFMA16(*(const h16x8*)(hf + (16 * pt + fr) * 128 + 32 * ks + 8 * fq), cff, y[0][pt]);
                y[0][pt] = MFMA16(*(const h16x8*)(hb + (16 * pt + fr) * 128 + 32 * ks + 8 * fq), cfb, y[0][pt]); }
            PINV(y[0][0]); PINV(y[0][1]); PINV(y[0][2]); PINV(y[0][3]); }
        const float dk = dsk[r]; const h16* zrow = proj + (size_t)(t0 + il) * NPJ + CZ + hd * 64;
#pragma unroll
        for (int pt = 0; pt < 4; ++pt) { const h16x4 zv = *(const h16x4*)(zrow + 16 * pt + 4 * fq);
#pragma unroll
            for (int e = 0; e < 4; ++e) { const float xv = (float)XT[r * 64 * 136 + (16 * pt + 4 * fq + e) * 136 + il]; y[0][pt][e] = (y[0][pt][e] * (1.0f / 256.f) + dk * xv) * siluf_((float)zv[e]); }
            const h16x4 yh = pack4(y[0][pt]); *(h16x4*)(orow + r * 64 + 16 * pt + 4 * fq) = yh;
#pragma unroll
            for (int e = 0; e < 4; ++e) { const float q = (float)yh[e]; ss += q * q; } }
    }
    ss += __shfl_xor(ss, 16); ss += __shfl_xor(ss, 32);
    const float rs = 1.0f / sqrtf(ss * (1.0f / 192.0f) + EPS);
    const float* nw = p.in[10] + l * 384 + g * 192;
    asm volatile("s_waitcnt vmcnt(0)" ::: "memory");
#pragma unroll 1
    for (int r = 0; r < 3; ++r)
#pragma unroll
        for (int pt = 0; pt < 4; ++pt) { const f32x4 wv = *(const f32x4*)(nw + r * 64 + 16 * pt + 4 * fq); h16* op = orow + r * 64 + 16 * pt + 4 * fq; const h16x4 yh = *(const h16x4*)op; f32x4 yv;
#pragma unroll
            for (int e = 0; e < 4; ++e) yv[e] = (float)yh[e] * rs * wv[e];
            *(h16x4*)op = pack4(yv); }
    __syncthreads();
}

template <bool FINAL>
__device__ __forceinline__ void lru_unit(const Frame& F, const Prm& p, int l, int u) {
    const int n = u % NCH, b = u / NCH; const long t0 = (long)b * SEQ + n * 128;
    const h16* proj = WSP(const h16, WS_R1);
    LAS h16* XC = (LAS h16*)F.lds;
    const float* cw = p.in[11] + (size_t)l * 4 * 256; const float* cb = p.in[12] + (size_t)l * 256;
    for (int it = F.tid; it < 128 * 32; it += 512) { const int row = it >> 5, cg = it & 31; float o[8];
        conv8(proj + CXR + 8 * cg, t0, n, row, cw + 8 * cg, 256, cb + 8 * cg, o); h16x8 v;
#pragma unroll
        for (int e = 0; e < 8; ++e) v[e] = (h16)o[e];
        *(LAS h16x8*)(XC + row * 264 + 8 * cg) = v; }
    __syncthreads();
    const int blk = F.wave & 3, jh = F.wave >> 2, fr = F.lane & 15, fq = F.lane >> 4;
#pragma unroll
    for (int dir = 0; dir < 2; ++dir) {
        h16x8 wa[2][2], wx[2][2]; float ba[2], bx[2], sp[2], car[2];
#pragma unroll
        for (int jt = 0; jt < 2; ++jt) { const int ch = blk * 64 + 32 * jh + 16 * jt + fr;
#pragma unroll
            for (int ks = 0; ks < 2; ++ks) { wa[jt][ks] = *(const h16x8*)(WSP(const h16, WS_LRUW) + (size_t)((dir * 2 + 0) * 4 + blk) * 4096 + (32 * jh + 16 * jt + fr) * 64 + 32 * ks + 8 * fq);
                wx[jt][ks] = *(const h16x8*)(WSP(const h16, WS_LRUW) + (size_t)((dir * 2 + 1) * 4 + blk) * 4096 + (32 * jh + 16 * jt + fr) * 64 + 32 * ks + 8 * fq); }
            ba[jt] = p.in[15][(l * 2 + dir) * 256 + ch]; bx[jt] = p.in[17][(l * 2 + dir) * 256 + ch]; sp[jt] = softplusf_(-p.in[13][(l * 2 + dir) * 256 + ch]);
            car[jt] = FINAL ? WSP(const float, OFF_LCAR)[((size_t)(b * NCH + n) * 2 + dir) * 256 + ch] : 0.f; }
        float atot[2] = {1.f, 1.f};
#pragma unroll 1
        for (int ti = 0; ti < 8; ++ti) { const int tt = dir == 0 ? ti : 7 - ti;
            h16x8 xf[2];
#pragma unroll
            for (int ks = 0; ks < 2; ++ks) xf[ks] = ldsfrag(XC + (16 * tt + fr) * 264 + blk * 64 + 32 * ks + 8 * fq);
#pragma unroll
            for (int jt = 0; jt < 2; ++jt) { const int ch = blk * 64 + 32 * jh + 16 * jt + fr;
                f32x4 ra = {0.f, 0.f, 0.f, 0.f}, ia = {0.f, 0.f, 0.f, 0.f};
#pragma unroll
                for (int ks = 0; ks < 2; ++ks) { ra = MFMA16(xf[ks], wa[jt][ks], ra); ia = MFMA16(xf[ks], wx[jt][ks], ia); }
                float av[4], uv[4]; float A = 1.f, H = 0.f;
#pragma unroll
                for (int ri = 0; ri < 4; ++ri) { const int rg = dir == 0 ? ri : 3 - ri; const float rgate = sigmoidf_(ra[rg] + ba[jt]), ig = sigmoidf_(ia[rg] + bx[jt]);
                    const float la = -8.0f * rgate * sp[jt]; const float a = __expf(la); const float mult = sqrtf(-expm1f(2.0f * la));
                    const float xv = (float)XC[(16 * tt + 4 * fq + rg) * 264 + ch]; const float uu = mult * ig * xv;
                    av[rg] = a; uv[rg] = uu; H = a * H + uu; A *= a; }
                float Ag[4], Hg[4];
#pragma unroll
                for (int gq = 0; gq < 4; ++gq) { Ag[gq] = __shfl(A, fr + 16 * gq); Hg[gq] = __shfl(H, fr + 16 * gq); }
                float hin = car[jt], cnew = car[jt], at = 1.f;
#pragma unroll
                for (int gi = 0; gi < 4; ++gi) { const int gq = dir == 0 ? gi : 3 - gi;
                    const bool before = dir == 0 ? (gq < fq) : (gq > fq);
                    if (before) hin = Ag[gq] * hin + Hg[gq];
                    cnew = Ag[gq] * cnew + Hg[gq]; at *= Ag[gq]; }
                car[jt] = cnew; atot[jt] *= at;
                if (FINAL) { float hh = hin;
#pragma unroll
                    for (int ri = 0; ri < 4; ++ri) { const int rg = dir == 0 ? ri : 3 - ri; hh = av[rg] * hh + uv[rg];
                        const long t = t0 + 16 * tt + 4 * fq + rg; h16* op = WSP(h16, OFF_OMIX) + (size_t)t * DM + 768 + ch;
                        if (dir == 0) *op = (h16)hh;
                        else { const float gt = (float)proj[(size_t)t * NPJ + CGT + ch]; *op = (h16)(((float)*op + hh) * gelu_tanh_(gt)); } } }
            } }
        if (!FINAL && fq == 0) {
#pragma unroll
            for (int jt = 0; jt < 2; ++jt) { const int ch = blk * 64 + 32 * jh + 16 * jt + fr; *(f32x2*)(WSP(float, OFF_LSUM) + (((size_t)(b * NCH + n) * 2 + dir) * 256 + ch) * 2) = (f32x2){atot[jt], car[jt]}; } }
    }
    __syncthreads();
}
__device__ __forceinline__ void lru_scan(const Frame& F) {
    const int gi = F.vcu * 512 + F.tid; if (gi >= NB * 2 * 256) return;
    const int ch = gi & 255, dir = (gi >> 8) & 1, b = gi >> 9; float H = 0.f;
    for (int i = 0; i < NCH; ++i) { const int n = dir == 0 ? i : NCH - 1 - i; const size_t idx = ((size_t)(b * NCH + n) * 2 + dir) * 256 + ch;
        const f32x2 s = *(const f32x2*)(WSP(const float, OFF_LSUM) + idx * 2); WSP(float, OFF_LCAR)[idx] = H; H = s[0] * H + s[1]; }
}

__device__ __forceinline__ void attn_unit(const Frame& F, int u) {
    const int qb = u & 15, hd = (u >> 4) & 3, b = u >> 6;
    const int fr = F.lane & 15, fq = F.lane >> 4; const long t = (long)b * SEQ + qb * 128 + 16 * F.wave + fr;
    LAS h16* TL = (LAS h16*)F.lds;
    const h16* qrow = WSP(const h16, OFF_QCA) + (size_t)t * DM + hd * 256;
    h16x8 qf[8];
#pragma unroll
    for (int ks = 0; ks < 8; ++ks) qf[ks] = *(const h16x8*)(qrow + 32 * ks + 8 * fq);
    f32x4 s[16];
#pragma unroll
    for (int half = 0; half < 2; ++half) {
        __syncthreads();
        const h16* kb = WSP(const h16, OFF_KB) + (size_t)(b * 256 + half * 128) * DM + hd * 256;
        for (int it = F.tid; it < 128 * 32; it += 512) { const int row = it >> 5, c = it & 31; *(LAS h16x8*)(TL + row * 264 + 8 * c) = *(const h16x8*)(kb + (size_t)row * DM + 8 * c); }
        __syncthreads();
#pragma unroll
        for (int jt = 0; jt < 8; ++jt) { f32x4 a = {0.f, 0.f, 0.f, 0.f};
#pragma unroll
            for (int ks = 0; ks < 8; ++ks) a = MFMA16(ldsfrag(TL + (16 * jt + fr) * 264 + 32 * ks + 8 * fq), qf[ks], a);
            PINV(a); s[half * 8 + jt] = a; }
    }
    float mx = -3.0e38f;
#pragma unroll
    for (int jt = 0; jt < 16; ++jt) mx = fmaxf(mx, fmaxf(fmaxf(s[jt][0], s[jt][1]), fmaxf(s[jt][2], s[jt][3])));
    mx = fmaxf(mx, __shfl_xor(mx, 16)); mx = fmaxf(mx, __shfl_xor(mx, 32));
    float sum = 0.f;
#pragma unroll
    for (int jt = 0; jt < 16; ++jt)
#pragma unroll
        for (int e = 0; e < 4; ++e) { const float pe = __expf(s[jt][e] - mx); s[jt][e] = pe; sum += pe; }
    sum += __shfl_xor(sum, 16); sum += __shfl_xor(sum, 32);
    const float inv = 1.0f / sum;
    h16x8 pf[8];
#pragma unroll
    for (int kp = 0; kp < 8; ++kp) pf[kp] = pack8(s[2 * kp] * inv, s[2 * kp + 1] * inv);
    f32x4 o[16];
#pragma unroll
    for (int et = 0; et < 16; ++et) o[et] = (f32x4){0.f, 0.f, 0.f, 0.f};
#pragma unroll
    for (int half = 0; half < 2; ++half) {
        __syncthreads();
        const h16* vt = WSP(const h16, OFF_VT) + (size_t)(b * 4 + hd) * 65536 + half * 128;
        for (int it = F.tid; it < 256 * 16; it += 512) { const int row = it >> 4, c = it & 15; *(LAS h16x8*)(TL + row * 136 + 8 * c) = *(const h16x8*)(vt + (size_t)row * 256 + 8 * c); }
        __syncthreads();
#pragma unroll
        for (int et = 0; et < 16; ++et) {
#pragma unroll
            for (int kp = 0; kp < 4; ++kp) { LAS const h16* vr = TL + (16 * et + fr) * 136 + 32 * kp + 4 * fq; o[et] = MFMA16(ldsfrag2(vr, vr + 16), pf[half * 4 + kp], o[et]); }
            PINV(o[et]); }
    }
    h16* orow = WSP(h16, OFF_OATT) + (size_t)t * DM + hd * 256;
#pragma unroll
    for (int et = 0; et < 16; ++et) *(h16x4*)(orow + 16 * et + 4 * fq) = pack4(o[et]);
}

__device__ __forceinline__ void phase_router(const Frame& F, const Prm& p, int l) {
    LAS float* RW = (LAS float*)F.lds;
    const float* gm = p.in[23] + l * DM; const float* wg = p.in[24] + (size_t)l * DM * 4; const float* we = p.in[26] + (size_t)l * DM * 32;
    for (int i = F.tid; i < 36 * DM; i += 512) { const int k = i / 36, j = i % 36; RW[j * DM + k] = gm[k] * (j < 4 ? wg[k * 4 + j] : we[k * 32 + (j - 4)]); }
    LAS unsigned* hist = (LAS unsigned*)(F.lds + 36 * DM * 4);
    if (F.tid < 32) hist[F.tid] = 0u;
    __syncthreads();
    const float* h = p.out; const float* ssq = WSP(const float, WS_SSQ);
    const int gw = F.vcu * 8 + F.wave, NGW = F.G * 8;
    const float biasv = F.lane < 4 ? p.in[25][l * 4 + F.lane] : (F.lane < 36 ? p.in[27][l * 32 + F.lane - 4] : 0.f);
    for (int tk = gw; tk < NT; tk += NGW) {
        f32x4 hv[4];
#pragma unroll
        for (int j = 0; j < 4; ++j) hv[j] = *(const f32x4*)(h + (size_t)tk * DM + 4 * F.lane + 256 * j);
        const float rs = row_rstd(ssq + (size_t)tk * 16);
        float mine = 0.f;
        for (int j = 0; j < 36; ++j) { float a = 0.f;
#pragma unroll
            for (int q = 0; q < 4; ++q) { const f32x4 wv = *(LAS const f32x4*)(RW + j * DM + 4 * F.lane + 256 * q); a += (hv[q][0] * wv[0] + hv[q][1] * wv[1]) + (hv[q][2] * wv[2] + hv[q][3] * wv[3]); }
            a = wave_sum(a); if (F.lane == j) mine = a; }
        mine = mine * rs + biasv;
        float gl[4];
#pragma unroll
        for (int j = 0; j < 4; ++j) gl[j] = __shfl(mine, j);
        int gi = 0; float gmx = gl[0];
#pragma unroll
        for (int j = 1; j < 4; ++j) if (gl[j] > gmx) { gmx = gl[j]; gi = j; }
        float gsum = 0.f;
#pragma unroll
        for (int j = 0; j < 4; ++j) gsum += __expf(gl[j] - gmx);
        const float gp = 1.0f / gsum;
        float el[8];
#pragma unroll
        for (int j = 0; j < 8; ++j) el[j] = __shfl(mine, 4 + gi * 8 + j);
        int e1 = 0; float m1 = el[0];
#pragma unroll
        for (int j = 1; j < 8; ++j) if (el[j] > m1) { m1 = el[j]; e1 = j; }
        int e2 = -1; float m2 = -3.0e38f;
#pragma unroll
        for (int j = 0; j < 8; ++j) if (j != e1 && el[j] > m2) { m2 = el[j]; e2 = j; }
        const float r2 = __expf(m2 - m1); const float g1 = gp / (1.0f + r2), g2 = gp * r2 / (1.0f + r2);
        if (F.lane == 0) { const int x1 = gi * 8 + e1, x2 = gi * 8 + e2;
            *(int2*)(WSP(int, OFF_EID) + (size_t)tk * 2) = make_int2(x1, x2); *(f32x2*)(WSP(float, OFF_GATE) + (size_t)tk * 2) = (f32x2){g1, g2};
            WSP(float, OFF_RSTDT)[tk] = rs; __hip_atomic_fetch_add(&hist[x1], 1u, __ATOMIC_RELAXED, __HIP_MEMORY_SCOPE_WORKGROUP); __hip_atomic_fetch_add(&hist[x2], 1u, __ATOMIC_RELAXED, __HIP_MEMORY_SCOPE_WORKGROUP); }
    }
    __syncthreads();
    if (F.tid < 32 && hist[F.tid]) atomicAdd(WSP(unsigned, WS_CTL) + CW_COUNTS + l * 64 + F.tid, hist[F.tid]);
    __syncthreads();
}
__device__ __forceinline__ void phase_dispatch(const Frame& F, int l) {
    LAS int* cnt = (LAS int*)F.lds; LAS int* base = cnt + 32; LAS int* pstart = base + 32; LAS int* slots = pstart + 40;
    unsigned* ctl = WSP(unsigned, WS_CTL);
    for (int blk = F.vcu; blk < NT / 128; blk += F.G) {
        __syncthreads();
        if (F.tid < 32) cnt[F.tid] = 0;
        if (F.tid == 32) { int acc = 0; for (int e = 0; e < 32; ++e) { pstart[e] = acc; acc += (int)((ctl[CW_COUNTS + l * 64 + e] + 255u) & ~255u); } pstart[32] = acc; }
        __syncthreads();
        int e = 0, rank = 0, tok = 0;
        if (F.tid < 256) { tok = blk * 128 + (F.tid >> 1); e = WSP(const int, OFF_EID)[(size_t)tok * 2 + (F.tid & 1)]; rank = __hip_atomic_fetch_add(&cnt[e], 1, __ATOMIC_RELAXED, __HIP_MEMORY_SCOPE_WORKGROUP); }
        __syncthreads();
        if (F.tid < 32) base[F.tid] = cnt[F.tid] ? (int)atomicAdd(&ctl[CW_CURSOR + l * 64 + F.tid], (unsigned)cnt[F.tid]) : 0;
        __syncthreads();
        if (F.tid < 256) { const int slot = pstart[e] + base[e] + rank; slots[F.tid] = slot; WSP(int, OFF_TSLOT)[(size_t)tok * 2 + (F.tid & 1)] = slot; WSP(float, OFF_SRSTD)[slot] = WSP(const float, OFF_RSTDT)[tok]; }
        __syncthreads();
        for (int a = F.wave * 32; a < F.wave * 32 + 32; ++a) { const int slot = slots[a]; const int tk = blk * 128 + (a >> 1);
            const h16* src = WSP(const h16, WS_HB) + (size_t)tk * DM; h16* dst = WSP(h16, OFF_XP) + (size_t)slot * DM;
            *(h16x8*)(dst + 8 * F.lane) = *(const h16x8*)(src + 8 * F.lane); *(h16x8*)(dst + 512 + 8 * F.lane) = *(const h16x8*)(src + 512 + 8 * F.lane); }
        if (blk == 0 && F.tid == 0) { const int ntl = pstart[32] >> 8; ctl[CW_NTILES + l] = (unsigned)ntl; int* te = WSP(int, OFF_TILEE);
            for (int e2 = 0; e2 < 32; ++e2) for (int tl = pstart[e2] >> 8; tl < (pstart[e2 + 1] >> 8); ++tl) te[tl] = e2; }
    }
    __syncthreads();
}
__device__ __forceinline__ void phase_combine(const Frame& F, const Prm& p, int l) {
    const int gw = F.vcu * 8 + F.wave, NGW = F.G * 8;
    const bool last = (l == NLAYER - 1);
    for (int tk = gw; tk < NT; tk += NGW) {
        const int2 sl = *(const int2*)(WSP(const int, OFF_TSLOT) + (size_t)tk * 2); const f32x2 gt = *(const f32x2*)(WSP(const float, OFF_GATE) + (size_t)tk * 2);
        float* hrow = p.out + (size_t)tk * DM; const h16* y0 = WSP(const h16, OFF_YP) + (size_t)sl.x * DM; const h16* y1 = WSP(const h16, OFF_YP) + (size_t)sl.y * DM;
        f32x4 v[4]; float s = 0.f;
#pragma unroll
        for (int j = 0; j < 4; ++j) { const int c = 4 * F.lane + 256 * j; const h16x4 a = *(const h16x4*)(y0 + c), bq = *(const h16x4*)(y1 + c); f32x4 hv = *(const f32x4*)(hrow + c);
#pragma unroll
            for (int e = 0; e < 4; ++e) hv[e] += gt[0] * (float)a[e] + gt[1] * (float)bq[e];
            v[j] = hv; s += (hv[0] * hv[0] + hv[1] * hv[1]) + (hv[2] * hv[2] + hv[3] * hv[3]); }
        s = wave_sum(s);
        if (!last) {
#pragma unroll
            for (int j = 0; j < 4; ++j) { const int c = 4 * F.lane + 256 * j; *(f32x4*)(hrow + c) = v[j]; *(h16x4*)(WSP(h16, WS_HB) + (size_t)tk * DM + c) = pack4(v[j]); }
            if (F.lane < 16) WSP(float, WS_SSQ)[(size_t)tk * 16 + F.lane] = (F.lane == 0) ? s : 0.f;
        } else { const float rs = 1.0f / sqrtf(s * (1.0f / DM) + EPS);
#pragma unroll
            for (int j = 0; j < 4; ++j) { const int c = 4 * F.lane + 256 * j; const f32x4 gf = *(const f32x4*)(p.in[31] + c); *(f32x4*)(hrow + c) = v[j] * rs * gf; } }
    }
}

__global__ void __launch_bounds__(512, 2) fwd(Prm p) {
    extern __shared__ __attribute__((aligned(16))) unsigned char lds_raw[];
    Frame F; F.lds = (LAS unsigned char*)lds_raw; F.ws = p.ws;
    F.tid = threadIdx.x; F.lane = F.tid & 63; F.wave = __builtin_amdgcn_readfirstlane(F.tid >> 6);
    F.G = gridDim.x; { const int bx = blockIdx.x; F.vcu = (F.G % 8 == 0) ? (bx % 8) * (F.G / 8) + bx / 8 : bx; }
    volatile LAS unsigned* misc = (volatile LAS unsigned*)(F.lds + LDS_MISC);
    if (F.tid < 4) misc[F.tid] = 0u;
    __syncthreads();
    const int lo = p.ph_lo, hi = p.ph_hi;
    XcdBarrier bar; bar.bar = WSP(unsigned, WS_CTL) + CW_BAR; bar.x = 0; bar.st = misc;
    if (hi - lo > 1) bar = xcd_barrier_post(WSP(unsigned, WS_CTL) + CW_BAR, misc);
#ifndef UMASK
#define UMASK 7
#endif
#ifndef PHMASK
#define PHMASK 0x3fff
#endif
#define IN(k) (((PHMASK >> ((k) % NPH)) & 1) && lo <= (k) && (k) < hi && (launder(F), true))
#define INR(k) (lo <= (k) && (k) < hi)
#define SEAM(k) do { if (INR(k) && INR((k) + 1)) xcd_barrier(bar); } while (0)
    for (int l = 0; l < NLAYER; ++l) {
        const int pb = l * NPH;
        if (IN(pb + 0)) { phase_convert(F, p, l); } SEAM(pb + 0);
        if (IN(pb + 1)) {
            if (UMASK & 1) { pg8::Gemm g{WSP(const h16, WS_HB), WSP(const h16, WS_WIN), DM, DM, DM}; pg8::StaticOrder S; S.init(NT, NPJ, F.G, (int)blockIdx.x);
              pg8::EpiScale16 E{WSP(h16, WS_R1), NPJ, WSP(const float, WS_SSQ)}; pg8::gemm_phase(F.lds, F.tid, g, S, E); }
            launder(F);
            if (UMASK & 2) { pg8::Gemm g{WSP(const h16, WS_MEM16), WSP(const h16, WS_WKV), DM, DM, DM}; pg8::StaticOrder S; S.init(NTM, 2048, F.G, (int)blockIdx.x);
              pg8::EpiKV E{WSP(h16, OFF_KB), WSP(h16, OFF_VT), WSP(const float, OFF_MSSQ)}; pg8::gemm_phase(F.lds, F.tid, g, S, E); }
        } SEAM(pb + 1);
        if (IN(pb + 2)) {
            if (UMASK & 1) for (int u = blockIdx.x; u < NB * NCH * 2; u += F.G) ssd_states_unit(F, p, l, u);
            if (UMASK & 2) for (int u = blockIdx.x; u < NB * NCH * 6; u += F.G) ret_states_unit(F, u);
            if (UMASK & 4) for (int u = blockIdx.x; u < NB * NCH; u += F.G) lru_unit<false>(F, p, l, u);
        } SEAM(pb + 2);
        if (IN(pb + 3)) {
            for (int u = blockIdx.x; u < 2 * NB * 6; u += F.G) ssd_scan_unit(F, u);
            for (int u = blockIdx.x; u < 2 * NB * 6; u += F.G) ret_scan_unit(F, u);
            lru_scan(F);
        } SEAM(pb + 3);
        if (IN(pb + 4)) {
            if (UMASK & 1) for (int u = blockIdx.x; u < NB * NCH * 2; u += F.G) ssd_out_unit(F, p, l, u);
            if (UMASK & 2) for (int u = blockIdx.x; u < NB * NCH * 6; u += F.G) ret_out_unit(F, u);
            if (UMASK & 4) for (int u = blockIdx.x; u < NB * NCH; u += F.G) lru_unit<true>(F, p, l, u);
        } SEAM(pb + 4);
        if (IN(pb + 5)) { pg8::Gemm g{WSP(const h16, OFF_OMIX), WSP(const h16, WS_WOUT), DM, DM, DM}; pg8::StaticOrder S; S.init(NT, DM, F.G, (int)blockIdx.x);
            pg8::EpiResid E{l == 0 ? p.in[0] : p.out, p.out, WSP(h16, WS_HB), WSP(float, WS_SSQ)}; pg8::gemm_phase(F.lds, F.tid, g, S, E); } SEAM(pb + 5);
        if (IN(pb + 6)) { pg8::Gemm g{WSP(const h16, WS_HB), WSP(const h16, WS_WQ), DM, DM, DM}; pg8::StaticOrder S; S.init(NT, DM, F.G, (int)blockIdx.x);
            pg8::EpiScale16 E{WSP(h16, OFF_QCA), DM, WSP(const float, WS_SSQ)}; pg8::gemm_phase(F.lds, F.tid, g, S, E); } SEAM(pb + 6);
        if (IN(pb + 7)) { for (int u = F.vcu; u < NB * 4 * 16; u += F.G) attn_unit(F, u); } SEAM(pb + 7);
        if (IN(pb + 8)) { pg8::Gemm g{WSP(const h16, OFF_OATT), WSP(const h16, WS_WO), DM, DM, DM}; pg8::StaticOrder S; S.init(NT, DM, F.G, (int)blockIdx.x);
            pg8::EpiResid E{p.out, p.out, WSP(h16, WS_HB), WSP(float, WS_SSQ)}; pg8::gemm_phase(F.lds, F.tid, g, S, E); } SEAM(pb + 8);
        if (IN(pb + 9)) { phase_router(F, p, l); } SEAM(pb + 9);
        if (IN(pb + 10)) { phase_dispatch(F, l); } SEAM(pb + 10);
        if (IN(pb + 11)) { pg8::Gemm g{WSP(const h16, OFF_XP), WSP(const h16, WS_W13), DM, DM, DM};
            pg8::GroupOrder S{WSP(const int, OFF_TILEE), __builtin_amdgcn_readfirstlane((int)WSP(const unsigned, WS_CTL)[CW_NTILES + l]), F.G, F.vcu};
            pg8::EpiGated E{WSP(h16, OFF_HP), WSP(const float, OFF_SRSTD)}; pg8::gemm_phase(F.lds, F.tid, g, S, E); } SEAM(pb + 11);
        if (IN(pb + 12)) { pg8::Gemm g{WSP(const h16, OFF_HP), WSP(const h16, WS_W2), 512, 512, 512};
            pg8::GroupOrder S{WSP(const int, OFF_TILEE), __builtin_amdgcn_readfirstlane((int)WSP(const unsigned, WS_CTL)[CW_NTILES + l]), F.G, F.vcu};
            pg8::EpiPlain16 E{WSP(h16, OFF_YP)}; pg8::gemm_phase(F.lds, F.tid, g, S, E); } SEAM(pb + 12);
        if (IN(pb + 13)) { phase_combine(F, p, l); } SEAM(pb + 13);
    }
#undef IN
#undef INR
#undef SEAM
}

extern "C" void kernel_launch(void* const* d_in, const int* in_sizes, int n_in, void* d_out, int out_size, void* d_ws, size_t ws_size, hipStream_t stream) {
    static int grid = 0;
    if (grid == 0) {
        if (n_in != 32 || out_size != NT * DM || ws_size < WS_END) { fprintf(stderr, "kernel_launch: unexpected shapes / workspace (%d inputs, out %d, ws %zu < %zu)\n", n_in, out_size, ws_size, (size_t)WS_END); grid = -1; return; }
        int dev = 0, cus = 0, per_cu = 0;
        if (hipGetDevice(&dev) != hipSuccess || hipDeviceGetAttribute(&cus, hipDeviceAttributeMultiprocessorCount, dev) != hipSuccess) { grid = -1; return; }
        if (hipFuncSetAttribute((const void*)fwd, hipFuncAttributeMaxDynamicSharedMemorySize, LDS_BYTES) != hipSuccess) { fprintf(stderr, "kernel_launch: hipFuncSetAttribute failed\n"); grid = -1; return; }
        if (hipOccupancyMaxActiveBlocksPerMultiprocessor(&per_cu, (const void*)fwd, 512, LDS_BYTES) != hipSuccess || per_cu < 1) { fprintf(stderr, "kernel_launch: occupancy query says %d\n", per_cu); }
        (void)hipGetLastError();
        grid = cus;
    }
    if (grid < 0) return;
    (void)hipMemsetAsync((char*)d_ws + WS_CTL, 0, CTL_ZERO_BYTES, stream);
    Prm p{};
    for (int i = 0; i < 32; ++i) p.in[i] = (const float*)d_in[i];
    p.out = (float*)d_out; p.ws = (unsigned char*)d_ws;
#if MK_SINGLE
    p.ph_lo = 0; p.ph_hi = NPHASES;
    hipLaunchKernelGGL(fwd, dim3(grid), dim3(512), LDS_BYTES, stream, p);
#else
    for (int ph = 0; ph < NPHASES; ++ph) { p.ph_lo = ph; p.ph_hi = ph + 1; hipLaunchKernelGGL(fwd, dim3(grid), dim3(512), LDS_BYTES, stream, p); }
#endif
}
```

```cpp
#include <hip/hip_runtime.h>
#include <cstdio>
#include <cstdint>

#ifndef MK_SINGLE
#define MK_SINGLE 1
#endif

typedef _Float16 h16;
typedef _Float16 h16x2 __attribute__((ext_vector_type(2)));
typedef _Float16 h16x4 __attribute__((ext_vector_type(4)));
typedef _Float16 h16x8 __attribute__((ext_vector_type(8)));
typedef float f32x2 __attribute__((ext_vector_type(2)));
typedef float f32x4 __attribute__((ext_vector_type(4)));
typedef unsigned u32x2 __attribute__((ext_vector_type(2)));
typedef unsigned u32x4 __attribute__((ext_vector_type(4)));
#define LAS __attribute__((address_space(3)))
#define PIN() do { asm volatile("" ::: "memory"); __builtin_amdgcn_sched_barrier(0); } while (0)
#define PINV(x) asm volatile("" : "+v"(x) :: "memory")
#define MFMA16(a, b, c) __builtin_amdgcn_mfma_f32_16x16x32_f16((a), (b), (c), 0, 0, 0)

constexpr int NB = 16, SEQ = 2048, DM = 1024, NT = NB * SEQ, MEML = 256, NTM = NB * MEML, NLAYER = 2;
constexpr int NPJ = 3584;
constexpr int CQ = 0, CK = 384, CV = 768, CG = 1152, CZ = 1536, CXS = 1920, CBM = 2304, CCM = 2560, CXR = 2816, CGT = 3072, CDT = 3328;
constexpr int DIN = 3334, NCH = 16, MAXSLOT = 73728;
constexpr float EPS = 1e-6f;
constexpr int NPH = 14;
constexpr int NPHASES = NLAYER * NPH;

constexpr size_t MiB = (size_t)1 << 20;
constexpr size_t WS_CTL = 0, CTL_ZERO_BYTES = 64 * 1024;
constexpr size_t WS_WIN = 1 * MiB, WS_WOUT = 8 * MiB, WS_WQ = 10 * MiB, WS_WKV = 12 * MiB, WS_WO = 16 * MiB, WS_W13 = 18 * MiB, WS_W2 = 82 * MiB, WS_LRUW = 114 * MiB;
constexpr size_t WS_HB = 115 * MiB;
constexpr size_t WS_R1 = 179 * MiB;
constexpr size_t WS_R2 = 403 * MiB;
constexpr size_t WS_KV = 547 * MiB, WS_MEM16 = 563 * MiB, WS_SSQ = 571 * MiB, WS_MISC = 573 * MiB, WS_END = 577 * MiB;
constexpr size_t OFF_QCA = WS_R1, OFF_OATT = WS_R1 + 64 * MiB, OFF_XP = WS_R1, OFF_HP = WS_R1 + 144 * MiB;
constexpr size_t OFF_OMIX = WS_R2, OFF_RST = WS_R2 + 64 * MiB, OFF_SST = WS_R2 + 88 * MiB, OFF_LSUM = WS_R2 + 136 * MiB, OFF_SDEC = WS_R2 + 137 * MiB, OFF_LCAR = WS_R2 + 138 * MiB, OFF_YP = WS_R2;
constexpr size_t OFF_KB = WS_KV, OFF_VT = WS_KV + 8 * MiB;
constexpr size_t OFF_ROPE = WS_MISC, OFF_MSSQ = WS_MISC + 512 * 1024, OFF_EID = WS_MISC + 768 * 1024, OFF_GATE = WS_MISC + 1024 * 1024, OFF_TSLOT = WS_MISC + 1280 * 1024,
                 OFF_RSTDT = WS_MISC + 1536 * 1024, OFF_SRSTD = WS_MISC + 1664 * 1024, OFF_TILEE = WS_MISC + 2000 * 1024;
constexpr int CW_COUNTS = 64, CW_CURSOR = 192, CW_NTILES = 320, CW_BAR = 4096;

constexpr int LDS_BYTES = 152 * 1024;
constexpr int LDS_MISC = 150 * 1024;

struct Prm { const float* in[32]; float* out; unsigned char* ws; int ph_lo, ph_hi; };

#define XB_TMO      128
#define XB_XCNT(j)  (256  + 64 * (j))
#define XB_XSUB(j)  (1280 + 64 * (j))
#define XB_XGEN(j)  (2304 + 64 * (j))
#define XB_TOP      3328
#define XB_TOPGEN   3392
#define XCD_BAR_WORDS 3456
#define XB_SPIN_CAP (1u << 18)
__device__ __forceinline__ unsigned xb_ld(unsigned* p)              { return __hip_atomic_load(p, __ATOMIC_RELAXED, __HIP_MEMORY_SCOPE_AGENT); }
__device__ __forceinline__ unsigned xb_add(unsigned* p, unsigned v) { return __hip_atomic_fetch_add(p, v, __ATOMIC_RELAXED, __HIP_MEMORY_SCOPE_AGENT); }
__device__ __forceinline__ unsigned xb_xcc_id() { return (unsigned)__builtin_amdgcn_s_getreg((3 << 11) | 20) & 0xFu; }
#define XB_SPIN(cond, bar) do { unsigned _sp = 0; while (cond) { __builtin_amdgcn_s_sleep(1); \
    if ((++_sp & 255u) == 0u) { if (xb_ld(&(bar)[XB_TMO])) break; if (_sp > XB_SPIN_CAP) { atomicAdd(&(bar)[XB_TMO], 1u); break; } } } } while (0)
struct XcdBarrier { unsigned* bar; unsigned x; volatile LAS unsigned* st; };
__device__ __forceinline__ XcdBarrier xcd_barrier_post(unsigned* bar, volatile LAS unsigned* st) {
    XcdBarrier b; b.bar = bar; b.x = xb_xcc_id(); b.st = st;
    if (threadIdx.x == 0) (void)xb_add(&bar[XB_XCNT(b.x)], 1u);
    return b;
}
__device__ __forceinline__ void xcd_barrier_complete(unsigned* bar, unsigned x, unsigned& nloc, unsigned& nx) {
    const unsigned G = gridDim.x * gridDim.y * gridDim.z;
    unsigned sum, cnt, mine, sp = 0u;
    for (;;) {
        sum = 0u; cnt = 0u; mine = 0u;
#pragma unroll
        for (unsigned j = 0; j < 16; ++j) { const unsigned c = xb_ld(&bar[XB_XCNT(j)]); sum += c; cnt += (c > 0u) ? 1u : 0u; mine = (j == x) ? c : mine; }
        if (sum == G) break;
        __builtin_amdgcn_s_sleep(1);
        if ((++sp & 255u) == 0u) { if (xb_ld(&bar[XB_TMO])) break; if (sp > XB_SPIN_CAP) { atomicAdd(&bar[XB_TMO], 1u); break; } }
    }
    nloc = mine > 0u ? mine : 1u; nx = cnt > 0u ? cnt : 1u;
}
__device__ __forceinline__ void xcd_barrier(const XcdBarrier& b) {
    asm volatile("s_waitcnt vmcnt(0)" ::: "memory");
    __syncthreads();
    if (threadIdx.x == 0) {
        unsigned* bar = b.bar;
        __builtin_amdgcn_s_waitcnt(0);
        unsigned nloc = b.st[0], nx = b.st[1];
        if (nloc == 0u) { xcd_barrier_complete(bar, b.x, nloc, nx); b.st[0] = nloc; b.st[1] = nx; }
        const unsigned old = xb_add(&bar[XB_XSUB(b.x)], 1u);
        const unsigned gen = old / nloc;
        if (old + 1u == (gen + 1u) * nloc) {
            __builtin_amdgcn_fence(__ATOMIC_RELEASE, "agent");
            asm volatile("s_waitcnt vmcnt(0)" ::: "memory");
            const unsigned og = xb_add(&bar[XB_TOP], 1u);
            const unsigned tg = og / nx;
            if (og + 1u == (tg + 1u) * nx) xb_add(&bar[XB_TOPGEN], 1u);
            else XB_SPIN(xb_ld(&bar[XB_TOPGEN]) == tg, bar);
            __builtin_amdgcn_fence(__ATOMIC_ACQUIRE, "agent");
            xb_add(&bar[XB_XGEN(b.x)], 1u);
            asm volatile("s_waitcnt vmcnt(0)" ::: "memory");
        } else {
            XB_SPIN(xb_ld(&bar[XB_XGEN(b.x)]) == gen, bar);
            __builtin_amdgcn_fence(__ATOMIC_ACQUIRE, "agent");
            asm volatile("s_waitcnt vmcnt(0)" ::: "memory");
        }
    }
    __syncthreads();
}

__device__ __forceinline__ float wave_sum(float v) {
#pragma unroll
    for (int o = 1; o < 64; o <<= 1) v += __shfl_xor(v, o);
    return v;
}
__device__ __forceinline__ float sigmoidf_(float x) { return 1.0f / (1.0f + __expf(-x)); }
__device__ __forceinline__ float siluf_(float x) { return x / (1.0f + __expf(-x)); }
__device__ __forceinline__ float softplusf_(float x) { return x > 20.f ? x : log1pf(__expf(x)); }
__device__ __forceinline__ float gelu_tanh_(float x) { const float y = 0.7978845608028654f * (x + 0.044715f * x * x * x); const float t = 1.0f - 2.0f / (__expf(2.0f * y) + 1.0f); return 0.5f * x * (1.0f + t); }
__device__ __forceinline__ h16x8 pack8(const f32x4 a, const f32x4 b) { h16x8 r; r[0] = (h16)a[0]; r[1] = (h16)a[1]; r[2] = (h16)a[2]; r[3] = (h16)a[3]; r[4] = (h16)b[0]; r[5] = (h16)b[1]; r[6] = (h16)b[2]; r[7] = (h16)b[3]; return r; }
__device__ __forceinline__ h16x4 pack4(const f32x4 a) { h16x4 r; r[0] = (h16)a[0]; r[1] = (h16)a[1]; r[2] = (h16)a[2]; r[3] = (h16)a[3]; return r; }
__device__ __forceinline__ h16x8 ldsfrag(LAS const h16* p) { return *(LAS const h16x8*)p; }
__device__ __forceinline__ h16x8 ldsfrag2(LAS const h16* p0, LAS const h16* p1) { const h16x4 a = *(LAS const h16x4*)p0, b = *(LAS const h16x4*)p1; return __builtin_shufflevector(a, b, 0, 1, 2, 3, 4, 5, 6, 7); }
__device__ __forceinline__ h16x8 scalefrag(const h16x8 f, float s) { const h16 hs = (h16)s; h16x8 v;
#pragma unroll
    for (int j = 0; j < 8; ++j) v[j] = hs; return f * v; }
__device__ __forceinline__ float row_rstd(const float* ssq16) {
    const f32x4 a = *(const f32x4*)ssq16, b = *(const f32x4*)(ssq16 + 4), c = *(const f32x4*)(ssq16 + 8), d = *(const f32x4*)(ssq16 + 12);
    const float s = ((a[0] + a[1]) + (a[2] + a[3])) + ((b[0] + b[1]) + (b[2] + b[3])) + ((c[0] + c[1]) + (c[2] + c[3])) + ((d[0] + d[1]) + (d[2] + d[3]));
    return 1.0f / sqrtf(s * (1.0f / DM) + EPS);
}

namespace pg8 {
constexpr int BM = 256, BK = 64, HALF = 128, HTB = HALF * BK * 2, STAGE_BYTES = 8 * HTB, NXCD = 8, WGM = 8;
__host__ __device__ __forceinline__ int lds_byte(int r, int c) { const int st = (r >> 4) * 2 + (c >> 5), rr = r & 15, cc = c & 31, ob = rr * 64 + cc * 2; return st * 1024 + (ob ^ (((ob >> 9) & 1) << 5)); }
__host__ __device__ __forceinline__ void stage_rc(int b, int& R, int& C) { const int st = b / 1024, sb = b % 1024, swz = sb ^ (((sb >> 9) & 1) << 5); R = (st >> 1) * 16 + swz / 64; C = (st & 1) * 32 + (swz % 64) / 2; }
__host__ __device__ __forceinline__ int perm32(int rho) { const int n = rho >> 4, i = rho & 15; return 8 * (i >> 2) + 4 * n + (i & 3); }
struct Unit { int pm, pn; };
struct Gemm { const h16* A; const h16* Bt; int lda, ldb, K; };
struct StaticOrder {
    int nM, nN, nwg, G, c;
    __device__ void init(int M, int N, int G_, int c_) { nM = M / BM; nN = N / BM; nwg = nM * nN; G = G_; c = c_; }
    __device__ bool next(int i, Unit& u) const {
        const long L = (long)i * G + c; if (L >= nwg) return false;
        int wgid = (int)L; { const int q = nwg / NXCD, r = nwg % NXCD, xcd = wgid % NXCD, off = wgid / NXCD; wgid = (xcd < r ? xcd * (q + 1) : r * (q + 1) + (xcd - r) * q) + off; }
        const int nig = WGM * nN, gid = wgid / nig, fm = gid * WGM, gsz = (nM - fm) < WGM ? (nM - fm) : WGM;
        u.pm = fm + ((wgid % nig) % gsz); u.pn = (wgid % nig) / gsz; return true;
    }
};
struct GroupOrder {
    const int* tile_e; int ntiles, G, vcu;
    __device__ bool next(int i, Unit& u) const {
        const int L = i * G + vcu, tile = L >> 2; if (tile >= ntiles) return false;
        u.pm = tile; u.pn = __builtin_amdgcn_readfirstlane(tile_e[tile]) * 4 + (L & 3); return true;
    }
};

struct EpiScale16 {
    static constexpr bool PERM = true;
    h16* O; int ldc; const float* ssq;
    __device__ __forceinline__ void operator()(const f32x4 (&acc)[2][2][4][2], const Unit& u, int wr, int wc, int fr, int fq) const {
        const int row0 = u.pm * BM + wr * 64 + fr, col0 = u.pn * BM + wc * 32 + 8 * fq;
#pragma unroll
        for (int ai = 0; ai < 2; ++ai)
#pragma unroll
            for (int m = 0; m < 4; ++m) { const int row = row0 + ai * HALF + m * 16; const float rs = row_rstd(ssq + (size_t)row * 16); h16* rowp = O + (size_t)row * ldc + col0;
#pragma unroll
                for (int bj = 0; bj < 2; ++bj) *(h16x8*)(rowp + bj * HALF) = pack8(acc[ai][bj][m][0] * rs, acc[ai][bj][m][1] * rs); }
    }
};
struct EpiKV {
    static constexpr bool PERM = true;
    h16* KB; h16* VT; const float* ssq;
    __device__ __forceinline__ void operator()(const f32x4 (&acc)[2][2][4][2], const Unit& u, int wr, int wc, int fr, int fq) const {
        const int row0 = u.pm * BM + wr * 64 + fr;
#pragma unroll
        for (int ai = 0; ai < 2; ++ai)
#pragma unroll
            for (int m = 0; m < 4; ++m) { const int row = row0 + ai * HALF + m * 16; const float rs = row_rstd(ssq + (size_t)row * 16);
                h16x8 pk[2];
#pragma unroll
                for (int bj = 0; bj < 2; ++bj) pk[bj] = pack8(acc[ai][bj][m][0] * rs, acc[ai][bj][m][1] * rs);
                if (u.pn < 4) { h16* rowp = KB + (size_t)row * DM + u.pn * BM + wc * 32 + 8 * fq;
                    *(h16x8*)rowp = pk[0]; *(h16x8*)(rowp + HALF) = pk[1];
                } else { const int b = row >> 8, key = row & 255, hd = u.pn - 4; h16* base = VT + ((size_t)(b * 4 + hd) * 256 + wc * 32 + 8 * fq) * 256 + key;
#pragma unroll
                    for (int bj = 0; bj < 2; ++bj)
#pragma unroll
                        for (int j = 0; j < 8; ++j) base[(bj * HALF + j) * 256] = pk[bj][j]; }
                PIN();
            }
    }
};
struct EpiResid {
    static constexpr bool PERM = false;
    const float* base; float* out; h16* hb; float* ssq;
    __device__ __forceinline__ void operator()(const f32x4 (&acc)[2][2][4][2], const Unit& u, int wr, int wc, int fr, int fq) const {
        const int row0 = u.pm * BM + wr * 64 + fr, col0 = u.pn * BM + wc * 32 + 4 * fq;
#pragma unroll
        for (int ai = 0; ai < 2; ++ai)
#pragma unroll
            for (int m = 0; m < 4; ++m) { const int row = row0 + ai * HALF + m * 16; const size_t off = (size_t)row * DM + col0; float s = 0.f;
#pragma unroll
                for (int bj = 0; bj < 2; ++bj)
#pragma unroll
                    for (int n = 0; n < 2; ++n) { const f32x4 v = *(const f32x4*)(base + off + bj * HALF + n * 16) + acc[ai][bj][m][n];
                        *(f32x4*)(out + off + bj * HALF + n * 16) = v; *(h16x4*)(hb + off + bj * HALF + n * 16) = pack4(v);
                        s += (v[0] * v[0] + v[1] * v[1]) + (v[2] * v[2] + v[3] * v[3]); }
                s += __shfl_xor(s, 16); s += __shfl_xor(s, 32);
                if (fq == 0) ssq[(size_t)row * 16 + u.pn * 4 + wc] = s; }
    }
};
struct EpiGated {
    static constexpr bool PERM = true;
    h16* O; const float* srstd;
    __device__ __forceinline__ void operator()(const f32x4 (&acc)[2][2][4][2], const Unit& u, int wr, int wc, int fr, int fq) const {
        const int row0 = u.pm * BM + wr * 64 + fr, col0 = (u.pn & 3) * HALF + wc * 32 + 8 * fq;
#pragma unroll
        for (int ai = 0; ai < 2; ++ai)
#pragma unroll
            for (int m = 0; m < 4; ++m) { const int row = row0 + ai * HALF + m * 16; const float rs = srstd[row]; f32x4 o[2];
#pragma unroll
                for (int n = 0; n < 2; ++n)
#pragma unroll
                    for (int j = 0; j < 4; ++j) { const float a = acc[ai][0][m][n][j] * rs, b = acc[ai][1][m][n][j] * rs; o[n][j] = siluf_(a) * b; }
                *(h16x8*)(O + (size_t)row * 512 + col0) = pack8(o[0], o[1]); }
    }
};
struct EpiPlain16 {
    static constexpr bool PERM = true;
    h16* O;
    __device__ __forceinline__ void operator()(const f32x4 (&acc)[2][2][4][2], const Unit& u, int wr, int wc, int fr, int fq) const {
        const int row0 = u.pm * BM + wr * 64 + fr, col0 = (u.pn & 3) * BM + wc * 32 + 8 * fq;
#pragma unroll
        for (int ai = 0; ai < 2; ++ai)
#pragma unroll
            for (int m = 0; m < 4; ++m) { h16* rowp = O + (size_t)(row0 + ai * HALF + m * 16) * DM + col0;
#pragma unroll
                for (int bj = 0; bj < 2; ++bj) *(h16x8*)(rowp + bj * HALF) = pack8(acc[ai][bj][m][0], acc[ai][bj][m][1]); }
    }
};

template <class Epi, class Sched>
__device__ __forceinline__ void gemm_phase(LAS unsigned char* lds, const int tid, const Gemm g, const Sched& S, const Epi& E) {
    const int wid = __builtin_amdgcn_readfirstlane(tid >> 6), lane = tid & 63, wr = wid >> 2, wc = wid & 3, fr = lane & 15, fq = lane >> 4;
    const int K = g.K, nt = K / BK;
    unsigned voffA[2], voffB[2];
#pragma unroll
    for (int i = 0; i < 2; ++i) { int R, C; stage_rc(tid * 16 + i * 8192, R, C); const int Rb = Epi::PERM ? ((R & ~31) + perm32(R & 31)) : R;
        voffA[i] = (unsigned)(R * g.lda + C) * 2u; voffB[i] = (unsigned)(Rb * g.ldb + C) * 2u; }
    const size_t kstep = (size_t)(BK * 2);
    const size_t hstepA = (size_t)HALF * g.lda * 2, hstepB = (size_t)HALF * g.ldb * 2;
    const size_t tstepA = 2 * hstepA, tstepB = 2 * hstepB;
    const unsigned ldsw = (unsigned)wid * 1024u;
    const int aoff = lds_byte(wr * 64 + fr, fq * 8), boff = lds_byte(wc * 32 + fr, fq * 8);
#define PG8_SA(b, h) (((b) * 2 + (h)) * HTB)
#define PG8_SB(b, h) ((4 + (b) * 2 + (h)) * HTB)
#define PG8_STAGE(bufoff, gbase, voff) do { _Pragma("unroll") for (int _i = 0; _i < 2; ++_i) \
        __builtin_amdgcn_global_load_lds((const unsigned*)((const char*)(gbase) + (voff)[_i]), (LAS unsigned*)(lds + (bufoff) + ldsw + _i * 8192), 16, 0, 0); } while (0)
#define PG8_LDA(dst, b, h) do { _Pragma("unroll") for (int m = 0; m < 4; ++m) _Pragma("unroll") for (int k = 0; k < 2; ++k) dst[m][k] = *(const LAS h16x8*)(lds + PG8_SA(b, h) + aoff + m * 2048 + k * 1024); } while (0)
#define PG8_LDB(dst, b, h) do { _Pragma("unroll") for (int n = 0; n < 2; ++n) _Pragma("unroll") for (int k = 0; k < 2; ++k) dst[n][k] = *(const LAS h16x8*)(lds + PG8_SB(b, h) + boff + n * 2048 + k * 1024); } while (0)
#define PG8_MMA(ai, bj, At, Bt) do { __builtin_amdgcn_s_setprio(1); _Pragma("unroll") for (int m = 0; m < 4; ++m) _Pragma("unroll") for (int n = 0; n < 2; ++n) _Pragma("unroll") for (int k = 0; k < 2; ++k) \
        acc[ai][bj][m][n] = __builtin_amdgcn_mfma_f32_16x16x32_f16(Bt[n][k], At[m][k], acc[ai][bj][m][n], 0, 0, 0); __builtin_amdgcn_s_setprio(0); } while (0)
#define PG8_WAIT_V(n) asm volatile("s_waitcnt vmcnt(" #n ")" ::: "memory")
#define PG8_WAIT_L(n) asm volatile("s_waitcnt lgkmcnt(" #n ")" ::: "memory")
#define PG8_BAR __builtin_amdgcn_s_barrier()
#define PG8_SCHED __builtin_amdgcn_sched_barrier(0)
    Unit cur, nxt; int ui = 0;
    if (!S.next(0, cur)) return;
    f32x4 acc[2][2][4][2];
#pragma unroll
    for (int a = 0; a < 2; ++a)
#pragma unroll
        for (int b = 0; b < 2; ++b)
#pragma unroll
            for (int m = 0; m < 4; ++m)
#pragma unroll
                for (int n = 0; n < 2; ++n) acc[a][b][m][n] = (f32x4){0.f, 0.f, 0.f, 0.f};
    h16x8 At[4][2], B0[2][2], B1[2][2];
    const char* cA = (const char*)g.A + (size_t)cur.pm * tstepA; const char* cB = (const char*)g.Bt + (size_t)cur.pn * tstepB;
    PG8_STAGE(PG8_SB(0, 0), cB, voffB); PG8_STAGE(PG8_SB(0, 1), cB + hstepB, voffB); PG8_STAGE(PG8_SA(0, 0), cA, voffA); PG8_STAGE(PG8_SA(0, 1), cA + hstepA, voffA);
    if (wr == 1) PG8_BAR;
    PG8_WAIT_V(2); PG8_BAR;
    PG8_STAGE(PG8_SB(1, 0), cB + kstep, voffB); PG8_STAGE(PG8_SA(1, 0), cA + kstep, voffA); PG8_STAGE(PG8_SB(1, 1), cB + hstepB + kstep, voffB);
    PG8_WAIT_V(6); PG8_BAR;
    for (;;) {
        const bool has_next = S.next(ui + 1, nxt);
        const char* nA = has_next ? (const char*)g.A + (size_t)nxt.pm * tstepA : cA; const char* nB = has_next ? (const char*)g.Bt + (size_t)nxt.pn * tstepB : cB;
        for (int t = 0; t < nt; t += 2) {
            const bool last = (t == nt - 2);
            const char* a1 = cA + (size_t)(t + 1) * kstep;
            const char* a2 = last ? nA : cA + (size_t)(t + 2) * kstep; const char* b2 = last ? nB : cB + (size_t)(t + 2) * kstep;
            const char* a3 = a2 + kstep; const char* b3 = b2 + kstep;
            PG8_LDB(B0, 0, 0); PG8_LDB(B1, 0, 1); PG8_SCHED; PG8_LDA(At, 0, 0); PG8_STAGE(PG8_SA(1, 1), a1 + hstepA, voffA);
            PG8_WAIT_V(8); PG8_WAIT_L(0); PG8_BAR; PG8_MMA(0, 0, At, B0); PG8_MMA(0, 1, At, B1); PG8_BAR; PG8_SCHED;
            PG8_LDA(At, 0, 1); PG8_STAGE(PG8_SB(0, 0), b2, voffB); PG8_STAGE(PG8_SB(0, 1), b2 + hstepB, voffB); PG8_STAGE(PG8_SA(0, 0), a2, voffA);
            PG8_WAIT_V(8); PG8_WAIT_L(0); PG8_BAR; PG8_MMA(1, 0, At, B0); PG8_MMA(1, 1, At, B1); PG8_BAR; PG8_SCHED;
            PG8_LDB(B0, 1, 0); PG8_LDB(B1, 1, 1); PG8_SCHED; PG8_LDA(At, 1, 0); PG8_STAGE(PG8_SA(0, 1), a2 + hstepA, voffA);
            PG8_WAIT_V(8); PG8_WAIT_L(0); PG8_BAR; PG8_MMA(0, 0, At, B0); PG8_MMA(0, 1, At, B1); PG8_BAR; PG8_SCHED;
            PG8_LDA(At, 1, 1); PG8_STAGE(PG8_SB(1, 0), b3, voffB); PG8_STAGE(PG8_SB(1, 1), b3 + hstepB, voffB); PG8_STAGE(PG8_SA(1, 0), a3, voffA);
            PG8_WAIT_V(8); PG8_WAIT_L(0); PG8_BAR; PG8_MMA(1, 0, At, B0); PG8_MMA(1, 1, At, B1); PG8_BAR; PG8_SCHED;
        }
        if (wr == 0) PG8_BAR;
        E(acc, cur, wr, wc, fr, fq);
        if (!has_next) break;
#pragma unroll
        for (int a = 0; a < 2; ++a)
#pragma unroll
            for (int b = 0; b < 2; ++b)
#pragma unroll
                for (int m = 0; m < 4; ++m)
#pragma unroll
                    for (int n = 0; n < 2; ++n) acc[a][b][m][n] = (f32x4){0.f, 0.f, 0.f, 0.f};
        cur = nxt; cA = nA; cB = nB; ++ui;
        if (wr == 1) PG8_BAR;
    }
    PG8_WAIT_V(0);
    PG8_BAR;
#undef PG8_SA
#undef PG8_SB
#undef PG8_STAGE
#undef PG8_LDA
#undef PG8_LDB
#undef PG8_MMA
#undef PG8_WAIT_V
#undef PG8_WAIT_L
#undef PG8_BAR
#undef PG8_SCHED
}
}

struct Frame {
    LAS unsigned char* lds;
    unsigned char* ws;
    int tid, lane, wave, G, vcu;
};
#define WSP(T, off) ((T*)(F.ws + (off)))
__device__ __forceinline__ void launder(Frame& F) {
    int wv = F.wave; asm volatile("" : "+s"(wv)); F.wave = wv;
    int t = wv * 64 + (int)__builtin_amdgcn_mbcnt_hi(~0u, __builtin_amdgcn_mbcnt_lo(~0u, 0u)); asm volatile("" : "+v"(t)); F.tid = t; F.lane = t & 63;
    const unsigned long long w = (unsigned long long)F.ws; unsigned wl = __builtin_amdgcn_readfirstlane((unsigned)w), wh = __builtin_amdgcn_readfirstlane((unsigned)(w >> 32));
    asm volatile("" : "+s"(wl), "+s"(wh)); F.ws = (unsigned char*)(((unsigned long long)wh << 32) | wl);
    unsigned lo = __builtin_amdgcn_readfirstlane((unsigned)(uintptr_t)F.lds); asm volatile("" : "+s"(lo)); F.lds = (LAS unsigned char*)(uintptr_t)lo;
    int v = __builtin_amdgcn_readfirstlane(F.vcu); asm volatile("" : "+s"(v)); F.vcu = v;
}

__device__ __forceinline__ void tr_item(const float* W, int ldw, int sc, int nvalid, const float* g, float mul, h16* Wt, int ldt, int d0, int k0, LAS float* scr, int lane) {
    const int n = lane & 31;
#pragma unroll 8
    for (int i = 0; i < 32; ++i) { const int kk = 2 * i + (lane >> 5); float v = 0.f;
        if (n < nvalid) { v = W[(size_t)(k0 + kk) * ldw + sc + n] * mul; if (g) v *= g[k0 + kk]; }
        scr[kk * 33 + n] = v; }
    asm volatile("s_waitcnt lgkmcnt(0)" ::: "memory");
    const int c = lane & 7;
#pragma unroll
    for (int j = 0; j < 4; ++j) { const int nn = (lane >> 3) + 8 * j; const LAS float* s = scr + (8 * c) * 33 + nn;
        h16x8 o;
#pragma unroll
        for (int e = 0; e < 8; ++e) o[e] = (h16)s[e * 33];
        *(h16x8*)(Wt + (size_t)(d0 + nn) * ldt + k0 + 8 * c) = o; }
    asm volatile("s_waitcnt lgkmcnt(0)" ::: "memory");
}
__device__ __forceinline__ void phase_convert(const Frame& F, const Prm& p, int l) {
    LAS float* scr = (LAS float*)(F.lds + F.wave * 16384);
    const int gw = F.vcu * 8 + F.wave, NGW = F.G * 8;
    constexpr int I_IN = 112 * 16, I_OUT = 512, I_Q = 512, I_KV = 1024, I_O = 512, I_13 = 32 * 32 * 16, I_2 = 32 * 32 * 8, I_L = 32;
    constexpr int NITEMS = I_IN + I_OUT + I_Q + I_KV + I_O + I_13 + I_2 + I_L;
    for (int it = gw; it < NITEMS; it += NGW) {
        int r = it;
        if (r < I_IN) { const int db = r / 16, kb = r % 16, d0 = 32 * db; int sc, nv;
            if (d0 < 2816) { sc = d0; nv = 32; } else if (d0 < 3328) { sc = d0 + 6; nv = 32; } else if (d0 == 3328) { sc = 2816; nv = 6; } else { sc = 0; nv = 0; }
            tr_item(p.in[3] + (size_t)l * DM * DIN, DIN, sc, nv, p.in[2] + l * DM, 1.f, WSP(h16, WS_WIN), DM, d0, 64 * kb, scr, F.lane); continue; } r -= I_IN;
        if (r < I_OUT) { tr_item(p.in[4] + (size_t)l * DM * DM, DM, 32 * (r / 16), 32, nullptr, 1.f, WSP(h16, WS_WOUT), DM, 32 * (r / 16), 64 * (r % 16), scr, F.lane); continue; } r -= I_OUT;
        if (r < I_Q) { tr_item(p.in[20] + (size_t)l * DM * DM, DM, 32 * (r / 16), 32, p.in[18] + l * DM, 0.0625f, WSP(h16, WS_WQ), DM, 32 * (r / 16), 64 * (r % 16), scr, F.lane); continue; } r -= I_Q;
        if (r < I_KV) { tr_item(p.in[21] + (size_t)l * DM * 2048, 2048, 32 * (r / 16), 32, p.in[19] + l * DM, 1.f, WSP(h16, WS_WKV), DM, 32 * (r / 16), 64 * (r % 16), scr, F.lane); continue; } r -= I_KV;
        if (r < I_O) { tr_item(p.in[22] + (size_t)l * DM * DM, DM, 32 * (r / 16), 32, nullptr, 1.f, WSP(h16, WS_WO), DM, 32 * (r / 16), 64 * (r % 16), scr, F.lane); continue; } r -= I_O;
        if (r < I_13) { const int e = r / 512, q = r % 512, db = q / 16, kb = q % 16, d0 = 32 * db, grp = d0 >> 8, rr = d0 & 255;
            const float* src = (rr < 128 ? p.in[28] : p.in[29]) + (size_t)(l * 32 + e) * DM * 512;
            tr_item(src, 512, grp * 128 + (rr & 127), 32, p.in[23] + l * DM, 1.f, WSP(h16, WS_W13) + (size_t)e * DM * DM, DM, d0, 64 * kb, scr, F.lane); continue; } r -= I_13;
        if (r < I_2) { const int e = r / 256, q = r % 256, db = q / 8, kb = q % 8;
            tr_item(p.in[30] + (size_t)(l * 32 + e) * 512 * DM, DM, 32 * db, 32, nullptr, 1.f, WSP(h16, WS_W2) + (size_t)e * DM * 512, 512, 32 * db, 64 * kb, scr, F.lane); continue; } r -= I_2;
        { const int db = r & 1, q = r >> 1, blk = q & 3, gate = (q >> 2) & 1, dir = q >> 3;
            const float* src = (gate ? p.in[16] : p.in[14]) + (size_t)((l * 2 + dir) * 4 + blk) * 4096;
            tr_item(src, 64, 32 * db, 32, nullptr, 1.f, WSP(h16, WS_LRUW) + (size_t)((dir * 2 + gate) * 4 + blk) * 4096, 64, 32 * db, 0, scr, F.lane); }
    }
    if (l == 0) {
        for (int m = gw; m < NT + NTM; m += NGW) {
            const bool isx = m < NT; const int row = isx ? m : m - NT;
            const float* src = (isx ? p.in[0] : p.in[1]) + (size_t)row * DM; h16* dst = (isx ? WSP(h16, WS_HB) : WSP(h16, WS_MEM16)) + (size_t)row * DM;
            float* sq = (isx ? WSP(float, WS_SSQ) : WSP(float, OFF_MSSQ)) + (size_t)row * 16;
            float s = 0.f;
#pragma unroll
            for (int j = 0; j < 4; ++j) { const f32x4 v = *(const f32x4*)(src + 4 * F.lane + 256 * j); *(h16x4*)(dst + 4 * F.lane + 256 * j) = pack4(v); s += (v[0] * v[0] + v[1] * v[1]) + (v[2] * v[2] + v[3] * v[3]); }
            s = wave_sum(s);
            if (F.lane < 16) sq[F.lane] = (F.lane == 0) ? s : 0.f;
        }
        float* rope = WSP(float, OFF_ROPE);
        for (int i = F.vcu * 512 + F.tid; i < SEQ * 32; i += F.G * 512) {
            const int pos = i >> 5, fi = i & 31; double th = 1.0;
            for (int k = 0; k < fi; ++k) th *= 0.74989420933245582730;
            const double rev = (double)pos * th * 0.15915494309189533577;
            const double fr = rev - floor(rev);
            const double r = (fr - 0.5) * 6.28318530717958647692;
            const double r2 = r * r; double sn = 1.0, cs = 1.0;
            for (int k = 14; k >= 1; --k) { sn = 1.0 - r2 / (double)((2 * k) * (2 * k + 1)) * sn; cs = 1.0 - r2 / (double)((2 * k - 1) * (2 * k)) * cs; }
            sn *= r;
            rope[pos * 64 + fi] = (float)(-cs); rope[pos * 64 + 32 + fi] = (float)(-sn);
        }
    }
}

__device__ __forceinline__ void conv8(const h16* projcol, long tbase, int n, int row, const float* cw, int cdim, const float* cb, float (&o)[8]) {
    const f32x4 b0 = *(const f32x4*)cb, b1 = *(const f32x4*)(cb + 4);
    o[0] = b0[0]; o[1] = b0[1]; o[2] = b0[2]; o[3] = b0[3]; o[4] = b1[0]; o[5] = b1[1]; o[6] = b1[2]; o[7] = b1[3];
#pragma unroll
    for (int k = 0; k < 4; ++k) { const int pos = n * 128 + row - 2 + k;
        if (pos >= 0 && pos < SEQ) { const h16x8 x = *(const h16x8*)(projcol + (size_t)(tbase + row - 2 + k) * NPJ);
            const f32x4 w0 = *(const f32x4*)(cw + k * cdim), w1 = *(const f32x4*)(cw + k * cdim + 4);
#pragma unroll
            for (int e = 0; e < 4; ++e) { o[e] += w0[e] * (float)x[e]; o[4 + e] += w1[e] * (float)x[4 + e]; } } }
}

__device__ __forceinline__ void ret_states_unit(const Frame& F, int u) {
    const int h = u % 6, bn = u / 6, n = bn % NCH, b = bn / NCH; const long t0 = (long)b * SEQ + n * 128;
    const h16* proj = WSP(const h16, WS_R1); const float* rope = WSP(const float, OFF_ROPE);
    LAS h16* KT = (LAS h16*)F.lds; LAS h16* VT = KT + 64 * 136;
    { const int r = F.tid >> 2, c = F.tid & 3; const h16* rowp = proj + (size_t)(t0 + r) * NPJ; const float* cs = rope + (size_t)(n * 128 + r) * 64 + 8 * c;
        const h16x8 k1 = *(const h16x8*)(rowp + CK + h * 64 + 8 * c), k2 = *(const h16x8*)(rowp + CK + h * 64 + 32 + 8 * c);
        const f32x4 c0 = *(const f32x4*)cs, c1 = *(const f32x4*)(cs + 4), s0 = *(const f32x4*)(cs + 32), s1 = *(const f32x4*)(cs + 36);
#pragma unroll
        for (int e = 0; e < 8; ++e) { const float x1 = (float)k1[e], x2 = (float)k2[e], co = e < 4 ? c0[e] : c1[e - 4], si = e < 4 ? s0[e] : s1[e - 4];
            KT[(8 * c + e) * 136 + r] = (h16)((x1 * co - x2 * si) * 0.125f); KT[(32 + 8 * c + e) * 136 + r] = (h16)((x1 * si + x2 * co) * 0.125f); }
        const h16x8 v1 = *(const h16x8*)(rowp + CV + h * 64 + 16 * c), v2 = *(const h16x8*)(rowp + CV + h * 64 + 16 * c + 8);
#pragma unroll
        for (int e = 0; e < 8; ++e) { VT[(16 * c + e) * 136 + r] = v1[e]; VT[(16 * c + 8 + e) * 136 + r] = v2[e]; } }
    __syncthreads();
    const int dir = F.wave >> 2, dt = F.wave & 3, fr = F.lane & 15, fq = F.lane >> 4;
    const float l2g = log1pf(-exp2f(-5.0f - (float)h)) * 1.4426950408889634f;
    h16x8 xw[4];
#pragma unroll
    for (int ks = 0; ks < 4; ++ks) { const h16x8 f = ldsfrag(KT + (16 * dt + fr) * 136 + 32 * ks + 8 * fq); h16x8 w;
#pragma unroll
        for (int jj = 0; jj < 8; ++jj) { const int j = 32 * ks + 8 * fq + jj; w[jj] = (h16)exp2f(l2g * (float)(dir == 0 ? 127 - j : j)); }
        xw[ks] = f * w; }
    h16* rst = WSP(h16, OFF_RST) + ((size_t)((dir * NB + b) * NCH + n) * 6 + h) * 4096;
#pragma unroll
    for (int et = 0; et < 4; ++et) { f32x4 acc = {0.f, 0.f, 0.f, 0.f};
#pragma unroll
        for (int ks = 0; ks < 4; ++ks) acc = MFMA16(xw[ks], ldsfrag(VT + (16 * et + fr) * 136 + 32 * ks + 8 * fq), acc);
        *(h16x4*)(rst + (16 * et + fr) * 64 + 16 * dt + 4 * fq) = pack4(acc); }
    __syncthreads();
}
__device__ __forceinline__ void ret_scan_unit(const Frame& F, int u) {
    const int h = u % 6, b = (u / 6) % NB, dir = u / (6 * NB);
    const float gC = exp2f(128.0f * log1pf(-exp2f(-5.0f - (float)h)) * 1.4426950408889634f);
    float acc[8];
#pragma unroll
    for (int e = 0; e < 8; ++e) acc[e] = 0.f;
    for (int i = 0; i < NCH; ++i) { const int n = dir == 0 ? i : NCH - 1 - i;
        h16* pp = WSP(h16, OFF_RST) + ((size_t)((dir * NB + b) * NCH + n) * 6 + h) * 4096 + F.tid * 8;
        const h16x8 s = *(const h16x8*)pp; h16x8 o;
#pragma unroll
        for (int e = 0; e < 8; ++e) { o[e] = (h16)acc[e]; acc[e] = acc[e] * gC + (float)s[e]; }
        *(h16x8*)pp = o; }
}
__device__ __forceinline__ void ret_out_unit(const Frame& F, int u) {
    const int h = u % 6, bn = u / 6, n = bn % NCH, b = bn / NCH; const long t0 = (long)b * SEQ + n * 128;
    const h16* proj = WSP(const h16, WS_R1); const float* rope = WSP(const float, OFF_ROPE);
    LAS h16* Qt = (LAS h16*)F.lds; LAS h16* Kt = Qt + 128 * 72; LAS h16* VT = Kt + 128 * 72; LAS h16* Ff = VT + 64 * 136; LAS h16* Fb = Ff + 64 * 72;
    { const int r = F.tid >> 2, c = F.tid & 3; const h16* rowp = proj + (size_t)(t0 + r) * NPJ; const float* cs = rope + (size_t)(n * 128 + r) * 64 + 8 * c;
        const f32x4 c0 = *(const f32x4*)cs, c1 = *(const f32x4*)(cs + 4), s0 = *(const f32x4*)(cs + 32), s1 = *(const f32x4*)(cs + 36);
        const h16x8 q1 = *(const h16x8*)(rowp + CQ + h * 64 + 8 * c), q2 = *(const h16x8*)(rowp + CQ + h * 64 + 32 + 8 * c);
        const h16x8 k1 = *(const h16x8*)(rowp + CK + h * 64 + 8 * c), k2 = *(const h16x8*)(rowp + CK + h * 64 + 32 + 8 * c);
        h16x8 qa, qb, ka, kb;
#pragma unroll
        for (int e = 0; e < 8; ++e) { const float co = e < 4 ? c0[e] : c1[e - 4], si = e < 4 ? s0[e] : s1[e - 4];
            float x1 = (float)q1[e], x2 = (float)q2[e]; qa[e] = (h16)(x1 * co - x2 * si); qb[e] = (h16)(x1 * si + x2 * co);
            x1 = (float)k1[e]; x2 = (float)k2[e]; ka[e] = (h16)((x1 * co - x2 * si) * 0.125f); kb[e] = (h16)((x1 * si + x2 * co) * 0.125f); }
        *(LAS h16x8*)(Qt + r * 72 + 8 * c) = qa; *(LAS h16x8*)(Qt + r * 72 + 32 + 8 * c) = qb;
        *(LAS h16x8*)(Kt + r * 72 + 8 * c) = ka; *(LAS h16x8*)(Kt + r * 72 + 32 + 8 * c) = kb;
        const h16x8 v1 = *(const h16x8*)(rowp + CV + h * 64 + 16 * c), v2 = *(const h16x8*)(rowp + CV + h * 64 + 16 * c + 8);
#pragma unroll
        for (int e = 0; e < 8; ++e) { VT[(16 * c + e) * 136 + r] = v1[e]; VT[(16 * c + 8 + e) * 136 + r] = v2[e]; }
        const int er = F.tid >> 3, d0 = (F.tid & 7) * 8;
        const h16* sf = WSP(const h16, OFF_RST) + ((size_t)((0 * NB + b) * NCH + n) * 6 + h) * 4096;
        const h16* sb = WSP(const h16, OFF_RST) + ((size_t)((1 * NB + b) * NCH + n) * 6 + h) * 4096;
        *(LAS h16x8*)(Ff + er * 72 + d0) = *(const h16x8*)(sf + F.tid * 8); *(LAS h16x8*)(Fb + er * 72 + d0) = *(const h16x8*)(sb + F.tid * 8); }
    __syncthreads();
    const int w = F.wave, fr = F.lane & 15, fq = F.lane >> 4, il = 16 * w + fr;
    const float l2g = log1pf(-exp2f(-5.0f - (float)h)) * 1.4426950408889634f;
    h16x8 qf[2];
#pragma unroll
    for (int ks = 0; ks < 2; ++ks) qf[ks] = ldsfrag(Qt + il * 72 + 32 * ks + 8 * fq);
    f32x4 s[8];
#pragma unroll
    for (int jt = 0; jt < 8; ++jt) { f32x4 a = {0.f, 0.f, 0.f, 0.f};
#pragma unroll
        for (int ks = 0; ks < 2; ++ks) a = MFMA16(ldsfrag(Kt + (16 * jt + fr) * 72 + 32 * ks + 8 * fq), qf[ks], a);
#pragma unroll
        for (int r = 0; r < 4; ++r) { const int j = 16 * jt + 4 * fq + r; const int dd = il > j ? il - j : j - il; a[r] *= exp2f(l2g * (float)dd); }
        PINV(a); s[jt] = a; }
    f32x4 o[4];
#pragma unroll
    for (int et = 0; et < 4; ++et) o[et] = (f32x4){0.f, 0.f, 0.f, 0.f};
#pragma unroll
    for (int kp = 0; kp < 4; ++kp) { const h16x8 pf = pack8(s[2 * kp], s[2 * kp + 1]);
#pragma unroll
        for (int et = 0; et < 4; ++et) o[et] = MFMA16(ldsfrag2(VT + (16 * et + fr) * 136 + 32 * kp + 4 * fq, VT + (16 * et + fr) * 136 + 32 * kp + 16 + 4 * fq), pf, o[et]); }
    const float gf = exp2f(l2g * (float)(il + 1)), gb = exp2f(l2g * (float)(128 - il));
#pragma unroll
    for (int ks = 0; ks < 2; ++ks) { const h16x8 qff = scalefrag(qf[ks], gf), qfb = scalefrag(qf[ks], gb);
#pragma unroll
        for (int et = 0; et < 4; ++et) { o[et] = MFMA16(ldsfrag(Ff + (16 * et + fr) * 72 + 32 * ks + 8 * fq), qff, o[et]); o[et] = MFMA16(ldsfrag(Fb + (16 * et + fr) * 72 + 32 * ks + 8 * fq), qfb, o[et]); } }
    float ss = 0.f;
#pragma unroll
    for (int et = 0; et < 4; ++et) ss += (o[et][0] * o[et][0] + o[et][1] * o[et][1]) + (o[et][2] * o[et][2] + o[et][3] * o[et][3]);
    ss += __shfl_xor(ss, 16); ss += __shfl_xor(ss, 32);
    const float rs = 1.0f / sqrtf(ss * (1.0f / 64.0f) + EPS);
    const h16* grow = proj + (size_t)(t0 + il) * NPJ + CG + h * 64; h16* orow = WSP(h16, OFF_OMIX) + (size_t)(t0 + il) * DM + h * 64;
#pragma unroll
    for (int et = 0; et < 4; ++et) { const h16x4 gv = *(const h16x4*)(grow + 16 * et + 4 * fq); f32x4 r;
#pragma unroll
        for (int e = 0; e < 4; ++e) r[e] = o[et][e] * rs * siluf_((float)gv[e]);
        *(h16x4*)(orow + 16 * et + 4 * fq) = pack4(r); }
    __syncthreads();
}

__device__ __forceinline__ void ssd_stage_dt(const Frame& F, const Prm& p, int l, int g, long t0, LAS float* LA, LAS float* DTS) {
    if (F.tid < 128) { const h16* dp = WSP(const h16, WS_R1) + (size_t)(t0 + F.tid) * NPJ + CDT + g * 3;
#pragma unroll
        for (int r = 0; r < 3; ++r) { const float raw = (float)dp[r];
#pragma unroll
            for (int dir = 0; dir < 2; ++dir) { const float dt = softplusf_(raw + p.in[7][(l * 2 + dir) * 6 + g * 3 + r]); const float la = -dt * __expf(p.in[8][(l * 2 + dir) * 6 + g * 3 + r]);
                DTS[(dir * 3 + r) * 128 + F.tid] = dt; LA[(dir * 3 + r) * 128 + F.tid] = la; } } }
}
__device__ __forceinline__ void ssd_cumsum(const Frame& F, LAS const float* LAq, float& v0, float& v1, float& c0, float& c1, float& tot) {
    v0 = LAq[2 * F.lane]; v1 = LAq[2 * F.lane + 1]; float s = v0 + v1;
#pragma unroll
    for (int o = 1; o < 64; o <<= 1) { const float t = __shfl_up(s, o); if (F.lane >= o) s += t; }
    c1 = s; c0 = s - v1; tot = __shfl(s, 63);
}
__device__ __forceinline__ void ssd_states_unit(const Frame& F, const Prm& p, int l, int u) {
    const int g = u & 1, bn = u >> 1, n = bn % NCH, b = bn / NCH; const long t0 = (long)b * SEQ + n * 128;
    const h16* proj = WSP(const h16, WS_R1);
    LAS h16* XT = (LAS h16*)F.lds; LAS h16* BT = XT + 3 * 64 * 136; LAS float* LA = (LAS float*)(BT + 128 * 136); LAS float* DTS = LA + 6 * 128; LAS float* WW = DTS + 6 * 128;
    ssd_stage_dt(F, p, l, g, t0, LA, DTS);
    const float* cw = p.in[5] + (size_t)l * 4 * 896; const float* cb = p.in[6] + (size_t)l * 896;
    for (int it = F.tid; it < 128 * 40; it += 512) { const int row = it / 40, cg = it % 40; float o[8];
        if (cg < 24) { conv8(proj + CXS + g * 192 + 8 * cg, t0, n, row, cw + g * 192 + 8 * cg, 896, cb + g * 192 + 8 * cg, o);
            LAS h16* d = XT + (cg >> 3) * 64 * 136 + ((cg & 7) * 8) * 136 + row;
#pragma unroll
            for (int e = 0; e < 8; ++e) d[e * 136] = (h16)siluf_(o[e]);
        } else { const int cb8 = cg - 24; conv8(proj + CBM + g * 128 + 8 * cb8, t0, n, row, cw + 384 + g * 128 + 8 * cb8, 896, cb + 384 + g * 128 + 8 * cb8, o);
            LAS h16* d = BT + (8 * cb8) * 136 + row;
#pragma unroll
            for (int e = 0; e < 8; ++e) d[e * 136] = (h16)siluf_(o[e]); } }
    __syncthreads();
    if (F.wave < 6) { const int q = F.wave, dir = q / 3, r = q % 3; float v0, v1, c0, c1, tot; ssd_cumsum(F, LA + q * 128, v0, v1, c0, c1, tot);
        const float d0 = DTS[q * 128 + 2 * F.lane], d1 = DTS[q * 128 + 2 * F.lane + 1];
        if (dir == 0) { WW[q * 128 + 2 * F.lane] = __expf(tot - c0) * d0 * 256.f; WW[q * 128 + 2 * F.lane + 1] = __expf(tot - c1) * d1 * 256.f; }
        else { WW[q * 128 + 2 * F.lane] = __expf(c0 - v0) * d0 * 256.f; WW[q * 128 + 2 * F.lane + 1] = __expf(c1 - v1) * d1 * 256.f; }
        if (F.lane == 0) WSP(float, OFF_SDEC)[((size_t)(b * NCH + n) * 6 + g * 3 + r) * 2 + dir] = tot; }
    __syncthreads();
    const int w = F.wave, fr = F.lane & 15, fq = F.lane >> 4;
    h16x8 xb[4];
#pragma unroll
    for (int ks = 0; ks < 4; ++ks) xb[ks] = ldsfrag(BT + (16 * w + fr) * 136 + 32 * ks + 8 * fq);
    for (int q = 0; q < 6; ++q) { const int dir = q / 3, r = q % 3;
        h16x8 wf[4];
#pragma unroll
        for (int ks = 0; ks < 4; ++ks) { const f32x4 a = *(LAS const f32x4*)(WW + q * 128 + 32 * ks + 8 * fq), c = *(LAS const f32x4*)(WW + q * 128 + 32 * ks + 8 * fq + 4); wf[ks] = pack8(a, c); }
        h16* sst = WSP(h16, OFF_SST) + ((size_t)((dir * NB + b) * NCH + n) * 6 + g * 3 + r) * 8192;
#pragma unroll
        for (int pt = 0; pt < 4; ++pt) { f32x4 acc = {0.f, 0.f, 0.f, 0.f};
#pragma unroll
            for (int ks = 0; ks < 4; ++ks) acc = MFMA16(xb[ks], ldsfrag(XT + r * 64 * 136 + (16 * pt + fr) * 136 + 32 * ks + 8 * fq) * wf[ks], acc);
            *(h16x4*)(sst + (16 * pt + fr) * 128 + 16 * w + 4 * fq) = pack4(acc * (1.0f / 256.f)); } }
    __syncthreads();
}
__device__ __forceinline__ void ssd_scan_unit(const Frame& F, int u) {
    const int hd = u % 6, b = (u / 6) % NB, dir = u / (6 * NB);
    float acc[16];
#pragma unroll
    for (int e = 0; e < 16; ++e) acc[e] = 0.f;
    for (int i = 0; i < NCH; ++i) { const int n = dir == 0 ? i : NCH - 1 - i;
        h16* pp = WSP(h16, OFF_SST) + ((size_t)((dir * NB + b) * NCH + n) * 6 + hd) * 8192 + F.tid * 16;
        const float dec = __expf(WSP(const float, OFF_SDEC)[((size_t)(b * NCH + n) * 6 + hd) * 2 + dir]);
        const h16x8 s0 = *(const h16x8*)pp, s1 = *(const h16x8*)(pp + 8); h16x8 o0, o1;
#pragma unroll
        for (int e = 0; e < 8; ++e) { o0[e] = (h16)acc[e]; o1[e] = (h16)acc[8 + e]; acc[e] = acc[e] * dec + (float)s0[e]; acc[8 + e] = acc[8 + e] * dec + (float)s1[e]; }
        *(h16x8*)pp = o0; *(h16x8*)(pp + 8) = o1; }
}
__device__ __forceinline__ void ssd_out_unit(const Frame& F, const Prm& p, int l, int u) {
    const int g = u & 1, bn = u >> 1, n = bn % NCH, b = bn / NCH; const long t0 = (long)b * SEQ + n * 128;
    const h16* proj = WSP(const h16, WS_R1);
    LAS h16* XT = (LAS h16*)F.lds; LAS h16* Bt = XT + 3 * 64 * 136; LAS h16* Ct = Bt + 128 * 136; LAS float* LA = (LAS float*)(Ct + 128 * 136); LAS float* DTS = LA + 6 * 128;
    LAS float* CE = DTS + 6 * 128;
    LAS float* TOTB = CE + 6 * 128;
    ssd_stage_dt(F, p, l, g, t0, LA, DTS);
    const float* cw = p.in[5] + (size_t)l * 4 * 896; const float* cb = p.in[6] + (size_t)l * 896;
    for (int it = F.tid; it < 128 * 56; it += 512) { const int row = it / 56, cg = it % 56; float o[8];
        if (cg < 24) { conv8(proj + CXS + g * 192 + 8 * cg, t0, n, row, cw + g * 192 + 8 * cg, 896, cb + g * 192 + 8 * cg, o);
            LAS h16* d = XT + (cg >> 3) * 64 * 136 + ((cg & 7) * 8) * 136 + row;
#pragma unroll
            for (int e = 0; e < 8; ++e) d[e * 136] = (h16)siluf_(o[e]);
        } else { const int c8 = (cg - 24) & 15; const bool isB = cg < 40; const int col = (isB ? CBM : CCM) + g * 128 + 8 * c8, ci = (isB ? 384 : 640) + g * 128 + 8 * c8;
            conv8(proj + col, t0, n, row, cw + ci, 896, cb + ci, o); h16x8 v;
#pragma unroll
            for (int e = 0; e < 8; ++e) v[e] = (h16)siluf_(o[e]);
            *(LAS h16x8*)((isB ? Bt : Ct) + row * 136 + 8 * c8) = v; } }
    __syncthreads();
    if (F.wave < 6) { const int q = F.wave; float v0, v1, c0, c1, tot; ssd_cumsum(F, LA + q * 128, v0, v1, c0, c1, tot);
        if (q < 3) { CE[q * 128 + 2 * F.lane] = c0; CE[q * 128 + 2 * F.lane + 1] = c1; }
        else { CE[q * 128 + 2 * F.lane] = c0 - v0; CE[q * 128 + 2 * F.lane + 1] = c1 - v1; if (F.lane == 0) TOTB[q - 3] = tot; } }
    __syncthreads();
    const int w = F.wave, fr = F.lane & 15, fq = F.lane >> 4, il = 16 * w + fr;
    h16x8 cf[4];
#pragma unroll
    for (int ks = 0; ks < 4; ++ks) cf[ks] = ldsfrag(Ct + il * 136 + 32 * ks + 8 * fq);
    f32x4 gT[8];
#pragma unroll
    for (int jt = 0; jt < 8; ++jt) { f32x4 a = {0.f, 0.f, 0.f, 0.f};
#pragma unroll
        for (int ks = 0; ks < 4; ++ks) a = MFMA16(ldsfrag(Bt + (16 * jt + fr) * 136 + 32 * ks + 8 * fq), cf[ks], a);
        PINV(a); gT[jt] = a; }
    const float* dsk = p.in[9] + l * 6 + g * 3;
    h16* orow = WSP(h16, OFF_OMIX) + (size_t)(t0 + il) * DM + 384 + g * 192;
    float ss = 0.f;
#pragma unroll 1
    for (int r = 0; r < 3; ++r) {
        f32x4 y[1][4];
        const int hd = g * 3 + r;
        const float cfi = CE[r * 128 + il], ebi = CE[(3 + r) * 128 + il], totb = TOTB[r];
#pragma unroll
        for (int pt = 0; pt < 4; ++pt) y[0][pt] = (f32x4){0.f, 0.f, 0.f, 0.f};
#pragma unroll
        for (int kp = 0; kp < 4; ++kp) { f32x4 pv[2];
#pragma unroll
            for (int jh = 0; jh < 2; ++jh) { const int jt = 2 * kp + jh, j0 = 16 * jt + 4 * fq;
                const f32x4 cfj = *(LAS const f32x4*)(CE + r * 128 + j0), ebj = *(LAS const f32x4*)(CE + (3 + r) * 128 + j0), dfj = *(LAS const f32x4*)(DTS + r * 128 + j0), dbj = *(LAS const f32x4*)(DTS + (3 + r) * 128 + j0);
#pragma unroll
                for (int e = 0; e < 4; ++e) { const int j = j0 + e; const float val = (il >= j) ? __expf(cfi - cfj[e]) * dfj[e] : __expf(ebj[e] - ebi) * dbj[e]; pv[jh][e] = gT[jt][e] * val * 256.f; } }
            const h16x8 pf = pack8(pv[0], pv[1]);
#pragma unroll
            for (int pt = 0; pt < 4; ++pt) { LAS const h16* xr = XT + r * 64 * 136 + (16 * pt + fr) * 136 + 32 * kp + 4 * fq; y[0][pt] = MFMA16(ldsfrag2(xr, xr + 16), pf, y[0][pt]); }
            PINV(y[0][0]); PINV(y[0][1]); PINV(y[0][2]); PINV(y[0][3]); }
        const float ef = __expf(cfi) * 256.f, eb = __expf(totb - ebi) * 256.f;
        const h16* hf = WSP(const h16, OFF_SST) + ((size_t)((0 * NB + b) * NCH + n) * 6 + hd) * 8192;
        const h16* hb = WSP(const h16, OFF_SST) + ((size_t)((1 * NB + b) * NCH + n) * 6 + hd) * 8192;
#pragma unroll
        for (int ks = 0; ks < 4; ++ks) { const h16x8 cff = scalefrag(cf[ks], ef), cfb = scalefrag(cf[ks], eb);
#pragma unroll
            for (int pt = 0; pt < 4; ++pt) { y[0][pt] = MFMA16(*(const h16x8*)(hf + (16 * pt + fr) * 128 + 32 * ks + 8 * fq), cff, y[0][pt]);
                y[0][pt] = MFMA16(*(const h16x8*)(hb + (16 * pt + fr) * 128 + 32 * ks + 8 * fq), cfb, y[0][pt]); }
            PINV(y[0][0]); PINV(y[0][1]); PINV(y[0][2]); PINV(y[0][3]); }
        const float dk = dsk[r]; const h16* zrow = proj + (size_t)(t0 + il) * NPJ + CZ + hd * 64;
#pragma unroll
        for (int pt = 0; pt < 4; ++pt) { const h16x4 zv = *(const h16x4*)(zrow + 16 * pt + 4 * fq);
#pragma unroll
            for (int e = 0; e < 4; ++e) { const float xv = (float)XT[r * 64 * 136 + (16 * pt + 4 * fq + e) * 136 + il]; y[0][pt][e] = (y[0][pt][e] * (1.0f / 256.f) + dk * xv) * siluf_((float)zv[e]); }
            const h16x4 yh = pack4(y[0][pt]); *(h16x4*)(orow + r * 64 + 16 * pt + 4 * fq) = yh;
#pragma unroll
            for (int e = 0; e < 4; ++e) { const float q = (float)yh[e]; ss += q * q; } }
    }
    ss += __shfl_xor(ss, 16); ss += __shfl_xor(ss, 32);
    const float rs = 1.0f / sqrtf(ss * (1.0f / 192.0f) + EPS);
    const float* nw = p.in[10] + l * 384 + g * 192;
    asm volatile("s_waitcnt vmcnt(0)" ::: "memory");
#pragma unroll 1
    for (int r = 0; r < 3; ++r)
#pragma unroll
        for (int pt = 0; pt < 4; ++pt) { const f32x4 wv = *(const f32x4*)(nw + r * 64 + 16 * pt + 4 * fq); h16* op = orow + r * 64 + 16 * pt + 4 * fq; const h16x4 yh = *(const h16x4*)op; f32x4 yv;
#pragma unroll
            for (int e = 0; e < 4; ++e) yv[e] = (float)yh[e] * rs * wv[e];
            *(h16x4*)op = pack4(yv); }
    __syncthreads();
}

template <bool FINAL>
__device__ __forceinline__ void lru_unit(const Frame& F, const Prm& p, int l, int u) {
    const int n = u % NCH, b = u / NCH; const long t0 = (long)b * SEQ + n * 128;
    const h16* proj = WSP(const h16, WS_R1);
    LAS h16* XC = (LAS h16*)F.lds;
    const float* cw = p.in[11] + (size_t)l * 4 * 256; const float* cb = p.in[12] + (size_t)l * 256;
    for (int it = F.tid; it < 128 * 32; it += 512) { const int row = it >> 5, cg = it & 31; float o[8];
        conv8(proj + CXR + 8 * cg, t0, n, row, cw + 8 * cg, 256, cb + 8 * cg, o); h16x8 v;
#pragma unroll
        for (int e = 0; e < 8; ++e) v[e] = (h16)o[e];
        *(LAS h16x8*)(XC + row * 264 + 8 * cg) = v; }
    __syncthreads();
    const int blk = F.wave & 3, jh = F.wave >> 2, fr = F.lane & 15, fq = F.lane >> 4;
#pragma unroll
    for (int dir = 0; dir < 2; ++dir) {
        h16x8 wa[2][2], wx[2][2]; float ba[2], bx[2], sp[2], car[2];
#pragma unroll
        for (int jt = 0; jt < 2; ++jt) { const int ch = blk * 64 + 32 * jh + 16 * jt + fr;
#pragma unroll
            for (int ks = 0; ks < 2; ++ks) { wa[jt][ks] = *(const h16x8*)(WSP(const h16, WS_LRUW) + (size_t)((dir * 2 + 0) * 4 + blk) * 4096 + (32 * jh + 16 * jt + fr) * 64 + 32 * ks + 8 * fq);
                wx[jt][ks] = *(const h16x8*)(WSP(const h16, WS_LRUW) + (size_t)((dir * 2 + 1) * 4 + blk) * 4096 + (32 * jh + 16 * jt + fr) * 64 + 32 * ks + 8 * fq); }
            ba[jt] = p.in[15][(l * 2 + dir) * 256 + ch]; bx[jt] = p.in[17][(l * 2 + dir) * 256 + ch]; sp[jt] = softplusf_(-p.in[13][(l * 2 + dir) * 256 + ch]);
            car[jt] = FINAL ? WSP(const float, OFF_LCAR)[((size_t)(b * NCH + n) * 2 + dir) * 256 + ch] : 0.f; }
        float atot[2] = {1.f, 1.f};
#pragma unroll 1
        for (int ti = 0; ti < 8; ++ti) { const int tt = dir == 0 ? ti : 7 - ti;
            h16x8 xf[2];
#pragma unroll
            for (int ks = 0; ks < 2; ++ks) xf[ks] = ldsfrag(XC + (16 * tt + fr) * 264 + blk * 64 + 32 * ks + 8 * fq);
#pragma unroll
            for (int jt = 0; jt < 2; ++jt) { const int ch = blk * 64 + 32 * jh + 16 * jt + fr;
                f32x4 ra = {0.f, 0.f, 0.f, 0.f}, ia = {0.f, 0.f, 0.f, 0.f};
#pragma unroll
                for (int ks = 0; ks < 2; ++ks) { ra = MFMA16(xf[ks], wa[jt][ks], ra); ia = MFMA16(xf[ks], wx[jt][ks], ia); }
                float av[4], uv[4]; float A = 1.f, H = 0.f;
#pragma unroll
                for (int ri = 0; ri < 4; ++ri) { const int rg = dir == 0 ? ri : 3 - ri; const float rgate = sigmoidf_(ra[rg] + ba[jt]), ig = sigmoidf_(ia[rg] + bx[jt]);
                    const float la = -8.0f * rgate * sp[jt]; const float a = __expf(la); const float mult = sqrtf(-expm1f(2.0f * la));
                    const float xv = (float)XC[(16 * tt + 4 * fq + rg) * 264 + ch]; const float uu = mult * ig * xv;
                    av[rg] = a; uv[rg] = uu; H = a * H + uu; A *= a; }
                float Ag[4], Hg[4];
#pragma unroll
                for (int gq = 0; gq < 4; ++gq) { Ag[gq] = __shfl(A, fr + 16 * gq); Hg[gq] = __shfl(H, fr + 16 * gq); }
                float hin = car[jt], cnew = car[jt], at = 1.f;
#pragma unroll
                for (int gi = 0; gi < 4; ++gi) { const int gq = dir == 0 ? gi : 3 - gi;
                    const bool before = dir == 0 ? (gq < fq) : (gq > fq);
                    if (before) hin = Ag[gq] * hin + Hg[gq];
                    cnew = Ag[gq] * cnew + Hg[gq]; at *= Ag[gq]; }
                car[jt] = cnew; atot[jt] *= at;
                if (FINAL) { float hh = hin;
#pragma unroll
                    for (int ri = 0; ri < 4; ++ri) { const int rg = dir == 0 ? ri : 3 - ri; hh = av[rg] * hh + uv[rg];
                        const long t = t0 + 16 * tt + 4 * fq + rg; h16* op = WSP(h16, OFF_OMIX) + (size_t)t * DM + 768 + ch;
                        if (dir == 0) *op = (h16)hh;
                        else { const float gt = (float)proj[(size_t)t * NPJ + CGT + ch]; *op = (h16)(((float)*op + hh) * gelu_tanh_(gt)); } } }
            } }
        if (!FINAL && fq == 0) {
#pragma unroll
            for (int jt = 0; jt < 2; ++jt) { const int ch = blk * 64 + 32 * jh + 16 * jt + fr; *(f32x2*)(WSP(float, OFF_LSUM) + (((size_t)(b * NCH + n) * 2 + dir) * 256 + ch) * 2) = (f32x2){atot[jt], car[jt]}; } }
    }
    __syncthreads();
}
__device__ __forceinline__ void lru_scan(const Frame& F) {
    const int gi = F.vcu * 512 + F.tid; if (gi >= NB * 2 * 256) return;
    const int ch = gi & 255, dir = (gi >> 8) & 1, b = gi >> 9; float H = 0.f;
    for (int i = 0; i < NCH; ++i) { const int n = dir == 0 ? i : NCH - 1 - i; const size_t idx = ((size_t)(b * NCH + n) * 2 + dir) * 256 + ch;
        const f32x2 s = *(const f32x2*)(WSP(const float, OFF_LSUM) + idx * 2); WSP(float, OFF_LCAR)[idx] = H; H = s[0] * H + s[1]; }
}

__device__ __forceinline__ void attn_unit(const Frame& F, int u) {
    const int qb = u & 15, hd = (u >> 4) & 3, b = u >> 6;
    const int fr = F.lane & 15, fq = F.lane >> 4; const long t = (long)b * SEQ + qb * 128 + 16 * F.wave + fr;
    LAS h16* TL = (LAS h16*)F.lds;
    const h16* qrow = WSP(const h16, OFF_QCA) + (size_t)t * DM + hd * 256;
    h16x8 qf[8];
#pragma unroll
    for (int ks = 0; ks < 8; ++ks) qf[ks] = *(const h16x8*)(qrow + 32 * ks + 8 * fq);
    f32x4 s[16];
#pragma unroll
    for (int half = 0; half < 2; ++half) {
        __syncthreads();
        const h16* kb = WSP(const h16, OFF_KB) + (size_t)(b * 256 + half * 128) * DM + hd * 256;
        for (int it = F.tid; it < 128 * 32; it += 512) { const int row = it >> 5, c = it & 31; *(LAS h16x8*)(TL + row * 264 + 8 * c) = *(const h16x8*)(kb + (size_t)row * DM + 8 * c); }
        __syncthreads();
#pragma unroll
        for (int jt = 0; jt < 8; ++jt) { f32x4 a = {0.f, 0.f, 0.f, 0.f};
#pragma unroll
            for (int ks = 0; ks < 8; ++ks) a = MFMA16(ldsfrag(TL + (16 * jt + fr) * 264 + 32 * ks + 8 * fq), qf[ks], a);
            PINV(a); s[half * 8 + jt] = a; }
    }
    float mx = -3.0e38f;
#pragma unroll
    for (int jt = 0; jt < 16; ++jt) mx = fmaxf(mx, fmaxf(fmaxf(s[jt][0], s[jt][1]), fmaxf(s[jt][2], s[jt][3])));
    mx = fmaxf(mx, __shfl_xor(mx, 16)); mx = fmaxf(mx, __shfl_xor(mx, 32));
    float sum = 0.f;
#pragma unroll
    for (int jt = 0; jt < 16; ++jt)
#pragma unroll
        for (int e = 0; e < 4; ++e) { const float pe = __expf(s[jt][e] - mx); s[jt][e] = pe; sum += pe; }
    sum += __shfl_xor(sum, 16); sum += __shfl_xor(sum, 32);
    const float inv = 1.0f / sum;
    h16x8 pf[8];
#pragma unroll
    for (int kp = 0; kp < 8; ++kp) pf[kp] = pack8(s[2 * kp] * inv, s[2 * kp + 1] * inv);
    f32x4 o[16];
#pragma unroll
    for (int et = 0; et < 16; ++et) o[et] = (f32x4){0.f, 0.f, 0.f, 0.f};
#pragma unroll
    for (int half = 0; half < 2; ++half) {
        __syncthreads();
        const h16* vt = WSP(const h16, OFF_VT) + (size_t)(b * 4 + hd) * 65536 + half * 128;
        for (int it = F.tid; it < 256 * 16; it += 512) { const int row = it >> 4, c = it & 15; *(LAS h16x8*)(TL + row * 136 + 8 * c) = *(const h16x8*)(vt + (size_t)row * 256 + 8 * c); }
        __syncthreads();
#pragma unroll
        for (int et = 0; et < 16; ++et) {
#pragma unroll
            for (int kp = 0; kp < 4; ++kp) { LAS const h16* vr = TL + (16 * et + fr) * 136 + 32 * kp + 4 * fq; o[et] = MFMA16(ldsfrag2(vr, vr + 16), pf[half * 4 + kp], o[et]); }
            PINV(o[et]); }
    }
    h16* orow = WSP(h16, OFF_OATT) + (size_t)t * DM + hd * 256;
#pragma unroll
    for (int et = 0; et < 16; ++et) *(h16x4*)(orow + 16 * et + 4 * fq) = pack4(o[et]);
}

__device__ __forceinline__ void phase_router(const Frame& F, const Prm& p, int l) {
    LAS float* RW = (LAS float*)F.lds;
    const float* gm = p.in[23] + l * DM; const float* wg = p.in[24] + (size_t)l * DM * 4; const float* we = p.in[26] + (size_t)l * DM * 32;
    for (int i = F.tid; i < 36 * DM; i += 512) { const int k = i / 36, j = i % 36; RW[j * DM + k] = gm[k] * (j < 4 ? wg[k * 4 + j] : we[k * 32 + (j - 4)]); }
    LAS unsigned* hist = (LAS unsigned*)(F.lds + 36 * DM * 4);
    if (F.tid < 32) hist[F.tid] = 0u;
    __syncthreads();
    const float* h = p.out; const float* ssq = WSP(const float, WS_SSQ);
    const int gw = F.vcu * 8 + F.wave, NGW = F.G * 8;
    const float biasv = F.lane < 4 ? p.in[25][l * 4 + F.lane] : (F.lane < 36 ? p.in[27][l * 32 + F.lane - 4] : 0.f);
    for (int tk = gw; tk < NT; tk += NGW) {
        f32x4 hv[4];
#pragma unroll
        for (int j = 0; j < 4; ++j) hv[j] = *(const f32x4*)(h + (size_t)tk * DM + 4 * F.lane + 256 * j);
        const float rs = row_rstd(ssq + (size_t)tk * 16);
        float mine = 0.f;
        for (int j = 0; j < 36; ++j) { float a = 0.f;
#pragma unroll
            for (int q = 0; q < 4; ++q) { const f32x4 wv = *(LAS const f32x4*)(RW + j * DM + 4 * F.lane + 256 * q); a += (hv[q][0] * wv[0] + hv[q][1] * wv[1]) + (hv[q][2] * wv[2] + hv[q][3] * wv[3]); }
            a = wave_sum(a); if (F.lane == j) mine = a; }
        mine = mine * rs + biasv;
        float gl[4];
#pragma unroll
        for (int j = 0; j < 4; ++j) gl[j] = __shfl(mine, j);
        int gi = 0; float gmx = gl[0];
#pragma unroll
        for (int j = 1; j < 4; ++j) if (gl[j] > gmx) { gmx = gl[j]; gi = j; }
        float gsum = 0.f;
#pragma unroll
        for (int j = 0; j < 4; ++j) gsum += __expf(gl[j] - gmx);
        const float gp = 1.0f / gsum;
        float el[8];
#pragma unroll
        for (int j = 0; j < 8; ++j) el[j] = __shfl(mine, 4 + gi * 8 + j);
        int e1 = 0; float m1 = el[0];
#pragma unroll
        for (int j = 1; j < 8; ++j) if (el[j] > m1) { m1 = el[j]; e1 = j; }
        int e2 = -1; float m2 = -3.0e38f;
#pragma unroll
        for (int j = 0; j < 8; ++j) if (j != e1 && el[j] > m2) { m2 = el[j]; e2 = j; }
        const float r2 = __expf(m2 - m1); const float g1 = gp / (1.0f + r2), g2 = gp * r2 / (1.0f + r2);
        if (F.lane == 0) { const int x1 = gi * 8 + e1, x2 = gi * 8 + e2;
            *(int2*)(WSP(int, OFF_EID) + (size_t)tk * 2) = make_int2(x1, x2); *(f32x2*)(WSP(float, OFF_GATE) + (size_t)tk * 2) = (f32x2){g1, g2};
            WSP(float, OFF_RSTDT)[tk] = rs; __hip_atomic_fetch_add(&hist[x1], 1u, __ATOMIC_RELAXED, __HIP_MEMORY_SCOPE_WORKGROUP); __hip_atomic_fetch_add(&hist[x2], 1u, __ATOMIC_RELAXED, __HIP_MEMORY_SCOPE_WORKGROUP); }
    }
    __syncthreads();
    if (F.tid < 32 && hist[F.tid]) atomicAdd(WSP(unsigned, WS_CTL) + CW_COUNTS + l * 64 + F.tid, hist[F.tid]);
    __syncthreads();
}
__device__ __forceinline__ void phase_dispatch(const Frame& F, int l) {
    LAS int* cnt = (LAS int*)F.lds; LAS int* base = cnt + 32; LAS int* pstart = base + 32; LAS int* slots = pstart + 40;
    unsigned* ctl = WSP(unsigned, WS_CTL);
    for (int blk = F.vcu; blk < NT / 128; blk += F.G) {
        __syncthreads();
        if (F.tid < 32) cnt[F.tid] = 0;
        if (F.tid == 32) { int acc = 0; for (int e = 0; e < 32; ++e) { pstart[e] = acc; acc += (int)((ctl[CW_COUNTS + l * 64 + e] + 255u) & ~255u); } pstart[32] = acc; }
        __syncthreads();
        int e = 0, rank = 0, tok = 0;
        if (F.tid < 256) { tok = blk * 128 + (F.tid >> 1); e = WSP(const int, OFF_EID)[(size_t)tok * 2 + (F.tid & 1)]; rank = __hip_atomic_fetch_add(&cnt[e], 1, __ATOMIC_RELAXED, __HIP_MEMORY_SCOPE_WORKGROUP); }
        __syncthreads();
        if (F.tid < 32) base[F.tid] = cnt[F.tid] ? (int)atomicAdd(&ctl[CW_CURSOR + l * 64 + F.tid], (unsigned)cnt[F.tid]) : 0;
        __syncthreads();
        if (F.tid < 256) { const int slot = pstart[e] + base[e] + rank; slots[F.tid] = slot; WSP(int, OFF_TSLOT)[(size_t)tok * 2 + (F.tid & 1)] = slot; WSP(float, OFF_SRSTD)[slot] = WSP(const float, OFF_RSTDT)[tok]; }
        __syncthreads();
        for (int a = F.wave * 32; a < F.wave * 32 + 32; ++a) { const int slot = slots[a]; const int tk = blk * 128 + (a >> 1);
            const h16* src = WSP(const h16, WS_HB) + (size_t)tk * DM; h16* dst = WSP(h16, OFF_XP) + (size_t)slot * DM;
            *(h16x8*)(dst + 8 * F.lane) = *(const h16x8*)(src + 8 * F.lane); *(h16x8*)(dst + 512 + 8 * F.lane) = *(const h16x8*)(src + 512 + 8 * F.lane); }
        if (blk == 0 && F.tid == 0) { const int ntl = pstart[32] >> 8; ctl[CW_NTILES + l] = (unsigned)ntl; int* te = WSP(int, OFF_TILEE);
            for (int e2 = 0; e2 < 32; ++e2) for (int tl = pstart[e2] >> 8; tl < (pstart[e2 + 1] >> 8); ++tl) te[tl] = e2; }
    }
    __syncthreads();
}
__device__ __forceinline__ void phase_combine(const Frame& F, const Prm& p, int l) {
    const int gw = F.vcu * 8 + F.wave, NGW = F.G * 8;
    const bool last = (l == NLAYER - 1);
    for (int tk = gw; tk < NT; tk += NGW) {
        const int2 sl = *(const int2*)(WSP(const int, OFF_TSLOT) + (size_t)tk * 2); const f32x2 gt = *(const f32x2*)(WSP(const float, OFF_GATE) + (size_t)tk * 2);
        float* hrow = p.out + (size_t)tk * DM; const h16* y0 = WSP(const h16, OFF_YP) + (size_t)sl.x * DM; const h16* y1 = WSP(const h16, OFF_YP) + (size_t)sl.y * DM;
        f32x4 v[4]; float s = 0.f;
#pragma unroll
        for (int j = 0; j < 4; ++j) { const int c = 4 * F.lane + 256 * j; const h16x4 a = *(const h16x4*)(y0 + c), bq = *(const h16x4*)(y1 + c); f32x4 hv = *(const f32x4*)(hrow + c);
#pragma unroll
            for (int e = 0; e < 4; ++e) hv[e] += gt[0] * (float)a[e] + gt[1] * (float)bq[e];
            v[j] = hv; s += (hv[0] * hv[0] + hv[1] * hv[1]) + (hv[2] * hv[2] + hv[3] * hv[3]); }
        s = wave_sum(s);
        if (!last) {
#pragma unroll
            for (int j = 0; j < 4; ++j) { const int c = 4 * F.lane + 256 * j; *(f32x4*)(hrow + c) = v[j]; *(h16x4*)(WSP(h16, WS_HB) + (size_t)tk * DM + c) = pack4(v[j]); }
            if (F.lane < 16) WSP(float, WS_SSQ)[(size_t)tk * 16 + F.lane] = (F.lane == 0) ? s : 0.f;
        } else { const float rs = 1.0f / sqrtf(s * (1.0f / DM) + EPS);
#pragma unroll
            for (int j = 0; j < 4; ++j) { const int c = 4 * F.lane + 256 * j; const f32x4 gf = *(const f32x4*)(p.in[31] + c); *(f32x4*)(hrow + c) = v[j] * rs * gf; } }
    }
}

__global__ void __launch_bounds__(512, 2) fwd(Prm p) {
    extern __shared__ __attribute__((aligned(16))) unsigned char lds_raw[];
    Frame F; F.lds = (LAS unsigned char*)lds_raw; F.ws = p.ws;
    F.tid = threadIdx.x; F.lane = F.tid & 63; F.wave = __builtin_amdgcn_readfirstlane(F.tid >> 6);
    F.G = gridDim.x; { const int bx = blockIdx.x; F.vcu = (F.G % 8 == 0) ? (bx % 8) * (F.G / 8) + bx / 8 : bx; }
    volatile LAS unsigned* misc = (volatile LAS unsigned*)(F.lds + LDS_MISC);
    if (F.tid < 4) misc[F.tid] = 0u;
    __syncthreads();
    const int lo = p.ph_lo, hi = p.ph_hi;
    XcdBarrier bar; bar.bar = WSP(unsigned, WS_CTL) + CW_BAR; bar.x = 0; bar.st = misc;
    if (hi - lo > 1) bar = xcd_barrier_post(WSP(unsigned, WS_CTL) + CW_BAR, misc);
#ifndef UMASK
#define UMASK 7
#endif
#ifndef PHMASK
#define PHMASK 0x3fff
#endif
#define IN(k) (((PHMASK >> ((k) % NPH)) & 1) && lo <= (k) && (k) < hi && (launder(F), true))
#define INR(k) (lo <= (k) && (k) < hi)
#define SEAM(k) do { if (INR(k) && INR((k) + 1)) xcd_barrier(bar); } while (0)
    for (int l = 0; l < NLAYER; ++l) {
        const int pb = l * NPH;
        if (IN(pb + 0)) { phase_convert(F, p, l); } SEAM(pb + 0);
        if (IN(pb + 1)) {
            if (UMASK & 1) { pg8::Gemm g{WSP(const h16, WS_HB), WSP(const h16, WS_WIN), DM, DM, DM}; pg8::StaticOrder S; S.init(NT, NPJ, F.G, (int)blockIdx.x);
              pg8::EpiScale16 E{WSP(h16, WS_R1), NPJ, WSP(const float, WS_SSQ)}; pg8::gemm_phase(F.lds, F.tid, g, S, E); }
            launder(F);
            if (UMASK & 2) { pg8::Gemm g{WSP(const h16, WS_MEM16), WSP(const h16, WS_WKV), DM, DM, DM}; pg8::StaticOrder S; S.init(NTM, 2048, F.G, (int)blockIdx.x);
              pg8::EpiKV E{WSP(h16, OFF_KB), WSP(h16, OFF_VT), WSP(const float, OFF_MSSQ)}; pg8::gemm_phase(F.lds, F.tid, g, S, E); }
        } SEAM(pb + 1);
        if (IN(pb + 2)) {
            if (UMASK & 1) for (int u = blockIdx.x; u < NB * NCH * 2; u += F.G) ssd_states_unit(F, p, l, u);
            if (UMASK & 2) for (int u = blockIdx.x; u < NB * NCH * 6; u += F.G) ret_states_unit(F, u);
            if (UMASK & 4) for (int u = blockIdx.x; u < NB * NCH; u += F.G) lru_unit<false>(F, p, l, u);
        } SEAM(pb + 2);
        if (IN(pb + 3)) {
            for (int u = blockIdx.x; u < 2 * NB * 6; u += F.G) ssd_scan_unit(F, u);
            for (int u = blockIdx.x; u < 2 * NB * 6; u += F.G) ret_scan_unit(F, u);
            lru_scan(F);
        } SEAM(pb + 3);
        if (IN(pb + 4)) {
            if (UMASK & 1) for (int u = blockIdx.x; u < NB * NCH * 2; u += F.G) ssd_out_unit(F, p, l, u);
            if (UMASK & 2) for (int u = blockIdx.x; u < NB * NCH * 6; u += F.G) ret_out_unit(F, u);
            if (UMASK & 4) for (int u = blockIdx.x; u < NB * NCH; u += F.G) lru_unit<true>(F, p, l, u);
        } SEAM(pb + 4);
        if (IN(pb + 5)) { pg8::Gemm g{WSP(const h16, OFF_OMIX), WSP(const h16, WS_WOUT), DM, DM, DM}; pg8::StaticOrder S; S.init(NT, DM, F.G, (int)blockIdx.x);
            pg8::EpiResid E{l == 0 ? p.in[0] : p.out, p.out, WSP(h16, WS_HB), WSP(float, WS_SSQ)}; pg8::gemm_phase(F.lds, F.tid, g, S, E); } SEAM(pb + 5);
        if (IN(pb + 6)) { pg8::Gemm g{WSP(const h16, WS_HB), WSP(const h16, WS_WQ), DM, DM, DM}; pg8::StaticOrder S; S.init(NT, DM, F.G, (int)blockIdx.x);
            pg8::EpiScale16 E{WSP(h16, OFF_QCA), DM, WSP(const float, WS_SSQ)}; pg8::gemm_phase(F.lds, F.tid, g, S, E); } SEAM(pb + 6);
        if (IN(pb + 7)) { for (int u = F.vcu; u < NB * 4 * 16; u += F.G) attn_unit(F, u); } SEAM(pb + 7);
        if (IN(pb + 8)) { pg8::Gemm g{WSP(const h16, OFF_OATT), WSP(const h16, WS_WO), DM, DM, DM}; pg8::StaticOrder S; S.init(NT, DM, F.G, (int)blockIdx.x);
            pg8::EpiResid E{p.out, p.out, WSP(h16, WS_HB), WSP(float, WS_SSQ)}; pg8::gemm_phase(F.lds, F.tid, g, S, E); } SEAM(pb + 8);
        if (IN(pb + 9)) { phase_router(F, p, l); } SEAM(pb + 9);
        if (IN(pb + 10)) { phase_dispatch(F, l); } SEAM(pb + 10);
        if (IN(pb + 11)) { pg8::Gemm g{WSP(const h16, OFF_XP), WSP(const h16, WS_W13), DM, DM, DM};
            pg8::GroupOrder S{WSP(const int, OFF_TILEE), __builtin_amdgcn_readfirstlane((int)WSP(const unsigned, WS_CTL)[CW_NTILES + l]), F.G, F.vcu};
            pg8::EpiGated E{WSP(h16, OFF_HP), WSP(const float, OFF_SRSTD)}; pg8::gemm_phase(F.lds, F.tid, g, S, E); } SEAM(pb + 11);
        if (IN(pb + 12)) { pg8::Gemm g{WSP(const h16, OFF_HP), WSP(const h16, WS_W2), 512, 512, 512};
            pg8::GroupOrder S{WSP(const int, OFF_TILEE), __builtin_amdgcn_readfirstlane((int)WSP(const unsigned, WS_CTL)[CW_NTILES + l]), F.G, F.vcu};
            pg8::EpiPlain16 E{WSP(h16, OFF_YP)}; pg8::gemm_phase(F.lds, F.tid, g, S, E); } SEAM(pb + 12);
        if (IN(pb + 13)) { phase_combine(F, p, l); } SEAM(pb + 13);
    }
#undef IN
#undef INR
#undef SEAM
}

extern "C" void kernel_launch(void* const* d_in, const int* in_sizes, int n_in, void* d_out, int out_size, void* d_ws, size_t ws_size, hipStream_t stream) {
    static int grid = 0;
    if (grid == 0) {
        if (n_in != 32 || out_size != NT * DM || ws_size < WS_END) { fprintf(stderr, "kernel_launch: unexpected shapes / workspace (%d inputs, out %d, ws %zu < %zu)\n", n_in, out_size, ws_size, (size_t)WS_END); grid = -1; return; }
        int dev = 0, cus = 0, per_cu = 0;
        if (hipGetDevice(&dev) != hipSuccess || hipDeviceGetAttribute(&cus, hipDeviceAttributeMultiprocessorCount, dev) != hipSuccess) { grid = -1; return; }
        if (hipFuncSetAttribute((const void*)fwd, hipFuncAttributeMaxDynamicSharedMemorySize, LDS_BYTES) != hipSuccess) { fprintf(stderr, "kernel_launch: hipFuncSetAttribute failed\n"); grid = -1; return; }
        if (hipOccupancyMaxActiveBlocksPerMultiprocessor(&per_cu, (const void*)fwd, 512, LDS_BYTES) != hipSuccess || per_cu < 1) { fprintf(stderr, "kernel_launch: occupancy query says %d\n", per_cu); }
        (void)hipGetLastError();
        grid = cus;
    }
    if (grid < 0) return;
    (void)hipMemsetAsync((char*)d_ws + WS_CTL, 0, CTL_ZERO_BYTES, stream);
    Prm p{};
    for (int i = 0; i < 32; ++i) p.in[i] = (const float*)d_in[i];
    p.out = (float*)d_out; p.ws = (unsigned char*)d_ws;
#if MK_SINGLE
    p.ph_lo = 0; p.ph_hi = NPHASES;
    hipLaunchKernelGGL(fwd, dim3(grid), dim3(512), LDS_BYTES, stream, p);
#else
    for (int ph = 0; ph < NPHASES; ++ph) { p.ph_lo = ph; p.ph_hi = ph + 1; hipLaunchKernelGGL(fwd, dim3(grid), dim3(512), LDS_BYTES, stream, p); }
#endif
}
```

```cpp
#include <hip/hip_runtime.h>
#include <cstdio>
#include <cstdint>

#ifndef MK_SINGLE
#define MK_SINGLE 1
#endif

typedef _Float16 h16;
typedef _Float16 h16x2 __attribute__((ext_vector_type(2)));
typedef _Float16 h16x4 __attribute__((ext_vector_type(4)));
typedef _Float16 h16x8 __attribute__((ext_vector_type(8)));
typedef float f32x2 __attribute__((ext_vector_type(2)));
typedef float f32x4 __attribute__((ext_vector_type(4)));
typedef unsigned u32x2 __attribute__((ext_vector_type(2)));
typedef unsigned u32x4 __attribute__((ext_vector_type(4)));
#define LAS __attribute__((address_space(3)))
#define PIN() do { asm volatile("" ::: "memory"); __builtin_amdgcn_sched_barrier(0); } while (0)
#define PINV(x) asm volatile("" : "+v"(x) :: "memory")
#define MFMA16(a, b, c) __builtin_amdgcn_mfma_f32_16x16x32_f16((a), (b), (c), 0, 0, 0)

constexpr int NB = 16, SEQ = 2048, DM = 1024, NT = NB * SEQ, MEML = 256, NTM = NB * MEML, NLAYER = 2;
constexpr int NPJ = 3584;
constexpr int CQ = 0, CK = 384, CV = 768, CG = 1152, CZ = 1536, CXS = 1920, CBM = 2304, CCM = 2560, CXR = 2816, CGT = 3072, CDT = 3328;
constexpr int DIN = 3334, NCH = 16, MAXSLOT = 73728;
constexpr float EPS = 1e-6f;
constexpr int NPH = 14;
constexpr int NPHASES = NLAYER * NPH;

constexpr size_t MiB = (size_t)1 << 20;
constexpr size_t WS_CTL = 0, CTL_ZERO_BYTES = 64 * 1024;
constexpr size_t WS_WIN = 1 * MiB, WS_WOUT = 8 * MiB, WS_WQ = 10 * MiB, WS_WKV = 12 * MiB, WS_WO = 16 * MiB, WS_W13 = 18 * MiB, WS_W2 = 82 * MiB, WS_LRUW = 114 * MiB;
constexpr size_t WS_HB = 115 * MiB;
constexpr size_t WS_R1 = 179 * MiB;
constexpr size_t WS_R2 = 403 * MiB;
constexpr size_t WS_KV = 547 * MiB, WS_MEM16 = 563 * MiB, WS_SSQ = 571 * MiB, WS_MISC = 573 * MiB, WS_END = 577 * MiB;
constexpr size_t OFF_QCA = WS_R1, OFF_OATT = WS_R1 + 64 * MiB, OFF_XP = WS_R1, OFF_HP = WS_R1 + 144 * MiB;
constexpr size_t OFF_OMIX = WS_R2, OFF_RST = WS_R2 + 64 * MiB, OFF_SST = WS_R2 + 88 * MiB, OFF_LSUM = WS_R2 + 136 * MiB, OFF_SDEC = WS_R2 + 137 * MiB, OFF_LCAR = WS_R2 + 138 * MiB, OFF_YP = WS_R2;
constexpr size_t OFF_KB = WS_KV, OFF_VT = WS_KV + 8 * MiB;
constexpr size_t OFF_ROPE = WS_MISC, OFF_MSSQ = WS_MISC + 512 * 1024, OFF_EID = WS_MISC + 768 * 1024, OFF_GATE = WS_MISC + 1024 * 1024, OFF_TSLOT = WS_MISC + 1280 * 1024,
                 OFF_RSTDT = WS_MISC + 1536 * 1024, OFF_SRSTD = WS_MISC + 1664 * 1024, OFF_TILEE = WS_MISC + 2000 * 1024;
constexpr int CW_COUNTS = 64, CW_CURSOR = 192, CW_NTILES = 320, CW_BAR = 4096;

constexpr int LDS_BYTES = 152 * 1024;
constexpr int LDS_MISC = 150 * 1024;

struct Prm { const float* in[32]; float* out; unsigned char* ws; int ph_lo, ph_hi; };

#define XB_TMO      128
#define XB_XCNT(j)  (256  + 64 * (j))
#define XB_XSUB(j)  (1280 + 64 * (j))
#define XB_XGEN(j)  (2304 + 64 * (j))
#define XB_TOP      3328
#define XB_TOPGEN   3392
#define XCD_BAR_WORDS 3456
#define XB_SPIN_CAP (1u << 18)
__device__ __forceinline__ unsigned xb_ld(unsigned* p)              { return __hip_atomic_load(p, __ATOMIC_RELAXED, __HIP_MEMORY_SCOPE_AGENT); }
__device__ __forceinline__ unsigned xb_add(unsigned* p, unsigned v) { return __hip_atomic_fetch_add(p, v, __ATOMIC_RELAXED, __HIP_MEMORY_SCOPE_AGENT); }
__device__ __forceinline__ unsigned xb_xcc_id() { return (unsigned)__builtin_amdgcn_s_getreg((3 << 11) | 20) & 0xFu; }
#define XB_SPIN(cond, bar) do { unsigned _sp = 0; while (cond) { __builtin_amdgcn_s_sleep(1); \
    if ((++_sp & 255u) == 0u) { if (xb_ld(&(bar)[XB_TMO])) break; if (_sp > XB_SPIN_CAP) { atomicAdd(&(bar)[XB_TMO], 1u); break; } } } } while (0)
struct XcdBarrier { unsigned* bar; unsigned x; volatile LAS unsigned* st; };
__device__ __forceinline__ XcdBarrier xcd_barrier_post(unsigned* bar, volatile LAS unsigned* st) {
    XcdBarrier b; b.bar = bar; b.x = xb_xcc_id(); b.st = st;
    if (threadIdx.x == 0) (void)xb_add(&bar[XB_XCNT(b.x)], 1u);
    return b;
}
__device__ __forceinline__ void xcd_barrier_complete(unsigned* bar, unsigned x, unsigned& nloc, unsigned& nx) {
    const unsigned G = gridDim.x * gridDim.y * gridDim.z;
    unsigned sum, cnt, mine, sp = 0u;
    for (;;) {
        sum = 0u; cnt = 0u; mine = 0u;
#pragma unroll
        for (unsigned j = 0; j < 16; ++j) { const unsigned c = xb_ld(&bar[XB_XCNT(j)]); sum += c; cnt += (c > 0u) ? 1u : 0u; mine = (j == x) ? c : mine; }
        if (sum == G) break;
        __builtin_amdgcn_s_sleep(1);
        if ((++sp & 255u) == 0u) { if (xb_ld(&bar[XB_TMO])) break; if (sp > XB_SPIN_CAP) { atomicAdd(&bar[XB_TMO], 1u); break; } }
    }
    nloc = mine > 0u ? mine : 1u; nx = cnt > 0u ? cnt : 1u;
}
__device__ __forceinline__ void xcd_barrier(const XcdBarrier& b) {
    asm volatile("s_waitcnt vmcnt(0)" ::: "memory");
    __syncthreads();
    if (threadIdx.x == 0) {
        unsigned* bar = b.bar;
        __builtin_amdgcn_s_waitcnt(0);
        unsigned nloc = b.st[0], nx = b.st[1];
        if (nloc == 0u) { xcd_barrier_complete(bar, b.x, nloc, nx); b.st[0] = nloc; b.st[1] = nx; }
        const unsigned old = xb_add(&bar[XB_XSUB(b.x)], 1u);
        const unsigned gen = old / nloc;
        if (old + 1u == (gen + 1u) * nloc) {
            __builtin_amdgcn_fence(__ATOMIC_RELEASE, "agent");
            asm volatile("s_waitcnt vmcnt(0)" ::: "memory");
            const unsigned og = xb_add(&bar[XB_TOP], 1u);
            const unsigned tg = og / nx;
            if (og + 1u == (tg + 1u) * nx) xb_add(&bar[XB_TOPGEN], 1u);
            else XB_SPIN(xb_ld(&bar[XB_TOPGEN]) == tg, bar);
            __builtin_amdgcn_fence(__ATOMIC_ACQUIRE, "agent");
            xb_add(&bar[XB_XGEN(b.x)], 1u);
            asm volatile("s_waitcnt vmcnt(0)" ::: "memory");
        } else {
            XB_SPIN(xb_ld(&bar[XB_XGEN(b.x)]) == gen, bar);
            __builtin_amdgcn_fence(__ATOMIC_ACQUIRE, "agent");
            asm volatile("s_waitcnt vmcnt(0)" ::: "memory");
        }
    }
    __syncthreads();
}

__device__ __forceinline__ float wave_sum(float v) {
#pragma unroll
    for (int o = 1; o < 64; o <<= 1) v += __shfl_xor(v, o);
    return v;
}
__device__ __forceinline__ float sigmoidf_(float x) { return 1.0f / (1.0f + __expf(-x)); }
__device__ __forceinline__ float siluf_(float x) { return x / (1.0f + __expf(-x)); }
__device__ __forceinline__ float softplusf_(float x) { return x > 20.f ? x : log1pf(__expf(x)); }
__device__ __forceinline__ float gelu_tanh_(float x) { const float y = 0.7978845608028654f * (x + 0.044715f * x * x * x); const float t = 1.0f - 2.0f / (__expf(2.0f * y) + 1.0f); return 0.5f * x * (1.0f + t); }
__device__ __forceinline__ h16x8 pack8(const f32x4 a, const f32x4 b) { h16x8 r; r[0] = (h16)a[0]; r[1] = (h16)a[1]; r[2] = (h16)a[2]; r[3] = (h16)a[3]; r[4] = (h16)b[0]; r[5] = (h16)b[1]; r[6] = (h16)b[2]; r[7] = (h16)b[3]; return r; }
__device__ __forceinline__ h16x4 pack4(const f32x4 a) { h16x4 r; r[0] = (h16)a[0]; r[1] = (h16)a[1]; r[2] = (h16)a[2]; r[3] = (h16)a[3]; return r; }
__device__ __forceinline__ h16x8 ldsfrag(LAS const h16* p) { return *(LAS const h16x8*)p; }
__device__ __forceinline__ h16x8 ldsfrag2(LAS const h16* p0, LAS const h16* p1) { const h16x4 a = *(LAS const h16x4*)p0, b = *(LAS const h16x4*)p1; return __builtin_shufflevector(a, b, 0, 1, 2, 3, 4, 5, 6, 7); }
__device__ __forceinline__ h16x8 scalefrag(const h16x8 f, float s) { const h16 hs = (h16)s; h16x8 v;
#pragma unroll
    for (int j = 0; j < 8; ++j) v[j] = hs; return f * v; }
__device__ __forceinline__ float row_rstd(const float* ssq16) {
    const f32x4 a = *(const f32x4*)ssq16, b = *(const f32x4*)(ssq16 + 4), c = *(const f32x4*)(ssq16 + 8), d = *(const f32x4*)(ssq16 + 12);
    const float s = ((a[0] + a[1]) + (a[2] + a[3])) + ((b[0] + b[1]) + (b[2] + b[3])) + ((c[0] + c[1]) + (c[2] + c[3])) + ((d[0] + d[1]) + (d[2] + d[3]));
    return 1.0f / sqrtf(s * (1.0f / DM) + EPS);
}

namespace pg8 {
constexpr int BM = 256, BK = 64, HALF = 128, HTB = HALF * BK * 2, STAGE_BYTES = 8 * HTB, NXCD = 8, WGM = 8;
__host__ __device__ __forceinline__ int lds_byte(int r, int c) { const int st = (r >> 4) * 2 + (c >> 5), rr = r & 15, cc = c & 31, ob = rr * 64 + cc * 2; return st * 1024 + (ob ^ (((ob >> 9) & 1) << 5)); }
__host__ __device__ __forceinline__ void stage_rc(int b, int& R, int& C) { const int st = b / 1024, sb = b % 1024, swz = sb ^ (((sb >> 9) & 1) << 5); R = (st >> 1) * 16 + swz / 64; C = (st & 1) * 32 + (swz % 64) / 2; }
__host__ __device__ __forceinline__ int perm32(int rho) { const int n = rho >> 4, i = rho & 15; return 8 * (i >> 2) + 4 * n + (i & 3); }
struct Unit { int pm, pn; };
struct Gemm { const h16* A; const h16* Bt; int lda, ldb, K; };
struct StaticOrder {
    int nM, nN, nwg, G, c;
    __device__ void init(int M, int N, int G_, int c_) { nM = M / BM; nN = N / BM; nwg = nM * nN; G = G_; c = c_; }
    __device__ bool next(int i, Unit& u) const {
        const long L = (long)i * G + c; if (L >= nwg) return false;
        int wgid = (int)L; { const int q = nwg / NXCD, r = nwg % NXCD, xcd = wgid % NXCD, off = wgid / NXCD; wgid = (xcd < r ? xcd * (q + 1) : r * (q + 1) + (xcd - r) * q) + off; }
        const int nig = WGM * nN, gid = wgid / nig, fm = gid * WGM, gsz = (nM - fm) < WGM ? (nM - fm) : WGM;
        u.pm = fm + ((wgid % nig) % gsz); u.pn = (wgid % nig) / gsz; return true;
    }
};
struct GroupOrder {
    const int* tile_e; int ntiles, G, vcu;
    __device__ bool next(int i, Unit& u) const {
        const int L = i * G + vcu, tile = L >> 2; if (tile >= ntiles) return false;
        u.pm = tile; u.pn = __builtin_amdgcn_readfirstlane(tile_e[tile]) * 4 + (L & 3); return true;
    }
};

struct EpiScale16 {
    static constexpr bool PERM = true;
    h16* O; int ldc; const float* ssq;
    __device__ __forceinline__ void operator()(const f32x4 (&acc)[2][2][4][2], const Unit& u, int wr, int wc, int fr, int fq) const {
        const int row0 = u.pm * BM + wr * 64 + fr, col0 = u.pn * BM + wc * 32 + 8 * fq;
#pragma unroll
        for (int ai = 0; ai < 2; ++ai)
#pragma unroll
            for (int m = 0; m < 4; ++m) { const int row = row0 + ai * HALF + m * 16; const float rs = row_rstd(ssq + (size_t)row * 16); h16* rowp = O + (size_t)row * ldc + col0;
#pragma unroll
                for (int bj = 0; bj < 2; ++bj) *(h16x8*)(rowp + bj * HALF) = pack8(acc[ai][bj][m][0] * rs, acc[ai][bj][m][1] * rs); }
    }
};
struct EpiKV {
    static constexpr bool PERM = true;
    h16* KB; h16* VT; const float* ssq;
    __device__ __forceinline__ void operator()(const f32x4 (&acc)[2][2][4][2], const Unit& u, int wr, int wc, int fr, int fq) const {
        const int row0 = u.pm * BM + wr * 64 + fr;
#pragma unroll
        for (int ai = 0; ai < 2; ++ai)
#pragma unroll
            for (int m = 0; m < 4; ++m) { const int row = row0 + ai * HALF + m * 16; const float rs = row_rstd(ssq + (size_t)row * 16);
                h16x8 pk[2];
#pragma unroll
                for (int bj = 0; bj < 2; ++bj) pk[bj] = pack8(acc[ai][bj][m][0] * rs, acc[ai][bj][m][1] * rs);
                if (u.pn < 4) { h16* rowp = KB + (size_t)row * DM + u.pn * BM + wc * 32 + 8 * fq;
                    *(h16x8*)rowp = pk[0]; *(h16x8*)(rowp + HALF) = pk[1];
                } else { const int b = row >> 8, key = row & 255, hd = u.pn - 4; h16* base = VT + ((size_t)(b * 4 + hd) * 256 + wc * 32 + 8 * fq) * 256 + key;
#pragma unroll
                    for (int bj = 0; bj < 2; ++bj)
#pragma unroll
                        for (int j = 0; j < 8; ++j) base[(bj * HALF + j) * 256] = pk[bj][j]; }
                PIN();
            }
    }
};
struct EpiResid {
    static constexpr bool PERM = false;
    const float* base; float* out; h16* hb; float* ssq;
    __device__ __forceinline__ void operator()(const f32x4 (&acc)[2][2][4][2], const Unit& u, int wr, int wc, int fr, int fq) const {
        const int row0 = u.pm * BM + wr * 64 + fr, col0 = u.pn * BM + wc * 32 + 4 * fq;
#pragma unroll
        for (int ai = 0; ai < 2; ++ai)
#pragma unroll
            for (int m = 0; m < 4; ++m) { const int row = row0 + ai * HALF + m * 16; const size_t off = (size_t)row * DM + col0; float s = 0.f;
#pragma unroll
                for (int bj = 0; bj < 2; ++bj)
#pragma unroll
                    for (int n = 0; n < 2; ++n) { const f32x4 v = *(const f32x4*)(base + off + bj * HALF + n * 16) + acc[ai][bj][m][n];
                        *(f32x4*)(out + off + bj * HALF + n * 16) = v; *(h16x4*)(hb + off + bj * HALF + n * 16) = pack4(v);
                        s += (v[0] * v[0] + v[1] * v[1]) + (v[2] * v[2] + v[3] * v[3]); }
                s += __shfl_xor(s, 16); s += __shfl_xor(s, 32);
                if (fq == 0) ssq[(size_t)row * 16 + u.pn * 4 + wc] = s; }
    }
};
struct EpiGated {
    static constexpr bool PERM = true;
    h16* O; const float* srstd;
    __device__ __forceinline__ void operator()(const f32x4 (&acc)[2][2][4][2], const Unit& u, int wr, int wc, int fr, int fq) const {
        const int row0 = u.pm * BM + wr * 64 + fr, col0 = (u.pn & 3) * HALF + wc * 32 + 8 * fq;
#pragma unroll
        for (int ai = 0; ai < 2; ++ai)
#pragma unroll
            for (int m = 0; m < 4; ++m) { const int row = row0 + ai * HALF + m * 16; const float rs = srstd[row]; f32x4 o[2];
#pragma unroll
                for (int n = 0; n < 2; ++n)
#pragma unroll
                    for (int j = 0; j < 4; ++j) { const float a = acc[ai][0][m][n][j] * rs, b = acc[ai][1][m][n][j] * rs; o[n][j] = siluf_(a) * b; }
                *(h16x8*)(O + (size_t)row * 512 + col0) = pack8(o[0], o[1]); }
    }
};
struct EpiPlain16 {
    static constexpr bool PERM = true;
    h16* O;
    __device__ __forceinline__ void operator()(const f32x4 (&acc)[2][2][4][2], const Unit& u, int wr, int wc, int fr, int fq) const {
        const int row0 = u.pm * BM + wr * 64 + fr, col0 = (u.pn & 3) * BM + wc * 32 + 8 * fq;
#pragma unroll
        for (int ai = 0; ai < 2; ++ai)
#pragma unroll
            for (int m = 0; m < 4; ++m) { h16* rowp = O + (size_t)(row0 + ai * HALF + m * 16) * DM + col0;
#pragma unroll
                for (int bj = 0; bj < 2; ++bj) *(h16x8*)(rowp + bj * HALF) = pack8(acc[ai][bj][m][0], acc[ai][bj][m][1]); }
    }
};

template <class Epi, class Sched>
__device__ __forceinline__ void gemm_phase(LAS unsigned char* lds, const int tid, const Gemm g, const Sched& S, const Epi& E) {
    const int wid = __builtin_amdgcn_readfirstlane(tid >> 6), lane = tid & 63, wr = wid >> 2, wc = wid & 3, fr = lane & 15, fq = lane >> 4;
    const int K = g.K, nt = K / BK;
    unsigned voffA[2], voffB[2];
#pragma unroll
    for (int i = 0; i < 2; ++i) { int R, C; stage_rc(tid * 16 + i * 8192, R, C); const int Rb = Epi::PERM ? ((R & ~31) + perm32(R & 31)) : R;
        voffA[i] = (unsigned)(R * g.lda + C) * 2u; voffB[i] = (unsigned)(Rb * g.ldb + C) * 2u; }
    const size_t kstep = (size_t)(BK * 2);
    const size_t hstepA = (size_t)HALF * g.lda * 2, hstepB = (size_t)HALF * g.ldb * 2;
    const size_t tstepA = 2 * hstepA, tstepB = 2 * hstepB;
    const unsigned ldsw = (unsigned)wid * 1024u;
    const int aoff = lds_byte(wr * 64 + fr, fq * 8), boff = lds_byte(wc * 32 + fr, fq * 8);
#define PG8_SA(b, h) (((b) * 2 + (h)) * HTB)
#define PG8_SB(b, h) ((4 + (b) * 2 + (h)) * HTB)
#define PG8_STAGE(bufoff, gbase, voff) do { _Pragma("unroll") for (int _i = 0; _i < 2; ++_i) \
        __builtin_amdgcn_global_load_lds((const unsigned*)((const char*)(gbase) + (voff)[_i]), (LAS unsigned*)(lds + (bufoff) + ldsw + _i * 8192), 16, 0, 0); } while (0)
#define PG8_LDA(dst, b, h) do { _Pragma("unroll") for (int m = 0; m < 4; ++m) _Pragma("unroll") for (int k = 0; k < 2; ++k) dst[m][k] = *(const LAS h16x8*)(lds + PG8_SA(b, h) + aoff + m * 2048 + k * 1024); } while (0)
#define PG8_LDB(dst, b, h) do { _Pragma("unroll") for (int n = 0; n < 2; ++n) _Pragma("unroll") for (int k = 0; k < 2; ++k) dst[n][k] = *(const LAS h16x8*)(lds + PG8_SB(b, h) + boff + n * 2048 + k * 1024); } while (0)
#define PG8_MMA(ai, bj, At, Bt) do { __builtin_amdgcn_s_setprio(1); _Pragma("unroll") for (int m = 0; m < 4; ++m) _Pragma("unroll") for (int n = 0; n < 2; ++n) _Pragma("unroll") for (int k = 0; k < 2; ++k) \
        acc[ai][bj][m][n] = __builtin_amdgcn_mfma_f32_16x16x32_f16(Bt[n][k], At[m][k], acc[ai][bj][m][n], 0, 0, 0); __builtin_amdgcn_s_setprio(0); } while (0)
#define PG8_WAIT_V(n) asm volatile("s_waitcnt vmcnt(" #n ")" ::: "memory")
#define PG8_WAIT_L(n) asm volatile("s_waitcnt lgkmcnt(" #n ")" ::: "memory")
#define PG8_BAR __builtin_amdgcn_s_barrier()
#define PG8_SCHED __builtin_amdgcn_sched_barrier(0)
    Unit cur, nxt; int ui = 0;
    if (!S.next(0, cur)) return;
    f32x4 acc[2][2][4][2];
#pragma unroll
    for (int a = 0; a < 2; ++a)
#pragma unroll
        for (int b = 0; b < 2; ++b)
#pragma unroll
            for (int m = 0; m < 4; ++m)
#pragma unroll
                for (int n = 0; n < 2; ++n) acc[a][b][m][n] = (f32x4){0.f, 0.f, 0.f, 0.f};
    h16x8 At[4][2], B0[2][2], B1[2][2];
    const char* cA = (const char*)g.A + (size_t)cur.pm * tstepA; const char* cB = (const char*)g.Bt + (size_t)cur.pn * tstepB;
    PG8_STAGE(PG8_SB(0, 0), cB, voffB); PG8_STAGE(PG8_SB(0, 1), cB + hstepB, voffB); PG8_STAGE(PG8_SA(0, 0), cA, voffA); PG8_STAGE(PG8_SA(0, 1), cA + hstepA, voffA);
    if (wr == 1) PG8_BAR;
    PG8_WAIT_V(2); PG8_BAR;
    PG8_STAGE(PG8_SB(1, 0), cB + kstep, voffB); PG8_STAGE(PG8_SA(1, 0), cA + kstep, voffA); PG8_STAGE(PG8_SB(1, 1), cB + hstepB + kstep, voffB);
    PG8_WAIT_V(6); PG8_BAR;
    for (;;) {
        const bool has_next = S.next(ui + 1, nxt);
        const char* nA = has_next ? (const char*)g.A + (size_t)nxt.pm * tstepA : cA; const char* nB = has_next ? (const char*)g.Bt + (size_t)nxt.pn * tstepB : cB;
        for (int t = 0; t < nt; t += 2) {
            const bool last = (t == nt - 2);
            const char* a1 = cA + (size_t)(t + 1) * kstep;
            const char* a2 = last ? nA : cA + (size_t)(t + 2) * kstep; const char* b2 = last ? nB : cB + (size_t)(t + 2) * kstep;
            const char* a3 = a2 + kstep; const char* b3 = b2 + kstep;
            PG8_LDB(B0, 0, 0); PG8_LDB(B1, 0, 1); PG8_SCHED; PG8_LDA(At, 0, 0); PG8_STAGE(PG8_SA(1, 1), a1 + hstepA, voffA);
            PG8_WAIT_V(8); PG8_WAIT_L(0); PG8_BAR; PG8_MMA(0, 0, At, B0); PG8_MMA(0, 1, At, B1); PG8_BAR; PG8_SCHED;
            PG8_LDA(At, 0, 1); PG8_STAGE(PG8_SB(0, 0), b2, voffB); PG8_STAGE(PG8_SB(0, 1), b2 + hstepB, voffB); PG8_STAGE(PG8_SA(0, 0), a2, voffA);
            PG8_WAIT_V(8); PG8_WAIT_L(0); PG8_BAR; PG8_MMA(1, 0, At, B0); PG8_MMA(1, 1, At, B1); PG8_BAR; PG8_SCHED;
            PG8_LDB(B0, 1, 0); PG8_LDB(B1, 1, 1); PG8_SCHED; PG8_LDA(At, 1, 0); PG8_STAGE(PG8_SA(0, 1), a2 + hstepA, voffA);
            PG8_WAIT_V(8); PG8_WAIT_L(0); PG8_BAR; PG8_MMA(0, 0, At, B0); PG8_MMA(0, 1, At, B1); PG8_BAR; PG8_SCHED;
            PG8_LDA(At, 1, 1); PG8_STAGE(PG8_SB(1, 0), b3, voffB); PG8_STAGE(PG8_SB(1, 1), b3 + hstepB, voffB); PG8_STAGE(PG8_SA(1, 0), a3, voffA);
            PG8_WAIT_V(8); PG8_WAIT_L(0); PG8_BAR; PG8_MMA(1, 0, At, B0); PG8_MMA(1, 1, At, B1); PG8_BAR; PG8_SCHED;
        }
        if (wr == 0) PG8_BAR;
        E(acc, cur, wr, wc, fr, fq);
        if (!has_next) break;
#pragma unroll
        for (int a = 0; a < 2; ++a)
#pragma unroll
            for (int b = 0; b < 2; ++b)
#pragma unroll
                for (int m = 0; m < 4; ++m)
#pragma unroll
                    for (int n = 0; n < 2; ++n) acc[a][b][m][n] = (f32x4){0.f, 0.f, 0.f, 0.f};
        cur = nxt; cA = nA; cB = nB; ++ui;
        if (wr == 1) PG8_BAR;
    }
    PG8_WAIT_V(0);
    PG8_BAR;
#undef PG8_SA
#undef PG8_SB
#undef PG8_STAGE
#undef PG8_LDA
#undef PG8_LDB
#undef PG8_MMA
#undef PG8_WAIT_V
#undef PG8_WAIT_L
#undef PG8_BAR
#undef PG8_SCHED
}
}

struct Frame {
    LAS unsigned char* lds;
    unsigned char* ws;
    int tid, lane, wave, G, vcu;
};
#define WSP(T, off) ((T*)(F.ws + (off)))
__device__ __forceinline__ void launder(Frame& F) {
    int wv = F.wave; asm volatile("" : "+s"(wv)); F.wave = wv;
    int t = wv * 64 + (int)__builtin_amdgcn_mbcnt_hi(~0u, __builtin_amdgcn_mbcnt_lo(~0u, 0u)); asm volatile("" : "+v"(t)); F.tid = t; F.lane = t & 63;
    const unsigned long long w = (unsigned long long)F.ws; unsigned wl = __builtin_amdgcn_readfirstlane((unsigned)w), wh = __builtin_amdgcn_readfirstlane((unsigned)(w >> 32));
    asm volatile("" : "+s"(wl), "+s"(wh)); F.ws = (unsigned char*)(((unsigned long long)wh << 32) | wl);
    unsigned lo = __builtin_amdgcn_readfirstlane((unsigned)(uintptr_t)F.lds); asm volatile("" : "+s"(lo)); F.lds = (LAS unsigned char*)(uintptr_t)lo;
    int v = __builtin_amdgcn_readfirstlane(F.vcu); asm volatile("" : "+s"(v)); F.vcu = v;
}

struct TrItem { const float* W; const float* g; h16* Wt; int ldw, sc, nvalid, ldt, d0, k0, vw; float mul; };
__device__ __forceinline__ void tr_describe(const Prm& p, unsigned char* wsb, int l, int it, TrItem& d) {
    int r = it; d.g = nullptr; d.mul = 1.f; d.nvalid = 64; d.vw = 4; d.ldt = DM; d.ldw = DM;
    if (r < 896) { const int db = r / 16, d0 = 64 * db; d.W = p.in[3] + (size_t)l * DM * DIN; d.ldw = DIN; d.g = p.in[2] + l * DM; d.Wt = (h16*)(wsb + WS_WIN); d.d0 = d0; d.k0 = 64 * (r % 16); d.vw = 2;
        if (d0 < 2816) d.sc = d0; else if (d0 < 3328) d.sc = d0 + 6; else if (d0 == 3328) { d.sc = 2816; d.nvalid = 6; } else { d.sc = 0; d.nvalid = 0; } return; } r -= 896;
    if (r < 256) { d.W = p.in[4] + (size_t)l * DM * DM; d.Wt = (h16*)(wsb + WS_WOUT); d.d0 = d.sc = 64 * (r / 16); d.k0 = 64 * (r % 16); return; } r -= 256;
    if (r < 256) { d.W = p.in[20] + (size_t)l * DM * DM; d.g = p.in[18] + l * DM; d.mul = 0.0625f; d.Wt = (h16*)(wsb + WS_WQ); d.d0 = d.sc = 64 * (r / 16); d.k0 = 64 * (r % 16); return; } r -= 256;
    if (r < 512) { d.W = p.in[21] + (size_t)l * DM * 2048; d.ldw = 2048; d.g = p.in[19] + l * DM; d.Wt = (h16*)(wsb + WS_WKV); d.d0 = d.sc = 64 * (r / 16); d.k0 = 64 * (r % 16); return; } r -= 512;
    if (r < 256) { d.W = p.in[22] + (size_t)l * DM * DM; d.Wt = (h16*)(wsb + WS_WO); d.d0 = d.sc = 64 * (r / 16); d.k0 = 64 * (r % 16); return; } r -= 256;
    if (r < 8192) { const int e = r / 256, q = r % 256, d0 = 64 * (q / 16), grp = d0 >> 8, rr = d0 & 255;
        d.W = (rr < 128 ? p.in[28] : p.in[29]) + (size_t)(l * 32 + e) * DM * 512; d.ldw = 512; d.sc = grp * 128 + (rr & 127); d.g = p.in[23] + l * DM; d.Wt = (h16*)(wsb + WS_W13) + (size_t)e * DM * DM; d.d0 = d0; d.k0 = 64 * (q % 16); return; } r -= 8192;
    if (r < 4096) { const int e = r / 128, q = r % 128; d.W = p.in[30] + (size_t)(l * 32 + e) * 512 * DM; d.Wt = (h16*)(wsb + WS_W2) + (size_t)e * DM * 512; d.ldt = 512; d.d0 = d.sc = 64 * (q / 8); d.k0 = 64 * (q % 8); return; } r -= 4096;
    { const int blk = r & 3, gate = (r >> 2) & 1, dir = r >> 3; d.W = (gate ? p.in[16] : p.in[14]) + (size_t)((l * 2 + dir) * 4 + blk) * 4096; d.ldw = 64; d.Wt = (h16*)(wsb + WS_LRUW) + (size_t)((dir * 2 + gate) * 4 + blk) * 4096; d.ldt = 64; d.d0 = d.sc = 0; d.k0 = 0; }
}
__device__ __forceinline__ void tr_load(const TrItem& d, int lane, f32x4 (&v)[16]) {
    if (d.vw == 4) { const int col = 4 * (lane & 15); const float* src = d.W + (size_t)(d.k0 + (lane >> 4)) * d.ldw + d.sc + col; const bool ok = col < d.nvalid;
#pragma unroll
        for (int i = 0; i < 16; ++i) v[i] = ok ? *(const f32x4*)(src + (size_t)(4 * i) * d.ldw) : (f32x4){0.f, 0.f, 0.f, 0.f};
    } else { const int col = 2 * (lane & 31); const float* src = d.W + (size_t)(d.k0 + (lane >> 5)) * d.ldw + d.sc + col; const bool ok = col < d.nvalid;
#pragma unroll
        for (int i = 0; i < 16; ++i) { const f32x2 a = ok ? *(const f32x2*)(src + (size_t)(4 * i) * d.ldw) : (f32x2){0.f, 0.f}, c = ok ? *(const f32x2*)(src + (size_t)(4 * i + 2) * d.ldw) : (f32x2){0.f, 0.f}; v[i] = (f32x4){a[0], a[1], c[0], c[1]}; } }
}
__device__ __forceinline__ void tr_to_lds(const TrItem& d, int lane, const f32x4 (&v)[16], LAS float* scr) {
    if (d.vw == 4) { LAS float* q = scr + (lane >> 4) * 65 + 4 * (lane & 15);
#pragma unroll
        for (int i = 0; i < 16; ++i) { q[(4 * i) * 65 + 0] = v[i][0]; q[(4 * i) * 65 + 1] = v[i][1]; q[(4 * i) * 65 + 2] = v[i][2]; q[(4 * i) * 65 + 3] = v[i][3]; }
    } else { LAS float* q = scr + (lane >> 5) * 65 + 2 * (lane & 31);
#pragma unroll
        for (int i = 0; i < 16; ++i) { q[(4 * i) * 65 + 0] = v[i][0]; q[(4 * i) * 65 + 1] = v[i][1]; q[(4 * i + 2) * 65 + 0] = v[i][2]; q[(4 * i + 2) * 65 + 1] = v[i][3]; } }
}
__device__ __forceinline__ void tr_from_lds(const TrItem& d, int lane, LAS const float* scr) {
    const int c = lane & 7; float gs[8];
    if (d.g) { const f32x4 g0 = *(const f32x4*)(d.g + d.k0 + 8 * c), g1 = *(const f32x4*)(d.g + d.k0 + 8 * c + 4);
        gs[0] = g0[0] * d.mul; gs[1] = g0[1] * d.mul; gs[2] = g0[2] * d.mul; gs[3] = g0[3] * d.mul; gs[4] = g1[0] * d.mul; gs[5] = g1[1] * d.mul; gs[6] = g1[2] * d.mul; gs[7] = g1[3] * d.mul;
    } else {
#pragma unroll
        for (int e = 0; e < 8; ++e) gs[e] = d.mul; }
#pragma unroll
    for (int j = 0; j < 8; ++j) { const int nn = (lane >> 3) + 8 * j; LAS const float* q = scr + (8 * c) * 65 + nn; h16x8 o;
#pragma unroll
        for (int e = 0; e < 8; ++e) o[e] = (h16)(q[e * 65] * gs[e]);
        *(h16x8*)(d.Wt + (size_t)(d.d0 + nn) * d.ldt + d.k0 + 8 * c) = o; }
}
__device__ __forceinline__ void phase_convert(const Frame& F, const Prm& p, int l) {
    LAS float* scr = (LAS float*)(F.lds + F.wave * 16640);
    const int gw = F.vcu * 8 + F.wave, NGW = F.G * 8;
    constexpr int NITEMS = 896 + 256 + 256 + 512 + 256 + 8192 + 4096 + 16;
    { TrItem cur, nxt; f32x4 v[16]; int it = gw;
        if (it < NITEMS) { tr_describe(p, F.ws, l, it, cur); tr_load(cur, F.lane, v); }
        while (it < NITEMS) { const int itn = it + NGW; const bool hn = itn < NITEMS;
            tr_to_lds(cur, F.lane, v, scr);
            if (hn) { tr_describe(p, F.ws, l, itn, nxt); tr_load(nxt, F.lane, v); }
            asm volatile("s_waitcnt lgkmcnt(0)" ::: "memory");
            tr_from_lds(cur, F.lane, scr);
            asm volatile("s_waitcnt lgkmcnt(0)" ::: "memory");
            cur = nxt; it = itn; } }
    if (l == 0) {
        for (int m = gw; m < NT + NTM; m += NGW) {
            const bool isx = m < NT; const int row = isx ? m : m - NT;
            const float* src = (isx ? p.in[0] : p.in[1]) + (size_t)row * DM; h16* dst = (isx ? WSP(h16, WS_HB) : WSP(h16, WS_MEM16)) + (size_t)row * DM;
            float* sq = (isx ? WSP(float, WS_SSQ) : WSP(float, OFF_MSSQ)) + (size_t)row * 16;
            float s = 0.f;
#pragma unroll
            for (int j = 0; j < 4; ++j) { const f32x4 v = *(const f32x4*)(src + 4 * F.lane + 256 * j); *(h16x4*)(dst + 4 * F.lane + 256 * j) = pack4(v); s += (v[0] * v[0] + v[1] * v[1]) + (v[2] * v[2] + v[3] * v[3]); }
            s = wave_sum(s);
            if (F.lane < 16) sq[F.lane] = (F.lane == 0) ? s : 0.f;
        }
        float* rope = WSP(float, OFF_ROPE);
        for (int i = F.vcu * 512 + F.tid; i < SEQ * 32; i += F.G * 512) {
            const int pos = i >> 5, fi = i & 31; double th = 1.0;
            for (int k = 0; k < fi; ++k) th *= 0.74989420933245582730;
            const double rev = (double)pos * th * 0.15915494309189533577;
            const double fr = rev - floor(rev);
            const double r = (fr - 0.5) * 6.28318530717958647692;
            const double r2 = r * r; double sn = 1.0, cs = 1.0;
            for (int k = 14; k >= 1; --k) { sn = 1.0 - r2 / (double)((2 * k) * (2 * k + 1)) * sn; cs = 1.0 - r2 / (double)((2 * k - 1) * (2 * k)) * cs; }
            sn *= r;
            rope[pos * 64 + fi] = (float)(-cs); rope[pos * 64 + 32 + fi] = (float)(-sn);
        }
    }
}

__device__ __forceinline__ void conv8(const h16* projcol, long tbase, int n, int row, const float* cw, int cdim, const float* cb, float (&o)[8]) {
    const f32x4 b0 = *(const f32x4*)cb, b1 = *(const f32x4*)(cb + 4);
    o[0] = b0[0]; o[1] = b0[1]; o[2] = b0[2]; o[3] = b0[3]; o[4] = b1[0]; o[5] = b1[1]; o[6] = b1[2]; o[7] = b1[3];
#pragma unroll
    for (int k = 0; k < 4; ++k) { const int pos = n * 128 + row - 2 + k;
        if (pos >= 0 && pos < SEQ) { const h16x8 x = *(const h16x8*)(projcol + (size_t)(tbase + row - 2 + k) * NPJ);
            const f32x4 w0 = *(const f32x4*)(cw + k * cdim), w1 = *(const f32x4*)(cw + k * cdim + 4);
#pragma unroll
            for (int e = 0; e < 4; ++e) { o[e] += w0[e] * (float)x[e]; o[4 + e] += w1[e] * (float)x[4 + e]; } } }
}

__device__ __forceinline__ void ret_states_unit(const Frame& F, int u) {
    const int h = u % 6, bn = u / 6, n = bn % NCH, b = bn / NCH; const long t0 = (long)b * SEQ + n * 128;
    const h16* proj = WSP(const h16, WS_R1); const float* rope = WSP(const float, OFF_ROPE);
    LAS h16* KT = (LAS h16*)F.lds; LAS h16* VT = KT + 64 * 136;
    { const int r = F.tid >> 2, c = F.tid & 3; const h16* rowp = proj + (size_t)(t0 + r) * NPJ; const float* cs = rope + (size_t)(n * 128 + r) * 64 + 8 * c;
        const h16x8 k1 = *(const h16x8*)(rowp + CK + h * 64 + 8 * c), k2 = *(const h16x8*)(rowp + CK + h * 64 + 32 + 8 * c);
        const f32x4 c0 = *(const f32x4*)cs, c1 = *(const f32x4*)(cs + 4), s0 = *(const f32x4*)(cs + 32), s1 = *(const f32x4*)(cs + 36);
#pragma unroll
        for (int e = 0; e < 8; ++e) { const float x1 = (float)k1[e], x2 = (float)k2[e], co = e < 4 ? c0[e] : c1[e - 4], si = e < 4 ? s0[e] : s1[e - 4];
            KT[(8 * c + e) * 136 + r] = (h16)((x1 * co - x2 * si) * 0.125f); KT[(32 + 8 * c + e) * 136 + r] = (h16)((x1 * si + x2 * co) * 0.125f); }
        const h16x8 v1 = *(const h16x8*)(rowp + CV + h * 64 + 16 * c), v2 = *(const h16x8*)(rowp + CV + h * 64 + 16 * c + 8);
#pragma unroll
        for (int e = 0; e < 8; ++e) { VT[(16 * c + e) * 136 + r] = v1[e]; VT[(16 * c + 8 + e) * 136 + r] = v2[e]; } }
    __syncthreads();
    const int dir = F.wave >> 2, dt = F.wave & 3, fr = F.lane & 15, fq = F.lane >> 4;
    const float l2g = log1pf(-exp2f(-5.0f - (float)h)) * 1.4426950408889634f;
    h16x8 xw[4];
#pragma unroll
    for (int ks = 0; ks < 4; ++ks) { const h16x8 f = ldsfrag(KT + (16 * dt + fr) * 136 + 32 * ks + 8 * fq); h16x8 w;
#pragma unroll
        for (int jj = 0; jj < 8; ++jj) { const int j = 32 * ks + 8 * fq + jj; w[jj] = (h16)exp2f(l2g * (float)(dir == 0 ? 127 - j : j)); }
        xw[ks] = f * w; }
    h16* rst = WSP(h16, OFF_RST) + ((size_t)((dir * NB + b) * NCH + n) * 6 + h) * 4096;
#pragma unroll
    for (int et = 0; et < 4; ++et) { f32x4 acc = {0.f, 0.f, 0.f, 0.f};
#pragma unroll
        for (int ks = 0; ks < 4; ++ks) acc = MFMA16(xw[ks], ldsfrag(VT + (16 * et + fr) * 136 + 32 * ks + 8 * fq), acc);
        *(h16x4*)(rst + (16 * et + fr) * 64 + 16 * dt + 4 * fq) = pack4(acc); }
    __syncthreads();
}
__device__ __forceinline__ void ret_scan_unit(const Frame& F, int u) {
    const int h = u % 6, b = (u / 6) % NB, dir = u / (6 * NB);
    const float gC = exp2f(128.0f * log1pf(-exp2f(-5.0f - (float)h)) * 1.4426950408889634f);
    float acc[8];
#pragma unroll
    for (int e = 0; e < 8; ++e) acc[e] = 0.f;
    for (int i = 0; i < NCH; ++i) { const int n = dir == 0 ? i : NCH - 1 - i;
        h16* pp = WSP(h16, OFF_RST) + ((size_t)((dir * NB + b) * NCH + n) * 6 + h) * 4096 + F.tid * 8;
        const h16x8 s = *(const h16x8*)pp; h16x8 o;
#pragma unroll
        for (int e = 0; e < 8; ++e) { o[e] = (h16)acc[e]; acc[e] = acc[e] * gC + (float)s[e]; }
        *(h16x8*)pp = o; }
}
__device__ __forceinline__ void ret_out_unit(const Frame& F, int u) {
    const int h = u % 6, bn = u / 6, n = bn % NCH, b = bn / NCH; const long t0 = (long)b * SEQ + n * 128;
    const h16* proj = WSP(const h16, WS_R1); const float* rope = WSP(const float, OFF_ROPE);
    LAS h16* Qt = (LAS h16*)F.lds; LAS h16* Kt = Qt + 128 * 72; LAS h16* VT = Kt + 128 * 72; LAS h16* Ff = VT + 64 * 136; LAS h16* Fb = Ff + 64 * 72;
    { const int r = F.tid >> 2, c = F.tid & 3; const h16* rowp = proj + (size_t)(t0 + r) * NPJ; const float* cs = rope + (size_t)(n * 128 + r) * 64 + 8 * c;
        const f32x4 c0 = *(const f32x4*)cs, c1 = *(const f32x4*)(cs + 4), s0 = *(const f32x4*)(cs + 32), s1 = *(const f32x4*)(cs + 36);
        const h16x8 q1 = *(const h16x8*)(rowp + CQ + h * 64 + 8 * c), q2 = *(const h16x8*)(rowp + CQ + h * 64 + 32 + 8 * c);
        const h16x8 k1 = *(const h16x8*)(rowp + CK + h * 64 + 8 * c), k2 = *(const h16x8*)(rowp + CK + h * 64 + 32 + 8 * c);
        h16x8 qa, qb, ka, kb;
#pragma unroll
        for (int e = 0; e < 8; ++e) { const float co = e < 4 ? c0[e] : c1[e - 4], si = e < 4 ? s0[e] : s1[e - 4];
            float x1 = (float)q1[e], x2 = (float)q2[e]; qa[e] = (h16)(x1 * co - x2 * si); qb[e] = (h16)(x1 * si + x2 * co);
            x1 = (float)k1[e]; x2 = (float)k2[e]; ka[e] = (h16)((x1 * co - x2 * si) * 0.125f); kb[e] = (h16)((x1 * si + x2 * co) * 0.125f); }
        *(LAS h16x8*)(Qt + r * 72 + 8 * c) = qa; *(LAS h16x8*)(Qt + r * 72 + 32 + 8 * c) = qb;
        *(LAS h16x8*)(Kt + r * 72 + 8 * c) = ka; *(LAS h16x8*)(Kt + r * 72 + 32 + 8 * c) = kb;
        const h16x8 v1 = *(const h16x8*)(rowp + CV + h * 64 + 16 * c), v2 = *(const h16x8*)(rowp + CV + h * 64 + 16 * c + 8);
#pragma unroll
        for (int e = 0; e < 8; ++e) { VT[(16 * c + e) * 136 + r] = v1[e]; VT[(16 * c + 8 + e) * 136 + r] = v2[e]; }
        const int er = F.tid >> 3, d0 = (F.tid & 7) * 8;
        const h16* sf = WSP(const h16, OFF_RST) + ((size_t)((0 * NB + b) * NCH + n) * 6 + h) * 4096;
        const h16* sb = WSP(const h16, OFF_RST) + ((size_t)((1 * NB + b) * NCH + n) * 6 + h) * 4096;
        *(LAS h16x8*)(Ff + er * 72 + d0) = *(const h16x8*)(sf + F.tid * 8); *(LAS h16x8*)(Fb + er * 72 + d0) = *(const h16x8*)(sb + F.tid * 8); }
    __syncthreads();
    const int w = F.wave, fr = F.lane & 15, fq = F.lane >> 4, il = 16 * w + fr;
    const float l2g = log1pf(-exp2f(-5.0f - (float)h)) * 1.4426950408889634f;
    h16x8 qf[2];
#pragma unroll
    for (int ks = 0; ks < 2; ++ks) qf[ks] = ldsfrag(Qt + il * 72 + 32 * ks + 8 * fq);
    f32x4 s[8];
#pragma unroll
    for (int jt = 0; jt < 8; ++jt) { f32x4 a = {0.f, 0.f, 0.f, 0.f};
#pragma unroll
        for (int ks = 0; ks < 2; ++ks) a = MFMA16(ldsfrag(Kt + (16 * jt + fr) * 72 + 32 * ks + 8 * fq), qf[ks], a);
#pragma unroll
        for (int r = 0; r < 4; ++r) { const int j = 16 * jt + 4 * fq + r; const int dd = il > j ? il - j : j - il; a[r] *= exp2f(l2g * (float)dd); }
        PINV(a); s[jt] = a; }
    f32x4 o[4];
#pragma unroll
    for (int et = 0; et < 4; ++et) o[et] = (f32x4){0.f, 0.f, 0.f, 0.f};
#pragma unroll
    for (int kp = 0; kp < 4; ++kp) { const h16x8 pf = pack8(s[2 * kp], s[2 * kp + 1]);
#pragma unroll
        for (int et = 0; et < 4; ++et) o[et] = MFMA16(ldsfrag2(VT + (16 * et + fr) * 136 + 32 * kp + 4 * fq, VT + (16 * et + fr) * 136 + 32 * kp + 16 + 4 * fq), pf, o[et]); }
    const float gf = exp2f(l2g * (float)(il + 1)), gb = exp2f(l2g * (float)(128 - il));
#pragma unroll
    for (int ks = 0; ks < 2; ++ks) { const h16x8 qff = scalefrag(qf[ks], gf), qfb = scalefrag(qf[ks], gb);
#pragma unroll
        for (int et = 0; et < 4; ++et) { o[et] = MFMA16(ldsfrag(Ff + (16 * et + fr) * 72 + 32 * ks + 8 * fq), qff, o[et]); o[et] = MFMA16(ldsfrag(Fb + (16 * et + fr) * 72 + 32 * ks + 8 * fq), qfb, o[et]); } }
    float ss = 0.f;
#pragma unroll
    for (int et = 0; et < 4; ++et) ss += (o[et][0] * o[et][0] + o[et][1] * o[et][1]) + (o[et][2] * o[et][2] + o[et][3] * o[et][3]);
    ss += __shfl_xor(ss, 16); ss += __shfl_xor(ss, 32);
    const float rs = 1.0f / sqrtf(ss * (1.0f / 64.0f) + EPS);
    const h16* grow = proj + (size_t)(t0 + il) * NPJ + CG + h * 64; h16* orow = WSP(h16, OFF_OMIX) + (size_t)(t0 + il) * DM + h * 64;
#pragma unroll
    for (int et = 0; et < 4; ++et) { const h16x4 gv = *(const h16x4*)(grow + 16 * et + 4 * fq); f32x4 r;
#pragma unroll
        for (int e = 0; e < 4; ++e) r[e] = o[et][e] * rs * siluf_((float)gv[e]);
        *(h16x4*)(orow + 16 * et + 4 * fq) = pack4(r); }
    __syncthreads();
}

__device__ __forceinline__ void ssd_stage_dt(const Frame& F, const Prm& p, int l, int g, long t0, LAS float* LA, LAS float* DTS) {
    if (F.tid < 128) { const h16* dp = WSP(const h16, WS_R1) + (size_t)(t0 + F.tid) * NPJ + CDT + g * 3;
#pragma unroll
        for (int r = 0; r < 3; ++r) { const float raw = (float)dp[r];
#pragma unroll
            for (int dir = 0; dir < 2; ++dir) { const float dt = softplusf_(raw + p.in[7][(l * 2 + dir) * 6 + g * 3 + r]); const float la = -dt * __expf(p.in[8][(l * 2 + dir) * 6 + g * 3 + r]);
                DTS[(dir * 3 + r) * 128 + F.tid] = dt; LA[(dir * 3 + r) * 128 + F.tid] = la; } } }
}
__device__ __forceinline__ void ssd_cumsum(const Frame& F, LAS const float* LAq, float& v0, float& v1, float& c0, float& c1, float& tot) {
    v0 = LAq[2 * F.lane]; v1 = LAq[2 * F.lane + 1]; float s = v0 + v1;
#pragma unroll
    for (int o = 1; o < 64; o <<= 1) { const float t = __shfl_up(s, o); if (F.lane >= o) s += t; }
    c1 = s; c0 = s - v1; tot = __shfl(s, 63);
}
__device__ __forceinline__ void ssd_states_unit(const Frame& F, const Prm& p, int l, int u) {
    const int g = u & 1, bn = u >> 1, n = bn % NCH, b = bn / NCH; const long t0 = (long)b * SEQ + n * 128;
    const h16* proj = WSP(const h16, WS_R1);
    LAS h16* XT = (LAS h16*)F.lds; LAS h16* BT = XT + 3 * 64 * 136; LAS float* LA = (LAS float*)(BT + 128 * 136); LAS float* DTS = LA + 6 * 128; LAS float* WW = DTS + 6 * 128;
    ssd_stage_dt(F, p, l, g, t0, LA, DTS);
    const float* cw = p.in[5] + (size_t)l * 4 * 896; const float* cb = p.in[6] + (size_t)l * 896;
    for (int it = F.tid; it < 128 * 40; it += 512) { const int row = it / 40, cg = it % 40; float o[8];
        if (cg < 24) { conv8(proj + CXS + g * 192 + 8 * cg, t0, n, row, cw + g * 192 + 8 * cg, 896, cb + g * 192 + 8 * cg, o);
            LAS h16* d = XT + (cg >> 3) * 64 * 136 + ((cg & 7) * 8) * 136 + row;
#pragma unroll
            for (int e = 0; e < 8; ++e) d[e * 136] = (h16)siluf_(o[e]);
        } else { const int cb8 = cg - 24; conv8(proj + CBM + g * 128 + 8 * cb8, t0, n, row, cw + 384 + g * 128 + 8 * cb8, 896, cb + 384 + g * 128 + 8 * cb8, o);
            LAS h16* d = BT + (8 * cb8) * 136 + row;
#pragma unroll
            for (int e = 0; e < 8; ++e) d[e * 136] = (h16)siluf_(o[e]); } }
    __syncthreads();
    if (F.wave < 6) { const int q = F.wave, dir = q / 3, r = q % 3; float v0, v1, c0, c1, tot; ssd_cumsum(F, LA + q * 128, v0, v1, c0, c1, tot);
        const float d0 = DTS[q * 128 + 2 * F.lane], d1 = DTS[q * 128 + 2 * F.lane + 1];
        if (dir == 0) { WW[q * 128 + 2 * F.lane] = __expf(tot - c0) * d0 * 256.f; WW[q * 128 + 2 * F.lane + 1] = __expf(tot - c1) * d1 * 256.f; }
        else { WW[q * 128 + 2 * F.lane] = __expf(c0 - v0) * d0 * 256.f; WW[q * 128 + 2 * F.lane + 1] = __expf(c1 - v1) * d1 * 256.f; }
        if (F.lane == 0) WSP(float, OFF_SDEC)[((size_t)(b * NCH + n) * 6 + g * 3 + r) * 2 + dir] = tot; }
    __syncthreads();
    const int w = F.wave, fr = F.lane & 15, fq = F.lane >> 4;
    h16x8 xb[4];
#pragma unroll
    for (int ks = 0; ks < 4; ++ks) xb[ks] = ldsfrag(BT + (16 * w + fr) * 136 + 32 * ks + 8 * fq);
    for (int q = 0; q < 6; ++q) { const int dir = q / 3, r = q % 3;
        h16x8 wf[4];
#pragma unroll
        for (int ks = 0; ks < 4; ++ks) { const f32x4 a = *(LAS const f32x4*)(WW + q * 128 + 32 * ks + 8 * fq), c = *(LAS const f32x4*)(WW + q * 128 + 32 * ks + 8 * fq + 4); wf[ks] = pack8(a, c); }
        h16* sst = WSP(h16, OFF_SST) + ((size_t)((dir * NB + b) * NCH + n) * 6 + g * 3 + r) * 8192;
#pragma unroll
        for (int pt = 0; pt < 4; ++pt) { f32x4 acc = {0.f, 0.f, 0.f, 0.f};
#pragma unroll
            for (int ks = 0; ks < 4; ++ks) acc = MFMA16(xb[ks], ldsfrag(XT + r * 64 * 136 + (16 * pt + fr) * 136 + 32 * ks + 8 * fq) * wf[ks], acc);
            *(h16x4*)(sst + (16 * pt + fr) * 128 + 16 * w + 4 * fq) = pack4(acc * (1.0f / 256.f)); } }
    __syncthreads();
}
__device__ __forceinline__ void ssd_scan_unit(const Frame& F, int u) {
    const int hd = u % 6, b = (u / 6) % NB, dir = u / (6 * NB);
    float acc[16];
#pragma unroll
    for (int e = 0; e < 16; ++e) acc[e] = 0.f;
    for (int i = 0; i < NCH; ++i) { const int n = dir == 0 ? i : NCH - 1 - i;
        h16* pp = WSP(h16, OFF_SST) + ((size_t)((dir * NB + b) * NCH + n) * 6 + hd) * 8192 + F.tid * 16;
        const float dec = __expf(WSP(const float, OFF_SDEC)[((size_t)(b * NCH + n) * 6 + hd) * 2 + dir]);
        const h16x8 s0 = *(const h16x8*)pp, s1 = *(const h16x8*)(pp + 8); h16x8 o0, o1;
#pragma unroll
        for (int e = 0; e < 8; ++e) { o0[e] = (h16)acc[e]; o1[e] = (h16)acc[8 + e]; acc[e] = acc[e] * dec + (float)s0[e]; acc[8 + e] = acc[8 + e] * dec + (float)s1[e]; }
        *(h16x8*)pp = o0; *(h16x8*)(pp + 8) = o1; }
}
__device__ __forceinline__ void ssd_out_unit(const Frame& F, const Prm& p, int l, int u) {
    const int g = u & 1, bn = u >> 1, n = bn % NCH, b = bn / NCH; const long t0 = (long)b * SEQ + n * 128;
    const h16* proj = WSP(const h16, WS_R1);
    LAS h16* XT = (LAS h16*)F.lds; LAS h16* Bt = XT + 3 * 64 * 136; LAS h16* Ct = Bt + 128 * 136; LAS float* LA = (LAS float*)(Ct + 128 * 136); LAS float* DTS = LA + 6 * 128;
    LAS float* CE = DTS + 6 * 128;
    LAS float* TOTB = CE + 6 * 128;
    ssd_stage_dt(F, p, l, g, t0, LA, DTS);
    const float* cw = p.in[5] + (size_t)l * 4 * 896; const float* cb = p.in[6] + (size_t)l * 896;
    for (int it = F.tid; it < 128 * 56; it += 512) { const int row = it / 56, cg = it % 56; float o[8];
        if (cg < 24) { conv8(proj + CXS + g * 192 + 8 * cg, t0, n, row, cw + g * 192 + 8 * cg, 896, cb + g * 192 + 8 * cg, o);
            LAS h16* d = XT + (cg >> 3) * 64 * 136 + ((cg & 7) * 8) * 136 + row;
#pragma unroll
            for (int e = 0; e < 8; ++e) d[e * 136] = (h16)siluf_(o[e]);
        } else { const int c8 = (cg - 24) & 15; const bool isB = cg < 40; const int col = (isB ? CBM : CCM) + g * 128 + 8 * c8, ci = (isB ? 384 : 640) + g * 128 + 8 * c8;
            conv8(proj + col, t0, n, row, cw + ci, 896, cb + ci, o); h16x8 v;
#pragma unroll
            for (int e = 0; e < 8; ++e) v[e] = (h16)siluf_(o[e]);
            *(LAS h16x8*)((isB ? Bt : Ct) + row * 136 + 8 * c8) = v; } }
    __syncthreads();
    if (F.wave < 6) { const int q = F.wave; float v0, v1, c0, c1, tot; ssd_cumsum(F, LA + q * 128, v0, v1, c0, c1, tot);
        if (q < 3) { CE[q * 128 + 2 * F.lane] = c0; CE[q * 128 + 2 * F.lane + 1] = c1; }
        else { CE[q * 128 + 2 * F.lane] = c0 - v0; CE[q * 128 + 2 * F.lane + 1] = c1 - v1; if (F.lane == 0) TOTB[q - 3] = tot; } }
    __syncthreads();
    const int w = F.wave, fr = F.lane & 15, fq = F.lane >> 4, il = 16 * w + fr;
    h16x8 cf[4];
#pragma unroll
    for (int ks = 0; ks < 4; ++ks) cf[ks] = ldsfrag(Ct + il * 136 + 32 * ks + 8 * fq);
    f32x4 gT[8];
#pragma unroll
    for (int jt = 0; jt < 8; ++jt) { f32x4 a = {0.f, 0.f, 0.f, 0.f};
#pragma unroll
        for (int ks = 0; ks < 4; ++ks) a = MFMA16(ldsfrag(Bt + (16 * jt + fr) * 136 + 32 * ks + 8 * fq), cf[ks], a);
        PINV(a); gT[jt] = a; }
    const float* dsk = p.in[9] + l * 6 + g * 3;
    h16* orow = WSP(h16, OFF_OMIX) + (size_t)(t0 + il) * DM + 384 + g * 192;
    float ss = 0.f;
#pragma unroll 1
    for (int r = 0; r < 3; ++r) {
        f32x4 y[1][4];
        const int hd = g * 3 + r;
        const float cfi = CE[r * 128 + il], ebi = CE[(3 + r) * 128 + il], totb = TOTB[r];
#pragma unroll
        for (int pt = 0; pt < 4; ++pt) y[0][pt] = (f32x4){0.f, 0.f, 0.f, 0.f};
#pragma unroll
        for (int kp = 0; kp < 4; ++kp) { f32x4 pv[2];
#pragma unroll
            for (int jh = 0; jh < 2; ++jh) { const int jt = 2 * kp + jh, j0 = 16 * jt + 4 * fq;
                const f32x4 cfj = *(LAS const f32x4*)(CE + r * 128 + j0), ebj = *(LAS const f32x4*)(CE + (3 + r) * 128 + j0), dfj = *(LAS const f32x4*)(DTS + r * 128 + j0), dbj = *(LAS const f32x4*)(DTS + (3 + r) * 128 + j0);
#pragma unroll
                for (int e = 0; e < 4; ++e) { const int j = j0 + e; const float val = (il >= j) ? __expf(cfi - cfj[e]) * dfj[e] : __expf(ebj[e] - ebi) * dbj[e]; pv[jh][e] = gT[jt][e] * val * 256.f; } }
            const h16x8 pf = pack8(pv[0], pv[1]);
#pragma unroll
            for (int pt = 0; pt < 4; ++pt) { LAS const h16* xr = XT + r * 64 * 136 + (16 * pt + fr) * 136 + 32 * kp + 4 * fq; y[0][pt] = MFMA16(ldsfrag2(xr, xr + 16), pf, y[0][pt]); }
            PINV(y[0][0]); PINV(y[0][1]); PINV(y[0][2]); PINV(y[0][3]); }
        const float ef = __expf(cfi) * 256.f, eb = __expf(totb - ebi) * 256.f;
        const h16* hf = WSP(const h16, OFF_SST) + ((size_t)((0 * NB + b) * NCH + n) * 6 + hd) * 8192;
        const h16* hb = WSP(const h16, OFF_SST) + ((size_t)((1 * NB + b) * NCH + n) * 6 + hd) * 8192;
#pragma unroll
        for (int ks = 0; ks < 4; ++ks) { const h16x8 cff = scalefrag(cf[ks], ef), cfb = scalefrag(cf[ks], eb);
#pragma unroll
            for (int pt = 0; pt < 4; ++pt) { y[0][pt] = MFMA16(*(const h16x8*)(hf + (16 * pt + fr) * 128 + 32 * ks + 8 * fq), cff, y[0][pt]);
                y[0][pt] = MFMA16(*(const h16x8*)(hb + (16 * pt + fr) * 128 + 32 * ks + 8 * fq), cfb, y[0][pt]); }
            PINV(y[0][0]); PINV(y[0][1]); PINV(y[0][2]); PINV(y[0][3]); }
        const float dk = dsk[r]; const h16* zrow = proj + (size_t)(t0 + il) * NPJ + CZ + hd * 64;
#pragma unroll
        for (int pt = 0; pt < 4; ++pt) { const h16x4 zv = *(const h16x4*)(zrow + 16 * pt + 4 * fq);
#pragma unroll
            for (int e = 0; e < 4; ++e) { const float xv = (float)XT[r * 64 * 136 + (16 * pt + 4 * fq + e) * 136 + il]; y[0][pt][e] = (y[0][pt][e] * (1.0f / 256.f) + dk * xv) * siluf_((float)zv[e]); }
            const h16x4 yh = pack4(y[0][pt]); *(h16x4*)(orow + r * 64 + 16 * pt + 4 * fq) = yh;
#pragma unroll
            for (int e = 0; e < 4; ++e) { const float q = (float)yh[e]; ss += q * q; } }
    }
    ss += __shfl_xor(ss, 16); ss += __shfl_xor(ss, 32);
    const float rs = 1.0f / sqrtf(ss * (1.0f / 192.0f) + EPS);
    const float* nw = p.in[10] + l * 384 + g * 192;
    asm volatile("s_waitcnt vmcnt(0)" ::: "memory");
#pragma unroll 1
    for (int r = 0; r < 3; ++r)
#pragma unroll
        for (int pt = 0; pt < 4; ++pt) { const f32x4 wv = *(const f32x4*)(nw + r * 64 + 16 * pt + 4 * fq); h16* op = orow + r * 64 + 16 * pt + 4 * fq; const h16x4 yh = *(const h16x4*)op; f32x4 yv;
#pragma unroll
            for (int e = 0; e < 4; ++e) yv[e] = (float)yh[e] * rs * wv[e];
            *(h16x4*)op = pack4(yv); }
    __syncthreads();
}

template <bool FINAL>
__device__ __forceinline__ void lru_unit(const Frame& F, const Prm& p, int l, int u) {
    const int n = u % NCH, b = u / NCH; const long t0 = (long)b * SEQ + n * 128;
    const h16* proj = WSP(const h16, WS_R1);
    LAS h16* XC = (LAS h16*)F.lds;
    const float* cw = p.in[11] + (size_t)l * 4 * 256; const float* cb = p.in[12] + (size_t)l * 256;
    for (int it = F.tid; it < 128 * 32; it += 512) { const int row = it >> 5, cg = it & 31; float o[8];
        conv8(proj + CXR + 8 * cg, t0, n, row, cw + 8 * cg, 256, cb + 8 * cg, o); h16x8 v;
#pragma unroll
        for (int e = 0; e < 8; ++e) v[e] = (h16)o[e];
        *(LAS h16x8*)(XC + row * 264 + 8 * cg) = v; }
    __syncthreads();
    const int blk = F.wave & 3, jh = F.wave >> 2, fr = F.lane & 15, fq = F.lane >> 4;
#pragma unroll
    for (int dir = 0; dir < 2; ++dir) {
        h16x8 wa[2][2], wx[2][2]; float ba[2], bx[2], sp[2], car[2];
#pragma unroll
        for (int jt = 0; jt < 2; ++jt) { const int ch = blk * 64 + 32 * jh + 16 * jt + fr;
#pragma unroll
            for (int ks = 0; ks < 2; ++ks) { wa[jt][ks] = *(const h16x8*)(WSP(const h16, WS_LRUW) + (size_t)((dir * 2 + 0) * 4 + blk) * 4096 + (32 * jh + 16 * jt + fr) * 64 + 32 * ks + 8 * fq);
                wx[jt][ks] = *(const h16x8*)(WSP(const h16, WS_LRUW) + (size_t)((dir * 2 + 1) * 4 + blk) * 4096 + (32 * jh + 16 * jt + fr) * 64 + 32 * ks + 8 * fq); }
            ba[jt] = p.in[15][(l * 2 + dir) * 256 + ch]; bx[jt] = p.in[17][(l * 2 + dir) * 256 + ch]; sp[jt] = softplusf_(-p.in[13][(l * 2 + dir) * 256 + ch]);
            car[jt] = FINAL ? WSP(const float, OFF_LCAR)[((size_t)(b * NCH + n) * 2 + dir) * 256 + ch] : 0.f; }
        float atot[2] = {1.f, 1.f};
#pragma unroll 1
        for (int ti = 0; ti < 8; ++ti) { const int tt = dir == 0 ? ti : 7 - ti;
            h16x8 xf[2];
#pragma unroll
            for (int ks = 0; ks < 2; ++ks) xf[ks] = ldsfrag(XC + (16 * tt + fr) * 264 + blk * 64 + 32 * ks + 8 * fq);
#pragma unroll
            for (int jt = 0; jt < 2; ++jt) { const int ch = blk * 64 + 32 * jh + 16 * jt + fr;
                f32x4 ra = {0.f, 0.f, 0.f, 0.f}, ia = {0.f, 0.f, 0.f, 0.f};
#pragma unroll
                for (int ks = 0; ks < 2; ++ks) { ra = MFMA16(xf[ks], wa[jt][ks], ra); ia = MFMA16(xf[ks], wx[jt][ks], ia); }
                float av[4], uv[4]; float A = 1.f, H = 0.f;
#pragma unroll
                for (int ri = 0; ri < 4; ++ri) { const int rg = dir == 0 ? ri : 3 - ri; const float rgate = sigmoidf_(ra[rg] + ba[jt]), ig = sigmoidf_(ia[rg] + bx[jt]);
                    const float la = -8.0f * rgate * sp[jt]; const float a = __expf(la); const float mult = sqrtf(-expm1f(2.0f * la));
                    const float xv = (float)XC[(16 * tt + 4 * fq + rg) * 264 + ch]; const float uu = mult * ig * xv;
                    av[rg] = a; uv[rg] = uu; H = a * H + uu; A *= a; }
                float Ag[4], Hg[4];
#pragma unroll
                for (int gq = 0; gq < 4; ++gq) { Ag[gq] = __shfl(A, fr + 16 * gq); Hg[gq] = __shfl(H, fr + 16 * gq); }
                float hin = car[jt], cnew = car[jt], at = 1.f;
#pragma unroll
                for (int gi = 0; gi < 4; ++gi) { const int gq = dir == 0 ? gi : 3 - gi;
                    const bool before = dir == 0 ? (gq < fq) : (gq > fq);
                    if (before) hin = Ag[gq] * hin + Hg[gq];
                    cnew = Ag[gq] * cnew + Hg[gq]; at *= Ag[gq]; }
                car[jt] = cnew; atot[jt] *= at;
                if (FINAL) { float hh = hin;
#pragma unroll
                    for (int ri = 0; ri < 4; ++ri) { const int rg = dir == 0 ? ri : 3 - ri; hh = av[rg] * hh + uv[rg];
                        const long t = t0 + 16 * tt + 4 * fq + rg; h16* op = WSP(h16, OFF_OMIX) + (size_t)t * DM + 768 + ch;
                        if (dir == 0) *op = (h16)hh;
                        else { const float gt = (float)proj[(size_t)t * NPJ + CGT + ch]; *op = (h16)(((float)*op + hh) * gelu_tanh_(gt)); } } }
            } }
        if (!FINAL && fq == 0) {
#pragma unroll
            for (int jt = 0; jt < 2; ++jt) { const int ch = blk * 64 + 32 * jh + 16 * jt + fr; *(f32x2*)(WSP(float, OFF_LSUM) + (((size_t)(b * NCH + n) * 2 + dir) * 256 + ch) * 2) = (f32x2){atot[jt], car[jt]}; } }
    }
    __syncthreads();
}
__device__ __forceinline__ void lru_scan(const Frame& F) {
    const int gi = F.vcu * 512 + F.tid; if (gi >= NB * 2 * 256) return;
    const int ch = gi & 255, dir = (gi >> 8) & 1, b = gi >> 9; float H = 0.f;
    for (int i = 0; i < NCH; ++i) { const int n = dir == 0 ? i : NCH - 1 - i; const size_t idx = ((size_t)(b * NCH + n) * 2 + dir) * 256 + ch;
        const f32x2 s = *(const f32x2*)(WSP(const float, OFF_LSUM) + idx * 2); WSP(float, OFF_LCAR)[idx] = H; H = s[0] * H + s[1]; }
}

__device__ __forceinline__ void attn_unit(const Frame& F, int u) {
    const int qb = u & 15, hd = (u >> 4) & 3, b = u >> 6;
    const int fr = F.lane & 15, fq = F.lane >> 4; const long t = (long)b * SEQ + qb * 128 + 16 * F.wave + fr;
    LAS h16* TL = (LAS h16*)F.lds;
    const h16* qrow = WSP(const h16, OFF_QCA) + (size_t)t * DM + hd * 256;
    h16x8 qf[8];
#pragma unroll
    for (int ks = 0; ks < 8; ++ks) qf[ks] = *(const h16x8*)(qrow + 32 * ks + 8 * fq);
    f32x4 s[16];
#pragma unroll
    for (int half = 0; half < 2; ++half) {
        __syncthreads();
        const h16* kb = WSP(const h16, OFF_KB) + (size_t)(b * 256 + half * 128) * DM + hd * 256;
        for (int it = F.tid; it < 128 * 32; it += 512) { const int row = it >> 5, c = it & 31; *(LAS h16x8*)(TL + row * 264 + 8 * c) = *(const h16x8*)(kb + (size_t)row * DM + 8 * c); }
        __syncthreads();
#pragma unroll
        for (int jt = 0; jt < 8; ++jt) { f32x4 a = {0.f, 0.f, 0.f, 0.f};
#pragma unroll
            for (int ks = 0; ks < 8; ++ks) a = MFMA16(ldsfrag(TL + (16 * jt + fr) * 264 + 32 * ks + 8 * fq), qf[ks], a);
            PINV(a); s[half * 8 + jt] = a; }
    }
    float mx = -3.0e38f;
#pragma unroll
    for (int jt = 0; jt < 16; ++jt) mx = fmaxf(mx, fmaxf(fmaxf(s[jt][0], s[jt][1]), fmaxf(s[jt][2], s[jt][3])));
    mx = fmaxf(mx, __shfl_xor(mx, 16)); mx = fmaxf(mx, __shfl_xor(mx, 32));
    float sum = 0.f;
#pragma unroll
    for (int jt = 0; jt < 16; ++jt)
#pragma unroll
        for (int e = 0; e < 4; ++e) { const float pe = __expf(s[jt][e] - mx); s[jt][e] = pe; sum += pe; }
    sum += __shfl_xor(sum, 16); sum += __shfl_xor(sum, 32);
    const float inv = 1.0f / sum;
    h16x8 pf[8];
#pragma unroll
    for (int kp = 0; kp < 8; ++kp) pf[kp] = pack8(s[2 * kp] * inv, s[2 * kp + 1] * inv);
    f32x4 o[16];
#pragma unroll
    for (int et = 0; et < 16; ++et) o[et] = (f32x4){0.f, 0.f, 0.f, 0.f};
#pragma unroll
    for (int half = 0; half < 2; ++half) {
        __syncthreads();
        const h16* vt = WSP(const h16, OFF_VT) + (size_t)(b * 4 + hd) * 65536 + half * 128;
        for (int it = F.tid; it < 256 * 16; it += 512) { const int row = it >> 4, c = it & 15; *(LAS h16x8*)(TL + row * 136 + 8 * c) = *(const h16x8*)(vt + (size_t)row * 256 + 8 * c); }
        __syncthreads();
#pragma unroll
        for (int et = 0; et < 16; ++et) {
#pragma unroll
            for (int kp = 0; kp < 4; ++kp) { LAS const h16* vr = TL + (16 * et + fr) * 136 + 32 * kp + 4 * fq; o[et] = MFMA16(ldsfrag2(vr, vr + 16), pf[half * 4 + kp], o[et]); }
            PINV(o[et]); }
    }
    h16* orow = WSP(h16, OFF_OATT) + (size_t)t * DM + hd * 256;
#pragma unroll
    for (int et = 0; et < 16; ++et) *(h16x4*)(orow + 16 * et + 4 * fq) = pack4(o[et]);
}

__device__ __forceinline__ void phase_router(const Frame& F, const Prm& p, int l) {
    LAS float* RW = (LAS float*)F.lds;
    const float* gm = p.in[23] + l * DM; const float* wg = p.in[24] + (size_t)l * DM * 4; const float* we = p.in[26] + (size_t)l * DM * 32;
    for (int i = F.tid; i < 36 * DM; i += 512) { const int k = i / 36, j = i % 36; RW[j * DM + (k ^ ((j & 3) << 4))] = gm[k] * (j < 4 ? wg[k * 4 + j] : we[k * 32 + (j - 4)]); }
    LAS unsigned* hist = (LAS unsigned*)(F.lds + 36 * DM * 4);
    if (F.tid < 32) hist[F.tid] = 0u;
    __syncthreads();
    const int gw = F.vcu * 8 + F.wave, NGW = F.G * 8, fr = F.lane & 15, fq = F.lane >> 4;
    for (int tg = gw; tg < NT / 16; tg += NGW) {
        const int tok = tg * 16 + fr;
        const float* hp = p.out + (size_t)tok * DM + 4 * fq;
        f32x4 acc[3]; LAS const float* wrow[3]; int sw[3];
#pragma unroll
        for (int mt = 0; mt < 3; ++mt) { acc[mt] = (f32x4){0.f, 0.f, 0.f, 0.f}; const int j = (16 * mt + fr) < 36 ? (16 * mt + fr) : 35; wrow[mt] = RW + j * DM; sw[mt] = (j & 3) << 4; }
#pragma unroll 4
        for (int s2 = 0; s2 < 64; ++s2) { const f32x4 hv = *(const f32x4*)(hp + 16 * s2);
#pragma unroll
            for (int mt = 0; mt < 3; ++mt) { const f32x4 wv = *(LAS const f32x4*)(wrow[mt] + ((16 * s2 + 4 * fq) ^ sw[mt]));
#pragma unroll
                for (int i = 0; i < 4; ++i) acc[mt] = __builtin_amdgcn_mfma_f32_16x16x4f32(wv[i], hv[i], acc[mt], 0, 0, 0); } }
        const float rs = row_rstd(WSP(const float, WS_SSQ) + (size_t)tok * 16);
        float gl[4];
#pragma unroll
        for (int r = 0; r < 4; ++r) gl[r] = __shfl(acc[0][r], fr) * rs + p.in[25][l * 4 + r];
        int gi = 0; float gmx = gl[0];
#pragma unroll
        for (int j = 1; j < 4; ++j) if (gl[j] > gmx) { gmx = gl[j]; gi = j; }
        float gsum = 0.f;
#pragma unroll
        for (int j = 0; j < 4; ++j) gsum += __expf(gl[j] - gmx);
        const float gp = 1.0f / gsum;
        const int src1 = fr + 16 * (1 + 2 * (gi & 1)), src2 = fr + 16 * (2 - 2 * (gi & 1)), mt1 = gi >> 1, mt2 = (gi + 1) >> 1;
        float el[8];
#pragma unroll
        for (int k = 0; k < 4; ++k) { const float a0 = __shfl(acc[0][k], src1), a1 = __shfl(acc[1][k], src1); el[k] = (mt1 ? a1 : a0) * rs + p.in[27][l * 32 + gi * 8 + k];
            const float b0 = __shfl(acc[0][k], src2), b1 = __shfl(acc[1][k], src2), b2 = __shfl(acc[2][k], src2); el[4 + k] = (mt2 == 0 ? b0 : (mt2 == 1 ? b1 : b2)) * rs + p.in[27][l * 32 + gi * 8 + 4 + k]; }
        int e1 = 0; float m1 = el[0];
#pragma unroll
        for (int j = 1; j < 8; ++j) if (el[j] > m1) { m1 = el[j]; e1 = j; }
        int e2 = -1; float m2 = -3.0e38f;
#pragma unroll
        for (int j = 0; j < 8; ++j) if (j != e1 && el[j] > m2) { m2 = el[j]; e2 = j; }
        const float r2 = __expf(m2 - m1); const float g1 = gp / (1.0f + r2), g2 = gp * r2 / (1.0f + r2);
        if (fq == 0) { const int x1 = gi * 8 + e1, x2 = gi * 8 + e2;
            *(int2*)(WSP(int, OFF_EID) + (size_t)tok * 2) = make_int2(x1, x2); *(f32x2*)(WSP(float, OFF_GATE) + (size_t)tok * 2) = (f32x2){g1, g2};
            WSP(float, OFF_RSTDT)[tok] = rs; __hip_atomic_fetch_add(&hist[x1], 1u, __ATOMIC_RELAXED, __HIP_MEMORY_SCOPE_WORKGROUP); __hip_atomic_fetch_add(&hist[x2], 1u, __ATOMIC_RELAXED, __HIP_MEMORY_SCOPE_WORKGROUP); }
    }
    __syncthreads();
    if (F.tid < 32 && hist[F.tid]) atomicAdd(WSP(unsigned, WS_CTL) + CW_COUNTS + l * 64 + F.tid, hist[F.tid]);
    __syncthreads();
}
__device__ __forceinline__ void phase_dispatch(const Frame& F, int l) {
    LAS int* cnt = (LAS int*)F.lds; LAS int* base = cnt + 32; LAS int* pstart = base + 32; LAS int* slots = pstart + 40;
    unsigned* ctl = WSP(unsigned, WS_CTL);
    for (int blk = F.vcu; blk < NT / 128; blk += F.G) {
        __syncthreads();
        if (F.tid < 32) cnt[F.tid] = 0;
        if (F.tid == 32) { int acc = 0; for (int e = 0; e < 32; ++e) { pstart[e] = acc; acc += (int)((ctl[CW_COUNTS + l * 64 + e] + 255u) & ~255u); } pstart[32] = acc; }
        __syncthreads();
        int e = 0, rank = 0, tok = 0;
        if (F.tid < 256) { tok = blk * 128 + (F.tid >> 1); e = WSP(const int, OFF_EID)[(size_t)tok * 2 + (F.tid & 1)]; rank = __hip_atomic_fetch_add(&cnt[e], 1, __ATOMIC_RELAXED, __HIP_MEMORY_SCOPE_WORKGROUP); }
        __syncthreads();
        if (F.tid < 32) base[F.tid] = cnt[F.tid] ? (int)atomicAdd(&ctl[CW_CURSOR + l * 64 + F.tid], (unsigned)cnt[F.tid]) : 0;
        __syncthreads();
        if (F.tid < 256) { const int slot = pstart[e] + base[e] + rank; slots[F.tid] = slot; WSP(int, OFF_TSLOT)[(size_t)tok * 2 + (F.tid & 1)] = slot; WSP(float, OFF_SRSTD)[slot] = WSP(const float, OFF_RSTDT)[tok]; }
        __syncthreads();
        for (int a0 = F.wave * 32; a0 < F.wave * 32 + 32; a0 += 16) { h16x8 buf[8][2];
#pragma unroll
            for (int q = 0; q < 8; ++q) { const h16* src = WSP(const h16, WS_HB) + (size_t)(blk * 128 + (a0 >> 1) + q) * DM; buf[q][0] = *(const h16x8*)(src + 8 * F.lane); buf[q][1] = *(const h16x8*)(src + 512 + 8 * F.lane); }
#pragma unroll
            for (int q = 0; q < 8; ++q)
#pragma unroll
                for (int k = 0; k < 2; ++k) { h16* dst = WSP(h16, OFF_XP) + (size_t)slots[a0 + 2 * q + k] * DM; *(h16x8*)(dst + 8 * F.lane) = buf[q][0]; *(h16x8*)(dst + 512 + 8 * F.lane) = buf[q][1]; } }
        if (blk == 0 && F.tid == 0) { const int ntl = pstart[32] >> 8; ctl[CW_NTILES + l] = (unsigned)ntl; int* te = WSP(int, OFF_TILEE);
            for (int e2 = 0; e2 < 32; ++e2) for (int tl = pstart[e2] >> 8; tl < (pstart[e2 + 1] >> 8); ++tl) te[tl] = e2; }
    }
    __syncthreads();
}
__device__ __forceinline__ void phase_combine(const Frame& F, const Prm& p, int l) {
    const int gw = F.vcu * 8 + F.wave, NGW = F.G * 8;
    const bool last = (l == NLAYER - 1);
    for (int tk0 = gw * 4; tk0 < NT; tk0 += NGW * 4) {
        int2 sl[4]; f32x2 gt[4];
#pragma unroll
        for (int q = 0; q < 4; ++q) { sl[q] = *(const int2*)(WSP(const int, OFF_TSLOT) + (size_t)(tk0 + q) * 2); gt[q] = *(const f32x2*)(WSP(const float, OFF_GATE) + (size_t)(tk0 + q) * 2); }
        f32x4 v[4][4]; h16x4 ya[4][4], yb[4][4];
#pragma unroll
        for (int q = 0; q < 4; ++q) { const float* hrow = p.out + (size_t)(tk0 + q) * DM; const h16* y0 = WSP(const h16, OFF_YP) + (size_t)sl[q].x * DM; const h16* y1 = WSP(const h16, OFF_YP) + (size_t)sl[q].y * DM;
#pragma unroll
            for (int j = 0; j < 4; ++j) { const int c = 4 * F.lane + 256 * j; v[q][j] = *(const f32x4*)(hrow + c); ya[q][j] = *(const h16x4*)(y0 + c); yb[q][j] = *(const h16x4*)(y1 + c); } }
#pragma unroll
        for (int q = 0; q < 4; ++q) { float s = 0.f; float* hrow = p.out + (size_t)(tk0 + q) * DM;
#pragma unroll
            for (int j = 0; j < 4; ++j) {
#pragma unroll
                for (int e = 0; e < 4; ++e) v[q][j][e] += gt[q][0] * (float)ya[q][j][e] + gt[q][1] * (float)yb[q][j][e];
                s += (v[q][j][0] * v[q][j][0] + v[q][j][1] * v[q][j][1]) + (v[q][j][2] * v[q][j][2] + v[q][j][3] * v[q][j][3]); }
            s = wave_sum(s);
            if (!last) {
#pragma unroll
                for (int j = 0; j < 4; ++j) { const int c = 4 * F.lane + 256 * j; *(f32x4*)(hrow + c) = v[q][j]; *(h16x4*)(WSP(h16, WS_HB) + (size_t)(tk0 + q) * DM + c) = pack4(v[q][j]); }
                if (F.lane < 16) WSP(float, WS_SSQ)[(size_t)(tk0 + q) * 16 + F.lane] = (F.lane == 0) ? s : 0.f;
            } else { const float rs = 1.0f / sqrtf(s * (1.0f / DM) + EPS);
#pragma unroll
                for (int j = 0; j < 4; ++j) { const int c = 4 * F.lane + 256 * j; const f32x4 gf = *(const f32x4*)(p.in[31] + c); *(f32x4*)(hrow + c) = v[q][j] * rs * gf; } } }
    }
}

__global__ void __launch_bounds__(512, 2) fwd(Prm p) {
    extern __shared__ __attribute__((aligned(16))) unsigned char lds_raw[];
    Frame F; F.lds = (LAS unsigned char*)lds_raw; F.ws = p.ws;
    F.tid = threadIdx.x; F.lane = F.tid & 63; F.wave = __builtin_amdgcn_readfirstlane(F.tid >> 6);
    F.G = gridDim.x; { const int bx = blockIdx.x; F.vcu = (F.G % 8 == 0) ? (bx % 8) * (F.G / 8) + bx / 8 : bx; }
    volatile LAS unsigned* misc = (volatile LAS unsigned*)(F.lds + LDS_MISC);
    if (F.tid < 4) misc[F.tid] = 0u;
    __syncthreads();
    const int lo = p.ph_lo, hi = p.ph_hi;
    XcdBarrier bar; bar.bar = WSP(unsigned, WS_CTL) + CW_BAR; bar.x = 0; bar.st = misc;
    if (hi - lo > 1) bar = xcd_barrier_post(WSP(unsigned, WS_CTL) + CW_BAR, misc);
#ifndef UMASK
#define UMASK 7
#endif
#ifndef REPMASK
#define REPMASK 0
#endif
#ifndef PHMASK
#define PHMASK 0x3fff
#endif
#define IN(k) (((PHMASK >> ((k) % NPH)) & 1) && lo <= (k) && (k) < hi && (launder(F), true))
#define REPS(k) (((REPMASK >> (k)) & 1) ? 2 : 1)
#define INR(k) (lo <= (k) && (k) < hi)
#define SEAM(k) do { if (INR(k) && INR((k) + 1)) xcd_barrier(bar); } while (0)
    for (int l = 0; l < NLAYER; ++l) {
        const int pb = l * NPH;
        if (IN(pb + 0)) for (int rep = 0; rep < REPS(0); ++rep) { phase_convert(F, p, l); } SEAM(pb + 0);
        if (IN(pb + 1)) for (int rep = 0; rep < REPS(1); ++rep) {
            if (UMASK & 1) { pg8::Gemm g{WSP(const h16, WS_HB), WSP(const h16, WS_WIN), DM, DM, DM}; pg8::StaticOrder S; S.init(NT, NPJ, F.G, (int)blockIdx.x);
              pg8::EpiScale16 E{WSP(h16, WS_R1), NPJ, WSP(const float, WS_SSQ)}; pg8::gemm_phase(F.lds, F.tid, g, S, E); }
            launder(F);
            if (UMASK & 2) { pg8::Gemm g{WSP(const h16, WS_MEM16), WSP(const h16, WS_WKV), DM, DM, DM}; pg8::StaticOrder S; S.init(NTM, 2048, F.G, (int)blockIdx.x);
              pg8::EpiKV E{WSP(h16, OFF_KB), WSP(h16, OFF_VT), WSP(const float, OFF_MSSQ)}; pg8::gemm_phase(F.lds, F.tid, g, S, E); }
        } SEAM(pb + 1);
        if (IN(pb + 2)) for (int rep = 0; rep < REPS(2); ++rep) {
            if (UMASK & 1) for (int r2 = 0; r2 < REPS(17); ++r2) for (int u = blockIdx.x; u < NB * NCH * 2; u += F.G) ssd_states_unit(F, p, l, u);
            if (UMASK & 2) for (int r2 = 0; r2 < REPS(18); ++r2) for (int u = blockIdx.x; u < NB * NCH * 6; u += F.G) ret_states_unit(F, u);
            if (UMASK & 4) for (int r2 = 0; r2 < REPS(19); ++r2) for (int u = blockIdx.x; u < NB * NCH; u += F.G) lru_unit<false>(F, p, l, u);
        } SEAM(pb + 2);
        if (IN(pb + 3)) for (int rep = 0; rep < REPS(3); ++rep) {
            for (int u = blockIdx.x; u < 2 * NB * 6; u += F.G) ssd_scan_unit(F, u);
            for (int u = blockIdx.x; u < 2 * NB * 6; u += F.G) ret_scan_unit(F, u);
            lru_scan(F);
        } SEAM(pb + 3);
        if (IN(pb + 4)) for (int rep = 0; rep < REPS(4); ++rep) {
            if (UMASK & 1) for (int r2 = 0; r2 < REPS(14); ++r2) for (int u = blockIdx.x; u < NB * NCH * 2; u += F.G) ssd_out_unit(F, p, l, u);
            if (UMASK & 2) for (int r2 = 0; r2 < REPS(15); ++r2) for (int u = blockIdx.x; u < NB * NCH * 6; u += F.G) ret_out_unit(F, u);
            if (UMASK & 4) for (int r2 = 0; r2 < REPS(16); ++r2) for (int u = blockIdx.x; u < NB * NCH; u += F.G) lru_unit<true>(F, p, l, u);
        } SEAM(pb + 4);
        if (IN(pb + 5)) for (int rep = 0; rep < REPS(5); ++rep) { pg8::Gemm g{WSP(const h16, OFF_OMIX), WSP(const h16, WS_WOUT), DM, DM, DM}; pg8::StaticOrder S; S.init(NT, DM, F.G, (int)blockIdx.x);
            pg8::EpiResid E{l == 0 ? p.in[0] : p.out, p.out, WSP(h16, WS_HB), WSP(float, WS_SSQ)}; pg8::gemm_phase(F.lds, F.tid, g, S, E); } SEAM(pb + 5);
        if (IN(pb + 6)) for (int rep = 0; rep < REPS(6); ++rep) { pg8::Gemm g{WSP(const h16, WS_HB), WSP(const h16, WS_WQ), DM, DM, DM}; pg8::StaticOrder S; S.init(NT, DM, F.G, (int)blockIdx.x);
            pg8::EpiScale16 E{WSP(h16, OFF_QCA), DM, WSP(const float, WS_SSQ)}; pg8::gemm_phase(F.lds, F.tid, g, S, E); } SEAM(pb + 6);
        if (IN(pb + 7)) for (int rep = 0; rep < REPS(7); ++rep) { for (int u = F.vcu; u < NB * 4 * 16; u += F.G) attn_unit(F, u); } SEAM(pb + 7);
        if (IN(pb + 8)) for (int rep = 0; rep < REPS(8); ++rep) { pg8::Gemm g{WSP(const h16, OFF_OATT), WSP(const h16, WS_WO), DM, DM, DM}; pg8::StaticOrder S; S.init(NT, DM, F.G, (int)blockIdx.x);
            pg8::EpiResid E{p.out, p.out, WSP(h16, WS_HB), WSP(float, WS_SSQ)}; pg8::gemm_phase(F.lds, F.tid, g, S, E); } SEAM(pb + 8);
        if (IN(pb + 9)) for (int rep = 0; rep < REPS(9); ++rep) { phase_router(F, p, l); } SEAM(pb + 9);
        if (IN(pb + 10)) for (int rep = 0; rep < REPS(10); ++rep) { phase_dispatch(F, l); } SEAM(pb + 10);
        if (IN(pb + 11)) for (int rep = 0; rep < REPS(11); ++rep) { pg8::Gemm g{WSP(const h16, OFF_XP), WSP(const h16, WS_W13), DM, DM, DM};
            pg8::GroupOrder S{WSP(const int, OFF_TILEE), __builtin_amdgcn_readfirstlane((int)WSP(const unsigned, WS_CTL)[CW_NTILES + l]), F.G, F.vcu};
            pg8::EpiGated E{WSP(h16, OFF_HP), WSP(const float, OFF_SRSTD)}; pg8::gemm_phase(F.lds, F.tid, g, S, E); } SEAM(pb + 11);
        if (IN(pb + 12)) for (int rep = 0; rep < REPS(12); ++rep) { pg8::Gemm g{WSP(const h16, OFF_HP), WSP(const h16, WS_W2), 512, 512, 512};
            pg8::GroupOrder S{WSP(const int, OFF_TILEE), __builtin_amdgcn_readfirstlane((int)WSP(const unsigned, WS_CTL)[CW_NTILES + l]), F.G, F.vcu};
            pg8::EpiPlain16 E{WSP(h16, OFF_YP)}; pg8::gemm_phase(F.lds, F.tid, g, S, E); } SEAM(pb + 12);
        if (IN(pb + 13)) for (int rep = 0; rep < REPS(13); ++rep) { phase_combine(F, p, l); } SEAM(pb + 13);
    }
#undef IN
#undef INR
#undef SEAM
}

extern "C" void kernel_launch(void* const* d_in, const int* in_sizes, int n_in, void* d_out, int out_size, void* d_ws, size_t ws_size, hipStream_t stream) {
    static int grid = 0;
    if (grid == 0) {
        if (n_in != 32 || out_size != NT * DM || ws_size < WS_END) { fprintf(stderr, "kernel_launch: unexpected shapes / workspace (%d inputs, out %d, ws %zu < %zu)\n", n_in, out_size, ws_size, (size_t)WS_END); grid = -1; return; }
        int dev = 0, cus = 0, per_cu = 0;
        if (hipGetDevice(&dev) != hipSuccess || hipDeviceGetAttribute(&cus, hipDeviceAttributeMultiprocessorCount, dev) != hipSuccess) { grid = -1; return; }
        if (hipFuncSetAttribute((const void*)fwd, hipFuncAttributeMaxDynamicSharedMemorySize, LDS_BYTES) != hipSuccess) { fprintf(stderr, "kernel_launch: hipFuncSetAttribute failed\n"); grid = -1; return; }
        if (hipOccupancyMaxActiveBlocksPerMultiprocessor(&per_cu, (const void*)fwd, 512, LDS_BYTES) != hipSuccess || per_cu < 1) { fprintf(stderr, "kernel_launch: occupancy query says %d\n", per_cu); }
        (void)hipGetLastError();
        grid = cus;
    }
    if (grid < 0) return;
    (void)hipMemsetAsync((char*)d_ws + WS_CTL, 0, CTL_ZERO_BYTES, stream);
    Prm p{};
    for (int i = 0; i < 32; ++i) p.in[i] = (const float*)d_in[i];
    p.out = (float*)d_out; p.ws = (unsigned char*)d_ws;
#if defined(PROBE_PHASE)
    p.ph_lo = 0; p.ph_hi = PROBE_PHASE + 1; hipLaunchKernelGGL(fwd, dim3(grid), dim3(512), LDS_BYTES, stream, p);
    (void)hipMemsetAsync((char*)d_ws + WS_CTL + CW_BAR * 4, 0, XCD_BAR_WORDS * 4, stream);
    p.ph_lo = PROBE_PHASE; p.ph_hi = PROBE_PHASE + 1; hipLaunchKernelGGL(fwd, dim3(grid), dim3(512), LDS_BYTES, stream, p);
    p.ph_lo = PROBE_PHASE + 1; p.ph_hi = NPHASES; hipLaunchKernelGGL(fwd, dim3(grid), dim3(512), LDS_BYTES, stream, p);
#elif MK_SINGLE
    p.ph_lo = 0; p.ph_hi = NPHASES;
    hipLaunchKernelGGL(fwd, dim3(grid), dim3(512), LDS_BYTES, stream, p);
#else
    for (int ph = 0; ph < NPHASES; ++ph) { p.ph_lo = ph; p.ph_hi = ph + 1; hipLaunchKernelGGL(fwd, dim3(grid), dim3(512), LDS_BYTES, stream, p); }
#endif
}
```

```cpp
#include <hip/hip_runtime.h>
#include <cstdio>
#include <cstdint>

#ifndef MK_SINGLE
#define MK_SINGLE 1
#endif

typedef _Float16 h16;
typedef _Float16 h16x2 __attribute__((ext_vector_type(2)));
typedef _Float16 h16x4 __attribute__((ext_vector_type(4)));
typedef _Float16 h16x8 __attribute__((ext_vector_type(8)));
typedef float f32x2 __attribute__((ext_vector_type(2)));
typedef float f32x4 __attribute__((ext_vector_type(4)));
typedef unsigned u32x2 __attribute__((ext_vector_type(2)));
typedef unsigned u32x4 __attribute__((ext_vector_type(4)));
#define LAS __attribute__((address_space(3)))
#define GAS __attribute__((address_space(1)))
#define PIN() do { asm volatile("" ::: "memory"); __builtin_amdgcn_sched_barrier(0); } while (0)
#define PINV(x) asm volatile("" : "+v"(x) :: "memory")
#define MFMA16(a, b, c) __builtin_amdgcn_mfma_f32_16x16x32_f16((a), (b), (c), 0, 0, 0)

constexpr int NB = 16, SEQ = 2048, DM = 1024, NT = NB * SEQ, MEML = 256, NTM = NB * MEML, NLAYER = 2;
constexpr int NPJ = 3584;
constexpr int CQ = 0, CK = 384, CV = 768, CG = 1152, CZ = 1536, CXS = 1920, CBM = 2304, CCM = 2560, CXR = 2816, CGT = 3072, CDT = 3328;
constexpr int DIN = 3334, NCH = 16, MAXSLOT = 73728;
constexpr float EPS = 1e-6f;
constexpr int NPH = 14;
constexpr int NPHASES = NLAYER * NPH;

constexpr size_t MiB = (size_t)1 << 20;
constexpr size_t WS_CTL = 0, CTL_ZERO_BYTES = 64 * 1024;
constexpr size_t WS_WIN = 1 * MiB, WS_WOUT = 8 * MiB, WS_WQ = 10 * MiB, WS_WKV = 12 * MiB, WS_WO = 16 * MiB, WS_W13 = 18 * MiB, WS_W2 = 82 * MiB, WS_LRUW = 114 * MiB;
constexpr size_t WS_HB = 115 * MiB;
constexpr size_t WS_R1 = 179 * MiB;
constexpr size_t WS_R2 = 403 * MiB;
constexpr size_t WS_KV = 547 * MiB, WS_MEM16 = 563 * MiB, WS_SSQ = 571 * MiB, WS_MISC = 573 * MiB, WS_END = 577 * MiB;
constexpr size_t OFF_QCA = WS_R1, OFF_OATT = WS_R1 + 64 * MiB, OFF_XP = WS_R1, OFF_HP = WS_R1 + 144 * MiB;
constexpr size_t OFF_OMIX = WS_R2, OFF_RST = WS_R2 + 64 * MiB, OFF_SST = WS_R2 + 88 * MiB, OFF_LSUM = WS_R2 + 136 * MiB, OFF_SDEC = WS_R2 + 137 * MiB, OFF_LCAR = WS_R2 + 138 * MiB, OFF_YP = WS_R2;
constexpr size_t OUT_XTG = 0, OUT_BCN = 24 * MiB, OUT_LAU = 56 * MiB;
constexpr size_t OFF_KB = WS_KV, OFF_VT = WS_KV + 8 * MiB;
constexpr size_t OFF_ROPE = WS_MISC, OFF_MSSQ = WS_MISC + 512 * 1024, OFF_EID = WS_MISC + 768 * 1024, OFF_GATE = WS_MISC + 1024 * 1024, OFF_TSLOT = WS_MISC + 1280 * 1024,
                 OFF_RSTDT = WS_MISC + 1536 * 1024, OFF_SRSTD = WS_MISC + 1664 * 1024, OFF_TILEE = WS_MISC + 2000 * 1024, OFF_STOK = WS_MISC + 2048 * 1024, OFF_RWG = WS_MISC + 2400 * 1024;
constexpr int CW_COUNTS = 64, CW_CURSOR = 192, CW_NTILES = 320, CW_BAR = 4096;

constexpr int LDS_BYTES = 152 * 1024;
constexpr int LDS_MISC = 150 * 1024;

struct Prm { const float* in[32]; float* out; unsigned char* ws; int ph_lo, ph_hi; };

#define XB_TMO      128
#define XB_XCNT(j)  (256  + 64 * (j))
#define XB_XSUB(j)  (1280 + 64 * (j))
#define XB_XGEN(j)  (2304 + 64 * (j))
#define XB_TOP      3328
#define XB_TOPGEN   3392
#define XCD_BAR_WORDS 3456
#define XB_SPIN_CAP (1u << 18)
__device__ __forceinline__ unsigned xb_ld(unsigned* p)              { return __hip_atomic_load(p, __ATOMIC_RELAXED, __HIP_MEMORY_SCOPE_AGENT); }
__device__ __forceinline__ unsigned xb_add(unsigned* p, unsigned v) { return __hip_atomic_fetch_add(p, v, __ATOMIC_RELAXED, __HIP_MEMORY_SCOPE_AGENT); }
__device__ __forceinline__ unsigned xb_xcc_id() { return (unsigned)__builtin_amdgcn_s_getreg((3 << 11) | 20) & 0xFu; }
#define XB_SPIN(cond, bar) do { unsigned _sp = 0; while (cond) { __builtin_amdgcn_s_sleep(1); \
    if ((++_sp & 255u) == 0u) { if (xb_ld(&(bar)[XB_TMO])) break; if (_sp > XB_SPIN_CAP) { atomicAdd(&(bar)[XB_TMO], 1u); break; } } } } while (0)
struct XcdBarrier { unsigned* bar; unsigned x; volatile LAS unsigned* st; };
__device__ __forceinline__ XcdBarrier xcd_barrier_post(unsigned* bar, volatile LAS unsigned* st) {
    XcdBarrier b; b.bar = bar; b.x = xb_xcc_id(); b.st = st;
    if (threadIdx.x == 0) (void)xb_add(&bar[XB_XCNT(b.x)], 1u);
    return b;
}
__device__ __forceinline__ void xcd_barrier_complete(unsigned* bar, unsigned x, unsigned& nloc, unsigned& nx) {
    const unsigned G = gridDim.x * gridDim.y * gridDim.z;
    unsigned sum, cnt, mine, sp = 0u;
    for (;;) {
        sum = 0u; cnt = 0u; mine = 0u;
#pragma unroll
        for (unsigned j = 0; j < 16; ++j) { const unsigned c = xb_ld(&bar[XB_XCNT(j)]); sum += c; cnt += (c > 0u) ? 1u : 0u; mine = (j == x) ? c : mine; }
        if (sum == G) break;
        __builtin_amdgcn_s_sleep(1);
        if ((++sp & 255u) == 0u) { if (xb_ld(&bar[XB_TMO])) break; if (sp > XB_SPIN_CAP) { atomicAdd(&bar[XB_TMO], 1u); break; } }
    }
    nloc = mine > 0u ? mine : 1u; nx = cnt > 0u ? cnt : 1u;
}
__device__ __forceinline__ void xcd_barrier(const XcdBarrier& b) {
    asm volatile("s_waitcnt vmcnt(0)" ::: "memory");
    __syncthreads();
    if (threadIdx.x == 0) {
        unsigned* bar = b.bar;
        __builtin_amdgcn_s_waitcnt(0);
        unsigned nloc = b.st[0], nx = b.st[1];
        if (nloc == 0u) { xcd_barrier_complete(bar, b.x, nloc, nx); b.st[0] = nloc; b.st[1] = nx; }
        const unsigned old = xb_add(&bar[XB_XSUB(b.x)], 1u);
        const unsigned gen = old / nloc;
        if (old + 1u == (gen + 1u) * nloc) {
            __builtin_amdgcn_fence(__ATOMIC_RELEASE, "agent");
            asm volatile("s_waitcnt vmcnt(0)" ::: "memory");
            const unsigned og = xb_add(&bar[XB_TOP], 1u);
            const unsigned tg = og / nx;
            if (og + 1u == (tg + 1u) * nx) xb_add(&bar[XB_TOPGEN], 1u);
            else XB_SPIN(xb_ld(&bar[XB_TOPGEN]) == tg, bar);
            __builtin_amdgcn_fence(__ATOMIC_ACQUIRE, "agent");
            xb_add(&bar[XB_XGEN(b.x)], 1u);
            asm volatile("s_waitcnt vmcnt(0)" ::: "memory");
        } else {
            XB_SPIN(xb_ld(&bar[XB_XGEN(b.x)]) == gen, bar);
            __builtin_amdgcn_fence(__ATOMIC_ACQUIRE, "agent");
            asm volatile("s_waitcnt vmcnt(0)" ::: "memory");
        }
    }
    __syncthreads();
}

__device__ __forceinline__ float wave_sum(float v) {
#pragma unroll
    for (int o = 1; o < 64; o <<= 1) v += __shfl_xor(v, o);
    return v;
}
__device__ __forceinline__ float siluf_(float x) { return x * __builtin_amdgcn_rcpf(1.0f + __expf(-x)); }
__device__ __forceinline__ float softplusf_(float x) { return x > 20.f ? x : log1pf(__expf(x)); }
__device__ __forceinline__ float gelu_tanh_(float x) { const float y = 0.7978845608028654f * (x + 0.044715f * x * x * x); const float t = 1.0f - 2.0f / (__expf(2.0f * y) + 1.0f); return 0.5f * x * (1.0f + t); }
__device__ __forceinline__ h16x8 pack8(const f32x4 a, const f32x4 b) { h16x8 r; r[0] = (h16)a[0]; r[1] = (h16)a[1]; r[2] = (h16)a[2]; r[3] = (h16)a[3]; r[4] = (h16)b[0]; r[5] = (h16)b[1]; r[6] = (h16)b[2]; r[7] = (h16)b[3]; return r; }
__device__ __forceinline__ h16x4 pack4(const f32x4 a) { h16x4 r; r[0] = (h16)a[0]; r[1] = (h16)a[1]; r[2] = (h16)a[2]; r[3] = (h16)a[3]; return r; }
__device__ __forceinline__ h16x8 ldsfrag(LAS const h16* p) { return *(LAS const h16x8*)p; }
__device__ __forceinline__ int kperm32(int k) { return (k & ~31) | (((k >> 2) & 3) << 3) | (((k >> 4) & 1) << 2) | (k & 3); }
__device__ __forceinline__ h16x8 scalefrag(const h16x8 f, float s) { const h16 hs = (h16)s; h16x8 v;
#pragma unroll
    for (int j = 0; j < 8; ++j) v[j] = hs; return f * v; }
__device__ __forceinline__ float row_rstd(const float* ssq16) {
    const f32x4 a = *(const f32x4*)ssq16, b = *(const f32x4*)(ssq16 + 4), c = *(const f32x4*)(ssq16 + 8), d = *(const f32x4*)(ssq16 + 12);
    const float s = ((a[0] + a[1]) + (a[2] + a[3])) + ((b[0] + b[1]) + (b[2] + b[3])) + ((c[0] + c[1]) + (c[2] + c[3])) + ((d[0] + d[1]) + (d[2] + d[3]));
    return 1.0f / sqrtf(s * (1.0f / DM) + EPS);
}

namespace pg8 {
constexpr int BM = 256, BK = 64, HALF = 128, HTB = HALF * BK * 2, STAGE_BYTES = 8 * HTB, NXCD = 8, WGM = 8;
__host__ __device__ __forceinline__ int lds_byte(int r, int c) { const int st = (r >> 4) * 2 + (c >> 5), rr = r & 15, cc = c & 31, ob = rr * 64 + cc * 2; return st * 1024 + (ob ^ (((ob >> 9) & 1) << 5)); }
__host__ __device__ __forceinline__ void stage_rc(int b, int& R, int& C) { const int st = b / 1024, sb = b % 1024, swz = sb ^ (((sb >> 9) & 1) << 5); R = (st >> 1) * 16 + swz / 64; C = (st & 1) * 32 + (swz % 64) / 2; }
__host__ __device__ __forceinline__ int perm32(int rho) { const int n = rho >> 4, i = rho & 15; return 8 * (i >> 2) + 4 * n + (i & 3); }
struct Unit { int pm, pn; };
struct Gemm { const h16* A; const h16* Bt; int lda, ldb, K; const int* rowidx; };
struct StaticOrder {
    int nM, nN, nwg, G, c;
    __device__ void init(int M, int N, int G_, int c_) { nM = M / BM; nN = N / BM; nwg = nM * nN; G = G_; c = c_; }
    __device__ bool next(int i, Unit& u) const {
        const long L = (long)i * G + c; if (L >= nwg) return false;
        int wgid = (int)L; { const int q = nwg / NXCD, r = nwg % NXCD, xcd = wgid % NXCD, off = wgid / NXCD; wgid = (xcd < r ? xcd * (q + 1) : r * (q + 1) + (xcd - r) * q) + off; }
        const int nig = WGM * nN, gid = wgid / nig, fm = gid * WGM, gsz = (nM - fm) < WGM ? (nM - fm) : WGM;
        u.pm = fm + ((wgid % nig) % gsz); u.pn = (wgid % nig) / gsz; return true;
    }
};
struct GroupOrder {
    const int* tile_e; int ntiles, G, vcu;
    __device__ bool next(int i, Unit& u) const {
        const int L = i * G + vcu, tile = L >> 2; if (tile >= ntiles) return false;
        u.pm = tile; u.pn = __builtin_amdgcn_readfirstlane(tile_e[tile]) * 4 + (L & 3); return true;
    }
};

struct EpiScale16 {
    static constexpr bool PERM = true;
    h16* O; int ldc; const float* ssq;
    __device__ __forceinline__ void operator()(const f32x4 (&acc)[2][2][4][2], const Unit& u, int wr, int wc, int fr, int fq) const {
        const int row0 = u.pm * BM + wr * 64 + fr, col0 = u.pn * BM + wc * 32 + 8 * fq;
#pragma unroll
        for (int ai = 0; ai < 2; ++ai)
#pragma unroll
            for (int m = 0; m < 4; ++m) { const int row = row0 + ai * HALF + m * 16; const float rs = row_rstd(ssq + (size_t)row * 16); h16* rowp = O + (size_t)row * ldc + col0;
#pragma unroll
                for (int bj = 0; bj < 2; ++bj) *(h16x8*)(rowp + bj * HALF) = pack8(acc[ai][bj][m][0] * rs, acc[ai][bj][m][1] * rs); }
    }
};
struct EpiScale16C {
    static constexpr bool PERM = true;
    h16* O; int ldc; const float* rstd;
    __device__ __forceinline__ void operator()(const f32x4 (&acc)[2][2][4][2], const Unit& u, int wr, int wc, int fr, int fq) const {
        const int row0 = u.pm * BM + wr * 64 + fr, col0 = u.pn * BM + wc * 32 + 8 * fq;
        float rs[2][4];
#pragma unroll
        for (int ai = 0; ai < 2; ++ai)
#pragma unroll
            for (int m = 0; m < 4; ++m) rs[ai][m] = rstd[row0 + ai * HALF + m * 16];
#pragma unroll
        for (int ai = 0; ai < 2; ++ai)
#pragma unroll
            for (int m = 0; m < 4; ++m) { h16* rowp = O + (size_t)(row0 + ai * HALF + m * 16) * ldc + col0;
#pragma unroll
                for (int bj = 0; bj < 2; ++bj) *(h16x8*)(rowp + bj * HALF) = pack8(acc[ai][bj][m][0] * rs[ai][m], acc[ai][bj][m][1] * rs[ai][m]); }
    }
};
struct EpiKV {
    static constexpr bool PERM = true;
    h16* KB; h16* VT; const float* ssq;
    __device__ __forceinline__ void operator()(const f32x4 (&acc)[2][2][4][2], const Unit& u, int wr, int wc, int fr, int fq) const {
        const int row0 = u.pm * BM + wr * 64 + fr;
#pragma unroll
        for (int ai = 0; ai < 2; ++ai)
#pragma unroll
            for (int m = 0; m < 4; ++m) { const int row = row0 + ai * HALF + m * 16; const float rs = row_rstd(ssq + (size_t)row * 16);
                h16x8 pk[2];
#pragma unroll
                for (int bj = 0; bj < 2; ++bj) pk[bj] = pack8(acc[ai][bj][m][0] * rs, acc[ai][bj][m][1] * rs);
                if (u.pn < 4) { h16* rowp = KB + (size_t)row * DM + u.pn * BM + wc * 32 + 8 * fq;
                    *(h16x8*)rowp = pk[0]; *(h16x8*)(rowp + HALF) = pk[1];
                } else { const int b = row >> 8, k0 = row & 255, hd = u.pn - 4;
                    const int key = (k0 & ~31) | (((k0 >> 2) & 3) << 3) | (((k0 >> 4) & 1) << 2) | (k0 & 3);
                    h16* base = VT + ((size_t)(b * 4 + hd) * 256 + wc * 32 + 8 * fq) * 256 + key;
#pragma unroll
                    for (int bj = 0; bj < 2; ++bj)
#pragma unroll
                        for (int j = 0; j < 8; ++j) base[(bj * HALF + j) * 256] = pk[bj][j]; }
                PIN();
            }
    }
};
struct EpiResid {
    static constexpr bool PERM = true;
    h16* hb; float* ssq;
    __device__ __forceinline__ void operator()(const f32x4 (&acc)[2][2][4][2], const Unit& u, int wr, int wc, int fr, int fq) const {
        const int row0 = u.pm * BM + wr * 64 + fr, col0 = u.pn * BM + wc * 32 + 8 * fq;
#pragma unroll
        for (int ai = 0; ai < 2; ++ai)
#pragma unroll
            for (int m = 0; m < 4; ++m) { const int row = row0 + ai * HALF + m * 16; h16* rowp = hb + (size_t)row * DM + col0; float s = 0.f;
#pragma unroll
                for (int bj = 0; bj < 2; ++bj) { const h16x8 bv = *(const h16x8*)(rowp + bj * HALF); f32x4 v0, v1;
#pragma unroll
                    for (int e = 0; e < 4; ++e) { v0[e] = (float)bv[e] + acc[ai][bj][m][0][e]; v1[e] = (float)bv[4 + e] + acc[ai][bj][m][1][e]; }
                    const h16x8 o = pack8(v0, v1); *(h16x8*)(rowp + bj * HALF) = o;
#pragma unroll
                    for (int e = 0; e < 8; ++e) { const float q = (float)o[e]; s += q * q; } }
                s += __shfl_xor(s, 16); s += __shfl_xor(s, 32);
                if (fq == 0) ssq[(size_t)row * 16 + u.pn * 4 + wc] = s; }
    }
};
struct EpiGated {
    static constexpr bool PERM = true;
    h16* O; const float* srstd;
    __device__ __forceinline__ void operator()(const f32x4 (&acc)[2][2][4][2], const Unit& u, int wr, int wc, int fr, int fq) const {
        const int row0 = u.pm * BM + wr * 64 + fr, col0 = (u.pn & 3) * HALF + wc * 32 + 8 * fq;
#pragma unroll
        for (int ai = 0; ai < 2; ++ai)
#pragma unroll
            for (int m = 0; m < 4; ++m) { const int row = row0 + ai * HALF + m * 16; const float rs = srstd[row]; f32x4 o[2];
#pragma unroll
                for (int n = 0; n < 2; ++n)
#pragma unroll
                    for (int j = 0; j < 4; ++j) { const float a = acc[ai][0][m][n][j] * rs, b = acc[ai][1][m][n][j] * rs; o[n][j] = siluf_(a) * b; }
                *(h16x8*)(O + (size_t)row * 512 + col0) = pack8(o[0], o[1]); }
    }
};
struct EpiPlain16 {
    static constexpr bool PERM = true;
    h16* O;
    __device__ __forceinline__ void operator()(const f32x4 (&acc)[2][2][4][2], const Unit& u, int wr, int wc, int fr, int fq) const {
        const int row0 = u.pm * BM + wr * 64 + fr, col0 = (u.pn & 3) * BM + wc * 32 + 8 * fq;
#pragma unroll
        for (int ai = 0; ai < 2; ++ai)
#pragma unroll
            for (int m = 0; m < 4; ++m) { h16* rowp = O + (size_t)(row0 + ai * HALF + m * 16) * DM + col0;
#pragma unroll
                for (int bj = 0; bj < 2; ++bj) *(h16x8*)(rowp + bj * HALF) = pack8(acc[ai][bj][m][0], acc[ai][bj][m][1]); }
    }
};

template <class Epi, class Sched, bool GATHER = false>
__device__ __forceinline__ void gemm_phase(LAS unsigned char* lds, const int tid, const Gemm g, const Sched& S, const Epi& E) {
    const int wid = __builtin_amdgcn_readfirstlane(tid >> 6), lane = tid & 63, wr = wid >> 2, wc = wid & 3, fr = lane & 15, fq = lane >> 4;
    const int K = g.K, nt = K / BK;
    unsigned voffA[2], voffB[2];
#pragma unroll
    for (int i = 0; i < 2; ++i) { int R, C; stage_rc(tid * 16 + i * 8192, R, C); const int Rb = Epi::PERM ? ((R & ~31) + perm32(R & 31)) : R;
        voffA[i] = (unsigned)(R * g.lda + C) * 2u; voffB[i] = (unsigned)(Rb * g.ldb + C) * 2u; }
    const size_t kstep = (size_t)(BK * 2);
    const size_t hstepA = (size_t)HALF * g.lda * 2, hstepB = (size_t)HALF * g.ldb * 2;
    const size_t tstepA = 2 * hstepA, tstepB = 2 * hstepB;
    const unsigned ldsw = (unsigned)wid * 1024u;
    const int aoff = lds_byte(wr * 64 + fr, fq * 8), boff = lds_byte(wc * 32 + fr, fq * 8);
#define PG8_SA(b, h) (((b) * 2 + (h)) * HTB)
#define PG8_SB(b, h) ((4 + (b) * 2 + (h)) * HTB)
#define PG8_STAGE(bufoff, gbase, voff) do { _Pragma("unroll") for (int _i = 0; _i < 2; ++_i) \
        __builtin_amdgcn_global_load_lds((const unsigned*)((const char*)(gbase) + (voff)[_i]), (LAS unsigned*)(lds + (bufoff) + ldsw + _i * 8192), 16, 0, 0); } while (0)
    unsigned coff[2], noff[2], cbyte[2];
    if constexpr (GATHER) {
#pragma unroll
        for (int i = 0; i < 2; ++i) { int R_, C_; stage_rc(tid * 16 + i * 8192, R_, C_); cbyte[i] = (unsigned)(C_ * 2); } }
#define PG8_GOFF(u_, o_) do { _Pragma("unroll") for (int _i = 0; _i < 2; ++_i) { int R_, C_; stage_rc(tid * 16 + _i * 8192, R_, C_); \
        o_[_i] = (unsigned)g.rowidx[(u_).pm * BM + R_] | ((unsigned)g.rowidx[(u_).pm * BM + HALF + R_] << 16); } } while (0)
#define PG8_STAGEA(bufoff, gbase, h, sel) do { if constexpr (GATHER) { _Pragma("unroll") for (int _i = 0; _i < 2; ++_i) { const unsigned pk_ = (sel) ? noff[_i] : coff[_i]; \
        __builtin_amdgcn_global_load_lds((const unsigned*)((const char*)(gbase) + (((pk_ >> (16 * (h))) & 0xffffu) * (unsigned)(g.lda * 2) + cbyte[_i])), (LAS unsigned*)(lds + (bufoff) + ldsw + _i * 8192), 16, 0, 0); } } \
        else { PG8_STAGE(bufoff, (gbase) + ((h) ? hstepA : 0), voffA); } } while (0)
#define PG8_LDA(dst, b, h) do { _Pragma("unroll") for (int m = 0; m < 4; ++m) _Pragma("unroll") for (int k = 0; k < 2; ++k) dst[m][k] = *(const LAS h16x8*)(lds + PG8_SA(b, h) + aoff + m * 2048 + k * 1024); } while (0)
#define PG8_LDB(dst, b, h) do { _Pragma("unroll") for (int n = 0; n < 2; ++n) _Pragma("unroll") for (int k = 0; k < 2; ++k) dst[n][k] = *(const LAS h16x8*)(lds + PG8_SB(b, h) + boff + n * 2048 + k * 1024); } while (0)
#define PG8_MMA(ai, bj, At, Bt) do { __builtin_amdgcn_s_setprio(1); _Pragma("unroll") for (int m = 0; m < 4; ++m) _Pragma("unroll") for (int n = 0; n < 2; ++n) _Pragma("unroll") for (int k = 0; k < 2; ++k) \
        acc[ai][bj][m][n] = __builtin_amdgcn_mfma_f32_16x16x32_f16(Bt[n][k], At[m][k], acc[ai][bj][m][n], 0, 0, 0); __builtin_amdgcn_s_setprio(0); } while (0)
#define PG8_WAIT_V(n) asm volatile("s_waitcnt vmcnt(" #n ")" ::: "memory")
#define PG8_WAIT_L(n) asm volatile("s_waitcnt lgkmcnt(" #n ")" ::: "memory")
#define PG8_BAR __builtin_amdgcn_s_barrier()
#define PG8_SCHED __builtin_amdgcn_sched_barrier(0)
    Unit cur, nxt; int ui = 0;
    if (!S.next(0, cur)) return;
    f32x4 acc[2][2][4][2];
#pragma unroll
    for (int a = 0; a < 2; ++a)
#pragma unroll
        for (int b = 0; b < 2; ++b)
#pragma unroll
            for (int m = 0; m < 4; ++m)
#pragma unroll
                for (int n = 0; n < 2; ++n) acc[a][b][m][n] = (f32x4){0.f, 0.f, 0.f, 0.f};
    h16x8 At[4][2], B0[2][2], B1[2][2];
    const char* cA = (const char*)g.A + (GATHER ? (size_t)0 : (size_t)cur.pm * tstepA); const char* cB = (const char*)g.Bt + (size_t)cur.pn * tstepB;
    if constexpr (GATHER) { PG8_GOFF(cur, coff); noff[0] = coff[0]; noff[1] = coff[1]; }
    PG8_STAGE(PG8_SB(0, 0), cB, voffB); PG8_STAGE(PG8_SB(0, 1), cB + hstepB, voffB); PG8_STAGEA(PG8_SA(0, 0), cA, 0, false); PG8_STAGEA(PG8_SA(0, 1), cA, 1, false);
    if (wr == 1) PG8_BAR;
    PG8_WAIT_V(2); PG8_BAR;
    PG8_STAGE(PG8_SB(1, 0), cB + kstep, voffB); PG8_STAGEA(PG8_SA(1, 0), cA + kstep, 0, false); PG8_STAGE(PG8_SB(1, 1), cB + hstepB + kstep, voffB);
    PG8_WAIT_V(6); PG8_BAR;
    for (;;) {
        const bool has_next = S.next(ui + 1, nxt);
        const char* nA = (has_next && !GATHER) ? (const char*)g.A + (size_t)nxt.pm * tstepA : cA; const char* nB = has_next ? (const char*)g.Bt + (size_t)nxt.pn * tstepB : cB;
        if constexpr (GATHER) { if (has_next) PG8_GOFF(nxt, noff); }
        for (int t = 0; t < nt; t += 2) {
            const bool last = (t == nt - 2);
            const char* a1 = cA + (size_t)(t + 1) * kstep;
            const char* a2 = last ? nA : cA + (size_t)(t + 2) * kstep; const char* b2 = last ? nB : cB + (size_t)(t + 2) * kstep;
            const char* a3 = a2 + kstep; const char* b3 = b2 + kstep;
            PG8_LDB(B0, 0, 0); PG8_LDB(B1, 0, 1); PG8_SCHED; PG8_LDA(At, 0, 0); PG8_STAGEA(PG8_SA(1, 1), a1, 1, false);
            PG8_WAIT_V(8); PG8_WAIT_L(0); PG8_BAR; PG8_MMA(0, 0, At, B0); PG8_MMA(0, 1, At, B1); PG8_BAR; PG8_SCHED;
            PG8_LDA(At, 0, 1); PG8_STAGE(PG8_SB(0, 0), b2, voffB); PG8_STAGE(PG8_SB(0, 1), b2 + hstepB, voffB); PG8_STAGEA(PG8_SA(0, 0), a2, 0, last);
            PG8_WAIT_V(8); PG8_WAIT_L(0); PG8_BAR; PG8_MMA(1, 0, At, B0); PG8_MMA(1, 1, At, B1); PG8_BAR; PG8_SCHED;
            PG8_LDB(B0, 1, 0); PG8_LDB(B1, 1, 1); PG8_SCHED; PG8_LDA(At, 1, 0); PG8_STAGEA(PG8_SA(0, 1), a2, 1, last);
            PG8_WAIT_V(8); PG8_WAIT_L(0); PG8_BAR; PG8_MMA(0, 0, At, B0); PG8_MMA(0, 1, At, B1); PG8_BAR; PG8_SCHED;
            PG8_LDA(At, 1, 1); PG8_STAGE(PG8_SB(1, 0), b3, voffB); PG8_STAGE(PG8_SB(1, 1), b3 + hstepB, voffB); PG8_STAGEA(PG8_SA(1, 0), a3, 0, last);
            PG8_WAIT_V(8); PG8_WAIT_L(0); PG8_BAR; PG8_MMA(1, 0, At, B0); PG8_MMA(1, 1, At, B1); PG8_BAR; PG8_SCHED;
        }
        if (wr == 0) PG8_BAR;
        E(acc, cur, wr, wc, fr, fq);
        if (!has_next) break;
#pragma unroll
        for (int a = 0; a < 2; ++a)
#pragma unroll
            for (int b = 0; b < 2; ++b)
#pragma unroll
                for (int m = 0; m < 4; ++m)
#pragma unroll
                    for (int n = 0; n < 2; ++n) acc[a][b][m][n] = (f32x4){0.f, 0.f, 0.f, 0.f};
        cur = nxt; cA = nA; cB = nB; ++ui;
        if constexpr (GATHER) { coff[0] = noff[0]; coff[1] = noff[1]; }
        if (wr == 1) PG8_BAR;
    }
    PG8_WAIT_V(0);
    PG8_BAR;
#undef PG8_SA
#undef PG8_SB
#undef PG8_STAGE
#undef PG8_LDA
#undef PG8_GOFF
#undef PG8_STAGEA
#undef PG8_LDB
#undef PG8_MMA
#undef PG8_WAIT_V
#undef PG8_WAIT_L
#undef PG8_BAR
#undef PG8_SCHED
}
}

struct Frame {
    LAS unsigned char* lds;
    GAS unsigned char* ws;
    volatile LAS unsigned long long* ptab;
    float* out;
    int tid, lane, wave, G, vcu;
};
#define WSP(T, off) ((T*)(GAS T*)(F.ws + (off)))
__device__ __forceinline__ const float* inptr(const Frame& F, int i) {
    const unsigned long long v = F.ptab[i];
    const unsigned lo = __builtin_amdgcn_readfirstlane((unsigned)v), hi = __builtin_amdgcn_readfirstlane((unsigned)(v >> 32));
    return (const float*)(GAS const float*)(((unsigned long long)hi << 32) | lo);
}
__device__ __forceinline__ void launder(Frame& F) {
    int wv = F.wave; asm volatile("" : "+s"(wv)); F.wave = wv;
    unsigned z = 0u; asm volatile("" : "+v"(z));
    int t = wv * 64 + (int)__builtin_amdgcn_mbcnt_hi(~0u, __builtin_amdgcn_mbcnt_lo(~0u, z)); F.tid = t; F.lane = t & 63;
    const unsigned long long w = (unsigned long long)F.ws; unsigned wl = __builtin_amdgcn_readfirstlane((unsigned)w), wh = __builtin_amdgcn_readfirstlane((unsigned)(w >> 32));
    asm volatile("" : "+s"(wl), "+s"(wh)); F.ws = (GAS unsigned char*)(((unsigned long long)wh << 32) | wl);
    unsigned lo = __builtin_amdgcn_readfirstlane((unsigned)(uintptr_t)F.lds); asm volatile("" : "+s"(lo)); F.lds = (LAS unsigned char*)(uintptr_t)lo;
    int v = __builtin_amdgcn_readfirstlane(F.vcu); asm volatile("" : "+s"(v)); F.vcu = v;
}

struct TrItem { const float* W; const float* g; h16* Wt; int ldw, sc, nvalid, ldt, d0, k0, vw; float mul; };
__device__ __forceinline__ void tr_describe(const Frame& F, GAS unsigned char* wsb_, int l, int it, TrItem& d) {
    unsigned char* wsb = (unsigned char*)wsb_;
    int r = it; d.g = nullptr; d.mul = 1.f; d.nvalid = 64; d.vw = 4; d.ldt = DM; d.ldw = DM;
    if (r < 896) { const int d0 = 64 * (r % 56); d.W = inptr(F, 3) + (size_t)l * DM * DIN; d.ldw = DIN; d.g = inptr(F, 2) + l * DM; d.Wt = (h16*)(wsb + WS_WIN); d.d0 = d0; d.k0 = 64 * (r / 56); d.vw = 2;
        if (d0 < 2816) d.sc = d0; else if (d0 < 3328) d.sc = d0 + 6; else if (d0 == 3328) { d.sc = 2816; d.nvalid = 6; } else { d.sc = 0; d.nvalid = 0; } return; } r -= 896;
    if (r < 256) { d.W = inptr(F, 4) + (size_t)l * DM * DM; d.Wt = (h16*)(wsb + WS_WOUT); d.d0 = d.sc = 64 * (r % 16); d.k0 = 64 * (r / 16); return; } r -= 256;
    if (r < 256) { d.W = inptr(F, 20) + (size_t)l * DM * DM; d.g = inptr(F, 18) + l * DM; d.mul = 0.0625f; d.Wt = (h16*)(wsb + WS_WQ); d.d0 = d.sc = 64 * (r % 16); d.k0 = 64 * (r / 16); return; } r -= 256;
    if (r < 512) { d.W = inptr(F, 21) + (size_t)l * DM * 2048; d.ldw = 2048; d.g = inptr(F, 19) + l * DM; d.Wt = (h16*)(wsb + WS_WKV); d.d0 = d.sc = 64 * (r % 32); d.k0 = 64 * (r / 32); return; } r -= 512;
    if (r < 256) { d.W = inptr(F, 22) + (size_t)l * DM * DM; d.Wt = (h16*)(wsb + WS_WO); d.d0 = d.sc = 64 * (r % 16); d.k0 = 64 * (r / 16); return; } r -= 256;
    if (r < 8192) { const int e = r / 256, q = r % 256, d0 = 64 * (q % 16), grp = d0 >> 8, rr = d0 & 255;
        d.W = (rr < 128 ? inptr(F, 28) : inptr(F, 29)) + (size_t)(l * 32 + e) * DM * 512; d.ldw = 512; d.sc = grp * 128 + (rr & 127); d.g = inptr(F, 23) + l * DM; d.Wt = (h16*)(wsb + WS_W13) + (size_t)e * DM * DM; d.d0 = d0; d.k0 = 64 * (q / 16); return; } r -= 8192;
    if (r < 4096) { const int e = r / 128, q = r % 128; d.W = inptr(F, 30) + (size_t)(l * 32 + e) * 512 * DM; d.Wt = (h16*)(wsb + WS_W2) + (size_t)e * DM * 512; d.ldt = 512; d.d0 = d.sc = 64 * (q % 16); d.k0 = 64 * (q / 16); return; } r -= 4096;
    { const int blk = r & 3, gate = (r >> 2) & 1, dir = r >> 3; d.W = (gate ? inptr(F, 16) : inptr(F, 14)) + (size_t)((l * 2 + dir) * 4 + blk) * 4096; d.ldw = 64; d.Wt = (h16*)(wsb + WS_LRUW) + (size_t)((dir * 2 + gate) * 4 + blk) * 4096; d.ldt = 64; d.d0 = d.sc = 0; d.k0 = 0; }
}
__device__ __forceinline__ void tr_load(const TrItem& d, int lane, f32x4 (&v)[16]) {
    if (d.vw == 4) { const int col = 4 * (lane & 15); const float* src = d.W + (size_t)(d.k0 + (lane >> 4)) * d.ldw + d.sc + col; const bool ok = col < d.nvalid;
#pragma unroll
        for (int i = 0; i < 16; ++i) v[i] = ok ? *(const f32x4*)(src + (size_t)(4 * i) * d.ldw) : (f32x4){0.f, 0.f, 0.f, 0.f};
    } else { const int col = 2 * (lane & 31); const float* src = d.W + (size_t)(d.k0 + (lane >> 5)) * d.ldw + d.sc + col; const bool ok = col < d.nvalid;
#pragma unroll
        for (int i = 0; i < 16; ++i) { const f32x2 a = ok ? *(const f32x2*)(src + (size_t)(4 * i) * d.ldw) : (f32x2){0.f, 0.f}, c = ok ? *(const f32x2*)(src + (size_t)(4 * i + 2) * d.ldw) : (f32x2){0.f, 0.f}; v[i] = (f32x4){a[0], a[1], c[0], c[1]}; } }
}
__device__ __forceinline__ void tr_to_lds(const TrItem& d, int lane, const f32x4 (&v)[16], LAS float* scr) {
    if (d.vw == 4) { LAS float* q = scr + (lane >> 4) * 65 + 4 * (lane & 15);
#pragma unroll
        for (int i = 0; i < 16; ++i) { q[(4 * i) * 65 + 0] = v[i][0]; q[(4 * i) * 65 + 1] = v[i][1]; q[(4 * i) * 65 + 2] = v[i][2]; q[(4 * i) * 65 + 3] = v[i][3]; }
    } else { LAS float* q = scr + (lane >> 5) * 65 + 2 * (lane & 31);
#pragma unroll
        for (int i = 0; i < 16; ++i) { q[(4 * i) * 65 + 0] = v[i][0]; q[(4 * i) * 65 + 1] = v[i][1]; q[(4 * i + 2) * 65 + 0] = v[i][2]; q[(4 * i + 2) * 65 + 1] = v[i][3]; } }
}
__device__ __forceinline__ void tr_from_lds(const TrItem& d, int lane, LAS const float* scr) {
    const int c = lane & 7; float gs[8];
    if (d.g) { const f32x4 g0 = *(const f32x4*)(d.g + d.k0 + 8 * c), g1 = *(const f32x4*)(d.g + d.k0 + 8 * c + 4);
        gs[0] = g0[0] * d.mul; gs[1] = g0[1] * d.mul; gs[2] = g0[2] * d.mul; gs[3] = g0[3] * d.mul; gs[4] = g1[0] * d.mul; gs[5] = g1[1] * d.mul; gs[6] = g1[2] * d.mul; gs[7] = g1[3] * d.mul;
    } else {
#pragma unroll
        for (int e = 0; e < 8; ++e) gs[e] = d.mul; }
#pragma unroll
    for (int j = 0; j < 8; ++j) { const int nn = (lane >> 3) + 8 * j; LAS const float* q = scr + (8 * c) * 65 + nn; h16x8 o;
#pragma unroll
        for (int e = 0; e < 8; ++e) o[e] = (h16)(q[e * 65] * gs[e]);
        *(h16x8*)(d.Wt + (size_t)(d.d0 + nn) * d.ldt + d.k0 + 8 * c) = o; }
}
__device__ __forceinline__ void phase_convert(const Frame& F, const Prm& p, int l) {
    LAS float* scr = (LAS float*)(F.lds + F.wave * 16640);
    const int gw = F.vcu * 8 + F.wave, NGW = F.G * 8;
    constexpr int NITEMS = 896 + 256 + 256 + 512 + 256 + 8192 + 4096 + 16;
    { TrItem cur, nxt; f32x4 v[16]; int it = gw;
        if (it < NITEMS) { tr_describe(F, F.ws, l, it, cur); tr_load(cur, F.lane, v); }
        while (it < NITEMS) { const int itn = it + NGW; const bool hn = itn < NITEMS;
            tr_to_lds(cur, F.lane, v, scr);
            if (hn) { tr_describe(F, F.ws, l, itn, nxt); tr_load(nxt, F.lane, v); }
            asm volatile("s_waitcnt lgkmcnt(0)" ::: "memory");
            tr_from_lds(cur, F.lane, scr);
            asm volatile("s_waitcnt lgkmcnt(0)" ::: "memory");
            cur = nxt; it = itn; } }
    {
        const float* gm = inptr(F, 23) + l * DM; const float* wg = inptr(F, 24) + (size_t)l * DM * 4; const float* we = inptr(F, 26) + (size_t)l * DM * 32; h16* rwg = WSP(h16, OFF_RWG);
        for (int i = F.vcu * 512 + F.tid; i < 36 * DM; i += 256 * 512) { const int k = i / 36, j = i % 36; const float wv = gm[k] * (j < 4 ? wg[k * 4 + j] : we[k * 32 + (j - 4)]) * 1024.0f;
            const h16 hi = (h16)wv; rwg[(size_t)j * 1032 + k] = hi; rwg[(size_t)(36 + j) * 1032 + k] = (h16)(wv - (float)hi); } }
    if (l == 0) {
        for (int m = gw; m < NT + NTM; m += NGW) {
            const bool isx = m < NT; const int row = isx ? m : m - NT;
            const float* src = (isx ? inptr(F, 0) : inptr(F, 1)) + (size_t)row * DM; h16* dst = (isx ? WSP(h16, WS_HB) : WSP(h16, WS_MEM16)) + (size_t)row * DM;
            float* sq = (isx ? WSP(float, WS_SSQ) : WSP(float, OFF_MSSQ)) + (size_t)row * 16;
            float s = 0.f;
#pragma unroll
            for (int j = 0; j < 4; ++j) { const f32x4 v = *(const f32x4*)(src + 4 * F.lane + 256 * j); *(h16x4*)(dst + 4 * F.lane + 256 * j) = pack4(v); s += (v[0] * v[0] + v[1] * v[1]) + (v[2] * v[2] + v[3] * v[3]); }
            s = wave_sum(s);
            if (F.lane < 16) sq[F.lane] = (F.lane == 0) ? s : 0.f;
            if (isx && F.lane == 0) WSP(float, OFF_RSTDT)[row] = 1.0f / sqrtf(s * (1.0f / DM) + EPS);
        }
        float* rope = WSP(float, OFF_ROPE);
        for (int i = F.vcu * 512 + F.tid; i < SEQ * 32; i += F.G * 512) {
            const int pos = i >> 5, fi = i & 31; double th = 1.0;
            for (int k = 0; k < fi; ++k) th *= 0.74989420933245582730;
            const double rev = (double)pos * th * 0.15915494309189533577;
            const double fr = rev - floor(rev);
            const double r = (fr - 0.5) * 6.28318530717958647692;
            const double r2 = r * r; double sn = 1.0, cs = 1.0;
            for (int k = 14; k >= 1; --k) { sn = 1.0 - r2 / (double)((2 * k) * (2 * k + 1)) * sn; cs = 1.0 - r2 / (double)((2 * k - 1) * (2 * k)) * cs; }
            sn *= r;
            rope[pos * 64 + fi] = (float)(-cs); rope[pos * 64 + 32 + fi] = (float)(-sn);
        }
    }
}

template <bool SILU>
__device__ __forceinline__ void conv_rows8(const h16* projcol, long tbase, int n, int r0, const float* cw, int cdim, const float* cb, h16x8 (&out)[8]) {
    f32x4 w[4][2];
#pragma unroll
    for (int k = 0; k < 4; ++k) { w[k][0] = *(const f32x4*)(cw + k * cdim); w[k][1] = *(const f32x4*)(cw + k * cdim + 4); }
    const f32x4 b0 = *(const f32x4*)cb, b1 = *(const f32x4*)(cb + 4);
    h16x8 x[11];
#pragma unroll
    for (int i = 0; i < 11; ++i) { const int pos = n * 128 + r0 - 2 + i; h16x8 z;
#pragma unroll
        for (int e = 0; e < 8; ++e) z[e] = (h16)0.f;
        x[i] = (pos >= 0 && pos < SEQ) ? *(const h16x8*)(projcol + (size_t)(tbase + r0 - 2 + i) * NPJ) : z; }
#pragma unroll
    for (int r = 0; r < 8; ++r) {
#pragma unroll
        for (int e = 0; e < 8; ++e) { float a = e < 4 ? b0[e] : b1[e - 4];
#pragma unroll
            for (int k = 0; k < 4; ++k) a += (e < 4 ? w[k][0][e] : w[k][1][e - 4]) * (float)x[r + k][e];
            out[r][e] = (h16)(SILU ? siluf_(a) : a); } }
}
__device__ __forceinline__ h16x8 col_of(const h16x8 (&o)[8], int e) { h16x8 c; c[0] = o[0][e]; c[1] = o[1][e]; c[2] = o[2][e]; c[3] = o[3][e]; c[4] = o[4][e]; c[5] = o[5][e]; c[6] = o[6][e]; c[7] = o[7][e]; return c; }

__device__ __forceinline__ void ret_scan_unit(const Frame& F, int u) {
    const int h = u % 6, b = (u / 6) % NB, dir = u / (6 * NB);
    const float gC = exp2f(128.0f * log1pf(-exp2f(-5.0f - (float)h)) * 1.4426950408889634f);
    h16* base = WSP(h16, OFF_RST) + ((size_t)((dir * NB + b) * NCH) * 6 + h) * 4096 + F.tid * 8;
    float acc[8];
#pragma unroll
    for (int e = 0; e < 8; ++e) acc[e] = 0.f;
#pragma unroll 1
    for (int half = 0; half < 2; ++half) { h16x8 sv[8];
#pragma unroll
        for (int i = 0; i < 8; ++i) { const int ii = 8 * half + i, n = dir == 0 ? ii : NCH - 1 - ii; sv[i] = *(const h16x8*)(base + (size_t)n * 6 * 4096); }
#pragma unroll
        for (int i = 0; i < 8; ++i) { const int ii = 8 * half + i, n = dir == 0 ? ii : NCH - 1 - ii; h16x8 o;
#pragma unroll
            for (int e = 0; e < 8; ++e) { o[e] = (h16)acc[e]; acc[e] = acc[e] * gC + (float)sv[i][e]; }
            *(h16x8*)(base + (size_t)n * 6 * 4096) = o; } }
}
#define RET_BAR() do { asm volatile("s_waitcnt lgkmcnt(0)" ::: "memory"); __builtin_amdgcn_s_barrier(); asm volatile("" ::: "memory"); } while (0)
__device__ __forceinline__ void ret_states_block(const Frame& F, int bn) {
    const int n = bn % NCH, b = bn / NCH; const long t0 = (long)b * SEQ + n * 128;
    const int r = F.tid >> 2, c = F.tid & 3;
    const h16* rowp = WSP(const h16, WS_R1) + (size_t)(t0 + r) * NPJ; const float* cs = WSP(const float, OFF_ROPE) + (size_t)(n * 128 + r) * 64 + 8 * c;
    const f32x4 c0 = *(const f32x4*)cs, c1 = *(const f32x4*)(cs + 4), s0 = *(const f32x4*)(cs + 32), s1 = *(const f32x4*)(cs + 36);
    const int dir = F.wave >> 2, dt = F.wave & 3, fr = F.lane & 15, fq = F.lane >> 4;
    h16x8 k1, k2, v1, v2;
#define RS_LOAD(hh) do { k1 = *(const h16x8*)(rowp + CK + (hh) * 64 + 8 * c); k2 = *(const h16x8*)(rowp + CK + (hh) * 64 + 32 + 8 * c); v1 = *(const h16x8*)(rowp + CV + (hh) * 64 + 16 * c); v2 = *(const h16x8*)(rowp + CV + (hh) * 64 + 16 * c + 8); } while (0)
    RS_LOAD(0);
#pragma unroll 1
    for (int h = 0; h < 6; ++h) {
        LAS h16* KT = (LAS h16*)(F.lds + (h & 1) * 34816); LAS h16* VT = KT + 64 * 136;
#pragma unroll
        for (int e = 0; e < 8; ++e) { const float x1 = (float)k1[e], x2 = (float)k2[e], co = e < 4 ? c0[e] : c1[e - 4], si = e < 4 ? s0[e] : s1[e - 4];
            KT[(8 * c + e) * 136 + r] = (h16)((x1 * co - x2 * si) * 0.125f); KT[(32 + 8 * c + e) * 136 + r] = (h16)((x1 * si + x2 * co) * 0.125f); }
#pragma unroll
        for (int e = 0; e < 8; ++e) { VT[(16 * c + e) * 136 + r] = v1[e]; VT[(16 * c + 8 + e) * 136 + r] = v2[e]; }
        if (h < 5) RS_LOAD(h + 1);
        RET_BAR();
        const float l2g = log1pf(-exp2f(-5.0f - (float)h)) * 1.4426950408889634f;
        h16x8 xw[4];
#pragma unroll
        for (int ks = 0; ks < 4; ++ks) { const h16x8 f = ldsfrag(KT + (16 * dt + fr) * 136 + 32 * ks + 8 * fq); h16x8 wv;
#pragma unroll
            for (int jj = 0; jj < 8; ++jj) { const int j = 32 * ks + 8 * fq + jj; wv[jj] = (h16)exp2f(l2g * (float)(dir == 0 ? 127 - j : j)); }
            xw[ks] = f * wv; }
        h16* rst = WSP(h16, OFF_RST) + ((size_t)((dir * NB + b) * NCH + n) * 6 + h) * 4096;
#pragma unroll
        for (int et = 0; et < 4; ++et) { f32x4 acc = {0.f, 0.f, 0.f, 0.f};
#pragma unroll
            for (int ks = 0; ks < 4; ++ks) acc = MFMA16(xw[ks], ldsfrag(VT + (16 * et + fr) * 136 + 32 * ks + 8 * fq), acc);
            *(h16x4*)(rst + (16 * et + fr) * 64 + 16 * dt + 4 * fq) = pack4(acc); }
    }
#undef RS_LOAD
    __syncthreads();
}
__device__ __forceinline__ void ret_out_block(const Frame& F, int bn) {
    const int n = bn % NCH, b = bn / NCH; const long t0 = (long)b * SEQ + n * 128;
    const int r = F.tid >> 2, c = F.tid & 3, rp = kperm32(r), er = F.tid >> 3, d0 = (F.tid & 7) * 8;
    const h16* rowp = WSP(const h16, WS_R1) + (size_t)(t0 + r) * NPJ; const float* cs = WSP(const float, OFF_ROPE) + (size_t)(n * 128 + r) * 64 + 8 * c;
    const f32x4 c0 = *(const f32x4*)cs, c1 = *(const f32x4*)(cs + 4), s0 = *(const f32x4*)(cs + 32), s1 = *(const f32x4*)(cs + 36);
    const int w = F.wave, fr = F.lane & 15, fq = F.lane >> 4, il = 16 * w + fr;
    const h16* grow = WSP(const h16, WS_R1) + (size_t)(t0 + il) * NPJ + CG + 4 * fq; h16* orow = WSP(h16, OFF_OMIX) + (size_t)(t0 + il) * DM + 4 * fq;
    const h16* st0 = WSP(const h16, OFF_RST) + ((size_t)((0 * NB + b) * NCH + n) * 6) * 4096 + F.tid * 8; const h16* st1 = WSP(const h16, OFF_RST) + ((size_t)((1 * NB + b) * NCH + n) * 6) * 4096 + F.tid * 8;
    h16x8 q1, q2, k1, k2, v1, v2, sf, sb; h16x4 gn[4];
#define RO_LOAD(hh) do { q1 = *(const h16x8*)(rowp + CQ + (hh) * 64 + 8 * c); q2 = *(const h16x8*)(rowp + CQ + (hh) * 64 + 32 + 8 * c); k1 = *(const h16x8*)(rowp + CK + (hh) * 64 + 8 * c); k2 = *(const h16x8*)(rowp + CK + (hh) * 64 + 32 + 8 * c); \
        v1 = *(const h16x8*)(rowp + CV + (hh) * 64 + 16 * c); v2 = *(const h16x8*)(rowp + CV + (hh) * 64 + 16 * c + 8); sf = *(const h16x8*)(st0 + (hh) * 4096); sb = *(const h16x8*)(st1 + (hh) * 4096); \
        _Pragma("unroll") for (int et_ = 0; et_ < 4; ++et_) gn[et_] = *(const h16x4*)(grow + (hh) * 64 + 16 * et_); } while (0)
    RO_LOAD(0);
#pragma unroll 1
    for (int h = 0; h < 6; ++h) {
        LAS h16* Qt = (LAS h16*)(F.lds + (h & 1) * 72704); LAS h16* Kt = Qt + 128 * 72; LAS h16* VT = Kt + 128 * 72; LAS h16* Ff = VT + 64 * 136; LAS h16* Fb = Ff + 64 * 72;
        { h16x8 qa, qb, ka, kb;
#pragma unroll
            for (int e = 0; e < 8; ++e) { const float co = e < 4 ? c0[e] : c1[e - 4], si = e < 4 ? s0[e] : s1[e - 4];
                float x1 = (float)q1[e], x2 = (float)q2[e]; qa[e] = (h16)(x1 * co - x2 * si); qb[e] = (h16)(x1 * si + x2 * co);
                x1 = (float)k1[e]; x2 = (float)k2[e]; ka[e] = (h16)((x1 * co - x2 * si) * 0.125f); kb[e] = (h16)((x1 * si + x2 * co) * 0.125f); }
            *(LAS h16x8*)(Qt + r * 72 + 8 * c) = qa; *(LAS h16x8*)(Qt + r * 72 + 32 + 8 * c) = qb;
            *(LAS h16x8*)(Kt + r * 72 + 8 * c) = ka; *(LAS h16x8*)(Kt + r * 72 + 32 + 8 * c) = kb; }
#pragma unroll
        for (int e = 0; e < 8; ++e) { VT[(16 * c + e) * 136 + rp] = v1[e]; VT[(16 * c + 8 + e) * 136 + rp] = v2[e]; }
        *(LAS h16x8*)(Ff + er * 72 + d0) = sf; *(LAS h16x8*)(Fb + er * 72 + d0) = sb;
        h16x4 gc[4];
#pragma unroll
        for (int et = 0; et < 4; ++et) gc[et] = gn[et];
        if (h < 5) RO_LOAD(h + 1);
        RET_BAR();
        const float l2g = log1pf(-exp2f(-5.0f - (float)h)) * 1.4426950408889634f;
        h16x8 qf[2];
#pragma unroll
        for (int ks = 0; ks < 2; ++ks) qf[ks] = ldsfrag(Qt + il * 72 + 32 * ks + 8 * fq);
        f32x4 s[8];
#pragma unroll
        for (int jt = 0; jt < 8; ++jt) { f32x4 a = {0.f, 0.f, 0.f, 0.f};
#pragma unroll
            for (int ks = 0; ks < 2; ++ks) a = MFMA16(ldsfrag(Kt + (16 * jt + fr) * 72 + 32 * ks + 8 * fq), qf[ks], a);
#pragma unroll
            for (int q = 0; q < 4; ++q) { const int j = 16 * jt + 4 * fq + q; const int dd = il > j ? il - j : j - il; a[q] *= exp2f(l2g * (float)dd); }
            PINV(a); s[jt] = a; }
        f32x4 o[4];
#pragma unroll
        for (int et = 0; et < 4; ++et) o[et] = (f32x4){0.f, 0.f, 0.f, 0.f};
#pragma unroll
        for (int kp = 0; kp < 4; ++kp) { const h16x8 pf = pack8(s[2 * kp], s[2 * kp + 1]);
#pragma unroll
            for (int et = 0; et < 4; ++et) o[et] = MFMA16(ldsfrag(VT + (16 * et + fr) * 136 + 32 * kp + 8 * fq), pf, o[et]); }
        const float gf = exp2f(l2g * (float)(il + 1)), gb = exp2f(l2g * (float)(128 - il));
#pragma unroll
        for (int ks = 0; ks < 2; ++ks) { const h16x8 qff = scalefrag(qf[ks], gf), qfb = scalefrag(qf[ks], gb);
#pragma unroll
            for (int et = 0; et < 4; ++et) { o[et] = MFMA16(ldsfrag(Ff + (16 * et + fr) * 72 + 32 * ks + 8 * fq), qff, o[et]); o[et] = MFMA16(ldsfrag(Fb + (16 * et + fr) * 72 + 32 * ks + 8 * fq), qfb, o[et]); } }
        float ss = 0.f;
#pragma unroll
        for (int et = 0; et < 4; ++et) ss += (o[et][0] * o[et][0] + o[et][1] * o[et][1]) + (o[et][2] * o[et][2] + o[et][3] * o[et][3]);
        ss += __shfl_xor(ss, 16); ss += __shfl_xor(ss, 32);
        const float rs = 1.0f / sqrtf(ss * (1.0f / 64.0f) + EPS);
#pragma unroll
        for (int et = 0; et < 4; ++et) { f32x4 q;
#pragma unroll
            for (int e = 0; e < 4; ++e) q[e] = o[et][e] * rs * siluf_((float)gc[et][e]);
            *(h16x4*)(orow + h * 64 + 16 * et) = pack4(q); }
    }
#undef RO_LOAD
    __syncthreads();
}
#undef RET_BAR

__device__ __forceinline__ void ssd_stage_dt(const Frame& F, const Prm& p, int l, int g, long t0, LAS float* LA, LAS float* DTS) {
    if (F.tid < 128) { const h16* dp = WSP(const h16, WS_R1) + (size_t)(t0 + F.tid) * NPJ + CDT + g * 3;
#pragma unroll
        for (int r = 0; r < 3; ++r) { const float raw = (float)dp[r];
#pragma unroll
            for (int dir = 0; dir < 2; ++dir) { const float dt = softplusf_(raw + inptr(F, 7)[(l * 2 + dir) * 6 + g * 3 + r]); const float la = -dt * __expf(inptr(F, 8)[(l * 2 + dir) * 6 + g * 3 + r]);
                DTS[(dir * 3 + r) * 128 + F.tid] = dt; LA[(dir * 3 + r) * 128 + F.tid] = la; } } }
}
__device__ __forceinline__ void ssd_cumsum(const Frame& F, LAS const float* LAq, float& v0, float& v1, float& c0, float& c1, float& tot) {
    v0 = LAq[2 * F.lane]; v1 = LAq[2 * F.lane + 1]; float s = v0 + v1;
#pragma unroll
    for (int o = 1; o < 64; o <<= 1) { const float t = __shfl_up(s, o); if (F.lane >= o) s += t; }
    c1 = s; c0 = s - v1; tot = __shfl(s, 63);
}
__device__ __forceinline__ void ssd_states_unit(const Frame& F, const Prm& p, int l, int u) {
    const int g = u & 1, bn = u >> 1, n = bn % NCH, b = bn / NCH; const long t0 = (long)b * SEQ + n * 128;
    const h16* proj = WSP(const h16, WS_R1);
    LAS h16* XT = (LAS h16*)F.lds; LAS h16* BT = XT + 3 * 64 * 136; LAS float* LA = (LAS float*)(BT + 128 * 136); LAS float* DTS = LA + 6 * 128; LAS float* WW = DTS + 6 * 128;
    ssd_stage_dt(F, p, l, g, t0, LA, DTS);
    const float* cw = inptr(F, 5) + (size_t)l * 4 * 896; const float* cb = inptr(F, 6) + (size_t)l * 896;
    h16* bcn = ((h16*)((unsigned char*)F.out + OUT_BCN));
    for (int task = F.tid; task < 56 * 16; task += 512) { const int cg = task % 56, r0 = (task / 56) * 8; h16x8 o[8];
        if (cg < 24) { conv_rows8<true>(proj + CXS + g * 192 + 8 * cg, t0, n, r0, cw + g * 192 + 8 * cg, 896, cb + g * 192 + 8 * cg, o);
            LAS h16* d = XT + (cg >> 3) * 64 * 136 + ((cg & 7) * 8) * 136 + r0;
#pragma unroll
            for (int e = 0; e < 8; ++e) *(LAS h16x8*)(d + e * 136) = col_of(o, e);
        } else { const int c8 = (cg - 24) & 15; const bool isB = cg < 40; const int col = (isB ? CBM : CCM) + g * 128 + 8 * c8, ci = (isB ? 384 : 640) + g * 128 + 8 * c8;
            conv_rows8<true>(proj + col, t0, n, r0, cw + ci, 896, cb + ci, o);
#pragma unroll
            for (int r = 0; r < 8; ++r) *(h16x8*)(bcn + (size_t)(t0 + r0 + r) * 512 + (isB ? 0 : 256) + g * 128 + 8 * c8) = o[r];
            if (isB) { LAS h16* d = BT + (8 * c8) * 136 + r0;
#pragma unroll
                for (int e = 0; e < 8; ++e) *(LAS h16x8*)(d + e * 136) = col_of(o, e); } } }
    __syncthreads();
    { h16* xtg = ((h16*)((unsigned char*)F.out + OUT_XTG)) + ((size_t)(b * NCH + n) * 6 + g * 3) * 8192;
#pragma unroll
        for (int k = 0; k < 6; ++k) { const int it = F.tid + 512 * k, rr = it >> 4, c = it & 15; const h16x8 v = *(LAS const h16x8*)(XT + rr * 136 + 8 * c);
            *(h16x4*)(xtg + rr * 128 + kperm32(8 * c)) = __builtin_shufflevector(v, v, 0, 1, 2, 3); *(h16x4*)(xtg + rr * 128 + kperm32(8 * c + 4)) = __builtin_shufflevector(v, v, 4, 5, 6, 7); } }
    if (F.wave < 6) { const int q = F.wave, dir = q / 3, r = q % 3; float v0, v1, c0, c1, tot; ssd_cumsum(F, LA + q * 128, v0, v1, c0, c1, tot);
        const float d0 = DTS[q * 128 + 2 * F.lane], d1 = DTS[q * 128 + 2 * F.lane + 1];
        if (dir == 0) { WW[q * 128 + 2 * F.lane] = __expf(tot - c0) * d0 * 256.f; WW[q * 128 + 2 * F.lane + 1] = __expf(tot - c1) * d1 * 256.f; }
        else { WW[q * 128 + 2 * F.lane] = __expf(c0 - v0) * d0 * 256.f; WW[q * 128 + 2 * F.lane + 1] = __expf(c1 - v1) * d1 * 256.f; }
        if (F.lane == 0) WSP(float, OFF_SDEC)[((size_t)(b * NCH + n) * 6 + g * 3 + r) * 2 + dir] = tot; }
    __syncthreads();
    const int w = F.wave, fr = F.lane & 15, fq = F.lane >> 4;
    h16x8 xb[4];
#pragma unroll
    for (int ks = 0; ks < 4; ++ks) xb[ks] = ldsfrag(BT + (16 * w + fr) * 136 + 32 * ks + 8 * fq);
    for (int q = 0; q < 6; ++q) { const int dir = q / 3, r = q % 3;
        h16x8 wf[4];
#pragma unroll
        for (int ks = 0; ks < 4; ++ks) { const f32x4 a = *(LAS const f32x4*)(WW + q * 128 + 32 * ks + 8 * fq), c = *(LAS const f32x4*)(WW + q * 128 + 32 * ks + 8 * fq + 4); wf[ks] = pack8(a, c); }
        h16* sst = WSP(h16, OFF_SST) + ((size_t)((dir * NB + b) * NCH + n) * 6 + g * 3 + r) * 8192;
#pragma unroll
        for (int pt = 0; pt < 4; ++pt) { f32x4 acc = {0.f, 0.f, 0.f, 0.f};
#pragma unroll
            for (int ks = 0; ks < 4; ++ks) acc = MFMA16(xb[ks], ldsfrag(XT + r * 64 * 136 + (16 * pt + fr) * 136 + 32 * ks + 8 * fq) * wf[ks], acc);
            *(h16x4*)(sst + (16 * pt + fr) * 128 + 16 * w + 4 * fq) = pack4(acc * (1.0f / 256.f)); } }
    __syncthreads();
}
__device__ __forceinline__ void ssd_scan_unit(const Frame& F, int u) {
    const int hd = u % 6, b = (u / 6) % NB, dir = u / (6 * NB);
    h16* base = WSP(h16, OFF_SST) + ((size_t)((dir * NB + b) * NCH) * 6 + hd) * 8192 + F.tid * 16;
    const float* dbase = WSP(const float, OFF_SDEC) + ((size_t)(b * NCH) * 6 + hd) * 2 + dir;
    float acc[16];
#pragma unroll
    for (int e = 0; e < 16; ++e) acc[e] = 0.f;
#pragma unroll 1
    for (int q = 0; q < 4; ++q) { h16x8 s0[4], s1[4]; float dec[4];
#pragma unroll
        for (int i = 0; i < 4; ++i) { const int ii = 4 * q + i, n = dir == 0 ? ii : NCH - 1 - ii; s0[i] = *(const h16x8*)(base + (size_t)n * 6 * 8192); s1[i] = *(const h16x8*)(base + (size_t)n * 6 * 8192 + 8); dec[i] = dbase[n * 12]; }
#pragma unroll
        for (int i = 0; i < 4; ++i) { const int ii = 4 * q + i, n = dir == 0 ? ii : NCH - 1 - ii; const float dc = __expf(dec[i]); h16x8 o0, o1;
#pragma unroll
            for (int e = 0; e < 8; ++e) { o0[e] = (h16)acc[e]; o1[e] = (h16)acc[8 + e]; acc[e] = acc[e] * dc + (float)s0[i][e]; acc[8 + e] = acc[8 + e] * dc + (float)s1[i][e]; }
            *(h16x8*)(base + (size_t)n * 6 * 8192) = o0; *(h16x8*)(base + (size_t)n * 6 * 8192 + 8) = o1; } }
}
__device__ __forceinline__ void ssd_out_unit(const Frame& F, const Prm& p, int l, int u) {
    const int g = u & 1, bn = u >> 1, n = bn % NCH, b = bn / NCH; const long t0 = (long)b * SEQ + n * 128;
    const h16* proj = WSP(const h16, WS_R1);
    LAS h16* XT = (LAS h16*)F.lds; LAS h16* Bt = XT + 3 * 64 * 136; LAS h16* Ct = Bt + 128 * 136; LAS float* LA = (LAS float*)(Ct + 128 * 136); LAS float* DTS = LA + 6 * 128;
    LAS float* CE = DTS + 6 * 128;
    LAS float* TOTB = CE + 6 * 128;
    ssd_stage_dt(F, p, l, g, t0, LA, DTS);
    const float* cw = inptr(F, 5) + (size_t)l * 4 * 896; const float* cb = inptr(F, 6) + (size_t)l * 896;
    { const h16* xtg = ((const h16*)((const unsigned char*)F.out + OUT_XTG)) + ((size_t)(b * NCH + n) * 6 + g * 3) * 8192; const h16* bcn = ((const h16*)((const unsigned char*)F.out + OUT_BCN)) + (size_t)t0 * 512 + g * 128;
        h16x8 xv[6], bv[8];
#pragma unroll
        for (int k = 0; k < 6; ++k) { const int it = F.tid + 512 * k; xv[k] = *(const h16x8*)(xtg + (it >> 4) * 128 + 8 * (it & 15)); }
#pragma unroll
        for (int k = 0; k < 8; ++k) { const int it = F.tid + 512 * k, row = it >> 5, c = it & 31; bv[k] = *(const h16x8*)(bcn + (size_t)row * 512 + (c < 16 ? 8 * c : 256 + 8 * (c - 16))); }
#pragma unroll
        for (int k = 0; k < 6; ++k) { const int it = F.tid + 512 * k; *(LAS h16x8*)(XT + (it >> 4) * 136 + 8 * (it & 15)) = xv[k]; }
#pragma unroll
        for (int k = 0; k < 8; ++k) { const int it = F.tid + 512 * k, row = it >> 5, c = it & 31; *(LAS h16x8*)((c < 16 ? Bt : Ct) + row * 136 + 8 * (c & 15)) = bv[k]; }
        PIN(); }
    __syncthreads();
    if (F.wave < 6) { const int q = F.wave; float v0, v1, c0, c1, tot; ssd_cumsum(F, LA + q * 128, v0, v1, c0, c1, tot);
        if (q < 3) { CE[q * 128 + 2 * F.lane] = c0; CE[q * 128 + 2 * F.lane + 1] = c1; }
        else { CE[q * 128 + 2 * F.lane] = c0 - v0; CE[q * 128 + 2 * F.lane + 1] = c1 - v1; if (F.lane == 0) TOTB[q - 3] = tot; } }
    __syncthreads();
    const int w = F.wave, fr = F.lane & 15, fq = F.lane >> 4, il = 16 * w + fr;
    h16x8 cf[4];
#pragma unroll
    for (int ks = 0; ks < 4; ++ks) cf[ks] = ldsfrag(Ct + il * 136 + 32 * ks + 8 * fq);
    f32x4 gT[8];
#pragma unroll
    for (int jt = 0; jt < 8; ++jt) { f32x4 a = {0.f, 0.f, 0.f, 0.f};
#pragma unroll
        for (int ks = 0; ks < 4; ++ks) a = MFMA16(ldsfrag(Bt + (16 * jt + fr) * 136 + 32 * ks + 8 * fq), cf[ks], a);
        PINV(a); gT[jt] = a; }
    const float* dsk = inptr(F, 9) + l * 6 + g * 3;
    h16* orow = WSP(h16, OFF_OMIX) + (size_t)(t0 + il) * DM + 384 + g * 192;
    float ss = 0.f;
    { h16x8 h0[4];
#pragma unroll
        for (int k = 0; k < 4; ++k) { const int it = F.tid + 512 * k, dir = it >> 10, e = it & 1023; h0[k] = *(const h16x8*)(WSP(const h16, OFF_SST) + ((size_t)((dir * NB + b) * NCH + n) * 6 + g * 3) * 8192 + e * 8); }
        __syncthreads();
#pragma unroll
        for (int k = 0; k < 4; ++k) { const int it = F.tid + 512 * k, dir = it >> 10, e = it & 1023; *(LAS h16x8*)(Bt + dir * 64 * 136 + (e >> 4) * 136 + 8 * (e & 15)) = h0[k]; }
        __syncthreads(); }
#pragma unroll 1
    for (int r = 0; r < 3; ++r) {
        f32x4 y[1][4];
        const int hd = g * 3 + r;
        const float cfi = CE[r * 128 + il], ebi = CE[(3 + r) * 128 + il], totb = TOTB[r];
#pragma unroll
        for (int pt = 0; pt < 4; ++pt) y[0][pt] = (f32x4){0.f, 0.f, 0.f, 0.f};
        LAS const h16* HL = (r & 1) ? Ct : Bt;
        h16x8 hreg[4];
        if (r < 2) {
#pragma unroll
            for (int k = 0; k < 4; ++k) { const int it = F.tid + 512 * k, dir = it >> 10, e = it & 1023; hreg[k] = *(const h16x8*)(WSP(const h16, OFF_SST) + ((size_t)((dir * NB + b) * NCH + n) * 6 + hd + 1) * 8192 + e * 8); } }
#pragma unroll
        for (int kp = 0; kp < 4; ++kp) { f32x4 pv[2];
#pragma unroll
            for (int jh = 0; jh < 2; ++jh) { const int jt = 2 * kp + jh, j0 = 16 * jt + 4 * fq;
                const f32x4 cfj = *(LAS const f32x4*)(CE + r * 128 + j0), ebj = *(LAS const f32x4*)(CE + (3 + r) * 128 + j0), dfj = *(LAS const f32x4*)(DTS + r * 128 + j0), dbj = *(LAS const f32x4*)(DTS + (3 + r) * 128 + j0);
#pragma unroll
                for (int e = 0; e < 4; ++e) { const int j = j0 + e; const float val = (il >= j) ? __expf(cfi - cfj[e]) * dfj[e] : __expf(ebj[e] - ebi) * dbj[e]; pv[jh][e] = gT[jt][e] * val * 256.f; }
                PINV(pv[jh]); }
            const h16x8 pf = pack8(pv[0], pv[1]);
#pragma unroll
            for (int pt = 0; pt < 4; ++pt) y[0][pt] = MFMA16(ldsfrag(XT + r * 64 * 136 + (16 * pt + fr) * 136 + 32 * kp + 8 * fq), pf, y[0][pt]);
            PINV(y[0][0]); PINV(y[0][1]); PINV(y[0][2]); PINV(y[0][3]); }
        const float ef = __expf(cfi) * 256.f, eb = __expf(totb - ebi) * 256.f;
#pragma unroll
        for (int ks = 0; ks < 4; ++ks) { const h16x8 cff = scalefrag(cf[ks], ef), cfb = scalefrag(cf[ks], eb);
#pragma unroll
            for (int pt = 0; pt < 4; ++pt) { y[0][pt] = MFMA16(ldsfrag(HL + (16 * pt + fr) * 136 + 32 * ks + 8 * fq), cff, y[0][pt]); y[0][pt] = MFMA16(ldsfrag(HL + 64 * 136 + (16 * pt + fr) * 136 + 32 * ks + 8 * fq), cfb, y[0][pt]); }
            PINV(y[0][0]); PINV(y[0][1]); PINV(y[0][2]); PINV(y[0][3]); }
        if (r < 2) { LAS h16* HN = (r & 1) ? Bt : Ct;
#pragma unroll
            for (int k = 0; k < 4; ++k) { const int it = F.tid + 512 * k, dir = it >> 10, e = it & 1023; *(LAS h16x8*)(HN + dir * 64 * 136 + (e >> 4) * 136 + 8 * (e & 15)) = hreg[k]; } }
        const float dk = dsk[r]; const h16* zrow = proj + (size_t)(t0 + il) * NPJ + CZ + hd * 64;
#pragma unroll
        for (int pt = 0; pt < 4; ++pt) { const h16x4 zv = *(const h16x4*)(zrow + 16 * pt + 4 * fq);
#pragma unroll
            for (int e = 0; e < 4; ++e) { const float xv = (float)XT[r * 64 * 136 + (16 * pt + 4 * fq + e) * 136 + kperm32(il)]; y[0][pt][e] = (y[0][pt][e] * (1.0f / 256.f) + dk * xv) * siluf_((float)zv[e]); }
            const h16x4 yh = pack4(y[0][pt]); *(h16x4*)(orow + r * 64 + 16 * pt + 4 * fq) = yh;
#pragma unroll
            for (int e = 0; e < 4; ++e) { const float q = (float)yh[e]; ss += q * q; } }
        __syncthreads();
    }
    ss += __shfl_xor(ss, 16); ss += __shfl_xor(ss, 32);
    const float rs = 1.0f / sqrtf(ss * (1.0f / 192.0f) + EPS);
    const float* nw = inptr(F, 10) + l * 384 + g * 192;
    asm volatile("s_waitcnt vmcnt(0)" ::: "memory");
#pragma unroll 1
    for (int r = 0; r < 3; ++r)
#pragma unroll
        for (int pt = 0; pt < 4; ++pt) { const f32x4 wv = *(const f32x4*)(nw + r * 64 + 16 * pt + 4 * fq); h16* op = orow + r * 64 + 16 * pt + 4 * fq; const h16x4 yh = *(const h16x4*)op; f32x4 yv;
#pragma unroll
            for (int e = 0; e < 4; ++e) yv[e] = (float)yh[e] * rs * wv[e];
            *(h16x4*)op = pack4(yv); }
    __syncthreads();
}

__device__ __forceinline__ void lru_unit(const Frame& F, const Prm& p, int l, int u) {
    const int n = u % NCH, b = u / NCH; const long t0 = (long)b * SEQ + n * 128;
    const h16* proj = WSP(const h16, WS_R1);
    LAS h16* XC = (LAS h16*)F.lds;
    const float* cw = inptr(F, 11) + (size_t)l * 4 * 256; const float* cb = inptr(F, 12) + (size_t)l * 256;
    { const int cg = F.tid & 31, r0 = (F.tid >> 5) * 8; h16x8 o[8];
        conv_rows8<false>(proj + CXR + 8 * cg, t0, n, r0, cw + 8 * cg, 256, cb + 8 * cg, o);
#pragma unroll
        for (int r = 0; r < 8; ++r) *(LAS h16x8*)(XC + (r0 + r) * 264 + 8 * cg) = o[r]; }
    __syncthreads();
    const int blk = F.wave & 3, jh = F.wave >> 2, fr = F.lane & 15, fq = F.lane >> 4;
    h16* lau = (h16*)((unsigned char*)F.out + OUT_LAU) + (size_t)(b * NCH + n) * 2 * 128 * 256 * 2;
    h16x8 wa[2][2][2], wx[2][2][2]; float ba[2][2], bx[2][2], sp[2][2], car[2][2], atot[2][2];
#pragma unroll
    for (int dir = 0; dir < 2; ++dir)
#pragma unroll
        for (int jt = 0; jt < 2; ++jt) { const int ch = blk * 64 + 32 * jh + 16 * jt + fr;
#pragma unroll
            for (int ks = 0; ks < 2; ++ks) { wa[dir][jt][ks] = *(const h16x8*)(WSP(const h16, WS_LRUW) + (size_t)((dir * 2 + 0) * 4 + blk) * 4096 + (32 * jh + 16 * jt + fr) * 64 + 32 * ks + 8 * fq);
                wx[dir][jt][ks] = *(const h16x8*)(WSP(const h16, WS_LRUW) + (size_t)((dir * 2 + 1) * 4 + blk) * 4096 + (32 * jh + 16 * jt + fr) * 64 + 32 * ks + 8 * fq); }
            ba[dir][jt] = inptr(F, 15)[(l * 2 + dir) * 256 + ch]; bx[dir][jt] = inptr(F, 17)[(l * 2 + dir) * 256 + ch]; sp[dir][jt] = softplusf_(-inptr(F, 13)[(l * 2 + dir) * 256 + ch]);
            car[dir][jt] = 0.f; atot[dir][jt] = 1.f; }
#pragma unroll 1
    for (int ti = 0; ti < 8; ++ti) {
#pragma unroll
        for (int dir = 0; dir < 2; ++dir) { const int tt = dir == 0 ? ti : 7 - ti;
            h16x8 xf[2];
#pragma unroll
            for (int ks = 0; ks < 2; ++ks) xf[ks] = ldsfrag(XC + (16 * tt + fr) * 264 + blk * 64 + 32 * ks + 8 * fq);
#pragma unroll
            for (int jt = 0; jt < 2; ++jt) { const int ch = blk * 64 + 32 * jh + 16 * jt + fr;
                f32x4 ra = {0.f, 0.f, 0.f, 0.f}, ia = {0.f, 0.f, 0.f, 0.f};
#pragma unroll
                for (int ks = 0; ks < 2; ++ks) { ra = MFMA16(xf[ks], wa[dir][jt][ks], ra); ia = MFMA16(xf[ks], wx[dir][jt][ks], ia); }
                float A = 1.f, H = 0.f;
#pragma unroll
                for (int ri = 0; ri < 4; ++ri) { const int rg = dir == 0 ? ri : 3 - ri;
                    const float e1 = 1.0f + __expf(-(ra[rg] + ba[dir][jt])), e2 = 1.0f + __expf(-(ia[rg] + bx[dir][jt])); const float inv = __builtin_amdgcn_rcpf(e1 * e2);
                    const float rgate = inv * e2, ig = inv * e1;
                    const float la = -8.0f * rgate * sp[dir][jt]; const float a = __expf(la); const float y = 2.0f * la;
                    const float om = y > -0.1f ? -y * (1.0f + y * (0.5f + y * (1.0f / 6.0f))) : 1.0f - a * a;
                    const float mult = __builtin_amdgcn_sqrtf(om);
                    const float xv = (float)XC[(16 * tt + 4 * fq + rg) * 264 + ch]; const float uu = mult * ig * xv;
                    H = a * H + uu; A *= a;
                    { h16x2 pk; pk[0] = (h16)la; pk[1] = (h16)uu; *(h16x2*)(lau + ((size_t)dir * 128 + 16 * tt + 4 * fq + rg) * 256 * 2 + 2 * ch) = pk; } }
                float Ag[4], Hg[4];
#pragma unroll
                for (int gq = 0; gq < 4; ++gq) { Ag[gq] = __shfl(A, fr + 16 * gq); Hg[gq] = __shfl(H, fr + 16 * gq); }
                float cnew = car[dir][jt], at = 1.f;
#pragma unroll
                for (int gi = 0; gi < 4; ++gi) { const int gq = dir == 0 ? gi : 3 - gi;
                    cnew = Ag[gq] * cnew + Hg[gq]; at *= Ag[gq]; }
                car[dir][jt] = cnew; atot[dir][jt] *= at;
            } } }
    if (fq == 0) {
#pragma unroll
        for (int dir = 0; dir < 2; ++dir)
#pragma unroll
            for (int jt = 0; jt < 2; ++jt) { const int ch = blk * 64 + 32 * jh + 16 * jt + fr; *(f32x2*)(WSP(float, OFF_LSUM) + (((size_t)(b * NCH + n) * 2 + dir) * 256 + ch) * 2) = (f32x2){atot[dir][jt], car[dir][jt]}; } }
    __syncthreads();
}
__device__ __forceinline__ void lru_out_unit(const Frame& F, int u) {
    const int n = u % NCH, b = u / NCH; const long t0 = (long)b * SEQ + n * 128;
    const h16* proj = WSP(const h16, WS_R1);
    LAS h16* HT = (LAS h16*)F.lds;
    const int blk = F.wave & 3, jh = F.wave >> 2, fr = F.lane & 15, fq = F.lane >> 4;
    const h16* lau = (const h16*)((const unsigned char*)F.out + OUT_LAU) + (size_t)(b * NCH + n) * 2 * 128 * 256 * 2;
    float car[2][2];
#pragma unroll
    for (int dir = 0; dir < 2; ++dir)
#pragma unroll
        for (int jt = 0; jt < 2; ++jt) car[dir][jt] = WSP(const float, OFF_LCAR)[((size_t)(b * NCH + n) * 2 + dir) * 256 + blk * 64 + 32 * jh + 16 * jt + fr];
#pragma unroll 1
    for (int ti = 0; ti < 8; ++ti) {
#pragma unroll
        for (int dir = 0; dir < 2; ++dir) { const int tt = dir == 0 ? ti : 7 - ti;
            h16x2 pk[2][4]; h16 gtv[2][4], ov[2][4];
#pragma unroll
            for (int jt = 0; jt < 2; ++jt)
#pragma unroll
                for (int rg = 0; rg < 4; ++rg) { const int tl = 16 * tt + 4 * fq + rg, ch = blk * 64 + 32 * jh + 16 * jt + fr;
                    pk[jt][rg] = *(const h16x2*)(lau + ((size_t)dir * 128 + tl) * 256 * 2 + 2 * ch); gtv[jt][rg] = proj[(size_t)(t0 + tl) * NPJ + CGT + ch]; ov[jt][rg] = ti >= 4 ? HT[tl * 264 + ch] : (h16)0.f; }
#pragma unroll
            for (int jt = 0; jt < 2; ++jt) { const int ch = blk * 64 + 32 * jh + 16 * jt + fr;
                float av[4], uv[4]; float A = 1.f, H = 0.f;
#pragma unroll
                for (int ri = 0; ri < 4; ++ri) { const int rg = dir == 0 ? ri : 3 - ri; const float a = __expf((float)pk[jt][rg][0]); const float uu = (float)pk[jt][rg][1]; av[rg] = a; uv[rg] = uu; H = a * H + uu; A *= a; }
                float Ag[4], Hg[4];
#pragma unroll
                for (int gq = 0; gq < 4; ++gq) { Ag[gq] = __shfl(A, fr + 16 * gq); Hg[gq] = __shfl(H, fr + 16 * gq); }
                float hin = car[dir][jt], cnew = car[dir][jt];
#pragma unroll
                for (int gi = 0; gi < 4; ++gi) { const int gq = dir == 0 ? gi : 3 - gi; const bool before = dir == 0 ? (gq < fq) : (gq > fq);
                    if (before) hin = Ag[gq] * hin + Hg[gq];
                    cnew = Ag[gq] * cnew + Hg[gq]; }
                car[dir][jt] = cnew;
                float hh = hin;
#pragma unroll
                for (int ri = 0; ri < 4; ++ri) { const int rg = dir == 0 ? ri : 3 - ri; hh = av[rg] * hh + uv[rg];
                    HT[(16 * tt + 4 * fq + rg) * 264 + ch] = (h16)((float)ov[jt][rg] + hh * gelu_tanh_((float)gtv[jt][rg])); } } } }
    __syncthreads();
#pragma unroll
    for (int k = 0; k < 8; ++k) { const int it = F.tid + 512 * k, row = it >> 5, c8 = it & 31; *(h16x8*)(WSP(h16, OFF_OMIX) + (size_t)(t0 + row) * DM + 768 + 8 * c8) = *(LAS const h16x8*)(HT + row * 264 + 8 * c8); }
    __syncthreads();
}
__device__ __forceinline__ void lru_scan(const Frame& F) {
    const int gi = (int)blockIdx.x * 512 + F.tid; if (gi >= NB * 2 * 256) return;
    const int ch = gi & 255, dir = (gi >> 8) & 1, b = gi >> 9; float H = 0.f;
    for (int i = 0; i < NCH; ++i) { const int n = dir == 0 ? i : NCH - 1 - i; const size_t idx = ((size_t)(b * NCH + n) * 2 + dir) * 256 + ch;
        const f32x2 s = *(const f32x2*)(WSP(const float, OFF_LSUM) + idx * 2); WSP(float, OFF_LCAR)[idx] = H; H = s[0] * H + s[1]; }
}

__device__ __forceinline__ void attn_phase(const Frame& F) {
    constexpr int NU = NB * 4 * 8;
    LAS unsigned char* B0 = F.lds; LAS unsigned char* B1 = F.lds + 67584;
    int u = F.vcu; if (u >= NU) return;
    int lanel = F.lane; asm volatile("" : "+v"(lanel)); int fr = lanel & 15, fq = lanel >> 4;
    const int w = F.wave;
    h16x8 qf[2][8];
#define AT_DMA(buf, src, rowstride) do { asm volatile("" : "+v"(lanel)); if (lanel < 32) { _Pragma("unroll") for (int i_ = 0; i_ < 16; ++i_) \
        __builtin_amdgcn_global_load_lds((const unsigned*)((src) + (size_t)(16 * w + i_) * (rowstride) + 8 * lanel), (LAS unsigned*)((buf) + (16 * w + i_) * 528), 16, 0, 0); } } while (0)
#define AT_FRAG(buf, row, chunk) (*(LAS const h16x8*)((buf) + (row) * 528 + (chunk) * 16))
#define AT_WAITBAR() do { asm volatile("s_waitcnt vmcnt(0) lgkmcnt(0)" ::: "memory"); __builtin_amdgcn_s_barrier(); asm volatile("" ::: "memory"); } while (0)
#define AT_LOADQ(uu) do { _Pragma("unroll") for (int a_ = 0; a_ < 2; ++a_) { const long t_ = (long)((uu) >> 5) * SEQ + ((uu) & 7) * 256 + 32 * w + 16 * a_ + fr; const h16* q_ = WSP(const h16, OFF_QCA) + (size_t)t_ * DM + (((uu) >> 3) & 3) * 256; \
        _Pragma("unroll") for (int ks_ = 0; ks_ < 8; ++ks_) qf[a_][ks_] = *(const h16x8*)(q_ + 32 * ks_ + 8 * fq); } } while (0)
    { const int b = u >> 5, hd = (u >> 3) & 3; AT_DMA(B0, WSP(const h16, OFF_KB) + (size_t)(b * 256) * DM + hd * 256, DM); }
    for (; u < NU; u += F.G) {
        const int qb = u & 7, hd = (u >> 3) & 3, b = u >> 5; const int un = u + F.G; const bool has_next = un < NU;
        asm volatile("" : "+v"(lanel)); fr = lanel & 15; fq = lanel >> 4;
        const h16* kb = WSP(const h16, OFF_KB) + (size_t)(b * 256) * DM + hd * 256; const h16* vt = WSP(const h16, OFF_VT) + (size_t)(b * 4 + hd) * 65536;
        AT_LOADQ(u);
        h16x8 pf[2][8]; float mq[2][4], Mr[2] = {-3.0e38f, -3.0e38f}, Lr[2] = {0.f, 0.f};
#pragma unroll
        for (int h = 0; h < 2; ++h) {
            AT_WAITBAR();
            if (h == 0) AT_DMA(B1, kb + (size_t)128 * DM, DM); else AT_DMA(B0, vt, 256);
            LAS const unsigned char* KB_ = h == 0 ? B0 : B1;
#pragma unroll
            for (int jh = 0; jh < 2; ++jh) { const int qd = 2 * h + jh; f32x4 s[2][4]; h16x8 kf[2][4];
#pragma unroll
                for (int j4 = 0; j4 < 4; ++j4) { s[0][j4] = (f32x4){0.f, 0.f, 0.f, 0.f}; s[1][j4] = (f32x4){0.f, 0.f, 0.f, 0.f}; kf[0][j4] = AT_FRAG(KB_, 16 * (4 * jh + j4) + fr, fq); }
#pragma unroll
                for (int ks = 0; ks < 8; ++ks) {
                    if (ks < 7) {
#pragma unroll
                        for (int j4 = 0; j4 < 4; ++j4) kf[(ks + 1) & 1][j4] = AT_FRAG(KB_, 16 * (4 * jh + j4) + fr, 4 * (ks + 1) + fq); }
                    PIN();
#pragma unroll
                    for (int j4 = 0; j4 < 4; ++j4) { s[0][j4] = MFMA16(kf[ks & 1][j4], qf[0][ks], s[0][j4]); s[1][j4] = MFMA16(kf[ks & 1][j4], qf[1][ks], s[1][j4]); }
                    PINV(s[0][0]); PINV(s[1][3]); }
#pragma unroll
                for (int a = 0; a < 2; ++a) { float mx = fmaxf(fmaxf(s[a][0][0], s[a][0][1]), fmaxf(s[a][0][2], s[a][0][3]));
#pragma unroll
                    for (int jt = 1; jt < 4; ++jt) mx = fmaxf(mx, fmaxf(fmaxf(s[a][jt][0], s[a][jt][1]), fmaxf(s[a][jt][2], s[a][jt][3])));
                    mx = fmaxf(mx, __shfl_xor(mx, 16)); mx = fmaxf(mx, __shfl_xor(mx, 32));
                    float sum = 0.f;
#pragma unroll
                    for (int jt = 0; jt < 4; ++jt)
#pragma unroll
                        for (int e = 0; e < 4; ++e) { const float pe = __expf(s[a][jt][e] - mx); s[a][jt][e] = pe; sum += pe; }
                    sum += __shfl_xor(sum, 16); sum += __shfl_xor(sum, 32);
                    mq[a][qd] = mx; { const float Mn = fmaxf(Mr[a], mx); Lr[a] = Lr[a] * __expf(Mr[a] - Mn) + sum * __expf(mx - Mn); Mr[a] = Mn; }
                    pf[a][2 * qd] = pack8(s[a][0], s[a][1]); pf[a][2 * qd + 1] = pack8(s[a][2], s[a][3]); } }
        }
#pragma unroll
        for (int a = 0; a < 2; ++a) { const float inv = 1.0f / Lr[a];
#pragma unroll
            for (int q = 0; q < 4; ++q) { const float cq = __expf(mq[a][q] - Mr[a]) * inv; pf[a][2 * q] = scalefrag(pf[a][2 * q], cq); pf[a][2 * q + 1] = scalefrag(pf[a][2 * q + 1], cq); } }
#pragma unroll
        for (int d = 0; d < 2; ++d) {
            AT_WAITBAR();
            if (d == 0) AT_DMA(B1, vt + (size_t)128 * 256, 256);
            else if (has_next) AT_DMA(B0, WSP(const h16, OFF_KB) + (size_t)((un >> 5) * 256) * DM + ((un >> 3) & 3) * 256, DM);
            LAS const unsigned char* VB_ = d == 0 ? B0 : B1;
#pragma unroll
            for (int eh = 0; eh < 2; ++eh) { f32x4 o[2][4]; h16x8 vf[2][4];
#pragma unroll
                for (int e4 = 0; e4 < 4; ++e4) { o[0][e4] = (f32x4){0.f, 0.f, 0.f, 0.f}; o[1][e4] = (f32x4){0.f, 0.f, 0.f, 0.f}; vf[0][e4] = AT_FRAG(VB_, 16 * (4 * eh + e4) + fr, fq); }
#pragma unroll
                for (int kp = 0; kp < 8; ++kp) {
                    if (kp < 7) {
#pragma unroll
                        for (int e4 = 0; e4 < 4; ++e4) vf[(kp + 1) & 1][e4] = AT_FRAG(VB_, 16 * (4 * eh + e4) + fr, 4 * (kp + 1) + fq); }
                    PIN();
#pragma unroll
                    for (int e4 = 0; e4 < 4; ++e4) { o[0][e4] = MFMA16(vf[kp & 1][e4], pf[0][kp], o[0][e4]); o[1][e4] = MFMA16(vf[kp & 1][e4], pf[1][kp], o[1][e4]); }
                    PINV(o[0][0]); PINV(o[1][3]); }
#pragma unroll
                for (int a = 0; a < 2; ++a) { const long t = (long)b * SEQ + qb * 256 + 32 * w + 16 * a + fr; h16* orow = WSP(h16, OFF_OATT) + (size_t)t * DM + hd * 256 + 128 * d + 64 * eh;
#pragma unroll
                    for (int e4 = 0; e4 < 4; ++e4) *(h16x4*)(orow + 16 * e4 + 4 * fq) = pack4(o[a][e4]); } }
        }
    }
    asm volatile("s_waitcnt vmcnt(0) lgkmcnt(0)" ::: "memory");
    __syncthreads();
#undef AT_DMA
#undef AT_FRAG
#undef AT_WAITBAR
#undef AT_LOADQ
}

__device__ __forceinline__ void phase_router(const Frame& F, const Prm& p, int l) {
    LAS h16* RW = (LAS h16*)F.lds;
    { const h16* rwg = WSP(const h16, OFF_RWG);
        for (int i = F.tid; i < 72 * 1032 / 8; i += 512) *(LAS h16x8*)(RW + 8 * i) = *(const h16x8*)(rwg + 8 * i); }
    LAS unsigned* hist = (LAS unsigned*)(F.lds + 72 * 1032 * 2);
    if (F.tid < 32) hist[F.tid] = 0u;
    if (F.G == 256) { for (int i = (int)blockIdx.x * 512 + F.tid; i < MAXSLOT; i += 256 * 512) WSP(int, OFF_STOK)[i] = 0; }
    else if (blockIdx.x == 0) { for (int i = F.tid; i < MAXSLOT; i += 512) WSP(int, OFF_STOK)[i] = 0; }
    __syncthreads();
    const int gw = F.vcu * 8 + F.wave, NGW = F.G * 8, fr = F.lane & 15, fq = F.lane >> 4;
    for (int tg = gw; tg < NT / 16; tg += NGW) {
        const int tok = tg * 16 + fr;
        const h16* hp = WSP(const h16, WS_HB) + (size_t)tok * DM + 8 * fq;
        f32x4 acc[3]; LAS const h16* wrow[3];
#pragma unroll
        for (int mt = 0; mt < 3; ++mt) { acc[mt] = (f32x4){0.f, 0.f, 0.f, 0.f}; const int j = (16 * mt + fr) < 36 ? (16 * mt + fr) : 35; wrow[mt] = RW + j * 1032 + 8 * fq; }
#pragma unroll
        for (int half = 0; half < 2; ++half) { h16x8 hf[16];
#pragma unroll
            for (int q = 0; q < 16; ++q) hf[q] = *(const h16x8*)(hp + 32 * (16 * half + q));
#pragma unroll
            for (int q = 0; q < 16; ++q) { const int ks = 16 * half + q;
#pragma unroll
                for (int mt = 0; mt < 3; ++mt) { acc[mt] = MFMA16(ldsfrag(wrow[mt] + 32 * ks), hf[q], acc[mt]); acc[mt] = MFMA16(ldsfrag(wrow[mt] + 36 * 1032 + 32 * ks), hf[q], acc[mt]); } } }
#pragma unroll
        for (int mt = 0; mt < 3; ++mt) acc[mt] *= (1.0f / 1024.0f);
        const float rs = row_rstd(WSP(const float, WS_SSQ) + (size_t)tok * 16);
        float gl[4];
#pragma unroll
        for (int r = 0; r < 4; ++r) gl[r] = __shfl(acc[0][r], fr) * rs + inptr(F, 25)[l * 4 + r];
        int gi = 0; float gmx = gl[0];
#pragma unroll
        for (int j = 1; j < 4; ++j) if (gl[j] > gmx) { gmx = gl[j]; gi = j; }
        float gsum = 0.f;
#pragma unroll
        for (int j = 0; j < 4; ++j) gsum += __expf(gl[j] - gmx);
        const float gp = 1.0f / gsum;
        const int src1 = fr + 16 * (1 + 2 * (gi & 1)), src2 = fr + 16 * (2 - 2 * (gi & 1)), mt1 = gi >> 1, mt2 = (gi + 1) >> 1;
        float el[8];
#pragma unroll
        for (int k = 0; k < 4; ++k) { const float a0 = __shfl(acc[0][k], src1), a1 = __shfl(acc[1][k], src1); el[k] = (mt1 ? a1 : a0) * rs + inptr(F, 27)[l * 32 + gi * 8 + k];
            const float b0 = __shfl(acc[0][k], src2), b1 = __shfl(acc[1][k], src2), b2 = __shfl(acc[2][k], src2); el[4 + k] = (mt2 == 0 ? b0 : (mt2 == 1 ? b1 : b2)) * rs + inptr(F, 27)[l * 32 + gi * 8 + 4 + k]; }
        int e1 = 0; float m1 = el[0];
#pragma unroll
        for (int j = 1; j < 8; ++j) if (el[j] > m1) { m1 = el[j]; e1 = j; }
        int e2 = -1; float m2 = -3.0e38f;
#pragma unroll
        for (int j = 0; j < 8; ++j) if (j != e1 && el[j] > m2) { m2 = el[j]; e2 = j; }
        const float r2 = __expf(m2 - m1); const float g1 = gp / (1.0f + r2), g2 = gp * r2 / (1.0f + r2);
        if (fq == 0) { const int x1 = gi * 8 + e1, x2 = gi * 8 + e2;
            *(int2*)(WSP(int, OFF_EID) + (size_t)tok * 2) = make_int2(x1, x2); *(f32x2*)(WSP(float, OFF_GATE) + (size_t)tok * 2) = (f32x2){g1, g2};
            WSP(float, OFF_RSTDT)[tok] = rs; __hip_atomic_fetch_add(&hist[x1], 1u, __ATOMIC_RELAXED, __HIP_MEMORY_SCOPE_WORKGROUP); __hip_atomic_fetch_add(&hist[x2], 1u, __ATOMIC_RELAXED, __HIP_MEMORY_SCOPE_WORKGROUP); }
    }
    __syncthreads();
    if (F.tid < 32 && hist[F.tid]) atomicAdd(WSP(unsigned, WS_CTL) + CW_COUNTS + l * 64 + F.tid, hist[F.tid]);
    __syncthreads();
}
__device__ __forceinline__ void phase_dispatch(const Frame& F, int l) {
    LAS int* cnt = (LAS int*)F.lds; LAS int* base = cnt + 32; LAS int* pstart = base + 32; LAS int* slots = pstart + 40;
    unsigned* ctl = WSP(unsigned, WS_CTL);
    for (int blk = F.vcu; blk < NT / 128; blk += F.G) {
        __syncthreads();
        if (F.tid < 32) cnt[F.tid] = 0;
        if (F.tid == 32) { int acc = 0; for (int e = 0; e < 32; ++e) { pstart[e] = acc; acc += (int)((ctl[CW_COUNTS + l * 64 + e] + 255u) & ~255u); } pstart[32] = acc; }
        __syncthreads();
        int e = 0, rank = 0, tok = 0;
        if (F.tid < 256) { tok = blk * 128 + (F.tid >> 1); e = WSP(const int, OFF_EID)[(size_t)tok * 2 + (F.tid & 1)]; rank = __hip_atomic_fetch_add(&cnt[e], 1, __ATOMIC_RELAXED, __HIP_MEMORY_SCOPE_WORKGROUP); }
        __syncthreads();
        if (F.tid < 32) base[F.tid] = cnt[F.tid] ? (int)atomicAdd(&ctl[CW_CURSOR + l * 64 + F.tid], (unsigned)cnt[F.tid]) : 0;
        __syncthreads();
        if (F.tid < 256) { const int slot = pstart[e] + base[e] + rank; slots[F.tid] = slot; WSP(int, OFF_TSLOT)[(size_t)tok * 2 + (F.tid & 1)] = slot; WSP(float, OFF_SRSTD)[slot] = WSP(const float, OFF_RSTDT)[tok]; WSP(int, OFF_STOK)[slot] = tok; }
        __syncthreads();
        if (blk == 0 && F.tid == 0) { const int ntl = pstart[32] >> 8; ctl[CW_NTILES + l] = (unsigned)ntl; int* te = WSP(int, OFF_TILEE);
            for (int e2 = 0; e2 < 32; ++e2) for (int tl = pstart[e2] >> 8; tl < (pstart[e2 + 1] >> 8); ++tl) te[tl] = e2; }
    }
    __syncthreads();
}
__device__ __forceinline__ void phase_combine(const Frame& F, const Prm& p, int l) {
    const int gw = F.vcu * 8 + F.wave, NGW = F.G * 8;
    const bool last = (l == NLAYER - 1);
    for (int tk0 = gw * 4; tk0 < NT; tk0 += NGW * 4) {
        int2 sl[4]; f32x2 gt[4];
#pragma unroll
        for (int q = 0; q < 4; ++q) { sl[q] = *(const int2*)(WSP(const int, OFF_TSLOT) + (size_t)(tk0 + q) * 2); gt[q] = *(const f32x2*)(WSP(const float, OFF_GATE) + (size_t)(tk0 + q) * 2); }
        f32x4 v[4][4]; h16x4 ya[4][4], yb[4][4];
#pragma unroll
        for (int q = 0; q < 4; ++q) { const h16* hrow = WSP(const h16, WS_HB) + (size_t)(tk0 + q) * DM; const h16* y0 = WSP(const h16, OFF_YP) + (size_t)sl[q].x * DM; const h16* y1 = WSP(const h16, OFF_YP) + (size_t)sl[q].y * DM;
#pragma unroll
            for (int j = 0; j < 4; ++j) { const int c = 4 * F.lane + 256 * j; const h16x4 hv = *(const h16x4*)(hrow + c); v[q][j] = (f32x4){(float)hv[0], (float)hv[1], (float)hv[2], (float)hv[3]}; ya[q][j] = *(const h16x4*)(y0 + c); yb[q][j] = *(const h16x4*)(y1 + c); } }
#pragma unroll
        for (int q = 0; q < 4; ++q) { float s = 0.f;
#pragma unroll
            for (int j = 0; j < 4; ++j) {
#pragma unroll
                for (int e = 0; e < 4; ++e) v[q][j][e] += gt[q][0] * (float)ya[q][j][e] + gt[q][1] * (float)yb[q][j][e];
                if (!last) { const h16x4 o = pack4(v[q][j]); v[q][j] = (f32x4){(float)o[0], (float)o[1], (float)o[2], (float)o[3]}; }
                s += (v[q][j][0] * v[q][j][0] + v[q][j][1] * v[q][j][1]) + (v[q][j][2] * v[q][j][2] + v[q][j][3] * v[q][j][3]); }
            s = wave_sum(s);
            if (!last) {
#pragma unroll
                for (int j = 0; j < 4; ++j) { const int c = 4 * F.lane + 256 * j; *(h16x4*)(WSP(h16, WS_HB) + (size_t)(tk0 + q) * DM + c) = pack4(v[q][j]); }
                if (F.lane < 16) WSP(float, WS_SSQ)[(size_t)(tk0 + q) * 16 + F.lane] = (F.lane == 0) ? s : 0.f;
                if (F.lane == 0) WSP(float, OFF_RSTDT)[tk0 + q] = 1.0f / sqrtf(s * (1.0f / DM) + EPS);
            } else { const float rs = 1.0f / sqrtf(s * (1.0f / DM) + EPS); float* orow = F.out + (size_t)(tk0 + q) * DM;
#pragma unroll
                for (int j = 0; j < 4; ++j) { const int c = 4 * F.lane + 256 * j; const f32x4 gf = *(const f32x4*)(inptr(F, 31) + c); *(f32x4*)(orow + c) = v[q][j] * rs * gf; } } }
    }
}

__global__ void __launch_bounds__(512, 2) fwd(Prm p) {
    extern __shared__ __attribute__((aligned(16))) unsigned char lds_raw[];
    Frame F; F.lds = (LAS unsigned char*)lds_raw; F.ws = (GAS unsigned char*)p.ws; F.out = p.out;
    F.tid = threadIdx.x; F.lane = F.tid & 63; F.wave = __builtin_amdgcn_readfirstlane(F.tid >> 6);
    F.G = gridDim.x; { const int bx = blockIdx.x; F.vcu = (F.G % 8 == 0) ? (bx % 8) * (F.G / 8) + bx / 8 : bx; }
    volatile LAS unsigned* misc = (volatile LAS unsigned*)(F.lds + LDS_MISC);
    if (F.tid < 4) misc[F.tid] = 0u;
    F.ptab = (volatile LAS unsigned long long*)(F.lds + LDS_MISC + 64);
    if (F.tid < 32) F.ptab[F.tid] = (unsigned long long)p.in[F.tid];
    __syncthreads();
    const int lo = p.ph_lo, hi = p.ph_hi;
    XcdBarrier bar; bar.bar = WSP(unsigned, WS_CTL) + CW_BAR; bar.x = 0; bar.st = misc;
    if (hi - lo > 1) bar = xcd_barrier_post(WSP(unsigned, WS_CTL) + CW_BAR, misc);
#ifndef UMASK
#define UMASK 7
#endif
#ifndef REPMASK
#define REPMASK 0
#endif
#ifndef PHMASK
#define PHMASK 0x3fff
#endif
#define IN(k) (((PHMASK >> ((k) % NPH)) & 1) && lo <= (k) && (k) < hi && (launder(F), true))
#define REPS(k) (((REPMASK >> (k)) & 1) ? 2 : 1)
#define INR(k) (lo <= (k) && (k) < hi)
#ifndef AMPMASK
#define AMPMASK 0
#endif
    unsigned long long tprev = AMPMASK ? __builtin_amdgcn_s_memrealtime() : 0ull;
#define SEAM(k) do { if (INR(k) && INR((k) + 1)) { xcd_barrier(bar); if (AMPMASK) { const unsigned long long tn = __builtin_amdgcn_s_memrealtime(); \
        if ((AMPMASK >> ((k) % NPH)) & 1) { const unsigned long long tgt = tn + 4ull * (tn - tprev); while (__builtin_amdgcn_s_memrealtime() < tgt) __builtin_amdgcn_s_sleep(8); } \
        tprev = __builtin_amdgcn_s_memrealtime(); } } } while (0)
    for (int l = 0; l < NLAYER; ++l) {
        const int pb = l * NPH;
        if (IN(pb + 0)) for (int rep = 0; rep < REPS(0); ++rep) { phase_convert(F, p, l); } SEAM(pb + 0);
        if (REPS(20) == 2 && INR(pb + 0) && INR(pb + 1)) { for (int q = 0; q < 20; ++q) xcd_barrier(bar); }
        if (IN(pb + 1)) for (int rep = 0; rep < REPS(1); ++rep) {
            if (UMASK & 1) { pg8::Gemm g{WSP(const h16, WS_HB), WSP(const h16, WS_WIN), DM, DM, DM, nullptr}; pg8::StaticOrder S; S.init(NT, NPJ, F.G, (int)blockIdx.x);
              pg8::EpiScale16C E{WSP(h16, WS_R1), NPJ, WSP(const float, OFF_RSTDT)}; pg8::gemm_phase(F.lds, F.tid, g, S, E); }
        } SEAM(pb + 1);
        if (IN(pb + 2)) for (int rep = 0; rep < REPS(2); ++rep) {
            if (UMASK & 1) for (int r2 = 0; r2 < REPS(17); ++r2) for (int u = blockIdx.x; u < NB * NCH * 2; u += F.G) ssd_states_unit(F, p, l, u);
            launder(F);
            if (UMASK & 2) for (int r2 = 0; r2 < REPS(18); ++r2) for (int u = blockIdx.x; u < NB * NCH; u += F.G) ret_states_block(F, u);
            launder(F);
            if (UMASK & 4) for (int r2 = 0; r2 < REPS(19); ++r2) for (int u = blockIdx.x; u < NB * NCH; u += F.G) lru_unit(F, p, l, u);
        } SEAM(pb + 2);
        if (IN(pb + 3)) for (int rep = 0; rep < REPS(3); ++rep) {
            const bool split = (F.G == 256); const int GS = split ? 128 : F.G;
            if (!split || blockIdx.x < 128) {
                for (int u = blockIdx.x; u < 2 * NB * 6; u += GS) ssd_scan_unit(F, u);
                launder(F);
                for (int u = blockIdx.x; u < 2 * NB * 6; u += GS) ret_scan_unit(F, u);
                lru_scan(F); }
            launder(F);
            if (!split || blockIdx.x >= 128) {
                pg8::Gemm g{WSP(const h16, WS_MEM16), WSP(const h16, WS_WKV), DM, DM, DM, nullptr}; pg8::StaticOrder S; S.init(NTM, 2048, GS, split ? (int)blockIdx.x - 128 : (int)blockIdx.x);
                pg8::EpiKV E{WSP(h16, OFF_KB), WSP(h16, OFF_VT), WSP(const float, OFF_MSSQ)}; pg8::gemm_phase(F.lds, F.tid, g, S, E); }
        } SEAM(pb + 3);
        if (IN(pb + 4)) for (int rep = 0; rep < REPS(4); ++rep) {
            if (UMASK & 1) for (int r2 = 0; r2 < REPS(14); ++r2) for (int u = blockIdx.x; u < NB * NCH * 2; u += F.G) ssd_out_unit(F, p, l, u);
            launder(F);
            if (UMASK & 2) for (int r2 = 0; r2 < REPS(15); ++r2) for (int u = blockIdx.x; u < NB * NCH; u += F.G) ret_out_block(F, u);
            launder(F);
            if (UMASK & 4) for (int r2 = 0; r2 < REPS(16); ++r2) for (int u = blockIdx.x; u < NB * NCH; u += F.G) lru_out_unit(F, u);
        } SEAM(pb + 4);
        if (IN(pb + 5)) for (int rep = 0; rep < REPS(5); ++rep) { pg8::Gemm g{WSP(const h16, OFF_OMIX), WSP(const h16, WS_WOUT), DM, DM, DM, nullptr}; pg8::StaticOrder S; S.init(NT, DM, F.G, (int)blockIdx.x);
            pg8::EpiResid E{WSP(h16, WS_HB), WSP(float, WS_SSQ)}; pg8::gemm_phase(F.lds, F.tid, g, S, E); } SEAM(pb + 5);
        if (IN(pb + 6)) for (int rep = 0; rep < REPS(6); ++rep) { pg8::Gemm g{WSP(const h16, WS_HB), WSP(const h16, WS_WQ), DM, DM, DM, nullptr}; pg8::StaticOrder S; S.init(NT, DM, F.G, (int)blockIdx.x);
            pg8::EpiScale16 E{WSP(h16, OFF_QCA), DM, WSP(const float, WS_SSQ)}; pg8::gemm_phase(F.lds, F.tid, g, S, E); } SEAM(pb + 6);
        if (IN(pb + 7)) for (int rep = 0; rep < REPS(7); ++rep) { attn_phase(F); } SEAM(pb + 7);
        if (IN(pb + 8)) for (int rep = 0; rep < REPS(8); ++rep) { pg8::Gemm g{WSP(const h16, OFF_OATT), WSP(const h16, WS_WO), DM, DM, DM, nullptr}; pg8::StaticOrder S; S.init(NT, DM, F.G, (int)blockIdx.x);
            pg8::EpiResid E{WSP(h16, WS_HB), WSP(float, WS_SSQ)}; pg8::gemm_phase(F.lds, F.tid, g, S, E); } SEAM(pb + 8);
        if (IN(pb + 9)) for (int rep = 0; rep < REPS(9); ++rep) { phase_router(F, p, l); } SEAM(pb + 9);
        if (IN(pb + 10)) for (int rep = 0; rep < REPS(10); ++rep) { phase_dispatch(F, l); } SEAM(pb + 10);
        if (IN(pb + 11)) for (int rep = 0; rep < REPS(11); ++rep) { pg8::Gemm g{WSP(const h16, WS_HB), WSP(const h16, WS_W13), DM, DM, DM, WSP(const int, OFF_STOK)};
            pg8::GroupOrder S{WSP(const int, OFF_TILEE), __builtin_amdgcn_readfirstlane((int)WSP(const unsigned, WS_CTL)[CW_NTILES + l]), F.G, F.vcu};
            pg8::EpiGated E{WSP(h16, OFF_HP), WSP(const float, OFF_SRSTD)}; pg8::gemm_phase<pg8::EpiGated, pg8::GroupOrder, true>(F.lds, F.tid, g, S, E); } SEAM(pb + 11);
        if (IN(pb + 12)) for (int rep = 0; rep < REPS(12); ++rep) { pg8::Gemm g{WSP(const h16, OFF_HP), WSP(const h16, WS_W2), 512, 512, 512, nullptr};
            pg8::GroupOrder S{WSP(const int, OFF_TILEE), __builtin_amdgcn_readfirstlane((int)WSP(const unsigned, WS_CTL)[CW_NTILES + l]), F.G, F.vcu};
            pg8::EpiPlain16 E{WSP(h16, OFF_YP)}; pg8::gemm_phase(F.lds, F.tid, g, S, E); } SEAM(pb + 12);
        if (IN(pb + 13)) for (int rep = 0; rep < REPS(13); ++rep) { phase_combine(F, p, l); } SEAM(pb + 13);
    }
#undef IN
#undef INR
#undef SEAM
}

extern "C" void kernel_launch(void* const* d_in, const int* in_sizes, int n_in, void* d_out, int out_size, void* d_ws, size_t ws_size, hipStream_t stream) {
    static int grid = 0;
    if (grid == 0) {
        if (n_in != 32 || out_size != NT * DM || ws_size < WS_END) { fprintf(stderr, "kernel_launch: unexpected shapes / workspace (%d inputs, out %d, ws %zu < %zu)\n", n_in, out_size, ws_size, (size_t)WS_END); grid = -1; return; }
        int dev = 0, cus = 0, per_cu = 0;
        if (hipGetDevice(&dev) != hipSuccess || hipDeviceGetAttribute(&cus, hipDeviceAttributeMultiprocessorCount, dev) != hipSuccess) { grid = -1; return; }
        if (hipFuncSetAttribute((const void*)fwd, hipFuncAttributeMaxDynamicSharedMemorySize, LDS_BYTES) != hipSuccess) { fprintf(stderr, "kernel_launch: hipFuncSetAttribute failed\n"); grid = -1; return; }
        if (hipOccupancyMaxActiveBlocksPerMultiprocessor(&per_cu, (const void*)fwd, 512, LDS_BYTES) != hipSuccess || per_cu < 1) { fprintf(stderr, "kernel_launch: occupancy query says %d\n", per_cu); }
        (void)hipGetLastError();
        grid = cus;
    }
    if (grid < 0) return;
    (void)hipMemsetAsync((char*)d_ws + WS_CTL, 0, CTL_ZERO_BYTES, stream);
    Prm p{};
    for (int i = 0; i < 32; ++i) p.in[i] = (const float*)d_in[i];
    p.out = (float*)d_out; p.ws = (unsigned char*)d_ws;
#if defined(PROBE_PHASE)
    p.ph_lo = 0; p.ph_hi = PROBE_PHASE + 1; hipLaunchKernelGGL(fwd, dim3(grid), dim3(512), LDS_BYTES, stream, p);
    (void)hipMemsetAsync((char*)d_ws + WS_CTL + CW_BAR * 4, 0, XCD_BAR_WORDS * 4, stream);
    p.ph_lo = PROBE_PHASE; p.ph_hi = PROBE_PHASE + 1; hipLaunchKernelGGL(fwd, dim3(grid), dim3(512), LDS_BYTES, stream, p);
    p.ph_lo = PROBE_PHASE + 1; p.ph_hi = NPHASES; hipLaunchKernelGGL(fwd, dim3(grid), dim3(512), LDS_BYTES, stream, p);
#elif MK_SINGLE
    p.ph_lo = 0; p.ph_hi = NPHASES;
    hipLaunchKernelGGL(fwd, dim3(grid), dim3(512), LDS_BYTES, stream, p);
#else
    for (int ph = 0; ph < NPHASES; ++ph) { p.ph_lo = ph; p.ph_hi = ph + 1; hipLaunchKernelGGL(fwd, dim3(grid), dim3(512), LDS_BYTES, stream, p); }
#endif
}
```

```cpp
#include <hip/hip_runtime.h>
#include <cstdio>
#include <cstdint>

#ifndef MK_SINGLE
#define MK_SINGLE 1
#endif

typedef _Float16 h16;
typedef _Float16 h16x2 __attribute__((ext_vector_type(2)));
typedef _Float16 h16x4 __attribute__((ext_vector_type(4)));
typedef _Float16 h16x8 __attribute__((ext_vector_type(8)));
typedef float f32x2 __attribute__((ext_vector_type(2)));
typedef float f32x4 __attribute__((ext_vector_type(4)));
typedef unsigned u32x2 __attribute__((ext_vector_type(2)));
typedef unsigned u32x4 __attribute__((ext_vector_type(4)));
#define LAS __attribute__((address_space(3)))
#define GAS __attribute__((address_space(1)))
#define PIN() do { asm volatile("" ::: "memory"); __builtin_amdgcn_sched_barrier(0); } while (0)
#define PINV(x) asm volatile("" : "+v"(x) :: "memory")
#define MFMA16(a, b, c) __builtin_amdgcn_mfma_f32_16x16x32_f16((a), (b), (c), 0, 0, 0)

constexpr int NB = 16, SEQ = 2048, DM = 1024, NT = NB * SEQ, MEML = 256, NTM = NB * MEML, NLAYER = 2;
constexpr int NPJ = 3584;
constexpr int CQ = 0, CK = 384, CV = 768, CG = 1152, CZ = 1536, CXS = 1920, CBM = 2304, CCM = 2560, CXR = 2816, CGT = 3072, CDT = 3328;
constexpr int DIN = 3334, NCH = 16, MAXSLOT = 73728;
constexpr float EPS = 1e-6f;
constexpr int NPH = 14;
constexpr int NPHASES = NLAYER * NPH;

constexpr size_t MiB = (size_t)1 << 20;
constexpr size_t WS_CTL = 0, CTL_ZERO_BYTES = 64 * 1024;
constexpr size_t WS_WIN = 1 * MiB, WS_WOUT = 8 * MiB, WS_WQ = 10 * MiB, WS_WKV = 12 * MiB, WS_WO = 16 * MiB, WS_W13 = 18 * MiB, WS_W2 = 82 * MiB, WS_LRUW = 114 * MiB;
constexpr size_t WS_HB = 115 * MiB;
constexpr size_t WS_R1 = 179 * MiB;
constexpr size_t WS_R2 = 403 * MiB;
constexpr size_t WS_KV = 547 * MiB, WS_MEM16 = 563 * MiB, WS_SSQ = 571 * MiB, WS_MISC = 573 * MiB, WS_END = 577 * MiB;
constexpr size_t OFF_QCA = WS_R1, OFF_OATT = WS_R1 + 64 * MiB, OFF_XP = WS_R1, OFF_HP = WS_R1 + 144 * MiB;
constexpr size_t OFF_OMIX = WS_R2, OFF_RST = WS_R2 + 64 * MiB, OFF_SST = WS_R2 + 88 * MiB, OFF_LSUM = WS_R2 + 136 * MiB, OFF_SDEC = WS_R2 + 137 * MiB, OFF_LCAR = WS_R2 + 138 * MiB, OFF_YP = WS_R2;
constexpr size_t OUT_XTG = 0, OUT_BCN = 24 * MiB, OUT_LAU = 56 * MiB;
constexpr size_t OFF_KB = WS_KV, OFF_VT = WS_KV + 8 * MiB;
constexpr size_t OFF_ROPE = WS_MISC, OFF_MSSQ = WS_MISC + 512 * 1024, OFF_EID = WS_MISC + 768 * 1024, OFF_GATE = WS_MISC + 1024 * 1024, OFF_TSLOT = WS_MISC + 1280 * 1024,
                 OFF_RSTDT = WS_MISC + 1536 * 1024, OFF_SRSTD = WS_MISC + 1664 * 1024, OFF_TILEE = WS_MISC + 2000 * 1024, OFF_STOK = WS_MISC + 2048 * 1024, OFF_RWG = WS_MISC + 2400 * 1024;
constexpr int CW_COUNTS = 64, CW_CURSOR = 192, CW_NTILES = 320, CW_BAR = 4096;

constexpr int LDS_BYTES = 152 * 1024;
constexpr int LDS_MISC = 150 * 1024;

struct Prm { const float* in[32]; float* out; unsigned char* ws; int ph_lo, ph_hi; };

#define XB_TMO      128
#define XB_XCNT(j)  (256  + 64 * (j))
#define XB_XSUB(j)  (1280 + 64 * (j))
#define XB_XGEN(j)  (2304 + 64 * (j))
#define XB_TOP      3328
#define XB_TOPGEN   3392
#define XCD_BAR_WORDS 3456
#define XB_SPIN_CAP (1u << 18)
__device__ __forceinline__ unsigned xb_ld(unsigned* p)              { return __hip_atomic_load(p, __ATOMIC_RELAXED, __HIP_MEMORY_SCOPE_AGENT); }
__device__ __forceinline__ unsigned xb_add(unsigned* p, unsigned v) { return __hip_atomic_fetch_add(p, v, __ATOMIC_RELAXED, __HIP_MEMORY_SCOPE_AGENT); }
__device__ __forceinline__ unsigned xb_xcc_id() { return (unsigned)__builtin_amdgcn_s_getreg((3 << 11) | 20) & 0xFu; }
#define XB_SPIN(cond, bar) do { unsigned _sp = 0; while (cond) { __builtin_amdgcn_s_sleep(1); \
    if ((++_sp & 255u) == 0u) { if (xb_ld(&(bar)[XB_TMO])) break; if (_sp > XB_SPIN_CAP) { atomicAdd(&(bar)[XB_TMO], 1u); break; } } } } while (0)
struct XcdBarrier { unsigned* bar; unsigned x; volatile LAS unsigned* st; };
__device__ __forceinline__ XcdBarrier xcd_barrier_post(unsigned* bar, volatile LAS unsigned* st) {
    XcdBarrier b; b.bar = bar; b.x = xb_xcc_id(); b.st = st;
    if (threadIdx.x == 0) (void)xb_add(&bar[XB_XCNT(b.x)], 1u);
    return b;
}
__device__ __forceinline__ void xcd_barrier_complete(unsigned* bar, unsigned x, unsigned& nloc, unsigned& nx) {
    const unsigned G = gridDim.x * gridDim.y * gridDim.z;
    unsigned sum, cnt, mine, sp = 0u;
    for (;;) {
        sum = 0u; cnt = 0u; mine = 0u;
#pragma unroll
        for (unsigned j = 0; j < 16; ++j) { const unsigned c = xb_ld(&bar[XB_XCNT(j)]); sum += c; cnt += (c > 0u) ? 1u : 0u; mine = (j == x) ? c : mine; }
        if (sum == G) break;
        __builtin_amdgcn_s_sleep(1);
        if ((++sp & 255u) == 0u) { if (xb_ld(&bar[XB_TMO])) break; if (sp > XB_SPIN_CAP) { atomicAdd(&bar[XB_TMO], 1u); break; } }
    }
    nloc = mine > 0u ? mine : 1u; nx = cnt > 0u ? cnt : 1u;
}
__device__ __forceinline__ void xcd_barrier(const XcdBarrier& b) {
    asm volatile("s_waitcnt vmcnt(0)" ::: "memory");
    __syncthreads();
    if (threadIdx.x == 0) {
        unsigned* bar = b.bar;
        __builtin_amdgcn_s_waitcnt(0);
        unsigned nloc = b.st[0], nx = b.st[1];
        if (nloc == 0u) { xcd_barrier_complete(bar, b.x, nloc, nx); b.st[0] = nloc; b.st[1] = nx; }
        const unsigned old = xb_add(&bar[XB_XSUB(b.x)], 1u);
        const unsigned gen = old / nloc;
        if (old + 1u == (gen + 1u) * nloc) {
            __builtin_amdgcn_fence(__ATOMIC_RELEASE, "agent");
            asm volatile("s_waitcnt vmcnt(0)" ::: "memory");
            const unsigned og = xb_add(&bar[XB_TOP], 1u);
            const unsigned tg = og / nx;
            if (og + 1u == (tg + 1u) * nx) xb_add(&bar[XB_TOPGEN], 1u);
            else XB_SPIN(xb_ld(&bar[XB_TOPGEN]) == tg, bar);
            __builtin_amdgcn_fence(__ATOMIC_ACQUIRE, "agent");
            xb_add(&bar[XB_XGEN(b.x)], 1u);
            asm volatile("s_waitcnt vmcnt(0)" ::: "memory");
        } else {
            XB_SPIN(xb_ld(&bar[XB_XGEN(b.x)]) == gen, bar);
            __builtin_amdgcn_fence(__ATOMIC_ACQUIRE, "agent");
            asm volatile("s_waitcnt vmcnt(0)" ::: "memory");
        }
    }
    __syncthreads();
}

__device__ __forceinline__ float wave_sum(float v) {
#pragma unroll
    for (int o = 1; o < 64; o <<= 1) v += __shfl_xor(v, o);
    return v;
}
__device__ __forceinline__ float siluf_(float x) { return x * __builtin_amdgcn_rcpf(1.0f + __expf(-x)); }
__device__ __forceinline__ float softplusf_(float x) { return x > 20.f ? x : log1pf(__expf(x)); }
__device__ __forceinline__ float gelu_tanh_(float x) { const float y = 0.7978845608028654f * (x + 0.044715f * x * x * x); const float t = 1.0f - 2.0f / (__expf(2.0f * y) + 1.0f); return 0.5f * x * (1.0f + t); }
__device__ __forceinline__ h16x8 pack8(const f32x4 a, const f32x4 b) { h16x8 r; r[0] = (h16)a[0]; r[1] = (h16)a[1]; r[2] = (h16)a[2]; r[3] = (h16)a[3]; r[4] = (h16)b[0]; r[5] = (h16)b[1]; r[6] = (h16)b[2]; r[7] = (h16)b[3]; return r; }
__device__ __forceinline__ h16x4 pack4(const f32x4 a) { h16x4 r; r[0] = (h16)a[0]; r[1] = (h16)a[1]; r[2] = (h16)a[2]; r[3] = (h16)a[3]; return r; }
__device__ __forceinline__ h16x8 ldsfrag(LAS const h16* p) { return *(LAS const h16x8*)p; }
__device__ __forceinline__ int kperm32(int k) { return (k & ~31) | (((k >> 2) & 3) << 3) | (((k >> 4) & 1) << 2) | (k & 3); }
__device__ __forceinline__ h16x8 scalefrag(const h16x8 f, float s) { const h16 hs = (h16)s; h16x8 v;
#pragma unroll
    for (int j = 0; j < 8; ++j) v[j] = hs; return f * v; }
__device__ __forceinline__ float row_rstd(const float* ssq16) {
    const f32x4 a = *(const f32x4*)ssq16, b = *(const f32x4*)(ssq16 + 4), c = *(const f32x4*)(ssq16 + 8), d = *(const f32x4*)(ssq16 + 12);
    const float s = ((a[0] + a[1]) + (a[2] + a[3])) + ((b[0] + b[1]) + (b[2] + b[3])) + ((c[0] + c[1]) + (c[2] + c[3])) + ((d[0] + d[1]) + (d[2] + d[3]));
    return 1.0f / sqrtf(s * (1.0f / DM) + EPS);
}

namespace pg8 {
constexpr int BM = 256, BK = 64, HALF = 128, HTB = HALF * BK * 2, STAGE_BYTES = 8 * HTB, NXCD = 8, WGM = 8;
__host__ __device__ __forceinline__ int lds_byte(int r, int c) { const int st = (r >> 4) * 2 + (c >> 5), rr = r & 15, cc = c & 31, ob = rr * 64 + cc * 2; return st * 1024 + (ob ^ (((ob >> 9) & 1) << 5)); }
__host__ __device__ __forceinline__ void stage_rc(int b, int& R, int& C) { const int st = b / 1024, sb = b % 1024, swz = sb ^ (((sb >> 9) & 1) << 5); R = (st >> 1) * 16 + swz / 64; C = (st & 1) * 32 + (swz % 64) / 2; }
__host__ __device__ __forceinline__ int perm32(int rho) { const int n = rho >> 4, i = rho & 15; return 8 * (i >> 2) + 4 * n + (i & 3); }
struct Unit { int pm, pn; };
struct Gemm { const h16* A; const h16* Bt; int lda, ldb, K; const int* rowidx; };
struct StaticOrder {
    int nM, nN, nwg, G, c;
    __device__ void init(int M, int N, int G_, int c_) { nM = M / BM; nN = N / BM; nwg = nM * nN; G = G_; c = c_; }
    __device__ bool next(int i, Unit& u) const {
        const long L = (long)i * G + c; if (L >= nwg) return false;
        int wgid = (int)L; { const int q = nwg / NXCD, r = nwg % NXCD, xcd = wgid % NXCD, off = wgid / NXCD; wgid = (xcd < r ? xcd * (q + 1) : r * (q + 1) + (xcd - r) * q) + off; }
        const int nig = WGM * nN, gid = wgid / nig, fm = gid * WGM, gsz = (nM - fm) < WGM ? (nM - fm) : WGM;
        u.pm = fm + ((wgid % nig) % gsz); u.pn = (wgid % nig) / gsz; return true;
    }
};
struct GroupOrder {
    const int* tile_e; int ntiles, G, vcu;
    __device__ bool next(int i, Unit& u) const {
        const int L = i * G + vcu, tile = L >> 2; if (tile >= ntiles) return false;
        u.pm = tile; u.pn = __builtin_amdgcn_readfirstlane(tile_e[tile]) * 4 + (L & 3); return true;
    }
};

struct EpiScale16 {
    static constexpr bool PERM = true;
    h16* O; int ldc; const float* ssq;
    __device__ __forceinline__ void operator()(const f32x4 (&acc)[2][2][4][2], const Unit& u, int wr, int wc, int fr, int fq) const {
        const int row0 = u.pm * BM + wr * 64 + fr, col0 = u.pn * BM + wc * 32 + 8 * fq;
#pragma unroll
        for (int ai = 0; ai < 2; ++ai)
#pragma unroll
            for (int m = 0; m < 4; ++m) { const int row = row0 + ai * HALF + m * 16; const float rs = row_rstd(ssq + (size_t)row * 16); h16* rowp = O + (size_t)row * ldc + col0;
#pragma unroll
                for (int bj = 0; bj < 2; ++bj) *(h16x8*)(rowp + bj * HALF) = pack8(acc[ai][bj][m][0] * rs, acc[ai][bj][m][1] * rs); }
    }
};
struct EpiScale16C {
    static constexpr bool PERM = true;
    h16* O; int ldc; const float* rstd;
    __device__ __forceinline__ void operator()(const f32x4 (&acc)[2][2][4][2], const Unit& u, int wr, int wc, int fr, int fq) const {
        const int row0 = u.pm * BM + wr * 64 + fr, col0 = u.pn * BM + wc * 32 + 8 * fq;
        float rs[2][4];
#pragma unroll
        for (int ai = 0; ai < 2; ++ai)
#pragma unroll
            for (int m = 0; m < 4; ++m) rs[ai][m] = rstd[row0 + ai * HALF + m * 16];
#pragma unroll
        for (int ai = 0; ai < 2; ++ai)
#pragma unroll
            for (int m = 0; m < 4; ++m) { h16* rowp = O + (size_t)(row0 + ai * HALF + m * 16) * ldc + col0;
#pragma unroll
                for (int bj = 0; bj < 2; ++bj) *(h16x8*)(rowp + bj * HALF) = pack8(acc[ai][bj][m][0] * rs[ai][m], acc[ai][bj][m][1] * rs[ai][m]); }
    }
};
struct EpiKV {
    static constexpr bool PERM = true;
    h16* KB; h16* VT; const float* ssq;
    __device__ __forceinline__ void operator()(const f32x4 (&acc)[2][2][4][2], const Unit& u, int wr, int wc, int fr, int fq) const {
        const int row0 = u.pm * BM + wr * 64 + fr;
#pragma unroll
        for (int ai = 0; ai < 2; ++ai)
#pragma unroll
            for (int m = 0; m < 4; ++m) { const int row = row0 + ai * HALF + m * 16; const float rs = row_rstd(ssq + (size_t)row * 16);
                h16x8 pk[2];
#pragma unroll
                for (int bj = 0; bj < 2; ++bj) pk[bj] = pack8(acc[ai][bj][m][0] * rs, acc[ai][bj][m][1] * rs);
                if (u.pn < 4) { h16* rowp = KB + (size_t)row * DM + u.pn * BM + wc * 32 + 8 * fq;
                    *(h16x8*)rowp = pk[0]; *(h16x8*)(rowp + HALF) = pk[1];
                } else { const int b = row >> 8, k0 = row & 255, hd = u.pn - 4;
                    const int key = (k0 & ~31) | (((k0 >> 2) & 3) << 3) | (((k0 >> 4) & 1) << 2) | (k0 & 3);
                    h16* base = VT + ((size_t)(b * 4 + hd) * 256 + wc * 32 + 8 * fq) * 256 + key;
#pragma unroll
                    for (int bj = 0; bj < 2; ++bj)
#pragma unroll
                        for (int j = 0; j < 8; ++j) base[(bj * HALF + j) * 256] = pk[bj][j]; }
                PIN();
            }
    }
};
struct EpiResid {
    static constexpr bool PERM = true;
    h16* hb; float* ssq;
    __device__ __forceinline__ void operator()(const f32x4 (&acc)[2][2][4][2], const Unit& u, int wr, int wc, int fr, int fq) const {
        const int row0 = u.pm * BM + wr * 64 + fr, col0 = u.pn * BM + wc * 32 + 8 * fq;
#pragma unroll
        for (int ai = 0; ai < 2; ++ai)
#pragma unroll
            for (int m = 0; m < 4; ++m) { const int row = row0 + ai * HALF + m * 16; h16* rowp = hb + (size_t)row * DM + col0; float s = 0.f;
#pragma unroll
                for (int bj = 0; bj < 2; ++bj) { const h16x8 bv = *(const h16x8*)(rowp + bj * HALF); f32x4 v0, v1;
#pragma unroll
                    for (int e = 0; e < 4; ++e) { v0[e] = (float)bv[e] + acc[ai][bj][m][0][e]; v1[e] = (float)bv[4 + e] + acc[ai][bj][m][1][e]; }
                    const h16x8 o = pack8(v0, v1); *(h16x8*)(rowp + bj * HALF) = o;
#pragma unroll
                    for (int e = 0; e < 8; ++e) { const float q = (float)o[e]; s += q * q; } }
                s += __shfl_xor(s, 16); s += __shfl_xor(s, 32);
                if (fq == 0) ssq[(size_t)row * 16 + u.pn * 4 + wc] = s; }
    }
};
struct EpiGated {
    static constexpr bool PERM = true;
    h16* O; const float* srstd;
    __device__ __forceinline__ void operator()(const f32x4 (&acc)[2][2][4][2], const Unit& u, int wr, int wc, int fr, int fq) const {
        const int row0 = u.pm * BM + wr * 64 + fr, col0 = (u.pn & 3) * HALF + wc * 32 + 8 * fq;
#pragma unroll
        for (int ai = 0; ai < 2; ++ai)
#pragma unroll
            for (int m = 0; m < 4; ++m) { const int row = row0 + ai * HALF + m * 16; const float rs = srstd[row]; f32x4 o[2];
#pragma unroll
                for (int n = 0; n < 2; ++n)
#pragma unroll
                    for (int j = 0; j < 4; ++j) { const float a = acc[ai][0][m][n][j] * rs, b = acc[ai][1][m][n][j] * rs; o[n][j] = siluf_(a) * b; }
                *(h16x8*)(O + (size_t)row * 512 + col0) = pack8(o[0], o[1]); }
    }
};
struct EpiPlain16 {
    static constexpr bool PERM = true;
    h16* O;
    __device__ __forceinline__ void operator()(const f32x4 (&acc)[2][2][4][2], const Unit& u, int wr, int wc, int fr, int fq) const {
        const int row0 = u.pm * BM + wr * 64 + fr, col0 = (u.pn & 3) * BM + wc * 32 + 8 * fq;
#pragma unroll
        for (int ai = 0; ai < 2; ++ai)
#pragma unroll
            for (int m = 0; m < 4; ++m) { h16* rowp = O + (size_t)(row0 + ai * HALF + m * 16) * DM + col0;
#pragma unroll
                for (int bj = 0; bj < 2; ++bj) *(h16x8*)(rowp + bj * HALF) = pack8(acc[ai][bj][m][0], acc[ai][bj][m][1]); }
    }
};

template <class Epi, class Sched, bool GATHER = false>
__device__ __forceinline__ void gemm_phase(LAS unsigned char* lds, const int tid, const Gemm g, const Sched& S, const Epi& E) {
    const int wid = __builtin_amdgcn_readfirstlane(tid >> 6), lane = tid & 63, wr = wid >> 2, wc = wid & 3, fr = lane & 15, fq = lane >> 4;
    const int K = g.K, nt = K / BK;
    unsigned voffA[2], voffB[2];
#pragma unroll
    for (int i = 0; i < 2; ++i) { int R, C; stage_rc(tid * 16 + i * 8192, R, C); const int Rb = Epi::PERM ? ((R & ~31) + perm32(R & 31)) : R;
        voffA[i] = (unsigned)(R * g.lda + C) * 2u; voffB[i] = (unsigned)(Rb * g.ldb + C) * 2u; }
    const size_t kstep = (size_t)(BK * 2);
    const size_t hstepA = (size_t)HALF * g.lda * 2, hstepB = (size_t)HALF * g.ldb * 2;
    const size_t tstepA = 2 * hstepA, tstepB = 2 * hstepB;
    const unsigned ldsw = (unsigned)wid * 1024u;
    const int aoff = lds_byte(wr * 64 + fr, fq * 8), boff = lds_byte(wc * 32 + fr, fq * 8);
#define PG8_SA(b, h) (((b) * 2 + (h)) * HTB)
#define PG8_SB(b, h) ((4 + (b) * 2 + (h)) * HTB)
#define PG8_STAGE(bufoff, gbase, voff) do { _Pragma("unroll") for (int _i = 0; _i < 2; ++_i) \
        __builtin_amdgcn_global_load_lds((const unsigned*)((const char*)(gbase) + (voff)[_i]), (LAS unsigned*)(lds + (bufoff) + ldsw + _i * 8192), 16, 0, 0); } while (0)
    unsigned coff[2], noff[2], cbyte[2];
    if constexpr (GATHER) {
#pragma unroll
        for (int i = 0; i < 2; ++i) { int R_, C_; stage_rc(tid * 16 + i * 8192, R_, C_); cbyte[i] = (unsigned)(C_ * 2); } }
#define PG8_GOFF(u_, o_) do { _Pragma("unroll") for (int _i = 0; _i < 2; ++_i) { int R_, C_; stage_rc(tid * 16 + _i * 8192, R_, C_); \
        o_[_i] = (unsigned)g.rowidx[(u_).pm * BM + R_] | ((unsigned)g.rowidx[(u_).pm * BM + HALF + R_] << 16); } } while (0)
#define PG8_STAGEA(bufoff, gbase, h, sel) do { if constexpr (GATHER) { _Pragma("unroll") for (int _i = 0; _i < 2; ++_i) { const unsigned pk_ = (sel) ? noff[_i] : coff[_i]; \
        __builtin_amdgcn_global_load_lds((const unsigned*)((const char*)(gbase) + (((pk_ >> (16 * (h))) & 0xffffu) * (unsigned)(g.lda * 2) + cbyte[_i])), (LAS unsigned*)(lds + (bufoff) + ldsw + _i * 8192), 16, 0, 0); } } \
        else { PG8_STAGE(bufoff, (gbase) + ((h) ? hstepA : 0), voffA); } } while (0)
#define PG8_LDA(dst, b, h) do { _Pragma("unroll") for (int m = 0; m < 4; ++m) _Pragma("unroll") for (int k = 0; k < 2; ++k) dst[m][k] = *(const LAS h16x8*)(lds + PG8_SA(b, h) + aoff + m * 2048 + k * 1024); } while (0)
#define PG8_LDB(dst, b, h) do { _Pragma("unroll") for (int n = 0; n < 2; ++n) _Pragma("unroll") for (int k = 0; k < 2; ++k) dst[n][k] = *(const LAS h16x8*)(lds + PG8_SB(b, h) + boff + n * 2048 + k * 1024); } while (0)
#define PG8_MMA(ai, bj, At, Bt) do { __builtin_amdgcn_s_setprio(1); _Pragma("unroll") for (int m = 0; m < 4; ++m) _Pragma("unroll") for (int n = 0; n < 2; ++n) _Pragma("unroll") for (int k = 0; k < 2; ++k) \
        acc[ai][bj][m][n] = __builtin_amdgcn_mfma_f32_16x16x32_f16(Bt[n][k], At[m][k], acc[ai][bj][m][n], 0, 0, 0); __builtin_amdgcn_s_setprio(0); } while (0)
#define PG8_WAIT_V(n) asm volatile("s_waitcnt vmcnt(" #n ")" ::: "memory")
#define PG8_WAIT_L(n) asm volatile("s_waitcnt lgkmcnt(" #n ")" ::: "memory")
#define PG8_BAR __builtin_amdgcn_s_barrier()
#define PG8_SCHED __builtin_amdgcn_sched_barrier(0)
    Unit cur, nxt; int ui = 0;
    if (!S.next(0, cur)) return;
    f32x4 acc[2][2][4][2];
#pragma unroll
    for (int a = 0; a < 2; ++a)
#pragma unroll
        for (int b = 0; b < 2; ++b)
#pragma unroll
            for (int m = 0; m < 4; ++m)
#pragma unroll
                for (int n = 0; n < 2; ++n) acc[a][b][m][n] = (f32x4){0.f, 0.f, 0.f, 0.f};
    h16x8 At[4][2], B0[2][2], B1[2][2];
    const char* cA = (const char*)g.A + (GATHER ? (size_t)0 : (size_t)cur.pm * tstepA); const char* cB = (const char*)g.Bt + (size_t)cur.pn * tstepB;
    if constexpr (GATHER) { PG8_GOFF(cur, coff); noff[0] = coff[0]; noff[1] = coff[1]; }
    PG8_STAGE(PG8_SB(0, 0), cB, voffB); PG8_STAGE(PG8_SB(0, 1), cB + hstepB, voffB); PG8_STAGEA(PG8_SA(0, 0), cA, 0, false); PG8_STAGEA(PG8_SA(0, 1), cA, 1, false);
    if (wr == 1) PG8_BAR;
    PG8_WAIT_V(2); PG8_BAR;
    PG8_STAGE(PG8_SB(1, 0), cB + kstep, voffB); PG8_STAGEA(PG8_SA(1, 0), cA + kstep, 0, false); PG8_STAGE(PG8_SB(1, 1), cB + hstepB + kstep, voffB);
    PG8_WAIT_V(6); PG8_BAR;
    for (;;) {
        const bool has_next = S.next(ui + 1, nxt);
        const char* nA = (has_next && !GATHER) ? (const char*)g.A + (size_t)nxt.pm * tstepA : cA; const char* nB = has_next ? (const char*)g.Bt + (size_t)nxt.pn * tstepB : cB;
        if constexpr (GATHER) { if (has_next) PG8_GOFF(nxt, noff); }
        for (int t = 0; t < nt; t += 2) {
            const bool last = (t == nt - 2);
            const char* a1 = cA + (size_t)(t + 1) * kstep;
            const char* a2 = last ? nA : cA + (size_t)(t + 2) * kstep; const char* b2 = last ? nB : cB + (size_t)(t + 2) * kstep;
            const char* a3 = a2 + kstep; const char* b3 = b2 + kstep;
            PG8_LDB(B0, 0, 0); PG8_LDB(B1, 0, 1); PG8_SCHED; PG8_LDA(At, 0, 0); PG8_STAGEA(PG8_SA(1, 1), a1, 1, false);
            PG8_WAIT_V(8); PG8_WAIT_L(0); PG8_BAR; PG8_MMA(0, 0, At, B0); PG8_MMA(0, 1, At, B1); PG8_BAR; PG8_SCHED;
            PG8_LDA(At, 0, 1); PG8_STAGE(PG8_SB(0, 0), b2, voffB); PG8_STAGE(PG8_SB(0, 1), b2 + hstepB, voffB); PG8_STAGEA(PG8_SA(0, 0), a2, 0, last);
            PG8_WAIT_V(8); PG8_WAIT_L(0); PG8_BAR; PG8_MMA(1, 0, At, B0); PG8_MMA(1, 1, At, B1); PG8_BAR; PG8_SCHED;
            PG8_LDB(B0, 1, 0); PG8_LDB(B1, 1, 1); PG8_SCHED; PG8_LDA(At, 1, 0); PG8_STAGEA(PG8_SA(0, 1), a2, 1, last);
            PG8_WAIT_V(8); PG8_WAIT_L(0); PG8_BAR; PG8_MMA(0, 0, At, B0); PG8_MMA(0, 1, At, B1); PG8_BAR; PG8_SCHED;
            PG8_LDA(At, 1, 1); PG8_STAGE(PG8_SB(1, 0), b3, voffB); PG8_STAGE(PG8_SB(1, 1), b3 + hstepB, voffB); PG8_STAGEA(PG8_SA(1, 0), a3, 0, last);
            PG8_WAIT_V(8); PG8_WAIT_L(0); PG8_BAR; PG8_MMA(1, 0, At, B0); PG8_MMA(1, 1, At, B1); PG8_BAR; PG8_SCHED;
        }
        if (wr == 0) PG8_BAR;
        E(acc, cur, wr, wc, fr, fq);
        if (!has_next) break;
#pragma unroll
        for (int a = 0; a < 2; ++a)
#pragma unroll
            for (int b = 0; b < 2; ++b)
#pragma unroll
                for (int m = 0; m < 4; ++m)
#pragma unroll
                    for (int n = 0; n < 2; ++n) acc[a][b][m][n] = (f32x4){0.f, 0.f, 0.f, 0.f};
        cur = nxt; cA = nA; cB = nB; ++ui;
        if constexpr (GATHER) { coff[0] = noff[0]; coff[1] = noff[1]; }
        if (wr == 1) PG8_BAR;
    }
    PG8_WAIT_V(0);
    PG8_BAR;
#undef PG8_SA
#undef PG8_SB
#undef PG8_STAGE
#undef PG8_LDA
#undef PG8_GOFF
#undef PG8_STAGEA
#undef PG8_LDB
#undef PG8_MMA
#undef PG8_WAIT_V
#undef PG8_WAIT_L
#undef PG8_BAR
#undef PG8_SCHED
}
}

struct Frame {
    LAS unsigned char* lds;
    GAS unsigned char* ws;
    volatile LAS unsigned long long* ptab;
    float* out;
    int tid, lane, wave, G, vcu;
};
#define WSP(T, off) ((T*)(GAS T*)(F.ws + (off)))
__device__ __forceinline__ const float* inptr(const Frame& F, int i) {
    const unsigned long long v = F.ptab[i];
    const unsigned lo = __builtin_amdgcn_readfirstlane((unsigned)v), hi = __builtin_amdgcn_readfirstlane((unsigned)(v >> 32));
    return (const float*)(GAS const float*)(((unsigned long long)hi << 32) | lo);
}
__device__ __forceinline__ void launder(Frame& F) {
    int wv = F.wave; asm volatile("" : "+s"(wv)); F.wave = wv;
    unsigned z = 0u; asm volatile("" : "+v"(z));
    int t = wv * 64 + (int)__builtin_amdgcn_mbcnt_hi(~0u, __builtin_amdgcn_mbcnt_lo(~0u, z)); F.tid = t; F.lane = t & 63;
    const unsigned long long w = (unsigned long long)F.ws; unsigned wl = __builtin_amdgcn_readfirstlane((unsigned)w), wh = __builtin_amdgcn_readfirstlane((unsigned)(w >> 32));
    asm volatile("" : "+s"(wl), "+s"(wh)); F.ws = (GAS unsigned char*)(((unsigned long long)wh << 32) | wl);
    unsigned lo = __builtin_amdgcn_readfirstlane((unsigned)(uintptr_t)F.lds); asm volatile("" : "+s"(lo)); F.lds = (LAS unsigned char*)(uintptr_t)lo;
    int v = __builtin_amdgcn_readfirstlane(F.vcu); asm volatile("" : "+s"(v)); F.vcu = v;
}

struct TrItem { const float* W; const float* g; h16* Wt; int ldw, sc, nvalid, ldt, d0, k0, vw; float mul; };
__device__ __forceinline__ void tr_describe(const Frame& F, GAS unsigned char* wsb_, int l, int it, TrItem& d) {
    unsigned char* wsb = (unsigned char*)wsb_;
    int r = it; d.g = nullptr; d.mul = 1.f; d.nvalid = 64; d.vw = 4; d.ldt = DM; d.ldw = DM;
    if (r < 896) { const int d0 = 64 * (r % 56); d.W = inptr(F, 3) + (size_t)l * DM * DIN; d.ldw = DIN; d.g = inptr(F, 2) + l * DM; d.Wt = (h16*)(wsb + WS_WIN); d.d0 = d0; d.k0 = 64 * (r / 56); d.vw = 2;
        if (d0 < 2816) d.sc = d0; else if (d0 < 3328) d.sc = d0 + 6; else if (d0 == 3328) { d.sc = 2816; d.nvalid = 6; } else { d.sc = 0; d.nvalid = 0; } return; } r -= 896;
    if (r < 256) { d.W = inptr(F, 4) + (size_t)l * DM * DM; d.Wt = (h16*)(wsb + WS_WOUT); d.d0 = d.sc = 64 * (r % 16); d.k0 = 64 * (r / 16); return; } r -= 256;
    if (r < 256) { d.W = inptr(F, 20) + (size_t)l * DM * DM; d.g = inptr(F, 18) + l * DM; d.mul = 0.0625f; d.Wt = (h16*)(wsb + WS_WQ); d.d0 = d.sc = 64 * (r % 16); d.k0 = 64 * (r / 16); return; } r -= 256;
    if (r < 512) { d.W = inptr(F, 21) + (size_t)l * DM * 2048; d.ldw = 2048; d.g = inptr(F, 19) + l * DM; d.Wt = (h16*)(wsb + WS_WKV); d.d0 = d.sc = 64 * (r % 32); d.k0 = 64 * (r / 32); return; } r -= 512;
    if (r < 256) { d.W = inptr(F, 22) + (size_t)l * DM * DM; d.Wt = (h16*)(wsb + WS_WO); d.d0 = d.sc = 64 * (r % 16); d.k0 = 64 * (r / 16); return; } r -= 256;
    if (r < 8192) { const int e = r / 256, q = r % 256, d0 = 64 * (q % 16), grp = d0 >> 8, rr = d0 & 255;
        d.W = (rr < 128 ? inptr(F, 28) : inptr(F, 29)) + (size_t)(l * 32 + e) * DM * 512; d.ldw = 512; d.sc = grp * 128 + (rr & 127); d.g = inptr(F, 23) + l * DM; d.Wt = (h16*)(wsb + WS_W13) + (size_t)e * DM * DM; d.d0 = d0; d.k0 = 64 * (q / 16); return; } r -= 8192;
    if (r < 4096) { const int e = r / 128, q = r % 128; d.W = inptr(F, 30) + (size_t)(l * 32 + e) * 512 * DM; d.Wt = (h16*)(wsb + WS_W2) + (size_t)e * DM * 512; d.ldt = 512; d.d0 = d.sc = 64 * (q % 16); d.k0 = 64 * (q / 16); return; } r -= 4096;
    { const int blk = r & 3, gate = (r >> 2) & 1, dir = r >> 3; d.W = (gate ? inptr(F, 16) : inptr(F, 14)) + (size_t)((l * 2 + dir) * 4 + blk) * 4096; d.ldw = 64; d.Wt = (h16*)(wsb + WS_LRUW) + (size_t)((dir * 2 + gate) * 4 + blk) * 4096; d.ldt = 64; d.d0 = d.sc = 0; d.k0 = 0; }
}
__device__ __forceinline__ void tr_load(const TrItem& d, int lane, f32x4 (&v)[16]) {
    if (d.vw == 4) { const int col = 4 * (lane & 15); const float* src = d.W + (size_t)(d.k0 + (lane >> 4)) * d.ldw + d.sc + col; const bool ok = col < d.nvalid;
#pragma unroll
        for (int i = 0; i < 16; ++i) v[i] = ok ? __builtin_nontemporal_load((const f32x4*)(src + (size_t)(4 * i) * d.ldw)) : (f32x4){0.f, 0.f, 0.f, 0.f};
    } else { const int col = 2 * (lane & 31); const float* src = d.W + (size_t)(d.k0 + (lane >> 5)) * d.ldw + d.sc + col; const bool ok = col < d.nvalid;
#pragma unroll
        for (int i = 0; i < 16; ++i) { const f32x2 a = ok ? __builtin_nontemporal_load((const f32x2*)(src + (size_t)(4 * i) * d.ldw)) : (f32x2){0.f, 0.f}, c = ok ? __builtin_nontemporal_load((const f32x2*)(src + (size_t)(4 * i + 2) * d.ldw)) : (f32x2){0.f, 0.f}; v[i] = (f32x4){a[0], a[1], c[0], c[1]}; } }
}
__device__ __forceinline__ void tr_to_lds(const TrItem& d, int lane, const f32x4 (&v)[16], LAS float* scr) {
    if (d.vw == 4) { LAS float* q = scr + (lane >> 4) * 65 + 4 * (lane & 15);
#pragma unroll
        for (int i = 0; i < 16; ++i) { q[(4 * i) * 65 + 0] = v[i][0]; q[(4 * i) * 65 + 1] = v[i][1]; q[(4 * i) * 65 + 2] = v[i][2]; q[(4 * i) * 65 + 3] = v[i][3]; }
    } else { LAS float* q = scr + (lane >> 5) * 65 + 2 * (lane & 31);
#pragma unroll
        for (int i = 0; i < 16; ++i) { q[(4 * i) * 65 + 0] = v[i][0]; q[(4 * i) * 65 + 1] = v[i][1]; q[(4 * i + 2) * 65 + 0] = v[i][2]; q[(4 * i + 2) * 65 + 1] = v[i][3]; } }
}
__device__ __forceinline__ void tr_from_lds(const TrItem& d, int lane, LAS const float* scr) {
    const int c = lane & 7; float gs[8];
    if (d.g) { const f32x4 g0 = *(const f32x4*)(d.g + d.k0 + 8 * c), g1 = *(const f32x4*)(d.g + d.k0 + 8 * c + 4);
        gs[0] = g0[0] * d.mul; gs[1] = g0[1] * d.mul; gs[2] = g0[2] * d.mul; gs[3] = g0[3] * d.mul; gs[4] = g1[0] * d.mul; gs[5] = g1[1] * d.mul; gs[6] = g1[2] * d.mul; gs[7] = g1[3] * d.mul;
    } else {
#pragma unroll
        for (int e = 0; e < 8; ++e) gs[e] = d.mul; }
#pragma unroll
    for (int j = 0; j < 8; ++j) { const int nn = (lane >> 3) + 8 * j; LAS const float* q = scr + (8 * c) * 65 + nn; h16x8 o;
#pragma unroll
        for (int e = 0; e < 8; ++e) o[e] = (h16)(q[e * 65] * gs[e]);
        *(h16x8*)(d.Wt + (size_t)(d.d0 + nn) * d.ldt + d.k0 + 8 * c) = o; }
}
__device__ __forceinline__ void phase_convert(const Frame& F, const Prm& p, int l) {
    LAS float* scr = (LAS float*)(F.lds + F.wave * 16640);
    const int gw = F.vcu * 8 + F.wave, NGW = F.G * 8;
    constexpr int NITEMS = 896 + 256 + 256 + 512 + 256 + 8192 + 4096 + 16;
    { TrItem cur, nxt; f32x4 v[16]; int it = gw;
        if (it < NITEMS) { tr_describe(F, F.ws, l, it, cur); tr_load(cur, F.lane, v); }
        while (it < NITEMS) { const int itn = it + NGW; const bool hn = itn < NITEMS;
            tr_to_lds(cur, F.lane, v, scr);
            if (hn) { tr_describe(F, F.ws, l, itn, nxt); tr_load(nxt, F.lane, v); }
            asm volatile("s_waitcnt lgkmcnt(0)" ::: "memory");
            tr_from_lds(cur, F.lane, scr);
            asm volatile("s_waitcnt lgkmcnt(0)" ::: "memory");
            cur = nxt; it = itn; } }
    {
        const float* gm = inptr(F, 23) + l * DM; const float* wg = inptr(F, 24) + (size_t)l * DM * 4; const float* we = inptr(F, 26) + (size_t)l * DM * 32; h16* rwg = WSP(h16, OFF_RWG);
        for (int i = F.vcu * 512 + F.tid; i < 36 * DM; i += 256 * 512) { const int k = i / 36, j = i % 36; const float wv = gm[k] * (j < 4 ? wg[k * 4 + j] : we[k * 32 + (j - 4)]) * 1024.0f;
            const h16 hi = (h16)wv; rwg[(size_t)j * 1032 + k] = hi; rwg[(size_t)(36 + j) * 1032 + k] = (h16)(wv - (float)hi); } }
    if (l == 0) {
        for (int m = gw; m < NT + NTM; m += NGW) {
            const bool isx = m < NT; const int row = isx ? m : m - NT;
            const float* src = (isx ? inptr(F, 0) : inptr(F, 1)) + (size_t)row * DM; h16* dst = (isx ? WSP(h16, WS_HB) : WSP(h16, WS_MEM16)) + (size_t)row * DM;
            float* sq = (isx ? WSP(float, WS_SSQ) : WSP(float, OFF_MSSQ)) + (size_t)row * 16;
            float s = 0.f;
#pragma unroll
            for (int j = 0; j < 4; ++j) { const f32x4 v = __builtin_nontemporal_load((const f32x4*)(src + 4 * F.lane + 256 * j)); *(h16x4*)(dst + 4 * F.lane + 256 * j) = pack4(v); s += (v[0] * v[0] + v[1] * v[1]) + (v[2] * v[2] + v[3] * v[3]); }
            s = wave_sum(s);
            if (F.lane < 16) sq[F.lane] = (F.lane == 0) ? s : 0.f;
            if (isx && F.lane == 0) WSP(float, OFF_RSTDT)[row] = 1.0f / sqrtf(s * (1.0f / DM) + EPS);
        }
        float* rope = WSP(float, OFF_ROPE);
        for (int i = F.vcu * 512 + F.tid; i < SEQ * 32; i += F.G * 512) {
            const int pos = i >> 5, fi = i & 31; double th = 1.0;
            for (int k = 0; k < fi; ++k) th *= 0.74989420933245582730;
            const double rev = (double)pos * th * 0.15915494309189533577;
            const double fr = rev - floor(rev);
            const double r = (fr - 0.5) * 6.28318530717958647692;
            const double r2 = r * r; double sn = 1.0, cs = 1.0;
            for (int k = 14; k >= 1; --k) { sn = 1.0 - r2 / (double)((2 * k) * (2 * k + 1)) * sn; cs = 1.0 - r2 / (double)((2 * k - 1) * (2 * k)) * cs; }
            sn *= r;
            rope[pos * 64 + fi] = (float)(-cs); rope[pos * 64 + 32 + fi] = (float)(-sn);
        }
    }
}

template <bool SILU>
__device__ __forceinline__ void conv_rows8(const h16* projcol, long tbase, int n, int r0, const float* cw, int cdim, const float* cb, h16x8 (&out)[8]) {
    f32x4 w[4][2];
#pragma unroll
    for (int k = 0; k < 4; ++k) { w[k][0] = *(const f32x4*)(cw + k * cdim); w[k][1] = *(const f32x4*)(cw + k * cdim + 4); }
    const f32x4 b0 = *(const f32x4*)cb, b1 = *(const f32x4*)(cb + 4);
    h16x8 x[11];
#pragma unroll
    for (int i = 0; i < 11; ++i) { const int pos = n * 128 + r0 - 2 + i; h16x8 z;
#pragma unroll
        for (int e = 0; e < 8; ++e) z[e] = (h16)0.f;
        x[i] = (pos >= 0 && pos < SEQ) ? *(const h16x8*)(projcol + (size_t)(tbase + r0 - 2 + i) * NPJ) : z; }
#pragma unroll
    for (int r = 0; r < 8; ++r) {
#pragma unroll
        for (int e = 0; e < 8; ++e) { float a = e < 4 ? b0[e] : b1[e - 4];
#pragma unroll
            for (int k = 0; k < 4; ++k) a += (e < 4 ? w[k][0][e] : w[k][1][e - 4]) * (float)x[r + k][e];
            out[r][e] = (h16)(SILU ? siluf_(a) : a); } }
}
__device__ __forceinline__ h16x8 col_of(const h16x8 (&o)[8], int e) { h16x8 c; c[0] = o[0][e]; c[1] = o[1][e]; c[2] = o[2][e]; c[3] = o[3][e]; c[4] = o[4][e]; c[5] = o[5][e]; c[6] = o[6][e]; c[7] = o[7][e]; return c; }

__device__ __forceinline__ void ret_scan_unit(const Frame& F, int u) {
    const int h = u % 6, b = (u / 6) % NB, dir = u / (6 * NB);
    const float gC = exp2f(128.0f * log1pf(-exp2f(-5.0f - (float)h)) * 1.4426950408889634f);
    h16* base = WSP(h16, OFF_RST) + ((size_t)((dir * NB + b) * NCH) * 6 + h) * 4096 + F.tid * 8;
    float acc[8];
#pragma unroll
    for (int e = 0; e < 8; ++e) acc[e] = 0.f;
#pragma unroll 1
    for (int half = 0; half < 2; ++half) { h16x8 sv[8];
#pragma unroll
        for (int i = 0; i < 8; ++i) { const int ii = 8 * half + i, n = dir == 0 ? ii : NCH - 1 - ii; sv[i] = *(const h16x8*)(base + (size_t)n * 6 * 4096); }
#pragma unroll
        for (int i = 0; i < 8; ++i) { const int ii = 8 * half + i, n = dir == 0 ? ii : NCH - 1 - ii; h16x8 o;
#pragma unroll
            for (int e = 0; e < 8; ++e) { o[e] = (h16)acc[e]; acc[e] = acc[e] * gC + (float)sv[i][e]; }
            *(h16x8*)(base + (size_t)n * 6 * 4096) = o; } }
}
#define RET_BAR() do { asm volatile("s_waitcnt lgkmcnt(0)" ::: "memory"); __builtin_amdgcn_s_barrier(); asm volatile("" ::: "memory"); } while (0)
__device__ __forceinline__ void ret_states_block(const Frame& F, int bn) {
    const int n = bn % NCH, b = bn / NCH; const long t0 = (long)b * SEQ + n * 128;
    const int r = F.tid >> 2, c = F.tid & 3;
    const h16* rowp = WSP(const h16, WS_R1) + (size_t)(t0 + r) * NPJ; const float* cs = WSP(const float, OFF_ROPE) + (size_t)(n * 128 + r) * 64 + 8 * c;
    const f32x4 c0 = *(const f32x4*)cs, c1 = *(const f32x4*)(cs + 4), s0 = *(const f32x4*)(cs + 32), s1 = *(const f32x4*)(cs + 36);
    const int dir = F.wave >> 2, dt = F.wave & 3, fr = F.lane & 15, fq = F.lane >> 4;
    h16x8 k1, k2, v1, v2;
#define RS_LOAD(hh) do { k1 = *(const h16x8*)(rowp + CK + (hh) * 64 + 8 * c); k2 = *(const h16x8*)(rowp + CK + (hh) * 64 + 32 + 8 * c); v1 = *(const h16x8*)(rowp + CV + (hh) * 64 + 16 * c); v2 = *(const h16x8*)(rowp + CV + (hh) * 64 + 16 * c + 8); } while (0)
    RS_LOAD(0);
#pragma unroll 1
    for (int h = 0; h < 6; ++h) {
        LAS h16* KT = (LAS h16*)(F.lds + (h & 1) * 34816); LAS h16* VT = KT + 64 * 136;
#pragma unroll
        for (int e = 0; e < 8; ++e) { const float x1 = (float)k1[e], x2 = (float)k2[e], co = e < 4 ? c0[e] : c1[e - 4], si = e < 4 ? s0[e] : s1[e - 4];
            KT[(8 * c + e) * 136 + r] = (h16)((x1 * co - x2 * si) * 0.125f); KT[(32 + 8 * c + e) * 136 + r] = (h16)((x1 * si + x2 * co) * 0.125f); }
#pragma unroll
        for (int e = 0; e < 8; ++e) { VT[(16 * c + e) * 136 + r] = v1[e]; VT[(16 * c + 8 + e) * 136 + r] = v2[e]; }
        if (h < 5) RS_LOAD(h + 1);
        RET_BAR();
        const float l2g = log1pf(-exp2f(-5.0f - (float)h)) * 1.4426950408889634f;
        h16x8 xw[4];
#pragma unroll
        for (int ks = 0; ks < 4; ++ks) { const h16x8 f = ldsfrag(KT + (16 * dt + fr) * 136 + 32 * ks + 8 * fq); h16x8 wv;
#pragma unroll
            for (int jj = 0; jj < 8; ++jj) { const int j = 32 * ks + 8 * fq + jj; wv[jj] = (h16)exp2f(l2g * (float)(dir == 0 ? 127 - j : j)); }
            xw[ks] = f * wv; }
        h16* rst = WSP(h16, OFF_RST) + ((size_t)((dir * NB + b) * NCH + n) * 6 + h) * 4096;
#pragma unroll
        for (int et = 0; et < 4; ++et) { f32x4 acc = {0.f, 0.f, 0.f, 0.f};
#pragma unroll
            for (int ks = 0; ks < 4; ++ks) acc = MFMA16(xw[ks], ldsfrag(VT + (16 * et + fr) * 136 + 32 * ks + 8 * fq), acc);
            *(h16x4*)(rst + (16 * et + fr) * 64 + 16 * dt + 4 * fq) = pack4(acc); }
    }
#undef RS_LOAD
    __syncthreads();
}
__device__ __forceinline__ void ret_out_block(const Frame& F, int bn) {
    const int n = bn % NCH, b = bn / NCH; const long t0 = (long)b * SEQ + n * 128;
    const int r = F.tid >> 2, c = F.tid & 3, rp = kperm32(r), er = F.tid >> 3, d0 = (F.tid & 7) * 8;
    const h16* rowp = WSP(const h16, WS_R1) + (size_t)(t0 + r) * NPJ; const float* cs = WSP(const float, OFF_ROPE) + (size_t)(n * 128 + r) * 64 + 8 * c;
    const f32x4 c0 = *(const f32x4*)cs, c1 = *(const f32x4*)(cs + 4), s0 = *(const f32x4*)(cs + 32), s1 = *(const f32x4*)(cs + 36);
    const int w = F.wave, fr = F.lane & 15, fq = F.lane >> 4, il = 16 * w + fr;
    const h16* grow = WSP(const h16, WS_R1) + (size_t)(t0 + il) * NPJ + CG + 4 * fq; h16* orow = WSP(h16, OFF_OMIX) + (size_t)(t0 + il) * DM + 4 * fq;
    const h16* st0 = WSP(const h16, OFF_RST) + ((size_t)((0 * NB + b) * NCH + n) * 6) * 4096 + F.tid * 8; const h16* st1 = WSP(const h16, OFF_RST) + ((size_t)((1 * NB + b) * NCH + n) * 6) * 4096 + F.tid * 8;
    h16x8 q1, q2, k1, k2, v1, v2, sf, sb; h16x4 gn[4];
#define RO_LOAD(hh) do { q1 = *(const h16x8*)(rowp + CQ + (hh) * 64 + 8 * c); q2 = *(const h16x8*)(rowp + CQ + (hh) * 64 + 32 + 8 * c); k1 = *(const h16x8*)(rowp + CK + (hh) * 64 + 8 * c); k2 = *(const h16x8*)(rowp + CK + (hh) * 64 + 32 + 8 * c); \
        v1 = *(const h16x8*)(rowp + CV + (hh) * 64 + 16 * c); v2 = *(const h16x8*)(rowp + CV + (hh) * 64 + 16 * c + 8); sf = *(const h16x8*)(st0 + (hh) * 4096); sb = *(const h16x8*)(st1 + (hh) * 4096); \
        _Pragma("unroll") for (int et_ = 0; et_ < 4; ++et_) gn[et_] = *(const h16x4*)(grow + (hh) * 64 + 16 * et_); } while (0)
    RO_LOAD(0);
#pragma unroll 1
    for (int h = 0; h < 6; ++h) {
        LAS h16* Qt = (LAS h16*)(F.lds + (h & 1) * 72704); LAS h16* Kt = Qt + 128 * 72; LAS h16* VT = Kt + 128 * 72; LAS h16* Ff = VT + 64 * 136; LAS h16* Fb = Ff + 64 * 72;
        { h16x8 qa, qb, ka, kb;
#pragma unroll
            for (int e = 0; e < 8; ++e) { const float co = e < 4 ? c0[e] : c1[e - 4], si = e < 4 ? s0[e] : s1[e - 4];
                float x1 = (float)q1[e], x2 = (float)q2[e]; qa[e] = (h16)(x1 * co - x2 * si); qb[e] = (h16)(x1 * si + x2 * co);
                x1 = (float)k1[e]; x2 = (float)k2[e]; ka[e] = (h16)((x1 * co - x2 * si) * 0.125f); kb[e] = (h16)((x1 * si + x2 * co) * 0.125f); }
            *(LAS h16x8*)(Qt + r * 72 + 8 * c) = qa; *(LAS h16x8*)(Qt + r * 72 + 32 + 8 * c) = qb;
            *(LAS h16x8*)(Kt + r * 72 + 8 * c) = ka; *(LAS h16x8*)(Kt + r * 72 + 32 + 8 * c) = kb; }
#pragma unroll
        for (int e = 0; e < 8; ++e) { VT[(16 * c + e) * 136 + rp] = v1[e]; VT[(16 * c + 8 + e) * 136 + rp] = v2[e]; }
        *(LAS h16x8*)(Ff + er * 72 + d0) = sf; *(LAS h16x8*)(Fb + er * 72 + d0) = sb;
        h16x4 gc[4];
#pragma unroll
        for (int et = 0; et < 4; ++et) gc[et] = gn[et];
        if (h < 5) RO_LOAD(h + 1);
        RET_BAR();
        const float l2g = log1pf(-exp2f(-5.0f - (float)h)) * 1.4426950408889634f;
        h16x8 qf[2];
#pragma unroll
        for (int ks = 0; ks < 2; ++ks) qf[ks] = ldsfrag(Qt + il * 72 + 32 * ks + 8 * fq);
        f32x4 s[8];
#pragma unroll
        for (int jt = 0; jt < 8; ++jt) { f32x4 a = {0.f, 0.f, 0.f, 0.f};
#pragma unroll
            for (int ks = 0; ks < 2; ++ks) a = MFMA16(ldsfrag(Kt + (16 * jt + fr) * 72 + 32 * ks + 8 * fq), qf[ks], a);
#pragma unroll
            for (int q = 0; q < 4; ++q) { const int j = 16 * jt + 4 * fq + q; const int dd = il > j ? il - j : j - il; a[q] *= exp2f(l2g * (float)dd); }
            PINV(a); s[jt] = a; }
        f32x4 o[4];
#pragma unroll
        for (int et = 0; et < 4; ++et) o[et] = (f32x4){0.f, 0.f, 0.f, 0.f};
#pragma unroll
        for (int kp = 0; kp < 4; ++kp) { const h16x8 pf = pack8(s[2 * kp], s[2 * kp + 1]);
#pragma unroll
            for (int et = 0; et < 4; ++et) o[et] = MFMA16(ldsfrag(VT + (16 * et + fr) * 136 + 32 * kp + 8 * fq), pf, o[et]); }
        const float gf = exp2f(l2g * (float)(il + 1)), gb = exp2f(l2g * (float)(128 - il));
#pragma unroll
        for (int ks = 0; ks < 2; ++ks) { const h16x8 qff = scalefrag(qf[ks], gf), qfb = scalefrag(qf[ks], gb);
#pragma unroll
            for (int et = 0; et < 4; ++et) { o[et] = MFMA16(ldsfrag(Ff + (16 * et + fr) * 72 + 32 * ks + 8 * fq), qff, o[et]); o[et] = MFMA16(ldsfrag(Fb + (16 * et + fr) * 72 + 32 * ks + 8 * fq), qfb, o[et]); } }
        float ss = 0.f;
#pragma unroll
        for (int et = 0; et < 4; ++et) ss += (o[et][0] * o[et][0] + o[et][1] * o[et][1]) + (o[et][2] * o[et][2] + o[et][3] * o[et][3]);
        ss += __shfl_xor(ss, 16); ss += __shfl_xor(ss, 32);
        const float rs = 1.0f / sqrtf(ss * (1.0f / 64.0f) + EPS);
#pragma unroll
        for (int et = 0; et < 4; ++et) { f32x4 q;
#pragma unroll
            for (int e = 0; e < 4; ++e) q[e] = o[et][e] * rs * siluf_((float)gc[et][e]);
            *(h16x4*)(orow + h * 64 + 16 * et) = pack4(q); }
    }
#undef RO_LOAD
    __syncthreads();
}
#undef RET_BAR

__device__ __forceinline__ void ssd_stage_dt(const Frame& F, const Prm& p, int l, int g, long t0, LAS float* LA, LAS float* DTS) {
    if (F.tid < 128) { const h16* dp = WSP(const h16, WS_R1) + (size_t)(t0 + F.tid) * NPJ + CDT + g * 3;
#pragma unroll
        for (int r = 0; r < 3; ++r) { const float raw = (float)dp[r];
#pragma unroll
            for (int dir = 0; dir < 2; ++dir) { const float dt = softplusf_(raw + inptr(F, 7)[(l * 2 + dir) * 6 + g * 3 + r]); const float la = -dt * __expf(inptr(F, 8)[(l * 2 + dir) * 6 + g * 3 + r]);
                DTS[(dir * 3 + r) * 128 + F.tid] = dt; LA[(dir * 3 + r) * 128 + F.tid] = la; } } }
}
__device__ __forceinline__ void ssd_cumsum(const Frame& F, LAS const float* LAq, float& v0, float& v1, float& c0, float& c1, float& tot) {
    v0 = LAq[2 * F.lane]; v1 = LAq[2 * F.lane + 1]; float s = v0 + v1;
#pragma unroll
    for (int o = 1; o < 64; o <<= 1) { const float t = __shfl_up(s, o); if (F.lane >= o) s += t; }
    c1 = s; c0 = s - v1; tot = __shfl(s, 63);
}
__device__ __forceinline__ void ssd_states_unit(const Frame& F, const Prm& p, int l, int u) {
    const int g = u & 1, bn = u >> 1, n = bn % NCH, b = bn / NCH; const long t0 = (long)b * SEQ + n * 128;
    const h16* proj = WSP(const h16, WS_R1);
    LAS h16* XT = (LAS h16*)F.lds; LAS h16* BT = XT + 3 * 64 * 136; LAS float* LA = (LAS float*)(BT + 128 * 136); LAS float* DTS = LA + 6 * 128; LAS float* WW = DTS + 6 * 128;
    ssd_stage_dt(F, p, l, g, t0, LA, DTS);
    const float* cw = inptr(F, 5) + (size_t)l * 4 * 896; const float* cb = inptr(F, 6) + (size_t)l * 896;
    h16* bcn = ((h16*)((unsigned char*)F.out + OUT_BCN));
    for (int task = F.tid; task < 56 * 16; task += 512) { const int cg = task % 56, r0 = (task / 56) * 8; h16x8 o[8];
        if (cg < 24) { conv_rows8<true>(proj + CXS + g * 192 + 8 * cg, t0, n, r0, cw + g * 192 + 8 * cg, 896, cb + g * 192 + 8 * cg, o);
            LAS h16* d = XT + (cg >> 3) * 64 * 136 + ((cg & 7) * 8) * 136 + r0;
#pragma unroll
            for (int e = 0; e < 8; ++e) *(LAS h16x8*)(d + e * 136) = col_of(o, e);
        } else { const int c8 = (cg - 24) & 15; const bool isB = cg < 40; const int col = (isB ? CBM : CCM) + g * 128 + 8 * c8, ci = (isB ? 384 : 640) + g * 128 + 8 * c8;
            conv_rows8<true>(proj + col, t0, n, r0, cw + ci, 896, cb + ci, o);
#pragma unroll
            for (int r = 0; r < 8; ++r) *(h16x8*)(bcn + (size_t)(t0 + r0 + r) * 512 + (isB ? 0 : 256) + g * 128 + 8 * c8) = o[r];
            if (isB) { LAS h16* d = BT + (8 * c8) * 136 + r0;
#pragma unroll
                for (int e = 0; e < 8; ++e) *(LAS h16x8*)(d + e * 136) = col_of(o, e); } } }
    __syncthreads();
    { h16* xtg = ((h16*)((unsigned char*)F.out + OUT_XTG)) + ((size_t)(b * NCH + n) * 6 + g * 3) * 8192;
#pragma unroll
        for (int k = 0; k < 6; ++k) { const int it = F.tid + 512 * k, rr = it >> 4, c = it & 15; const h16x8 v = *(LAS const h16x8*)(XT + rr * 136 + 8 * c);
            *(h16x4*)(xtg + rr * 128 + kperm32(8 * c)) = __builtin_shufflevector(v, v, 0, 1, 2, 3); *(h16x4*)(xtg + rr * 128 + kperm32(8 * c + 4)) = __builtin_shufflevector(v, v, 4, 5, 6, 7); } }
    if (F.wave < 6) { const int q = F.wave, dir = q / 3, r = q % 3; float v0, v1, c0, c1, tot; ssd_cumsum(F, LA + q * 128, v0, v1, c0, c1, tot);
        const float d0 = DTS[q * 128 + 2 * F.lane], d1 = DTS[q * 128 + 2 * F.lane + 1];
        if (dir == 0) { WW[q * 128 + 2 * F.lane] = __expf(tot - c0) * d0 * 256.f; WW[q * 128 + 2 * F.lane + 1] = __expf(tot - c1) * d1 * 256.f; }
        else { WW[q * 128 + 2 * F.lane] = __expf(c0 - v0) * d0 * 256.f; WW[q * 128 + 2 * F.lane + 1] = __expf(c1 - v1) * d1 * 256.f; }
        if (F.lane == 0) WSP(float, OFF_SDEC)[((size_t)(b * NCH + n) * 6 + g * 3 + r) * 2 + dir] = tot; }
    __syncthreads();
    const int w = F.wave, fr = F.lane & 15, fq = F.lane >> 4;
    h16x8 xb[4];
#pragma unroll
    for (int ks = 0; ks < 4; ++ks) xb[ks] = ldsfrag(BT + (16 * w + fr) * 136 + 32 * ks + 8 * fq);
    for (int q = 0; q < 6; ++q) { const int dir = q / 3, r = q % 3;
        h16x8 wf[4];
#pragma unroll
        for (int ks = 0; ks < 4; ++ks) { const f32x4 a = *(LAS const f32x4*)(WW + q * 128 + 32 * ks + 8 * fq), c = *(LAS const f32x4*)(WW + q * 128 + 32 * ks + 8 * fq + 4); wf[ks] = pack8(a, c); }
        h16* sst = WSP(h16, OFF_SST) + ((size_t)((dir * NB + b) * NCH + n) * 6 + g * 3 + r) * 8192;
#pragma unroll
        for (int pt = 0; pt < 4; ++pt) { f32x4 acc = {0.f, 0.f, 0.f, 0.f};
#pragma unroll
            for (int ks = 0; ks < 4; ++ks) acc = MFMA16(xb[ks], ldsfrag(XT + r * 64 * 136 + (16 * pt + fr) * 136 + 32 * ks + 8 * fq) * wf[ks], acc);
            *(h16x4*)(sst + (16 * pt + fr) * 128 + 16 * w + 4 * fq) = pack4(acc * (1.0f / 256.f)); } }
    __syncthreads();
}
__device__ __forceinline__ void ssd_scan_unit(const Frame& F, int u) {
    const int hd = u % 6, b = (u / 6) % NB, dir = u / (6 * NB);
    h16* base = WSP(h16, OFF_SST) + ((size_t)((dir * NB + b) * NCH) * 6 + hd) * 8192 + F.tid * 16;
    const float* dbase = WSP(const float, OFF_SDEC) + ((size_t)(b * NCH) * 6 + hd) * 2 + dir;
    float acc[16];
#pragma unroll
    for (int e = 0; e < 16; ++e) acc[e] = 0.f;
#pragma unroll 1
    for (int q = 0; q < 4; ++q) { h16x8 s0[4], s1[4]; float dec[4];
#pragma unroll
        for (int i = 0; i < 4; ++i) { const int ii = 4 * q + i, n = dir == 0 ? ii : NCH - 1 - ii; s0[i] = *(const h16x8*)(base + (size_t)n * 6 * 8192); s1[i] = *(const h16x8*)(base + (size_t)n * 6 * 8192 + 8); dec[i] = dbase[n * 12]; }
#pragma unroll
        for (int i = 0; i < 4; ++i) { const int ii = 4 * q + i, n = dir == 0 ? ii : NCH - 1 - ii; const float dc = __expf(dec[i]); h16x8 o0, o1;
#pragma unroll
            for (int e = 0; e < 8; ++e) { o0[e] = (h16)acc[e]; o1[e] = (h16)acc[8 + e]; acc[e] = acc[e] * dc + (float)s0[i][e]; acc[8 + e] = acc[8 + e] * dc + (float)s1[i][e]; }
            *(h16x8*)(base + (size_t)n * 6 * 8192) = o0; *(h16x8*)(base + (size_t)n * 6 * 8192 + 8) = o1; } }
}
__device__ __forceinline__ void ssd_out_unit(const Frame& F, const Prm& p, int l, int u) {
    const int g = u & 1, bn = u >> 1, n = bn % NCH, b = bn / NCH; const long t0 = (long)b * SEQ + n * 128;
    const h16* proj = WSP(const h16, WS_R1);
    LAS h16* XT = (LAS h16*)F.lds; LAS h16* Bt = XT + 3 * 64 * 136; LAS h16* Ct = Bt + 128 * 136; LAS float* LA = (LAS float*)(Ct + 128 * 136); LAS float* DTS = LA + 6 * 128;
    LAS float* CE = DTS + 6 * 128;
    LAS float* TOTB = CE + 6 * 128;
    ssd_stage_dt(F, p, l, g, t0, LA, DTS);
    const float* cw = inptr(F, 5) + (size_t)l * 4 * 896; const float* cb = inptr(F, 6) + (size_t)l * 896;
    { const h16* xtg = ((const h16*)((const unsigned char*)F.out + OUT_XTG)) + ((size_t)(b * NCH + n) * 6 + g * 3) * 8192; const h16* bcn = ((const h16*)((const unsigned char*)F.out + OUT_BCN)) + (size_t)t0 * 512 + g * 128;
        h16x8 xv[6], bv[8];
#pragma unroll
        for (int k = 0; k < 6; ++k) { const int it = F.tid + 512 * k; xv[k] = *(const h16x8*)(xtg + (it >> 4) * 128 + 8 * (it & 15)); }
#pragma unroll
        for (int k = 0; k < 8; ++k) { const int it = F.tid + 512 * k, row = it >> 5, c = it & 31; bv[k] = *(const h16x8*)(bcn + (size_t)row * 512 + (c < 16 ? 8 * c : 256 + 8 * (c - 16))); }
#pragma unroll
        for (int k = 0; k < 6; ++k) { const int it = F.tid + 512 * k; *(LAS h16x8*)(XT + (it >> 4) * 136 + 8 * (it & 15)) = xv[k]; }
#pragma unroll
        for (int k = 0; k < 8; ++k) { const int it = F.tid + 512 * k, row = it >> 5, c = it & 31; *(LAS h16x8*)((c < 16 ? Bt : Ct) + row * 136 + 8 * (c & 15)) = bv[k]; }
        PIN(); }
    __syncthreads();
    if (F.wave < 6) { const int q = F.wave; float v0, v1, c0, c1, tot; ssd_cumsum(F, LA + q * 128, v0, v1, c0, c1, tot);
        if (q < 3) { CE[q * 128 + 2 * F.lane] = c0; CE[q * 128 + 2 * F.lane + 1] = c1; }
        else { CE[q * 128 + 2 * F.lane] = c0 - v0; CE[q * 128 + 2 * F.lane + 1] = c1 - v1; if (F.lane == 0) TOTB[q - 3] = tot; } }
    __syncthreads();
    const int w = F.wave, fr = F.lane & 15, fq = F.lane >> 4, il = 16 * w + fr;
    h16x8 cf[4];
#pragma unroll
    for (int ks = 0; ks < 4; ++ks) cf[ks] = ldsfrag(Ct + il * 136 + 32 * ks + 8 * fq);
    f32x4 gT[8];
#pragma unroll
    for (int jt = 0; jt < 8; ++jt) { f32x4 a = {0.f, 0.f, 0.f, 0.f};
#pragma unroll
        for (int ks = 0; ks < 4; ++ks) a = MFMA16(ldsfrag(Bt + (16 * jt + fr) * 136 + 32 * ks + 8 * fq), cf[ks], a);
        PINV(a); gT[jt] = a; }
    const float* dsk = inptr(F, 9) + l * 6 + g * 3;
    h16* orow = WSP(h16, OFF_OMIX) + (size_t)(t0 + il) * DM + 384 + g * 192;
    float ss = 0.f;
    { h16x8 h0[4];
#pragma unroll
        for (int k = 0; k < 4; ++k) { const int it = F.tid + 512 * k, dir = it >> 10, e = it & 1023; h0[k] = *(const h16x8*)(WSP(const h16, OFF_SST) + ((size_t)((dir * NB + b) * NCH + n) * 6 + g * 3) * 8192 + e * 8); }
        __syncthreads();
#pragma unroll
        for (int k = 0; k < 4; ++k) { const int it = F.tid + 512 * k, dir = it >> 10, e = it & 1023; *(LAS h16x8*)(Bt + dir * 64 * 136 + (e >> 4) * 136 + 8 * (e & 15)) = h0[k]; }
        __syncthreads(); }
#pragma unroll 1
    for (int r = 0; r < 3; ++r) {
        f32x4 y[1][4];
        const int hd = g * 3 + r;
        const float cfi = CE[r * 128 + il], ebi = CE[(3 + r) * 128 + il], totb = TOTB[r];
#pragma unroll
        for (int pt = 0; pt < 4; ++pt) y[0][pt] = (f32x4){0.f, 0.f, 0.f, 0.f};
        LAS const h16* HL = (r & 1) ? Ct : Bt;
        h16x8 hreg[4];
        if (r < 2) {
#pragma unroll
            for (int k = 0; k < 4; ++k) { const int it = F.tid + 512 * k, dir = it >> 10, e = it & 1023; hreg[k] = *(const h16x8*)(WSP(const h16, OFF_SST) + ((size_t)((dir * NB + b) * NCH + n) * 6 + hd + 1) * 8192 + e * 8); } }
#pragma unroll
        for (int kp = 0; kp < 4; ++kp) { f32x4 pv[2];
#pragma unroll
            for (int jh = 0; jh < 2; ++jh) { const int jt = 2 * kp + jh, j0 = 16 * jt + 4 * fq;
                const f32x4 cfj = *(LAS const f32x4*)(CE + r * 128 + j0), ebj = *(LAS const f32x4*)(CE + (3 + r) * 128 + j0), dfj = *(LAS const f32x4*)(DTS + r * 128 + j0), dbj = *(LAS const f32x4*)(DTS + (3 + r) * 128 + j0);
#pragma unroll
                for (int e = 0; e < 4; ++e) { const int j = j0 + e; const float val = (il >= j) ? __expf(cfi - cfj[e]) * dfj[e] : __expf(ebj[e] - ebi) * dbj[e]; pv[jh][e] = gT[jt][e] * val * 256.f; }
                PINV(pv[jh]); }
            const h16x8 pf = pack8(pv[0], pv[1]);
#pragma unroll
            for (int pt = 0; pt < 4; ++pt) y[0][pt] = MFMA16(ldsfrag(XT + r * 64 * 136 + (16 * pt + fr) * 136 + 32 * kp + 8 * fq), pf, y[0][pt]);
            PINV(y[0][0]); PINV(y[0][1]); PINV(y[0][2]); PINV(y[0][3]); }
        const float ef = __expf(cfi) * 256.f, eb = __expf(totb - ebi) * 256.f;
#pragma unroll
        for (int ks = 0; ks < 4; ++ks) { const h16x8 cff = scalefrag(cf[ks], ef), cfb = scalefrag(cf[ks], eb);
#pragma unroll
            for (int pt = 0; pt < 4; ++pt) { y[0][pt] = MFMA16(ldsfrag(HL + (16 * pt + fr) * 136 + 32 * ks + 8 * fq), cff, y[0][pt]); y[0][pt] = MFMA16(ldsfrag(HL + 64 * 136 + (16 * pt + fr) * 136 + 32 * ks + 8 * fq), cfb, y[0][pt]); }
            PINV(y[0][0]); PINV(y[0][1]); PINV(y[0][2]); PINV(y[0][3]); }
        if (r < 2) { LAS h16* HN = (r & 1) ? Bt : Ct;
#pragma unroll
            for (int k = 0; k < 4; ++k) { const int it = F.tid + 512 * k, dir = it >> 10, e = it & 1023; *(LAS h16x8*)(HN + dir * 64 * 136 + (e >> 4) * 136 + 8 * (e & 15)) = hreg[k]; } }
        const float dk = dsk[r]; const h16* zrow = proj + (size_t)(t0 + il) * NPJ + CZ + hd * 64;
#pragma unroll
        for (int pt = 0; pt < 4; ++pt) { const h16x4 zv = *(const h16x4*)(zrow + 16 * pt + 4 * fq);
#pragma unroll
            for (int e = 0; e < 4; ++e) { const float xv = (float)XT[r * 64 * 136 + (16 * pt + 4 * fq + e) * 136 + kperm32(il)]; y[0][pt][e] = (y[0][pt][e] * (1.0f / 256.f) + dk * xv) * siluf_((float)zv[e]); }
            const h16x4 yh = pack4(y[0][pt]); *(h16x4*)(orow + r * 64 + 16 * pt + 4 * fq) = yh;
#pragma unroll
            for (int e = 0; e < 4; ++e) { const float q = (float)yh[e]; ss += q * q; } }
        __syncthreads();
    }
    ss += __shfl_xor(ss, 16); ss += __shfl_xor(ss, 32);
    const float rs = 1.0f / sqrtf(ss * (1.0f / 192.0f) + EPS);
    const float* nw = inptr(F, 10) + l * 384 + g * 192;
    asm volatile("s_waitcnt vmcnt(0)" ::: "memory");
#pragma unroll 1
    for (int r = 0; r < 3; ++r)
#pragma unroll
        for (int pt = 0; pt < 4; ++pt) { const f32x4 wv = *(const f32x4*)(nw + r * 64 + 16 * pt + 4 * fq); h16* op = orow + r * 64 + 16 * pt + 4 * fq; const h16x4 yh = *(const h16x4*)op; f32x4 yv;
#pragma unroll
            for (int e = 0; e < 4; ++e) yv[e] = (float)yh[e] * rs * wv[e];
            *(h16x4*)op = pack4(yv); }
    __syncthreads();
}

__device__ __forceinline__ void lru_unit(const Frame& F, const Prm& p, int l, int u) {
    const int n = u % NCH, b = u / NCH; const long t0 = (long)b * SEQ + n * 128;
    const h16* proj = WSP(const h16, WS_R1);
    LAS h16* XC = (LAS h16*)F.lds;
    const float* cw = inptr(F, 11) + (size_t)l * 4 * 256; const float* cb = inptr(F, 12) + (size_t)l * 256;
    { const int cg = F.tid & 31, r0 = (F.tid >> 5) * 8; h16x8 o[8];
        conv_rows8<false>(proj + CXR + 8 * cg, t0, n, r0, cw + 8 * cg, 256, cb + 8 * cg, o);
#pragma unroll
        for (int r = 0; r < 8; ++r) *(LAS h16x8*)(XC + (r0 + r) * 264 + 8 * cg) = o[r]; }
    __syncthreads();
    const int blk = F.wave & 3, jh = F.wave >> 2, fr = F.lane & 15, fq = F.lane >> 4;
    h16* lau = (h16*)((unsigned char*)F.out + OUT_LAU) + (size_t)(b * NCH + n) * 2 * 128 * 256 * 2;
    h16x8 wa[2][2][2], wx[2][2][2]; float ba[2][2], bx[2][2], sp[2][2], car[2][2], atot[2][2];
#pragma unroll
    for (int dir = 0; dir < 2; ++dir)
#pragma unroll
        for (int jt = 0; jt < 2; ++jt) { const int ch = blk * 64 + 32 * jh + 16 * jt + fr;
#pragma unroll
            for (int ks = 0; ks < 2; ++ks) { wa[dir][jt][ks] = *(const h16x8*)(WSP(const h16, WS_LRUW) + (size_t)((dir * 2 + 0) * 4 + blk) * 4096 + (32 * jh + 16 * jt + fr) * 64 + 32 * ks + 8 * fq);
                wx[dir][jt][ks] = *(const h16x8*)(WSP(const h16, WS_LRUW) + (size_t)((dir * 2 + 1) * 4 + blk) * 4096 + (32 * jh + 16 * jt + fr) * 64 + 32 * ks + 8 * fq); }
            ba[dir][jt] = inptr(F, 15)[(l * 2 + dir) * 256 + ch]; bx[dir][jt] = inptr(F, 17)[(l * 2 + dir) * 256 + ch]; sp[dir][jt] = softplusf_(-inptr(F, 13)[(l * 2 + dir) * 256 + ch]);
            car[dir][jt] = 0.f; atot[dir][jt] = 1.f; }
#pragma unroll 1
    for (int ti = 0; ti < 8; ++ti) {
#pragma unroll
        for (int dir = 0; dir < 2; ++dir) { const int tt = dir == 0 ? ti : 7 - ti;
            h16x8 xf[2];
#pragma unroll
            for (int ks = 0; ks < 2; ++ks) xf[ks] = ldsfrag(XC + (16 * tt + fr) * 264 + blk * 64 + 32 * ks + 8 * fq);
#pragma unroll
            for (int jt = 0; jt < 2; ++jt) { const int ch = blk * 64 + 32 * jh + 16 * jt + fr;
                f32x4 ra = {0.f, 0.f, 0.f, 0.f}, ia = {0.f, 0.f, 0.f, 0.f};
#pragma unroll
                for (int ks = 0; ks < 2; ++ks) { ra = MFMA16(xf[ks], wa[dir][jt][ks], ra); ia = MFMA16(xf[ks], wx[dir][jt][ks], ia); }
                float A = 1.f, H = 0.f;
#pragma unroll
                for (int ri = 0; ri < 4; ++ri) { const int rg = dir == 0 ? ri : 3 - ri;
                    const float e1 = 1.0f + __expf(-(ra[rg] + ba[dir][jt])), e2 = 1.0f + __expf(-(ia[rg] + bx[dir][jt])); const float inv = __builtin_amdgcn_rcpf(e1 * e2);
                    const float rgate = inv * e2, ig = inv * e1;
                    const float la = -8.0f * rgate * sp[dir][jt]; const float a = __expf(la); const float y = 2.0f * la;
                    const float om = y > -0.1f ? -y * (1.0f + y * (0.5f + y * (1.0f / 6.0f))) : 1.0f - a * a;
                    const float mult = __builtin_amdgcn_sqrtf(om);
                    const float xv = (float)XC[(16 * tt + 4 * fq + rg) * 264 + ch]; const float uu = mult * ig * xv;
                    H = a * H + uu; A *= a;
                    { h16x2 pk; pk[0] = (h16)la; pk[1] = (h16)uu; *(h16x2*)(lau + ((size_t)dir * 128 + 16 * tt + 4 * fq + rg) * 256 * 2 + 2 * ch) = pk; } }
                float Ag[4], Hg[4];
#pragma unroll
                for (int gq = 0; gq < 4; ++gq) { Ag[gq] = __shfl(A, fr + 16 * gq); Hg[gq] = __shfl(H, fr + 16 * gq); }
                float cnew = car[dir][jt], at = 1.f;
#pragma unroll
                for (int gi = 0; gi < 4; ++gi) { const int gq = dir == 0 ? gi : 3 - gi;
                    cnew = Ag[gq] * cnew + Hg[gq]; at *= Ag[gq]; }
                car[dir][jt] = cnew; atot[dir][jt] *= at;
            } } }
    if (fq == 0) {
#pragma unroll
        for (int dir = 0; dir < 2; ++dir)
#pragma unroll
            for (int jt = 0; jt < 2; ++jt) { const int ch = blk * 64 + 32 * jh + 16 * jt + fr; *(f32x2*)(WSP(float, OFF_LSUM) + (((size_t)(b * NCH + n) * 2 + dir) * 256 + ch) * 2) = (f32x2){atot[dir][jt], car[dir][jt]}; } }
    __syncthreads();
}
__device__ __forceinline__ void lru_out_unit(const Frame& F, int u) {
    const int n = u % NCH, b = u / NCH; const long t0 = (long)b * SEQ + n * 128;
    const h16* proj = WSP(const h16, WS_R1);
    LAS h16* HT = (LAS h16*)F.lds;
    const int blk = F.wave & 3, jh = F.wave >> 2, fr = F.lane & 15, fq = F.lane >> 4;
    const h16* lau = (const h16*)((const unsigned char*)F.out + OUT_LAU) + (size_t)(b * NCH + n) * 2 * 128 * 256 * 2;
    float car[2][2];
#pragma unroll
    for (int dir = 0; dir < 2; ++dir)
#pragma unroll
        for (int jt = 0; jt < 2; ++jt) car[dir][jt] = WSP(const float, OFF_LCAR)[((size_t)(b * NCH + n) * 2 + dir) * 256 + blk * 64 + 32 * jh + 16 * jt + fr];
#pragma unroll 1
    for (int ti = 0; ti < 8; ++ti) {
#pragma unroll
        for (int dir = 0; dir < 2; ++dir) { const int tt = dir == 0 ? ti : 7 - ti;
            h16x2 pk[2][4]; h16 gtv[2][4], ov[2][4];
#pragma unroll
            for (int jt = 0; jt < 2; ++jt)
#pragma unroll
                for (int rg = 0; rg < 4; ++rg) { const int tl = 16 * tt + 4 * fq + rg, ch = blk * 64 + 32 * jh + 16 * jt + fr;
                    pk[jt][rg] = *(const h16x2*)(lau + ((size_t)dir * 128 + tl) * 256 * 2 + 2 * ch); gtv[jt][rg] = proj[(size_t)(t0 + tl) * NPJ + CGT + ch]; ov[jt][rg] = ti >= 4 ? HT[tl * 264 + ch] : (h16)0.f; }
#pragma unroll
            for (int jt = 0; jt < 2; ++jt) { const int ch = blk * 64 + 32 * jh + 16 * jt + fr;
                float av[4], uv[4]; float A = 1.f, H = 0.f;
#pragma unroll
                for (int ri = 0; ri < 4; ++ri) { const int rg = dir == 0 ? ri : 3 - ri; const float a = __expf((float)pk[jt][rg][0]); const float uu = (float)pk[jt][rg][1]; av[rg] = a; uv[rg] = uu; H = a * H + uu; A *= a; }
                float Ag[4], Hg[4];
#pragma unroll
                for (int gq = 0; gq < 4; ++gq) { Ag[gq] = __shfl(A, fr + 16 * gq); Hg[gq] = __shfl(H, fr + 16 * gq); }
                float hin = car[dir][jt], cnew = car[dir][jt];
#pragma unroll
                for (int gi = 0; gi < 4; ++gi) { const int gq = dir == 0 ? gi : 3 - gi; const bool before = dir == 0 ? (gq < fq) : (gq > fq);
                    if (before) hin = Ag[gq] * hin + Hg[gq];
                    cnew = Ag[gq] * cnew + Hg[gq]; }
                car[dir][jt] = cnew;
                float hh = hin;
#pragma unroll
                for (int ri = 0; ri < 4; ++ri) { const int rg = dir == 0 ? ri : 3 - ri; hh = av[rg] * hh + uv[rg];
                    HT[(16 * tt + 4 * fq + rg) * 264 + ch] = (h16)((float)ov[jt][rg] + hh * gelu_tanh_((float)gtv[jt][rg])); } } } }
    __syncthreads();
#pragma unroll
    for (int k = 0; k < 8; ++k) { const int it = F.tid + 512 * k, row = it >> 5, c8 = it & 31; *(h16x8*)(WSP(h16, OFF_OMIX) + (size_t)(t0 + row) * DM + 768 + 8 * c8) = *(LAS const h16x8*)(HT + row * 264 + 8 * c8); }
    __syncthreads();
}
__device__ __forceinline__ void lru_scan(const Frame& F) {
    const int gi = (int)blockIdx.x * 512 + F.tid; if (gi >= NB * 2 * 256) return;
    const int ch = gi & 255, dir = (gi >> 8) & 1, b = gi >> 9; float H = 0.f;
    for (int i = 0; i < NCH; ++i) { const int n = dir == 0 ? i : NCH - 1 - i; const size_t idx = ((size_t)(b * NCH + n) * 2 + dir) * 256 + ch;
        const f32x2 s = *(const f32x2*)(WSP(const float, OFF_LSUM) + idx * 2); WSP(float, OFF_LCAR)[idx] = H; H = s[0] * H + s[1]; }
}

__device__ __forceinline__ void attn_phase(const Frame& F) {
    constexpr int NU = NB * 4 * 8;
    LAS unsigned char* B0 = F.lds; LAS unsigned char* B1 = F.lds + 67584;
    int u = F.vcu; if (u >= NU) return;
    int lanel = F.lane; asm volatile("" : "+v"(lanel)); int fr = lanel & 15, fq = lanel >> 4;
    const int w = F.wave;
    h16x8 qf[2][8];
#define AT_DMA(buf, src, rowstride) do { asm volatile("" : "+v"(lanel)); if (lanel < 32) { _Pragma("unroll") for (int i_ = 0; i_ < 16; ++i_) \
        __builtin_amdgcn_global_load_lds((const unsigned*)((src) + (size_t)(16 * w + i_) * (rowstride) + 8 * lanel), (LAS unsigned*)((buf) + (16 * w + i_) * 528), 16, 0, 0); } } while (0)
#define AT_FRAG(buf, row, chunk) (*(LAS const h16x8*)((buf) + (row) * 528 + (chunk) * 16))
#define AT_WAITBAR() do { asm volatile("s_waitcnt vmcnt(0) lgkmcnt(0)" ::: "memory"); __builtin_amdgcn_s_barrier(); asm volatile("" ::: "memory"); } while (0)
#define AT_LOADQ(uu) do { _Pragma("unroll") for (int a_ = 0; a_ < 2; ++a_) { const long t_ = (long)((uu) >> 5) * SEQ + ((uu) & 7) * 256 + 32 * w + 16 * a_ + fr; const h16* q_ = WSP(const h16, OFF_QCA) + (size_t)t_ * DM + (((uu) >> 3) & 3) * 256; \
        _Pragma("unroll") for (int ks_ = 0; ks_ < 8; ++ks_) qf[a_][ks_] = *(const h16x8*)(q_ + 32 * ks_ + 8 * fq); } } while (0)
    { const int b = u >> 5, hd = (u >> 3) & 3; AT_DMA(B0, WSP(const h16, OFF_KB) + (size_t)(b * 256) * DM + hd * 256, DM); }
    for (; u < NU; u += F.G) {
        const int qb = u & 7, hd = (u >> 3) & 3, b = u >> 5; const int un = u + F.G; const bool has_next = un < NU;
        asm volatile("" : "+v"(lanel)); fr = lanel & 15; fq = lanel >> 4;
        const h16* kb = WSP(const h16, OFF_KB) + (size_t)(b * 256) * DM + hd * 256; const h16* vt = WSP(const h16, OFF_VT) + (size_t)(b * 4 + hd) * 65536;
        AT_LOADQ(u);
        h16x8 pf[2][8]; float mq[2][4], Mr[2] = {-3.0e38f, -3.0e38f}, Lr[2] = {0.f, 0.f};
#pragma unroll
        for (int h = 0; h < 2; ++h) {
            AT_WAITBAR();
            if (h == 0) AT_DMA(B1, kb + (size_t)128 * DM, DM); else AT_DMA(B0, vt, 256);
            LAS const unsigned char* KB_ = h == 0 ? B0 : B1;
#pragma unroll
            for (int jh = 0; jh < 2; ++jh) { const int qd = 2 * h + jh; f32x4 s[2][4]; h16x8 kf[2][4];
#pragma unroll
                for (int j4 = 0; j4 < 4; ++j4) { s[0][j4] = (f32x4){0.f, 0.f, 0.f, 0.f}; s[1][j4] = (f32x4){0.f, 0.f, 0.f, 0.f}; kf[0][j4] = AT_FRAG(KB_, 16 * (4 * jh + j4) + fr, fq); }
#pragma unroll
                for (int ks = 0; ks < 8; ++ks) {
                    if (ks < 7) {
#pragma unroll
                        for (int j4 = 0; j4 < 4; ++j4) kf[(ks + 1) & 1][j4] = AT_FRAG(KB_, 16 * (4 * jh + j4) + fr, 4 * (ks + 1) + fq); }
                    PIN();
#pragma unroll
                    for (int j4 = 0; j4 < 4; ++j4) { s[0][j4] = MFMA16(kf[ks & 1][j4], qf[0][ks], s[0][j4]); s[1][j4] = MFMA16(kf[ks & 1][j4], qf[1][ks], s[1][j4]); }
                    PINV(s[0][0]); PINV(s[1][3]); }
#pragma unroll
                for (int a = 0; a < 2; ++a) { float mx = fmaxf(fmaxf(s[a][0][0], s[a][0][1]), fmaxf(s[a][0][2], s[a][0][3]));
#pragma unroll
                    for (int jt = 1; jt < 4; ++jt) mx = fmaxf(mx, fmaxf(fmaxf(s[a][jt][0], s[a][jt][1]), fmaxf(s[a][jt][2], s[a][jt][3])));
                    mx = fmaxf(mx, __shfl_xor(mx, 16)); mx = fmaxf(mx, __shfl_xor(mx, 32));
                    float sum = 0.f;
#pragma unroll
                    for (int jt = 0; jt < 4; ++jt)
#pragma unroll
                        for (int e = 0; e < 4; ++e) { const float pe = __expf(s[a][jt][e] - mx); s[a][jt][e] = pe; sum += pe; }
                    sum += __shfl_xor(sum, 16); sum += __shfl_xor(sum, 32);
                    mq[a][qd] = mx; { const float Mn = fmaxf(Mr[a], mx); Lr[a] = Lr[a] * __expf(Mr[a] - Mn) + sum * __expf(mx - Mn); Mr[a] = Mn; }
                    pf[a][2 * qd] = pack8(s[a][0], s[a][1]); pf[a][2 * qd + 1] = pack8(s[a][2], s[a][3]); } }
        }
#pragma unroll
        for (int a = 0; a < 2; ++a) { const float inv = 1.0f / Lr[a];
#pragma unroll
            for (int q = 0; q < 4; ++q) { const float cq = __expf(mq[a][q] - Mr[a]) * inv; pf[a][2 * q] = scalefrag(pf[a][2 * q], cq); pf[a][2 * q + 1] = scalefrag(pf[a][2 * q + 1], cq); } }
#pragma unroll
        for (int d = 0; d < 2; ++d) {
            AT_WAITBAR();
            if (d == 0) AT_DMA(B1, vt + (size_t)128 * 256, 256);
            else if (has_next) AT_DMA(B0, WSP(const h16, OFF_KB) + (size_t)((un >> 5) * 256) * DM + ((un >> 3) & 3) * 256, DM);
            LAS const unsigned char* VB_ = d == 0 ? B0 : B1;
#pragma unroll
            for (int eh = 0; eh < 2; ++eh) { f32x4 o[2][4]; h16x8 vf[2][4];
#pragma unroll
                for (int e4 = 0; e4 < 4; ++e4) { o[0][e4] = (f32x4){0.f, 0.f, 0.f, 0.f}; o[1][e4] = (f32x4){0.f, 0.f, 0.f, 0.f}; vf[0][e4] = AT_FRAG(VB_, 16 * (4 * eh + e4) + fr, fq); }
#pragma unroll
                for (int kp = 0; kp < 8; ++kp) {
                    if (kp < 7) {
#pragma unroll
                        for (int e4 = 0; e4 < 4; ++e4) vf[(kp + 1) & 1][e4] = AT_FRAG(VB_, 16 * (4 * eh + e4) + fr, 4 * (kp + 1) + fq); }
                    PIN();
#pragma unroll
                    for (int e4 = 0; e4 < 4; ++e4) { o[0][e4] = MFMA16(vf[kp & 1][e4], pf[0][kp], o[0][e4]); o[1][e4] = MFMA16(vf[kp & 1][e4], pf[1][kp], o[1][e4]); }
                    PINV(o[0][0]); PINV(o[1][3]); }
#pragma unroll
                for (int a = 0; a < 2; ++a) { const long t = (long)b * SEQ + qb * 256 + 32 * w + 16 * a + fr; h16* orow = WSP(h16, OFF_OATT) + (size_t)t * DM + hd * 256 + 128 * d + 64 * eh;
#pragma unroll
                    for (int e4 = 0; e4 < 4; ++e4) *(h16x4*)(orow + 16 * e4 + 4 * fq) = pack4(o[a][e4]); } }
        }
    }
    asm volatile("s_waitcnt vmcnt(0) lgkmcnt(0)" ::: "memory");
    __syncthreads();
#undef AT_DMA
#undef AT_FRAG
#undef AT_WAITBAR
#undef AT_LOADQ
}

__device__ __forceinline__ void phase_router(const Frame& F, const Prm& p, int l) {
    LAS h16* RW = (LAS h16*)F.lds;
    { const h16* rwg = WSP(const h16, OFF_RWG);
        for (int i = F.tid; i < 72 * 1032 / 8; i += 512) *(LAS h16x8*)(RW + 8 * i) = *(const h16x8*)(rwg + 8 * i); }
    LAS unsigned* hist = (LAS unsigned*)(F.lds + 72 * 1032 * 2);
    if (F.tid < 32) hist[F.tid] = 0u;
    if (F.G == 256) { for (int i = (int)blockIdx.x * 512 + F.tid; i < MAXSLOT; i += 256 * 512) WSP(int, OFF_STOK)[i] = 0; }
    else if (blockIdx.x == 0) { for (int i = F.tid; i < MAXSLOT; i += 512) WSP(int, OFF_STOK)[i] = 0; }
    __syncthreads();
    const int gw = F.vcu * 8 + F.wave, NGW = F.G * 8, fr = F.lane & 15, fq = F.lane >> 4;
    for (int tg = gw; tg < NT / 16; tg += NGW) {
        const int tok = tg * 16 + fr;
        const h16* hp = WSP(const h16, WS_HB) + (size_t)tok * DM + 8 * fq;
        f32x4 acc[3]; LAS const h16* wrow[3];
#pragma unroll
        for (int mt = 0; mt < 3; ++mt) { acc[mt] = (f32x4){0.f, 0.f, 0.f, 0.f}; const int j = (16 * mt + fr) < 36 ? (16 * mt + fr) : 35; wrow[mt] = RW + j * 1032 + 8 * fq; }
#pragma unroll
        for (int half = 0; half < 2; ++half) { h16x8 hf[16];
#pragma unroll
            for (int q = 0; q < 16; ++q) hf[q] = *(const h16x8*)(hp + 32 * (16 * half + q));
#pragma unroll
            for (int q = 0; q < 16; ++q) { const int ks = 16 * half + q;
#pragma unroll
                for (int mt = 0; mt < 3; ++mt) { acc[mt] = MFMA16(ldsfrag(wrow[mt] + 32 * ks), hf[q], acc[mt]); acc[mt] = MFMA16(ldsfrag(wrow[mt] + 36 * 1032 + 32 * ks), hf[q], acc[mt]); } } }
#pragma unroll
        for (int mt = 0; mt < 3; ++mt) acc[mt] *= (1.0f / 1024.0f);
        const float rs = row_rstd(WSP(const float, WS_SSQ) + (size_t)tok * 16);
        float gl[4];
#pragma unroll
        for (int r = 0; r < 4; ++r) gl[r] = __shfl(acc[0][r], fr) * rs + inptr(F, 25)[l * 4 + r];
        int gi = 0; float gmx = gl[0];
#pragma unroll
        for (int j = 1; j < 4; ++j) if (gl[j] > gmx) { gmx = gl[j]; gi = j; }
        float gsum = 0.f;
#pragma unroll
        for (int j = 0; j < 4; ++j) gsum += __expf(gl[j] - gmx);
        const float gp = 1.0f / gsum;
        const int src1 = fr + 16 * (1 + 2 * (gi & 1)), src2 = fr + 16 * (2 - 2 * (gi & 1)), mt1 = gi >> 1, mt2 = (gi + 1) >> 1;
        float el[8];
#pragma unroll
        for (int k = 0; k < 4; ++k) { const float a0 = __shfl(acc[0][k], src1), a1 = __shfl(acc[1][k], src1); el[k] = (mt1 ? a1 : a0) * rs + inptr(F, 27)[l * 32 + gi * 8 + k];
            const float b0 = __shfl(acc[0][k], src2), b1 = __shfl(acc[1][k], src2), b2 = __shfl(acc[2][k], src2); el[4 + k] = (mt2 == 0 ? b0 : (mt2 == 1 ? b1 : b2)) * rs + inptr(F, 27)[l * 32 + gi * 8 + 4 + k]; }
        int e1 = 0; float m1 = el[0];
#pragma unroll
        for (int j = 1; j < 8; ++j) if (el[j] > m1) { m1 = el[j]; e1 = j; }
        int e2 = -1; float m2 = -3.0e38f;
#pragma unroll
        for (int j = 0; j < 8; ++j) if (j != e1 && el[j] > m2) { m2 = el[j]; e2 = j; }
        const float r2 = __expf(m2 - m1); const float g1 = gp / (1.0f + r2), g2 = gp * r2 / (1.0f + r2);
        if (fq == 0) { const int x1 = gi * 8 + e1, x2 = gi * 8 + e2;
            *(int2*)(WSP(int, OFF_EID) + (size_t)tok * 2) = make_int2(x1, x2); *(f32x2*)(WSP(float, OFF_GATE) + (size_t)tok * 2) = (f32x2){g1, g2};
            WSP(float, OFF_RSTDT)[tok] = rs; __hip_atomic_fetch_add(&hist[x1], 1u, __ATOMIC_RELAXED, __HIP_MEMORY_SCOPE_WORKGROUP); __hip_atomic_fetch_add(&hist[x2], 1u, __ATOMIC_RELAXED, __HIP_MEMORY_SCOPE_WORKGROUP); }
    }
    __syncthreads();
    if (F.tid < 32 && hist[F.tid]) atomicAdd(WSP(unsigned, WS_CTL) + CW_COUNTS + l * 64 + F.tid, hist[F.tid]);
    __syncthreads();
}
__device__ __forceinline__ void phase_dispatch(const Frame& F, int l) {
    LAS int* cnt = (LAS int*)F.lds; LAS int* base = cnt + 32; LAS int* pstart = base + 32; LAS int* slots = pstart + 40;
    unsigned* ctl = WSP(unsigned, WS_CTL);
    for (int blk = F.vcu; blk < NT / 128; blk += F.G) {
        __syncthreads();
        if (F.tid < 32) cnt[F.tid] = 0;
        if (F.tid == 32) { int acc = 0; for (int e = 0; e < 32; ++e) { pstart[e] = acc; acc += (int)((ctl[CW_COUNTS + l * 64 + e] + 255u) & ~255u); } pstart[32] = acc; }
        __syncthreads();
        int e = 0, rank = 0, tok = 0;
        if (F.tid < 256) { tok = blk * 128 + (F.tid >> 1); e = WSP(const int, OFF_EID)[(size_t)tok * 2 + (F.tid & 1)]; rank = __hip_atomic_fetch_add(&cnt[e], 1, __ATOMIC_RELAXED, __HIP_MEMORY_SCOPE_WORKGROUP); }
        __syncthreads();
        if (F.tid < 32) base[F.tid] = cnt[F.tid] ? (int)atomicAdd(&ctl[CW_CURSOR + l * 64 + F.tid], (unsigned)cnt[F.tid]) : 0;
        __syncthreads();
        if (F.tid < 256) { const int slot = pstart[e] + base[e] + rank; slots[F.tid] = slot; WSP(int, OFF_TSLOT)[(size_t)tok * 2 + (F.tid & 1)] = slot; WSP(float, OFF_SRSTD)[slot] = WSP(const float, OFF_RSTDT)[tok]; WSP(int, OFF_STOK)[slot] = tok; }
        __syncthreads();
        if (blk == 0 && F.tid == 0) { const int ntl = pstart[32] >> 8; ctl[CW_NTILES + l] = (unsigned)ntl; int* te = WSP(int, OFF_TILEE);
            for (int e2 = 0; e2 < 32; ++e2) for (int tl = pstart[e2] >> 8; tl < (pstart[e2 + 1] >> 8); ++tl) te[tl] = e2; }
    }
    __syncthreads();
}
__device__ __forceinline__ void phase_combine(const Frame& F, const Prm& p, int l) {
    const int gw = F.vcu * 8 + F.wave, NGW = F.G * 8;
    const bool last = (l == NLAYER - 1);
    for (int tk0 = gw * 4; tk0 < NT; tk0 += NGW * 4) {
        int2 sl[4]; f32x2 gt[4];
#pragma unroll
        for (int q = 0; q < 4; ++q) { sl[q] = *(const int2*)(WSP(const int, OFF_TSLOT) + (size_t)(tk0 + q) * 2); gt[q] = *(const f32x2*)(WSP(const float, OFF_GATE) + (size_t)(tk0 + q) * 2); }
        f32x4 v[4][4]; h16x4 ya[4][4], yb[4][4];
#pragma unroll
        for (int q = 0; q < 4; ++q) { const h16* hrow = WSP(const h16, WS_HB) + (size_t)(tk0 + q) * DM; const h16* y0 = WSP(const h16, OFF_YP) + (size_t)sl[q].x * DM; const h16* y1 = WSP(const h16, OFF_YP) + (size_t)sl[q].y * DM;
#pragma unroll
            for (int j = 0; j < 4; ++j) { const int c = 4 * F.lane + 256 * j; const h16x4 hv = *(const h16x4*)(hrow + c); v[q][j] = (f32x4){(float)hv[0], (float)hv[1], (float)hv[2], (float)hv[3]}; ya[q][j] = __builtin_nontemporal_load((const h16x4*)(y0 + c)); yb[q][j] = __builtin_nontemporal_load((const h16x4*)(y1 + c)); } }
#pragma unroll
        for (int q = 0; q < 4; ++q) { float s = 0.f;
#pragma unroll
            for (int j = 0; j < 4; ++j) {
#pragma unroll
                for (int e = 0; e < 4; ++e) v[q][j][e] += gt[q][0] * (float)ya[q][j][e] + gt[q][1] * (float)yb[q][j][e];
                if (!last) { const h16x4 o = pack4(v[q][j]); v[q][j] = (f32x4){(float)o[0], (float)o[1], (float)o[2], (float)o[3]}; }
                s += (v[q][j][0] * v[q][j][0] + v[q][j][1] * v[q][j][1]) + (v[q][j][2] * v[q][j][2] + v[q][j][3] * v[q][j][3]); }
            s = wave_sum(s);
            if (!last) {
#pragma unroll
                for (int j = 0; j < 4; ++j) { const int c = 4 * F.lane + 256 * j; *(h16x4*)(WSP(h16, WS_HB) + (size_t)(tk0 + q) * DM + c) = pack4(v[q][j]); }
                if (F.lane < 16) WSP(float, WS_SSQ)[(size_t)(tk0 + q) * 16 + F.lane] = (F.lane == 0) ? s : 0.f;
                if (F.lane == 0) WSP(float, OFF_RSTDT)[tk0 + q] = 1.0f / sqrtf(s * (1.0f / DM) + EPS);
            } else { const float rs = 1.0f / sqrtf(s * (1.0f / DM) + EPS); float* orow = F.out + (size_t)(tk0 + q) * DM;
#pragma unroll
                for (int j = 0; j < 4; ++j) { const int c = 4 * F.lane + 256 * j; const f32x4 gf = *(const f32x4*)(inptr(F, 31) + c); *(f32x4*)(orow + c) = v[q][j] * rs * gf; } } }
    }
}

__global__ void __launch_bounds__(512, 2) fwd(Prm p) {
    extern __shared__ __attribute__((aligned(16))) unsigned char lds_raw[];
    Frame F; F.lds = (LAS unsigned char*)lds_raw; F.ws = (GAS unsigned char*)p.ws; F.out = p.out;
    F.tid = threadIdx.x; F.lane = F.tid & 63; F.wave = __builtin_amdgcn_readfirstlane(F.tid >> 6);
    F.G = gridDim.x; { const int bx = blockIdx.x; F.vcu = (F.G % 8 == 0) ? (bx % 8) * (F.G / 8) + bx / 8 : bx; }
    volatile LAS unsigned* misc = (volatile LAS unsigned*)(F.lds + LDS_MISC);
    if (F.tid < 4) misc[F.tid] = 0u;
    F.ptab = (volatile LAS unsigned long long*)(F.lds + LDS_MISC + 64);
    if (F.tid < 32) F.ptab[F.tid] = (unsigned long long)p.in[F.tid];
    __syncthreads();
    const int lo = p.ph_lo, hi = p.ph_hi;
    XcdBarrier bar; bar.bar = WSP(unsigned, WS_CTL) + CW_BAR; bar.x = 0; bar.st = misc;
    if (hi - lo > 1) bar = xcd_barrier_post(WSP(unsigned, WS_CTL) + CW_BAR, misc);
#ifndef UMASK
#define UMASK 7
#endif
#ifndef REPMASK
#define REPMASK 0
#endif
#ifndef PHMASK
#define PHMASK 0x3fff
#endif
#define IN(k) (((PHMASK >> ((k) % NPH)) & 1) && lo <= (k) && (k) < hi && (launder(F), true))
#define REPS(k) (((REPMASK >> (k)) & 1) ? 2 : 1)
#define INR(k) (lo <= (k) && (k) < hi)
#ifndef AMPMASK
#define AMPMASK 0
#endif
    unsigned long long tprev = AMPMASK ? __builtin_amdgcn_s_memrealtime() : 0ull;
#define SEAM(k) do { if (INR(k) && INR((k) + 1)) { xcd_barrier(bar); if (AMPMASK) { const unsigned long long tn = __builtin_amdgcn_s_memrealtime(); \
        if ((AMPMASK >> ((k) % NPH)) & 1) { const unsigned long long tgt = tn + 4ull * (tn - tprev); while (__builtin_amdgcn_s_memrealtime() < tgt) __builtin_amdgcn_s_sleep(8); } \
        tprev = __builtin_amdgcn_s_memrealtime(); } } } while (0)
    for (int l = 0; l < NLAYER; ++l) {
        const int pb = l * NPH;
        if (IN(pb + 0)) for (int rep = 0; rep < REPS(0); ++rep) { phase_convert(F, p, l); } SEAM(pb + 0);
        if (REPS(20) == 2 && INR(pb + 0) && INR(pb + 1)) { for (int q = 0; q < 20; ++q) xcd_barrier(bar); }
        if (IN(pb + 1)) for (int rep = 0; rep < REPS(1); ++rep) {
            if (UMASK & 1) { pg8::Gemm g{WSP(const h16, WS_HB), WSP(const h16, WS_WIN), DM, DM, DM, nullptr}; pg8::StaticOrder S; S.init(NT, NPJ, F.G, (int)blockIdx.x);
              pg8::EpiScale16C E{WSP(h16, WS_R1), NPJ, WSP(const float, OFF_RSTDT)}; pg8::gemm_phase(F.lds, F.tid, g, S, E); }
        } SEAM(pb + 1);
        if (IN(pb + 2)) for (int rep = 0; rep < REPS(2); ++rep) {
            if (UMASK & 1) for (int r2 = 0; r2 < REPS(17); ++r2) for (int u = blockIdx.x; u < NB * NCH * 2; u += F.G) ssd_states_unit(F, p, l, u);
            launder(F);
            if (UMASK & 2) for (int r2 = 0; r2 < REPS(18); ++r2) for (int u = blockIdx.x; u < NB * NCH; u += F.G) ret_states_block(F, u);
            launder(F);
            if (UMASK & 4) for (int r2 = 0; r2 < REPS(19); ++r2) for (int u = blockIdx.x; u < NB * NCH; u += F.G) lru_unit(F, p, l, u);
        } SEAM(pb + 2);
        if (IN(pb + 3)) for (int rep = 0; rep < REPS(3); ++rep) {
            const bool split = (F.G == 256); const int GS = split ? 128 : F.G;
            if (!split || blockIdx.x < 128) {
                for (int u = blockIdx.x; u < 2 * NB * 6; u += GS) ssd_scan_unit(F, u);
                launder(F);
                for (int u = blockIdx.x; u < 2 * NB * 6; u += GS) ret_scan_unit(F, u);
                lru_scan(F); }
            launder(F);
            if (!split || blockIdx.x >= 128) {
                pg8::Gemm g{WSP(const h16, WS_MEM16), WSP(const h16, WS_WKV), DM, DM, DM, nullptr}; pg8::StaticOrder S; S.init(NTM, 2048, GS, split ? (int)blockIdx.x - 128 : (int)blockIdx.x);
                pg8::EpiKV E{WSP(h16, OFF_KB), WSP(h16, OFF_VT), WSP(const float, OFF_MSSQ)}; pg8::gemm_phase(F.lds, F.tid, g, S, E); }
        } SEAM(pb + 3);
        if (IN(pb + 4)) for (int rep = 0; rep < REPS(4); ++rep) {
            if (UMASK & 1) for (int r2 = 0; r2 < REPS(14); ++r2) for (int u = blockIdx.x; u < NB * NCH * 2; u += F.G) ssd_out_unit(F, p, l, u);
            launder(F);
            if (UMASK & 2) for (int r2 = 0; r2 < REPS(15); ++r2) for (int u = blockIdx.x; u < NB * NCH; u += F.G) ret_out_block(F, u);
            launder(F);
            if (UMASK & 4) for (int r2 = 0; r2 < REPS(16); ++r2) for (int u = blockIdx.x; u < NB * NCH; u += F.G) lru_out_unit(F, u);
        } SEAM(pb + 4);
        if (IN(pb + 5)) for (int rep = 0; rep < REPS(5); ++rep) { pg8::Gemm g{WSP(const h16, OFF_OMIX), WSP(const h16, WS_WOUT), DM, DM, DM, nullptr}; pg8::StaticOrder S; S.init(NT, DM, F.G, (int)blockIdx.x);
            pg8::EpiResid E{WSP(h16, WS_HB), WSP(float, WS_SSQ)}; pg8::gemm_phase(F.lds, F.tid, g, S, E); } SEAM(pb + 5);
        if (IN(pb + 6)) for (int rep = 0; rep < REPS(6); ++rep) { pg8::Gemm g{WSP(const h16, WS_HB), WSP(const h16, WS_WQ), DM, DM, DM, nullptr}; pg8::StaticOrder S; S.init(NT, DM, F.G, (int)blockIdx.x);
            pg8::EpiScale16 E{WSP(h16, OFF_QCA), DM, WSP(const float, WS_SSQ)}; pg8::gemm_phase(F.lds, F.tid, g, S, E); } SEAM(pb + 6);
        if (IN(pb + 7)) for (int rep = 0; rep < REPS(7); ++rep) { attn_phase(F); } SEAM(pb + 7);
        if (IN(pb + 8)) for (int rep = 0; rep < REPS(8); ++rep) { pg8::Gemm g{WSP(const h16, OFF_OATT), WSP(const h16, WS_WO), DM, DM, DM, nullptr}; pg8::StaticOrder S; S.init(NT, DM, F.G, (int)blockIdx.x);
            pg8::EpiResid E{WSP(h16, WS_HB), WSP(float, WS_SSQ)}; pg8::gemm_phase(F.lds, F.tid, g, S, E); } SEAM(pb + 8);
        if (IN(pb + 9)) for (int rep = 0; rep < REPS(9); ++rep) { phase_router(F, p, l); } SEAM(pb + 9);
        if (IN(pb + 10)) for (int rep = 0; rep < REPS(10); ++rep) { phase_dispatch(F, l); } SEAM(pb + 10);
        if (IN(pb + 11)) for (int rep = 0; rep < REPS(11); ++rep) { pg8::Gemm g{WSP(const h16, WS_HB), WSP(const h16, WS_W13), DM, DM, DM, WSP(const int, OFF_STOK)};
            pg8::GroupOrder S{WSP(const int, OFF_TILEE), __builtin_amdgcn_readfirstlane((int)WSP(const unsigned, WS_CTL)[CW_NTILES + l]), F.G, F.vcu};
            pg8::EpiGated E{WSP(h16, OFF_HP), WSP(const float, OFF_SRSTD)}; pg8::gemm_phase<pg8::EpiGated, pg8::GroupOrder, true>(F.lds, F.tid, g, S, E); } SEAM(pb + 11);
        if (IN(pb + 12)) for (int rep = 0; rep < REPS(12); ++rep) { pg8::Gemm g{WSP(const h16, OFF_HP), WSP(const h16, WS_W2), 512, 512, 512, nullptr};
            pg8::GroupOrder S{WSP(const int, OFF_TILEE), __builtin_amdgcn_readfirstlane((int)WSP(const unsigned, WS_CTL)[CW_NTILES + l]), F.G, F.vcu};
            pg8::EpiPlain16 E{WSP(h16, OFF_YP)}; pg8::gemm_phase(F.lds, F.tid, g, S, E); } SEAM(pb + 12);
        if (IN(pb + 13)) for (int rep = 0; rep < REPS(13); ++rep) { phase_combine(F, p, l); } SEAM(pb + 13);
    }
#undef IN
#undef INR
#undef SEAM
}

extern "C" void kernel_launch(void* const* d_in, const int* in_sizes, int n_in, void* d_out, int out_size, void* d_ws, size_t ws_size, hipStream_t stream) {
    static int grid = 0;
    if (grid == 0) {
        if (n_in != 32 || out_size != NT * DM || ws_size < WS_END) { fprintf(stderr, "kernel_launch: unexpected shapes / workspace (%d inputs, out %d, ws %zu < %zu)\n", n_in, out_size, ws_size, (size_t)WS_END); grid = -1; return; }
        int dev = 0, cus = 0, per_cu = 0;
        if (hipGetDevice(&dev) != hipSuccess || hipDeviceGetAttribute(&cus, hipDeviceAttributeMultiprocessorCount, dev) != hipSuccess) { grid = -1; return; }
        if (hipFuncSetAttribute((const void*)fwd, hipFuncAttributeMaxDynamicSharedMemorySize, LDS_BYTES) != hipSuccess) { fprintf(stderr, "kernel_launch: hipFuncSetAttribute failed\n"); grid = -1; return; }
        if (hipOccupancyMaxActiveBlocksPerMultiprocessor(&per_cu, (const void*)fwd, 512, LDS_BYTES) != hipSuccess || per_cu < 1) { fprintf(stderr, "kernel_launch: occupancy query says %d\n", per_cu); }
        (void)hipGetLastError();
        grid = cus;
    }
    if (grid < 0) return;
    (void)hipMemsetAsync((char*)d_ws + WS_CTL, 0, CTL_ZERO_BYTES, stream);
    Prm p{};
    for (int i = 0; i < 32; ++i) p.in[i] = (const float*)d_in[i];
    p.out = (float*)d_out; p.ws = (unsigned char*)d_ws;
#if defined(PROBE_PHASE)
    p.ph_lo = 0; p.ph_hi = PROBE_PHASE + 1; hipLaunchKernelGGL(fwd, dim3(grid), dim3(512), LDS_BYTES, stream, p);
    (void)hipMemsetAsync((char*)d_ws + WS_CTL + CW_BAR * 4, 0, XCD_BAR_WORDS * 4, stream);
    p.ph_lo = PROBE_PHASE; p.ph_hi = PROBE_PHASE + 1; hipLaunchKernelGGL(fwd, dim3(grid), dim3(512), LDS_BYTES, stream, p);
    p.ph_lo = PROBE_PHASE + 1; p.ph_hi = NPHASES; hipLaunchKernelGGL(fwd, dim3(grid), dim3(512), LDS_BYTES, stream, p);
#elif MK_SINGLE
    p.ph_lo = 0; p.ph_hi = NPHASES;
    hipLaunchKernelGGL(fwd, dim3(grid), dim3(512), LDS_BYTES, stream, p);
#else
    for (int ph = 0; ph < NPHASES; ++ph) { p.ph_lo = ph; p.ph_hi = ph + 1; hipLaunchKernelGGL(fwd, dim3(grid), dim3(512), LDS_BYTES, stream, p); }
#endif
}
```

```cpp
#include <hip/hip_runtime.h>
#include <cstdio>
#include <cstdint>

#ifndef MK_SINGLE
#define MK_SINGLE 1
#endif

typedef _Float16 h16;
typedef _Float16 h16x2 __attribute__((ext_vector_type(2)));
typedef _Float16 h16x4 __attribute__((ext_vector_type(4)));
typedef _Float16 h16x8 __attribute__((ext_vector_type(8)));
typedef float f32x2 __attribute__((ext_vector_type(2)));
typedef float f32x4 __attribute__((ext_vector_type(4)));
typedef unsigned u32x2 __attribute__((ext_vector_type(2)));
typedef unsigned u32x4 __attribute__((ext_vector_type(4)));
#define LAS __attribute__((address_space(3)))
#define GAS __attribute__((address_space(1)))
#define PIN() do { asm volatile("" ::: "memory"); __builtin_amdgcn_sched_barrier(0); } while (0)
#define PINV(x) asm volatile("" : "+v"(x) :: "memory")
#define NTL(T, p) __builtin_nontemporal_load((const T*)(p))
#define MFMA16(a, b, c) __builtin_amdgcn_mfma_f32_16x16x32_f16((a), (b), (c), 0, 0, 0)

constexpr int NB = 16, SEQ = 2048, DM = 1024, NT = NB * SEQ, MEML = 256, NTM = NB * MEML, NLAYER = 2;
constexpr int NPJ = 3584;
constexpr int CQ = 0, CK = 384, CV = 768, CG = 1152, CZ = 1536, CXS = 1920, CBM = 2304, CCM = 2560, CXR = 2816, CGT = 3072, CDT = 3328;
constexpr int DIN = 3334, NCH = 16, MAXSLOT = 73728;
constexpr float EPS = 1e-6f;
constexpr int NPH = 14;
constexpr int NPHASES = NLAYER * NPH;

constexpr size_t MiB = (size_t)1 << 20;
constexpr size_t WS_CTL = 0, CTL_ZERO_BYTES = 64 * 1024;
constexpr size_t WS_WIN = 1 * MiB, WS_WOUT = 8 * MiB, WS_WQ = 10 * MiB, WS_WKV = 12 * MiB, WS_WO = 16 * MiB, WS_W13 = 18 * MiB, WS_W2 = 82 * MiB, WS_LRUW = 114 * MiB;
constexpr size_t WS_HB = 115 * MiB;
constexpr size_t WS_R1 = 179 * MiB;
constexpr size_t WS_R2 = 403 * MiB;
constexpr size_t WS_KV = 547 * MiB, WS_MEM16 = 563 * MiB, WS_SSQ = 571 * MiB, WS_MISC = 573 * MiB, WS_END = 577 * MiB;
constexpr size_t OFF_QCA = WS_R1, OFF_OATT = WS_R1 + 64 * MiB, OFF_XP = WS_R1, OFF_HP = WS_R1 + 144 * MiB;
constexpr size_t OFF_OMIX = WS_R2, OFF_RST = WS_R2 + 64 * MiB, OFF_SST = WS_R2 + 88 * MiB, OFF_LSUM = WS_R2 + 136 * MiB, OFF_SDEC = WS_R2 + 137 * MiB, OFF_LCAR = WS_R2 + 138 * MiB, OFF_YP = WS_R2;
constexpr size_t OUT_XTG = 0, OUT_BCN = 24 * MiB, OUT_LAU = 56 * MiB;
constexpr size_t OFF_KB = WS_KV, OFF_VT = WS_KV + 8 * MiB;
constexpr size_t OFF_ROPE = WS_MISC, OFF_MSSQ = WS_MISC + 512 * 1024, OFF_EID = WS_MISC + 768 * 1024, OFF_GATE = WS_MISC + 1024 * 1024, OFF_TSLOT = WS_MISC + 1280 * 1024,
                 OFF_RSTDT = WS_MISC + 1536 * 1024, OFF_SRSTD = WS_MISC + 1664 * 1024, OFF_TILEE = WS_MISC + 2000 * 1024, OFF_STOK = WS_MISC + 2048 * 1024, OFF_RWG = WS_MISC + 2400 * 1024;
constexpr int CW_COUNTS = 64, CW_CURSOR = 192, CW_NTILES = 320, CW_BAR = 4096;

constexpr int LDS_BYTES = 152 * 1024;
constexpr int LDS_MISC = 150 * 1024;

struct Prm { const float* in[32]; float* out; unsigned char* ws; int ph_lo, ph_hi; };

#define XB_TMO      128
#define XB_XCNT(j)  (256  + 64 * (j))
#define XB_XSUB(j)  (1280 + 64 * (j))
#define XB_XGEN(j)  (2304 + 64 * (j))
#define XB_TOP      3328
#define XB_TOPGEN   3392
#define XCD_BAR_WORDS 3456
#define XB_SPIN_CAP (1u << 18)
__device__ __forceinline__ unsigned xb_ld(unsigned* p)              { return __hip_atomic_load(p, __ATOMIC_RELAXED, __HIP_MEMORY_SCOPE_AGENT); }
__device__ __forceinline__ unsigned xb_add(unsigned* p, unsigned v) { return __hip_atomic_fetch_add(p, v, __ATOMIC_RELAXED, __HIP_MEMORY_SCOPE_AGENT); }
__device__ __forceinline__ unsigned xb_xcc_id() { return (unsigned)__builtin_amdgcn_s_getreg((3 << 11) | 20) & 0xFu; }
#define XB_SPIN(cond, bar) do { unsigned _sp = 0; while (cond) { __builtin_amdgcn_s_sleep(1); \
    if ((++_sp & 255u) == 0u) { if (xb_ld(&(bar)[XB_TMO])) break; if (_sp > XB_SPIN_CAP) { atomicAdd(&(bar)[XB_TMO], 1u); break; } } } } while (0)
struct XcdBarrier { unsigned* bar; unsigned x; volatile LAS unsigned* st; };
__device__ __forceinline__ XcdBarrier xcd_barrier_post(unsigned* bar, volatile LAS unsigned* st) {
    XcdBarrier b; b.bar = bar; b.x = xb_xcc_id(); b.st = st;
    if (threadIdx.x == 0) (void)xb_add(&bar[XB_XCNT(b.x)], 1u);
    return b;
}
__device__ __forceinline__ void xcd_barrier_complete(unsigned* bar, unsigned x, unsigned& nloc, unsigned& nx) {
    const unsigned G = gridDim.x * gridDim.y * gridDim.z;
    unsigned sum, cnt, mine, sp = 0u;
    for (;;) {
        sum = 0u; cnt = 0u; mine = 0u;
#pragma unroll
        for (unsigned j = 0; j < 16; ++j) { const unsigned c = xb_ld(&bar[XB_XCNT(j)]); sum += c; cnt += (c > 0u) ? 1u : 0u; mine = (j == x) ? c : mine; }
        if (sum == G) break;
        __builtin_amdgcn_s_sleep(1);
        if ((++sp & 255u) == 0u) { if (xb_ld(&bar[XB_TMO])) break; if (sp > XB_SPIN_CAP) { atomicAdd(&bar[XB_TMO], 1u); break; } }
    }
    nloc = mine > 0u ? mine : 1u; nx = cnt > 0u ? cnt : 1u;
}
__device__ __forceinline__ void xcd_barrier(const XcdBarrier& b) {
    asm volatile("s_waitcnt vmcnt(0)" ::: "memory");
    __syncthreads();
    if (threadIdx.x == 0) {
        unsigned* bar = b.bar;
        __builtin_amdgcn_s_waitcnt(0);
        unsigned nloc = b.st[0], nx = b.st[1];
        if (nloc == 0u) { xcd_barrier_complete(bar, b.x, nloc, nx); b.st[0] = nloc; b.st[1] = nx; }
        const unsigned old = xb_add(&bar[XB_XSUB(b.x)], 1u);
        const unsigned gen = old / nloc;
        if (old + 1u == (gen + 1u) * nloc) {
            __builtin_amdgcn_fence(__ATOMIC_RELEASE, "agent");
            asm volatile("s_waitcnt vmcnt(0)" ::: "memory");
            const unsigned og = xb_add(&bar[XB_TOP], 1u);
            const unsigned tg = og / nx;
            if (og + 1u == (tg + 1u) * nx) xb_add(&bar[XB_TOPGEN], 1u);
            else XB_SPIN(xb_ld(&bar[XB_TOPGEN]) == tg, bar);
            __builtin_amdgcn_fence(__ATOMIC_ACQUIRE, "agent");
            xb_add(&bar[XB_XGEN(b.x)], 1u);
            asm volatile("s_waitcnt vmcnt(0)" ::: "memory");
        } else {
            XB_SPIN(xb_ld(&bar[XB_XGEN(b.x)]) == gen, bar);
            __builtin_amdgcn_fence(__ATOMIC_ACQUIRE, "agent");
            asm volatile("s_waitcnt vmcnt(0)" ::: "memory");
        }
    }
    __syncthreads();
}

__device__ __forceinline__ float wave_sum(float v) {
#pragma unroll
    for (int o = 1; o < 64; o <<= 1) v += __shfl_xor(v, o);
    return v;
}
__device__ __forceinline__ float siluf_(float x) { return x * __builtin_amdgcn_rcpf(1.0f + __expf(-x)); }
__device__ __forceinline__ float softplusf_(float x) { return x > 20.f ? x : log1pf(__expf(x)); }
__device__ __forceinline__ float gelu_tanh_(float x) { const float y = 0.7978845608028654f * (x + 0.044715f * x * x * x); const float t = 1.0f - 2.0f / (__expf(2.0f * y) + 1.0f); return 0.5f * x * (1.0f + t); }
__device__ __forceinline__ h16x8 pack8(const f32x4 a, const f32x4 b) { h16x8 r; r[0] = (h16)a[0]; r[1] = (h16)a[1]; r[2] = (h16)a[2]; r[3] = (h16)a[3]; r[4] = (h16)b[0]; r[5] = (h16)b[1]; r[6] = (h16)b[2]; r[7] = (h16)b[3]; return r; }
__device__ __forceinline__ h16x4 pack4(const f32x4 a) { h16x4 r; r[0] = (h16)a[0]; r[1] = (h16)a[1]; r[2] = (h16)a[2]; r[3] = (h16)a[3]; return r; }
__device__ __forceinline__ h16x8 ldsfrag(LAS const h16* p) { return *(LAS const h16x8*)p; }
__device__ __forceinline__ int kperm32(int k) { return (k & ~31) | (((k >> 2) & 3) << 3) | (((k >> 4) & 1) << 2) | (k & 3); }
__device__ __forceinline__ h16x8 scalefrag(const h16x8 f, float s) { const h16 hs = (h16)s; h16x8 v;
#pragma unroll
    for (int j = 0; j < 8; ++j) v[j] = hs; return f * v; }
__device__ __forceinline__ float row_rstd(const float* ssq16) {
    const f32x4 a = *(const f32x4*)ssq16, b = *(const f32x4*)(ssq16 + 4), c = *(const f32x4*)(ssq16 + 8), d = *(const f32x4*)(ssq16 + 12);
    const float s = ((a[0] + a[1]) + (a[2] + a[3])) + ((b[0] + b[1]) + (b[2] + b[3])) + ((c[0] + c[1]) + (c[2] + c[3])) + ((d[0] + d[1]) + (d[2] + d[3]));
    return 1.0f / sqrtf(s * (1.0f / DM) + EPS);
}

namespace pg8 {
constexpr int BM = 256, BK = 64, HALF = 128, HTB = HALF * BK * 2, STAGE_BYTES = 8 * HTB, NXCD = 8, WGM = 8;
__host__ __device__ __forceinline__ int lds_byte(int r, int c) { const int st = (r >> 4) * 2 + (c >> 5), rr = r & 15, cc = c & 31, ob = rr * 64 + cc * 2; return st * 1024 + (ob ^ (((ob >> 9) & 1) << 5)); }
__host__ __device__ __forceinline__ void stage_rc(int b, int& R, int& C) { const int st = b / 1024, sb = b % 1024, swz = sb ^ (((sb >> 9) & 1) << 5); R = (st >> 1) * 16 + swz / 64; C = (st & 1) * 32 + (swz % 64) / 2; }
__host__ __device__ __forceinline__ int perm32(int rho) { const int n = rho >> 4, i = rho & 15; return 8 * (i >> 2) + 4 * n + (i & 3); }
struct Unit { int pm, pn; };
struct Gemm { const h16* A; const h16* Bt; int lda, ldb, K; const int* rowidx; };
struct StaticOrder {
    int nM, nN, nwg, G, c;
    __device__ void init(int M, int N, int G_, int c_) { nM = M / BM; nN = N / BM; nwg = nM * nN; G = G_; c = c_; }
    __device__ bool next(int i, Unit& u) const {
        const long L = (long)i * G + c; if (L >= nwg) return false;
        int wgid = (int)L; { const int q = nwg / NXCD, r = nwg % NXCD, xcd = wgid % NXCD, off = wgid / NXCD; wgid = (xcd < r ? xcd * (q + 1) : r * (q + 1) + (xcd - r) * q) + off; }
        const int nig = WGM * nN, gid = wgid / nig, fm = gid * WGM, gsz = (nM - fm) < WGM ? (nM - fm) : WGM;
        u.pm = fm + ((wgid % nig) % gsz); u.pn = (wgid % nig) / gsz; return true;
    }
};
struct GroupOrder {
    const int* tile_e; int ntiles, G, vcu;
    __device__ bool next(int i, Unit& u) const {
        const int L = i * G + vcu, tile = L >> 2; if (tile >= ntiles) return false;
        u.pm = tile; u.pn = __builtin_amdgcn_readfirstlane(tile_e[tile]) * 4 + (L & 3); return true;
    }
};

struct EpiScale16 {
    static constexpr bool PERM = true;
    h16* O; int ldc; const float* ssq;
    __device__ __forceinline__ void operator()(const f32x4 (&acc)[2][2][4][2], const Unit& u, int wr, int wc, int fr, int fq) const {
        const int row0 = u.pm * BM + wr * 64 + fr, col0 = u.pn * BM + wc * 32 + 8 * fq;
#pragma unroll
        for (int ai = 0; ai < 2; ++ai)
#pragma unroll
            for (int m = 0; m < 4; ++m) { const int row = row0 + ai * HALF + m * 16; const float rs = row_rstd(ssq + (size_t)row * 16); h16* rowp = O + (size_t)row * ldc + col0;
#pragma unroll
                for (int bj = 0; bj < 2; ++bj) *(h16x8*)(rowp + bj * HALF) = pack8(acc[ai][bj][m][0] * rs, acc[ai][bj][m][1] * rs); }
    }
};
struct EpiScale16C {
    static constexpr bool PERM = true;
    h16* O; int ldc; const float* rstd;
    __device__ __forceinline__ void operator()(const f32x4 (&acc)[2][2][4][2], const Unit& u, int wr, int wc, int fr, int fq) const {
        const int row0 = u.pm * BM + wr * 64 + fr, col0 = u.pn * BM + wc * 32 + 8 * fq;
        float rs[2][4];
#pragma unroll
        for (int ai = 0; ai < 2; ++ai)
#pragma unroll
            for (int m = 0; m < 4; ++m) rs[ai][m] = rstd[row0 + ai * HALF + m * 16];
#pragma unroll
        for (int ai = 0; ai < 2; ++ai)
#pragma unroll
            for (int m = 0; m < 4; ++m) { h16* rowp = O + (size_t)(row0 + ai * HALF + m * 16) * ldc + col0;
#pragma unroll
                for (int bj = 0; bj < 2; ++bj) *(h16x8*)(rowp + bj * HALF) = pack8(acc[ai][bj][m][0] * rs[ai][m], acc[ai][bj][m][1] * rs[ai][m]); }
    }
};
struct EpiKV {
    static constexpr bool PERM = true;
    h16* KB; h16* VT; const float* ssq;
    __device__ __forceinline__ void operator()(const f32x4 (&acc)[2][2][4][2], const Unit& u, int wr, int wc, int fr, int fq) const {
        const int row0 = u.pm * BM + wr * 64 + fr;
#pragma unroll
        for (int ai = 0; ai < 2; ++ai)
#pragma unroll
            for (int m = 0; m < 4; ++m) { const int row = row0 + ai * HALF + m * 16; const float rs = row_rstd(ssq + (size_t)row * 16);
                h16x8 pk[2];
#pragma unroll
                for (int bj = 0; bj < 2; ++bj) pk[bj] = pack8(acc[ai][bj][m][0] * rs, acc[ai][bj][m][1] * rs);
                if (u.pn < 4) { h16* rowp = KB + (size_t)row * DM + u.pn * BM + wc * 32 + 8 * fq;
                    *(h16x8*)rowp = pk[0]; *(h16x8*)(rowp + HALF) = pk[1];
                } else { const int b = row >> 8, k0 = row & 255, hd = u.pn - 4;
                    const int key = (k0 & ~31) | (((k0 >> 2) & 3) << 3) | (((k0 >> 4) & 1) << 2) | (k0 & 3);
                    h16* base = VT + ((size_t)(b * 4 + hd) * 256 + wc * 32 + 8 * fq) * 256 + key;
#pragma unroll
                    for (int bj = 0; bj < 2; ++bj)
#pragma unroll
                        for (int j = 0; j < 8; ++j) base[(bj * HALF + j) * 256] = pk[bj][j]; }
                PIN();
            }
    }
};
struct EpiResid {
    static constexpr bool PERM = true;
    h16* hb; float* ssq;
    __device__ __forceinline__ void operator()(const f32x4 (&acc)[2][2][4][2], const Unit& u, int wr, int wc, int fr, int fq) const {
        const int row0 = u.pm * BM + wr * 64 + fr, col0 = u.pn * BM + wc * 32 + 8 * fq;
#pragma unroll
        for (int ai = 0; ai < 2; ++ai)
#pragma unroll
            for (int m = 0; m < 4; ++m) { const int row = row0 + ai * HALF + m * 16; h16* rowp = hb + (size_t)row * DM + col0; float s = 0.f;
#pragma unroll
                for (int bj = 0; bj < 2; ++bj) { const h16x8 bv = *(const h16x8*)(rowp + bj * HALF); f32x4 v0, v1;
#pragma unroll
                    for (int e = 0; e < 4; ++e) { v0[e] = (float)bv[e] + acc[ai][bj][m][0][e]; v1[e] = (float)bv[4 + e] + acc[ai][bj][m][1][e]; }
                    const h16x8 o = pack8(v0, v1); *(h16x8*)(rowp + bj * HALF) = o;
#pragma unroll
                    for (int e = 0; e < 8; ++e) { const float q = (float)o[e]; s += q * q; } }
                s += __shfl_xor(s, 16); s += __shfl_xor(s, 32);
                if (fq == 0) ssq[(size_t)row * 16 + u.pn * 4 + wc] = s; }
    }
};
struct EpiGated {
    static constexpr bool PERM = true;
    h16* O; const float* srstd;
    __device__ __forceinline__ void operator()(const f32x4 (&acc)[2][2][4][2], const Unit& u, int wr, int wc, int fr, int fq) const {
        const int row0 = u.pm * BM + wr * 64 + fr, col0 = (u.pn & 3) * HALF + wc * 32 + 8 * fq;
#pragma unroll
        for (int ai = 0; ai < 2; ++ai)
#pragma unroll
            for (int m = 0; m < 4; ++m) { const int row = row0 + ai * HALF + m * 16; const float rs = srstd[row]; f32x4 o[2];
#pragma unroll
                for (int n = 0; n < 2; ++n)
#pragma unroll
                    for (int j = 0; j < 4; ++j) { const float a = acc[ai][0][m][n][j] * rs, b = acc[ai][1][m][n][j] * rs; o[n][j] = siluf_(a) * b; }
                *(h16x8*)(O + (size_t)row * 512 + col0) = pack8(o[0], o[1]); }
    }
};
struct EpiPlain16 {
    static constexpr bool PERM = true;
    h16* O;
    __device__ __forceinline__ void operator()(const f32x4 (&acc)[2][2][4][2], const Unit& u, int wr, int wc, int fr, int fq) const {
        const int row0 = u.pm * BM + wr * 64 + fr, col0 = (u.pn & 3) * BM + wc * 32 + 8 * fq;
#pragma unroll
        for (int ai = 0; ai < 2; ++ai)
#pragma unroll
            for (int m = 0; m < 4; ++m) { h16* rowp = O + (size_t)(row0 + ai * HALF + m * 16) * DM + col0;
#pragma unroll
                for (int bj = 0; bj < 2; ++bj) *(h16x8*)(rowp + bj * HALF) = pack8(acc[ai][bj][m][0], acc[ai][bj][m][1]); }
    }
};

template <class Epi, class Sched, bool GATHER = false>
__device__ __forceinline__ void gemm_phase(LAS unsigned char* lds, const int tid, const Gemm g, const Sched& S, const Epi& E) {
    const int wid = __builtin_amdgcn_readfirstlane(tid >> 6), lane = tid & 63, wr = wid >> 2, wc = wid & 3, fr = lane & 15, fq = lane >> 4;
    const int K = g.K, nt = K / BK;
    unsigned voffA[2], voffB[2];
#pragma unroll
    for (int i = 0; i < 2; ++i) { int R, C; stage_rc(tid * 16 + i * 8192, R, C); const int Rb = Epi::PERM ? ((R & ~31) + perm32(R & 31)) : R;
        voffA[i] = (unsigned)(R * g.lda + C) * 2u; voffB[i] = (unsigned)(Rb * g.ldb + C) * 2u; }
    const size_t kstep = (size_t)(BK * 2);
    const size_t hstepA = (size_t)HALF * g.lda * 2, hstepB = (size_t)HALF * g.ldb * 2;
    const size_t tstepA = 2 * hstepA, tstepB = 2 * hstepB;
    const unsigned ldsw = (unsigned)wid * 1024u;
    const int aoff = lds_byte(wr * 64 + fr, fq * 8), boff = lds_byte(wc * 32 + fr, fq * 8);
#define PG8_SA(b, h) (((b) * 2 + (h)) * HTB)
#define PG8_SB(b, h) ((4 + (b) * 2 + (h)) * HTB)
#define PG8_STAGE(bufoff, gbase, voff) do { _Pragma("unroll") for (int _i = 0; _i < 2; ++_i) \
        __builtin_amdgcn_global_load_lds((const unsigned*)((const char*)(gbase) + (voff)[_i]), (LAS unsigned*)(lds + (bufoff) + ldsw + _i * 8192), 16, 0, 0); } while (0)
    unsigned coff[2], noff[2], cbyte[2];
    if constexpr (GATHER) {
#pragma unroll
        for (int i = 0; i < 2; ++i) { int R_, C_; stage_rc(tid * 16 + i * 8192, R_, C_); cbyte[i] = (unsigned)(C_ * 2); } }
#define PG8_GOFF(u_, o_) do { _Pragma("unroll") for (int _i = 0; _i < 2; ++_i) { int R_, C_; stage_rc(tid * 16 + _i * 8192, R_, C_); \
        o_[_i] = (unsigned)g.rowidx[(u_).pm * BM + R_] | ((unsigned)g.rowidx[(u_).pm * BM + HALF + R_] << 16); } } while (0)
#define PG8_STAGEA(bufoff, gbase, h, sel) do { if constexpr (GATHER) { _Pragma("unroll") for (int _i = 0; _i < 2; ++_i) { const unsigned pk_ = (sel) ? noff[_i] : coff[_i]; \
        __builtin_amdgcn_global_load_lds((const unsigned*)((const char*)(gbase) + (((pk_ >> (16 * (h))) & 0xffffu) * (unsigned)(g.lda * 2) + cbyte[_i])), (LAS unsigned*)(lds + (bufoff) + ldsw + _i * 8192), 16, 0, 0); } } \
        else { PG8_STAGE(bufoff, (gbase) + ((h) ? hstepA : 0), voffA); } } while (0)
#define PG8_LDA(dst, b, h) do { _Pragma("unroll") for (int m = 0; m < 4; ++m) _Pragma("unroll") for (int k = 0; k < 2; ++k) dst[m][k] = *(const LAS h16x8*)(lds + PG8_SA(b, h) + aoff + m * 2048 + k * 1024); } while (0)
#define PG8_LDB(dst, b, h) do { _Pragma("unroll") for (int n = 0; n < 2; ++n) _Pragma("unroll") for (int k = 0; k < 2; ++k) dst[n][k] = *(const LAS h16x8*)(lds + PG8_SB(b, h) + boff + n * 2048 + k * 1024); } while (0)
#define PG8_MMA(ai, bj, At, Bt) do { __builtin_amdgcn_s_setprio(1); _Pragma("unroll") for (int m = 0; m < 4; ++m) _Pragma("unroll") for (int n = 0; n < 2; ++n) _Pragma("unroll") for (int k = 0; k < 2; ++k) \
        acc[ai][bj][m][n] = __builtin_amdgcn_mfma_f32_16x16x32_f16(Bt[n][k], At[m][k], acc[ai][bj][m][n], 0, 0, 0); __builtin_amdgcn_s_setprio(0); } while (0)
#define PG8_WAIT_V(n) asm volatile("s_waitcnt vmcnt(" #n ")" ::: "memory")
#define PG8_WAIT_L(n) asm volatile("s_waitcnt lgkmcnt(" #n ")" ::: "memory")
#define PG8_BAR __builtin_amdgcn_s_barrier()
#define PG8_SCHED __builtin_amdgcn_sched_barrier(0)
    Unit cur, nxt; int ui = 0;
    if (!S.next(0, cur)) return;
    f32x4 acc[2][2][4][2];
#pragma unroll
    for (int a = 0; a < 2; ++a)
#pragma unroll
        for (int b = 0; b < 2; ++b)
#pragma unroll
            for (int m = 0; m < 4; ++m)
#pragma unroll
                for (int n = 0; n < 2; ++n) acc[a][b][m][n] = (f32x4){0.f, 0.f, 0.f, 0.f};
    h16x8 At[4][2], B0[2][2], B1[2][2];
    const char* cA = (const char*)g.A + (GATHER ? (size_t)0 : (size_t)cur.pm * tstepA); const char* cB = (const char*)g.Bt + (size_t)cur.pn * tstepB;
    if constexpr (GATHER) { PG8_GOFF(cur, coff); noff[0] = coff[0]; noff[1] = coff[1]; }
    PG8_STAGE(PG8_SB(0, 0), cB, voffB); PG8_STAGE(PG8_SB(0, 1), cB + hstepB, voffB); PG8_STAGEA(PG8_SA(0, 0), cA, 0, false); PG8_STAGEA(PG8_SA(0, 1), cA, 1, false);
    if (wr == 1) PG8_BAR;
    PG8_WAIT_V(2); PG8_BAR;
    PG8_STAGE(PG8_SB(1, 0), cB + kstep, voffB); PG8_STAGEA(PG8_SA(1, 0), cA + kstep, 0, false); PG8_STAGE(PG8_SB(1, 1), cB + hstepB + kstep, voffB);
    PG8_WAIT_V(6); PG8_BAR;
    for (;;) {
        const bool has_next = S.next(ui + 1, nxt);
        const char* nA = (has_next && !GATHER) ? (const char*)g.A + (size_t)nxt.pm * tstepA : cA; const char* nB = has_next ? (const char*)g.Bt + (size_t)nxt.pn * tstepB : cB;
        if constexpr (GATHER) { if (has_next) PG8_GOFF(nxt, noff); }
        for (int t = 0; t < nt; t += 2) {
            const bool last = (t == nt - 2);
            const char* a1 = cA + (size_t)(t + 1) * kstep;
            const char* a2 = last ? nA : cA + (size_t)(t + 2) * kstep; const char* b2 = last ? nB : cB + (size_t)(t + 2) * kstep;
            const char* a3 = a2 + kstep; const char* b3 = b2 + kstep;
            PG8_LDB(B0, 0, 0); PG8_LDB(B1, 0, 1); PG8_SCHED; PG8_LDA(At, 0, 0); PG8_STAGEA(PG8_SA(1, 1), a1, 1, false);
            PG8_WAIT_V(8); PG8_WAIT_L(0); PG8_BAR; PG8_MMA(0, 0, At, B0); PG8_MMA(0, 1, At, B1); PG8_BAR; PG8_SCHED;
            PG8_LDA(At, 0, 1); PG8_STAGE(PG8_SB(0, 0), b2, voffB); PG8_STAGE(PG8_SB(0, 1), b2 + hstepB, voffB); PG8_STAGEA(PG8_SA(0, 0), a2, 0, last);
            PG8_WAIT_V(8); PG8_WAIT_L(0); PG8_BAR; PG8_MMA(1, 0, At, B0); PG8_MMA(1, 1, At, B1); PG8_BAR; PG8_SCHED;
            PG8_LDB(B0, 1, 0); PG8_LDB(B1, 1, 1); PG8_SCHED; PG8_LDA(At, 1, 0); PG8_STAGEA(PG8_SA(0, 1), a2, 1, last);
            PG8_WAIT_V(8); PG8_WAIT_L(0); PG8_BAR; PG8_MMA(0, 0, At, B0); PG8_MMA(0, 1, At, B1); PG8_BAR; PG8_SCHED;
            PG8_LDA(At, 1, 1); PG8_STAGE(PG8_SB(1, 0), b3, voffB); PG8_STAGE(PG8_SB(1, 1), b3 + hstepB, voffB); PG8_STAGEA(PG8_SA(1, 0), a3, 0, last);
            PG8_WAIT_V(8); PG8_WAIT_L(0); PG8_BAR; PG8_MMA(1, 0, At, B0); PG8_MMA(1, 1, At, B1); PG8_BAR; PG8_SCHED;
        }
        if (wr == 0) PG8_BAR;
        E(acc, cur, wr, wc, fr, fq);
        if (!has_next) break;
#pragma unroll
        for (int a = 0; a < 2; ++a)
#pragma unroll
            for (int b = 0; b < 2; ++b)
#pragma unroll
                for (int m = 0; m < 4; ++m)
#pragma unroll
                    for (int n = 0; n < 2; ++n) acc[a][b][m][n] = (f32x4){0.f, 0.f, 0.f, 0.f};
        cur = nxt; cA = nA; cB = nB; ++ui;
        if constexpr (GATHER) { coff[0] = noff[0]; coff[1] = noff[1]; }
        if (wr == 1) PG8_BAR;
    }
    PG8_WAIT_V(0);
    PG8_BAR;
#undef PG8_SA
#undef PG8_SB
#undef PG8_STAGE
#undef PG8_LDA
#undef PG8_GOFF
#undef PG8_STAGEA
#undef PG8_LDB
#undef PG8_MMA
#undef PG8_WAIT_V
#undef PG8_WAIT_L
#undef PG8_BAR
#undef PG8_SCHED
}
}

struct Frame {
    LAS unsigned char* lds;
    GAS unsigned char* ws;
    volatile LAS unsigned long long* ptab;
    float* out;
    int tid, lane, wave, G, vcu;
};
#define WSP(T, off) ((T*)(GAS T*)(F.ws + (off)))
__device__ __forceinline__ const float* inptr(const Frame& F, int i) {
    const unsigned long long v = F.ptab[i];
    const unsigned lo = __builtin_amdgcn_readfirstlane((unsigned)v), hi = __builtin_amdgcn_readfirstlane((unsigned)(v >> 32));
    return (const float*)(GAS const float*)(((unsigned long long)hi << 32) | lo);
}
__device__ __forceinline__ void launder(Frame& F) {
    int wv = F.wave; asm volatile("" : "+s"(wv)); F.wave = wv;
    unsigned z = 0u; asm volatile("" : "+v"(z));
    int t = wv * 64 + (int)__builtin_amdgcn_mbcnt_hi(~0u, __builtin_amdgcn_mbcnt_lo(~0u, z)); F.tid = t; F.lane = t & 63;
    const unsigned long long w = (unsigned long long)F.ws; unsigned wl = __builtin_amdgcn_readfirstlane((unsigned)w), wh = __builtin_amdgcn_readfirstlane((unsigned)(w >> 32));
    asm volatile("" : "+s"(wl), "+s"(wh)); F.ws = (GAS unsigned char*)(((unsigned long long)wh << 32) | wl);
    unsigned lo = __builtin_amdgcn_readfirstlane((unsigned)(uintptr_t)F.lds); asm volatile("" : "+s"(lo)); F.lds = (LAS unsigned char*)(uintptr_t)lo;
    int v = __builtin_amdgcn_readfirstlane(F.vcu); asm volatile("" : "+s"(v)); F.vcu = v;
}

struct TrItem { const float* W; const float* g; h16* Wt; int ldw, sc, nvalid, ldt, d0, k0, vw; float mul; };
__device__ __forceinline__ void tr_describe(const Frame& F, GAS unsigned char* wsb_, int l, int it, TrItem& d) {
    unsigned char* wsb = (unsigned char*)wsb_;
    int r = it; d.g = nullptr; d.mul = 1.f; d.nvalid = 64; d.vw = 4; d.ldt = DM; d.ldw = DM;
    if (r < 896) { const int d0 = 64 * (r % 56); d.W = inptr(F, 3) + (size_t)l * DM * DIN; d.ldw = DIN; d.g = inptr(F, 2) + l * DM; d.Wt = (h16*)(wsb + WS_WIN); d.d0 = d0; d.k0 = 64 * (r / 56); d.vw = 2;
        if (d0 < 2816) d.sc = d0; else if (d0 < 3328) d.sc = d0 + 6; else if (d0 == 3328) { d.sc = 2816; d.nvalid = 6; } else { d.sc = 0; d.nvalid = 0; } return; } r -= 896;
    if (r < 256) { d.W = inptr(F, 4) + (size_t)l * DM * DM; d.Wt = (h16*)(wsb + WS_WOUT); d.d0 = d.sc = 64 * (r % 16); d.k0 = 64 * (r / 16); return; } r -= 256;
    if (r < 256) { d.W = inptr(F, 20) + (size_t)l * DM * DM; d.g = inptr(F, 18) + l * DM; d.mul = 0.0625f; d.Wt = (h16*)(wsb + WS_WQ); d.d0 = d.sc = 64 * (r % 16); d.k0 = 64 * (r / 16); return; } r -= 256;
    if (r < 512) { d.W = inptr(F, 21) + (size_t)l * DM * 2048; d.ldw = 2048; d.g = inptr(F, 19) + l * DM; d.Wt = (h16*)(wsb + WS_WKV); d.d0 = d.sc = 64 * (r % 32); d.k0 = 64 * (r / 32); return; } r -= 512;
    if (r < 256) { d.W = inptr(F, 22) + (size_t)l * DM * DM; d.Wt = (h16*)(wsb + WS_WO); d.d0 = d.sc = 64 * (r % 16); d.k0 = 64 * (r / 16); return; } r -= 256;
    if (r < 8192) { const int e = r / 256, q = r % 256, d0 = 64 * (q % 16), grp = d0 >> 8, rr = d0 & 255;
        d.W = (rr < 128 ? inptr(F, 28) : inptr(F, 29)) + (size_t)(l * 32 + e) * DM * 512; d.ldw = 512; d.sc = grp * 128 + (rr & 127); d.g = inptr(F, 23) + l * DM; d.Wt = (h16*)(wsb + WS_W13) + (size_t)e * DM * DM; d.d0 = d0; d.k0 = 64 * (q / 16); return; } r -= 8192;
    if (r < 4096) { const int e = r / 128, q = r % 128; d.W = inptr(F, 30) + (size_t)(l * 32 + e) * 512 * DM; d.Wt = (h16*)(wsb + WS_W2) + (size_t)e * DM * 512; d.ldt = 512; d.d0 = d.sc = 64 * (q % 16); d.k0 = 64 * (q / 16); return; } r -= 4096;
    { const int blk = r & 3, gate = (r >> 2) & 1, dir = r >> 3; d.W = (gate ? inptr(F, 16) : inptr(F, 14)) + (size_t)((l * 2 + dir) * 4 + blk) * 4096; d.ldw = 64; d.Wt = (h16*)(wsb + WS_LRUW) + (size_t)((dir * 2 + gate) * 4 + blk) * 4096; d.ldt = 64; d.d0 = d.sc = 0; d.k0 = 0; }
}
__device__ __forceinline__ void tr_load(const TrItem& d, int lane, f32x4 (&v)[16]) {
    if (d.vw == 4) { const int col = 4 * (lane & 15); const float* src = d.W + (size_t)(d.k0 + (lane >> 4)) * d.ldw + d.sc + col; const bool ok = col < d.nvalid;
#pragma unroll
        for (int i = 0; i < 16; ++i) v[i] = ok ? __builtin_nontemporal_load((const f32x4*)(src + (size_t)(4 * i) * d.ldw)) : (f32x4){0.f, 0.f, 0.f, 0.f};
    } else { const int col = 2 * (lane & 31); const float* src = d.W + (size_t)(d.k0 + (lane >> 5)) * d.ldw + d.sc + col; const bool ok = col < d.nvalid;
#pragma unroll
        for (int i = 0; i < 16; ++i) { const f32x2 a = ok ? __builtin_nontemporal_load((const f32x2*)(src + (size_t)(4 * i) * d.ldw)) : (f32x2){0.f, 0.f}, c = ok ? __builtin_nontemporal_load((const f32x2*)(src + (size_t)(4 * i + 2) * d.ldw)) : (f32x2){0.f, 0.f}; v[i] = (f32x4){a[0], a[1], c[0], c[1]}; } }
}
__device__ __forceinline__ void tr_to_lds(const TrItem& d, int lane, const f32x4 (&v)[16], LAS float* scr) {
    if (d.vw == 4) { LAS float* q = scr + (lane >> 4) * 65 + 4 * (lane & 15);
#pragma unroll
        for (int i = 0; i < 16; ++i) { q[(4 * i) * 65 + 0] = v[i][0]; q[(4 * i) * 65 + 1] = v[i][1]; q[(4 * i) * 65 + 2] = v[i][2]; q[(4 * i) * 65 + 3] = v[i][3]; }
    } else { LAS float* q = scr + (lane >> 5) * 65 + 2 * (lane & 31);
#pragma unroll
        for (int i = 0; i < 16; ++i) { q[(4 * i) * 65 + 0] = v[i][0]; q[(4 * i) * 65 + 1] = v[i][1]; q[(4 * i + 2) * 65 + 0] = v[i][2]; q[(4 * i + 2) * 65 + 1] = v[i][3]; } }
}
__device__ __forceinline__ void tr_from_lds(const TrItem& d, int lane, LAS const float* scr) {
    const int c = lane & 7; float gs[8];
    if (d.g) { const f32x4 g0 = *(const f32x4*)(d.g + d.k0 + 8 * c), g1 = *(const f32x4*)(d.g + d.k0 + 8 * c + 4);
        gs[0] = g0[0] * d.mul; gs[1] = g0[1] * d.mul; gs[2] = g0[2] * d.mul; gs[3] = g0[3] * d.mul; gs[4] = g1[0] * d.mul; gs[5] = g1[1] * d.mul; gs[6] = g1[2] * d.mul; gs[7] = g1[3] * d.mul;
    } else {
#pragma unroll
        for (int e = 0; e < 8; ++e) gs[e] = d.mul; }
#pragma unroll
    for (int j = 0; j < 8; ++j) { const int nn = (lane >> 3) + 8 * j; LAS const float* q = scr + (8 * c) * 65 + nn; h16x8 o;
#pragma unroll
        for (int e = 0; e < 8; ++e) o[e] = (h16)(q[e * 65] * gs[e]);
        *(h16x8*)(d.Wt + (size_t)(d.d0 + nn) * d.ldt + d.k0 + 8 * c) = o; }
}
__device__ __forceinline__ void phase_convert(const Frame& F, const Prm& p, int l) {
    LAS float* scr = (LAS float*)(F.lds + F.wave * 16640);
    const int gw = F.vcu * 8 + F.wave, NGW = F.G * 8;
    constexpr int NITEMS = 896 + 256 + 256 + 512 + 256 + 8192 + 4096 + 16;
    { TrItem cur, nxt; f32x4 v[16]; int it = gw;
        if (it < NITEMS) { tr_describe(F, F.ws, l, it, cur); tr_load(cur, F.lane, v); }
        while (it < NITEMS) { const int itn = it + NGW; const bool hn = itn < NITEMS;
            tr_to_lds(cur, F.lane, v, scr);
            if (hn) { tr_describe(F, F.ws, l, itn, nxt); tr_load(nxt, F.lane, v); }
            asm volatile("s_waitcnt lgkmcnt(0)" ::: "memory");
            tr_from_lds(cur, F.lane, scr);
            asm volatile("s_waitcnt lgkmcnt(0)" ::: "memory");
            cur = nxt; it = itn; } }
    {
        const float* gm = inptr(F, 23) + l * DM; const float* wg = inptr(F, 24) + (size_t)l * DM * 4; const float* we = inptr(F, 26) + (size_t)l * DM * 32; h16* rwg = WSP(h16, OFF_RWG);
        for (int i = F.vcu * 512 + F.tid; i < 36 * DM; i += 256 * 512) { const int k = i / 36, j = i % 36; const float wv = gm[k] * (j < 4 ? wg[k * 4 + j] : we[k * 32 + (j - 4)]) * 1024.0f;
            const h16 hi = (h16)wv; rwg[(size_t)j * 1032 + k] = hi; rwg[(size_t)(36 + j) * 1032 + k] = (h16)(wv - (float)hi); } }
    if (l == 0) {
        for (int m = gw; m < NT + NTM; m += NGW) {
            const bool isx = m < NT; const int row = isx ? m : m - NT;
            const float* src = (isx ? inptr(F, 0) : inptr(F, 1)) + (size_t)row * DM; h16* dst = (isx ? WSP(h16, WS_HB) : WSP(h16, WS_MEM16)) + (size_t)row * DM;
            float* sq = (isx ? WSP(float, WS_SSQ) : WSP(float, OFF_MSSQ)) + (size_t)row * 16;
            float s = 0.f;
#pragma unroll
            for (int j = 0; j < 4; ++j) { const f32x4 v = __builtin_nontemporal_load((const f32x4*)(src + 4 * F.lane + 256 * j)); *(h16x4*)(dst + 4 * F.lane + 256 * j) = pack4(v); s += (v[0] * v[0] + v[1] * v[1]) + (v[2] * v[2] + v[3] * v[3]); }
            s = wave_sum(s);
            if (F.lane < 16) sq[F.lane] = (F.lane == 0) ? s : 0.f;
            if (isx && F.lane == 0) WSP(float, OFF_RSTDT)[row] = 1.0f / sqrtf(s * (1.0f / DM) + EPS);
        }
        float* rope = WSP(float, OFF_ROPE);
        for (int i = F.vcu * 512 + F.tid; i < SEQ * 32; i += F.G * 512) {
            const int pos = i >> 5, fi = i & 31; double th = 1.0;
            for (int k = 0; k < fi; ++k) th *= 0.74989420933245582730;
            const double rev = (double)pos * th * 0.15915494309189533577;
            const double fr = rev - floor(rev);
            const double r = (fr - 0.5) * 6.28318530717958647692;
            const double r2 = r * r; double sn = 1.0, cs = 1.0;
            for (int k = 14; k >= 1; --k) { sn = 1.0 - r2 / (double)((2 * k) * (2 * k + 1)) * sn; cs = 1.0 - r2 / (double)((2 * k - 1) * (2 * k)) * cs; }
            sn *= r;
            rope[pos * 64 + fi] = (float)(-cs); rope[pos * 64 + 32 + fi] = (float)(-sn);
        }
    }
}

template <bool SILU>
__device__ __forceinline__ void conv_rows8(const h16* projcol, long tbase, int n, int r0, const float* cw, int cdim, const float* cb, h16x8 (&out)[8]) {
    f32x4 w[4][2];
#pragma unroll
    for (int k = 0; k < 4; ++k) { w[k][0] = *(const f32x4*)(cw + k * cdim); w[k][1] = *(const f32x4*)(cw + k * cdim + 4); }
    const f32x4 b0 = *(const f32x4*)cb, b1 = *(const f32x4*)(cb + 4);
    h16x8 x[11];
#pragma unroll
    for (int i = 0; i < 11; ++i) { const int pos = n * 128 + r0 - 2 + i; h16x8 z;
#pragma unroll
        for (int e = 0; e < 8; ++e) z[e] = (h16)0.f;
        x[i] = (pos >= 0 && pos < SEQ) ? NTL(h16x8, projcol + (size_t)(tbase + r0 - 2 + i) * NPJ) : z; }
#pragma unroll
    for (int r = 0; r < 8; ++r) {
#pragma unroll
        for (int e = 0; e < 8; ++e) { float a = e < 4 ? b0[e] : b1[e - 4];
#pragma unroll
            for (int k = 0; k < 4; ++k) a += (e < 4 ? w[k][0][e] : w[k][1][e - 4]) * (float)x[r + k][e];
            out[r][e] = (h16)(SILU ? siluf_(a) : a); } }
}
__device__ __forceinline__ h16x8 col_of(const h16x8 (&o)[8], int e) { h16x8 c; c[0] = o[0][e]; c[1] = o[1][e]; c[2] = o[2][e]; c[3] = o[3][e]; c[4] = o[4][e]; c[5] = o[5][e]; c[6] = o[6][e]; c[7] = o[7][e]; return c; }

__device__ __forceinline__ void ret_scan_unit(const Frame& F, int u) {
    const int h = u % 6, b = (u / 6) % NB, dir = u / (6 * NB);
    const float gC = exp2f(128.0f * log1pf(-exp2f(-5.0f - (float)h)) * 1.4426950408889634f);
    h16* base = WSP(h16, OFF_RST) + ((size_t)((dir * NB + b) * NCH) * 6 + h) * 4096 + F.tid * 8;
    float acc[8];
#pragma unroll
    for (int e = 0; e < 8; ++e) acc[e] = 0.f;
#pragma unroll 1
    for (int half = 0; half < 2; ++half) { h16x8 sv[8];
#pragma unroll
        for (int i = 0; i < 8; ++i) { const int ii = 8 * half + i, n = dir == 0 ? ii : NCH - 1 - ii; sv[i] = *(const h16x8*)(base + (size_t)n * 6 * 4096); }
#pragma unroll
        for (int i = 0; i < 8; ++i) { const int ii = 8 * half + i, n = dir == 0 ? ii : NCH - 1 - ii; h16x8 o;
#pragma unroll
            for (int e = 0; e < 8; ++e) { o[e] = (h16)acc[e]; acc[e] = acc[e] * gC + (float)sv[i][e]; }
            *(h16x8*)(base + (size_t)n * 6 * 4096) = o; } }
}
#define RET_BAR() do { asm volatile("s_waitcnt lgkmcnt(0)" ::: "memory"); __builtin_amdgcn_s_barrier(); asm volatile("" ::: "memory"); } while (0)
__device__ __forceinline__ void ret_states_block(const Frame& F, int bn) {
    const int n = bn % NCH, b = bn / NCH; const long t0 = (long)b * SEQ + n * 128;
    const int r = F.tid >> 2, c = F.tid & 3;
    const h16* rowp = WSP(const h16, WS_R1) + (size_t)(t0 + r) * NPJ; const float* cs = WSP(const float, OFF_ROPE) + (size_t)(n * 128 + r) * 64 + 8 * c;
    const f32x4 c0 = *(const f32x4*)cs, c1 = *(const f32x4*)(cs + 4), s0 = *(const f32x4*)(cs + 32), s1 = *(const f32x4*)(cs + 36);
    const int dir = F.wave >> 2, dt = F.wave & 3, fr = F.lane & 15, fq = F.lane >> 4;
    h16x8 k1, k2, v1, v2;
#define RS_LOAD(hh) do { k1 = *(const h16x8*)(rowp + CK + (hh) * 64 + 8 * c); k2 = *(const h16x8*)(rowp + CK + (hh) * 64 + 32 + 8 * c); v1 = *(const h16x8*)(rowp + CV + (hh) * 64 + 16 * c); v2 = *(const h16x8*)(rowp + CV + (hh) * 64 + 16 * c + 8); } while (0)
    RS_LOAD(0);
#pragma unroll 1
    for (int h = 0; h < 6; ++h) {
        LAS h16* KT = (LAS h16*)(F.lds + (h & 1) * 34816); LAS h16* VT = KT + 64 * 136;
#pragma unroll
        for (int e = 0; e < 8; ++e) { const float x1 = (float)k1[e], x2 = (float)k2[e], co = e < 4 ? c0[e] : c1[e - 4], si = e < 4 ? s0[e] : s1[e - 4];
            KT[(8 * c + e) * 136 + r] = (h16)((x1 * co - x2 * si) * 0.125f); KT[(32 + 8 * c + e) * 136 + r] = (h16)((x1 * si + x2 * co) * 0.125f); }
#pragma unroll
        for (int e = 0; e < 8; ++e) { VT[(16 * c + e) * 136 + r] = v1[e]; VT[(16 * c + 8 + e) * 136 + r] = v2[e]; }
        if (h < 5) RS_LOAD(h + 1);
        RET_BAR();
        const float l2g = log1pf(-exp2f(-5.0f - (float)h)) * 1.4426950408889634f;
        h16x8 xw[4];
#pragma unroll
        for (int ks = 0; ks < 4; ++ks) { const h16x8 f = ldsfrag(KT + (16 * dt + fr) * 136 + 32 * ks + 8 * fq); h16x8 wv;
#pragma unroll
            for (int jj = 0; jj < 8; ++jj) { const int j = 32 * ks + 8 * fq + jj; wv[jj] = (h16)exp2f(l2g * (float)(dir == 0 ? 127 - j : j)); }
            xw[ks] = f * wv; }
        h16* rst = WSP(h16, OFF_RST) + ((size_t)((dir * NB + b) * NCH + n) * 6 + h) * 4096;
#pragma unroll
        for (int et = 0; et < 4; ++et) { f32x4 acc = {0.f, 0.f, 0.f, 0.f};
#pragma unroll
            for (int ks = 0; ks < 4; ++ks) acc = MFMA16(xw[ks], ldsfrag(VT + (16 * et + fr) * 136 + 32 * ks + 8 * fq), acc);
            *(h16x4*)(rst + (16 * et + fr) * 64 + 16 * dt + 4 * fq) = pack4(acc); }
    }
#undef RS_LOAD
    __syncthreads();
}
__device__ __forceinline__ void ret_out_block(const Frame& F, int bn) {
    const int n = bn % NCH, b = bn / NCH; const long t0 = (long)b * SEQ + n * 128;
    const int r = F.tid >> 2, c = F.tid & 3, rp = kperm32(r), er = F.tid >> 3, d0 = (F.tid & 7) * 8;
    const h16* rowp = WSP(const h16, WS_R1) + (size_t)(t0 + r) * NPJ; const float* cs = WSP(const float, OFF_ROPE) + (size_t)(n * 128 + r) * 64 + 8 * c;
    const f32x4 c0 = *(const f32x4*)cs, c1 = *(const f32x4*)(cs + 4), s0 = *(const f32x4*)(cs + 32), s1 = *(const f32x4*)(cs + 36);
    const int w = F.wave, fr = F.lane & 15, fq = F.lane >> 4, il = 16 * w + fr;
    const h16* grow = WSP(const h16, WS_R1) + (size_t)(t0 + il) * NPJ + CG + 4 * fq; h16* orow = WSP(h16, OFF_OMIX) + (size_t)(t0 + il) * DM + 4 * fq;
    const h16* st0 = WSP(const h16, OFF_RST) + ((size_t)((0 * NB + b) * NCH + n) * 6) * 4096 + F.tid * 8; const h16* st1 = WSP(const h16, OFF_RST) + ((size_t)((1 * NB + b) * NCH + n) * 6) * 4096 + F.tid * 8;
    h16x8 q1, q2, k1, k2, v1, v2, sf, sb; h16x4 gn[4];
#define RO_LOAD(hh) do { q1 = NTL(h16x8, rowp + CQ + (hh) * 64 + 8 * c); q2 = NTL(h16x8, rowp + CQ + (hh) * 64 + 32 + 8 * c); k1 = NTL(h16x8, rowp + CK + (hh) * 64 + 8 * c); k2 = NTL(h16x8, rowp + CK + (hh) * 64 + 32 + 8 * c); \
        v1 = NTL(h16x8, rowp + CV + (hh) * 64 + 16 * c); v2 = NTL(h16x8, rowp + CV + (hh) * 64 + 16 * c + 8); sf = NTL(h16x8, st0 + (hh) * 4096); sb = NTL(h16x8, st1 + (hh) * 4096); \
        _Pragma("unroll") for (int et_ = 0; et_ < 4; ++et_) gn[et_] = NTL(h16x4, grow + (hh) * 64 + 16 * et_); } while (0)
    RO_LOAD(0);
#pragma unroll 1
    for (int h = 0; h < 6; ++h) {
        LAS h16* Qt = (LAS h16*)(F.lds + (h & 1) * 72704); LAS h16* Kt = Qt + 128 * 72; LAS h16* VT = Kt + 128 * 72; LAS h16* Ff = VT + 64 * 136; LAS h16* Fb = Ff + 64 * 72;
        { h16x8 qa, qb, ka, kb;
#pragma unroll
            for (int e = 0; e < 8; ++e) { const float co = e < 4 ? c0[e] : c1[e - 4], si = e < 4 ? s0[e] : s1[e - 4];
                float x1 = (float)q1[e], x2 = (float)q2[e]; qa[e] = (h16)(x1 * co - x2 * si); qb[e] = (h16)(x1 * si + x2 * co);
                x1 = (float)k1[e]; x2 = (float)k2[e]; ka[e] = (h16)((x1 * co - x2 * si) * 0.125f); kb[e] = (h16)((x1 * si + x2 * co) * 0.125f); }
            *(LAS h16x8*)(Qt + r * 72 + 8 * c) = qa; *(LAS h16x8*)(Qt + r * 72 + 32 + 8 * c) = qb;
            *(LAS h16x8*)(Kt + r * 72 + 8 * c) = ka; *(LAS h16x8*)(Kt + r * 72 + 32 + 8 * c) = kb; }
#pragma unroll
        for (int e = 0; e < 8; ++e) { VT[(16 * c + e) * 136 + rp] = v1[e]; VT[(16 * c + 8 + e) * 136 + rp] = v2[e]; }
        *(LAS h16x8*)(Ff + er * 72 + d0) = sf; *(LAS h16x8*)(Fb + er * 72 + d0) = sb;
        h16x4 gc[4];
#pragma unroll
        for (int et = 0; et < 4; ++et) gc[et] = gn[et];
        if (h < 5) RO_LOAD(h + 1);
        RET_BAR();
        const float l2g = log1pf(-exp2f(-5.0f - (float)h)) * 1.4426950408889634f;
        h16x8 qf[2];
#pragma unroll
        for (int ks = 0; ks < 2; ++ks) qf[ks] = ldsfrag(Qt + il * 72 + 32 * ks + 8 * fq);
        f32x4 s[8];
#pragma unroll
        for (int jt = 0; jt < 8; ++jt) { f32x4 a = {0.f, 0.f, 0.f, 0.f};
#pragma unroll
            for (int ks = 0; ks < 2; ++ks) a = MFMA16(ldsfrag(Kt + (16 * jt + fr) * 72 + 32 * ks + 8 * fq), qf[ks], a);
#pragma unroll
            for (int q = 0; q < 4; ++q) { const int j = 16 * jt + 4 * fq + q; const int dd = il > j ? il - j : j - il; a[q] *= exp2f(l2g * (float)dd); }
            PINV(a); s[jt] = a; }
        f32x4 o[4];
#pragma unroll
        for (int et = 0; et < 4; ++et) o[et] = (f32x4){0.f, 0.f, 0.f, 0.f};
#pragma unroll
        for (int kp = 0; kp < 4; ++kp) { const h16x8 pf = pack8(s[2 * kp], s[2 * kp + 1]);
#pragma unroll
            for (int et = 0; et < 4; ++et) o[et] = MFMA16(ldsfrag(VT + (16 * et + fr) * 136 + 32 * kp + 8 * fq), pf, o[et]); }
        const float gf = exp2f(l2g * (float)(il + 1)), gb = exp2f(l2g * (float)(128 - il));
#pragma unroll
        for (int ks = 0; ks < 2; ++ks) { const h16x8 qff = scalefrag(qf[ks], gf), qfb = scalefrag(qf[ks], gb);
#pragma unroll
            for (int et = 0; et < 4; ++et) { o[et] = MFMA16(ldsfrag(Ff + (16 * et + fr) * 72 + 32 * ks + 8 * fq), qff, o[et]); o[et] = MFMA16(ldsfrag(Fb + (16 * et + fr) * 72 + 32 * ks + 8 * fq), qfb, o[et]); } }
        float ss = 0.f;
#pragma unroll
        for (int et = 0; et < 4; ++et) ss += (o[et][0] * o[et][0] + o[et][1] * o[et][1]) + (o[et][2] * o[et][2] + o[et][3] * o[et][3]);
        ss += __shfl_xor(ss, 16); ss += __shfl_xor(ss, 32);
        const float rs = 1.0f / sqrtf(ss * (1.0f / 64.0f) + EPS);
#pragma unroll
        for (int et = 0; et < 4; ++et) { f32x4 q;
#pragma unroll
            for (int e = 0; e < 4; ++e) q[e] = o[et][e] * rs * siluf_((float)gc[et][e]);
            *(h16x4*)(orow + h * 64 + 16 * et) = pack4(q); }
    }
#undef RO_LOAD
    __syncthreads();
}
#undef RET_BAR

__device__ __forceinline__ void ssd_stage_dt(const Frame& F, const Prm& p, int l, int g, long t0, LAS float* LA, LAS float* DTS) {
    if (F.tid < 128) { const h16* dp = WSP(const h16, WS_R1) + (size_t)(t0 + F.tid) * NPJ + CDT + g * 3;
#pragma unroll
        for (int r = 0; r < 3; ++r) { const float raw = (float)dp[r];
#pragma unroll
            for (int dir = 0; dir < 2; ++dir) { const float dt = softplusf_(raw + inptr(F, 7)[(l * 2 + dir) * 6 + g * 3 + r]); const float la = -dt * __expf(inptr(F, 8)[(l * 2 + dir) * 6 + g * 3 + r]);
                DTS[(dir * 3 + r) * 128 + F.tid] = dt; LA[(dir * 3 + r) * 128 + F.tid] = la; } } }
}
__device__ __forceinline__ void ssd_cumsum(const Frame& F, LAS const float* LAq, float& v0, float& v1, float& c0, float& c1, float& tot) {
    v0 = LAq[2 * F.lane]; v1 = LAq[2 * F.lane + 1]; float s = v0 + v1;
#pragma unroll
    for (int o = 1; o < 64; o <<= 1) { const float t = __shfl_up(s, o); if (F.lane >= o) s += t; }
    c1 = s; c0 = s - v1; tot = __shfl(s, 63);
}
__device__ __forceinline__ void ssd_states_unit(const Frame& F, const Prm& p, int l, int u) {
    const int g = u & 1, bn = u >> 1, n = bn % NCH, b = bn / NCH; const long t0 = (long)b * SEQ + n * 128;
    const h16* proj = WSP(const h16, WS_R1);
    LAS h16* XT = (LAS h16*)F.lds; LAS h16* BT = XT + 3 * 64 * 136; LAS float* LA = (LAS float*)(BT + 128 * 136); LAS float* DTS = LA + 6 * 128; LAS float* WW = DTS + 6 * 128;
    ssd_stage_dt(F, p, l, g, t0, LA, DTS);
    const float* cw = inptr(F, 5) + (size_t)l * 4 * 896; const float* cb = inptr(F, 6) + (size_t)l * 896;
    h16* bcn = ((h16*)((unsigned char*)F.out + OUT_BCN));
    for (int task = F.tid; task < 56 * 16; task += 512) { const int cg = task % 56, r0 = (task / 56) * 8; h16x8 o[8];
        if (cg < 24) { conv_rows8<true>(proj + CXS + g * 192 + 8 * cg, t0, n, r0, cw + g * 192 + 8 * cg, 896, cb + g * 192 + 8 * cg, o);
            LAS h16* d = XT + (cg >> 3) * 64 * 136 + ((cg & 7) * 8) * 136 + r0;
#pragma unroll
            for (int e = 0; e < 8; ++e) *(LAS h16x8*)(d + e * 136) = col_of(o, e);
        } else { const int c8 = (cg - 24) & 15; const bool isB = cg < 40; const int col = (isB ? CBM : CCM) + g * 128 + 8 * c8, ci = (isB ? 384 : 640) + g * 128 + 8 * c8;
            conv_rows8<true>(proj + col, t0, n, r0, cw + ci, 896, cb + ci, o);
#pragma unroll
            for (int r = 0; r < 8; ++r) *(h16x8*)(bcn + (size_t)(t0 + r0 + r) * 512 + (isB ? 0 : 256) + g * 128 + 8 * c8) = o[r];
            if (isB) { LAS h16* d = BT + (8 * c8) * 136 + r0;
#pragma unroll
                for (int e = 0; e < 8; ++e) *(LAS h16x8*)(d + e * 136) = col_of(o, e); } } }
    __syncthreads();
    { h16* xtg = ((h16*)((unsigned char*)F.out + OUT_XTG)) + ((size_t)(b * NCH + n) * 6 + g * 3) * 8192;
#pragma unroll
        for (int k = 0; k < 6; ++k) { const int it = F.tid + 512 * k, rr = it >> 4, c = it & 15; const h16x8 v = *(LAS const h16x8*)(XT + rr * 136 + 8 * c);
            *(h16x4*)(xtg + rr * 128 + kperm32(8 * c)) = __builtin_shufflevector(v, v, 0, 1, 2, 3); *(h16x4*)(xtg + rr * 128 + kperm32(8 * c + 4)) = __builtin_shufflevector(v, v, 4, 5, 6, 7); } }
    if (F.wave < 6) { const int q = F.wave, dir = q / 3, r = q % 3; float v0, v1, c0, c1, tot; ssd_cumsum(F, LA + q * 128, v0, v1, c0, c1, tot);
        const float d0 = DTS[q * 128 + 2 * F.lane], d1 = DTS[q * 128 + 2 * F.lane + 1];
        if (dir == 0) { WW[q * 128 + 2 * F.lane] = __expf(tot - c0) * d0 * 256.f; WW[q * 128 + 2 * F.lane + 1] = __expf(tot - c1) * d1 * 256.f; }
        else { WW[q * 128 + 2 * F.lane] = __expf(c0 - v0) * d0 * 256.f; WW[q * 128 + 2 * F.lane + 1] = __expf(c1 - v1) * d1 * 256.f; }
        if (F.lane == 0) WSP(float, OFF_SDEC)[((size_t)(b * NCH + n) * 6 + g * 3 + r) * 2 + dir] = tot; }
    __syncthreads();
    const int w = F.wave, fr = F.lane & 15, fq = F.lane >> 4;
    h16x8 xb[4];
#pragma unroll
    for (int ks = 0; ks < 4; ++ks) xb[ks] = ldsfrag(BT + (16 * w + fr) * 136 + 32 * ks + 8 * fq);
    for (int q = 0; q < 6; ++q) { const int dir = q / 3, r = q % 3;
        h16x8 wf[4];
#pragma unroll
        for (int ks = 0; ks < 4; ++ks) { const f32x4 a = *(LAS const f32x4*)(WW + q * 128 + 32 * ks + 8 * fq), c = *(LAS const f32x4*)(WW + q * 128 + 32 * ks + 8 * fq + 4); wf[ks] = pack8(a, c); }
        h16* sst = WSP(h16, OFF_SST) + ((size_t)((dir * NB + b) * NCH + n) * 6 + g * 3 + r) * 8192;
#pragma unroll
        for (int pt = 0; pt < 4; ++pt) { f32x4 acc = {0.f, 0.f, 0.f, 0.f};
#pragma unroll
            for (int ks = 0; ks < 4; ++ks) acc = MFMA16(xb[ks], ldsfrag(XT + r * 64 * 136 + (16 * pt + fr) * 136 + 32 * ks + 8 * fq) * wf[ks], acc);
            *(h16x4*)(sst + (16 * pt + fr) * 128 + 16 * w + 4 * fq) = pack4(acc * (1.0f / 256.f)); } }
    __syncthreads();
}
__device__ __forceinline__ void ssd_scan_unit(const Frame& F, int u) {
    const int hd = u % 6, b = (u / 6) % NB, dir = u / (6 * NB);
    h16* base = WSP(h16, OFF_SST) + ((size_t)((dir * NB + b) * NCH) * 6 + hd) * 8192 + F.tid * 16;
    const float* dbase = WSP(const float, OFF_SDEC) + ((size_t)(b * NCH) * 6 + hd) * 2 + dir;
    float acc[16];
#pragma unroll
    for (int e = 0; e < 16; ++e) acc[e] = 0.f;
#pragma unroll 1
    for (int q = 0; q < 4; ++q) { h16x8 s0[4], s1[4]; float dec[4];
#pragma unroll
        for (int i = 0; i < 4; ++i) { const int ii = 4 * q + i, n = dir == 0 ? ii : NCH - 1 - ii; s0[i] = *(const h16x8*)(base + (size_t)n * 6 * 8192); s1[i] = *(const h16x8*)(base + (size_t)n * 6 * 8192 + 8); dec[i] = dbase[n * 12]; }
#pragma unroll
        for (int i = 0; i < 4; ++i) { const int ii = 4 * q + i, n = dir == 0 ? ii : NCH - 1 - ii; const float dc = __expf(dec[i]); h16x8 o0, o1;
#pragma unroll
            for (int e = 0; e < 8; ++e) { o0[e] = (h16)acc[e]; o1[e] = (h16)acc[8 + e]; acc[e] = acc[e] * dc + (float)s0[i][e]; acc[8 + e] = acc[8 + e] * dc + (float)s1[i][e]; }
            *(h16x8*)(base + (size_t)n * 6 * 8192) = o0; *(h16x8*)(base + (size_t)n * 6 * 8192 + 8) = o1; } }
}
__device__ __forceinline__ void ssd_out_unit(const Frame& F, const Prm& p, int l, int u) {
    const int g = u & 1, bn = u >> 1, n = bn % NCH, b = bn / NCH; const long t0 = (long)b * SEQ + n * 128;
    const h16* proj = WSP(const h16, WS_R1);
    LAS h16* XT = (LAS h16*)F.lds; LAS h16* Bt = XT + 3 * 64 * 136; LAS h16* Ct = Bt + 128 * 136; LAS float* LA = (LAS float*)(Ct + 128 * 136); LAS float* DTS = LA + 6 * 128;
    LAS float* CE = DTS + 6 * 128;
    LAS float* TOTB = CE + 6 * 128;
    ssd_stage_dt(F, p, l, g, t0, LA, DTS);
    const float* cw = inptr(F, 5) + (size_t)l * 4 * 896; const float* cb = inptr(F, 6) + (size_t)l * 896;
    { const h16* xtg = ((const h16*)((const unsigned char*)F.out + OUT_XTG)) + ((size_t)(b * NCH + n) * 6 + g * 3) * 8192; const h16* bcn = ((const h16*)((const unsigned char*)F.out + OUT_BCN)) + (size_t)t0 * 512 + g * 128;
        h16x8 xv[6], bv[8];
#pragma unroll
        for (int k = 0; k < 6; ++k) { const int it = F.tid + 512 * k; xv[k] = NTL(h16x8, xtg + (it >> 4) * 128 + 8 * (it & 15)); }
#pragma unroll
        for (int k = 0; k < 8; ++k) { const int it = F.tid + 512 * k, row = it >> 5, c = it & 31; bv[k] = NTL(h16x8, bcn + (size_t)row * 512 + (c < 16 ? 8 * c : 256 + 8 * (c - 16))); }
#pragma unroll
        for (int k = 0; k < 6; ++k) { const int it = F.tid + 512 * k; *(LAS h16x8*)(XT + (it >> 4) * 136 + 8 * (it & 15)) = xv[k]; }
#pragma unroll
        for (int k = 0; k < 8; ++k) { const int it = F.tid + 512 * k, row = it >> 5, c = it & 31; *(LAS h16x8*)((c < 16 ? Bt : Ct) + row * 136 + 8 * (c & 15)) = bv[k]; }
        PIN(); }
    __syncthreads();
    if (F.wave < 6) { const int q = F.wave; float v0, v1, c0, c1, tot; ssd_cumsum(F, LA + q * 128, v0, v1, c0, c1, tot);
        if (q < 3) { CE[q * 128 + 2 * F.lane] = c0; CE[q * 128 + 2 * F.lane + 1] = c1; }
        else { CE[q * 128 + 2 * F.lane] = c0 - v0; CE[q * 128 + 2 * F.lane + 1] = c1 - v1; if (F.lane == 0) TOTB[q - 3] = tot; } }
    __syncthreads();
    const int w = F.wave, fr = F.lane & 15, fq = F.lane >> 4, il = 16 * w + fr;
    h16x8 cf[4];
#pragma unroll
    for (int ks = 0; ks < 4; ++ks) cf[ks] = ldsfrag(Ct + il * 136 + 32 * ks + 8 * fq);
    f32x4 gT[8];
#pragma unroll
    for (int jt = 0; jt < 8; ++jt) { f32x4 a = {0.f, 0.f, 0.f, 0.f};
#pragma unroll
        for (int ks = 0; ks < 4; ++ks) a = MFMA16(ldsfrag(Bt + (16 * jt + fr) * 136 + 32 * ks + 8 * fq), cf[ks], a);
        PINV(a); gT[jt] = a; }
    const float* dsk = inptr(F, 9) + l * 6 + g * 3;
    h16* orow = WSP(h16, OFF_OMIX) + (size_t)(t0 + il) * DM + 384 + g * 192;
    float ss = 0.f;
    { h16x8 h0[4];
#pragma unroll
        for (int k = 0; k < 4; ++k) { const int it = F.tid + 512 * k, dir = it >> 10, e = it & 1023; h0[k] = NTL(h16x8, WSP(const h16, OFF_SST) + ((size_t)((dir * NB + b) * NCH + n) * 6 + g * 3) * 8192 + e * 8); }
        __syncthreads();
#pragma unroll
        for (int k = 0; k < 4; ++k) { const int it = F.tid + 512 * k, dir = it >> 10, e = it & 1023; *(LAS h16x8*)(Bt + dir * 64 * 136 + (e >> 4) * 136 + 8 * (e & 15)) = h0[k]; }
        __syncthreads(); }
#pragma unroll 1
    for (int r = 0; r < 3; ++r) {
        f32x4 y[1][4];
        const int hd = g * 3 + r;
        const float cfi = CE[r * 128 + il], ebi = CE[(3 + r) * 128 + il], totb = TOTB[r];
#pragma unroll
        for (int pt = 0; pt < 4; ++pt) y[0][pt] = (f32x4){0.f, 0.f, 0.f, 0.f};
        LAS const h16* HL = (r & 1) ? Ct : Bt;
        h16x8 hreg[4];
        if (r < 2) {
#pragma unroll
            for (int k = 0; k < 4; ++k) { const int it = F.tid + 512 * k, dir = it >> 10, e = it & 1023; hreg[k] = NTL(h16x8, WSP(const h16, OFF_SST) + ((size_t)((dir * NB + b) * NCH + n) * 6 + hd + 1) * 8192 + e * 8); } }
#pragma unroll
        for (int kp = 0; kp < 4; ++kp) { f32x4 pv[2];
#pragma unroll
            for (int jh = 0; jh < 2; ++jh) { const int jt = 2 * kp + jh, j0 = 16 * jt + 4 * fq;
                const f32x4 cfj = *(LAS const f32x4*)(CE + r * 128 + j0), ebj = *(LAS const f32x4*)(CE + (3 + r) * 128 + j0), dfj = *(LAS const f32x4*)(DTS + r * 128 + j0), dbj = *(LAS const f32x4*)(DTS + (3 + r) * 128 + j0);
#pragma unroll
                for (int e = 0; e < 4; ++e) { const int j = j0 + e; const float val = (il >= j) ? __expf(cfi - cfj[e]) * dfj[e] : __expf(ebj[e] - ebi) * dbj[e]; pv[jh][e] = gT[jt][e] * val * 256.f; }
                PINV(pv[jh]); }
            const h16x8 pf = pack8(pv[0], pv[1]);
#pragma unroll
            for (int pt = 0; pt < 4; ++pt) y[0][pt] = MFMA16(ldsfrag(XT + r * 64 * 136 + (16 * pt + fr) * 136 + 32 * kp + 8 * fq), pf, y[0][pt]);
            PINV(y[0][0]); PINV(y[0][1]); PINV(y[0][2]); PINV(y[0][3]); }
        const float ef = __expf(cfi) * 256.f, eb = __expf(totb - ebi) * 256.f;
#pragma unroll
        for (int ks = 0; ks < 4; ++ks) { const h16x8 cff = scalefrag(cf[ks], ef), cfb = scalefrag(cf[ks], eb);
#pragma unroll
            for (int pt = 0; pt < 4; ++pt) { y[0][pt] = MFMA16(ldsfrag(HL + (16 * pt + fr) * 136 + 32 * ks + 8 * fq), cff, y[0][pt]); y[0][pt] = MFMA16(ldsfrag(HL + 64 * 136 + (16 * pt + fr) * 136 + 32 * ks + 8 * fq), cfb, y[0][pt]); }
            PINV(y[0][0]); PINV(y[0][1]); PINV(y[0][2]); PINV(y[0][3]); }
        if (r < 2) { LAS h16* HN = (r & 1) ? Bt : Ct;
#pragma unroll
            for (int k = 0; k < 4; ++k) { const int it = F.tid + 512 * k, dir = it >> 10, e = it & 1023; *(LAS h16x8*)(HN + dir * 64 * 136 + (e >> 4) * 136 + 8 * (e & 15)) = hreg[k]; } }
        const float dk = dsk[r]; const h16* zrow = proj + (size_t)(t0 + il) * NPJ + CZ + hd * 64;
#pragma unroll
        for (int pt = 0; pt < 4; ++pt) { const h16x4 zv = NTL(h16x4, zrow + 16 * pt + 4 * fq);
#pragma unroll
            for (int e = 0; e < 4; ++e) { const float xv = (float)XT[r * 64 * 136 + (16 * pt + 4 * fq + e) * 136 + kperm32(il)]; y[0][pt][e] = (y[0][pt][e] * (1.0f / 256.f) + dk * xv) * siluf_((float)zv[e]); }
            const h16x4 yh = pack4(y[0][pt]); *(h16x4*)(orow + r * 64 + 16 * pt + 4 * fq) = yh;
#pragma unroll
            for (int e = 0; e < 4; ++e) { const float q = (float)yh[e]; ss += q * q; } }
        __syncthreads();
    }
    ss += __shfl_xor(ss, 16); ss += __shfl_xor(ss, 32);
    const float rs = 1.0f / sqrtf(ss * (1.0f / 192.0f) + EPS);
    const float* nw = inptr(F, 10) + l * 384 + g * 192;
    asm volatile("s_waitcnt vmcnt(0)" ::: "memory");
#pragma unroll 1
    for (int r = 0; r < 3; ++r)
#pragma unroll
        for (int pt = 0; pt < 4; ++pt) { const f32x4 wv = *(const f32x4*)(nw + r * 64 + 16 * pt + 4 * fq); h16* op = orow + r * 64 + 16 * pt + 4 * fq; const h16x4 yh = *(const h16x4*)op; f32x4 yv;
#pragma unroll
            for (int e = 0; e < 4; ++e) yv[e] = (float)yh[e] * rs * wv[e];
            *(h16x4*)op = pack4(yv); }
    __syncthreads();
}

__device__ __forceinline__ void lru_unit(const Frame& F, const Prm& p, int l, int u) {
    const int n = u % NCH, b = u / NCH; const long t0 = (long)b * SEQ + n * 128;
    const h16* proj = WSP(const h16, WS_R1);
    LAS h16* XC = (LAS h16*)F.lds;
    const float* cw = inptr(F, 11) + (size_t)l * 4 * 256; const float* cb = inptr(F, 12) + (size_t)l * 256;
    { const int cg = F.tid & 31, r0 = (F.tid >> 5) * 8; h16x8 o[8];
        conv_rows8<false>(proj + CXR + 8 * cg, t0, n, r0, cw + 8 * cg, 256, cb + 8 * cg, o);
#pragma unroll
        for (int r = 0; r < 8; ++r) *(LAS h16x8*)(XC + (r0 + r) * 264 + 8 * cg) = o[r]; }
    __syncthreads();
    const int blk = F.wave & 3, jh = F.wave >> 2, fr = F.lane & 15, fq = F.lane >> 4;
    h16* lau = (h16*)((unsigned char*)F.out + OUT_LAU) + (size_t)(b * NCH + n) * 2 * 128 * 256 * 2;
    h16x8 wa[2][2][2], wx[2][2][2]; float ba[2][2], bx[2][2], sp[2][2], car[2][2], atot[2][2];
#pragma unroll
    for (int dir = 0; dir < 2; ++dir)
#pragma unroll
        for (int jt = 0; jt < 2; ++jt) { const int ch = blk * 64 + 32 * jh + 16 * jt + fr;
#pragma unroll
            for (int ks = 0; ks < 2; ++ks) { wa[dir][jt][ks] = *(const h16x8*)(WSP(const h16, WS_LRUW) + (size_t)((dir * 2 + 0) * 4 + blk) * 4096 + (32 * jh + 16 * jt + fr) * 64 + 32 * ks + 8 * fq);
                wx[dir][jt][ks] = *(const h16x8*)(WSP(const h16, WS_LRUW) + (size_t)((dir * 2 + 1) * 4 + blk) * 4096 + (32 * jh + 16 * jt + fr) * 64 + 32 * ks + 8 * fq); }
            ba[dir][jt] = inptr(F, 15)[(l * 2 + dir) * 256 + ch]; bx[dir][jt] = inptr(F, 17)[(l * 2 + dir) * 256 + ch]; sp[dir][jt] = softplusf_(-inptr(F, 13)[(l * 2 + dir) * 256 + ch]);
            car[dir][jt] = 0.f; atot[dir][jt] = 1.f; }
#pragma unroll 1
    for (int ti = 0; ti < 8; ++ti) {
#pragma unroll
        for (int dir = 0; dir < 2; ++dir) { const int tt = dir == 0 ? ti : 7 - ti;
            h16x8 xf[2];
#pragma unroll
            for (int ks = 0; ks < 2; ++ks) xf[ks] = ldsfrag(XC + (16 * tt + fr) * 264 + blk * 64 + 32 * ks + 8 * fq);
#pragma unroll
            for (int jt = 0; jt < 2; ++jt) { const int ch = blk * 64 + 32 * jh + 16 * jt + fr;
                f32x4 ra = {0.f, 0.f, 0.f, 0.f}, ia = {0.f, 0.f, 0.f, 0.f};
#pragma unroll
                for (int ks = 0; ks < 2; ++ks) { ra = MFMA16(xf[ks], wa[dir][jt][ks], ra); ia = MFMA16(xf[ks], wx[dir][jt][ks], ia); }
                float A = 1.f, H = 0.f;
#pragma unroll
                for (int ri = 0; ri < 4; ++ri) { const int rg = dir == 0 ? ri : 3 - ri;
                    const float e1 = 1.0f + __expf(-(ra[rg] + ba[dir][jt])), e2 = 1.0f + __expf(-(ia[rg] + bx[dir][jt])); const float inv = __builtin_amdgcn_rcpf(e1 * e2);
                    const float rgate = inv * e2, ig = inv * e1;
                    const float la = -8.0f * rgate * sp[dir][jt]; const float a = __expf(la); const float y = 2.0f * la;
                    const float om = y > -0.1f ? -y * (1.0f + y * (0.5f + y * (1.0f / 6.0f))) : 1.0f - a * a;
                    const float mult = __builtin_amdgcn_sqrtf(om);
                    const float xv = (float)XC[(16 * tt + 4 * fq + rg) * 264 + ch]; const float uu = mult * ig * xv;
                    H = a * H + uu; A *= a;
                    { h16x2 pk; pk[0] = (h16)la; pk[1] = (h16)uu; *(h16x2*)(lau + ((size_t)dir * 128 + 16 * tt + 4 * fq + rg) * 256 * 2 + 2 * ch) = pk; } }
                float Ag[4], Hg[4];
#pragma unroll
                for (int gq = 0; gq < 4; ++gq) { Ag[gq] = __shfl(A, fr + 16 * gq); Hg[gq] = __shfl(H, fr + 16 * gq); }
                float cnew = car[dir][jt], at = 1.f;
#pragma unroll
                for (int gi = 0; gi < 4; ++gi) { const int gq = dir == 0 ? gi : 3 - gi;
                    cnew = Ag[gq] * cnew + Hg[gq]; at *= Ag[gq]; }
                car[dir][jt] = cnew; atot[dir][jt] *= at;
            } } }
    if (fq == 0) {
#pragma unroll
        for (int dir = 0; dir < 2; ++dir)
#pragma unroll
            for (int jt = 0; jt < 2; ++jt) { const int ch = blk * 64 + 32 * jh + 16 * jt + fr; *(f32x2*)(WSP(float, OFF_LSUM) + (((size_t)(b * NCH + n) * 2 + dir) * 256 + ch) * 2) = (f32x2){atot[dir][jt], car[dir][jt]}; } }
    __syncthreads();
}
__device__ __forceinline__ void lru_out_unit(const Frame& F, int u) {
    const int n = u % NCH, b = u / NCH; const long t0 = (long)b * SEQ + n * 128;
    const h16* proj = WSP(const h16, WS_R1);
    LAS h16* HT = (LAS h16*)F.lds;
    const int blk = F.wave & 3, jh = F.wave >> 2, fr = F.lane & 15, fq = F.lane >> 4;
    const h16* lau = (const h16*)((const unsigned char*)F.out + OUT_LAU) + (size_t)(b * NCH + n) * 2 * 128 * 256 * 2;
    float car[2][2];
#pragma unroll
    for (int dir = 0; dir < 2; ++dir)
#pragma unroll
        for (int jt = 0; jt < 2; ++jt) car[dir][jt] = WSP(const float, OFF_LCAR)[((size_t)(b * NCH + n) * 2 + dir) * 256 + blk * 64 + 32 * jh + 16 * jt + fr];
#pragma unroll 1
    for (int ti = 0; ti < 8; ++ti) {
#pragma unroll
        for (int dir = 0; dir < 2; ++dir) { const int tt = dir == 0 ? ti : 7 - ti;
            h16x2 pk[2][4]; h16 gtv[2][4], ov[2][4];
#pragma unroll
            for (int jt = 0; jt < 2; ++jt)
#pragma unroll
                for (int rg = 0; rg < 4; ++rg) { const int tl = 16 * tt + 4 * fq + rg, ch = blk * 64 + 32 * jh + 16 * jt + fr;
                    pk[jt][rg] = NTL(h16x2, lau + ((size_t)dir * 128 + tl) * 256 * 2 + 2 * ch); gtv[jt][rg] = NTL(h16, proj + (size_t)(t0 + tl) * NPJ + CGT + ch); ov[jt][rg] = ti >= 4 ? HT[tl * 264 + ch] : (h16)0.f; }
#pragma unroll
            for (int jt = 0; jt < 2; ++jt) { const int ch = blk * 64 + 32 * jh + 16 * jt + fr;
                float av[4], uv[4]; float A = 1.f, H = 0.f;
#pragma unroll
                for (int ri = 0; ri < 4; ++ri) { const int rg = dir == 0 ? ri : 3 - ri; const float a = __expf((float)pk[jt][rg][0]); const float uu = (float)pk[jt][rg][1]; av[rg] = a; uv[rg] = uu; H = a * H + uu; A *= a; }
                float Ag[4], Hg[4];
#pragma unroll
                for (int gq = 0; gq < 4; ++gq) { Ag[gq] = __shfl(A, fr + 16 * gq); Hg[gq] = __shfl(H, fr + 16 * gq); }
                float hin = car[dir][jt], cnew = car[dir][jt];
#pragma unroll
                for (int gi = 0; gi < 4; ++gi) { const int gq = dir == 0 ? gi : 3 - gi; const bool before = dir == 0 ? (gq < fq) : (gq > fq);
                    if (before) hin = Ag[gq] * hin + Hg[gq];
                    cnew = Ag[gq] * cnew + Hg[gq]; }
                car[dir][jt] = cnew;
                float hh = hin;
#pragma unroll
                for (int ri = 0; ri < 4; ++ri) { const int rg = dir == 0 ? ri : 3 - ri; hh = av[rg] * hh + uv[rg];
                    HT[(16 * tt + 4 * fq + rg) * 264 + ch] = (h16)((float)ov[jt][rg] + hh * gelu_tanh_((float)gtv[jt][rg])); } } } }
    __syncthreads();
#pragma unroll
    for (int k = 0; k < 8; ++k) { const int it = F.tid + 512 * k, row = it >> 5, c8 = it & 31; *(h16x8*)(WSP(h16, OFF_OMIX) + (size_t)(t0 + row) * DM + 768 + 8 * c8) = *(LAS const h16x8*)(HT + row * 264 + 8 * c8); }
    __syncthreads();
}
__device__ __forceinline__ void lru_scan(const Frame& F) {
    const int gi = (int)blockIdx.x * 512 + F.tid; if (gi >= NB * 2 * 256) return;
    const int ch = gi & 255, dir = (gi >> 8) & 1, b = gi >> 9; float H = 0.f;
    for (int i = 0; i < NCH; ++i) { const int n = dir == 0 ? i : NCH - 1 - i; const size_t idx = ((size_t)(b * NCH + n) * 2 + dir) * 256 + ch;
        const f32x2 s = *(const f32x2*)(WSP(const float, OFF_LSUM) + idx * 2); WSP(float, OFF_LCAR)[idx] = H; H = s[0] * H + s[1]; }
}

__device__ __forceinline__ void attn_phase(const Frame& F) {
    constexpr int NU = NB * 4 * 8;
    LAS unsigned char* B0 = F.lds; LAS unsigned char* B1 = F.lds + 67584;
    int u = F.vcu; if (u >= NU) return;
    int lanel = F.lane; asm volatile("" : "+v"(lanel)); int fr = lanel & 15, fq = lanel >> 4;
    const int w = F.wave;
    h16x8 qf[2][8];
#define AT_DMA(buf, src, rowstride) do { asm volatile("" : "+v"(lanel)); if (lanel < 32) { _Pragma("unroll") for (int i_ = 0; i_ < 16; ++i_) \
        __builtin_amdgcn_global_load_lds((const unsigned*)((src) + (size_t)(16 * w + i_) * (rowstride) + 8 * lanel), (LAS unsigned*)((buf) + (16 * w + i_) * 528), 16, 0, 0); } } while (0)
#define AT_FRAG(buf, row, chunk) (*(LAS const h16x8*)((buf) + (row) * 528 + (chunk) * 16))
#define AT_WAITBAR() do { asm volatile("s_waitcnt vmcnt(0) lgkmcnt(0)" ::: "memory"); __builtin_amdgcn_s_barrier(); asm volatile("" ::: "memory"); } while (0)
#define AT_LOADQ(uu) do { _Pragma("unroll") for (int a_ = 0; a_ < 2; ++a_) { const long t_ = (long)((uu) >> 5) * SEQ + ((uu) & 7) * 256 + 32 * w + 16 * a_ + fr; const h16* q_ = WSP(const h16, OFF_QCA) + (size_t)t_ * DM + (((uu) >> 3) & 3) * 256; \
        _Pragma("unroll") for (int ks_ = 0; ks_ < 8; ++ks_) qf[a_][ks_] = NTL(h16x8, q_ + 32 * ks_ + 8 * fq); } } while (0)
    { const int b = u >> 5, hd = (u >> 3) & 3; AT_DMA(B0, WSP(const h16, OFF_KB) + (size_t)(b * 256) * DM + hd * 256, DM); }
    for (; u < NU; u += F.G) {
        const int qb = u & 7, hd = (u >> 3) & 3, b = u >> 5; const int un = u + F.G; const bool has_next = un < NU;
        asm volatile("" : "+v"(lanel)); fr = lanel & 15; fq = lanel >> 4;
        const h16* kb = WSP(const h16, OFF_KB) + (size_t)(b * 256) * DM + hd * 256; const h16* vt = WSP(const h16, OFF_VT) + (size_t)(b * 4 + hd) * 65536;
        AT_LOADQ(u);
        h16x8 pf[2][8]; float mq[2][4], Mr[2] = {-3.0e38f, -3.0e38f}, Lr[2] = {0.f, 0.f};
#pragma unroll
        for (int h = 0; h < 2; ++h) {
            AT_WAITBAR();
            if (h == 0) AT_DMA(B1, kb + (size_t)128 * DM, DM); else AT_DMA(B0, vt, 256);
            LAS const unsigned char* KB_ = h == 0 ? B0 : B1;
#pragma unroll
            for (int jh = 0; jh < 2; ++jh) { const int qd = 2 * h + jh; f32x4 s[2][4]; h16x8 kf[2][4];
#pragma unroll
                for (int j4 = 0; j4 < 4; ++j4) { s[0][j4] = (f32x4){0.f, 0.f, 0.f, 0.f}; s[1][j4] = (f32x4){0.f, 0.f, 0.f, 0.f}; kf[0][j4] = AT_FRAG(KB_, 16 * (4 * jh + j4) + fr, fq); }
#pragma unroll
                for (int ks = 0; ks < 8; ++ks) {
                    if (ks < 7) {
#pragma unroll
                        for (int j4 = 0; j4 < 4; ++j4) kf[(ks + 1) & 1][j4] = AT_FRAG(KB_, 16 * (4 * jh + j4) + fr, 4 * (ks + 1) + fq); }
                    PIN();
#pragma unroll
                    for (int j4 = 0; j4 < 4; ++j4) { s[0][j4] = MFMA16(kf[ks & 1][j4], qf[0][ks], s[0][j4]); s[1][j4] = MFMA16(kf[ks & 1][j4], qf[1][ks], s[1][j4]); }
                    PINV(s[0][0]); PINV(s[1][3]); }
#pragma unroll
                for (int a = 0; a < 2; ++a) { float mx = fmaxf(fmaxf(s[a][0][0], s[a][0][1]), fmaxf(s[a][0][2], s[a][0][3]));
#pragma unroll
                    for (int jt = 1; jt < 4; ++jt) mx = fmaxf(mx, fmaxf(fmaxf(s[a][jt][0], s[a][jt][1]), fmaxf(s[a][jt][2], s[a][jt][3])));
                    mx = fmaxf(mx, __shfl_xor(mx, 16)); mx = fmaxf(mx, __shfl_xor(mx, 32));
                    float sum = 0.f;
#pragma unroll
                    for (int jt = 0; jt < 4; ++jt)
#pragma unroll
                        for (int e = 0; e < 4; ++e) { const float pe = __expf(s[a][jt][e] - mx); s[a][jt][e] = pe; sum += pe; }
                    sum += __shfl_xor(sum, 16); sum += __shfl_xor(sum, 32);
                    mq[a][qd] = mx; { const float Mn = fmaxf(Mr[a], mx); Lr[a] = Lr[a] * __expf(Mr[a] - Mn) + sum * __expf(mx - Mn); Mr[a] = Mn; }
                    pf[a][2 * qd] = pack8(s[a][0], s[a][1]); pf[a][2 * qd + 1] = pack8(s[a][2], s[a][3]); } }
        }
#pragma unroll
        for (int a = 0; a < 2; ++a) { const float inv = 1.0f / Lr[a];
#pragma unroll
            for (int q = 0; q < 4; ++q) { const float cq = __expf(mq[a][q] - Mr[a]) * inv; pf[a][2 * q] = scalefrag(pf[a][2 * q], cq); pf[a][2 * q + 1] = scalefrag(pf[a][2 * q + 1], cq); } }
#pragma unroll
        for (int d = 0; d < 2; ++d) {
            AT_WAITBAR();
            if (d == 0) AT_DMA(B1, vt + (size_t)128 * 256, 256);
            else if (has_next) AT_DMA(B0, WSP(const h16, OFF_KB) + (size_t)((un >> 5) * 256) * DM + ((un >> 3) & 3) * 256, DM);
            LAS const unsigned char* VB_ = d == 0 ? B0 : B1;
#pragma unroll
            for (int eh = 0; eh < 2; ++eh) { f32x4 o[2][4]; h16x8 vf[2][4];
#pragma unroll
                for (int e4 = 0; e4 < 4; ++e4) { o[0][e4] = (f32x4){0.f, 0.f, 0.f, 0.f}; o[1][e4] = (f32x4){0.f, 0.f, 0.f, 0.f}; vf[0][e4] = AT_FRAG(VB_, 16 * (4 * eh + e4) + fr, fq); }
#pragma unroll
                for (int kp = 0; kp < 8; ++kp) {
                    if (kp < 7) {
#pragma unroll
                        for (int e4 = 0; e4 < 4; ++e4) vf[(kp + 1) & 1][e4] = AT_FRAG(VB_, 16 * (4 * eh + e4) + fr, 4 * (kp + 1) + fq); }
                    PIN();
#pragma unroll
                    for (int e4 = 0; e4 < 4; ++e4) { o[0][e4] = MFMA16(vf[kp & 1][e4], pf[0][kp], o[0][e4]); o[1][e4] = MFMA16(vf[kp & 1][e4], pf[1][kp], o[1][e4]); }
                    PINV(o[0][0]); PINV(o[1][3]); }
#pragma unroll
                for (int a = 0; a < 2; ++a) { const long t = (long)b * SEQ + qb * 256 + 32 * w + 16 * a + fr; h16* orow = WSP(h16, OFF_OATT) + (size_t)t * DM + hd * 256 + 128 * d + 64 * eh;
#pragma unroll
                    for (int e4 = 0; e4 < 4; ++e4) *(h16x4*)(orow + 16 * e4 + 4 * fq) = pack4(o[a][e4]); } }
        }
    }
    asm volatile("s_waitcnt vmcnt(0) lgkmcnt(0)" ::: "memory");
    __syncthreads();
#undef AT_DMA
#undef AT_FRAG
#undef AT_WAITBAR
#undef AT_LOADQ
}

__device__ __forceinline__ void phase_router(const Frame& F, const Prm& p, int l) {
    LAS h16* RW = (LAS h16*)F.lds;
    { const h16* rwg = WSP(const h16, OFF_RWG);
        for (int i = F.tid; i < 72 * 1032 / 8; i += 512) *(LAS h16x8*)(RW + 8 * i) = *(const h16x8*)(rwg + 8 * i); }
    LAS unsigned* hist = (LAS unsigned*)(F.lds + 72 * 1032 * 2);
    if (F.tid < 32) hist[F.tid] = 0u;
    if (F.G == 256) { for (int i = (int)blockIdx.x * 512 + F.tid; i < MAXSLOT; i += 256 * 512) WSP(int, OFF_STOK)[i] = 0; }
    else if (blockIdx.x == 0) { for (int i = F.tid; i < MAXSLOT; i += 512) WSP(int, OFF_STOK)[i] = 0; }
    __syncthreads();
    const int gw = F.vcu * 8 + F.wave, NGW = F.G * 8, fr = F.lane & 15, fq = F.lane >> 4;
    for (int tg = gw; tg < NT / 16; tg += NGW) {
        const int tok = tg * 16 + fr;
        const h16* hp = WSP(const h16, WS_HB) + (size_t)tok * DM + 8 * fq;
        f32x4 acc[3]; LAS const h16* wrow[3];
#pragma unroll
        for (int mt = 0; mt < 3; ++mt) { acc[mt] = (f32x4){0.f, 0.f, 0.f, 0.f}; const int j = (16 * mt + fr) < 36 ? (16 * mt + fr) : 35; wrow[mt] = RW + j * 1032 + 8 * fq; }
#pragma unroll
        for (int half = 0; half < 2; ++half) { h16x8 hf[16];
#pragma unroll
            for (int q = 0; q < 16; ++q) hf[q] = *(const h16x8*)(hp + 32 * (16 * half + q));
#pragma unroll
            for (int q = 0; q < 16; ++q) { const int ks = 16 * half + q;
#pragma unroll
                for (int mt = 0; mt < 3; ++mt) { acc[mt] = MFMA16(ldsfrag(wrow[mt] + 32 * ks), hf[q], acc[mt]); acc[mt] = MFMA16(ldsfrag(wrow[mt] + 36 * 1032 + 32 * ks), hf[q], acc[mt]); } } }
#pragma unroll
        for (int mt = 0; mt < 3; ++mt) acc[mt] *= (1.0f / 1024.0f);
        const float rs = row_rstd(WSP(const float, WS_SSQ) + (size_t)tok * 16);
        float gl[4];
#pragma unroll
        for (int r = 0; r < 4; ++r) gl[r] = __shfl(acc[0][r], fr) * rs + inptr(F, 25)[l * 4 + r];
        int gi = 0; float gmx = gl[0];
#pragma unroll
        for (int j = 1; j < 4; ++j) if (gl[j] > gmx) { gmx = gl[j]; gi = j; }
        float gsum = 0.f;
#pragma unroll
        for (int j = 0; j < 4; ++j) gsum += __expf(gl[j] - gmx);
        const float gp = 1.0f / gsum;
        const int src1 = fr + 16 * (1 + 2 * (gi & 1)), src2 = fr + 16 * (2 - 2 * (gi & 1)), mt1 = gi >> 1, mt2 = (gi + 1) >> 1;
        float el[8];
#pragma unroll
        for (int k = 0; k < 4; ++k) { const float a0 = __shfl(acc[0][k], src1), a1 = __shfl(acc[1][k], src1); el[k] = (mt1 ? a1 : a0) * rs + inptr(F, 27)[l * 32 + gi * 8 + k];
            const float b0 = __shfl(acc[0][k], src2), b1 = __shfl(acc[1][k], src2), b2 = __shfl(acc[2][k], src2); el[4 + k] = (mt2 == 0 ? b0 : (mt2 == 1 ? b1 : b2)) * rs + inptr(F, 27)[l * 32 + gi * 8 + 4 + k]; }
        int e1 = 0; float m1 = el[0];
#pragma unroll
        for (int j = 1; j < 8; ++j) if (el[j] > m1) { m1 = el[j]; e1 = j; }
        int e2 = -1; float m2 = -3.0e38f;
#pragma unroll
        for (int j = 0; j < 8; ++j) if (j != e1 && el[j] > m2) { m2 = el[j]; e2 = j; }
        const float r2 = __expf(m2 - m1); const float g1 = gp / (1.0f + r2), g2 = gp * r2 / (1.0f + r2);
        if (fq == 0) { const int x1 = gi * 8 + e1, x2 = gi * 8 + e2;
            *(int2*)(WSP(int, OFF_EID) + (size_t)tok * 2) = make_int2(x1, x2); *(f32x2*)(WSP(float, OFF_GATE) + (size_t)tok * 2) = (f32x2){g1, g2};
            WSP(float, OFF_RSTDT)[tok] = rs; __hip_atomic_fetch_add(&hist[x1], 1u, __ATOMIC_RELAXED, __HIP_MEMORY_SCOPE_WORKGROUP); __hip_atomic_fetch_add(&hist[x2], 1u, __ATOMIC_RELAXED, __HIP_MEMORY_SCOPE_WORKGROUP); }
    }
    __syncthreads();
    if (F.tid < 32 && hist[F.tid]) atomicAdd(WSP(unsigned, WS_CTL) + CW_COUNTS + l * 64 + F.tid, hist[F.tid]);
    __syncthreads();
}
__device__ __forceinline__ void phase_dispatch(const Frame& F, int l) {
    LAS int* cnt = (LAS int*)F.lds; LAS int* base = cnt + 32; LAS int* pstart = base + 32; LAS int* slots = pstart + 40;
    unsigned* ctl = WSP(unsigned, WS_CTL);
    for (int blk = F.vcu; blk < NT / 128; blk += F.G) {
        __syncthreads();
        if (F.tid < 32) cnt[F.tid] = 0;
        if (F.tid == 32) { int acc = 0; for (int e = 0; e < 32; ++e) { pstart[e] = acc; acc += (int)((ctl[CW_COUNTS + l * 64 + e] + 255u) & ~255u); } pstart[32] = acc; }
        __syncthreads();
        int e = 0, rank = 0, tok = 0;
        if (F.tid < 256) { tok = blk * 128 + (F.tid >> 1); e = WSP(const int, OFF_EID)[(size_t)tok * 2 + (F.tid & 1)]; rank = __hip_atomic_fetch_add(&cnt[e], 1, __ATOMIC_RELAXED, __HIP_MEMORY_SCOPE_WORKGROUP); }
        __syncthreads();
        if (F.tid < 32) base[F.tid] = cnt[F.tid] ? (int)atomicAdd(&ctl[CW_CURSOR + l * 64 + F.tid], (unsigned)cnt[F.tid]) : 0;
        __syncthreads();
        if (F.tid < 256) { const int slot = pstart[e] + base[e] + rank; slots[F.tid] = slot; WSP(int, OFF_TSLOT)[(size_t)tok * 2 + (F.tid & 1)] = slot; WSP(float, OFF_SRSTD)[slot] = WSP(const float, OFF_RSTDT)[tok]; WSP(int, OFF_STOK)[slot] = tok; }
        __syncthreads();
        if (blk == 0 && F.tid == 0) { const int ntl = pstart[32] >> 8; ctl[CW_NTILES + l] = (unsigned)ntl; int* te = WSP(int, OFF_TILEE);
            for (int e2 = 0; e2 < 32; ++e2) for (int tl = pstart[e2] >> 8; tl < (pstart[e2 + 1] >> 8); ++tl) te[tl] = e2; }
    }
    __syncthreads();
}
__device__ __forceinline__ void phase_combine(const Frame& F, const Prm& p, int l) {
    const int gw = F.vcu * 8 + F.wave, NGW = F.G * 8;
    const bool last = (l == NLAYER - 1);
    for (int tk0 = gw * 4; tk0 < NT; tk0 += NGW * 4) {
        int2 sl[4]; f32x2 gt[4];
#pragma unroll
        for (int q = 0; q < 4; ++q) { sl[q] = *(const int2*)(WSP(const int, OFF_TSLOT) + (size_t)(tk0 + q) * 2); gt[q] = *(const f32x2*)(WSP(const float, OFF_GATE) + (size_t)(tk0 + q) * 2); }
        f32x4 v[4][4]; h16x4 ya[4][4], yb[4][4];
#pragma unroll
        for (int q = 0; q < 4; ++q) { const h16* hrow = WSP(const h16, WS_HB) + (size_t)(tk0 + q) * DM; const h16* y0 = WSP(const h16, OFF_YP) + (size_t)sl[q].x * DM; const h16* y1 = WSP(const h16, OFF_YP) + (size_t)sl[q].y * DM;
#pragma unroll
            for (int j = 0; j < 4; ++j) { const int c = 4 * F.lane + 256 * j; const h16x4 hv = *(const h16x4*)(hrow + c); v[q][j] = (f32x4){(float)hv[0], (float)hv[1], (float)hv[2], (float)hv[3]}; ya[q][j] = __builtin_nontemporal_load((const h16x4*)(y0 + c)); yb[q][j] = __builtin_nontemporal_load((const h16x4*)(y1 + c)); } }
#pragma unroll
        for (int q = 0; q < 4; ++q) { float s = 0.f;
#pragma unroll
            for (int j = 0; j < 4; ++j) {
#pragma unroll
                for (int e = 0; e < 4; ++e) v[q][j][e] += gt[q][0] * (float)ya[q][j][e] + gt[q][1] * (float)yb[q][j][e];
                if (!last) { const h16x4 o = pack4(v[q][j]); v[q][j] = (f32x4){(float)o[0], (float)o[1], (float)o[2], (float)o[3]}; }
                s += (v[q][j][0] * v[q][j][0] + v[q][j][1] * v[q][j][1]) + (v[q][j][2] * v[q][j][2] + v[q][j][3] * v[q][j][3]); }
            s = wave_sum(s);
            if (!last) {
#pragma unroll
                for (int j = 0; j < 4; ++j) { const int c = 4 * F.lane + 256 * j; *(h16x4*)(WSP(h16, WS_HB) + (size_t)(tk0 + q) * DM + c) = pack4(v[q][j]); }
                if (F.lane < 16) WSP(float, WS_SSQ)[(size_t)(tk0 + q) * 16 + F.lane] = (F.lane == 0) ? s : 0.f;
                if (F.lane == 0) WSP(float, OFF_RSTDT)[tk0 + q] = 1.0f / sqrtf(s * (1.0f / DM) + EPS);
            } else { const float rs = 1.0f / sqrtf(s * (1.0f / DM) + EPS); float* orow = F.out + (size_t)(tk0 + q) * DM;
#pragma unroll
                for (int j = 0; j < 4; ++j) { const int c = 4 * F.lane + 256 * j; const f32x4 gf = *(const f32x4*)(inptr(F, 31) + c); *(f32x4*)(orow + c) = v[q][j] * rs * gf; } } }
    }
}

__global__ void __launch_bounds__(512, 2) fwd(Prm p) {
    extern __shared__ __attribute__((aligned(16))) unsigned char lds_raw[];
    Frame F; F.lds = (LAS unsigned char*)lds_raw; F.ws = (GAS unsigned char*)p.ws; F.out = p.out;
    F.tid = threadIdx.x; F.lane = F.tid & 63; F.wave = __builtin_amdgcn_readfirstlane(F.tid >> 6);
    F.G = gridDim.x; { const int bx = blockIdx.x; F.vcu = (F.G % 8 == 0) ? (bx % 8) * (F.G / 8) + bx / 8 : bx; }
    volatile LAS unsigned* misc = (volatile LAS unsigned*)(F.lds + LDS_MISC);
    if (F.tid < 4) misc[F.tid] = 0u;
    F.ptab = (volatile LAS unsigned long long*)(F.lds + LDS_MISC + 64);
    if (F.tid < 32) F.ptab[F.tid] = (unsigned long long)p.in[F.tid];
    __syncthreads();
    const int lo = p.ph_lo, hi = p.ph_hi;
    XcdBarrier bar; bar.bar = WSP(unsigned, WS_CTL) + CW_BAR; bar.x = 0; bar.st = misc;
    if (hi - lo > 1) bar = xcd_barrier_post(WSP(unsigned, WS_CTL) + CW_BAR, misc);
#ifndef UMASK
#define UMASK 7
#endif
#ifndef REPMASK
#define REPMASK 0
#endif
#ifndef PHMASK
#define PHMASK 0x3fff
#endif
#define IN(k) (((PHMASK >> ((k) % NPH)) & 1) && lo <= (k) && (k) < hi && (launder(F), true))
#define REPS(k) (((REPMASK >> (k)) & 1) ? 2 : 1)
#define INR(k) (lo <= (k) && (k) < hi)
#ifndef AMPMASK
#define AMPMASK 0
#endif
    unsigned long long tprev = AMPMASK ? __builtin_amdgcn_s_memrealtime() : 0ull;
#define SEAM(k) do { if (INR(k) && INR((k) + 1)) { xcd_barrier(bar); if (AMPMASK) { const unsigned long long tn = __builtin_amdgcn_s_memrealtime(); \
        if ((AMPMASK >> ((k) % NPH)) & 1) { const unsigned long long tgt = tn + 4ull * (tn - tprev); while (__builtin_amdgcn_s_memrealtime() < tgt) __builtin_amdgcn_s_sleep(8); } \
        tprev = __builtin_amdgcn_s_memrealtime(); } } } while (0)
    for (int l = 0; l < NLAYER; ++l) {
        const int pb = l * NPH;
        if (IN(pb + 0)) for (int rep = 0; rep < REPS(0); ++rep) { phase_convert(F, p, l); } SEAM(pb + 0);
        if (REPS(20) == 2 && INR(pb + 0) && INR(pb + 1)) { for (int q = 0; q < 20; ++q) xcd_barrier(bar); }
        if (IN(pb + 1)) for (int rep = 0; rep < REPS(1); ++rep) {
            if (UMASK & 1) { pg8::Gemm g{WSP(const h16, WS_HB), WSP(const h16, WS_WIN), DM, DM, DM, nullptr}; pg8::StaticOrder S; S.init(NT, NPJ, F.G, (int)blockIdx.x);
              pg8::EpiScale16C E{WSP(h16, WS_R1), NPJ, WSP(const float, OFF_RSTDT)}; pg8::gemm_phase(F.lds, F.tid, g, S, E); }
        } SEAM(pb + 1);
        if (IN(pb + 2)) for (int rep = 0; rep < REPS(2); ++rep) {
            if (UMASK & 1) for (int r2 = 0; r2 < REPS(17); ++r2) for (int u = blockIdx.x; u < NB * NCH * 2; u += F.G) ssd_states_unit(F, p, l, u);
            launder(F);
            if (UMASK & 2) for (int r2 = 0; r2 < REPS(18); ++r2) for (int u = blockIdx.x; u < NB * NCH; u += F.G) ret_states_block(F, u);
            launder(F);
            if (UMASK & 4) for (int r2 = 0; r2 < REPS(19); ++r2) for (int u = blockIdx.x; u < NB * NCH; u += F.G) lru_unit(F, p, l, u);
        } SEAM(pb + 2);
        if (IN(pb + 3)) for (int rep = 0; rep < REPS(3); ++rep) {
            const bool split = (F.G == 256); const int GS = split ? 128 : F.G;
            if (!split || blockIdx.x < 128) {
                for (int u = blockIdx.x; u < 2 * NB * 6; u += GS) ssd_scan_unit(F, u);
                launder(F);
                for (int u = blockIdx.x; u < 2 * NB * 6; u += GS) ret_scan_unit(F, u);
                lru_scan(F); }
            launder(F);
            if (!split || blockIdx.x >= 128) {
                pg8::Gemm g{WSP(const h16, WS_MEM16), WSP(const h16, WS_WKV), DM, DM, DM, nullptr}; pg8::StaticOrder S; S.init(NTM, 2048, GS, split ? (int)blockIdx.x - 128 : (int)blockIdx.x);
                pg8::EpiKV E{WSP(h16, OFF_KB), WSP(h16, OFF_VT), WSP(const float, OFF_MSSQ)}; pg8::gemm_phase(F.lds, F.tid, g, S, E); }
        } SEAM(pb + 3);
        if (IN(pb + 4)) for (int rep = 0; rep < REPS(4); ++rep) {
            if (UMASK & 1) for (int r2 = 0; r2 < REPS(14); ++r2) for (int u = blockIdx.x; u < NB * NCH * 2; u += F.G) ssd_out_unit(F, p, l, u);
            launder(F);
            if (UMASK & 2) for (int r2 = 0; r2 < REPS(15); ++r2) for (int u = blockIdx.x; u < NB * NCH; u += F.G) ret_out_block(F, u);
            launder(F);
            if (UMASK & 4) for (int r2 = 0; r2 < REPS(16); ++r2) for (int u = blockIdx.x; u < NB * NCH; u += F.G) lru_out_unit(F, u);
        } SEAM(pb + 4);
        if (IN(pb + 5)) for (int rep = 0; rep < REPS(5); ++rep) { pg8::Gemm g{WSP(const h16, OFF_OMIX), WSP(const h16, WS_WOUT), DM, DM, DM, nullptr}; pg8::StaticOrder S; S.init(NT, DM, F.G, (int)blockIdx.x);
            pg8::EpiResid E{WSP(h16, WS_HB), WSP(float, WS_SSQ)}; pg8::gemm_phase(F.lds, F.tid, g, S, E); } SEAM(pb + 5);
        if (IN(pb + 6)) for (int rep = 0; rep < REPS(6); ++rep) { pg8::Gemm g{WSP(const h16, WS_HB), WSP(const h16, WS_WQ), DM, DM, DM, nullptr}; pg8::StaticOrder S; S.init(NT, DM, F.G, (int)blockIdx.x);
            pg8::EpiScale16 E{WSP(h16, OFF_QCA), DM, WSP(const float, WS_SSQ)}; pg8::gemm_phase(F.lds, F.tid, g, S, E); } SEAM(pb + 6);
        if (IN(pb + 7)) for (int rep = 0; rep < REPS(7); ++rep) { attn_phase(F); } SEAM(pb + 7);
        if (IN(pb + 8)) for (int rep = 0; rep < REPS(8); ++rep) { pg8::Gemm g{WSP(const h16, OFF_OATT), WSP(const h16, WS_WO), DM, DM, DM, nullptr}; pg8::StaticOrder S; S.init(NT, DM, F.G, (int)blockIdx.x);
            pg8::EpiResid E{WSP(h16, WS_HB), WSP(float, WS_SSQ)}; pg8::gemm_phase(F.lds, F.tid, g, S, E); } SEAM(pb + 8);
        if (IN(pb + 9)) for (int rep = 0; rep < REPS(9); ++rep) { phase_router(F, p, l); } SEAM(pb + 9);
        if (IN(pb + 10)) for (int rep = 0; rep < REPS(10); ++rep) { phase_dispatch(F, l); } SEAM(pb + 10);
        if (IN(pb + 11)) for (int rep = 0; rep < REPS(11); ++rep) { pg8::Gemm g{WSP(const h16, WS_HB), WSP(const h16, WS_W13), DM, DM, DM, WSP(const int, OFF_STOK)};
            pg8::GroupOrder S{WSP(const int, OFF_TILEE), __builtin_amdgcn_readfirstlane((int)WSP(const unsigned, WS_CTL)[CW_NTILES + l]), F.G, F.vcu};
            pg8::EpiGated E{WSP(h16, OFF_HP), WSP(const float, OFF_SRSTD)}; pg8::gemm_phase<pg8::EpiGated, pg8::GroupOrder, true>(F.lds, F.tid, g, S, E); } SEAM(pb + 11);
        if (IN(pb + 12)) for (int rep = 0; rep < REPS(12); ++rep) { pg8::Gemm g{WSP(const h16, OFF_HP), WSP(const h16, WS_W2), 512, 512, 512, nullptr};
            pg8::GroupOrder S{WSP(const int, OFF_TILEE), __builtin_amdgcn_readfirstlane((int)WSP(const unsigned, WS_CTL)[CW_NTILES + l]), F.G, F.vcu};
            pg8::EpiPlain16 E{WSP(h16, OFF_YP)}; pg8::gemm_phase(F.lds, F.tid, g, S, E); } SEAM(pb + 12);
        if (IN(pb + 13)) for (int rep = 0; rep < REPS(13); ++rep) { phase_combine(F, p, l); } SEAM(pb + 13);
    }
#undef IN
#undef INR
#undef SEAM
}

extern "C" void kernel_launch(void* const* d_in, const int* in_sizes, int n_in, void* d_out, int out_size, void* d_ws, size_t ws_size, hipStream_t stream) {
    static int grid = 0;
    if (grid == 0) {
        if (n_in != 32 || out_size != NT * DM || ws_size < WS_END) { fprintf(stderr, "kernel_launch: unexpected shapes / workspace (%d inputs, out %d, ws %zu < %zu)\n", n_in, out_size, ws_size, (size_t)WS_END); grid = -1; return; }
        int dev = 0, cus = 0, per_cu = 0;
        if (hipGetDevice(&dev) != hipSuccess || hipDeviceGetAttribute(&cus, hipDeviceAttributeMultiprocessorCount, dev) != hipSuccess) { grid = -1; return; }
        if (hipFuncSetAttribute((const void*)fwd, hipFuncAttributeMaxDynamicSharedMemorySize, LDS_BYTES) != hipSuccess) { fprintf(stderr, "kernel_launch: hipFuncSetAttribute failed\n"); grid = -1; return; }
        if (hipOccupancyMaxActiveBlocksPerMultiprocessor(&per_cu, (const void*)fwd, 512, LDS_BYTES) != hipSuccess || per_cu < 1) { fprintf(stderr, "kernel_launch: occupancy query says %d\n", per_cu); }
        (void)hipGetLastError();
        grid = cus;
    }
    if (grid < 0) return;
    (void)hipMemsetAsync((char*)d_ws + WS_CTL, 0, CTL_ZERO_BYTES, stream);
    Prm p{};
    for (int i = 0; i < 32; ++i) p.in[i] = (const float*)d_in[i];
    p.out = (float*)d_out; p.ws = (unsigned char*)d_ws;
#if defined(PROBE_PHASE)
    p.ph_lo = 0; p.ph_hi = PROBE_PHASE + 1; hipLaunchKernelGGL(fwd, dim3(grid), dim3(512), LDS_BYTES, stream, p);
    (void)hipMemsetAsync((char*)d_ws + WS_CTL + CW_BAR * 4, 0, XCD_BAR_WORDS * 4, stream);
    p.ph_lo = PROBE_PHASE; p.ph_hi = PROBE_PHASE + 1; hipLaunchKernelGGL(fwd, dim3(grid), dim3(512), LDS_BYTES, stream, p);
    p.ph_lo = PROBE_PHASE + 1; p.ph_hi = NPHASES; hipLaunchKernelGGL(fwd, dim3(grid), dim3(512), LDS_BYTES, stream, p);
#elif MK_SINGLE
    p.ph_lo = 0; p.ph_hi = NPHASES;
    hipLaunchKernelGGL(fwd, dim3(grid), dim3(512), LDS_BYTES, stream, p);
#else
    for (int ph = 0; ph < NPHASES; ++ph) { p.ph_lo = ph; p.ph_hi = ph + 1; hipLaunchKernelGGL(fwd, dim3(grid), dim3(512), LDS_BYTES, stream, p); }
#endif
}
```

```cpp
#include <hip/hip_runtime.h>
#include <cstdio>
#include <cstdint>

#ifndef MK_SINGLE
#define MK_SINGLE 1
#endif

typedef _Float16 h16;
typedef _Float16 h16x2 __attribute__((ext_vector_type(2)));
typedef _Float16 h16x4 __attribute__((ext_vector_type(4)));
typedef _Float16 h16x8 __attribute__((ext_vector_type(8)));
typedef float f32x2 __attribute__((ext_vector_type(2)));
typedef float f32x4 __attribute__((ext_vector_type(4)));
typedef unsigned u32x2 __attribute__((ext_vector_type(2)));
typedef unsigned u32x4 __attribute__((ext_vector_type(4)));
typedef int i32x4 __attribute__((ext_vector_type(4)));
typedef int i32x8 __attribute__((ext_vector_type(8)));
#define LAS __attribute__((address_space(3)))
#define GAS __attribute__((address_space(1)))
#define PIN() do { asm volatile("" ::: "memory"); __builtin_amdgcn_sched_barrier(0); } while (0)
#define PINV(x) asm volatile("" : "+v"(x) :: "memory")
#define NTL(T, p) __builtin_nontemporal_load((const T*)(p))
#ifndef F8_PROJ
#define F8_PROJ 0
#endif
#ifndef F8_Q
#define F8_Q 1
#endif
#ifndef F8_UP
#define F8_UP 1
#endif
#ifndef F8_DOWN
#define F8_DOWN 1
#endif
#define F8_HB (F8_PROJ || F8_Q || F8_UP)
#define MFMA16(a, b, c) __builtin_amdgcn_mfma_f32_16x16x32_f16((a), (b), (c), 0, 0, 0)

constexpr int NB = 16, SEQ = 2048, DM = 1024, NT = NB * SEQ, MEML = 256, NTM = NB * MEML, NLAYER = 2;
constexpr int NPJ = 3584;
constexpr int CQ = 0, CK = 384, CV = 768, CG = 1152, CZ = 1536, CXS = 1920, CBM = 2304, CCM = 2560, CXR = 2816, CGT = 3072, CDT = 3328;
constexpr int DIN = 3334, NCH = 16, MAXSLOT = 73728;
constexpr float EPS = 1e-6f;
constexpr int NPH = 14;
constexpr int NPHASES = NLAYER * NPH;

constexpr size_t MiB = (size_t)1 << 20;
constexpr size_t WS_CTL = 0, CTL_ZERO_BYTES = 64 * 1024;
constexpr size_t WS_WIN = 1 * MiB, WS_WOUT = 8 * MiB, WS_WQ = 10 * MiB, WS_WKV = 12 * MiB, WS_WO = 16 * MiB, WS_W13 = 18 * MiB, WS_W2 = 82 * MiB, WS_LRUW = 114 * MiB;
constexpr size_t WS_HB = 115 * MiB;
constexpr size_t WS_R1 = 179 * MiB;
constexpr size_t WS_R2 = 403 * MiB;
constexpr size_t WS_KV = 547 * MiB, WS_MEM16 = 563 * MiB, WS_SSQ = 571 * MiB, WS_MISC = 573 * MiB, WS_END = 577 * MiB;
constexpr size_t OFF_QCA = WS_R1, OFF_OATT = WS_R1 + 64 * MiB, OFF_XP = WS_R1, OFF_HP = WS_R1 + 144 * MiB;
constexpr size_t OFF_OMIX = WS_R2, OFF_RST = WS_R2 + 64 * MiB, OFF_SST = WS_R2 + 88 * MiB, OFF_LSUM = WS_R2 + 136 * MiB, OFF_SDEC = WS_R2 + 137 * MiB, OFF_LCAR = WS_R2 + 138 * MiB, OFF_YP = WS_R2;
constexpr size_t OUT_HB8 = 0;
constexpr size_t OUT_XTG = 0, OUT_BCN = 24 * MiB, OUT_LAU = 56 * MiB;
constexpr size_t OFF_KB = WS_KV, OFF_VT = WS_KV + 8 * MiB;
constexpr size_t OFF_ROPE = WS_MISC, OFF_MSSQ = WS_MISC + 512 * 1024, OFF_EID = WS_MISC + 768 * 1024, OFF_GATE = WS_MISC + 1024 * 1024, OFF_TSLOT = WS_MISC + 1280 * 1024,
                 OFF_RSTDT = WS_MISC + 1536 * 1024, OFF_SRSTD = WS_MISC + 1664 * 1024, OFF_TILEE = WS_MISC + 2000 * 1024, OFF_STOK = WS_MISC + 2048 * 1024, OFF_RWG = WS_MISC + 2400 * 1024;
constexpr int CW_COUNTS = 64, CW_CURSOR = 192, CW_NTILES = 320, CW_BAR = 4096;

constexpr int LDS_BYTES = 152 * 1024;
constexpr int LDS_MISC = 150 * 1024;

struct Prm { const float* in[32]; float* out; unsigned char* ws; int ph_lo, ph_hi; };

#define XB_TMO      128
#define XB_XCNT(j)  (256  + 64 * (j))
#define XB_XSUB(j)  (1280 + 64 * (j))
#define XB_XGEN(j)  (2304 + 64 * (j))
#define XB_TOP      3328
#define XB_TOPGEN   3392
#define XCD_BAR_WORDS 3456
#define XB_SPIN_CAP (1u << 18)
__device__ __forceinline__ unsigned xb_ld(unsigned* p)              { return __hip_atomic_load(p, __ATOMIC_RELAXED, __HIP_MEMORY_SCOPE_AGENT); }
__device__ __forceinline__ unsigned xb_add(unsigned* p, unsigned v) { return __hip_atomic_fetch_add(p, v, __ATOMIC_RELAXED, __HIP_MEMORY_SCOPE_AGENT); }
__device__ __forceinline__ unsigned xb_xcc_id() { return (unsigned)__builtin_amdgcn_s_getreg((3 << 11) | 20) & 0xFu; }
#define XB_SPIN(cond, bar) do { unsigned _sp = 0; while (cond) { __builtin_amdgcn_s_sleep(1); \
    if ((++_sp & 255u) == 0u) { if (xb_ld(&(bar)[XB_TMO])) break; if (_sp > XB_SPIN_CAP) { atomicAdd(&(bar)[XB_TMO], 1u); break; } } } } while (0)
struct XcdBarrier { unsigned* bar; unsigned x; volatile LAS unsigned* st; };
__device__ __forceinline__ XcdBarrier xcd_barrier_post(unsigned* bar, volatile LAS unsigned* st) {
    XcdBarrier b; b.bar = bar; b.x = xb_xcc_id(); b.st = st;
    if (threadIdx.x == 0) (void)xb_add(&bar[XB_XCNT(b.x)], 1u);
    return b;
}
__device__ __forceinline__ void xcd_barrier_complete(unsigned* bar, unsigned x, unsigned& nloc, unsigned& nx) {
    const unsigned G = gridDim.x * gridDim.y * gridDim.z;
    unsigned sum, cnt, mine, sp = 0u;
    for (;;) {
        sum = 0u; cnt = 0u; mine = 0u;
#pragma unroll
        for (unsigned j = 0; j < 16; ++j) { const unsigned c = xb_ld(&bar[XB_XCNT(j)]); sum += c; cnt += (c > 0u) ? 1u : 0u; mine = (j == x) ? c : mine; }
        if (sum == G) break;
        __builtin_amdgcn_s_sleep(1);
        if ((++sp & 255u) == 0u) { if (xb_ld(&bar[XB_TMO])) break; if (sp > XB_SPIN_CAP) { atomicAdd(&bar[XB_TMO], 1u); break; } }
    }
    nloc = mine > 0u ? mine : 1u; nx = cnt > 0u ? cnt : 1u;
}
__device__ __forceinline__ void xcd_barrier(const XcdBarrier& b) {
    asm volatile("s_waitcnt vmcnt(0)" ::: "memory");
    __syncthreads();
    if (threadIdx.x == 0) {
        unsigned* bar = b.bar;
        __builtin_amdgcn_s_waitcnt(0);
        unsigned nloc = b.st[0], nx = b.st[1];
        if (nloc == 0u) { xcd_barrier_complete(bar, b.x, nloc, nx); b.st[0] = nloc; b.st[1] = nx; }
        const unsigned old = xb_add(&bar[XB_XSUB(b.x)], 1u);
        const unsigned gen = old / nloc;
        if (old + 1u == (gen + 1u) * nloc) {
            __builtin_amdgcn_fence(__ATOMIC_RELEASE, "agent");
            asm volatile("s_waitcnt vmcnt(0)" ::: "memory");
            const unsigned og = xb_add(&bar[XB_TOP], 1u);
            const unsigned tg = og / nx;
            if (og + 1u == (tg + 1u) * nx) xb_add(&bar[XB_TOPGEN], 1u);
            else XB_SPIN(xb_ld(&bar[XB_TOPGEN]) == tg, bar);
            __builtin_amdgcn_fence(__ATOMIC_ACQUIRE, "agent");
            xb_add(&bar[XB_XGEN(b.x)], 1u);
            asm volatile("s_waitcnt vmcnt(0)" ::: "memory");
        } else {
            XB_SPIN(xb_ld(&bar[XB_XGEN(b.x)]) == gen, bar);
            __builtin_amdgcn_fence(__ATOMIC_ACQUIRE, "agent");
            asm volatile("s_waitcnt vmcnt(0)" ::: "memory");
        }
    }
    __syncthreads();
}

__device__ __forceinline__ float wave_sum(float v) {
#pragma unroll
    for (int o = 1; o < 64; o <<= 1) v += __shfl_xor(v, o);
    return v;
}
__device__ __forceinline__ float siluf_(float x) { return x * __builtin_amdgcn_rcpf(1.0f + __expf(-x)); }
__device__ __forceinline__ float softplusf_(float x) { return x > 20.f ? x : log1pf(__expf(x)); }
__device__ __forceinline__ float gelu_tanh_(float x) { const float y = 0.7978845608028654f * (x + 0.044715f * x * x * x); const float t = 1.0f - 2.0f / (__expf(2.0f * y) + 1.0f); return 0.5f * x * (1.0f + t); }
__device__ __forceinline__ h16x8 pack8(const f32x4 a, const f32x4 b) { h16x8 r; r[0] = (h16)a[0]; r[1] = (h16)a[1]; r[2] = (h16)a[2]; r[3] = (h16)a[3]; r[4] = (h16)b[0]; r[5] = (h16)b[1]; r[6] = (h16)b[2]; r[7] = (h16)b[3]; return r; }
__device__ __forceinline__ h16x4 pack4(const f32x4 a) { h16x4 r; r[0] = (h16)a[0]; r[1] = (h16)a[1]; r[2] = (h16)a[2]; r[3] = (h16)a[3]; return r; }
__device__ __forceinline__ unsigned cvt4_fp8(float a, float b, float c, float d) {
    a = __builtin_amdgcn_fmed3f(a, -448.f, 448.f); b = __builtin_amdgcn_fmed3f(b, -448.f, 448.f); c = __builtin_amdgcn_fmed3f(c, -448.f, 448.f); d = __builtin_amdgcn_fmed3f(d, -448.f, 448.f);
    int p = __builtin_amdgcn_cvt_pk_fp8_f32(a, b, 0, false); p = __builtin_amdgcn_cvt_pk_fp8_f32(c, d, p, true); return (unsigned)p; }
__device__ __forceinline__ h16x8 ldsfrag(LAS const h16* p) { return *(LAS const h16x8*)p; }
__device__ __forceinline__ int kperm32(int k) { return (k & ~31) | (((k >> 2) & 3) << 3) | (((k >> 4) & 1) << 2) | (k & 3); }
__device__ __forceinline__ h16x8 scalefrag(const h16x8 f, float s) { const h16 hs = (h16)s; h16x8 v;
#pragma unroll
    for (int j = 0; j < 8; ++j) v[j] = hs; return f * v; }
__device__ __forceinline__ float row_rstd(const float* ssq16) {
    const f32x4 a = *(const f32x4*)ssq16, b = *(const f32x4*)(ssq16 + 4), c = *(const f32x4*)(ssq16 + 8), d = *(const f32x4*)(ssq16 + 12);
    const float s = ((a[0] + a[1]) + (a[2] + a[3])) + ((b[0] + b[1]) + (b[2] + b[3])) + ((c[0] + c[1]) + (c[2] + c[3])) + ((d[0] + d[1]) + (d[2] + d[3]));
    return 1.0f / sqrtf(s * (1.0f / DM) + EPS);
}

namespace pg8 {
constexpr int BM = 256, BK = 64, HALF = 128, HTB = HALF * BK * 2, STAGE_BYTES = 8 * HTB, NXCD = 8, WGM = 8;
__host__ __device__ __forceinline__ int lds_byte(int r, int c) { const int st = (r >> 4) * 2 + (c >> 5), rr = r & 15, cc = c & 31, ob = rr * 64 + cc * 2; return st * 1024 + (ob ^ (((ob >> 9) & 1) << 5)); }
__host__ __device__ __forceinline__ void stage_rc(int b, int& R, int& C) { const int st = b / 1024, sb = b % 1024, swz = sb ^ (((sb >> 9) & 1) << 5); R = (st >> 1) * 16 + swz / 64; C = (st & 1) * 32 + (swz % 64) / 2; }
__host__ __device__ __forceinline__ int perm32(int rho) { const int n = rho >> 4, i = rho & 15; return 8 * (i >> 2) + 4 * n + (i & 3); }
struct Unit { int pm, pn; };
struct Gemm { const h16* A; const h16* Bt; int lda, ldb, K; const int* rowidx; };
struct StaticOrder {
    int nM, nN, nwg, G, c;
    __device__ void init(int M, int N, int G_, int c_) { nM = M / BM; nN = N / BM; nwg = nM * nN; G = G_; c = c_; }
    __device__ bool next(int i, Unit& u) const {
        const long L = (long)i * G + c; if (L >= nwg) return false;
        int wgid = (int)L; { const int q = nwg / NXCD, r = nwg % NXCD, xcd = wgid % NXCD, off = wgid / NXCD; wgid = (xcd < r ? xcd * (q + 1) : r * (q + 1) + (xcd - r) * q) + off; }
        const int nig = WGM * nN, gid = wgid / nig, fm = gid * WGM, gsz = (nM - fm) < WGM ? (nM - fm) : WGM;
        u.pm = fm + ((wgid % nig) % gsz); u.pn = (wgid % nig) / gsz; return true;
    }
};
struct GroupOrder {
    const int* tile_e; int ntiles, G, vcu;
    __device__ bool next(int i, Unit& u) const {
        const int L = i * G + vcu, tile = L >> 2; if (tile >= ntiles) return false;
        u.pm = tile; u.pn = __builtin_amdgcn_readfirstlane(tile_e[tile]) * 4 + (L & 3); return true;
    }
};

struct EpiScale16 {
    static constexpr bool PERM = true;
    h16* O; int ldc; const float* ssq; float cs;
    __device__ __forceinline__ void operator()(const f32x4 (&acc)[2][2][4][2], const Unit& u, int wr, int wc, int fr, int fq) const {
        const int row0 = u.pm * BM + wr * 64 + fr, col0 = u.pn * BM + wc * 32 + 8 * fq;
#pragma unroll
        for (int ai = 0; ai < 2; ++ai)
#pragma unroll
            for (int m = 0; m < 4; ++m) { const int row = row0 + ai * HALF + m * 16; const float rs = row_rstd(ssq + (size_t)row * 16) * cs; h16* rowp = O + (size_t)row * ldc + col0;
#pragma unroll
                for (int bj = 0; bj < 2; ++bj) *(h16x8*)(rowp + bj * HALF) = pack8(acc[ai][bj][m][0] * rs, acc[ai][bj][m][1] * rs); }
    }
};
struct EpiScale16C {
    static constexpr bool PERM = true;
    h16* O; int ldc; const float* rstd; float cs;
    __device__ __forceinline__ void operator()(const f32x4 (&acc)[2][2][4][2], const Unit& u, int wr, int wc, int fr, int fq) const {
        const int row0 = u.pm * BM + wr * 64 + fr, col0 = u.pn * BM + wc * 32 + 8 * fq;
        float rs[2][4];
#pragma unroll
        for (int ai = 0; ai < 2; ++ai)
#pragma unroll
            for (int m = 0; m < 4; ++m) rs[ai][m] = rstd[row0 + ai * HALF + m * 16] * cs;
#pragma unroll
        for (int ai = 0; ai < 2; ++ai)
#pragma unroll
            for (int m = 0; m < 4; ++m) { h16* rowp = O + (size_t)(row0 + ai * HALF + m * 16) * ldc + col0;
#pragma unroll
                for (int bj = 0; bj < 2; ++bj) *(h16x8*)(rowp + bj * HALF) = pack8(acc[ai][bj][m][0] * rs[ai][m], acc[ai][bj][m][1] * rs[ai][m]); }
    }
};
struct EpiKV {
    static constexpr bool PERM = true;
    h16* KB; h16* VT; const float* ssq;
    __device__ __forceinline__ void operator()(const f32x4 (&acc)[2][2][4][2], const Unit& u, int wr, int wc, int fr, int fq) const {
        const int row0 = u.pm * BM + wr * 64 + fr;
#pragma unroll
        for (int ai = 0; ai < 2; ++ai)
#pragma unroll
            for (int m = 0; m < 4; ++m) { const int row = row0 + ai * HALF + m * 16; const float rs = row_rstd(ssq + (size_t)row * 16);
                h16x8 pk[2];
#pragma unroll
                for (int bj = 0; bj < 2; ++bj) pk[bj] = pack8(acc[ai][bj][m][0] * rs, acc[ai][bj][m][1] * rs);
                if (u.pn < 4) { h16* rowp = KB + (size_t)row * DM + u.pn * BM + wc * 32 + 8 * fq;
                    *(h16x8*)rowp = pk[0]; *(h16x8*)(rowp + HALF) = pk[1];
                } else { const int b = row >> 8, k0 = row & 255, hd = u.pn - 4;
                    const int key = (k0 & ~31) | (((k0 >> 2) & 3) << 3) | (((k0 >> 4) & 1) << 2) | (k0 & 3);
                    h16* base = VT + ((size_t)(b * 4 + hd) * 256 + wc * 32 + 8 * fq) * 256 + key;
#pragma unroll
                    for (int bj = 0; bj < 2; ++bj)
#pragma unroll
                        for (int j = 0; j < 8; ++j) base[(bj * HALF + j) * 256] = pk[bj][j]; }
                PIN();
            }
    }
};
struct EpiResid {
    static constexpr bool PERM = true;
    h16* hb; float* ssq; unsigned char* hb8;
    __device__ __forceinline__ void operator()(const f32x4 (&acc)[2][2][4][2], const Unit& u, int wr, int wc, int fr, int fq) const {
        const int row0 = u.pm * BM + wr * 64 + fr, col0 = u.pn * BM + wc * 32 + 8 * fq;
#pragma unroll
        for (int ai = 0; ai < 2; ++ai)
#pragma unroll
            for (int m = 0; m < 4; ++m) { const int row = row0 + ai * HALF + m * 16; h16* rowp = hb + (size_t)row * DM + col0; float s = 0.f;
#pragma unroll
                for (int bj = 0; bj < 2; ++bj) { const h16x8 bv = *(const h16x8*)(rowp + bj * HALF); f32x4 v0, v1;
#pragma unroll
                    for (int e = 0; e < 4; ++e) { v0[e] = (float)bv[e] + acc[ai][bj][m][0][e]; v1[e] = (float)bv[4 + e] + acc[ai][bj][m][1][e]; }
                    const h16x8 o = pack8(v0, v1); *(h16x8*)(rowp + bj * HALF) = o;
                    if (F8_HB) *(u32x2*)(hb8 + (size_t)row * DM + col0 + bj * HALF) = (u32x2){cvt4_fp8(v0[0], v0[1], v0[2], v0[3]), cvt4_fp8(v1[0], v1[1], v1[2], v1[3])};
#pragma unroll
                    for (int e = 0; e < 8; ++e) { const float q = (float)o[e]; s += q * q; } }
                s += __shfl_xor(s, 16); s += __shfl_xor(s, 32);
                if (fq == 0) ssq[(size_t)row * 16 + u.pn * 4 + wc] = s; }
    }
};
struct EpiGated {
    static constexpr bool PERM = true;
    h16* O; const float* srstd; float cs;
    __device__ __forceinline__ void operator()(const f32x4 (&acc)[2][2][4][2], const Unit& u, int wr, int wc, int fr, int fq) const {
        const int row0 = u.pm * BM + wr * 64 + fr, col0 = (u.pn & 3) * HALF + wc * 32 + 8 * fq;
#pragma unroll
        for (int ai = 0; ai < 2; ++ai)
#pragma unroll
            for (int m = 0; m < 4; ++m) { const int row = row0 + ai * HALF + m * 16; const float rs = srstd[row] * cs; f32x4 o[2];
#pragma unroll
                for (int n = 0; n < 2; ++n)
#pragma unroll
                    for (int j = 0; j < 4; ++j) { const float a = acc[ai][0][m][n][j] * rs, b = acc[ai][1][m][n][j] * rs; o[n][j] = siluf_(a) * b; }
                if (F8_DOWN) *(u32x2*)((unsigned char*)O + (size_t)row * 512 + col0) = (u32x2){cvt4_fp8(16.f * o[0][0], 16.f * o[0][1], 16.f * o[0][2], 16.f * o[0][3]), cvt4_fp8(16.f * o[1][0], 16.f * o[1][1], 16.f * o[1][2], 16.f * o[1][3])};
                else *(h16x8*)(O + (size_t)row * 512 + col0) = pack8(o[0], o[1]); }
    }
};
struct EpiPlain16 {
    static constexpr bool PERM = true;
    h16* O; float cs;
    __device__ __forceinline__ void operator()(const f32x4 (&acc)[2][2][4][2], const Unit& u, int wr, int wc, int fr, int fq) const {
        const int row0 = u.pm * BM + wr * 64 + fr, col0 = (u.pn & 3) * BM + wc * 32 + 8 * fq;
#pragma unroll
        for (int ai = 0; ai < 2; ++ai)
#pragma unroll
            for (int m = 0; m < 4; ++m) { h16* rowp = O + (size_t)(row0 + ai * HALF + m * 16) * DM + col0;
#pragma unroll
                for (int bj = 0; bj < 2; ++bj) *(h16x8*)(rowp + bj * HALF) = F8_DOWN ? pack8(acc[ai][bj][m][0] * cs, acc[ai][bj][m][1] * cs) : pack8(acc[ai][bj][m][0], acc[ai][bj][m][1]); }
    }
};

template <class Epi, class Sched, bool GATHER = false, int F8W = 0>
__device__ __forceinline__ void gemm_phase(LAS unsigned char* lds, const int tid, const Gemm g, const Sched& S, const Epi& E) {
    const int wid = __builtin_amdgcn_readfirstlane(tid >> 6), lane = tid & 63, wr = wid >> 2, wc = wid & 3, fr = lane & 15, fq = lane >> 4;
    int K_ = g.K; asm volatile("" : "+s"(K_));
    const int K = K_, nt = K / BK;
    unsigned voffA[2], voffB[2];
#pragma unroll
    for (int i = 0; i < 2; ++i) { int R, C; stage_rc(tid * 16 + i * 8192, R, C); const int Rb = Epi::PERM ? ((R & ~31) + perm32(R & 31)) : R;
        voffA[i] = (unsigned)(R * g.lda + C) * 2u; voffB[i] = (unsigned)(Rb * g.ldb + C) * 2u; }
    const size_t kstep = (size_t)(BK * 2);
    const size_t hstepA = (size_t)HALF * g.lda * 2, hstepB = (size_t)HALF * g.ldb * 2;
    const size_t tstepA = 2 * hstepA, tstepB = 2 * hstepB;
    const unsigned ldsw = (unsigned)wid * 1024u;
    const int aoff = lds_byte(wr * 64 + fr, fq * 8), boff = lds_byte(wc * 32 + fr, fq * 8);
#define PG8_SA(b, h) (((b) * 2 + (h)) * HTB)
#define PG8_SB(b, h) ((4 + (b) * 2 + (h)) * HTB)
#define PG8_STAGE(bufoff, gbase, voff) do { _Pragma("unroll") for (int _i = 0; _i < 2; ++_i) \
        __builtin_amdgcn_global_load_lds((const unsigned*)((const char*)(gbase) + (voff)[_i]), (LAS unsigned*)(lds + (bufoff) + ldsw + _i * 8192), 16, 0, 0); } while (0)
    unsigned coff[2], noff[2], cbyte[2];
    if constexpr (GATHER) {
#pragma unroll
        for (int i = 0; i < 2; ++i) { int R_, C_; stage_rc(tid * 16 + i * 8192, R_, C_); cbyte[i] = (unsigned)(C_ * 2); } }
#define PG8_GOFF(u_, o_) do { _Pragma("unroll") for (int _i = 0; _i < 2; ++_i) { int R_, C_; stage_rc(tid * 16 + _i * 8192, R_, C_); \
        o_[_i] = (unsigned)g.rowidx[(u_).pm * BM + R_] | ((unsigned)g.rowidx[(u_).pm * BM + HALF + R_] << 16); } } while (0)
#define PG8_STAGEA(bufoff, gbase, h, sel) do { if constexpr (GATHER) { _Pragma("unroll") for (int _i = 0; _i < 2; ++_i) { const unsigned pk_ = (sel) ? noff[_i] : coff[_i]; \
        __builtin_amdgcn_global_load_lds((const unsigned*)((const char*)(gbase) + (((pk_ >> (16 * (h))) & 0xffffu) * (unsigned)(g.lda * 2) + cbyte[_i])), (LAS unsigned*)(lds + (bufoff) + ldsw + _i * 8192), 16, 0, 0); } } \
        else { PG8_STAGE(bufoff, (gbase) + ((h) ? hstepA : 0), voffA); } } while (0)
#define PG8_LDA(dst, b, h) do { _Pragma("unroll") for (int m = 0; m < 4; ++m) _Pragma("unroll") for (int k = 0; k < 2; ++k) dst[m][k] = *(const LAS h16x8*)(lds + PG8_SA(b, h) + aoff + m * 2048 + k * 1024); } while (0)
#define PG8_LDB(dst, b, h) do { _Pragma("unroll") for (int n = 0; n < 2; ++n) _Pragma("unroll") for (int k = 0; k < 2; ++k) dst[n][k] = *(const LAS h16x8*)(lds + PG8_SB(b, h) + boff + n * 2048 + k * 1024); } while (0)
#define PG8_MMA(ai, bj, At, Bt) do { __builtin_amdgcn_s_setprio(1); _Pragma("unroll") for (int m = 0; m < 4; ++m) _Pragma("unroll") for (int n = 0; n < 2; ++n) _Pragma("unroll") for (int k = 0; k < 2; ++k) \
        acc[ai][bj][m][n] = __builtin_amdgcn_mfma_f32_16x16x32_f16(Bt[n][k], At[m][k], acc[ai][bj][m][n], 0, 0, 0); __builtin_amdgcn_s_setprio(0); } while (0)
#define PG8_MMA8(ai, bj, At, Bt) do { __builtin_amdgcn_s_setprio(1); _Pragma("unroll") for (int m = 0; m < 4; ++m) _Pragma("unroll") for (int n = 0; n < 2; ++n) { \
        const i32x8 wf_ = __builtin_shufflevector(__builtin_bit_cast(i32x4, Bt[n][0]), __builtin_bit_cast(i32x4, Bt[n][1]), 0, 1, 2, 3, 4, 5, 6, 7), af_ = __builtin_shufflevector(__builtin_bit_cast(i32x4, At[m][0]), __builtin_bit_cast(i32x4, At[m][1]), 0, 1, 2, 3, 4, 5, 6, 7); \
        asm volatile("v_mfma_f32_16x16x128_f8f6f4 %0, %1, %2, %0" : "+v"(acc[ai][bj][m][n]) : "v"(wf_), "v"(af_)); } __builtin_amdgcn_s_setprio(0); } while (0)
#define PG8_MM(ai, bj, At, Bt) do { if constexpr (F8W != 0) PG8_MMA8(ai, bj, At, Bt); else PG8_MMA(ai, bj, At, Bt); } while (0)
#define PG8_WAIT_V(n) asm volatile("s_waitcnt vmcnt(" #n ")" ::: "memory")
#define PG8_WAIT_L(n) asm volatile("s_waitcnt lgkmcnt(" #n ")" ::: "memory")
#define PG8_BAR __builtin_amdgcn_s_barrier()
#define PG8_SCHED __builtin_amdgcn_sched_barrier(0)
    Unit cur, nxt; int ui = 0;
    if (!S.next(0, cur)) return;
    f32x4 acc[2][2][4][2];
#pragma unroll
    for (int a = 0; a < 2; ++a)
#pragma unroll
        for (int b = 0; b < 2; ++b)
#pragma unroll
            for (int m = 0; m < 4; ++m)
#pragma unroll
                for (int n = 0; n < 2; ++n) acc[a][b][m][n] = (f32x4){0.f, 0.f, 0.f, 0.f};
    h16x8 At[4][2], B0[2][2], B1[2][2];
    const char* cA = (const char*)g.A + (GATHER ? (size_t)0 : (size_t)cur.pm * tstepA); const char* cB = (const char*)g.Bt + (size_t)cur.pn * tstepB;
    if constexpr (GATHER) { PG8_GOFF(cur, coff); noff[0] = coff[0]; noff[1] = coff[1]; }
    PG8_STAGE(PG8_SB(0, 0), cB, voffB); PG8_STAGE(PG8_SB(0, 1), cB + hstepB, voffB); PG8_STAGEA(PG8_SA(0, 0), cA, 0, false); PG8_STAGEA(PG8_SA(0, 1), cA, 1, false);
    if (wr == 1) PG8_BAR;
    PG8_WAIT_V(2); PG8_BAR;
    PG8_STAGE(PG8_SB(1, 0), cB + kstep, voffB); PG8_STAGEA(PG8_SA(1, 0), cA + kstep, 0, false); PG8_STAGE(PG8_SB(1, 1), cB + hstepB + kstep, voffB);
    PG8_WAIT_V(6); PG8_BAR;
    for (;;) {
        const bool has_next = S.next(ui + 1, nxt);
        const char* nA = (has_next && !GATHER) ? (const char*)g.A + (size_t)nxt.pm * tstepA : cA; const char* nB = has_next ? (const char*)g.Bt + (size_t)nxt.pn * tstepB : cB;
        if constexpr (GATHER) { if (has_next) PG8_GOFF(nxt, noff); }
        for (int t = 0; t < nt; t += 2) {
            const bool last = (t == nt - 2);
            const char* a1 = cA + (size_t)(t + 1) * kstep;
            const char* a2 = last ? nA : cA + (size_t)(t + 2) * kstep; const char* b2 = last ? nB : cB + (size_t)(t + 2) * kstep;
            const char* a3 = a2 + kstep; const char* b3 = b2 + kstep;
            PG8_LDB(B0, 0, 0); PG8_LDB(B1, 0, 1); PG8_SCHED; PG8_LDA(At, 0, 0); PG8_STAGEA(PG8_SA(1, 1), a1, 1, false);
            PG8_WAIT_V(8); PG8_WAIT_L(0); PG8_BAR; PG8_MM(0, 0, At, B0); PG8_MM(0, 1, At, B1); PG8_BAR; PG8_SCHED;
            PG8_LDA(At, 0, 1); PG8_STAGE(PG8_SB(0, 0), b2, voffB); PG8_STAGE(PG8_SB(0, 1), b2 + hstepB, voffB); PG8_STAGEA(PG8_SA(0, 0), a2, 0, last);
            PG8_WAIT_V(8); PG8_WAIT_L(0); PG8_BAR; PG8_MM(1, 0, At, B0); PG8_MM(1, 1, At, B1); PG8_BAR; PG8_SCHED;
            PG8_LDB(B0, 1, 0); PG8_LDB(B1, 1, 1); PG8_SCHED; PG8_LDA(At, 1, 0); PG8_STAGEA(PG8_SA(0, 1), a2, 1, last);
            PG8_WAIT_V(8); PG8_WAIT_L(0); PG8_BAR; PG8_MM(0, 0, At, B0); PG8_MM(0, 1, At, B1); PG8_BAR; PG8_SCHED;
            PG8_LDA(At, 1, 1); PG8_STAGE(PG8_SB(1, 0), b3, voffB); PG8_STAGE(PG8_SB(1, 1), b3 + hstepB, voffB); PG8_STAGEA(PG8_SA(1, 0), a3, 0, last);
            PG8_WAIT_V(8); PG8_WAIT_L(0); PG8_BAR; PG8_MM(1, 0, At, B0); PG8_MM(1, 1, At, B1); PG8_BAR; PG8_SCHED;
        }
        if (wr == 0) PG8_BAR;
        if constexpr (F8W != 0) asm volatile("s_nop 7\n\ts_nop 7\n\ts_nop 7" ::: "memory");
        E(acc, cur, wr, wc, fr, fq);
        if (!has_next) break;
#pragma unroll
        for (int a = 0; a < 2; ++a)
#pragma unroll
            for (int b = 0; b < 2; ++b)
#pragma unroll
                for (int m = 0; m < 4; ++m)
#pragma unroll
                    for (int n = 0; n < 2; ++n) acc[a][b][m][n] = (f32x4){0.f, 0.f, 0.f, 0.f};
        cur = nxt; cA = nA; cB = nB; ++ui;
        if constexpr (GATHER) { coff[0] = noff[0]; coff[1] = noff[1]; }
        if (wr == 1) PG8_BAR;
    }
    PG8_WAIT_V(0);
    PG8_BAR;
#undef PG8_SA
#undef PG8_SB
#undef PG8_STAGE
#undef PG8_LDA
#undef PG8_GOFF
#undef PG8_STAGEA
#undef PG8_LDB
#undef PG8_MMA
#undef PG8_MMA8
#undef PG8_MM
#undef PG8_WAIT_V
#undef PG8_WAIT_L
#undef PG8_BAR
#undef PG8_SCHED
}
}

struct Frame {
    LAS unsigned char* lds;
    GAS unsigned char* ws;
    volatile LAS unsigned long long* ptab;
    float* out;
    int tid, lane, wave, G, vcu;
};
#define WSP(T, off) ((T*)(GAS T*)(F.ws + (off)))
__device__ __forceinline__ const float* inptr(const Frame& F, int i) {
    const unsigned long long v = F.ptab[i];
    const unsigned lo = __builtin_amdgcn_readfirstlane((unsigned)v), hi = __builtin_amdgcn_readfirstlane((unsigned)(v >> 32));
    return (const float*)(GAS const float*)(((unsigned long long)hi << 32) | lo);
}
__device__ __forceinline__ void launder(Frame& F) {
    int wv = F.wave; asm volatile("" : "+s"(wv)); F.wave = wv;
    unsigned z = 0u; asm volatile("" : "+v"(z));
    int t = wv * 64 + (int)__builtin_amdgcn_mbcnt_hi(~0u, __builtin_amdgcn_mbcnt_lo(~0u, z)); F.tid = t; F.lane = t & 63;
    const unsigned long long w = (unsigned long long)F.ws; unsigned wl = __builtin_amdgcn_readfirstlane((unsigned)w), wh = __builtin_amdgcn_readfirstlane((unsigned)(w >> 32));
    asm volatile("" : "+s"(wl), "+s"(wh)); F.ws = (GAS unsigned char*)(((unsigned long long)wh << 32) | wl);
    unsigned lo = __builtin_amdgcn_readfirstlane((unsigned)(uintptr_t)F.lds); asm volatile("" : "+s"(lo)); F.lds = (LAS unsigned char*)(uintptr_t)lo;
    int v = __builtin_amdgcn_readfirstlane(F.vcu); asm volatile("" : "+s"(v)); F.vcu = v;
}

struct TrItem { const float* W; const float* g; h16* Wt; int ldw, sc, nvalid, ldt, d0, k0, vw, f8; float mul; };
__device__ __forceinline__ void tr_describe(const Frame& F, GAS unsigned char* wsb_, int l, int it, TrItem& d) {
    unsigned char* wsb = (unsigned char*)wsb_;
    int r = it; d.g = nullptr; d.mul = 1.f; d.nvalid = 64; d.vw = 4; d.ldt = DM; d.ldw = DM; d.f8 = 0;
    if (r < 896) { const int d0 = 64 * (r % 56); d.W = inptr(F, 3) + (size_t)l * DM * DIN; d.ldw = DIN; d.g = inptr(F, 2) + l * DM; d.Wt = (h16*)(wsb + WS_WIN); d.d0 = d0; d.k0 = 64 * (r / 56); d.vw = 2; if (F8_PROJ) { d.f8 = 1; d.mul = 256.f; }
        if (d0 < 2816) d.sc = d0; else if (d0 < 3328) d.sc = d0 + 6; else if (d0 == 3328) { d.sc = 2816; d.nvalid = 6; } else { d.sc = 0; d.nvalid = 0; } return; } r -= 896;
    if (r < 256) { d.W = inptr(F, 4) + (size_t)l * DM * DM; d.Wt = (h16*)(wsb + WS_WOUT); d.d0 = d.sc = 64 * (r % 16); d.k0 = 64 * (r / 16); return; } r -= 256;
    if (r < 256) { d.W = inptr(F, 20) + (size_t)l * DM * DM; d.g = inptr(F, 18) + l * DM; d.mul = F8_Q ? 256.f : 0.0625f; d.f8 = F8_Q; d.Wt = (h16*)(wsb + WS_WQ); d.d0 = d.sc = 64 * (r % 16); d.k0 = 64 * (r / 16); return; } r -= 256;
    if (r < 512) { d.W = inptr(F, 21) + (size_t)l * DM * 2048; d.ldw = 2048; d.g = inptr(F, 19) + l * DM; d.Wt = (h16*)(wsb + WS_WKV); d.d0 = d.sc = 64 * (r % 32); d.k0 = 64 * (r / 32); return; } r -= 512;
    if (r < 256) { d.W = inptr(F, 22) + (size_t)l * DM * DM; d.Wt = (h16*)(wsb + WS_WO); d.d0 = d.sc = 64 * (r % 16); d.k0 = 64 * (r / 16); return; } r -= 256;
    if (r < 8192) { const int e = r / 256, q = r % 256, d0 = 64 * (q % 16), grp = d0 >> 8, rr = d0 & 255;
        d.W = (rr < 128 ? inptr(F, 28) : inptr(F, 29)) + (size_t)(l * 32 + e) * DM * 512; d.ldw = 512; d.sc = grp * 128 + (rr & 127); d.g = inptr(F, 23) + l * DM; d.Wt = (h16*)(wsb + WS_W13 + (size_t)e * DM * DM * (F8_UP ? 1 : 2)); if (F8_UP) { d.f8 = 1; d.mul = 256.f; } d.d0 = d0; d.k0 = 64 * (q / 16); return; } r -= 8192;
    if (r < 4096) { const int e = r / 128, q = r % 128; d.W = inptr(F, 30) + (size_t)(l * 32 + e) * 512 * DM; d.Wt = (h16*)(wsb + WS_W2 + (size_t)e * DM * 512 * (F8_DOWN ? 1 : 2)); if (F8_DOWN) { d.f8 = 1; d.mul = 256.f; } d.ldt = 512; d.d0 = d.sc = 64 * (q % 16); d.k0 = 64 * (q / 16); return; } r -= 4096;
    { const int blk = r & 3, gate = (r >> 2) & 1, dir = r >> 3; d.W = (gate ? inptr(F, 16) : inptr(F, 14)) + (size_t)((l * 2 + dir) * 4 + blk) * 4096; d.ldw = 64; d.Wt = (h16*)(wsb + WS_LRUW) + (size_t)((dir * 2 + gate) * 4 + blk) * 4096; d.ldt = 64; d.d0 = d.sc = 0; d.k0 = 0; }
}
__device__ __forceinline__ void tr_load(const TrItem& d, int lane, f32x4 (&v)[16]) {
    if (d.vw == 4) { const int col = 4 * (lane & 15); const float* src = d.W + (size_t)(d.k0 + (lane >> 4)) * d.ldw + d.sc + col; const bool ok = col < d.nvalid;
#pragma unroll
        for (int i = 0; i < 16; ++i) v[i] = ok ? __builtin_nontemporal_load((const f32x4*)(src + (size_t)(4 * i) * d.ldw)) : (f32x4){0.f, 0.f, 0.f, 0.f};
    } else { const int col = 2 * (lane & 31); const float* src = d.W + (size_t)(d.k0 + (lane >> 5)) * d.ldw + d.sc + col; const bool ok = col < d.nvalid;
#pragma unroll
        for (int i = 0; i < 16; ++i) { const f32x2 a = ok ? __builtin_nontemporal_load((const f32x2*)(src + (size_t)(4 * i) * d.ldw)) : (f32x2){0.f, 0.f}, c = ok ? __builtin_nontemporal_load((const f32x2*)(src + (size_t)(4 * i + 2) * d.ldw)) : (f32x2){0.f, 0.f}; v[i] = (f32x4){a[0], a[1], c[0], c[1]}; } }
}
__device__ __forceinline__ void tr_to_lds(const TrItem& d, int lane, const f32x4 (&v)[16], LAS float* scr) {
    if (d.vw == 4) { LAS float* q = scr + (lane >> 4) * 65 + 4 * (lane & 15);
#pragma unroll
        for (int i = 0; i < 16; ++i) { q[(4 * i) * 65 + 0] = v[i][0]; q[(4 * i) * 65 + 1] = v[i][1]; q[(4 * i) * 65 + 2] = v[i][2]; q[(4 * i) * 65 + 3] = v[i][3]; }
    } else { LAS float* q = scr + (lane >> 5) * 65 + 2 * (lane & 31);
#pragma unroll
        for (int i = 0; i < 16; ++i) { q[(4 * i) * 65 + 0] = v[i][0]; q[(4 * i) * 65 + 1] = v[i][1]; q[(4 * i + 2) * 65 + 0] = v[i][2]; q[(4 * i + 2) * 65 + 1] = v[i][3]; } }
}
__device__ __forceinline__ void tr_from_lds(const TrItem& d, int lane, LAS const float* scr) {
    const int c = lane & 7; float gs[8];
    if (d.g) { const f32x4 g0 = *(const f32x4*)(d.g + d.k0 + 8 * c), g1 = *(const f32x4*)(d.g + d.k0 + 8 * c + 4);
        gs[0] = g0[0] * d.mul; gs[1] = g0[1] * d.mul; gs[2] = g0[2] * d.mul; gs[3] = g0[3] * d.mul; gs[4] = g1[0] * d.mul; gs[5] = g1[1] * d.mul; gs[6] = g1[2] * d.mul; gs[7] = g1[3] * d.mul;
    } else {
#pragma unroll
        for (int e = 0; e < 8; ++e) gs[e] = d.mul; }
    if (d.f8) {
#pragma unroll
        for (int j = 0; j < 8; ++j) { const int nn = (lane >> 3) + 8 * j; LAS const float* q = scr + (8 * c) * 65 + nn; float f[8];
#pragma unroll
            for (int e = 0; e < 8; ++e) f[e] = q[e * 65] * gs[e];
            *(u32x2*)((unsigned char*)d.Wt + (size_t)(d.d0 + nn) * d.ldt + d.k0 + 8 * c) = (u32x2){cvt4_fp8(f[0], f[1], f[2], f[3]), cvt4_fp8(f[4], f[5], f[6], f[7])}; }
        return; }
#pragma unroll
    for (int j = 0; j < 8; ++j) { const int nn = (lane >> 3) + 8 * j; LAS const float* q = scr + (8 * c) * 65 + nn; h16x8 o;
#pragma unroll
        for (int e = 0; e < 8; ++e) o[e] = (h16)(q[e * 65] * gs[e]);
        *(h16x8*)(d.Wt + (size_t)(d.d0 + nn) * d.ldt + d.k0 + 8 * c) = o; }
}
__device__ __forceinline__ void phase_convert(const Frame& F, const Prm& p, int l) {
    LAS float* scr = (LAS float*)(F.lds + F.wave * 16640);
    const int gw = F.vcu * 8 + F.wave, NGW = F.G * 8;
    constexpr int NITEMS = 896 + 256 + 256 + 512 + 256 + 8192 + 4096 + 16;
    { TrItem cur, nxt; f32x4 v[16]; int it = gw;
        if (it < NITEMS) { tr_describe(F, F.ws, l, it, cur); tr_load(cur, F.lane, v); }
        while (it < NITEMS) { const int itn = it + NGW; const bool hn = itn < NITEMS;
            tr_to_lds(cur, F.lane, v, scr);
            if (hn) { tr_describe(F, F.ws, l, itn, nxt); tr_load(nxt, F.lane, v); }
            asm volatile("s_waitcnt lgkmcnt(0)" ::: "memory");
            tr_from_lds(cur, F.lane, scr);
            asm volatile("s_waitcnt lgkmcnt(0)" ::: "memory");
            cur = nxt; it = itn; } }
    {
        const float* gm = inptr(F, 23) + l * DM; const float* wg = inptr(F, 24) + (size_t)l * DM * 4; const float* we = inptr(F, 26) + (size_t)l * DM * 32; h16* rwg = WSP(h16, OFF_RWG);
        for (int i = F.vcu * 512 + F.tid; i < 36 * DM; i += 256 * 512) { const int k = i / 36, j = i % 36; const float wv = gm[k] * (j < 4 ? wg[k * 4 + j] : we[k * 32 + (j - 4)]) * 1024.0f;
            const h16 hi = (h16)wv; rwg[(size_t)j * 1032 + k] = hi; rwg[(size_t)(36 + j) * 1032 + k] = (h16)(wv - (float)hi); } }
    if (l == 0) {
        for (int m = gw; m < NT + NTM; m += NGW) {
            const bool isx = m < NT; const int row = isx ? m : m - NT;
            const float* src = (isx ? inptr(F, 0) : inptr(F, 1)) + (size_t)row * DM; h16* dst = (isx ? WSP(h16, WS_HB) : WSP(h16, WS_MEM16)) + (size_t)row * DM;
            float* sq = (isx ? WSP(float, WS_SSQ) : WSP(float, OFF_MSSQ)) + (size_t)row * 16;
            float s = 0.f;
#pragma unroll
            for (int j = 0; j < 4; ++j) { const f32x4 v = __builtin_nontemporal_load((const f32x4*)(src + 4 * F.lane + 256 * j)); *(h16x4*)(dst + 4 * F.lane + 256 * j) = pack4(v);
                if (F8_HB && isx) *(unsigned*)((unsigned char*)F.out + OUT_HB8 + (size_t)row * DM + 4 * F.lane + 256 * j) = cvt4_fp8(v[0], v[1], v[2], v[3]); s += (v[0] * v[0] + v[1] * v[1]) + (v[2] * v[2] + v[3] * v[3]); }
            s = wave_sum(s);
            if (F.lane < 16) sq[F.lane] = (F.lane == 0) ? s : 0.f;
            if (isx && F.lane == 0) WSP(float, OFF_RSTDT)[row] = 1.0f / sqrtf(s * (1.0f / DM) + EPS);
        }
        float* rope = WSP(float, OFF_ROPE);
        for (int i = F.vcu * 512 + F.tid; i < SEQ * 32; i += F.G * 512) {
            const int pos = i >> 5, fi = i & 31; double th = 1.0;
            for (int k = 0; k < fi; ++k) th *= 0.74989420933245582730;
            const double rev = (double)pos * th * 0.15915494309189533577;
            const double fr = rev - floor(rev);
            const double r = (fr - 0.5) * 6.28318530717958647692;
            const double r2 = r * r; double sn = 1.0, cs = 1.0;
            for (int k = 14; k >= 1; --k) { sn = 1.0 - r2 / (double)((2 * k) * (2 * k + 1)) * sn; cs = 1.0 - r2 / (double)((2 * k - 1) * (2 * k)) * cs; }
            sn *= r;
            rope[pos * 64 + fi] = (float)(-cs); rope[pos * 64 + 32 + fi] = (float)(-sn);
        }
    }
}

template <bool SILU>
__device__ __forceinline__ void conv_rows8(const h16* projcol, long tbase, int n, int r0, const float* cw, int cdim, const float* cb, h16x8 (&out)[8]) {
    f32x4 w[4][2];
#pragma unroll
    for (int k = 0; k < 4; ++k) { w[k][0] = *(const f32x4*)(cw + k * cdim); w[k][1] = *(const f32x4*)(cw + k * cdim + 4); }
    const f32x4 b0 = *(const f32x4*)cb, b1 = *(const f32x4*)(cb + 4);
    h16x8 x[11];
#pragma unroll
    for (int i = 0; i < 11; ++i) { const int pos = n * 128 + r0 - 2 + i; h16x8 z;
#pragma unroll
        for (int e = 0; e < 8; ++e) z[e] = (h16)0.f;
        x[i] = (pos >= 0 && pos < SEQ) ? NTL(h16x8, projcol + (size_t)(tbase + r0 - 2 + i) * NPJ) : z; }
#pragma unroll
    for (int r = 0; r < 8; ++r) {
#pragma unroll
        for (int e = 0; e < 8; ++e) { float a = e < 4 ? b0[e] : b1[e - 4];
#pragma unroll
            for (int k = 0; k < 4; ++k) a += (e < 4 ? w[k][0][e] : w[k][1][e - 4]) * (float)x[r + k][e];
            out[r][e] = (h16)(SILU ? siluf_(a) : a); } }
}
__device__ __forceinline__ h16x8 col_of(const h16x8 (&o)[8], int e) { h16x8 c; c[0] = o[0][e]; c[1] = o[1][e]; c[2] = o[2][e]; c[3] = o[3][e]; c[4] = o[4][e]; c[5] = o[5][e]; c[6] = o[6][e]; c[7] = o[7][e]; return c; }

__device__ __forceinline__ void ret_scan_unit(const Frame& F, int u) {
    const int h = u % 6, b = (u / 6) % NB, dir = u / (6 * NB);
    const float gC = exp2f(128.0f * log1pf(-exp2f(-5.0f - (float)h)) * 1.4426950408889634f);
    h16* base = WSP(h16, OFF_RST) + ((size_t)((dir * NB + b) * NCH) * 6 + h) * 4096 + F.tid * 8;
    float acc[8];
#pragma unroll
    for (int e = 0; e < 8; ++e) acc[e] = 0.f;
#pragma unroll 1
    for (int half = 0; half < 2; ++half) { h16x8 sv[8];
#pragma unroll
        for (int i = 0; i < 8; ++i) { const int ii = 8 * half + i, n = dir == 0 ? ii : NCH - 1 - ii; sv[i] = *(const h16x8*)(base + (size_t)n * 6 * 4096); }
#pragma unroll
        for (int i = 0; i < 8; ++i) { const int ii = 8 * half + i, n = dir == 0 ? ii : NCH - 1 - ii; h16x8 o;
#pragma unroll
            for (int e = 0; e < 8; ++e) { o[e] = (h16)acc[e]; acc[e] = acc[e] * gC + (float)sv[i][e]; }
            *(h16x8*)(base + (size_t)n * 6 * 4096) = o; } }
}
#define RET_BAR() do { asm volatile("s_waitcnt lgkmcnt(0)" ::: "memory"); __builtin_amdgcn_s_barrier(); asm volatile("" ::: "memory"); } while (0)
__device__ __forceinline__ void ret_states_block(const Frame& F, int bn) {
    const int n = bn % NCH, b = bn / NCH; const long t0 = (long)b * SEQ + n * 128;
    const int r = F.tid >> 2, c = F.tid & 3;
    const h16* rowp = WSP(const h16, WS_R1) + (size_t)(t0 + r) * NPJ; const float* cs = WSP(const float, OFF_ROPE) + (size_t)(n * 128 + r) * 64 + 8 * c;
    const f32x4 c0 = *(const f32x4*)cs, c1 = *(const f32x4*)(cs + 4), s0 = *(const f32x4*)(cs + 32), s1 = *(const f32x4*)(cs + 36);
    const int dir = F.wave >> 2, dt = F.wave & 3, fr = F.lane & 15, fq = F.lane >> 4;
    h16x8 k1, k2, v1, v2;
#define RS_LOAD(hh) do { k1 = *(const h16x8*)(rowp + CK + (hh) * 64 + 8 * c); k2 = *(const h16x8*)(rowp + CK + (hh) * 64 + 32 + 8 * c); v1 = *(const h16x8*)(rowp + CV + (hh) * 64 + 16 * c); v2 = *(const h16x8*)(rowp + CV + (hh) * 64 + 16 * c + 8); } while (0)
    RS_LOAD(0);
#pragma unroll 1
    for (int h = 0; h < 6; ++h) {
        LAS h16* KT = (LAS h16*)(F.lds + (h & 1) * 34816); LAS h16* VT = KT + 64 * 136;
#pragma unroll
        for (int e = 0; e < 8; ++e) { const float x1 = (float)k1[e], x2 = (float)k2[e], co = e < 4 ? c0[e] : c1[e - 4], si = e < 4 ? s0[e] : s1[e - 4];
            KT[(8 * c + e) * 136 + r] = (h16)((x1 * co - x2 * si) * 0.125f); KT[(32 + 8 * c + e) * 136 + r] = (h16)((x1 * si + x2 * co) * 0.125f); }
#pragma unroll
        for (int e = 0; e < 8; ++e) { VT[(16 * c + e) * 136 + r] = v1[e]; VT[(16 * c + 8 + e) * 136 + r] = v2[e]; }
        if (h < 5) RS_LOAD(h + 1);
        RET_BAR();
        const float l2g = log1pf(-exp2f(-5.0f - (float)h)) * 1.4426950408889634f;
        h16x8 xw[4];
#pragma unroll
        for (int ks = 0; ks < 4; ++ks) { const h16x8 f = ldsfrag(KT + (16 * dt + fr) * 136 + 32 * ks + 8 * fq); h16x8 wv;
#pragma unroll
            for (int jj = 0; jj < 8; ++jj) { const int j = 32 * ks + 8 * fq + jj; wv[jj] = (h16)exp2f(l2g * (float)(dir == 0 ? 127 - j : j)); }
            xw[ks] = f * wv; }
        h16* rst = WSP(h16, OFF_RST) + ((size_t)((dir * NB + b) * NCH + n) * 6 + h) * 4096;
#pragma unroll
        for (int et = 0; et < 4; ++et) { f32x4 acc = {0.f, 0.f, 0.f, 0.f};
#pragma unroll
            for (int ks = 0; ks < 4; ++ks) acc = MFMA16(xw[ks], ldsfrag(VT + (16 * et + fr) * 136 + 32 * ks + 8 * fq), acc);
            *(h16x4*)(rst + (16 * et + fr) * 64 + 16 * dt + 4 * fq) = pack4(acc); }
    }
#undef RS_LOAD
    __syncthreads();
}
__device__ __forceinline__ void ret_out_block(const Frame& F, int bn) {
    const int n = bn % NCH, b = bn / NCH; const long t0 = (long)b * SEQ + n * 128;
    const int r = F.tid >> 2, c = F.tid & 3, rp = kperm32(r), er = F.tid >> 3, d0 = (F.tid & 7) * 8;
    const h16* rowp = WSP(const h16, WS_R1) + (size_t)(t0 + r) * NPJ; const float* cs = WSP(const float, OFF_ROPE) + (size_t)(n * 128 + r) * 64 + 8 * c;
    const f32x4 c0 = *(const f32x4*)cs, c1 = *(const f32x4*)(cs + 4), s0 = *(const f32x4*)(cs + 32), s1 = *(const f32x4*)(cs + 36);
    const int w = F.wave, fr = F.lane & 15, fq = F.lane >> 4, il = 16 * w + fr;
    const h16* grow = WSP(const h16, WS_R1) + (size_t)(t0 + il) * NPJ + CG + 4 * fq; h16* orow = WSP(h16, OFF_OMIX) + (size_t)(t0 + il) * DM + 4 * fq;
    const h16* st0 = WSP(const h16, OFF_RST) + ((size_t)((0 * NB + b) * NCH + n) * 6) * 4096 + F.tid * 8; const h16* st1 = WSP(const h16, OFF_RST) + ((size_t)((1 * NB + b) * NCH + n) * 6) * 4096 + F.tid * 8;
    h16x8 q1, q2, k1, k2, v1, v2, sf, sb; h16x4 gn[4];
#define RO_LOAD(hh) do { q1 = NTL(h16x8, rowp + CQ + (hh) * 64 + 8 * c); q2 = NTL(h16x8, rowp + CQ + (hh) * 64 + 32 + 8 * c); k1 = NTL(h16x8, rowp + CK + (hh) * 64 + 8 * c); k2 = NTL(h16x8, rowp + CK + (hh) * 64 + 32 + 8 * c); \
        v1 = NTL(h16x8, rowp + CV + (hh) * 64 + 16 * c); v2 = NTL(h16x8, rowp + CV + (hh) * 64 + 16 * c + 8); sf = NTL(h16x8, st0 + (hh) * 4096); sb = NTL(h16x8, st1 + (hh) * 4096); \
        _Pragma("unroll") for (int et_ = 0; et_ < 4; ++et_) gn[et_] = NTL(h16x4, grow + (hh) * 64 + 16 * et_); } while (0)
    RO_LOAD(0);
#pragma unroll 1
    for (int h = 0; h < 6; ++h) {
        LAS h16* Qt = (LAS h16*)(F.lds + (h & 1) * 72704); LAS h16* Kt = Qt + 128 * 72; LAS h16* VT = Kt + 128 * 72; LAS h16* Ff = VT + 64 * 136; LAS h16* Fb = Ff + 64 * 72;
        { h16x8 qa, qb, ka, kb;
#pragma unroll
            for (int e = 0; e < 8; ++e) { const float co = e < 4 ? c0[e] : c1[e - 4], si = e < 4 ? s0[e] : s1[e - 4];
                float x1 = (float)q1[e], x2 = (float)q2[e]; qa[e] = (h16)(x1 * co - x2 * si); qb[e] = (h16)(x1 * si + x2 * co);
                x1 = (float)k1[e]; x2 = (float)k2[e]; ka[e] = (h16)((x1 * co - x2 * si) * 0.125f); kb[e] = (h16)((x1 * si + x2 * co) * 0.125f); }
            *(LAS h16x8*)(Qt + r * 72 + 8 * c) = qa; *(LAS h16x8*)(Qt + r * 72 + 32 + 8 * c) = qb;
            *(LAS h16x8*)(Kt + r * 72 + 8 * c) = ka; *(LAS h16x8*)(Kt + r * 72 + 32 + 8 * c) = kb; }
#pragma unroll
        for (int e = 0; e < 8; ++e) { VT[(16 * c + e) * 136 + rp] = v1[e]; VT[(16 * c + 8 + e) * 136 + rp] = v2[e]; }
        *(LAS h16x8*)(Ff + er * 72 + d0) = sf; *(LAS h16x8*)(Fb + er * 72 + d0) = sb;
        h16x4 gc[4];
#pragma unroll
        for (int et = 0; et < 4; ++et) gc[et] = gn[et];
        if (h < 5) RO_LOAD(h + 1);
        RET_BAR();
        const float l2g = log1pf(-exp2f(-5.0f - (float)h)) * 1.4426950408889634f;
        h16x8 qf[2];
#pragma unroll
        for (int ks = 0; ks < 2; ++ks) qf[ks] = ldsfrag(Qt + il * 72 + 32 * ks + 8 * fq);
        f32x4 s[8];
#pragma unroll
        for (int jt = 0; jt < 8; ++jt) { f32x4 a = {0.f, 0.f, 0.f, 0.f};
#pragma unroll
            for (int ks = 0; ks < 2; ++ks) a = MFMA16(ldsfrag(Kt + (16 * jt + fr) * 72 + 32 * ks + 8 * fq), qf[ks], a);
#pragma unroll
            for (int q = 0; q < 4; ++q) { const int j = 16 * jt + 4 * fq + q; const int dd = il > j ? il - j : j - il; a[q] *= exp2f(l2g * (float)dd); }
            PINV(a); s[jt] = a; }
        f32x4 o[4];
#pragma unroll
        for (int et = 0; et < 4; ++et) o[et] = (f32x4){0.f, 0.f, 0.f, 0.f};
#pragma unroll
        for (int kp = 0; kp < 4; ++kp) { const h16x8 pf = pack8(s[2 * kp], s[2 * kp + 1]);
#pragma unroll
            for (int et = 0; et < 4; ++et) o[et] = MFMA16(ldsfrag(VT + (16 * et + fr) * 136 + 32 * kp + 8 * fq), pf, o[et]); }
        const float gf = exp2f(l2g * (float)(il + 1)), gb = exp2f(l2g * (float)(128 - il));
#pragma unroll
        for (int ks = 0; ks < 2; ++ks) { const h16x8 qff = scalefrag(qf[ks], gf), qfb = scalefrag(qf[ks], gb);
#pragma unroll
            for (int et = 0; et < 4; ++et) { o[et] = MFMA16(ldsfrag(Ff + (16 * et + fr) * 72 + 32 * ks + 8 * fq), qff, o[et]); o[et] = MFMA16(ldsfrag(Fb + (16 * et + fr) * 72 + 32 * ks + 8 * fq), qfb, o[et]); } }
        float ss = 0.f;
#pragma unroll
        for (int et = 0; et < 4; ++et) ss += (o[et][0] * o[et][0] + o[et][1] * o[et][1]) + (o[et][2] * o[et][2] + o[et][3] * o[et][3]);
        ss += __shfl_xor(ss, 16); ss += __shfl_xor(ss, 32);
        const float rs = 1.0f / sqrtf(ss * (1.0f / 64.0f) + EPS);
#pragma unroll
        for (int et = 0; et < 4; ++et) { f32x4 q;
#pragma unroll
            for (int e = 0; e < 4; ++e) q[e] = o[et][e] * rs * siluf_((float)gc[et][e]);
            *(h16x4*)(orow + h * 64 + 16 * et) = pack4(q); }
    }
#undef RO_LOAD
    __syncthreads();
}
#undef RET_BAR

__device__ __forceinline__ void ssd_stage_dt(const Frame& F, const Prm& p, int l, int g, long t0, LAS float* LA, LAS float* DTS) {
    if (F.tid < 128) { const h16* dp = WSP(const h16, WS_R1) + (size_t)(t0 + F.tid) * NPJ + CDT + g * 3;
#pragma unroll
        for (int r = 0; r < 3; ++r) { const float raw = (float)dp[r];
#pragma unroll
            for (int dir = 0; dir < 2; ++dir) { const float dt = softplusf_(raw + inptr(F, 7)[(l * 2 + dir) * 6 + g * 3 + r]); const float la = -dt * __expf(inptr(F, 8)[(l * 2 + dir) * 6 + g * 3 + r]);
                DTS[(dir * 3 + r) * 128 + F.tid] = dt; LA[(dir * 3 + r) * 128 + F.tid] = la; } } }
}
__device__ __forceinline__ void ssd_cumsum(const Frame& F, LAS const float* LAq, float& v0, float& v1, float& c0, float& c1, float& tot) {
    v0 = LAq[2 * F.lane]; v1 = LAq[2 * F.lane + 1]; float s = v0 + v1;
#pragma unroll
    for (int o = 1; o < 64; o <<= 1) { const float t = __shfl_up(s, o); if (F.lane >= o) s += t; }
    c1 = s; c0 = s - v1; tot = __shfl(s, 63);
}
__device__ __forceinline__ void ssd_states_unit(const Frame& F, const Prm& p, int l, int u) {
    const int g = u & 1, bn = u >> 1, n = bn % NCH, b = bn / NCH; const long t0 = (long)b * SEQ + n * 128;
    const h16* proj = WSP(const h16, WS_R1);
    LAS h16* XT = (LAS h16*)F.lds; LAS h16* BT = XT + 3 * 64 * 136; LAS float* LA = (LAS float*)(BT + 128 * 136); LAS float* DTS = LA + 6 * 128; LAS float* WW = DTS + 6 * 128;
    ssd_stage_dt(F, p, l, g, t0, LA, DTS);
    const float* cw = inptr(F, 5) + (size_t)l * 4 * 896; const float* cb = inptr(F, 6) + (size_t)l * 896;
    h16* bcn = ((h16*)((unsigned char*)F.out + OUT_BCN));
    for (int task = F.tid; task < 56 * 16; task += 512) { const int cg = task % 56, r0 = (task / 56) * 8; h16x8 o[8];
        if (cg < 24) { conv_rows8<true>(proj + CXS + g * 192 + 8 * cg, t0, n, r0, cw + g * 192 + 8 * cg, 896, cb + g * 192 + 8 * cg, o);
            LAS h16* d = XT + (cg >> 3) * 64 * 136 + ((cg & 7) * 8) * 136 + r0;
#pragma unroll
            for (int e = 0; e < 8; ++e) *(LAS h16x8*)(d + e * 136) = col_of(o, e);
        } else { const int c8 = (cg - 24) & 15; const bool isB = cg < 40; const int col = (isB ? CBM : CCM) + g * 128 + 8 * c8, ci = (isB ? 384 : 640) + g * 128 + 8 * c8;
            conv_rows8<true>(proj + col, t0, n, r0, cw + ci, 896, cb + ci, o);
#pragma unroll
            for (int r = 0; r < 8; ++r) *(h16x8*)(bcn + (size_t)(t0 + r0 + r) * 512 + (isB ? 0 : 256) + g * 128 + 8 * c8) = o[r];
            if (isB) { LAS h16* d = BT + (8 * c8) * 136 + r0;
#pragma unroll
                for (int e = 0; e < 8; ++e) *(LAS h16x8*)(d + e * 136) = col_of(o, e); } } }
    __syncthreads();
    { h16* xtg = ((h16*)((unsigned char*)F.out + OUT_XTG)) + ((size_t)(b * NCH + n) * 6 + g * 3) * 8192;
#pragma unroll
        for (int k = 0; k < 6; ++k) { const int it = F.tid + 512 * k, rr = it >> 4, c = it & 15; const h16x8 v = *(LAS const h16x8*)(XT + rr * 136 + 8 * c);
            *(h16x4*)(xtg + rr * 128 + kperm32(8 * c)) = __builtin_shufflevector(v, v, 0, 1, 2, 3); *(h16x4*)(xtg + rr * 128 + kperm32(8 * c + 4)) = __builtin_shufflevector(v, v, 4, 5, 6, 7); } }
    if (F.wave < 6) { const int q = F.wave, dir = q / 3, r = q % 3; float v0, v1, c0, c1, tot; ssd_cumsum(F, LA + q * 128, v0, v1, c0, c1, tot);
        const float d0 = DTS[q * 128 + 2 * F.lane], d1 = DTS[q * 128 + 2 * F.lane + 1];
        if (dir == 0) { WW[q * 128 + 2 * F.lane] = __expf(tot - c0) * d0 * 256.f; WW[q * 128 + 2 * F.lane + 1] = __expf(tot - c1) * d1 * 256.f; }
        else { WW[q * 128 + 2 * F.lane] = __expf(c0 - v0) * d0 * 256.f; WW[q * 128 + 2 * F.lane + 1] = __expf(c1 - v1) * d1 * 256.f; }
        if (F.lane == 0) WSP(float, OFF_SDEC)[((size_t)(b * NCH + n) * 6 + g * 3 + r) * 2 + dir] = tot; }
    __syncthreads();
    const int w = F.wave, fr = F.lane & 15, fq = F.lane >> 4;
    h16x8 xb[4];
#pragma unroll
    for (int ks = 0; ks < 4; ++ks) xb[ks] = ldsfrag(BT + (16 * w + fr) * 136 + 32 * ks + 8 * fq);
    for (int q = 0; q < 6; ++q) { const int dir = q / 3, r = q % 3;
        h16x8 wf[4];
#pragma unroll
        for (int ks = 0; ks < 4; ++ks) { const f32x4 a = *(LAS const f32x4*)(WW + q * 128 + 32 * ks + 8 * fq), c = *(LAS const f32x4*)(WW + q * 128 + 32 * ks + 8 * fq + 4); wf[ks] = pack8(a, c); }
        h16* sst = WSP(h16, OFF_SST) + ((size_t)((dir * NB + b) * NCH + n) * 6 + g * 3 + r) * 8192;
#pragma unroll
        for (int pt = 0; pt < 4; ++pt) { f32x4 acc = {0.f, 0.f, 0.f, 0.f};
#pragma unroll
            for (int ks = 0; ks < 4; ++ks) acc = MFMA16(xb[ks], ldsfrag(XT + r * 64 * 136 + (16 * pt + fr) * 136 + 32 * ks + 8 * fq) * wf[ks], acc);
            *(h16x4*)(sst + (16 * pt + fr) * 128 + 16 * w + 4 * fq) = pack4(acc * (1.0f / 256.f)); } }
    __syncthreads();
}
__device__ __forceinline__ void ssd_scan_unit(const Frame& F, int u) {
    const int hd = u % 6, b = (u / 6) % NB, dir = u / (6 * NB);
    h16* base = WSP(h16, OFF_SST) + ((size_t)((dir * NB + b) * NCH) * 6 + hd) * 8192 + F.tid * 16;
    const float* dbase = WSP(const float, OFF_SDEC) + ((size_t)(b * NCH) * 6 + hd) * 2 + dir;
    float acc[16];
#pragma unroll
    for (int e = 0; e < 16; ++e) acc[e] = 0.f;
#pragma unroll 1
    for (int q = 0; q < 4; ++q) { h16x8 s0[4], s1[4]; float dec[4];
#pragma unroll
        for (int i = 0; i < 4; ++i) { const int ii = 4 * q + i, n = dir == 0 ? ii : NCH - 1 - ii; s0[i] = *(const h16x8*)(base + (size_t)n * 6 * 8192); s1[i] = *(const h16x8*)(base + (size_t)n * 6 * 8192 + 8); dec[i] = dbase[n * 12]; }
#pragma unroll
        for (int i = 0; i < 4; ++i) { const int ii = 4 * q + i, n = dir == 0 ? ii : NCH - 1 - ii; const float dc = __expf(dec[i]); h16x8 o0, o1;
#pragma unroll
            for (int e = 0; e < 8; ++e) { o0[e] = (h16)acc[e]; o1[e] = (h16)acc[8 + e]; acc[e] = acc[e] * dc + (float)s0[i][e]; acc[8 + e] = acc[8 + e] * dc + (float)s1[i][e]; }
            *(h16x8*)(base + (size_t)n * 6 * 8192) = o0; *(h16x8*)(base + (size_t)n * 6 * 8192 + 8) = o1; } }
}
__device__ __forceinline__ void ssd_out_unit(const Frame& F, const Prm& p, int l, int u) {
    const int g = u & 1, bn = u >> 1, n = bn % NCH, b = bn / NCH; const long t0 = (long)b * SEQ + n * 128;
    const h16* proj = WSP(const h16, WS_R1);
    LAS h16* XT = (LAS h16*)F.lds; LAS h16* Bt = XT + 3 * 64 * 136; LAS h16* Ct = Bt + 128 * 136; LAS float* LA = (LAS float*)(Ct + 128 * 136); LAS float* DTS = LA + 6 * 128;
    LAS float* CE = DTS + 6 * 128;
    LAS float* TOTB = CE + 6 * 128;
    ssd_stage_dt(F, p, l, g, t0, LA, DTS);
    const float* cw = inptr(F, 5) + (size_t)l * 4 * 896; const float* cb = inptr(F, 6) + (size_t)l * 896;
    { const h16* xtg = ((const h16*)((const unsigned char*)F.out + OUT_XTG)) + ((size_t)(b * NCH + n) * 6 + g * 3) * 8192; const h16* bcn = ((const h16*)((const unsigned char*)F.out + OUT_BCN)) + (size_t)t0 * 512 + g * 128;
        h16x8 xv[6], bv[8];
#pragma unroll
        for (int k = 0; k < 6; ++k) { const int it = F.tid + 512 * k; xv[k] = NTL(h16x8, xtg + (it >> 4) * 128 + 8 * (it & 15)); }
#pragma unroll
        for (int k = 0; k < 8; ++k) { const int it = F.tid + 512 * k, row = it >> 5, c = it & 31; bv[k] = NTL(h16x8, bcn + (size_t)row * 512 + (c < 16 ? 8 * c : 256 + 8 * (c - 16))); }
#pragma unroll
        for (int k = 0; k < 6; ++k) { const int it = F.tid + 512 * k; *(LAS h16x8*)(XT + (it >> 4) * 136 + 8 * (it & 15)) = xv[k]; }
#pragma unroll
        for (int k = 0; k < 8; ++k) { const int it = F.tid + 512 * k, row = it >> 5, c = it & 31; *(LAS h16x8*)((c < 16 ? Bt : Ct) + row * 136 + 8 * (c & 15)) = bv[k]; }
        PIN(); }
    __syncthreads();
    if (F.wave < 6) { const int q = F.wave; float v0, v1, c0, c1, tot; ssd_cumsum(F, LA + q * 128, v0, v1, c0, c1, tot);
        if (q < 3) { CE[q * 128 + 2 * F.lane] = c0; CE[q * 128 + 2 * F.lane + 1] = c1; }
        else { CE[q * 128 + 2 * F.lane] = c0 - v0; CE[q * 128 + 2 * F.lane + 1] = c1 - v1; if (F.lane == 0) TOTB[q - 3] = tot; } }
    __syncthreads();
    const int w = F.wave, fr = F.lane & 15, fq = F.lane >> 4, il = 16 * w + fr;
    h16x8 cf[4];
#pragma unroll
    for (int ks = 0; ks < 4; ++ks) cf[ks] = ldsfrag(Ct + il * 136 + 32 * ks + 8 * fq);
    f32x4 gT[8];
#pragma unroll
    for (int jt = 0; jt < 8; ++jt) { f32x4 a = {0.f, 0.f, 0.f, 0.f};
#pragma unroll
        for (int ks = 0; ks < 4; ++ks) a = MFMA16(ldsfrag(Bt + (16 * jt + fr) * 136 + 32 * ks + 8 * fq), cf[ks], a);
        PINV(a); gT[jt] = a; }
    const float* dsk = inptr(F, 9) + l * 6 + g * 3;
    h16* orow = WSP(h16, OFF_OMIX) + (size_t)(t0 + il) * DM + 384 + g * 192;
    float ss = 0.f;
    { h16x8 h0[4];
#pragma unroll
        for (int k = 0; k < 4; ++k) { const int it = F.tid + 512 * k, dir = it >> 10, e = it & 1023; h0[k] = NTL(h16x8, WSP(const h16, OFF_SST) + ((size_t)((dir * NB + b) * NCH + n) * 6 + g * 3) * 8192 + e * 8); }
        __syncthreads();
#pragma unroll
        for (int k = 0; k < 4; ++k) { const int it = F.tid + 512 * k, dir = it >> 10, e = it & 1023; *(LAS h16x8*)(Bt + dir * 64 * 136 + (e >> 4) * 136 + 8 * (e & 15)) = h0[k]; }
        __syncthreads(); }
#pragma unroll 1
    for (int r = 0; r < 3; ++r) {
        f32x4 y[1][4];
        const int hd = g * 3 + r;
        const float cfi = CE[r * 128 + il], ebi = CE[(3 + r) * 128 + il], totb = TOTB[r];
#pragma unroll
        for (int pt = 0; pt < 4; ++pt) y[0][pt] = (f32x4){0.f, 0.f, 0.f, 0.f};
        LAS const h16* HL = (r & 1) ? Ct : Bt;
        h16x8 hreg[4];
        if (r < 2) {
#pragma unroll
            for (int k = 0; k < 4; ++k) { const int it = F.tid + 512 * k, dir = it >> 10, e = it & 1023; hreg[k] = NTL(h16x8, WSP(const h16, OFF_SST) + ((size_t)((dir * NB + b) * NCH + n) * 6 + hd + 1) * 8192 + e * 8); } }
#pragma unroll
        for (int kp = 0; kp < 4; ++kp) { f32x4 pv[2];
#pragma unroll
            for (int jh = 0; jh < 2; ++jh) { const int jt = 2 * kp + jh, j0 = 16 * jt + 4 * fq;
                const f32x4 cfj = *(LAS const f32x4*)(CE + r * 128 + j0), ebj = *(LAS const f32x4*)(CE + (3 + r) * 128 + j0), dfj = *(LAS const f32x4*)(DTS + r * 128 + j0), dbj = *(LAS const f32x4*)(DTS + (3 + r) * 128 + j0);
#pragma unroll
                for (int e = 0; e < 4; ++e) { const int j = j0 + e; const float val = (il >= j) ? __expf(cfi - cfj[e]) * dfj[e] : __expf(ebj[e] - ebi) * dbj[e]; pv[jh][e] = gT[jt][e] * val * 256.f; }
                PINV(pv[jh]); }
            const h16x8 pf = pack8(pv[0], pv[1]);
#pragma unroll
            for (int pt = 0; pt < 4; ++pt) y[0][pt] = MFMA16(ldsfrag(XT + r * 64 * 136 + (16 * pt + fr) * 136 + 32 * kp + 8 * fq), pf, y[0][pt]);
            PINV(y[0][0]); PINV(y[0][1]); PINV(y[0][2]); PINV(y[0][3]); }
        const float ef = __expf(cfi) * 256.f, eb = __expf(totb - ebi) * 256.f;
#pragma unroll
        for (int ks = 0; ks < 4; ++ks) { const h16x8 cff = scalefrag(cf[ks], ef), cfb = scalefrag(cf[ks], eb);
#pragma unroll
            for (int pt = 0; pt < 4; ++pt) { y[0][pt] = MFMA16(ldsfrag(HL + (16 * pt + fr) * 136 + 32 * ks + 8 * fq), cff, y[0][pt]); y[0][pt] = MFMA16(ldsfrag(HL + 64 * 136 + (16 * pt + fr) * 136 + 32 * ks + 8 * fq), cfb, y[0][pt]); }
            PINV(y[0][0]); PINV(y[0][1]); PINV(y[0][2]); PINV(y[0][3]); }
        if (r < 2) { LAS h16* HN = (r & 1) ? Bt : Ct;
#pragma unroll
            for (int k = 0; k < 4; ++k) { const int it = F.tid + 512 * k, dir = it >> 10, e = it & 1023; *(LAS h16x8*)(HN + dir * 64 * 136 + (e >> 4) * 136 + 8 * (e & 15)) = hreg[k]; } }
        const float dk = dsk[r]; const h16* zrow = proj + (size_t)(t0 + il) * NPJ + CZ + hd * 64;
#pragma unroll
        for (int pt = 0; pt < 4; ++pt) { const h16x4 zv = NTL(h16x4, zrow + 16 * pt + 4 * fq);
#pragma unroll
            for (int e = 0; e < 4; ++e) { const float xv = (float)XT[r * 64 * 136 + (16 * pt + 4 * fq + e) * 136 + kperm32(il)]; y[0][pt][e] = (y[0][pt][e] * (1.0f / 256.f) + dk * xv) * siluf_((float)zv[e]); }
            const h16x4 yh = pack4(y[0][pt]); *(h16x4*)(orow + r * 64 + 16 * pt + 4 * fq) = yh;
#pragma unroll
            for (int e = 0; e < 4; ++e) { const float q = (float)yh[e]; ss += q * q; } }
        __syncthreads();
    }
    ss += __shfl_xor(ss, 16); ss += __shfl_xor(ss, 32);
    const float rs = 1.0f / sqrtf(ss * (1.0f / 192.0f) + EPS);
    const float* nw = inptr(F, 10) + l * 384 + g * 192;
    asm volatile("s_waitcnt vmcnt(0)" ::: "memory");
#pragma unroll 1
    for (int r = 0; r < 3; ++r)
#pragma unroll
        for (int pt = 0; pt < 4; ++pt) { const f32x4 wv = *(const f32x4*)(nw + r * 64 + 16 * pt + 4 * fq); h16* op = orow + r * 64 + 16 * pt + 4 * fq; const h16x4 yh = *(const h16x4*)op; f32x4 yv;
#pragma unroll
            for (int e = 0; e < 4; ++e) yv[e] = (float)yh[e] * rs * wv[e];
            *(h16x4*)op = pack4(yv); }
    __syncthreads();
}

__device__ __forceinline__ void lru_unit(const Frame& F, const Prm& p, int l, int u) {
    const int n = u % NCH, b = u / NCH; const long t0 = (long)b * SEQ + n * 128;
    const h16* proj = WSP(const h16, WS_R1);
    LAS h16* XC = (LAS h16*)F.lds;
    const float* cw = inptr(F, 11) + (size_t)l * 4 * 256; const float* cb = inptr(F, 12) + (size_t)l * 256;
    { const int cg = F.tid & 31, r0 = (F.tid >> 5) * 8; h16x8 o[8];
        conv_rows8<false>(proj + CXR + 8 * cg, t0, n, r0, cw + 8 * cg, 256, cb + 8 * cg, o);
#pragma unroll
        for (int r = 0; r < 8; ++r) *(LAS h16x8*)(XC + (r0 + r) * 264 + 8 * cg) = o[r]; }
    __syncthreads();
    const int blk = F.wave & 3, jh = F.wave >> 2, fr = F.lane & 15, fq = F.lane >> 4;
    h16* lau = (h16*)((unsigned char*)F.out + OUT_LAU) + (size_t)(b * NCH + n) * 2 * 128 * 256 * 2;
    h16x8 wa[2][2][2], wx[2][2][2]; float ba[2][2], bx[2][2], sp[2][2], car[2][2], atot[2][2];
#pragma unroll
    for (int dir = 0; dir < 2; ++dir)
#pragma unroll
        for (int jt = 0; jt < 2; ++jt) { const int ch = blk * 64 + 32 * jh + 16 * jt + fr;
#pragma unroll
            for (int ks = 0; ks < 2; ++ks) { wa[dir][jt][ks] = *(const h16x8*)(WSP(const h16, WS_LRUW) + (size_t)((dir * 2 + 0) * 4 + blk) * 4096 + (32 * jh + 16 * jt + fr) * 64 + 32 * ks + 8 * fq);
                wx[dir][jt][ks] = *(const h16x8*)(WSP(const h16, WS_LRUW) + (size_t)((dir * 2 + 1) * 4 + blk) * 4096 + (32 * jh + 16 * jt + fr) * 64 + 32 * ks + 8 * fq); }
            ba[dir][jt] = inptr(F, 15)[(l * 2 + dir) * 256 + ch]; bx[dir][jt] = inptr(F, 17)[(l * 2 + dir) * 256 + ch]; sp[dir][jt] = softplusf_(-inptr(F, 13)[(l * 2 + dir) * 256 + ch]);
            car[dir][jt] = 0.f; atot[dir][jt] = 1.f; }
#pragma unroll 1
    for (int ti = 0; ti < 8; ++ti) {
#pragma unroll
        for (int dir = 0; dir < 2; ++dir) { const int tt = dir == 0 ? ti : 7 - ti;
            h16x8 xf[2];
#pragma unroll
            for (int ks = 0; ks < 2; ++ks) xf[ks] = ldsfrag(XC + (16 * tt + fr) * 264 + blk * 64 + 32 * ks + 8 * fq);
#pragma unroll
            for (int jt = 0; jt < 2; ++jt) { const int ch = blk * 64 + 32 * jh + 16 * jt + fr;
                f32x4 ra = {0.f, 0.f, 0.f, 0.f}, ia = {0.f, 0.f, 0.f, 0.f};
#pragma unroll
                for (int ks = 0; ks < 2; ++ks) { ra = MFMA16(xf[ks], wa[dir][jt][ks], ra); ia = MFMA16(xf[ks], wx[dir][jt][ks], ia); }
                float A = 1.f, H = 0.f;
#pragma unroll
                for (int ri = 0; ri < 4; ++ri) { const int rg = dir == 0 ? ri : 3 - ri;
                    const float e1 = 1.0f + __expf(-(ra[rg] + ba[dir][jt])), e2 = 1.0f + __expf(-(ia[rg] + bx[dir][jt])); const float inv = __builtin_amdgcn_rcpf(e1 * e2);
                    const float rgate = inv * e2, ig = inv * e1;
                    const float la = -8.0f * rgate * sp[dir][jt]; const float a = __expf(la); const float y = 2.0f * la;
                    const float om = y > -0.1f ? -y * (1.0f + y * (0.5f + y * (1.0f / 6.0f))) : 1.0f - a * a;
                    const float mult = __builtin_amdgcn_sqrtf(om);
                    const float xv = (float)XC[(16 * tt + 4 * fq + rg) * 264 + ch]; const float uu = mult * ig * xv;
                    H = a * H + uu; A *= a;
                    { h16x2 pk; pk[0] = (h16)la; pk[1] = (h16)uu; *(h16x2*)(lau + ((size_t)dir * 128 + 16 * tt + 4 * fq + rg) * 256 * 2 + 2 * ch) = pk; } }
                float Ag[4], Hg[4];
#pragma unroll
                for (int gq = 0; gq < 4; ++gq) { Ag[gq] = __shfl(A, fr + 16 * gq); Hg[gq] = __shfl(H, fr + 16 * gq); }
                float cnew = car[dir][jt], at = 1.f;
#pragma unroll
                for (int gi = 0; gi < 4; ++gi) { const int gq = dir == 0 ? gi : 3 - gi;
                    cnew = Ag[gq] * cnew + Hg[gq]; at *= Ag[gq]; }
                car[dir][jt] = cnew; atot[dir][jt] *= at;
            } } }
    if (fq == 0) {
#pragma unroll
        for (int dir = 0; dir < 2; ++dir)
#pragma unroll
            for (int jt = 0; jt < 2; ++jt) { const int ch = blk * 64 + 32 * jh + 16 * jt + fr; *(f32x2*)(WSP(float, OFF_LSUM) + (((size_t)(b * NCH + n) * 2 + dir) * 256 + ch) * 2) = (f32x2){atot[dir][jt], car[dir][jt]}; } }
    __syncthreads();
}
__device__ __forceinline__ void lru_out_unit(const Frame& F, int u) {
    const int n = u % NCH, b = u / NCH; const long t0 = (long)b * SEQ + n * 128;
    const h16* proj = WSP(const h16, WS_R1);
    LAS h16* HT = (LAS h16*)F.lds;
    const int blk = F.wave & 3, jh = F.wave >> 2, fr = F.lane & 15, fq = F.lane >> 4;
    const h16* lau = (const h16*)((const unsigned char*)F.out + OUT_LAU) + (size_t)(b * NCH + n) * 2 * 128 * 256 * 2;
    float car[2][2];
#pragma unroll
    for (int dir = 0; dir < 2; ++dir)
#pragma unroll
        for (int jt = 0; jt < 2; ++jt) car[dir][jt] = WSP(const float, OFF_LCAR)[((size_t)(b * NCH + n) * 2 + dir) * 256 + blk * 64 + 32 * jh + 16 * jt + fr];
#pragma unroll 1
    for (int ti = 0; ti < 8; ++ti) {
#pragma unroll
        for (int dir = 0; dir < 2; ++dir) { const int tt = dir == 0 ? ti : 7 - ti;
            h16x2 pk[2][4]; h16 gtv[2][4], ov[2][4];
#pragma unroll
            for (int jt = 0; jt < 2; ++jt)
#pragma unroll
                for (int rg = 0; rg < 4; ++rg) { const int tl = 16 * tt + 4 * fq + rg, ch = blk * 64 + 32 * jh + 16 * jt + fr;
                    pk[jt][rg] = NTL(h16x2, lau + ((size_t)dir * 128 + tl) * 256 * 2 + 2 * ch); gtv[jt][rg] = NTL(h16, proj + (size_t)(t0 + tl) * NPJ + CGT + ch); ov[jt][rg] = ti >= 4 ? HT[tl * 264 + ch] : (h16)0.f; }
#pragma unroll
            for (int jt = 0; jt < 2; ++jt) { const int ch = blk * 64 + 32 * jh + 16 * jt + fr;
                float av[4], uv[4]; float A = 1.f, H = 0.f;
#pragma unroll
                for (int ri = 0; ri < 4; ++ri) { const int rg = dir == 0 ? ri : 3 - ri; const float a = __expf((float)pk[jt][rg][0]); const float uu = (float)pk[jt][rg][1]; av[rg] = a; uv[rg] = uu; H = a * H + uu; A *= a; }
                float Ag[4], Hg[4];
#pragma unroll
                for (int gq = 0; gq < 4; ++gq) { Ag[gq] = __shfl(A, fr + 16 * gq); Hg[gq] = __shfl(H, fr + 16 * gq); }
                float hin = car[dir][jt], cnew = car[dir][jt];
#pragma unroll
                for (int gi = 0; gi < 4; ++gi) { const int gq = dir == 0 ? gi : 3 - gi; const bool before = dir == 0 ? (gq < fq) : (gq > fq);
                    if (before) hin = Ag[gq] * hin + Hg[gq];
                    cnew = Ag[gq] * cnew + Hg[gq]; }
                car[dir][jt] = cnew;
                float hh = hin;
#pragma unroll
                for (int ri = 0; ri < 4; ++ri) { const int rg = dir == 0 ? ri : 3 - ri; hh = av[rg] * hh + uv[rg];
                    HT[(16 * tt + 4 * fq + rg) * 264 + ch] = (h16)((float)ov[jt][rg] + hh * gelu_tanh_((float)gtv[jt][rg])); } } } }
    __syncthreads();
#pragma unroll
    for (int k = 0; k < 8; ++k) { const int it = F.tid + 512 * k, row = it >> 5, c8 = it & 31; *(h16x8*)(WSP(h16, OFF_OMIX) + (size_t)(t0 + row) * DM + 768 + 8 * c8) = *(LAS const h16x8*)(HT + row * 264 + 8 * c8); }
    __syncthreads();
}
__device__ __forceinline__ void lru_scan(const Frame& F) {
    const int gi = (int)blockIdx.x * 512 + F.tid; if (gi >= NB * 2 * 256) return;
    const int ch = gi & 255, dir = (gi >> 8) & 1, b = gi >> 9; float H = 0.f;
    for (int i = 0; i < NCH; ++i) { const int n = dir == 0 ? i : NCH - 1 - i; const size_t idx = ((size_t)(b * NCH + n) * 2 + dir) * 256 + ch;
        const f32x2 s = *(const f32x2*)(WSP(const float, OFF_LSUM) + idx * 2); WSP(float, OFF_LCAR)[idx] = H; H = s[0] * H + s[1]; }
}

__device__ __forceinline__ void attn_phase(const Frame& F) {
    constexpr int NU = NB * 4 * 8;
    LAS unsigned char* B0 = F.lds; LAS unsigned char* B1 = F.lds + 67584;
    int u = F.vcu; if (u >= NU) return;
    int lanel = F.lane; asm volatile("" : "+v"(lanel)); int fr = lanel & 15, fq = lanel >> 4;
    const int w = F.wave;
    h16x8 qf[2][8];
#define AT_DMA(buf, src, rowstride) do { asm volatile("" : "+v"(lanel)); if (lanel < 32) { _Pragma("unroll") for (int i_ = 0; i_ < 16; ++i_) \
        __builtin_amdgcn_global_load_lds((const unsigned*)((src) + (size_t)(16 * w + i_) * (rowstride) + 8 * lanel), (LAS unsigned*)((buf) + (16 * w + i_) * 528), 16, 0, 0); } } while (0)
#define AT_FRAG(buf, row, chunk) (*(LAS const h16x8*)((buf) + (row) * 528 + (chunk) * 16))
#define AT_WAITBAR() do { asm volatile("s_waitcnt vmcnt(0) lgkmcnt(0)" ::: "memory"); __builtin_amdgcn_s_barrier(); asm volatile("" ::: "memory"); } while (0)
#define AT_LOADQ(uu) do { _Pragma("unroll") for (int a_ = 0; a_ < 2; ++a_) { const long t_ = (long)((uu) >> 5) * SEQ + ((uu) & 7) * 256 + 32 * w + 16 * a_ + fr; const h16* q_ = WSP(const h16, OFF_QCA) + (size_t)t_ * DM + (((uu) >> 3) & 3) * 256; \
        _Pragma("unroll") for (int ks_ = 0; ks_ < 8; ++ks_) qf[a_][ks_] = NTL(h16x8, q_ + 32 * ks_ + 8 * fq); } } while (0)
    { const int b = u >> 5, hd = (u >> 3) & 3; AT_DMA(B0, WSP(const h16, OFF_KB) + (size_t)(b * 256) * DM + hd * 256, DM); }
    for (; u < NU; u += F.G) {
        const int qb = u & 7, hd = (u >> 3) & 3, b = u >> 5; const int un = u + F.G; const bool has_next = un < NU;
        asm volatile("" : "+v"(lanel)); fr = lanel & 15; fq = lanel >> 4;
        const h16* kb = WSP(const h16, OFF_KB) + (size_t)(b * 256) * DM + hd * 256; const h16* vt = WSP(const h16, OFF_VT) + (size_t)(b * 4 + hd) * 65536;
        AT_LOADQ(u);
        h16x8 pf[2][8]; float mq[2][4], Mr[2] = {-3.0e38f, -3.0e38f}, Lr[2] = {0.f, 0.f};
#pragma unroll
        for (int h = 0; h < 2; ++h) {
            AT_WAITBAR();
            if (h == 0) AT_DMA(B1, kb + (size_t)128 * DM, DM); else AT_DMA(B0, vt, 256);
            LAS const unsigned char* KB_ = h == 0 ? B0 : B1;
#pragma unroll
            for (int jh = 0; jh < 2; ++jh) { const int qd = 2 * h + jh; f32x4 s[2][4]; h16x8 kf[2][4];
#pragma unroll
                for (int j4 = 0; j4 < 4; ++j4) { s[0][j4] = (f32x4){0.f, 0.f, 0.f, 0.f}; s[1][j4] = (f32x4){0.f, 0.f, 0.f, 0.f}; kf[0][j4] = AT_FRAG(KB_, 16 * (4 * jh + j4) + fr, fq); }
#pragma unroll
                for (int ks = 0; ks < 8; ++ks) {
                    if (ks < 7) {
#pragma unroll
                        for (int j4 = 0; j4 < 4; ++j4) kf[(ks + 1) & 1][j4] = AT_FRAG(KB_, 16 * (4 * jh + j4) + fr, 4 * (ks + 1) + fq); }
                    PIN();
#pragma unroll
                    for (int j4 = 0; j4 < 4; ++j4) { s[0][j4] = MFMA16(kf[ks & 1][j4], qf[0][ks], s[0][j4]); s[1][j4] = MFMA16(kf[ks & 1][j4], qf[1][ks], s[1][j4]); }
                    PINV(s[0][0]); PINV(s[1][3]); }
#pragma unroll
                for (int a = 0; a < 2; ++a) { float mx = fmaxf(fmaxf(s[a][0][0], s[a][0][1]), fmaxf(s[a][0][2], s[a][0][3]));
#pragma unroll
                    for (int jt = 1; jt < 4; ++jt) mx = fmaxf(mx, fmaxf(fmaxf(s[a][jt][0], s[a][jt][1]), fmaxf(s[a][jt][2], s[a][jt][3])));
                    mx = fmaxf(mx, __shfl_xor(mx, 16)); mx = fmaxf(mx, __shfl_xor(mx, 32));
                    float sum = 0.f;
#pragma unroll
                    for (int jt = 0; jt < 4; ++jt)
#pragma unroll
                        for (int e = 0; e < 4; ++e) { const float pe = __expf(s[a][jt][e] - mx); s[a][jt][e] = pe; sum += pe; }
                    sum += __shfl_xor(sum, 16); sum += __shfl_xor(sum, 32);
                    mq[a][qd] = mx; { const float Mn = fmaxf(Mr[a], mx); Lr[a] = Lr[a] * __expf(Mr[a] - Mn) + sum * __expf(mx - Mn); Mr[a] = Mn; }
                    pf[a][2 * qd] = pack8(s[a][0], s[a][1]); pf[a][2 * qd + 1] = pack8(s[a][2], s[a][3]); } }
        }
#pragma unroll
        for (int a = 0; a < 2; ++a) { const float inv = 1.0f / Lr[a];
#pragma unroll
            for (int q = 0; q < 4; ++q) { const float cq = __expf(mq[a][q] - Mr[a]) * inv; pf[a][2 * q] = scalefrag(pf[a][2 * q], cq); pf[a][2 * q + 1] = scalefrag(pf[a][2 * q + 1], cq); } }
#pragma unroll
        for (int d = 0; d < 2; ++d) {
            AT_WAITBAR();
            if (d == 0) AT_DMA(B1, vt + (size_t)128 * 256, 256);
            else if (has_next) AT_DMA(B0, WSP(const h16, OFF_KB) + (size_t)((un >> 5) * 256) * DM + ((un >> 3) & 3) * 256, DM);
            LAS const unsigned char* VB_ = d == 0 ? B0 : B1;
#pragma unroll
            for (int eh = 0; eh < 2; ++eh) { f32x4 o[2][4]; h16x8 vf[2][4];
#pragma unroll
                for (int e4 = 0; e4 < 4; ++e4) { o[0][e4] = (f32x4){0.f, 0.f, 0.f, 0.f}; o[1][e4] = (f32x4){0.f, 0.f, 0.f, 0.f}; vf[0][e4] = AT_FRAG(VB_, 16 * (4 * eh + e4) + fr, fq); }
#pragma unroll
                for (int kp = 0; kp < 8; ++kp) {
                    if (kp < 7) {
#pragma unroll
                        for (int e4 = 0; e4 < 4; ++e4) vf[(kp + 1) & 1][e4] = AT_FRAG(VB_, 16 * (4 * eh + e4) + fr, 4 * (kp + 1) + fq); }
                    PIN();
#pragma unroll
                    for (int e4 = 0; e4 < 4; ++e4) { o[0][e4] = MFMA16(vf[kp & 1][e4], pf[0][kp], o[0][e4]); o[1][e4] = MFMA16(vf[kp & 1][e4], pf[1][kp], o[1][e4]); }
                    PINV(o[0][0]); PINV(o[1][3]); }
#pragma unroll
                for (int a = 0; a < 2; ++a) { const long t = (long)b * SEQ + qb * 256 + 32 * w + 16 * a + fr; h16* orow = WSP(h16, OFF_OATT) + (size_t)t * DM + hd * 256 + 128 * d + 64 * eh;
#pragma unroll
                    for (int e4 = 0; e4 < 4; ++e4) *(h16x4*)(orow + 16 * e4 + 4 * fq) = pack4(o[a][e4]); } }
        }
    }
    asm volatile("s_waitcnt vmcnt(0) lgkmcnt(0)" ::: "memory");
    __syncthreads();
#undef AT_DMA
#undef AT_FRAG
#undef AT_WAITBAR
#undef AT_LOADQ
}

__device__ __forceinline__ void phase_router(const Frame& F, const Prm& p, int l) {
    LAS h16* RW = (LAS h16*)F.lds;
    { const h16* rwg = WSP(const h16, OFF_RWG);
        for (int i = F.tid; i < 72 * 1032 / 8; i += 512) *(LAS h16x8*)(RW + 8 * i) = *(const h16x8*)(rwg + 8 * i); }
    LAS unsigned* hist = (LAS unsigned*)(F.lds + 72 * 1032 * 2);
    if (F.tid < 32) hist[F.tid] = 0u;
    if (F.G == 256) { for (int i = (int)blockIdx.x * 512 + F.tid; i < MAXSLOT; i += 256 * 512) WSP(int, OFF_STOK)[i] = 0; }
    else if (blockIdx.x == 0) { for (int i = F.tid; i < MAXSLOT; i += 512) WSP(int, OFF_STOK)[i] = 0; }
    __syncthreads();
    const int gw = F.vcu * 8 + F.wave, NGW = F.G * 8, fr = F.lane & 15, fq = F.lane >> 4;
    for (int tg = gw; tg < NT / 16; tg += NGW) {
        const int tok = tg * 16 + fr;
        const h16* hp = WSP(const h16, WS_HB) + (size_t)tok * DM + 8 * fq;
        f32x4 acc[3]; LAS const h16* wrow[3];
#pragma unroll
        for (int mt = 0; mt < 3; ++mt) { acc[mt] = (f32x4){0.f, 0.f, 0.f, 0.f}; const int j = (16 * mt + fr) < 36 ? (16 * mt + fr) : 35; wrow[mt] = RW + j * 1032 + 8 * fq; }
#pragma unroll
        for (int half = 0; half < 2; ++half) { h16x8 hf[16];
#pragma unroll
            for (int q = 0; q < 16; ++q) hf[q] = *(const h16x8*)(hp + 32 * (16 * half + q));
#pragma unroll
            for (int q = 0; q < 16; ++q) { const int ks = 16 * half + q;
#pragma unroll
                for (int mt = 0; mt < 3; ++mt) { acc[mt] = MFMA16(ldsfrag(wrow[mt] + 32 * ks), hf[q], acc[mt]); acc[mt] = MFMA16(ldsfrag(wrow[mt] + 36 * 1032 + 32 * ks), hf[q], acc[mt]); } } }
#pragma unroll
        for (int mt = 0; mt < 3; ++mt) acc[mt] *= (1.0f / 1024.0f);
        const float rs = row_rstd(WSP(const float, WS_SSQ) + (size_t)tok * 16);
        float gl[4];
#pragma unroll
        for (int r = 0; r < 4; ++r) gl[r] = __shfl(acc[0][r], fr) * rs + inptr(F, 25)[l * 4 + r];
        int gi = 0; float gmx = gl[0];
#pragma unroll
        for (int j = 1; j < 4; ++j) if (gl[j] > gmx) { gmx = gl[j]; gi = j; }
        float gsum = 0.f;
#pragma unroll
        for (int j = 0; j < 4; ++j) gsum += __expf(gl[j] - gmx);
        const float gp = 1.0f / gsum;
        const int src1 = fr + 16 * (1 + 2 * (gi & 1)), src2 = fr + 16 * (2 - 2 * (gi & 1)), mt1 = gi >> 1, mt2 = (gi + 1) >> 1;
        float el[8];
#pragma unroll
        for (int k = 0; k < 4; ++k) { const float a0 = __shfl(acc[0][k], src1), a1 = __shfl(acc[1][k], src1); el[k] = (mt1 ? a1 : a0) * rs + inptr(F, 27)[l * 32 + gi * 8 + k];
            const float b0 = __shfl(acc[0][k], src2), b1 = __shfl(acc[1][k], src2), b2 = __shfl(acc[2][k], src2); el[4 + k] = (mt2 == 0 ? b0 : (mt2 == 1 ? b1 : b2)) * rs + inptr(F, 27)[l * 32 + gi * 8 + 4 + k]; }
        int e1 = 0; float m1 = el[0];
#pragma unroll
        for (int j = 1; j < 8; ++j) if (el[j] > m1) { m1 = el[j]; e1 = j; }
        int e2 = -1; float m2 = -3.0e38f;
#pragma unroll
        for (int j = 0; j < 8; ++j) if (j != e1 && el[j] > m2) { m2 = el[j]; e2 = j; }
        const float r2 = __expf(m2 - m1); const float g1 = gp / (1.0f + r2), g2 = gp * r2 / (1.0f + r2);
        if (fq == 0) { const int x1 = gi * 8 + e1, x2 = gi * 8 + e2;
            *(int2*)(WSP(int, OFF_EID) + (size_t)tok * 2) = make_int2(x1, x2); *(f32x2*)(WSP(float, OFF_GATE) + (size_t)tok * 2) = (f32x2){g1, g2};
            WSP(float, OFF_RSTDT)[tok] = rs; __hip_atomic_fetch_add(&hist[x1], 1u, __ATOMIC_RELAXED, __HIP_MEMORY_SCOPE_WORKGROUP); __hip_atomic_fetch_add(&hist[x2], 1u, __ATOMIC_RELAXED, __HIP_MEMORY_SCOPE_WORKGROUP); }
    }
    __syncthreads();
    if (F.tid < 32 && hist[F.tid]) atomicAdd(WSP(unsigned, WS_CTL) + CW_COUNTS + l * 64 + F.tid, hist[F.tid]);
    __syncthreads();
}
__device__ __forceinline__ void phase_dispatch(const Frame& F, int l) {
    LAS int* cnt = (LAS int*)F.lds; LAS int* base = cnt + 32; LAS int* pstart = base + 32; LAS int* slots = pstart + 40;
    unsigned* ctl = WSP(unsigned, WS_CTL);
    for (int blk = F.vcu; blk < NT / 128; blk += F.G) {
        __syncthreads();
        if (F.tid < 32) cnt[F.tid] = 0;
        if (F.tid == 32) { int acc = 0; for (int e = 0; e < 32; ++e) { pstart[e] = acc; acc += (int)((ctl[CW_COUNTS + l * 64 + e] + 255u) & ~255u); } pstart[32] = acc; }
        __syncthreads();
        int e = 0, rank = 0, tok = 0;
        if (F.tid < 256) { tok = blk * 128 + (F.tid >> 1); e = WSP(const int, OFF_EID)[(size_t)tok * 2 + (F.tid & 1)]; rank = __hip_atomic_fetch_add(&cnt[e], 1, __ATOMIC_RELAXED, __HIP_MEMORY_SCOPE_WORKGROUP); }
        __syncthreads();
        if (F.tid < 32) base[F.tid] = cnt[F.tid] ? (int)atomicAdd(&ctl[CW_CURSOR + l * 64 + F.tid], (unsigned)cnt[F.tid]) : 0;
        __syncthreads();
        if (F.tid < 256) { const int slot = pstart[e] + base[e] + rank; slots[F.tid] = slot; WSP(int, OFF_TSLOT)[(size_t)tok * 2 + (F.tid & 1)] = slot; WSP(float, OFF_SRSTD)[slot] = WSP(const float, OFF_RSTDT)[tok]; WSP(int, OFF_STOK)[slot] = tok; }
        __syncthreads();
        if (blk == 0 && F.tid == 0) { const int ntl = pstart[32] >> 8; ctl[CW_NTILES + l] = (unsigned)ntl; int* te = WSP(int, OFF_TILEE);
            for (int e2 = 0; e2 < 32; ++e2) for (int tl = pstart[e2] >> 8; tl < (pstart[e2 + 1] >> 8); ++tl) te[tl] = e2; }
    }
    __syncthreads();
}
__device__ __forceinline__ void phase_combine(const Frame& F, const Prm& p, int l) {
    const int gw = F.vcu * 8 + F.wave, NGW = F.G * 8;
    const bool last = (l == NLAYER - 1);
    for (int tk0 = gw * 4; tk0 < NT; tk0 += NGW * 4) {
        int2 sl[4]; f32x2 gt[4];
#pragma unroll
        for (int q = 0; q < 4; ++q) { sl[q] = *(const int2*)(WSP(const int, OFF_TSLOT) + (size_t)(tk0 + q) * 2); gt[q] = *(const f32x2*)(WSP(const float, OFF_GATE) + (size_t)(tk0 + q) * 2); }
        f32x4 v[4][4]; h16x4 ya[4][4], yb[4][4];
#pragma unroll
        for (int q = 0; q < 4; ++q) { const h16* hrow = WSP(const h16, WS_HB) + (size_t)(tk0 + q) * DM; const h16* y0 = WSP(const h16, OFF_YP) + (size_t)sl[q].x * DM; const h16* y1 = WSP(const h16, OFF_YP) + (size_t)sl[q].y * DM;
#pragma unroll
            for (int j = 0; j < 4; ++j) { const int c = 4 * F.lane + 256 * j; const h16x4 hv = *(const h16x4*)(hrow + c); v[q][j] = (f32x4){(float)hv[0], (float)hv[1], (float)hv[2], (float)hv[3]}; ya[q][j] = __builtin_nontemporal_load((const h16x4*)(y0 + c)); yb[q][j] = __builtin_nontemporal_load((const h16x4*)(y1 + c)); } }
#pragma unroll
        for (int q = 0; q < 4; ++q) { float s = 0.f;
#pragma unroll
            for (int j = 0; j < 4; ++j) {
#pragma unroll
                for (int e = 0; e < 4; ++e) v[q][j][e] += gt[q][0] * (float)ya[q][j][e] + gt[q][1] * (float)yb[q][j][e];
                if (!last) { const h16x4 o = pack4(v[q][j]); v[q][j] = (f32x4){(float)o[0], (float)o[1], (float)o[2], (float)o[3]}; }
                s += (v[q][j][0] * v[q][j][0] + v[q][j][1] * v[q][j][1]) + (v[q][j][2] * v[q][j][2] + v[q][j][3] * v[q][j][3]); }
            s = wave_sum(s);
            if (!last) {
#pragma unroll
                for (int j = 0; j < 4; ++j) { const int c = 4 * F.lane + 256 * j; *(h16x4*)(WSP(h16, WS_HB) + (size_t)(tk0 + q) * DM + c) = pack4(v[q][j]);
                    if (F8_HB) *(unsigned*)((unsigned char*)F.out + OUT_HB8 + (size_t)(tk0 + q) * DM + c) = cvt4_fp8(v[q][j][0], v[q][j][1], v[q][j][2], v[q][j][3]); }
                if (F.lane < 16) WSP(float, WS_SSQ)[(size_t)(tk0 + q) * 16 + F.lane] = (F.lane == 0) ? s : 0.f;
                if (F.lane == 0) WSP(float, OFF_RSTDT)[tk0 + q] = 1.0f / sqrtf(s * (1.0f / DM) + EPS);
            } else { const float rs = 1.0f / sqrtf(s * (1.0f / DM) + EPS); float* orow = F.out + (size_t)(tk0 + q) * DM;
#pragma unroll
                for (int j = 0; j < 4; ++j) { const int c = 4 * F.lane + 256 * j; const f32x4 gf = *(const f32x4*)(inptr(F, 31) + c); *(f32x4*)(orow + c) = v[q][j] * rs * gf; } } }
    }
}

__global__ void __launch_bounds__(512, 2) fwd(Prm p) {
    extern __shared__ __attribute__((aligned(16))) unsigned char lds_raw[];
    Frame F; F.lds = (LAS unsigned char*)lds_raw; F.ws = (GAS unsigned char*)p.ws; F.out = p.out;
    F.tid = threadIdx.x; F.lane = F.tid & 63; F.wave = __builtin_amdgcn_readfirstlane(F.tid >> 6);
    F.G = gridDim.x; { const int bx = blockIdx.x; F.vcu = (F.G % 8 == 0) ? (bx % 8) * (F.G / 8) + bx / 8 : bx; }
    volatile LAS unsigned* misc = (volatile LAS unsigned*)(F.lds + LDS_MISC);
    if (F.tid < 4) misc[F.tid] = 0u;
    F.ptab = (volatile LAS unsigned long long*)(F.lds + LDS_MISC + 64);
    if (F.tid < 32) F.ptab[F.tid] = (unsigned long long)p.in[F.tid];
    __syncthreads();
    const int lo = p.ph_lo, hi = p.ph_hi;
    XcdBarrier bar; bar.bar = WSP(unsigned, WS_CTL) + CW_BAR; bar.x = 0; bar.st = misc;
    if (hi - lo > 1) bar = xcd_barrier_post(WSP(unsigned, WS_CTL) + CW_BAR, misc);
#ifndef UMASK
#define UMASK 7
#endif
#ifndef REPMASK
#define REPMASK 0
#endif
#ifndef PHMASK
#define PHMASK 0x3fff
#endif
#define IN(k) (((PHMASK >> ((k) % NPH)) & 1) && lo <= (k) && (k) < hi && (launder(F), true))
#define REPS(k) (((REPMASK >> (k)) & 1) ? 2 : 1)
#define INR(k) (lo <= (k) && (k) < hi)
#ifndef AMPMASK
#define AMPMASK 0
#endif
    unsigned long long tprev = AMPMASK ? __builtin_amdgcn_s_memrealtime() : 0ull;
#define SEAM(k) do { if (INR(k) && INR((k) + 1)) { xcd_barrier(bar); if (AMPMASK) { const unsigned long long tn = __builtin_amdgcn_s_memrealtime(); \
        if ((AMPMASK >> ((k) % NPH)) & 1) { const unsigned long long tgt = tn + 4ull * (tn - tprev); while (__builtin_amdgcn_s_memrealtime() < tgt) __builtin_amdgcn_s_sleep(8); } \
        tprev = __builtin_amdgcn_s_memrealtime(); } } } while (0)
    for (int l = 0; l < NLAYER; ++l) {
        const int pb = l * NPH;
        if (IN(pb + 0)) for (int rep = 0; rep < REPS(0); ++rep) { phase_convert(F, p, l); } SEAM(pb + 0);
        if (REPS(20) == 2 && INR(pb + 0) && INR(pb + 1)) { for (int q = 0; q < 20; ++q) xcd_barrier(bar); }
        if (IN(pb + 1)) for (int rep = 0; rep < REPS(1); ++rep) {
            if (UMASK & 1) { pg8::StaticOrder S; S.init(NT, NPJ, F.G, (int)blockIdx.x); pg8::EpiScale16C E{WSP(h16, WS_R1), NPJ, WSP(const float, OFF_RSTDT), F8_PROJ ? 1.0f / 256.0f : 1.0f};
#if F8_PROJ
              pg8::Gemm g{(const h16*)((const unsigned char*)F.out + OUT_HB8), WSP(const h16, WS_WIN), DM / 2, DM / 2, DM / 2, nullptr}; pg8::gemm_phase<pg8::EpiScale16C, pg8::StaticOrder, false, 1>(F.lds, F.tid, g, S, E);
#else
              pg8::Gemm g{WSP(const h16, WS_HB), WSP(const h16, WS_WIN), DM, DM, DM, nullptr}; pg8::gemm_phase(F.lds, F.tid, g, S, E);
#endif
            }
        } SEAM(pb + 1);
        if (IN(pb + 2)) for (int rep = 0; rep < REPS(2); ++rep) {
            if (UMASK & 1) for (int r2 = 0; r2 < REPS(17); ++r2) for (int u = blockIdx.x; u < NB * NCH * 2; u += F.G) ssd_states_unit(F, p, l, u);
            launder(F);
            if (UMASK & 2) for (int r2 = 0; r2 < REPS(18); ++r2) for (int u = blockIdx.x; u < NB * NCH; u += F.G) ret_states_block(F, u);
            launder(F);
            if (UMASK & 4) for (int r2 = 0; r2 < REPS(19); ++r2) for (int u = blockIdx.x; u < NB * NCH; u += F.G) lru_unit(F, p, l, u);
        } SEAM(pb + 2);
        if (IN(pb + 3)) for (int rep = 0; rep < REPS(3); ++rep) {
            const bool split = (F.G == 256); const int GS = split ? 128 : F.G;
            if (!split || blockIdx.x < 128) {
                for (int u = blockIdx.x; u < 2 * NB * 6; u += GS) ssd_scan_unit(F, u);
                launder(F);
                for (int u = blockIdx.x; u < 2 * NB * 6; u += GS) ret_scan_unit(F, u);
                lru_scan(F); }
            launder(F);
            if (!split || blockIdx.x >= 128) {
                pg8::Gemm g{WSP(const h16, WS_MEM16), WSP(const h16, WS_WKV), DM, DM, DM, nullptr}; pg8::StaticOrder S; S.init(NTM, 2048, GS, split ? (int)blockIdx.x - 128 : (int)blockIdx.x);
                pg8::EpiKV E{WSP(h16, OFF_KB), WSP(h16, OFF_VT), WSP(const float, OFF_MSSQ)}; pg8::gemm_phase(F.lds, F.tid, g, S, E); }
        } SEAM(pb + 3);
        if (IN(pb + 4)) for (int rep = 0; rep < REPS(4); ++rep) {
            if (UMASK & 1) for (int r2 = 0; r2 < REPS(14); ++r2) for (int u = blockIdx.x; u < NB * NCH * 2; u += F.G) ssd_out_unit(F, p, l, u);
            launder(F);
            if (UMASK & 2) for (int r2 = 0; r2 < REPS(15); ++r2) for (int u = blockIdx.x; u < NB * NCH; u += F.G) ret_out_block(F, u);
            launder(F);
            if (UMASK & 4) for (int r2 = 0; r2 < REPS(16); ++r2) for (int u = blockIdx.x; u < NB * NCH; u += F.G) lru_out_unit(F, u);
        } SEAM(pb + 4);
        if (IN(pb + 5)) for (int rep = 0; rep < REPS(5); ++rep) { pg8::Gemm g{WSP(const h16, OFF_OMIX), WSP(const h16, WS_WOUT), DM, DM, DM, nullptr}; pg8::StaticOrder S; S.init(NT, DM, F.G, (int)blockIdx.x);
            pg8::EpiResid E{WSP(h16, WS_HB), WSP(float, WS_SSQ), (unsigned char*)F.out + OUT_HB8}; pg8::gemm_phase(F.lds, F.tid, g, S, E); } SEAM(pb + 5);
        if (IN(pb + 6)) for (int rep = 0; rep < REPS(6); ++rep) { pg8::StaticOrder S; S.init(NT, DM, F.G, (int)blockIdx.x); pg8::EpiScale16 E{WSP(h16, OFF_QCA), DM, WSP(const float, WS_SSQ), F8_Q ? 1.0f / 4096.0f : 1.0f};
#if F8_Q
            pg8::Gemm g{(const h16*)((const unsigned char*)F.out + OUT_HB8), WSP(const h16, WS_WQ), DM / 2, DM / 2, DM / 2, nullptr}; pg8::gemm_phase<pg8::EpiScale16, pg8::StaticOrder, false, 1>(F.lds, F.tid, g, S, E);
#else
            pg8::Gemm g{WSP(const h16, WS_HB), WSP(const h16, WS_WQ), DM, DM, DM, nullptr}; pg8::gemm_phase(F.lds, F.tid, g, S, E);
#endif
            } SEAM(pb + 6);
        if (IN(pb + 7)) for (int rep = 0; rep < REPS(7); ++rep) { attn_phase(F); } SEAM(pb + 7);
        if (IN(pb + 8)) for (int rep = 0; rep < REPS(8); ++rep) { pg8::Gemm g{WSP(const h16, OFF_OATT), WSP(const h16, WS_WO), DM, DM, DM, nullptr}; pg8::StaticOrder S; S.init(NT, DM, F.G, (int)blockIdx.x);
            pg8::EpiResid E{WSP(h16, WS_HB), WSP(float, WS_SSQ), (unsigned char*)F.out + OUT_HB8}; pg8::gemm_phase(F.lds, F.tid, g, S, E); } SEAM(pb + 8);
        if (IN(pb + 9)) for (int rep = 0; rep < REPS(9); ++rep) { phase_router(F, p, l); } SEAM(pb + 9);
        if (IN(pb + 10)) for (int rep = 0; rep < REPS(10); ++rep) { phase_dispatch(F, l); } SEAM(pb + 10);
        if (IN(pb + 11)) for (int rep = 0; rep < REPS(11); ++rep) {
            pg8::GroupOrder S{WSP(const int, OFF_TILEE), __builtin_amdgcn_readfirstlane((int)WSP(const unsigned, WS_CTL)[CW_NTILES + l]), F.G, F.vcu}; pg8::EpiGated E{WSP(h16, OFF_HP), WSP(const float, OFF_SRSTD), F8_UP ? 1.0f / 256.0f : 1.0f};
#if F8_UP
            pg8::Gemm g{(const h16*)((const unsigned char*)F.out + OUT_HB8), WSP(const h16, WS_W13), DM / 2, DM / 2, DM / 2, WSP(const int, OFF_STOK)}; pg8::gemm_phase<pg8::EpiGated, pg8::GroupOrder, true, 1>(F.lds, F.tid, g, S, E);
#else
            pg8::Gemm g{WSP(const h16, WS_HB), WSP(const h16, WS_W13), DM, DM, DM, WSP(const int, OFF_STOK)}; pg8::gemm_phase<pg8::EpiGated, pg8::GroupOrder, true>(F.lds, F.tid, g, S, E);
#endif
            } SEAM(pb + 11);
        if (IN(pb + 12)) for (int rep = 0; rep < REPS(12); ++rep) {
            pg8::GroupOrder S{WSP(const int, OFF_TILEE), __builtin_amdgcn_readfirstlane((int)WSP(const unsigned, WS_CTL)[CW_NTILES + l]), F.G, F.vcu}; pg8::EpiPlain16 E{WSP(h16, OFF_YP), 1.0f / 4096.0f};
#if F8_DOWN
            pg8::Gemm g{WSP(const h16, OFF_HP), WSP(const h16, WS_W2), 256, 256, 256, nullptr}; pg8::gemm_phase<pg8::EpiPlain16, pg8::GroupOrder, false, 1>(F.lds, F.tid, g, S, E);
#else
            pg8::Gemm g{WSP(const h16, OFF_HP), WSP(const h16, WS_W2), 512, 512, 512, nullptr}; pg8::gemm_phase(F.lds, F.tid, g, S, E);
#endif
            } SEAM(pb + 12);
        if (IN(pb + 13)) for (int rep = 0; rep < REPS(13); ++rep) { phase_combine(F, p, l); } SEAM(pb + 13);
    }
#undef IN
#undef INR
#undef SEAM
}

extern "C" void kernel_launch(void* const* d_in, const int* in_sizes, int n_in, void* d_out, int out_size, void* d_ws, size_t ws_size, hipStream_t stream) {
    static int grid = 0;
    if (grid == 0) {
        if (n_in != 32 || out_size != NT * DM || ws_size < WS_END) { fprintf(stderr, "kernel_launch: unexpected shapes / workspace (%d inputs, out %d, ws %zu < %zu)\n", n_in, out_size, ws_size, (size_t)WS_END); grid = -1; return; }
        int dev = 0, cus = 0, per_cu = 0;
        if (hipGetDevice(&dev) != hipSuccess || hipDeviceGetAttribute(&cus, hipDeviceAttributeMultiprocessorCount, dev) != hipSuccess) { grid = -1; return; }
        if (hipFuncSetAttribute((const void*)fwd, hipFuncAttributeMaxDynamicSharedMemorySize, LDS_BYTES) != hipSuccess) { fprintf(stderr, "kernel_launch: hipFuncSetAttribute failed\n"); grid = -1; return; }
        if (hipOccupancyMaxActiveBlocksPerMultiprocessor(&per_cu, (const void*)fwd, 512, LDS_BYTES) != hipSuccess || per_cu < 1) { fprintf(stderr, "kernel_launch: occupancy query says %d\n", per_cu); }
        (void)hipGetLastError();
        grid = cus;
    }
    if (grid < 0) return;
    (void)hipMemsetAsync((char*)d_ws + WS_CTL, 0, CTL_ZERO_BYTES, stream);
    Prm p{};
    for (int i = 0; i < 32; ++i) p.in[i] = (const float*)d_in[i];
    p.out = (float*)d_out; p.ws = (unsigned char*)d_ws;
#if defined(PROBE_PHASE)
    p.ph_lo = 0; p.ph_hi = PROBE_PHASE + 1; hipLaunchKernelGGL(fwd, dim3(grid), dim3(512), LDS_BYTES, stream, p);
    (void)hipMemsetAsync((char*)d_ws + WS_CTL + CW_BAR * 4, 0, XCD_BAR_WORDS * 4, stream);
    p.ph_lo = PROBE_PHASE; p.ph_hi = PROBE_PHASE + 1; hipLaunchKernelGGL(fwd, dim3(grid), dim3(512), LDS_BYTES, stream, p);
    p.ph_lo = PROBE_PHASE + 1; p.ph_hi = NPHASES; hipLaunchKernelGGL(fwd, dim3(grid), dim3(512), LDS_BYTES, stream, p);
#elif MK_SINGLE
    p.ph_lo = 0; p.ph_hi = NPHASES;
    hipLaunchKernelGGL(fwd, dim3(grid), dim3(512), LDS_BYTES, stream, p);
#else
    for (int ph = 0; ph < NPHASES; ++ph) { p.ph_lo = ph; p.ph_hi = ph + 1; hipLaunchKernelGGL(fwd, dim3(grid), dim3(512), LDS_BYTES, stream, p); }
#endif
}
```

```cpp
#include <hip/hip_runtime.h>
#include <cstdio>
#include <cstdint>

#ifndef MK_SINGLE
#define MK_SINGLE 1
#endif

typedef _Float16 h16;
typedef _Float16 h16x2 __attribute__((ext_vector_type(2)));
typedef _Float16 h16x4 __attribute__((ext_vector_type(4)));
typedef _Float16 h16x8 __attribute__((ext_vector_type(8)));
typedef float f32x2 __attribute__((ext_vector_type(2)));
typedef float f32x4 __attribute__((ext_vector_type(4)));
typedef unsigned u32x2 __attribute__((ext_vector_type(2)));
typedef unsigned u32x4 __attribute__((ext_vector_type(4)));
typedef int i32x4 __attribute__((ext_vector_type(4)));
typedef int i32x8 __attribute__((ext_vector_type(8)));
#define LAS __attribute__((address_space(3)))
#define GAS __attribute__((address_space(1)))
#define PIN() do { asm volatile("" ::: "memory"); __builtin_amdgcn_sched_barrier(0); } while (0)
#define PINV(x) asm volatile("" : "+v"(x) :: "memory")
#define NTL(T, p) __builtin_nontemporal_load((const T*)(p))
#ifndef F8_PROJ
#define F8_PROJ 0
#endif
#ifndef F8_Q
#define F8_Q 1
#endif
#ifndef F8_UP
#define F8_UP 1
#endif
#ifndef F8_DOWN
#define F8_DOWN 1
#endif
#ifndef F8_OUT
#define F8_OUT 0
#endif
#ifndef F8_O
#define F8_O 1
#endif
#define F8_HB (F8_PROJ || F8_Q || F8_UP)
#define MFMA16(a, b, c) __builtin_amdgcn_mfma_f32_16x16x32_f16((a), (b), (c), 0, 0, 0)

constexpr int NB = 16, SEQ = 2048, DM = 1024, NT = NB * SEQ, MEML = 256, NTM = NB * MEML, NLAYER = 2;
constexpr int NPJ = 3584;
constexpr int CQ = 0, CK = 384, CV = 768, CG = 1152, CZ = 1536, CXS = 1920, CBM = 2304, CCM = 2560, CXR = 2816, CGT = 3072, CDT = 3328;
constexpr int DIN = 3334, NCH = 16, MAXSLOT = 73728;
constexpr float EPS = 1e-6f;
constexpr int NPH = 14;
constexpr int NPHASES = NLAYER * NPH;

constexpr size_t MiB = (size_t)1 << 20;
constexpr size_t WS_CTL = 0, CTL_ZERO_BYTES = 64 * 1024;
constexpr size_t WS_WIN = 1 * MiB, WS_WOUT = 8 * MiB, WS_WQ = 10 * MiB, WS_WKV = 12 * MiB, WS_WO = 16 * MiB, WS_W13 = 18 * MiB, WS_W2 = 82 * MiB, WS_LRUW = 114 * MiB;
constexpr size_t WS_HB = 115 * MiB;
constexpr size_t WS_R1 = 179 * MiB;
constexpr size_t WS_R2 = 403 * MiB;
constexpr size_t WS_KV = 547 * MiB, WS_MEM16 = 563 * MiB, WS_SSQ = 571 * MiB, WS_MISC = 573 * MiB, WS_END = 577 * MiB;
constexpr size_t OFF_QCA = WS_R1, OFF_OATT = WS_R1 + 64 * MiB, OFF_XP = WS_R1, OFF_HP = WS_R1 + 144 * MiB;
constexpr size_t OFF_OMIX = WS_R2, OFF_RST = WS_R2 + 64 * MiB, OFF_SST = WS_R2 + 88 * MiB, OFF_LSUM = WS_R2 + 136 * MiB, OFF_SDEC = WS_R2 + 137 * MiB, OFF_LCAR = WS_R2 + 138 * MiB, OFF_YP = WS_R2;
constexpr size_t OUT_HB8 = 0;
constexpr size_t OUT_XTG = 0, OUT_BCN = 24 * MiB, OUT_LAU = 56 * MiB;
constexpr size_t OFF_OMIX8 = WS_W13 + 32 * MiB;
static_assert(!F8_OUT || F8_UP, "OMIX8 lives in the space freed by the fp8 expert weights");
constexpr size_t OFF_KB = WS_KV, OFF_VT = WS_KV + 8 * MiB;
constexpr size_t OFF_ROPE = WS_MISC, OFF_MSSQ = WS_MISC + 512 * 1024, OFF_EID = WS_MISC + 768 * 1024, OFF_GATE = WS_MISC + 1024 * 1024, OFF_TSLOT = WS_MISC + 1280 * 1024,
                 OFF_RSTDT = WS_MISC + 1536 * 1024, OFF_SRSTD = WS_MISC + 1664 * 1024, OFF_TILEE = WS_MISC + 2000 * 1024, OFF_STOK = WS_MISC + 2048 * 1024, OFF_RWG = WS_MISC + 2400 * 1024;
constexpr int CW_COUNTS = 64, CW_CURSOR = 192, CW_NTILES = 320, CW_BAR = 4096;

constexpr int LDS_BYTES = 152 * 1024;
constexpr int LDS_MISC = 150 * 1024;

struct Prm { const float* in[32]; float* out; unsigned char* ws; int ph_lo, ph_hi; };

#define XB_TMO      128
#define XB_XCNT(j)  (256  + 64 * (j))
#define XB_XSUB(j)  (1280 + 64 * (j))
#define XB_XGEN(j)  (2304 + 64 * (j))
#define XB_TOP      3328
#define XB_TOPGEN   3392
#define XCD_BAR_WORDS 3456
#define XB_SPIN_CAP (1u << 18)
__device__ __forceinline__ unsigned xb_ld(unsigned* p)              { return __hip_atomic_load(p, __ATOMIC_RELAXED, __HIP_MEMORY_SCOPE_AGENT); }
__device__ __forceinline__ unsigned xb_add(unsigned* p, unsigned v) { return __hip_atomic_fetch_add(p, v, __ATOMIC_RELAXED, __HIP_MEMORY_SCOPE_AGENT); }
__device__ __forceinline__ unsigned xb_xcc_id() { return (unsigned)__builtin_amdgcn_s_getreg((3 << 11) | 20) & 0xFu; }
#define XB_SPIN(cond, bar) do { unsigned _sp = 0; while (cond) { __builtin_amdgcn_s_sleep(1); \
    if ((++_sp & 255u) == 0u) { if (xb_ld(&(bar)[XB_TMO])) break; if (_sp > XB_SPIN_CAP) { atomicAdd(&(bar)[XB_TMO], 1u); break; } } } } while (0)
struct XcdBarrier { unsigned* bar; unsigned x; volatile LAS unsigned* st; };
__device__ __forceinline__ XcdBarrier xcd_barrier_post(unsigned* bar, volatile LAS unsigned* st) {
    XcdBarrier b; b.bar = bar; b.x = xb_xcc_id(); b.st = st;
    if (threadIdx.x == 0) (void)xb_add(&bar[XB_XCNT(b.x)], 1u);
    return b;
}
__device__ __forceinline__ void xcd_barrier_complete(unsigned* bar, unsigned x, unsigned& nloc, unsigned& nx) {
    const unsigned G = gridDim.x * gridDim.y * gridDim.z;
    unsigned sum, cnt, mine, sp = 0u;
    for (;;) {
        sum = 0u; cnt = 0u; mine = 0u;
#pragma unroll
        for (unsigned j = 0; j < 16; ++j) { const unsigned c = xb_ld(&bar[XB_XCNT(j)]); sum += c; cnt += (c > 0u) ? 1u : 0u; mine = (j == x) ? c : mine; }
        if (sum == G) break;
        __builtin_amdgcn_s_sleep(1);
        if ((++sp & 255u) == 0u) { if (xb_ld(&bar[XB_TMO])) break; if (sp > XB_SPIN_CAP) { atomicAdd(&bar[XB_TMO], 1u); break; } }
    }
    nloc = mine > 0u ? mine : 1u; nx = cnt > 0u ? cnt : 1u;
}
__device__ __forceinline__ void xcd_barrier(const XcdBarrier& b) {
    asm volatile("s_waitcnt vmcnt(0)" ::: "memory");
    __syncthreads();
    if (threadIdx.x == 0) {
        unsigned* bar = b.bar;
        __builtin_amdgcn_s_waitcnt(0);
        unsigned nloc = b.st[0], nx = b.st[1];
        if (nloc == 0u) { xcd_barrier_complete(bar, b.x, nloc, nx); b.st[0] = nloc; b.st[1] = nx; }
        const unsigned old = xb_add(&bar[XB_XSUB(b.x)], 1u);
        const unsigned gen = old / nloc;
        if (old + 1u == (gen + 1u) * nloc) {
            __builtin_amdgcn_fence(__ATOMIC_RELEASE, "agent");
            asm volatile("s_waitcnt vmcnt(0)" ::: "memory");
            const unsigned og = xb_add(&bar[XB_TOP], 1u);
            const unsigned tg = og / nx;
            if (og + 1u == (tg + 1u) * nx) xb_add(&bar[XB_TOPGEN], 1u);
            else XB_SPIN(xb_ld(&bar[XB_TOPGEN]) == tg, bar);
            __builtin_amdgcn_fence(__ATOMIC_ACQUIRE, "agent");
            xb_add(&bar[XB_XGEN(b.x)], 1u);
            asm volatile("s_waitcnt vmcnt(0)" ::: "memory");
        } else {
            XB_SPIN(xb_ld(&bar[XB_XGEN(b.x)]) == gen, bar);
            __builtin_amdgcn_fence(__ATOMIC_ACQUIRE, "agent");
            asm volatile("s_waitcnt vmcnt(0)" ::: "memory");
        }
    }
    __syncthreads();
}

__device__ __forceinline__ float wave_sum(float v) {
#pragma unroll
    for (int o = 1; o < 64; o <<= 1) v += __shfl_xor(v, o);
    return v;
}
__device__ __forceinline__ float siluf_(float x) { return x * __builtin_amdgcn_rcpf(1.0f + __expf(-x)); }
__device__ __forceinline__ float softplusf_(float x) { return x > 20.f ? x : log1pf(__expf(x)); }
__device__ __forceinline__ float gelu_tanh_(float x) { const float y = 0.7978845608028654f * (x + 0.044715f * x * x * x); const float t = 1.0f - 2.0f / (__expf(2.0f * y) + 1.0f); return 0.5f * x * (1.0f + t); }
__device__ __forceinline__ h16x8 pack8(const f32x4 a, const f32x4 b) { h16x8 r; r[0] = (h16)a[0]; r[1] = (h16)a[1]; r[2] = (h16)a[2]; r[3] = (h16)a[3]; r[4] = (h16)b[0]; r[5] = (h16)b[1]; r[6] = (h16)b[2]; r[7] = (h16)b[3]; return r; }
__device__ __forceinline__ h16x4 pack4(const f32x4 a) { h16x4 r; r[0] = (h16)a[0]; r[1] = (h16)a[1]; r[2] = (h16)a[2]; r[3] = (h16)a[3]; return r; }
__device__ __forceinline__ unsigned cvt4_fp8(float a, float b, float c, float d) {
    a = __builtin_amdgcn_fmed3f(a, -448.f, 448.f); b = __builtin_amdgcn_fmed3f(b, -448.f, 448.f); c = __builtin_amdgcn_fmed3f(c, -448.f, 448.f); d = __builtin_amdgcn_fmed3f(d, -448.f, 448.f);
    int p = __builtin_amdgcn_cvt_pk_fp8_f32(a, b, 0, false); p = __builtin_amdgcn_cvt_pk_fp8_f32(c, d, p, true); return (unsigned)p; }
__device__ __forceinline__ h16x8 ldsfrag(LAS const h16* p) { return *(LAS const h16x8*)p; }
__device__ __forceinline__ int kperm32(int k) { return (k & ~31) | (((k >> 2) & 3) << 3) | (((k >> 4) & 1) << 2) | (k & 3); }
__device__ __forceinline__ h16x8 scalefrag(const h16x8 f, float s) { const h16 hs = (h16)s; h16x8 v;
#pragma unroll
    for (int j = 0; j < 8; ++j) v[j] = hs; return f * v; }
__device__ __forceinline__ float row_rstd(const float* ssq16) {
    const f32x4 a = *(const f32x4*)ssq16, b = *(const f32x4*)(ssq16 + 4), c = *(const f32x4*)(ssq16 + 8), d = *(const f32x4*)(ssq16 + 12);
    const float s = ((a[0] + a[1]) + (a[2] + a[3])) + ((b[0] + b[1]) + (b[2] + b[3])) + ((c[0] + c[1]) + (c[2] + c[3])) + ((d[0] + d[1]) + (d[2] + d[3]));
    return 1.0f / sqrtf(s * (1.0f / DM) + EPS);
}

namespace pg8 {
constexpr int BM = 256, BK = 64, HALF = 128, HTB = HALF * BK * 2, STAGE_BYTES = 8 * HTB, NXCD = 8, WGM = 8;
__host__ __device__ __forceinline__ int lds_byte(int r, int c) { const int st = (r >> 4) * 2 + (c >> 5), rr = r & 15, cc = c & 31, ob = rr * 64 + cc * 2; return st * 1024 + (ob ^ (((ob >> 9) & 1) << 5)); }
__host__ __device__ __forceinline__ void stage_rc(int b, int& R, int& C) { const int st = b / 1024, sb = b % 1024, swz = sb ^ (((sb >> 9) & 1) << 5); R = (st >> 1) * 16 + swz / 64; C = (st & 1) * 32 + (swz % 64) / 2; }
__host__ __device__ __forceinline__ int perm32(int rho) { const int n = rho >> 4, i = rho & 15; return 8 * (i >> 2) + 4 * n + (i & 3); }
struct Unit { int pm, pn; };
struct Gemm { const h16* A; const h16* Bt; int lda, ldb, K; const int* rowidx; };
struct StaticOrder {
    int nM, nN, nwg, G, c;
    __device__ void init(int M, int N, int G_, int c_) { nM = M / BM; nN = N / BM; nwg = nM * nN; G = G_; c = c_; }
    __device__ bool next(int i, Unit& u) const {
        const long L = (long)i * G + c; if (L >= nwg) return false;
        int wgid = (int)L; { const int q = nwg / NXCD, r = nwg % NXCD, xcd = wgid % NXCD, off = wgid / NXCD; wgid = (xcd < r ? xcd * (q + 1) : r * (q + 1) + (xcd - r) * q) + off; }
        const int nig = WGM * nN, gid = wgid / nig, fm = gid * WGM, gsz = (nM - fm) < WGM ? (nM - fm) : WGM;
        u.pm = fm + ((wgid % nig) % gsz); u.pn = (wgid % nig) / gsz; return true;
    }
};
struct GroupOrder {
    const int* tile_e; int ntiles, G, vcu;
    __device__ bool next(int i, Unit& u) const {
        const int L = i * G + vcu, tile = L >> 2; if (tile >= ntiles) return false;
        u.pm = tile; u.pn = __builtin_amdgcn_readfirstlane(tile_e[tile]) * 4 + (L & 3); return true;
    }
};

struct EpiScale16 {
    static constexpr bool PERM = true;
    h16* O; int ldc; const float* ssq; float cs;
    __device__ __forceinline__ void operator()(const f32x4 (&acc)[2][2][4][2], const Unit& u, int wr, int wc, int fr, int fq) const {
        const int row0 = u.pm * BM + wr * 64 + fr, col0 = u.pn * BM + wc * 32 + 8 * fq;
#pragma unroll
        for (int ai = 0; ai < 2; ++ai)
#pragma unroll
            for (int m = 0; m < 4; ++m) { const int row = row0 + ai * HALF + m * 16; const float rs = row_rstd(ssq + (size_t)row * 16) * cs; h16* rowp = O + (size_t)row * ldc + col0;
#pragma unroll
                for (int bj = 0; bj < 2; ++bj) *(h16x8*)(rowp + bj * HALF) = pack8(acc[ai][bj][m][0] * rs, acc[ai][bj][m][1] * rs); }
    }
};
struct EpiScale16C {
    static constexpr bool PERM = true;
    h16* O; int ldc; const float* rstd; float cs;
    __device__ __forceinline__ void operator()(const f32x4 (&acc)[2][2][4][2], const Unit& u, int wr, int wc, int fr, int fq) const {
        const int row0 = u.pm * BM + wr * 64 + fr, col0 = u.pn * BM + wc * 32 + 8 * fq;
        float rs[2][4];
#pragma unroll
        for (int ai = 0; ai < 2; ++ai)
#pragma unroll
            for (int m = 0; m < 4; ++m) rs[ai][m] = rstd[row0 + ai * HALF + m * 16] * cs;
#pragma unroll
        for (int ai = 0; ai < 2; ++ai)
#pragma unroll
            for (int m = 0; m < 4; ++m) { h16* rowp = O + (size_t)(row0 + ai * HALF + m * 16) * ldc + col0;
#pragma unroll
                for (int bj = 0; bj < 2; ++bj) *(h16x8*)(rowp + bj * HALF) = pack8(acc[ai][bj][m][0] * rs[ai][m], acc[ai][bj][m][1] * rs[ai][m]); }
    }
};
struct EpiKV {
    static constexpr bool PERM = true;
    h16* KB; h16* VT; const float* ssq;
    __device__ __forceinline__ void operator()(const f32x4 (&acc)[2][2][4][2], const Unit& u, int wr, int wc, int fr, int fq) const {
        const int row0 = u.pm * BM + wr * 64 + fr;
#pragma unroll
        for (int ai = 0; ai < 2; ++ai)
#pragma unroll
            for (int m = 0; m < 4; ++m) { const int row = row0 + ai * HALF + m * 16; const float rs = row_rstd(ssq + (size_t)row * 16);
                h16x8 pk[2];
#pragma unroll
                for (int bj = 0; bj < 2; ++bj) pk[bj] = pack8(acc[ai][bj][m][0] * rs, acc[ai][bj][m][1] * rs);
                if (u.pn < 4) { h16* rowp = KB + (size_t)row * DM + u.pn * BM + wc * 32 + 8 * fq;
                    *(h16x8*)rowp = pk[0]; *(h16x8*)(rowp + HALF) = pk[1];
                } else { const int b = row >> 8, k0 = row & 255, hd = u.pn - 4;
                    const int key = (k0 & ~31) | (((k0 >> 2) & 3) << 3) | (((k0 >> 4) & 1) << 2) | (k0 & 3);
                    h16* base = VT + ((size_t)(b * 4 + hd) * 256 + wc * 32 + 8 * fq) * 256 + key;
#pragma unroll
                    for (int bj = 0; bj < 2; ++bj)
#pragma unroll
                        for (int j = 0; j < 8; ++j) base[(bj * HALF + j) * 256] = pk[bj][j]; }
                PIN();
            }
    }
};
struct EpiResid {
    static constexpr bool PERM = true;
    h16* hb; float* ssq; unsigned char* hb8; float cs;
    __device__ __forceinline__ void operator()(const f32x4 (&acc)[2][2][4][2], const Unit& u, int wr, int wc, int fr, int fq) const {
        const int row0 = u.pm * BM + wr * 64 + fr, col0 = u.pn * BM + wc * 32 + 8 * fq;
#pragma unroll
        for (int ai = 0; ai < 2; ++ai)
#pragma unroll
            for (int mp = 0; mp < 2; ++mp) { unsigned ch[2][2][2];
#pragma unroll
                for (int mm = 0; mm < 2; ++mm) { const int m = 2 * mp + mm; const int row = row0 + ai * HALF + m * 16; h16* rowp = hb + (size_t)row * DM + col0; float s = 0.f;
#pragma unroll
                    for (int bj = 0; bj < 2; ++bj) { const h16x8 bv = *(const h16x8*)(rowp + bj * HALF); f32x4 v0, v1;
#pragma unroll
                        for (int e = 0; e < 4; ++e) { v0[e] = (float)bv[e] + acc[ai][bj][m][0][e] * cs; v1[e] = (float)bv[4 + e] + acc[ai][bj][m][1][e] * cs; }
                        const h16x8 o = pack8(v0, v1); *(h16x8*)(rowp + bj * HALF) = o;
                        if (F8_HB) { ch[mm][bj][0] = cvt4_fp8(v0[0], v0[1], v0[2], v0[3]); ch[mm][bj][1] = cvt4_fp8(v1[0], v1[1], v1[2], v1[3]); }
#pragma unroll
                        for (int e = 0; e < 8; ++e) { const float q = (float)o[e]; s += q * q; } }
                    s += __shfl_xor(s, 16); s += __shfl_xor(s, 32);
                    if (fq == 0) ssq[(size_t)row * 16 + u.pn * 4 + wc] = s; }
                if (F8_HB) {
                    const int row = row0 + ai * HALF + (2 * mp + (fq & 1)) * 16; unsigned char* p8 = hb8 + (size_t)row * DM + u.pn * BM + wc * 32 + 8 * (fq & ~1);
#pragma unroll
                    for (int bj = 0; bj < 2; ++bj) { const auto s0 = __builtin_amdgcn_permlane16_swap(ch[0][bj][0], ch[1][bj][0], false, false), s1 = __builtin_amdgcn_permlane16_swap(ch[0][bj][1], ch[1][bj][1], false, false);
                        *(u32x4*)(p8 + bj * HALF) = (u32x4){s0[0], s1[0], s0[1], s1[1]}; } } }
    }
};
struct EpiGated {
    static constexpr bool PERM = true;
    h16* O; const float* srstd; float cs;
    __device__ __forceinline__ void operator()(const f32x4 (&acc)[2][2][4][2], const Unit& u, int wr, int wc, int fr, int fq) const {
        const int row0 = u.pm * BM + wr * 64 + fr, col0 = (u.pn & 3) * HALF + wc * 32 + 8 * fq;
#pragma unroll
        for (int ai = 0; ai < 2; ++ai)
#pragma unroll
            for (int m = 0; m < 4; ++m) { const int row = row0 + ai * HALF + m * 16; const float rs = srstd[row] * cs; f32x4 o[2];
#pragma unroll
                for (int n = 0; n < 2; ++n)
#pragma unroll
                    for (int j = 0; j < 4; ++j) { const float a = acc[ai][0][m][n][j] * rs, b = acc[ai][1][m][n][j] * rs; o[n][j] = siluf_(a) * b; }
                if (F8_DOWN) *(u32x2*)((unsigned char*)O + (size_t)row * 512 + col0) = (u32x2){cvt4_fp8(16.f * o[0][0], 16.f * o[0][1], 16.f * o[0][2], 16.f * o[0][3]), cvt4_fp8(16.f * o[1][0], 16.f * o[1][1], 16.f * o[1][2], 16.f * o[1][3])};
                else *(h16x8*)(O + (size_t)row * 512 + col0) = pack8(o[0], o[1]); }
    }
};
struct EpiPlain16 {
    static constexpr bool PERM = true;
    h16* O; float cs;
    __device__ __forceinline__ void operator()(const f32x4 (&acc)[2][2][4][2], const Unit& u, int wr, int wc, int fr, int fq) const {
        const int row0 = u.pm * BM + wr * 64 + fr, col0 = (u.pn & 3) * BM + wc * 32 + 8 * fq;
#pragma unroll
        for (int ai = 0; ai < 2; ++ai)
#pragma unroll
            for (int m = 0; m < 4; ++m) { h16* rowp = O + (size_t)(row0 + ai * HALF + m * 16) * DM + col0;
#pragma unroll
                for (int bj = 0; bj < 2; ++bj) *(h16x8*)(rowp + bj * HALF) = F8_DOWN ? pack8(acc[ai][bj][m][0] * cs, acc[ai][bj][m][1] * cs) : pack8(acc[ai][bj][m][0], acc[ai][bj][m][1]); }
    }
};

template <class Epi, class Sched, bool GATHER = false, int F8W = 0>
__device__ __forceinline__ void gemm_phase(LAS unsigned char* lds, const int tid, const Gemm g, const Sched& S, const Epi& E) {
    const int wid = __builtin_amdgcn_readfirstlane(tid >> 6), lane = tid & 63, wr = wid >> 2, wc = wid & 3, fr = lane & 15, fq = lane >> 4;
    int K_ = g.K; asm volatile("" : "+s"(K_));
    const int K = K_, nt = K / BK;
    unsigned voffA[2], voffB[2];
#pragma unroll
    for (int i = 0; i < 2; ++i) { int R, C; stage_rc(tid * 16 + i * 8192, R, C); const int Rb = Epi::PERM ? ((R & ~31) + perm32(R & 31)) : R;
        voffA[i] = (unsigned)(R * g.lda + C) * 2u; voffB[i] = (unsigned)(Rb * g.ldb + C) * 2u; }
    const size_t kstep = (size_t)(BK * 2);
    const size_t hstepA = (size_t)HALF * g.lda * 2, hstepB = (size_t)HALF * g.ldb * 2;
    const size_t tstepA = 2 * hstepA, tstepB = 2 * hstepB;
    const unsigned ldsw = (unsigned)wid * 1024u;
    const int aoff = lds_byte(wr * 64 + fr, fq * 8), boff = lds_byte(wc * 32 + fr, fq * 8);
#define PG8_SA(b, h) (((b) * 2 + (h)) * HTB)
#define PG8_SB(b, h) ((4 + (b) * 2 + (h)) * HTB)
#define PG8_STAGE(bufoff, gbase, voff) do { _Pragma("unroll") for (int _i = 0; _i < 2; ++_i) \
        __builtin_amdgcn_global_load_lds((const unsigned*)((const char*)(gbase) + (voff)[_i]), (LAS unsigned*)(lds + (bufoff) + ldsw + _i * 8192), 16, 0, 0); } while (0)
    unsigned coff[2], noff[2], cbyte[2];
    if constexpr (GATHER) {
#pragma unroll
        for (int i = 0; i < 2; ++i) { int R_, C_; stage_rc(tid * 16 + i * 8192, R_, C_); cbyte[i] = (unsigned)(C_ * 2); } }
#define PG8_GOFF(u_, o_) do { _Pragma("unroll") for (int _i = 0; _i < 2; ++_i) { int R_, C_; stage_rc(tid * 16 + _i * 8192, R_, C_); \
        o_[_i] = (unsigned)g.rowidx[(u_).pm * BM + R_] | ((unsigned)g.rowidx[(u_).pm * BM + HALF + R_] << 16); } } while (0)
#define PG8_STAGEA(bufoff, gbase, h, sel) do { if constexpr (GATHER) { _Pragma("unroll") for (int _i = 0; _i < 2; ++_i) { const unsigned pk_ = (sel) ? noff[_i] : coff[_i]; \
        __builtin_amdgcn_global_load_lds((const unsigned*)((const char*)(gbase) + (((pk_ >> (16 * (h))) & 0xffffu) * (unsigned)(g.lda * 2) + cbyte[_i])), (LAS unsigned*)(lds + (bufoff) + ldsw + _i * 8192), 16, 0, 0); } } \
        else { PG8_STAGE(bufoff, (gbase) + ((h) ? hstepA : 0), voffA); } } while (0)
#define PG8_LDA(dst, b, h) do { _Pragma("unroll") for (int m = 0; m < 4; ++m) _Pragma("unroll") for (int k = 0; k < 2; ++k) dst[m][k] = *(const LAS h16x8*)(lds + PG8_SA(b, h) + aoff + m * 2048 + k * 1024); } while (0)
#define PG8_LDB(dst, b, h) do { _Pragma("unroll") for (int n = 0; n < 2; ++n) _Pragma("unroll") for (int k = 0; k < 2; ++k) dst[n][k] = *(const LAS h16x8*)(lds + PG8_SB(b, h) + boff + n * 2048 + k * 1024); } while (0)
#define PG8_MMA(ai, bj, At, Bt) do { __builtin_amdgcn_s_setprio(1); _Pragma("unroll") for (int m = 0; m < 4; ++m) _Pragma("unroll") for (int n = 0; n < 2; ++n) _Pragma("unroll") for (int k = 0; k < 2; ++k) \
        acc[ai][bj][m][n] = __builtin_amdgcn_mfma_f32_16x16x32_f16(Bt[n][k], At[m][k], acc[ai][bj][m][n], 0, 0, 0); __builtin_amdgcn_s_setprio(0); } while (0)
#define PG8_MMA8(ai, bj, At, Bt) do { __builtin_amdgcn_s_setprio(1); _Pragma("unroll") for (int m = 0; m < 4; ++m) _Pragma("unroll") for (int n = 0; n < 2; ++n) { \
        const i32x8 wf_ = __builtin_shufflevector(__builtin_bit_cast(i32x4, Bt[n][0]), __builtin_bit_cast(i32x4, Bt[n][1]), 0, 1, 2, 3, 4, 5, 6, 7), af_ = __builtin_shufflevector(__builtin_bit_cast(i32x4, At[m][0]), __builtin_bit_cast(i32x4, At[m][1]), 0, 1, 2, 3, 4, 5, 6, 7); \
        asm volatile("v_mfma_f32_16x16x128_f8f6f4 %0, %1, %2, %0" : "+v"(acc[ai][bj][m][n]) : "v"(wf_), "v"(af_)); } __builtin_amdgcn_s_setprio(0); } while (0)
#define PG8_MM(ai, bj, At, Bt) do { if constexpr (F8W != 0) PG8_MMA8(ai, bj, At, Bt); else PG8_MMA(ai, bj, At, Bt); } while (0)
#define PG8_WAIT_V(n) asm volatile("s_waitcnt vmcnt(" #n ")" ::: "memory")
#define PG8_WAIT_L(n) asm volatile("s_waitcnt lgkmcnt(" #n ")" ::: "memory")
#define PG8_BAR __builtin_amdgcn_s_barrier()
#define PG8_SCHED __builtin_amdgcn_sched_barrier(0)
    Unit cur, nxt; int ui = 0;
    if (!S.next(0, cur)) return;
    f32x4 acc[2][2][4][2];
#pragma unroll
    for (int a = 0; a < 2; ++a)
#pragma unroll
        for (int b = 0; b < 2; ++b)
#pragma unroll
            for (int m = 0; m < 4; ++m)
#pragma unroll
                for (int n = 0; n < 2; ++n) acc[a][b][m][n] = (f32x4){0.f, 0.f, 0.f, 0.f};
    h16x8 At[4][2], B0[2][2], B1[2][2];
    const char* cA = (const char*)g.A + (GATHER ? (size_t)0 : (size_t)cur.pm * tstepA); const char* cB = (const char*)g.Bt + (size_t)cur.pn * tstepB;
    if constexpr (GATHER) { PG8_GOFF(cur, coff); noff[0] = coff[0]; noff[1] = coff[1]; }
    PG8_STAGE(PG8_SB(0, 0), cB, voffB); PG8_STAGE(PG8_SB(0, 1), cB + hstepB, voffB); PG8_STAGEA(PG8_SA(0, 0), cA, 0, false); PG8_STAGEA(PG8_SA(0, 1), cA, 1, false);
    if (wr == 1) PG8_BAR;
    PG8_WAIT_V(2); PG8_BAR;
    PG8_STAGE(PG8_SB(1, 0), cB + kstep, voffB); PG8_STAGEA(PG8_SA(1, 0), cA + kstep, 0, false); PG8_STAGE(PG8_SB(1, 1), cB + hstepB + kstep, voffB);
    PG8_WAIT_V(6); PG8_BAR;
    for (;;) {
        const bool has_next = S.next(ui + 1, nxt);
        const char* nA = (has_next && !GATHER) ? (const char*)g.A + (size_t)nxt.pm * tstepA : cA; const char* nB = has_next ? (const char*)g.Bt + (size_t)nxt.pn * tstepB : cB;
        if constexpr (GATHER) { if (has_next) PG8_GOFF(nxt, noff); }
        for (int t = 0; t < nt; t += 2) {
            const bool last = (t == nt - 2);
            const char* a1 = cA + (size_t)(t + 1) * kstep;
            const char* a2 = last ? nA : cA + (size_t)(t + 2) * kstep; const char* b2 = last ? nB : cB + (size_t)(t + 2) * kstep;
            const char* a3 = a2 + kstep; const char* b3 = b2 + kstep;
            PG8_LDB(B0, 0, 0); PG8_LDB(B1, 0, 1); PG8_SCHED; PG8_LDA(At, 0, 0); PG8_STAGEA(PG8_SA(1, 1), a1, 1, false);
            PG8_WAIT_V(8); PG8_WAIT_L(0); PG8_BAR; PG8_MM(0, 0, At, B0); PG8_MM(0, 1, At, B1); PG8_BAR; PG8_SCHED;
            PG8_LDA(At, 0, 1); PG8_STAGE(PG8_SB(0, 0), b2, voffB); PG8_STAGE(PG8_SB(0, 1), b2 + hstepB, voffB); PG8_STAGEA(PG8_SA(0, 0), a2, 0, last);
            PG8_WAIT_V(8); PG8_WAIT_L(0); PG8_BAR; PG8_MM(1, 0, At, B0); PG8_MM(1, 1, At, B1); PG8_BAR; PG8_SCHED;
            PG8_LDB(B0, 1, 0); PG8_LDB(B1, 1, 1); PG8_SCHED; PG8_LDA(At, 1, 0); PG8_STAGEA(PG8_SA(0, 1), a2, 1, last);
            PG8_WAIT_V(8); PG8_WAIT_L(0); PG8_BAR; PG8_MM(0, 0, At, B0); PG8_MM(0, 1, At, B1); PG8_BAR; PG8_SCHED;
            PG8_LDA(At, 1, 1); PG8_STAGE(PG8_SB(1, 0), b3, voffB); PG8_STAGE(PG8_SB(1, 1), b3 + hstepB, voffB); PG8_STAGEA(PG8_SA(1, 0), a3, 0, last);
            PG8_WAIT_V(8); PG8_WAIT_L(0); PG8_BAR; PG8_MM(1, 0, At, B0); PG8_MM(1, 1, At, B1); PG8_BAR; PG8_SCHED;
        }
        if (wr == 0) PG8_BAR;
        if constexpr (F8W != 0) asm volatile("s_nop 7\n\ts_nop 7\n\ts_nop 7" ::: "memory");
        E(acc, cur, wr, wc, fr, fq);
        if (!has_next) break;
#pragma unroll
        for (int a = 0; a < 2; ++a)
#pragma unroll
            for (int b = 0; b < 2; ++b)
#pragma unroll
                for (int m = 0; m < 4; ++m)
#pragma unroll
                    for (int n = 0; n < 2; ++n) acc[a][b][m][n] = (f32x4){0.f, 0.f, 0.f, 0.f};
        cur = nxt; cA = nA; cB = nB; ++ui;
        if constexpr (GATHER) { coff[0] = noff[0]; coff[1] = noff[1]; }
        if (wr == 1) PG8_BAR;
    }
    PG8_WAIT_V(0);
    PG8_BAR;
#undef PG8_SA
#undef PG8_SB
#undef PG8_STAGE
#undef PG8_LDA
#undef PG8_GOFF
#undef PG8_STAGEA
#undef PG8_LDB
#undef PG8_MMA
#undef PG8_MMA8
#undef PG8_MM
#undef PG8_WAIT_V
#undef PG8_WAIT_L
#undef PG8_BAR
#undef PG8_SCHED
}
}

struct Frame {
    LAS unsigned char* lds;
    GAS unsigned char* ws;
    volatile LAS unsigned long long* ptab;
    float* out;
    int tid, lane, wave, G, vcu;
};
#define WSP(T, off) ((T*)(GAS T*)(F.ws + (off)))
__device__ __forceinline__ const float* inptr(const Frame& F, int i) {
    const unsigned long long v = F.ptab[i];
    const unsigned lo = __builtin_amdgcn_readfirstlane((unsigned)v), hi = __builtin_amdgcn_readfirstlane((unsigned)(v >> 32));
    return (const float*)(GAS const float*)(((unsigned long long)hi << 32) | lo);
}
__device__ __forceinline__ void launder(Frame& F) {
    int wv = F.wave; asm volatile("" : "+s"(wv)); F.wave = wv;
    unsigned z = 0u; asm volatile("" : "+v"(z));
    int t = wv * 64 + (int)__builtin_amdgcn_mbcnt_hi(~0u, __builtin_amdgcn_mbcnt_lo(~0u, z)); F.tid = t; F.lane = t & 63;
    const unsigned long long w = (unsigned long long)F.ws; unsigned wl = __builtin_amdgcn_readfirstlane((unsigned)w), wh = __builtin_amdgcn_readfirstlane((unsigned)(w >> 32));
    asm volatile("" : "+s"(wl), "+s"(wh)); F.ws = (GAS unsigned char*)(((unsigned long long)wh << 32) | wl);
    unsigned lo = __builtin_amdgcn_readfirstlane((unsigned)(uintptr_t)F.lds); asm volatile("" : "+s"(lo)); F.lds = (LAS unsigned char*)(uintptr_t)lo;
    int v = __builtin_amdgcn_readfirstlane(F.vcu); asm volatile("" : "+s"(v)); F.vcu = v;
}

struct TrItem { const float* W; const float* g; h16* Wt; int ldw, sc, nvalid, ldt, d0, k0, vw, f8; float mul; };
__device__ __forceinline__ void tr_describe(const Frame& F, GAS unsigned char* wsb_, int l, int it, TrItem& d) {
    unsigned char* wsb = (unsigned char*)wsb_;
    int r = it; d.g = nullptr; d.mul = 1.f; d.nvalid = 64; d.vw = 4; d.ldt = DM; d.ldw = DM; d.f8 = 0;
    if (r < 896) { const int d0 = 64 * (r % 56); d.W = inptr(F, 3) + (size_t)l * DM * DIN; d.ldw = DIN; d.g = inptr(F, 2) + l * DM; d.Wt = (h16*)(wsb + WS_WIN); d.d0 = d0; d.k0 = 64 * (r / 56); d.vw = 2; if (F8_PROJ) { d.f8 = 1; d.mul = 256.f; }
        if (d0 < 2816) d.sc = d0; else if (d0 < 3328) d.sc = d0 + 6; else if (d0 == 3328) { d.sc = 2816; d.nvalid = 6; } else { d.sc = 0; d.nvalid = 0; } return; } r -= 896;
    if (r < 256) { d.W = inptr(F, 4) + (size_t)l * DM * DM; if (F8_OUT) { d.f8 = 1; d.mul = 256.f; } d.Wt = (h16*)(wsb + WS_WOUT); d.d0 = d.sc = 64 * (r % 16); d.k0 = 64 * (r / 16); return; } r -= 256;
    if (r < 256) { d.W = inptr(F, 20) + (size_t)l * DM * DM; d.g = inptr(F, 18) + l * DM; d.mul = F8_Q ? 256.f : 0.0625f; d.f8 = F8_Q; d.Wt = (h16*)(wsb + WS_WQ); d.d0 = d.sc = 64 * (r % 16); d.k0 = 64 * (r / 16); return; } r -= 256;
    if (r < 512) { d.W = inptr(F, 21) + (size_t)l * DM * 2048; d.ldw = 2048; d.g = inptr(F, 19) + l * DM; d.Wt = (h16*)(wsb + WS_WKV); d.d0 = d.sc = 64 * (r % 32); d.k0 = 64 * (r / 32); return; } r -= 512;
    if (r < 256) { d.W = inptr(F, 22) + (size_t)l * DM * DM; if (F8_O) { d.f8 = 1; d.mul = 256.f; } d.Wt = (h16*)(wsb + WS_WO); d.d0 = d.sc = 64 * (r % 16); d.k0 = 64 * (r / 16); return; } r -= 256;
    if (r < 8192) { const int e = r / 256, q = r % 256, d0 = 64 * (q % 16), grp = d0 >> 8, rr = d0 & 255;
        d.W = (rr < 128 ? inptr(F, 28) : inptr(F, 29)) + (size_t)(l * 32 + e) * DM * 512; d.ldw = 512; d.sc = grp * 128 + (rr & 127); d.g = inptr(F, 23) + l * DM; d.Wt = (h16*)(wsb + WS_W13 + (size_t)e * DM * DM * (F8_UP ? 1 : 2)); if (F8_UP) { d.f8 = 1; d.mul = 256.f; } d.d0 = d0; d.k0 = 64 * (q / 16); return; } r -= 8192;
    if (r < 4096) { const int e = r / 128, q = r % 128; d.W = inptr(F, 30) + (size_t)(l * 32 + e) * 512 * DM; d.Wt = (h16*)(wsb + WS_W2 + (size_t)e * DM * 512 * (F8_DOWN ? 1 : 2)); if (F8_DOWN) { d.f8 = 1; d.mul = 256.f; } d.ldt = 512; d.d0 = d.sc = 64 * (q % 16); d.k0 = 64 * (q / 16); return; } r -= 4096;
    { const int blk = r & 3, gate = (r >> 2) & 1, dir = r >> 3; d.W = (gate ? inptr(F, 16) : inptr(F, 14)) + (size_t)((l * 2 + dir) * 4 + blk) * 4096; d.ldw = 64; d.Wt = (h16*)(wsb + WS_LRUW) + (size_t)((dir * 2 + gate) * 4 + blk) * 4096; d.ldt = 64; d.d0 = d.sc = 0; d.k0 = 0; }
}
__device__ __forceinline__ void tr_load(const TrItem& d, int lane, f32x4 (&v)[16]) {
    if (d.vw == 4) { const int col = 4 * (lane & 15); const float* src = d.W + (size_t)(d.k0 + (lane >> 4)) * d.ldw + d.sc + col; const bool ok = col < d.nvalid;
#pragma unroll
        for (int i = 0; i < 16; ++i) v[i] = ok ? __builtin_nontemporal_load((const f32x4*)(src + (size_t)(4 * i) * d.ldw)) : (f32x4){0.f, 0.f, 0.f, 0.f};
    } else { const int col = 2 * (lane & 31); const float* src = d.W + (size_t)(d.k0 + (lane >> 5)) * d.ldw + d.sc + col; const bool ok = col < d.nvalid;
#pragma unroll
        for (int i = 0; i < 16; ++i) { const f32x2 a = ok ? __builtin_nontemporal_load((const f32x2*)(src + (size_t)(4 * i) * d.ldw)) : (f32x2){0.f, 0.f}, c = ok ? __builtin_nontemporal_load((const f32x2*)(src + (size_t)(4 * i + 2) * d.ldw)) : (f32x2){0.f, 0.f}; v[i] = (f32x4){a[0], a[1], c[0], c[1]}; } }
}
__device__ __forceinline__ void tr_to_lds(const TrItem& d, int lane, const f32x4 (&v)[16], LAS float* scr) {
    if (d.vw == 4) { LAS float* q = scr + (lane >> 4) * 65 + 4 * (lane & 15);
#pragma unroll
        for (int i = 0; i < 16; ++i) { q[(4 * i) * 65 + 0] = v[i][0]; q[(4 * i) * 65 + 1] = v[i][1]; q[(4 * i) * 65 + 2] = v[i][2]; q[(4 * i) * 65 + 3] = v[i][3]; }
    } else { LAS float* q = scr + (lane >> 5) * 65 + 2 * (lane & 31);
#pragma unroll
        for (int i = 0; i < 16; ++i) { q[(4 * i) * 65 + 0] = v[i][0]; q[(4 * i) * 65 + 1] = v[i][1]; q[(4 * i + 2) * 65 + 0] = v[i][2]; q[(4 * i + 2) * 65 + 1] = v[i][3]; } }
}
__device__ __forceinline__ void tr_from_lds(const TrItem& d, int lane, LAS const float* scr) {
    const int c = lane & 7; float gs[8];
    if (d.g) { const f32x4 g0 = *(const f32x4*)(d.g + d.k0 + 8 * c), g1 = *(const f32x4*)(d.g + d.k0 + 8 * c + 4);
        gs[0] = g0[0] * d.mul; gs[1] = g0[1] * d.mul; gs[2] = g0[2] * d.mul; gs[3] = g0[3] * d.mul; gs[4] = g1[0] * d.mul; gs[5] = g1[1] * d.mul; gs[6] = g1[2] * d.mul; gs[7] = g1[3] * d.mul;
    } else {
#pragma unroll
        for (int e = 0; e < 8; ++e) gs[e] = d.mul; }
    if (d.f8) {
#pragma unroll
        for (int j = 0; j < 8; ++j) { const int nn = (lane >> 3) + 8 * j; LAS const float* q = scr + (8 * c) * 65 + nn; float f[8];
#pragma unroll
            for (int e = 0; e < 8; ++e) f[e] = q[e * 65] * gs[e];
            *(u32x2*)((unsigned char*)d.Wt + (size_t)(d.d0 + nn) * d.ldt + d.k0 + 8 * c) = (u32x2){cvt4_fp8(f[0], f[1], f[2], f[3]), cvt4_fp8(f[4], f[5], f[6], f[7])}; }
        return; }
#pragma unroll
    for (int j = 0; j < 8; ++j) { const int nn = (lane >> 3) + 8 * j; LAS const float* q = scr + (8 * c) * 65 + nn; h16x8 o;
#pragma unroll
        for (int e = 0; e < 8; ++e) o[e] = (h16)(q[e * 65] * gs[e]);
        *(h16x8*)(d.Wt + (size_t)(d.d0 + nn) * d.ldt + d.k0 + 8 * c) = o; }
}
__device__ __forceinline__ void phase_convert(const Frame& F, const Prm& p, int l) {
    LAS float* scr = (LAS float*)(F.lds + F.wave * 16640);
    const int gw = F.vcu * 8 + F.wave, NGW = F.G * 8;
    constexpr int NITEMS = 896 + 256 + 256 + 512 + 256 + 8192 + 4096 + 16;
    { TrItem cur, nxt; f32x4 v[16]; int it = gw;
        if (it < NITEMS) { tr_describe(F, F.ws, l, it, cur); tr_load(cur, F.lane, v); }
        while (it < NITEMS) { const int itn = it + NGW; const bool hn = itn < NITEMS;
            tr_to_lds(cur, F.lane, v, scr);
            if (hn) { tr_describe(F, F.ws, l, itn, nxt); tr_load(nxt, F.lane, v); }
            asm volatile("s_waitcnt lgkmcnt(0)" ::: "memory");
            tr_from_lds(cur, F.lane, scr);
            asm volatile("s_waitcnt lgkmcnt(0)" ::: "memory");
            cur = nxt; it = itn; } }
    {
        const float* gm = inptr(F, 23) + l * DM; const float* wg = inptr(F, 24) + (size_t)l * DM * 4; const float* we = inptr(F, 26) + (size_t)l * DM * 32; h16* rwg = WSP(h16, OFF_RWG);
        for (int i = F.vcu * 512 + F.tid; i < 36 * DM; i += 256 * 512) { const int k = i / 36, j = i % 36; const float wv = gm[k] * (j < 4 ? wg[k * 4 + j] : we[k * 32 + (j - 4)]) * 1024.0f;
            const h16 hi = (h16)wv; rwg[(size_t)j * 1032 + k] = hi; rwg[(size_t)(36 + j) * 1032 + k] = (h16)(wv - (float)hi); } }
    if (l == 0) {
        for (int m = gw; m < NT + NTM; m += NGW) {
            const bool isx = m < NT; const int row = isx ? m : m - NT;
            const float* src = (isx ? inptr(F, 0) : inptr(F, 1)) + (size_t)row * DM; h16* dst = (isx ? WSP(h16, WS_HB) : WSP(h16, WS_MEM16)) + (size_t)row * DM;
            float* sq = (isx ? WSP(float, WS_SSQ) : WSP(float, OFF_MSSQ)) + (size_t)row * 16;
            float s = 0.f;
#pragma unroll
            for (int j = 0; j < 4; ++j) { const f32x4 v = __builtin_nontemporal_load((const f32x4*)(src + 4 * F.lane + 256 * j)); *(h16x4*)(dst + 4 * F.lane + 256 * j) = pack4(v);
                if (F8_HB && isx) *(unsigned*)((unsigned char*)F.out + OUT_HB8 + (size_t)row * DM + 4 * F.lane + 256 * j) = cvt4_fp8(v[0], v[1], v[2], v[3]); s += (v[0] * v[0] + v[1] * v[1]) + (v[2] * v[2] + v[3] * v[3]); }
            s = wave_sum(s);
            if (F.lane < 16) sq[F.lane] = (F.lane == 0) ? s : 0.f;
            if (isx && F.lane == 0) WSP(float, OFF_RSTDT)[row] = 1.0f / sqrtf(s * (1.0f / DM) + EPS);
        }
        float* rope = WSP(float, OFF_ROPE);
        for (int i = F.vcu * 512 + F.tid; i < SEQ * 32; i += F.G * 512) {
            const int pos = i >> 5, fi = i & 31; double th = 1.0;
            for (int k = 0; k < fi; ++k) th *= 0.74989420933245582730;
            const double rev = (double)pos * th * 0.15915494309189533577;
            const double fr = rev - floor(rev);
            const double r = (fr - 0.5) * 6.28318530717958647692;
            const double r2 = r * r; double sn = 1.0, cs = 1.0;
            for (int k = 14; k >= 1; --k) { sn = 1.0 - r2 / (double)((2 * k) * (2 * k + 1)) * sn; cs = 1.0 - r2 / (double)((2 * k - 1) * (2 * k)) * cs; }
            sn *= r;
            rope[pos * 64 + fi] = (float)(-cs); rope[pos * 64 + 32 + fi] = (float)(-sn);
        }
    }
}

template <bool SILU>
__device__ __forceinline__ void conv_rows8(const h16* projcol, long tbase, int n, int r0, const float* cw, int cdim, const float* cb, h16x8 (&out)[8]) {
    f32x4 w[4][2];
#pragma unroll
    for (int k = 0; k < 4; ++k) { w[k][0] = *(const f32x4*)(cw + k * cdim); w[k][1] = *(const f32x4*)(cw + k * cdim + 4); }
    const f32x4 b0 = *(const f32x4*)cb, b1 = *(const f32x4*)(cb + 4);
    h16x8 x[11];
#pragma unroll
    for (int i = 0; i < 11; ++i) { const int pos = n * 128 + r0 - 2 + i; h16x8 z;
#pragma unroll
        for (int e = 0; e < 8; ++e) z[e] = (h16)0.f;
        x[i] = (pos >= 0 && pos < SEQ) ? NTL(h16x8, projcol + (size_t)(tbase + r0 - 2 + i) * NPJ) : z; }
#pragma unroll
    for (int r = 0; r < 8; ++r) {
#pragma unroll
        for (int e = 0; e < 8; ++e) { float a = e < 4 ? b0[e] : b1[e - 4];
#pragma unroll
            for (int k = 0; k < 4; ++k) a += (e < 4 ? w[k][0][e] : w[k][1][e - 4]) * (float)x[r + k][e];
            out[r][e] = (h16)(SILU ? siluf_(a) : a); } }
}
__device__ __forceinline__ h16x8 col_of(const h16x8 (&o)[8], int e) { h16x8 c; c[0] = o[0][e]; c[1] = o[1][e]; c[2] = o[2][e]; c[3] = o[3][e]; c[4] = o[4][e]; c[5] = o[5][e]; c[6] = o[6][e]; c[7] = o[7][e]; return c; }

__device__ __forceinline__ void ret_scan_unit(const Frame& F, int u) {
    const int h = u % 6, b = (u / 6) % NB, dir = u / (6 * NB);
    const float gC = exp2f(128.0f * log1pf(-exp2f(-5.0f - (float)h)) * 1.4426950408889634f);
    h16* base = WSP(h16, OFF_RST) + ((size_t)((dir * NB + b) * NCH) * 6 + h) * 4096 + F.tid * 8;
    float acc[8];
#pragma unroll
    for (int e = 0; e < 8; ++e) acc[e] = 0.f;
#pragma unroll 1
    for (int half = 0; half < 2; ++half) { h16x8 sv[8];
#pragma unroll
        for (int i = 0; i < 8; ++i) { const int ii = 8 * half + i, n = dir == 0 ? ii : NCH - 1 - ii; sv[i] = *(const h16x8*)(base + (size_t)n * 6 * 4096); }
#pragma unroll
        for (int i = 0; i < 8; ++i) { const int ii = 8 * half + i, n = dir == 0 ? ii : NCH - 1 - ii; h16x8 o;
#pragma unroll
            for (int e = 0; e < 8; ++e) { o[e] = (h16)acc[e]; acc[e] = acc[e] * gC + (float)sv[i][e]; }
            *(h16x8*)(base + (size_t)n * 6 * 4096) = o; } }
}
#define RET_BAR() do { asm volatile("s_waitcnt lgkmcnt(0)" ::: "memory"); __builtin_amdgcn_s_barrier(); asm volatile("" ::: "memory"); } while (0)
__device__ __forceinline__ void ret_states_block(const Frame& F, int bn) {
    const int n = bn % NCH, b = bn / NCH; const long t0 = (long)b * SEQ + n * 128;
    const int r = F.tid >> 2, c = F.tid & 3;
    const h16* rowp = WSP(const h16, WS_R1) + (size_t)(t0 + r) * NPJ; const float* cs = WSP(const float, OFF_ROPE) + (size_t)(n * 128 + r) * 64 + 8 * c;
    const f32x4 c0 = *(const f32x4*)cs, c1 = *(const f32x4*)(cs + 4), s0 = *(const f32x4*)(cs + 32), s1 = *(const f32x4*)(cs + 36);
    const int dir = F.wave >> 2, dt = F.wave & 3, fr = F.lane & 15, fq = F.lane >> 4;
    h16x8 k1, k2, v1, v2;
#define RS_LOAD(hh) do { k1 = *(const h16x8*)(rowp + CK + (hh) * 64 + 8 * c); k2 = *(const h16x8*)(rowp + CK + (hh) * 64 + 32 + 8 * c); v1 = *(const h16x8*)(rowp + CV + (hh) * 64 + 16 * c); v2 = *(const h16x8*)(rowp + CV + (hh) * 64 + 16 * c + 8); } while (0)
    RS_LOAD(0);
#pragma unroll 1
    for (int h = 0; h < 6; ++h) {
        LAS h16* KT = (LAS h16*)(F.lds + (h & 1) * 34816); LAS h16* VT = KT + 64 * 136;
#pragma unroll
        for (int e = 0; e < 8; ++e) { const float x1 = (float)k1[e], x2 = (float)k2[e], co = e < 4 ? c0[e] : c1[e - 4], si = e < 4 ? s0[e] : s1[e - 4];
            KT[(8 * c + e) * 136 + r] = (h16)((x1 * co - x2 * si) * 0.125f); KT[(32 + 8 * c + e) * 136 + r] = (h16)((x1 * si + x2 * co) * 0.125f); }
#pragma unroll
        for (int e = 0; e < 8; ++e) { VT[(16 * c + e) * 136 + r] = v1[e]; VT[(16 * c + 8 + e) * 136 + r] = v2[e]; }
        if (h < 5) RS_LOAD(h + 1);
        RET_BAR();
        const float l2g = log1pf(-exp2f(-5.0f - (float)h)) * 1.4426950408889634f;
        h16x8 xw[4];
#pragma unroll
        for (int ks = 0; ks < 4; ++ks) { const h16x8 f = ldsfrag(KT + (16 * dt + fr) * 136 + 32 * ks + 8 * fq); h16x8 wv;
#pragma unroll
            for (int jj = 0; jj < 8; ++jj) { const int j = 32 * ks + 8 * fq + jj; wv[jj] = (h16)exp2f(l2g * (float)(dir == 0 ? 127 - j : j)); }
            xw[ks] = f * wv; }
        h16* rst = WSP(h16, OFF_RST) + ((size_t)((dir * NB + b) * NCH + n) * 6 + h) * 4096;
#pragma unroll
        for (int et = 0; et < 4; ++et) { f32x4 acc = {0.f, 0.f, 0.f, 0.f};
#pragma unroll
            for (int ks = 0; ks < 4; ++ks) acc = MFMA16(xw[ks], ldsfrag(VT + (16 * et + fr) * 136 + 32 * ks + 8 * fq), acc);
            *(h16x4*)(rst + (16 * et + fr) * 64 + 16 * dt + 4 * fq) = pack4(acc); }
    }
#undef RS_LOAD
    __syncthreads();
}
__device__ __forceinline__ void ret_out_block(const Frame& F, int bn) {
    const int n = bn % NCH, b = bn / NCH; const long t0 = (long)b * SEQ + n * 128;
    const int r = F.tid >> 2, c = F.tid & 3, rp = kperm32(r), er = F.tid >> 3, d0 = (F.tid & 7) * 8;
    const h16* rowp = WSP(const h16, WS_R1) + (size_t)(t0 + r) * NPJ; const float* cs = WSP(const float, OFF_ROPE) + (size_t)(n * 128 + r) * 64 + 8 * c;
    const f32x4 c0 = *(const f32x4*)cs, c1 = *(const f32x4*)(cs + 4), s0 = *(const f32x4*)(cs + 32), s1 = *(const f32x4*)(cs + 36);
    const int w = F.wave, fr = F.lane & 15, fq = F.lane >> 4, il = 16 * w + fr;
    const h16* grow = WSP(const h16, WS_R1) + (size_t)(t0 + il) * NPJ + CG + 4 * fq; h16* orow = WSP(h16, OFF_OMIX) + (size_t)(t0 + il) * DM + 4 * fq; unsigned char* orow8 = WSP(unsigned char, OFF_OMIX8) + (size_t)(t0 + il) * DM + 4 * fq;
    const h16* st0 = WSP(const h16, OFF_RST) + ((size_t)((0 * NB + b) * NCH + n) * 6) * 4096 + F.tid * 8; const h16* st1 = WSP(const h16, OFF_RST) + ((size_t)((1 * NB + b) * NCH + n) * 6) * 4096 + F.tid * 8;
    h16x8 q1, q2, k1, k2, v1, v2, sf, sb; h16x4 gn[4];
#define RO_LOAD(hh) do { q1 = NTL(h16x8, rowp + CQ + (hh) * 64 + 8 * c); q2 = NTL(h16x8, rowp + CQ + (hh) * 64 + 32 + 8 * c); k1 = NTL(h16x8, rowp + CK + (hh) * 64 + 8 * c); k2 = NTL(h16x8, rowp + CK + (hh) * 64 + 32 + 8 * c); \
        v1 = NTL(h16x8, rowp + CV + (hh) * 64 + 16 * c); v2 = NTL(h16x8, rowp + CV + (hh) * 64 + 16 * c + 8); sf = NTL(h16x8, st0 + (hh) * 4096); sb = NTL(h16x8, st1 + (hh) * 4096); \
        _Pragma("unroll") for (int et_ = 0; et_ < 4; ++et_) gn[et_] = NTL(h16x4, grow + (hh) * 64 + 16 * et_); } while (0)
    RO_LOAD(0);
#pragma unroll 1
    for (int h = 0; h < 6; ++h) {
        LAS h16* Qt = (LAS h16*)(F.lds + (h & 1) * 72704); LAS h16* Kt = Qt + 128 * 72; LAS h16* VT = Kt + 128 * 72; LAS h16* Ff = VT + 64 * 136; LAS h16* Fb = Ff + 64 * 72;
        { h16x8 qa, qb, ka, kb;
#pragma unroll
            for (int e = 0; e < 8; ++e) { const float co = e < 4 ? c0[e] : c1[e - 4], si = e < 4 ? s0[e] : s1[e - 4];
                float x1 = (float)q1[e], x2 = (float)q2[e]; qa[e] = (h16)(x1 * co - x2 * si); qb[e] = (h16)(x1 * si + x2 * co);
                x1 = (float)k1[e]; x2 = (float)k2[e]; ka[e] = (h16)((x1 * co - x2 * si) * 0.125f); kb[e] = (h16)((x1 * si + x2 * co) * 0.125f); }
            *(LAS h16x8*)(Qt + r * 72 + 8 * c) = qa; *(LAS h16x8*)(Qt + r * 72 + 32 + 8 * c) = qb;
            *(LAS h16x8*)(Kt + r * 72 + 8 * c) = ka; *(LAS h16x8*)(Kt + r * 72 + 32 + 8 * c) = kb; }
#pragma unroll
        for (int e = 0; e < 8; ++e) { VT[(16 * c + e) * 136 + rp] = v1[e]; VT[(16 * c + 8 + e) * 136 + rp] = v2[e]; }
        *(LAS h16x8*)(Ff + er * 72 + d0) = sf; *(LAS h16x8*)(Fb + er * 72 + d0) = sb;
        h16x4 gc[4];
#pragma unroll
        for (int et = 0; et < 4; ++et) gc[et] = gn[et];
        if (h < 5) RO_LOAD(h + 1);
        RET_BAR();
        const float l2g = log1pf(-exp2f(-5.0f - (float)h)) * 1.4426950408889634f;
        h16x8 qf[2];
#pragma unroll
        for (int ks = 0; ks < 2; ++ks) qf[ks] = ldsfrag(Qt + il * 72 + 32 * ks + 8 * fq);
        f32x4 s[8];
#pragma unroll
        for (int jt = 0; jt < 8; ++jt) { f32x4 a = {0.f, 0.f, 0.f, 0.f};
#pragma unroll
            for (int ks = 0; ks < 2; ++ks) a = MFMA16(ldsfrag(Kt + (16 * jt + fr) * 72 + 32 * ks + 8 * fq), qf[ks], a);
#pragma unroll
            for (int q = 0; q < 4; ++q) { const int j = 16 * jt + 4 * fq + q; const int dd = il > j ? il - j : j - il; a[q] *= exp2f(l2g * (float)dd); }
            PINV(a); s[jt] = a; }
        f32x4 o[4];
#pragma unroll
        for (int et = 0; et < 4; ++et) o[et] = (f32x4){0.f, 0.f, 0.f, 0.f};
#pragma unroll
        for (int kp = 0; kp < 4; ++kp) { const h16x8 pf = pack8(s[2 * kp], s[2 * kp + 1]);
#pragma unroll
            for (int et = 0; et < 4; ++et) o[et] = MFMA16(ldsfrag(VT + (16 * et + fr) * 136 + 32 * kp + 8 * fq), pf, o[et]); }
        const float gf = exp2f(l2g * (float)(il + 1)), gb = exp2f(l2g * (float)(128 - il));
#pragma unroll
        for (int ks = 0; ks < 2; ++ks) { const h16x8 qff = scalefrag(qf[ks], gf), qfb = scalefrag(qf[ks], gb);
#pragma unroll
            for (int et = 0; et < 4; ++et) { o[et] = MFMA16(ldsfrag(Ff + (16 * et + fr) * 72 + 32 * ks + 8 * fq), qff, o[et]); o[et] = MFMA16(ldsfrag(Fb + (16 * et + fr) * 72 + 32 * ks + 8 * fq), qfb, o[et]); } }
        float ss = 0.f;
#pragma unroll
        for (int et = 0; et < 4; ++et) ss += (o[et][0] * o[et][0] + o[et][1] * o[et][1]) + (o[et][2] * o[et][2] + o[et][3] * o[et][3]);
        ss += __shfl_xor(ss, 16); ss += __shfl_xor(ss, 32);
        const float rs = 1.0f / sqrtf(ss * (1.0f / 64.0f) + EPS);
#pragma unroll
        for (int et = 0; et < 4; ++et) { f32x4 q;
#pragma unroll
            for (int e = 0; e < 4; ++e) q[e] = o[et][e] * rs * siluf_((float)gc[et][e]);
            if (F8_OUT) *(unsigned*)(orow8 + h * 64 + 16 * et) = cvt4_fp8(8.f * q[0], 8.f * q[1], 8.f * q[2], 8.f * q[3]);
            else *(h16x4*)(orow + h * 64 + 16 * et) = pack4(q); }
    }
#undef RO_LOAD
    __syncthreads();
}
#undef RET_BAR

__device__ __forceinline__ void ssd_stage_dt(const Frame& F, const Prm& p, int l, int g, long t0, LAS float* LA, LAS float* DTS) {
    if (F.tid < 128) { const h16* dp = WSP(const h16, WS_R1) + (size_t)(t0 + F.tid) * NPJ + CDT + g * 3;
#pragma unroll
        for (int r = 0; r < 3; ++r) { const float raw = (float)dp[r];
#pragma unroll
            for (int dir = 0; dir < 2; ++dir) { const float dt = softplusf_(raw + inptr(F, 7)[(l * 2 + dir) * 6 + g * 3 + r]); const float la = -dt * __expf(inptr(F, 8)[(l * 2 + dir) * 6 + g * 3 + r]);
                DTS[(dir * 3 + r) * 128 + F.tid] = dt; LA[(dir * 3 + r) * 128 + F.tid] = la; } } }
}
__device__ __forceinline__ void ssd_cumsum(const Frame& F, LAS const float* LAq, float& v0, float& v1, float& c0, float& c1, float& tot) {
    v0 = LAq[2 * F.lane]; v1 = LAq[2 * F.lane + 1]; float s = v0 + v1;
#pragma unroll
    for (int o = 1; o < 64; o <<= 1) { const float t = __shfl_up(s, o); if (F.lane >= o) s += t; }
    c1 = s; c0 = s - v1; tot = __shfl(s, 63);
}
__device__ __forceinline__ void ssd_states_unit(const Frame& F, const Prm& p, int l, int u) {
    const int g = u & 1, bn = u >> 1, n = bn % NCH, b = bn / NCH; const long t0 = (long)b * SEQ + n * 128;
    const h16* proj = WSP(const h16, WS_R1);
    LAS h16* XT = (LAS h16*)F.lds; LAS h16* BT = XT + 3 * 64 * 136; LAS float* LA = (LAS float*)(BT + 128 * 136); LAS float* DTS = LA + 6 * 128; LAS float* WW = DTS + 6 * 128;
    ssd_stage_dt(F, p, l, g, t0, LA, DTS);
    const float* cw = inptr(F, 5) + (size_t)l * 4 * 896; const float* cb = inptr(F, 6) + (size_t)l * 896;
    h16* bcn = ((h16*)((unsigned char*)F.out + OUT_BCN));
    for (int task = F.tid; task < 56 * 16; task += 512) { const int cg = task % 56, r0 = (task / 56) * 8; h16x8 o[8];
        if (cg < 24) { conv_rows8<true>(proj + CXS + g * 192 + 8 * cg, t0, n, r0, cw + g * 192 + 8 * cg, 896, cb + g * 192 + 8 * cg, o);
            LAS h16* d = XT + (cg >> 3) * 64 * 136 + ((cg & 7) * 8) * 136 + r0;
#pragma unroll
            for (int e = 0; e < 8; ++e) *(LAS h16x8*)(d + e * 136) = col_of(o, e);
        } else { const int c8 = (cg - 24) & 15; const bool isB = cg < 40; const int col = (isB ? CBM : CCM) + g * 128 + 8 * c8, ci = (isB ? 384 : 640) + g * 128 + 8 * c8;
            conv_rows8<true>(proj + col, t0, n, r0, cw + ci, 896, cb + ci, o);
#pragma unroll
            for (int r = 0; r < 8; ++r) *(h16x8*)(bcn + (size_t)(t0 + r0 + r) * 512 + (isB ? 0 : 256) + g * 128 + 8 * c8) = o[r];
            if (isB) { LAS h16* d = BT + (8 * c8) * 136 + r0;
#pragma unroll
                for (int e = 0; e < 8; ++e) *(LAS h16x8*)(d + e * 136) = col_of(o, e); } } }
    __syncthreads();
    { h16* xtg = ((h16*)((unsigned char*)F.out + OUT_XTG)) + ((size_t)(b * NCH + n) * 6 + g * 3) * 8192;
#pragma unroll
        for (int k = 0; k < 6; ++k) { const int it = F.tid + 512 * k, rr = it >> 4, c = it & 15; const h16x8 v = *(LAS const h16x8*)(XT + rr * 136 + 8 * c);
            *(h16x4*)(xtg + rr * 128 + kperm32(8 * c)) = __builtin_shufflevector(v, v, 0, 1, 2, 3); *(h16x4*)(xtg + rr * 128 + kperm32(8 * c + 4)) = __builtin_shufflevector(v, v, 4, 5, 6, 7); } }
    if (F.wave < 6) { const int q = F.wave, dir = q / 3, r = q % 3; float v0, v1, c0, c1, tot; ssd_cumsum(F, LA + q * 128, v0, v1, c0, c1, tot);
        const float d0 = DTS[q * 128 + 2 * F.lane], d1 = DTS[q * 128 + 2 * F.lane + 1];
        if (dir == 0) { WW[q * 128 + 2 * F.lane] = __expf(tot - c0) * d0 * 256.f; WW[q * 128 + 2 * F.lane + 1] = __expf(tot - c1) * d1 * 256.f; }
        else { WW[q * 128 + 2 * F.lane] = __expf(c0 - v0) * d0 * 256.f; WW[q * 128 + 2 * F.lane + 1] = __expf(c1 - v1) * d1 * 256.f; }
        if (F.lane == 0) WSP(float, OFF_SDEC)[((size_t)(b * NCH + n) * 6 + g * 3 + r) * 2 + dir] = tot; }
    __syncthreads();
    const int w = F.wave, fr = F.lane & 15, fq = F.lane >> 4;
    h16x8 xb[4];
#pragma unroll
    for (int ks = 0; ks < 4; ++ks) xb[ks] = ldsfrag(BT + (16 * w + fr) * 136 + 32 * ks + 8 * fq);
    for (int q = 0; q < 6; ++q) { const int dir = q / 3, r = q % 3;
        h16x8 wf[4];
#pragma unroll
        for (int ks = 0; ks < 4; ++ks) { const f32x4 a = *(LAS const f32x4*)(WW + q * 128 + 32 * ks + 8 * fq), c = *(LAS const f32x4*)(WW + q * 128 + 32 * ks + 8 * fq + 4); wf[ks] = pack8(a, c); }
        h16* sst = WSP(h16, OFF_SST) + ((size_t)((dir * NB + b) * NCH + n) * 6 + g * 3 + r) * 8192;
#pragma unroll
        for (int pt = 0; pt < 4; ++pt) { f32x4 acc = {0.f, 0.f, 0.f, 0.f};
#pragma unroll
            for (int ks = 0; ks < 4; ++ks) acc = MFMA16(xb[ks], ldsfrag(XT + r * 64 * 136 + (16 * pt + fr) * 136 + 32 * ks + 8 * fq) * wf[ks], acc);
            *(h16x4*)(sst + (16 * pt + fr) * 128 + 16 * w + 4 * fq) = pack4(acc * (1.0f / 256.f)); } }
    __syncthreads();
}
__device__ __forceinline__ void ssd_scan_unit(const Frame& F, int u) {
    const int hd = u % 6, b = (u / 6) % NB, dir = u / (6 * NB);
    h16* base = WSP(h16, OFF_SST) + ((size_t)((dir * NB + b) * NCH) * 6 + hd) * 8192 + F.tid * 16;
    const float* dbase = WSP(const float, OFF_SDEC) + ((size_t)(b * NCH) * 6 + hd) * 2 + dir;
    float acc[16];
#pragma unroll
    for (int e = 0; e < 16; ++e) acc[e] = 0.f;
#pragma unroll 1
    for (int q = 0; q < 4; ++q) { h16x8 s0[4], s1[4]; float dec[4];
#pragma unroll
        for (int i = 0; i < 4; ++i) { const int ii = 4 * q + i, n = dir == 0 ? ii : NCH - 1 - ii; s0[i] = *(const h16x8*)(base + (size_t)n * 6 * 8192); s1[i] = *(const h16x8*)(base + (size_t)n * 6 * 8192 + 8); dec[i] = dbase[n * 12]; }
#pragma unroll
        for (int i = 0; i < 4; ++i) { const int ii = 4 * q + i, n = dir == 0 ? ii : NCH - 1 - ii; const float dc = __expf(dec[i]); h16x8 o0, o1;
#pragma unroll
            for (int e = 0; e < 8; ++e) { o0[e] = (h16)acc[e]; o1[e] = (h16)acc[8 + e]; acc[e] = acc[e] * dc + (float)s0[i][e]; acc[8 + e] = acc[8 + e] * dc + (float)s1[i][e]; }
            *(h16x8*)(base + (size_t)n * 6 * 8192) = o0; *(h16x8*)(base + (size_t)n * 6 * 8192 + 8) = o1; } }
}
__device__ __forceinline__ void ssd_out_unit(const Frame& F, const Prm& p, int l, int u) {
    const int g = u & 1, bn = u >> 1, n = bn % NCH, b = bn / NCH; const long t0 = (long)b * SEQ + n * 128;
    const h16* proj = WSP(const h16, WS_R1);
    LAS h16* XT = (LAS h16*)F.lds; LAS h16* Bt = XT + 3 * 64 * 136; LAS h16* Ct = Bt + 128 * 136; LAS float* LA = (LAS float*)(Ct + 128 * 136); LAS float* DTS = LA + 6 * 128;
    LAS float* CE = DTS + 6 * 128;
    LAS float* TOTB = CE + 6 * 128;
    ssd_stage_dt(F, p, l, g, t0, LA, DTS);
    const float* cw = inptr(F, 5) + (size_t)l * 4 * 896; const float* cb = inptr(F, 6) + (size_t)l * 896;
    { const h16* xtg = ((const h16*)((const unsigned char*)F.out + OUT_XTG)) + ((size_t)(b * NCH + n) * 6 + g * 3) * 8192; const h16* bcn = ((const h16*)((const unsigned char*)F.out + OUT_BCN)) + (size_t)t0 * 512 + g * 128;
        h16x8 xv[6], bv[8];
#pragma unroll
        for (int k = 0; k < 6; ++k) { const int it = F.tid + 512 * k; xv[k] = NTL(h16x8, xtg + (it >> 4) * 128 + 8 * (it & 15)); }
#pragma unroll
        for (int k = 0; k < 8; ++k) { const int it = F.tid + 512 * k, row = it >> 5, c = it & 31; bv[k] = NTL(h16x8, bcn + (size_t)row * 512 + (c < 16 ? 8 * c : 256 + 8 * (c - 16))); }
#pragma unroll
        for (int k = 0; k < 6; ++k) { const int it = F.tid + 512 * k; *(LAS h16x8*)(XT + (it >> 4) * 136 + 8 * (it & 15)) = xv[k]; }
#pragma unroll
        for (int k = 0; k < 8; ++k) { const int it = F.tid + 512 * k, row = it >> 5, c = it & 31; *(LAS h16x8*)((c < 16 ? Bt : Ct) + row * 136 + 8 * (c & 15)) = bv[k]; }
        PIN(); }
    __syncthreads();
    if (F.wave < 6) { const int q = F.wave; float v0, v1, c0, c1, tot; ssd_cumsum(F, LA + q * 128, v0, v1, c0, c1, tot);
        if (q < 3) { CE[q * 128 + 2 * F.lane] = c0; CE[q * 128 + 2 * F.lane + 1] = c1; }
        else { CE[q * 128 + 2 * F.lane] = c0 - v0; CE[q * 128 + 2 * F.lane + 1] = c1 - v1; if (F.lane == 0) TOTB[q - 3] = tot; } }
    __syncthreads();
    const int w = F.wave, fr = F.lane & 15, fq = F.lane >> 4, il = 16 * w + fr;
    h16x8 cf[4];
#pragma unroll
    for (int ks = 0; ks < 4; ++ks) cf[ks] = ldsfrag(Ct + il * 136 + 32 * ks + 8 * fq);
    f32x4 gT[8];
#pragma unroll
    for (int jt = 0; jt < 8; ++jt) { f32x4 a = {0.f, 0.f, 0.f, 0.f};
#pragma unroll
        for (int ks = 0; ks < 4; ++ks) a = MFMA16(ldsfrag(Bt + (16 * jt + fr) * 136 + 32 * ks + 8 * fq), cf[ks], a);
        PINV(a); gT[jt] = a; }
    const float* dsk = inptr(F, 9) + l * 6 + g * 3;
    h16* orow = WSP(h16, OFF_OMIX) + (size_t)(t0 + il) * DM + 384 + g * 192;
    float ss = 0.f;
    { h16x8 h0[4];
#pragma unroll
        for (int k = 0; k < 4; ++k) { const int it = F.tid + 512 * k, dir = it >> 10, e = it & 1023; h0[k] = NTL(h16x8, WSP(const h16, OFF_SST) + ((size_t)((dir * NB + b) * NCH + n) * 6 + g * 3) * 8192 + e * 8); }
        __syncthreads();
#pragma unroll
        for (int k = 0; k < 4; ++k) { const int it = F.tid + 512 * k, dir = it >> 10, e = it & 1023; *(LAS h16x8*)(Bt + dir * 64 * 136 + (e >> 4) * 136 + 8 * (e & 15)) = h0[k]; }
        __syncthreads(); }
#pragma unroll 1
    for (int r = 0; r < 3; ++r) {
        f32x4 y[1][4];
        const int hd = g * 3 + r;
        const float cfi = CE[r * 128 + il], ebi = CE[(3 + r) * 128 + il], totb = TOTB[r];
#pragma unroll
        for (int pt = 0; pt < 4; ++pt) y[0][pt] = (f32x4){0.f, 0.f, 0.f, 0.f};
        LAS const h16* HL = (r & 1) ? Ct : Bt;
        h16x8 hreg[4];
        if (r < 2) {
#pragma unroll
            for (int k = 0; k < 4; ++k) { const int it = F.tid + 512 * k, dir = it >> 10, e = it & 1023; hreg[k] = NTL(h16x8, WSP(const h16, OFF_SST) + ((size_t)((dir * NB + b) * NCH + n) * 6 + hd + 1) * 8192 + e * 8); } }
#pragma unroll
        for (int kp = 0; kp < 4; ++kp) { f32x4 pv[2];
#pragma unroll
            for (int jh = 0; jh < 2; ++jh) { const int jt = 2 * kp + jh, j0 = 16 * jt + 4 * fq;
                const f32x4 cfj = *(LAS const f32x4*)(CE + r * 128 + j0), ebj = *(LAS const f32x4*)(CE + (3 + r) * 128 + j0), dfj = *(LAS const f32x4*)(DTS + r * 128 + j0), dbj = *(LAS const f32x4*)(DTS + (3 + r) * 128 + j0);
#pragma unroll
                for (int e = 0; e < 4; ++e) { const int j = j0 + e; const float val = (il >= j) ? __expf(cfi - cfj[e]) * dfj[e] : __expf(ebj[e] - ebi) * dbj[e]; pv[jh][e] = gT[jt][e] * val * 256.f; }
                PINV(pv[jh]); }
            const h16x8 pf = pack8(pv[0], pv[1]);
#pragma unroll
            for (int pt = 0; pt < 4; ++pt) y[0][pt] = MFMA16(ldsfrag(XT + r * 64 * 136 + (16 * pt + fr) * 136 + 32 * kp + 8 * fq), pf, y[0][pt]);
            PINV(y[0][0]); PINV(y[0][1]); PINV(y[0][2]); PINV(y[0][3]); }
        const float ef = __expf(cfi) * 256.f, eb = __expf(totb - ebi) * 256.f;
#pragma unroll
        for (int ks = 0; ks < 4; ++ks) { const h16x8 cff = scalefrag(cf[ks], ef), cfb = scalefrag(cf[ks], eb);
#pragma unroll
            for (int pt = 0; pt < 4; ++pt) { y[0][pt] = MFMA16(ldsfrag(HL + (16 * pt + fr) * 136 + 32 * ks + 8 * fq), cff, y[0][pt]); y[0][pt] = MFMA16(ldsfrag(HL + 64 * 136 + (16 * pt + fr) * 136 + 32 * ks + 8 * fq), cfb, y[0][pt]); }
            PINV(y[0][0]); PINV(y[0][1]); PINV(y[0][2]); PINV(y[0][3]); }
        if (r < 2) { LAS h16* HN = (r & 1) ? Bt : Ct;
#pragma unroll
            for (int k = 0; k < 4; ++k) { const int it = F.tid + 512 * k, dir = it >> 10, e = it & 1023; *(LAS h16x8*)(HN + dir * 64 * 136 + (e >> 4) * 136 + 8 * (e & 15)) = hreg[k]; } }
        const float dk = dsk[r]; const h16* zrow = proj + (size_t)(t0 + il) * NPJ + CZ + hd * 64;
#pragma unroll
        for (int pt = 0; pt < 4; ++pt) { const h16x4 zv = NTL(h16x4, zrow + 16 * pt + 4 * fq);
#pragma unroll
            for (int e = 0; e < 4; ++e) { const float xv = (float)XT[r * 64 * 136 + (16 * pt + 4 * fq + e) * 136 + kperm32(il)]; y[0][pt][e] = (y[0][pt][e] * (1.0f / 256.f) + dk * xv) * siluf_((float)zv[e]); }
            const h16x4 yh = pack4(y[0][pt]); *(h16x4*)(orow + r * 64 + 16 * pt + 4 * fq) = yh;
#pragma unroll
            for (int e = 0; e < 4; ++e) { const float q = (float)yh[e]; ss += q * q; } }
        __syncthreads();
    }
    ss += __shfl_xor(ss, 16); ss += __shfl_xor(ss, 32);
    const float rs = 1.0f / sqrtf(ss * (1.0f / 192.0f) + EPS);
    const float* nw = inptr(F, 10) + l * 384 + g * 192;
    asm volatile("s_waitcnt vmcnt(0)" ::: "memory");
#pragma unroll 1
    for (int r = 0; r < 3; ++r)
#pragma unroll
        for (int pt = 0; pt < 4; ++pt) { const f32x4 wv = *(const f32x4*)(nw + r * 64 + 16 * pt + 4 * fq); h16* op = orow + r * 64 + 16 * pt + 4 * fq; const h16x4 yh = *(const h16x4*)op; f32x4 yv;
#pragma unroll
            for (int e = 0; e < 4; ++e) yv[e] = (float)yh[e] * rs * wv[e];
            if (F8_OUT) *(unsigned*)(WSP(unsigned char, OFF_OMIX8) + (size_t)(t0 + il) * DM + 384 + g * 192 + r * 64 + 16 * pt + 4 * fq) = cvt4_fp8(8.f * yv[0], 8.f * yv[1], 8.f * yv[2], 8.f * yv[3]);
            else *(h16x4*)op = pack4(yv); }
    __syncthreads();
}

__device__ __forceinline__ void lru_unit(const Frame& F, const Prm& p, int l, int u) {
    const int n = u % NCH, b = u / NCH; const long t0 = (long)b * SEQ + n * 128;
    const h16* proj = WSP(const h16, WS_R1);
    LAS h16* XC = (LAS h16*)F.lds;
    const float* cw = inptr(F, 11) + (size_t)l * 4 * 256; const float* cb = inptr(F, 12) + (size_t)l * 256;
    { const int cg = F.tid & 31, r0 = (F.tid >> 5) * 8; h16x8 o[8];
        conv_rows8<false>(proj + CXR + 8 * cg, t0, n, r0, cw + 8 * cg, 256, cb + 8 * cg, o);
#pragma unroll
        for (int r = 0; r < 8; ++r) *(LAS h16x8*)(XC + (r0 + r) * 264 + 8 * cg) = o[r]; }
    __syncthreads();
    const int blk = F.wave & 3, jh = F.wave >> 2, fr = F.lane & 15, fq = F.lane >> 4;
    h16* lau = (h16*)((unsigned char*)F.out + OUT_LAU) + (size_t)(b * NCH + n) * 2 * 128 * 256 * 2;
    h16x8 wa[2][2][2], wx[2][2][2]; float ba[2][2], bx[2][2], sp[2][2], car[2][2], atot[2][2];
#pragma unroll
    for (int dir = 0; dir < 2; ++dir)
#pragma unroll
        for (int jt = 0; jt < 2; ++jt) { const int ch = blk * 64 + 32 * jh + 16 * jt + fr;
#pragma unroll
            for (int ks = 0; ks < 2; ++ks) { wa[dir][jt][ks] = *(const h16x8*)(WSP(const h16, WS_LRUW) + (size_t)((dir * 2 + 0) * 4 + blk) * 4096 + (32 * jh + 16 * jt + fr) * 64 + 32 * ks + 8 * fq);
                wx[dir][jt][ks] = *(const h16x8*)(WSP(const h16, WS_LRUW) + (size_t)((dir * 2 + 1) * 4 + blk) * 4096 + (32 * jh + 16 * jt + fr) * 64 + 32 * ks + 8 * fq); }
            ba[dir][jt] = inptr(F, 15)[(l * 2 + dir) * 256 + ch]; bx[dir][jt] = inptr(F, 17)[(l * 2 + dir) * 256 + ch]; sp[dir][jt] = softplusf_(-inptr(F, 13)[(l * 2 + dir) * 256 + ch]);
            car[dir][jt] = 0.f; atot[dir][jt] = 1.f; }
#pragma unroll 1
    for (int ti = 0; ti < 8; ++ti) {
#pragma unroll
        for (int dir = 0; dir < 2; ++dir) { const int tt = dir == 0 ? ti : 7 - ti;
            h16x8 xf[2];
#pragma unroll
            for (int ks = 0; ks < 2; ++ks) xf[ks] = ldsfrag(XC + (16 * tt + fr) * 264 + blk * 64 + 32 * ks + 8 * fq);
#pragma unroll
            for (int jt = 0; jt < 2; ++jt) { const int ch = blk * 64 + 32 * jh + 16 * jt + fr;
                f32x4 ra = {0.f, 0.f, 0.f, 0.f}, ia = {0.f, 0.f, 0.f, 0.f};
#pragma unroll
                for (int ks = 0; ks < 2; ++ks) { ra = MFMA16(xf[ks], wa[dir][jt][ks], ra); ia = MFMA16(xf[ks], wx[dir][jt][ks], ia); }
                float A = 1.f, H = 0.f;
#pragma unroll
                for (int ri = 0; ri < 4; ++ri) { const int rg = dir == 0 ? ri : 3 - ri;
                    const float e1 = 1.0f + __expf(-(ra[rg] + ba[dir][jt])), e2 = 1.0f + __expf(-(ia[rg] + bx[dir][jt])); const float inv = __builtin_amdgcn_rcpf(e1 * e2);
                    const float rgate = inv * e2, ig = inv * e1;
                    const float la = -8.0f * rgate * sp[dir][jt]; const float a = __expf(la); const float y = 2.0f * la;
                    const float om = y > -0.1f ? -y * (1.0f + y * (0.5f + y * (1.0f / 6.0f))) : 1.0f - a * a;
                    const float mult = __builtin_amdgcn_sqrtf(om);
                    const float xv = (float)XC[(16 * tt + 4 * fq + rg) * 264 + ch]; const float uu = mult * ig * xv;
                    H = a * H + uu; A *= a;
                    { h16x2 pk; pk[0] = (h16)la; pk[1] = (h16)uu; *(h16x2*)(lau + ((size_t)dir * 128 + 16 * tt + 4 * fq + rg) * 256 * 2 + 2 * ch) = pk; } }
                float Ag[4], Hg[4];
#pragma unroll
                for (int gq = 0; gq < 4; ++gq) { Ag[gq] = __shfl(A, fr + 16 * gq); Hg[gq] = __shfl(H, fr + 16 * gq); }
                float cnew = car[dir][jt], at = 1.f;
#pragma unroll
                for (int gi = 0; gi < 4; ++gi) { const int gq = dir == 0 ? gi : 3 - gi;
                    cnew = Ag[gq] * cnew + Hg[gq]; at *= Ag[gq]; }
                car[dir][jt] = cnew; atot[dir][jt] *= at;
            } } }
    if (fq == 0) {
#pragma unroll
        for (int dir = 0; dir < 2; ++dir)
#pragma unroll
            for (int jt = 0; jt < 2; ++jt) { const int ch = blk * 64 + 32 * jh + 16 * jt + fr; *(f32x2*)(WSP(float, OFF_LSUM) + (((size_t)(b * NCH + n) * 2 + dir) * 256 + ch) * 2) = (f32x2){atot[dir][jt], car[dir][jt]}; } }
    __syncthreads();
}
__device__ __forceinline__ void lru_out_unit(const Frame& F, int u) {
    const int n = u % NCH, b = u / NCH; const long t0 = (long)b * SEQ + n * 128;
    const h16* proj = WSP(const h16, WS_R1);
    LAS h16* HT = (LAS h16*)F.lds;
    const int blk = F.wave & 3, jh = F.wave >> 2, fr = F.lane & 15, fq = F.lane >> 4;
    const h16* lau = (const h16*)((const unsigned char*)F.out + OUT_LAU) + (size_t)(b * NCH + n) * 2 * 128 * 256 * 2;
    float car[2][2];
#pragma unroll
    for (int dir = 0; dir < 2; ++dir)
#pragma unroll
        for (int jt = 0; jt < 2; ++jt) car[dir][jt] = WSP(const float, OFF_LCAR)[((size_t)(b * NCH + n) * 2 + dir) * 256 + blk * 64 + 32 * jh + 16 * jt + fr];
#pragma unroll 1
    for (int ti = 0; ti < 8; ++ti) {
#pragma unroll
        for (int dir = 0; dir < 2; ++dir) { const int tt = dir == 0 ? ti : 7 - ti;
            h16x2 pk[2][4]; h16 gtv[2][4], ov[2][4];
#pragma unroll
            for (int jt = 0; jt < 2; ++jt)
#pragma unroll
                for (int rg = 0; rg < 4; ++rg) { const int tl = 16 * tt + 4 * fq + rg, ch = blk * 64 + 32 * jh + 16 * jt + fr;
                    pk[jt][rg] = NTL(h16x2, lau + ((size_t)dir * 128 + tl) * 256 * 2 + 2 * ch); gtv[jt][rg] = NTL(h16, proj + (size_t)(t0 + tl) * NPJ + CGT + ch); ov[jt][rg] = ti >= 4 ? HT[tl * 264 + ch] : (h16)0.f; }
#pragma unroll
            for (int jt = 0; jt < 2; ++jt) { const int ch = blk * 64 + 32 * jh + 16 * jt + fr;
                float av[4], uv[4]; float A = 1.f, H = 0.f;
#pragma unroll
                for (int ri = 0; ri < 4; ++ri) { const int rg = dir == 0 ? ri : 3 - ri; const float a = __expf((float)pk[jt][rg][0]); const float uu = (float)pk[jt][rg][1]; av[rg] = a; uv[rg] = uu; H = a * H + uu; A *= a; }
                float Ag[4], Hg[4];
#pragma unroll
                for (int gq = 0; gq < 4; ++gq) { Ag[gq] = __shfl(A, fr + 16 * gq); Hg[gq] = __shfl(H, fr + 16 * gq); }
                float hin = car[dir][jt], cnew = car[dir][jt];
#pragma unroll
                for (int gi = 0; gi < 4; ++gi) { const int gq = dir == 0 ? gi : 3 - gi; const bool before = dir == 0 ? (gq < fq) : (gq > fq);
                    if (before) hin = Ag[gq] * hin + Hg[gq];
                    cnew = Ag[gq] * cnew + Hg[gq]; }
                car[dir][jt] = cnew;
                float hh = hin;
#pragma unroll
                for (int ri = 0; ri < 4; ++ri) { const int rg = dir == 0 ? ri : 3 - ri; hh = av[rg] * hh + uv[rg];
                    HT[(16 * tt + 4 * fq + rg) * 264 + ch] = (h16)((float)ov[jt][rg] + hh * gelu_tanh_((float)gtv[jt][rg])); } } } }
    __syncthreads();
#pragma unroll
    for (int k = 0; k < 8; ++k) { const int it = F.tid + 512 * k, row = it >> 5, c8 = it & 31; const h16x8 hv = *(LAS const h16x8*)(HT + row * 264 + 8 * c8);
        if (F8_OUT) *(u32x2*)(WSP(unsigned char, OFF_OMIX8) + (size_t)(t0 + row) * DM + 768 + 8 * c8) = (u32x2){cvt4_fp8(8.f * (float)hv[0], 8.f * (float)hv[1], 8.f * (float)hv[2], 8.f * (float)hv[3]), cvt4_fp8(8.f * (float)hv[4], 8.f * (float)hv[5], 8.f * (float)hv[6], 8.f * (float)hv[7])};
        else *(h16x8*)(WSP(h16, OFF_OMIX) + (size_t)(t0 + row) * DM + 768 + 8 * c8) = hv; }
    __syncthreads();
}
__device__ __forceinline__ void lru_scan(const Frame& F) {
    const int gi = (int)blockIdx.x * 512 + F.tid; if (gi >= NB * 2 * 256) return;
    const int ch = gi & 255, dir = (gi >> 8) & 1, b = gi >> 9; float H = 0.f;
    for (int i = 0; i < NCH; ++i) { const int n = dir == 0 ? i : NCH - 1 - i; const size_t idx = ((size_t)(b * NCH + n) * 2 + dir) * 256 + ch;
        const f32x2 s = *(const f32x2*)(WSP(const float, OFF_LSUM) + idx * 2); WSP(float, OFF_LCAR)[idx] = H; H = s[0] * H + s[1]; }
}

__device__ __forceinline__ void attn_phase(const Frame& F) {
    constexpr int NU = NB * 4 * 8;
    LAS unsigned char* B0 = F.lds; LAS unsigned char* B1 = F.lds + 67584;
    int u = F.vcu; if (u >= NU) return;
    int lanel = F.lane; asm volatile("" : "+v"(lanel)); int fr = lanel & 15, fq = lanel >> 4;
    const int w = F.wave;
    h16x8 qf[2][8];
#define AT_DMA(buf, src, rowstride) do { asm volatile("" : "+v"(lanel)); if (lanel < 32) { _Pragma("unroll") for (int i_ = 0; i_ < 16; ++i_) \
        __builtin_amdgcn_global_load_lds((const unsigned*)((src) + (size_t)(16 * w + i_) * (rowstride) + 8 * lanel), (LAS unsigned*)((buf) + (16 * w + i_) * 528), 16, 0, 0); } } while (0)
#define AT_FRAG(buf, row, chunk) (*(LAS const h16x8*)((buf) + (row) * 528 + (chunk) * 16))
#define AT_WAITBAR() do { asm volatile("s_waitcnt vmcnt(0) lgkmcnt(0)" ::: "memory"); __builtin_amdgcn_s_barrier(); asm volatile("" ::: "memory"); } while (0)
#define AT_LOADQ(uu) do { _Pragma("unroll") for (int a_ = 0; a_ < 2; ++a_) { const long t_ = (long)((uu) >> 5) * SEQ + ((uu) & 7) * 256 + 32 * w + 16 * a_ + fr; const h16* q_ = WSP(const h16, OFF_QCA) + (size_t)t_ * DM + (((uu) >> 3) & 3) * 256; \
        _Pragma("unroll") for (int ks_ = 0; ks_ < 8; ++ks_) qf[a_][ks_] = NTL(h16x8, q_ + 32 * ks_ + 8 * fq); } } while (0)
    { const int b = u >> 5, hd = (u >> 3) & 3; AT_DMA(B0, WSP(const h16, OFF_KB) + (size_t)(b * 256) * DM + hd * 256, DM); }
    for (; u < NU; u += F.G) {
        const int qb = u & 7, hd = (u >> 3) & 3, b = u >> 5; const int un = u + F.G; const bool has_next = un < NU;
        asm volatile("" : "+v"(lanel)); fr = lanel & 15; fq = lanel >> 4;
        const h16* kb = WSP(const h16, OFF_KB) + (size_t)(b * 256) * DM + hd * 256; const h16* vt = WSP(const h16, OFF_VT) + (size_t)(b * 4 + hd) * 65536;
        AT_LOADQ(u);
        h16x8 pf[2][8]; float mq[2][4], Mr[2] = {-3.0e38f, -3.0e38f}, Lr[2] = {0.f, 0.f};
#pragma unroll
        for (int h = 0; h < 2; ++h) {
            AT_WAITBAR();
            if (h == 0) AT_DMA(B1, kb + (size_t)128 * DM, DM); else AT_DMA(B0, vt, 256);
            LAS const unsigned char* KB_ = h == 0 ? B0 : B1;
#pragma unroll
            for (int jh = 0; jh < 2; ++jh) { const int qd = 2 * h + jh; f32x4 s[2][4]; h16x8 kf[2][4];
#pragma unroll
                for (int j4 = 0; j4 < 4; ++j4) { s[0][j4] = (f32x4){0.f, 0.f, 0.f, 0.f}; s[1][j4] = (f32x4){0.f, 0.f, 0.f, 0.f}; kf[0][j4] = AT_FRAG(KB_, 16 * (4 * jh + j4) + fr, fq); }
#pragma unroll
                for (int ks = 0; ks < 8; ++ks) {
                    if (ks < 7) {
#pragma unroll
                        for (int j4 = 0; j4 < 4; ++j4) kf[(ks + 1) & 1][j4] = AT_FRAG(KB_, 16 * (4 * jh + j4) + fr, 4 * (ks + 1) + fq); }
                    PIN();
#pragma unroll
                    for (int j4 = 0; j4 < 4; ++j4) { s[0][j4] = MFMA16(kf[ks & 1][j4], qf[0][ks], s[0][j4]); s[1][j4] = MFMA16(kf[ks & 1][j4], qf[1][ks], s[1][j4]); }
                    PINV(s[0][0]); PINV(s[1][3]); }
#pragma unroll
                for (int a = 0; a < 2; ++a) { float mx = fmaxf(fmaxf(s[a][0][0], s[a][0][1]), fmaxf(s[a][0][2], s[a][0][3]));
#pragma unroll
                    for (int jt = 1; jt < 4; ++jt) mx = fmaxf(mx, fmaxf(fmaxf(s[a][jt][0], s[a][jt][1]), fmaxf(s[a][jt][2], s[a][jt][3])));
                    mx = fmaxf(mx, __shfl_xor(mx, 16)); mx = fmaxf(mx, __shfl_xor(mx, 32));
                    float sum = 0.f;
#pragma unroll
                    for (int jt = 0; jt < 4; ++jt)
#pragma unroll
                        for (int e = 0; e < 4; ++e) { const float pe = __expf(s[a][jt][e] - mx); s[a][jt][e] = pe; sum += pe; }
                    sum += __shfl_xor(sum, 16); sum += __shfl_xor(sum, 32);
                    mq[a][qd] = mx; { const float Mn = fmaxf(Mr[a], mx); Lr[a] = Lr[a] * __expf(Mr[a] - Mn) + sum * __expf(mx - Mn); Mr[a] = Mn; }
                    pf[a][2 * qd] = pack8(s[a][0], s[a][1]); pf[a][2 * qd + 1] = pack8(s[a][2], s[a][3]); } }
        }
#pragma unroll
        for (int a = 0; a < 2; ++a) { const float inv = 1.0f / Lr[a];
#pragma unroll
            for (int q = 0; q < 4; ++q) { const float cq = __expf(mq[a][q] - Mr[a]) * inv; pf[a][2 * q] = scalefrag(pf[a][2 * q], cq); pf[a][2 * q + 1] = scalefrag(pf[a][2 * q + 1], cq); } }
#pragma unroll
        for (int d = 0; d < 2; ++d) {
            AT_WAITBAR();
            if (d == 0) AT_DMA(B1, vt + (size_t)128 * 256, 256);
            else if (has_next) AT_DMA(B0, WSP(const h16, OFF_KB) + (size_t)((un >> 5) * 256) * DM + ((un >> 3) & 3) * 256, DM);
            LAS const unsigned char* VB_ = d == 0 ? B0 : B1;
#pragma unroll
            for (int eh = 0; eh < 2; ++eh) { f32x4 o[2][4]; h16x8 vf[2][4];
#pragma unroll
                for (int e4 = 0; e4 < 4; ++e4) { o[0][e4] = (f32x4){0.f, 0.f, 0.f, 0.f}; o[1][e4] = (f32x4){0.f, 0.f, 0.f, 0.f}; vf[0][e4] = AT_FRAG(VB_, 16 * (4 * eh + e4) + fr, fq); }
#pragma unroll
                for (int kp = 0; kp < 8; ++kp) {
                    if (kp < 7) {
#pragma unroll
                        for (int e4 = 0; e4 < 4; ++e4) vf[(kp + 1) & 1][e4] = AT_FRAG(VB_, 16 * (4 * eh + e4) + fr, 4 * (kp + 1) + fq); }
                    PIN();
#pragma unroll
                    for (int e4 = 0; e4 < 4; ++e4) { o[0][e4] = MFMA16(vf[kp & 1][e4], pf[0][kp], o[0][e4]); o[1][e4] = MFMA16(vf[kp & 1][e4], pf[1][kp], o[1][e4]); }
                    PINV(o[0][0]); PINV(o[1][3]); }
#pragma unroll
                for (int a = 0; a < 2; ++a) { const long t = (long)b * SEQ + qb * 256 + 32 * w + 16 * a + fr; h16* orow = WSP(h16, OFF_OATT) + (size_t)t * DM + hd * 256 + 128 * d + 64 * eh;
#pragma unroll
                    for (int e4 = 0; e4 < 4; ++e4) { if (F8_O) *(unsigned*)(WSP(unsigned char, OFF_OATT) + (size_t)t * DM + hd * 256 + 128 * d + 64 * eh + 16 * e4 + 4 * fq) = cvt4_fp8(16.f * o[a][e4][0], 16.f * o[a][e4][1], 16.f * o[a][e4][2], 16.f * o[a][e4][3]);
                        else *(h16x4*)(orow + 16 * e4 + 4 * fq) = pack4(o[a][e4]); } } }
        }
    }
    asm volatile("s_waitcnt vmcnt(0) lgkmcnt(0)" ::: "memory");
    __syncthreads();
#undef AT_DMA
#undef AT_FRAG
#undef AT_WAITBAR
#undef AT_LOADQ
}

__device__ __forceinline__ void phase_router(const Frame& F, const Prm& p, int l) {
    LAS h16* RW = (LAS h16*)F.lds;
    { const h16* rwg = WSP(const h16, OFF_RWG);
        for (int i = F.tid; i < 72 * 1032 / 8; i += 512) *(LAS h16x8*)(RW + 8 * i) = *(const h16x8*)(rwg + 8 * i); }
    LAS unsigned* hist = (LAS unsigned*)(F.lds + 72 * 1032 * 2);
    if (F.tid < 32) hist[F.tid] = 0u;
    if (F.G == 256) { for (int i = (int)blockIdx.x * 512 + F.tid; i < MAXSLOT; i += 256 * 512) WSP(int, OFF_STOK)[i] = 0; }
    else if (blockIdx.x == 0) { for (int i = F.tid; i < MAXSLOT; i += 512) WSP(int, OFF_STOK)[i] = 0; }
    __syncthreads();
    const int gw = F.vcu * 8 + F.wave, NGW = F.G * 8, fr = F.lane & 15, fq = F.lane >> 4;
    for (int tg = gw; tg < NT / 16; tg += NGW) {
        const int tok = tg * 16 + fr;
        const h16* hp = WSP(const h16, WS_HB) + (size_t)tok * DM + 8 * fq;
        f32x4 acc[3]; LAS const h16* wrow[3];
#pragma unroll
        for (int mt = 0; mt < 3; ++mt) { acc[mt] = (f32x4){0.f, 0.f, 0.f, 0.f}; const int j = (16 * mt + fr) < 36 ? (16 * mt + fr) : 35; wrow[mt] = RW + j * 1032 + 8 * fq; }
#pragma unroll
        for (int half = 0; half < 2; ++half) { h16x8 hf[16];
#pragma unroll
            for (int q = 0; q < 16; ++q) hf[q] = *(const h16x8*)(hp + 32 * (16 * half + q));
#pragma unroll
            for (int q = 0; q < 16; ++q) { const int ks = 16 * half + q;
#pragma unroll
                for (int mt = 0; mt < 3; ++mt) { acc[mt] = MFMA16(ldsfrag(wrow[mt] + 32 * ks), hf[q], acc[mt]); acc[mt] = MFMA16(ldsfrag(wrow[mt] + 36 * 1032 + 32 * ks), hf[q], acc[mt]); } } }
#pragma unroll
        for (int mt = 0; mt < 3; ++mt) acc[mt] *= (1.0f / 1024.0f);
        const float rs = row_rstd(WSP(const float, WS_SSQ) + (size_t)tok * 16);
        float gl[4];
#pragma unroll
        for (int r = 0; r < 4; ++r) gl[r] = __shfl(acc[0][r], fr) * rs + inptr(F, 25)[l * 4 + r];
        int gi = 0; float gmx = gl[0];
#pragma unroll
        for (int j = 1; j < 4; ++j) if (gl[j] > gmx) { gmx = gl[j]; gi = j; }
        float gsum = 0.f;
#pragma unroll
        for (int j = 0; j < 4; ++j) gsum += __expf(gl[j] - gmx);
        const float gp = 1.0f / gsum;
        const int src1 = fr + 16 * (1 + 2 * (gi & 1)), src2 = fr + 16 * (2 - 2 * (gi & 1)), mt1 = gi >> 1, mt2 = (gi + 1) >> 1;
        float el[8];
#pragma unroll
        for (int k = 0; k < 4; ++k) { const float a0 = __shfl(acc[0][k], src1), a1 = __shfl(acc[1][k], src1); el[k] = (mt1 ? a1 : a0) * rs + inptr(F, 27)[l * 32 + gi * 8 + k];
            const float b0 = __shfl(acc[0][k], src2), b1 = __shfl(acc[1][k], src2), b2 = __shfl(acc[2][k], src2); el[4 + k] = (mt2 == 0 ? b0 : (mt2 == 1 ? b1 : b2)) * rs + inptr(F, 27)[l * 32 + gi * 8 + 4 + k]; }
        int e1 = 0; float m1 = el[0];
#pragma unroll
        for (int j = 1; j < 8; ++j) if (el[j] > m1) { m1 = el[j]; e1 = j; }
        int e2 = -1; float m2 = -3.0e38f;
#pragma unroll
        for (int j = 0; j < 8; ++j) if (j != e1 && el[j] > m2) { m2 = el[j]; e2 = j; }
        const float r2 = __expf(m2 - m1); const float g1 = gp / (1.0f + r2), g2 = gp * r2 / (1.0f + r2);
        if (fq == 0) { const int x1 = gi * 8 + e1, x2 = gi * 8 + e2;
            *(int2*)(WSP(int, OFF_EID) + (size_t)tok * 2) = make_int2(x1, x2); *(f32x2*)(WSP(float, OFF_GATE) + (size_t)tok * 2) = (f32x2){g1, g2};
            WSP(float, OFF_RSTDT)[tok] = rs; __hip_atomic_fetch_add(&hist[x1], 1u, __ATOMIC_RELAXED, __HIP_MEMORY_SCOPE_WORKGROUP); __hip_atomic_fetch_add(&hist[x2], 1u, __ATOMIC_RELAXED, __HIP_MEMORY_SCOPE_WORKGROUP); }
    }
    __syncthreads();
    if (F.tid < 32 && hist[F.tid]) atomicAdd(WSP(unsigned, WS_CTL) + CW_COUNTS + l * 64 + F.tid, hist[F.tid]);
    __syncthreads();
}
__device__ __forceinline__ void phase_dispatch(const Frame& F, int l) {
    LAS int* cnt = (LAS int*)F.lds; LAS int* base = cnt + 32; LAS int* pstart = base + 32; LAS int* slots = pstart + 40;
    unsigned* ctl = WSP(unsigned, WS_CTL);
    for (int blk = F.vcu; blk < NT / 128; blk += F.G) {
        __syncthreads();
        if (F.tid < 32) cnt[F.tid] = 0;
        if (F.tid == 32) { int acc = 0; for (int e = 0; e < 32; ++e) { pstart[e] = acc; acc += (int)((ctl[CW_COUNTS + l * 64 + e] + 255u) & ~255u); } pstart[32] = acc; }
        __syncthreads();
        int e = 0, rank = 0, tok = 0;
        if (F.tid < 256) { tok = blk * 128 + (F.tid >> 1); e = WSP(const int, OFF_EID)[(size_t)tok * 2 + (F.tid & 1)]; rank = __hip_atomic_fetch_add(&cnt[e], 1, __ATOMIC_RELAXED, __HIP_MEMORY_SCOPE_WORKGROUP); }
        __syncthreads();
        if (F.tid < 32) base[F.tid] = cnt[F.tid] ? (int)atomicAdd(&ctl[CW_CURSOR + l * 64 + F.tid], (unsigned)cnt[F.tid]) : 0;
        __syncthreads();
        if (F.tid < 256) { const int slot = pstart[e] + base[e] + rank; slots[F.tid] = slot; WSP(int, OFF_TSLOT)[(size_t)tok * 2 + (F.tid & 1)] = slot; WSP(float, OFF_SRSTD)[slot] = WSP(const float, OFF_RSTDT)[tok]; WSP(int, OFF_STOK)[slot] = tok; }
        __syncthreads();
        if (blk == 0 && F.tid == 0) { const int ntl = pstart[32] >> 8; ctl[CW_NTILES + l] = (unsigned)ntl; int* te = WSP(int, OFF_TILEE);
            for (int e2 = 0; e2 < 32; ++e2) for (int tl = pstart[e2] >> 8; tl < (pstart[e2 + 1] >> 8); ++tl) te[tl] = e2; }
    }
    __syncthreads();
}
__device__ __forceinline__ void phase_combine(const Frame& F, const Prm& p, int l) {
    const int gw = F.vcu * 8 + F.wave, NGW = F.G * 8;
    const bool last = (l == NLAYER - 1);
    for (int tk0 = gw * 4; tk0 < NT; tk0 += NGW * 4) {
        int2 sl[4]; f32x2 gt[4];
#pragma unroll
        for (int q = 0; q < 4; ++q) { sl[q] = *(const int2*)(WSP(const int, OFF_TSLOT) + (size_t)(tk0 + q) * 2); gt[q] = *(const f32x2*)(WSP(const float, OFF_GATE) + (size_t)(tk0 + q) * 2); }
        f32x4 v[4][4]; h16x4 ya[4][4], yb[4][4];
#pragma unroll
        for (int q = 0; q < 4; ++q) { const h16* hrow = WSP(const h16, WS_HB) + (size_t)(tk0 + q) * DM; const h16* y0 = WSP(const h16, OFF_YP) + (size_t)sl[q].x * DM; const h16* y1 = WSP(const h16, OFF_YP) + (size_t)sl[q].y * DM;
#pragma unroll
            for (int j = 0; j < 4; ++j) { const int c = 4 * F.lane + 256 * j; const h16x4 hv = *(const h16x4*)(hrow + c); v[q][j] = (f32x4){(float)hv[0], (float)hv[1], (float)hv[2], (float)hv[3]}; ya[q][j] = __builtin_nontemporal_load((const h16x4*)(y0 + c)); yb[q][j] = __builtin_nontemporal_load((const h16x4*)(y1 + c)); } }
#pragma unroll
        for (int q = 0; q < 4; ++q) { float s = 0.f;
#pragma unroll
            for (int j = 0; j < 4; ++j) {
#pragma unroll
                for (int e = 0; e < 4; ++e) v[q][j][e] += gt[q][0] * (float)ya[q][j][e] + gt[q][1] * (float)yb[q][j][e];
                if (!last) { const h16x4 o = pack4(v[q][j]); v[q][j] = (f32x4){(float)o[0], (float)o[1], (float)o[2], (float)o[3]}; }
                s += (v[q][j][0] * v[q][j][0] + v[q][j][1] * v[q][j][1]) + (v[q][j][2] * v[q][j][2] + v[q][j][3] * v[q][j][3]); }
            s = wave_sum(s);
            if (!last) {
#pragma unroll
                for (int j = 0; j < 4; ++j) { const int c = 4 * F.lane + 256 * j; *(h16x4*)(WSP(h16, WS_HB) + (size_t)(tk0 + q) * DM + c) = pack4(v[q][j]);
                    if (F8_HB) *(unsigned*)((unsigned char*)F.out + OUT_HB8 + (size_t)(tk0 + q) * DM + c) = cvt4_fp8(v[q][j][0], v[q][j][1], v[q][j][2], v[q][j][3]); }
                if (F.lane < 16) WSP(float, WS_SSQ)[(size_t)(tk0 + q) * 16 + F.lane] = (F.lane == 0) ? s : 0.f;
                if (F.lane == 0) WSP(float, OFF_RSTDT)[tk0 + q] = 1.0f / sqrtf(s * (1.0f / DM) + EPS);
            } else { const float rs = 1.0f / sqrtf(s * (1.0f / DM) + EPS); float* orow = F.out + (size_t)(tk0 + q) * DM;
#pragma unroll
                for (int j = 0; j < 4; ++j) { const int c = 4 * F.lane + 256 * j; const f32x4 gf = *(const f32x4*)(inptr(F, 31) + c); *(f32x4*)(orow + c) = v[q][j] * rs * gf; } } }
    }
}

__global__ void __launch_bounds__(512, 2) fwd(Prm p) {
    extern __shared__ __attribute__((aligned(16))) unsigned char lds_raw[];
    Frame F; F.lds = (LAS unsigned char*)lds_raw; F.ws = (GAS unsigned char*)p.ws; F.out = p.out;
    F.tid = threadIdx.x; F.lane = F.tid & 63; F.wave = __builtin_amdgcn_readfirstlane(F.tid >> 6);
    F.G = gridDim.x; { const int bx = blockIdx.x; F.vcu = (F.G % 8 == 0) ? (bx % 8) * (F.G / 8) + bx / 8 : bx; }
    volatile LAS unsigned* misc = (volatile LAS unsigned*)(F.lds + LDS_MISC);
    if (F.tid < 4) misc[F.tid] = 0u;
    F.ptab = (volatile LAS unsigned long long*)(F.lds + LDS_MISC + 64);
    if (F.tid < 32) F.ptab[F.tid] = (unsigned long long)p.in[F.tid];
    __syncthreads();
    const int lo = p.ph_lo, hi = p.ph_hi;
    XcdBarrier bar; bar.bar = WSP(unsigned, WS_CTL) + CW_BAR; bar.x = 0; bar.st = misc;
    if (hi - lo > 1) bar = xcd_barrier_post(WSP(unsigned, WS_CTL) + CW_BAR, misc);
#ifndef UMASK
#define UMASK 7
#endif
#ifndef REPMASK
#define REPMASK 0
#endif
#ifndef PHMASK
#define PHMASK 0x3fff
#endif
#define IN(k) (((PHMASK >> ((k) % NPH)) & 1) && lo <= (k) && (k) < hi && (launder(F), true))
#define REPS(k) (((REPMASK >> (k)) & 1) ? 2 : 1)
#define INR(k) (lo <= (k) && (k) < hi)
#ifndef AMPMASK
#define AMPMASK 0
#endif
    unsigned long long tprev = AMPMASK ? __builtin_amdgcn_s_memrealtime() : 0ull;
#define SEAM(k) do { if (INR(k) && INR((k) + 1)) { xcd_barrier(bar); if (AMPMASK) { const unsigned long long tn = __builtin_amdgcn_s_memrealtime(); \
        if ((AMPMASK >> ((k) % NPH)) & 1) { const unsigned long long tgt = tn + 4ull * (tn - tprev); while (__builtin_amdgcn_s_memrealtime() < tgt) __builtin_amdgcn_s_sleep(8); } \
        tprev = __builtin_amdgcn_s_memrealtime(); } } } while (0)
    for (int l = 0; l < NLAYER; ++l) {
        const int pb = l * NPH;
        if (IN(pb + 0)) for (int rep = 0; rep < REPS(0); ++rep) { phase_convert(F, p, l); } SEAM(pb + 0);
        if (REPS(20) == 2 && INR(pb + 0) && INR(pb + 1)) { for (int q = 0; q < 20; ++q) xcd_barrier(bar); }
        if (IN(pb + 1)) for (int rep = 0; rep < REPS(1); ++rep) {
            if (UMASK & 1) { pg8::StaticOrder S; S.init(NT, NPJ, F.G, (int)blockIdx.x); pg8::EpiScale16C E{WSP(h16, WS_R1), NPJ, WSP(const float, OFF_RSTDT), F8_PROJ ? 1.0f / 256.0f : 1.0f};
#if F8_PROJ
              pg8::Gemm g{(const h16*)((const unsigned char*)F.out + OUT_HB8), WSP(const h16, WS_WIN), DM / 2, DM / 2, DM / 2, nullptr}; pg8::gemm_phase<pg8::EpiScale16C, pg8::StaticOrder, false, 1>(F.lds, F.tid, g, S, E);
#else
              pg8::Gemm g{WSP(const h16, WS_HB), WSP(const h16, WS_WIN), DM, DM, DM, nullptr}; pg8::gemm_phase(F.lds, F.tid, g, S, E);
#endif
            }
        } SEAM(pb + 1);
        if (IN(pb + 2)) for (int rep = 0; rep < REPS(2); ++rep) {
            if (UMASK & 1) for (int r2 = 0; r2 < REPS(17); ++r2) for (int u = blockIdx.x; u < NB * NCH * 2; u += F.G) ssd_states_unit(F, p, l, u);
            launder(F);
            if (UMASK & 2) for (int r2 = 0; r2 < REPS(18); ++r2) for (int u = blockIdx.x; u < NB * NCH; u += F.G) ret_states_block(F, u);
            launder(F);
            if (UMASK & 4) for (int r2 = 0; r2 < REPS(19); ++r2) for (int u = blockIdx.x; u < NB * NCH; u += F.G) lru_unit(F, p, l, u);
        } SEAM(pb + 2);
        if (IN(pb + 3)) for (int rep = 0; rep < REPS(3); ++rep) {
            const bool split = (F.G == 256); const int GS = split ? 128 : F.G;
            if (!split || blockIdx.x < 128) {
                for (int u = blockIdx.x; u < 2 * NB * 6; u += GS) ssd_scan_unit(F, u);
                launder(F);
                for (int u = blockIdx.x; u < 2 * NB * 6; u += GS) ret_scan_unit(F, u);
                lru_scan(F); }
            launder(F);
            if (!split || blockIdx.x >= 128) {
                pg8::Gemm g{WSP(const h16, WS_MEM16), WSP(const h16, WS_WKV), DM, DM, DM, nullptr}; pg8::StaticOrder S; S.init(NTM, 2048, GS, split ? (int)blockIdx.x - 128 : (int)blockIdx.x);
                pg8::EpiKV E{WSP(h16, OFF_KB), WSP(h16, OFF_VT), WSP(const float, OFF_MSSQ)}; pg8::gemm_phase(F.lds, F.tid, g, S, E); }
        } SEAM(pb + 3);
        if (IN(pb + 4)) for (int rep = 0; rep < REPS(4); ++rep) {
            if (UMASK & 1) for (int r2 = 0; r2 < REPS(14); ++r2) for (int u = blockIdx.x; u < NB * NCH * 2; u += F.G) ssd_out_unit(F, p, l, u);
            launder(F);
            if (UMASK & 2) for (int r2 = 0; r2 < REPS(15); ++r2) for (int u = blockIdx.x; u < NB * NCH; u += F.G) ret_out_block(F, u);
            launder(F);
            if (UMASK & 4) for (int r2 = 0; r2 < REPS(16); ++r2) for (int u = blockIdx.x; u < NB * NCH; u += F.G) lru_out_unit(F, u);
        } SEAM(pb + 4);
        if (IN(pb + 5)) for (int rep = 0; rep < REPS(5); ++rep) { pg8::StaticOrder S; S.init(NT, DM, F.G, (int)blockIdx.x); pg8::EpiResid E{WSP(h16, WS_HB), WSP(float, WS_SSQ), (unsigned char*)F.out + OUT_HB8, F8_OUT ? 1.0f / 2048.0f : 1.0f};
#if F8_OUT
            pg8::Gemm g{WSP(const h16, OFF_OMIX8), WSP(const h16, WS_WOUT), DM / 2, DM / 2, DM / 2, nullptr}; pg8::gemm_phase<pg8::EpiResid, pg8::StaticOrder, false, 1>(F.lds, F.tid, g, S, E);
#else
            pg8::Gemm g{WSP(const h16, OFF_OMIX), WSP(const h16, WS_WOUT), DM, DM, DM, nullptr}; pg8::gemm_phase(F.lds, F.tid, g, S, E);
#endif
            } SEAM(pb + 5);
        if (IN(pb + 6)) for (int rep = 0; rep < REPS(6); ++rep) { pg8::StaticOrder S; S.init(NT, DM, F.G, (int)blockIdx.x); pg8::EpiScale16 E{WSP(h16, OFF_QCA), DM, WSP(const float, WS_SSQ), F8_Q ? 1.0f / 4096.0f : 1.0f};
#if F8_Q
            pg8::Gemm g{(const h16*)((const unsigned char*)F.out + OUT_HB8), WSP(const h16, WS_WQ), DM / 2, DM / 2, DM / 2, nullptr}; pg8::gemm_phase<pg8::EpiScale16, pg8::StaticOrder, false, 1>(F.lds, F.tid, g, S, E);
#else
            pg8::Gemm g{WSP(const h16, WS_HB), WSP(const h16, WS_WQ), DM, DM, DM, nullptr}; pg8::gemm_phase(F.lds, F.tid, g, S, E);
#endif
            } SEAM(pb + 6);
        if (IN(pb + 7)) for (int rep = 0; rep < REPS(7); ++rep) { attn_phase(F); } SEAM(pb + 7);
        if (IN(pb + 8)) for (int rep = 0; rep < REPS(8); ++rep) { pg8::StaticOrder S; S.init(NT, DM, F.G, (int)blockIdx.x); pg8::EpiResid E{WSP(h16, WS_HB), WSP(float, WS_SSQ), (unsigned char*)F.out + OUT_HB8, F8_O ? 1.0f / 4096.0f : 1.0f};
#if F8_O
            pg8::Gemm g{WSP(const h16, OFF_OATT), WSP(const h16, WS_WO), DM / 2, DM / 2, DM / 2, nullptr}; pg8::gemm_phase<pg8::EpiResid, pg8::StaticOrder, false, 1>(F.lds, F.tid, g, S, E);
#else
            pg8::Gemm g{WSP(const h16, OFF_OATT), WSP(const h16, WS_WO), DM, DM, DM, nullptr}; pg8::gemm_phase(F.lds, F.tid, g, S, E);
#endif
            } SEAM(pb + 8);
        if (IN(pb + 9)) for (int rep = 0; rep < REPS(9); ++rep) { phase_router(F, p, l); } SEAM(pb + 9);
        if (IN(pb + 10)) for (int rep = 0; rep < REPS(10); ++rep) { phase_dispatch(F, l); } SEAM(pb + 10);
        if (IN(pb + 11)) for (int rep = 0; rep < REPS(11); ++rep) {
            pg8::GroupOrder S{WSP(const int, OFF_TILEE), __builtin_amdgcn_readfirstlane((int)WSP(const unsigned, WS_CTL)[CW_NTILES + l]), F.G, F.vcu}; pg8::EpiGated E{WSP(h16, OFF_HP), WSP(const float, OFF_SRSTD), F8_UP ? 1.0f / 256.0f : 1.0f};
#if F8_UP
            pg8::Gemm g{(const h16*)((const unsigned char*)F.out + OUT_HB8), WSP(const h16, WS_W13), DM / 2, DM / 2, DM / 2, WSP(const int, OFF_STOK)}; pg8::gemm_phase<pg8::EpiGated, pg8::GroupOrder, true, 1>(F.lds, F.tid, g, S, E);
#else
            pg8::Gemm g{WSP(const h16, WS_HB), WSP(const h16, WS_W13), DM, DM, DM, WSP(const int, OFF_STOK)}; pg8::gemm_phase<pg8::EpiGated, pg8::GroupOrder, true>(F.lds, F.tid, g, S, E);
#endif
            } SEAM(pb + 11);
        if (IN(pb + 12)) for (int rep = 0; rep < REPS(12); ++rep) {
            pg8::GroupOrder S{WSP(const int, OFF_TILEE), __builtin_amdgcn_readfirstlane((int)WSP(const unsigned, WS_CTL)[CW_NTILES + l]), F.G, F.vcu}; pg8::EpiPlain16 E{WSP(h16, OFF_YP), 1.0f / 4096.0f};
#if F8_DOWN
            pg8::Gemm g{WSP(const h16, OFF_HP), WSP(const h16, WS_W2), 256, 256, 256, nullptr}; pg8::gemm_phase<pg8::EpiPlain16, pg8::GroupOrder, false, 1>(F.lds, F.tid, g, S, E);
#else
            pg8::Gemm g{WSP(const h16, OFF_HP), WSP(const h16, WS_W2), 512, 512, 512, nullptr}; pg8::gemm_phase(F.lds, F.tid, g, S, E);
#endif
            } SEAM(pb + 12);
        if (IN(pb + 13)) for (int rep = 0; rep < REPS(13); ++rep) { phase_combine(F, p, l); } SEAM(pb + 13);
    }
#undef IN
#undef INR
#undef SEAM
}

extern "C" void kernel_launch(void* const* d_in, const int* in_sizes, int n_in, void* d_out, int out_size, void* d_ws, size_t ws_size, hipStream_t stream) {
    static int grid = 0;
    if (grid == 0) {
        if (n_in != 32 || out_size != NT * DM || ws_size < WS_END) { fprintf(stderr, "kernel_launch: unexpected shapes / workspace (%d inputs, out %d, ws %zu < %zu)\n", n_in, out_size, ws_size, (size_t)WS_END); grid = -1; return; }
        int dev = 0, cus = 0, per_cu = 0;
        if (hipGetDevice(&dev) != hipSuccess || hipDeviceGetAttribute(&cus, hipDeviceAttributeMultiprocessorCount, dev) != hipSuccess) { grid = -1; return; }
        if (hipFuncSetAttribute((const void*)fwd, hipFuncAttributeMaxDynamicSharedMemorySize, LDS_BYTES) != hipSuccess) { fprintf(stderr, "kernel_launch: hipFuncSetAttribute failed\n"); grid = -1; return; }
        if (hipOccupancyMaxActiveBlocksPerMultiprocessor(&per_cu, (const void*)fwd, 512, LDS_BYTES) != hipSuccess || per_cu < 1) { fprintf(stderr, "kernel_launch: occupancy query says %d\n", per_cu); }
        (void)hipGetLastError();
        grid = cus;
    }
    if (grid < 0) return;
    (void)hipMemsetAsync((char*)d_ws + WS_CTL, 0, CTL_ZERO_BYTES, stream);
    Prm p{};
    for (int i = 0; i < 32; ++i) p.in[i] = (const float*)d_in[i];
    p.out = (float*)d_out; p.ws = (unsigned char*)d_ws;
#if defined(PROBE_PHASE)
    p.ph_lo = 0; p.ph_hi = PROBE_PHASE + 1; hipLaunchKernelGGL(fwd, dim3(grid), dim3(512), LDS_BYTES, stream, p);
    (void)hipMemsetAsync((char*)d_ws + WS_CTL + CW_BAR * 4, 0, XCD_BAR_WORDS * 4, stream);
    p.ph_lo = PROBE_PHASE; p.ph_hi = PROBE_PHASE + 1; hipLaunchKernelGGL(fwd, dim3(grid), dim3(512), LDS_BYTES, stream, p);
    p.ph_lo = PROBE_PHASE + 1; p.ph_hi = NPHASES; hipLaunchKernelGGL(fwd, dim3(grid), dim3(512), LDS_BYTES, stream, p);
#elif MK_SINGLE
    p.ph_lo = 0; p.ph_hi = NPHASES;
    hipLaunchKernelGGL(fwd, dim3(grid), dim3(512), LDS_BYTES, stream, p);
#else
    for (int ph = 0; ph < NPHASES; ++ph) { p.ph_lo = ph; p.ph_hi = ph + 1; hipLaunchKernelGGL(fwd, dim3(grid), dim3(512), LDS_BYTES, stream, p); }
#endif
}
```

```cpp
#include <hip/hip_runtime.h>
#include <cstdio>
#include <cstdint>

#ifndef MK_SINGLE
#define MK_SINGLE 1
#endif

typedef _Float16 h16;
typedef _Float16 h16x2 __attribute__((ext_vector_type(2)));
typedef _Float16 h16x4 __attribute__((ext_vector_type(4)));
typedef _Float16 h16x8 __attribute__((ext_vector_type(8)));
typedef float f32x2 __attribute__((ext_vector_type(2)));
typedef float f32x4 __attribute__((ext_vector_type(4)));
typedef unsigned u32x2 __attribute__((ext_vector_type(2)));
typedef unsigned u32x4 __attribute__((ext_vector_type(4)));
typedef int i32x4 __attribute__((ext_vector_type(4)));
typedef int i32x8 __attribute__((ext_vector_type(8)));
#define LAS __attribute__((address_space(3)))
#define GAS __attribute__((address_space(1)))
#define PIN() do { asm volatile("" ::: "memory"); __builtin_amdgcn_sched_barrier(0); } while (0)
#define PINV(x) asm volatile("" : "+v"(x) :: "memory")
#define NTL(T, p) __builtin_nontemporal_load((const T*)(p))
#ifndef F8_PROJ
#define F8_PROJ 0
#endif
#ifndef F8_Q
#define F8_Q 1
#endif
#ifndef F8_UP
#define F8_UP 1
#endif
#ifndef F8_DOWN
#define F8_DOWN 1
#endif
#ifndef F8_OUT
#define F8_OUT 0
#endif
#ifndef F8_O
#define F8_O 1
#endif
#define F8_HB (F8_PROJ || F8_Q || F8_UP)
#define MFMA16(a, b, c) __builtin_amdgcn_mfma_f32_16x16x32_f16((a), (b), (c), 0, 0, 0)

constexpr int NB = 16, SEQ = 2048, DM = 1024, NT = NB * SEQ, MEML = 256, NTM = NB * MEML, NLAYER = 2;
constexpr int NPJ = 3584;
constexpr int CQ = 0, CK = 384, CV = 768, CG = 1152, CZ = 1536, CXS = 1920, CBM = 2304, CCM = 2560, CXR = 2816, CGT = 3072, CDT = 3328;
constexpr int DIN = 3334, NCH = 16, MAXSLOT = 73728;
constexpr float EPS = 1e-6f;
constexpr int NPH = 14;
constexpr int NPHASES = NLAYER * NPH;

constexpr size_t MiB = (size_t)1 << 20;
constexpr size_t WS_CTL = 0, CTL_ZERO_BYTES = 64 * 1024;
constexpr size_t WS_WIN = 1 * MiB, WS_WOUT = 8 * MiB, WS_WQ = 10 * MiB, WS_WKV = 12 * MiB, WS_WO = 16 * MiB, WS_W13 = 18 * MiB, WS_W2 = 82 * MiB, WS_LRUW = 114 * MiB;
constexpr size_t WS_HB = 115 * MiB;
constexpr size_t WS_R1 = 179 * MiB;
constexpr size_t WS_R2 = 403 * MiB;
constexpr size_t WS_KV = 547 * MiB, WS_MEM16 = 563 * MiB, WS_SSQ = 571 * MiB, WS_MISC = 573 * MiB, WS_END = 577 * MiB;
constexpr size_t OFF_QCA = WS_R1, OFF_OATT = WS_R1 + 64 * MiB, OFF_XP = WS_R1, OFF_HP = WS_R1 + 144 * MiB;
constexpr size_t OFF_OMIX = WS_R2, OFF_RST = WS_R2 + 64 * MiB, OFF_SST = WS_R2 + 88 * MiB, OFF_LSUM = WS_R2 + 136 * MiB, OFF_SDEC = WS_R2 + 137 * MiB, OFF_LCAR = WS_R2 + 138 * MiB, OFF_YP = WS_R2;
constexpr size_t OUT_HB8 = 0;
constexpr size_t OUT_XTG = 0, OUT_BCN = 24 * MiB, OUT_LAU = 56 * MiB;
constexpr size_t OFF_OMIX8 = WS_W13 + 32 * MiB;
static_assert(!F8_OUT || F8_UP, "OMIX8 lives in the space freed by the fp8 expert weights");
constexpr size_t OFF_KB = WS_KV, OFF_VT = WS_KV + 8 * MiB;
constexpr size_t OFF_ROPE = WS_MISC, OFF_MSSQ = WS_MISC + 512 * 1024, OFF_EID = WS_MISC + 768 * 1024, OFF_GATE = WS_MISC + 1024 * 1024, OFF_TSLOT = WS_MISC + 1280 * 1024,
                 OFF_RSTDT = WS_MISC + 1536 * 1024, OFF_SRSTD = WS_MISC + 1664 * 1024, OFF_TILEE = WS_MISC + 2000 * 1024, OFF_STOK = WS_MISC + 2048 * 1024, OFF_RWG = WS_MISC + 2400 * 1024, OFF_MRSTD = WS_MISC + 2600 * 1024;
constexpr int CW_COUNTS = 64, CW_CURSOR = 192, CW_NTILES = 320, CW_BAR = 4096;

constexpr int LDS_BYTES = 152 * 1024;
constexpr int LDS_MISC = 150 * 1024;

struct Prm { const float* in[32]; float* out; unsigned char* ws; int ph_lo, ph_hi; };

#define XB_TMO      128
#define XB_XCNT(j)  (256  + 64 * (j))
#define XB_XSUB(j)  (1280 + 64 * (j))
#define XB_XGEN(j)  (2304 + 64 * (j))
#define XB_TOP      3328
#define XB_TOPGEN   3392
#define XCD_BAR_WORDS 3456
#define XB_SPIN_CAP (1u << 18)
__device__ __forceinline__ unsigned xb_ld(unsigned* p)              { return __hip_atomic_load(p, __ATOMIC_RELAXED, __HIP_MEMORY_SCOPE_AGENT); }
__device__ __forceinline__ unsigned xb_add(unsigned* p, unsigned v) { return __hip_atomic_fetch_add(p, v, __ATOMIC_RELAXED, __HIP_MEMORY_SCOPE_AGENT); }
__device__ __forceinline__ unsigned xb_xcc_id() { return (unsigned)__builtin_amdgcn_s_getreg((3 << 11) | 20) & 0xFu; }
#define XB_SPIN(cond, bar) do { unsigned _sp = 0; while (cond) { __builtin_amdgcn_s_sleep(1); \
    if ((++_sp & 255u) == 0u) { if (xb_ld(&(bar)[XB_TMO])) break; if (_sp > XB_SPIN_CAP) { atomicAdd(&(bar)[XB_TMO], 1u); break; } } } } while (0)
struct XcdBarrier { unsigned* bar; unsigned x; volatile LAS unsigned* st; };
__device__ __forceinline__ XcdBarrier xcd_barrier_post(unsigned* bar, volatile LAS unsigned* st) {
    XcdBarrier b; b.bar = bar; b.x = xb_xcc_id(); b.st = st;
    if (threadIdx.x == 0) (void)xb_add(&bar[XB_XCNT(b.x)], 1u);
    return b;
}
__device__ __forceinline__ void xcd_barrier_complete(unsigned* bar, unsigned x, unsigned& nloc, unsigned& nx) {
    const unsigned G = gridDim.x * gridDim.y * gridDim.z;
    unsigned sum, cnt, mine, sp = 0u;
    for (;;) {
        sum = 0u; cnt = 0u; mine = 0u;
#pragma unroll
        for (unsigned j = 0; j < 16; ++j) { const unsigned c = xb_ld(&bar[XB_XCNT(j)]); sum += c; cnt += (c > 0u) ? 1u : 0u; mine = (j == x) ? c : mine; }
        if (sum == G) break;
        __builtin_amdgcn_s_sleep(1);
        if ((++sp & 255u) == 0u) { if (xb_ld(&bar[XB_TMO])) break; if (sp > XB_SPIN_CAP) { atomicAdd(&bar[XB_TMO], 1u); break; } }
    }
    nloc = mine > 0u ? mine : 1u; nx = cnt > 0u ? cnt : 1u;
}
__device__ __forceinline__ void xcd_barrier(const XcdBarrier& b) {
    asm volatile("s_waitcnt vmcnt(0)" ::: "memory");
    __syncthreads();
    if (threadIdx.x == 0) {
        unsigned* bar = b.bar;
        __builtin_amdgcn_s_waitcnt(0);
        unsigned nloc = b.st[0], nx = b.st[1];
        if (nloc == 0u) { xcd_barrier_complete(bar, b.x, nloc, nx); b.st[0] = nloc; b.st[1] = nx; }
        const unsigned old = xb_add(&bar[XB_XSUB(b.x)], 1u);
        const unsigned gen = old / nloc;
        if (old + 1u == (gen + 1u) * nloc) {
            __builtin_amdgcn_fence(__ATOMIC_RELEASE, "agent");
            asm volatile("s_waitcnt vmcnt(0)" ::: "memory");
            const unsigned og = xb_add(&bar[XB_TOP], 1u);
            const unsigned tg = og / nx;
            if (og + 1u == (tg + 1u) * nx) xb_add(&bar[XB_TOPGEN], 1u);
            else XB_SPIN(xb_ld(&bar[XB_TOPGEN]) == tg, bar);
            __builtin_amdgcn_fence(__ATOMIC_ACQUIRE, "agent");
            xb_add(&bar[XB_XGEN(b.x)], 1u);
            asm volatile("s_waitcnt vmcnt(0)" ::: "memory");
        } else {
            XB_SPIN(xb_ld(&bar[XB_XGEN(b.x)]) == gen, bar);
            __builtin_amdgcn_fence(__ATOMIC_ACQUIRE, "agent");
            asm volatile("s_waitcnt vmcnt(0)" ::: "memory");
        }
    }
    __syncthreads();
}

__device__ __forceinline__ float wave_sum(float v) {
#pragma unroll
    for (int o = 1; o < 64; o <<= 1) v += __shfl_xor(v, o);
    return v;
}
__device__ __forceinline__ float siluf_(float x) { return x * __builtin_amdgcn_rcpf(1.0f + __expf(-x)); }
__device__ __forceinline__ float softplusf_(float x) { return x > 20.f ? x : log1pf(__expf(x)); }
__device__ __forceinline__ float gelu_tanh_(float x) { const float y = 0.7978845608028654f * (x + 0.044715f * x * x * x); const float t = 1.0f - 2.0f / (__expf(2.0f * y) + 1.0f); return 0.5f * x * (1.0f + t); }
__device__ __forceinline__ h16x8 pack8(const f32x4 a, const f32x4 b) { h16x8 r; r[0] = (h16)a[0]; r[1] = (h16)a[1]; r[2] = (h16)a[2]; r[3] = (h16)a[3]; r[4] = (h16)b[0]; r[5] = (h16)b[1]; r[6] = (h16)b[2]; r[7] = (h16)b[3]; return r; }
__device__ __forceinline__ h16x4 pack4(const f32x4 a) { h16x4 r; r[0] = (h16)a[0]; r[1] = (h16)a[1]; r[2] = (h16)a[2]; r[3] = (h16)a[3]; return r; }
__device__ __forceinline__ unsigned cvt4_fp8(float a, float b, float c, float d) {
    a = __builtin_amdgcn_fmed3f(a, -448.f, 448.f); b = __builtin_amdgcn_fmed3f(b, -448.f, 448.f); c = __builtin_amdgcn_fmed3f(c, -448.f, 448.f); d = __builtin_amdgcn_fmed3f(d, -448.f, 448.f);
    int p = __builtin_amdgcn_cvt_pk_fp8_f32(a, b, 0, false); p = __builtin_amdgcn_cvt_pk_fp8_f32(c, d, p, true); return (unsigned)p; }
__device__ __forceinline__ h16x8 ldsfrag(LAS const h16* p) { return *(LAS const h16x8*)p; }
__device__ __forceinline__ int kperm32(int k) { return (k & ~31) | (((k >> 2) & 3) << 3) | (((k >> 4) & 1) << 2) | (k & 3); }
__device__ __forceinline__ h16x8 scalefrag(const h16x8 f, float s) { const h16 hs = (h16)s; h16x8 v;
#pragma unroll
    for (int j = 0; j < 8; ++j) v[j] = hs; return f * v; }
__device__ __forceinline__ float row_rstd(const float* ssq16) {
    const f32x4 a = *(const f32x4*)ssq16, b = *(const f32x4*)(ssq16 + 4), c = *(const f32x4*)(ssq16 + 8), d = *(const f32x4*)(ssq16 + 12);
    const float s = ((a[0] + a[1]) + (a[2] + a[3])) + ((b[0] + b[1]) + (b[2] + b[3])) + ((c[0] + c[1]) + (c[2] + c[3])) + ((d[0] + d[1]) + (d[2] + d[3]));
    return 1.0f / sqrtf(s * (1.0f / DM) + EPS);
}

namespace pg8 {
constexpr int BM = 256, BK = 64, HALF = 128, HTB = HALF * BK * 2, STAGE_BYTES = 8 * HTB, NXCD = 8, WGM = 8;
__host__ __device__ __forceinline__ int lds_byte(int r, int c) { const int st = (r >> 4) * 2 + (c >> 5), rr = r & 15, cc = c & 31, ob = rr * 64 + cc * 2; return st * 1024 + (ob ^ (((ob >> 9) & 1) << 5)); }
__host__ __device__ __forceinline__ void stage_rc(int b, int& R, int& C) { const int st = b / 1024, sb = b % 1024, swz = sb ^ (((sb >> 9) & 1) << 5); R = (st >> 1) * 16 + swz / 64; C = (st & 1) * 32 + (swz % 64) / 2; }
__host__ __device__ __forceinline__ int perm32(int rho) { const int n = rho >> 4, i = rho & 15; return 8 * (i >> 2) + 4 * n + (i & 3); }
struct Unit { int pm, pn; };
struct Gemm { const h16* A; const h16* Bt; int lda, ldb, K; const int* rowidx; };
struct StaticOrder {
    int nM, nN, nwg, G, c;
    __device__ void init(int M, int N, int G_, int c_) { nM = M / BM; nN = N / BM; nwg = nM * nN; G = G_; c = c_; }
    __device__ bool next(int i, Unit& u) const {
        const long L = (long)i * G + c; if (L >= nwg) return false;
        int wgid = (int)L; { const int q = nwg / NXCD, r = nwg % NXCD, xcd = wgid % NXCD, off = wgid / NXCD; wgid = (xcd < r ? xcd * (q + 1) : r * (q + 1) + (xcd - r) * q) + off; }
        const int nig = WGM * nN, gid = wgid / nig, fm = gid * WGM, gsz = (nM - fm) < WGM ? (nM - fm) : WGM;
        u.pm = fm + ((wgid % nig) % gsz); u.pn = (wgid % nig) / gsz; return true;
    }
};
struct GroupOrder {
    const int* tile_e; int ntiles, G, vcu;
    __device__ bool next(int i, Unit& u) const {
        const int L = i * G + vcu, tile = L >> 2; if (tile >= ntiles) return false;
        u.pm = tile; u.pn = __builtin_amdgcn_readfirstlane(tile_e[tile]) * 4 + (L & 3); return true;
    }
};

struct EpiScale16 {
    static constexpr bool PERM = true;
    h16* O; int ldc; const float* ssq; float cs;
    __device__ __forceinline__ void operator()(const f32x4 (&acc)[2][2][4][2], const Unit& u, int wr, int wc, int fr, int fq) const {
        const int row0 = u.pm * BM + wr * 64 + fr, col0 = u.pn * BM + wc * 32 + 8 * fq;
#pragma unroll
        for (int ai = 0; ai < 2; ++ai)
#pragma unroll
            for (int m = 0; m < 4; ++m) { const int row = row0 + ai * HALF + m * 16; const float rs = row_rstd(ssq + (size_t)row * 16) * cs; h16* rowp = O + (size_t)row * ldc + col0;
#pragma unroll
                for (int bj = 0; bj < 2; ++bj) *(h16x8*)(rowp + bj * HALF) = pack8(acc[ai][bj][m][0] * rs, acc[ai][bj][m][1] * rs); }
    }
};
struct EpiScale16C {
    static constexpr bool PERM = true;
    h16* O; int ldc; const float* rstd; float cs;
    __device__ __forceinline__ void operator()(const f32x4 (&acc)[2][2][4][2], const Unit& u, int wr, int wc, int fr, int fq) const {
        const int row0 = u.pm * BM + wr * 64 + fr, col0 = u.pn * BM + wc * 32 + 8 * fq;
        float rs[2][4];
#pragma unroll
        for (int ai = 0; ai < 2; ++ai)
#pragma unroll
            for (int m = 0; m < 4; ++m) rs[ai][m] = rstd[row0 + ai * HALF + m * 16] * cs;
#pragma unroll
        for (int ai = 0; ai < 2; ++ai)
#pragma unroll
            for (int m = 0; m < 4; ++m) { h16* rowp = O + (size_t)(row0 + ai * HALF + m * 16) * ldc + col0;
#pragma unroll
                for (int bj = 0; bj < 2; ++bj) *(h16x8*)(rowp + bj * HALF) = pack8(acc[ai][bj][m][0] * rs[ai][m], acc[ai][bj][m][1] * rs[ai][m]); }
    }
};
struct EpiVT {
    static constexpr bool PERM = false;
    h16* VT; const float* mrstd;
    __device__ __forceinline__ void operator()(const f32x4 (&acc)[2][2][4][2], const Unit& u, int wr, int wc, int fr, int fq) const {
#pragma unroll
        for (int ai = 0; ai < 2; ++ai) { f32x4 rs[4];
#pragma unroll
            for (int m = 0; m < 4; ++m) rs[m] = *(const f32x4*)(mrstd + u.pm * BM + ai * HALF + wr * 64 + m * 16 + 4 * fq);
#pragma unroll
            for (int bj = 0; bj < 2; ++bj)
#pragma unroll
                for (int n = 0; n < 2; ++n) { h16* rowp = VT + ((size_t)(u.pm * 4 + u.pn) * 256 + bj * HALF + wc * 32 + n * 16 + fr) * 256 + ai * HALF + wr * 64 + 8 * fq;
#pragma unroll
                    for (int mm = 0; mm < 2; ++mm) *(h16x8*)(rowp + 32 * mm) = pack8(acc[ai][bj][2 * mm][n] * rs[2 * mm], acc[ai][bj][2 * mm + 1][n] * rs[2 * mm + 1]); } }
    }
};
struct EpiResid {
    static constexpr bool PERM = true;
    h16* hb; float* ssq; unsigned char* hb8; float cs;
    __device__ __forceinline__ void operator()(const f32x4 (&acc)[2][2][4][2], const Unit& u, int wr, int wc, int fr, int fq) const {
        const int row0 = u.pm * BM + wr * 64 + fr, col0 = u.pn * BM + wc * 32 + 8 * fq;
#pragma unroll
        for (int ai = 0; ai < 2; ++ai)
#pragma unroll
            for (int mp = 0; mp < 2; ++mp) { unsigned ch[2][2][2];
#pragma unroll
                for (int mm = 0; mm < 2; ++mm) { const int m = 2 * mp + mm; const int row = row0 + ai * HALF + m * 16; h16* rowp = hb + (size_t)row * DM + col0; float s = 0.f;
#pragma unroll
                    for (int bj = 0; bj < 2; ++bj) { const h16x8 bv = *(const h16x8*)(rowp + bj * HALF); f32x4 v0, v1;
#pragma unroll
                        for (int e = 0; e < 4; ++e) { v0[e] = (float)bv[e] + acc[ai][bj][m][0][e] * cs; v1[e] = (float)bv[4 + e] + acc[ai][bj][m][1][e] * cs; }
                        const h16x8 o = pack8(v0, v1); *(h16x8*)(rowp + bj * HALF) = o;
                        if (F8_HB) { ch[mm][bj][0] = cvt4_fp8(v0[0], v0[1], v0[2], v0[3]); ch[mm][bj][1] = cvt4_fp8(v1[0], v1[1], v1[2], v1[3]); }
#pragma unroll
                        for (int e = 0; e < 8; ++e) { const float q = (float)o[e]; s += q * q; } }
                    s += __shfl_xor(s, 16); s += __shfl_xor(s, 32);
                    if (fq == 0) ssq[(size_t)row * 16 + u.pn * 4 + wc] = s; }
                if (F8_HB) {
                    const int row = row0 + ai * HALF + (2 * mp + (fq & 1)) * 16; unsigned char* p8 = hb8 + (size_t)row * DM + u.pn * BM + wc * 32 + 8 * (fq & ~1);
#pragma unroll
                    for (int bj = 0; bj < 2; ++bj) { const auto s0 = __builtin_amdgcn_permlane16_swap(ch[0][bj][0], ch[1][bj][0], false, false), s1 = __builtin_amdgcn_permlane16_swap(ch[0][bj][1], ch[1][bj][1], false, false);
                        *(u32x4*)(p8 + bj * HALF) = (u32x4){s0[0], s1[0], s0[1], s1[1]}; } } }
    }
};
struct EpiGated {
    static constexpr bool PERM = true;
    h16* O; const float* srstd; float cs;
    __device__ __forceinline__ void operator()(const f32x4 (&acc)[2][2][4][2], const Unit& u, int wr, int wc, int fr, int fq) const {
        const int row0 = u.pm * BM + wr * 64 + fr, col0 = (u.pn & 3) * HALF + wc * 32 + 8 * fq;
#pragma unroll
        for (int ai = 0; ai < 2; ++ai)
#pragma unroll
            for (int m = 0; m < 4; ++m) { const int row = row0 + ai * HALF + m * 16; const float rs = srstd[row] * cs; f32x4 o[2];
#pragma unroll
                for (int n = 0; n < 2; ++n)
#pragma unroll
                    for (int j = 0; j < 4; ++j) { const float a = acc[ai][0][m][n][j] * rs, b = acc[ai][1][m][n][j] * rs; o[n][j] = siluf_(a) * b; }
                if (F8_DOWN) *(u32x2*)((unsigned char*)O + (size_t)row * 512 + col0) = (u32x2){cvt4_fp8(16.f * o[0][0], 16.f * o[0][1], 16.f * o[0][2], 16.f * o[0][3]), cvt4_fp8(16.f * o[1][0], 16.f * o[1][1], 16.f * o[1][2], 16.f * o[1][3])};
                else *(h16x8*)(O + (size_t)row * 512 + col0) = pack8(o[0], o[1]); }
    }
};
struct EpiPlain16 {
    static constexpr bool PERM = true;
    h16* O; float cs;
    __device__ __forceinline__ void operator()(const f32x4 (&acc)[2][2][4][2], const Unit& u, int wr, int wc, int fr, int fq) const {
        const int row0 = u.pm * BM + wr * 64 + fr, col0 = (u.pn & 3) * BM + wc * 32 + 8 * fq;
#pragma unroll
        for (int ai = 0; ai < 2; ++ai)
#pragma unroll
            for (int m = 0; m < 4; ++m) { h16* rowp = O + (size_t)(row0 + ai * HALF + m * 16) * DM + col0;
#pragma unroll
                for (int bj = 0; bj < 2; ++bj) *(h16x8*)(rowp + bj * HALF) = F8_DOWN ? pack8(acc[ai][bj][m][0] * cs, acc[ai][bj][m][1] * cs) : pack8(acc[ai][bj][m][0], acc[ai][bj][m][1]); }
    }
};

template <class Epi, class Sched, bool GATHER = false, int F8W = 0, bool SWAP = false>
__device__ __forceinline__ void gemm_phase(LAS unsigned char* lds, const int tid, const Gemm g, const Sched& S, const Epi& E) {
    const int wid = __builtin_amdgcn_readfirstlane(tid >> 6), lane = tid & 63, wr = wid >> 2, wc = wid & 3, fr = lane & 15, fq = lane >> 4;
    int K_ = g.K; asm volatile("" : "+s"(K_));
    const int K = K_, nt = K / BK;
    unsigned voffA[2], voffB[2];
#pragma unroll
    for (int i = 0; i < 2; ++i) { int R, C; stage_rc(tid * 16 + i * 8192, R, C); const int Rb = Epi::PERM ? ((R & ~31) + perm32(R & 31)) : R;
        voffA[i] = (unsigned)(R * g.lda + C) * 2u; voffB[i] = (unsigned)(Rb * g.ldb + C) * 2u; }
    const size_t kstep = (size_t)(BK * 2);
    const size_t hstepA = (size_t)HALF * g.lda * 2, hstepB = (size_t)HALF * g.ldb * 2;
    const size_t tstepA = 2 * hstepA, tstepB = 2 * hstepB;
    const unsigned ldsw = (unsigned)wid * 1024u;
    const int aoff = lds_byte(wr * 64 + fr, fq * 8), boff = lds_byte(wc * 32 + fr, fq * 8);
#define PG8_SA(b, h) (((b) * 2 + (h)) * HTB)
#define PG8_SB(b, h) ((4 + (b) * 2 + (h)) * HTB)
#define PG8_STAGE(bufoff, gbase, voff) do { _Pragma("unroll") for (int _i = 0; _i < 2; ++_i) \
        __builtin_amdgcn_global_load_lds((const unsigned*)((const char*)(gbase) + (voff)[_i]), (LAS unsigned*)(lds + (bufoff) + ldsw + _i * 8192), 16, 0, 0); } while (0)
    unsigned coff[2], noff[2], cbyte[2];
    if constexpr (GATHER) {
#pragma unroll
        for (int i = 0; i < 2; ++i) { int R_, C_; stage_rc(tid * 16 + i * 8192, R_, C_); cbyte[i] = (unsigned)(C_ * 2); } }
#define PG8_GOFF(u_, o_) do { _Pragma("unroll") for (int _i = 0; _i < 2; ++_i) { int R_, C_; stage_rc(tid * 16 + _i * 8192, R_, C_); \
        o_[_i] = (unsigned)g.rowidx[(u_).pm * BM + R_] | ((unsigned)g.rowidx[(u_).pm * BM + HALF + R_] << 16); } } while (0)
#define PG8_STAGEA(bufoff, gbase, h, sel) do { if constexpr (GATHER) { _Pragma("unroll") for (int _i = 0; _i < 2; ++_i) { const unsigned pk_ = (sel) ? noff[_i] : coff[_i]; \
        __builtin_amdgcn_global_load_lds((const unsigned*)((const char*)(gbase) + (((pk_ >> (16 * (h))) & 0xffffu) * (unsigned)(g.lda * 2) + cbyte[_i])), (LAS unsigned*)(lds + (bufoff) + ldsw + _i * 8192), 16, 0, 0); } } \
        else { PG8_STAGE(bufoff, (gbase) + ((h) ? hstepA : 0), voffA); } } while (0)
#define PG8_LDA(dst, b, h) do { _Pragma("unroll") for (int m = 0; m < 4; ++m) _Pragma("unroll") for (int k = 0; k < 2; ++k) dst[m][k] = *(const LAS h16x8*)(lds + PG8_SA(b, h) + aoff + m * 2048 + k * 1024); } while (0)
#define PG8_LDB(dst, b, h) do { _Pragma("unroll") for (int n = 0; n < 2; ++n) _Pragma("unroll") for (int k = 0; k < 2; ++k) dst[n][k] = *(const LAS h16x8*)(lds + PG8_SB(b, h) + boff + n * 2048 + k * 1024); } while (0)
#define PG8_MMA(ai, bj, At, Bt) do { __builtin_amdgcn_s_setprio(1); _Pragma("unroll") for (int m = 0; m < 4; ++m) _Pragma("unroll") for (int n = 0; n < 2; ++n) _Pragma("unroll") for (int k = 0; k < 2; ++k) \
        acc[ai][bj][m][n] = SWAP ? __builtin_amdgcn_mfma_f32_16x16x32_f16(At[m][k], Bt[n][k], acc[ai][bj][m][n], 0, 0, 0) : __builtin_amdgcn_mfma_f32_16x16x32_f16(Bt[n][k], At[m][k], acc[ai][bj][m][n], 0, 0, 0); __builtin_amdgcn_s_setprio(0); } while (0)
#define PG8_MMA8(ai, bj, At, Bt) do { __builtin_amdgcn_s_setprio(1); _Pragma("unroll") for (int m = 0; m < 4; ++m) _Pragma("unroll") for (int n = 0; n < 2; ++n) { \
        const i32x8 wf_ = __builtin_shufflevector(__builtin_bit_cast(i32x4, Bt[n][0]), __builtin_bit_cast(i32x4, Bt[n][1]), 0, 1, 2, 3, 4, 5, 6, 7), af_ = __builtin_shufflevector(__builtin_bit_cast(i32x4, At[m][0]), __builtin_bit_cast(i32x4, At[m][1]), 0, 1, 2, 3, 4, 5, 6, 7); \
        asm volatile("v_mfma_f32_16x16x128_f8f6f4 %0, %1, %2, %0" : "+v"(acc[ai][bj][m][n]) : "v"(wf_), "v"(af_)); } __builtin_amdgcn_s_setprio(0); } while (0)
#define PG8_MM(ai, bj, At, Bt) do { if constexpr (F8W != 0) PG8_MMA8(ai, bj, At, Bt); else PG8_MMA(ai, bj, At, Bt); } while (0)
#define PG8_WAIT_V(n) asm volatile("s_waitcnt vmcnt(" #n ")" ::: "memory")
#define PG8_WAIT_L(n) asm volatile("s_waitcnt lgkmcnt(" #n ")" ::: "memory")
#define PG8_BAR __builtin_amdgcn_s_barrier()
#define PG8_SCHED __builtin_amdgcn_sched_barrier(0)
    Unit cur, nxt; int ui = 0;
    if (!S.next(0, cur)) return;
    f32x4 acc[2][2][4][2];
#pragma unroll
    for (int a = 0; a < 2; ++a)
#pragma unroll
        for (int b = 0; b < 2; ++b)
#pragma unroll
            for (int m = 0; m < 4; ++m)
#pragma unroll
                for (int n = 0; n < 2; ++n) acc[a][b][m][n] = (f32x4){0.f, 0.f, 0.f, 0.f};
    h16x8 At[4][2], B0[2][2], B1[2][2];
    const char* cA = (const char*)g.A + (GATHER ? (size_t)0 : (size_t)cur.pm * tstepA); const char* cB = (const char*)g.Bt + (size_t)cur.pn * tstepB;
    if constexpr (GATHER) { PG8_GOFF(cur, coff); noff[0] = coff[0]; noff[1] = coff[1]; }
    PG8_STAGE(PG8_SB(0, 0), cB, voffB); PG8_STAGE(PG8_SB(0, 1), cB + hstepB, voffB); PG8_STAGEA(PG8_SA(0, 0), cA, 0, false); PG8_STAGEA(PG8_SA(0, 1), cA, 1, false);
    if (wr == 1) PG8_BAR;
    PG8_WAIT_V(2); PG8_BAR;
    PG8_STAGE(PG8_SB(1, 0), cB + kstep, voffB); PG8_STAGEA(PG8_SA(1, 0), cA + kstep, 0, false); PG8_STAGE(PG8_SB(1, 1), cB + hstepB + kstep, voffB);
    PG8_WAIT_V(6); PG8_BAR;
    for (;;) {
        const bool has_next = S.next(ui + 1, nxt);
        const char* nA = (has_next && !GATHER) ? (const char*)g.A + (size_t)nxt.pm * tstepA : cA; const char* nB = has_next ? (const char*)g.Bt + (size_t)nxt.pn * tstepB : cB;
        if constexpr (GATHER) { if (has_next) PG8_GOFF(nxt, noff); }
        for (int t = 0; t < nt; t += 2) {
            const bool last = (t == nt - 2);
            const char* a1 = cA + (size_t)(t + 1) * kstep;
            const char* a2 = last ? nA : cA + (size_t)(t + 2) * kstep; const char* b2 = last ? nB : cB + (size_t)(t + 2) * kstep;
            const char* a3 = a2 + kstep; const char* b3 = b2 + kstep;
            PG8_LDB(B0, 0, 0); PG8_LDB(B1, 0, 1); PG8_SCHED; PG8_LDA(At, 0, 0); PG8_STAGEA(PG8_SA(1, 1), a1, 1, false);
            PG8_WAIT_V(8); PG8_WAIT_L(0); PG8_BAR; PG8_MM(0, 0, At, B0); PG8_MM(0, 1, At, B1); PG8_BAR; PG8_SCHED;
            PG8_LDA(At, 0, 1); PG8_STAGE(PG8_SB(0, 0), b2, voffB); PG8_STAGE(PG8_SB(0, 1), b2 + hstepB, voffB); PG8_STAGEA(PG8_SA(0, 0), a2, 0, last);
            PG8_WAIT_V(8); PG8_WAIT_L(0); PG8_BAR; PG8_MM(1, 0, At, B0); PG8_MM(1, 1, At, B1); PG8_BAR; PG8_SCHED;
            PG8_LDB(B0, 1, 0); PG8_LDB(B1, 1, 1); PG8_SCHED; PG8_LDA(At, 1, 0); PG8_STAGEA(PG8_SA(0, 1), a2, 1, last);
            PG8_WAIT_V(8); PG8_WAIT_L(0); PG8_BAR; PG8_MM(0, 0, At, B0); PG8_MM(0, 1, At, B1); PG8_BAR; PG8_SCHED;
            PG8_LDA(At, 1, 1); PG8_STAGE(PG8_SB(1, 0), b3, voffB); PG8_STAGE(PG8_SB(1, 1), b3 + hstepB, voffB); PG8_STAGEA(PG8_SA(1, 0), a3, 0, last);
            PG8_WAIT_V(8); PG8_WAIT_L(0); PG8_BAR; PG8_MM(1, 0, At, B0); PG8_MM(1, 1, At, B1); PG8_BAR; PG8_SCHED;
        }
        if (wr == 0) PG8_BAR;
        if constexpr (F8W != 0) asm volatile("s_nop 7\n\ts_nop 7\n\ts_nop 7" ::: "memory");
        E(acc, cur, wr, wc, fr, fq);
        if (!has_next) break;
#pragma unroll
        for (int a = 0; a < 2; ++a)
#pragma unroll
            for (int b = 0; b < 2; ++b)
#pragma unroll
                for (int m = 0; m < 4; ++m)
#pragma unroll
                    for (int n = 0; n < 2; ++n) acc[a][b][m][n] = (f32x4){0.f, 0.f, 0.f, 0.f};
        cur = nxt; cA = nA; cB = nB; ++ui;
        if constexpr (GATHER) { coff[0] = noff[0]; coff[1] = noff[1]; }
        if (wr == 1) PG8_BAR;
    }
    PG8_WAIT_V(0);
    PG8_BAR;
#undef PG8_SA
#undef PG8_SB
#undef PG8_STAGE
#undef PG8_LDA
#undef PG8_GOFF
#undef PG8_STAGEA
#undef PG8_LDB
#undef PG8_MMA
#undef PG8_MMA8
#undef PG8_MM
#undef PG8_WAIT_V
#undef PG8_WAIT_L
#undef PG8_BAR
#undef PG8_SCHED
}
}

struct Frame {
    LAS unsigned char* lds;
    GAS unsigned char* ws;
    volatile LAS unsigned long long* ptab;
    float* out;
    int tid, lane, wave, G, vcu;
};
#define WSP(T, off) ((T*)(GAS T*)(F.ws + (off)))
__device__ __forceinline__ const float* inptr(const Frame& F, int i) {
    const unsigned long long v = F.ptab[i];
    const unsigned lo = __builtin_amdgcn_readfirstlane((unsigned)v), hi = __builtin_amdgcn_readfirstlane((unsigned)(v >> 32));
    return (const float*)(GAS const float*)(((unsigned long long)hi << 32) | lo);
}
__device__ __forceinline__ void launder(Frame& F) {
    int wv = F.wave; asm volatile("" : "+s"(wv)); F.wave = wv;
    unsigned z = 0u; asm volatile("" : "+v"(z));
    int t = wv * 64 + (int)__builtin_amdgcn_mbcnt_hi(~0u, __builtin_amdgcn_mbcnt_lo(~0u, z)); F.tid = t; F.lane = t & 63;
    const unsigned long long w = (unsigned long long)F.ws; unsigned wl = __builtin_amdgcn_readfirstlane((unsigned)w), wh = __builtin_amdgcn_readfirstlane((unsigned)(w >> 32));
    asm volatile("" : "+s"(wl), "+s"(wh)); F.ws = (GAS unsigned char*)(((unsigned long long)wh << 32) | wl);
    unsigned lo = __builtin_amdgcn_readfirstlane((unsigned)(uintptr_t)F.lds); asm volatile("" : "+s"(lo)); F.lds = (LAS unsigned char*)(uintptr_t)lo;
    int v = __builtin_amdgcn_readfirstlane(F.vcu); asm volatile("" : "+s"(v)); F.vcu = v;
}

struct TrItem { const float* W; const float* g; h16* Wt; int ldw, sc, nvalid, ldt, d0, k0, vw, f8; float mul; };
__device__ __forceinline__ void tr_describe(const Frame& F, GAS unsigned char* wsb_, int l, int it, TrItem& d) {
    unsigned char* wsb = (unsigned char*)wsb_;
    int r = it; d.g = nullptr; d.mul = 1.f; d.nvalid = 64; d.vw = 4; d.ldt = DM; d.ldw = DM; d.f8 = 0;
    if (r < 896) { const int d0 = 64 * (r % 56); d.W = inptr(F, 3) + (size_t)l * DM * DIN; d.ldw = DIN; d.g = inptr(F, 2) + l * DM; d.Wt = (h16*)(wsb + WS_WIN); d.d0 = d0; d.k0 = 64 * (r / 56); d.vw = 2; if (F8_PROJ) { d.f8 = 1; d.mul = 256.f; }
        if (d0 < 2816) d.sc = d0; else if (d0 < 3328) d.sc = d0 + 6; else if (d0 == 3328) { d.sc = 2816; d.nvalid = 6; } else { d.sc = 0; d.nvalid = 0; } return; } r -= 896;
    if (r < 256) { d.W = inptr(F, 4) + (size_t)l * DM * DM; if (F8_OUT) { d.f8 = 1; d.mul = 256.f; } d.Wt = (h16*)(wsb + WS_WOUT); d.d0 = d.sc = 64 * (r % 16); d.k0 = 64 * (r / 16); return; } r -= 256;
    if (r < 256) { d.W = inptr(F, 20) + (size_t)l * DM * DM; d.g = inptr(F, 18) + l * DM; d.mul = F8_Q ? 256.f : 0.0625f; d.f8 = F8_Q; d.Wt = (h16*)(wsb + WS_WQ); d.d0 = d.sc = 64 * (r % 16); d.k0 = 64 * (r / 16); return; } r -= 256;
    if (r < 512) { d.W = inptr(F, 21) + (size_t)l * DM * 2048; d.ldw = 2048; d.g = inptr(F, 19) + l * DM; d.Wt = (h16*)(wsb + WS_WKV); d.d0 = d.sc = 64 * (r % 32); d.k0 = 64 * (r / 32); return; } r -= 512;
    if (r < 256) { d.W = inptr(F, 22) + (size_t)l * DM * DM; if (F8_O) { d.f8 = 1; d.mul = 256.f; } d.Wt = (h16*)(wsb + WS_WO); d.d0 = d.sc = 64 * (r % 16); d.k0 = 64 * (r / 16); return; } r -= 256;
    if (r < 8192) { const int e = r / 256, q = r % 256, d0 = 64 * (q % 16), grp = d0 >> 8, rr = d0 & 255;
        d.W = (rr < 128 ? inptr(F, 28) : inptr(F, 29)) + (size_t)(l * 32 + e) * DM * 512; d.ldw = 512; d.sc = grp * 128 + (rr & 127); d.g = inptr(F, 23) + l * DM; d.Wt = (h16*)(wsb + WS_W13 + (size_t)e * DM * DM * (F8_UP ? 1 : 2)); if (F8_UP) { d.f8 = 1; d.mul = 256.f; } d.d0 = d0; d.k0 = 64 * (q / 16); return; } r -= 8192;
    if (r < 4096) { const int e = r / 128, q = r % 128; d.W = inptr(F, 30) + (size_t)(l * 32 + e) * 512 * DM; d.Wt = (h16*)(wsb + WS_W2 + (size_t)e * DM * 512 * (F8_DOWN ? 1 : 2)); if (F8_DOWN) { d.f8 = 1; d.mul = 256.f; } d.ldt = 512; d.d0 = d.sc = 64 * (q % 16); d.k0 = 64 * (q / 16); return; } r -= 4096;
    { const int blk = r & 3, gate = (r >> 2) & 1, dir = r >> 3; d.W = (gate ? inptr(F, 16) : inptr(F, 14)) + (size_t)((l * 2 + dir) * 4 + blk) * 4096; d.ldw = 64; d.Wt = (h16*)(wsb + WS_LRUW) + (size_t)((dir * 2 + gate) * 4 + blk) * 4096; d.ldt = 64; d.d0 = d.sc = 0; d.k0 = 0; }
}
__device__ __forceinline__ void tr_load(const TrItem& d, int lane, f32x4 (&v)[16]) {
    if (d.vw == 4) { const int col = 4 * (lane & 15); const float* src = d.W + (size_t)(d.k0 + (lane >> 4)) * d.ldw + d.sc + col; const bool ok = col < d.nvalid;
#pragma unroll
        for (int i = 0; i < 16; ++i) v[i] = ok ? __builtin_nontemporal_load((const f32x4*)(src + (size_t)(4 * i) * d.ldw)) : (f32x4){0.f, 0.f, 0.f, 0.f};
    } else { const int col = 2 * (lane & 31); const float* src = d.W + (size_t)(d.k0 + (lane >> 5)) * d.ldw + d.sc + col; const bool ok = col < d.nvalid;
#pragma unroll
        for (int i = 0; i < 16; ++i) { const f32x2 a = ok ? __builtin_nontemporal_load((const f32x2*)(src + (size_t)(4 * i) * d.ldw)) : (f32x2){0.f, 0.f}, c = ok ? __builtin_nontemporal_load((const f32x2*)(src + (size_t)(4 * i + 2) * d.ldw)) : (f32x2){0.f, 0.f}; v[i] = (f32x4){a[0], a[1], c[0], c[1]}; } }
}
__device__ __forceinline__ void tr_to_lds(const TrItem& d, int lane, const f32x4 (&v)[16], LAS float* scr) {
    if (d.vw == 4) { LAS float* q = scr + (lane >> 4) * 65 + 4 * (lane & 15);
#pragma unroll
        for (int i = 0; i < 16; ++i) { q[(4 * i) * 65 + 0] = v[i][0]; q[(4 * i) * 65 + 1] = v[i][1]; q[(4 * i) * 65 + 2] = v[i][2]; q[(4 * i) * 65 + 3] = v[i][3]; }
    } else { LAS float* q = scr + (lane >> 5) * 65 + 2 * (lane & 31);
#pragma unroll
        for (int i = 0; i < 16; ++i) { q[(4 * i) * 65 + 0] = v[i][0]; q[(4 * i) * 65 + 1] = v[i][1]; q[(4 * i + 2) * 65 + 0] = v[i][2]; q[(4 * i + 2) * 65 + 1] = v[i][3]; } }
}
__device__ __forceinline__ void tr_from_lds(const TrItem& d, int lane, LAS const float* scr) {
    const int c = lane & 7; float gs[8];
    if (d.g) { const f32x4 g0 = *(const f32x4*)(d.g + d.k0 + 8 * c), g1 = *(const f32x4*)(d.g + d.k0 + 8 * c + 4);
        gs[0] = g0[0] * d.mul; gs[1] = g0[1] * d.mul; gs[2] = g0[2] * d.mul; gs[3] = g0[3] * d.mul; gs[4] = g1[0] * d.mul; gs[5] = g1[1] * d.mul; gs[6] = g1[2] * d.mul; gs[7] = g1[3] * d.mul;
    } else {
#pragma unroll
        for (int e = 0; e < 8; ++e) gs[e] = d.mul; }
    if (d.f8) {
#pragma unroll
        for (int j = 0; j < 8; ++j) { const int nn = (lane >> 3) + 8 * j; LAS const float* q = scr + (8 * c) * 65 + nn; float f[8];
#pragma unroll
            for (int e = 0; e < 8; ++e) f[e] = q[e * 65] * gs[e];
            *(u32x2*)((unsigned char*)d.Wt + (size_t)(d.d0 + nn) * d.ldt + d.k0 + 8 * c) = (u32x2){cvt4_fp8(f[0], f[1], f[2], f[3]), cvt4_fp8(f[4], f[5], f[6], f[7])}; }
        return; }
#pragma unroll
    for (int j = 0; j < 8; ++j) { const int nn = (lane >> 3) + 8 * j; LAS const float* q = scr + (8 * c) * 65 + nn; h16x8 o;
#pragma unroll
        for (int e = 0; e < 8; ++e) o[e] = (h16)(q[e * 65] * gs[e]);
        *(h16x8*)(d.Wt + (size_t)(d.d0 + nn) * d.ldt + d.k0 + 8 * c) = o; }
}
__device__ __forceinline__ void phase_convert(const Frame& F, const Prm& p, int l) {
    LAS float* scr = (LAS float*)(F.lds + F.wave * 16640);
    const int gw = F.vcu * 8 + F.wave, NGW = F.G * 8;
    constexpr int NITEMS = 896 + 256 + 256 + 512 + 256 + 8192 + 4096 + 16;
    { TrItem cur, nxt; f32x4 v[16]; int it = gw;
        if (it < NITEMS) { tr_describe(F, F.ws, l, it, cur); tr_load(cur, F.lane, v); }
        while (it < NITEMS) { const int itn = it + NGW; const bool hn = itn < NITEMS;
            tr_to_lds(cur, F.lane, v, scr);
            if (hn) { tr_describe(F, F.ws, l, itn, nxt); tr_load(nxt, F.lane, v); }
            asm volatile("s_waitcnt lgkmcnt(0)" ::: "memory");
            tr_from_lds(cur, F.lane, scr);
            asm volatile("s_waitcnt lgkmcnt(0)" ::: "memory");
            cur = nxt; it = itn; } }
    {
        const float* gm = inptr(F, 23) + l * DM; const float* wg = inptr(F, 24) + (size_t)l * DM * 4; const float* we = inptr(F, 26) + (size_t)l * DM * 32; h16* rwg = WSP(h16, OFF_RWG);
        for (int i = F.vcu * 512 + F.tid; i < 36 * DM; i += 256 * 512) { const int k = i / 36, j = i % 36; const float wv = gm[k] * (j < 4 ? wg[k * 4 + j] : we[k * 32 + (j - 4)]) * 1024.0f;
            const h16 hi = (h16)wv; rwg[(size_t)j * 1032 + k] = hi; rwg[(size_t)(36 + j) * 1032 + k] = (h16)(wv - (float)hi); } }
    if (l == 0) {
        for (int m = gw; m < NT + NTM; m += NGW) {
            const bool isx = m < NT; const int row = isx ? m : m - NT;
            const float* src = (isx ? inptr(F, 0) : inptr(F, 1)) + (size_t)row * DM; h16* dst = (isx ? WSP(h16, WS_HB) : WSP(h16, WS_MEM16)) + (size_t)row * DM;
            float* sq = (isx ? WSP(float, WS_SSQ) : WSP(float, OFF_MSSQ)) + (size_t)row * 16;
            float s = 0.f;
#pragma unroll
            for (int j = 0; j < 4; ++j) { const f32x4 v = __builtin_nontemporal_load((const f32x4*)(src + 4 * F.lane + 256 * j)); *(h16x4*)(dst + 4 * F.lane + 256 * j) = pack4(v);
                if (F8_HB && isx) *(unsigned*)((unsigned char*)F.out + OUT_HB8 + (size_t)row * DM + 4 * F.lane + 256 * j) = cvt4_fp8(v[0], v[1], v[2], v[3]); s += (v[0] * v[0] + v[1] * v[1]) + (v[2] * v[2] + v[3] * v[3]); }
            s = wave_sum(s);
            if (F.lane < 16) sq[F.lane] = (F.lane == 0) ? s : 0.f;
            if (F.lane == 0) (isx ? WSP(float, OFF_RSTDT) : WSP(float, OFF_MRSTD))[row] = 1.0f / sqrtf(s * (1.0f / DM) + EPS);
        }
        float* rope = WSP(float, OFF_ROPE);
        for (int i = F.vcu * 512 + F.tid; i < SEQ * 32; i += F.G * 512) {
            const int pos = i >> 5, fi = i & 31; double th = 1.0;
            for (int k = 0; k < fi; ++k) th *= 0.74989420933245582730;
            const double rev = (double)pos * th * 0.15915494309189533577;
            const double fr = rev - floor(rev);
            const double r = (fr - 0.5) * 6.28318530717958647692;
            const double r2 = r * r; double sn = 1.0, cs = 1.0;
            for (int k = 14; k >= 1; --k) { sn = 1.0 - r2 / (double)((2 * k) * (2 * k + 1)) * sn; cs = 1.0 - r2 / (double)((2 * k - 1) * (2 * k)) * cs; }
            sn *= r;
            rope[pos * 64 + fi] = (float)(-cs); rope[pos * 64 + 32 + fi] = (float)(-sn);
        }
    }
}

template <bool SILU>
__device__ __forceinline__ void conv_rows8(const h16* projcol, long tbase, int n, int r0, const float* cw, int cdim, const float* cb, h16x8 (&out)[8]) {
    f32x4 w[4][2];
#pragma unroll
    for (int k = 0; k < 4; ++k) { w[k][0] = *(const f32x4*)(cw + k * cdim); w[k][1] = *(const f32x4*)(cw + k * cdim + 4); }
    const f32x4 b0 = *(const f32x4*)cb, b1 = *(const f32x4*)(cb + 4);
    h16x8 x[11];
#pragma unroll
    for (int i = 0; i < 11; ++i) { const int pos = n * 128 + r0 - 2 + i; h16x8 z;
#pragma unroll
        for (int e = 0; e < 8; ++e) z[e] = (h16)0.f;
        x[i] = (pos >= 0 && pos < SEQ) ? NTL(h16x8, projcol + (size_t)(tbase + r0 - 2 + i) * NPJ) : z; }
#pragma unroll
    for (int r = 0; r < 8; ++r) {
#pragma unroll
        for (int e = 0; e < 8; ++e) { float a = e < 4 ? b0[e] : b1[e - 4];
#pragma unroll
            for (int k = 0; k < 4; ++k) a += (e < 4 ? w[k][0][e] : w[k][1][e - 4]) * (float)x[r + k][e];
            out[r][e] = (h16)(SILU ? siluf_(a) : a); } }
}
__device__ __forceinline__ h16x8 col_of(const h16x8 (&o)[8], int e) { h16x8 c; c[0] = o[0][e]; c[1] = o[1][e]; c[2] = o[2][e]; c[3] = o[3][e]; c[4] = o[4][e]; c[5] = o[5][e]; c[6] = o[6][e]; c[7] = o[7][e]; return c; }

__device__ __forceinline__ void ret_scan_unit(const Frame& F, int u) {
    const int h = u % 6, b = (u / 6) % NB, dir = u / (6 * NB);
    const float gC = exp2f(128.0f * log1pf(-exp2f(-5.0f - (float)h)) * 1.4426950408889634f);
    h16* base = WSP(h16, OFF_RST) + ((size_t)((dir * NB + b) * NCH) * 6 + h) * 4096 + F.tid * 8;
    float acc[8];
#pragma unroll
    for (int e = 0; e < 8; ++e) acc[e] = 0.f;
#pragma unroll 1
    for (int half = 0; half < 2; ++half) { h16x8 sv[8];
#pragma unroll
        for (int i = 0; i < 8; ++i) { const int ii = 8 * half + i, n = dir == 0 ? ii : NCH - 1 - ii; sv[i] = *(const h16x8*)(base + (size_t)n * 6 * 4096); }
#pragma unroll
        for (int i = 0; i < 8; ++i) { const int ii = 8 * half + i, n = dir == 0 ? ii : NCH - 1 - ii; h16x8 o;
#pragma unroll
            for (int e = 0; e < 8; ++e) { o[e] = (h16)acc[e]; acc[e] = acc[e] * gC + (float)sv[i][e]; }
            *(h16x8*)(base + (size_t)n * 6 * 4096) = o; } }
}
#define RET_BAR() do { asm volatile("s_waitcnt lgkmcnt(0)" ::: "memory"); __builtin_amdgcn_s_barrier(); asm volatile("" ::: "memory"); } while (0)
__device__ __forceinline__ void ret_states_block(const Frame& F, int bn) {
    const int n = bn % NCH, b = bn / NCH; const long t0 = (long)b * SEQ + n * 128;
    const int r = F.tid >> 2, c = F.tid & 3;
    const h16* rowp = WSP(const h16, WS_R1) + (size_t)(t0 + r) * NPJ; const float* cs = WSP(const float, OFF_ROPE) + (size_t)(n * 128 + r) * 64 + 8 * c;
    const f32x4 c0 = *(const f32x4*)cs, c1 = *(const f32x4*)(cs + 4), s0 = *(const f32x4*)(cs + 32), s1 = *(const f32x4*)(cs + 36);
    const int dir = F.wave >> 2, dt = F.wave & 3, fr = F.lane & 15, fq = F.lane >> 4;
    h16x8 k1, k2, v1, v2;
#define RS_LOAD(hh) do { k1 = *(const h16x8*)(rowp + CK + (hh) * 64 + 8 * c); k2 = *(const h16x8*)(rowp + CK + (hh) * 64 + 32 + 8 * c); v1 = *(const h16x8*)(rowp + CV + (hh) * 64 + 16 * c); v2 = *(const h16x8*)(rowp + CV + (hh) * 64 + 16 * c + 8); } while (0)
    RS_LOAD(0);
#pragma unroll 1
    for (int h = 0; h < 6; ++h) {
        LAS h16* KT = (LAS h16*)(F.lds + (h & 1) * 34816); LAS h16* VT = KT + 64 * 136;
#pragma unroll
        for (int e = 0; e < 8; ++e) { const float x1 = (float)k1[e], x2 = (float)k2[e], co = e < 4 ? c0[e] : c1[e - 4], si = e < 4 ? s0[e] : s1[e - 4];
            KT[(8 * c + e) * 136 + r] = (h16)((x1 * co - x2 * si) * 0.125f); KT[(32 + 8 * c + e) * 136 + r] = (h16)((x1 * si + x2 * co) * 0.125f); }
#pragma unroll
        for (int e = 0; e < 8; ++e) { VT[(16 * c + e) * 136 + r] = v1[e]; VT[(16 * c + 8 + e) * 136 + r] = v2[e]; }
        if (h < 5) RS_LOAD(h + 1);
        RET_BAR();
        const float l2g = log1pf(-exp2f(-5.0f - (float)h)) * 1.4426950408889634f;
        h16x8 xw[4];
#pragma unroll
        for (int ks = 0; ks < 4; ++ks) { const h16x8 f = ldsfrag(KT + (16 * dt + fr) * 136 + 32 * ks + 8 * fq); h16x8 wv;
#pragma unroll
            for (int jj = 0; jj < 8; ++jj) { const int j = 32 * ks + 8 * fq + jj; wv[jj] = (h16)exp2f(l2g * (float)(dir == 0 ? 127 - j : j)); }
            xw[ks] = f * wv; }
        h16* rst = WSP(h16, OFF_RST) + ((size_t)((dir * NB + b) * NCH + n) * 6 + h) * 4096;
#pragma unroll
        for (int et = 0; et < 4; ++et) { f32x4 acc = {0.f, 0.f, 0.f, 0.f};
#pragma unroll
            for (int ks = 0; ks < 4; ++ks) acc = MFMA16(xw[ks], ldsfrag(VT + (16 * et + fr) * 136 + 32 * ks + 8 * fq), acc);
            *(h16x4*)(rst + (16 * et + fr) * 64 + 16 * dt + 4 * fq) = pack4(acc); }
    }
#undef RS_LOAD
    __syncthreads();
}
__device__ __forceinline__ void ret_out_block(const Frame& F, int bn) {
    const int n = bn % NCH, b = bn / NCH; const long t0 = (long)b * SEQ + n * 128;
    const int r = F.tid >> 2, c = F.tid & 3, rp = kperm32(r), er = F.tid >> 3, d0 = (F.tid & 7) * 8;
    const h16* rowp = WSP(const h16, WS_R1) + (size_t)(t0 + r) * NPJ; const float* cs = WSP(const float, OFF_ROPE) + (size_t)(n * 128 + r) * 64 + 8 * c;
    const f32x4 c0 = *(const f32x4*)cs, c1 = *(const f32x4*)(cs + 4), s0 = *(const f32x4*)(cs + 32), s1 = *(const f32x4*)(cs + 36);
    const int w = F.wave, fr = F.lane & 15, fq = F.lane >> 4, il = 16 * w + fr;
    const h16* grow = WSP(const h16, WS_R1) + (size_t)(t0 + il) * NPJ + CG + 4 * fq; h16* orow = WSP(h16, OFF_OMIX) + (size_t)(t0 + il) * DM + 4 * fq; unsigned char* orow8 = WSP(unsigned char, OFF_OMIX8) + (size_t)(t0 + il) * DM + 4 * fq;
    const h16* st0 = WSP(const h16, OFF_RST) + ((size_t)((0 * NB + b) * NCH + n) * 6) * 4096 + F.tid * 8; const h16* st1 = WSP(const h16, OFF_RST) + ((size_t)((1 * NB + b) * NCH + n) * 6) * 4096 + F.tid * 8;
    h16x8 q1, q2, k1, k2, v1, v2, sf, sb; h16x4 gn[4];
#define RO_LOAD(hh) do { q1 = NTL(h16x8, rowp + CQ + (hh) * 64 + 8 * c); q2 = NTL(h16x8, rowp + CQ + (hh) * 64 + 32 + 8 * c); k1 = NTL(h16x8, rowp + CK + (hh) * 64 + 8 * c); k2 = NTL(h16x8, rowp + CK + (hh) * 64 + 32 + 8 * c); \
        v1 = NTL(h16x8, rowp + CV + (hh) * 64 + 16 * c); v2 = NTL(h16x8, rowp + CV + (hh) * 64 + 16 * c + 8); sf = NTL(h16x8, st0 + (hh) * 4096); sb = NTL(h16x8, st1 + (hh) * 4096); \
        _Pragma("unroll") for (int et_ = 0; et_ < 4; ++et_) gn[et_] = NTL(h16x4, grow + (hh) * 64 + 16 * et_); } while (0)
    RO_LOAD(0);
#pragma unroll 1
    for (int h = 0; h < 6; ++h) {
        LAS h16* Qt = (LAS h16*)(F.lds + (h & 1) * 72704); LAS h16* Kt = Qt + 128 * 72; LAS h16* VT = Kt + 128 * 72; LAS h16* Ff = VT + 64 * 136; LAS h16* Fb = Ff + 64 * 72;
        { h16x8 qa, qb, ka, kb;
#pragma unroll
            for (int e = 0; e < 8; ++e) { const float co = e < 4 ? c0[e] : c1[e - 4], si = e < 4 ? s0[e] : s1[e - 4];
                float x1 = (float)q1[e], x2 = (float)q2[e]; qa[e] = (h16)(x1 * co - x2 * si); qb[e] = (h16)(x1 * si + x2 * co);
                x1 = (float)k1[e]; x2 = (float)k2[e]; ka[e] = (h16)((x1 * co - x2 * si) * 0.125f); kb[e] = (h16)((x1 * si + x2 * co) * 0.125f); }
            *(LAS h16x8*)(Qt + r * 72 + 8 * c) = qa; *(LAS h16x8*)(Qt + r * 72 + 32 + 8 * c) = qb;
            *(LAS h16x8*)(Kt + r * 72 + 8 * c) = ka; *(LAS h16x8*)(Kt + r * 72 + 32 + 8 * c) = kb; }
#pragma unroll
        for (int e = 0; e < 8; ++e) { VT[(16 * c + e) * 136 + rp] = v1[e]; VT[(16 * c + 8 + e) * 136 + rp] = v2[e]; }
        *(LAS h16x8*)(Ff + er * 72 + d0) = sf; *(LAS h16x8*)(Fb + er * 72 + d0) = sb;
        h16x4 gc[4];
#pragma unroll
        for (int et = 0; et < 4; ++et) gc[et] = gn[et];
        if (h < 5) RO_LOAD(h + 1);
        RET_BAR();
        const float l2g = log1pf(-exp2f(-5.0f - (float)h)) * 1.4426950408889634f;
        h16x8 qf[2];
#pragma unroll
        for (int ks = 0; ks < 2; ++ks) qf[ks] = ldsfrag(Qt + il * 72 + 32 * ks + 8 * fq);
        f32x4 s[8];
#pragma unroll
        for (int jt = 0; jt < 8; ++jt) { f32x4 a = {0.f, 0.f, 0.f, 0.f};
#pragma unroll
            for (int ks = 0; ks < 2; ++ks) a = MFMA16(ldsfrag(Kt + (16 * jt + fr) * 72 + 32 * ks + 8 * fq), qf[ks], a);
#pragma unroll
            for (int q = 0; q < 4; ++q) { const int j = 16 * jt + 4 * fq + q; const int dd = il > j ? il - j : j - il; a[q] *= exp2f(l2g * (float)dd); }
            PINV(a); s[jt] = a; }
        f32x4 o[4];
#pragma unroll
        for (int et = 0; et < 4; ++et) o[et] = (f32x4){0.f, 0.f, 0.f, 0.f};
#pragma unroll
        for (int kp = 0; kp < 4; ++kp) { const h16x8 pf = pack8(s[2 * kp], s[2 * kp + 1]);
#pragma unroll
            for (int et = 0; et < 4; ++et) o[et] = MFMA16(ldsfrag(VT + (16 * et + fr) * 136 + 32 * kp + 8 * fq), pf, o[et]); }
        const float gf = exp2f(l2g * (float)(il + 1)), gb = exp2f(l2g * (float)(128 - il));
#pragma unroll
        for (int ks = 0; ks < 2; ++ks) { const h16x8 qff = scalefrag(qf[ks], gf), qfb = scalefrag(qf[ks], gb);
#pragma unroll
            for (int et = 0; et < 4; ++et) { o[et] = MFMA16(ldsfrag(Ff + (16 * et + fr) * 72 + 32 * ks + 8 * fq), qff, o[et]); o[et] = MFMA16(ldsfrag(Fb + (16 * et + fr) * 72 + 32 * ks + 8 * fq), qfb, o[et]); } }
        float ss = 0.f;
#pragma unroll
        for (int et = 0; et < 4; ++et) ss += (o[et][0] * o[et][0] + o[et][1] * o[et][1]) + (o[et][2] * o[et][2] + o[et][3] * o[et][3]);
        ss += __shfl_xor(ss, 16); ss += __shfl_xor(ss, 32);
        const float rs = 1.0f / sqrtf(ss * (1.0f / 64.0f) + EPS);
#pragma unroll
        for (int et = 0; et < 4; ++et) { f32x4 q;
#pragma unroll
            for (int e = 0; e < 4; ++e) q[e] = o[et][e] * rs * siluf_((float)gc[et][e]);
            if (F8_OUT) *(unsigned*)(orow8 + h * 64 + 16 * et) = cvt4_fp8(8.f * q[0], 8.f * q[1], 8.f * q[2], 8.f * q[3]);
            else *(h16x4*)(orow + h * 64 + 16 * et) = pack4(q); }
    }
#undef RO_LOAD
    __syncthreads();
}
#undef RET_BAR

__device__ __forceinline__ void ssd_stage_dt(const Frame& F, const Prm& p, int l, int g, long t0, LAS float* LA, LAS float* DTS) {
    if (F.tid < 128) { const h16* dp = WSP(const h16, WS_R1) + (size_t)(t0 + F.tid) * NPJ + CDT + g * 3;
#pragma unroll
        for (int r = 0; r < 3; ++r) { const float raw = (float)dp[r];
#pragma unroll
            for (int dir = 0; dir < 2; ++dir) { const float dt = softplusf_(raw + inptr(F, 7)[(l * 2 + dir) * 6 + g * 3 + r]); const float la = -dt * __expf(inptr(F, 8)[(l * 2 + dir) * 6 + g * 3 + r]);
                DTS[(dir * 3 + r) * 128 + F.tid] = dt; LA[(dir * 3 + r) * 128 + F.tid] = la; } } }
}
__device__ __forceinline__ void ssd_cumsum(const Frame& F, LAS const float* LAq, float& v0, float& v1, float& c0, float& c1, float& tot) {
    v0 = LAq[2 * F.lane]; v1 = LAq[2 * F.lane + 1]; float s = v0 + v1;
#pragma unroll
    for (int o = 1; o < 64; o <<= 1) { const float t = __shfl_up(s, o); if (F.lane >= o) s += t; }
    c1 = s; c0 = s - v1; tot = __shfl(s, 63);
}
__device__ __forceinline__ void ssd_states_unit(const Frame& F, const Prm& p, int l, int u) {
    const int g = u & 1, bn = u >> 1, n = bn % NCH, b = bn / NCH; const long t0 = (long)b * SEQ + n * 128;
    const h16* proj = WSP(const h16, WS_R1);
    LAS h16* XT = (LAS h16*)F.lds; LAS h16* BT = XT + 3 * 64 * 136; LAS float* LA = (LAS float*)(BT + 128 * 136); LAS float* DTS = LA + 6 * 128; LAS float* WW = DTS + 6 * 128;
    ssd_stage_dt(F, p, l, g, t0, LA, DTS);
    const float* cw = inptr(F, 5) + (size_t)l * 4 * 896; const float* cb = inptr(F, 6) + (size_t)l * 896;
    h16* bcn = ((h16*)((unsigned char*)F.out + OUT_BCN));
    for (int task = F.tid; task < 56 * 16; task += 512) { const int cg = task % 56, r0 = (task / 56) * 8; h16x8 o[8];
        if (cg < 24) { conv_rows8<true>(proj + CXS + g * 192 + 8 * cg, t0, n, r0, cw + g * 192 + 8 * cg, 896, cb + g * 192 + 8 * cg, o);
            LAS h16* d = XT + (cg >> 3) * 64 * 136 + ((cg & 7) * 8) * 136 + r0;
#pragma unroll
            for (int e = 0; e < 8; ++e) *(LAS h16x8*)(d + e * 136) = col_of(o, e);
        } else { const int c8 = (cg - 24) & 15; const bool isB = cg < 40; const int col = (isB ? CBM : CCM) + g * 128 + 8 * c8, ci = (isB ? 384 : 640) + g * 128 + 8 * c8;
            conv_rows8<true>(proj + col, t0, n, r0, cw + ci, 896, cb + ci, o);
#pragma unroll
            for (int r = 0; r < 8; ++r) *(h16x8*)(bcn + (size_t)(t0 + r0 + r) * 512 + (isB ? 0 : 256) + g * 128 + 8 * c8) = o[r];
            if (isB) { LAS h16* d = BT + (8 * c8) * 136 + r0;
#pragma unroll
                for (int e = 0; e < 8; ++e) *(LAS h16x8*)(d + e * 136) = col_of(o, e); } } }
    __syncthreads();
    { h16* xtg = ((h16*)((unsigned char*)F.out + OUT_XTG)) + ((size_t)(b * NCH + n) * 6 + g * 3) * 8192;
#pragma unroll
        for (int k = 0; k < 6; ++k) { const int it = F.tid + 512 * k, rr = it >> 4, c = it & 15; const h16x8 v = *(LAS const h16x8*)(XT + rr * 136 + 8 * c);
            *(h16x4*)(xtg + rr * 128 + kperm32(8 * c)) = __builtin_shufflevector(v, v, 0, 1, 2, 3); *(h16x4*)(xtg + rr * 128 + kperm32(8 * c + 4)) = __builtin_shufflevector(v, v, 4, 5, 6, 7); } }
    if (F.wave < 6) { const int q = F.wave, dir = q / 3, r = q % 3; float v0, v1, c0, c1, tot; ssd_cumsum(F, LA + q * 128, v0, v1, c0, c1, tot);
        const float d0 = DTS[q * 128 + 2 * F.lane], d1 = DTS[q * 128 + 2 * F.lane + 1];
        if (dir == 0) { WW[q * 128 + 2 * F.lane] = __expf(tot - c0) * d0 * 256.f; WW[q * 128 + 2 * F.lane + 1] = __expf(tot - c1) * d1 * 256.f; }
        else { WW[q * 128 + 2 * F.lane] = __expf(c0 - v0) * d0 * 256.f; WW[q * 128 + 2 * F.lane + 1] = __expf(c1 - v1) * d1 * 256.f; }
        if (F.lane == 0) WSP(float, OFF_SDEC)[((size_t)(b * NCH + n) * 6 + g * 3 + r) * 2 + dir] = tot; }
    __syncthreads();
    const int w = F.wave, fr = F.lane & 15, fq = F.lane >> 4;
    h16x8 xb[4];
#pragma unroll
    for (int ks = 0; ks < 4; ++ks) xb[ks] = ldsfrag(BT + (16 * w + fr) * 136 + 32 * ks + 8 * fq);
    for (int q = 0; q < 6; ++q) { const int dir = q / 3, r = q % 3;
        h16x8 wf[4];
#pragma unroll
        for (int ks = 0; ks < 4; ++ks) { const f32x4 a = *(LAS const f32x4*)(WW + q * 128 + 32 * ks + 8 * fq), c = *(LAS const f32x4*)(WW + q * 128 + 32 * ks + 8 * fq + 4); wf[ks] = pack8(a, c); }
        h16* sst = WSP(h16, OFF_SST) + ((size_t)((dir * NB + b) * NCH + n) * 6 + g * 3 + r) * 8192;
#pragma unroll
        for (int pt = 0; pt < 4; ++pt) { f32x4 acc = {0.f, 0.f, 0.f, 0.f};
#pragma unroll
            for (int ks = 0; ks < 4; ++ks) acc = MFMA16(xb[ks], ldsfrag(XT + r * 64 * 136 + (16 * pt + fr) * 136 + 32 * ks + 8 * fq) * wf[ks], acc);
            *(h16x4*)(sst + (16 * pt + fr) * 128 + 16 * w + 4 * fq) = pack4(acc * (1.0f / 256.f)); } }
    __syncthreads();
}
__device__ __forceinline__ void ssd_scan_unit(const Frame& F, int u) {
    const int hd = u % 6, b = (u / 6) % NB, dir = u / (6 * NB);
    h16* base = WSP(h16, OFF_SST) + ((size_t)((dir * NB + b) * NCH) * 6 + hd) * 8192 + F.tid * 16;
    const float* dbase = WSP(const float, OFF_SDEC) + ((size_t)(b * NCH) * 6 + hd) * 2 + dir;
    float acc[16];
#pragma unroll
    for (int e = 0; e < 16; ++e) acc[e] = 0.f;
#pragma unroll 1
    for (int q = 0; q < 4; ++q) { h16x8 s0[4], s1[4]; float dec[4];
#pragma unroll
        for (int i = 0; i < 4; ++i) { const int ii = 4 * q + i, n = dir == 0 ? ii : NCH - 1 - ii; s0[i] = *(const h16x8*)(base + (size_t)n * 6 * 8192); s1[i] = *(const h16x8*)(base + (size_t)n * 6 * 8192 + 8); dec[i] = dbase[n * 12]; }
#pragma unroll
        for (int i = 0; i < 4; ++i) { const int ii = 4 * q + i, n = dir == 0 ? ii : NCH - 1 - ii; const float dc = __expf(dec[i]); h16x8 o0, o1;
#pragma unroll
            for (int e = 0; e < 8; ++e) { o0[e] = (h16)acc[e]; o1[e] = (h16)acc[8 + e]; acc[e] = acc[e] * dc + (float)s0[i][e]; acc[8 + e] = acc[8 + e] * dc + (float)s1[i][e]; }
            *(h16x8*)(base + (size_t)n * 6 * 8192) = o0; *(h16x8*)(base + (size_t)n * 6 * 8192 + 8) = o1; } }
}
__device__ __forceinline__ void ssd_out_unit(const Frame& F, const Prm& p, int l, int u) {
    const int g = u & 1, bn = u >> 1, n = bn % NCH, b = bn / NCH; const long t0 = (long)b * SEQ + n * 128;
    const h16* proj = WSP(const h16, WS_R1);
    LAS h16* XT = (LAS h16*)F.lds; LAS h16* Bt = XT + 3 * 64 * 136; LAS h16* Ct = Bt + 128 * 136; LAS float* LA = (LAS float*)(Ct + 128 * 136); LAS float* DTS = LA + 6 * 128;
    LAS float* CE = DTS + 6 * 128;
    LAS float* TOTB = CE + 6 * 128;
    ssd_stage_dt(F, p, l, g, t0, LA, DTS);
    const float* cw = inptr(F, 5) + (size_t)l * 4 * 896; const float* cb = inptr(F, 6) + (size_t)l * 896;
    { const h16* xtg = ((const h16*)((const unsigned char*)F.out + OUT_XTG)) + ((size_t)(b * NCH + n) * 6 + g * 3) * 8192; const h16* bcn = ((const h16*)((const unsigned char*)F.out + OUT_BCN)) + (size_t)t0 * 512 + g * 128;
        h16x8 xv[6], bv[8];
#pragma unroll
        for (int k = 0; k < 6; ++k) { const int it = F.tid + 512 * k; xv[k] = NTL(h16x8, xtg + (it >> 4) * 128 + 8 * (it & 15)); }
#pragma unroll
        for (int k = 0; k < 8; ++k) { const int it = F.tid + 512 * k, row = it >> 5, c = it & 31; bv[k] = NTL(h16x8, bcn + (size_t)row * 512 + (c < 16 ? 8 * c : 256 + 8 * (c - 16))); }
#pragma unroll
        for (int k = 0; k < 6; ++k) { const int it = F.tid + 512 * k; *(LAS h16x8*)(XT + (it >> 4) * 136 + 8 * (it & 15)) = xv[k]; }
#pragma unroll
        for (int k = 0; k < 8; ++k) { const int it = F.tid + 512 * k, row = it >> 5, c = it & 31; *(LAS h16x8*)((c < 16 ? Bt : Ct) + row * 136 + 8 * (c & 15)) = bv[k]; }
        PIN(); }
    __syncthreads();
    if (F.wave < 6) { const int q = F.wave; float v0, v1, c0, c1, tot; ssd_cumsum(F, LA + q * 128, v0, v1, c0, c1, tot);
        if (q < 3) { CE[q * 128 + 2 * F.lane] = c0; CE[q * 128 + 2 * F.lane + 1] = c1; }
        else { CE[q * 128 + 2 * F.lane] = c0 - v0; CE[q * 128 + 2 * F.lane + 1] = c1 - v1; if (F.lane == 0) TOTB[q - 3] = tot; } }
    __syncthreads();
    const int w = F.wave, fr = F.lane & 15, fq = F.lane >> 4, il = 16 * w + fr;
    h16x8 cf[4];
#pragma unroll
    for (int ks = 0; ks < 4; ++ks) cf[ks] = ldsfrag(Ct + il * 136 + 32 * ks + 8 * fq);
    f32x4 gT[8];
#pragma unroll
    for (int jt = 0; jt < 8; ++jt) { f32x4 a = {0.f, 0.f, 0.f, 0.f};
#pragma unroll
        for (int ks = 0; ks < 4; ++ks) a = MFMA16(ldsfrag(Bt + (16 * jt + fr) * 136 + 32 * ks + 8 * fq), cf[ks], a);
        PINV(a); gT[jt] = a; }
    const float* dsk = inptr(F, 9) + l * 6 + g * 3;
    h16* orow = WSP(h16, OFF_OMIX) + (size_t)(t0 + il) * DM + 384 + g * 192;
    float ss = 0.f;
    { h16x8 h0[4];
#pragma unroll
        for (int k = 0; k < 4; ++k) { const int it = F.tid + 512 * k, dir = it >> 10, e = it & 1023; h0[k] = NTL(h16x8, WSP(const h16, OFF_SST) + ((size_t)((dir * NB + b) * NCH + n) * 6 + g * 3) * 8192 + e * 8); }
        __syncthreads();
#pragma unroll
        for (int k = 0; k < 4; ++k) { const int it = F.tid + 512 * k, dir = it >> 10, e = it & 1023; *(LAS h16x8*)(Bt + dir * 64 * 136 + (e >> 4) * 136 + 8 * (e & 15)) = h0[k]; }
        __syncthreads(); }
#pragma unroll 1
    for (int r = 0; r < 3; ++r) {
        f32x4 y[1][4];
        const int hd = g * 3 + r;
        const float cfi = CE[r * 128 + il], ebi = CE[(3 + r) * 128 + il], totb = TOTB[r];
#pragma unroll
        for (int pt = 0; pt < 4; ++pt) y[0][pt] = (f32x4){0.f, 0.f, 0.f, 0.f};
        LAS const h16* HL = (r & 1) ? Ct : Bt;
        h16x8 hreg[4];
        if (r < 2) {
#pragma unroll
            for (int k = 0; k < 4; ++k) { const int it = F.tid + 512 * k, dir = it >> 10, e = it & 1023; hreg[k] = NTL(h16x8, WSP(const h16, OFF_SST) + ((size_t)((dir * NB + b) * NCH + n) * 6 + hd + 1) * 8192 + e * 8); } }
#pragma unroll
        for (int kp = 0; kp < 4; ++kp) { f32x4 pv[2];
#pragma unroll
            for (int jh = 0; jh < 2; ++jh) { const int jt = 2 * kp + jh, j0 = 16 * jt + 4 * fq;
                const f32x4 cfj = *(LAS const f32x4*)(CE + r * 128 + j0), ebj = *(LAS const f32x4*)(CE + (3 + r) * 128 + j0), dfj = *(LAS const f32x4*)(DTS + r * 128 + j0), dbj = *(LAS const f32x4*)(DTS + (3 + r) * 128 + j0);
#pragma unroll
                for (int e = 0; e < 4; ++e) { const int j = j0 + e; const float val = (il >= j) ? __expf(cfi - cfj[e]) * dfj[e] : __expf(ebj[e] - ebi) * dbj[e]; pv[jh][e] = gT[jt][e] * val * 256.f; }
                PINV(pv[jh]); }
            const h16x8 pf = pack8(pv[0], pv[1]);
#pragma unroll
            for (int pt = 0; pt < 4; ++pt) y[0][pt] = MFMA16(ldsfrag(XT + r * 64 * 136 + (16 * pt + fr) * 136 + 32 * kp + 8 * fq), pf, y[0][pt]);
            PINV(y[0][0]); PINV(y[0][1]); PINV(y[0][2]); PINV(y[0][3]); }
        const float ef = __expf(cfi) * 256.f, eb = __expf(totb - ebi) * 256.f;
#pragma unroll
        for (int ks = 0; ks < 4; ++ks) { const h16x8 cff = scalefrag(cf[ks], ef), cfb = scalefrag(cf[ks], eb);
#pragma unroll
            for (int pt = 0; pt < 4; ++pt) { y[0][pt] = MFMA16(ldsfrag(HL + (16 * pt + fr) * 136 + 32 * ks + 8 * fq), cff, y[0][pt]); y[0][pt] = MFMA16(ldsfrag(HL + 64 * 136 + (16 * pt + fr) * 136 + 32 * ks + 8 * fq), cfb, y[0][pt]); }
            PINV(y[0][0]); PINV(y[0][1]); PINV(y[0][2]); PINV(y[0][3]); }
        if (r < 2) { LAS h16* HN = (r & 1) ? Bt : Ct;
#pragma unroll
            for (int k = 0; k < 4; ++k) { const int it = F.tid + 512 * k, dir = it >> 10, e = it & 1023; *(LAS h16x8*)(HN + dir * 64 * 136 + (e >> 4) * 136 + 8 * (e & 15)) = hreg[k]; } }
        const float dk = dsk[r]; const h16* zrow = proj + (size_t)(t0 + il) * NPJ + CZ + hd * 64;
#pragma unroll
        for (int pt = 0; pt < 4; ++pt) { const h16x4 zv = NTL(h16x4, zrow + 16 * pt + 4 * fq);
#pragma unroll
            for (int e = 0; e < 4; ++e) { const float xv = (float)XT[r * 64 * 136 + (16 * pt + 4 * fq + e) * 136 + kperm32(il)]; y[0][pt][e] = (y[0][pt][e] * (1.0f / 256.f) + dk * xv) * siluf_((float)zv[e]); }
            const h16x4 yh = pack4(y[0][pt]); *(h16x4*)(orow + r * 64 + 16 * pt + 4 * fq) = yh;
#pragma unroll
            for (int e = 0; e < 4; ++e) { const float q = (float)yh[e]; ss += q * q; } }
        __syncthreads();
    }
    ss += __shfl_xor(ss, 16); ss += __shfl_xor(ss, 32);
    const float rs = 1.0f / sqrtf(ss * (1.0f / 192.0f) + EPS);
    const float* nw = inptr(F, 10) + l * 384 + g * 192;
    asm volatile("s_waitcnt vmcnt(0)" ::: "memory");
#pragma unroll 1
    for (int r = 0; r < 3; ++r)
#pragma unroll
        for (int pt = 0; pt < 4; ++pt) { const f32x4 wv = *(const f32x4*)(nw + r * 64 + 16 * pt + 4 * fq); h16* op = orow + r * 64 + 16 * pt + 4 * fq; const h16x4 yh = *(const h16x4*)op; f32x4 yv;
#pragma unroll
            for (int e = 0; e < 4; ++e) yv[e] = (float)yh[e] * rs * wv[e];
            if (F8_OUT) *(unsigned*)(WSP(unsigned char, OFF_OMIX8) + (size_t)(t0 + il) * DM + 384 + g * 192 + r * 64 + 16 * pt + 4 * fq) = cvt4_fp8(8.f * yv[0], 8.f * yv[1], 8.f * yv[2], 8.f * yv[3]);
            else *(h16x4*)op = pack4(yv); }
    __syncthreads();
}

__device__ __forceinline__ void lru_unit(const Frame& F, const Prm& p, int l, int u) {
    const int n = u % NCH, b = u / NCH; const long t0 = (long)b * SEQ + n * 128;
    const h16* proj = WSP(const h16, WS_R1);
    LAS h16* XC = (LAS h16*)F.lds;
    const float* cw = inptr(F, 11) + (size_t)l * 4 * 256; const float* cb = inptr(F, 12) + (size_t)l * 256;
    { const int cg = F.tid & 31, r0 = (F.tid >> 5) * 8; h16x8 o[8];
        conv_rows8<false>(proj + CXR + 8 * cg, t0, n, r0, cw + 8 * cg, 256, cb + 8 * cg, o);
#pragma unroll
        for (int r = 0; r < 8; ++r) *(LAS h16x8*)(XC + (r0 + r) * 264 + 8 * cg) = o[r]; }
    __syncthreads();
    const int blk = F.wave & 3, jh = F.wave >> 2, fr = F.lane & 15, fq = F.lane >> 4;
    h16* lau = (h16*)((unsigned char*)F.out + OUT_LAU) + (size_t)(b * NCH + n) * 2 * 128 * 256 * 2;
    h16x8 wa[2][2][2], wx[2][2][2]; float ba[2][2], bx[2][2], sp[2][2], car[2][2], atot[2][2];
#pragma unroll
    for (int dir = 0; dir < 2; ++dir)
#pragma unroll
        for (int jt = 0; jt < 2; ++jt) { const int ch = blk * 64 + 32 * jh + 16 * jt + fr;
#pragma unroll
            for (int ks = 0; ks < 2; ++ks) { wa[dir][jt][ks] = *(const h16x8*)(WSP(const h16, WS_LRUW) + (size_t)((dir * 2 + 0) * 4 + blk) * 4096 + (32 * jh + 16 * jt + fr) * 64 + 32 * ks + 8 * fq);
                wx[dir][jt][ks] = *(const h16x8*)(WSP(const h16, WS_LRUW) + (size_t)((dir * 2 + 1) * 4 + blk) * 4096 + (32 * jh + 16 * jt + fr) * 64 + 32 * ks + 8 * fq); }
            ba[dir][jt] = inptr(F, 15)[(l * 2 + dir) * 256 + ch]; bx[dir][jt] = inptr(F, 17)[(l * 2 + dir) * 256 + ch]; sp[dir][jt] = softplusf_(-inptr(F, 13)[(l * 2 + dir) * 256 + ch]);
            car[dir][jt] = 0.f; atot[dir][jt] = 1.f; }
#pragma unroll 1
    for (int ti = 0; ti < 8; ++ti) {
#pragma unroll
        for (int dir = 0; dir < 2; ++dir) { const int tt = dir == 0 ? ti : 7 - ti;
            h16x8 xf[2];
#pragma unroll
            for (int ks = 0; ks < 2; ++ks) xf[ks] = ldsfrag(XC + (16 * tt + fr) * 264 + blk * 64 + 32 * ks + 8 * fq);
#pragma unroll
            for (int jt = 0; jt < 2; ++jt) { const int ch = blk * 64 + 32 * jh + 16 * jt + fr;
                f32x4 ra = {0.f, 0.f, 0.f, 0.f}, ia = {0.f, 0.f, 0.f, 0.f};
#pragma unroll
                for (int ks = 0; ks < 2; ++ks) { ra = MFMA16(xf[ks], wa[dir][jt][ks], ra); ia = MFMA16(xf[ks], wx[dir][jt][ks], ia); }
                float A = 1.f, H = 0.f;
#pragma unroll
                for (int ri = 0; ri < 4; ++ri) { const int rg = dir == 0 ? ri : 3 - ri;
                    const float e1 = 1.0f + __expf(-(ra[rg] + ba[dir][jt])), e2 = 1.0f + __expf(-(ia[rg] + bx[dir][jt])); const float inv = __builtin_amdgcn_rcpf(e1 * e2);
                    const float rgate = inv * e2, ig = inv * e1;
                    const float la = -8.0f * rgate * sp[dir][jt]; const float a = __expf(la); const float y = 2.0f * la;
                    const float om = y > -0.1f ? -y * (1.0f + y * (0.5f + y * (1.0f / 6.0f))) : 1.0f - a * a;
                    const float mult = __builtin_amdgcn_sqrtf(om);
                    const float xv = (float)XC[(16 * tt + 4 * fq + rg) * 264 + ch]; const float uu = mult * ig * xv;
                    H = a * H + uu; A *= a;
                    { h16x2 pk; pk[0] = (h16)la; pk[1] = (h16)uu; *(h16x2*)(lau + ((size_t)dir * 128 + 16 * tt + 4 * fq + rg) * 256 * 2 + 2 * ch) = pk; } }
                float Ag[4], Hg[4];
#pragma unroll
                for (int gq = 0; gq < 4; ++gq) { Ag[gq] = __shfl(A, fr + 16 * gq); Hg[gq] = __shfl(H, fr + 16 * gq); }
                float cnew = car[dir][jt], at = 1.f;
#pragma unroll
                for (int gi = 0; gi < 4; ++gi) { const int gq = dir == 0 ? gi : 3 - gi;
                    cnew = Ag[gq] * cnew + Hg[gq]; at *= Ag[gq]; }
                car[dir][jt] = cnew; atot[dir][jt] *= at;
            } } }
    if (fq == 0) {
#pragma unroll
        for (int dir = 0; dir < 2; ++dir)
#pragma unroll
            for (int jt = 0; jt < 2; ++jt) { const int ch = blk * 64 + 32 * jh + 16 * jt + fr; *(f32x2*)(WSP(float, OFF_LSUM) + (((size_t)(b * NCH + n) * 2 + dir) * 256 + ch) * 2) = (f32x2){atot[dir][jt], car[dir][jt]}; } }
    __syncthreads();
}
__device__ __forceinline__ void lru_out_unit(const Frame& F, int u) {
    const int n = u % NCH, b = u / NCH; const long t0 = (long)b * SEQ + n * 128;
    const h16* proj = WSP(const h16, WS_R1);
    LAS h16* HT = (LAS h16*)F.lds;
    const int blk = F.wave & 3, jh = F.wave >> 2, fr = F.lane & 15, fq = F.lane >> 4;
    const h16* lau = (const h16*)((const unsigned char*)F.out + OUT_LAU) + (size_t)(b * NCH + n) * 2 * 128 * 256 * 2;
    float car[2][2];
#pragma unroll
    for (int dir = 0; dir < 2; ++dir)
#pragma unroll
        for (int jt = 0; jt < 2; ++jt) car[dir][jt] = WSP(const float, OFF_LCAR)[((size_t)(b * NCH + n) * 2 + dir) * 256 + blk * 64 + 32 * jh + 16 * jt + fr];
#pragma unroll 1
    for (int ti = 0; ti < 8; ++ti) {
#pragma unroll
        for (int dir = 0; dir < 2; ++dir) { const int tt = dir == 0 ? ti : 7 - ti;
            h16x2 pk[2][4]; h16 gtv[2][4], ov[2][4];
#pragma unroll
            for (int jt = 0; jt < 2; ++jt)
#pragma unroll
                for (int rg = 0; rg < 4; ++rg) { const int tl = 16 * tt + 4 * fq + rg, ch = blk * 64 + 32 * jh + 16 * jt + fr;
                    pk[jt][rg] = NTL(h16x2, lau + ((size_t)dir * 128 + tl) * 256 * 2 + 2 * ch); gtv[jt][rg] = NTL(h16, proj + (size_t)(t0 + tl) * NPJ + CGT + ch); ov[jt][rg] = ti >= 4 ? HT[tl * 264 + ch] : (h16)0.f; }
#pragma unroll
            for (int jt = 0; jt < 2; ++jt) { const int ch = blk * 64 + 32 * jh + 16 * jt + fr;
                float av[4], uv[4]; float A = 1.f, H = 0.f;
#pragma unroll
                for (int ri = 0; ri < 4; ++ri) { const int rg = dir == 0 ? ri : 3 - ri; const float a = __expf((float)pk[jt][rg][0]); const float uu = (float)pk[jt][rg][1]; av[rg] = a; uv[rg] = uu; H = a * H + uu; A *= a; }
                float Ag[4], Hg[4];
#pragma unroll
                for (int gq = 0; gq < 4; ++gq) { Ag[gq] = __shfl(A, fr + 16 * gq); Hg[gq] = __shfl(H, fr + 16 * gq); }
                float hin = car[dir][jt], cnew = car[dir][jt];
#pragma unroll
                for (int gi = 0; gi < 4; ++gi) { const int gq = dir == 0 ? gi : 3 - gi; const bool before = dir == 0 ? (gq < fq) : (gq > fq);
                    if (before) hin = Ag[gq] * hin + Hg[gq];
                    cnew = Ag[gq] * cnew + Hg[gq]; }
                car[dir][jt] = cnew;
                float hh = hin;
#pragma unroll
                for (int ri = 0; ri < 4; ++ri) { const int rg = dir == 0 ? ri : 3 - ri; hh = av[rg] * hh + uv[rg];
                    HT[(16 * tt + 4 * fq + rg) * 264 + ch] = (h16)((float)ov[jt][rg] + hh * gelu_tanh_((float)gtv[jt][rg])); } } } }
    __syncthreads();
#pragma unroll
    for (int k = 0; k < 8; ++k) { const int it = F.tid + 512 * k, row = it >> 5, c8 = it & 31; const h16x8 hv = *(LAS const h16x8*)(HT + row * 264 + 8 * c8);
        if (F8_OUT) *(u32x2*)(WSP(unsigned char, OFF_OMIX8) + (size_t)(t0 + row) * DM + 768 + 8 * c8) = (u32x2){cvt4_fp8(8.f * (float)hv[0], 8.f * (float)hv[1], 8.f * (float)hv[2], 8.f * (float)hv[3]), cvt4_fp8(8.f * (float)hv[4], 8.f * (float)hv[5], 8.f * (float)hv[6], 8.f * (float)hv[7])};
        else *(h16x8*)(WSP(h16, OFF_OMIX) + (size_t)(t0 + row) * DM + 768 + 8 * c8) = hv; }
    __syncthreads();
}
__device__ __forceinline__ void lru_scan(const Frame& F) {
    const int gi = (int)blockIdx.x * 512 + F.tid; if (gi >= NB * 2 * 256) return;
    const int ch = gi & 255, dir = (gi >> 8) & 1, b = gi >> 9; float H = 0.f;
    for (int i = 0; i < NCH; ++i) { const int n = dir == 0 ? i : NCH - 1 - i; const size_t idx = ((size_t)(b * NCH + n) * 2 + dir) * 256 + ch;
        const f32x2 s = *(const f32x2*)(WSP(const float, OFF_LSUM) + idx * 2); WSP(float, OFF_LCAR)[idx] = H; H = s[0] * H + s[1]; }
}

__device__ __forceinline__ void attn_phase(const Frame& F) {
    constexpr int NU = NB * 4 * 8;
    LAS unsigned char* B0 = F.lds; LAS unsigned char* B1 = F.lds + 67584;
    int u = F.vcu; if (u >= NU) return;
    int lanel = F.lane; asm volatile("" : "+v"(lanel)); int fr = lanel & 15, fq = lanel >> 4;
    const int w = F.wave;
    h16x8 qf[2][8];
#define AT_DMA(buf, src, rowstride) do { asm volatile("" : "+v"(lanel)); if (lanel < 32) { _Pragma("unroll") for (int i_ = 0; i_ < 16; ++i_) \
        __builtin_amdgcn_global_load_lds((const unsigned*)((src) + (size_t)(16 * w + i_) * (rowstride) + 8 * lanel), (LAS unsigned*)((buf) + (16 * w + i_) * 528), 16, 0, 0); } } while (0)
#define AT_FRAG(buf, row, chunk) (*(LAS const h16x8*)((buf) + (row) * 528 + (chunk) * 16))
#define AT_WAITBAR() do { asm volatile("s_waitcnt vmcnt(0) lgkmcnt(0)" ::: "memory"); __builtin_amdgcn_s_barrier(); asm volatile("" ::: "memory"); } while (0)
#define AT_LOADQ(uu) do { _Pragma("unroll") for (int a_ = 0; a_ < 2; ++a_) { const long t_ = (long)((uu) >> 5) * SEQ + ((uu) & 7) * 256 + 32 * w + 16 * a_ + fr; const h16* q_ = WSP(const h16, OFF_QCA) + (size_t)t_ * DM + (((uu) >> 3) & 3) * 256; \
        _Pragma("unroll") for (int ks_ = 0; ks_ < 8; ++ks_) qf[a_][ks_] = NTL(h16x8, q_ + 32 * ks_ + 8 * fq); } } while (0)
    { const int b = u >> 5, hd = (u >> 3) & 3; AT_DMA(B0, WSP(const h16, OFF_KB) + (size_t)(b * 256) * DM + hd * 256, DM); }
    for (; u < NU; u += F.G) {
        const int qb = u & 7, hd = (u >> 3) & 3, b = u >> 5; const int un = u + F.G; const bool has_next = un < NU;
        asm volatile("" : "+v"(lanel)); fr = lanel & 15; fq = lanel >> 4;
        const h16* kb = WSP(const h16, OFF_KB) + (size_t)(b * 256) * DM + hd * 256; const h16* vt = WSP(const h16, OFF_VT) + (size_t)(b * 4 + hd) * 65536;
        AT_LOADQ(u);
        h16x8 pf[2][8]; float mq[2][4], Mr[2] = {-3.0e38f, -3.0e38f}, Lr[2] = {0.f, 0.f};
#pragma unroll
        for (int h = 0; h < 2; ++h) {
            AT_WAITBAR();
            if (h == 0) AT_DMA(B1, kb + (size_t)128 * DM, DM); else AT_DMA(B0, vt, 256);
            LAS const unsigned char* KB_ = h == 0 ? B0 : B1;
#pragma unroll
            for (int jh = 0; jh < 2; ++jh) { const int qd = 2 * h + jh; f32x4 s[2][4]; h16x8 kf[2][4];
#pragma unroll
                for (int j4 = 0; j4 < 4; ++j4) { s[0][j4] = (f32x4){0.f, 0.f, 0.f, 0.f}; s[1][j4] = (f32x4){0.f, 0.f, 0.f, 0.f}; kf[0][j4] = AT_FRAG(KB_, 16 * (4 * jh + j4) + fr, fq); }
#pragma unroll
                for (int ks = 0; ks < 8; ++ks) {
                    if (ks < 7) {
#pragma unroll
                        for (int j4 = 0; j4 < 4; ++j4) kf[(ks + 1) & 1][j4] = AT_FRAG(KB_, 16 * (4 * jh + j4) + fr, 4 * (ks + 1) + fq); }
                    PIN();
#pragma unroll
                    for (int j4 = 0; j4 < 4; ++j4) { s[0][j4] = MFMA16(kf[ks & 1][j4], qf[0][ks], s[0][j4]); s[1][j4] = MFMA16(kf[ks & 1][j4], qf[1][ks], s[1][j4]); }
                    PINV(s[0][0]); PINV(s[1][3]); }
#pragma unroll
                for (int a = 0; a < 2; ++a) { float mx = fmaxf(fmaxf(s[a][0][0], s[a][0][1]), fmaxf(s[a][0][2], s[a][0][3]));
#pragma unroll
                    for (int jt = 1; jt < 4; ++jt) mx = fmaxf(mx, fmaxf(fmaxf(s[a][jt][0], s[a][jt][1]), fmaxf(s[a][jt][2], s[a][jt][3])));
                    mx = fmaxf(mx, __shfl_xor(mx, 16)); mx = fmaxf(mx, __shfl_xor(mx, 32));
                    float sum = 0.f;
#pragma unroll
                    for (int jt = 0; jt < 4; ++jt)
#pragma unroll
                        for (int e = 0; e < 4; ++e) { const float pe = __expf(s[a][jt][e] - mx); s[a][jt][e] = pe; sum += pe; }
                    sum += __shfl_xor(sum, 16); sum += __shfl_xor(sum, 32);
                    mq[a][qd] = mx; { const float Mn = fmaxf(Mr[a], mx); Lr[a] = Lr[a] * __expf(Mr[a] - Mn) + sum * __expf(mx - Mn); Mr[a] = Mn; }
                    pf[a][2 * qd] = pack8(s[a][0], s[a][1]); pf[a][2 * qd + 1] = pack8(s[a][2], s[a][3]); } }
        }
#pragma unroll
        for (int a = 0; a < 2; ++a) { const float inv = 1.0f / Lr[a];
#pragma unroll
            for (int q = 0; q < 4; ++q) { const float cq = __expf(mq[a][q] - Mr[a]) * inv; pf[a][2 * q] = scalefrag(pf[a][2 * q], cq); pf[a][2 * q + 1] = scalefrag(pf[a][2 * q + 1], cq); } }
#pragma unroll
        for (int d = 0; d < 2; ++d) {
            AT_WAITBAR();
            if (d == 0) AT_DMA(B1, vt + (size_t)128 * 256, 256);
            else if (has_next) AT_DMA(B0, WSP(const h16, OFF_KB) + (size_t)((un >> 5) * 256) * DM + ((un >> 3) & 3) * 256, DM);
            LAS const unsigned char* VB_ = d == 0 ? B0 : B1;
#pragma unroll
            for (int eh = 0; eh < 2; ++eh) { f32x4 o[2][4]; h16x8 vf[2][4];
#pragma unroll
                for (int e4 = 0; e4 < 4; ++e4) { o[0][e4] = (f32x4){0.f, 0.f, 0.f, 0.f}; o[1][e4] = (f32x4){0.f, 0.f, 0.f, 0.f}; vf[0][e4] = AT_FRAG(VB_, 16 * (4 * eh + e4) + fr, fq); }
#pragma unroll
                for (int kp = 0; kp < 8; ++kp) {
                    if (kp < 7) {
#pragma unroll
                        for (int e4 = 0; e4 < 4; ++e4) vf[(kp + 1) & 1][e4] = AT_FRAG(VB_, 16 * (4 * eh + e4) + fr, 4 * (kp + 1) + fq); }
                    PIN();
#pragma unroll
                    for (int e4 = 0; e4 < 4; ++e4) { o[0][e4] = MFMA16(vf[kp & 1][e4], pf[0][kp], o[0][e4]); o[1][e4] = MFMA16(vf[kp & 1][e4], pf[1][kp], o[1][e4]); }
                    PINV(o[0][0]); PINV(o[1][3]); }
#pragma unroll
                for (int a = 0; a < 2; ++a) { const long t = (long)b * SEQ + qb * 256 + 32 * w + 16 * a + fr; h16* orow = WSP(h16, OFF_OATT) + (size_t)t * DM + hd * 256 + 128 * d + 64 * eh;
#pragma unroll
                    for (int e4 = 0; e4 < 4; ++e4) { if (F8_O) *(unsigned*)(WSP(unsigned char, OFF_OATT) + (size_t)t * DM + hd * 256 + 128 * d + 64 * eh + 16 * e4 + 4 * fq) = cvt4_fp8(16.f * o[a][e4][0], 16.f * o[a][e4][1], 16.f * o[a][e4][2], 16.f * o[a][e4][3]);
                        else *(h16x4*)(orow + 16 * e4 + 4 * fq) = pack4(o[a][e4]); } } }
        }
    }
    asm volatile("s_waitcnt vmcnt(0) lgkmcnt(0)" ::: "memory");
    __syncthreads();
#undef AT_DMA
#undef AT_FRAG
#undef AT_WAITBAR
#undef AT_LOADQ
}

__device__ __forceinline__ void phase_router(const Frame& F, const Prm& p, int l) {
    LAS h16* RW = (LAS h16*)F.lds;
    { const h16* rwg = WSP(const h16, OFF_RWG);
        for (int i = F.tid; i < 72 * 1032 / 8; i += 512) *(LAS h16x8*)(RW + 8 * i) = *(const h16x8*)(rwg + 8 * i); }
    LAS unsigned* hist = (LAS unsigned*)(F.lds + 72 * 1032 * 2);
    if (F.tid < 32) hist[F.tid] = 0u;
    if (F.G == 256) { for (int i = (int)blockIdx.x * 512 + F.tid; i < MAXSLOT; i += 256 * 512) WSP(int, OFF_STOK)[i] = 0; }
    else if (blockIdx.x == 0) { for (int i = F.tid; i < MAXSLOT; i += 512) WSP(int, OFF_STOK)[i] = 0; }
    __syncthreads();
    const int gw = F.vcu * 8 + F.wave, NGW = F.G * 8, fr = F.lane & 15, fq = F.lane >> 4;
    for (int tg = gw; tg < NT / 16; tg += NGW) {
        const int tok = tg * 16 + fr;
        const h16* hp = WSP(const h16, WS_HB) + (size_t)tok * DM + 8 * fq;
        f32x4 acc[3]; LAS const h16* wrow[3];
#pragma unroll
        for (int mt = 0; mt < 3; ++mt) { acc[mt] = (f32x4){0.f, 0.f, 0.f, 0.f}; const int j = (16 * mt + fr) < 36 ? (16 * mt + fr) : 35; wrow[mt] = RW + j * 1032 + 8 * fq; }
#pragma unroll
        for (int half = 0; half < 2; ++half) { h16x8 hf[16];
#pragma unroll
            for (int q = 0; q < 16; ++q) hf[q] = *(const h16x8*)(hp + 32 * (16 * half + q));
#pragma unroll
            for (int q = 0; q < 16; ++q) { const int ks = 16 * half + q;
#pragma unroll
                for (int mt = 0; mt < 3; ++mt) { acc[mt] = MFMA16(ldsfrag(wrow[mt] + 32 * ks), hf[q], acc[mt]); acc[mt] = MFMA16(ldsfrag(wrow[mt] + 36 * 1032 + 32 * ks), hf[q], acc[mt]); } } }
#pragma unroll
        for (int mt = 0; mt < 3; ++mt) acc[mt] *= (1.0f / 1024.0f);
        const float rs = row_rstd(WSP(const float, WS_SSQ) + (size_t)tok * 16);
        float gl[4];
#pragma unroll
        for (int r = 0; r < 4; ++r) gl[r] = __shfl(acc[0][r], fr) * rs + inptr(F, 25)[l * 4 + r];
        int gi = 0; float gmx = gl[0];
#pragma unroll
        for (int j = 1; j < 4; ++j) if (gl[j] > gmx) { gmx = gl[j]; gi = j; }
        float gsum = 0.f;
#pragma unroll
        for (int j = 0; j < 4; ++j) gsum += __expf(gl[j] - gmx);
        const float gp = 1.0f / gsum;
        const int src1 = fr + 16 * (1 + 2 * (gi & 1)), src2 = fr + 16 * (2 - 2 * (gi & 1)), mt1 = gi >> 1, mt2 = (gi + 1) >> 1;
        float el[8];
#pragma unroll
        for (int k = 0; k < 4; ++k) { const float a0 = __shfl(acc[0][k], src1), a1 = __shfl(acc[1][k], src1); el[k] = (mt1 ? a1 : a0) * rs + inptr(F, 27)[l * 32 + gi * 8 + k];
            const float b0 = __shfl(acc[0][k], src2), b1 = __shfl(acc[1][k], src2), b2 = __shfl(acc[2][k], src2); el[4 + k] = (mt2 == 0 ? b0 : (mt2 == 1 ? b1 : b2)) * rs + inptr(F, 27)[l * 32 + gi * 8 + 4 + k]; }
        int e1 = 0; float m1 = el[0];
#pragma unroll
        for (int j = 1; j < 8; ++j) if (el[j] > m1) { m1 = el[j]; e1 = j; }
        int e2 = -1; float m2 = -3.0e38f;
#pragma unroll
        for (int j = 0; j < 8; ++j) if (j != e1 && el[j] > m2) { m2 = el[j]; e2 = j; }
        const float r2 = __expf(m2 - m1); const float g1 = gp / (1.0f + r2), g2 = gp * r2 / (1.0f + r2);
        if (fq == 0) { const int x1 = gi * 8 + e1, x2 = gi * 8 + e2;
            *(int2*)(WSP(int, OFF_EID) + (size_t)tok * 2) = make_int2(x1, x2); *(f32x2*)(WSP(float, OFF_GATE) + (size_t)tok * 2) = (f32x2){g1, g2};
            WSP(float, OFF_RSTDT)[tok] = rs; __hip_atomic_fetch_add(&hist[x1], 1u, __ATOMIC_RELAXED, __HIP_MEMORY_SCOPE_WORKGROUP); __hip_atomic_fetch_add(&hist[x2], 1u, __ATOMIC_RELAXED, __HIP_MEMORY_SCOPE_WORKGROUP); }
    }
    __syncthreads();
    if (F.tid < 32 && hist[F.tid]) atomicAdd(WSP(unsigned, WS_CTL) + CW_COUNTS + l * 64 + F.tid, hist[F.tid]);
    __syncthreads();
}
__device__ __forceinline__ void phase_dispatch(const Frame& F, int l) {
    LAS int* cnt = (LAS int*)F.lds; LAS int* base = cnt + 32; LAS int* pstart = base + 32; LAS int* slots = pstart + 40;
    unsigned* ctl = WSP(unsigned, WS_CTL);
    for (int blk = F.vcu; blk < NT / 128; blk += F.G) {
        __syncthreads();
        if (F.tid < 32) cnt[F.tid] = 0;
        if (F.tid == 32) { int acc = 0; for (int e = 0; e < 32; ++e) { pstart[e] = acc; acc += (int)((ctl[CW_COUNTS + l * 64 + e] + 255u) & ~255u); } pstart[32] = acc; }
        __syncthreads();
        int e = 0, rank = 0, tok = 0;
        if (F.tid < 256) { tok = blk * 128 + (F.tid >> 1); e = WSP(const int, OFF_EID)[(size_t)tok * 2 + (F.tid & 1)]; rank = __hip_atomic_fetch_add(&cnt[e], 1, __ATOMIC_RELAXED, __HIP_MEMORY_SCOPE_WORKGROUP); }
        __syncthreads();
        if (F.tid < 32) base[F.tid] = cnt[F.tid] ? (int)atomicAdd(&ctl[CW_CURSOR + l * 64 + F.tid], (unsigned)cnt[F.tid]) : 0;
        __syncthreads();
        if (F.tid < 256) { const int slot = pstart[e] + base[e] + rank; slots[F.tid] = slot; WSP(int, OFF_TSLOT)[(size_t)tok * 2 + (F.tid & 1)] = slot; WSP(float, OFF_SRSTD)[slot] = WSP(const float, OFF_RSTDT)[tok]; WSP(int, OFF_STOK)[slot] = tok; }
        __syncthreads();
        if (blk == 0 && F.tid == 0) { const int ntl = pstart[32] >> 8; ctl[CW_NTILES + l] = (unsigned)ntl; int* te = WSP(int, OFF_TILEE);
            for (int e2 = 0; e2 < 32; ++e2) for (int tl = pstart[e2] >> 8; tl < (pstart[e2 + 1] >> 8); ++tl) te[tl] = e2; }
    }
    __syncthreads();
}
__device__ __forceinline__ void phase_combine(const Frame& F, const Prm& p, int l) {
    const int gw = F.vcu * 8 + F.wave, NGW = F.G * 8;
    const bool last = (l == NLAYER - 1);
    for (int tk0 = gw * 4; tk0 < NT; tk0 += NGW * 4) {
        int2 sl[4]; f32x2 gt[4];
#pragma unroll
        for (int q = 0; q < 4; ++q) { sl[q] = *(const int2*)(WSP(const int, OFF_TSLOT) + (size_t)(tk0 + q) * 2); gt[q] = *(const f32x2*)(WSP(const float, OFF_GATE) + (size_t)(tk0 + q) * 2); }
        f32x4 v[4][4]; h16x4 ya[4][4], yb[4][4];
#pragma unroll
        for (int q = 0; q < 4; ++q) { const h16* hrow = WSP(const h16, WS_HB) + (size_t)(tk0 + q) * DM; const h16* y0 = WSP(const h16, OFF_YP) + (size_t)sl[q].x * DM; const h16* y1 = WSP(const h16, OFF_YP) + (size_t)sl[q].y * DM;
#pragma unroll
            for (int j = 0; j < 4; ++j) { const int c = 4 * F.lane + 256 * j; const h16x4 hv = *(const h16x4*)(hrow + c); v[q][j] = (f32x4){(float)hv[0], (float)hv[1], (float)hv[2], (float)hv[3]}; ya[q][j] = __builtin_nontemporal_load((const h16x4*)(y0 + c)); yb[q][j] = __builtin_nontemporal_load((const h16x4*)(y1 + c)); } }
#pragma unroll
        for (int q = 0; q < 4; ++q) { float s = 0.f;
#pragma unroll
            for (int j = 0; j < 4; ++j) {
#pragma unroll
                for (int e = 0; e < 4; ++e) v[q][j][e] += gt[q][0] * (float)ya[q][j][e] + gt[q][1] * (float)yb[q][j][e];
                if (!last) { const h16x4 o = pack4(v[q][j]); v[q][j] = (f32x4){(float)o[0], (float)o[1], (float)o[2], (float)o[3]}; }
                s += (v[q][j][0] * v[q][j][0] + v[q][j][1] * v[q][j][1]) + (v[q][j][2] * v[q][j][2] + v[q][j][3] * v[q][j][3]); }
            s = wave_sum(s);
            if (!last) {
#pragma unroll
                for (int j = 0; j < 4; ++j) { const int c = 4 * F.lane + 256 * j; *(h16x4*)(WSP(h16, WS_HB) + (size_t)(tk0 + q) * DM + c) = pack4(v[q][j]);
                    if (F8_HB) *(unsigned*)((unsigned char*)F.out + OUT_HB8 + (size_t)(tk0 + q) * DM + c) = cvt4_fp8(v[q][j][0], v[q][j][1], v[q][j][2], v[q][j][3]); }
                if (F.lane < 16) WSP(float, WS_SSQ)[(size_t)(tk0 + q) * 16 + F.lane] = (F.lane == 0) ? s : 0.f;
                if (F.lane == 0) WSP(float, OFF_RSTDT)[tk0 + q] = 1.0f / sqrtf(s * (1.0f / DM) + EPS);
            } else { const float rs = 1.0f / sqrtf(s * (1.0f / DM) + EPS); float* orow = F.out + (size_t)(tk0 + q) * DM;
#pragma unroll
                for (int j = 0; j < 4; ++j) { const int c = 4 * F.lane + 256 * j; const f32x4 gf = *(const f32x4*)(inptr(F, 31) + c); *(f32x4*)(orow + c) = v[q][j] * rs * gf; } } }
    }
}

__global__ void __launch_bounds__(512, 2) fwd(Prm p) {
    extern __shared__ __attribute__((aligned(16))) unsigned char lds_raw[];
    Frame F; F.lds = (LAS unsigned char*)lds_raw; F.ws = (GAS unsigned char*)p.ws; F.out = p.out;
    F.tid = threadIdx.x; F.lane = F.tid & 63; F.wave = __builtin_amdgcn_readfirstlane(F.tid >> 6);
    F.G = gridDim.x; { const int bx = blockIdx.x; F.vcu = (F.G % 8 == 0) ? (bx % 8) * (F.G / 8) + bx / 8 : bx; }
    volatile LAS unsigned* misc = (volatile LAS unsigned*)(F.lds + LDS_MISC);
    if (F.tid < 4) misc[F.tid] = 0u;
    F.ptab = (volatile LAS unsigned long long*)(F.lds + LDS_MISC + 64);
    if (F.tid < 32) F.ptab[F.tid] = (unsigned long long)p.in[F.tid];
    __syncthreads();
    const int lo = p.ph_lo, hi = p.ph_hi;
    XcdBarrier bar; bar.bar = WSP(unsigned, WS_CTL) + CW_BAR; bar.x = 0; bar.st = misc;
    if (hi - lo > 1) bar = xcd_barrier_post(WSP(unsigned, WS_CTL) + CW_BAR, misc);
#ifndef UMASK
#define UMASK 7
#endif
#ifndef REPMASK
#define REPMASK 0
#endif
#ifndef PHMASK
#define PHMASK 0x3fff
#endif
#define IN(k) (((PHMASK >> ((k) % NPH)) & 1) && lo <= (k) && (k) < hi && (launder(F), true))
#define REPS(k) (((REPMASK >> (k)) & 1) ? 2 : 1)
#define INR(k) (lo <= (k) && (k) < hi)
#ifndef AMPMASK
#define AMPMASK 0
#endif
    unsigned long long tprev = AMPMASK ? __builtin_amdgcn_s_memrealtime() : 0ull;
#define SEAM(k) do { if (INR(k) && INR((k) + 1)) { xcd_barrier(bar); if (AMPMASK) { const unsigned long long tn = __builtin_amdgcn_s_memrealtime(); \
        if ((AMPMASK >> ((k) % NPH)) & 1) { const unsigned long long tgt = tn + 4ull * (tn - tprev); while (__builtin_amdgcn_s_memrealtime() < tgt) __builtin_amdgcn_s_sleep(8); } \
        tprev = __builtin_amdgcn_s_memrealtime(); } } } while (0)
    for (int l = 0; l < NLAYER; ++l) {
        const int pb = l * NPH;
        if (IN(pb + 0)) for (int rep = 0; rep < REPS(0); ++rep) { phase_convert(F, p, l); } SEAM(pb + 0);
        if (REPS(20) == 2 && INR(pb + 0) && INR(pb + 1)) { for (int q = 0; q < 20; ++q) xcd_barrier(bar); }
        if (IN(pb + 1)) for (int rep = 0; rep < REPS(1); ++rep) {
            if (UMASK & 1) { pg8::StaticOrder S; S.init(NT, NPJ, F.G, (int)blockIdx.x); pg8::EpiScale16C E{WSP(h16, WS_R1), NPJ, WSP(const float, OFF_RSTDT), F8_PROJ ? 1.0f / 256.0f : 1.0f};
#if F8_PROJ
              pg8::Gemm g{(const h16*)((const unsigned char*)F.out + OUT_HB8), WSP(const h16, WS_WIN), DM / 2, DM / 2, DM / 2, nullptr}; pg8::gemm_phase<pg8::EpiScale16C, pg8::StaticOrder, false, 1>(F.lds, F.tid, g, S, E);
#else
              pg8::Gemm g{WSP(const h16, WS_HB), WSP(const h16, WS_WIN), DM, DM, DM, nullptr}; pg8::gemm_phase(F.lds, F.tid, g, S, E);
#endif
            }
        } SEAM(pb + 1);
        if (IN(pb + 2)) for (int rep = 0; rep < REPS(2); ++rep) {
            if (UMASK & 1) for (int r2 = 0; r2 < REPS(17); ++r2) for (int u = blockIdx.x; u < NB * NCH * 2; u += F.G) ssd_states_unit(F, p, l, u);
            launder(F);
            if (UMASK & 2) for (int r2 = 0; r2 < REPS(18); ++r2) for (int u = blockIdx.x; u < NB * NCH; u += F.G) ret_states_block(F, u);
            launder(F);
            if (UMASK & 4) for (int r2 = 0; r2 < REPS(19); ++r2) for (int u = blockIdx.x; u < NB * NCH; u += F.G) lru_unit(F, p, l, u);
        } SEAM(pb + 2);
        if (IN(pb + 3)) for (int rep = 0; rep < REPS(3); ++rep) {
            const bool split = (F.G == 256); const int GS = split ? 128 : F.G;
            if (!split || blockIdx.x < 128) {
                for (int u = blockIdx.x; u < 2 * NB * 6; u += GS) ssd_scan_unit(F, u);
                launder(F);
                for (int u = blockIdx.x; u < 2 * NB * 6; u += GS) ret_scan_unit(F, u);
                lru_scan(F); }
            launder(F);
            if (!split || (blockIdx.x >= 128 && blockIdx.x < 192)) {
                pg8::Gemm g{WSP(const h16, WS_MEM16), WSP(const h16, WS_WKV), DM, DM, DM, nullptr}; pg8::StaticOrder S; S.init(NTM, DM, split ? 64 : F.G, split ? (int)blockIdx.x - 128 : (int)blockIdx.x);
                pg8::EpiScale16 E{WSP(h16, OFF_KB), DM, WSP(const float, OFF_MSSQ), 1.0f}; pg8::gemm_phase(F.lds, F.tid, g, S, E); }
            launder(F);
            if (!split || blockIdx.x >= 192) {
                pg8::Gemm g{WSP(const h16, WS_MEM16), WSP(const h16, WS_WKV) + (size_t)DM * DM, DM, DM, DM, nullptr}; pg8::StaticOrder S; S.init(NTM, DM, split ? 64 : F.G, split ? (int)blockIdx.x - 192 : (int)blockIdx.x);
                pg8::EpiVT E{WSP(h16, OFF_VT), WSP(const float, OFF_MRSTD)}; pg8::gemm_phase<pg8::EpiVT, pg8::StaticOrder, false, 0, true>(F.lds, F.tid, g, S, E); }
        } SEAM(pb + 3);
        if (IN(pb + 4)) for (int rep = 0; rep < REPS(4); ++rep) {
            if (UMASK & 1) for (int r2 = 0; r2 < REPS(14); ++r2) for (int u = blockIdx.x; u < NB * NCH * 2; u += F.G) ssd_out_unit(F, p, l, u);
            launder(F);
            if (UMASK & 2) for (int r2 = 0; r2 < REPS(15); ++r2) for (int u = blockIdx.x; u < NB * NCH; u += F.G) ret_out_block(F, u);
            launder(F);
            if (UMASK & 4) for (int r2 = 0; r2 < REPS(16); ++r2) for (int u = blockIdx.x; u < NB * NCH; u += F.G) lru_out_unit(F, u);
        } SEAM(pb + 4);
        if (IN(pb + 5)) for (int rep = 0; rep < REPS(5); ++rep) { pg8::StaticOrder S; S.init(NT, DM, F.G, (int)blockIdx.x); pg8::EpiResid E{WSP(h16, WS_HB), WSP(float, WS_SSQ), (unsigned char*)F.out + OUT_HB8, F8_OUT ? 1.0f / 2048.0f : 1.0f};
#if F8_OUT
            pg8::Gemm g{WSP(const h16, OFF_OMIX8), WSP(const h16, WS_WOUT), DM / 2, DM / 2, DM / 2, nullptr}; pg8::gemm_phase<pg8::EpiResid, pg8::StaticOrder, false, 1>(F.lds, F.tid, g, S, E);
#else
            pg8::Gemm g{WSP(const h16, OFF_OMIX), WSP(const h16, WS_WOUT), DM, DM, DM, nullptr}; pg8::gemm_phase(F.lds, F.tid, g, S, E);
#endif
            } SEAM(pb + 5);
        if (IN(pb + 6)) for (int rep = 0; rep < REPS(6); ++rep) { pg8::StaticOrder S; S.init(NT, DM, F.G, (int)blockIdx.x); pg8::EpiScale16 E{WSP(h16, OFF_QCA), DM, WSP(const float, WS_SSQ), F8_Q ? 1.0f / 4096.0f : 1.0f};
#if F8_Q
            pg8::Gemm g{(const h16*)((const unsigned char*)F.out + OUT_HB8), WSP(const h16, WS_WQ), DM / 2, DM / 2, DM / 2, nullptr}; pg8::gemm_phase<pg8::EpiScale16, pg8::StaticOrder, false, 1>(F.lds, F.tid, g, S, E);
#else
            pg8::Gemm g{WSP(const h16, WS_HB), WSP(const h16, WS_WQ), DM, DM, DM, nullptr}; pg8::gemm_phase(F.lds, F.tid, g, S, E);
#endif
            } SEAM(pb + 6);
        if (IN(pb + 7)) for (int rep = 0; rep < REPS(7); ++rep) { attn_phase(F); } SEAM(pb + 7);
        if (IN(pb + 8)) for (int rep = 0; rep < REPS(8); ++rep) { pg8::StaticOrder S; S.init(NT, DM, F.G, (int)blockIdx.x); pg8::EpiResid E{WSP(h16, WS_HB), WSP(float, WS_SSQ), (unsigned char*)F.out + OUT_HB8, F8_O ? 1.0f / 4096.0f : 1.0f};
#if F8_O
            pg8::Gemm g{WSP(const h16, OFF_OATT), WSP(const h16, WS_WO), DM / 2, DM / 2, DM / 2, nullptr}; pg8::gemm_phase<pg8::EpiResid, pg8::StaticOrder, false, 1>(F.lds, F.tid, g, S, E);
#else
            pg8::Gemm g{WSP(const h16, OFF_OATT), WSP(const h16, WS_WO), DM, DM, DM, nullptr}; pg8::gemm_phase(F.lds, F.tid, g, S, E);
#endif
            } SEAM(pb + 8);
        if (IN(pb + 9)) for (int rep = 0; rep < REPS(9); ++rep) { phase_router(F, p, l); } SEAM(pb + 9);
        if (IN(pb + 10)) for (int rep = 0; rep < REPS(10); ++rep) { phase_dispatch(F, l); } SEAM(pb + 10);
        if (IN(pb + 11)) for (int rep = 0; rep < REPS(11); ++rep) {
            pg8::GroupOrder S{WSP(const int, OFF_TILEE), __builtin_amdgcn_readfirstlane((int)WSP(const unsigned, WS_CTL)[CW_NTILES + l]), F.G, F.vcu}; pg8::EpiGated E{WSP(h16, OFF_HP), WSP(const float, OFF_SRSTD), F8_UP ? 1.0f / 256.0f : 1.0f};
#if F8_UP
            pg8::Gemm g{(const h16*)((const unsigned char*)F.out + OUT_HB8), WSP(const h16, WS_W13), DM / 2, DM / 2, DM / 2, WSP(const int, OFF_STOK)}; pg8::gemm_phase<pg8::EpiGated, pg8::GroupOrder, true, 1>(F.lds, F.tid, g, S, E);
#else
            pg8::Gemm g{WSP(const h16, WS_HB), WSP(const h16, WS_W13), DM, DM, DM, WSP(const int, OFF_STOK)}; pg8::gemm_phase<pg8::EpiGated, pg8::GroupOrder, true>(F.lds, F.tid, g, S, E);
#endif
            } SEAM(pb + 11);
        if (IN(pb + 12)) for (int rep = 0; rep < REPS(12); ++rep) {
            pg8::GroupOrder S{WSP(const int, OFF_TILEE), __builtin_amdgcn_readfirstlane((int)WSP(const unsigned, WS_CTL)[CW_NTILES + l]), F.G, F.vcu}; pg8::EpiPlain16 E{WSP(h16, OFF_YP), 1.0f / 4096.0f};
#if F8_DOWN
            pg8::Gemm g{WSP(const h16, OFF_HP), WSP(const h16, WS_W2), 256, 256, 256, nullptr}; pg8::gemm_phase<pg8::EpiPlain16, pg8::GroupOrder, false, 1>(F.lds, F.tid, g, S, E);
#else
            pg8::Gemm g{WSP(const h16, OFF_HP), WSP(const h16, WS_W2), 512, 512, 512, nullptr}; pg8::gemm_phase(F.lds, F.tid, g, S, E);
#endif
            } SEAM(pb + 12);
        if (IN(pb + 13)) for (int rep = 0; rep < REPS(13); ++rep) { phase_combine(F, p, l); } SEAM(pb + 13);
    }
#undef IN
#undef INR
#undef SEAM
}

extern "C" void kernel_launch(void* const* d_in, const int* in_sizes, int n_in, void* d_out, int out_size, void* d_ws, size_t ws_size, hipStream_t stream) {
    static int grid = 0;
    if (grid == 0) {
        if (n_in != 32 || out_size != NT * DM || ws_size < WS_END) { fprintf(stderr, "kernel_launch: unexpected shapes / workspace (%d inputs, out %d, ws %zu < %zu)\n", n_in, out_size, ws_size, (size_t)WS_END); grid = -1; return; }
        int dev = 0, cus = 0, per_cu = 0;
        if (hipGetDevice(&dev) != hipSuccess || hipDeviceGetAttribute(&cus, hipDeviceAttributeMultiprocessorCount, dev) != hipSuccess) { grid = -1; return; }
        if (hipFuncSetAttribute((const void*)fwd, hipFuncAttributeMaxDynamicSharedMemorySize, LDS_BYTES) != hipSuccess) { fprintf(stderr, "kernel_launch: hipFuncSetAttribute failed\n"); grid = -1; return; }
        if (hipOccupancyMaxActiveBlocksPerMultiprocessor(&per_cu, (const void*)fwd, 512, LDS_BYTES) != hipSuccess || per_cu < 1) { fprintf(stderr, "kernel_launch: occupancy query says %d\n", per_cu); }
        (void)hipGetLastError();
        grid = cus;
    }
    if (grid < 0) return;
    (void)hipMemsetAsync((char*)d_ws + WS_CTL, 0, CTL_ZERO_BYTES, stream);
    Prm p{};
    for (int i = 0; i < 32; ++i) p.in[i] = (const float*)d_in[i];
    p.out = (float*)d_out; p.ws = (unsigned char*)d_ws;
#if defined(PROBE_PHASE)
    p.ph_lo = 0; p.ph_hi = PROBE_PHASE + 1; hipLaunchKernelGGL(fwd, dim3(grid), dim3(512), LDS_BYTES, stream, p);
    (void)hipMemsetAsync((char*)d_ws + WS_CTL + CW_BAR * 4, 0, XCD_BAR_WORDS * 4, stream);
    p.ph_lo = PROBE_PHASE; p.ph_hi = PROBE_PHASE + 1; hipLaunchKernelGGL(fwd, dim3(grid), dim3(512), LDS_BYTES, stream, p);
    p.ph_lo = PROBE_PHASE + 1; p.ph_hi = NPHASES; hipLaunchKernelGGL(fwd, dim3(grid), dim3(512), LDS_BYTES, stream, p);
#elif MK_SINGLE
    p.ph_lo = 0; p.ph_hi = NPHASES;
    hipLaunchKernelGGL(fwd, dim3(grid), dim3(512), LDS_BYTES, stream, p);
#else
    for (int ph = 0; ph < NPHASES; ++ph) { p.ph_lo = ph; p.ph_hi = ph + 1; hipLaunchKernelGGL(fwd, dim3(grid), dim3(512), LDS_BYTES, stream, p); }
#endif
}
```

```cpp
#include <hip/hip_runtime.h>
#include <cstdio>
#include <cstdint>

#ifndef MK_SINGLE
#define MK_SINGLE 1
#endif

typedef _Float16 h16;
typedef _Float16 h16x2 __attribute__((ext_vector_type(2)));
typedef _Float16 h16x4 __attribute__((ext_vector_type(4)));
typedef _Float16 h16x8 __attribute__((ext_vector_type(8)));
typedef float f32x2 __attribute__((ext_vector_type(2)));
typedef float f32x4 __attribute__((ext_vector_type(4)));
typedef unsigned u32x2 __attribute__((ext_vector_type(2)));
typedef unsigned u32x4 __attribute__((ext_vector_type(4)));
typedef int i32x4 __attribute__((ext_vector_type(4)));
typedef int i32x8 __attribute__((ext_vector_type(8)));
#define LAS __attribute__((address_space(3)))
#define GAS __attribute__((address_space(1)))
#define PIN() do { asm volatile("" ::: "memory"); __builtin_amdgcn_sched_barrier(0); } while (0)
#define PINV(x) asm volatile("" : "+v"(x) :: "memory")
#define NTL(T, p) __builtin_nontemporal_load((const T*)(p))
#ifndef F8_Q
#define F8_Q 1
#endif
#ifndef F8_UP
#define F8_UP 1
#endif
#ifndef F8_DOWN
#define F8_DOWN 1
#endif
#ifndef F8_OUT
#define F8_OUT 0
#endif
#ifndef F8_O
#define F8_O 1
#endif
#ifndef P8MASK
#define P8MASK 0x607
#endif
#define F8_HB (P8MASK != 0 || F8_Q || F8_UP)
constexpr int p8_count(unsigned m) { int c = 0; for (int t = 0; t < 14; ++t) c += (m >> t) & 1; return c; }
constexpr unsigned long long p8_list(unsigned m) { unsigned long long r = 0; int j = 0; for (int t = 0; t < 14; ++t) if ((m >> t) & 1) { r |= (unsigned long long)t << (4 * j); ++j; } return r; }
constexpr unsigned long long p8_inv(unsigned m8) { unsigned long long r = 0; int j8 = 0, j16 = 0; for (int t = 0; t < 14; ++t) { if ((m8 >> t) & 1) { r |= (unsigned long long)j8 << (4 * t); ++j8; } else { r |= (unsigned long long)j16 << (4 * t); ++j16; } } return r; }
constexpr int P8_N8 = p8_count(P8MASK), P8_N16 = 14 - P8_N8;
constexpr size_t P8_WOFF = (size_t)P8_N16 * 256 * 2048;
constexpr unsigned long long P8_LIST8 = p8_list(P8MASK), P8_LIST16 = p8_list(~(unsigned)P8MASK & 0x3FFFu), P8_INV = p8_inv(P8MASK);
#define MFMA16(a, b, c) __builtin_amdgcn_mfma_f32_16x16x32_f16((a), (b), (c), 0, 0, 0)

constexpr int NB = 16, SEQ = 2048, DM = 1024, NT = NB * SEQ, MEML = 256, NTM = NB * MEML, NLAYER = 2;
constexpr int NPJ = 3584;
constexpr int CQ = 0, CK = 384, CV = 768, CG = 1152, CZ = 1536, CXS = 1920, CBM = 2304, CCM = 2560, CXR = 2816, CGT = 3072, CDT = 3328;
constexpr int DIN = 3334, NCH = 16, MAXSLOT = 73728;
constexpr float EPS = 1e-6f;
constexpr int NPH = 14;
constexpr int NPHASES = NLAYER * NPH;

constexpr size_t MiB = (size_t)1 << 20;
constexpr size_t WS_CTL = 0, CTL_ZERO_BYTES = 64 * 1024;
constexpr size_t WS_WIN = 1 * MiB, WS_WOUT = 8 * MiB, WS_WQ = 10 * MiB, WS_WKV = 12 * MiB, WS_WO = 16 * MiB, WS_W13 = 18 * MiB, WS_W2 = 82 * MiB, WS_LRUW = 114 * MiB;
constexpr size_t WS_HB = 115 * MiB;
constexpr size_t WS_R1 = 179 * MiB;
constexpr size_t WS_R2 = 403 * MiB;
constexpr size_t WS_KV = 547 * MiB, WS_MEM16 = 563 * MiB, WS_SSQ = 571 * MiB, WS_MISC = 573 * MiB, WS_END = 577 * MiB;
constexpr size_t OFF_QCA = WS_R1, OFF_OATT = WS_R1 + 64 * MiB, OFF_XP = WS_R1, OFF_HP = WS_R1 + 144 * MiB;
constexpr size_t OFF_OMIX = WS_R2, OFF_RST = WS_R2 + 64 * MiB, OFF_SST = WS_R2 + 88 * MiB, OFF_LSUM = WS_R2 + 136 * MiB, OFF_SDEC = WS_R2 + 137 * MiB, OFF_LCAR = WS_R2 + 138 * MiB, OFF_YP = WS_R2;
constexpr size_t OUT_HB8 = 0;
constexpr size_t OUT_XTG = 0, OUT_BCN = 24 * MiB, OUT_LAU = 56 * MiB;
constexpr size_t OFF_OMIX8 = WS_W13 + 32 * MiB;
static_assert(!F8_OUT || F8_UP, "OMIX8 lives in the space freed by the fp8 expert weights");
constexpr size_t OFF_KB = WS_KV, OFF_VT = WS_KV + 8 * MiB;
constexpr size_t OFF_ROPE = WS_MISC, OFF_MSSQ = WS_MISC + 512 * 1024, OFF_EID = WS_MISC + 768 * 1024, OFF_GATE = WS_MISC + 1024 * 1024, OFF_TSLOT = WS_MISC + 1280 * 1024,
                 OFF_RSTDT = WS_MISC + 1536 * 1024, OFF_SRSTD = WS_MISC + 1664 * 1024, OFF_TILEE = WS_MISC + 2000 * 1024, OFF_STOK = WS_MISC + 2048 * 1024, OFF_RWG = WS_MISC + 2400 * 1024, OFF_MRSTD = WS_MISC + 2600 * 1024;
constexpr int CW_COUNTS = 64, CW_CURSOR = 192, CW_NTILES = 320, CW_BAR = 4096;

constexpr int LDS_BYTES = 152 * 1024;
constexpr int LDS_MISC = 150 * 1024;

struct Prm { const float* in[32]; float* out; unsigned char* ws; int ph_lo, ph_hi; };

#define XB_TMO      128
#define XB_XCNT(j)  (256  + 64 * (j))
#define XB_XSUB(j)  (1280 + 64 * (j))
#define XB_XGEN(j)  (2304 + 64 * (j))
#define XB_TOP      3328
#define XB_TOPGEN   3392
#define XCD_BAR_WORDS 3456
#define XB_SPIN_CAP (1u << 18)
__device__ __forceinline__ unsigned xb_ld(unsigned* p)              { return __hip_atomic_load(p, __ATOMIC_RELAXED, __HIP_MEMORY_SCOPE_AGENT); }
__device__ __forceinline__ unsigned xb_add(unsigned* p, unsigned v) { return __hip_atomic_fetch_add(p, v, __ATOMIC_RELAXED, __HIP_MEMORY_SCOPE_AGENT); }
__device__ __forceinline__ unsigned xb_xcc_id() { return (unsigned)__builtin_amdgcn_s_getreg((3 << 11) | 20) & 0xFu; }
#define XB_SPIN(cond, bar) do { unsigned _sp = 0; while (cond) { __builtin_amdgcn_s_sleep(1); \
    if ((++_sp & 255u) == 0u) { if (xb_ld(&(bar)[XB_TMO])) break; if (_sp > XB_SPIN_CAP) { atomicAdd(&(bar)[XB_TMO], 1u); break; } } } } while (0)
struct XcdBarrier { unsigned* bar; unsigned x; volatile LAS unsigned* st; };
__device__ __forceinline__ XcdBarrier xcd_barrier_post(unsigned* bar, volatile LAS unsigned* st) {
    XcdBarrier b; b.bar = bar; b.x = xb_xcc_id(); b.st = st;
    if (threadIdx.x == 0) (void)xb_add(&bar[XB_XCNT(b.x)], 1u);
    return b;
}
__device__ __forceinline__ void xcd_barrier_complete(unsigned* bar, unsigned x, unsigned& nloc, unsigned& nx) {
    const unsigned G = gridDim.x * gridDim.y * gridDim.z;
    unsigned sum, cnt, mine, sp = 0u;
    for (;;) {
        sum = 0u; cnt = 0u; mine = 0u;
#pragma unroll
        for (unsigned j = 0; j < 16; ++j) { const unsigned c = xb_ld(&bar[XB_XCNT(j)]); sum += c; cnt += (c > 0u) ? 1u : 0u; mine = (j == x) ? c : mine; }
        if (sum == G) break;
        __builtin_amdgcn_s_sleep(1);
        if ((++sp & 255u) == 0u) { if (xb_ld(&bar[XB_TMO])) break; if (sp > XB_SPIN_CAP) { atomicAdd(&bar[XB_TMO], 1u); break; } }
    }
    nloc = mine > 0u ? mine : 1u; nx = cnt > 0u ? cnt : 1u;
}
__device__ __forceinline__ void xcd_barrier(const XcdBarrier& b) {
    asm volatile("s_waitcnt vmcnt(0)" ::: "memory");
    __syncthreads();
    if (threadIdx.x == 0) {
        unsigned* bar = b.bar;
        __builtin_amdgcn_s_waitcnt(0);
        unsigned nloc = b.st[0], nx = b.st[1];
        if (nloc == 0u) { xcd_barrier_complete(bar, b.x, nloc, nx); b.st[0] = nloc; b.st[1] = nx; }
        const unsigned old = xb_add(&bar[XB_XSUB(b.x)], 1u);
        const unsigned gen = old / nloc;
        if (old + 1u == (gen + 1u) * nloc) {
            __builtin_amdgcn_fence(__ATOMIC_RELEASE, "agent");
            asm volatile("s_waitcnt vmcnt(0)" ::: "memory");
            const unsigned og = xb_add(&bar[XB_TOP], 1u);
            const unsigned tg = og / nx;
            if (og + 1u == (tg + 1u) * nx) xb_add(&bar[XB_TOPGEN], 1u);
            else XB_SPIN(xb_ld(&bar[XB_TOPGEN]) == tg, bar);
            __builtin_amdgcn_fence(__ATOMIC_ACQUIRE, "agent");
            xb_add(&bar[XB_XGEN(b.x)], 1u);
            asm volatile("s_waitcnt vmcnt(0)" ::: "memory");
        } else {
            XB_SPIN(xb_ld(&bar[XB_XGEN(b.x)]) == gen, bar);
            __builtin_amdgcn_fence(__ATOMIC_ACQUIRE, "agent");
            asm volatile("s_waitcnt vmcnt(0)" ::: "memory");
        }
    }
    __syncthreads();
}

__device__ __forceinline__ float wave_sum(float v) {
#pragma unroll
    for (int o = 1; o < 64; o <<= 1) v += __shfl_xor(v, o);
    return v;
}
__device__ __forceinline__ float siluf_(float x) { return x * __builtin_amdgcn_rcpf(1.0f + __expf(-x)); }
__device__ __forceinline__ float softplusf_(float x) { return x > 20.f ? x : log1pf(__expf(x)); }
__device__ __forceinline__ float gelu_tanh_(float x) { const float y = 0.7978845608028654f * (x + 0.044715f * x * x * x); const float t = 1.0f - 2.0f / (__expf(2.0f * y) + 1.0f); return 0.5f * x * (1.0f + t); }
__device__ __forceinline__ h16x8 pack8(const f32x4 a, const f32x4 b) { h16x8 r; r[0] = (h16)a[0]; r[1] = (h16)a[1]; r[2] = (h16)a[2]; r[3] = (h16)a[3]; r[4] = (h16)b[0]; r[5] = (h16)b[1]; r[6] = (h16)b[2]; r[7] = (h16)b[3]; return r; }
__device__ __forceinline__ h16x4 pack4(const f32x4 a) { h16x4 r; r[0] = (h16)a[0]; r[1] = (h16)a[1]; r[2] = (h16)a[2]; r[3] = (h16)a[3]; return r; }
__device__ __forceinline__ unsigned cvt4_fp8(float a, float b, float c, float d) {
    a = __builtin_amdgcn_fmed3f(a, -448.f, 448.f); b = __builtin_amdgcn_fmed3f(b, -448.f, 448.f); c = __builtin_amdgcn_fmed3f(c, -448.f, 448.f); d = __builtin_amdgcn_fmed3f(d, -448.f, 448.f);
    int p = __builtin_amdgcn_cvt_pk_fp8_f32(a, b, 0, false); p = __builtin_amdgcn_cvt_pk_fp8_f32(c, d, p, true); return (unsigned)p; }
__device__ __forceinline__ h16x8 ldsfrag(LAS const h16* p) { return *(LAS const h16x8*)p; }
__device__ __forceinline__ int kperm32(int k) { return (k & ~31) | (((k >> 2) & 3) << 3) | (((k >> 4) & 1) << 2) | (k & 3); }
__device__ __forceinline__ h16x8 scalefrag(const h16x8 f, float s) { const h16 hs = (h16)s; h16x8 v;
#pragma unroll
    for (int j = 0; j < 8; ++j) v[j] = hs; return f * v; }
__device__ __forceinline__ float row_rstd(const float* ssq16) {
    const f32x4 a = *(const f32x4*)ssq16, b = *(const f32x4*)(ssq16 + 4), c = *(const f32x4*)(ssq16 + 8), d = *(const f32x4*)(ssq16 + 12);
    const float s = ((a[0] + a[1]) + (a[2] + a[3])) + ((b[0] + b[1]) + (b[2] + b[3])) + ((c[0] + c[1]) + (c[2] + c[3])) + ((d[0] + d[1]) + (d[2] + d[3]));
    return 1.0f / sqrtf(s * (1.0f / DM) + EPS);
}

namespace pg8 {
constexpr int BM = 256, BK = 64, HALF = 128, HTB = HALF * BK * 2, STAGE_BYTES = 8 * HTB, NXCD = 8, WGM = 8;
__host__ __device__ __forceinline__ int lds_byte(int r, int c) { const int st = (r >> 4) * 2 + (c >> 5), rr = r & 15, cc = c & 31, ob = rr * 64 + cc * 2; return st * 1024 + (ob ^ (((ob >> 9) & 1) << 5)); }
__host__ __device__ __forceinline__ void stage_rc(int b, int& R, int& C) { const int st = b / 1024, sb = b % 1024, swz = sb ^ (((sb >> 9) & 1) << 5); R = (st >> 1) * 16 + swz / 64; C = (st & 1) * 32 + (swz % 64) / 2; }
__host__ __device__ __forceinline__ int perm32(int rho) { const int n = rho >> 4, i = rho & 15; return 8 * (i >> 2) + 4 * n + (i & 3); }
struct Unit { int pm, pn; };
struct Gemm { const h16* A; const h16* Bt; int lda, ldb, K; const int* rowidx; };
struct StaticOrder {
    int nM, nN, nwg, G, c;
    __device__ void init(int M, int N, int G_, int c_) { nM = M / BM; nN = N / BM; nwg = nM * nN; G = G_; c = c_; }
    __device__ bool next(int i, Unit& u) const {
        const long L = (long)i * G + c; if (L >= nwg) return false;
        int wgid = (int)L; { const int q = nwg / NXCD, r = nwg % NXCD, xcd = wgid % NXCD, off = wgid / NXCD; wgid = (xcd < r ? xcd * (q + 1) : r * (q + 1) + (xcd - r) * q) + off; }
        const int nig = WGM * nN, gid = wgid / nig, fm = gid * WGM, gsz = (nM - fm) < WGM ? (nM - fm) : WGM;
        u.pm = fm + ((wgid % nig) % gsz); u.pn = (wgid % nig) / gsz; return true;
    }
};
struct GroupOrder {
    const int* tile_e; int ntiles, G, vcu;
    __device__ bool next(int i, Unit& u) const {
        const int L = i * G + vcu, tile = L >> 2; if (tile >= ntiles) return false;
        u.pm = tile; u.pn = __builtin_amdgcn_readfirstlane(tile_e[tile]) * 4 + (L & 3); return true;
    }
};

struct EpiScale16 {
    static constexpr bool PERM = true;
    h16* O; int ldc; const float* ssq; float cs;
    __device__ __forceinline__ void operator()(const f32x4 (&acc)[2][2][4][2], const Unit& u, int wr, int wc, int fr, int fq) const {
        const int row0 = u.pm * BM + wr * 64 + fr, col0 = u.pn * BM + wc * 32 + 8 * fq;
#pragma unroll
        for (int ai = 0; ai < 2; ++ai)
#pragma unroll
            for (int m = 0; m < 4; ++m) { const int row = row0 + ai * HALF + m * 16; const float rs = row_rstd(ssq + (size_t)row * 16) * cs; h16* rowp = O + (size_t)row * ldc + col0;
#pragma unroll
                for (int bj = 0; bj < 2; ++bj) *(h16x8*)(rowp + bj * HALF) = pack8(acc[ai][bj][m][0] * rs, acc[ai][bj][m][1] * rs); }
    }
};
struct EpiScale16C {
    static constexpr bool PERM = true;
    h16* O; int ldc; const float* rstd; float cs; unsigned long long cmap;
    __device__ __forceinline__ void operator()(const f32x4 (&acc)[2][2][4][2], const Unit& u, int wr, int wc, int fr, int fq) const {
        const int row0 = u.pm * BM + wr * 64 + fr, col0 = (int)((cmap >> (4 * u.pn)) & 15) * BM + wc * 32 + 8 * fq;
        float rs[2][4];
#pragma unroll
        for (int ai = 0; ai < 2; ++ai)
#pragma unroll
            for (int m = 0; m < 4; ++m) rs[ai][m] = rstd[row0 + ai * HALF + m * 16] * cs;
#pragma unroll
        for (int ai = 0; ai < 2; ++ai)
#pragma unroll
            for (int m = 0; m < 4; ++m) { h16* rowp = O + (size_t)(row0 + ai * HALF + m * 16) * ldc + col0;
#pragma unroll
                for (int bj = 0; bj < 2; ++bj) *(h16x8*)(rowp + bj * HALF) = pack8(acc[ai][bj][m][0] * rs[ai][m], acc[ai][bj][m][1] * rs[ai][m]); }
    }
};
struct EpiVT {
    static constexpr bool PERM = false;
    h16* VT; const float* mrstd;
    __device__ __forceinline__ void operator()(const f32x4 (&acc)[2][2][4][2], const Unit& u, int wr, int wc, int fr, int fq) const {
#pragma unroll
        for (int ai = 0; ai < 2; ++ai) { f32x4 rs[4];
#pragma unroll
            for (int m = 0; m < 4; ++m) rs[m] = *(const f32x4*)(mrstd + u.pm * BM + ai * HALF + wr * 64 + m * 16 + 4 * fq);
#pragma unroll
            for (int bj = 0; bj < 2; ++bj)
#pragma unroll
                for (int n = 0; n < 2; ++n) { h16* rowp = VT + ((size_t)(u.pm * 4 + u.pn) * 256 + bj * HALF + wc * 32 + n * 16 + fr) * 256 + ai * HALF + wr * 64 + 8 * fq;
#pragma unroll
                    for (int mm = 0; mm < 2; ++mm) *(h16x8*)(rowp + 32 * mm) = pack8(acc[ai][bj][2 * mm][n] * rs[2 * mm], acc[ai][bj][2 * mm + 1][n] * rs[2 * mm + 1]); } }
    }
};
struct EpiResid {
    static constexpr bool PERM = true;
    h16* hb; float* ssq; unsigned char* hb8; float cs;
    __device__ __forceinline__ void operator()(const f32x4 (&acc)[2][2][4][2], const Unit& u, int wr, int wc, int fr, int fq) const {
        const int row0 = u.pm * BM + wr * 64 + fr, col0 = u.pn * BM + wc * 32 + 8 * fq;
#pragma unroll
        for (int ai = 0; ai < 2; ++ai)
#pragma unroll
            for (int mp = 0; mp < 2; ++mp) { unsigned ch[2][2][2];
#pragma unroll
                for (int mm = 0; mm < 2; ++mm) { const int m = 2 * mp + mm; const int row = row0 + ai * HALF + m * 16; h16* rowp = hb + (size_t)row * DM + col0; float s = 0.f;
#pragma unroll
                    for (int bj = 0; bj < 2; ++bj) { const h16x8 bv = *(const h16x8*)(rowp + bj * HALF); f32x4 v0, v1;
#pragma unroll
                        for (int e = 0; e < 4; ++e) { v0[e] = (float)bv[e] + acc[ai][bj][m][0][e] * cs; v1[e] = (float)bv[4 + e] + acc[ai][bj][m][1][e] * cs; }
                        const h16x8 o = pack8(v0, v1); *(h16x8*)(rowp + bj * HALF) = o;
                        if (F8_HB) { ch[mm][bj][0] = cvt4_fp8(v0[0], v0[1], v0[2], v0[3]); ch[mm][bj][1] = cvt4_fp8(v1[0], v1[1], v1[2], v1[3]); }
#pragma unroll
                        for (int e = 0; e < 8; ++e) { const float q = (float)o[e]; s += q * q; } }
                    s += __shfl_xor(s, 16); s += __shfl_xor(s, 32);
                    if (fq == 0) ssq[(size_t)row * 16 + u.pn * 4 + wc] = s; }
                if (F8_HB) {
                    const int row = row0 + ai * HALF + (2 * mp + (fq & 1)) * 16; unsigned char* p8 = hb8 + (size_t)row * DM + u.pn * BM + wc * 32 + 8 * (fq & ~1);
#pragma unroll
                    for (int bj = 0; bj < 2; ++bj) { const auto s0 = __builtin_amdgcn_permlane16_swap(ch[0][bj][0], ch[1][bj][0], false, false), s1 = __builtin_amdgcn_permlane16_swap(ch[0][bj][1], ch[1][bj][1], false, false);
                        *(u32x4*)(p8 + bj * HALF) = (u32x4){s0[0], s1[0], s0[1], s1[1]}; } } }
    }
};
struct EpiGated {
    static constexpr bool PERM = true;
    h16* O; const float* srstd; float cs;
    __device__ __forceinline__ void operator()(const f32x4 (&acc)[2][2][4][2], const Unit& u, int wr, int wc, int fr, int fq) const {
        const int row0 = u.pm * BM + wr * 64 + fr, col0 = (u.pn & 3) * HALF + wc * 32 + 8 * fq;
#pragma unroll
        for (int ai = 0; ai < 2; ++ai)
#pragma unroll
            for (int m = 0; m < 4; ++m) { const int row = row0 + ai * HALF + m * 16; const float rs = srstd[row] * cs; f32x4 o[2];
#pragma unroll
                for (int n = 0; n < 2; ++n)
#pragma unroll
                    for (int j = 0; j < 4; ++j) { const float a = acc[ai][0][m][n][j] * rs, b = acc[ai][1][m][n][j] * rs; o[n][j] = siluf_(a) * b; }
                if (F8_DOWN) *(u32x2*)((unsigned char*)O + (size_t)row * 512 + col0) = (u32x2){cvt4_fp8(16.f * o[0][0], 16.f * o[0][1], 16.f * o[0][2], 16.f * o[0][3]), cvt4_fp8(16.f * o[1][0], 16.f * o[1][1], 16.f * o[1][2], 16.f * o[1][3])};
                else *(h16x8*)(O + (size_t)row * 512 + col0) = pack8(o[0], o[1]); }
    }
};
struct EpiPlain16 {
    static constexpr bool PERM = true;
    h16* O; float cs;
    __device__ __forceinline__ void operator()(const f32x4 (&acc)[2][2][4][2], const Unit& u, int wr, int wc, int fr, int fq) const {
        const int row0 = u.pm * BM + wr * 64 + fr, col0 = (u.pn & 3) * BM + wc * 32 + 8 * fq;
#pragma unroll
        for (int ai = 0; ai < 2; ++ai)
#pragma unroll
            for (int m = 0; m < 4; ++m) { h16* rowp = O + (size_t)(row0 + ai * HALF + m * 16) * DM + col0;
#pragma unroll
                for (int bj = 0; bj < 2; ++bj) *(h16x8*)(rowp + bj * HALF) = F8_DOWN ? pack8(acc[ai][bj][m][0] * cs, acc[ai][bj][m][1] * cs) : pack8(acc[ai][bj][m][0], acc[ai][bj][m][1]); }
    }
};

template <class Epi, class Sched, bool GATHER = false, int F8W = 0, bool SWAP = false>
__device__ __forceinline__ void gemm_phase(LAS unsigned char* lds, const int tid, const Gemm g, const Sched& S, const Epi& E) {
    const int wid = __builtin_amdgcn_readfirstlane(tid >> 6), lane = tid & 63, wr = wid >> 2, wc = wid & 3, fr = lane & 15, fq = lane >> 4;
    int K_ = g.K; asm volatile("" : "+s"(K_));
    const int K = K_, nt = K / BK;
    unsigned voffA[2], voffB[2];
#pragma unroll
    for (int i = 0; i < 2; ++i) { int R, C; stage_rc(tid * 16 + i * 8192, R, C); const int Rb = Epi::PERM ? ((R & ~31) + perm32(R & 31)) : R;
        voffA[i] = (unsigned)(R * g.lda + C) * 2u; voffB[i] = (unsigned)(Rb * g.ldb + C) * 2u; }
    const size_t kstep = (size_t)(BK * 2);
    const size_t hstepA = (size_t)HALF * g.lda * 2, hstepB = (size_t)HALF * g.ldb * 2;
    const size_t tstepA = 2 * hstepA, tstepB = 2 * hstepB;
    const unsigned ldsw = (unsigned)wid * 1024u;
    const int aoff = lds_byte(wr * 64 + fr, fq * 8), boff = lds_byte(wc * 32 + fr, fq * 8);
#define PG8_SA(b, h) (((b) * 2 + (h)) * HTB)
#define PG8_SB(b, h) ((4 + (b) * 2 + (h)) * HTB)
#define PG8_STAGE(bufoff, gbase, voff) do { _Pragma("unroll") for (int _i = 0; _i < 2; ++_i) \
        __builtin_amdgcn_global_load_lds((const unsigned*)((const char*)(gbase) + (voff)[_i]), (LAS unsigned*)(lds + (bufoff) + ldsw + _i * 8192), 16, 0, 0); } while (0)
    unsigned coff[2], noff[2], cbyte[2];
    if constexpr (GATHER) {
#pragma unroll
        for (int i = 0; i < 2; ++i) { int R_, C_; stage_rc(tid * 16 + i * 8192, R_, C_); cbyte[i] = (unsigned)(C_ * 2); } }
#define PG8_GOFF(u_, o_) do { _Pragma("unroll") for (int _i = 0; _i < 2; ++_i) { int R_, C_; stage_rc(tid * 16 + _i * 8192, R_, C_); \
        o_[_i] = (unsigned)g.rowidx[(u_).pm * BM + R_] | ((unsigned)g.rowidx[(u_).pm * BM + HALF + R_] << 16); } } while (0)
#define PG8_STAGEA(bufoff, gbase, h, sel) do { if constexpr (GATHER) { _Pragma("unroll") for (int _i = 0; _i < 2; ++_i) { const unsigned pk_ = (sel) ? noff[_i] : coff[_i]; \
        __builtin_amdgcn_global_load_lds((const unsigned*)((const char*)(gbase) + (((pk_ >> (16 * (h))) & 0xffffu) * (unsigned)(g.lda * 2) + cbyte[_i])), (LAS unsigned*)(lds + (bufoff) + ldsw + _i * 8192), 16, 0, 0); } } \
        else { PG8_STAGE(bufoff, (gbase) + ((h) ? hstepA : 0), voffA); } } while (0)
#define PG8_LDA(dst, b, h) do { _Pragma("unroll") for (int m = 0; m < 4; ++m) _Pragma("unroll") for (int k = 0; k < 2; ++k) dst[m][k] = *(const LAS h16x8*)(lds + PG8_SA(b, h) + aoff + m * 2048 + k * 1024); } while (0)
#define PG8_LDB(dst, b, h) do { _Pragma("unroll") for (int n = 0; n < 2; ++n) _Pragma("unroll") for (int k = 0; k < 2; ++k) dst[n][k] = *(const LAS h16x8*)(lds + PG8_SB(b, h) + boff + n * 2048 + k * 1024); } while (0)
#define PG8_MMA(ai, bj, At, Bt) do { __builtin_amdgcn_s_setprio(1); _Pragma("unroll") for (int m = 0; m < 4; ++m) _Pragma("unroll") for (int n = 0; n < 2; ++n) _Pragma("unroll") for (int k = 0; k < 2; ++k) \
        acc[ai][bj][m][n] = SWAP ? __builtin_amdgcn_mfma_f32_16x16x32_f16(At[m][k], Bt[n][k], acc[ai][bj][m][n], 0, 0, 0) : __builtin_amdgcn_mfma_f32_16x16x32_f16(Bt[n][k], At[m][k], acc[ai][bj][m][n], 0, 0, 0); __builtin_amdgcn_s_setprio(0); } while (0)
#define PG8_MMA8(ai, bj, At, Bt) do { __builtin_amdgcn_s_setprio(1); _Pragma("unroll") for (int m = 0; m < 4; ++m) _Pragma("unroll") for (int n = 0; n < 2; ++n) { \
        const i32x8 wf_ = __builtin_shufflevector(__builtin_bit_cast(i32x4, Bt[n][0]), __builtin_bit_cast(i32x4, Bt[n][1]), 0, 1, 2, 3, 4, 5, 6, 7), af_ = __builtin_shufflevector(__builtin_bit_cast(i32x4, At[m][0]), __builtin_bit_cast(i32x4, At[m][1]), 0, 1, 2, 3, 4, 5, 6, 7); \
        asm volatile("v_mfma_f32_16x16x128_f8f6f4 %0, %1, %2, %0" : "+v"(acc[ai][bj][m][n]) : "v"(wf_), "v"(af_)); } __builtin_amdgcn_s_setprio(0); } while (0)
#define PG8_MM(ai, bj, At, Bt) do { if constexpr (F8W != 0) PG8_MMA8(ai, bj, At, Bt); else PG8_MMA(ai, bj, At, Bt); } while (0)
#define PG8_WAIT_V(n) asm volatile("s_waitcnt vmcnt(" #n ")" ::: "memory")
#define PG8_WAIT_L(n) asm volatile("s_waitcnt lgkmcnt(" #n ")" ::: "memory")
#define PG8_BAR __builtin_amdgcn_s_barrier()
#define PG8_SCHED __builtin_amdgcn_sched_barrier(0)
    Unit cur, nxt; int ui = 0;
    if (!S.next(0, cur)) return;
    f32x4 acc[2][2][4][2];
#pragma unroll
    for (int a = 0; a < 2; ++a)
#pragma unroll
        for (int b = 0; b < 2; ++b)
#pragma unroll
            for (int m = 0; m < 4; ++m)
#pragma unroll
                for (int n = 0; n < 2; ++n) acc[a][b][m][n] = (f32x4){0.f, 0.f, 0.f, 0.f};
    h16x8 At[4][2], B0[2][2], B1[2][2];
    const char* cA = (const char*)g.A + (GATHER ? (size_t)0 : (size_t)cur.pm * tstepA); const char* cB = (const char*)g.Bt + (size_t)cur.pn * tstepB;
    if constexpr (GATHER) { PG8_GOFF(cur, coff); noff[0] = coff[0]; noff[1] = coff[1]; }
    PG8_STAGE(PG8_SB(0, 0), cB, voffB); PG8_STAGE(PG8_SB(0, 1), cB + hstepB, voffB); PG8_STAGEA(PG8_SA(0, 0), cA, 0, false); PG8_STAGEA(PG8_SA(0, 1), cA, 1, false);
    if (wr == 1) PG8_BAR;
    PG8_WAIT_V(2); PG8_BAR;
    PG8_STAGE(PG8_SB(1, 0), cB + kstep, voffB); PG8_STAGEA(PG8_SA(1, 0), cA + kstep, 0, false); PG8_STAGE(PG8_SB(1, 1), cB + hstepB + kstep, voffB);
    PG8_WAIT_V(6); PG8_BAR;
    for (;;) {
        const bool has_next = S.next(ui + 1, nxt);
        const char* nA = (has_next && !GATHER) ? (const char*)g.A + (size_t)nxt.pm * tstepA : cA; const char* nB = has_next ? (const char*)g.Bt + (size_t)nxt.pn * tstepB : cB;
        if constexpr (GATHER) { if (has_next) PG8_GOFF(nxt, noff); }
        for (int t = 0; t < nt; t += 2) {
            const bool last = (t == nt - 2);
            const char* a1 = cA + (size_t)(t + 1) * kstep;
            const char* a2 = last ? nA : cA + (size_t)(t + 2) * kstep; const char* b2 = last ? nB : cB + (size_t)(t + 2) * kstep;
            const char* a3 = a2 + kstep; const char* b3 = b2 + kstep;
            PG8_LDB(B0, 0, 0); PG8_LDB(B1, 0, 1); PG8_SCHED; PG8_LDA(At, 0, 0); PG8_STAGEA(PG8_SA(1, 1), a1, 1, false);
            PG8_WAIT_V(8); PG8_WAIT_L(0); PG8_BAR; PG8_MM(0, 0, At, B0); PG8_MM(0, 1, At, B1); PG8_BAR; PG8_SCHED;
            PG8_LDA(At, 0, 1); PG8_STAGE(PG8_SB(0, 0), b2, voffB); PG8_STAGE(PG8_SB(0, 1), b2 + hstepB, voffB); PG8_STAGEA(PG8_SA(0, 0), a2, 0, last);
            PG8_WAIT_V(8); PG8_WAIT_L(0); PG8_BAR; PG8_MM(1, 0, At, B0); PG8_MM(1, 1, At, B1); PG8_BAR; PG8_SCHED;
            PG8_LDB(B0, 1, 0); PG8_LDB(B1, 1, 1); PG8_SCHED; PG8_LDA(At, 1, 0); PG8_STAGEA(PG8_SA(0, 1), a2, 1, last);
            PG8_WAIT_V(8); PG8_WAIT_L(0); PG8_BAR; PG8_MM(0, 0, At, B0); PG8_MM(0, 1, At, B1); PG8_BAR; PG8_SCHED;
            PG8_LDA(At, 1, 1); PG8_STAGE(PG8_SB(1, 0), b3, voffB); PG8_STAGE(PG8_SB(1, 1), b3 + hstepB, voffB); PG8_STAGEA(PG8_SA(1, 0), a3, 0, last);
            PG8_WAIT_V(8); PG8_WAIT_L(0); PG8_BAR; PG8_MM(1, 0, At, B0); PG8_MM(1, 1, At, B1); PG8_BAR; PG8_SCHED;
        }
        if (wr == 0) PG8_BAR;
        if constexpr (F8W != 0) asm volatile("s_nop 7\n\ts_nop 7\n\ts_nop 7" ::: "memory");
        E(acc, cur, wr, wc, fr, fq);
        if (!has_next) break;
#pragma unroll
        for (int a = 0; a < 2; ++a)
#pragma unroll
            for (int b = 0; b < 2; ++b)
#pragma unroll
                for (int m = 0; m < 4; ++m)
#pragma unroll
                    for (int n = 0; n < 2; ++n) acc[a][b][m][n] = (f32x4){0.f, 0.f, 0.f, 0.f};
        cur = nxt; cA = nA; cB = nB; ++ui;
        if constexpr (GATHER) { coff[0] = noff[0]; coff[1] = noff[1]; }
        if (wr == 1) PG8_BAR;
    }
    PG8_WAIT_V(0);
    PG8_BAR;
#undef PG8_SA
#undef PG8_SB
#undef PG8_STAGE
#undef PG8_LDA
#undef PG8_GOFF
#undef PG8_STAGEA
#undef PG8_LDB
#undef PG8_MMA
#undef PG8_MMA8
#undef PG8_MM
#undef PG8_WAIT_V
#undef PG8_WAIT_L
#undef PG8_BAR
#undef PG8_SCHED
}
}

struct Frame {
    LAS unsigned char* lds;
    GAS unsigned char* ws;
    volatile LAS unsigned long long* ptab;
    float* out;
    int tid, lane, wave, G, vcu;
};
#define WSP(T, off) ((T*)(GAS T*)(F.ws + (off)))
__device__ __forceinline__ const float* inptr(const Frame& F, int i) {
    const unsigned long long v = F.ptab[i];
    const unsigned lo = __builtin_amdgcn_readfirstlane((unsigned)v), hi = __builtin_amdgcn_readfirstlane((unsigned)(v >> 32));
    return (const float*)(GAS const float*)(((unsigned long long)hi << 32) | lo);
}
__device__ __forceinline__ void launder(Frame& F) {
    int wv = F.wave; asm volatile("" : "+s"(wv)); F.wave = wv;
    unsigned z = 0u; asm volatile("" : "+v"(z));
    int t = wv * 64 + (int)__builtin_amdgcn_mbcnt_hi(~0u, __builtin_amdgcn_mbcnt_lo(~0u, z)); F.tid = t; F.lane = t & 63;
    const unsigned long long w = (unsigned long long)F.ws; unsigned wl = __builtin_amdgcn_readfirstlane((unsigned)w), wh = __builtin_amdgcn_readfirstlane((unsigned)(w >> 32));
    asm volatile("" : "+s"(wl), "+s"(wh)); F.ws = (GAS unsigned char*)(((unsigned long long)wh << 32) | wl);
    unsigned lo = __builtin_amdgcn_readfirstlane((unsigned)(uintptr_t)F.lds); asm volatile("" : "+s"(lo)); F.lds = (LAS unsigned char*)(uintptr_t)lo;
    int v = __builtin_amdgcn_readfirstlane(F.vcu); asm volatile("" : "+s"(v)); F.vcu = v;
}

struct TrItem { const float* W; const float* g; h16* Wt; int ldw, sc, nvalid, ldt, d0, k0, vw, f8; float mul; };
__device__ __forceinline__ void tr_describe(const Frame& F, GAS unsigned char* wsb_, int l, int it, TrItem& d) {
    unsigned char* wsb = (unsigned char*)wsb_;
    int r = it; d.g = nullptr; d.mul = 1.f; d.nvalid = 64; d.vw = 4; d.ldt = DM; d.ldw = DM; d.f8 = 0;
    if (r < 896) { const int d0 = 64 * (r % 56); d.W = inptr(F, 3) + (size_t)l * DM * DIN; d.ldw = DIN; d.g = inptr(F, 2) + l * DM; { const int tile = d0 >> 8, is8 = (P8MASK >> tile) & 1, pos = (int)((P8_INV >> (4 * tile)) & 15); d.Wt = (h16*)(wsb + WS_WIN + (is8 ? P8_WOFF : 0)); d.d0 = pos * 256 + (d0 & 255); if (is8) { d.f8 = 1; d.mul = 256.f; } }
        d.k0 = 64 * (r / 56); d.vw = 2;
        if (d0 < 2816) d.sc = d0; else if (d0 < 3328) d.sc = d0 + 6; else if (d0 == 3328) { d.sc = 2816; d.nvalid = 6; } else { d.sc = 0; d.nvalid = 0; } return; } r -= 896;
    if (r < 256) { d.W = inptr(F, 4) + (size_t)l * DM * DM; if (F8_OUT) { d.f8 = 1; d.mul = 256.f; } d.Wt = (h16*)(wsb + WS_WOUT); d.d0 = d.sc = 64 * (r % 16); d.k0 = 64 * (r / 16); return; } r -= 256;
    if (r < 256) { d.W = inptr(F, 20) + (size_t)l * DM * DM; d.g = inptr(F, 18) + l * DM; d.mul = F8_Q ? 256.f : 0.0625f; d.f8 = F8_Q; d.Wt = (h16*)(wsb + WS_WQ); d.d0 = d.sc = 64 * (r % 16); d.k0 = 64 * (r / 16); return; } r -= 256;
    if (r < 512) { d.W = inptr(F, 21) + (size_t)l * DM * 2048; d.ldw = 2048; d.g = inptr(F, 19) + l * DM; d.Wt = (h16*)(wsb + WS_WKV); d.d0 = d.sc = 64 * (r % 32); d.k0 = 64 * (r / 32); return; } r -= 512;
    if (r < 256) { d.W = inptr(F, 22) + (size_t)l * DM * DM; if (F8_O) { d.f8 = 1; d.mul = 256.f; } d.Wt = (h16*)(wsb + WS_WO); d.d0 = d.sc = 64 * (r % 16); d.k0 = 64 * (r / 16); return; } r -= 256;
    if (r < 8192) { const int e = r / 256, q = r % 256, d0 = 64 * (q % 16), grp = d0 >> 8, rr = d0 & 255;
        d.W = (rr < 128 ? inptr(F, 28) : inptr(F, 29)) + (size_t)(l * 32 + e) * DM * 512; d.ldw = 512; d.sc = grp * 128 + (rr & 127); d.g = inptr(F, 23) + l * DM; d.Wt = (h16*)(wsb + WS_W13 + (size_t)e * DM * DM * (F8_UP ? 1 : 2)); if (F8_UP) { d.f8 = 1; d.mul = 256.f; } d.d0 = d0; d.k0 = 64 * (q / 16); return; } r -= 8192;
    if (r < 4096) { const int e = r / 128, q = r % 128; d.W = inptr(F, 30) + (size_t)(l * 32 + e) * 512 * DM; d.Wt = (h16*)(wsb + WS_W2 + (size_t)e * DM * 512 * (F8_DOWN ? 1 : 2)); if (F8_DOWN) { d.f8 = 1; d.mul = 256.f; } d.ldt = 512; d.d0 = d.sc = 64 * (q % 16); d.k0 = 64 * (q / 16); return; } r -= 4096;
    { const int blk = r & 3, gate = (r >> 2) & 1, dir = r >> 3; d.W = (gate ? inptr(F, 16) : inptr(F, 14)) + (size_t)((l * 2 + dir) * 4 + blk) * 4096; d.ldw = 64; d.Wt = (h16*)(wsb + WS_LRUW) + (size_t)((dir * 2 + gate) * 4 + blk) * 4096; d.ldt = 64; d.d0 = d.sc = 0; d.k0 = 0; }
}
__device__ __forceinline__ void tr_load(const TrItem& d, int lane, f32x4 (&v)[16]) {
    if (d.vw == 4) { const int col = 4 * (lane & 15); const float* src = d.W + (size_t)(d.k0 + (lane >> 4)) * d.ldw + d.sc + col; const bool ok = col < d.nvalid;
#pragma unroll
        for (int i = 0; i < 16; ++i) v[i] = ok ? __builtin_nontemporal_load((const f32x4*)(src + (size_t)(4 * i) * d.ldw)) : (f32x4){0.f, 0.f, 0.f, 0.f};
    } else { const int col = 2 * (lane & 31); const float* src = d.W + (size_t)(d.k0 + (lane >> 5)) * d.ldw + d.sc + col; const bool ok = col < d.nvalid;
#pragma unroll
        for (int i = 0; i < 16; ++i) { const f32x2 a = ok ? __builtin_nontemporal_load((const f32x2*)(src + (size_t)(4 * i) * d.ldw)) : (f32x2){0.f, 0.f}, c = ok ? __builtin_nontemporal_load((const f32x2*)(src + (size_t)(4 * i + 2) * d.ldw)) : (f32x2){0.f, 0.f}; v[i] = (f32x4){a[0], a[1], c[0], c[1]}; } }
}
__device__ __forceinline__ void tr_to_lds(const TrItem& d, int lane, const f32x4 (&v)[16], LAS float* scr) {
    if (d.vw == 4) { LAS float* q = scr + (lane >> 4) * 65 + 4 * (lane & 15);
#pragma unroll
        for (int i = 0; i < 16; ++i) { q[(4 * i) * 65 + 0] = v[i][0]; q[(4 * i) * 65 + 1] = v[i][1]; q[(4 * i) * 65 + 2] = v[i][2]; q[(4 * i) * 65 + 3] = v[i][3]; }
    } else { LAS float* q = scr + (lane >> 5) * 65 + 2 * (lane & 31);
#pragma unroll
        for (int i = 0; i < 16; ++i) { q[(4 * i) * 65 + 0] = v[i][0]; q[(4 * i) * 65 + 1] = v[i][1]; q[(4 * i + 2) * 65 + 0] = v[i][2]; q[(4 * i + 2) * 65 + 1] = v[i][3]; } }
}
__device__ __forceinline__ void tr_from_lds(const TrItem& d, int lane, LAS const float* scr) {
    const int c = lane & 7; float gs[8];
    if (d.g) { const f32x4 g0 = *(const f32x4*)(d.g + d.k0 + 8 * c), g1 = *(const f32x4*)(d.g + d.k0 + 8 * c + 4);
        gs[0] = g0[0] * d.mul; gs[1] = g0[1] * d.mul; gs[2] = g0[2] * d.mul; gs[3] = g0[3] * d.mul; gs[4] = g1[0] * d.mul; gs[5] = g1[1] * d.mul; gs[6] = g1[2] * d.mul; gs[7] = g1[3] * d.mul;
    } else {
#pragma unroll
        for (int e = 0; e < 8; ++e) gs[e] = d.mul; }
    if (d.f8) {
#pragma unroll
        for (int j = 0; j < 8; ++j) { const int nn = (lane >> 3) + 8 * j; LAS const float* q = scr + (8 * c) * 65 + nn; float f[8];
#pragma unroll
            for (int e = 0; e < 8; ++e) f[e] = q[e * 65] * gs[e];
            *(u32x2*)((unsigned char*)d.Wt + (size_t)(d.d0 + nn) * d.ldt + d.k0 + 8 * c) = (u32x2){cvt4_fp8(f[0], f[1], f[2], f[3]), cvt4_fp8(f[4], f[5], f[6], f[7])}; }
        return; }
#pragma unroll
    for (int j = 0; j < 8; ++j) { const int nn = (lane >> 3) + 8 * j; LAS const float* q = scr + (8 * c) * 65 + nn; h16x8 o;
#pragma unroll
        for (int e = 0; e < 8; ++e) o[e] = (h16)(q[e * 65] * gs[e]);
        *(h16x8*)(d.Wt + (size_t)(d.d0 + nn) * d.ldt + d.k0 + 8 * c) = o; }
}
__device__ __forceinline__ void phase_convert(const Frame& F, const Prm& p, int l) {
    LAS float* scr = (LAS float*)(F.lds + F.wave * 16640);
    const int gw = F.vcu * 8 + F.wave, NGW = F.G * 8;
    constexpr int NITEMS = 896 + 256 + 256 + 512 + 256 + 8192 + 4096 + 16;
    { TrItem cur, nxt; f32x4 v[16]; int it = gw;
        if (it < NITEMS) { tr_describe(F, F.ws, l, it, cur); tr_load(cur, F.lane, v); }
        while (it < NITEMS) { const int itn = it + NGW; const bool hn = itn < NITEMS;
            tr_to_lds(cur, F.lane, v, scr);
            if (hn) { tr_describe(F, F.ws, l, itn, nxt); tr_load(nxt, F.lane, v); }
            asm volatile("s_waitcnt lgkmcnt(0)" ::: "memory");
            tr_from_lds(cur, F.lane, scr);
            asm volatile("s_waitcnt lgkmcnt(0)" ::: "memory");
            cur = nxt; it = itn; } }
    {
        const float* gm = inptr(F, 23) + l * DM; const float* wg = inptr(F, 24) + (size_t)l * DM * 4; const float* we = inptr(F, 26) + (size_t)l * DM * 32; h16* rwg = WSP(h16, OFF_RWG);
        for (int i = F.vcu * 512 + F.tid; i < 36 * DM; i += 256 * 512) { const int k = i / 36, j = i % 36; const float wv = gm[k] * (j < 4 ? wg[k * 4 + j] : we[k * 32 + (j - 4)]) * 1024.0f;
            const h16 hi = (h16)wv; rwg[(size_t)j * 1032 + k] = hi; rwg[(size_t)(36 + j) * 1032 + k] = (h16)(wv - (float)hi); } }
    if (l == 0) {
        for (int m = gw; m < NT + NTM; m += NGW) {
            const bool isx = m < NT; const int row = isx ? m : m - NT;
            const float* src = (isx ? inptr(F, 0) : inptr(F, 1)) + (size_t)row * DM; h16* dst = (isx ? WSP(h16, WS_HB) : WSP(h16, WS_MEM16)) + (size_t)row * DM;
            float* sq = (isx ? WSP(float, WS_SSQ) : WSP(float, OFF_MSSQ)) + (size_t)row * 16;
            float s = 0.f;
#pragma unroll
            for (int j = 0; j < 4; ++j) { const f32x4 v = __builtin_nontemporal_load((const f32x4*)(src + 4 * F.lane + 256 * j)); *(h16x4*)(dst + 4 * F.lane + 256 * j) = pack4(v);
                if (F8_HB && isx) *(unsigned*)((unsigned char*)F.out + OUT_HB8 + (size_t)row * DM + 4 * F.lane + 256 * j) = cvt4_fp8(v[0], v[1], v[2], v[3]); s += (v[0] * v[0] + v[1] * v[1]) + (v[2] * v[2] + v[3] * v[3]); }
            s = wave_sum(s);
            if (F.lane < 16) sq[F.lane] = (F.lane == 0) ? s : 0.f;
            if (F.lane == 0) (isx ? WSP(float, OFF_RSTDT) : WSP(float, OFF_MRSTD))[row] = 1.0f / sqrtf(s * (1.0f / DM) + EPS);
        }
        float* rope = WSP(float, OFF_ROPE);
        for (int i = F.vcu * 512 + F.tid; i < SEQ * 32; i += F.G * 512) {
            const int pos = i >> 5, fi = i & 31; double th = 1.0;
            for (int k = 0; k < fi; ++k) th *= 0.74989420933245582730;
            const double rev = (double)pos * th * 0.15915494309189533577;
            const double fr = rev - floor(rev);
            const double r = (fr - 0.5) * 6.28318530717958647692;
            const double r2 = r * r; double sn = 1.0, cs = 1.0;
            for (int k = 14; k >= 1; --k) { sn = 1.0 - r2 / (double)((2 * k) * (2 * k + 1)) * sn; cs = 1.0 - r2 / (double)((2 * k - 1) * (2 * k)) * cs; }
            sn *= r;
            rope[pos * 64 + fi] = (float)(-cs); rope[pos * 64 + 32 + fi] = (float)(-sn);
        }
    }
}

template <bool SILU>
__device__ __forceinline__ void conv_rows8(const h16* projcol, long tbase, int n, int r0, const float* cw, int cdim, const float* cb, h16x8 (&out)[8]) {
    f32x4 w[4][2];
#pragma unroll
    for (int k = 0; k < 4; ++k) { w[k][0] = *(const f32x4*)(cw + k * cdim); w[k][1] = *(const f32x4*)(cw + k * cdim + 4); }
    const f32x4 b0 = *(const f32x4*)cb, b1 = *(const f32x4*)(cb + 4);
    h16x8 x[11];
#pragma unroll
    for (int i = 0; i < 11; ++i) { const int pos = n * 128 + r0 - 2 + i; h16x8 z;
#pragma unroll
        for (int e = 0; e < 8; ++e) z[e] = (h16)0.f;
        x[i] = (pos >= 0 && pos < SEQ) ? NTL(h16x8, projcol + (size_t)(tbase + r0 - 2 + i) * NPJ) : z; }
#pragma unroll
    for (int r = 0; r < 8; ++r) {
#pragma unroll
        for (int e = 0; e < 8; ++e) { float a = e < 4 ? b0[e] : b1[e - 4];
#pragma unroll
            for (int k = 0; k < 4; ++k) a += (e < 4 ? w[k][0][e] : w[k][1][e - 4]) * (float)x[r + k][e];
            out[r][e] = (h16)(SILU ? siluf_(a) : a); } }
}
__device__ __forceinline__ h16x8 col_of(const h16x8 (&o)[8], int e) { h16x8 c; c[0] = o[0][e]; c[1] = o[1][e]; c[2] = o[2][e]; c[3] = o[3][e]; c[4] = o[4][e]; c[5] = o[5][e]; c[6] = o[6][e]; c[7] = o[7][e]; return c; }

__device__ __forceinline__ void ret_scan_unit(const Frame& F, int u) {
    const int h = u % 6, b = (u / 6) % NB, dir = u / (6 * NB);
    const float gC = exp2f(128.0f * log1pf(-exp2f(-5.0f - (float)h)) * 1.4426950408889634f);
    h16* base = WSP(h16, OFF_RST) + ((size_t)((dir * NB + b) * NCH) * 6 + h) * 4096 + F.tid * 8;
    float acc[8];
#pragma unroll
    for (int e = 0; e < 8; ++e) acc[e] = 0.f;
#pragma unroll 1
    for (int half = 0; half < 2; ++half) { h16x8 sv[8];
#pragma unroll
        for (int i = 0; i < 8; ++i) { const int ii = 8 * half + i, n = dir == 0 ? ii : NCH - 1 - ii; sv[i] = *(const h16x8*)(base + (size_t)n * 6 * 4096); }
#pragma unroll
        for (int i = 0; i < 8; ++i) { const int ii = 8 * half + i, n = dir == 0 ? ii : NCH - 1 - ii; h16x8 o;
#pragma unroll
            for (int e = 0; e < 8; ++e) { o[e] = (h16)acc[e]; acc[e] = acc[e] * gC + (float)sv[i][e]; }
            *(h16x8*)(base + (size_t)n * 6 * 4096) = o; } }
}
#define RET_BAR() do { asm volatile("s_waitcnt lgkmcnt(0)" ::: "memory"); __builtin_amdgcn_s_barrier(); asm volatile("" ::: "memory"); } while (0)
__device__ __forceinline__ void ret_states_block(const Frame& F, int bn) {
    const int n = bn % NCH, b = bn / NCH; const long t0 = (long)b * SEQ + n * 128;
    const int r = F.tid >> 2, c = F.tid & 3;
    const h16* rowp = WSP(const h16, WS_R1) + (size_t)(t0 + r) * NPJ; const float* cs = WSP(const float, OFF_ROPE) + (size_t)(n * 128 + r) * 64 + 8 * c;
    const f32x4 c0 = *(const f32x4*)cs, c1 = *(const f32x4*)(cs + 4), s0 = *(const f32x4*)(cs + 32), s1 = *(const f32x4*)(cs + 36);
    const int dir = F.wave >> 2, dt = F.wave & 3, fr = F.lane & 15, fq = F.lane >> 4;
    h16x8 k1, k2, v1, v2;
#define RS_LOAD(hh) do { k1 = *(const h16x8*)(rowp + CK + (hh) * 64 + 8 * c); k2 = *(const h16x8*)(rowp + CK + (hh) * 64 + 32 + 8 * c); v1 = *(const h16x8*)(rowp + CV + (hh) * 64 + 16 * c); v2 = *(const h16x8*)(rowp + CV + (hh) * 64 + 16 * c + 8); } while (0)
    RS_LOAD(0);
#pragma unroll 1
    for (int h = 0; h < 6; ++h) {
        LAS h16* KT = (LAS h16*)(F.lds + (h & 1) * 34816); LAS h16* VT = KT + 64 * 136;
#pragma unroll
        for (int e = 0; e < 8; ++e) { const float x1 = (float)k1[e], x2 = (float)k2[e], co = e < 4 ? c0[e] : c1[e - 4], si = e < 4 ? s0[e] : s1[e - 4];
            KT[(8 * c + e) * 136 + r] = (h16)((x1 * co - x2 * si) * 0.125f); KT[(32 + 8 * c + e) * 136 + r] = (h16)((x1 * si + x2 * co) * 0.125f); }
#pragma unroll
        for (int e = 0; e < 8; ++e) { VT[(16 * c + e) * 136 + r] = v1[e]; VT[(16 * c + 8 + e) * 136 + r] = v2[e]; }
        if (h < 5) RS_LOAD(h + 1);
        RET_BAR();
        const float l2g = log1pf(-exp2f(-5.0f - (float)h)) * 1.4426950408889634f;
        h16x8 xw[4];
#pragma unroll
        for (int ks = 0; ks < 4; ++ks) { const h16x8 f = ldsfrag(KT + (16 * dt + fr) * 136 + 32 * ks + 8 * fq); h16x8 wv;
#pragma unroll
            for (int jj = 0; jj < 8; ++jj) { const int j = 32 * ks + 8 * fq + jj; wv[jj] = (h16)exp2f(l2g * (float)(dir == 0 ? 127 - j : j)); }
            xw[ks] = f * wv; }
        h16* rst = WSP(h16, OFF_RST) + ((size_t)((dir * NB + b) * NCH + n) * 6 + h) * 4096;
#pragma unroll
        for (int et = 0; et < 4; ++et) { f32x4 acc = {0.f, 0.f, 0.f, 0.f};
#pragma unroll
            for (int ks = 0; ks < 4; ++ks) acc = MFMA16(xw[ks], ldsfrag(VT + (16 * et + fr) * 136 + 32 * ks + 8 * fq), acc);
            *(h16x4*)(rst + (16 * et + fr) * 64 + 16 * dt + 4 * fq) = pack4(acc); }
    }
#undef RS_LOAD
    __syncthreads();
}
__device__ __forceinline__ void ret_out_block(const Frame& F, int bn) {
    const int n = bn % NCH, b = bn / NCH; const long t0 = (long)b * SEQ + n * 128;
    const int r = F.tid >> 2, c = F.tid & 3, rp = kperm32(r), er = F.tid >> 3, d0 = (F.tid & 7) * 8;
    const h16* rowp = WSP(const h16, WS_R1) + (size_t)(t0 + r) * NPJ; const float* cs = WSP(const float, OFF_ROPE) + (size_t)(n * 128 + r) * 64 + 8 * c;
    const f32x4 c0 = *(const f32x4*)cs, c1 = *(const f32x4*)(cs + 4), s0 = *(const f32x4*)(cs + 32), s1 = *(const f32x4*)(cs + 36);
    const int w = F.wave, fr = F.lane & 15, fq = F.lane >> 4, il = 16 * w + fr;
    const h16* grow = WSP(const h16, WS_R1) + (size_t)(t0 + il) * NPJ + CG + 4 * fq; h16* orow = WSP(h16, OFF_OMIX) + (size_t)(t0 + il) * DM + 4 * fq; unsigned char* orow8 = WSP(unsigned char, OFF_OMIX8) + (size_t)(t0 + il) * DM + 4 * fq;
    const h16* st0 = WSP(const h16, OFF_RST) + ((size_t)((0 * NB + b) * NCH + n) * 6) * 4096 + F.tid * 8; const h16* st1 = WSP(const h16, OFF_RST) + ((size_t)((1 * NB + b) * NCH + n) * 6) * 4096 + F.tid * 8;
    h16x8 q1, q2, k1, k2, v1, v2, sf, sb; h16x4 gn[4];
#define RO_LOAD(hh) do { q1 = NTL(h16x8, rowp + CQ + (hh) * 64 + 8 * c); q2 = NTL(h16x8, rowp + CQ + (hh) * 64 + 32 + 8 * c); k1 = NTL(h16x8, rowp + CK + (hh) * 64 + 8 * c); k2 = NTL(h16x8, rowp + CK + (hh) * 64 + 32 + 8 * c); \
        v1 = NTL(h16x8, rowp + CV + (hh) * 64 + 16 * c); v2 = NTL(h16x8, rowp + CV + (hh) * 64 + 16 * c + 8); sf = NTL(h16x8, st0 + (hh) * 4096); sb = NTL(h16x8, st1 + (hh) * 4096); \
        _Pragma("unroll") for (int et_ = 0; et_ < 4; ++et_) gn[et_] = NTL(h16x4, grow + (hh) * 64 + 16 * et_); } while (0)
    RO_LOAD(0);
#pragma unroll 1
    for (int h = 0; h < 6; ++h) {
        LAS h16* Qt = (LAS h16*)(F.lds + (h & 1) * 72704); LAS h16* Kt = Qt + 128 * 72; LAS h16* VT = Kt + 128 * 72; LAS h16* Ff = VT + 64 * 136; LAS h16* Fb = Ff + 64 * 72;
        { h16x8 qa, qb, ka, kb;
#pragma unroll
            for (int e = 0; e < 8; ++e) { const float co = e < 4 ? c0[e] : c1[e - 4], si = e < 4 ? s0[e] : s1[e - 4];
                float x1 = (float)q1[e], x2 = (float)q2[e]; qa[e] = (h16)(x1 * co - x2 * si); qb[e] = (h16)(x1 * si + x2 * co);
                x1 = (float)k1[e]; x2 = (float)k2[e]; ka[e] = (h16)((x1 * co - x2 * si) * 0.125f); kb[e] = (h16)((x1 * si + x2 * co) * 0.125f); }
            *(LAS h16x8*)(Qt + r * 72 + 8 * c) = qa; *(LAS h16x8*)(Qt + r * 72 + 32 + 8 * c) = qb;
            *(LAS h16x8*)(Kt + r * 72 + 8 * c) = ka; *(LAS h16x8*)(Kt + r * 72 + 32 + 8 * c) = kb; }
#pragma unroll
        for (int e = 0; e < 8; ++e) { VT[(16 * c + e) * 136 + rp] = v1[e]; VT[(16 * c + 8 + e) * 136 + rp] = v2[e]; }
        *(LAS h16x8*)(Ff + er * 72 + d0) = sf; *(LAS h16x8*)(Fb + er * 72 + d0) = sb;
        h16x4 gc[4];
#pragma unroll
        for (int et = 0; et < 4; ++et) gc[et] = gn[et];
        if (h < 5) RO_LOAD(h + 1);
        RET_BAR();
        const float l2g = log1pf(-exp2f(-5.0f - (float)h)) * 1.4426950408889634f;
        h16x8 qf[2];
#pragma unroll
        for (int ks = 0; ks < 2; ++ks) qf[ks] = ldsfrag(Qt + il * 72 + 32 * ks + 8 * fq);
        f32x4 s[8];
#pragma unroll
        for (int jt = 0; jt < 8; ++jt) { f32x4 a = {0.f, 0.f, 0.f, 0.f};
#pragma unroll
            for (int ks = 0; ks < 2; ++ks) a = MFMA16(ldsfrag(Kt + (16 * jt + fr) * 72 + 32 * ks + 8 * fq), qf[ks], a);
#pragma unroll
            for (int q = 0; q < 4; ++q) { const int j = 16 * jt + 4 * fq + q; const int dd = il > j ? il - j : j - il; a[q] *= exp2f(l2g * (float)dd); }
            PINV(a); s[jt] = a; }
        f32x4 o[4];
#pragma unroll
        for (int et = 0; et < 4; ++et) o[et] = (f32x4){0.f, 0.f, 0.f, 0.f};
#pragma unroll
        for (int kp = 0; kp < 4; ++kp) { const h16x8 pf = pack8(s[2 * kp], s[2 * kp + 1]);
#pragma unroll
            for (int et = 0; et < 4; ++et) o[et] = MFMA16(ldsfrag(VT + (16 * et + fr) * 136 + 32 * kp + 8 * fq), pf, o[et]); }
        const float gf = exp2f(l2g * (float)(il + 1)), gb = exp2f(l2g * (float)(128 - il));
#pragma unroll
        for (int ks = 0; ks < 2; ++ks) { const h16x8 qff = scalefrag(qf[ks], gf), qfb = scalefrag(qf[ks], gb);
#pragma unroll
            for (int et = 0; et < 4; ++et) { o[et] = MFMA16(ldsfrag(Ff + (16 * et + fr) * 72 + 32 * ks + 8 * fq), qff, o[et]); o[et] = MFMA16(ldsfrag(Fb + (16 * et + fr) * 72 + 32 * ks + 8 * fq), qfb, o[et]); } }
        float ss = 0.f;
#pragma unroll
        for (int et = 0; et < 4; ++et) ss += (o[et][0] * o[et][0] + o[et][1] * o[et][1]) + (o[et][2] * o[et][2] + o[et][3] * o[et][3]);
        ss += __shfl_xor(ss, 16); ss += __shfl_xor(ss, 32);
        const float rs = 1.0f / sqrtf(ss * (1.0f / 64.0f) + EPS);
#pragma unroll
        for (int et = 0; et < 4; ++et) { f32x4 q;
#pragma unroll
            for (int e = 0; e < 4; ++e) q[e] = o[et][e] * rs * siluf_((float)gc[et][e]);
            if (F8_OUT) *(unsigned*)(orow8 + h * 64 + 16 * et) = cvt4_fp8(8.f * q[0], 8.f * q[1], 8.f * q[2], 8.f * q[3]);
            else *(h16x4*)(orow + h * 64 + 16 * et) = pack4(q); }
    }
#undef RO_LOAD
    __syncthreads();
}
#undef RET_BAR

__device__ __forceinline__ void ssd_stage_dt(const Frame& F, const Prm& p, int l, int g, long t0, LAS float* LA, LAS float* DTS) {
    if (F.tid < 128) { const h16* dp = WSP(const h16, WS_R1) + (size_t)(t0 + F.tid) * NPJ + CDT + g * 3;
#pragma unroll
        for (int r = 0; r < 3; ++r) { const float raw = (float)dp[r];
#pragma unroll
            for (int dir = 0; dir < 2; ++dir) { const float dt = softplusf_(raw + inptr(F, 7)[(l * 2 + dir) * 6 + g * 3 + r]); const float la = -dt * __expf(inptr(F, 8)[(l * 2 + dir) * 6 + g * 3 + r]);
                DTS[(dir * 3 + r) * 128 + F.tid] = dt; LA[(dir * 3 + r) * 128 + F.tid] = la; } } }
}
__device__ __forceinline__ void ssd_cumsum(const Frame& F, LAS const float* LAq, float& v0, float& v1, float& c0, float& c1, float& tot) {
    v0 = LAq[2 * F.lane]; v1 = LAq[2 * F.lane + 1]; float s = v0 + v1;
#pragma unroll
    for (int o = 1; o < 64; o <<= 1) { const float t = __shfl_up(s, o); if (F.lane >= o) s += t; }
    c1 = s; c0 = s - v1; tot = __shfl(s, 63);
}
__device__ __forceinline__ void ssd_states_unit(const Frame& F, const Prm& p, int l, int u) {
    const int g = u & 1, bn = u >> 1, n = bn % NCH, b = bn / NCH; const long t0 = (long)b * SEQ + n * 128;
    const h16* proj = WSP(const h16, WS_R1);
    LAS h16* XT = (LAS h16*)F.lds; LAS h16* BT = XT + 3 * 64 * 136; LAS float* LA = (LAS float*)(BT + 128 * 136); LAS float* DTS = LA + 6 * 128; LAS float* WW = DTS + 6 * 128;
    ssd_stage_dt(F, p, l, g, t0, LA, DTS);
    const float* cw = inptr(F, 5) + (size_t)l * 4 * 896; const float* cb = inptr(F, 6) + (size_t)l * 896;
    h16* bcn = ((h16*)((unsigned char*)F.out + OUT_BCN));
    for (int task = F.tid; task < 56 * 16; task += 512) { const int cg = task % 56, r0 = (task / 56) * 8; h16x8 o[8];
        if (cg < 24) { conv_rows8<true>(proj + CXS + g * 192 + 8 * cg, t0, n, r0, cw + g * 192 + 8 * cg, 896, cb + g * 192 + 8 * cg, o);
            LAS h16* d = XT + (cg >> 3) * 64 * 136 + ((cg & 7) * 8) * 136 + r0;
#pragma unroll
            for (int e = 0; e < 8; ++e) *(LAS h16x8*)(d + e * 136) = col_of(o, e);
        } else { const int c8 = (cg - 24) & 15; const bool isB = cg < 40; const int col = (isB ? CBM : CCM) + g * 128 + 8 * c8, ci = (isB ? 384 : 640) + g * 128 + 8 * c8;
            conv_rows8<true>(proj + col, t0, n, r0, cw + ci, 896, cb + ci, o);
#pragma unroll
            for (int r = 0; r < 8; ++r) *(h16x8*)(bcn + (size_t)(t0 + r0 + r) * 512 + (isB ? 0 : 256) + g * 128 + 8 * c8) = o[r];
            if (isB) { LAS h16* d = BT + (8 * c8) * 136 + r0;
#pragma unroll
                for (int e = 0; e < 8; ++e) *(LAS h16x8*)(d + e * 136) = col_of(o, e); } } }
    __syncthreads();
    { h16* xtg = ((h16*)((unsigned char*)F.out + OUT_XTG)) + ((size_t)(b * NCH + n) * 6 + g * 3) * 8192;
#pragma unroll
        for (int k = 0; k < 6; ++k) { const int it = F.tid + 512 * k, rr = it >> 4, c = it & 15; const h16x8 v = *(LAS const h16x8*)(XT + rr * 136 + 8 * c);
            *(h16x4*)(xtg + rr * 128 + kperm32(8 * c)) = __builtin_shufflevector(v, v, 0, 1, 2, 3); *(h16x4*)(xtg + rr * 128 + kperm32(8 * c + 4)) = __builtin_shufflevector(v, v, 4, 5, 6, 7); } }
    if (F.wave < 6) { const int q = F.wave, dir = q / 3, r = q % 3; float v0, v1, c0, c1, tot; ssd_cumsum(F, LA + q * 128, v0, v1, c0, c1, tot);
        const float d0 = DTS[q * 128 + 2 * F.lane], d1 = DTS[q * 128 + 2 * F.lane + 1];
        if (dir == 0) { WW[q * 128 + 2 * F.lane] = __expf(tot - c0) * d0 * 256.f; WW[q * 128 + 2 * F.lane + 1] = __expf(tot - c1) * d1 * 256.f; }
        else { WW[q * 128 + 2 * F.lane] = __expf(c0 - v0) * d0 * 256.f; WW[q * 128 + 2 * F.lane + 1] = __expf(c1 - v1) * d1 * 256.f; }
        if (F.lane == 0) WSP(float, OFF_SDEC)[((size_t)(b * NCH + n) * 6 + g * 3 + r) * 2 + dir] = tot; }
    __syncthreads();
    const int w = F.wave, fr = F.lane & 15, fq = F.lane >> 4;
    h16x8 xb[4];
#pragma unroll
    for (int ks = 0; ks < 4; ++ks) xb[ks] = ldsfrag(BT + (16 * w + fr) * 136 + 32 * ks + 8 * fq);
    for (int q = 0; q < 6; ++q) { const int dir = q / 3, r = q % 3;
        h16x8 wf[4];
#pragma unroll
        for (int ks = 0; ks < 4; ++ks) { const f32x4 a = *(LAS const f32x4*)(WW + q * 128 + 32 * ks + 8 * fq), c = *(LAS const f32x4*)(WW + q * 128 + 32 * ks + 8 * fq + 4); wf[ks] = pack8(a, c); }
        h16* sst = WSP(h16, OFF_SST) + ((size_t)((dir * NB + b) * NCH + n) * 6 + g * 3 + r) * 8192;
#pragma unroll
        for (int pt = 0; pt < 4; ++pt) { f32x4 acc = {0.f, 0.f, 0.f, 0.f};
#pragma unroll
            for (int ks = 0; ks < 4; ++ks) acc = MFMA16(xb[ks], ldsfrag(XT + r * 64 * 136 + (16 * pt + fr) * 136 + 32 * ks + 8 * fq) * wf[ks], acc);
            *(h16x4*)(sst + (16 * pt + fr) * 128 + 16 * w + 4 * fq) = pack4(acc * (1.0f / 256.f)); } }
    __syncthreads();
}
__device__ __forceinline__ void ssd_scan_unit(const Frame& F, int u) {
    const int hd = u % 6, b = (u / 6) % NB, dir = u / (6 * NB);
    h16* base = WSP(h16, OFF_SST) + ((size_t)((dir * NB + b) * NCH) * 6 + hd) * 8192 + F.tid * 16;
    const float* dbase = WSP(const float, OFF_SDEC) + ((size_t)(b * NCH) * 6 + hd) * 2 + dir;
    float acc[16];
#pragma unroll
    for (int e = 0; e < 16; ++e) acc[e] = 0.f;
#pragma unroll 1
    for (int q = 0; q < 4; ++q) { h16x8 s0[4], s1[4]; float dec[4];
#pragma unroll
        for (int i = 0; i < 4; ++i) { const int ii = 4 * q + i, n = dir == 0 ? ii : NCH - 1 - ii; s0[i] = *(const h16x8*)(base + (size_t)n * 6 * 8192); s1[i] = *(const h16x8*)(base + (size_t)n * 6 * 8192 + 8); dec[i] = dbase[n * 12]; }
#pragma unroll
        for (int i = 0; i < 4; ++i) { const int ii = 4 * q + i, n = dir == 0 ? ii : NCH - 1 - ii; const float dc = __expf(dec[i]); h16x8 o0, o1;
#pragma unroll
            for (int e = 0; e < 8; ++e) { o0[e] = (h16)acc[e]; o1[e] = (h16)acc[8 + e]; acc[e] = acc[e] * dc + (float)s0[i][e]; acc[8 + e] = acc[8 + e] * dc + (float)s1[i][e]; }
            *(h16x8*)(base + (size_t)n * 6 * 8192) = o0; *(h16x8*)(base + (size_t)n * 6 * 8192 + 8) = o1; } }
}
__device__ __forceinline__ void ssd_out_unit(const Frame& F, const Prm& p, int l, int u) {
    const int g = u & 1, bn = u >> 1, n = bn % NCH, b = bn / NCH; const long t0 = (long)b * SEQ + n * 128;
    const h16* proj = WSP(const h16, WS_R1);
    LAS h16* XT = (LAS h16*)F.lds; LAS h16* Bt = XT + 3 * 64 * 136; LAS h16* Ct = Bt + 128 * 136; LAS float* LA = (LAS float*)(Ct + 128 * 136); LAS float* DTS = LA + 6 * 128;
    LAS float* CE = DTS + 6 * 128;
    LAS float* TOTB = CE + 6 * 128;
    ssd_stage_dt(F, p, l, g, t0, LA, DTS);
    const float* cw = inptr(F, 5) + (size_t)l * 4 * 896; const float* cb = inptr(F, 6) + (size_t)l * 896;
    { const h16* xtg = ((const h16*)((const unsigned char*)F.out + OUT_XTG)) + ((size_t)(b * NCH + n) * 6 + g * 3) * 8192; const h16* bcn = ((const h16*)((const unsigned char*)F.out + OUT_BCN)) + (size_t)t0 * 512 + g * 128;
        h16x8 xv[6], bv[8];
#pragma unroll
        for (int k = 0; k < 6; ++k) { const int it = F.tid + 512 * k; xv[k] = NTL(h16x8, xtg + (it >> 4) * 128 + 8 * (it & 15)); }
#pragma unroll
        for (int k = 0; k < 8; ++k) { const int it = F.tid + 512 * k, row = it >> 5, c = it & 31; bv[k] = NTL(h16x8, bcn + (size_t)row * 512 + (c < 16 ? 8 * c : 256 + 8 * (c - 16))); }
#pragma unroll
        for (int k = 0; k < 6; ++k) { const int it = F.tid + 512 * k; *(LAS h16x8*)(XT + (it >> 4) * 136 + 8 * (it & 15)) = xv[k]; }
#pragma unroll
        for (int k = 0; k < 8; ++k) { const int it = F.tid + 512 * k, row = it >> 5, c = it & 31; *(LAS h16x8*)((c < 16 ? Bt : Ct) + row * 136 + 8 * (c & 15)) = bv[k]; }
        PIN(); }
    __syncthreads();
    if (F.wave < 6) { const int q = F.wave; float v0, v1, c0, c1, tot; ssd_cumsum(F, LA + q * 128, v0, v1, c0, c1, tot);
        if (q < 3) { CE[q * 128 + 2 * F.lane] = c0; CE[q * 128 + 2 * F.lane + 1] = c1; }
        else { CE[q * 128 + 2 * F.lane] = c0 - v0; CE[q * 128 + 2 * F.lane + 1] = c1 - v1; if (F.lane == 0) TOTB[q - 3] = tot; } }
    __syncthreads();
    const int w = F.wave, fr = F.lane & 15, fq = F.lane >> 4, il = 16 * w + fr;
    h16x8 cf[4];
#pragma unroll
    for (int ks = 0; ks < 4; ++ks) cf[ks] = ldsfrag(Ct + il * 136 + 32 * ks + 8 * fq);
    f32x4 gT[8];
#pragma unroll
    for (int jt = 0; jt < 8; ++jt) { f32x4 a = {0.f, 0.f, 0.f, 0.f};
#pragma unroll
        for (int ks = 0; ks < 4; ++ks) a = MFMA16(ldsfrag(Bt + (16 * jt + fr) * 136 + 32 * ks + 8 * fq), cf[ks], a);
        PINV(a); gT[jt] = a; }
    const float* dsk = inptr(F, 9) + l * 6 + g * 3;
    h16* orow = WSP(h16, OFF_OMIX) + (size_t)(t0 + il) * DM + 384 + g * 192;
    float ss = 0.f;
    { h16x8 h0[4];
#pragma unroll
        for (int k = 0; k < 4; ++k) { const int it = F.tid + 512 * k, dir = it >> 10, e = it & 1023; h0[k] = NTL(h16x8, WSP(const h16, OFF_SST) + ((size_t)((dir * NB + b) * NCH + n) * 6 + g * 3) * 8192 + e * 8); }
        __syncthreads();
#pragma unroll
        for (int k = 0; k < 4; ++k) { const int it = F.tid + 512 * k, dir = it >> 10, e = it & 1023; *(LAS h16x8*)(Bt + dir * 64 * 136 + (e >> 4) * 136 + 8 * (e & 15)) = h0[k]; }
        __syncthreads(); }
#pragma unroll 1
    for (int r = 0; r < 3; ++r) {
        f32x4 y[1][4];
        const int hd = g * 3 + r;
        const float cfi = CE[r * 128 + il], ebi = CE[(3 + r) * 128 + il], totb = TOTB[r];
#pragma unroll
        for (int pt = 0; pt < 4; ++pt) y[0][pt] = (f32x4){0.f, 0.f, 0.f, 0.f};
        LAS const h16* HL = (r & 1) ? Ct : Bt;
        h16x8 hreg[4];
        if (r < 2) {
#pragma unroll
            for (int k = 0; k < 4; ++k) { const int it = F.tid + 512 * k, dir = it >> 10, e = it & 1023; hreg[k] = NTL(h16x8, WSP(const h16, OFF_SST) + ((size_t)((dir * NB + b) * NCH + n) * 6 + hd + 1) * 8192 + e * 8); } }
#pragma unroll
        for (int kp = 0; kp < 4; ++kp) { f32x4 pv[2];
#pragma unroll
            for (int jh = 0; jh < 2; ++jh) { const int jt = 2 * kp + jh, j0 = 16 * jt + 4 * fq;
                const f32x4 cfj = *(LAS const f32x4*)(CE + r * 128 + j0), ebj = *(LAS const f32x4*)(CE + (3 + r) * 128 + j0), dfj = *(LAS const f32x4*)(DTS + r * 128 + j0), dbj = *(LAS const f32x4*)(DTS + (3 + r) * 128 + j0);
#pragma unroll
                for (int e = 0; e < 4; ++e) { const int j = j0 + e; const float val = (il >= j) ? __expf(cfi - cfj[e]) * dfj[e] : __expf(ebj[e] - ebi) * dbj[e]; pv[jh][e] = gT[jt][e] * val * 256.f; }
                PINV(pv[jh]); }
            const h16x8 pf = pack8(pv[0], pv[1]);
#pragma unroll
            for (int pt = 0; pt < 4; ++pt) y[0][pt] = MFMA16(ldsfrag(XT + r * 64 * 136 + (16 * pt + fr) * 136 + 32 * kp + 8 * fq), pf, y[0][pt]);
            PINV(y[0][0]); PINV(y[0][1]); PINV(y[0][2]); PINV(y[0][3]); }
        const float ef = __expf(cfi) * 256.f, eb = __expf(totb - ebi) * 256.f;
#pragma unroll
        for (int ks = 0; ks < 4; ++ks) { const h16x8 cff = scalefrag(cf[ks], ef), cfb = scalefrag(cf[ks], eb);
#pragma unroll
            for (int pt = 0; pt < 4; ++pt) { y[0][pt] = MFMA16(ldsfrag(HL + (16 * pt + fr) * 136 + 32 * ks + 8 * fq), cff, y[0][pt]); y[0][pt] = MFMA16(ldsfrag(HL + 64 * 136 + (16 * pt + fr) * 136 + 32 * ks + 8 * fq), cfb, y[0][pt]); }
            PINV(y[0][0]); PINV(y[0][1]); PINV(y[0][2]); PINV(y[0][3]); }
        if (r < 2) { LAS h16* HN = (r & 1) ? Bt : Ct;
#pragma unroll
            for (int k = 0; k < 4; ++k) { const int it = F.tid + 512 * k, dir = it >> 10, e = it & 1023; *(LAS h16x8*)(HN + dir * 64 * 136 + (e >> 4) * 136 + 8 * (e & 15)) = hreg[k]; } }
        const float dk = dsk[r]; const h16* zrow = proj + (size_t)(t0 + il) * NPJ + CZ + hd * 64;
#pragma unroll
        for (int pt = 0; pt < 4; ++pt) { const h16x4 zv = NTL(h16x4, zrow + 16 * pt + 4 * fq);
#pragma unroll
            for (int e = 0; e < 4; ++e) { const float xv = (float)XT[r * 64 * 136 + (16 * pt + 4 * fq + e) * 136 + kperm32(il)]; y[0][pt][e] = (y[0][pt][e] * (1.0f / 256.f) + dk * xv) * siluf_((float)zv[e]); }
            const h16x4 yh = pack4(y[0][pt]); *(h16x4*)(orow + r * 64 + 16 * pt + 4 * fq) = yh;
#pragma unroll
            for (int e = 0; e < 4; ++e) { const float q = (float)yh[e]; ss += q * q; } }
        __syncthreads();
    }
    ss += __shfl_xor(ss, 16); ss += __shfl_xor(ss, 32);
    const float rs = 1.0f / sqrtf(ss * (1.0f / 192.0f) + EPS);
    const float* nw = inptr(F, 10) + l * 384 + g * 192;
    asm volatile("s_waitcnt vmcnt(0)" ::: "memory");
#pragma unroll 1
    for (int r = 0; r < 3; ++r)
#pragma unroll
        for (int pt = 0; pt < 4; ++pt) { const f32x4 wv = *(const f32x4*)(nw + r * 64 + 16 * pt + 4 * fq); h16* op = orow + r * 64 + 16 * pt + 4 * fq; const h16x4 yh = *(const h16x4*)op; f32x4 yv;
#pragma unroll
            for (int e = 0; e < 4; ++e) yv[e] = (float)yh[e] * rs * wv[e];
            if (F8_OUT) *(unsigned*)(WSP(unsigned char, OFF_OMIX8) + (size_t)(t0 + il) * DM + 384 + g * 192 + r * 64 + 16 * pt + 4 * fq) = cvt4_fp8(8.f * yv[0], 8.f * yv[1], 8.f * yv[2], 8.f * yv[3]);
            else *(h16x4*)op = pack4(yv); }
    __syncthreads();
}

__device__ __forceinline__ void lru_unit(const Frame& F, const Prm& p, int l, int u) {
    const int n = u % NCH, b = u / NCH; const long t0 = (long)b * SEQ + n * 128;
    const h16* proj = WSP(const h16, WS_R1);
    LAS h16* XC = (LAS h16*)F.lds;
    const float* cw = inptr(F, 11) + (size_t)l * 4 * 256; const float* cb = inptr(F, 12) + (size_t)l * 256;
    { const int cg = F.tid & 31, r0 = (F.tid >> 5) * 8; h16x8 o[8];
        conv_rows8<false>(proj + CXR + 8 * cg, t0, n, r0, cw + 8 * cg, 256, cb + 8 * cg, o);
#pragma unroll
        for (int r = 0; r < 8; ++r) *(LAS h16x8*)(XC + (r0 + r) * 264 + 8 * cg) = o[r]; }
    __syncthreads();
    const int blk = F.wave & 3, jh = F.wave >> 2, fr = F.lane & 15, fq = F.lane >> 4;
    h16* lau = (h16*)((unsigned char*)F.out + OUT_LAU) + (size_t)(b * NCH + n) * 2 * 128 * 256 * 2;
    h16x8 wa[2][2][2], wx[2][2][2]; float ba[2][2], bx[2][2], sp[2][2], car[2][2], atot[2][2];
#pragma unroll
    for (int dir = 0; dir < 2; ++dir)
#pragma unroll
        for (int jt = 0; jt < 2; ++jt) { const int ch = blk * 64 + 32 * jh + 16 * jt + fr;
#pragma unroll
            for (int ks = 0; ks < 2; ++ks) { wa[dir][jt][ks] = *(const h16x8*)(WSP(const h16, WS_LRUW) + (size_t)((dir * 2 + 0) * 4 + blk) * 4096 + (32 * jh + 16 * jt + fr) * 64 + 32 * ks + 8 * fq);
                wx[dir][jt][ks] = *(const h16x8*)(WSP(const h16, WS_LRUW) + (size_t)((dir * 2 + 1) * 4 + blk) * 4096 + (32 * jh + 16 * jt + fr) * 64 + 32 * ks + 8 * fq); }
            ba[dir][jt] = inptr(F, 15)[(l * 2 + dir) * 256 + ch]; bx[dir][jt] = inptr(F, 17)[(l * 2 + dir) * 256 + ch]; sp[dir][jt] = softplusf_(-inptr(F, 13)[(l * 2 + dir) * 256 + ch]);
            car[dir][jt] = 0.f; atot[dir][jt] = 1.f; }
#pragma unroll 1
    for (int ti = 0; ti < 8; ++ti) {
#pragma unroll
        for (int dir = 0; dir < 2; ++dir) { const int tt = dir == 0 ? ti : 7 - ti;
            h16x8 xf[2];
#pragma unroll
            for (int ks = 0; ks < 2; ++ks) xf[ks] = ldsfrag(XC + (16 * tt + fr) * 264 + blk * 64 + 32 * ks + 8 * fq);
#pragma unroll
            for (int jt = 0; jt < 2; ++jt) { const int ch = blk * 64 + 32 * jh + 16 * jt + fr;
                f32x4 ra = {0.f, 0.f, 0.f, 0.f}, ia = {0.f, 0.f, 0.f, 0.f};
#pragma unroll
                for (int ks = 0; ks < 2; ++ks) { ra = MFMA16(xf[ks], wa[dir][jt][ks], ra); ia = MFMA16(xf[ks], wx[dir][jt][ks], ia); }
                float A = 1.f, H = 0.f;
#pragma unroll
                for (int ri = 0; ri < 4; ++ri) { const int rg = dir == 0 ? ri : 3 - ri;
                    const float e1 = 1.0f + __expf(-(ra[rg] + ba[dir][jt])), e2 = 1.0f + __expf(-(ia[rg] + bx[dir][jt])); const float inv = __builtin_amdgcn_rcpf(e1 * e2);
                    const float rgate = inv * e2, ig = inv * e1;
                    const float la = -8.0f * rgate * sp[dir][jt]; const float a = __expf(la); const float y = 2.0f * la;
                    const float om = y > -0.1f ? -y * (1.0f + y * (0.5f + y * (1.0f / 6.0f))) : 1.0f - a * a;
                    const float mult = __builtin_amdgcn_sqrtf(om);
                    const float xv = (float)XC[(16 * tt + 4 * fq + rg) * 264 + ch]; const float uu = mult * ig * xv;
                    H = a * H + uu; A *= a;
                    { h16x2 pk; pk[0] = (h16)la; pk[1] = (h16)uu; *(h16x2*)(lau + ((size_t)dir * 128 + 16 * tt + 4 * fq + rg) * 256 * 2 + 2 * ch) = pk; } }
                float Ag[4], Hg[4];
#pragma unroll
                for (int gq = 0; gq < 4; ++gq) { Ag[gq] = __shfl(A, fr + 16 * gq); Hg[gq] = __shfl(H, fr + 16 * gq); }
                float cnew = car[dir][jt], at = 1.f;
#pragma unroll
                for (int gi = 0; gi < 4; ++gi) { const int gq = dir == 0 ? gi : 3 - gi;
                    cnew = Ag[gq] * cnew + Hg[gq]; at *= Ag[gq]; }
                car[dir][jt] = cnew; atot[dir][jt] *= at;
            } } }
    if (fq == 0) {
#pragma unroll
        for (int dir = 0; dir < 2; ++dir)
#pragma unroll
            for (int jt = 0; jt < 2; ++jt) { const int ch = blk * 64 + 32 * jh + 16 * jt + fr; *(f32x2*)(WSP(float, OFF_LSUM) + (((size_t)(b * NCH + n) * 2 + dir) * 256 + ch) * 2) = (f32x2){atot[dir][jt], car[dir][jt]}; } }
    __syncthreads();
}
__device__ __forceinline__ void lru_out_unit(const Frame& F, int u) {
    const int n = u % NCH, b = u / NCH; const long t0 = (long)b * SEQ + n * 128;
    const h16* proj = WSP(const h16, WS_R1);
    LAS h16* HT = (LAS h16*)F.lds;
    const int blk = F.wave & 3, jh = F.wave >> 2, fr = F.lane & 15, fq = F.lane >> 4;
    const h16* lau = (const h16*)((const unsigned char*)F.out + OUT_LAU) + (size_t)(b * NCH + n) * 2 * 128 * 256 * 2;
    float car[2][2];
#pragma unroll
    for (int dir = 0; dir < 2; ++dir)
#pragma unroll
        for (int jt = 0; jt < 2; ++jt) car[dir][jt] = WSP(const float, OFF_LCAR)[((size_t)(b * NCH + n) * 2 + dir) * 256 + blk * 64 + 32 * jh + 16 * jt + fr];
#pragma unroll 1
    for (int ti = 0; ti < 8; ++ti) {
#pragma unroll
        for (int dir = 0; dir < 2; ++dir) { const int tt = dir == 0 ? ti : 7 - ti;
            h16x2 pk[2][4]; h16 gtv[2][4], ov[2][4];
#pragma unroll
            for (int jt = 0; jt < 2; ++jt)
#pragma unroll
                for (int rg = 0; rg < 4; ++rg) { const int tl = 16 * tt + 4 * fq + rg, ch = blk * 64 + 32 * jh + 16 * jt + fr;
                    pk[jt][rg] = NTL(h16x2, lau + ((size_t)dir * 128 + tl) * 256 * 2 + 2 * ch); gtv[jt][rg] = NTL(h16, proj + (size_t)(t0 + tl) * NPJ + CGT + ch); ov[jt][rg] = ti >= 4 ? HT[tl * 264 + ch] : (h16)0.f; }
#pragma unroll
            for (int jt = 0; jt < 2; ++jt) { const int ch = blk * 64 + 32 * jh + 16 * jt + fr;
                float av[4], uv[4]; float A = 1.f, H = 0.f;
#pragma unroll
                for (int ri = 0; ri < 4; ++ri) { const int rg = dir == 0 ? ri : 3 - ri; const float a = __expf((float)pk[jt][rg][0]); const float uu = (float)pk[jt][rg][1]; av[rg] = a; uv[rg] = uu; H = a * H + uu; A *= a; }
                float Ag[4], Hg[4];
#pragma unroll
                for (int gq = 0; gq < 4; ++gq) { Ag[gq] = __shfl(A, fr + 16 * gq); Hg[gq] = __shfl(H, fr + 16 * gq); }
                float hin = car[dir][jt], cnew = car[dir][jt];
#pragma unroll
                for (int gi = 0; gi < 4; ++gi) { const int gq = dir == 0 ? gi : 3 - gi; const bool before = dir == 0 ? (gq < fq) : (gq > fq);
                    if (before) hin = Ag[gq] * hin + Hg[gq];
                    cnew = Ag[gq] * cnew + Hg[gq]; }
                car[dir][jt] = cnew;
                float hh = hin;
#pragma unroll
                for (int ri = 0; ri < 4; ++ri) { const int rg = dir == 0 ? ri : 3 - ri; hh = av[rg] * hh + uv[rg];
                    HT[(16 * tt + 4 * fq + rg) * 264 + ch] = (h16)((float)ov[jt][rg] + hh * gelu_tanh_((float)gtv[jt][rg])); } } } }
    __syncthreads();
#pragma unroll
    for (int k = 0; k < 8; ++k) { const int it = F.tid + 512 * k, row = it >> 5, c8 = it & 31; const h16x8 hv = *(LAS const h16x8*)(HT + row * 264 + 8 * c8);
        if (F8_OUT) *(u32x2*)(WSP(unsigned char, OFF_OMIX8) + (size_t)(t0 + row) * DM + 768 + 8 * c8) = (u32x2){cvt4_fp8(8.f * (float)hv[0], 8.f * (float)hv[1], 8.f * (float)hv[2], 8.f * (float)hv[3]), cvt4_fp8(8.f * (float)hv[4], 8.f * (float)hv[5], 8.f * (float)hv[6], 8.f * (float)hv[7])};
        else *(h16x8*)(WSP(h16, OFF_OMIX) + (size_t)(t0 + row) * DM + 768 + 8 * c8) = hv; }
    __syncthreads();
}
__device__ __forceinline__ void lru_scan(const Frame& F) {
    const int gi = (int)blockIdx.x * 512 + F.tid; if (gi >= NB * 2 * 256) return;
    const int ch = gi & 255, dir = (gi >> 8) & 1, b = gi >> 9; float H = 0.f;
    for (int i = 0; i < NCH; ++i) { const int n = dir == 0 ? i : NCH - 1 - i; const size_t idx = ((size_t)(b * NCH + n) * 2 + dir) * 256 + ch;
        const f32x2 s = *(const f32x2*)(WSP(const float, OFF_LSUM) + idx * 2); WSP(float, OFF_LCAR)[idx] = H; H = s[0] * H + s[1]; }
}

__device__ __forceinline__ void attn_phase(const Frame& F) {
    constexpr int NU = NB * 4 * 8;
    LAS unsigned char* B0 = F.lds; LAS unsigned char* B1 = F.lds + 67584;
    int u = F.vcu; if (u >= NU) return;
    int lanel = F.lane; asm volatile("" : "+v"(lanel)); int fr = lanel & 15, fq = lanel >> 4;
    const int w = F.wave;
    h16x8 qf[2][8];
#define AT_DMA(buf, src, rowstride) do { asm volatile("" : "+v"(lanel)); if (lanel < 32) { _Pragma("unroll") for (int i_ = 0; i_ < 16; ++i_) \
        __builtin_amdgcn_global_load_lds((const unsigned*)((src) + (size_t)(16 * w + i_) * (rowstride) + 8 * lanel), (LAS unsigned*)((buf) + (16 * w + i_) * 528), 16, 0, 0); } } while (0)
#define AT_FRAG(buf, row, chunk) (*(LAS const h16x8*)((buf) + (row) * 528 + (chunk) * 16))
#define AT_WAITBAR() do { asm volatile("s_waitcnt vmcnt(0) lgkmcnt(0)" ::: "memory"); __builtin_amdgcn_s_barrier(); asm volatile("" ::: "memory"); } while (0)
#define AT_LOADQ(uu) do { _Pragma("unroll") for (int a_ = 0; a_ < 2; ++a_) { const long t_ = (long)((uu) >> 5) * SEQ + ((uu) & 7) * 256 + 32 * w + 16 * a_ + fr; const h16* q_ = WSP(const h16, OFF_QCA) + (size_t)t_ * DM + (((uu) >> 3) & 3) * 256; \
        _Pragma("unroll") for (int ks_ = 0; ks_ < 8; ++ks_) qf[a_][ks_] = NTL(h16x8, q_ + 32 * ks_ + 8 * fq); } } while (0)
    { const int b = u >> 5, hd = (u >> 3) & 3; AT_DMA(B0, WSP(const h16, OFF_KB) + (size_t)(b * 256) * DM + hd * 256, DM); }
    for (; u < NU; u += F.G) {
        const int qb = u & 7, hd = (u >> 3) & 3, b = u >> 5; const int un = u + F.G; const bool has_next = un < NU;
        asm volatile("" : "+v"(lanel)); fr = lanel & 15; fq = lanel >> 4;
        const h16* kb = WSP(const h16, OFF_KB) + (size_t)(b * 256) * DM + hd * 256; const h16* vt = WSP(const h16, OFF_VT) + (size_t)(b * 4 + hd) * 65536;
        AT_LOADQ(u);
        h16x8 pf[2][8]; float mq[2][4], Mr[2] = {-3.0e38f, -3.0e38f}, Lr[2] = {0.f, 0.f};
#pragma unroll
        for (int h = 0; h < 2; ++h) {
            AT_WAITBAR();
            if (h == 0) AT_DMA(B1, kb + (size_t)128 * DM, DM); else AT_DMA(B0, vt, 256);
            LAS const unsigned char* KB_ = h == 0 ? B0 : B1;
#pragma unroll
            for (int jh = 0; jh < 2; ++jh) { const int qd = 2 * h + jh; f32x4 s[2][4]; h16x8 kf[2][4];
#pragma unroll
                for (int j4 = 0; j4 < 4; ++j4) { s[0][j4] = (f32x4){0.f, 0.f, 0.f, 0.f}; s[1][j4] = (f32x4){0.f, 0.f, 0.f, 0.f}; kf[0][j4] = AT_FRAG(KB_, 16 * (4 * jh + j4) + fr, fq); }
#pragma unroll
                for (int ks = 0; ks < 8; ++ks) {
                    if (ks < 7) {
#pragma unroll
                        for (int j4 = 0; j4 < 4; ++j4) kf[(ks + 1) & 1][j4] = AT_FRAG(KB_, 16 * (4 * jh + j4) + fr, 4 * (ks + 1) + fq); }
                    PIN();
#pragma unroll
                    for (int j4 = 0; j4 < 4; ++j4) { s[0][j4] = MFMA16(kf[ks & 1][j4], qf[0][ks], s[0][j4]); s[1][j4] = MFMA16(kf[ks & 1][j4], qf[1][ks], s[1][j4]); }
                    PINV(s[0][0]); PINV(s[1][3]); }
#pragma unroll
                for (int a = 0; a < 2; ++a) { float mx = fmaxf(fmaxf(s[a][0][0], s[a][0][1]), fmaxf(s[a][0][2], s[a][0][3]));
#pragma unroll
                    for (int jt = 1; jt < 4; ++jt) mx = fmaxf(mx, fmaxf(fmaxf(s[a][jt][0], s[a][jt][1]), fmaxf(s[a][jt][2], s[a][jt][3])));
                    mx = fmaxf(mx, __shfl_xor(mx, 16)); mx = fmaxf(mx, __shfl_xor(mx, 32));
                    float sum = 0.f;
#pragma unroll
                    for (int jt = 0; jt < 4; ++jt)
#pragma unroll
                        for (int e = 0; e < 4; ++e) { const float pe = __expf(s[a][jt][e] - mx); s[a][jt][e] = pe; sum += pe; }
                    sum += __shfl_xor(sum, 16); sum += __shfl_xor(sum, 32);
                    mq[a][qd] = mx; { const float Mn = fmaxf(Mr[a], mx); Lr[a] = Lr[a] * __expf(Mr[a] - Mn) + sum * __expf(mx - Mn); Mr[a] = Mn; }
                    pf[a][2 * qd] = pack8(s[a][0], s[a][1]); pf[a][2 * qd + 1] = pack8(s[a][2], s[a][3]); } }
        }
#pragma unroll
        for (int a = 0; a < 2; ++a) { const float inv = 1.0f / Lr[a];
#pragma unroll
            for (int q = 0; q < 4; ++q) { const float cq = __expf(mq[a][q] - Mr[a]) * inv; pf[a][2 * q] = scalefrag(pf[a][2 * q], cq); pf[a][2 * q + 1] = scalefrag(pf[a][2 * q + 1], cq); } }
#pragma unroll
        for (int d = 0; d < 2; ++d) {
            AT_WAITBAR();
            if (d == 0) AT_DMA(B1, vt + (size_t)128 * 256, 256);
            else if (has_next) AT_DMA(B0, WSP(const h16, OFF_KB) + (size_t)((un >> 5) * 256) * DM + ((un >> 3) & 3) * 256, DM);
            LAS const unsigned char* VB_ = d == 0 ? B0 : B1;
#pragma unroll
            for (int eh = 0; eh < 2; ++eh) { f32x4 o[2][4]; h16x8 vf[2][4];
#pragma unroll
                for (int e4 = 0; e4 < 4; ++e4) { o[0][e4] = (f32x4){0.f, 0.f, 0.f, 0.f}; o[1][e4] = (f32x4){0.f, 0.f, 0.f, 0.f}; vf[0][e4] = AT_FRAG(VB_, 16 * (4 * eh + e4) + fr, fq); }
#pragma unroll
                for (int kp = 0; kp < 8; ++kp) {
                    if (kp < 7) {
#pragma unroll
                        for (int e4 = 0; e4 < 4; ++e4) vf[(kp + 1) & 1][e4] = AT_FRAG(VB_, 16 * (4 * eh + e4) + fr, 4 * (kp + 1) + fq); }
                    PIN();
#pragma unroll
                    for (int e4 = 0; e4 < 4; ++e4) { o[0][e4] = MFMA16(vf[kp & 1][e4], pf[0][kp], o[0][e4]); o[1][e4] = MFMA16(vf[kp & 1][e4], pf[1][kp], o[1][e4]); }
                    PINV(o[0][0]); PINV(o[1][3]); }
#pragma unroll
                for (int a = 0; a < 2; ++a) { const long t = (long)b * SEQ + qb * 256 + 32 * w + 16 * a + fr; h16* orow = WSP(h16, OFF_OATT) + (size_t)t * DM + hd * 256 + 128 * d + 64 * eh;
#pragma unroll
                    for (int e4 = 0; e4 < 4; ++e4) { if (F8_O) *(unsigned*)(WSP(unsigned char, OFF_OATT) + (size_t)t * DM + hd * 256 + 128 * d + 64 * eh + 16 * e4 + 4 * fq) = cvt4_fp8(16.f * o[a][e4][0], 16.f * o[a][e4][1], 16.f * o[a][e4][2], 16.f * o[a][e4][3]);
                        else *(h16x4*)(orow + 16 * e4 + 4 * fq) = pack4(o[a][e4]); } } }
        }
    }
    asm volatile("s_waitcnt vmcnt(0) lgkmcnt(0)" ::: "memory");
    __syncthreads();
#undef AT_DMA
#undef AT_FRAG
#undef AT_WAITBAR
#undef AT_LOADQ
}

__device__ __forceinline__ void phase_router(const Frame& F, const Prm& p, int l) {
    LAS h16* RW = (LAS h16*)F.lds;
    { const h16* rwg = WSP(const h16, OFF_RWG);
        for (int i = F.tid; i < 72 * 1032 / 8; i += 512) *(LAS h16x8*)(RW + 8 * i) = *(const h16x8*)(rwg + 8 * i); }
    LAS unsigned* hist = (LAS unsigned*)(F.lds + 72 * 1032 * 2);
    if (F.tid < 32) hist[F.tid] = 0u;
    if (F.G == 256) { for (int i = (int)blockIdx.x * 512 + F.tid; i < MAXSLOT; i += 256 * 512) WSP(int, OFF_STOK)[i] = 0; }
    else if (blockIdx.x == 0) { for (int i = F.tid; i < MAXSLOT; i += 512) WSP(int, OFF_STOK)[i] = 0; }
    __syncthreads();
    const int gw = F.vcu * 8 + F.wave, NGW = F.G * 8, fr = F.lane & 15, fq = F.lane >> 4;
    for (int tg = gw; tg < NT / 16; tg += NGW) {
        const int tok = tg * 16 + fr;
        const h16* hp = WSP(const h16, WS_HB) + (size_t)tok * DM + 8 * fq;
        f32x4 acc[3]; LAS const h16* wrow[3];
#pragma unroll
        for (int mt = 0; mt < 3; ++mt) { acc[mt] = (f32x4){0.f, 0.f, 0.f, 0.f}; const int j = (16 * mt + fr) < 36 ? (16 * mt + fr) : 35; wrow[mt] = RW + j * 1032 + 8 * fq; }
#pragma unroll
        for (int half = 0; half < 2; ++half) { h16x8 hf[16];
#pragma unroll
            for (int q = 0; q < 16; ++q) hf[q] = *(const h16x8*)(hp + 32 * (16 * half + q));
#pragma unroll
            for (int q = 0; q < 16; ++q) { const int ks = 16 * half + q;
#pragma unroll
                for (int mt = 0; mt < 3; ++mt) { acc[mt] = MFMA16(ldsfrag(wrow[mt] + 32 * ks), hf[q], acc[mt]); acc[mt] = MFMA16(ldsfrag(wrow[mt] + 36 * 1032 + 32 * ks), hf[q], acc[mt]); } } }
#pragma unroll
        for (int mt = 0; mt < 3; ++mt) acc[mt] *= (1.0f / 1024.0f);
        const float rs = row_rstd(WSP(const float, WS_SSQ) + (size_t)tok * 16);
        float gl[4];
#pragma unroll
        for (int r = 0; r < 4; ++r) gl[r] = __shfl(acc[0][r], fr) * rs + inptr(F, 25)[l * 4 + r];
        int gi = 0; float gmx = gl[0];
#pragma unroll
        for (int j = 1; j < 4; ++j) if (gl[j] > gmx) { gmx = gl[j]; gi = j; }
        float gsum = 0.f;
#pragma unroll
        for (int j = 0; j < 4; ++j) gsum += __expf(gl[j] - gmx);
        const float gp = 1.0f / gsum;
        const int src1 = fr + 16 * (1 + 2 * (gi & 1)), src2 = fr + 16 * (2 - 2 * (gi & 1)), mt1 = gi >> 1, mt2 = (gi + 1) >> 1;
        float el[8];
#pragma unroll
        for (int k = 0; k < 4; ++k) { const float a0 = __shfl(acc[0][k], src1), a1 = __shfl(acc[1][k], src1); el[k] = (mt1 ? a1 : a0) * rs + inptr(F, 27)[l * 32 + gi * 8 + k];
            const float b0 = __shfl(acc[0][k], src2), b1 = __shfl(acc[1][k], src2), b2 = __shfl(acc[2][k], src2); el[4 + k] = (mt2 == 0 ? b0 : (mt2 == 1 ? b1 : b2)) * rs + inptr(F, 27)[l * 32 + gi * 8 + 4 + k]; }
        int e1 = 0; float m1 = el[0];
#pragma unroll
        for (int j = 1; j < 8; ++j) if (el[j] > m1) { m1 = el[j]; e1 = j; }
        int e2 = -1; float m2 = -3.0e38f;
#pragma unroll
        for (int j = 0; j < 8; ++j) if (j != e1 && el[j] > m2) { m2 = el[j]; e2 = j; }
        const float r2 = __expf(m2 - m1); const float g1 = gp / (1.0f + r2), g2 = gp * r2 / (1.0f + r2);
        if (fq == 0) { const int x1 = gi * 8 + e1, x2 = gi * 8 + e2;
            *(int2*)(WSP(int, OFF_EID) + (size_t)tok * 2) = make_int2(x1, x2); *(f32x2*)(WSP(float, OFF_GATE) + (size_t)tok * 2) = (f32x2){g1, g2};
            WSP(float, OFF_RSTDT)[tok] = rs; __hip_atomic_fetch_add(&hist[x1], 1u, __ATOMIC_RELAXED, __HIP_MEMORY_SCOPE_WORKGROUP); __hip_atomic_fetch_add(&hist[x2], 1u, __ATOMIC_RELAXED, __HIP_MEMORY_SCOPE_WORKGROUP); }
    }
    __syncthreads();
    if (F.tid < 32 && hist[F.tid]) atomicAdd(WSP(unsigned, WS_CTL) + CW_COUNTS + l * 64 + F.tid, hist[F.tid]);
    __syncthreads();
}
__device__ __forceinline__ void phase_dispatch(const Frame& F, int l) {
    LAS int* cnt = (LAS int*)F.lds; LAS int* base = cnt + 32; LAS int* pstart = base + 32; LAS int* slots = pstart + 40;
    unsigned* ctl = WSP(unsigned, WS_CTL);
    for (int blk = F.vcu; blk < NT / 128; blk += F.G) {
        __syncthreads();
        if (F.tid < 32) cnt[F.tid] = 0;
        if (F.tid == 32) { int acc = 0; for (int e = 0; e < 32; ++e) { pstart[e] = acc; acc += (int)((ctl[CW_COUNTS + l * 64 + e] + 255u) & ~255u); } pstart[32] = acc; }
        __syncthreads();
        int e = 0, rank = 0, tok = 0;
        if (F.tid < 256) { tok = blk * 128 + (F.tid >> 1); e = WSP(const int, OFF_EID)[(size_t)tok * 2 + (F.tid & 1)]; rank = __hip_atomic_fetch_add(&cnt[e], 1, __ATOMIC_RELAXED, __HIP_MEMORY_SCOPE_WORKGROUP); }
        __syncthreads();
        if (F.tid < 32) base[F.tid] = cnt[F.tid] ? (int)atomicAdd(&ctl[CW_CURSOR + l * 64 + F.tid], (unsigned)cnt[F.tid]) : 0;
        __syncthreads();
        if (F.tid < 256) { const int slot = pstart[e] + base[e] + rank; slots[F.tid] = slot; WSP(int, OFF_TSLOT)[(size_t)tok * 2 + (F.tid & 1)] = slot; WSP(float, OFF_SRSTD)[slot] = WSP(const float, OFF_RSTDT)[tok]; WSP(int, OFF_STOK)[slot] = tok; }
        __syncthreads();
        if (blk == 0 && F.tid == 0) { const int ntl = pstart[32] >> 8; ctl[CW_NTILES + l] = (unsigned)ntl; int* te = WSP(int, OFF_TILEE);
            for (int e2 = 0; e2 < 32; ++e2) for (int tl = pstart[e2] >> 8; tl < (pstart[e2 + 1] >> 8); ++tl) te[tl] = e2; }
    }
    __syncthreads();
}
__device__ __forceinline__ void phase_combine(const Frame& F, const Prm& p, int l) {
    const int gw = F.vcu * 8 + F.wave, NGW = F.G * 8;
    const bool last = (l == NLAYER - 1);
    for (int tk0 = gw * 4; tk0 < NT; tk0 += NGW * 4) {
        int2 sl[4]; f32x2 gt[4];
#pragma unroll
        for (int q = 0; q < 4; ++q) { sl[q] = *(const int2*)(WSP(const int, OFF_TSLOT) + (size_t)(tk0 + q) * 2); gt[q] = *(const f32x2*)(WSP(const float, OFF_GATE) + (size_t)(tk0 + q) * 2); }
        f32x4 v[4][4]; h16x4 ya[4][4], yb[4][4];
#pragma unroll
        for (int q = 0; q < 4; ++q) { const h16* hrow = WSP(const h16, WS_HB) + (size_t)(tk0 + q) * DM; const h16* y0 = WSP(const h16, OFF_YP) + (size_t)sl[q].x * DM; const h16* y1 = WSP(const h16, OFF_YP) + (size_t)sl[q].y * DM;
#pragma unroll
            for (int j = 0; j < 4; ++j) { const int c = 4 * F.lane + 256 * j; const h16x4 hv = *(const h16x4*)(hrow + c); v[q][j] = (f32x4){(float)hv[0], (float)hv[1], (float)hv[2], (float)hv[3]}; ya[q][j] = __builtin_nontemporal_load((const h16x4*)(y0 + c)); yb[q][j] = __builtin_nontemporal_load((const h16x4*)(y1 + c)); } }
#pragma unroll
        for (int q = 0; q < 4; ++q) { float s = 0.f;
#pragma unroll
            for (int j = 0; j < 4; ++j) {
#pragma unroll
                for (int e = 0; e < 4; ++e) v[q][j][e] += gt[q][0] * (float)ya[q][j][e] + gt[q][1] * (float)yb[q][j][e];
                if (!last) { const h16x4 o = pack4(v[q][j]); v[q][j] = (f32x4){(float)o[0], (float)o[1], (float)o[2], (float)o[3]}; }
                s += (v[q][j][0] * v[q][j][0] + v[q][j][1] * v[q][j][1]) + (v[q][j][2] * v[q][j][2] + v[q][j][3] * v[q][j][3]); }
            s = wave_sum(s);
            if (!last) {
#pragma unroll
                for (int j = 0; j < 4; ++j) { const int c = 4 * F.lane + 256 * j; *(h16x4*)(WSP(h16, WS_HB) + (size_t)(tk0 + q) * DM + c) = pack4(v[q][j]);
                    if (F8_HB) *(unsigned*)((unsigned char*)F.out + OUT_HB8 + (size_t)(tk0 + q) * DM + c) = cvt4_fp8(v[q][j][0], v[q][j][1], v[q][j][2], v[q][j][3]); }
                if (F.lane < 16) WSP(float, WS_SSQ)[(size_t)(tk0 + q) * 16 + F.lane] = (F.lane == 0) ? s : 0.f;
                if (F.lane == 0) WSP(float, OFF_RSTDT)[tk0 + q] = 1.0f / sqrtf(s * (1.0f / DM) + EPS);
            } else { const float rs = 1.0f / sqrtf(s * (1.0f / DM) + EPS); float* orow = F.out + (size_t)(tk0 + q) * DM;
#pragma unroll
                for (int j = 0; j < 4; ++j) { const int c = 4 * F.lane + 256 * j; const f32x4 gf = *(const f32x4*)(inptr(F, 31) + c); *(f32x4*)(orow + c) = v[q][j] * rs * gf; } } }
    }
}

__global__ void __launch_bounds__(512, 2) fwd(Prm p) {
    extern __shared__ __attribute__((aligned(16))) unsigned char lds_raw[];
    Frame F; F.lds = (LAS unsigned char*)lds_raw; F.ws = (GAS unsigned char*)p.ws; F.out = p.out;
    F.tid = threadIdx.x; F.lane = F.tid & 63; F.wave = __builtin_amdgcn_readfirstlane(F.tid >> 6);
    F.G = gridDim.x; { const int bx = blockIdx.x; F.vcu = (F.G % 8 == 0) ? (bx % 8) * (F.G / 8) + bx / 8 : bx; }
    volatile LAS unsigned* misc = (volatile LAS unsigned*)(F.lds + LDS_MISC);
    if (F.tid < 4) misc[F.tid] = 0u;
    F.ptab = (volatile LAS unsigned long long*)(F.lds + LDS_MISC + 64);
    if (F.tid < 32) F.ptab[F.tid] = (unsigned long long)p.in[F.tid];
    __syncthreads();
    const int lo = p.ph_lo, hi = p.ph_hi;
    XcdBarrier bar; bar.bar = WSP(unsigned, WS_CTL) + CW_BAR; bar.x = 0; bar.st = misc;
    if (hi - lo > 1) bar = xcd_barrier_post(WSP(unsigned, WS_CTL) + CW_BAR, misc);
#ifndef UMASK
#define UMASK 7
#endif
#ifndef REPMASK
#define REPMASK 0
#endif
#ifndef PHMASK
#define PHMASK 0x3fff
#endif
#define IN(k) (((PHMASK >> ((k) % NPH)) & 1) && lo <= (k) && (k) < hi && (launder(F), true))
#define REPS(k) (((REPMASK >> (k)) & 1) ? 2 : 1)
#define INR(k) (lo <= (k) && (k) < hi)
#ifndef AMPMASK
#define AMPMASK 0
#endif
    unsigned long long tprev = AMPMASK ? __builtin_amdgcn_s_memrealtime() : 0ull;
#define SEAM(k) do { if (INR(k) && INR((k) + 1)) { xcd_barrier(bar); if (AMPMASK) { const unsigned long long tn = __builtin_amdgcn_s_memrealtime(); \
        if ((AMPMASK >> ((k) % NPH)) & 1) { const unsigned long long tgt = tn + 4ull * (tn - tprev); while (__builtin_amdgcn_s_memrealtime() < tgt) __builtin_amdgcn_s_sleep(8); } \
        tprev = __builtin_amdgcn_s_memrealtime(); } } } while (0)
    for (int l = 0; l < NLAYER; ++l) {
        const int pb = l * NPH;
        if (IN(pb + 0)) for (int rep = 0; rep < REPS(0); ++rep) { phase_convert(F, p, l); } SEAM(pb + 0);
        if (REPS(20) == 2 && INR(pb + 0) && INR(pb + 1)) { for (int q = 0; q < 20; ++q) xcd_barrier(bar); }
        if (IN(pb + 1)) for (int rep = 0; rep < REPS(1); ++rep) {
            if (P8_N16 > 0) { pg8::StaticOrder S; S.init(NT, P8_N16 * 256, F.G, (int)blockIdx.x); pg8::EpiScale16C E{WSP(h16, WS_R1), NPJ, WSP(const float, OFF_RSTDT), 1.0f, P8_LIST16};
              pg8::Gemm g{WSP(const h16, WS_HB), WSP(const h16, WS_WIN), DM, DM, DM, nullptr}; pg8::gemm_phase(F.lds, F.tid, g, S, E); }
            launder(F);
            if (P8_N8 > 0) { pg8::StaticOrder S; S.init(NT, P8_N8 * 256, F.G, (int)((blockIdx.x + F.G / 2) % F.G));
              pg8::EpiScale16C E{WSP(h16, WS_R1), NPJ, WSP(const float, OFF_RSTDT), 1.0f / 256.0f, P8_LIST8};
              pg8::Gemm g{(const h16*)((const unsigned char*)F.out + OUT_HB8), WSP(const h16, WS_WIN + P8_WOFF), DM / 2, DM / 2, DM / 2, nullptr}; pg8::gemm_phase<pg8::EpiScale16C, pg8::StaticOrder, false, 1>(F.lds, F.tid, g, S, E); }
        } SEAM(pb + 1);
        if (IN(pb + 2)) for (int rep = 0; rep < REPS(2); ++rep) {
            if (UMASK & 1) for (int r2 = 0; r2 < REPS(17); ++r2) for (int u = blockIdx.x; u < NB * NCH * 2; u += F.G) ssd_states_unit(F, p, l, u);
            launder(F);
            if (UMASK & 2) for (int r2 = 0; r2 < REPS(18); ++r2) for (int u = blockIdx.x; u < NB * NCH; u += F.G) ret_states_block(F, u);
            launder(F);
            if (UMASK & 4) for (int r2 = 0; r2 < REPS(19); ++r2) for (int u = blockIdx.x; u < NB * NCH; u += F.G) lru_unit(F, p, l, u);
        } SEAM(pb + 2);
        if (IN(pb + 3)) for (int rep = 0; rep < REPS(3); ++rep) {
            const bool split = (F.G == 256); const int GS = split ? 128 : F.G;
            if (!split || blockIdx.x < 128) {
                for (int u = blockIdx.x; u < 2 * NB * 6; u += GS) ssd_scan_unit(F, u);
                launder(F);
                for (int u = blockIdx.x; u < 2 * NB * 6; u += GS) ret_scan_unit(F, u);
                lru_scan(F); }
            launder(F);
            if (!split || (blockIdx.x >= 128 && blockIdx.x < 192)) {
                pg8::Gemm g{WSP(const h16, WS_MEM16), WSP(const h16, WS_WKV), DM, DM, DM, nullptr}; pg8::StaticOrder S; S.init(NTM, DM, split ? 64 : F.G, split ? (int)blockIdx.x - 128 : (int)blockIdx.x);
                pg8::EpiScale16 E{WSP(h16, OFF_KB), DM, WSP(const float, OFF_MSSQ), 1.0f}; pg8::gemm_phase(F.lds, F.tid, g, S, E); }
            launder(F);
            if (!split || blockIdx.x >= 192) {
                pg8::Gemm g{WSP(const h16, WS_MEM16), WSP(const h16, WS_WKV) + (size_t)DM * DM, DM, DM, DM, nullptr}; pg8::StaticOrder S; S.init(NTM, DM, split ? 64 : F.G, split ? (int)blockIdx.x - 192 : (int)blockIdx.x);
                pg8::EpiVT E{WSP(h16, OFF_VT), WSP(const float, OFF_MRSTD)}; pg8::gemm_phase<pg8::EpiVT, pg8::StaticOrder, false, 0, true>(F.lds, F.tid, g, S, E); }
        } SEAM(pb + 3);
        if (IN(pb + 4)) for (int rep = 0; rep < REPS(4); ++rep) {
            if (UMASK & 1) for (int r2 = 0; r2 < REPS(14); ++r2) for (int u = blockIdx.x; u < NB * NCH * 2; u += F.G) ssd_out_unit(F, p, l, u);
            launder(F);
            if (UMASK & 2) for (int r2 = 0; r2 < REPS(15); ++r2) for (int u = blockIdx.x; u < NB * NCH; u += F.G) ret_out_block(F, u);
            launder(F);
            if (UMASK & 4) for (int r2 = 0; r2 < REPS(16); ++r2) for (int u = blockIdx.x; u < NB * NCH; u += F.G) lru_out_unit(F, u);
        } SEAM(pb + 4);
        if (IN(pb + 5)) for (int rep = 0; rep < REPS(5); ++rep) { pg8::StaticOrder S; S.init(NT, DM, F.G, (int)blockIdx.x); pg8::EpiResid E{WSP(h16, WS_HB), WSP(float, WS_SSQ), (unsigned char*)F.out + OUT_HB8, F8_OUT ? 1.0f / 2048.0f : 1.0f};
#if F8_OUT
            pg8::Gemm g{WSP(const h16, OFF_OMIX8), WSP(const h16, WS_WOUT), DM / 2, DM / 2, DM / 2, nullptr}; pg8::gemm_phase<pg8::EpiResid, pg8::StaticOrder, false, 1>(F.lds, F.tid, g, S, E);
#else
            pg8::Gemm g{WSP(const h16, OFF_OMIX), WSP(const h16, WS_WOUT), DM, DM, DM, nullptr}; pg8::gemm_phase(F.lds, F.tid, g, S, E);
#endif
            } SEAM(pb + 5);
        if (IN(pb + 6)) for (int rep = 0; rep < REPS(6); ++rep) { pg8::StaticOrder S; S.init(NT, DM, F.G, (int)blockIdx.x); pg8::EpiScale16 E{WSP(h16, OFF_QCA), DM, WSP(const float, WS_SSQ), F8_Q ? 1.0f / 4096.0f : 1.0f};
#if F8_Q
            pg8::Gemm g{(const h16*)((const unsigned char*)F.out + OUT_HB8), WSP(const h16, WS_WQ), DM / 2, DM / 2, DM / 2, nullptr}; pg8::gemm_phase<pg8::EpiScale16, pg8::StaticOrder, false, 1>(F.lds, F.tid, g, S, E);
#else
            pg8::Gemm g{WSP(const h16, WS_HB), WSP(const h16, WS_WQ), DM, DM, DM, nullptr}; pg8::gemm_phase(F.lds, F.tid, g, S, E);
#endif
            } SEAM(pb + 6);
        if (IN(pb + 7)) for (int rep = 0; rep < REPS(7); ++rep) { attn_phase(F); } SEAM(pb + 7);
        if (IN(pb + 8)) for (int rep = 0; rep < REPS(8); ++rep) { pg8::StaticOrder S; S.init(NT, DM, F.G, (int)blockIdx.x); pg8::EpiResid E{WSP(h16, WS_HB), WSP(float, WS_SSQ), (unsigned char*)F.out + OUT_HB8, F8_O ? 1.0f / 4096.0f : 1.0f};
#if F8_O
            pg8::Gemm g{WSP(const h16, OFF_OATT), WSP(const h16, WS_WO), DM / 2, DM / 2, DM / 2, nullptr}; pg8::gemm_phase<pg8::EpiResid, pg8::StaticOrder, false, 1>(F.lds, F.tid, g, S, E);
#else
            pg8::Gemm g{WSP(const h16, OFF_OATT), WSP(const h16, WS_WO), DM, DM, DM, nullptr}; pg8::gemm_phase(F.lds, F.tid, g, S, E);
#endif
            } SEAM(pb + 8);
        if (IN(pb + 9)) for (int rep = 0; rep < REPS(9); ++rep) { phase_router(F, p, l); } SEAM(pb + 9);
        if (IN(pb + 10)) for (int rep = 0; rep < REPS(10); ++rep) { phase_dispatch(F, l); } SEAM(pb + 10);
        if (IN(pb + 11)) for (int rep = 0; rep < REPS(11); ++rep) {
            pg8::GroupOrder S{WSP(const int, OFF_TILEE), __builtin_amdgcn_readfirstlane((int)WSP(const unsigned, WS_CTL)[CW_NTILES + l]), F.G, F.vcu}; pg8::EpiGated E{WSP(h16, OFF_HP), WSP(const float, OFF_SRSTD), F8_UP ? 1.0f / 256.0f : 1.0f};
#if F8_UP
            pg8::Gemm g{(const h16*)((const unsigned char*)F.out + OUT_HB8), WSP(const h16, WS_W13), DM / 2, DM / 2, DM / 2, WSP(const int, OFF_STOK)}; pg8::gemm_phase<pg8::EpiGated, pg8::GroupOrder, true, 1>(F.lds, F.tid, g, S, E);
#else
            pg8::Gemm g{WSP(const h16, WS_HB), WSP(const h16, WS_W13), DM, DM, DM, WSP(const int, OFF_STOK)}; pg8::gemm_phase<pg8::EpiGated, pg8::GroupOrder, true>(F.lds, F.tid, g, S, E);
#endif
            } SEAM(pb + 11);
        if (IN(pb + 12)) for (int rep = 0; rep < REPS(12); ++rep) {
            pg8::GroupOrder S{WSP(const int, OFF_TILEE), __builtin_amdgcn_readfirstlane((int)WSP(const unsigned, WS_CTL)[CW_NTILES + l]), F.G, F.vcu}; pg8::EpiPlain16 E{WSP(h16, OFF_YP), 1.0f / 4096.0f};
#if F8_DOWN
            pg8::Gemm g{WSP(const h16, OFF_HP), WSP(const h16, WS_W2), 256, 256, 256, nullptr}; pg8::gemm_phase<pg8::EpiPlain16, pg8::GroupOrder, false, 1>(F.lds, F.tid, g, S, E);
#else
            pg8::Gemm g{WSP(const h16, OFF_HP), WSP(const h16, WS_W2), 512, 512, 512, nullptr}; pg8::gemm_phase(F.lds, F.tid, g, S, E);
#endif
            } SEAM(pb + 12);
        if (IN(pb + 13)) for (int rep = 0; rep < REPS(13); ++rep) { phase_combine(F, p, l); } SEAM(pb + 13);
    }
#undef IN
#undef INR
#undef SEAM
}

extern "C" void kernel_launch(void* const* d_in, const int* in_sizes, int n_in, void* d_out, int out_size, void* d_ws, size_t ws_size, hipStream_t stream) {
    static int grid = 0;
    if (grid == 0) {
        if (n_in != 32 || out_size != NT * DM || ws_size < WS_END) { fprintf(stderr, "kernel_launch: unexpected shapes / workspace (%d inputs, out %d, ws %zu < %zu)\n", n_in, out_size, ws_size, (size_t)WS_END); grid = -1; return; }
        int dev = 0, cus = 0, per_cu = 0;
        if (hipGetDevice(&dev) != hipSuccess || hipDeviceGetAttribute(&cus, hipDeviceAttributeMultiprocessorCount, dev) != hipSuccess) { grid = -1; return; }
        if (hipFuncSetAttribute((const void*)fwd, hipFuncAttributeMaxDynamicSharedMemorySize, LDS_BYTES) != hipSuccess) { fprintf(stderr, "kernel_launch: hipFuncSetAttribute failed\n"); grid = -1; return; }
        if (hipOccupancyMaxActiveBlocksPerMultiprocessor(&per_cu, (const void*)fwd, 512, LDS_BYTES) != hipSuccess || per_cu < 1) { fprintf(stderr, "kernel_launch: occupancy query says %d\n", per_cu); }
        (void)hipGetLastError();
        grid = cus;
    }
    if (grid < 0) return;
    (void)hipMemsetAsync((char*)d_ws + WS_CTL, 0, CTL_ZERO_BYTES, stream);
    Prm p{};
    for (int i = 0; i < 32; ++i) p.in[i] = (const float*)d_in[i];
    p.out = (float*)d_out; p.ws = (unsigned char*)d_ws;
#if defined(PROBE_PHASE)
    p.ph_lo = 0; p.ph_hi = PROBE_PHASE + 1; hipLaunchKernelGGL(fwd, dim3(grid), dim3(512), LDS_BYTES, stream, p);
    (void)hipMemsetAsync((char*)d_ws + WS_CTL + CW_BAR * 4, 0, XCD_BAR_WORDS * 4, stream);
    p.ph_lo = PROBE_PHASE; p.ph_hi = PROBE_PHASE + 1; hipLaunchKernelGGL(fwd, dim3(grid), dim3(512), LDS_BYTES, stream, p);
    p.ph_lo = PROBE_PHASE + 1; p.ph_hi = NPHASES; hipLaunchKernelGGL(fwd, dim3(grid), dim3(512), LDS_BYTES, stream, p);
#elif MK_SINGLE
    p.ph_lo = 0; p.ph_hi = NPHASES;
    hipLaunchKernelGGL(fwd, dim3(grid), dim3(512), LDS_BYTES, stream, p);
#else
    for (int ph = 0; ph < NPHASES; ++ph) { p.ph_lo = ph; p.ph_hi = ph + 1; hipLaunchKernelGGL(fwd, dim3(grid), dim3(512), LDS_BYTES, stream, p); }
#endif
}
```

```cpp
#include <hip/hip_runtime.h>
#include <cstdio>
#include <cstdint>

#ifndef MK_SINGLE
#define MK_SINGLE 1
#endif

typedef _Float16 h16;
typedef _Float16 h16x2 __attribute__((ext_vector_type(2)));
typedef _Float16 h16x4 __attribute__((ext_vector_type(4)));
typedef _Float16 h16x8 __attribute__((ext_vector_type(8)));
typedef float f32x2 __attribute__((ext_vector_type(2)));
typedef float f32x4 __attribute__((ext_vector_type(4)));
typedef unsigned u32x2 __attribute__((ext_vector_type(2)));
typedef unsigned u32x4 __attribute__((ext_vector_type(4)));
typedef int i32x4 __attribute__((ext_vector_type(4)));
typedef int i32x8 __attribute__((ext_vector_type(8)));
#define LAS __attribute__((address_space(3)))
#define GAS __attribute__((address_space(1)))
#define PIN() do { asm volatile("" ::: "memory"); __builtin_amdgcn_sched_barrier(0); } while (0)
#define PINV(x) asm volatile("" : "+v"(x) :: "memory")
#define NTL(T, p) __builtin_nontemporal_load((const T*)(p))
#ifndef F8_Q
#define F8_Q 1
#endif
#ifndef F8_UP
#define F8_UP 1
#endif
#ifndef F8_DOWN
#define F8_DOWN 1
#endif
#ifndef F8_OUT
#define F8_OUT 0
#endif
#ifndef F8_O
#define F8_O 1
#endif
#ifndef P8MASK
#define P8MASK 0x607
#endif
#ifndef F8_YP
#define F8_YP 1
#endif
#define F8_HB (P8MASK != 0 || F8_Q || F8_UP)
constexpr int p8_count(unsigned m) { int c = 0; for (int t = 0; t < 14; ++t) c += (m >> t) & 1; return c; }
constexpr unsigned long long p8_list(unsigned m) { unsigned long long r = 0; int j = 0; for (int t = 0; t < 14; ++t) if ((m >> t) & 1) { r |= (unsigned long long)t << (4 * j); ++j; } return r; }
constexpr unsigned long long p8_inv(unsigned m8) { unsigned long long r = 0; int j8 = 0, j16 = 0; for (int t = 0; t < 14; ++t) { if ((m8 >> t) & 1) { r |= (unsigned long long)j8 << (4 * t); ++j8; } else { r |= (unsigned long long)j16 << (4 * t); ++j16; } } return r; }
constexpr int P8_N8 = p8_count(P8MASK), P8_N16 = 14 - P8_N8;
constexpr size_t P8_WOFF = (size_t)P8_N16 * 256 * 2048;
constexpr unsigned long long P8_LIST8 = p8_list(P8MASK), P8_LIST16 = p8_list(~(unsigned)P8MASK & 0x3FFFu), P8_INV = p8_inv(P8MASK);
#define MFMA16(a, b, c) __builtin_amdgcn_mfma_f32_16x16x32_f16((a), (b), (c), 0, 0, 0)

constexpr int NB = 16, SEQ = 2048, DM = 1024, NT = NB * SEQ, MEML = 256, NTM = NB * MEML, NLAYER = 2;
constexpr int NPJ = 3584;
constexpr int CQ = 0, CK = 384, CV = 768, CG = 1152, CZ = 1536, CXS = 1920, CBM = 2304, CCM = 2560, CXR = 2816, CGT = 3072, CDT = 3328;
constexpr int DIN = 3334, NCH = 16, MAXSLOT = 73728;
constexpr float EPS = 1e-6f;
constexpr int NPH = 14;
constexpr int NPHASES = NLAYER * NPH;

constexpr size_t MiB = (size_t)1 << 20;
constexpr size_t WS_CTL = 0, CTL_ZERO_BYTES = 64 * 1024;
constexpr size_t WS_WIN = 1 * MiB, WS_WOUT = 8 * MiB, WS_WQ = 10 * MiB, WS_WKV = 12 * MiB, WS_WO = 16 * MiB, WS_W13 = 18 * MiB, WS_W2 = 82 * MiB, WS_LRUW = 114 * MiB;
constexpr size_t WS_HB = 115 * MiB;
constexpr size_t WS_R1 = 179 * MiB;
constexpr size_t WS_R2 = 403 * MiB;
constexpr size_t WS_KV = 547 * MiB, WS_MEM16 = 563 * MiB, WS_SSQ = 571 * MiB, WS_MISC = 573 * MiB, WS_END = 577 * MiB;
constexpr size_t OFF_QCA = WS_R1, OFF_OATT = WS_R1 + 64 * MiB, OFF_XP = WS_R1, OFF_HP = WS_R1 + 144 * MiB;
constexpr size_t OFF_OMIX = WS_R2, OFF_RST = WS_R2 + 64 * MiB, OFF_SST = WS_R2 + 88 * MiB, OFF_LSUM = WS_R2 + 136 * MiB, OFF_SDEC = WS_R2 + 137 * MiB, OFF_LCAR = WS_R2 + 138 * MiB, OFF_YP = WS_R2;
constexpr size_t OUT_HB8 = 0;
constexpr size_t OUT_XTG = 0, OUT_BCN = 24 * MiB, OUT_LAU = 56 * MiB;
constexpr size_t OFF_OMIX8 = WS_W13 + 32 * MiB;
static_assert(!F8_OUT || F8_UP, "OMIX8 lives in the space freed by the fp8 expert weights");
constexpr size_t OFF_KB = WS_KV, OFF_VT = WS_KV + 8 * MiB;
constexpr size_t OFF_ROPE = WS_MISC, OFF_MSSQ = WS_MISC + 512 * 1024, OFF_EID = WS_MISC + 768 * 1024, OFF_GATE = WS_MISC + 1024 * 1024, OFF_TSLOT = WS_MISC + 1280 * 1024,
                 OFF_RSTDT = WS_MISC + 1536 * 1024, OFF_SRSTD = WS_MISC + 1664 * 1024, OFF_TILEE = WS_MISC + 2000 * 1024, OFF_STOK = WS_MISC + 2048 * 1024, OFF_RWG = WS_MISC + 2400 * 1024, OFF_MRSTD = WS_MISC + 2600 * 1024;
constexpr int CW_COUNTS = 64, CW_CURSOR = 192, CW_NTILES = 320, CW_BAR = 4096;

constexpr int LDS_BYTES = 152 * 1024;
constexpr int LDS_MISC = 150 * 1024;

struct Prm { const float* in[32]; float* out; unsigned char* ws; int ph_lo, ph_hi; };

#define XB_TMO      128
#define XB_XCNT(j)  (256  + 64 * (j))
#define XB_XSUB(j)  (1280 + 64 * (j))
#define XB_XGEN(j)  (2304 + 64 * (j))
#define XB_TOP      3328
#define XB_TOPGEN   3392
#define XCD_BAR_WORDS 3456
#define XB_SPIN_CAP (1u << 18)
__device__ __forceinline__ unsigned xb_ld(unsigned* p)              { return __hip_atomic_load(p, __ATOMIC_RELAXED, __HIP_MEMORY_SCOPE_AGENT); }
__device__ __forceinline__ unsigned xb_add(unsigned* p, unsigned v) { return __hip_atomic_fetch_add(p, v, __ATOMIC_RELAXED, __HIP_MEMORY_SCOPE_AGENT); }
__device__ __forceinline__ unsigned xb_xcc_id() { return (unsigned)__builtin_amdgcn_s_getreg((3 << 11) | 20) & 0xFu; }
#define XB_SPIN(cond, bar) do { unsigned _sp = 0; while (cond) { __builtin_amdgcn_s_sleep(1); \
    if ((++_sp & 255u) == 0u) { if (xb_ld(&(bar)[XB_TMO])) break; if (_sp > XB_SPIN_CAP) { atomicAdd(&(bar)[XB_TMO], 1u); break; } } } } while (0)
struct XcdBarrier { unsigned* bar; unsigned x; volatile LAS unsigned* st; };
__device__ __forceinline__ XcdBarrier xcd_barrier_post(unsigned* bar, volatile LAS unsigned* st) {
    XcdBarrier b; b.bar = bar; b.x = xb_xcc_id(); b.st = st;
    if (threadIdx.x == 0) (void)xb_add(&bar[XB_XCNT(b.x)], 1u);
    return b;
}
__device__ __forceinline__ void xcd_barrier_complete(unsigned* bar, unsigned x, unsigned& nloc, unsigned& nx) {
    const unsigned G = gridDim.x * gridDim.y * gridDim.z;
    unsigned sum, cnt, mine, sp = 0u;
    for (;;) {
        sum = 0u; cnt = 0u; mine = 0u;
#pragma unroll
        for (unsigned j = 0; j < 16; ++j) { const unsigned c = xb_ld(&bar[XB_XCNT(j)]); sum += c; cnt += (c > 0u) ? 1u : 0u; mine = (j == x) ? c : mine; }
        if (sum == G) break;
        __builtin_amdgcn_s_sleep(1);
        if ((++sp & 255u) == 0u) { if (xb_ld(&bar[XB_TMO])) break; if (sp > XB_SPIN_CAP) { atomicAdd(&bar[XB_TMO], 1u); break; } }
    }
    nloc = mine > 0u ? mine : 1u; nx = cnt > 0u ? cnt : 1u;
}
__device__ __forceinline__ void xcd_barrier(const XcdBarrier& b) {
    asm volatile("s_waitcnt vmcnt(0)" ::: "memory");
    __syncthreads();
    if (threadIdx.x == 0) {
        unsigned* bar = b.bar;
        __builtin_amdgcn_s_waitcnt(0);
        unsigned nloc = b.st[0], nx = b.st[1];
        if (nloc == 0u) { xcd_barrier_complete(bar, b.x, nloc, nx); b.st[0] = nloc; b.st[1] = nx; }
        const unsigned old = xb_add(&bar[XB_XSUB(b.x)], 1u);
        const unsigned gen = old / nloc;
        if (old + 1u == (gen + 1u) * nloc) {
            __builtin_amdgcn_fence(__ATOMIC_RELEASE, "agent");
            asm volatile("s_waitcnt vmcnt(0)" ::: "memory");
            const unsigned og = xb_add(&bar[XB_TOP], 1u);
            const unsigned tg = og / nx;
            if (og + 1u == (tg + 1u) * nx) xb_add(&bar[XB_TOPGEN], 1u);
            else XB_SPIN(xb_ld(&bar[XB_TOPGEN]) == tg, bar);
            __builtin_amdgcn_fence(__ATOMIC_ACQUIRE, "agent");
            xb_add(&bar[XB_XGEN(b.x)], 1u);
            asm volatile("s_waitcnt vmcnt(0)" ::: "memory");
        } else {
            XB_SPIN(xb_ld(&bar[XB_XGEN(b.x)]) == gen, bar);
            __builtin_amdgcn_fence(__ATOMIC_ACQUIRE, "agent");
            asm volatile("s_waitcnt vmcnt(0)" ::: "memory");
        }
    }
    __syncthreads();
}

__device__ __forceinline__ float wave_sum(float v) {
#pragma unroll
    for (int o = 1; o < 64; o <<= 1) v += __shfl_xor(v, o);
    return v;
}
__device__ __forceinline__ float siluf_(float x) { return x * __builtin_amdgcn_rcpf(1.0f + __expf(-x)); }
__device__ __forceinline__ float softplusf_(float x) { return x > 20.f ? x : log1pf(__expf(x)); }
__device__ __forceinline__ float gelu_tanh_(float x) { const float y = 0.7978845608028654f * (x + 0.044715f * x * x * x); const float t = 1.0f - 2.0f / (__expf(2.0f * y) + 1.0f); return 0.5f * x * (1.0f + t); }
__device__ __forceinline__ h16x8 pack8(const f32x4 a, const f32x4 b) { h16x8 r; r[0] = (h16)a[0]; r[1] = (h16)a[1]; r[2] = (h16)a[2]; r[3] = (h16)a[3]; r[4] = (h16)b[0]; r[5] = (h16)b[1]; r[6] = (h16)b[2]; r[7] = (h16)b[3]; return r; }
__device__ __forceinline__ h16x4 pack4(const f32x4 a) { h16x4 r; r[0] = (h16)a[0]; r[1] = (h16)a[1]; r[2] = (h16)a[2]; r[3] = (h16)a[3]; return r; }
__device__ __forceinline__ unsigned cvt4_fp8(float a, float b, float c, float d) {
    a = __builtin_amdgcn_fmed3f(a, -448.f, 448.f); b = __builtin_amdgcn_fmed3f(b, -448.f, 448.f); c = __builtin_amdgcn_fmed3f(c, -448.f, 448.f); d = __builtin_amdgcn_fmed3f(d, -448.f, 448.f);
    int p = __builtin_amdgcn_cvt_pk_fp8_f32(a, b, 0, false); p = __builtin_amdgcn_cvt_pk_fp8_f32(c, d, p, true); return (unsigned)p; }
__device__ __forceinline__ h16x8 ldsfrag(LAS const h16* p) { return *(LAS const h16x8*)p; }
__device__ __forceinline__ int kperm32(int k) { return (k & ~31) | (((k >> 2) & 3) << 3) | (((k >> 4) & 1) << 2) | (k & 3); }
__device__ __forceinline__ h16x8 scalefrag(const h16x8 f, float s) { const h16 hs = (h16)s; h16x8 v;
#pragma unroll
    for (int j = 0; j < 8; ++j) v[j] = hs; return f * v; }
__device__ __forceinline__ float row_rstd(const float* ssq16) {
    const f32x4 a = *(const f32x4*)ssq16, b = *(const f32x4*)(ssq16 + 4), c = *(const f32x4*)(ssq16 + 8), d = *(const f32x4*)(ssq16 + 12);
    const float s = ((a[0] + a[1]) + (a[2] + a[3])) + ((b[0] + b[1]) + (b[2] + b[3])) + ((c[0] + c[1]) + (c[2] + c[3])) + ((d[0] + d[1]) + (d[2] + d[3]));
    return 1.0f / sqrtf(s * (1.0f / DM) + EPS);
}

namespace pg8 {
constexpr int BM = 256, BK = 64, HALF = 128, HTB = HALF * BK * 2, STAGE_BYTES = 8 * HTB, NXCD = 8, WGM = 8;
__host__ __device__ __forceinline__ int lds_byte(int r, int c) { const int st = (r >> 4) * 2 + (c >> 5), rr = r & 15, cc = c & 31, ob = rr * 64 + cc * 2; return st * 1024 + (ob ^ (((ob >> 9) & 1) << 5)); }
__host__ __device__ __forceinline__ void stage_rc(int b, int& R, int& C) { const int st = b / 1024, sb = b % 1024, swz = sb ^ (((sb >> 9) & 1) << 5); R = (st >> 1) * 16 + swz / 64; C = (st & 1) * 32 + (swz % 64) / 2; }
__host__ __device__ __forceinline__ int perm32(int rho) { const int n = rho >> 4, i = rho & 15; return 8 * (i >> 2) + 4 * n + (i & 3); }
struct Unit { int pm, pn; };
struct Gemm { const h16* A; const h16* Bt; int lda, ldb, K; const int* rowidx; };
struct StaticOrder {
    int nM, nN, nwg, G, c;
    __device__ void init(int M, int N, int G_, int c_) { nM = M / BM; nN = N / BM; nwg = nM * nN; G = G_; c = c_; }
    __device__ bool next(int i, Unit& u) const {
        const long L = (long)i * G + c; if (L >= nwg) return false;
        int wgid = (int)L; { const int q = nwg / NXCD, r = nwg % NXCD, xcd = wgid % NXCD, off = wgid / NXCD; wgid = (xcd < r ? xcd * (q + 1) : r * (q + 1) + (xcd - r) * q) + off; }
        const int nig = WGM * nN, gid = wgid / nig, fm = gid * WGM, gsz = (nM - fm) < WGM ? (nM - fm) : WGM;
        u.pm = fm + ((wgid % nig) % gsz); u.pn = (wgid % nig) / gsz; return true;
    }
};
struct GroupOrder {
    const int* tile_e; int ntiles, G, vcu;
    __device__ bool next(int i, Unit& u) const {
        const int L = i * G + vcu, tile = L >> 2; if (tile >= ntiles) return false;
        u.pm = tile; u.pn = __builtin_amdgcn_readfirstlane(tile_e[tile]) * 4 + (L & 3); return true;
    }
};

struct EpiScale16 {
    static constexpr bool PERM = true;
    h16* O; int ldc; const float* ssq; float cs;
    __device__ __forceinline__ void operator()(const f32x4 (&acc)[2][2][4][2], const Unit& u, int wr, int wc, int fr, int fq) const {
        const int row0 = u.pm * BM + wr * 64 + fr, col0 = u.pn * BM + wc * 32 + 8 * fq;
#pragma unroll
        for (int ai = 0; ai < 2; ++ai)
#pragma unroll
            for (int m = 0; m < 4; ++m) { const int row = row0 + ai * HALF + m * 16; const float rs = row_rstd(ssq + (size_t)row * 16) * cs; h16* rowp = O + (size_t)row * ldc + col0;
#pragma unroll
                for (int bj = 0; bj < 2; ++bj) *(h16x8*)(rowp + bj * HALF) = pack8(acc[ai][bj][m][0] * rs, acc[ai][bj][m][1] * rs); }
    }
};
struct EpiScale16C {
    static constexpr bool PERM = true;
    h16* O; int ldc; const float* rstd; float cs; unsigned long long cmap;
    __device__ __forceinline__ void operator()(const f32x4 (&acc)[2][2][4][2], const Unit& u, int wr, int wc, int fr, int fq) const {
        const int row0 = u.pm * BM + wr * 64 + fr, col0 = (int)((cmap >> (4 * u.pn)) & 15) * BM + wc * 32 + 8 * fq;
        float rs[2][4];
#pragma unroll
        for (int ai = 0; ai < 2; ++ai)
#pragma unroll
            for (int m = 0; m < 4; ++m) rs[ai][m] = rstd[row0 + ai * HALF + m * 16] * cs;
#pragma unroll
        for (int ai = 0; ai < 2; ++ai)
#pragma unroll
            for (int m = 0; m < 4; ++m) { h16* rowp = O + (size_t)(row0 + ai * HALF + m * 16) * ldc + col0;
#pragma unroll
                for (int bj = 0; bj < 2; ++bj) *(h16x8*)(rowp + bj * HALF) = pack8(acc[ai][bj][m][0] * rs[ai][m], acc[ai][bj][m][1] * rs[ai][m]); }
    }
};
struct EpiVT {
    static constexpr bool PERM = false;
    h16* VT; const float* mrstd;
    __device__ __forceinline__ void operator()(const f32x4 (&acc)[2][2][4][2], const Unit& u, int wr, int wc, int fr, int fq) const {
#pragma unroll
        for (int ai = 0; ai < 2; ++ai) { f32x4 rs[4];
#pragma unroll
            for (int m = 0; m < 4; ++m) rs[m] = *(const f32x4*)(mrstd + u.pm * BM + ai * HALF + wr * 64 + m * 16 + 4 * fq);
#pragma unroll
            for (int bj = 0; bj < 2; ++bj)
#pragma unroll
                for (int n = 0; n < 2; ++n) { h16* rowp = VT + ((size_t)(u.pm * 4 + u.pn) * 256 + bj * HALF + wc * 32 + n * 16 + fr) * 256 + ai * HALF + wr * 64 + 8 * fq;
#pragma unroll
                    for (int mm = 0; mm < 2; ++mm) *(h16x8*)(rowp + 32 * mm) = pack8(acc[ai][bj][2 * mm][n] * rs[2 * mm], acc[ai][bj][2 * mm + 1][n] * rs[2 * mm + 1]); } }
    }
};
struct EpiResid {
    static constexpr bool PERM = true;
    h16* hb; float* ssq; unsigned char* hb8; float cs;
    __device__ __forceinline__ void operator()(const f32x4 (&acc)[2][2][4][2], const Unit& u, int wr, int wc, int fr, int fq) const {
        const int row0 = u.pm * BM + wr * 64 + fr, col0 = u.pn * BM + wc * 32 + 8 * fq;
#pragma unroll
        for (int ai = 0; ai < 2; ++ai)
#pragma unroll
            for (int mp = 0; mp < 2; ++mp) { unsigned ch[2][2][2];
#pragma unroll
                for (int mm = 0; mm < 2; ++mm) { const int m = 2 * mp + mm; const int row = row0 + ai * HALF + m * 16; h16* rowp = hb + (size_t)row * DM + col0; float s = 0.f;
#pragma unroll
                    for (int bj = 0; bj < 2; ++bj) { const h16x8 bv = *(const h16x8*)(rowp + bj * HALF); f32x4 v0, v1;
#pragma unroll
                        for (int e = 0; e < 4; ++e) { v0[e] = (float)bv[e] + acc[ai][bj][m][0][e] * cs; v1[e] = (float)bv[4 + e] + acc[ai][bj][m][1][e] * cs; }
                        const h16x8 o = pack8(v0, v1); *(h16x8*)(rowp + bj * HALF) = o;
                        if (F8_HB) { ch[mm][bj][0] = cvt4_fp8(v0[0], v0[1], v0[2], v0[3]); ch[mm][bj][1] = cvt4_fp8(v1[0], v1[1], v1[2], v1[3]); }
#pragma unroll
                        for (int e = 0; e < 8; ++e) { const float q = (float)o[e]; s += q * q; } }
                    s += __shfl_xor(s, 16); s += __shfl_xor(s, 32);
                    if (fq == 0) ssq[(size_t)row * 16 + u.pn * 4 + wc] = s; }
                if (F8_HB) {
                    const int row = row0 + ai * HALF + (2 * mp + (fq & 1)) * 16; unsigned char* p8 = hb8 + (size_t)row * DM + u.pn * BM + wc * 32 + 8 * (fq & ~1);
#pragma unroll
                    for (int bj = 0; bj < 2; ++bj) { const auto s0 = __builtin_amdgcn_permlane16_swap(ch[0][bj][0], ch[1][bj][0], false, false), s1 = __builtin_amdgcn_permlane16_swap(ch[0][bj][1], ch[1][bj][1], false, false);
                        *(u32x4*)(p8 + bj * HALF) = (u32x4){s0[0], s1[0], s0[1], s1[1]}; } } }
    }
};
struct EpiGated {
    static constexpr bool PERM = true;
    h16* O; const float* srstd; float cs;
    __device__ __forceinline__ void operator()(const f32x4 (&acc)[2][2][4][2], const Unit& u, int wr, int wc, int fr, int fq) const {
        const int row0 = u.pm * BM + wr * 64 + fr, col0 = (u.pn & 3) * HALF + wc * 32 + 8 * fq;
#pragma unroll
        for (int ai = 0; ai < 2; ++ai)
#pragma unroll
            for (int mp = 0; mp < 2; ++mp) { unsigned ch[2][2];
#pragma unroll
                for (int mm = 0; mm < 2; ++mm) { const int m = 2 * mp + mm; const int row = row0 + ai * HALF + m * 16; const float rs = srstd[row] * cs; f32x4 o[2];
#pragma unroll
                    for (int n = 0; n < 2; ++n)
#pragma unroll
                        for (int j = 0; j < 4; ++j) { const float a = acc[ai][0][m][n][j] * rs, b = acc[ai][1][m][n][j] * rs; o[n][j] = siluf_(a) * b; }
                    if (F8_DOWN) { ch[mm][0] = cvt4_fp8(16.f * o[0][0], 16.f * o[0][1], 16.f * o[0][2], 16.f * o[0][3]); ch[mm][1] = cvt4_fp8(16.f * o[1][0], 16.f * o[1][1], 16.f * o[1][2], 16.f * o[1][3]); }
                    else *(h16x8*)(O + (size_t)row * 512 + col0) = pack8(o[0], o[1]); }
                if (F8_DOWN) {
                    const auto s0 = __builtin_amdgcn_permlane16_swap(ch[0][0], ch[1][0], false, false), s1 = __builtin_amdgcn_permlane16_swap(ch[0][1], ch[1][1], false, false);
                    *(u32x4*)((unsigned char*)O + (size_t)(row0 + ai * HALF + (2 * mp + (fq & 1)) * 16) * 512 + (u.pn & 3) * HALF + wc * 32 + 8 * (fq & ~1)) = (u32x4){s0[0], s1[0], s0[1], s1[1]}; } }
    }
};
struct EpiPlain8 {
    static constexpr bool PERM = true;
    unsigned char* O; float cs;
    __device__ __forceinline__ void operator()(const f32x4 (&acc)[2][2][4][2], const Unit& u, int wr, int wc, int fr, int fq) const {
        const int row0 = u.pm * BM + wr * 64 + fr;
#pragma unroll
        for (int ai = 0; ai < 2; ++ai)
#pragma unroll
            for (int mp = 0; mp < 2; ++mp) { unsigned char* p8 = O + (size_t)(row0 + ai * HALF + (2 * mp + (fq & 1)) * 16) * DM + (u.pn & 3) * BM + wc * 32 + 8 * (fq & ~1);
#pragma unroll
                for (int bj = 0; bj < 2; ++bj) { unsigned ch[2][2];
#pragma unroll
                    for (int mm = 0; mm < 2; ++mm) { const f32x4 a0 = acc[ai][bj][2 * mp + mm][0] * cs, a1 = acc[ai][bj][2 * mp + mm][1] * cs; ch[mm][0] = cvt4_fp8(a0[0], a0[1], a0[2], a0[3]); ch[mm][1] = cvt4_fp8(a1[0], a1[1], a1[2], a1[3]); }
                    const auto s0 = __builtin_amdgcn_permlane16_swap(ch[0][0], ch[1][0], false, false), s1 = __builtin_amdgcn_permlane16_swap(ch[0][1], ch[1][1], false, false);
                    *(u32x4*)(p8 + bj * HALF) = (u32x4){s0[0], s1[0], s0[1], s1[1]}; } }
    }
};
struct EpiPlain16 {
    static constexpr bool PERM = true;
    h16* O; float cs;
    __device__ __forceinline__ void operator()(const f32x4 (&acc)[2][2][4][2], const Unit& u, int wr, int wc, int fr, int fq) const {
        const int row0 = u.pm * BM + wr * 64 + fr, col0 = (u.pn & 3) * BM + wc * 32 + 8 * fq;
#pragma unroll
        for (int ai = 0; ai < 2; ++ai)
#pragma unroll
            for (int m = 0; m < 4; ++m) { h16* rowp = O + (size_t)(row0 + ai * HALF + m * 16) * DM + col0;
#pragma unroll
                for (int bj = 0; bj < 2; ++bj) *(h16x8*)(rowp + bj * HALF) = F8_DOWN ? pack8(acc[ai][bj][m][0] * cs, acc[ai][bj][m][1] * cs) : pack8(acc[ai][bj][m][0], acc[ai][bj][m][1]); }
    }
};

template <class Epi, class Sched, bool GATHER = false, int F8W = 0, bool SWAP = false>
__device__ __forceinline__ void gemm_phase(LAS unsigned char* lds, const int tid, const Gemm g, const Sched& S, const Epi& E) {
    const int wid = __builtin_amdgcn_readfirstlane(tid >> 6), lane = tid & 63, wr = wid >> 2, wc = wid & 3, fr = lane & 15, fq = lane >> 4;
    int K_ = g.K; asm volatile("" : "+s"(K_));
    const int K = K_, nt = K / BK;
    unsigned voffA[2], voffB[2];
#pragma unroll
    for (int i = 0; i < 2; ++i) { int R, C; stage_rc(tid * 16 + i * 8192, R, C); const int Rb = Epi::PERM ? ((R & ~31) + perm32(R & 31)) : R;
        voffA[i] = (unsigned)(R * g.lda + C) * 2u; voffB[i] = (unsigned)(Rb * g.ldb + C) * 2u; }
    const size_t kstep = (size_t)(BK * 2);
    const size_t hstepA = (size_t)HALF * g.lda * 2, hstepB = (size_t)HALF * g.ldb * 2;
    const size_t tstepA = 2 * hstepA, tstepB = 2 * hstepB;
    const unsigned ldsw = (unsigned)wid * 1024u;
    const int aoff = lds_byte(wr * 64 + fr, fq * 8), boff = lds_byte(wc * 32 + fr, fq * 8);
#define PG8_SA(b, h) (((b) * 2 + (h)) * HTB)
#define PG8_SB(b, h) ((4 + (b) * 2 + (h)) * HTB)
#define PG8_STAGE(bufoff, gbase, voff) do { _Pragma("unroll") for (int _i = 0; _i < 2; ++_i) \
        __builtin_amdgcn_global_load_lds((const unsigned*)((const char*)(gbase) + (voff)[_i]), (LAS unsigned*)(lds + (bufoff) + ldsw + _i * 8192), 16, 0, 0); } while (0)
    unsigned coff[2], noff[2], cbyte[2];
    if constexpr (GATHER) {
#pragma unroll
        for (int i = 0; i < 2; ++i) { int R_, C_; stage_rc(tid * 16 + i * 8192, R_, C_); cbyte[i] = (unsigned)(C_ * 2); } }
#define PG8_GOFF(u_, o_) do { _Pragma("unroll") for (int _i = 0; _i < 2; ++_i) { int R_, C_; stage_rc(tid * 16 + _i * 8192, R_, C_); \
        o_[_i] = (unsigned)g.rowidx[(u_).pm * BM + R_] | ((unsigned)g.rowidx[(u_).pm * BM + HALF + R_] << 16); } } while (0)
#define PG8_STAGEA(bufoff, gbase, h, sel) do { if constexpr (GATHER) { _Pragma("unroll") for (int _i = 0; _i < 2; ++_i) { const unsigned pk_ = (sel) ? noff[_i] : coff[_i]; \
        __builtin_amdgcn_global_load_lds((const unsigned*)((const char*)(gbase) + (((pk_ >> (16 * (h))) & 0xffffu) * (unsigned)(g.lda * 2) + cbyte[_i])), (LAS unsigned*)(lds + (bufoff) + ldsw + _i * 8192), 16, 0, 0); } } \
        else { PG8_STAGE(bufoff, (gbase) + ((h) ? hstepA : 0), voffA); } } while (0)
#define PG8_LDA(dst, b, h) do { _Pragma("unroll") for (int m = 0; m < 4; ++m) _Pragma("unroll") for (int k = 0; k < 2; ++k) dst[m][k] = *(const LAS h16x8*)(lds + PG8_SA(b, h) + aoff + m * 2048 + k * 1024); } while (0)
#define PG8_LDB(dst, b, h) do { _Pragma("unroll") for (int n = 0; n < 2; ++n) _Pragma("unroll") for (int k = 0; k < 2; ++k) dst[n][k] = *(const LAS h16x8*)(lds + PG8_SB(b, h) + boff + n * 2048 + k * 1024); } while (0)
#define PG8_MMA(ai, bj, At, Bt) do { __builtin_amdgcn_s_setprio(1); _Pragma("unroll") for (int m = 0; m < 4; ++m) _Pragma("unroll") for (int n = 0; n < 2; ++n) _Pragma("unroll") for (int k = 0; k < 2; ++k) \
        acc[ai][bj][m][n] = SWAP ? __builtin_amdgcn_mfma_f32_16x16x32_f16(At[m][k], Bt[n][k], acc[ai][bj][m][n], 0, 0, 0) : __builtin_amdgcn_mfma_f32_16x16x32_f16(Bt[n][k], At[m][k], acc[ai][bj][m][n], 0, 0, 0); __builtin_amdgcn_s_setprio(0); } while (0)
#define PG8_MMA8(ai, bj, At, Bt) do { __builtin_amdgcn_s_setprio(1); _Pragma("unroll") for (int m = 0; m < 4; ++m) _Pragma("unroll") for (int n = 0; n < 2; ++n) { \
        const i32x8 wf_ = __builtin_shufflevector(__builtin_bit_cast(i32x4, Bt[n][0]), __builtin_bit_cast(i32x4, Bt[n][1]), 0, 1, 2, 3, 4, 5, 6, 7), af_ = __builtin_shufflevector(__builtin_bit_cast(i32x4, At[m][0]), __builtin_bit_cast(i32x4, At[m][1]), 0, 1, 2, 3, 4, 5, 6, 7); \
        asm volatile("v_mfma_f32_16x16x128_f8f6f4 %0, %1, %2, %0" : "+v"(acc[ai][bj][m][n]) : "v"(wf_), "v"(af_)); } __builtin_amdgcn_s_setprio(0); } while (0)
#define PG8_MM(ai, bj, At, Bt) do { if constexpr (F8W != 0) PG8_MMA8(ai, bj, At, Bt); else PG8_MMA(ai, bj, At, Bt); } while (0)
#define PG8_WAIT_V(n) asm volatile("s_waitcnt vmcnt(" #n ")" ::: "memory")
#define PG8_WAIT_L(n) asm volatile("s_waitcnt lgkmcnt(" #n ")" ::: "memory")
#define PG8_BAR __builtin_amdgcn_s_barrier()
#define PG8_SCHED __builtin_amdgcn_sched_barrier(0)
    Unit cur, nxt; int ui = 0;
    if (!S.next(0, cur)) return;
    f32x4 acc[2][2][4][2];
#pragma unroll
    for (int a = 0; a < 2; ++a)
#pragma unroll
        for (int b = 0; b < 2; ++b)
#pragma unroll
            for (int m = 0; m < 4; ++m)
#pragma unroll
                for (int n = 0; n < 2; ++n) acc[a][b][m][n] = (f32x4){0.f, 0.f, 0.f, 0.f};
    h16x8 At[4][2], B0[2][2], B1[2][2];
    const char* cA = (const char*)g.A + (GATHER ? (size_t)0 : (size_t)cur.pm * tstepA); const char* cB = (const char*)g.Bt + (size_t)cur.pn * tstepB;
    if constexpr (GATHER) { PG8_GOFF(cur, coff); noff[0] = coff[0]; noff[1] = coff[1]; }
    PG8_STAGE(PG8_SB(0, 0), cB, voffB); PG8_STAGE(PG8_SB(0, 1), cB + hstepB, voffB); PG8_STAGEA(PG8_SA(0, 0), cA, 0, false); PG8_STAGEA(PG8_SA(0, 1), cA, 1, false);
    if (wr == 1) PG8_BAR;
    PG8_WAIT_V(2); PG8_BAR;
    PG8_STAGE(PG8_SB(1, 0), cB + kstep, voffB); PG8_STAGEA(PG8_SA(1, 0), cA + kstep, 0, false); PG8_STAGE(PG8_SB(1, 1), cB + hstepB + kstep, voffB);
    PG8_WAIT_V(6); PG8_BAR;
    for (;;) {
        const bool has_next = S.next(ui + 1, nxt);
        const char* nA = (has_next && !GATHER) ? (const char*)g.A + (size_t)nxt.pm * tstepA : cA; const char* nB = has_next ? (const char*)g.Bt + (size_t)nxt.pn * tstepB : cB;
        if constexpr (GATHER) { if (has_next) PG8_GOFF(nxt, noff); }
        for (int t = 0; t < nt; t += 2) {
            const bool last = (t == nt - 2);
            const char* a1 = cA + (size_t)(t + 1) * kstep;
            const char* a2 = last ? nA : cA + (size_t)(t + 2) * kstep; const char* b2 = last ? nB : cB + (size_t)(t + 2) * kstep;
            const char* a3 = a2 + kstep; const char* b3 = b2 + kstep;
            PG8_LDB(B0, 0, 0); PG8_LDB(B1, 0, 1); PG8_SCHED; PG8_LDA(At, 0, 0); PG8_STAGEA(PG8_SA(1, 1), a1, 1, false);
            PG8_WAIT_V(8); PG8_WAIT_L(0); PG8_BAR; PG8_MM(0, 0, At, B0); PG8_MM(0, 1, At, B1); PG8_BAR; PG8_SCHED;
            PG8_LDA(At, 0, 1); PG8_STAGE(PG8_SB(0, 0), b2, voffB); PG8_STAGE(PG8_SB(0, 1), b2 + hstepB, voffB); PG8_STAGEA(PG8_SA(0, 0), a2, 0, last);
            PG8_WAIT_V(8); PG8_WAIT_L(0); PG8_BAR; PG8_MM(1, 0, At, B0); PG8_MM(1, 1, At, B1); PG8_BAR; PG8_SCHED;
            PG8_LDB(B0, 1, 0); PG8_LDB(B1, 1, 1); PG8_SCHED; PG8_LDA(At, 1, 0); PG8_STAGEA(PG8_SA(0, 1), a2, 1, last);
            PG8_WAIT_V(8); PG8_WAIT_L(0); PG8_BAR; PG8_MM(0, 0, At, B0); PG8_MM(0, 1, At, B1); PG8_BAR; PG8_SCHED;
            PG8_LDA(At, 1, 1); PG8_STAGE(PG8_SB(1, 0), b3, voffB); PG8_STAGE(PG8_SB(1, 1), b3 + hstepB, voffB); PG8_STAGEA(PG8_SA(1, 0), a3, 0, last);
            PG8_WAIT_V(8); PG8_WAIT_L(0); PG8_BAR; PG8_MM(1, 0, At, B0); PG8_MM(1, 1, At, B1); PG8_BAR; PG8_SCHED;
        }
        if (wr == 0) PG8_BAR;
        if constexpr (F8W != 0) asm volatile("s_nop 7\n\ts_nop 7\n\ts_nop 7" ::: "memory");
        E(acc, cur, wr, wc, fr, fq);
        if (!has_next) break;
#pragma unroll
        for (int a = 0; a < 2; ++a)
#pragma unroll
            for (int b = 0; b < 2; ++b)
#pragma unroll
                for (int m = 0; m < 4; ++m)
#pragma unroll
                    for (int n = 0; n < 2; ++n) acc[a][b][m][n] = (f32x4){0.f, 0.f, 0.f, 0.f};
        cur = nxt; cA = nA; cB = nB; ++ui;
        if constexpr (GATHER) { coff[0] = noff[0]; coff[1] = noff[1]; }
        if (wr == 1) PG8_BAR;
    }
    PG8_WAIT_V(0);
    PG8_BAR;
#undef PG8_SA
#undef PG8_SB
#undef PG8_STAGE
#undef PG8_LDA
#undef PG8_GOFF
#undef PG8_STAGEA
#undef PG8_LDB
#undef PG8_MMA
#undef PG8_MMA8
#undef PG8_MM
#undef PG8_WAIT_V
#undef PG8_WAIT_L
#undef PG8_BAR
#undef PG8_SCHED
}
}

struct Frame {
    LAS unsigned char* lds;
    GAS unsigned char* ws;
    volatile LAS unsigned long long* ptab;
    float* out;
    int tid, lane, wave, G, vcu;
};
#define WSP(T, off) ((T*)(GAS T*)(F.ws + (off)))
__device__ __forceinline__ const float* inptr(const Frame& F, int i) {
    const unsigned long long v = F.ptab[i];
    const unsigned lo = __builtin_amdgcn_readfirstlane((unsigned)v), hi = __builtin_amdgcn_readfirstlane((unsigned)(v >> 32));
    return (const float*)(GAS const float*)(((unsigned long long)hi << 32) | lo);
}
__device__ __forceinline__ void launder(Frame& F) {
    int wv = F.wave; asm volatile("" : "+s"(wv)); F.wave = wv;
    unsigned z = 0u; asm volatile("" : "+v"(z));
    int t = wv * 64 + (int)__builtin_amdgcn_mbcnt_hi(~0u, __builtin_amdgcn_mbcnt_lo(~0u, z)); F.tid = t; F.lane = t & 63;
    const unsigned long long w = (unsigned long long)F.ws; unsigned wl = __builtin_amdgcn_readfirstlane((unsigned)w), wh = __builtin_amdgcn_readfirstlane((unsigned)(w >> 32));
    asm volatile("" : "+s"(wl), "+s"(wh)); F.ws = (GAS unsigned char*)(((unsigned long long)wh << 32) | wl);
    unsigned lo = __builtin_amdgcn_readfirstlane((unsigned)(uintptr_t)F.lds); asm volatile("" : "+s"(lo)); F.lds = (LAS unsigned char*)(uintptr_t)lo;
    int v = __builtin_amdgcn_readfirstlane(F.vcu); asm volatile("" : "+s"(v)); F.vcu = v;
}

struct TrItem { const float* W; const float* g; h16* Wt; int ldw, sc, nvalid, ldt, d0, k0, vw, f8; float mul; };
__device__ __forceinline__ void tr_describe(const Frame& F, GAS unsigned char* wsb_, int l, int it, TrItem& d) {
    unsigned char* wsb = (unsigned char*)wsb_;
    int r = it; d.g = nullptr; d.mul = 1.f; d.nvalid = 64; d.vw = 4; d.ldt = DM; d.ldw = DM; d.f8 = 0;
    if (r < 896) { const int d0 = 64 * (r % 56); d.W = inptr(F, 3) + (size_t)l * DM * DIN; d.ldw = DIN; d.g = inptr(F, 2) + l * DM; { const int tile = d0 >> 8, is8 = (P8MASK >> tile) & 1, pos = (int)((P8_INV >> (4 * tile)) & 15); d.Wt = (h16*)(wsb + WS_WIN + (is8 ? P8_WOFF : 0)); d.d0 = pos * 256 + (d0 & 255); if (is8) { d.f8 = 1; d.mul = 256.f; } }
        d.k0 = 64 * (r / 56); d.vw = 2;
        if (d0 < 2816) d.sc = d0; else if (d0 < 3328) d.sc = d0 + 6; else if (d0 == 3328) { d.sc = 2816; d.nvalid = 6; } else { d.sc = 0; d.nvalid = 0; } return; } r -= 896;
    if (r < 256) { d.W = inptr(F, 4) + (size_t)l * DM * DM; if (F8_OUT) { d.f8 = 1; d.mul = 256.f; } d.Wt = (h16*)(wsb + WS_WOUT); d.d0 = d.sc = 64 * (r % 16); d.k0 = 64 * (r / 16); return; } r -= 256;
    if (r < 256) { d.W = inptr(F, 20) + (size_t)l * DM * DM; d.g = inptr(F, 18) + l * DM; d.mul = F8_Q ? 256.f : 0.0625f; d.f8 = F8_Q; d.Wt = (h16*)(wsb + WS_WQ); d.d0 = d.sc = 64 * (r % 16); d.k0 = 64 * (r / 16); return; } r -= 256;
    if (r < 512) { d.W = inptr(F, 21) + (size_t)l * DM * 2048; d.ldw = 2048; d.g = inptr(F, 19) + l * DM; d.Wt = (h16*)(wsb + WS_WKV); d.d0 = d.sc = 64 * (r % 32); d.k0 = 64 * (r / 32); return; } r -= 512;
    if (r < 256) { d.W = inptr(F, 22) + (size_t)l * DM * DM; if (F8_O) { d.f8 = 1; d.mul = 256.f; } d.Wt = (h16*)(wsb + WS_WO); d.d0 = d.sc = 64 * (r % 16); d.k0 = 64 * (r / 16); return; } r -= 256;
    if (r < 8192) { const int e = r / 256, q = r % 256, d0 = 64 * (q % 16), grp = d0 >> 8, rr = d0 & 255;
        d.W = (rr < 128 ? inptr(F, 28) : inptr(F, 29)) + (size_t)(l * 32 + e) * DM * 512; d.ldw = 512; d.sc = grp * 128 + (rr & 127); d.g = inptr(F, 23) + l * DM; d.Wt = (h16*)(wsb + WS_W13 + (size_t)e * DM * DM * (F8_UP ? 1 : 2)); if (F8_UP) { d.f8 = 1; d.mul = 256.f; } d.d0 = d0; d.k0 = 64 * (q / 16); return; } r -= 8192;
    if (r < 4096) { const int e = r / 128, q = r % 128; d.W = inptr(F, 30) + (size_t)(l * 32 + e) * 512 * DM; d.Wt = (h16*)(wsb + WS_W2 + (size_t)e * DM * 512 * (F8_DOWN ? 1 : 2)); if (F8_DOWN) { d.f8 = 1; d.mul = 256.f; } d.ldt = 512; d.d0 = d.sc = 64 * (q % 16); d.k0 = 64 * (q / 16); return; } r -= 4096;
    { const int blk = r & 3, gate = (r >> 2) & 1, dir = r >> 3; d.W = (gate ? inptr(F, 16) : inptr(F, 14)) + (size_t)((l * 2 + dir) * 4 + blk) * 4096; d.ldw = 64; d.Wt = (h16*)(wsb + WS_LRUW) + (size_t)((dir * 2 + gate) * 4 + blk) * 4096; d.ldt = 64; d.d0 = d.sc = 0; d.k0 = 0; }
}
__device__ __forceinline__ void tr_load(const TrItem& d, int lane, f32x4 (&v)[16]) {
    if (d.vw == 4) { const int col = 4 * (lane & 15); const float* src = d.W + (size_t)(d.k0 + (lane >> 4)) * d.ldw + d.sc + col; const bool ok = col < d.nvalid;
#pragma unroll
        for (int i = 0; i < 16; ++i) v[i] = ok ? __builtin_nontemporal_load((const f32x4*)(src + (size_t)(4 * i) * d.ldw)) : (f32x4){0.f, 0.f, 0.f, 0.f};
    } else { const int col = 2 * (lane & 31); const float* src = d.W + (size_t)(d.k0 + (lane >> 5)) * d.ldw + d.sc + col; const bool ok = col < d.nvalid;
#pragma unroll
        for (int i = 0; i < 16; ++i) { const f32x2 a = ok ? __builtin_nontemporal_load((const f32x2*)(src + (size_t)(4 * i) * d.ldw)) : (f32x2){0.f, 0.f}, c = ok ? __builtin_nontemporal_load((const f32x2*)(src + (size_t)(4 * i + 2) * d.ldw)) : (f32x2){0.f, 0.f}; v[i] = (f32x4){a[0], a[1], c[0], c[1]}; } }
}
__device__ __forceinline__ void tr_to_lds(const TrItem& d, int lane, const f32x4 (&v)[16], LAS float* scr) {
    if (d.vw == 4) { LAS float* q = scr + (lane >> 4) * 65 + 4 * (lane & 15);
#pragma unroll
        for (int i = 0; i < 16; ++i) { q[(4 * i) * 65 + 0] = v[i][0]; q[(4 * i) * 65 + 1] = v[i][1]; q[(4 * i) * 65 + 2] = v[i][2]; q[(4 * i) * 65 + 3] = v[i][3]; }
    } else { LAS float* q = scr + (lane >> 5) * 65 + 2 * (lane & 31);
#pragma unroll
        for (int i = 0; i < 16; ++i) { q[(4 * i) * 65 + 0] = v[i][0]; q[(4 * i) * 65 + 1] = v[i][1]; q[(4 * i + 2) * 65 + 0] = v[i][2]; q[(4 * i + 2) * 65 + 1] = v[i][3]; } }
}
__device__ __forceinline__ void tr_from_lds(const TrItem& d, int lane, LAS const float* scr) {
    const int c = lane & 7; float gs[8];
    if (d.g) { const f32x4 g0 = *(const f32x4*)(d.g + d.k0 + 8 * c), g1 = *(const f32x4*)(d.g + d.k0 + 8 * c + 4);
        gs[0] = g0[0] * d.mul; gs[1] = g0[1] * d.mul; gs[2] = g0[2] * d.mul; gs[3] = g0[3] * d.mul; gs[4] = g1[0] * d.mul; gs[5] = g1[1] * d.mul; gs[6] = g1[2] * d.mul; gs[7] = g1[3] * d.mul;
    } else {
#pragma unroll
        for (int e = 0; e < 8; ++e) gs[e] = d.mul; }
    if (d.f8) {
#pragma unroll
        for (int j = 0; j < 8; ++j) { const int nn = (lane >> 3) + 8 * j; LAS const float* q = scr + (8 * c) * 65 + nn; float f[8];
#pragma unroll
            for (int e = 0; e < 8; ++e) f[e] = q[e * 65] * gs[e];
            *(u32x2*)((unsigned char*)d.Wt + (size_t)(d.d0 + nn) * d.ldt + d.k0 + 8 * c) = (u32x2){cvt4_fp8(f[0], f[1], f[2], f[3]), cvt4_fp8(f[4], f[5], f[6], f[7])}; }
        return; }
#pragma unroll
    for (int j = 0; j < 8; ++j) { const int nn = (lane >> 3) + 8 * j; LAS const float* q = scr + (8 * c) * 65 + nn; h16x8 o;
#pragma unroll
        for (int e = 0; e < 8; ++e) o[e] = (h16)(q[e * 65] * gs[e]);
        *(h16x8*)(d.Wt + (size_t)(d.d0 + nn) * d.ldt + d.k0 + 8 * c) = o; }
}
__device__ __forceinline__ void phase_convert(const Frame& F, const Prm& p, int l) {
    LAS float* scr = (LAS float*)(F.lds + F.wave * 16640);
    const int gw = F.vcu * 8 + F.wave, NGW = F.G * 8;
    constexpr int NITEMS = 896 + 256 + 256 + 512 + 256 + 8192 + 4096 + 16;
    { TrItem cur, nxt; f32x4 v[16]; int it = gw;
        if (it < NITEMS) { tr_describe(F, F.ws, l, it, cur); tr_load(cur, F.lane, v); }
        while (it < NITEMS) { const int itn = it + NGW; const bool hn = itn < NITEMS;
            tr_to_lds(cur, F.lane, v, scr);
            if (hn) { tr_describe(F, F.ws, l, itn, nxt); tr_load(nxt, F.lane, v); }
            asm volatile("s_waitcnt lgkmcnt(0)" ::: "memory");
            tr_from_lds(cur, F.lane, scr);
            asm volatile("s_waitcnt lgkmcnt(0)" ::: "memory");
            cur = nxt; it = itn; } }
    {
        const float* gm = inptr(F, 23) + l * DM; const float* wg = inptr(F, 24) + (size_t)l * DM * 4; const float* we = inptr(F, 26) + (size_t)l * DM * 32; h16* rwg = WSP(h16, OFF_RWG);
        for (int i = F.vcu * 512 + F.tid; i < 36 * DM; i += 256 * 512) { const int k = i / 36, j = i % 36; const float wv = gm[k] * (j < 4 ? wg[k * 4 + j] : we[k * 32 + (j - 4)]) * 1024.0f;
            const h16 hi = (h16)wv; rwg[(size_t)j * 1032 + k] = hi; rwg[(size_t)(36 + j) * 1032 + k] = (h16)(wv - (float)hi); } }
    if (l == 0) {
        for (int m = gw; m < NT + NTM; m += NGW) {
            const bool isx = m < NT; const int row = isx ? m : m - NT;
            const float* src = (isx ? inptr(F, 0) : inptr(F, 1)) + (size_t)row * DM; h16* dst = (isx ? WSP(h16, WS_HB) : WSP(h16, WS_MEM16)) + (size_t)row * DM;
            float* sq = (isx ? WSP(float, WS_SSQ) : WSP(float, OFF_MSSQ)) + (size_t)row * 16;
            float s = 0.f;
#pragma unroll
            for (int j = 0; j < 4; ++j) { const f32x4 v = __builtin_nontemporal_load((const f32x4*)(src + 4 * F.lane + 256 * j)); *(h16x4*)(dst + 4 * F.lane + 256 * j) = pack4(v);
                if (F8_HB && isx) *(unsigned*)((unsigned char*)F.out + OUT_HB8 + (size_t)row * DM + 4 * F.lane + 256 * j) = cvt4_fp8(v[0], v[1], v[2], v[3]); s += (v[0] * v[0] + v[1] * v[1]) + (v[2] * v[2] + v[3] * v[3]); }
            s = wave_sum(s);
            if (F.lane < 16) sq[F.lane] = (F.lane == 0) ? s : 0.f;
            if (F.lane == 0) (isx ? WSP(float, OFF_RSTDT) : WSP(float, OFF_MRSTD))[row] = 1.0f / sqrtf(s * (1.0f / DM) + EPS);
        }
        float* rope = WSP(float, OFF_ROPE);
        for (int i = F.vcu * 512 + F.tid; i < SEQ * 32; i += F.G * 512) {
            const int pos = i >> 5, fi = i & 31; double th = 1.0;
            for (int k = 0; k < fi; ++k) th *= 0.74989420933245582730;
            const double rev = (double)pos * th * 0.15915494309189533577;
            const double fr = rev - floor(rev);
            const double r = (fr - 0.5) * 6.28318530717958647692;
            const double r2 = r * r; double sn = 1.0, cs = 1.0;
            for (int k = 14; k >= 1; --k) { sn = 1.0 - r2 / (double)((2 * k) * (2 * k + 1)) * sn; cs = 1.0 - r2 / (double)((2 * k - 1) * (2 * k)) * cs; }
            sn *= r;
            rope[pos * 64 + fi] = (float)(-cs); rope[pos * 64 + 32 + fi] = (float)(-sn);
        }
    }
}

template <bool SILU>
__device__ __forceinline__ void conv_rows8(const h16* projcol, long tbase, int n, int r0, const float* cw, int cdim, const float* cb, h16x8 (&out)[8]) {
    f32x4 w[4][2];
#pragma unroll
    for (int k = 0; k < 4; ++k) { w[k][0] = *(const f32x4*)(cw + k * cdim); w[k][1] = *(const f32x4*)(cw + k * cdim + 4); }
    const f32x4 b0 = *(const f32x4*)cb, b1 = *(const f32x4*)(cb + 4);
    h16x8 x[11];
#pragma unroll
    for (int i = 0; i < 11; ++i) { const int pos = n * 128 + r0 - 2 + i; h16x8 z;
#pragma unroll
        for (int e = 0; e < 8; ++e) z[e] = (h16)0.f;
        x[i] = (pos >= 0 && pos < SEQ) ? NTL(h16x8, projcol + (size_t)(tbase + r0 - 2 + i) * NPJ) : z; }
#pragma unroll
    for (int r = 0; r < 8; ++r) {
#pragma unroll
        for (int e = 0; e < 8; ++e) { float a = e < 4 ? b0[e] : b1[e - 4];
#pragma unroll
            for (int k = 0; k < 4; ++k) a += (e < 4 ? w[k][0][e] : w[k][1][e - 4]) * (float)x[r + k][e];
            out[r][e] = (h16)(SILU ? siluf_(a) : a); } }
}
__device__ __forceinline__ h16x8 col_of(const h16x8 (&o)[8], int e) { h16x8 c; c[0] = o[0][e]; c[1] = o[1][e]; c[2] = o[2][e]; c[3] = o[3][e]; c[4] = o[4][e]; c[5] = o[5][e]; c[6] = o[6][e]; c[7] = o[7][e]; return c; }

__device__ __forceinline__ void ret_scan_unit(const Frame& F, int u) {
    const int h = u % 6, b = (u / 6) % NB, dir = u / (6 * NB);
    const float gC = exp2f(128.0f * log1pf(-exp2f(-5.0f - (float)h)) * 1.4426950408889634f);
    h16* base = WSP(h16, OFF_RST) + ((size_t)((dir * NB + b) * NCH) * 6 + h) * 4096 + F.tid * 8;
    float acc[8]; float zf = 0.f; asm volatile("" : "+v"(zf));
#pragma unroll
    for (int e = 0; e < 8; ++e) acc[e] = zf;
    h16x8 sv[16];
#pragma unroll
    for (int i = 0; i < 16; ++i) { const int n = dir == 0 ? i : NCH - 1 - i; sv[i] = *(const h16x8*)(base + (size_t)n * 6 * 4096); }
#pragma unroll
    for (int i = 0; i < 16; ++i) { const int n = dir == 0 ? i : NCH - 1 - i; h16x8 o;
#pragma unroll
        for (int e = 0; e < 8; ++e) { o[e] = (h16)acc[e]; acc[e] = acc[e] * gC + (float)sv[i][e]; }
        *(h16x8*)(base + (size_t)n * 6 * 4096) = o; }
}
#define RET_BAR() do { asm volatile("s_waitcnt lgkmcnt(0)" ::: "memory"); __builtin_amdgcn_s_barrier(); asm volatile("" ::: "memory"); } while (0)
__device__ __forceinline__ void ret_states_block(const Frame& F, int bn) {
    const int n = bn % NCH, b = bn / NCH; const long t0 = (long)b * SEQ + n * 128;
    const int r = F.tid >> 2, c = F.tid & 3;
    const h16* rowp = WSP(const h16, WS_R1) + (size_t)(t0 + r) * NPJ; const float* cs = WSP(const float, OFF_ROPE) + (size_t)(n * 128 + r) * 64 + 8 * c;
    const f32x4 c0 = *(const f32x4*)cs, c1 = *(const f32x4*)(cs + 4), s0 = *(const f32x4*)(cs + 32), s1 = *(const f32x4*)(cs + 36);
    const int dir = F.wave >> 2, dt = F.wave & 3, fr = F.lane & 15, fq = F.lane >> 4;
    h16x8 k1, k2, v1, v2;
#define RS_LOAD(hh) do { k1 = *(const h16x8*)(rowp + CK + (hh) * 64 + 8 * c); k2 = *(const h16x8*)(rowp + CK + (hh) * 64 + 32 + 8 * c); v1 = *(const h16x8*)(rowp + CV + (hh) * 64 + 16 * c); v2 = *(const h16x8*)(rowp + CV + (hh) * 64 + 16 * c + 8); } while (0)
    RS_LOAD(0);
#pragma unroll 1
    for (int h = 0; h < 6; ++h) {
        LAS h16* KT = (LAS h16*)(F.lds + (h & 1) * 34816); LAS h16* VT = KT + 64 * 136;
#pragma unroll
        for (int e = 0; e < 8; ++e) { const float x1 = (float)k1[e], x2 = (float)k2[e], co = e < 4 ? c0[e] : c1[e - 4], si = e < 4 ? s0[e] : s1[e - 4];
            KT[(8 * c + e) * 136 + r] = (h16)((x1 * co - x2 * si) * 0.125f); KT[(32 + 8 * c + e) * 136 + r] = (h16)((x1 * si + x2 * co) * 0.125f); }
#pragma unroll
        for (int e = 0; e < 8; ++e) { VT[(16 * c + e) * 136 + r] = v1[e]; VT[(16 * c + 8 + e) * 136 + r] = v2[e]; }
        if (h < 5) RS_LOAD(h + 1);
        RET_BAR();
        const float l2g = log1pf(-exp2f(-5.0f - (float)h)) * 1.4426950408889634f;
        h16x8 xw[4];
#pragma unroll
        for (int ks = 0; ks < 4; ++ks) { const h16x8 f = ldsfrag(KT + (16 * dt + fr) * 136 + 32 * ks + 8 * fq); h16x8 wv;
#pragma unroll
            for (int jj = 0; jj < 8; ++jj) { const int j = 32 * ks + 8 * fq + jj; wv[jj] = (h16)exp2f(l2g * (float)(dir == 0 ? 127 - j : j)); }
            xw[ks] = f * wv; }
        h16* rst = WSP(h16, OFF_RST) + ((size_t)((dir * NB + b) * NCH + n) * 6 + h) * 4096;
#pragma unroll
        for (int et = 0; et < 4; ++et) { f32x4 acc = {0.f, 0.f, 0.f, 0.f};
#pragma unroll
            for (int ks = 0; ks < 4; ++ks) acc = MFMA16(xw[ks], ldsfrag(VT + (16 * et + fr) * 136 + 32 * ks + 8 * fq), acc);
            *(h16x4*)(rst + (16 * et + fr) * 64 + 16 * dt + 4 * fq) = pack4(acc); }
    }
#undef RS_LOAD
    __syncthreads();
}
__device__ __forceinline__ void ret_out_block(const Frame& F, int bn) {
    const int n = bn % NCH, b = bn / NCH; const long t0 = (long)b * SEQ + n * 128;
    const int r = F.tid >> 2, c = F.tid & 3, rp = kperm32(r), er = F.tid >> 3, d0 = (F.tid & 7) * 8;
    const h16* rowp = WSP(const h16, WS_R1) + (size_t)(t0 + r) * NPJ; const float* cs = WSP(const float, OFF_ROPE) + (size_t)(n * 128 + r) * 64 + 8 * c;
    const f32x4 c0 = *(const f32x4*)cs, c1 = *(const f32x4*)(cs + 4), s0 = *(const f32x4*)(cs + 32), s1 = *(const f32x4*)(cs + 36);
    const int w = F.wave, fr = F.lane & 15, fq = F.lane >> 4, il = 16 * w + fr;
    const h16* grow = WSP(const h16, WS_R1) + (size_t)(t0 + il) * NPJ + CG + 4 * fq; h16* orow = WSP(h16, OFF_OMIX) + (size_t)(t0 + il) * DM + 4 * fq; unsigned char* orow8 = WSP(unsigned char, OFF_OMIX8) + (size_t)(t0 + il) * DM + 4 * fq;
    const h16* st0 = WSP(const h16, OFF_RST) + ((size_t)((0 * NB + b) * NCH + n) * 6) * 4096 + F.tid * 8; const h16* st1 = WSP(const h16, OFF_RST) + ((size_t)((1 * NB + b) * NCH + n) * 6) * 4096 + F.tid * 8;
    h16x8 q1, q2, k1, k2, v1, v2, sf, sb; h16x4 gn[4];
#define RO_LOAD(hh) do { q1 = NTL(h16x8, rowp + CQ + (hh) * 64 + 8 * c); q2 = NTL(h16x8, rowp + CQ + (hh) * 64 + 32 + 8 * c); k1 = NTL(h16x8, rowp + CK + (hh) * 64 + 8 * c); k2 = NTL(h16x8, rowp + CK + (hh) * 64 + 32 + 8 * c); \
        v1 = NTL(h16x8, rowp + CV + (hh) * 64 + 16 * c); v2 = NTL(h16x8, rowp + CV + (hh) * 64 + 16 * c + 8); sf = NTL(h16x8, st0 + (hh) * 4096); sb = NTL(h16x8, st1 + (hh) * 4096); \
        _Pragma("unroll") for (int et_ = 0; et_ < 4; ++et_) gn[et_] = NTL(h16x4, grow + (hh) * 64 + 16 * et_); } while (0)
    RO_LOAD(0);
#pragma unroll 1
    for (int h = 0; h < 6; ++h) {
        LAS h16* Qt = (LAS h16*)(F.lds + (h & 1) * 72704); LAS h16* Kt = Qt + 128 * 72; LAS h16* VT = Kt + 128 * 72; LAS h16* Ff = VT + 64 * 136; LAS h16* Fb = Ff + 64 * 72;
        { h16x8 qa, qb, ka, kb;
#pragma unroll
            for (int e = 0; e < 8; ++e) { const float co = e < 4 ? c0[e] : c1[e - 4], si = e < 4 ? s0[e] : s1[e - 4];
                float x1 = (float)q1[e], x2 = (float)q2[e]; qa[e] = (h16)(x1 * co - x2 * si); qb[e] = (h16)(x1 * si + x2 * co);
                x1 = (float)k1[e]; x2 = (float)k2[e]; ka[e] = (h16)((x1 * co - x2 * si) * 0.125f); kb[e] = (h16)((x1 * si + x2 * co) * 0.125f); }
            *(LAS h16x8*)(Qt + r * 72 + 8 * c) = qa; *(LAS h16x8*)(Qt + r * 72 + 32 + 8 * c) = qb;
            *(LAS h16x8*)(Kt + r * 72 + 8 * c) = ka; *(LAS h16x8*)(Kt + r * 72 + 32 + 8 * c) = kb; }
#pragma unroll
        for (int e = 0; e < 8; ++e) { VT[(16 * c + e) * 136 + rp] = v1[e]; VT[(16 * c + 8 + e) * 136 + rp] = v2[e]; }
        *(LAS h16x8*)(Ff + er * 72 + d0) = sf; *(LAS h16x8*)(Fb + er * 72 + d0) = sb;
        h16x4 gc[4];
#pragma unroll
        for (int et = 0; et < 4; ++et) gc[et] = gn[et];
        if (h < 5) RO_LOAD(h + 1);
        RET_BAR();
        const float l2g = log1pf(-exp2f(-5.0f - (float)h)) * 1.4426950408889634f;
        h16x8 qf[2];
#pragma unroll
        for (int ks = 0; ks < 2; ++ks) qf[ks] = ldsfrag(Qt + il * 72 + 32 * ks + 8 * fq);
        f32x4 s[8];
#pragma unroll
        for (int jt = 0; jt < 8; ++jt) { f32x4 a = {0.f, 0.f, 0.f, 0.f};
#pragma unroll
            for (int ks = 0; ks < 2; ++ks) a = MFMA16(ldsfrag(Kt + (16 * jt + fr) * 72 + 32 * ks + 8 * fq), qf[ks], a);
#pragma unroll
            for (int q = 0; q < 4; ++q) { const int j = 16 * jt + 4 * fq + q; const int dd = il > j ? il - j : j - il; a[q] *= exp2f(l2g * (float)dd); }
            PINV(a); s[jt] = a; }
        f32x4 o[4];
#pragma unroll
        for (int et = 0; et < 4; ++et) o[et] = (f32x4){0.f, 0.f, 0.f, 0.f};
#pragma unroll
        for (int kp = 0; kp < 4; ++kp) { const h16x8 pf = pack8(s[2 * kp], s[2 * kp + 1]);
#pragma unroll
            for (int et = 0; et < 4; ++et) o[et] = MFMA16(ldsfrag(VT + (16 * et + fr) * 136 + 32 * kp + 8 * fq), pf, o[et]); }
        const float gf = exp2f(l2g * (float)(il + 1)), gb = exp2f(l2g * (float)(128 - il));
#pragma unroll
        for (int ks = 0; ks < 2; ++ks) { const h16x8 qff = scalefrag(qf[ks], gf), qfb = scalefrag(qf[ks], gb);
#pragma unroll
            for (int et = 0; et < 4; ++et) { o[et] = MFMA16(ldsfrag(Ff + (16 * et + fr) * 72 + 32 * ks + 8 * fq), qff, o[et]); o[et] = MFMA16(ldsfrag(Fb + (16 * et + fr) * 72 + 32 * ks + 8 * fq), qfb, o[et]); } }
        float ss = 0.f;
#pragma unroll
        for (int et = 0; et < 4; ++et) ss += (o[et][0] * o[et][0] + o[et][1] * o[et][1]) + (o[et][2] * o[et][2] + o[et][3] * o[et][3]);
        ss += __shfl_xor(ss, 16); ss += __shfl_xor(ss, 32);
        const float rs = 1.0f / sqrtf(ss * (1.0f / 64.0f) + EPS);
#pragma unroll
        for (int et = 0; et < 4; ++et) { f32x4 q;
#pragma unroll
            for (int e = 0; e < 4; ++e) q[e] = o[et][e] * rs * siluf_((float)gc[et][e]);
            if (F8_OUT) *(unsigned*)(orow8 + h * 64 + 16 * et) = cvt4_fp8(8.f * q[0], 8.f * q[1], 8.f * q[2], 8.f * q[3]);
            else *(h16x4*)(orow + h * 64 + 16 * et) = pack4(q); }
    }
#undef RO_LOAD
    __syncthreads();
}
#undef RET_BAR

__device__ __forceinline__ void ssd_stage_dt(const Frame& F, const Prm& p, int l, int g, long t0, LAS float* LA, LAS float* DTS) {
    if (F.tid < 128) { const h16* dp = WSP(const h16, WS_R1) + (size_t)(t0 + F.tid) * NPJ + CDT + g * 3;
#pragma unroll
        for (int r = 0; r < 3; ++r) { const float raw = (float)dp[r];
#pragma unroll
            for (int dir = 0; dir < 2; ++dir) { const float dt = softplusf_(raw + inptr(F, 7)[(l * 2 + dir) * 6 + g * 3 + r]); const float la = -dt * __expf(inptr(F, 8)[(l * 2 + dir) * 6 + g * 3 + r]);
                DTS[(dir * 3 + r) * 128 + F.tid] = dt; LA[(dir * 3 + r) * 128 + F.tid] = la; } } }
}
__device__ __forceinline__ void ssd_cumsum(const Frame& F, LAS const float* LAq, float& v0, float& v1, float& c0, float& c1, float& tot) {
    v0 = LAq[2 * F.lane]; v1 = LAq[2 * F.lane + 1]; float s = v0 + v1;
#pragma unroll
    for (int o = 1; o < 64; o <<= 1) { const float t = __shfl_up(s, o); if (F.lane >= o) s += t; }
    c1 = s; c0 = s - v1; tot = __shfl(s, 63);
}
__device__ __forceinline__ void ssd_states_unit(const Frame& F, const Prm& p, int l, int u) {
    const int g = u & 1, bn = u >> 1, n = bn % NCH, b = bn / NCH; const long t0 = (long)b * SEQ + n * 128;
    const h16* proj = WSP(const h16, WS_R1);
    LAS h16* XT = (LAS h16*)F.lds; LAS h16* BT = XT + 3 * 64 * 136; LAS float* LA = (LAS float*)(BT + 128 * 136); LAS float* DTS = LA + 6 * 128; LAS float* WW = DTS + 6 * 128;
    ssd_stage_dt(F, p, l, g, t0, LA, DTS);
    const float* cw = inptr(F, 5) + (size_t)l * 4 * 896; const float* cb = inptr(F, 6) + (size_t)l * 896;
    h16* bcn = ((h16*)((unsigned char*)F.out + OUT_BCN));
    for (int task = F.tid; task < 56 * 16; task += 512) { const int cg = task % 56, r0 = (task / 56) * 8; h16x8 o[8];
        if (cg < 24) { conv_rows8<true>(proj + CXS + g * 192 + 8 * cg, t0, n, r0, cw + g * 192 + 8 * cg, 896, cb + g * 192 + 8 * cg, o);
            LAS h16* d = XT + (cg >> 3) * 64 * 136 + ((cg & 7) * 8) * 136 + r0;
#pragma unroll
            for (int e = 0; e < 8; ++e) *(LAS h16x8*)(d + e * 136) = col_of(o, e);
        } else { const int c8 = (cg - 24) & 15; const bool isB = cg < 40; const int col = (isB ? CBM : CCM) + g * 128 + 8 * c8, ci = (isB ? 384 : 640) + g * 128 + 8 * c8;
            conv_rows8<true>(proj + col, t0, n, r0, cw + ci, 896, cb + ci, o);
#pragma unroll
            for (int r = 0; r < 8; ++r) *(h16x8*)(bcn + (size_t)(t0 + r0 + r) * 512 + (isB ? 0 : 256) + g * 128 + 8 * c8) = o[r];
            if (isB) { LAS h16* d = BT + (8 * c8) * 136 + r0;
#pragma unroll
                for (int e = 0; e < 8; ++e) *(LAS h16x8*)(d + e * 136) = col_of(o, e); } } }
    __syncthreads();
    { h16* xtg = ((h16*)((unsigned char*)F.out + OUT_XTG)) + ((size_t)(b * NCH + n) * 6 + g * 3) * 8192;
#pragma unroll
        for (int k = 0; k < 6; ++k) { const int it = F.tid + 512 * k, rr = it >> 4, c = it & 15; const h16x8 v = *(LAS const h16x8*)(XT + rr * 136 + 8 * c);
            *(h16x4*)(xtg + rr * 128 + kperm32(8 * c)) = __builtin_shufflevector(v, v, 0, 1, 2, 3); *(h16x4*)(xtg + rr * 128 + kperm32(8 * c + 4)) = __builtin_shufflevector(v, v, 4, 5, 6, 7); } }
    if (F.wave < 6) { const int q = F.wave, dir = q / 3, r = q % 3; float v0, v1, c0, c1, tot; ssd_cumsum(F, LA + q * 128, v0, v1, c0, c1, tot);
        const float d0 = DTS[q * 128 + 2 * F.lane], d1 = DTS[q * 128 + 2 * F.lane + 1];
        if (dir == 0) { WW[q * 128 + 2 * F.lane] = __expf(tot - c0) * d0 * 256.f; WW[q * 128 + 2 * F.lane + 1] = __expf(tot - c1) * d1 * 256.f; }
        else { WW[q * 128 + 2 * F.lane] = __expf(c0 - v0) * d0 * 256.f; WW[q * 128 + 2 * F.lane + 1] = __expf(c1 - v1) * d1 * 256.f; }
        if (F.lane == 0) WSP(float, OFF_SDEC)[((size_t)(b * NCH + n) * 6 + g * 3 + r) * 2 + dir] = tot; }
    __syncthreads();
    const int w = F.wave, fr = F.lane & 15, fq = F.lane >> 4;
    h16x8 xb[4];
#pragma unroll
    for (int ks = 0; ks < 4; ++ks) xb[ks] = ldsfrag(BT + (16 * w + fr) * 136 + 32 * ks + 8 * fq);
    for (int q = 0; q < 6; ++q) { const int dir = q / 3, r = q % 3;
        h16x8 wf[4];
#pragma unroll
        for (int ks = 0; ks < 4; ++ks) { const f32x4 a = *(LAS const f32x4*)(WW + q * 128 + 32 * ks + 8 * fq), c = *(LAS const f32x4*)(WW + q * 128 + 32 * ks + 8 * fq + 4); wf[ks] = pack8(a, c); }
        h16* sst = WSP(h16, OFF_SST) + ((size_t)((dir * NB + b) * NCH + n) * 6 + g * 3 + r) * 8192;
#pragma unroll
        for (int pt = 0; pt < 4; ++pt) { f32x4 acc = {0.f, 0.f, 0.f, 0.f};
#pragma unroll
            for (int ks = 0; ks < 4; ++ks) acc = MFMA16(xb[ks], ldsfrag(XT + r * 64 * 136 + (16 * pt + fr) * 136 + 32 * ks + 8 * fq) * wf[ks], acc);
            *(h16x4*)(sst + (16 * pt + fr) * 128 + 16 * w + 4 * fq) = pack4(acc * (1.0f / 256.f)); } }
    __syncthreads();
}
__device__ __forceinline__ void ssd_scan_unit(const Frame& F, int uh) {
    const int u = uh >> 1, hd = u % 6, b = (u / 6) % NB, dir = u / (6 * NB);
    h16* base = WSP(h16, OFF_SST) + ((size_t)((dir * NB + b) * NCH) * 6 + hd) * 8192 + (uh & 1) * 4096 + F.tid * 8;
    const float* dbase = WSP(const float, OFF_SDEC) + ((size_t)(b * NCH) * 6 + hd) * 2 + dir;
    float acc[8]; float zf = 0.f; asm volatile("" : "+v"(zf));
#pragma unroll
    for (int e = 0; e < 8; ++e) acc[e] = zf;
    h16x8 sv[16]; float dec[16];
#pragma unroll
    for (int i = 0; i < 16; ++i) { const int n = dir == 0 ? i : NCH - 1 - i; sv[i] = *(const h16x8*)(base + (size_t)n * 6 * 8192); dec[i] = dbase[n * 12]; }
#pragma unroll
    for (int i = 0; i < 16; ++i) { const int n = dir == 0 ? i : NCH - 1 - i; const float dc = __expf(dec[i]); h16x8 o;
#pragma unroll
        for (int e = 0; e < 8; ++e) { o[e] = (h16)acc[e]; acc[e] = acc[e] * dc + (float)sv[i][e]; }
        *(h16x8*)(base + (size_t)n * 6 * 8192) = o; }
}
__device__ __forceinline__ void ssd_out_unit(const Frame& F, const Prm& p, int l, int u) {
    const int g = u & 1, bn = u >> 1, n = bn % NCH, b = bn / NCH; const long t0 = (long)b * SEQ + n * 128;
    const h16* proj = WSP(const h16, WS_R1);
    LAS h16* XT = (LAS h16*)F.lds; LAS h16* Bt = XT + 3 * 64 * 136; LAS h16* Ct = Bt + 128 * 136; LAS float* LA = (LAS float*)(Ct + 128 * 136); LAS float* DTS = LA + 6 * 128;
    LAS float* CE = DTS + 6 * 128;
    LAS float* TOTB = CE + 6 * 128;
    ssd_stage_dt(F, p, l, g, t0, LA, DTS);
    const float* cw = inptr(F, 5) + (size_t)l * 4 * 896; const float* cb = inptr(F, 6) + (size_t)l * 896;
    { const h16* xtg = ((const h16*)((const unsigned char*)F.out + OUT_XTG)) + ((size_t)(b * NCH + n) * 6 + g * 3) * 8192; const h16* bcn = ((const h16*)((const unsigned char*)F.out + OUT_BCN)) + (size_t)t0 * 512 + g * 128;
        h16x8 xv[6], bv[8];
#pragma unroll
        for (int k = 0; k < 6; ++k) { const int it = F.tid + 512 * k; xv[k] = NTL(h16x8, xtg + (it >> 4) * 128 + 8 * (it & 15)); }
#pragma unroll
        for (int k = 0; k < 8; ++k) { const int it = F.tid + 512 * k, row = it >> 5, c = it & 31; bv[k] = NTL(h16x8, bcn + (size_t)row * 512 + (c < 16 ? 8 * c : 256 + 8 * (c - 16))); }
#pragma unroll
        for (int k = 0; k < 6; ++k) { const int it = F.tid + 512 * k; *(LAS h16x8*)(XT + (it >> 4) * 136 + 8 * (it & 15)) = xv[k]; }
#pragma unroll
        for (int k = 0; k < 8; ++k) { const int it = F.tid + 512 * k, row = it >> 5, c = it & 31; *(LAS h16x8*)((c < 16 ? Bt : Ct) + row * 136 + 8 * (c & 15)) = bv[k]; }
        PIN(); }
    __syncthreads();
    if (F.wave < 6) { const int q = F.wave; float v0, v1, c0, c1, tot; ssd_cumsum(F, LA + q * 128, v0, v1, c0, c1, tot);
        if (q < 3) { CE[q * 128 + 2 * F.lane] = c0; CE[q * 128 + 2 * F.lane + 1] = c1; }
        else { CE[q * 128 + 2 * F.lane] = c0 - v0; CE[q * 128 + 2 * F.lane + 1] = c1 - v1; if (F.lane == 0) TOTB[q - 3] = tot; } }
    __syncthreads();
    const int w = F.wave, fr = F.lane & 15, fq = F.lane >> 4, il = 16 * w + fr;
    h16x8 cf[4];
#pragma unroll
    for (int ks = 0; ks < 4; ++ks) cf[ks] = ldsfrag(Ct + il * 136 + 32 * ks + 8 * fq);
    f32x4 gT[8];
#pragma unroll
    for (int jt = 0; jt < 8; ++jt) { f32x4 a = {0.f, 0.f, 0.f, 0.f};
#pragma unroll
        for (int ks = 0; ks < 4; ++ks) a = MFMA16(ldsfrag(Bt + (16 * jt + fr) * 136 + 32 * ks + 8 * fq), cf[ks], a);
        PINV(a); gT[jt] = a; }
    const float* dsk = inptr(F, 9) + l * 6 + g * 3;
    h16* orow = WSP(h16, OFF_OMIX) + (size_t)(t0 + il) * DM + 384 + g * 192;
    float ss = 0.f;
    { h16x8 h0[4];
#pragma unroll
        for (int k = 0; k < 4; ++k) { const int it = F.tid + 512 * k, dir = it >> 10, e = it & 1023; h0[k] = NTL(h16x8, WSP(const h16, OFF_SST) + ((size_t)((dir * NB + b) * NCH + n) * 6 + g * 3) * 8192 + e * 8); }
        __syncthreads();
#pragma unroll
        for (int k = 0; k < 4; ++k) { const int it = F.tid + 512 * k, dir = it >> 10, e = it & 1023; *(LAS h16x8*)(Bt + dir * 64 * 136 + (e >> 4) * 136 + 8 * (e & 15)) = h0[k]; }
        __syncthreads(); }
#pragma unroll 1
    for (int r = 0; r < 3; ++r) {
        f32x4 y[1][4];
        const int hd = g * 3 + r;
        const float cfi = CE[r * 128 + il], ebi = CE[(3 + r) * 128 + il], totb = TOTB[r];
#pragma unroll
        for (int pt = 0; pt < 4; ++pt) y[0][pt] = (f32x4){0.f, 0.f, 0.f, 0.f};
        LAS const h16* HL = (r & 1) ? Ct : Bt;
        h16x8 hreg[4];
        if (r < 2) {
#pragma unroll
            for (int k = 0; k < 4; ++k) { const int it = F.tid + 512 * k, dir = it >> 10, e = it & 1023; hreg[k] = NTL(h16x8, WSP(const h16, OFF_SST) + ((size_t)((dir * NB + b) * NCH + n) * 6 + hd + 1) * 8192 + e * 8); } }
#pragma unroll
        for (int kp = 0; kp < 4; ++kp) { f32x4 pv[2];
#pragma unroll
            for (int jh = 0; jh < 2; ++jh) { const int jt = 2 * kp + jh, j0 = 16 * jt + 4 * fq;
                const f32x4 cfj = *(LAS const f32x4*)(CE + r * 128 + j0), ebj = *(LAS const f32x4*)(CE + (3 + r) * 128 + j0), dfj = *(LAS const f32x4*)(DTS + r * 128 + j0), dbj = *(LAS const f32x4*)(DTS + (3 + r) * 128 + j0);
#pragma unroll
                for (int e = 0; e < 4; ++e) { const int j = j0 + e; const float val = (il >= j) ? __expf(cfi - cfj[e]) * dfj[e] : __expf(ebj[e] - ebi) * dbj[e]; pv[jh][e] = gT[jt][e] * val * 256.f; }
                PINV(pv[jh]); }
            const h16x8 pf = pack8(pv[0], pv[1]);
#pragma unroll
            for (int pt = 0; pt < 4; ++pt) y[0][pt] = MFMA16(ldsfrag(XT + r * 64 * 136 + (16 * pt + fr) * 136 + 32 * kp + 8 * fq), pf, y[0][pt]);
            PINV(y[0][0]); PINV(y[0][1]); PINV(y[0][2]); PINV(y[0][3]); }
        const float ef = __expf(cfi) * 256.f, eb = __expf(totb - ebi) * 256.f;
#pragma unroll
        for (int ks = 0; ks < 4; ++ks) { const h16x8 cff = scalefrag(cf[ks], ef), cfb = scalefrag(cf[ks], eb);
#pragma unroll
            for (int pt = 0; pt < 4; ++pt) { y[0][pt] = MFMA16(ldsfrag(HL + (16 * pt + fr) * 136 + 32 * ks + 8 * fq), cff, y[0][pt]); y[0][pt] = MFMA16(ldsfrag(HL + 64 * 136 + (16 * pt + fr) * 136 + 32 * ks + 8 * fq), cfb, y[0][pt]); }
            PINV(y[0][0]); PINV(y[0][1]); PINV(y[0][2]); PINV(y[0][3]); }
        if (r < 2) { LAS h16* HN = (r & 1) ? Bt : Ct;
#pragma unroll
            for (int k = 0; k < 4; ++k) { const int it = F.tid + 512 * k, dir = it >> 10, e = it & 1023; *(LAS h16x8*)(HN + dir * 64 * 136 + (e >> 4) * 136 + 8 * (e & 15)) = hreg[k]; } }
        const float dk = dsk[r]; const h16* zrow = proj + (size_t)(t0 + il) * NPJ + CZ + hd * 64;
#pragma unroll
        for (int pt = 0; pt < 4; ++pt) { const h16x4 zv = NTL(h16x4, zrow + 16 * pt + 4 * fq);
#pragma unroll
            for (int e = 0; e < 4; ++e) { const float xv = (float)XT[r * 64 * 136 + (16 * pt + 4 * fq + e) * 136 + kperm32(il)]; y[0][pt][e] = (y[0][pt][e] * (1.0f / 256.f) + dk * xv) * siluf_((float)zv[e]); }
            const h16x4 yh = pack4(y[0][pt]); *(h16x4*)(orow + r * 64 + 16 * pt + 4 * fq) = yh;
#pragma unroll
            for (int e = 0; e < 4; ++e) { const float q = (float)yh[e]; ss += q * q; } }
        __syncthreads();
    }
    ss += __shfl_xor(ss, 16); ss += __shfl_xor(ss, 32);
    const float rs = 1.0f / sqrtf(ss * (1.0f / 192.0f) + EPS);
    const float* nw = inptr(F, 10) + l * 384 + g * 192;
    asm volatile("s_waitcnt vmcnt(0)" ::: "memory");
#pragma unroll 1
    for (int r = 0; r < 3; ++r)
#pragma unroll
        for (int pt = 0; pt < 4; ++pt) { const f32x4 wv = *(const f32x4*)(nw + r * 64 + 16 * pt + 4 * fq); h16* op = orow + r * 64 + 16 * pt + 4 * fq; const h16x4 yh = *(const h16x4*)op; f32x4 yv;
#pragma unroll
            for (int e = 0; e < 4; ++e) yv[e] = (float)yh[e] * rs * wv[e];
            if (F8_OUT) *(unsigned*)(WSP(unsigned char, OFF_OMIX8) + (size_t)(t0 + il) * DM + 384 + g * 192 + r * 64 + 16 * pt + 4 * fq) = cvt4_fp8(8.f * yv[0], 8.f * yv[1], 8.f * yv[2], 8.f * yv[3]);
            else *(h16x4*)op = pack4(yv); }
    __syncthreads();
}

__device__ __forceinline__ void lru_unit(const Frame& F, const Prm& p, int l, int u) {
    const int n = u % NCH, b = u / NCH; const long t0 = (long)b * SEQ + n * 128;
    const h16* proj = WSP(const h16, WS_R1);
    LAS h16* XC = (LAS h16*)F.lds;
    const float* cw = inptr(F, 11) + (size_t)l * 4 * 256; const float* cb = inptr(F, 12) + (size_t)l * 256;
    { const int cg = F.tid & 31, r0 = (F.tid >> 5) * 8; h16x8 o[8];
        conv_rows8<false>(proj + CXR + 8 * cg, t0, n, r0, cw + 8 * cg, 256, cb + 8 * cg, o);
#pragma unroll
        for (int r = 0; r < 8; ++r) *(LAS h16x8*)(XC + (r0 + r) * 264 + 8 * cg) = o[r]; }
    __syncthreads();
    const int blk = F.wave & 3, jh = F.wave >> 2, fr = F.lane & 15, fq = F.lane >> 4;
    h16* lau = (h16*)((unsigned char*)F.out + OUT_LAU) + (size_t)(b * NCH + n) * 2 * 128 * 256 * 2;
    h16x8 wa[2][2][2], wx[2][2][2]; float ba[2][2], bx[2][2], sp[2][2], car[2][2], atot[2][2];
#pragma unroll
    for (int dir = 0; dir < 2; ++dir)
#pragma unroll
        for (int jt = 0; jt < 2; ++jt) { const int ch = blk * 64 + 32 * jh + 16 * jt + fr;
#pragma unroll
            for (int ks = 0; ks < 2; ++ks) { wa[dir][jt][ks] = *(const h16x8*)(WSP(const h16, WS_LRUW) + (size_t)((dir * 2 + 0) * 4 + blk) * 4096 + (32 * jh + 16 * jt + fr) * 64 + 32 * ks + 8 * fq);
                wx[dir][jt][ks] = *(const h16x8*)(WSP(const h16, WS_LRUW) + (size_t)((dir * 2 + 1) * 4 + blk) * 4096 + (32 * jh + 16 * jt + fr) * 64 + 32 * ks + 8 * fq); }
            ba[dir][jt] = inptr(F, 15)[(l * 2 + dir) * 256 + ch]; bx[dir][jt] = inptr(F, 17)[(l * 2 + dir) * 256 + ch]; sp[dir][jt] = softplusf_(-inptr(F, 13)[(l * 2 + dir) * 256 + ch]);
            car[dir][jt] = 0.f; atot[dir][jt] = 1.f; }
#pragma unroll 1
    for (int ti = 0; ti < 8; ++ti) {
#pragma unroll
        for (int dir = 0; dir < 2; ++dir) { const int tt = dir == 0 ? ti : 7 - ti;
            h16x8 xf[2];
#pragma unroll
            for (int ks = 0; ks < 2; ++ks) xf[ks] = ldsfrag(XC + (16 * tt + fr) * 264 + blk * 64 + 32 * ks + 8 * fq);
#pragma unroll
            for (int jt = 0; jt < 2; ++jt) { const int ch = blk * 64 + 32 * jh + 16 * jt + fr;
                f32x4 ra = {0.f, 0.f, 0.f, 0.f}, ia = {0.f, 0.f, 0.f, 0.f};
#pragma unroll
                for (int ks = 0; ks < 2; ++ks) { ra = MFMA16(xf[ks], wa[dir][jt][ks], ra); ia = MFMA16(xf[ks], wx[dir][jt][ks], ia); }
                float A = 1.f, H = 0.f;
#pragma unroll
                for (int ri = 0; ri < 4; ++ri) { const int rg = dir == 0 ? ri : 3 - ri;
                    const float e1 = 1.0f + __expf(-(ra[rg] + ba[dir][jt])), e2 = 1.0f + __expf(-(ia[rg] + bx[dir][jt])); const float inv = __builtin_amdgcn_rcpf(e1 * e2);
                    const float rgate = inv * e2, ig = inv * e1;
                    const float la = -8.0f * rgate * sp[dir][jt]; const float a = __expf(la); const float y = 2.0f * la;
                    const float om = y > -0.1f ? -y * (1.0f + y * (0.5f + y * (1.0f / 6.0f))) : 1.0f - a * a;
                    const float mult = __builtin_amdgcn_sqrtf(om);
                    const float xv = (float)XC[(16 * tt + 4 * fq + rg) * 264 + ch]; const float uu = mult * ig * xv;
                    H = a * H + uu; A *= a;
                    { h16x2 pk; pk[0] = (h16)la; pk[1] = (h16)uu; *(h16x2*)(lau + ((size_t)dir * 128 + 16 * tt + 4 * fq + rg) * 256 * 2 + 2 * ch) = pk; } }
                float Ag[4], Hg[4];
#pragma unroll
                for (int gq = 0; gq < 4; ++gq) { Ag[gq] = __shfl(A, fr + 16 * gq); Hg[gq] = __shfl(H, fr + 16 * gq); }
                float cnew = car[dir][jt], at = 1.f;
#pragma unroll
                for (int gi = 0; gi < 4; ++gi) { const int gq = dir == 0 ? gi : 3 - gi;
                    cnew = Ag[gq] * cnew + Hg[gq]; at *= Ag[gq]; }
                car[dir][jt] = cnew; atot[dir][jt] *= at;
            } } }
    if (fq == 0) {
#pragma unroll
        for (int dir = 0; dir < 2; ++dir)
#pragma unroll
            for (int jt = 0; jt < 2; ++jt) { const int ch = blk * 64 + 32 * jh + 16 * jt + fr; *(f32x2*)(WSP(float, OFF_LSUM) + (((size_t)(b * NCH + n) * 2 + dir) * 256 + ch) * 2) = (f32x2){atot[dir][jt], car[dir][jt]}; } }
    __syncthreads();
}
__device__ __forceinline__ void lru_out_unit(const Frame& F, int u) {
    const int n = u % NCH, b = u / NCH; const long t0 = (long)b * SEQ + n * 128;
    const h16* proj = WSP(const h16, WS_R1);
    LAS h16* HT = (LAS h16*)F.lds;
    const int blk = F.wave & 3, jh = F.wave >> 2, fr = F.lane & 15, fq = F.lane >> 4;
    const h16* lau = (const h16*)((const unsigned char*)F.out + OUT_LAU) + (size_t)(b * NCH + n) * 2 * 128 * 256 * 2;
    float car[2][2];
#pragma unroll
    for (int dir = 0; dir < 2; ++dir)
#pragma unroll
        for (int jt = 0; jt < 2; ++jt) car[dir][jt] = WSP(const float, OFF_LCAR)[((size_t)(b * NCH + n) * 2 + dir) * 256 + blk * 64 + 32 * jh + 16 * jt + fr];
#pragma unroll 1
    for (int ti = 0; ti < 8; ++ti) {
#pragma unroll
        for (int dir = 0; dir < 2; ++dir) { const int tt = dir == 0 ? ti : 7 - ti;
            h16x2 pk[2][4]; h16 gtv[2][4], ov[2][4];
#pragma unroll
            for (int jt = 0; jt < 2; ++jt)
#pragma unroll
                for (int rg = 0; rg < 4; ++rg) { const int tl = 16 * tt + 4 * fq + rg, ch = blk * 64 + 32 * jh + 16 * jt + fr;
                    pk[jt][rg] = NTL(h16x2, lau + ((size_t)dir * 128 + tl) * 256 * 2 + 2 * ch); gtv[jt][rg] = NTL(h16, proj + (size_t)(t0 + tl) * NPJ + CGT + ch); ov[jt][rg] = ti >= 4 ? HT[tl * 264 + ch] : (h16)0.f; }
#pragma unroll
            for (int jt = 0; jt < 2; ++jt) { const int ch = blk * 64 + 32 * jh + 16 * jt + fr;
                float av[4], uv[4]; float A = 1.f, H = 0.f;
#pragma unroll
                for (int ri = 0; ri < 4; ++ri) { const int rg = dir == 0 ? ri : 3 - ri; const float a = __expf((float)pk[jt][rg][0]); const float uu = (float)pk[jt][rg][1]; av[rg] = a; uv[rg] = uu; H = a * H + uu; A *= a; }
                float Ag[4], Hg[4];
#pragma unroll
                for (int gq = 0; gq < 4; ++gq) { Ag[gq] = __shfl(A, fr + 16 * gq); Hg[gq] = __shfl(H, fr + 16 * gq); }
                float hin = car[dir][jt], cnew = car[dir][jt];
#pragma unroll
                for (int gi = 0; gi < 4; ++gi) { const int gq = dir == 0 ? gi : 3 - gi; const bool before = dir == 0 ? (gq < fq) : (gq > fq);
                    if (before) hin = Ag[gq] * hin + Hg[gq];
                    cnew = Ag[gq] * cnew + Hg[gq]; }
                car[dir][jt] = cnew;
                float hh = hin;
#pragma unroll
                for (int ri = 0; ri < 4; ++ri) { const int rg = dir == 0 ? ri : 3 - ri; hh = av[rg] * hh + uv[rg];
                    HT[(16 * tt + 4 * fq + rg) * 264 + ch] = (h16)((float)ov[jt][rg] + hh * gelu_tanh_((float)gtv[jt][rg])); } } } }
    __syncthreads();
#pragma unroll
    for (int k = 0; k < 8; ++k) { const int it = F.tid + 512 * k, row = it >> 5, c8 = it & 31; const h16x8 hv = *(LAS const h16x8*)(HT + row * 264 + 8 * c8);
        if (F8_OUT) *(u32x2*)(WSP(unsigned char, OFF_OMIX8) + (size_t)(t0 + row) * DM + 768 + 8 * c8) = (u32x2){cvt4_fp8(8.f * (float)hv[0], 8.f * (float)hv[1], 8.f * (float)hv[2], 8.f * (float)hv[3]), cvt4_fp8(8.f * (float)hv[4], 8.f * (float)hv[5], 8.f * (float)hv[6], 8.f * (float)hv[7])};
        else *(h16x8*)(WSP(h16, OFF_OMIX) + (size_t)(t0 + row) * DM + 768 + 8 * c8) = hv; }
    __syncthreads();
}
__device__ __forceinline__ void lru_scan(const Frame& F, int blk) {
    const int gi = blk * 512 + F.tid; if (blk < 0 || gi >= NB * 2 * 256) return;
    const int ch = gi & 255, dir = (gi >> 8) & 1, b = gi >> 9; float H = 0.f;
    for (int i = 0; i < NCH; ++i) { const int n = dir == 0 ? i : NCH - 1 - i; const size_t idx = ((size_t)(b * NCH + n) * 2 + dir) * 256 + ch;
        const f32x2 s = *(const f32x2*)(WSP(const float, OFF_LSUM) + idx * 2); WSP(float, OFF_LCAR)[idx] = H; H = s[0] * H + s[1]; }
}

__device__ __forceinline__ void attn_phase(const Frame& F) {
    constexpr int NU = NB * 4 * 8;
    LAS unsigned char* B0 = F.lds; LAS unsigned char* B1 = F.lds + 67584;
    int u = F.vcu; if (u >= NU) return;
    int lanel = F.lane; asm volatile("" : "+v"(lanel)); int fr = lanel & 15, fq = lanel >> 4;
    const int w = F.wave;
    h16x8 qf[2][8];
#define AT_DMA(buf, src, rowstride) do { asm volatile("" : "+v"(lanel)); if (lanel < 32) { _Pragma("unroll") for (int i_ = 0; i_ < 16; ++i_) \
        __builtin_amdgcn_global_load_lds((const unsigned*)((src) + (size_t)(16 * w + i_) * (rowstride) + 8 * lanel), (LAS unsigned*)((buf) + (16 * w + i_) * 528), 16, 0, 0); } } while (0)
#define AT_FRAG(buf, row, chunk) (*(LAS const h16x8*)((buf) + (row) * 528 + (chunk) * 16))
#define AT_WAITBAR() do { asm volatile("s_waitcnt vmcnt(0) lgkmcnt(0)" ::: "memory"); __builtin_amdgcn_s_barrier(); asm volatile("" ::: "memory"); } while (0)
#define AT_LOADQ(uu) do { _Pragma("unroll") for (int a_ = 0; a_ < 2; ++a_) { const long t_ = (long)((uu) >> 5) * SEQ + ((uu) & 7) * 256 + 32 * w + 16 * a_ + fr; const h16* q_ = WSP(const h16, OFF_QCA) + (size_t)t_ * DM + (((uu) >> 3) & 3) * 256; \
        _Pragma("unroll") for (int ks_ = 0; ks_ < 8; ++ks_) qf[a_][ks_] = NTL(h16x8, q_ + 32 * ks_ + 8 * fq); } } while (0)
    { const int b = u >> 5, hd = (u >> 3) & 3; AT_DMA(B0, WSP(const h16, OFF_KB) + (size_t)(b * 256) * DM + hd * 256, DM); }
    for (; u < NU; u += F.G) {
        const int qb = u & 7, hd = (u >> 3) & 3, b = u >> 5; const int un = u + F.G; const bool has_next = un < NU;
        asm volatile("" : "+v"(lanel)); fr = lanel & 15; fq = lanel >> 4;
        const h16* kb = WSP(const h16, OFF_KB) + (size_t)(b * 256) * DM + hd * 256; const h16* vt = WSP(const h16, OFF_VT) + (size_t)(b * 4 + hd) * 65536;
        AT_LOADQ(u);
        h16x8 pf[2][8]; float mq[2][4], Mr[2] = {-3.0e38f, -3.0e38f}, Lr[2] = {0.f, 0.f};
#pragma unroll
        for (int h = 0; h < 2; ++h) {
            AT_WAITBAR();
            if (h == 0) AT_DMA(B1, kb + (size_t)128 * DM, DM); else AT_DMA(B0, vt, 256);
            LAS const unsigned char* KB_ = h == 0 ? B0 : B1;
#pragma unroll
            for (int jh = 0; jh < 2; ++jh) { const int qd = 2 * h + jh; f32x4 s[2][4]; h16x8 kf[2][4];
#pragma unroll
                for (int j4 = 0; j4 < 4; ++j4) { s[0][j4] = (f32x4){0.f, 0.f, 0.f, 0.f}; s[1][j4] = (f32x4){0.f, 0.f, 0.f, 0.f}; kf[0][j4] = AT_FRAG(KB_, 16 * (4 * jh + j4) + fr, fq); }
#pragma unroll
                for (int ks = 0; ks < 8; ++ks) {
                    if (ks < 7) {
#pragma unroll
                        for (int j4 = 0; j4 < 4; ++j4) kf[(ks + 1) & 1][j4] = AT_FRAG(KB_, 16 * (4 * jh + j4) + fr, 4 * (ks + 1) + fq); }
                    PIN();
#pragma unroll
                    for (int j4 = 0; j4 < 4; ++j4) { s[0][j4] = MFMA16(kf[ks & 1][j4], qf[0][ks], s[0][j4]); s[1][j4] = MFMA16(kf[ks & 1][j4], qf[1][ks], s[1][j4]); }
                    PINV(s[0][0]); PINV(s[1][3]); }
#pragma unroll
                for (int a = 0; a < 2; ++a) { float mx = fmaxf(fmaxf(s[a][0][0], s[a][0][1]), fmaxf(s[a][0][2], s[a][0][3]));
#pragma unroll
                    for (int jt = 1; jt < 4; ++jt) mx = fmaxf(mx, fmaxf(fmaxf(s[a][jt][0], s[a][jt][1]), fmaxf(s[a][jt][2], s[a][jt][3])));
                    mx = fmaxf(mx, __shfl_xor(mx, 16)); mx = fmaxf(mx, __shfl_xor(mx, 32));
                    float sum = 0.f;
#pragma unroll
                    for (int jt = 0; jt < 4; ++jt)
#pragma unroll
                        for (int e = 0; e < 4; ++e) { const float pe = __expf(s[a][jt][e] - mx); s[a][jt][e] = pe; sum += pe; }
                    sum += __shfl_xor(sum, 16); sum += __shfl_xor(sum, 32);
                    mq[a][qd] = mx; { const float Mn = fmaxf(Mr[a], mx); Lr[a] = Lr[a] * __expf(Mr[a] - Mn) + sum * __expf(mx - Mn); Mr[a] = Mn; }
                    pf[a][2 * qd] = pack8(s[a][0], s[a][1]); pf[a][2 * qd + 1] = pack8(s[a][2], s[a][3]); } }
        }
#pragma unroll
        for (int a = 0; a < 2; ++a) { const float inv = 1.0f / Lr[a];
#pragma unroll
            for (int q = 0; q < 4; ++q) { const float cq = __expf(mq[a][q] - Mr[a]) * inv; pf[a][2 * q] = scalefrag(pf[a][2 * q], cq); pf[a][2 * q + 1] = scalefrag(pf[a][2 * q + 1], cq); } }
#pragma unroll
        for (int d = 0; d < 2; ++d) {
            AT_WAITBAR();
            if (d == 0) AT_DMA(B1, vt + (size_t)128 * 256, 256);
            else if (has_next) AT_DMA(B0, WSP(const h16, OFF_KB) + (size_t)((un >> 5) * 256) * DM + ((un >> 3) & 3) * 256, DM);
            LAS const unsigned char* VB_ = d == 0 ? B0 : B1;
#pragma unroll
            for (int eh = 0; eh < 2; ++eh) { f32x4 o[2][4]; h16x8 vf[2][4];
#pragma unroll
                for (int e4 = 0; e4 < 4; ++e4) { o[0][e4] = (f32x4){0.f, 0.f, 0.f, 0.f}; o[1][e4] = (f32x4){0.f, 0.f, 0.f, 0.f}; vf[0][e4] = AT_FRAG(VB_, 16 * (4 * eh + e4) + fr, fq); }
#pragma unroll
                for (int kp = 0; kp < 8; ++kp) {
                    if (kp < 7) {
#pragma unroll
                        for (int e4 = 0; e4 < 4; ++e4) vf[(kp + 1) & 1][e4] = AT_FRAG(VB_, 16 * (4 * eh + e4) + fr, 4 * (kp + 1) + fq); }
                    PIN();
#pragma unroll
                    for (int e4 = 0; e4 < 4; ++e4) { o[0][e4] = MFMA16(vf[kp & 1][e4], pf[0][kp], o[0][e4]); o[1][e4] = MFMA16(vf[kp & 1][e4], pf[1][kp], o[1][e4]); }
                    PINV(o[0][0]); PINV(o[1][3]); }
#pragma unroll
                for (int a = 0; a < 2; ++a) { const long t = (long)b * SEQ + qb * 256 + 32 * w + 16 * a + fr; h16* orow = WSP(h16, OFF_OATT) + (size_t)t * DM + hd * 256 + 128 * d + 64 * eh;
#pragma unroll
                    for (int e4 = 0; e4 < 4; ++e4) { if (F8_O) *(unsigned*)(WSP(unsigned char, OFF_OATT) + (size_t)t * DM + hd * 256 + 128 * d + 64 * eh + 16 * e4 + 4 * fq) = cvt4_fp8(16.f * o[a][e4][0], 16.f * o[a][e4][1], 16.f * o[a][e4][2], 16.f * o[a][e4][3]);
                        else *(h16x4*)(orow + 16 * e4 + 4 * fq) = pack4(o[a][e4]); } } }
        }
    }
    asm volatile("s_waitcnt vmcnt(0) lgkmcnt(0)" ::: "memory");
    __syncthreads();
#undef AT_DMA
#undef AT_FRAG
#undef AT_WAITBAR
#undef AT_LOADQ
}

__device__ __forceinline__ void phase_router(const Frame& F, const Prm& p, int l) {
    LAS h16* RW = (LAS h16*)F.lds;
    { const h16* rwg = WSP(const h16, OFF_RWG);
        for (int i = F.tid; i < 72 * 1032 / 8; i += 512) *(LAS h16x8*)(RW + 8 * i) = *(const h16x8*)(rwg + 8 * i); }
    LAS unsigned* hist = (LAS unsigned*)(F.lds + 72 * 1032 * 2);
    if (F.tid < 32) hist[F.tid] = 0u;
    if (F.G == 256) { for (int i = (int)blockIdx.x * 512 + F.tid; i < MAXSLOT; i += 256 * 512) WSP(int, OFF_STOK)[i] = 0; }
    else if (blockIdx.x == 0) { for (int i = F.tid; i < MAXSLOT; i += 512) WSP(int, OFF_STOK)[i] = 0; }
    __syncthreads();
    const int gw = F.vcu * 8 + F.wave, NGW = F.G * 8, fr = F.lane & 15, fq = F.lane >> 4;
    for (int tg = gw; tg < NT / 16; tg += NGW) {
        const int tok = tg * 16 + fr;
        const h16* hp = WSP(const h16, WS_HB) + (size_t)tok * DM + 8 * fq;
        f32x4 acc[3]; LAS const h16* wrow[3];
#pragma unroll
        for (int mt = 0; mt < 3; ++mt) { acc[mt] = (f32x4){0.f, 0.f, 0.f, 0.f}; const int j = (16 * mt + fr) < 36 ? (16 * mt + fr) : 35; wrow[mt] = RW + j * 1032 + 8 * fq; }
#pragma unroll
        for (int half = 0; half < 2; ++half) { h16x8 hf[16];
#pragma unroll
            for (int q = 0; q < 16; ++q) hf[q] = *(const h16x8*)(hp + 32 * (16 * half + q));
#pragma unroll
            for (int q = 0; q < 16; ++q) { const int ks = 16 * half + q;
#pragma unroll
                for (int mt = 0; mt < 3; ++mt) { acc[mt] = MFMA16(ldsfrag(wrow[mt] + 32 * ks), hf[q], acc[mt]); acc[mt] = MFMA16(ldsfrag(wrow[mt] + 36 * 1032 + 32 * ks), hf[q], acc[mt]); } } }
#pragma unroll
        for (int mt = 0; mt < 3; ++mt) acc[mt] *= (1.0f / 1024.0f);
        const float rs = row_rstd(WSP(const float, WS_SSQ) + (size_t)tok * 16);
        float gl[4];
#pragma unroll
        for (int r = 0; r < 4; ++r) gl[r] = __shfl(acc[0][r], fr) * rs + inptr(F, 25)[l * 4 + r];
        int gi = 0; float gmx = gl[0];
#pragma unroll
        for (int j = 1; j < 4; ++j) if (gl[j] > gmx) { gmx = gl[j]; gi = j; }
        float gsum = 0.f;
#pragma unroll
        for (int j = 0; j < 4; ++j) gsum += __expf(gl[j] - gmx);
        const float gp = 1.0f / gsum;
        const int src1 = fr + 16 * (1 + 2 * (gi & 1)), src2 = fr + 16 * (2 - 2 * (gi & 1)), mt1 = gi >> 1, mt2 = (gi + 1) >> 1;
        float el[8];
#pragma unroll
        for (int k = 0; k < 4; ++k) { const float a0 = __shfl(acc[0][k], src1), a1 = __shfl(acc[1][k], src1); el[k] = (mt1 ? a1 : a0) * rs + inptr(F, 27)[l * 32 + gi * 8 + k];
            const float b0 = __shfl(acc[0][k], src2), b1 = __shfl(acc[1][k], src2), b2 = __shfl(acc[2][k], src2); el[4 + k] = (mt2 == 0 ? b0 : (mt2 == 1 ? b1 : b2)) * rs + inptr(F, 27)[l * 32 + gi * 8 + 4 + k]; }
        int e1 = 0; float m1 = el[0];
#pragma unroll
        for (int j = 1; j < 8; ++j) if (el[j] > m1) { m1 = el[j]; e1 = j; }
        int e2 = -1; float m2 = -3.0e38f;
#pragma unroll
        for (int j = 0; j < 8; ++j) if (j != e1 && el[j] > m2) { m2 = el[j]; e2 = j; }
        const float r2 = __expf(m2 - m1); const float g1 = gp / (1.0f + r2), g2 = gp * r2 / (1.0f + r2);
        if (fq == 0) { const int x1 = gi * 8 + e1, x2 = gi * 8 + e2;
            *(int2*)(WSP(int, OFF_EID) + (size_t)tok * 2) = make_int2(x1, x2); *(f32x2*)(WSP(float, OFF_GATE) + (size_t)tok * 2) = (f32x2){g1, g2};
            WSP(float, OFF_RSTDT)[tok] = rs; __hip_atomic_fetch_add(&hist[x1], 1u, __ATOMIC_RELAXED, __HIP_MEMORY_SCOPE_WORKGROUP); __hip_atomic_fetch_add(&hist[x2], 1u, __ATOMIC_RELAXED, __HIP_MEMORY_SCOPE_WORKGROUP); }
    }
    __syncthreads();
    if (F.tid < 32 && hist[F.tid]) atomicAdd(WSP(unsigned, WS_CTL) + CW_COUNTS + l * 64 + F.tid, hist[F.tid]);
    __syncthreads();
}
__device__ __forceinline__ void phase_dispatch(const Frame& F, int l) {
    LAS int* cnt = (LAS int*)F.lds; LAS int* base = cnt + 32; LAS int* pstart = base + 32; LAS int* slots = pstart + 40;
    unsigned* ctl = WSP(unsigned, WS_CTL);
    for (int blk = F.vcu; blk < NT / 128; blk += F.G) {
        __syncthreads();
        if (F.tid < 32) cnt[F.tid] = 0;
        if (F.tid == 32) { int acc = 0; for (int e = 0; e < 32; ++e) { pstart[e] = acc; acc += (int)((ctl[CW_COUNTS + l * 64 + e] + 255u) & ~255u); } pstart[32] = acc; }
        __syncthreads();
        int e = 0, rank = 0, tok = 0;
        if (F.tid < 256) { tok = blk * 128 + (F.tid >> 1); e = WSP(const int, OFF_EID)[(size_t)tok * 2 + (F.tid & 1)]; rank = __hip_atomic_fetch_add(&cnt[e], 1, __ATOMIC_RELAXED, __HIP_MEMORY_SCOPE_WORKGROUP); }
        __syncthreads();
        if (F.tid < 32) base[F.tid] = cnt[F.tid] ? (int)atomicAdd(&ctl[CW_CURSOR + l * 64 + F.tid], (unsigned)cnt[F.tid]) : 0;
        __syncthreads();
        if (F.tid < 256) { const int slot = pstart[e] + base[e] + rank; slots[F.tid] = slot; WSP(int, OFF_TSLOT)[(size_t)tok * 2 + (F.tid & 1)] = slot; WSP(float, OFF_SRSTD)[slot] = WSP(const float, OFF_RSTDT)[tok]; WSP(int, OFF_STOK)[slot] = tok; }
        __syncthreads();
        if (blk == 0 && F.tid == 0) { const int ntl = pstart[32] >> 8; ctl[CW_NTILES + l] = (unsigned)ntl; int* te = WSP(int, OFF_TILEE);
            for (int e2 = 0; e2 < 32; ++e2) for (int tl = pstart[e2] >> 8; tl < (pstart[e2 + 1] >> 8); ++tl) te[tl] = e2; }
    }
    __syncthreads();
}
__device__ __forceinline__ void phase_combine(const Frame& F, const Prm& p, int l) {
    const int gw = F.vcu * 8 + F.wave, NGW = F.G * 8;
    const bool last = (l == NLAYER - 1);
    for (int tk0 = gw * 4; tk0 < NT; tk0 += NGW * 4) {
        int2 sl[4]; f32x2 gt[4];
#pragma unroll
        for (int q = 0; q < 4; ++q) { sl[q] = *(const int2*)(WSP(const int, OFF_TSLOT) + (size_t)(tk0 + q) * 2); gt[q] = *(const f32x2*)(WSP(const float, OFF_GATE) + (size_t)(tk0 + q) * 2); }
        f32x4 v[4][4];
#if F8_YP
        unsigned ya[4][4], yb[4][4];
#else
        h16x4 ya[4][4], yb[4][4];
#endif
#pragma unroll
        for (int q = 0; q < 4; ++q) { const h16* hrow = WSP(const h16, WS_HB) + (size_t)(tk0 + q) * DM;
#if F8_YP
            const unsigned char* y0 = WSP(const unsigned char, OFF_YP) + (size_t)sl[q].x * DM; const unsigned char* y1 = WSP(const unsigned char, OFF_YP) + (size_t)sl[q].y * DM;
#else
            const h16* y0 = WSP(const h16, OFF_YP) + (size_t)sl[q].x * DM; const h16* y1 = WSP(const h16, OFF_YP) + (size_t)sl[q].y * DM;
#endif

#pragma unroll
            for (int j = 0; j < 4; ++j) { const int c = 4 * F.lane + 256 * j; const h16x4 hv = *(const h16x4*)(hrow + c); v[q][j] = (f32x4){(float)hv[0], (float)hv[1], (float)hv[2], (float)hv[3]};
#if F8_YP
                ya[q][j] = __builtin_nontemporal_load((const unsigned*)(y0 + c)); yb[q][j] = __builtin_nontemporal_load((const unsigned*)(y1 + c)); } }
#else
                ya[q][j] = __builtin_nontemporal_load((const h16x4*)(y0 + c)); yb[q][j] = __builtin_nontemporal_load((const h16x4*)(y1 + c)); } }
#endif

#pragma unroll
        for (int q = 0; q < 4; ++q) { float s = 0.f;
#pragma unroll
            for (int j = 0; j < 4; ++j) {
#if F8_YP
                { const f32x2 a0 = __builtin_amdgcn_cvt_pk_f32_fp8((int)ya[q][j], false), a1 = __builtin_amdgcn_cvt_pk_f32_fp8((int)ya[q][j], true), b0 = __builtin_amdgcn_cvt_pk_f32_fp8((int)yb[q][j], false), b1 = __builtin_amdgcn_cvt_pk_f32_fp8((int)yb[q][j], true);
                  const float g0 = gt[q][0] * (1.0f / 32.0f), g1 = gt[q][1] * (1.0f / 32.0f);
                  v[q][j][0] += g0 * a0[0] + g1 * b0[0]; v[q][j][1] += g0 * a0[1] + g1 * b0[1]; v[q][j][2] += g0 * a1[0] + g1 * b1[0]; v[q][j][3] += g0 * a1[1] + g1 * b1[1]; }
#else
#pragma unroll
                for (int e = 0; e < 4; ++e) v[q][j][e] += gt[q][0] * (float)ya[q][j][e] + gt[q][1] * (float)yb[q][j][e];
#endif

                if (!last) { const h16x4 o = pack4(v[q][j]); v[q][j] = (f32x4){(float)o[0], (float)o[1], (float)o[2], (float)o[3]}; }
                s += (v[q][j][0] * v[q][j][0] + v[q][j][1] * v[q][j][1]) + (v[q][j][2] * v[q][j][2] + v[q][j][3] * v[q][j][3]); }
            s = wave_sum(s);
            if (!last) {
#pragma unroll
                for (int j = 0; j < 4; ++j) { const int c = 4 * F.lane + 256 * j; *(h16x4*)(WSP(h16, WS_HB) + (size_t)(tk0 + q) * DM + c) = pack4(v[q][j]);
                    if (F8_HB) *(unsigned*)((unsigned char*)F.out + OUT_HB8 + (size_t)(tk0 + q) * DM + c) = cvt4_fp8(v[q][j][0], v[q][j][1], v[q][j][2], v[q][j][3]); }
                if (F.lane < 16) WSP(float, WS_SSQ)[(size_t)(tk0 + q) * 16 + F.lane] = (F.lane == 0) ? s : 0.f;
                if (F.lane == 0) WSP(float, OFF_RSTDT)[tk0 + q] = 1.0f / sqrtf(s * (1.0f / DM) + EPS);
            } else { const float rs = 1.0f / sqrtf(s * (1.0f / DM) + EPS); float* orow = F.out + (size_t)(tk0 + q) * DM;
#pragma unroll
                for (int j = 0; j < 4; ++j) { const int c = 4 * F.lane + 256 * j; const f32x4 gf = *(const f32x4*)(inptr(F, 31) + c); *(f32x4*)(orow + c) = v[q][j] * rs * gf; } } }
    }
}

__global__ void __launch_bounds__(512, 2) fwd(Prm p) {
    extern __shared__ __attribute__((aligned(16))) unsigned char lds_raw[];
    Frame F; F.lds = (LAS unsigned char*)lds_raw; F.ws = (GAS unsigned char*)p.ws; F.out = p.out;
    F.tid = threadIdx.x; F.lane = F.tid & 63; F.wave = __builtin_amdgcn_readfirstlane(F.tid >> 6);
    F.G = gridDim.x; { const int bx = blockIdx.x; F.vcu = (F.G % 8 == 0) ? (bx % 8) * (F.G / 8) + bx / 8 : bx; }
    volatile LAS unsigned* misc = (volatile LAS unsigned*)(F.lds + LDS_MISC);
    if (F.tid < 4) misc[F.tid] = 0u;
    F.ptab = (volatile LAS unsigned long long*)(F.lds + LDS_MISC + 64);
    if (F.tid < 32) F.ptab[F.tid] = (unsigned long long)p.in[F.tid];
    __syncthreads();
    const int lo = p.ph_lo, hi = p.ph_hi;
    XcdBarrier bar; bar.bar = WSP(unsigned, WS_CTL) + CW_BAR; bar.x = 0; bar.st = misc;
    if (hi - lo > 1) bar = xcd_barrier_post(WSP(unsigned, WS_CTL) + CW_BAR, misc);
#ifndef UMASK
#define UMASK 7
#endif
#ifndef REPMASK
#define REPMASK 0
#endif
#ifndef PHMASK
#define PHMASK 0x3fff
#endif
#define IN(k) (((PHMASK >> ((k) % NPH)) & 1) && lo <= (k) && (k) < hi && (launder(F), true))
#define REPS(k) (((REPMASK >> (k)) & 1) ? 2 : 1)
#define INR(k) (lo <= (k) && (k) < hi)
#ifndef AMPMASK
#define AMPMASK 0
#endif
    unsigned long long tprev = AMPMASK ? __builtin_amdgcn_s_memrealtime() : 0ull;
#define SEAM(k) do { if (INR(k) && INR((k) + 1)) { xcd_barrier(bar); if (AMPMASK) { const unsigned long long tn = __builtin_amdgcn_s_memrealtime(); \
        if ((AMPMASK >> ((k) % NPH)) & 1) { const unsigned long long tgt = tn + 4ull * (tn - tprev); while (__builtin_amdgcn_s_memrealtime() < tgt) __builtin_amdgcn_s_sleep(8); } \
        tprev = __builtin_amdgcn_s_memrealtime(); } } } while (0)
    for (int l = 0; l < NLAYER; ++l) {
        const int pb = l * NPH;
        if (IN(pb + 0)) for (int rep = 0; rep < REPS(0); ++rep) { phase_convert(F, p, l); } SEAM(pb + 0);
        if (REPS(20) == 2 && INR(pb + 0) && INR(pb + 1)) { for (int q = 0; q < 20; ++q) xcd_barrier(bar); }
        if (IN(pb + 1)) for (int rep = 0; rep < REPS(1); ++rep) {
            if (P8_N16 > 0) { pg8::StaticOrder S; S.init(NT, P8_N16 * 256, F.G, (int)blockIdx.x); pg8::EpiScale16C E{WSP(h16, WS_R1), NPJ, WSP(const float, OFF_RSTDT), 1.0f, P8_LIST16};
              pg8::Gemm g{WSP(const h16, WS_HB), WSP(const h16, WS_WIN), DM, DM, DM, nullptr}; pg8::gemm_phase(F.lds, F.tid, g, S, E); }
            launder(F);
            if (P8_N8 > 0) { pg8::StaticOrder S; S.init(NT, P8_N8 * 256, F.G, (int)((blockIdx.x + F.G / 2) % F.G));
              pg8::EpiScale16C E{WSP(h16, WS_R1), NPJ, WSP(const float, OFF_RSTDT), 1.0f / 256.0f, P8_LIST8};
              pg8::Gemm g{(const h16*)((const unsigned char*)F.out + OUT_HB8), WSP(const h16, WS_WIN + P8_WOFF), DM / 2, DM / 2, DM / 2, nullptr}; pg8::gemm_phase<pg8::EpiScale16C, pg8::StaticOrder, false, 1>(F.lds, F.tid, g, S, E); }
        } SEAM(pb + 1);
        if (IN(pb + 2)) for (int rep = 0; rep < REPS(2); ++rep) {
            if (UMASK & 1) for (int r2 = 0; r2 < REPS(17); ++r2) for (int u = blockIdx.x; u < NB * NCH * 2; u += F.G) ssd_states_unit(F, p, l, u);
            launder(F);
            if (UMASK & 2) for (int r2 = 0; r2 < REPS(18); ++r2) for (int u = blockIdx.x; u < NB * NCH; u += F.G) ret_states_block(F, u);
            launder(F);
            if (UMASK & 4) for (int r2 = 0; r2 < REPS(19); ++r2) for (int u = blockIdx.x; u < NB * NCH; u += F.G) lru_unit(F, p, l, u);
        } SEAM(pb + 2);
        if (IN(pb + 3)) for (int rep = 0; rep < REPS(3); ++rep) {
            const bool split = (F.G == 256); const int bx = (int)blockIdx.x;
            if (!split || bx < 64) {
                pg8::Gemm g{WSP(const h16, WS_MEM16), WSP(const h16, WS_WKV), DM, DM, DM, nullptr}; pg8::StaticOrder S; S.init(NTM, DM, split ? 64 : F.G, bx);
                pg8::EpiScale16 E{WSP(h16, OFF_KB), DM, WSP(const float, OFF_MSSQ), 1.0f}; pg8::gemm_phase(F.lds, F.tid, g, S, E); }
            launder(F);
            if (!split || (bx >= 64 && bx < 128)) {
                pg8::Gemm g{WSP(const h16, WS_MEM16), WSP(const h16, WS_WKV) + (size_t)DM * DM, DM, DM, DM, nullptr}; pg8::StaticOrder S; S.init(NTM, DM, split ? 64 : F.G, split ? bx - 64 : bx);
                pg8::EpiVT E{WSP(h16, OFF_VT), WSP(const float, OFF_MRSTD)}; pg8::gemm_phase<pg8::EpiVT, pg8::StaticOrder, false, 0, true>(F.lds, F.tid, g, S, E); }
            launder(F);
            if (!split || bx >= 128) for (int u = split ? bx - 128 : bx; u < 4 * NB * 6; u += split ? 128 : F.G) ssd_scan_unit(F, u);
            launder(F);
            if (!split || bx < 192) for (int u = bx; u < 2 * NB * 6; u += split ? 256 : F.G) ret_scan_unit(F, u);
            lru_scan(F, split ? bx - 192 : bx);
        } SEAM(pb + 3);
        if (IN(pb + 4)) for (int rep = 0; rep < REPS(4); ++rep) {
            if (UMASK & 1) for (int r2 = 0; r2 < REPS(14); ++r2) for (int u = blockIdx.x; u < NB * NCH * 2; u += F.G) ssd_out_unit(F, p, l, u);
            launder(F);
            if (UMASK & 2) for (int r2 = 0; r2 < REPS(15); ++r2) for (int u = blockIdx.x; u < NB * NCH; u += F.G) ret_out_block(F, u);
            launder(F);
            if (UMASK & 4) for (int r2 = 0; r2 < REPS(16); ++r2) for (int u = blockIdx.x; u < NB * NCH; u += F.G) lru_out_unit(F, u);
        } SEAM(pb + 4);
        if (IN(pb + 5)) for (int rep = 0; rep < REPS(5); ++rep) { pg8::StaticOrder S; S.init(NT, DM, F.G, (int)blockIdx.x); pg8::EpiResid E{WSP(h16, WS_HB), WSP(float, WS_SSQ), (unsigned char*)F.out + OUT_HB8, F8_OUT ? 1.0f / 2048.0f : 1.0f};
#if F8_OUT
            pg8::Gemm g{WSP(const h16, OFF_OMIX8), WSP(const h16, WS_WOUT), DM / 2, DM / 2, DM / 2, nullptr}; pg8::gemm_phase<pg8::EpiResid, pg8::StaticOrder, false, 1>(F.lds, F.tid, g, S, E);
#else
            pg8::Gemm g{WSP(const h16, OFF_OMIX), WSP(const h16, WS_WOUT), DM, DM, DM, nullptr}; pg8::gemm_phase(F.lds, F.tid, g, S, E);
#endif
            } SEAM(pb + 5);
        if (IN(pb + 6)) for (int rep = 0; rep < REPS(6); ++rep) { pg8::StaticOrder S; S.init(NT, DM, F.G, (int)blockIdx.x); pg8::EpiScale16 E{WSP(h16, OFF_QCA), DM, WSP(const float, WS_SSQ), F8_Q ? 1.0f / 4096.0f : 1.0f};
#if F8_Q
            pg8::Gemm g{(const h16*)((const unsigned char*)F.out + OUT_HB8), WSP(const h16, WS_WQ), DM / 2, DM / 2, DM / 2, nullptr}; pg8::gemm_phase<pg8::EpiScale16, pg8::StaticOrder, false, 1>(F.lds, F.tid, g, S, E);
#else
            pg8::Gemm g{WSP(const h16, WS_HB), WSP(const h16, WS_WQ), DM, DM, DM, nullptr}; pg8::gemm_phase(F.lds, F.tid, g, S, E);
#endif
            } SEAM(pb + 6);
        if (IN(pb + 7)) for (int rep = 0; rep < REPS(7); ++rep) { attn_phase(F); } SEAM(pb + 7);
        if (IN(pb + 8)) for (int rep = 0; rep < REPS(8); ++rep) { pg8::StaticOrder S; S.init(NT, DM, F.G, (int)blockIdx.x); pg8::EpiResid E{WSP(h16, WS_HB), WSP(float, WS_SSQ), (unsigned char*)F.out + OUT_HB8, F8_O ? 1.0f / 4096.0f : 1.0f};
#if F8_O
            pg8::Gemm g{WSP(const h16, OFF_OATT), WSP(const h16, WS_WO), DM / 2, DM / 2, DM / 2, nullptr}; pg8::gemm_phase<pg8::EpiResid, pg8::StaticOrder, false, 1>(F.lds, F.tid, g, S, E);
#else
            pg8::Gemm g{WSP(const h16, OFF_OATT), WSP(const h16, WS_WO), DM, DM, DM, nullptr}; pg8::gemm_phase(F.lds, F.tid, g, S, E);
#endif
            } SEAM(pb + 8);
        if (IN(pb + 9)) for (int rep = 0; rep < REPS(9); ++rep) { phase_router(F, p, l); } SEAM(pb + 9);
        if (IN(pb + 10)) for (int rep = 0; rep < REPS(10); ++rep) { phase_dispatch(F, l); } SEAM(pb + 10);
        if (IN(pb + 11)) for (int rep = 0; rep < REPS(11); ++rep) {
            pg8::GroupOrder S{WSP(const int, OFF_TILEE), __builtin_amdgcn_readfirstlane((int)WSP(const unsigned, WS_CTL)[CW_NTILES + l]), F.G, F.vcu}; pg8::EpiGated E{WSP(h16, OFF_HP), WSP(const float, OFF_SRSTD), F8_UP ? 1.0f / 256.0f : 1.0f};
#if F8_UP
            pg8::Gemm g{(const h16*)((const unsigned char*)F.out + OUT_HB8), WSP(const h16, WS_W13), DM / 2, DM / 2, DM / 2, WSP(const int, OFF_STOK)}; pg8::gemm_phase<pg8::EpiGated, pg8::GroupOrder, true, 1>(F.lds, F.tid, g, S, E);
#else
            pg8::Gemm g{WSP(const h16, WS_HB), WSP(const h16, WS_W13), DM, DM, DM, WSP(const int, OFF_STOK)}; pg8::gemm_phase<pg8::EpiGated, pg8::GroupOrder, true>(F.lds, F.tid, g, S, E);
#endif
            } SEAM(pb + 11);
        if (IN(pb + 12)) for (int rep = 0; rep < REPS(12); ++rep) {
            pg8::GroupOrder S{WSP(const int, OFF_TILEE), __builtin_amdgcn_readfirstlane((int)WSP(const unsigned, WS_CTL)[CW_NTILES + l]), F.G, F.vcu}; pg8::EpiPlain16 E{WSP(h16, OFF_YP), 1.0f / 4096.0f};
#if F8_DOWN && F8_YP
            pg8::EpiPlain8 E8{WSP(unsigned char, OFF_YP), 32.0f / 4096.0f};
            pg8::Gemm g{WSP(const h16, OFF_HP), WSP(const h16, WS_W2), 256, 256, 256, nullptr}; pg8::gemm_phase<pg8::EpiPlain8, pg8::GroupOrder, false, 1>(F.lds, F.tid, g, S, E8);
#elif F8_DOWN
            pg8::Gemm g{WSP(const h16, OFF_HP), WSP(const h16, WS_W2), 256, 256, 256, nullptr}; pg8::gemm_phase<pg8::EpiPlain16, pg8::GroupOrder, false, 1>(F.lds, F.tid, g, S, E);
#else
            pg8::Gemm g{WSP(const h16, OFF_HP), WSP(const h16, WS_W2), 512, 512, 512, nullptr}; pg8::gemm_phase(F.lds, F.tid, g, S, E);
#endif
            } SEAM(pb + 12);
        if (IN(pb + 13)) for (int rep = 0; rep < REPS(13); ++rep) { phase_combine(F, p, l); } SEAM(pb + 13);
    }
#undef IN
#undef INR
#undef SEAM
}

extern "C" void kernel_launch(void* const* d_in, const int* in_sizes, int n_in, void* d_out, int out_size, void* d_ws, size_t ws_size, hipStream_t stream) {
    static int grid = 0;
    if (grid == 0) {
        if (n_in != 32 || out_size != NT * DM || ws_size < WS_END) { fprintf(stderr, "kernel_launch: unexpected shapes / workspace (%d inputs, out %d, ws %zu < %zu)\n", n_in, out_size, ws_size, (size_t)WS_END); grid = -1; return; }
        int dev = 0, cus = 0, per_cu = 0;
        if (hipGetDevice(&dev) != hipSuccess || hipDeviceGetAttribute(&cus, hipDeviceAttributeMultiprocessorCount, dev) != hipSuccess) { grid = -1; return; }
        if (hipFuncSetAttribute((const void*)fwd, hipFuncAttributeMaxDynamicSharedMemorySize, LDS_BYTES) != hipSuccess) { fprintf(stderr, "kernel_launch: hipFuncSetAttribute failed\n"); grid = -1; return; }
        if (hipOccupancyMaxActiveBlocksPerMultiprocessor(&per_cu, (const void*)fwd, 512, LDS_BYTES) != hipSuccess || per_cu < 1) { fprintf(stderr, "kernel_launch: occupancy query says %d\n", per_cu); }
        (void)hipGetLastError();
        grid = cus;
    }
    if (grid < 0) return;
    (void)hipMemsetAsync((char*)d_ws + WS_CTL, 0, CTL_ZERO_BYTES, stream);
    Prm p{};
    for (int i = 0; i < 32; ++i) p.in[i] = (const float*)d_in[i];
    p.out = (float*)d_out; p.ws = (unsigned char*)d_ws;
#if defined(PROBE_PHASE)
    p.ph_lo = 0; p.ph_hi = PROBE_PHASE + 1; hipLaunchKernelGGL(fwd, dim3(grid), dim3(512), LDS_BYTES, stream, p);
    (void)hipMemsetAsync((char*)d_ws + WS_CTL + CW_BAR * 4, 0, XCD_BAR_WORDS * 4, stream);
    p.ph_lo = PROBE_PHASE; p.ph_hi = PROBE_PHASE + 1; hipLaunchKernelGGL(fwd, dim3(grid), dim3(512), LDS_BYTES, stream, p);
    p.ph_lo = PROBE_PHASE + 1; p.ph_hi = NPHASES; hipLaunchKernelGGL(fwd, dim3(grid), dim3(512), LDS_BYTES, stream, p);
#elif MK_SINGLE
    p.ph_lo = 0; p.ph_hi = NPHASES;
    hipLaunchKernelGGL(fwd, dim3(grid), dim3(512), LDS_BYTES, stream, p);
#else
    for (int ph = 0; ph < NPHASES; ++ph) { p.ph_lo = ph; p.ph_hi = ph + 1; hipLaunchKernelGGL(fwd, dim3(grid), dim3(512), LDS_BYTES, stream, p); }
#endif
}
```

```cpp
#include <hip/hip_runtime.h>
#include <cstdio>
#include <cstdint>

#ifndef MK_SINGLE
#define MK_SINGLE 1
#endif

typedef _Float16 h16;
typedef _Float16 h16x2 __attribute__((ext_vector_type(2)));
typedef _Float16 h16x4 __attribute__((ext_vector_type(4)));
typedef _Float16 h16x8 __attribute__((ext_vector_type(8)));
typedef float f32x2 __attribute__((ext_vector_type(2)));
typedef float f32x4 __attribute__((ext_vector_type(4)));
typedef unsigned u32x2 __attribute__((ext_vector_type(2)));
typedef unsigned u32x4 __attribute__((ext_vector_type(4)));
typedef int i32x4 __attribute__((ext_vector_type(4)));
typedef int i32x8 __attribute__((ext_vector_type(8)));
#define LAS __attribute__((address_space(3)))
#define GAS __attribute__((address_space(1)))
#define PIN() do { asm volatile("" ::: "memory"); __builtin_amdgcn_sched_barrier(0); } while (0)
#define PINV(x) asm volatile("" : "+v"(x) :: "memory")
#define NTL(T, p) __builtin_nontemporal_load((const T*)(p))
#ifndef F8_Q
#define F8_Q 1
#endif
#ifndef F8_UP
#define F8_UP 1
#endif
#ifndef F8_DOWN
#define F8_DOWN 1
#endif
#ifndef F8_OUT
#define F8_OUT 0
#endif
#ifndef F8_O
#define F8_O 1
#endif
#ifndef P8MASK
#define P8MASK 0x607
#endif
#ifndef F8_YP
#define F8_YP 1
#endif
#define F8_HB (P8MASK != 0 || F8_Q || F8_UP)
constexpr int p8_count(unsigned m) { int c = 0; for (int t = 0; t < 14; ++t) c += (m >> t) & 1; return c; }
constexpr unsigned long long p8_list(unsigned m) { unsigned long long r = 0; int j = 0; for (int t = 0; t < 14; ++t) if ((m >> t) & 1) { r |= (unsigned long long)t << (4 * j); ++j; } return r; }
constexpr unsigned long long p8_inv(unsigned m8) { unsigned long long r = 0; int j8 = 0, j16 = 0; for (int t = 0; t < 14; ++t) { if ((m8 >> t) & 1) { r |= (unsigned long long)j8 << (4 * t); ++j8; } else { r |= (unsigned long long)j16 << (4 * t); ++j16; } } return r; }
constexpr int P8_N8 = p8_count(P8MASK), P8_N16 = 14 - P8_N8;
constexpr size_t P8_WOFF = (size_t)P8_N16 * 256 * 2048;
constexpr unsigned long long P8_LIST8 = p8_list(P8MASK), P8_LIST16 = p8_list(~(unsigned)P8MASK & 0x3FFFu), P8_INV = p8_inv(P8MASK);
#define MFMA16(a, b, c) __builtin_amdgcn_mfma_f32_16x16x32_f16((a), (b), (c), 0, 0, 0)

constexpr int NB = 16, SEQ = 2048, DM = 1024, NT = NB * SEQ, MEML = 256, NTM = NB * MEML, NLAYER = 2;
constexpr int NPJ = 3584;
constexpr int CQ = 0, CK = 384, CV = 768, CG = 1152, CZ = 1536, CXS = 1920, CBM = 2304, CCM = 2560, CXR = 2816, CGT = 3072, CDT = 3328;
constexpr int DIN = 3334, NCH = 16, MAXSLOT = 73728;
constexpr float EPS = 1e-6f;
constexpr int NPH = 14;
constexpr int NPHASES = NLAYER * NPH;

constexpr size_t MiB = (size_t)1 << 20;
constexpr size_t WS_CTL = 0, CTL_ZERO_BYTES = 64 * 1024;
constexpr size_t WS_WIN = 1 * MiB, WS_WOUT = 8 * MiB, WS_WQ = 10 * MiB, WS_WKV = 12 * MiB, WS_WO = 16 * MiB, WS_W13 = 18 * MiB, WS_W2 = 82 * MiB, WS_LRUW = 114 * MiB;
constexpr size_t WS_HB = 115 * MiB;
constexpr size_t WS_R1 = 179 * MiB;
constexpr size_t WS_R2 = 403 * MiB;
constexpr size_t WS_KV = 547 * MiB, WS_MEM16 = 563 * MiB, WS_SSQ = 571 * MiB, WS_MISC = 573 * MiB, WS_END = 577 * MiB;
constexpr size_t OFF_QCA = WS_R1, OFF_OATT = WS_R1 + 64 * MiB, OFF_XP = WS_R1, OFF_HP = WS_R1 + 144 * MiB;
constexpr size_t OFF_OMIX = WS_R2, OFF_RST = WS_R2 + 64 * MiB, OFF_SST = WS_R2 + 88 * MiB, OFF_LSUM = WS_R2 + 136 * MiB, OFF_SDEC = WS_R2 + 137 * MiB, OFF_LCAR = WS_R2 + 138 * MiB, OFF_YP = WS_R2;
constexpr size_t OUT_HB8 = 0;
constexpr size_t OUT_XTG = 0, OUT_BCN = 24 * MiB, OUT_LAU = 56 * MiB;
constexpr size_t OFF_OMIX8 = WS_W13 + 32 * MiB;
static_assert(!F8_OUT || F8_UP, "OMIX8 lives in the space freed by the fp8 expert weights");
constexpr size_t OFF_KB = WS_KV, OFF_VT = WS_KV + 8 * MiB;
constexpr size_t OFF_ROPE = WS_MISC, OFF_MSSQ = WS_MISC + 512 * 1024, OFF_EID = WS_MISC + 768 * 1024, OFF_GATE = WS_MISC + 1024 * 1024, OFF_TSLOT = WS_MISC + 1280 * 1024,
                 OFF_RSTDT = WS_MISC + 1536 * 1024, OFF_SRSTD = WS_MISC + 1664 * 1024, OFF_TILEE = WS_MISC + 2000 * 1024, OFF_STOK = WS_MISC + 2048 * 1024, OFF_RWG = WS_MISC + 2400 * 1024, OFF_MRSTD = WS_MISC + 2600 * 1024;
constexpr int CW_COUNTS = 64, CW_CURSOR = 192, CW_NTILES = 320, CW_BAR = 4096;

constexpr int LDS_BYTES = 152 * 1024;
constexpr int LDS_MISC = 150 * 1024;

struct Prm { const float* in[32]; float* out; unsigned char* ws; int ph_lo, ph_hi; };

#define XB_TMO      128
#define XB_XCNT(j)  (256  + 64 * (j))
#define XB_XSUB(j)  (1280 + 64 * (j))
#define XB_XGEN(j)  (2304 + 64 * (j))
#define XB_TOP      3328
#define XB_TOPGEN   3392
#define XCD_BAR_WORDS 3456
#define XB_SPIN_CAP (1u << 18)
__device__ __forceinline__ unsigned xb_ld(unsigned* p)              { return __hip_atomic_load(p, __ATOMIC_RELAXED, __HIP_MEMORY_SCOPE_AGENT); }
__device__ __forceinline__ unsigned xb_add(unsigned* p, unsigned v) { return __hip_atomic_fetch_add(p, v, __ATOMIC_RELAXED, __HIP_MEMORY_SCOPE_AGENT); }
__device__ __forceinline__ unsigned xb_xcc_id() { return (unsigned)__builtin_amdgcn_s_getreg((3 << 11) | 20) & 0xFu; }
#define XB_SPIN(cond, bar) do { unsigned _sp = 0; while (cond) { __builtin_amdgcn_s_sleep(1); \
    if ((++_sp & 255u) == 0u) { if (xb_ld(&(bar)[XB_TMO])) break; if (_sp > XB_SPIN_CAP) { atomicAdd(&(bar)[XB_TMO], 1u); break; } } } } while (0)
struct XcdBarrier { unsigned* bar; unsigned x; volatile LAS unsigned* st; };
__device__ __forceinline__ XcdBarrier xcd_barrier_post(unsigned* bar, volatile LAS unsigned* st) {
    XcdBarrier b; b.bar = bar; b.x = xb_xcc_id(); b.st = st;
    if (threadIdx.x == 0) (void)xb_add(&bar[XB_XCNT(b.x)], 1u);
    return b;
}
__device__ __forceinline__ void xcd_barrier_complete(unsigned* bar, unsigned x, unsigned& nloc, unsigned& nx) {
    const unsigned G = gridDim.x * gridDim.y * gridDim.z;
    unsigned sum, cnt, mine, sp = 0u;
    for (;;) {
        sum = 0u; cnt = 0u; mine = 0u;
#pragma unroll
        for (unsigned j = 0; j < 16; ++j) { const unsigned c = xb_ld(&bar[XB_XCNT(j)]); sum += c; cnt += (c > 0u) ? 1u : 0u; mine = (j == x) ? c : mine; }
        if (sum == G) break;
        __builtin_amdgcn_s_sleep(1);
        if ((++sp & 255u) == 0u) { if (xb_ld(&bar[XB_TMO])) break; if (sp > XB_SPIN_CAP) { atomicAdd(&bar[XB_TMO], 1u); break; } }
    }
    nloc = mine > 0u ? mine : 1u; nx = cnt > 0u ? cnt : 1u;
}
__device__ __forceinline__ void xcd_barrier(const XcdBarrier& b) {
    asm volatile("s_waitcnt vmcnt(0)" ::: "memory");
    __syncthreads();
    if (threadIdx.x == 0) {
        unsigned* bar = b.bar;
        __builtin_amdgcn_s_waitcnt(0);
        unsigned nloc = b.st[0], nx = b.st[1];
        if (nloc == 0u) { xcd_barrier_complete(bar, b.x, nloc, nx); b.st[0] = nloc; b.st[1] = nx; }
        const unsigned old = xb_add(&bar[XB_XSUB(b.x)], 1u);
        const unsigned gen = old / nloc;
        if (old + 1u == (gen + 1u) * nloc) {
            __builtin_amdgcn_fence(__ATOMIC_RELEASE, "agent");
            asm volatile("s_waitcnt vmcnt(0)" ::: "memory");
            const unsigned og = xb_add(&bar[XB_TOP], 1u);
            const unsigned tg = og / nx;
            if (og + 1u == (tg + 1u) * nx) xb_add(&bar[XB_TOPGEN], 1u);
            else XB_SPIN(xb_ld(&bar[XB_TOPGEN]) == tg, bar);
            __builtin_amdgcn_fence(__ATOMIC_ACQUIRE, "agent");
            xb_add(&bar[XB_XGEN(b.x)], 1u);
            asm volatile("s_waitcnt vmcnt(0)" ::: "memory");
        } else {
            XB_SPIN(xb_ld(&bar[XB_XGEN(b.x)]) == gen, bar);
            __builtin_amdgcn_fence(__ATOMIC_ACQUIRE, "agent");
            asm volatile("s_waitcnt vmcnt(0)" ::: "memory");
        }
    }
    __syncthreads();
}

__device__ __forceinline__ float wave_sum(float v) {
#pragma unroll
    for (int o = 1; o < 64; o <<= 1) v += __shfl_xor(v, o);
    return v;
}
__device__ __forceinline__ float siluf_(float x) { return x * __builtin_amdgcn_rcpf(1.0f + __expf(-x)); }
__device__ __forceinline__ float softplusf_(float x) { return x > 20.f ? x : log1pf(__expf(x)); }
__device__ __forceinline__ float gelu_tanh_(float x) { const float y = 0.7978845608028654f * (x + 0.044715f * x * x * x); const float t = 1.0f - 2.0f / (__expf(2.0f * y) + 1.0f); return 0.5f * x * (1.0f + t); }
__device__ __forceinline__ h16x8 pack8(const f32x4 a, const f32x4 b) { h16x8 r; r[0] = (h16)a[0]; r[1] = (h16)a[1]; r[2] = (h16)a[2]; r[3] = (h16)a[3]; r[4] = (h16)b[0]; r[5] = (h16)b[1]; r[6] = (h16)b[2]; r[7] = (h16)b[3]; return r; }
__device__ __forceinline__ h16x4 pack4(const f32x4 a) { h16x4 r; r[0] = (h16)a[0]; r[1] = (h16)a[1]; r[2] = (h16)a[2]; r[3] = (h16)a[3]; return r; }
__device__ __forceinline__ unsigned cvt4_fp8(float a, float b, float c, float d) {
    a = __builtin_amdgcn_fmed3f(a, -448.f, 448.f); b = __builtin_amdgcn_fmed3f(b, -448.f, 448.f); c = __builtin_amdgcn_fmed3f(c, -448.f, 448.f); d = __builtin_amdgcn_fmed3f(d, -448.f, 448.f);
    int p = __builtin_amdgcn_cvt_pk_fp8_f32(a, b, 0, false); p = __builtin_amdgcn_cvt_pk_fp8_f32(c, d, p, true); return (unsigned)p; }
__device__ __forceinline__ h16x8 ldsfrag(LAS const h16* p) { return *(LAS const h16x8*)p; }
__device__ __forceinline__ int kperm32(int k) { return (k & ~31) | (((k >> 2) & 3) << 3) | (((k >> 4) & 1) << 2) | (k & 3); }
__device__ __forceinline__ h16x8 scalefrag(const h16x8 f, float s) { const h16 hs = (h16)s; h16x8 v;
#pragma unroll
    for (int j = 0; j < 8; ++j) v[j] = hs; return f * v; }
__device__ __forceinline__ float row_rstd(const float* ssq16) {
    const f32x4 a = *(const f32x4*)ssq16, b = *(const f32x4*)(ssq16 + 4), c = *(const f32x4*)(ssq16 + 8), d = *(const f32x4*)(ssq16 + 12);
    const float s = ((a[0] + a[1]) + (a[2] + a[3])) + ((b[0] + b[1]) + (b[2] + b[3])) + ((c[0] + c[1]) + (c[2] + c[3])) + ((d[0] + d[1]) + (d[2] + d[3]));
    return 1.0f / sqrtf(s * (1.0f / DM) + EPS);
}

namespace pg8 {
constexpr int BM = 256, BK = 64, HALF = 128, HTB = HALF * BK * 2, STAGE_BYTES = 8 * HTB, NXCD = 8, WGM = 8;
__host__ __device__ __forceinline__ int lds_byte(int r, int c) { const int st = (r >> 4) * 2 + (c >> 5), rr = r & 15, cc = c & 31, ob = rr * 64 + cc * 2; return st * 1024 + (ob ^ (((ob >> 9) & 1) << 5)); }
__host__ __device__ __forceinline__ void stage_rc(int b, int& R, int& C) { const int st = b / 1024, sb = b % 1024, swz = sb ^ (((sb >> 9) & 1) << 5); R = (st >> 1) * 16 + swz / 64; C = (st & 1) * 32 + (swz % 64) / 2; }
__host__ __device__ __forceinline__ int perm32(int rho) { const int n = rho >> 4, i = rho & 15; return 8 * (i >> 2) + 4 * n + (i & 3); }
struct Unit { int pm, pn; };
struct Gemm { const h16* A; const h16* Bt; int lda, ldb, K; const int* rowidx; };
struct StaticOrder {
    int nM, nN, nwg, G, c;
    __device__ void init(int M, int N, int G_, int c_) { nM = M / BM; nN = N / BM; nwg = nM * nN; G = G_; c = c_; }
    __device__ bool next(int i, Unit& u) const {
        const long L = (long)i * G + c; if (L >= nwg) return false;
        int wgid = (int)L; { const int q = nwg / NXCD, r = nwg % NXCD, xcd = wgid % NXCD, off = wgid / NXCD; wgid = (xcd < r ? xcd * (q + 1) : r * (q + 1) + (xcd - r) * q) + off; }
        const int nig = WGM * nN, gid = wgid / nig, fm = gid * WGM, gsz = (nM - fm) < WGM ? (nM - fm) : WGM;
        u.pm = fm + ((wgid % nig) % gsz); u.pn = (wgid % nig) / gsz; return true;
    }
};
struct GroupOrder {
    const int* tile_e; int ntiles, G, vcu;
    __device__ bool next(int i, Unit& u) const {
        const int L = i * G + vcu, tile = L >> 2; if (tile >= ntiles) return false;
        u.pm = tile; u.pn = __builtin_amdgcn_readfirstlane(tile_e[tile]) * 4 + (L & 3); return true;
    }
};

struct EpiScale16 {
    static constexpr bool PERM = true;
    h16* O; int ldc; const float* ssq; float cs;
    __device__ __forceinline__ void operator()(const f32x4 (&acc)[2][2][4][2], const Unit& u, int wr, int wc, int fr, int fq) const {
        const int row0 = u.pm * BM + wr * 64 + fr, col0 = u.pn * BM + wc * 32 + 8 * fq;
#pragma unroll
        for (int ai = 0; ai < 2; ++ai)
#pragma unroll
            for (int m = 0; m < 4; ++m) { const int row = row0 + ai * HALF + m * 16; const float rs = row_rstd(ssq + (size_t)row * 16) * cs; h16* rowp = O + (size_t)row * ldc + col0;
#pragma unroll
                for (int bj = 0; bj < 2; ++bj) *(h16x8*)(rowp + bj * HALF) = pack8(acc[ai][bj][m][0] * rs, acc[ai][bj][m][1] * rs); }
    }
};
struct EpiScale16C {
    static constexpr bool PERM = true;
    h16* O; int ldc; const float* rstd; float cs; unsigned long long cmap;
    __device__ __forceinline__ void operator()(const f32x4 (&acc)[2][2][4][2], const Unit& u, int wr, int wc, int fr, int fq) const {
        const int row0 = u.pm * BM + wr * 64 + fr, col0 = (int)((cmap >> (4 * u.pn)) & 15) * BM + wc * 32 + 8 * fq;
        float rs[2][4];
#pragma unroll
        for (int ai = 0; ai < 2; ++ai)
#pragma unroll
            for (int m = 0; m < 4; ++m) rs[ai][m] = rstd[row0 + ai * HALF + m * 16] * cs;
#pragma unroll
        for (int ai = 0; ai < 2; ++ai)
#pragma unroll
            for (int m = 0; m < 4; ++m) { h16* rowp = O + (size_t)(row0 + ai * HALF + m * 16) * ldc + col0;
#pragma unroll
                for (int bj = 0; bj < 2; ++bj) *(h16x8*)(rowp + bj * HALF) = pack8(acc[ai][bj][m][0] * rs[ai][m], acc[ai][bj][m][1] * rs[ai][m]); }
    }
};
struct EpiVT {
    static constexpr bool PERM = false;
    h16* VT; const float* mrstd;
    __device__ __forceinline__ void operator()(const f32x4 (&acc)[2][2][4][2], const Unit& u, int wr, int wc, int fr, int fq) const {
#pragma unroll
        for (int ai = 0; ai < 2; ++ai) { f32x4 rs[4];
#pragma unroll
            for (int m = 0; m < 4; ++m) rs[m] = *(const f32x4*)(mrstd + u.pm * BM + ai * HALF + wr * 64 + m * 16 + 4 * fq);
#pragma unroll
            for (int bj = 0; bj < 2; ++bj)
#pragma unroll
                for (int n = 0; n < 2; ++n) { h16* rowp = VT + ((size_t)(u.pm * 4 + u.pn) * 256 + bj * HALF + wc * 32 + n * 16 + fr) * 256 + ai * HALF + wr * 64 + 8 * fq;
#pragma unroll
                    for (int mm = 0; mm < 2; ++mm) *(h16x8*)(rowp + 32 * mm) = pack8(acc[ai][bj][2 * mm][n] * rs[2 * mm], acc[ai][bj][2 * mm + 1][n] * rs[2 * mm + 1]); } }
    }
};
struct EpiResid {
    static constexpr bool PERM = true;
    h16* hb; float* ssq; unsigned char* hb8; float cs;
    __device__ __forceinline__ void operator()(const f32x4 (&acc)[2][2][4][2], const Unit& u, int wr, int wc, int fr, int fq) const {
        const int row0 = u.pm * BM + wr * 64 + fr, col0 = u.pn * BM + wc * 32 + 8 * fq;
#pragma unroll
        for (int ai = 0; ai < 2; ++ai)
#pragma unroll
            for (int mp = 0; mp < 2; ++mp) { unsigned ch[2][2][2];
#pragma unroll
                for (int mm = 0; mm < 2; ++mm) { const int m = 2 * mp + mm; const int row = row0 + ai * HALF + m * 16; h16* rowp = hb + (size_t)row * DM + col0; float s = 0.f;
#pragma unroll
                    for (int bj = 0; bj < 2; ++bj) { const h16x8 bv = *(const h16x8*)(rowp + bj * HALF); f32x4 v0, v1;
#pragma unroll
                        for (int e = 0; e < 4; ++e) { v0[e] = (float)bv[e] + acc[ai][bj][m][0][e] * cs; v1[e] = (float)bv[4 + e] + acc[ai][bj][m][1][e] * cs; }
                        const h16x8 o = pack8(v0, v1); *(h16x8*)(rowp + bj * HALF) = o;
                        if (F8_HB) { ch[mm][bj][0] = cvt4_fp8(v0[0], v0[1], v0[2], v0[3]); ch[mm][bj][1] = cvt4_fp8(v1[0], v1[1], v1[2], v1[3]); }
#pragma unroll
                        for (int e = 0; e < 8; ++e) { const float q = (float)o[e]; s += q * q; } }
                    s += __shfl_xor(s, 16); s += __shfl_xor(s, 32);
                    if (fq == 0) ssq[(size_t)row * 16 + u.pn * 4 + wc] = s; }
                if (F8_HB) {
                    const int row = row0 + ai * HALF + (2 * mp + (fq & 1)) * 16; unsigned char* p8 = hb8 + (size_t)row * DM + u.pn * BM + wc * 32 + 8 * (fq & ~1);
#pragma unroll
                    for (int bj = 0; bj < 2; ++bj) { const auto s0 = __builtin_amdgcn_permlane16_swap(ch[0][bj][0], ch[1][bj][0], false, false), s1 = __builtin_amdgcn_permlane16_swap(ch[0][bj][1], ch[1][bj][1], false, false);
                        *(u32x4*)(p8 + bj * HALF) = (u32x4){s0[0], s1[0], s0[1], s1[1]}; } } }
    }
};
struct EpiGated {
    static constexpr bool PERM = true;
    h16* O; const float* srstd; float cs;
    __device__ __forceinline__ void operator()(const f32x4 (&acc)[2][2][4][2], const Unit& u, int wr, int wc, int fr, int fq) const {
        const int row0 = u.pm * BM + wr * 64 + fr, col0 = (u.pn & 3) * HALF + wc * 32 + 8 * fq;
#pragma unroll
        for (int ai = 0; ai < 2; ++ai)
#pragma unroll
            for (int mp = 0; mp < 2; ++mp) { unsigned ch[2][2];
#pragma unroll
                for (int mm = 0; mm < 2; ++mm) { const int m = 2 * mp + mm; const int row = row0 + ai * HALF + m * 16; const float rs = srstd[row] * cs; f32x4 o[2];
#pragma unroll
                    for (int n = 0; n < 2; ++n)
#pragma unroll
                        for (int j = 0; j < 4; ++j) { const float a = acc[ai][0][m][n][j] * rs, b = acc[ai][1][m][n][j] * rs; o[n][j] = siluf_(a) * b; }
                    if (F8_DOWN) { ch[mm][0] = cvt4_fp8(16.f * o[0][0], 16.f * o[0][1], 16.f * o[0][2], 16.f * o[0][3]); ch[mm][1] = cvt4_fp8(16.f * o[1][0], 16.f * o[1][1], 16.f * o[1][2], 16.f * o[1][3]); }
                    else *(h16x8*)(O + (size_t)row * 512 + col0) = pack8(o[0], o[1]); }
                if (F8_DOWN) {
                    const auto s0 = __builtin_amdgcn_permlane16_swap(ch[0][0], ch[1][0], false, false), s1 = __builtin_amdgcn_permlane16_swap(ch[0][1], ch[1][1], false, false);
                    *(u32x4*)((unsigned char*)O + (size_t)(row0 + ai * HALF + (2 * mp + (fq & 1)) * 16) * 512 + (u.pn & 3) * HALF + wc * 32 + 8 * (fq & ~1)) = (u32x4){s0[0], s1[0], s0[1], s1[1]}; } }
    }
};
struct EpiPlain8 {
    static constexpr bool PERM = true;
    unsigned char* O; float cs;
    __device__ __forceinline__ void operator()(const f32x4 (&acc)[2][2][4][2], const Unit& u, int wr, int wc, int fr, int fq) const {
        const int row0 = u.pm * BM + wr * 64 + fr;
#pragma unroll
        for (int ai = 0; ai < 2; ++ai)
#pragma unroll
            for (int mp = 0; mp < 2; ++mp) { unsigned char* p8 = O + (size_t)(row0 + ai * HALF + (2 * mp + (fq & 1)) * 16) * DM + (u.pn & 3) * BM + wc * 32 + 8 * (fq & ~1);
#pragma unroll
                for (int bj = 0; bj < 2; ++bj) { unsigned ch[2][2];
#pragma unroll
                    for (int mm = 0; mm < 2; ++mm) { const f32x4 a0 = acc[ai][bj][2 * mp + mm][0] * cs, a1 = acc[ai][bj][2 * mp + mm][1] * cs; ch[mm][0] = cvt4_fp8(a0[0], a0[1], a0[2], a0[3]); ch[mm][1] = cvt4_fp8(a1[0], a1[1], a1[2], a1[3]); }
                    const auto s0 = __builtin_amdgcn_permlane16_swap(ch[0][0], ch[1][0], false, false), s1 = __builtin_amdgcn_permlane16_swap(ch[0][1], ch[1][1], false, false);
                    *(u32x4*)(p8 + bj * HALF) = (u32x4){s0[0], s1[0], s0[1], s1[1]}; } }
    }
};
struct EpiPlain16 {
    static constexpr bool PERM = true;
    h16* O; float cs;
    __device__ __forceinline__ void operator()(const f32x4 (&acc)[2][2][4][2], const Unit& u, int wr, int wc, int fr, int fq) const {
        const int row0 = u.pm * BM + wr * 64 + fr, col0 = (u.pn & 3) * BM + wc * 32 + 8 * fq;
#pragma unroll
        for (int ai = 0; ai < 2; ++ai)
#pragma unroll
            for (int m = 0; m < 4; ++m) { h16* rowp = O + (size_t)(row0 + ai * HALF + m * 16) * DM + col0;
#pragma unroll
                for (int bj = 0; bj < 2; ++bj) *(h16x8*)(rowp + bj * HALF) = F8_DOWN ? pack8(acc[ai][bj][m][0] * cs, acc[ai][bj][m][1] * cs) : pack8(acc[ai][bj][m][0], acc[ai][bj][m][1]); }
    }
};

template <class Epi, class Sched, bool GATHER = false, int F8W = 0, bool SWAP = false>
__device__ __forceinline__ void gemm_phase(LAS unsigned char* lds, const int tid, const Gemm g, const Sched& S, const Epi& E) {
    const int wid = __builtin_amdgcn_readfirstlane(tid >> 6), lane = tid & 63, wr = wid >> 2, wc = wid & 3, fr = lane & 15, fq = lane >> 4;
    int K_ = g.K; asm volatile("" : "+s"(K_));
    const int K = K_, nt = K / BK;
    unsigned voffA[2], voffB[2];
#pragma unroll
    for (int i = 0; i < 2; ++i) { int R, C; stage_rc(tid * 16 + i * 8192, R, C); const int Rb = Epi::PERM ? ((R & ~31) + perm32(R & 31)) : R;
        voffA[i] = (unsigned)(R * g.lda + C) * 2u; voffB[i] = (unsigned)(Rb * g.ldb + C) * 2u; }
    const size_t kstep = (size_t)(BK * 2);
    const size_t hstepA = (size_t)HALF * g.lda * 2, hstepB = (size_t)HALF * g.ldb * 2;
    const size_t tstepA = 2 * hstepA, tstepB = 2 * hstepB;
    const unsigned ldsw = (unsigned)wid * 1024u;
    const int aoff = lds_byte(wr * 64 + fr, fq * 8), boff = lds_byte(wc * 32 + fr, fq * 8);
#define PG8_SA(b, h) (((b) * 2 + (h)) * HTB)
#define PG8_SB(b, h) ((4 + (b) * 2 + (h)) * HTB)
#define PG8_STAGE(bufoff, gbase, voff) do { _Pragma("unroll") for (int _i = 0; _i < 2; ++_i) \
        __builtin_amdgcn_global_load_lds((const unsigned*)((const char*)(gbase) + (voff)[_i]), (LAS unsigned*)(lds + (bufoff) + ldsw + _i * 8192), 16, 0, 0); } while (0)
    unsigned coff[2], noff[2], cbyte[2];
    if constexpr (GATHER) {
#pragma unroll
        for (int i = 0; i < 2; ++i) { int R_, C_; stage_rc(tid * 16 + i * 8192, R_, C_); cbyte[i] = (unsigned)(C_ * 2); } }
#define PG8_GOFF(u_, o_) do { _Pragma("unroll") for (int _i = 0; _i < 2; ++_i) { int R_, C_; stage_rc(tid * 16 + _i * 8192, R_, C_); \
        o_[_i] = (unsigned)g.rowidx[(u_).pm * BM + R_] | ((unsigned)g.rowidx[(u_).pm * BM + HALF + R_] << 16); } } while (0)
#define PG8_STAGEA(bufoff, gbase, h, sel) do { if constexpr (GATHER) { _Pragma("unroll") for (int _i = 0; _i < 2; ++_i) { const unsigned pk_ = (sel) ? noff[_i] : coff[_i]; \
        __builtin_amdgcn_global_load_lds((const unsigned*)((const char*)(gbase) + (((pk_ >> (16 * (h))) & 0xffffu) * (unsigned)(g.lda * 2) + cbyte[_i])), (LAS unsigned*)(lds + (bufoff) + ldsw + _i * 8192), 16, 0, 0); } } \
        else { PG8_STAGE(bufoff, (gbase) + ((h) ? hstepA : 0), voffA); } } while (0)
#define PG8_LDA(dst, b, h) do { _Pragma("unroll") for (int m = 0; m < 4; ++m) _Pragma("unroll") for (int k = 0; k < 2; ++k) dst[m][k] = *(const LAS h16x8*)(lds + PG8_SA(b, h) + aoff + m * 2048 + k * 1024); } while (0)
#define PG8_LDB(dst, b, h) do { _Pragma("unroll") for (int n = 0; n < 2; ++n) _Pragma("unroll") for (int k = 0; k < 2; ++k) dst[n][k] = *(const LAS h16x8*)(lds + PG8_SB(b, h) + boff + n * 2048 + k * 1024); } while (0)
#define PG8_MMA(ai, bj, At, Bt) do { __builtin_amdgcn_s_setprio(1); _Pragma("unroll") for (int m = 0; m < 4; ++m) _Pragma("unroll") for (int n = 0; n < 2; ++n) _Pragma("unroll") for (int k = 0; k < 2; ++k) \
        acc[ai][bj][m][n] = SWAP ? __builtin_amdgcn_mfma_f32_16x16x32_f16(At[m][k], Bt[n][k], acc[ai][bj][m][n], 0, 0, 0) : __builtin_amdgcn_mfma_f32_16x16x32_f16(Bt[n][k], At[m][k], acc[ai][bj][m][n], 0, 0, 0); __builtin_amdgcn_s_setprio(0); } while (0)
#define PG8_MMA8(ai, bj, At, Bt) do { __builtin_amdgcn_s_setprio(1); _Pragma("unroll") for (int m = 0; m < 4; ++m) _Pragma("unroll") for (int n = 0; n < 2; ++n) { \
        const i32x8 wf_ = __builtin_shufflevector(__builtin_bit_cast(i32x4, Bt[n][0]), __builtin_bit_cast(i32x4, Bt[n][1]), 0, 1, 2, 3, 4, 5, 6, 7), af_ = __builtin_shufflevector(__builtin_bit_cast(i32x4, At[m][0]), __builtin_bit_cast(i32x4, At[m][1]), 0, 1, 2, 3, 4, 5, 6, 7); \
        asm volatile("v_mfma_f32_16x16x128_f8f6f4 %0, %1, %2, %0" : "+v"(acc[ai][bj][m][n]) : "v"(wf_), "v"(af_)); } __builtin_amdgcn_s_setprio(0); } while (0)
#define PG8_MM(ai, bj, At, Bt) do { if constexpr (F8W != 0) PG8_MMA8(ai, bj, At, Bt); else PG8_MMA(ai, bj, At, Bt); } while (0)
#define PG8_WAIT_V(n) asm volatile("s_waitcnt vmcnt(" #n ")" ::: "memory")
#define PG8_WAIT_L(n) asm volatile("s_waitcnt lgkmcnt(" #n ")" ::: "memory")
#define PG8_BAR __builtin_amdgcn_s_barrier()
#define PG8_SCHED __builtin_amdgcn_sched_barrier(0)
    Unit cur, nxt; int ui = 0;
    if (!S.next(0, cur)) return;
    f32x4 acc[2][2][4][2];
#pragma unroll
    for (int a = 0; a < 2; ++a)
#pragma unroll
        for (int b = 0; b < 2; ++b)
#pragma unroll
            for (int m = 0; m < 4; ++m)
#pragma unroll
                for (int n = 0; n < 2; ++n) acc[a][b][m][n] = (f32x4){0.f, 0.f, 0.f, 0.f};
    h16x8 At[4][2], B0[2][2], B1[2][2];
    const char* cA = (const char*)g.A + (GATHER ? (size_t)0 : (size_t)cur.pm * tstepA); const char* cB = (const char*)g.Bt + (size_t)cur.pn * tstepB;
    if constexpr (GATHER) { PG8_GOFF(cur, coff); noff[0] = coff[0]; noff[1] = coff[1]; }
    PG8_STAGE(PG8_SB(0, 0), cB, voffB); PG8_STAGE(PG8_SB(0, 1), cB + hstepB, voffB); PG8_STAGEA(PG8_SA(0, 0), cA, 0, false); PG8_STAGEA(PG8_SA(0, 1), cA, 1, false);
    if (wr == 1) PG8_BAR;
    PG8_WAIT_V(2); PG8_BAR;
    PG8_STAGE(PG8_SB(1, 0), cB + kstep, voffB); PG8_STAGEA(PG8_SA(1, 0), cA + kstep, 0, false); PG8_STAGE(PG8_SB(1, 1), cB + hstepB + kstep, voffB);
    PG8_WAIT_V(6); PG8_BAR;
    for (;;) {
        const bool has_next = S.next(ui + 1, nxt);
        const char* nA = (has_next && !GATHER) ? (const char*)g.A + (size_t)nxt.pm * tstepA : cA; const char* nB = has_next ? (const char*)g.Bt + (size_t)nxt.pn * tstepB : cB;
        if constexpr (GATHER) { if (has_next) PG8_GOFF(nxt, noff); }
        for (int t = 0; t < nt; t += 2) {
            const bool last = (t == nt - 2);
            const char* a1 = cA + (size_t)(t + 1) * kstep;
            const char* a2 = last ? nA : cA + (size_t)(t + 2) * kstep; const char* b2 = last ? nB : cB + (size_t)(t + 2) * kstep;
            const char* a3 = a2 + kstep; const char* b3 = b2 + kstep;
            PG8_LDB(B0, 0, 0); PG8_LDB(B1, 0, 1); PG8_SCHED; PG8_LDA(At, 0, 0); PG8_STAGEA(PG8_SA(1, 1), a1, 1, false);
            PG8_WAIT_V(8); PG8_WAIT_L(0); PG8_BAR; PG8_MM(0, 0, At, B0); PG8_MM(0, 1, At, B1); PG8_BAR; PG8_SCHED;
            PG8_LDA(At, 0, 1); PG8_STAGE(PG8_SB(0, 0), b2, voffB); PG8_STAGE(PG8_SB(0, 1), b2 + hstepB, voffB); PG8_STAGEA(PG8_SA(0, 0), a2, 0, last);
            PG8_WAIT_V(8); PG8_WAIT_L(0); PG8_BAR; PG8_MM(1, 0, At, B0); PG8_MM(1, 1, At, B1); PG8_BAR; PG8_SCHED;
            PG8_LDB(B0, 1, 0); PG8_LDB(B1, 1, 1); PG8_SCHED; PG8_LDA(At, 1, 0); PG8_STAGEA(PG8_SA(0, 1), a2, 1, last);
            PG8_WAIT_V(8); PG8_WAIT_L(0); PG8_BAR; PG8_MM(0, 0, At, B0); PG8_MM(0, 1, At, B1); PG8_BAR; PG8_SCHED;
            PG8_LDA(At, 1, 1); PG8_STAGE(PG8_SB(1, 0), b3, voffB); PG8_STAGE(PG8_SB(1, 1), b3 + hstepB, voffB); PG8_STAGEA(PG8_SA(1, 0), a3, 0, last);
            PG8_WAIT_V(8); PG8_WAIT_L(0); PG8_BAR; PG8_MM(1, 0, At, B0); PG8_MM(1, 1, At, B1); PG8_BAR; PG8_SCHED;
        }
        if (wr == 0) PG8_BAR;
        if constexpr (F8W != 0) asm volatile("s_nop 7\n\ts_nop 7\n\ts_nop 7" ::: "memory");
        E(acc, cur, wr, wc, fr, fq);
        if (!has_next) break;
#pragma unroll
        for (int a = 0; a < 2; ++a)
#pragma unroll
            for (int b = 0; b < 2; ++b)
#pragma unroll
                for (int m = 0; m < 4; ++m)
#pragma unroll
                    for (int n = 0; n < 2; ++n) acc[a][b][m][n] = (f32x4){0.f, 0.f, 0.f, 0.f};
        cur = nxt; cA = nA; cB = nB; ++ui;
        if constexpr (GATHER) { coff[0] = noff[0]; coff[1] = noff[1]; }
        if (wr == 1) PG8_BAR;
    }
    PG8_WAIT_V(0);
    PG8_BAR;
#undef PG8_SA
#undef PG8_SB
#undef PG8_STAGE
#undef PG8_LDA
#undef PG8_GOFF
#undef PG8_STAGEA
#undef PG8_LDB
#undef PG8_MMA
#undef PG8_MMA8
#undef PG8_MM
#undef PG8_WAIT_V
#undef PG8_WAIT_L
#undef PG8_BAR
#undef PG8_SCHED
}
}

struct Frame {
    LAS unsigned char* lds;
    GAS unsigned char* ws;
    volatile LAS unsigned long long* ptab;
    float* out;
    int tid, lane, wave, G, vcu;
};
#define WSP(T, off) ((T*)(GAS T*)(F.ws + (off)))
__device__ __forceinline__ const float* inptr(const Frame& F, int i) {
    const unsigned long long v = F.ptab[i];
    const unsigned lo = __builtin_amdgcn_readfirstlane((unsigned)v), hi = __builtin_amdgcn_readfirstlane((unsigned)(v >> 32));
    return (const float*)(GAS const float*)(((unsigned long long)hi << 32) | lo);
}
__device__ __forceinline__ void launder(Frame& F) {
    int wv = F.wave; asm volatile("" : "+s"(wv)); F.wave = wv;
    unsigned z = 0u; asm volatile("" : "+v"(z));
    int t = wv * 64 + (int)__builtin_amdgcn_mbcnt_hi(~0u, __builtin_amdgcn_mbcnt_lo(~0u, z)); F.tid = t; F.lane = t & 63;
    const unsigned long long w = (unsigned long long)F.ws; unsigned wl = __builtin_amdgcn_readfirstlane((unsigned)w), wh = __builtin_amdgcn_readfirstlane((unsigned)(w >> 32));
    asm volatile("" : "+s"(wl), "+s"(wh)); F.ws = (GAS unsigned char*)(((unsigned long long)wh << 32) | wl);
    unsigned lo = __builtin_amdgcn_readfirstlane((unsigned)(uintptr_t)F.lds); asm volatile("" : "+s"(lo)); F.lds = (LAS unsigned char*)(uintptr_t)lo;
    int v = __builtin_amdgcn_readfirstlane(F.vcu); asm volatile("" : "+s"(v)); F.vcu = v;
}

struct TrItem { const float* W; const float* g; h16* Wt; int ldw, sc, nvalid, ldt, d0, k0, vw, f8; float mul; };
__device__ __forceinline__ void tr_describe(const Frame& F, GAS unsigned char* wsb_, int l, int it, TrItem& d) {
    unsigned char* wsb = (unsigned char*)wsb_;
    int r = it; d.g = nullptr; d.mul = 1.f; d.nvalid = 64; d.vw = 4; d.ldt = DM; d.ldw = DM; d.f8 = 0;
    if (r < 896) { const int d0 = 64 * (r % 56); d.W = inptr(F, 3) + (size_t)l * DM * DIN; d.ldw = DIN; d.g = inptr(F, 2) + l * DM; { const int tile = d0 >> 8, is8 = (P8MASK >> tile) & 1, pos = (int)((P8_INV >> (4 * tile)) & 15); d.Wt = (h16*)(wsb + WS_WIN + (is8 ? P8_WOFF : 0)); d.d0 = pos * 256 + (d0 & 255); if (is8) { d.f8 = 1; d.mul = 256.f; } }
        d.k0 = 64 * (r / 56); d.vw = 2;
        if (d0 < 2816) d.sc = d0; else if (d0 < 3328) d.sc = d0 + 6; else if (d0 == 3328) { d.sc = 2816; d.nvalid = 6; } else { d.sc = 0; d.nvalid = 0; } return; } r -= 896;
    if (r < 256) { d.W = inptr(F, 4) + (size_t)l * DM * DM; if (F8_OUT) { d.f8 = 1; d.mul = 256.f; } d.Wt = (h16*)(wsb + WS_WOUT); d.d0 = d.sc = 64 * (r % 16); d.k0 = 64 * (r / 16); return; } r -= 256;
    if (r < 256) { d.W = inptr(F, 20) + (size_t)l * DM * DM; d.g = inptr(F, 18) + l * DM; d.mul = F8_Q ? 256.f : 0.0625f; d.f8 = F8_Q; d.Wt = (h16*)(wsb + WS_WQ); d.d0 = d.sc = 64 * (r % 16); d.k0 = 64 * (r / 16); return; } r -= 256;
    if (r < 512) { d.W = inptr(F, 21) + (size_t)l * DM * 2048; d.ldw = 2048; d.g = inptr(F, 19) + l * DM; d.Wt = (h16*)(wsb + WS_WKV); d.d0 = d.sc = 64 * (r % 32); d.k0 = 64 * (r / 32); return; } r -= 512;
    if (r < 256) { d.W = inptr(F, 22) + (size_t)l * DM * DM; if (F8_O) { d.f8 = 1; d.mul = 256.f; } d.Wt = (h16*)(wsb + WS_WO); d.d0 = d.sc = 64 * (r % 16); d.k0 = 64 * (r / 16); return; } r -= 256;
    if (r < 8192) { const int e = r / 256, q = r % 256, d0 = 64 * (q % 16), grp = d0 >> 8, rr = d0 & 255;
        d.W = (rr < 128 ? inptr(F, 28) : inptr(F, 29)) + (size_t)(l * 32 + e) * DM * 512; d.ldw = 512; d.sc = grp * 128 + (rr & 127); d.g = inptr(F, 23) + l * DM; d.Wt = (h16*)(wsb + WS_W13 + (size_t)e * DM * DM * (F8_UP ? 1 : 2)); if (F8_UP) { d.f8 = 1; d.mul = 256.f; } d.d0 = d0; d.k0 = 64 * (q / 16); return; } r -= 8192;
    if (r < 4096) { const int e = r / 128, q = r % 128; d.W = inptr(F, 30) + (size_t)(l * 32 + e) * 512 * DM; d.Wt = (h16*)(wsb + WS_W2 + (size_t)e * DM * 512 * (F8_DOWN ? 1 : 2)); if (F8_DOWN) { d.f8 = 1; d.mul = 256.f; } d.ldt = 512; d.d0 = d.sc = 64 * (q % 16); d.k0 = 64 * (q / 16); return; } r -= 4096;
    { const int blk = r & 3, gate = (r >> 2) & 1, dir = r >> 3; d.W = (gate ? inptr(F, 16) : inptr(F, 14)) + (size_t)((l * 2 + dir) * 4 + blk) * 4096; d.ldw = 64; d.Wt = (h16*)(wsb + WS_LRUW) + (size_t)((dir * 2 + gate) * 4 + blk) * 4096; d.ldt = 64; d.d0 = d.sc = 0; d.k0 = 0; }
}
__device__ __forceinline__ void tr_load(const TrItem& d, int lane, f32x4 (&v)[16]) {
    if (d.vw == 4) { const int col = 4 * (lane & 15); const float* src = d.W + (size_t)(d.k0 + (lane >> 4)) * d.ldw + d.sc + col; const bool ok = col < d.nvalid;
#pragma unroll
        for (int i = 0; i < 16; ++i) v[i] = ok ? __builtin_nontemporal_load((const f32x4*)(src + (size_t)(4 * i) * d.ldw)) : (f32x4){0.f, 0.f, 0.f, 0.f};
    } else { const int col = 2 * (lane & 31); const float* src = d.W + (size_t)(d.k0 + (lane >> 5)) * d.ldw + d.sc + col; const bool ok = col < d.nvalid;
#pragma unroll
        for (int i = 0; i < 16; ++i) { const f32x2 a = ok ? __builtin_nontemporal_load((const f32x2*)(src + (size_t)(4 * i) * d.ldw)) : (f32x2){0.f, 0.f}, c = ok ? __builtin_nontemporal_load((const f32x2*)(src + (size_t)(4 * i + 2) * d.ldw)) : (f32x2){0.f, 0.f}; v[i] = (f32x4){a[0], a[1], c[0], c[1]}; } }
}
__device__ __forceinline__ void tr_to_lds(const TrItem& d, int lane, const f32x4 (&v)[16], LAS float* scr) {
    if (d.vw == 4) { LAS float* q = scr + (lane >> 4) * 65 + 4 * (lane & 15);
#pragma unroll
        for (int i = 0; i < 16; ++i) { q[(4 * i) * 65 + 0] = v[i][0]; q[(4 * i) * 65 + 1] = v[i][1]; q[(4 * i) * 65 + 2] = v[i][2]; q[(4 * i) * 65 + 3] = v[i][3]; }
    } else { LAS float* q = scr + (lane >> 5) * 65 + 2 * (lane & 31);
#pragma unroll
        for (int i = 0; i < 16; ++i) { q[(4 * i) * 65 + 0] = v[i][0]; q[(4 * i) * 65 + 1] = v[i][1]; q[(4 * i + 2) * 65 + 0] = v[i][2]; q[(4 * i + 2) * 65 + 1] = v[i][3]; } }
}
__device__ __forceinline__ void tr_from_lds(const TrItem& d, int lane, LAS const float* scr) {
    const int c = lane & 7; float gs[8];
    if (d.g) { const f32x4 g0 = *(const f32x4*)(d.g + d.k0 + 8 * c), g1 = *(const f32x4*)(d.g + d.k0 + 8 * c + 4);
        gs[0] = g0[0] * d.mul; gs[1] = g0[1] * d.mul; gs[2] = g0[2] * d.mul; gs[3] = g0[3] * d.mul; gs[4] = g1[0] * d.mul; gs[5] = g1[1] * d.mul; gs[6] = g1[2] * d.mul; gs[7] = g1[3] * d.mul;
    } else {
#pragma unroll
        for (int e = 0; e < 8; ++e) gs[e] = d.mul; }
    if (d.f8) {
#pragma unroll
        for (int j = 0; j < 8; ++j) { const int nn = (lane >> 3) + 8 * j; LAS const float* q = scr + (8 * c) * 65 + nn; float f[8];
#pragma unroll
            for (int e = 0; e < 8; ++e) f[e] = q[e * 65] * gs[e];
            *(u32x2*)((unsigned char*)d.Wt + (size_t)(d.d0 + nn) * d.ldt + d.k0 + 8 * c) = (u32x2){cvt4_fp8(f[0], f[1], f[2], f[3]), cvt4_fp8(f[4], f[5], f[6], f[7])}; }
        return; }
#pragma unroll
    for (int j = 0; j < 8; ++j) { const int nn = (lane >> 3) + 8 * j; LAS const float* q = scr + (8 * c) * 65 + nn; h16x8 o;
#pragma unroll
        for (int e = 0; e < 8; ++e) o[e] = (h16)(q[e * 65] * gs[e]);
        *(h16x8*)(d.Wt + (size_t)(d.d0 + nn) * d.ldt + d.k0 + 8 * c) = o; }
}
__device__ __forceinline__ void phase_convert(const Frame& F, const Prm& p, int l) {
    LAS float* scr = (LAS float*)(F.lds + F.wave * 16640);
    const int gw = F.vcu * 8 + F.wave, NGW = F.G * 8;
    constexpr int NITEMS = 896 + 256 + 256 + 512 + 256 + 8192 + 4096 + 16;
    { TrItem cur, nxt; f32x4 v[16]; int it = gw;
        if (it < NITEMS) { tr_describe(F, F.ws, l, it, cur); tr_load(cur, F.lane, v); }
        while (it < NITEMS) { const int itn = it + NGW; const bool hn = itn < NITEMS;
            tr_to_lds(cur, F.lane, v, scr);
            if (hn) { tr_describe(F, F.ws, l, itn, nxt); tr_load(nxt, F.lane, v); }
            asm volatile("s_waitcnt lgkmcnt(0)" ::: "memory");
            tr_from_lds(cur, F.lane, scr);
            asm volatile("s_waitcnt lgkmcnt(0)" ::: "memory");
            cur = nxt; it = itn; } }
    {
        const float* gm = inptr(F, 23) + l * DM; const float* wg = inptr(F, 24) + (size_t)l * DM * 4; const float* we = inptr(F, 26) + (size_t)l * DM * 32; h16* rwg = WSP(h16, OFF_RWG);
        for (int i = F.vcu * 512 + F.tid; i < 36 * DM; i += 256 * 512) { const int k = i / 36, j = i % 36; const float wv = gm[k] * (j < 4 ? wg[k * 4 + j] : we[k * 32 + (j - 4)]) * 1024.0f;
            const h16 hi = (h16)wv; rwg[(size_t)j * 1032 + k] = hi; rwg[(size_t)(36 + j) * 1032 + k] = (h16)(wv - (float)hi); } }
    if (l == 0) {
        for (int m = gw; m < NT + NTM; m += NGW) {
            const bool isx = m < NT; const int row = isx ? m : m - NT;
            const float* src = (isx ? inptr(F, 0) : inptr(F, 1)) + (size_t)row * DM; h16* dst = (isx ? WSP(h16, WS_HB) : WSP(h16, WS_MEM16)) + (size_t)row * DM;
            float* sq = (isx ? WSP(float, WS_SSQ) : WSP(float, OFF_MSSQ)) + (size_t)row * 16;
            float s = 0.f;
#pragma unroll
            for (int j = 0; j < 4; ++j) { const f32x4 v = __builtin_nontemporal_load((const f32x4*)(src + 4 * F.lane + 256 * j)); *(h16x4*)(dst + 4 * F.lane + 256 * j) = pack4(v);
                if (F8_HB && isx) *(unsigned*)((unsigned char*)F.out + OUT_HB8 + (size_t)row * DM + 4 * F.lane + 256 * j) = cvt4_fp8(v[0], v[1], v[2], v[3]); s += (v[0] * v[0] + v[1] * v[1]) + (v[2] * v[2] + v[3] * v[3]); }
            s = wave_sum(s);
            if (F.lane < 16) sq[F.lane] = (F.lane == 0) ? s : 0.f;
            if (F.lane == 0) (isx ? WSP(float, OFF_RSTDT) : WSP(float, OFF_MRSTD))[row] = 1.0f / sqrtf(s * (1.0f / DM) + EPS);
        }
        float* rope = WSP(float, OFF_ROPE);
        for (int i = F.vcu * 512 + F.tid; i < SEQ * 32; i += F.G * 512) {
            const int pos = i >> 5, fi = i & 31; double th = 1.0;
            for (int k = 0; k < fi; ++k) th *= 0.74989420933245582730;
            const double rev = (double)pos * th * 0.15915494309189533577;
            const double fr = rev - floor(rev);
            const double r = (fr - 0.5) * 6.28318530717958647692;
            const double r2 = r * r; double sn = 1.0, cs = 1.0;
            for (int k = 14; k >= 1; --k) { sn = 1.0 - r2 / (double)((2 * k) * (2 * k + 1)) * sn; cs = 1.0 - r2 / (double)((2 * k - 1) * (2 * k)) * cs; }
            sn *= r;
            rope[pos * 64 + fi] = (float)(-cs); rope[pos * 64 + 32 + fi] = (float)(-sn);
        }
    }
}

template <bool SILU>
__device__ __forceinline__ void conv_rows8(const h16* projcol, long tbase, int n, int r0, const float* cw, int cdim, const float* cb, h16x8 (&out)[8]) {
    f32x4 w[4][2];
#pragma unroll
    for (int k = 0; k < 4; ++k) { w[k][0] = *(const f32x4*)(cw + k * cdim); w[k][1] = *(const f32x4*)(cw + k * cdim + 4); }
    const f32x4 b0 = *(const f32x4*)cb, b1 = *(const f32x4*)(cb + 4);
    h16x8 x[11];
#pragma unroll
    for (int i = 0; i < 11; ++i) { const int pos = n * 128 + r0 - 2 + i; h16x8 z;
#pragma unroll
        for (int e = 0; e < 8; ++e) z[e] = (h16)0.f;
        x[i] = (pos >= 0 && pos < SEQ) ? NTL(h16x8, projcol + (size_t)(tbase + r0 - 2 + i) * NPJ) : z; }
#pragma unroll
    for (int r = 0; r < 8; ++r) {
#pragma unroll
        for (int e = 0; e < 8; ++e) { float a = e < 4 ? b0[e] : b1[e - 4];
#pragma unroll
            for (int k = 0; k < 4; ++k) a += (e < 4 ? w[k][0][e] : w[k][1][e - 4]) * (float)x[r + k][e];
            out[r][e] = (h16)(SILU ? siluf_(a) : a); } }
}
__device__ __forceinline__ h16x8 col_of(const h16x8 (&o)[8], int e) { h16x8 c; c[0] = o[0][e]; c[1] = o[1][e]; c[2] = o[2][e]; c[3] = o[3][e]; c[4] = o[4][e]; c[5] = o[5][e]; c[6] = o[6][e]; c[7] = o[7][e]; return c; }

__device__ __forceinline__ void ret_scan_unit(const Frame& F, int u) {
    const int h = u % 6, b = (u / 6) % NB, dir = u / (6 * NB);
    const float gC = exp2f(128.0f * log1pf(-exp2f(-5.0f - (float)h)) * 1.4426950408889634f);
    h16* base = WSP(h16, OFF_RST) + ((size_t)((dir * NB + b) * NCH) * 6 + h) * 4096 + F.tid * 8;
    float acc[8]; float zf = 0.f; asm volatile("" : "+v"(zf));
#pragma unroll
    for (int e = 0; e < 8; ++e) acc[e] = zf;
    h16x8 sv[16];
#pragma unroll
    for (int i = 0; i < 16; ++i) { const int n = dir == 0 ? i : NCH - 1 - i; sv[i] = *(const h16x8*)(base + (size_t)n * 6 * 4096); }
#pragma unroll
    for (int i = 0; i < 16; ++i) { const int n = dir == 0 ? i : NCH - 1 - i; h16x8 o;
#pragma unroll
        for (int e = 0; e < 8; ++e) { o[e] = (h16)acc[e]; acc[e] = acc[e] * gC + (float)sv[i][e]; }
        *(h16x8*)(base + (size_t)n * 6 * 4096) = o; }
}
#define RET_BAR() do { asm volatile("s_waitcnt lgkmcnt(0)" ::: "memory"); __builtin_amdgcn_s_barrier(); asm volatile("" ::: "memory"); } while (0)
__device__ __forceinline__ void ret_states_block(const Frame& F, int bn) {
    const int n = bn % NCH, b = bn / NCH; const long t0 = (long)b * SEQ + n * 128;
    const int r = F.tid >> 2, c = F.tid & 3;
    const h16* rowp = WSP(const h16, WS_R1) + (size_t)(t0 + r) * NPJ; const float* cs = WSP(const float, OFF_ROPE) + (size_t)(n * 128 + r) * 64 + 8 * c;
    const f32x4 c0 = *(const f32x4*)cs, c1 = *(const f32x4*)(cs + 4), s0 = *(const f32x4*)(cs + 32), s1 = *(const f32x4*)(cs + 36);
    const int dir = F.wave >> 2, dt = F.wave & 3, fr = F.lane & 15, fq = F.lane >> 4;
    h16x8 k1, k2, v1, v2;
#define RS_LOAD(hh) do { k1 = *(const h16x8*)(rowp + CK + (hh) * 64 + 8 * c); k2 = *(const h16x8*)(rowp + CK + (hh) * 64 + 32 + 8 * c); v1 = *(const h16x8*)(rowp + CV + (hh) * 64 + 16 * c); v2 = *(const h16x8*)(rowp + CV + (hh) * 64 + 16 * c + 8); } while (0)
    RS_LOAD(0);
#pragma unroll 1
    for (int h = 0; h < 6; ++h) {
        LAS h16* KT = (LAS h16*)(F.lds + (h & 1) * 34816); LAS h16* VT = KT + 64 * 136;
#pragma unroll
        for (int e = 0; e < 8; ++e) { const float x1 = (float)k1[e], x2 = (float)k2[e], co = e < 4 ? c0[e] : c1[e - 4], si = e < 4 ? s0[e] : s1[e - 4];
            KT[(8 * c + e) * 136 + r] = (h16)((x1 * co - x2 * si) * 0.125f); KT[(32 + 8 * c + e) * 136 + r] = (h16)((x1 * si + x2 * co) * 0.125f); }
#pragma unroll
        for (int e = 0; e < 8; ++e) { VT[(16 * c + e) * 136 + r] = v1[e]; VT[(16 * c + 8 + e) * 136 + r] = v2[e]; }
        if (h < 5) RS_LOAD(h + 1);
        RET_BAR();
        const float l2g = log1pf(-exp2f(-5.0f - (float)h)) * 1.4426950408889634f;
        h16x8 xw[4];
#pragma unroll
        for (int ks = 0; ks < 4; ++ks) { const h16x8 f = ldsfrag(KT + (16 * dt + fr) * 136 + 32 * ks + 8 * fq); h16x8 wv;
#pragma unroll
            for (int jj = 0; jj < 8; ++jj) { const int j = 32 * ks + 8 * fq + jj; wv[jj] = (h16)exp2f(l2g * (float)(dir == 0 ? 127 - j : j)); }
            xw[ks] = f * wv; }
        h16* rst = WSP(h16, OFF_RST) + ((size_t)((dir * NB + b) * NCH + n) * 6 + h) * 4096;
#pragma unroll
        for (int et = 0; et < 4; ++et) { f32x4 acc = {0.f, 0.f, 0.f, 0.f};
#pragma unroll
            for (int ks = 0; ks < 4; ++ks) acc = MFMA16(xw[ks], ldsfrag(VT + (16 * et + fr) * 136 + 32 * ks + 8 * fq), acc);
            *(h16x4*)(rst + (16 * et + fr) * 64 + 16 * dt + 4 * fq) = pack4(acc); }
    }
#undef RS_LOAD
    __syncthreads();
}
__device__ __forceinline__ void ret_out_block(const Frame& F, int bn) {
    const int n = bn % NCH, b = bn / NCH; const long t0 = (long)b * SEQ + n * 128;
    const int r = F.tid >> 2, c = F.tid & 3, rp = kperm32(r), er = F.tid >> 3, d0 = (F.tid & 7) * 8;
    const h16* rowp = WSP(const h16, WS_R1) + (size_t)(t0 + r) * NPJ; const float* cs = WSP(const float, OFF_ROPE) + (size_t)(n * 128 + r) * 64 + 8 * c;
    const f32x4 c0 = *(const f32x4*)cs, c1 = *(const f32x4*)(cs + 4), s0 = *(const f32x4*)(cs + 32), s1 = *(const f32x4*)(cs + 36);
    const int w = F.wave, fr = F.lane & 15, fq = F.lane >> 4, il = 16 * w + fr;
    const h16* grow = WSP(const h16, WS_R1) + (size_t)(t0 + il) * NPJ + CG + 4 * fq; h16* orow = WSP(h16, OFF_OMIX) + (size_t)(t0 + il) * DM + 4 * fq; unsigned char* orow8 = WSP(unsigned char, OFF_OMIX8) + (size_t)(t0 + il) * DM + 4 * fq;
    const h16* st0 = WSP(const h16, OFF_RST) + ((size_t)((0 * NB + b) * NCH + n) * 6) * 4096 + F.tid * 8; const h16* st1 = WSP(const h16, OFF_RST) + ((size_t)((1 * NB + b) * NCH + n) * 6) * 4096 + F.tid * 8;
    h16x8 q1, q2, k1, k2, v1, v2, sf, sb; h16x4 gn[4];
#define RO_LOAD(hh) do { q1 = NTL(h16x8, rowp + CQ + (hh) * 64 + 8 * c); q2 = NTL(h16x8, rowp + CQ + (hh) * 64 + 32 + 8 * c); k1 = NTL(h16x8, rowp + CK + (hh) * 64 + 8 * c); k2 = NTL(h16x8, rowp + CK + (hh) * 64 + 32 + 8 * c); \
        v1 = NTL(h16x8, rowp + CV + (hh) * 64 + 16 * c); v2 = NTL(h16x8, rowp + CV + (hh) * 64 + 16 * c + 8); sf = NTL(h16x8, st0 + (hh) * 4096); sb = NTL(h16x8, st1 + (hh) * 4096); \
        _Pragma("unroll") for (int et_ = 0; et_ < 4; ++et_) gn[et_] = NTL(h16x4, grow + (hh) * 64 + 16 * et_); } while (0)
    RO_LOAD(0);
#pragma unroll 1
    for (int h = 0; h < 6; ++h) {
        LAS h16* Qt = (LAS h16*)(F.lds + (h & 1) * 72704); LAS h16* Kt = Qt + 128 * 72; LAS h16* VT = Kt + 128 * 72; LAS h16* Ff = VT + 64 * 136; LAS h16* Fb = Ff + 64 * 72;
        { h16x8 qa, qb, ka, kb;
#pragma unroll
            for (int e = 0; e < 8; ++e) { const float co = e < 4 ? c0[e] : c1[e - 4], si = e < 4 ? s0[e] : s1[e - 4];
                float x1 = (float)q1[e], x2 = (float)q2[e]; qa[e] = (h16)(x1 * co - x2 * si); qb[e] = (h16)(x1 * si + x2 * co);
                x1 = (float)k1[e]; x2 = (float)k2[e]; ka[e] = (h16)((x1 * co - x2 * si) * 0.125f); kb[e] = (h16)((x1 * si + x2 * co) * 0.125f); }
            *(LAS h16x8*)(Qt + r * 72 + 8 * c) = qa; *(LAS h16x8*)(Qt + r * 72 + 32 + 8 * c) = qb;
            *(LAS h16x8*)(Kt + r * 72 + 8 * c) = ka; *(LAS h16x8*)(Kt + r * 72 + 32 + 8 * c) = kb; }
#pragma unroll
        for (int e = 0; e < 8; ++e) { VT[(16 * c + e) * 136 + rp] = v1[e]; VT[(16 * c + 8 + e) * 136 + rp] = v2[e]; }
        *(LAS h16x8*)(Ff + er * 72 + d0) = sf; *(LAS h16x8*)(Fb + er * 72 + d0) = sb;
        h16x4 gc[4];
#pragma unroll
        for (int et = 0; et < 4; ++et) gc[et] = gn[et];
        if (h < 5) RO_LOAD(h + 1);
        RET_BAR();
        const float l2g = log1pf(-exp2f(-5.0f - (float)h)) * 1.4426950408889634f;
        h16x8 qf[2];
#pragma unroll
        for (int ks = 0; ks < 2; ++ks) qf[ks] = ldsfrag(Qt + il * 72 + 32 * ks + 8 * fq);
        f32x4 s[8];
#pragma unroll
        for (int jt = 0; jt < 8; ++jt) { f32x4 a = {0.f, 0.f, 0.f, 0.f};
#pragma unroll
            for (int ks = 0; ks < 2; ++ks) a = MFMA16(ldsfrag(Kt + (16 * jt + fr) * 72 + 32 * ks + 8 * fq), qf[ks], a);
#pragma unroll
            for (int q = 0; q < 4; ++q) { const int j = 16 * jt + 4 * fq + q; const int dd = il > j ? il - j : j - il; a[q] *= exp2f(l2g * (float)dd); }
            PINV(a); s[jt] = a; }
        f32x4 o[4];
#pragma unroll
        for (int et = 0; et < 4; ++et) o[et] = (f32x4){0.f, 0.f, 0.f, 0.f};
#pragma unroll
        for (int kp = 0; kp < 4; ++kp) { const h16x8 pf = pack8(s[2 * kp], s[2 * kp + 1]);
#pragma unroll
            for (int et = 0; et < 4; ++et) o[et] = MFMA16(ldsfrag(VT + (16 * et + fr) * 136 + 32 * kp + 8 * fq), pf, o[et]); }
        const float gf = exp2f(l2g * (float)(il + 1)), gb = exp2f(l2g * (float)(128 - il));
#pragma unroll
        for (int ks = 0; ks < 2; ++ks) { const h16x8 qff = scalefrag(qf[ks], gf), qfb = scalefrag(qf[ks], gb);
#pragma unroll
            for (int et = 0; et < 4; ++et) { o[et] = MFMA16(ldsfrag(Ff + (16 * et + fr) * 72 + 32 * ks + 8 * fq), qff, o[et]); o[et] = MFMA16(ldsfrag(Fb + (16 * et + fr) * 72 + 32 * ks + 8 * fq), qfb, o[et]); } }
        float ss = 0.f;
#pragma unroll
        for (int et = 0; et < 4; ++et) ss += (o[et][0] * o[et][0] + o[et][1] * o[et][1]) + (o[et][2] * o[et][2] + o[et][3] * o[et][3]);
        ss += __shfl_xor(ss, 16); ss += __shfl_xor(ss, 32);
        const float rs = 1.0f / sqrtf(ss * (1.0f / 64.0f) + EPS);
#pragma unroll
        for (int et = 0; et < 4; ++et) { f32x4 q;
#pragma unroll
            for (int e = 0; e < 4; ++e) q[e] = o[et][e] * rs * siluf_((float)gc[et][e]);
            if (F8_OUT) *(unsigned*)(orow8 + h * 64 + 16 * et) = cvt4_fp8(8.f * q[0], 8.f * q[1], 8.f * q[2], 8.f * q[3]);
            else *(h16x4*)(orow + h * 64 + 16 * et) = pack4(q); }
    }
#undef RO_LOAD
    __syncthreads();
}
#undef RET_BAR

__device__ __forceinline__ void ssd_stage_dt(const Frame& F, const Prm& p, int l, int g, long t0, LAS float* LA, LAS float* DTS) {
    if (F.tid < 128) { const h16* dp = WSP(const h16, WS_R1) + (size_t)(t0 + F.tid) * NPJ + CDT + g * 3;
#pragma unroll
        for (int r = 0; r < 3; ++r) { const float raw = (float)dp[r];
#pragma unroll
            for (int dir = 0; dir < 2; ++dir) { const float dt = softplusf_(raw + inptr(F, 7)[(l * 2 + dir) * 6 + g * 3 + r]); const float la = -dt * __expf(inptr(F, 8)[(l * 2 + dir) * 6 + g * 3 + r]);
                DTS[(dir * 3 + r) * 128 + F.tid] = dt; LA[(dir * 3 + r) * 128 + F.tid] = la; } } }
}
__device__ __forceinline__ void ssd_cumsum(const Frame& F, LAS const float* LAq, float& v0, float& v1, float& c0, float& c1, float& tot) {
    v0 = LAq[2 * F.lane]; v1 = LAq[2 * F.lane + 1]; float s = v0 + v1;
#pragma unroll
    for (int o = 1; o < 64; o <<= 1) { const float t = __shfl_up(s, o); if (F.lane >= o) s += t; }
    c1 = s; c0 = s - v1; tot = __shfl(s, 63);
}
__device__ __forceinline__ void ssd_states_unit(const Frame& F, const Prm& p, int l, int u) {
    const int g = u & 1, bn = u >> 1, n = bn % NCH, b = bn / NCH; const long t0 = (long)b * SEQ + n * 128;
    const h16* proj = WSP(const h16, WS_R1);
    LAS h16* XT = (LAS h16*)F.lds; LAS h16* BT = XT + 3 * 64 * 136; LAS float* LA = (LAS float*)(BT + 128 * 136); LAS float* DTS = LA + 6 * 128; LAS float* WW = DTS + 6 * 128;
    ssd_stage_dt(F, p, l, g, t0, LA, DTS);
    const float* cw = inptr(F, 5) + (size_t)l * 4 * 896; const float* cb = inptr(F, 6) + (size_t)l * 896;
    h16* bcn = ((h16*)((unsigned char*)F.out + OUT_BCN));
    for (int task = F.tid; task < 56 * 16; task += 512) { const int cg = task % 56, r0 = (task / 56) * 8; h16x8 o[8];
        if (cg < 24) { conv_rows8<true>(proj + CXS + g * 192 + 8 * cg, t0, n, r0, cw + g * 192 + 8 * cg, 896, cb + g * 192 + 8 * cg, o);
            LAS h16* d = XT + (cg >> 3) * 64 * 136 + ((cg & 7) * 8) * 136 + r0;
#pragma unroll
            for (int e = 0; e < 8; ++e) *(LAS h16x8*)(d + e * 136) = col_of(o, e);
        } else { const int c8 = (cg - 24) & 15; const bool isB = cg < 40; const int col = (isB ? CBM : CCM) + g * 128 + 8 * c8, ci = (isB ? 384 : 640) + g * 128 + 8 * c8;
            conv_rows8<true>(proj + col, t0, n, r0, cw + ci, 896, cb + ci, o);
#pragma unroll
            for (int r = 0; r < 8; ++r) *(h16x8*)(bcn + (size_t)(t0 + r0 + r) * 512 + (isB ? 0 : 256) + g * 128 + 8 * c8) = o[r];
            if (isB) { LAS h16* d = BT + (8 * c8) * 136 + r0;
#pragma unroll
                for (int e = 0; e < 8; ++e) *(LAS h16x8*)(d + e * 136) = col_of(o, e); } } }
    __syncthreads();
    { h16* xtg = ((h16*)((unsigned char*)F.out + OUT_XTG)) + ((size_t)(b * NCH + n) * 6 + g * 3) * 8192;
#pragma unroll
        for (int k = 0; k < 6; ++k) { const int it = F.tid + 512 * k, rr = it >> 4, c = it & 15; const h16x8 v = *(LAS const h16x8*)(XT + rr * 136 + 8 * c);
            *(h16x4*)(xtg + rr * 128 + kperm32(8 * c)) = __builtin_shufflevector(v, v, 0, 1, 2, 3); *(h16x4*)(xtg + rr * 128 + kperm32(8 * c + 4)) = __builtin_shufflevector(v, v, 4, 5, 6, 7); } }
    if (F.wave < 6) { const int q = F.wave, dir = q / 3, r = q % 3; float v0, v1, c0, c1, tot; ssd_cumsum(F, LA + q * 128, v0, v1, c0, c1, tot);
        const float d0 = DTS[q * 128 + 2 * F.lane], d1 = DTS[q * 128 + 2 * F.lane + 1];
        if (dir == 0) { WW[q * 128 + 2 * F.lane] = __expf(tot - c0) * d0 * 256.f; WW[q * 128 + 2 * F.lane + 1] = __expf(tot - c1) * d1 * 256.f; }
        else { WW[q * 128 + 2 * F.lane] = __expf(c0 - v0) * d0 * 256.f; WW[q * 128 + 2 * F.lane + 1] = __expf(c1 - v1) * d1 * 256.f; }
        if (F.lane == 0) WSP(float, OFF_SDEC)[((size_t)(b * NCH + n) * 6 + g * 3 + r) * 2 + dir] = tot; }
    __syncthreads();
    const int w = F.wave, fr = F.lane & 15, fq = F.lane >> 4;
    h16x8 xb[4];
#pragma unroll
    for (int ks = 0; ks < 4; ++ks) xb[ks] = ldsfrag(BT + (16 * w + fr) * 136 + 32 * ks + 8 * fq);
    for (int q = 0; q < 6; ++q) { const int dir = q / 3, r = q % 3;
        h16x8 wf[4];
#pragma unroll
        for (int ks = 0; ks < 4; ++ks) { const f32x4 a = *(LAS const f32x4*)(WW + q * 128 + 32 * ks + 8 * fq), c = *(LAS const f32x4*)(WW + q * 128 + 32 * ks + 8 * fq + 4); wf[ks] = pack8(a, c); }
        h16* sst = WSP(h16, OFF_SST) + ((size_t)((dir * NB + b) * NCH + n) * 6 + g * 3 + r) * 8192;
#pragma unroll
        for (int pt = 0; pt < 4; ++pt) { f32x4 acc = {0.f, 0.f, 0.f, 0.f};
#pragma unroll
            for (int ks = 0; ks < 4; ++ks) acc = MFMA16(xb[ks], ldsfrag(XT + r * 64 * 136 + (16 * pt + fr) * 136 + 32 * ks + 8 * fq) * wf[ks], acc);
            *(h16x4*)(sst + (16 * pt + fr) * 128 + 16 * w + 4 * fq) = pack4(acc * (1.0f / 256.f)); } }
    __syncthreads();
}
__device__ __forceinline__ void ssd_scan_unit(const Frame& F, int uh) {
    const int u = uh >> 1, hd = u % 6, b = (u / 6) % NB, dir = u / (6 * NB);
    h16* base = WSP(h16, OFF_SST) + ((size_t)((dir * NB + b) * NCH) * 6 + hd) * 8192 + (uh & 1) * 4096 + F.tid * 8;
    const float* dbase = WSP(const float, OFF_SDEC) + ((size_t)(b * NCH) * 6 + hd) * 2 + dir;
    float acc[8]; float zf = 0.f; asm volatile("" : "+v"(zf));
#pragma unroll
    for (int e = 0; e < 8; ++e) acc[e] = zf;
    h16x8 sv[16]; float dec[16];
#pragma unroll
    for (int i = 0; i < 16; ++i) { const int n = dir == 0 ? i : NCH - 1 - i; sv[i] = *(const h16x8*)(base + (size_t)n * 6 * 8192); dec[i] = dbase[n * 12]; }
#pragma unroll
    for (int i = 0; i < 16; ++i) { const int n = dir == 0 ? i : NCH - 1 - i; const float dc = __expf(dec[i]); h16x8 o;
#pragma unroll
        for (int e = 0; e < 8; ++e) { o[e] = (h16)acc[e]; acc[e] = acc[e] * dc + (float)sv[i][e]; }
        *(h16x8*)(base + (size_t)n * 6 * 8192) = o; }
}
__device__ __forceinline__ void ssd_out_unit(const Frame& F, const Prm& p, int l, int u) {
    const int g = u & 1, bn = u >> 1, n = bn % NCH, b = bn / NCH; const long t0 = (long)b * SEQ + n * 128;
    const h16* proj = WSP(const h16, WS_R1);
    LAS h16* XT = (LAS h16*)F.lds; LAS h16* Bt = XT + 3 * 64 * 136; LAS h16* Ct = Bt + 128 * 136; LAS float* LA = (LAS float*)(Ct + 128 * 136); LAS float* DTS = LA + 6 * 128;
    LAS float* CE = DTS + 6 * 128;
    LAS float* TOTB = CE + 6 * 128;
    ssd_stage_dt(F, p, l, g, t0, LA, DTS);
    const float* cw = inptr(F, 5) + (size_t)l * 4 * 896; const float* cb = inptr(F, 6) + (size_t)l * 896;
    { const h16* xtg = ((const h16*)((const unsigned char*)F.out + OUT_XTG)) + ((size_t)(b * NCH + n) * 6 + g * 3) * 8192; const h16* bcn = ((const h16*)((const unsigned char*)F.out + OUT_BCN)) + (size_t)t0 * 512 + g * 128;
        h16x8 xv[6], bv[8];
#pragma unroll
        for (int k = 0; k < 6; ++k) { const int it = F.tid + 512 * k; xv[k] = NTL(h16x8, xtg + (it >> 4) * 128 + 8 * (it & 15)); }
#pragma unroll
        for (int k = 0; k < 8; ++k) { const int it = F.tid + 512 * k, row = it >> 5, c = it & 31; bv[k] = NTL(h16x8, bcn + (size_t)row * 512 + (c < 16 ? 8 * c : 256 + 8 * (c - 16))); }
#pragma unroll
        for (int k = 0; k < 6; ++k) { const int it = F.tid + 512 * k; *(LAS h16x8*)(XT + (it >> 4) * 136 + 8 * (it & 15)) = xv[k]; }
#pragma unroll
        for (int k = 0; k < 8; ++k) { const int it = F.tid + 512 * k, row = it >> 5, c = it & 31; *(LAS h16x8*)((c < 16 ? Bt : Ct) + row * 136 + 8 * (c & 15)) = bv[k]; }
        PIN(); }
    __syncthreads();
    if (F.wave < 6) { const int q = F.wave; float v0, v1, c0, c1, tot; ssd_cumsum(F, LA + q * 128, v0, v1, c0, c1, tot);
        if (q < 3) { CE[q * 128 + 2 * F.lane] = c0; CE[q * 128 + 2 * F.lane + 1] = c1; }
        else { CE[q * 128 + 2 * F.lane] = c0 - v0; CE[q * 128 + 2 * F.lane + 1] = c1 - v1; if (F.lane == 0) TOTB[q - 3] = tot; } }
    __syncthreads();
    const int w = F.wave, fr = F.lane & 15, fq = F.lane >> 4, il = 16 * w + fr;
    h16x8 cf[4];
#pragma unroll
    for (int ks = 0; ks < 4; ++ks) cf[ks] = ldsfrag(Ct + il * 136 + 32 * ks + 8 * fq);
    f32x4 gT[8];
#pragma unroll
    for (int jt = 0; jt < 8; ++jt) { f32x4 a = {0.f, 0.f, 0.f, 0.f};
#pragma unroll
        for (int ks = 0; ks < 4; ++ks) a = MFMA16(ldsfrag(Bt + (16 * jt + fr) * 136 + 32 * ks + 8 * fq), cf[ks], a);
        PINV(a); gT[jt] = a; }
    const float* dsk = inptr(F, 9) + l * 6 + g * 3;
    h16* orow = WSP(h16, OFF_OMIX) + (size_t)(t0 + il) * DM + 384 + g * 192;
    float ss = 0.f;
    { h16x8 h0[4];
#pragma unroll
        for (int k = 0; k < 4; ++k) { const int it = F.tid + 512 * k, dir = it >> 10, e = it & 1023; h0[k] = NTL(h16x8, WSP(const h16, OFF_SST) + ((size_t)((dir * NB + b) * NCH + n) * 6 + g * 3) * 8192 + e * 8); }
        __syncthreads();
#pragma unroll
        for (int k = 0; k < 4; ++k) { const int it = F.tid + 512 * k, dir = it >> 10, e = it & 1023; *(LAS h16x8*)(Bt + dir * 64 * 136 + (e >> 4) * 136 + 8 * (e & 15)) = h0[k]; }
        __syncthreads(); }
#pragma unroll 1
    for (int r = 0; r < 3; ++r) {
        f32x4 y[1][4];
        const int hd = g * 3 + r;
        const float cfi = CE[r * 128 + il], ebi = CE[(3 + r) * 128 + il], totb = TOTB[r];
#pragma unroll
        for (int pt = 0; pt < 4; ++pt) y[0][pt] = (f32x4){0.f, 0.f, 0.f, 0.f};
        LAS const h16* HL = (r & 1) ? Ct : Bt;
        h16x8 hreg[4];
        if (r < 2) {
#pragma unroll
            for (int k = 0; k < 4; ++k) { const int it = F.tid + 512 * k, dir = it >> 10, e = it & 1023; hreg[k] = NTL(h16x8, WSP(const h16, OFF_SST) + ((size_t)((dir * NB + b) * NCH + n) * 6 + hd + 1) * 8192 + e * 8); } }
#pragma unroll
        for (int kp = 0; kp < 4; ++kp) { f32x4 pv[2];
#pragma unroll
            for (int jh = 0; jh < 2; ++jh) { const int jt = 2 * kp + jh, j0 = 16 * jt + 4 * fq;
                const f32x4 cfj = *(LAS const f32x4*)(CE + r * 128 + j0), ebj = *(LAS const f32x4*)(CE + (3 + r) * 128 + j0), dfj = *(LAS const f32x4*)(DTS + r * 128 + j0), dbj = *(LAS const f32x4*)(DTS + (3 + r) * 128 + j0);
#pragma unroll
                for (int e = 0; e < 4; ++e) { const int j = j0 + e; const float val = (il >= j) ? __expf(cfi - cfj[e]) * dfj[e] : __expf(ebj[e] - ebi) * dbj[e]; pv[jh][e] = gT[jt][e] * val * 256.f; }
                PINV(pv[jh]); }
            const h16x8 pf = pack8(pv[0], pv[1]);
#pragma unroll
            for (int pt = 0; pt < 4; ++pt) y[0][pt] = MFMA16(ldsfrag(XT + r * 64 * 136 + (16 * pt + fr) * 136 + 32 * kp + 8 * fq), pf, y[0][pt]);
            PINV(y[0][0]); PINV(y[0][1]); PINV(y[0][2]); PINV(y[0][3]); }
        const float ef = __expf(cfi) * 256.f, eb = __expf(totb - ebi) * 256.f;
#pragma unroll
        for (int ks = 0; ks < 4; ++ks) { const h16x8 cff = scalefrag(cf[ks], ef), cfb = scalefrag(cf[ks], eb);
#pragma unroll
            for (int pt = 0; pt < 4; ++pt) { y[0][pt] = MFMA16(ldsfrag(HL + (16 * pt + fr) * 136 + 32 * ks + 8 * fq), cff, y[0][pt]); y[0][pt] = MFMA16(ldsfrag(HL + 64 * 136 + (16 * pt + fr) * 136 + 32 * ks + 8 * fq), cfb, y[0][pt]); }
            PINV(y[0][0]); PINV(y[0][1]); PINV(y[0][2]); PINV(y[0][3]); }
        if (r < 2) { LAS h16* HN = (r & 1) ? Bt : Ct;
#pragma unroll
            for (int k = 0; k < 4; ++k) { const int it = F.tid + 512 * k, dir = it >> 10, e = it & 1023; *(LAS h16x8*)(HN + dir * 64 * 136 + (e >> 4) * 136 + 8 * (e & 15)) = hreg[k]; } }
        const float dk = dsk[r]; const h16* zrow = proj + (size_t)(t0 + il) * NPJ + CZ + hd * 64;
#pragma unroll
        for (int pt = 0; pt < 4; ++pt) { const h16x4 zv = NTL(h16x4, zrow + 16 * pt + 4 * fq);
#pragma unroll
            for (int e = 0; e < 4; ++e) { const float xv = (float)XT[r * 64 * 136 + (16 * pt + 4 * fq + e) * 136 + kperm32(il)]; y[0][pt][e] = (y[0][pt][e] * (1.0f / 256.f) + dk * xv) * siluf_((float)zv[e]); }
            const h16x4 yh = pack4(y[0][pt]); *(h16x4*)(orow + r * 64 + 16 * pt + 4 * fq) = yh;
#pragma unroll
            for (int e = 0; e < 4; ++e) { const float q = (float)yh[e]; ss += q * q; } }
        __syncthreads();
    }
    ss += __shfl_xor(ss, 16); ss += __shfl_xor(ss, 32);
    const float rs = 1.0f / sqrtf(ss * (1.0f / 192.0f) + EPS);
    const float* nw = inptr(F, 10) + l * 384 + g * 192;
    asm volatile("s_waitcnt vmcnt(0)" ::: "memory");
#pragma unroll 1
    for (int r = 0; r < 3; ++r)
#pragma unroll
        for (int pt = 0; pt < 4; ++pt) { const f32x4 wv = *(const f32x4*)(nw + r * 64 + 16 * pt + 4 * fq); h16* op = orow + r * 64 + 16 * pt + 4 * fq; const h16x4 yh = *(const h16x4*)op; f32x4 yv;
#pragma unroll
            for (int e = 0; e < 4; ++e) yv[e] = (float)yh[e] * rs * wv[e];
            if (F8_OUT) *(unsigned*)(WSP(unsigned char, OFF_OMIX8) + (size_t)(t0 + il) * DM + 384 + g * 192 + r * 64 + 16 * pt + 4 * fq) = cvt4_fp8(8.f * yv[0], 8.f * yv[1], 8.f * yv[2], 8.f * yv[3]);
            else *(h16x4*)op = pack4(yv); }
    __syncthreads();
}

__device__ __forceinline__ void lru_unit(const Frame& F, const Prm& p, int l, int u) {
    const int n = u % NCH, b = u / NCH; const long t0 = (long)b * SEQ + n * 128;
    const h16* proj = WSP(const h16, WS_R1);
    LAS h16* XC = (LAS h16*)F.lds;
    const float* cw = inptr(F, 11) + (size_t)l * 4 * 256; const float* cb = inptr(F, 12) + (size_t)l * 256;
    { const int cg = F.tid & 31, r0 = (F.tid >> 5) * 8; h16x8 o[8];
        conv_rows8<false>(proj + CXR + 8 * cg, t0, n, r0, cw + 8 * cg, 256, cb + 8 * cg, o);
#pragma unroll
        for (int r = 0; r < 8; ++r) *(LAS h16x8*)(XC + (r0 + r) * 264 + 8 * cg) = o[r]; }
    __syncthreads();
    const int blk = F.wave & 3, jh = F.wave >> 2, fr = F.lane & 15, fq = F.lane >> 4;
    h16* lau = (h16*)((unsigned char*)F.out + OUT_LAU) + (size_t)(b * NCH + n) * 2 * 128 * 256 * 2;
    h16x8 wa[2][2][2], wx[2][2][2]; float ba[2][2], bx[2][2], sp[2][2], car[2][2], atot[2][2];
#pragma unroll
    for (int dir = 0; dir < 2; ++dir)
#pragma unroll
        for (int jt = 0; jt < 2; ++jt) { const int ch = blk * 64 + 32 * jh + 16 * jt + fr;
#pragma unroll
            for (int ks = 0; ks < 2; ++ks) { wa[dir][jt][ks] = *(const h16x8*)(WSP(const h16, WS_LRUW) + (size_t)((dir * 2 + 0) * 4 + blk) * 4096 + (32 * jh + 16 * jt + fr) * 64 + 32 * ks + 8 * fq);
                wx[dir][jt][ks] = *(const h16x8*)(WSP(const h16, WS_LRUW) + (size_t)((dir * 2 + 1) * 4 + blk) * 4096 + (32 * jh + 16 * jt + fr) * 64 + 32 * ks + 8 * fq); }
            ba[dir][jt] = inptr(F, 15)[(l * 2 + dir) * 256 + ch]; bx[dir][jt] = inptr(F, 17)[(l * 2 + dir) * 256 + ch]; sp[dir][jt] = softplusf_(-inptr(F, 13)[(l * 2 + dir) * 256 + ch]);
            car[dir][jt] = 0.f; atot[dir][jt] = 1.f; }
#pragma unroll 1
    for (int ti = 0; ti < 8; ++ti) {
#pragma unroll
        for (int dir = 0; dir < 2; ++dir) { const int tt = dir == 0 ? ti : 7 - ti;
            h16x8 xf[2];
#pragma unroll
            for (int ks = 0; ks < 2; ++ks) xf[ks] = ldsfrag(XC + (16 * tt + fr) * 264 + blk * 64 + 32 * ks + 8 * fq);
#pragma unroll
            for (int jt = 0; jt < 2; ++jt) { const int ch = blk * 64 + 32 * jh + 16 * jt + fr;
                f32x4 ra = {0.f, 0.f, 0.f, 0.f}, ia = {0.f, 0.f, 0.f, 0.f};
#pragma unroll
                for (int ks = 0; ks < 2; ++ks) { ra = MFMA16(xf[ks], wa[dir][jt][ks], ra); ia = MFMA16(xf[ks], wx[dir][jt][ks], ia); }
                float A = 1.f, H = 0.f;
#pragma unroll
                for (int ri = 0; ri < 4; ++ri) { const int rg = dir == 0 ? ri : 3 - ri;
                    const float e1 = 1.0f + __expf(-(ra[rg] + ba[dir][jt])), e2 = 1.0f + __expf(-(ia[rg] + bx[dir][jt])); const float inv = __builtin_amdgcn_rcpf(e1 * e2);
                    const float rgate = inv * e2, ig = inv * e1;
                    const float la = -8.0f * rgate * sp[dir][jt]; const float a = __expf(la); const float y = 2.0f * la;
                    const float om = y > -0.1f ? -y * (1.0f + y * (0.5f + y * (1.0f / 6.0f))) : 1.0f - a * a;
                    const float mult = __builtin_amdgcn_sqrtf(om);
                    const float xv = (float)XC[(16 * tt + 4 * fq + rg) * 264 + ch]; const float uu = mult * ig * xv;
                    H = a * H + uu; A *= a;
                    { h16x2 pk; pk[0] = (h16)la; pk[1] = (h16)uu; *(h16x2*)(lau + ((size_t)dir * 128 + 16 * tt + 4 * fq + rg) * 256 * 2 + 2 * ch) = pk; } }
                float Ag[4], Hg[4];
#pragma unroll
                for (int gq = 0; gq < 4; ++gq) { Ag[gq] = __shfl(A, fr + 16 * gq); Hg[gq] = __shfl(H, fr + 16 * gq); }
                float cnew = car[dir][jt], at = 1.f;
#pragma unroll
                for (int gi = 0; gi < 4; ++gi) { const int gq = dir == 0 ? gi : 3 - gi;
                    cnew = Ag[gq] * cnew + Hg[gq]; at *= Ag[gq]; }
                car[dir][jt] = cnew; atot[dir][jt] *= at;
            } } }
    if (fq == 0) {
#pragma unroll
        for (int dir = 0; dir < 2; ++dir)
#pragma unroll
            for (int jt = 0; jt < 2; ++jt) { const int ch = blk * 64 + 32 * jh + 16 * jt + fr; *(f32x2*)(WSP(float, OFF_LSUM) + (((size_t)(b * NCH + n) * 2 + dir) * 256 + ch) * 2) = (f32x2){atot[dir][jt], car[dir][jt]}; } }
    __syncthreads();
}
__device__ __forceinline__ void lru_out_unit(const Frame& F, int u) {
    const int n = u % NCH, b = u / NCH; const long t0 = (long)b * SEQ + n * 128;
    const h16* proj = WSP(const h16, WS_R1);
    LAS h16* HT = (LAS h16*)F.lds;
    const int blk = F.wave & 3, jh = F.wave >> 2, fr = F.lane & 15, fq = F.lane >> 4;
    const h16* lau = (const h16*)((const unsigned char*)F.out + OUT_LAU) + (size_t)(b * NCH + n) * 2 * 128 * 256 * 2;
    float car[2][2];
#pragma unroll
    for (int dir = 0; dir < 2; ++dir)
#pragma unroll
        for (int jt = 0; jt < 2; ++jt) car[dir][jt] = WSP(const float, OFF_LCAR)[((size_t)(b * NCH + n) * 2 + dir) * 256 + blk * 64 + 32 * jh + 16 * jt + fr];
#pragma unroll 1
    for (int ti = 0; ti < 8; ++ti) {
#pragma unroll
        for (int dir = 0; dir < 2; ++dir) { const int tt = dir == 0 ? ti : 7 - ti;
            h16x2 pk[2][4]; h16 gtv[2][4], ov[2][4];
#pragma unroll
            for (int jt = 0; jt < 2; ++jt)
#pragma unroll
                for (int rg = 0; rg < 4; ++rg) { const int tl = 16 * tt + 4 * fq + rg, ch = blk * 64 + 32 * jh + 16 * jt + fr;
                    pk[jt][rg] = NTL(h16x2, lau + ((size_t)dir * 128 + tl) * 256 * 2 + 2 * ch); gtv[jt][rg] = NTL(h16, proj + (size_t)(t0 + tl) * NPJ + CGT + ch); ov[jt][rg] = ti >= 4 ? HT[tl * 264 + ch] : (h16)0.f; }
#pragma unroll
            for (int jt = 0; jt < 2; ++jt) { const int ch = blk * 64 + 32 * jh + 16 * jt + fr;
                float av[4], uv[4]; float A = 1.f, H = 0.f;
#pragma unroll
                for (int ri = 0; ri < 4; ++ri) { const int rg = dir == 0 ? ri : 3 - ri; const float a = __expf((float)pk[jt][rg][0]); const float uu = (float)pk[jt][rg][1]; av[rg] = a; uv[rg] = uu; H = a * H + uu; A *= a; }
                float Ag[4], Hg[4];
#pragma unroll
                for (int gq = 0; gq < 4; ++gq) { Ag[gq] = __shfl(A, fr + 16 * gq); Hg[gq] = __shfl(H, fr + 16 * gq); }
                float hin = car[dir][jt], cnew = car[dir][jt];
#pragma unroll
                for (int gi = 0; gi < 4; ++gi) { const int gq = dir == 0 ? gi : 3 - gi; const bool before = dir == 0 ? (gq < fq) : (gq > fq);
                    if (before) hin = Ag[gq] * hin + Hg[gq];
                    cnew = Ag[gq] * cnew + Hg[gq]; }
                car[dir][jt] = cnew;
                float hh = hin;
#pragma unroll
                for (int ri = 0; ri < 4; ++ri) { const int rg = dir == 0 ? ri : 3 - ri; hh = av[rg] * hh + uv[rg];
                    HT[(16 * tt + 4 * fq + rg) * 264 + ch] = (h16)((float)ov[jt][rg] + hh * gelu_tanh_((float)gtv[jt][rg])); } } } }
    __syncthreads();
#pragma unroll
    for (int k = 0; k < 8; ++k) { const int it = F.tid + 512 * k, row = it >> 5, c8 = it & 31; const h16x8 hv = *(LAS const h16x8*)(HT + row * 264 + 8 * c8);
        if (F8_OUT) *(u32x2*)(WSP(unsigned char, OFF_OMIX8) + (size_t)(t0 + row) * DM + 768 + 8 * c8) = (u32x2){cvt4_fp8(8.f * (float)hv[0], 8.f * (float)hv[1], 8.f * (float)hv[2], 8.f * (float)hv[3]), cvt4_fp8(8.f * (float)hv[4], 8.f * (float)hv[5], 8.f * (float)hv[6], 8.f * (float)hv[7])};
        else *(h16x8*)(WSP(h16, OFF_OMIX) + (size_t)(t0 + row) * DM + 768 + 8 * c8) = hv; }
    __syncthreads();
}
__device__ __forceinline__ void lru_scan(const Frame& F, int blk) {
    const int gi = blk * 512 + F.tid; if (blk < 0 || gi >= NB * 2 * 256) return;
    const int ch = gi & 255, dir = (gi >> 8) & 1, b = gi >> 9; float H = 0.f;
    for (int i = 0; i < NCH; ++i) { const int n = dir == 0 ? i : NCH - 1 - i; const size_t idx = ((size_t)(b * NCH + n) * 2 + dir) * 256 + ch;
        const f32x2 s = *(const f32x2*)(WSP(const float, OFF_LSUM) + idx * 2); WSP(float, OFF_LCAR)[idx] = H; H = s[0] * H + s[1]; }
}

__device__ __forceinline__ void attn_phase(const Frame& F) {
    constexpr int NU = NB * 4 * 8;
    LAS unsigned char* B0 = F.lds; LAS unsigned char* B1 = F.lds + 67584;
    int u = F.vcu; if (u >= NU) return;
    int lanel = F.lane; asm volatile("" : "+v"(lanel)); int fr = lanel & 15, fq = lanel >> 4;
    const int w = F.wave;
    h16x8 qf[2][8];
#define AT_DMA(buf, src, rowstride) do { asm volatile("" : "+v"(lanel)); if (lanel < 32) { _Pragma("unroll") for (int i_ = 0; i_ < 16; ++i_) \
        __builtin_amdgcn_global_load_lds((const unsigned*)((src) + (size_t)(16 * w + i_) * (rowstride) + 8 * lanel), (LAS unsigned*)((buf) + (16 * w + i_) * 528), 16, 0, 0); } } while (0)
#define AT_FRAG(buf, row, chunk) (*(LAS const h16x8*)((buf) + (row) * 528 + (chunk) * 16))
#define AT_WAITBAR() do { asm volatile("s_waitcnt vmcnt(0) lgkmcnt(0)" ::: "memory"); __builtin_amdgcn_s_barrier(); asm volatile("" ::: "memory"); } while (0)
#define AT_LOADQ(uu) do { _Pragma("unroll") for (int a_ = 0; a_ < 2; ++a_) { const long t_ = (long)((uu) >> 5) * SEQ + ((uu) & 7) * 256 + 32 * w + 16 * a_ + fr; const h16* q_ = WSP(const h16, OFF_QCA) + (size_t)t_ * DM + (((uu) >> 3) & 3) * 256; \
        _Pragma("unroll") for (int ks_ = 0; ks_ < 8; ++ks_) qf[a_][ks_] = NTL(h16x8, q_ + 32 * ks_ + 8 * fq); } } while (0)
    { const int b = u >> 5, hd = (u >> 3) & 3; AT_DMA(B0, WSP(const h16, OFF_KB) + (size_t)(b * 256) * DM + hd * 256, DM); }
    for (; u < NU; u += F.G) {
        const int qb = u & 7, hd = (u >> 3) & 3, b = u >> 5; const int un = u + F.G; const bool has_next = un < NU;
        asm volatile("" : "+v"(lanel)); fr = lanel & 15; fq = lanel >> 4;
        const h16* kb = WSP(const h16, OFF_KB) + (size_t)(b * 256) * DM + hd * 256; const h16* vt = WSP(const h16, OFF_VT) + (size_t)(b * 4 + hd) * 65536;
        AT_LOADQ(u);
        h16x8 pf[2][8]; float mq[2][4], Mr[2] = {-3.0e38f, -3.0e38f}, Lr[2] = {0.f, 0.f};
#pragma unroll
        for (int h = 0; h < 2; ++h) {
            AT_WAITBAR();
            if (h == 0) AT_DMA(B1, kb + (size_t)128 * DM, DM); else AT_DMA(B0, vt, 256);
            LAS const unsigned char* KB_ = h == 0 ? B0 : B1;
#pragma unroll
            for (int jh = 0; jh < 2; ++jh) { const int qd = 2 * h + jh; f32x4 s[2][4]; h16x8 kf[2][4];
#pragma unroll
                for (int j4 = 0; j4 < 4; ++j4) { s[0][j4] = (f32x4){0.f, 0.f, 0.f, 0.f}; s[1][j4] = (f32x4){0.f, 0.f, 0.f, 0.f}; kf[0][j4] = AT_FRAG(KB_, 16 * (4 * jh + j4) + fr, fq); }
#pragma unroll
                for (int ks = 0; ks < 8; ++ks) {
                    if (ks < 7) {
#pragma unroll
                        for (int j4 = 0; j4 < 4; ++j4) kf[(ks + 1) & 1][j4] = AT_FRAG(KB_, 16 * (4 * jh + j4) + fr, 4 * (ks + 1) + fq); }
                    PIN();
#pragma unroll
                    for (int j4 = 0; j4 < 4; ++j4) { s[0][j4] = MFMA16(kf[ks & 1][j4], qf[0][ks], s[0][j4]); s[1][j4] = MFMA16(kf[ks & 1][j4], qf[1][ks], s[1][j4]); }
                    PINV(s[0][0]); PINV(s[1][3]); }
#pragma unroll
                for (int a = 0; a < 2; ++a) { float mx = fmaxf(fmaxf(s[a][0][0], s[a][0][1]), fmaxf(s[a][0][2], s[a][0][3]));
#pragma unroll
                    for (int jt = 1; jt < 4; ++jt) mx = fmaxf(mx, fmaxf(fmaxf(s[a][jt][0], s[a][jt][1]), fmaxf(s[a][jt][2], s[a][jt][3])));
                    mx = fmaxf(mx, __shfl_xor(mx, 16)); mx = fmaxf(mx, __shfl_xor(mx, 32));
                    float sum = 0.f;
#pragma unroll
                    for (int jt = 0; jt < 4; ++jt)
#pragma unroll
                        for (int e = 0; e < 4; ++e) { const float pe = __expf(s[a][jt][e] - mx); s[a][jt][e] = pe; sum += pe; }
                    sum += __shfl_xor(sum, 16); sum += __shfl_xor(sum, 32);
                    mq[a][qd] = mx; { const float Mn = fmaxf(Mr[a], mx); Lr[a] = Lr[a] * __expf(Mr[a] - Mn) + sum * __expf(mx - Mn); Mr[a] = Mn; }
                    pf[a][2 * qd] = pack8(s[a][0], s[a][1]); pf[a][2 * qd + 1] = pack8(s[a][2], s[a][3]); } }
        }
#pragma unroll
        for (int a = 0; a < 2; ++a) { const float inv = 1.0f / Lr[a];
#pragma unroll
            for (int q = 0; q < 4; ++q) { const float cq = __expf(mq[a][q] - Mr[a]) * inv; pf[a][2 * q] = scalefrag(pf[a][2 * q], cq); pf[a][2 * q + 1] = scalefrag(pf[a][2 * q + 1], cq); } }
#pragma unroll
        for (int d = 0; d < 2; ++d) {
            AT_WAITBAR();
            if (d == 0) AT_DMA(B1, vt + (size_t)128 * 256, 256);
            else if (has_next) AT_DMA(B0, WSP(const h16, OFF_KB) + (size_t)((un >> 5) * 256) * DM + ((un >> 3) & 3) * 256, DM);
            LAS const unsigned char* VB_ = d == 0 ? B0 : B1;
#pragma unroll
            for (int eh = 0; eh < 2; ++eh) { f32x4 o[2][4]; h16x8 vf[2][4];
#pragma unroll
                for (int e4 = 0; e4 < 4; ++e4) { o[0][e4] = (f32x4){0.f, 0.f, 0.f, 0.f}; o[1][e4] = (f32x4){0.f, 0.f, 0.f, 0.f}; vf[0][e4] = AT_FRAG(VB_, 16 * (4 * eh + e4) + fr, fq); }
#pragma unroll
                for (int kp = 0; kp < 8; ++kp) {
                    if (kp < 7) {
#pragma unroll
                        for (int e4 = 0; e4 < 4; ++e4) vf[(kp + 1) & 1][e4] = AT_FRAG(VB_, 16 * (4 * eh + e4) + fr, 4 * (kp + 1) + fq); }
                    PIN();
#pragma unroll
                    for (int e4 = 0; e4 < 4; ++e4) { o[0][e4] = MFMA16(vf[kp & 1][e4], pf[0][kp], o[0][e4]); o[1][e4] = MFMA16(vf[kp & 1][e4], pf[1][kp], o[1][e4]); }
                    PINV(o[0][0]); PINV(o[1][3]); }
#pragma unroll
                for (int a = 0; a < 2; ++a) { const long t = (long)b * SEQ + qb * 256 + 32 * w + 16 * a + fr; h16* orow = WSP(h16, OFF_OATT) + (size_t)t * DM + hd * 256 + 128 * d + 64 * eh;
#pragma unroll
                    for (int e4 = 0; e4 < 4; ++e4) { if (F8_O) *(unsigned*)(WSP(unsigned char, OFF_OATT) + (size_t)t * DM + hd * 256 + 128 * d + 64 * eh + 16 * e4 + 4 * fq) = cvt4_fp8(16.f * o[a][e4][0], 16.f * o[a][e4][1], 16.f * o[a][e4][2], 16.f * o[a][e4][3]);
                        else *(h16x4*)(orow + 16 * e4 + 4 * fq) = pack4(o[a][e4]); } } }
        }
    }
    asm volatile("s_waitcnt vmcnt(0) lgkmcnt(0)" ::: "memory");
    __syncthreads();
#undef AT_DMA
#undef AT_FRAG
#undef AT_WAITBAR
#undef AT_LOADQ
}

__device__ __forceinline__ void phase_router(const Frame& F, const Prm& p, int l) {
    LAS h16* RW = (LAS h16*)F.lds;
    { const h16* rwg = WSP(const h16, OFF_RWG);
        for (int i = F.tid; i < 72 * 1032 / 8; i += 512) *(LAS h16x8*)(RW + 8 * i) = *(const h16x8*)(rwg + 8 * i); }
    LAS unsigned* hist = (LAS unsigned*)(F.lds + 72 * 1032 * 2);
    if (F.tid < 32) hist[F.tid] = 0u;
    if (F.G == 256) { for (int i = (int)blockIdx.x * 512 + F.tid; i < MAXSLOT; i += 256 * 512) WSP(int, OFF_STOK)[i] = 0; }
    else if (blockIdx.x == 0) { for (int i = F.tid; i < MAXSLOT; i += 512) WSP(int, OFF_STOK)[i] = 0; }
    const int gw = F.vcu * 8 + F.wave, NGW = F.G * 8, fr = F.lane & 15, fq = F.lane >> 4;
    h16x8 hf[16];
    if (gw < NT / 16) { const h16* hp0 = WSP(const h16, WS_HB) + (size_t)(gw * 16 + fr) * DM + 8 * fq;
#pragma unroll
        for (int q = 0; q < 16; ++q) hf[q] = *(const h16x8*)(hp0 + 32 * q); }
    __syncthreads();
    for (int tg = gw; tg < NT / 16; tg += NGW) {
        const int tok = tg * 16 + fr;
        const h16* hp = WSP(const h16, WS_HB) + (size_t)tok * DM + 8 * fq;
        f32x4 acc[3]; LAS const h16* wrow[3];
#pragma unroll
        for (int mt = 0; mt < 3; ++mt) { acc[mt] = (f32x4){0.f, 0.f, 0.f, 0.f}; const int j = (16 * mt + fr) < 36 ? (16 * mt + fr) : 35; wrow[mt] = RW + j * 1032 + 8 * fq; }
#pragma unroll
        for (int half = 0; half < 2; ++half) {
            if (half == 1) {
#pragma unroll
                for (int q = 0; q < 16; ++q) hf[q] = *(const h16x8*)(hp + 32 * (16 + q)); }
#pragma unroll
            for (int q = 0; q < 16; ++q) { const int ks = 16 * half + q;
#pragma unroll
                for (int mt = 0; mt < 3; ++mt) { acc[mt] = MFMA16(ldsfrag(wrow[mt] + 32 * ks), hf[q], acc[mt]); acc[mt] = MFMA16(ldsfrag(wrow[mt] + 36 * 1032 + 32 * ks), hf[q], acc[mt]); } } }
#pragma unroll
        for (int mt = 0; mt < 3; ++mt) acc[mt] *= (1.0f / 1024.0f);
        if (tg + NGW < NT / 16) { const h16* hpn = WSP(const h16, WS_HB) + (size_t)((tg + NGW) * 16 + fr) * DM + 8 * fq;
#pragma unroll
            for (int q = 0; q < 16; ++q) hf[q] = *(const h16x8*)(hpn + 32 * q); }
        const float rs = row_rstd(WSP(const float, WS_SSQ) + (size_t)tok * 16);
        float gl[4];
#pragma unroll
        for (int r = 0; r < 4; ++r) gl[r] = __shfl(acc[0][r], fr) * rs + inptr(F, 25)[l * 4 + r];
        int gi = 0; float gmx = gl[0];
#pragma unroll
        for (int j = 1; j < 4; ++j) if (gl[j] > gmx) { gmx = gl[j]; gi = j; }
        float gsum = 0.f;
#pragma unroll
        for (int j = 0; j < 4; ++j) gsum += __expf(gl[j] - gmx);
        const float gp = 1.0f / gsum;
        const int src1 = fr + 16 * (1 + 2 * (gi & 1)), src2 = fr + 16 * (2 - 2 * (gi & 1)), mt1 = gi >> 1, mt2 = (gi + 1) >> 1;
        float el[8];
#pragma unroll
        for (int k = 0; k < 4; ++k) { const float a0 = __shfl(acc[0][k], src1), a1 = __shfl(acc[1][k], src1); el[k] = (mt1 ? a1 : a0) * rs + inptr(F, 27)[l * 32 + gi * 8 + k];
            const float b0 = __shfl(acc[0][k], src2), b1 = __shfl(acc[1][k], src2), b2 = __shfl(acc[2][k], src2); el[4 + k] = (mt2 == 0 ? b0 : (mt2 == 1 ? b1 : b2)) * rs + inptr(F, 27)[l * 32 + gi * 8 + 4 + k]; }
        int e1 = 0; float m1 = el[0];
#pragma unroll
        for (int j = 1; j < 8; ++j) if (el[j] > m1) { m1 = el[j]; e1 = j; }
        int e2 = -1; float m2 = -3.0e38f;
#pragma unroll
        for (int j = 0; j < 8; ++j) if (j != e1 && el[j] > m2) { m2 = el[j]; e2 = j; }
        const float r2 = __expf(m2 - m1); const float g1 = gp / (1.0f + r2), g2 = gp * r2 / (1.0f + r2);
        if (fq == 0) { const int x1 = gi * 8 + e1, x2 = gi * 8 + e2;
            *(int2*)(WSP(int, OFF_EID) + (size_t)tok * 2) = make_int2(x1, x2); *(f32x2*)(WSP(float, OFF_GATE) + (size_t)tok * 2) = (f32x2){g1, g2};
            WSP(float, OFF_RSTDT)[tok] = rs; __hip_atomic_fetch_add(&hist[x1], 1u, __ATOMIC_RELAXED, __HIP_MEMORY_SCOPE_WORKGROUP); __hip_atomic_fetch_add(&hist[x2], 1u, __ATOMIC_RELAXED, __HIP_MEMORY_SCOPE_WORKGROUP); }
    }
    __syncthreads();
    if (F.tid < 32 && hist[F.tid]) atomicAdd(WSP(unsigned, WS_CTL) + CW_COUNTS + l * 64 + F.tid, hist[F.tid]);
    __syncthreads();
}
__device__ __forceinline__ void phase_dispatch(const Frame& F, int l) {
    LAS int* cnt = (LAS int*)F.lds; LAS int* base = cnt + 32; LAS int* pstart = base + 32; LAS int* slots = pstart + 40;
    unsigned* ctl = WSP(unsigned, WS_CTL);
    for (int blk = F.vcu; blk < NT / 128; blk += F.G) {
        __syncthreads();
        if (F.tid < 32) cnt[F.tid] = 0;
        if (F.tid >= 64 && F.tid < 128) { const int e = F.tid - 64; const int c = e < 32 ? (int)((ctl[CW_COUNTS + l * 64 + e] + 255u) & ~255u) : 0; int inc = c;
#pragma unroll
            for (int o = 1; o < 32; o <<= 1) { const int t = __shfl_up(inc, o); if (e >= o) inc += t; }
            if (e < 32) pstart[e] = inc - c; if (e == 31) pstart[32] = inc; }
        __syncthreads();
        int e = 0, rank = 0, tok = 0;
        if (F.tid < 256) { tok = blk * 128 + (F.tid >> 1); e = WSP(const int, OFF_EID)[(size_t)tok * 2 + (F.tid & 1)]; rank = __hip_atomic_fetch_add(&cnt[e], 1, __ATOMIC_RELAXED, __HIP_MEMORY_SCOPE_WORKGROUP); }
        __syncthreads();
        if (F.tid < 32) base[F.tid] = cnt[F.tid] ? (int)atomicAdd(&ctl[CW_CURSOR + l * 64 + F.tid], (unsigned)cnt[F.tid]) : 0;
        __syncthreads();
        if (F.tid < 256) { const int slot = pstart[e] + base[e] + rank; slots[F.tid] = slot; WSP(int, OFF_TSLOT)[(size_t)tok * 2 + (F.tid & 1)] = slot; WSP(float, OFF_SRSTD)[slot] = WSP(const float, OFF_RSTDT)[tok]; WSP(int, OFF_STOK)[slot] = tok; }
        __syncthreads();
        if (blk == 0 && F.tid == 0) { const int ntl = pstart[32] >> 8; ctl[CW_NTILES + l] = (unsigned)ntl; int* te = WSP(int, OFF_TILEE);
            for (int e2 = 0; e2 < 32; ++e2) for (int tl = pstart[e2] >> 8; tl < (pstart[e2 + 1] >> 8); ++tl) te[tl] = e2; }
    }
    __syncthreads();
}
__device__ __forceinline__ void phase_combine(const Frame& F, const Prm& p, int l) {
    const int gw = F.vcu * 8 + F.wave, NGW = F.G * 8;
    const bool last = (l == NLAYER - 1);
    for (int tk0 = gw * 4; tk0 < NT; tk0 += NGW * 4) {
        int2 sl[4]; f32x2 gt[4];
#pragma unroll
        for (int q = 0; q < 4; ++q) { sl[q] = *(const int2*)(WSP(const int, OFF_TSLOT) + (size_t)(tk0 + q) * 2); gt[q] = *(const f32x2*)(WSP(const float, OFF_GATE) + (size_t)(tk0 + q) * 2); }
        f32x4 v[4][4];
#if F8_YP
        unsigned ya[4][4], yb[4][4];
#else
        h16x4 ya[4][4], yb[4][4];
#endif
#pragma unroll
        for (int q = 0; q < 4; ++q) { const h16* hrow = WSP(const h16, WS_HB) + (size_t)(tk0 + q) * DM;
#if F8_YP
            const unsigned char* y0 = WSP(const unsigned char, OFF_YP) + (size_t)sl[q].x * DM; const unsigned char* y1 = WSP(const unsigned char, OFF_YP) + (size_t)sl[q].y * DM;
#else
            const h16* y0 = WSP(const h16, OFF_YP) + (size_t)sl[q].x * DM; const h16* y1 = WSP(const h16, OFF_YP) + (size_t)sl[q].y * DM;
#endif

#pragma unroll
            for (int j = 0; j < 4; ++j) { const int c = 4 * F.lane + 256 * j; const h16x4 hv = *(const h16x4*)(hrow + c); v[q][j] = (f32x4){(float)hv[0], (float)hv[1], (float)hv[2], (float)hv[3]};
#if F8_YP
                ya[q][j] = __builtin_nontemporal_load((const unsigned*)(y0 + c)); yb[q][j] = __builtin_nontemporal_load((const unsigned*)(y1 + c)); } }
#else
                ya[q][j] = __builtin_nontemporal_load((const h16x4*)(y0 + c)); yb[q][j] = __builtin_nontemporal_load((const h16x4*)(y1 + c)); } }
#endif

#pragma unroll
        for (int q = 0; q < 4; ++q) { float s = 0.f;
#pragma unroll
            for (int j = 0; j < 4; ++j) {
#if F8_YP
                { const f32x2 a0 = __builtin_amdgcn_cvt_pk_f32_fp8((int)ya[q][j], false), a1 = __builtin_amdgcn_cvt_pk_f32_fp8((int)ya[q][j], true), b0 = __builtin_amdgcn_cvt_pk_f32_fp8((int)yb[q][j], false), b1 = __builtin_amdgcn_cvt_pk_f32_fp8((int)yb[q][j], true);
                  const float g0 = gt[q][0] * (1.0f / 32.0f), g1 = gt[q][1] * (1.0f / 32.0f);
                  v[q][j][0] += g0 * a0[0] + g1 * b0[0]; v[q][j][1] += g0 * a0[1] + g1 * b0[1]; v[q][j][2] += g0 * a1[0] + g1 * b1[0]; v[q][j][3] += g0 * a1[1] + g1 * b1[1]; }
#else
#pragma unroll
                for (int e = 0; e < 4; ++e) v[q][j][e] += gt[q][0] * (float)ya[q][j][e] + gt[q][1] * (float)yb[q][j][e];
#endif

                if (!last) { const h16x4 o = pack4(v[q][j]); v[q][j] = (f32x4){(float)o[0], (float)o[1], (float)o[2], (float)o[3]}; }
                s += (v[q][j][0] * v[q][j][0] + v[q][j][1] * v[q][j][1]) + (v[q][j][2] * v[q][j][2] + v[q][j][3] * v[q][j][3]); }
            s = wave_sum(s);
            if (!last) {
#pragma unroll
                for (int j = 0; j < 4; ++j) { const int c = 4 * F.lane + 256 * j; *(h16x4*)(WSP(h16, WS_HB) + (size_t)(tk0 + q) * DM + c) = pack4(v[q][j]);
                    if (F8_HB) *(unsigned*)((unsigned char*)F.out + OUT_HB8 + (size_t)(tk0 + q) * DM + c) = cvt4_fp8(v[q][j][0], v[q][j][1], v[q][j][2], v[q][j][3]); }
                if (F.lane < 16) WSP(float, WS_SSQ)[(size_t)(tk0 + q) * 16 + F.lane] = (F.lane == 0) ? s : 0.f;
                if (F.lane == 0) WSP(float, OFF_RSTDT)[tk0 + q] = 1.0f / sqrtf(s * (1.0f / DM) + EPS);
            } else { const float rs = 1.0f / sqrtf(s * (1.0f / DM) + EPS); float* orow = F.out + (size_t)(tk0 + q) * DM;
#pragma unroll
                for (int j = 0; j < 4; ++j) { const int c = 4 * F.lane + 256 * j; const f32x4 gf = *(const f32x4*)(inptr(F, 31) + c); *(f32x4*)(orow + c) = v[q][j] * rs * gf; } } }
    }
}

__global__ void __launch_bounds__(512, 2) fwd(Prm p) {
    extern __shared__ __attribute__((aligned(16))) unsigned char lds_raw[];
    Frame F; F.lds = (LAS unsigned char*)lds_raw; F.ws = (GAS unsigned char*)p.ws; F.out = p.out;
    F.tid = threadIdx.x; F.lane = F.tid & 63; F.wave = __builtin_amdgcn_readfirstlane(F.tid >> 6);
    F.G = gridDim.x; { const int bx = blockIdx.x; F.vcu = (F.G % 8 == 0) ? (bx % 8) * (F.G / 8) + bx / 8 : bx; }
    volatile LAS unsigned* misc = (volatile LAS unsigned*)(F.lds + LDS_MISC);
    if (F.tid < 4) misc[F.tid] = 0u;
    F.ptab = (volatile LAS unsigned long long*)(F.lds + LDS_MISC + 64);
    if (F.tid < 32) F.ptab[F.tid] = (unsigned long long)p.in[F.tid];
    __syncthreads();
    const int lo = p.ph_lo, hi = p.ph_hi;
    XcdBarrier bar; bar.bar = WSP(unsigned, WS_CTL) + CW_BAR; bar.x = 0; bar.st = misc;
    if (hi - lo > 1) bar = xcd_barrier_post(WSP(unsigned, WS_CTL) + CW_BAR, misc);
#ifndef UMASK
#define UMASK 7
#endif
#ifndef REPMASK
#define REPMASK 0
#endif
#ifndef PHMASK
#define PHMASK 0x3fff
#endif
#define IN(k) (((PHMASK >> ((k) % NPH)) & 1) && lo <= (k) && (k) < hi && (launder(F), true))
#define REPS(k) (((REPMASK >> (k)) & 1) ? 2 : 1)
#define INR(k) (lo <= (k) && (k) < hi)
#ifndef AMPMASK
#define AMPMASK 0
#endif
    unsigned long long tprev = AMPMASK ? __builtin_amdgcn_s_memrealtime() : 0ull;
#define SEAM(k) do { if (INR(k) && INR((k) + 1)) { xcd_barrier(bar); if (AMPMASK) { const unsigned long long tn = __builtin_amdgcn_s_memrealtime(); \
        if ((AMPMASK >> ((k) % NPH)) & 1) { const unsigned long long tgt = tn + 4ull * (tn - tprev); while (__builtin_amdgcn_s_memrealtime() < tgt) __builtin_amdgcn_s_sleep(8); } \
        tprev = __builtin_amdgcn_s_memrealtime(); } } } while (0)
    for (int l = 0; l < NLAYER; ++l) {
        const int pb = l * NPH;
        if (IN(pb + 0)) for (int rep = 0; rep < REPS(0); ++rep) { phase_convert(F, p, l); } SEAM(pb + 0);
        if (REPS(20) == 2 && INR(pb + 0) && INR(pb + 1)) { for (int q = 0; q < 20; ++q) xcd_barrier(bar); }
        if (IN(pb + 1)) for (int rep = 0; rep < REPS(1); ++rep) {
            if (P8_N16 > 0) { pg8::StaticOrder S; S.init(NT, P8_N16 * 256, F.G, (int)blockIdx.x); pg8::EpiScale16C E{WSP(h16, WS_R1), NPJ, WSP(const float, OFF_RSTDT), 1.0f, P8_LIST16};
              pg8::Gemm g{WSP(const h16, WS_HB), WSP(const h16, WS_WIN), DM, DM, DM, nullptr}; pg8::gemm_phase(F.lds, F.tid, g, S, E); }
            launder(F);
            if (P8_N8 > 0) { pg8::StaticOrder S; S.init(NT, P8_N8 * 256, F.G, (int)((blockIdx.x + F.G / 2) % F.G));
              pg8::EpiScale16C E{WSP(h16, WS_R1), NPJ, WSP(const float, OFF_RSTDT), 1.0f / 256.0f, P8_LIST8};
              pg8::Gemm g{(const h16*)((const unsigned char*)F.out + OUT_HB8), WSP(const h16, WS_WIN + P8_WOFF), DM / 2, DM / 2, DM / 2, nullptr}; pg8::gemm_phase<pg8::EpiScale16C, pg8::StaticOrder, false, 1>(F.lds, F.tid, g, S, E); }
        } SEAM(pb + 1);
        if (IN(pb + 2)) for (int rep = 0; rep < REPS(2); ++rep) {
            if (UMASK & 1) for (int r2 = 0; r2 < REPS(17); ++r2) for (int u = blockIdx.x; u < NB * NCH * 2; u += F.G) ssd_states_unit(F, p, l, u);
            launder(F);
            if (UMASK & 2) for (int r2 = 0; r2 < REPS(18); ++r2) for (int u = blockIdx.x; u < NB * NCH; u += F.G) ret_states_block(F, u);
            launder(F);
            if (UMASK & 4) for (int r2 = 0; r2 < REPS(19); ++r2) for (int u = blockIdx.x; u < NB * NCH; u += F.G) lru_unit(F, p, l, u);
        } SEAM(pb + 2);
        if (IN(pb + 3)) for (int rep = 0; rep < REPS(3); ++rep) {
            const bool split = (F.G == 256); const int bx = (int)blockIdx.x;
            if (!split || bx < 64) {
                pg8::Gemm g{WSP(const h16, WS_MEM16), WSP(const h16, WS_WKV), DM, DM, DM, nullptr}; pg8::StaticOrder S; S.init(NTM, DM, split ? 64 : F.G, bx);
                pg8::EpiScale16 E{WSP(h16, OFF_KB), DM, WSP(const float, OFF_MSSQ), 1.0f}; pg8::gemm_phase(F.lds, F.tid, g, S, E); }
            launder(F);
            if (!split || (bx >= 64 && bx < 128)) {
                pg8::Gemm g{WSP(const h16, WS_MEM16), WSP(const h16, WS_WKV) + (size_t)DM * DM, DM, DM, DM, nullptr}; pg8::StaticOrder S; S.init(NTM, DM, split ? 64 : F.G, split ? bx - 64 : bx);
                pg8::EpiVT E{WSP(h16, OFF_VT), WSP(const float, OFF_MRSTD)}; pg8::gemm_phase<pg8::EpiVT, pg8::StaticOrder, false, 0, true>(F.lds, F.tid, g, S, E); }
            launder(F);
            if (!split || bx >= 128) for (int u = split ? bx - 128 : bx; u < 4 * NB * 6; u += split ? 128 : F.G) ssd_scan_unit(F, u);
            launder(F);
            if (!split || bx < 192) for (int u = bx; u < 2 * NB * 6; u += split ? 256 : F.G) ret_scan_unit(F, u);
            lru_scan(F, split ? bx - 192 : bx);
        } SEAM(pb + 3);
        if (IN(pb + 4)) for (int rep = 0; rep < REPS(4); ++rep) {
            if (UMASK & 1) for (int r2 = 0; r2 < REPS(14); ++r2) for (int u = blockIdx.x; u < NB * NCH * 2; u += F.G) ssd_out_unit(F, p, l, u);
            launder(F);
            if (UMASK & 2) for (int r2 = 0; r2 < REPS(15); ++r2) for (int u = blockIdx.x; u < NB * NCH; u += F.G) ret_out_block(F, u);
            launder(F);
            if (UMASK & 4) for (int r2 = 0; r2 < REPS(16); ++r2) for (int u = blockIdx.x; u < NB * NCH; u += F.G) lru_out_unit(F, u);
        } SEAM(pb + 4);
        if (IN(pb + 5)) for (int rep = 0; rep < REPS(5); ++rep) { pg8::StaticOrder S; S.init(NT, DM, F.G, (int)blockIdx.x); pg8::EpiResid E{WSP(h16, WS_HB), WSP(float, WS_SSQ), (unsigned char*)F.out + OUT_HB8, F8_OUT ? 1.0f / 2048.0f : 1.0f};
#if F8_OUT
            pg8::Gemm g{WSP(const h16, OFF_OMIX8), WSP(const h16, WS_WOUT), DM / 2, DM / 2, DM / 2, nullptr}; pg8::gemm_phase<pg8::EpiResid, pg8::StaticOrder, false, 1>(F.lds, F.tid, g, S, E);
#else
            pg8::Gemm g{WSP(const h16, OFF_OMIX), WSP(const h16, WS_WOUT), DM, DM, DM, nullptr}; pg8::gemm_phase(F.lds, F.tid, g, S, E);
#endif
            } SEAM(pb + 5);
        if (IN(pb + 6)) for (int rep = 0; rep < REPS(6); ++rep) { pg8::StaticOrder S; S.init(NT, DM, F.G, (int)blockIdx.x); pg8::EpiScale16 E{WSP(h16, OFF_QCA), DM, WSP(const float, WS_SSQ), F8_Q ? 1.0f / 4096.0f : 1.0f};
#if F8_Q
            pg8::Gemm g{(const h16*)((const unsigned char*)F.out + OUT_HB8), WSP(const h16, WS_WQ), DM / 2, DM / 2, DM / 2, nullptr}; pg8::gemm_phase<pg8::EpiScale16, pg8::StaticOrder, false, 1>(F.lds, F.tid, g, S, E);
#else
            pg8::Gemm g{WSP(const h16, WS_HB), WSP(const h16, WS_WQ), DM, DM, DM, nullptr}; pg8::gemm_phase(F.lds, F.tid, g, S, E);
#endif
            } SEAM(pb + 6);
        if (IN(pb + 7)) for (int rep = 0; rep < REPS(7); ++rep) { attn_phase(F); } SEAM(pb + 7);
        if (IN(pb + 8)) for (int rep = 0; rep < REPS(8); ++rep) { pg8::StaticOrder S; S.init(NT, DM, F.G, (int)blockIdx.x); pg8::EpiResid E{WSP(h16, WS_HB), WSP(float, WS_SSQ), (unsigned char*)F.out + OUT_HB8, F8_O ? 1.0f / 4096.0f : 1.0f};
#if F8_O
            pg8::Gemm g{WSP(const h16, OFF_OATT), WSP(const h16, WS_WO), DM / 2, DM / 2, DM / 2, nullptr}; pg8::gemm_phase<pg8::EpiResid, pg8::StaticOrder, false, 1>(F.lds, F.tid, g, S, E);
#else
            pg8::Gemm g{WSP(const h16, OFF_OATT), WSP(const h16, WS_WO), DM, DM, DM, nullptr}; pg8::gemm_phase(F.lds, F.tid, g, S, E);
#endif
            } SEAM(pb + 8);
        if (IN(pb + 9)) for (int rep = 0; rep < REPS(9); ++rep) { phase_router(F, p, l); } SEAM(pb + 9);
        if (IN(pb + 10)) for (int rep = 0; rep < REPS(10); ++rep) { phase_dispatch(F, l); } SEAM(pb + 10);
        if (IN(pb + 11)) for (int rep = 0; rep < REPS(11); ++rep) {
            pg8::GroupOrder S{WSP(const int, OFF_TILEE), __builtin_amdgcn_readfirstlane((int)WSP(const unsigned, WS_CTL)[CW_NTILES + l]), F.G, F.vcu}; pg8::EpiGated E{WSP(h16, OFF_HP), WSP(const float, OFF_SRSTD), F8_UP ? 1.0f / 256.0f : 1.0f};
#if F8_UP
            pg8::Gemm g{(const h16*)((const unsigned char*)F.out + OUT_HB8), WSP(const h16, WS_W13), DM / 2, DM / 2, DM / 2, WSP(const int, OFF_STOK)}; pg8::gemm_phase<pg8::EpiGated, pg8::GroupOrder, true, 1>(F.lds, F.tid, g, S, E);
#else
            pg8::Gemm g{WSP(const h16, WS_HB), WSP(const h16, WS_W13), DM, DM, DM, WSP(const int, OFF_STOK)}; pg8::gemm_phase<pg8::EpiGated, pg8::GroupOrder, true>(F.lds, F.tid, g, S, E);
#endif
            } SEAM(pb + 11);
        if (IN(pb + 12)) for (int rep = 0; rep < REPS(12); ++rep) {
            pg8::GroupOrder S{WSP(const int, OFF_TILEE), __builtin_amdgcn_readfirstlane((int)WSP(const unsigned, WS_CTL)[CW_NTILES + l]), F.G, F.vcu}; pg8::EpiPlain16 E{WSP(h16, OFF_YP), 1.0f / 4096.0f};
#if F8_DOWN && F8_YP
            pg8::EpiPlain8 E8{WSP(unsigned char, OFF_YP), 32.0f / 4096.0f};
            pg8::Gemm g{WSP(const h16, OFF_HP), WSP(const h16, WS_W2), 256, 256, 256, nullptr}; pg8::gemm_phase<pg8::EpiPlain8, pg8::GroupOrder, false, 1>(F.lds, F.tid, g, S, E8);
#elif F8_DOWN
            pg8::Gemm g{WSP(const h16, OFF_HP), WSP(const h16, WS_W2), 256, 256, 256, nullptr}; pg8::gemm_phase<pg8::EpiPlain16, pg8::GroupOrder, false, 1>(F.lds, F.tid, g, S, E);
#else
            pg8::Gemm g{WSP(const h16, OFF_HP), WSP(const h16, WS_W2), 512, 512, 512, nullptr}; pg8::gemm_phase(F.lds, F.tid, g, S, E);
#endif
            } SEAM(pb + 12);
        if (IN(pb + 13)) for (int rep = 0; rep < REPS(13); ++rep) { phase_combine(F, p, l); }
        if (!MK_SINGLE || AMPMASK || l == NLAYER - 1) SEAM(pb + 13);
    }
#undef IN
#undef INR
#undef SEAM
}

extern "C" void kernel_launch(void* const* d_in, const int* in_sizes, int n_in, void* d_out, int out_size, void* d_ws, size_t ws_size, hipStream_t stream) {
    static int grid = 0;
    if (grid == 0) {
        if (n_in != 32 || out_size != NT * DM || ws_size < WS_END) { fprintf(stderr, "kernel_launch: unexpected shapes / workspace (%d inputs, out %d, ws %zu < %zu)\n", n_in, out_size, ws_size, (size_t)WS_END); grid = -1; return; }
        int dev = 0, cus = 0, per_cu = 0;
        if (hipGetDevice(&dev) != hipSuccess || hipDeviceGetAttribute(&cus, hipDeviceAttributeMultiprocessorCount, dev) != hipSuccess) { grid = -1; return; }
        if (hipFuncSetAttribute((const void*)fwd, hipFuncAttributeMaxDynamicSharedMemorySize, LDS_BYTES) != hipSuccess) { fprintf(stderr, "kernel_launch: hipFuncSetAttribute failed\n"); grid = -1; return; }
        if (hipOccupancyMaxActiveBlocksPerMultiprocessor(&per_cu, (const void*)fwd, 512, LDS_BYTES) != hipSuccess || per_cu < 1) { fprintf(stderr, "kernel_launch: occupancy query says %d\n", per_cu); }
        (void)hipGetLastError();
        grid = cus;
    }
    if (grid < 0) return;
    (void)hipMemsetAsync((char*)d_ws + WS_CTL, 0, CTL_ZERO_BYTES, stream);
    Prm p{};
    for (int i = 0; i < 32; ++i) p.in[i] = (const float*)d_in[i];
    p.out = (float*)d_out; p.ws = (unsigned char*)d_ws;
#if defined(PROBE_PHASE)
    p.ph_lo = 0; p.ph_hi = PROBE_PHASE + 1; hipLaunchKernelGGL(fwd, dim3(grid), dim3(512), LDS_BYTES, stream, p);
    (void)hipMemsetAsync((char*)d_ws + WS_CTL + CW_BAR * 4, 0, XCD_BAR_WORDS * 4, stream);
    p.ph_lo = PROBE_PHASE; p.ph_hi = PROBE_PHASE + 1; hipLaunchKernelGGL(fwd, dim3(grid), dim3(512), LDS_BYTES, stream, p);
    p.ph_lo = PROBE_PHASE + 1; p.ph_hi = NPHASES; hipLaunchKernelGGL(fwd, dim3(grid), dim3(512), LDS_BYTES, stream, p);
#elif MK_SINGLE
    p.ph_lo = 0; p.ph_hi = NPHASES;
    hipLaunchKernelGGL(fwd, dim3(grid), dim3(512), LDS_BYTES, stream, p);
#else
    for (int ph = 0; ph < NPHASES; ++ph) { p.ph_lo = ph; p.ph_hi = ph + 1; hipLaunchKernelGGL(fwd, dim3(grid), dim3(512), LDS_BYTES, stream, p); }
#endif
}
```

```cpp
#include <hip/hip_runtime.h>
#include <cstdio>
#include <cstdint>

#ifndef MK_SINGLE
#define MK_SINGLE 1
#endif

typedef _Float16 h16;
typedef _Float16 h16x2 __attribute__((ext_vector_type(2)));
typedef _Float16 h16x4 __attribute__((ext_vector_type(4)));
typedef _Float16 h16x8 __attribute__((ext_vector_type(8)));
typedef float f32x2 __attribute__((ext_vector_type(2)));
typedef float f32x4 __attribute__((ext_vector_type(4)));
typedef unsigned u32x2 __attribute__((ext_vector_type(2)));
typedef unsigned u32x4 __attribute__((ext_vector_type(4)));
typedef int i32x4 __attribute__((ext_vector_type(4)));
typedef int i32x8 __attribute__((ext_vector_type(8)));
#define LAS __attribute__((address_space(3)))
#define GAS __attribute__((address_space(1)))
#define PIN() do { asm volatile("" ::: "memory"); __builtin_amdgcn_sched_barrier(0); } while (0)
#define PINV(x) asm volatile("" : "+v"(x) :: "memory")
#define NTL(T, p) __builtin_nontemporal_load((const T*)(p))
#ifndef F8_Q
#define F8_Q 1
#endif
#ifndef F8_UP
#define F8_UP 1
#endif
#ifndef F8_DOWN
#define F8_DOWN 1
#endif
#ifndef F8_OUT
#define F8_OUT 0
#endif
#ifndef F8_O
#define F8_O 1
#endif
#ifndef P8MASK
#define P8MASK 0x607
#endif
#ifndef F8_YP
#define F8_YP 1
#endif
#define F8_HB (P8MASK != 0 || F8_Q || F8_UP)
constexpr int p8_count(unsigned m) { int c = 0; for (int t = 0; t < 14; ++t) c += (m >> t) & 1; return c; }
constexpr unsigned long long p8_list(unsigned m) { unsigned long long r = 0; int j = 0; for (int t = 0; t < 14; ++t) if ((m >> t) & 1) { r |= (unsigned long long)t << (4 * j); ++j; } return r; }
constexpr unsigned long long p8_inv(unsigned m8) { unsigned long long r = 0; int j8 = 0, j16 = 0; for (int t = 0; t < 14; ++t) { if ((m8 >> t) & 1) { r |= (unsigned long long)j8 << (4 * t); ++j8; } else { r |= (unsigned long long)j16 << (4 * t); ++j16; } } return r; }
constexpr int P8_N8 = p8_count(P8MASK), P8_N16 = 14 - P8_N8;
constexpr size_t P8_WOFF = (size_t)P8_N16 * 256 * 2048;
constexpr unsigned long long P8_LIST8 = p8_list(P8MASK), P8_LIST16 = p8_list(~(unsigned)P8MASK & 0x3FFFu), P8_INV = p8_inv(P8MASK);
#define MFMA16(a, b, c) __builtin_amdgcn_mfma_f32_16x16x32_f16((a), (b), (c), 0, 0, 0)

constexpr int NB = 16, SEQ = 2048, DM = 1024, NT = NB * SEQ, MEML = 256, NTM = NB * MEML, NLAYER = 2;
constexpr int NPJ = 3584;
constexpr int CQ = 0, CK = 384, CV = 768, CG = 1152, CZ = 1536, CXS = 1920, CBM = 2304, CCM = 2560, CXR = 2816, CGT = 3072, CDT = 3328;
constexpr int DIN = 3334, NCH = 16, MAXSLOT = 73728;
constexpr float EPS = 1e-6f;
constexpr int NPH = 14;
constexpr int NPHASES = NLAYER * NPH;

constexpr size_t MiB = (size_t)1 << 20;
constexpr size_t WS_CTL = 0, CTL_ZERO_BYTES = 64 * 1024;
constexpr size_t WS_WIN = 1 * MiB, WS_WOUT = 8 * MiB, WS_WQ = 10 * MiB, WS_WKV = 12 * MiB, WS_WO = 16 * MiB, WS_W13 = 18 * MiB, WS_W2 = 82 * MiB, WS_LRUW = 114 * MiB;
constexpr size_t WS_HB = 115 * MiB;
constexpr size_t WS_R1 = 179 * MiB;
constexpr size_t WS_R2 = 403 * MiB;
constexpr size_t WS_KV = 547 * MiB, WS_MEM16 = 563 * MiB, WS_SSQ = 571 * MiB, WS_MISC = 573 * MiB, WS_END = 577 * MiB;
constexpr size_t OFF_QCA = WS_R1, OFF_OATT = WS_R1 + 64 * MiB, OFF_XP = WS_R1, OFF_HP = WS_R1 + 144 * MiB;
constexpr size_t OFF_OMIX = WS_R2, OFF_RST = WS_R2 + 64 * MiB, OFF_SST = WS_R2 + 88 * MiB, OFF_LSUM = WS_R2 + 136 * MiB, OFF_SDEC = WS_R2 + 137 * MiB, OFF_LCAR = WS_R2 + 138 * MiB, OFF_YP = WS_R2;
constexpr size_t OUT_HB8 = 0;
constexpr size_t OUT_XTG = 0, OUT_BCN = 24 * MiB, OUT_LAU = 56 * MiB;
constexpr size_t OFF_OMIX8 = WS_W13 + 32 * MiB;
static_assert(!F8_OUT || F8_UP, "OMIX8 lives in the space freed by the fp8 expert weights");
constexpr size_t OFF_KB = WS_KV, OFF_VT = WS_KV + 8 * MiB;
constexpr size_t OFF_ROPE = WS_MISC, OFF_MSSQ = WS_MISC + 512 * 1024, OFF_EID = WS_MISC + 768 * 1024, OFF_GATE = WS_MISC + 1024 * 1024, OFF_TSLOT = WS_MISC + 1280 * 1024,
                 OFF_RSTDT = WS_MISC + 1536 * 1024, OFF_SRSTD = WS_MISC + 1664 * 1024, OFF_TILEE = WS_MISC + 2000 * 1024, OFF_STOK = WS_MISC + 2048 * 1024, OFF_RWG = WS_MISC + 2400 * 1024, OFF_MRSTD = WS_MISC + 2600 * 1024;
constexpr int CW_COUNTS = 64, CW_CURSOR = 192, CW_NTILES = 320, CW_BAR = 4096;

constexpr int LDS_BYTES = 152 * 1024;
constexpr int LDS_MISC = 150 * 1024;

struct Prm { const float* in[32]; float* out; unsigned char* ws; int ph_lo, ph_hi; };

#define XB_TMO      128
#define XB_XCNT(j)  (256  + 64 * (j))
#define XB_XSUB(j)  (1280 + 64 * (j))
#define XB_XGEN(j)  (2304 + 64 * (j))
#define XB_TOP      3328
#define XB_TOPGEN   3392
#define XCD_BAR_WORDS 3456
#define XB_SPIN_CAP (1u << 18)
__device__ __forceinline__ unsigned xb_ld(unsigned* p)              { return __hip_atomic_load(p, __ATOMIC_RELAXED, __HIP_MEMORY_SCOPE_AGENT); }
__device__ __forceinline__ unsigned xb_add(unsigned* p, unsigned v) { return __hip_atomic_fetch_add(p, v, __ATOMIC_RELAXED, __HIP_MEMORY_SCOPE_AGENT); }
__device__ __forceinline__ unsigned xb_xcc_id() { return (unsigned)__builtin_amdgcn_s_getreg((3 << 11) | 20) & 0xFu; }
#define XB_SPIN(cond, bar) do { unsigned _sp = 0; while (cond) { __builtin_amdgcn_s_sleep(1); \
    if ((++_sp & 255u) == 0u) { if (xb_ld(&(bar)[XB_TMO])) break; if (_sp > XB_SPIN_CAP) { atomicAdd(&(bar)[XB_TMO], 1u); break; } } } } while (0)
struct XcdBarrier { unsigned* bar; unsigned x; volatile LAS unsigned* st; };
__device__ __forceinline__ XcdBarrier xcd_barrier_post(unsigned* bar, volatile LAS unsigned* st) {
    XcdBarrier b; b.bar = bar; b.x = xb_xcc_id(); b.st = st;
    if (threadIdx.x == 0) (void)xb_add(&bar[XB_XCNT(b.x)], 1u);
    return b;
}
__device__ __forceinline__ void xcd_barrier_complete(unsigned* bar, unsigned x, unsigned& nloc, unsigned& nx) {
    const unsigned G = gridDim.x * gridDim.y * gridDim.z;
    unsigned sum, cnt, mine, sp = 0u;
    for (;;) {
        sum = 0u; cnt = 0u; mine = 0u;
#pragma unroll
        for (unsigned j = 0; j < 16; ++j) { const unsigned c = xb_ld(&bar[XB_XCNT(j)]); sum += c; cnt += (c > 0u) ? 1u : 0u; mine = (j == x) ? c : mine; }
        if (sum == G) break;
        __builtin_amdgcn_s_sleep(1);
        if ((++sp & 255u) == 0u) { if (xb_ld(&bar[XB_TMO])) break; if (sp > XB_SPIN_CAP) { atomicAdd(&bar[XB_TMO], 1u); break; } }
    }
    nloc = mine > 0u ? mine : 1u; nx = cnt > 0u ? cnt : 1u;
}
__device__ __forceinline__ void xcd_barrier(const XcdBarrier& b) {
    asm volatile("s_waitcnt vmcnt(0)" ::: "memory");
    __syncthreads();
    if (threadIdx.x == 0) {
        unsigned* bar = b.bar;
        __builtin_amdgcn_s_waitcnt(0);
        unsigned nloc = b.st[0], nx = b.st[1];
        if (nloc == 0u) { xcd_barrier_complete(bar, b.x, nloc, nx); b.st[0] = nloc; b.st[1] = nx; }
        const unsigned old = xb_add(&bar[XB_XSUB(b.x)], 1u);
        const unsigned gen = old / nloc;
        if (old + 1u == (gen + 1u) * nloc) {
            __builtin_amdgcn_fence(__ATOMIC_RELEASE, "agent");
            asm volatile("s_waitcnt vmcnt(0)" ::: "memory");
            const unsigned og = xb_add(&bar[XB_TOP], 1u);
            const unsigned tg = og / nx;
            if (og + 1u == (tg + 1u) * nx) xb_add(&bar[XB_TOPGEN], 1u);
            else XB_SPIN(xb_ld(&bar[XB_TOPGEN]) == tg, bar);
            __builtin_amdgcn_fence(__ATOMIC_ACQUIRE, "agent");
            xb_add(&bar[XB_XGEN(b.x)], 1u);
            asm volatile("s_waitcnt vmcnt(0)" ::: "memory");
        } else {
            XB_SPIN(xb_ld(&bar[XB_XGEN(b.x)]) == gen, bar);
            __builtin_amdgcn_fence(__ATOMIC_ACQUIRE, "agent");
            asm volatile("s_waitcnt vmcnt(0)" ::: "memory");
        }
    }
    __syncthreads();
}

__device__ __forceinline__ float wave_sum(float v) {
#pragma unroll
    for (int o = 1; o < 64; o <<= 1) v += __shfl_xor(v, o);
    return v;
}
__device__ __forceinline__ float siluf_(float x) { return x * __builtin_amdgcn_rcpf(1.0f + __expf(-x)); }
__device__ __forceinline__ float softplusf_(float x) { return x > 20.f ? x : log1pf(__expf(x)); }
__device__ __forceinline__ float gelu_tanh_(float x) { const float y = 0.7978845608028654f * (x + 0.044715f * x * x * x); const float t = 1.0f - 2.0f / (__expf(2.0f * y) + 1.0f); return 0.5f * x * (1.0f + t); }
__device__ __forceinline__ h16x8 pack8(const f32x4 a, const f32x4 b) { h16x8 r; r[0] = (h16)a[0]; r[1] = (h16)a[1]; r[2] = (h16)a[2]; r[3] = (h16)a[3]; r[4] = (h16)b[0]; r[5] = (h16)b[1]; r[6] = (h16)b[2]; r[7] = (h16)b[3]; return r; }
__device__ __forceinline__ h16x4 pack4(const f32x4 a) { h16x4 r; r[0] = (h16)a[0]; r[1] = (h16)a[1]; r[2] = (h16)a[2]; r[3] = (h16)a[3]; return r; }
__device__ __forceinline__ unsigned cvt4_fp8(float a, float b, float c, float d) {
    a = __builtin_amdgcn_fmed3f(a, -448.f, 448.f); b = __builtin_amdgcn_fmed3f(b, -448.f, 448.f); c = __builtin_amdgcn_fmed3f(c, -448.f, 448.f); d = __builtin_amdgcn_fmed3f(d, -448.f, 448.f);
    int p = __builtin_amdgcn_cvt_pk_fp8_f32(a, b, 0, false); p = __builtin_amdgcn_cvt_pk_fp8_f32(c, d, p, true); return (unsigned)p; }
__device__ __forceinline__ int lane_now() { unsigned z = 0u; asm volatile("" : "+v"(z)); return (int)__builtin_amdgcn_mbcnt_hi(~0u, __builtin_amdgcn_mbcnt_lo(~0u, z)); }
__device__ __forceinline__ h16x8 ldsfrag(LAS const h16* p) { return *(LAS const h16x8*)p; }
__device__ __forceinline__ int kperm32(int k) { return (k & ~31) | (((k >> 2) & 3) << 3) | (((k >> 4) & 1) << 2) | (k & 3); }
__device__ __forceinline__ h16x8 scalefrag(const h16x8 f, float s) { const h16 hs = (h16)s; h16x8 v;
#pragma unroll
    for (int j = 0; j < 8; ++j) v[j] = hs; return f * v; }
__device__ __forceinline__ float row_rstd(const float* ssq16) {
    const f32x4 a = *(const f32x4*)ssq16, b = *(const f32x4*)(ssq16 + 4), c = *(const f32x4*)(ssq16 + 8), d = *(const f32x4*)(ssq16 + 12);
    const float s = ((a[0] + a[1]) + (a[2] + a[3])) + ((b[0] + b[1]) + (b[2] + b[3])) + ((c[0] + c[1]) + (c[2] + c[3])) + ((d[0] + d[1]) + (d[2] + d[3]));
    return 1.0f / sqrtf(s * (1.0f / DM) + EPS);
}

namespace pg8 {
constexpr int BM = 256, BK = 64, HALF = 128, HTB = HALF * BK * 2, STAGE_BYTES = 8 * HTB, NXCD = 8, WGM = 8;
__host__ __device__ __forceinline__ int lds_byte(int r, int c) { const int st = (r >> 4) * 2 + (c >> 5), rr = r & 15, cc = c & 31, ob = rr * 64 + cc * 2; return st * 1024 + (ob ^ (((ob >> 9) & 1) << 5)); }
__host__ __device__ __forceinline__ void stage_rc(int b, int& R, int& C) { const int st = b / 1024, sb = b % 1024, swz = sb ^ (((sb >> 9) & 1) << 5); R = (st >> 1) * 16 + swz / 64; C = (st & 1) * 32 + (swz % 64) / 2; }
__host__ __device__ __forceinline__ int perm32(int rho) { const int n = rho >> 4, i = rho & 15; return 8 * (i >> 2) + 4 * n + (i & 3); }
struct Unit { int pm, pn; };
struct Gemm { const h16* A; const h16* Bt; int lda, ldb, K; const int* rowidx; };
struct StaticOrder {
    int nM, nN, nwg, G, c;
    __device__ void init(int M, int N, int G_, int c_) { nM = M / BM; nN = N / BM; nwg = nM * nN; G = G_; c = c_; }
    __device__ bool next(int i, Unit& u) const {
        const long L = (long)i * G + c; if (L >= nwg) return false;
        int wgid = (int)L; { const int q = nwg / NXCD, r = nwg % NXCD, xcd = wgid % NXCD, off = wgid / NXCD; wgid = (xcd < r ? xcd * (q + 1) : r * (q + 1) + (xcd - r) * q) + off; }
        const int nig = WGM * nN, gid = wgid / nig, fm = gid * WGM, gsz = (nM - fm) < WGM ? (nM - fm) : WGM;
        u.pm = fm + ((wgid % nig) % gsz); u.pn = (wgid % nig) / gsz; return true;
    }
};
struct GroupOrder {
    const int* tile_e; int ntiles, G, vcu;
    __device__ bool next(int i, Unit& u) const {
        const int L = i * G + vcu, tile = L >> 2; if (tile >= ntiles) return false;
        u.pm = tile; u.pn = __builtin_amdgcn_readfirstlane(tile_e[tile]) * 4 + (L & 3); return true;
    }
};

struct EpiScale16 {
    static constexpr bool PERM = true;
    h16* O; int ldc; const float* ssq; float cs;
    __device__ __forceinline__ void operator()(const f32x4 (&acc)[2][2][4][2], const Unit& u, int wr, int wc, int fr, int fq) const {
        const int row0 = u.pm * BM + wr * 64 + fr, col0 = u.pn * BM + wc * 32 + 8 * fq;
        float rs[2][4];
#pragma unroll
        for (int ai = 0; ai < 2; ++ai) {
#pragma unroll
            for (int m = 0; m < 4; ++m) rs[ai][m] = row_rstd(ssq + (size_t)(row0 + ai * HALF + m * 16) * 16) * cs;
            PIN(); }
#pragma unroll
        for (int ai = 0; ai < 2; ++ai)
#pragma unroll
            for (int m = 0; m < 4; ++m) { h16* rowp = O + (size_t)(row0 + ai * HALF + m * 16) * ldc + col0;
#pragma unroll
                for (int bj = 0; bj < 2; ++bj) *(h16x8*)(rowp + bj * HALF) = pack8(acc[ai][bj][m][0] * rs[ai][m], acc[ai][bj][m][1] * rs[ai][m]); }
    }
};
struct EpiScale16C {
    static constexpr bool PERM = true;
    h16* O; int ldc; const float* rstd; float cs; unsigned long long cmap;
    __device__ __forceinline__ void operator()(const f32x4 (&acc)[2][2][4][2], const Unit& u, int wr, int wc, int fr, int fq) const {
        const int row0 = u.pm * BM + wr * 64 + fr, col0 = (int)((cmap >> (4 * u.pn)) & 15) * BM + wc * 32 + 8 * fq;
        float rs[2][4];
#pragma unroll
        for (int ai = 0; ai < 2; ++ai)
#pragma unroll
            for (int m = 0; m < 4; ++m) rs[ai][m] = rstd[row0 + ai * HALF + m * 16] * cs;
#pragma unroll
        for (int ai = 0; ai < 2; ++ai)
#pragma unroll
            for (int m = 0; m < 4; ++m) { h16* rowp = O + (size_t)(row0 + ai * HALF + m * 16) * ldc + col0;
#pragma unroll
                for (int bj = 0; bj < 2; ++bj) *(h16x8*)(rowp + bj * HALF) = pack8(acc[ai][bj][m][0] * rs[ai][m], acc[ai][bj][m][1] * rs[ai][m]); }
    }
};
struct EpiVT {
    static constexpr bool PERM = false;
    h16* VT; const float* mrstd;
    __device__ __forceinline__ void operator()(const f32x4 (&acc)[2][2][4][2], const Unit& u, int wr, int wc, int fr, int fq) const {
#pragma unroll
        for (int ai = 0; ai < 2; ++ai) { f32x4 rs[4];
#pragma unroll
            for (int m = 0; m < 4; ++m) rs[m] = *(const f32x4*)(mrstd + u.pm * BM + ai * HALF + wr * 64 + m * 16 + 4 * fq);
#pragma unroll
            for (int bj = 0; bj < 2; ++bj)
#pragma unroll
                for (int n = 0; n < 2; ++n) { h16* rowp = VT + ((size_t)(u.pm * 4 + u.pn) * 256 + bj * HALF + wc * 32 + n * 16 + fr) * 256 + ai * HALF + wr * 64 + 8 * fq;
#pragma unroll
                    for (int mm = 0; mm < 2; ++mm) *(h16x8*)(rowp + 32 * mm) = pack8(acc[ai][bj][2 * mm][n] * rs[2 * mm], acc[ai][bj][2 * mm + 1][n] * rs[2 * mm + 1]); } }
    }
};
struct EpiResid {
    static constexpr bool PERM = true;
    h16* hb; float* ssq; unsigned char* hb8; float cs;
    __device__ __forceinline__ void operator()(const f32x4 (&acc)[2][2][4][2], const Unit& u, int wr, int wc, int fr, int fq) const {
        const int row0 = u.pm * BM + wr * 64 + fr, col0 = u.pn * BM + wc * 32 + 8 * fq;
        h16x8 bvs[2][4][2];
#pragma unroll
        for (int ai = 0; ai < 2; ++ai)
#pragma unroll
            for (int m = 0; m < 4; ++m)
#pragma unroll
                for (int bj = 0; bj < 2; ++bj) bvs[ai][m][bj] = *(const h16x8*)(hb + (size_t)(row0 + ai * HALF + m * 16) * DM + col0 + bj * HALF);
        PIN();
#pragma unroll
        for (int ai = 0; ai < 2; ++ai)
#pragma unroll
            for (int mp = 0; mp < 2; ++mp) { unsigned ch[2][2][2];
#pragma unroll
                for (int mm = 0; mm < 2; ++mm) { const int m = 2 * mp + mm; const int row = row0 + ai * HALF + m * 16; h16* rowp = hb + (size_t)row * DM + col0; float s = 0.f;
#pragma unroll
                    for (int bj = 0; bj < 2; ++bj) { const h16x8 bv = bvs[ai][m][bj]; f32x4 v0, v1;
#pragma unroll
                        for (int e = 0; e < 4; ++e) { v0[e] = (float)bv[e] + acc[ai][bj][m][0][e] * cs; v1[e] = (float)bv[4 + e] + acc[ai][bj][m][1][e] * cs; }
                        const h16x8 o = pack8(v0, v1); *(h16x8*)(rowp + bj * HALF) = o;
                        if (F8_HB) { ch[mm][bj][0] = cvt4_fp8(v0[0], v0[1], v0[2], v0[3]); ch[mm][bj][1] = cvt4_fp8(v1[0], v1[1], v1[2], v1[3]); }
#pragma unroll
                        for (int e = 0; e < 8; ++e) { const float q = (float)o[e]; s += q * q; } }
                    s += __shfl_xor(s, 16); s += __shfl_xor(s, 32);
                    if (fq == 0) ssq[(size_t)row * 16 + u.pn * 4 + wc] = s; }
                if (F8_HB) {
                    const int row = row0 + ai * HALF + (2 * mp + (fq & 1)) * 16; unsigned char* p8 = hb8 + (size_t)row * DM + u.pn * BM + wc * 32 + 8 * (fq & ~1);
#pragma unroll
                    for (int bj = 0; bj < 2; ++bj) { const auto s0 = __builtin_amdgcn_permlane16_swap(ch[0][bj][0], ch[1][bj][0], false, false), s1 = __builtin_amdgcn_permlane16_swap(ch[0][bj][1], ch[1][bj][1], false, false);
                        *(u32x4*)(p8 + bj * HALF) = (u32x4){s0[0], s1[0], s0[1], s1[1]}; } } }
    }
};
struct EpiGated {
    static constexpr bool PERM = true;
    h16* O; const float* srstd; float cs;
    __device__ __forceinline__ void operator()(const f32x4 (&acc)[2][2][4][2], const Unit& u, int wr, int wc, int fr, int fq) const {
        const int row0 = u.pm * BM + wr * 64 + fr, col0 = (u.pn & 3) * HALF + wc * 32 + 8 * fq;
        float rsv[2][4];
#pragma unroll
        for (int ai = 0; ai < 2; ++ai)
#pragma unroll
            for (int m = 0; m < 4; ++m) rsv[ai][m] = srstd[row0 + ai * HALF + m * 16] * cs;
        PIN();
#pragma unroll
        for (int ai = 0; ai < 2; ++ai)
#pragma unroll
            for (int mp = 0; mp < 2; ++mp) { unsigned ch[2][2];
#pragma unroll
                for (int mm = 0; mm < 2; ++mm) { const int m = 2 * mp + mm; const int row = row0 + ai * HALF + m * 16; const float rs = rsv[ai][m]; f32x4 o[2];
#pragma unroll
                    for (int n = 0; n < 2; ++n)
#pragma unroll
                        for (int j = 0; j < 4; ++j) { const float a = acc[ai][0][m][n][j] * rs, b = acc[ai][1][m][n][j] * rs; o[n][j] = siluf_(a) * b; }
                    if (F8_DOWN) { ch[mm][0] = cvt4_fp8(16.f * o[0][0], 16.f * o[0][1], 16.f * o[0][2], 16.f * o[0][3]); ch[mm][1] = cvt4_fp8(16.f * o[1][0], 16.f * o[1][1], 16.f * o[1][2], 16.f * o[1][3]); }
                    else *(h16x8*)(O + (size_t)row * 512 + col0) = pack8(o[0], o[1]); }
                if (F8_DOWN) {
                    const auto s0 = __builtin_amdgcn_permlane16_swap(ch[0][0], ch[1][0], false, false), s1 = __builtin_amdgcn_permlane16_swap(ch[0][1], ch[1][1], false, false);
                    *(u32x4*)((unsigned char*)O + (size_t)(row0 + ai * HALF + (2 * mp + (fq & 1)) * 16) * 512 + (u.pn & 3) * HALF + wc * 32 + 8 * (fq & ~1)) = (u32x4){s0[0], s1[0], s0[1], s1[1]}; } }
    }
};
struct EpiPlain8 {
    static constexpr bool PERM = true;
    unsigned char* O; float cs;
    __device__ __forceinline__ void operator()(const f32x4 (&acc)[2][2][4][2], const Unit& u, int wr, int wc, int fr, int fq) const {
        const int row0 = u.pm * BM + wr * 64 + fr;
#pragma unroll
        for (int ai = 0; ai < 2; ++ai)
#pragma unroll
            for (int mp = 0; mp < 2; ++mp) { unsigned char* p8 = O + (size_t)(row0 + ai * HALF + (2 * mp + (fq & 1)) * 16) * DM + (u.pn & 3) * BM + wc * 32 + 8 * (fq & ~1);
#pragma unroll
                for (int bj = 0; bj < 2; ++bj) { unsigned ch[2][2];
#pragma unroll
                    for (int mm = 0; mm < 2; ++mm) { const f32x4 a0 = acc[ai][bj][2 * mp + mm][0] * cs, a1 = acc[ai][bj][2 * mp + mm][1] * cs; ch[mm][0] = cvt4_fp8(a0[0], a0[1], a0[2], a0[3]); ch[mm][1] = cvt4_fp8(a1[0], a1[1], a1[2], a1[3]); }
                    const auto s0 = __builtin_amdgcn_permlane16_swap(ch[0][0], ch[1][0], false, false), s1 = __builtin_amdgcn_permlane16_swap(ch[0][1], ch[1][1], false, false);
                    *(u32x4*)(p8 + bj * HALF) = (u32x4){s0[0], s1[0], s0[1], s1[1]}; } }
    }
};
struct EpiPlain16 {
    static constexpr bool PERM = true;
    h16* O; float cs;
    __device__ __forceinline__ void operator()(const f32x4 (&acc)[2][2][4][2], const Unit& u, int wr, int wc, int fr, int fq) const {
        const int row0 = u.pm * BM + wr * 64 + fr, col0 = (u.pn & 3) * BM + wc * 32 + 8 * fq;
#pragma unroll
        for (int ai = 0; ai < 2; ++ai)
#pragma unroll
            for (int m = 0; m < 4; ++m) { h16* rowp = O + (size_t)(row0 + ai * HALF + m * 16) * DM + col0;
#pragma unroll
                for (int bj = 0; bj < 2; ++bj) *(h16x8*)(rowp + bj * HALF) = F8_DOWN ? pack8(acc[ai][bj][m][0] * cs, acc[ai][bj][m][1] * cs) : pack8(acc[ai][bj][m][0], acc[ai][bj][m][1]); }
    }
};

template <class Epi, class Sched, bool GATHER = false, int F8W = 0, bool SWAP = false>
__device__ __forceinline__ void gemm_phase(LAS unsigned char* lds, const int tid, const Gemm g, const Sched& S, const Epi& E) {
    const int wid = __builtin_amdgcn_readfirstlane(tid >> 6), lane = tid & 63, wr = wid >> 2, wc = wid & 3, fr = lane & 15, fq = lane >> 4;
    int K_ = g.K; asm volatile("" : "+s"(K_));
    const int K = K_, nt = K / BK;
    unsigned voffA[2], voffB[2];
#pragma unroll
    for (int i = 0; i < 2; ++i) { int R, C; stage_rc(tid * 16 + i * 8192, R, C); const int Rb = Epi::PERM ? ((R & ~31) + perm32(R & 31)) : R;
        voffA[i] = (unsigned)(R * g.lda + C) * 2u; voffB[i] = (unsigned)(Rb * g.ldb + C) * 2u; }
    const size_t kstep = (size_t)(BK * 2);
    const size_t hstepA = (size_t)HALF * g.lda * 2, hstepB = (size_t)HALF * g.ldb * 2;
    const size_t tstepA = 2 * hstepA, tstepB = 2 * hstepB;
    const unsigned ldsw = (unsigned)wid * 1024u;
    const int aoff = lds_byte(wr * 64 + fr, fq * 8), boff = lds_byte(wc * 32 + fr, fq * 8);
#define PG8_SA(b, h) (((b) * 2 + (h)) * HTB)
#define PG8_SB(b, h) ((4 + (b) * 2 + (h)) * HTB)
#define PG8_STAGE(bufoff, gbase, voff) do { _Pragma("unroll") for (int _i = 0; _i < 2; ++_i) \
        __builtin_amdgcn_global_load_lds((const unsigned*)((const char*)(gbase) + (voff)[_i]), (LAS unsigned*)(lds + (bufoff) + ldsw + _i * 8192), 16, 0, 0); } while (0)
    unsigned coff[2], noff[2], cbyte[2];
    if constexpr (GATHER) {
#pragma unroll
        for (int i = 0; i < 2; ++i) { int R_, C_; stage_rc(tid * 16 + i * 8192, R_, C_); cbyte[i] = (unsigned)(C_ * 2); } }
#define PG8_GOFF(u_, o_) do { _Pragma("unroll") for (int _i = 0; _i < 2; ++_i) { int R_, C_; stage_rc(tid * 16 + _i * 8192, R_, C_); \
        o_[_i] = (unsigned)g.rowidx[(u_).pm * BM + R_] | ((unsigned)g.rowidx[(u_).pm * BM + HALF + R_] << 16); } } while (0)
#define PG8_STAGEA(bufoff, gbase, h, sel) do { if constexpr (GATHER) { _Pragma("unroll") for (int _i = 0; _i < 2; ++_i) { const unsigned pk_ = (sel) ? noff[_i] : coff[_i]; \
        __builtin_amdgcn_global_load_lds((const unsigned*)((const char*)(gbase) + (((pk_ >> (16 * (h))) & 0xffffu) * (unsigned)(g.lda * 2) + cbyte[_i])), (LAS unsigned*)(lds + (bufoff) + ldsw + _i * 8192), 16, 0, 0); } } \
        else { PG8_STAGE(bufoff, (gbase) + ((h) ? hstepA : 0), voffA); } } while (0)
#define PG8_LDA(dst, b, h) do { _Pragma("unroll") for (int m = 0; m < 4; ++m) _Pragma("unroll") for (int k = 0; k < 2; ++k) dst[m][k] = *(const LAS h16x8*)(lds + PG8_SA(b, h) + aoff + m * 2048 + k * 1024); } while (0)
#define PG8_LDB(dst, b, h) do { _Pragma("unroll") for (int n = 0; n < 2; ++n) _Pragma("unroll") for (int k = 0; k < 2; ++k) dst[n][k] = *(const LAS h16x8*)(lds + PG8_SB(b, h) + boff + n * 2048 + k * 1024); } while (0)
#define PG8_MMA(ai, bj, At, Bt) do { __builtin_amdgcn_s_setprio(1); _Pragma("unroll") for (int m = 0; m < 4; ++m) _Pragma("unroll") for (int n = 0; n < 2; ++n) _Pragma("unroll") for (int k = 0; k < 2; ++k) \
        acc[ai][bj][m][n] = SWAP ? __builtin_amdgcn_mfma_f32_16x16x32_f16(At[m][k], Bt[n][k], acc[ai][bj][m][n], 0, 0, 0) : __builtin_amdgcn_mfma_f32_16x16x32_f16(Bt[n][k], At[m][k], acc[ai][bj][m][n], 0, 0, 0); __builtin_amdgcn_s_setprio(0); } while (0)
#define PG8_MMA8(ai, bj, At, Bt) do { __builtin_amdgcn_s_setprio(1); _Pragma("unroll") for (int m = 0; m < 4; ++m) _Pragma("unroll") for (int n = 0; n < 2; ++n) { \
        const i32x8 wf_ = __builtin_shufflevector(__builtin_bit_cast(i32x4, Bt[n][0]), __builtin_bit_cast(i32x4, Bt[n][1]), 0, 1, 2, 3, 4, 5, 6, 7), af_ = __builtin_shufflevector(__builtin_bit_cast(i32x4, At[m][0]), __builtin_bit_cast(i32x4, At[m][1]), 0, 1, 2, 3, 4, 5, 6, 7); \
        asm volatile("v_mfma_f32_16x16x128_f8f6f4 %0, %1, %2, %0" : "+v"(acc[ai][bj][m][n]) : "v"(wf_), "v"(af_)); } __builtin_amdgcn_s_setprio(0); } while (0)
#define PG8_MM(ai, bj, At, Bt) do { if constexpr (F8W != 0) PG8_MMA8(ai, bj, At, Bt); else PG8_MMA(ai, bj, At, Bt); } while (0)
#define PG8_WAIT_V(n) asm volatile("s_waitcnt vmcnt(" #n ")" ::: "memory")
#define PG8_WAIT_L(n) asm volatile("s_waitcnt lgkmcnt(" #n ")" ::: "memory")
#define PG8_BAR __builtin_amdgcn_s_barrier()
#define PG8_SCHED __builtin_amdgcn_sched_barrier(0)
    Unit cur, nxt; int ui = 0;
    if (!S.next(0, cur)) return;
    f32x4 acc[2][2][4][2];
#pragma unroll
    for (int a = 0; a < 2; ++a)
#pragma unroll
        for (int b = 0; b < 2; ++b)
#pragma unroll
            for (int m = 0; m < 4; ++m)
#pragma unroll
                for (int n = 0; n < 2; ++n) acc[a][b][m][n] = (f32x4){0.f, 0.f, 0.f, 0.f};
    h16x8 At[4][2], B0[2][2], B1[2][2];
    const char* cA = (const char*)g.A + (GATHER ? (size_t)0 : (size_t)cur.pm * tstepA); const char* cB = (const char*)g.Bt + (size_t)cur.pn * tstepB;
    if constexpr (GATHER) { PG8_GOFF(cur, coff); noff[0] = coff[0]; noff[1] = coff[1]; }
    PG8_STAGE(PG8_SB(0, 0), cB, voffB); PG8_STAGE(PG8_SB(0, 1), cB + hstepB, voffB); PG8_STAGEA(PG8_SA(0, 0), cA, 0, false); PG8_STAGEA(PG8_SA(0, 1), cA, 1, false);
    if (wr == 1) PG8_BAR;
    PG8_WAIT_V(2); PG8_BAR;
    PG8_STAGE(PG8_SB(1, 0), cB + kstep, voffB); PG8_STAGEA(PG8_SA(1, 0), cA + kstep, 0, false); PG8_STAGE(PG8_SB(1, 1), cB + hstepB + kstep, voffB);
    PG8_WAIT_V(6); PG8_BAR;
    for (;;) {
        const bool has_next = S.next(ui + 1, nxt);
        const char* nA = (has_next && !GATHER) ? (const char*)g.A + (size_t)nxt.pm * tstepA : cA; const char* nB = has_next ? (const char*)g.Bt + (size_t)nxt.pn * tstepB : cB;
        if constexpr (GATHER) { if (has_next) PG8_GOFF(nxt, noff); }
        for (int t = 0; t < nt; t += 2) {
            const bool last = (t == nt - 2);
            const char* a1 = cA + (size_t)(t + 1) * kstep;
            const char* a2 = last ? nA : cA + (size_t)(t + 2) * kstep; const char* b2 = last ? nB : cB + (size_t)(t + 2) * kstep;
            const char* a3 = a2 + kstep; const char* b3 = b2 + kstep;
            PG8_LDB(B0, 0, 0); PG8_LDB(B1, 0, 1); PG8_SCHED; PG8_LDA(At, 0, 0); PG8_STAGEA(PG8_SA(1, 1), a1, 1, false);
            PG8_WAIT_V(8); PG8_WAIT_L(0); PG8_BAR; PG8_MM(0, 0, At, B0); PG8_MM(0, 1, At, B1); PG8_BAR; PG8_SCHED;
            PG8_LDA(At, 0, 1); PG8_STAGE(PG8_SB(0, 0), b2, voffB); PG8_STAGE(PG8_SB(0, 1), b2 + hstepB, voffB); PG8_STAGEA(PG8_SA(0, 0), a2, 0, last);
            PG8_WAIT_V(8); PG8_WAIT_L(0); PG8_BAR; PG8_MM(1, 0, At, B0); PG8_MM(1, 1, At, B1); PG8_BAR; PG8_SCHED;
            PG8_LDB(B0, 1, 0); PG8_LDB(B1, 1, 1); PG8_SCHED; PG8_LDA(At, 1, 0); PG8_STAGEA(PG8_SA(0, 1), a2, 1, last);
            PG8_WAIT_V(8); PG8_WAIT_L(0); PG8_BAR; PG8_MM(0, 0, At, B0); PG8_MM(0, 1, At, B1); PG8_BAR; PG8_SCHED;
            PG8_LDA(At, 1, 1); PG8_STAGE(PG8_SB(1, 0), b3, voffB); PG8_STAGE(PG8_SB(1, 1), b3 + hstepB, voffB); PG8_STAGEA(PG8_SA(1, 0), a3, 0, last);
            PG8_WAIT_V(8); PG8_WAIT_L(0); PG8_BAR; PG8_MM(1, 0, At, B0); PG8_MM(1, 1, At, B1); PG8_BAR; PG8_SCHED;
        }
        if (wr == 0) PG8_BAR;
        if constexpr (F8W != 0) asm volatile("s_nop 7\n\ts_nop 7\n\ts_nop 7" ::: "memory");
        { const int ln_ = lane_now();
          E(acc, cur, wr, wc, ln_ & 15, ln_ >> 4); }
        if (!has_next) break;
#pragma unroll
        for (int a = 0; a < 2; ++a)
#pragma unroll
            for (int b = 0; b < 2; ++b)
#pragma unroll
                for (int m = 0; m < 4; ++m)
#pragma unroll
                    for (int n = 0; n < 2; ++n) acc[a][b][m][n] = (f32x4){0.f, 0.f, 0.f, 0.f};
        cur = nxt; cA = nA; cB = nB; ++ui;
        if constexpr (GATHER) { coff[0] = noff[0]; coff[1] = noff[1]; }
        if (wr == 1) PG8_BAR;
    }
    PG8_WAIT_V(0);
    PG8_BAR;
#undef PG8_SA
#undef PG8_SB
#undef PG8_STAGE
#undef PG8_LDA
#undef PG8_GOFF
#undef PG8_STAGEA
#undef PG8_LDB
#undef PG8_MMA
#undef PG8_MMA8
#undef PG8_MM
#undef PG8_WAIT_V
#undef PG8_WAIT_L
#undef PG8_BAR
#undef PG8_SCHED
}
}

struct Frame {
    LAS unsigned char* lds;
    GAS unsigned char* ws;
    volatile LAS unsigned long long* ptab;
    float* out;
    int tid, lane, wave, G, vcu;
};
#define WSP(T, off) ((T*)(GAS T*)(F.ws + (off)))
__device__ __forceinline__ const float* inptr(const Frame& F, int i) {
    const unsigned long long v = F.ptab[i];
    const unsigned lo = __builtin_amdgcn_readfirstlane((unsigned)v), hi = __builtin_amdgcn_readfirstlane((unsigned)(v >> 32));
    return (const float*)(GAS const float*)(((unsigned long long)hi << 32) | lo);
}
__device__ __forceinline__ void launder(Frame& F) {
    int wv = F.wave; asm volatile("" : "+s"(wv)); F.wave = wv;
    unsigned z = 0u; asm volatile("" : "+v"(z));
    int t = wv * 64 + (int)__builtin_amdgcn_mbcnt_hi(~0u, __builtin_amdgcn_mbcnt_lo(~0u, z)); F.tid = t; F.lane = t & 63;
    const unsigned long long w = (unsigned long long)F.ws; unsigned wl = __builtin_amdgcn_readfirstlane((unsigned)w), wh = __builtin_amdgcn_readfirstlane((unsigned)(w >> 32));
    asm volatile("" : "+s"(wl), "+s"(wh)); F.ws = (GAS unsigned char*)(((unsigned long long)wh << 32) | wl);
    unsigned lo = __builtin_amdgcn_readfirstlane((unsigned)(uintptr_t)F.lds); asm volatile("" : "+s"(lo)); F.lds = (LAS unsigned char*)(uintptr_t)lo;
    int v = __builtin_amdgcn_readfirstlane(F.vcu); asm volatile("" : "+s"(v)); F.vcu = v;
}

struct TrItem { const float* W; const float* g; h16* Wt; int ldw, sc, nvalid, ldt, d0, k0, vw, f8; float mul; };
__device__ __forceinline__ void tr_describe(const Frame& F, GAS unsigned char* wsb_, int l, int it, TrItem& d) {
    unsigned char* wsb = (unsigned char*)wsb_;
    int r = it; d.g = nullptr; d.mul = 1.f; d.nvalid = 64; d.vw = 4; d.ldt = DM; d.ldw = DM; d.f8 = 0;
    if (r < 896) { const int d0 = 64 * (r % 56); d.W = inptr(F, 3) + (size_t)l * DM * DIN; d.ldw = DIN; d.g = inptr(F, 2) + l * DM; { const int tile = d0 >> 8, is8 = (P8MASK >> tile) & 1, pos = (int)((P8_INV >> (4 * tile)) & 15); d.Wt = (h16*)(wsb + WS_WIN + (is8 ? P8_WOFF : 0)); d.d0 = pos * 256 + (d0 & 255); if (is8) { d.f8 = 1; d.mul = 256.f; } }
        d.k0 = 64 * (r / 56); d.vw = 2;
        if (d0 < 2816) d.sc = d0; else if (d0 < 3328) d.sc = d0 + 6; else if (d0 == 3328) { d.sc = 2816; d.nvalid = 6; } else { d.sc = 0; d.nvalid = 0; } return; } r -= 896;
    if (r < 256) { d.W = inptr(F, 4) + (size_t)l * DM * DM; if (F8_OUT) { d.f8 = 1; d.mul = 256.f; } d.Wt = (h16*)(wsb + WS_WOUT); d.d0 = d.sc = 64 * (r % 16); d.k0 = 64 * (r / 16); return; } r -= 256;
    if (r < 256) { d.W = inptr(F, 20) + (size_t)l * DM * DM; d.g = inptr(F, 18) + l * DM; d.mul = F8_Q ? 256.f : 0.0625f; d.f8 = F8_Q; d.Wt = (h16*)(wsb + WS_WQ); d.d0 = d.sc = 64 * (r % 16); d.k0 = 64 * (r / 16); return; } r -= 256;
    if (r < 512) { d.W = inptr(F, 21) + (size_t)l * DM * 2048; d.ldw = 2048; d.g = inptr(F, 19) + l * DM; d.Wt = (h16*)(wsb + WS_WKV); d.d0 = d.sc = 64 * (r % 32); d.k0 = 64 * (r / 32); return; } r -= 512;
    if (r < 256) { d.W = inptr(F, 22) + (size_t)l * DM * DM; if (F8_O) { d.f8 = 1; d.mul = 256.f; } d.Wt = (h16*)(wsb + WS_WO); d.d0 = d.sc = 64 * (r % 16); d.k0 = 64 * (r / 16); return; } r -= 256;
    if (r < 8192) { const int e = r / 256, q = r % 256, d0 = 64 * (q % 16), grp = d0 >> 8, rr = d0 & 255;
        d.W = (rr < 128 ? inptr(F, 28) : inptr(F, 29)) + (size_t)(l * 32 + e) * DM * 512; d.ldw = 512; d.sc = grp * 128 + (rr & 127); d.g = inptr(F, 23) + l * DM; d.Wt = (h16*)(wsb + WS_W13 + (size_t)e * DM * DM * (F8_UP ? 1 : 2)); if (F8_UP) { d.f8 = 1; d.mul = 256.f; } d.d0 = d0; d.k0 = 64 * (q / 16); return; } r -= 8192;
    if (r < 4096) { const int e = r / 128, q = r % 128; d.W = inptr(F, 30) + (size_t)(l * 32 + e) * 512 * DM; d.Wt = (h16*)(wsb + WS_W2 + (size_t)e * DM * 512 * (F8_DOWN ? 1 : 2)); if (F8_DOWN) { d.f8 = 1; d.mul = 256.f; } d.ldt = 512; d.d0 = d.sc = 64 * (q % 16); d.k0 = 64 * (q / 16); return; } r -= 4096;
    { const int blk = r & 3, gate = (r >> 2) & 1, dir = r >> 3; d.W = (gate ? inptr(F, 16) : inptr(F, 14)) + (size_t)((l * 2 + dir) * 4 + blk) * 4096; d.ldw = 64; d.Wt = (h16*)(wsb + WS_LRUW) + (size_t)((dir * 2 + gate) * 4 + blk) * 4096; d.ldt = 64; d.d0 = d.sc = 0; d.k0 = 0; }
}
__device__ __forceinline__ void tr_load(const TrItem& d, int lane, f32x4 (&v)[16]) {
    if (d.vw == 4) { const int col = 4 * (lane & 15); const float* src = d.W + (size_t)(d.k0 + (lane >> 4)) * d.ldw + d.sc + col; const bool ok = col < d.nvalid;
#pragma unroll
        for (int i = 0; i < 16; ++i) v[i] = ok ? __builtin_nontemporal_load((const f32x4*)(src + (size_t)(4 * i) * d.ldw)) : (f32x4){0.f, 0.f, 0.f, 0.f};
    } else { const int col = 2 * (lane & 31); const float* src = d.W + (size_t)(d.k0 + (lane >> 5)) * d.ldw + d.sc + col; const bool ok = col < d.nvalid;
#pragma unroll
        for (int i = 0; i < 16; ++i) { const f32x2 a = ok ? __builtin_nontemporal_load((const f32x2*)(src + (size_t)(4 * i) * d.ldw)) : (f32x2){0.f, 0.f}, c = ok ? __builtin_nontemporal_load((const f32x2*)(src + (size_t)(4 * i + 2) * d.ldw)) : (f32x2){0.f, 0.f}; v[i] = (f32x4){a[0], a[1], c[0], c[1]}; } }
}
__device__ __forceinline__ void tr_to_lds(const TrItem& d, int lane, const f32x4 (&v)[16], LAS float* scr) {
    if (d.vw == 4) { LAS float* q = scr + (lane >> 4) * 65 + 4 * (lane & 15);
#pragma unroll
        for (int i = 0; i < 16; ++i) { q[(4 * i) * 65 + 0] = v[i][0]; q[(4 * i) * 65 + 1] = v[i][1]; q[(4 * i) * 65 + 2] = v[i][2]; q[(4 * i) * 65 + 3] = v[i][3]; }
    } else { LAS float* q = scr + (lane >> 5) * 65 + 2 * (lane & 31);
#pragma unroll
        for (int i = 0; i < 16; ++i) { q[(4 * i) * 65 + 0] = v[i][0]; q[(4 * i) * 65 + 1] = v[i][1]; q[(4 * i + 2) * 65 + 0] = v[i][2]; q[(4 * i + 2) * 65 + 1] = v[i][3]; } }
}
__device__ __forceinline__ void tr_from_lds(const TrItem& d, int lane, LAS const float* scr) {
    const int c = lane & 7; float gs[8];
    if (d.g) { const f32x4 g0 = *(const f32x4*)(d.g + d.k0 + 8 * c), g1 = *(const f32x4*)(d.g + d.k0 + 8 * c + 4);
        gs[0] = g0[0] * d.mul; gs[1] = g0[1] * d.mul; gs[2] = g0[2] * d.mul; gs[3] = g0[3] * d.mul; gs[4] = g1[0] * d.mul; gs[5] = g1[1] * d.mul; gs[6] = g1[2] * d.mul; gs[7] = g1[3] * d.mul;
    } else {
#pragma unroll
        for (int e = 0; e < 8; ++e) gs[e] = d.mul; }
    if (d.f8) {
#pragma unroll
        for (int j = 0; j < 8; ++j) { const int nn = (lane >> 3) + 8 * j; LAS const float* q = scr + (8 * c) * 65 + nn; float f[8];
#pragma unroll
            for (int e = 0; e < 8; ++e) f[e] = q[e * 65] * gs[e];
            *(u32x2*)((unsigned char*)d.Wt + (size_t)(d.d0 + nn) * d.ldt + d.k0 + 8 * c) = (u32x2){cvt4_fp8(f[0], f[1], f[2], f[3]), cvt4_fp8(f[4], f[5], f[6], f[7])}; }
        return; }
#pragma unroll
    for (int j = 0; j < 8; ++j) { const int nn = (lane >> 3) + 8 * j; LAS const float* q = scr + (8 * c) * 65 + nn; h16x8 o;
#pragma unroll
        for (int e = 0; e < 8; ++e) o[e] = (h16)(q[e * 65] * gs[e]);
        *(h16x8*)(d.Wt + (size_t)(d.d0 + nn) * d.ldt + d.k0 + 8 * c) = o; }
}
__device__ __forceinline__ void phase_convert(const Frame& F, const Prm& p, int l) {
    LAS float* scr = (LAS float*)(F.lds + F.wave * 16640);
    const int gw = F.vcu * 8 + F.wave, NGW = F.G * 8;
    constexpr int NITEMS = 896 + 256 + 256 + 512 + 256 + 8192 + 4096 + 16;
    { TrItem cur, nxt; f32x4 v[16]; int it = gw;
        if (it < NITEMS) { tr_describe(F, F.ws, l, it, cur); tr_load(cur, F.lane, v); }
        while (it < NITEMS) { const int itn = it + NGW; const bool hn = itn < NITEMS;
            tr_to_lds(cur, F.lane, v, scr);
            if (hn) { tr_describe(F, F.ws, l, itn, nxt); tr_load(nxt, F.lane, v); }
            asm volatile("s_waitcnt lgkmcnt(0)" ::: "memory");
            tr_from_lds(cur, F.lane, scr);
            asm volatile("s_waitcnt lgkmcnt(0)" ::: "memory");
            cur = nxt; it = itn; } }
    {
        const float* gm = inptr(F, 23) + l * DM; const float* wg = inptr(F, 24) + (size_t)l * DM * 4; const float* we = inptr(F, 26) + (size_t)l * DM * 32; h16* rwg = WSP(h16, OFF_RWG);
        for (int i = F.vcu * 512 + F.tid; i < 36 * DM; i += 256 * 512) { const int k = i / 36, j = i % 36; const float wv = gm[k] * (j < 4 ? wg[k * 4 + j] : we[k * 32 + (j - 4)]) * 1024.0f;
            const h16 hi = (h16)wv; rwg[(size_t)j * 1032 + k] = hi; rwg[(size_t)(36 + j) * 1032 + k] = (h16)(wv - (float)hi); } }
    if (l == 0) {
        for (int m = gw; m < NT + NTM; m += NGW) {
            const bool isx = m < NT; const int row = isx ? m : m - NT;
            const float* src = (isx ? inptr(F, 0) : inptr(F, 1)) + (size_t)row * DM; h16* dst = (isx ? WSP(h16, WS_HB) : WSP(h16, WS_MEM16)) + (size_t)row * DM;
            float* sq = (isx ? WSP(float, WS_SSQ) : WSP(float, OFF_MSSQ)) + (size_t)row * 16;
            float s = 0.f;
#pragma unroll
            for (int j = 0; j < 4; ++j) { const f32x4 v = __builtin_nontemporal_load((const f32x4*)(src + 4 * F.lane + 256 * j)); *(h16x4*)(dst + 4 * F.lane + 256 * j) = pack4(v);
                if (F8_HB && isx) *(unsigned*)((unsigned char*)F.out + OUT_HB8 + (size_t)row * DM + 4 * F.lane + 256 * j) = cvt4_fp8(v[0], v[1], v[2], v[3]); s += (v[0] * v[0] + v[1] * v[1]) + (v[2] * v[2] + v[3] * v[3]); }
            s = wave_sum(s);
            if (F.lane < 16) sq[F.lane] = (F.lane == 0) ? s : 0.f;
            if (F.lane == 0) (isx ? WSP(float, OFF_RSTDT) : WSP(float, OFF_MRSTD))[row] = 1.0f / sqrtf(s * (1.0f / DM) + EPS);
        }
        float* rope = WSP(float, OFF_ROPE);
        for (int i = F.vcu * 512 + F.tid; i < SEQ * 32; i += F.G * 512) {
            const int pos = i >> 5, fi = i & 31; double th = 1.0;
            for (int k = 0; k < fi; ++k) th *= 0.74989420933245582730;
            const double rev = (double)pos * th * 0.15915494309189533577;
            const double fr = rev - floor(rev);
            const double r = (fr - 0.5) * 6.28318530717958647692;
            const double r2 = r * r; double sn = 1.0, cs = 1.0;
            for (int k = 14; k >= 1; --k) { sn = 1.0 - r2 / (double)((2 * k) * (2 * k + 1)) * sn; cs = 1.0 - r2 / (double)((2 * k - 1) * (2 * k)) * cs; }
            sn *= r;
            rope[pos * 64 + fi] = (float)(-cs); rope[pos * 64 + 32 + fi] = (float)(-sn);
        }
    }
}

template <bool SILU>
__device__ __forceinline__ void conv_rows8(const h16* projcol, long tbase, int n, int r0, const float* cw, int cdim, const float* cb, h16x8 (&out)[8]) {
    f32x4 w[4][2];
#pragma unroll
    for (int k = 0; k < 4; ++k) { w[k][0] = *(const f32x4*)(cw + k * cdim); w[k][1] = *(const f32x4*)(cw + k * cdim + 4); }
    const f32x4 b0 = *(const f32x4*)cb, b1 = *(const f32x4*)(cb + 4);
    h16x8 x[11];
#pragma unroll
    for (int i = 0; i < 11; ++i) { const int pos = n * 128 + r0 - 2 + i; h16x8 z;
#pragma unroll
        for (int e = 0; e < 8; ++e) z[e] = (h16)0.f;
        x[i] = (pos >= 0 && pos < SEQ) ? NTL(h16x8, projcol + (size_t)(tbase + r0 - 2 + i) * NPJ) : z; }
#pragma unroll
    for (int r = 0; r < 8; ++r) {
#pragma unroll
        for (int e = 0; e < 8; ++e) { float a = e < 4 ? b0[e] : b1[e - 4];
#pragma unroll
            for (int k = 0; k < 4; ++k) a += (e < 4 ? w[k][0][e] : w[k][1][e - 4]) * (float)x[r + k][e];
            out[r][e] = (h16)(SILU ? siluf_(a) : a); } }
}
__device__ __forceinline__ h16x8 col_of(const h16x8 (&o)[8], int e) { h16x8 c; c[0] = o[0][e]; c[1] = o[1][e]; c[2] = o[2][e]; c[3] = o[3][e]; c[4] = o[4][e]; c[5] = o[5][e]; c[6] = o[6][e]; c[7] = o[7][e]; return c; }

__device__ __forceinline__ void ret_scan_unit(const Frame& F, int u) {
    const int h = u % 6, b = (u / 6) % NB, dir = u / (6 * NB);
    const float gC = exp2f(128.0f * log1pf(-exp2f(-5.0f - (float)h)) * 1.4426950408889634f);
    h16* base = WSP(h16, OFF_RST) + ((size_t)((dir * NB + b) * NCH) * 6 + h) * 4096 + F.tid * 8;
    float acc[8]; float zf = 0.f; asm volatile("" : "+v"(zf));
#pragma unroll
    for (int e = 0; e < 8; ++e) acc[e] = zf;
    h16x8 sv[16];
#pragma unroll
    for (int i = 0; i < 16; ++i) { const int n = dir == 0 ? i : NCH - 1 - i; sv[i] = *(const h16x8*)(base + (size_t)n * 6 * 4096); }
#pragma unroll
    for (int i = 0; i < 16; ++i) { const int n = dir == 0 ? i : NCH - 1 - i; h16x8 o;
#pragma unroll
        for (int e = 0; e < 8; ++e) { o[e] = (h16)acc[e]; acc[e] = acc[e] * gC + (float)sv[i][e]; }
        *(h16x8*)(base + (size_t)n * 6 * 4096) = o; }
}
#define RET_BAR() do { asm volatile("s_waitcnt lgkmcnt(0)" ::: "memory"); __builtin_amdgcn_s_barrier(); asm volatile("" ::: "memory"); } while (0)
__device__ __forceinline__ void ret_states_block(const Frame& F, int bn) {
    const int n = bn % NCH, b = bn / NCH; const long t0 = (long)b * SEQ + n * 128;
    const int r = F.tid >> 2, c = F.tid & 3;
    const h16* rowp = WSP(const h16, WS_R1) + (size_t)(t0 + r) * NPJ; const float* cs = WSP(const float, OFF_ROPE) + (size_t)(n * 128 + r) * 64 + 8 * c;
    const f32x4 c0 = *(const f32x4*)cs, c1 = *(const f32x4*)(cs + 4), s0 = *(const f32x4*)(cs + 32), s1 = *(const f32x4*)(cs + 36);
    const int dir = F.wave >> 2, dt = F.wave & 3, fr = F.lane & 15, fq = F.lane >> 4;
    h16x8 k1, k2, v1, v2;
#define RS_LOAD(hh) do { k1 = *(const h16x8*)(rowp + CK + (hh) * 64 + 8 * c); k2 = *(const h16x8*)(rowp + CK + (hh) * 64 + 32 + 8 * c); v1 = *(const h16x8*)(rowp + CV + (hh) * 64 + 16 * c); v2 = *(const h16x8*)(rowp + CV + (hh) * 64 + 16 * c + 8); } while (0)
    RS_LOAD(0);
#pragma unroll 1
    for (int h = 0; h < 6; ++h) {
        LAS h16* KT = (LAS h16*)(F.lds + (h & 1) * 34816); LAS h16* VT = KT + 64 * 136;
#pragma unroll
        for (int e = 0; e < 8; ++e) { const float x1 = (float)k1[e], x2 = (float)k2[e], co = e < 4 ? c0[e] : c1[e - 4], si = e < 4 ? s0[e] : s1[e - 4];
            KT[(8 * c + e) * 136 + r] = (h16)((x1 * co - x2 * si) * 0.125f); KT[(32 + 8 * c + e) * 136 + r] = (h16)((x1 * si + x2 * co) * 0.125f); }
#pragma unroll
        for (int e = 0; e < 8; ++e) { VT[(16 * c + e) * 136 + r] = v1[e]; VT[(16 * c + 8 + e) * 136 + r] = v2[e]; }
        if (h < 5) RS_LOAD(h + 1);
        RET_BAR();
        const float l2g = log1pf(-exp2f(-5.0f - (float)h)) * 1.4426950408889634f;
        h16x8 xw[4];
#pragma unroll
        for (int ks = 0; ks < 4; ++ks) { const h16x8 f = ldsfrag(KT + (16 * dt + fr) * 136 + 32 * ks + 8 * fq); h16x8 wv;
#pragma unroll
            for (int jj = 0; jj < 8; ++jj) { const int j = 32 * ks + 8 * fq + jj; wv[jj] = (h16)exp2f(l2g * (float)(dir == 0 ? 127 - j : j)); }
            xw[ks] = f * wv; }
        h16* rst = WSP(h16, OFF_RST) + ((size_t)((dir * NB + b) * NCH + n) * 6 + h) * 4096;
#pragma unroll
        for (int et = 0; et < 4; ++et) { f32x4 acc = {0.f, 0.f, 0.f, 0.f};
#pragma unroll
            for (int ks = 0; ks < 4; ++ks) acc = MFMA16(xw[ks], ldsfrag(VT + (16 * et + fr) * 136 + 32 * ks + 8 * fq), acc);
            *(h16x4*)(rst + (16 * et + fr) * 64 + 16 * dt + 4 * fq) = pack4(acc); }
    }
#undef RS_LOAD
    __syncthreads();
}
__device__ __forceinline__ void ret_out_block(const Frame& F, int bn) {
    const int n = bn % NCH, b = bn / NCH; const long t0 = (long)b * SEQ + n * 128;
    const int r = F.tid >> 2, c = F.tid & 3, rp = kperm32(r), er = F.tid >> 3, d0 = (F.tid & 7) * 8;
    const h16* rowp = WSP(const h16, WS_R1) + (size_t)(t0 + r) * NPJ; const float* cs = WSP(const float, OFF_ROPE) + (size_t)(n * 128 + r) * 64 + 8 * c;
    const f32x4 c0 = *(const f32x4*)cs, c1 = *(const f32x4*)(cs + 4), s0 = *(const f32x4*)(cs + 32), s1 = *(const f32x4*)(cs + 36);
    const int w = F.wave, fr = F.lane & 15, fq = F.lane >> 4, il = 16 * w + fr;
    const h16* grow = WSP(const h16, WS_R1) + (size_t)(t0 + il) * NPJ + CG + 4 * fq; h16* orow = WSP(h16, OFF_OMIX) + (size_t)(t0 + il) * DM + 4 * fq; unsigned char* orow8 = WSP(unsigned char, OFF_OMIX8) + (size_t)(t0 + il) * DM + 4 * fq;
    const h16* st0 = WSP(const h16, OFF_RST) + ((size_t)((0 * NB + b) * NCH + n) * 6) * 4096 + F.tid * 8; const h16* st1 = WSP(const h16, OFF_RST) + ((size_t)((1 * NB + b) * NCH + n) * 6) * 4096 + F.tid * 8;
    h16x8 q1, q2, k1, k2, v1, v2, sf, sb; h16x4 gn[4];
#define RO_LOAD(hh) do { q1 = NTL(h16x8, rowp + CQ + (hh) * 64 + 8 * c); q2 = NTL(h16x8, rowp + CQ + (hh) * 64 + 32 + 8 * c); k1 = NTL(h16x8, rowp + CK + (hh) * 64 + 8 * c); k2 = NTL(h16x8, rowp + CK + (hh) * 64 + 32 + 8 * c); \
        v1 = NTL(h16x8, rowp + CV + (hh) * 64 + 16 * c); v2 = NTL(h16x8, rowp + CV + (hh) * 64 + 16 * c + 8); sf = NTL(h16x8, st0 + (hh) * 4096); sb = NTL(h16x8, st1 + (hh) * 4096); \
        _Pragma("unroll") for (int et_ = 0; et_ < 4; ++et_) gn[et_] = NTL(h16x4, grow + (hh) * 64 + 16 * et_); } while (0)
    RO_LOAD(0);
#pragma unroll 1
    for (int h = 0; h < 6; ++h) {
        LAS h16* Qt = (LAS h16*)(F.lds + (h & 1) * 72704); LAS h16* Kt = Qt + 128 * 72; LAS h16* VT = Kt + 128 * 72; LAS h16* Ff = VT + 64 * 136; LAS h16* Fb = Ff + 64 * 72;
        { h16x8 qa, qb, ka, kb;
#pragma unroll
            for (int e = 0; e < 8; ++e) { const float co = e < 4 ? c0[e] : c1[e - 4], si = e < 4 ? s0[e] : s1[e - 4];
                float x1 = (float)q1[e], x2 = (float)q2[e]; qa[e] = (h16)(x1 * co - x2 * si); qb[e] = (h16)(x1 * si + x2 * co);
                x1 = (float)k1[e]; x2 = (float)k2[e]; ka[e] = (h16)((x1 * co - x2 * si) * 0.125f); kb[e] = (h16)((x1 * si + x2 * co) * 0.125f); }
            *(LAS h16x8*)(Qt + r * 72 + 8 * c) = qa; *(LAS h16x8*)(Qt + r * 72 + 32 + 8 * c) = qb;
            *(LAS h16x8*)(Kt + r * 72 + 8 * c) = ka; *(LAS h16x8*)(Kt + r * 72 + 32 + 8 * c) = kb; }
#pragma unroll
        for (int e = 0; e < 8; ++e) { VT[(16 * c + e) * 136 + rp] = v1[e]; VT[(16 * c + 8 + e) * 136 + rp] = v2[e]; }
        *(LAS h16x8*)(Ff + er * 72 + d0) = sf; *(LAS h16x8*)(Fb + er * 72 + d0) = sb;
        h16x4 gc[4];
#pragma unroll
        for (int et = 0; et < 4; ++et) gc[et] = gn[et];
        if (h < 5) RO_LOAD(h + 1);
        RET_BAR();
        const float l2g = log1pf(-exp2f(-5.0f - (float)h)) * 1.4426950408889634f;
        h16x8 qf[2];
#pragma unroll
        for (int ks = 0; ks < 2; ++ks) qf[ks] = ldsfrag(Qt + il * 72 + 32 * ks + 8 * fq);
        f32x4 s[8];
#pragma unroll
        for (int jt = 0; jt < 8; ++jt) { f32x4 a = {0.f, 0.f, 0.f, 0.f};
#pragma unroll
            for (int ks = 0; ks < 2; ++ks) a = MFMA16(ldsfrag(Kt + (16 * jt + fr) * 72 + 32 * ks + 8 * fq), qf[ks], a);
#pragma unroll
            for (int q = 0; q < 4; ++q) { const int j = 16 * jt + 4 * fq + q; const int dd = il > j ? il - j : j - il; a[q] *= exp2f(l2g * (float)dd); }
            PINV(a); s[jt] = a; }
        f32x4 o[4];
#pragma unroll
        for (int et = 0; et < 4; ++et) o[et] = (f32x4){0.f, 0.f, 0.f, 0.f};
#pragma unroll
        for (int kp = 0; kp < 4; ++kp) { const h16x8 pf = pack8(s[2 * kp], s[2 * kp + 1]);
#pragma unroll
            for (int et = 0; et < 4; ++et) o[et] = MFMA16(ldsfrag(VT + (16 * et + fr) * 136 + 32 * kp + 8 * fq), pf, o[et]); }
        const float gf = exp2f(l2g * (float)(il + 1)), gb = exp2f(l2g * (float)(128 - il));
#pragma unroll
        for (int ks = 0; ks < 2; ++ks) { const h16x8 qff = scalefrag(qf[ks], gf), qfb = scalefrag(qf[ks], gb);
#pragma unroll
            for (int et = 0; et < 4; ++et) { o[et] = MFMA16(ldsfrag(Ff + (16 * et + fr) * 72 + 32 * ks + 8 * fq), qff, o[et]); o[et] = MFMA16(ldsfrag(Fb + (16 * et + fr) * 72 + 32 * ks + 8 * fq), qfb, o[et]); } }
        float ss = 0.f;
#pragma unroll
        for (int et = 0; et < 4; ++et) ss += (o[et][0] * o[et][0] + o[et][1] * o[et][1]) + (o[et][2] * o[et][2] + o[et][3] * o[et][3]);
        ss += __shfl_xor(ss, 16); ss += __shfl_xor(ss, 32);
        const float rs = 1.0f / sqrtf(ss * (1.0f / 64.0f) + EPS);
#pragma unroll
        for (int et = 0; et < 4; ++et) { f32x4 q;
#pragma unroll
            for (int e = 0; e < 4; ++e) q[e] = o[et][e] * rs * siluf_((float)gc[et][e]);
            if (F8_OUT) *(unsigned*)(orow8 + h * 64 + 16 * et) = cvt4_fp8(8.f * q[0], 8.f * q[1], 8.f * q[2], 8.f * q[3]);
            else *(h16x4*)(orow + h * 64 + 16 * et) = pack4(q); }
    }
#undef RO_LOAD
    __syncthreads();
}
#undef RET_BAR

__device__ __forceinline__ void ssd_stage_dt(const Frame& F, const Prm& p, int l, int g, long t0, LAS float* LA, LAS float* DTS) {
    if (F.tid < 128) { const h16* dp = WSP(const h16, WS_R1) + (size_t)(t0 + F.tid) * NPJ + CDT + g * 3;
#pragma unroll
        for (int r = 0; r < 3; ++r) { const float raw = (float)dp[r];
#pragma unroll
            for (int dir = 0; dir < 2; ++dir) { const float dt = softplusf_(raw + inptr(F, 7)[(l * 2 + dir) * 6 + g * 3 + r]); const float la = -dt * __expf(inptr(F, 8)[(l * 2 + dir) * 6 + g * 3 + r]);
                DTS[(dir * 3 + r) * 128 + F.tid] = dt; LA[(dir * 3 + r) * 128 + F.tid] = la; } } }
}
__device__ __forceinline__ void ssd_cumsum(const Frame& F, LAS const float* LAq, float& v0, float& v1, float& c0, float& c1, float& tot) {
    v0 = LAq[2 * F.lane]; v1 = LAq[2 * F.lane + 1]; float s = v0 + v1;
#pragma unroll
    for (int o = 1; o < 64; o <<= 1) { const float t = __shfl_up(s, o); if (F.lane >= o) s += t; }
    c1 = s; c0 = s - v1; tot = __shfl(s, 63);
}
__device__ __forceinline__ void ssd_states_unit(const Frame& F, const Prm& p, int l, int u) {
    const int g = u & 1, bn = u >> 1, n = bn % NCH, b = bn / NCH; const long t0 = (long)b * SEQ + n * 128;
    const h16* proj = WSP(const h16, WS_R1);
    LAS h16* XT = (LAS h16*)F.lds; LAS h16* BT = XT + 3 * 64 * 136; LAS float* LA = (LAS float*)(BT + 128 * 136); LAS float* DTS = LA + 6 * 128; LAS float* WW = DTS + 6 * 128;
    ssd_stage_dt(F, p, l, g, t0, LA, DTS);
    const float* cw = inptr(F, 5) + (size_t)l * 4 * 896; const float* cb = inptr(F, 6) + (size_t)l * 896;
    h16* bcn = ((h16*)((unsigned char*)F.out + OUT_BCN));
    for (int task = F.tid; task < 56 * 16; task += 512) { const int cg = task % 56, r0 = (task / 56) * 8; h16x8 o[8];
        if (cg < 24) { conv_rows8<true>(proj + CXS + g * 192 + 8 * cg, t0, n, r0, cw + g * 192 + 8 * cg, 896, cb + g * 192 + 8 * cg, o);
            LAS h16* d = XT + (cg >> 3) * 64 * 136 + ((cg & 7) * 8) * 136 + r0;
#pragma unroll
            for (int e = 0; e < 8; ++e) *(LAS h16x8*)(d + e * 136) = col_of(o, e);
        } else { const int c8 = (cg - 24) & 15; const bool isB = cg < 40; const int col = (isB ? CBM : CCM) + g * 128 + 8 * c8, ci = (isB ? 384 : 640) + g * 128 + 8 * c8;
            conv_rows8<true>(proj + col, t0, n, r0, cw + ci, 896, cb + ci, o);
#pragma unroll
            for (int r = 0; r < 8; ++r) *(h16x8*)(bcn + (size_t)(t0 + r0 + r) * 512 + (isB ? 0 : 256) + g * 128 + 8 * c8) = o[r];
            if (isB) { LAS h16* d = BT + (8 * c8) * 136 + r0;
#pragma unroll
                for (int e = 0; e < 8; ++e) *(LAS h16x8*)(d + e * 136) = col_of(o, e); } } }
    __syncthreads();
    { h16* xtg = ((h16*)((unsigned char*)F.out + OUT_XTG)) + ((size_t)(b * NCH + n) * 6 + g * 3) * 8192;
#pragma unroll
        for (int k = 0; k < 6; ++k) { const int it = F.tid + 512 * k, rr = it >> 4, c = it & 15; const h16x8 v = *(LAS const h16x8*)(XT + rr * 136 + 8 * c);
            *(h16x4*)(xtg + rr * 128 + kperm32(8 * c)) = __builtin_shufflevector(v, v, 0, 1, 2, 3); *(h16x4*)(xtg + rr * 128 + kperm32(8 * c + 4)) = __builtin_shufflevector(v, v, 4, 5, 6, 7); } }
    if (F.wave < 6) { const int q = F.wave, dir = q / 3, r = q % 3; float v0, v1, c0, c1, tot; ssd_cumsum(F, LA + q * 128, v0, v1, c0, c1, tot);
        const float d0 = DTS[q * 128 + 2 * F.lane], d1 = DTS[q * 128 + 2 * F.lane + 1];
        if (dir == 0) { WW[q * 128 + 2 * F.lane] = __expf(tot - c0) * d0 * 256.f; WW[q * 128 + 2 * F.lane + 1] = __expf(tot - c1) * d1 * 256.f; }
        else { WW[q * 128 + 2 * F.lane] = __expf(c0 - v0) * d0 * 256.f; WW[q * 128 + 2 * F.lane + 1] = __expf(c1 - v1) * d1 * 256.f; }
        if (F.lane == 0) WSP(float, OFF_SDEC)[((size_t)(b * NCH + n) * 6 + g * 3 + r) * 2 + dir] = tot; }
    __syncthreads();
    const int w = F.wave, fr = F.lane & 15, fq = F.lane >> 4;
    h16x8 xb[4];
#pragma unroll
    for (int ks = 0; ks < 4; ++ks) xb[ks] = ldsfrag(BT + (16 * w + fr) * 136 + 32 * ks + 8 * fq);
    for (int q = 0; q < 6; ++q) { const int dir = q / 3, r = q % 3;
        h16x8 wf[4];
#pragma unroll
        for (int ks = 0; ks < 4; ++ks) { const f32x4 a = *(LAS const f32x4*)(WW + q * 128 + 32 * ks + 8 * fq), c = *(LAS const f32x4*)(WW + q * 128 + 32 * ks + 8 * fq + 4); wf[ks] = pack8(a, c); }
        h16* sst = WSP(h16, OFF_SST) + ((size_t)((dir * NB + b) * NCH + n) * 6 + g * 3 + r) * 8192;
#pragma unroll
        for (int pt = 0; pt < 4; ++pt) { f32x4 acc = {0.f, 0.f, 0.f, 0.f};
#pragma unroll
            for (int ks = 0; ks < 4; ++ks) acc = MFMA16(xb[ks], ldsfrag(XT + r * 64 * 136 + (16 * pt + fr) * 136 + 32 * ks + 8 * fq) * wf[ks], acc);
            *(h16x4*)(sst + (16 * pt + fr) * 128 + 16 * w + 4 * fq) = pack4(acc * (1.0f / 256.f)); } }
    __syncthreads();
}
__device__ __forceinline__ void ssd_scan_unit(const Frame& F, int uh) {
    const int u = uh >> 1, hd = u % 6, b = (u / 6) % NB, dir = u / (6 * NB);
    h16* base = WSP(h16, OFF_SST) + ((size_t)((dir * NB + b) * NCH) * 6 + hd) * 8192 + (uh & 1) * 4096 + F.tid * 8;
    const float* dbase = WSP(const float, OFF_SDEC) + ((size_t)(b * NCH) * 6 + hd) * 2 + dir;
    float acc[8]; float zf = 0.f; asm volatile("" : "+v"(zf));
#pragma unroll
    for (int e = 0; e < 8; ++e) acc[e] = zf;
    h16x8 sv[16]; float dec[16];
#pragma unroll
    for (int i = 0; i < 16; ++i) { const int n = dir == 0 ? i : NCH - 1 - i; sv[i] = *(const h16x8*)(base + (size_t)n * 6 * 8192); dec[i] = dbase[n * 12]; }
#pragma unroll
    for (int i = 0; i < 16; ++i) { const int n = dir == 0 ? i : NCH - 1 - i; const float dc = __expf(dec[i]); h16x8 o;
#pragma unroll
        for (int e = 0; e < 8; ++e) { o[e] = (h16)acc[e]; acc[e] = acc[e] * dc + (float)sv[i][e]; }
        *(h16x8*)(base + (size_t)n * 6 * 8192) = o; }
}
__device__ __forceinline__ void ssd_out_unit(const Frame& F, const Prm& p, int l, int u) {
    const int g = u & 1, bn = u >> 1, n = bn % NCH, b = bn / NCH; const long t0 = (long)b * SEQ + n * 128;
    const h16* proj = WSP(const h16, WS_R1);
    LAS h16* XT = (LAS h16*)F.lds; LAS h16* Bt = XT + 3 * 64 * 136; LAS h16* Ct = Bt + 128 * 136; LAS float* LA = (LAS float*)(Ct + 128 * 136); LAS float* DTS = LA + 6 * 128;
    LAS float* CE = DTS + 6 * 128;
    LAS float* TOTB = CE + 6 * 128;
    ssd_stage_dt(F, p, l, g, t0, LA, DTS);
    const float* cw = inptr(F, 5) + (size_t)l * 4 * 896; const float* cb = inptr(F, 6) + (size_t)l * 896;
    { const h16* xtg = ((const h16*)((const unsigned char*)F.out + OUT_XTG)) + ((size_t)(b * NCH + n) * 6 + g * 3) * 8192; const h16* bcn = ((const h16*)((const unsigned char*)F.out + OUT_BCN)) + (size_t)t0 * 512 + g * 128;
        h16x8 xv[6], bv[8];
#pragma unroll
        for (int k = 0; k < 6; ++k) { const int it = F.tid + 512 * k; xv[k] = NTL(h16x8, xtg + (it >> 4) * 128 + 8 * (it & 15)); }
#pragma unroll
        for (int k = 0; k < 8; ++k) { const int it = F.tid + 512 * k, row = it >> 5, c = it & 31; bv[k] = NTL(h16x8, bcn + (size_t)row * 512 + (c < 16 ? 8 * c : 256 + 8 * (c - 16))); }
#pragma unroll
        for (int k = 0; k < 6; ++k) { const int it = F.tid + 512 * k; *(LAS h16x8*)(XT + (it >> 4) * 136 + 8 * (it & 15)) = xv[k]; }
#pragma unroll
        for (int k = 0; k < 8; ++k) { const int it = F.tid + 512 * k, row = it >> 5, c = it & 31; *(LAS h16x8*)((c < 16 ? Bt : Ct) + row * 136 + 8 * (c & 15)) = bv[k]; }
        PIN(); }
    __syncthreads();
    if (F.wave < 6) { const int q = F.wave; float v0, v1, c0, c1, tot; ssd_cumsum(F, LA + q * 128, v0, v1, c0, c1, tot);
        if (q < 3) { CE[q * 128 + 2 * F.lane] = c0; CE[q * 128 + 2 * F.lane + 1] = c1; }
        else { CE[q * 128 + 2 * F.lane] = c0 - v0; CE[q * 128 + 2 * F.lane + 1] = c1 - v1; if (F.lane == 0) TOTB[q - 3] = tot; } }
    __syncthreads();
    const int w = F.wave, fr = F.lane & 15, fq = F.lane >> 4, il = 16 * w + fr;
    h16x8 cf[4];
#pragma unroll
    for (int ks = 0; ks < 4; ++ks) cf[ks] = ldsfrag(Ct + il * 136 + 32 * ks + 8 * fq);
    f32x4 gT[8];
#pragma unroll
    for (int jt = 0; jt < 8; ++jt) { f32x4 a = {0.f, 0.f, 0.f, 0.f};
#pragma unroll
        for (int ks = 0; ks < 4; ++ks) a = MFMA16(ldsfrag(Bt + (16 * jt + fr) * 136 + 32 * ks + 8 * fq), cf[ks], a);
        PINV(a); gT[jt] = a; }
    const float* dsk = inptr(F, 9) + l * 6 + g * 3;
    h16* orow = WSP(h16, OFF_OMIX) + (size_t)(t0 + il) * DM + 384 + g * 192;
    float ss = 0.f;
    { h16x8 h0[4];
#pragma unroll
        for (int k = 0; k < 4; ++k) { const int it = F.tid + 512 * k, dir = it >> 10, e = it & 1023; h0[k] = NTL(h16x8, WSP(const h16, OFF_SST) + ((size_t)((dir * NB + b) * NCH + n) * 6 + g * 3) * 8192 + e * 8); }
        __syncthreads();
#pragma unroll
        for (int k = 0; k < 4; ++k) { const int it = F.tid + 512 * k, dir = it >> 10, e = it & 1023; *(LAS h16x8*)(Bt + dir * 64 * 136 + (e >> 4) * 136 + 8 * (e & 15)) = h0[k]; }
        __syncthreads(); }
#pragma unroll 1
    for (int r = 0; r < 3; ++r) {
        f32x4 y[1][4];
        const int hd = g * 3 + r;
        const float cfi = CE[r * 128 + il], ebi = CE[(3 + r) * 128 + il], totb = TOTB[r];
#pragma unroll
        for (int pt = 0; pt < 4; ++pt) y[0][pt] = (f32x4){0.f, 0.f, 0.f, 0.f};
        LAS const h16* HL = (r & 1) ? Ct : Bt;
        h16x8 hreg[4];
        if (r < 2) {
#pragma unroll
            for (int k = 0; k < 4; ++k) { const int it = F.tid + 512 * k, dir = it >> 10, e = it & 1023; hreg[k] = NTL(h16x8, WSP(const h16, OFF_SST) + ((size_t)((dir * NB + b) * NCH + n) * 6 + hd + 1) * 8192 + e * 8); } }
#pragma unroll
        for (int kp = 0; kp < 4; ++kp) { f32x4 pv[2];
#pragma unroll
            for (int jh = 0; jh < 2; ++jh) { const int jt = 2 * kp + jh, j0 = 16 * jt + 4 * fq;
                const f32x4 cfj = *(LAS const f32x4*)(CE + r * 128 + j0), ebj = *(LAS const f32x4*)(CE + (3 + r) * 128 + j0), dfj = *(LAS const f32x4*)(DTS + r * 128 + j0), dbj = *(LAS const f32x4*)(DTS + (3 + r) * 128 + j0);
#pragma unroll
                for (int e = 0; e < 4; ++e) { const int j = j0 + e; const float val = (il >= j) ? __expf(cfi - cfj[e]) * dfj[e] : __expf(ebj[e] - ebi) * dbj[e]; pv[jh][e] = gT[jt][e] * val * 256.f; }
                PINV(pv[jh]); }
            const h16x8 pf = pack8(pv[0], pv[1]);
#pragma unroll
            for (int pt = 0; pt < 4; ++pt) y[0][pt] = MFMA16(ldsfrag(XT + r * 64 * 136 + (16 * pt + fr) * 136 + 32 * kp + 8 * fq), pf, y[0][pt]);
            PINV(y[0][0]); PINV(y[0][1]); PINV(y[0][2]); PINV(y[0][3]); }
        const float ef = __expf(cfi) * 256.f, eb = __expf(totb - ebi) * 256.f;
#pragma unroll
        for (int ks = 0; ks < 4; ++ks) { const h16x8 cff = scalefrag(cf[ks], ef), cfb = scalefrag(cf[ks], eb);
#pragma unroll
            for (int pt = 0; pt < 4; ++pt) { y[0][pt] = MFMA16(ldsfrag(HL + (16 * pt + fr) * 136 + 32 * ks + 8 * fq), cff, y[0][pt]); y[0][pt] = MFMA16(ldsfrag(HL + 64 * 136 + (16 * pt + fr) * 136 + 32 * ks + 8 * fq), cfb, y[0][pt]); }
            PINV(y[0][0]); PINV(y[0][1]); PINV(y[0][2]); PINV(y[0][3]); }
        if (r < 2) { LAS h16* HN = (r & 1) ? Bt : Ct;
#pragma unroll
            for (int k = 0; k < 4; ++k) { const int it = F.tid + 512 * k, dir = it >> 10, e = it & 1023; *(LAS h16x8*)(HN + dir * 64 * 136 + (e >> 4) * 136 + 8 * (e & 15)) = hreg[k]; } }
        const float dk = dsk[r]; const h16* zrow = proj + (size_t)(t0 + il) * NPJ + CZ + hd * 64;
#pragma unroll
        for (int pt = 0; pt < 4; ++pt) { const h16x4 zv = NTL(h16x4, zrow + 16 * pt + 4 * fq);
#pragma unroll
            for (int e = 0; e < 4; ++e) { const float xv = (float)XT[r * 64 * 136 + (16 * pt + 4 * fq + e) * 136 + kperm32(il)]; y[0][pt][e] = (y[0][pt][e] * (1.0f / 256.f) + dk * xv) * siluf_((float)zv[e]); }
            const h16x4 yh = pack4(y[0][pt]); *(h16x4*)(orow + r * 64 + 16 * pt + 4 * fq) = yh;
#pragma unroll
            for (int e = 0; e < 4; ++e) { const float q = (float)yh[e]; ss += q * q; } }
        __syncthreads();
    }
    ss += __shfl_xor(ss, 16); ss += __shfl_xor(ss, 32);
    const float rs = 1.0f / sqrtf(ss * (1.0f / 192.0f) + EPS);
    const float* nw = inptr(F, 10) + l * 384 + g * 192;
    asm volatile("s_waitcnt vmcnt(0)" ::: "memory");
#pragma unroll 1
    for (int r = 0; r < 3; ++r)
#pragma unroll
        for (int pt = 0; pt < 4; ++pt) { const f32x4 wv = *(const f32x4*)(nw + r * 64 + 16 * pt + 4 * fq); h16* op = orow + r * 64 + 16 * pt + 4 * fq; const h16x4 yh = *(const h16x4*)op; f32x4 yv;
#pragma unroll
            for (int e = 0; e < 4; ++e) yv[e] = (float)yh[e] * rs * wv[e];
            if (F8_OUT) *(unsigned*)(WSP(unsigned char, OFF_OMIX8) + (size_t)(t0 + il) * DM + 384 + g * 192 + r * 64 + 16 * pt + 4 * fq) = cvt4_fp8(8.f * yv[0], 8.f * yv[1], 8.f * yv[2], 8.f * yv[3]);
            else *(h16x4*)op = pack4(yv); }
    __syncthreads();
}

__device__ __forceinline__ void lru_unit(const Frame& F, const Prm& p, int l, int u) {
    const int n = u % NCH, b = u / NCH; const long t0 = (long)b * SEQ + n * 128;
    const h16* proj = WSP(const h16, WS_R1);
    LAS h16* XC = (LAS h16*)F.lds;
    const float* cw = inptr(F, 11) + (size_t)l * 4 * 256; const float* cb = inptr(F, 12) + (size_t)l * 256;
    { const int cg = F.tid & 31, r0 = (F.tid >> 5) * 8; h16x8 o[8];
        conv_rows8<false>(proj + CXR + 8 * cg, t0, n, r0, cw + 8 * cg, 256, cb + 8 * cg, o);
#pragma unroll
        for (int r = 0; r < 8; ++r) *(LAS h16x8*)(XC + (r0 + r) * 264 + 8 * cg) = o[r]; }
    __syncthreads();
    const int blk = F.wave & 3, jh = F.wave >> 2, fr = F.lane & 15, fq = F.lane >> 4;
    h16* lau = (h16*)((unsigned char*)F.out + OUT_LAU) + (size_t)(b * NCH + n) * 2 * 128 * 256 * 2;
    h16x8 wa[2][2][2], wx[2][2][2]; float ba[2][2], bx[2][2], sp[2][2], car[2][2], atot[2][2];
#pragma unroll
    for (int dir = 0; dir < 2; ++dir)
#pragma unroll
        for (int jt = 0; jt < 2; ++jt) { const int ch = blk * 64 + 32 * jh + 16 * jt + fr;
#pragma unroll
            for (int ks = 0; ks < 2; ++ks) { wa[dir][jt][ks] = *(const h16x8*)(WSP(const h16, WS_LRUW) + (size_t)((dir * 2 + 0) * 4 + blk) * 4096 + (32 * jh + 16 * jt + fr) * 64 + 32 * ks + 8 * fq);
                wx[dir][jt][ks] = *(const h16x8*)(WSP(const h16, WS_LRUW) + (size_t)((dir * 2 + 1) * 4 + blk) * 4096 + (32 * jh + 16 * jt + fr) * 64 + 32 * ks + 8 * fq); }
            ba[dir][jt] = inptr(F, 15)[(l * 2 + dir) * 256 + ch]; bx[dir][jt] = inptr(F, 17)[(l * 2 + dir) * 256 + ch]; sp[dir][jt] = softplusf_(-inptr(F, 13)[(l * 2 + dir) * 256 + ch]);
            car[dir][jt] = 0.f; atot[dir][jt] = 1.f; }
#pragma unroll 1
    for (int ti = 0; ti < 8; ++ti) {
#pragma unroll
        for (int dir = 0; dir < 2; ++dir) { const int tt = dir == 0 ? ti : 7 - ti;
            h16x8 xf[2];
#pragma unroll
            for (int ks = 0; ks < 2; ++ks) xf[ks] = ldsfrag(XC + (16 * tt + fr) * 264 + blk * 64 + 32 * ks + 8 * fq);
#pragma unroll
            for (int jt = 0; jt < 2; ++jt) { const int ch = blk * 64 + 32 * jh + 16 * jt + fr;
                f32x4 ra = {0.f, 0.f, 0.f, 0.f}, ia = {0.f, 0.f, 0.f, 0.f};
#pragma unroll
                for (int ks = 0; ks < 2; ++ks) { ra = MFMA16(xf[ks], wa[dir][jt][ks], ra); ia = MFMA16(xf[ks], wx[dir][jt][ks], ia); }
                float A = 1.f, H = 0.f;
#pragma unroll
                for (int ri = 0; ri < 4; ++ri) { const int rg = dir == 0 ? ri : 3 - ri;
                    const float e1 = 1.0f + __expf(-(ra[rg] + ba[dir][jt])), e2 = 1.0f + __expf(-(ia[rg] + bx[dir][jt])); const float inv = __builtin_amdgcn_rcpf(e1 * e2);
                    const float rgate = inv * e2, ig = inv * e1;
                    const float la = -8.0f * rgate * sp[dir][jt]; const float a = __expf(la); const float y = 2.0f * la;
                    const float om = y > -0.1f ? -y * (1.0f + y * (0.5f + y * (1.0f / 6.0f))) : 1.0f - a * a;
                    const float mult = __builtin_amdgcn_sqrtf(om);
                    const float xv = (float)XC[(16 * tt + 4 * fq + rg) * 264 + ch]; const float uu = mult * ig * xv;
                    H = a * H + uu; A *= a;
                    { h16x2 pk; pk[0] = (h16)la; pk[1] = (h16)uu; *(h16x2*)(lau + ((size_t)dir * 128 + 16 * tt + 4 * fq + rg) * 256 * 2 + 2 * ch) = pk; } }
                float Ag[4], Hg[4];
#pragma unroll
                for (int gq = 0; gq < 4; ++gq) { Ag[gq] = __shfl(A, fr + 16 * gq); Hg[gq] = __shfl(H, fr + 16 * gq); }
                float cnew = car[dir][jt], at = 1.f;
#pragma unroll
                for (int gi = 0; gi < 4; ++gi) { const int gq = dir == 0 ? gi : 3 - gi;
                    cnew = Ag[gq] * cnew + Hg[gq]; at *= Ag[gq]; }
                car[dir][jt] = cnew; atot[dir][jt] *= at;
            } } }
    if (fq == 0) {
#pragma unroll
        for (int dir = 0; dir < 2; ++dir)
#pragma unroll
            for (int jt = 0; jt < 2; ++jt) { const int ch = blk * 64 + 32 * jh + 16 * jt + fr; *(f32x2*)(WSP(float, OFF_LSUM) + (((size_t)(b * NCH + n) * 2 + dir) * 256 + ch) * 2) = (f32x2){atot[dir][jt], car[dir][jt]}; } }
    __syncthreads();
}
__device__ __forceinline__ void lru_out_unit(const Frame& F, int u) {
    const int n = u % NCH, b = u / NCH; const long t0 = (long)b * SEQ + n * 128;
    const h16* proj = WSP(const h16, WS_R1);
    LAS h16* HT = (LAS h16*)F.lds;
    const int blk = F.wave & 3, jh = F.wave >> 2, fr = F.lane & 15, fq = F.lane >> 4;
    const h16* lau = (const h16*)((const unsigned char*)F.out + OUT_LAU) + (size_t)(b * NCH + n) * 2 * 128 * 256 * 2;
    float car[2][2];
#pragma unroll
    for (int dir = 0; dir < 2; ++dir)
#pragma unroll
        for (int jt = 0; jt < 2; ++jt) car[dir][jt] = WSP(const float, OFF_LCAR)[((size_t)(b * NCH + n) * 2 + dir) * 256 + blk * 64 + 32 * jh + 16 * jt + fr];
#pragma unroll 1
    for (int ti = 0; ti < 8; ++ti) {
#pragma unroll
        for (int dir = 0; dir < 2; ++dir) { const int tt = dir == 0 ? ti : 7 - ti;
            h16x2 pk[2][4]; h16 gtv[2][4], ov[2][4];
#pragma unroll
            for (int jt = 0; jt < 2; ++jt)
#pragma unroll
                for (int rg = 0; rg < 4; ++rg) { const int tl = 16 * tt + 4 * fq + rg, ch = blk * 64 + 32 * jh + 16 * jt + fr;
                    pk[jt][rg] = NTL(h16x2, lau + ((size_t)dir * 128 + tl) * 256 * 2 + 2 * ch); gtv[jt][rg] = NTL(h16, proj + (size_t)(t0 + tl) * NPJ + CGT + ch); ov[jt][rg] = ti >= 4 ? HT[tl * 264 + ch] : (h16)0.f; }
#pragma unroll
            for (int jt = 0; jt < 2; ++jt) { const int ch = blk * 64 + 32 * jh + 16 * jt + fr;
                float av[4], uv[4]; float A = 1.f, H = 0.f;
#pragma unroll
                for (int ri = 0; ri < 4; ++ri) { const int rg = dir == 0 ? ri : 3 - ri; const float a = __expf((float)pk[jt][rg][0]); const float uu = (float)pk[jt][rg][1]; av[rg] = a; uv[rg] = uu; H = a * H + uu; A *= a; }
                float Ag[4], Hg[4];
#pragma unroll
                for (int gq = 0; gq < 4; ++gq) { Ag[gq] = __shfl(A, fr + 16 * gq); Hg[gq] = __shfl(H, fr + 16 * gq); }
                float hin = car[dir][jt], cnew = car[dir][jt];
#pragma unroll
                for (int gi = 0; gi < 4; ++gi) { const int gq = dir == 0 ? gi : 3 - gi; const bool before = dir == 0 ? (gq < fq) : (gq > fq);
                    if (before) hin = Ag[gq] * hin + Hg[gq];
                    cnew = Ag[gq] * cnew + Hg[gq]; }
                car[dir][jt] = cnew;
                float hh = hin;
#pragma unroll
                for (int ri = 0; ri < 4; ++ri) { const int rg = dir == 0 ? ri : 3 - ri; hh = av[rg] * hh + uv[rg];
                    HT[(16 * tt + 4 * fq + rg) * 264 + ch] = (h16)((float)ov[jt][rg] + hh * gelu_tanh_((float)gtv[jt][rg])); } } } }
    __syncthreads();
#pragma unroll
    for (int k = 0; k < 8; ++k) { const int it = F.tid + 512 * k, row = it >> 5, c8 = it & 31; const h16x8 hv = *(LAS const h16x8*)(HT + row * 264 + 8 * c8);
        if (F8_OUT) *(u32x2*)(WSP(unsigned char, OFF_OMIX8) + (size_t)(t0 + row) * DM + 768 + 8 * c8) = (u32x2){cvt4_fp8(8.f * (float)hv[0], 8.f * (float)hv[1], 8.f * (float)hv[2], 8.f * (float)hv[3]), cvt4_fp8(8.f * (float)hv[4], 8.f * (float)hv[5], 8.f * (float)hv[6], 8.f * (float)hv[7])};
        else *(h16x8*)(WSP(h16, OFF_OMIX) + (size_t)(t0 + row) * DM + 768 + 8 * c8) = hv; }
    __syncthreads();
}
__device__ __forceinline__ void lru_scan(const Frame& F, int blk) {
    const int gi = blk * 512 + F.tid; if (blk < 0 || gi >= NB * 2 * 256) return;
    const int ch = gi & 255, dir = (gi >> 8) & 1, b = gi >> 9; float H = 0.f;
    for (int i = 0; i < NCH; ++i) { const int n = dir == 0 ? i : NCH - 1 - i; const size_t idx = ((size_t)(b * NCH + n) * 2 + dir) * 256 + ch;
        const f32x2 s = *(const f32x2*)(WSP(const float, OFF_LSUM) + idx * 2); WSP(float, OFF_LCAR)[idx] = H; H = s[0] * H + s[1]; }
}

__device__ __forceinline__ void attn_phase(const Frame& F) {
    constexpr int NU = NB * 4 * 8;
    LAS unsigned char* B0 = F.lds; LAS unsigned char* B1 = F.lds + 67584;
    int u = F.vcu; if (u >= NU) return;
    int lanel = F.lane; asm volatile("" : "+v"(lanel)); int fr = lanel & 15, fq = lanel >> 4;
    const int w = F.wave;
    h16x8 qf[2][8];
#define AT_DMA(buf, src, rowstride) do { asm volatile("" : "+v"(lanel)); if (lanel < 32) { _Pragma("unroll") for (int i_ = 0; i_ < 16; ++i_) \
        __builtin_amdgcn_global_load_lds((const unsigned*)((src) + (size_t)(16 * w + i_) * (rowstride) + 8 * lanel), (LAS unsigned*)((buf) + (16 * w + i_) * 528), 16, 0, 0); } } while (0)
#define AT_FRAG(buf, row, chunk) (*(LAS const h16x8*)((buf) + (row) * 528 + (chunk) * 16))
#define AT_WAITBAR() do { asm volatile("s_waitcnt vmcnt(0) lgkmcnt(0)" ::: "memory"); __builtin_amdgcn_s_barrier(); asm volatile("" ::: "memory"); } while (0)
#define AT_LOADQ(uu) do { _Pragma("unroll") for (int a_ = 0; a_ < 2; ++a_) { const long t_ = (long)((uu) >> 5) * SEQ + ((uu) & 7) * 256 + 32 * w + 16 * a_ + fr; const h16* q_ = WSP(const h16, OFF_QCA) + (size_t)t_ * DM + (((uu) >> 3) & 3) * 256; \
        _Pragma("unroll") for (int ks_ = 0; ks_ < 8; ++ks_) qf[a_][ks_] = NTL(h16x8, q_ + 32 * ks_ + 8 * fq); } } while (0)
    { const int b = u >> 5, hd = (u >> 3) & 3; AT_DMA(B0, WSP(const h16, OFF_KB) + (size_t)(b * 256) * DM + hd * 256, DM); }
    for (; u < NU; u += F.G) {
        const int qb = u & 7, hd = (u >> 3) & 3, b = u >> 5; const int un = u + F.G; const bool has_next = un < NU;
        asm volatile("" : "+v"(lanel)); fr = lanel & 15; fq = lanel >> 4;
        const h16* kb = WSP(const h16, OFF_KB) + (size_t)(b * 256) * DM + hd * 256; const h16* vt = WSP(const h16, OFF_VT) + (size_t)(b * 4 + hd) * 65536;
        AT_LOADQ(u);
        h16x8 pf[2][8]; float mq[2][4], Mr[2] = {-3.0e38f, -3.0e38f}, Lr[2] = {0.f, 0.f};
#pragma unroll
        for (int h = 0; h < 2; ++h) {
            AT_WAITBAR();
            if (h == 0) AT_DMA(B1, kb + (size_t)128 * DM, DM); else AT_DMA(B0, vt, 256);
            LAS const unsigned char* KB_ = h == 0 ? B0 : B1;
#pragma unroll
            for (int jh = 0; jh < 2; ++jh) { const int qd = 2 * h + jh; f32x4 s[2][4]; h16x8 kf[2][4];
#pragma unroll
                for (int j4 = 0; j4 < 4; ++j4) { s[0][j4] = (f32x4){0.f, 0.f, 0.f, 0.f}; s[1][j4] = (f32x4){0.f, 0.f, 0.f, 0.f}; kf[0][j4] = AT_FRAG(KB_, 16 * (4 * jh + j4) + fr, fq); }
#pragma unroll
                for (int ks = 0; ks < 8; ++ks) {
                    if (ks < 7) {
#pragma unroll
                        for (int j4 = 0; j4 < 4; ++j4) kf[(ks + 1) & 1][j4] = AT_FRAG(KB_, 16 * (4 * jh + j4) + fr, 4 * (ks + 1) + fq); }
                    PIN();
#pragma unroll
                    for (int j4 = 0; j4 < 4; ++j4) { s[0][j4] = MFMA16(kf[ks & 1][j4], qf[0][ks], s[0][j4]); s[1][j4] = MFMA16(kf[ks & 1][j4], qf[1][ks], s[1][j4]); }
                    PINV(s[0][0]); PINV(s[1][3]); }
#pragma unroll
                for (int a = 0; a < 2; ++a) { float mx = fmaxf(fmaxf(s[a][0][0], s[a][0][1]), fmaxf(s[a][0][2], s[a][0][3]));
#pragma unroll
                    for (int jt = 1; jt < 4; ++jt) mx = fmaxf(mx, fmaxf(fmaxf(s[a][jt][0], s[a][jt][1]), fmaxf(s[a][jt][2], s[a][jt][3])));
                    mx = fmaxf(mx, __shfl_xor(mx, 16)); mx = fmaxf(mx, __shfl_xor(mx, 32));
                    float sum = 0.f;
#pragma unroll
                    for (int jt = 0; jt < 4; ++jt)
#pragma unroll
                        for (int e = 0; e < 4; ++e) { const float pe = __expf(s[a][jt][e] - mx); s[a][jt][e] = pe; sum += pe; }
                    sum += __shfl_xor(sum, 16); sum += __shfl_xor(sum, 32);
                    mq[a][qd] = mx; { const float Mn = fmaxf(Mr[a], mx); Lr[a] = Lr[a] * __expf(Mr[a] - Mn) + sum * __expf(mx - Mn); Mr[a] = Mn; }
                    pf[a][2 * qd] = pack8(s[a][0], s[a][1]); pf[a][2 * qd + 1] = pack8(s[a][2], s[a][3]); } }
        }
#pragma unroll
        for (int a = 0; a < 2; ++a) { const float inv = 1.0f / Lr[a];
#pragma unroll
            for (int q = 0; q < 4; ++q) { const float cq = __expf(mq[a][q] - Mr[a]) * inv; pf[a][2 * q] = scalefrag(pf[a][2 * q], cq); pf[a][2 * q + 1] = scalefrag(pf[a][2 * q + 1], cq); } }
#pragma unroll
        for (int d = 0; d < 2; ++d) {
            AT_WAITBAR();
            if (d == 0) AT_DMA(B1, vt + (size_t)128 * 256, 256);
            else if (has_next) AT_DMA(B0, WSP(const h16, OFF_KB) + (size_t)((un >> 5) * 256) * DM + ((un >> 3) & 3) * 256, DM);
            LAS const unsigned char* VB_ = d == 0 ? B0 : B1;
#pragma unroll
            for (int eh = 0; eh < 2; ++eh) { f32x4 o[2][4]; h16x8 vf[2][4];
#pragma unroll
                for (int e4 = 0; e4 < 4; ++e4) { o[0][e4] = (f32x4){0.f, 0.f, 0.f, 0.f}; o[1][e4] = (f32x4){0.f, 0.f, 0.f, 0.f}; vf[0][e4] = AT_FRAG(VB_, 16 * (4 * eh + e4) + fr, fq); }
#pragma unroll
                for (int kp = 0; kp < 8; ++kp) {
                    if (kp < 7) {
#pragma unroll
                        for (int e4 = 0; e4 < 4; ++e4) vf[(kp + 1) & 1][e4] = AT_FRAG(VB_, 16 * (4 * eh + e4) + fr, 4 * (kp + 1) + fq); }
                    PIN();
#pragma unroll
                    for (int e4 = 0; e4 < 4; ++e4) { o[0][e4] = MFMA16(vf[kp & 1][e4], pf[0][kp], o[0][e4]); o[1][e4] = MFMA16(vf[kp & 1][e4], pf[1][kp], o[1][e4]); }
                    PINV(o[0][0]); PINV(o[1][3]); }
#pragma unroll
                for (int a = 0; a < 2; ++a) { const int ln2 = lane_now(), fr2 = ln2 & 15, fq2 = ln2 >> 4; const long t = (long)b * SEQ + qb * 256 + 32 * w + 16 * a + fr2; h16* orow = WSP(h16, OFF_OATT) + (size_t)t * DM + hd * 256 + 128 * d + 64 * eh;
#pragma unroll
                    for (int e4 = 0; e4 < 4; ++e4) { if (F8_O) *(unsigned*)(WSP(unsigned char, OFF_OATT) + (size_t)t * DM + hd * 256 + 128 * d + 64 * eh + 16 * e4 + 4 * fq2) = cvt4_fp8(16.f * o[a][e4][0], 16.f * o[a][e4][1], 16.f * o[a][e4][2], 16.f * o[a][e4][3]);
                        else *(h16x4*)(orow + 16 * e4 + 4 * fq2) = pack4(o[a][e4]); } } }
        }
    }
    asm volatile("s_waitcnt vmcnt(0) lgkmcnt(0)" ::: "memory");
    __syncthreads();
#undef AT_DMA
#undef AT_FRAG
#undef AT_WAITBAR
#undef AT_LOADQ
}

__device__ __forceinline__ void phase_router(const Frame& F, const Prm& p, int l) {
    LAS h16* RW = (LAS h16*)F.lds;
    { const h16* rwg = WSP(const h16, OFF_RWG);
        for (int i = F.tid; i < 72 * 1032 / 8; i += 512) *(LAS h16x8*)(RW + 8 * i) = *(const h16x8*)(rwg + 8 * i); }
    LAS unsigned* hist = (LAS unsigned*)(F.lds + 72 * 1032 * 2);
    if (F.tid < 32) hist[F.tid] = 0u;
    if (F.G == 256) { for (int i = (int)blockIdx.x * 512 + F.tid; i < MAXSLOT; i += 256 * 512) WSP(int, OFF_STOK)[i] = 0; }
    else if (blockIdx.x == 0) { for (int i = F.tid; i < MAXSLOT; i += 512) WSP(int, OFF_STOK)[i] = 0; }
    const int gw = F.vcu * 8 + F.wave, NGW = F.G * 8, fr = F.lane & 15, fq = F.lane >> 4;
    h16x8 hf[16];
    if (gw < NT / 16) { const h16* hp0 = WSP(const h16, WS_HB) + (size_t)(gw * 16 + fr) * DM + 8 * fq;
#pragma unroll
        for (int q = 0; q < 16; ++q) hf[q] = *(const h16x8*)(hp0 + 32 * q); }
    __syncthreads();
    for (int tg = gw; tg < NT / 16; tg += NGW) {
        const int tok = tg * 16 + fr;
        const h16* hp = WSP(const h16, WS_HB) + (size_t)tok * DM + 8 * fq;
        f32x4 acc[3]; LAS const h16* wrow[3];
#pragma unroll
        for (int mt = 0; mt < 3; ++mt) { acc[mt] = (f32x4){0.f, 0.f, 0.f, 0.f}; const int j = (16 * mt + fr) < 36 ? (16 * mt + fr) : 35; wrow[mt] = RW + j * 1032 + 8 * fq; }
#pragma unroll
        for (int half = 0; half < 2; ++half) {
            if (half == 1) {
#pragma unroll
                for (int q = 0; q < 16; ++q) hf[q] = *(const h16x8*)(hp + 32 * (16 + q)); }
#pragma unroll
            for (int q = 0; q < 16; ++q) { const int ks = 16 * half + q;
#pragma unroll
                for (int mt = 0; mt < 3; ++mt) { acc[mt] = MFMA16(ldsfrag(wrow[mt] + 32 * ks), hf[q], acc[mt]); acc[mt] = MFMA16(ldsfrag(wrow[mt] + 36 * 1032 + 32 * ks), hf[q], acc[mt]); } } }
#pragma unroll
        for (int mt = 0; mt < 3; ++mt) acc[mt] *= (1.0f / 1024.0f);
        if (tg + NGW < NT / 16) { const h16* hpn = WSP(const h16, WS_HB) + (size_t)((tg + NGW) * 16 + fr) * DM + 8 * fq;
#pragma unroll
            for (int q = 0; q < 16; ++q) hf[q] = *(const h16x8*)(hpn + 32 * q); }
        const float rs = row_rstd(WSP(const float, WS_SSQ) + (size_t)tok * 16);
        float gl[4];
#pragma unroll
        for (int r = 0; r < 4; ++r) gl[r] = __shfl(acc[0][r], fr) * rs + inptr(F, 25)[l * 4 + r];
        int gi = 0; float gmx = gl[0];
#pragma unroll
        for (int j = 1; j < 4; ++j) if (gl[j] > gmx) { gmx = gl[j]; gi = j; }
        float gsum = 0.f;
#pragma unroll
        for (int j = 0; j < 4; ++j) gsum += __expf(gl[j] - gmx);
        const float gp = 1.0f / gsum;
        const int src1 = fr + 16 * (1 + 2 * (gi & 1)), src2 = fr + 16 * (2 - 2 * (gi & 1)), mt1 = gi >> 1, mt2 = (gi + 1) >> 1;
        float el[8];
#pragma unroll
        for (int k = 0; k < 4; ++k) { const float a0 = __shfl(acc[0][k], src1), a1 = __shfl(acc[1][k], src1); el[k] = (mt1 ? a1 : a0) * rs + inptr(F, 27)[l * 32 + gi * 8 + k];
            const float b0 = __shfl(acc[0][k], src2), b1 = __shfl(acc[1][k], src2), b2 = __shfl(acc[2][k], src2); el[4 + k] = (mt2 == 0 ? b0 : (mt2 == 1 ? b1 : b2)) * rs + inptr(F, 27)[l * 32 + gi * 8 + 4 + k]; }
        int e1 = 0; float m1 = el[0];
#pragma unroll
        for (int j = 1; j < 8; ++j) if (el[j] > m1) { m1 = el[j]; e1 = j; }
        int e2 = -1; float m2 = -3.0e38f;
#pragma unroll
        for (int j = 0; j < 8; ++j) if (j != e1 && el[j] > m2) { m2 = el[j]; e2 = j; }
        const float r2 = __expf(m2 - m1); const float g1 = gp / (1.0f + r2), g2 = gp * r2 / (1.0f + r2);
        if (fq == 0) { const int x1 = gi * 8 + e1, x2 = gi * 8 + e2;
            *(int2*)(WSP(int, OFF_EID) + (size_t)tok * 2) = make_int2(x1, x2); *(f32x2*)(WSP(float, OFF_GATE) + (size_t)tok * 2) = (f32x2){g1, g2};
            WSP(float, OFF_RSTDT)[tok] = rs; __hip_atomic_fetch_add(&hist[x1], 1u, __ATOMIC_RELAXED, __HIP_MEMORY_SCOPE_WORKGROUP); __hip_atomic_fetch_add(&hist[x2], 1u, __ATOMIC_RELAXED, __HIP_MEMORY_SCOPE_WORKGROUP); }
    }
    __syncthreads();
    if (F.tid < 32 && hist[F.tid]) atomicAdd(WSP(unsigned, WS_CTL) + CW_COUNTS + l * 64 + F.tid, hist[F.tid]);
    __syncthreads();
}
__device__ __forceinline__ void phase_dispatch(const Frame& F, int l) {
    LAS int* cnt = (LAS int*)F.lds; LAS int* base = cnt + 32; LAS int* pstart = base + 32; LAS int* slots = pstart + 40;
    unsigned* ctl = WSP(unsigned, WS_CTL);
    for (int blk = F.vcu; blk < NT / 128; blk += F.G) {
        __syncthreads();
        if (F.tid < 32) cnt[F.tid] = 0;
        if (F.tid >= 64 && F.tid < 128) { const int e = F.tid - 64; const int c = e < 32 ? (int)((ctl[CW_COUNTS + l * 64 + e] + 255u) & ~255u) : 0; int inc = c;
#pragma unroll
            for (int o = 1; o < 32; o <<= 1) { const int t = __shfl_up(inc, o); if (e >= o) inc += t; }
            if (e < 32) pstart[e] = inc - c; if (e == 31) pstart[32] = inc; }
        __syncthreads();
        int e = 0, rank = 0, tok = 0;
        if (F.tid < 256) { tok = blk * 128 + (F.tid >> 1); e = WSP(const int, OFF_EID)[(size_t)tok * 2 + (F.tid & 1)]; rank = __hip_atomic_fetch_add(&cnt[e], 1, __ATOMIC_RELAXED, __HIP_MEMORY_SCOPE_WORKGROUP); }
        __syncthreads();
        if (F.tid < 32) base[F.tid] = cnt[F.tid] ? (int)atomicAdd(&ctl[CW_CURSOR + l * 64 + F.tid], (unsigned)cnt[F.tid]) : 0;
        __syncthreads();
        if (F.tid < 256) { const int slot = pstart[e] + base[e] + rank; slots[F.tid] = slot; WSP(int, OFF_TSLOT)[(size_t)tok * 2 + (F.tid & 1)] = slot; WSP(float, OFF_SRSTD)[slot] = WSP(const float, OFF_RSTDT)[tok]; WSP(int, OFF_STOK)[slot] = tok; }
        __syncthreads();
        if (blk == 0 && F.tid == 0) { const int ntl = pstart[32] >> 8; ctl[CW_NTILES + l] = (unsigned)ntl; int* te = WSP(int, OFF_TILEE);
            for (int e2 = 0; e2 < 32; ++e2) for (int tl = pstart[e2] >> 8; tl < (pstart[e2 + 1] >> 8); ++tl) te[tl] = e2; }
    }
    __syncthreads();
}
__device__ __forceinline__ void phase_combine(const Frame& F, const Prm& p, int l) {
    const int gw = F.vcu * 8 + F.wave, NGW = F.G * 8;
    const bool last = (l == NLAYER - 1);
    for (int tk0 = gw * 4; tk0 < NT; tk0 += NGW * 4) {
        int2 sl[4]; f32x2 gt[4];
#pragma unroll
        for (int q = 0; q < 4; ++q) { sl[q] = *(const int2*)(WSP(const int, OFF_TSLOT) + (size_t)(tk0 + q) * 2); gt[q] = *(const f32x2*)(WSP(const float, OFF_GATE) + (size_t)(tk0 + q) * 2); }
        f32x4 v[4][4];
#if F8_YP
        unsigned ya[4][4], yb[4][4];
#else
        h16x4 ya[4][4], yb[4][4];
#endif
#pragma unroll
        for (int q = 0; q < 4; ++q) { const h16* hrow = WSP(const h16, WS_HB) + (size_t)(tk0 + q) * DM;
#if F8_YP
            const unsigned char* y0 = WSP(const unsigned char, OFF_YP) + (size_t)sl[q].x * DM; const unsigned char* y1 = WSP(const unsigned char, OFF_YP) + (size_t)sl[q].y * DM;
#else
            const h16* y0 = WSP(const h16, OFF_YP) + (size_t)sl[q].x * DM; const h16* y1 = WSP(const h16, OFF_YP) + (size_t)sl[q].y * DM;
#endif

#pragma unroll
            for (int j = 0; j < 4; ++j) { const int c = 4 * F.lane + 256 * j; const h16x4 hv = *(const h16x4*)(hrow + c); v[q][j] = (f32x4){(float)hv[0], (float)hv[1], (float)hv[2], (float)hv[3]};
#if F8_YP
                ya[q][j] = __builtin_nontemporal_load((const unsigned*)(y0 + c)); yb[q][j] = __builtin_nontemporal_load((const unsigned*)(y1 + c)); } }
#else
                ya[q][j] = __builtin_nontemporal_load((const h16x4*)(y0 + c)); yb[q][j] = __builtin_nontemporal_load((const h16x4*)(y1 + c)); } }
#endif

#pragma unroll
        for (int q = 0; q < 4; ++q) { float s = 0.f;
#pragma unroll
            for (int j = 0; j < 4; ++j) {
#if F8_YP
                { const f32x2 a0 = __builtin_amdgcn_cvt_pk_f32_fp8((int)ya[q][j], false), a1 = __builtin_amdgcn_cvt_pk_f32_fp8((int)ya[q][j], true), b0 = __builtin_amdgcn_cvt_pk_f32_fp8((int)yb[q][j], false), b1 = __builtin_amdgcn_cvt_pk_f32_fp8((int)yb[q][j], true);
                  const float g0 = gt[q][0] * (1.0f / 32.0f), g1 = gt[q][1] * (1.0f / 32.0f);
                  v[q][j][0] += g0 * a0[0] + g1 * b0[0]; v[q][j][1] += g0 * a0[1] + g1 * b0[1]; v[q][j][2] += g0 * a1[0] + g1 * b1[0]; v[q][j][3] += g0 * a1[1] + g1 * b1[1]; }
#else
#pragma unroll
                for (int e = 0; e < 4; ++e) v[q][j][e] += gt[q][0] * (float)ya[q][j][e] + gt[q][1] * (float)yb[q][j][e];
#endif

                if (!last) { const h16x4 o = pack4(v[q][j]); v[q][j] = (f32x4){(float)o[0], (float)o[1], (float)o[2], (float)o[3]}; }
                s += (v[q][j][0] * v[q][j][0] + v[q][j][1] * v[q][j][1]) + (v[q][j][2] * v[q][j][2] + v[q][j][3] * v[q][j][3]); }
            s = wave_sum(s);
            if (!last) {
#pragma unroll
                for (int j = 0; j < 4; ++j) { const int c = 4 * F.lane + 256 * j; *(h16x4*)(WSP(h16, WS_HB) + (size_t)(tk0 + q) * DM + c) = pack4(v[q][j]);
                    if (F8_HB) *(unsigned*)((unsigned char*)F.out + OUT_HB8 + (size_t)(tk0 + q) * DM + c) = cvt4_fp8(v[q][j][0], v[q][j][1], v[q][j][2], v[q][j][3]); }
                if (F.lane < 16) WSP(float, WS_SSQ)[(size_t)(tk0 + q) * 16 + F.lane] = (F.lane == 0) ? s : 0.f;
                if (F.lane == 0) WSP(float, OFF_RSTDT)[tk0 + q] = 1.0f / sqrtf(s * (1.0f / DM) + EPS);
            } else { const float rs = 1.0f / sqrtf(s * (1.0f / DM) + EPS); float* orow = F.out + (size_t)(tk0 + q) * DM;
#pragma unroll
                for (int j = 0; j < 4; ++j) { const int c = 4 * F.lane + 256 * j; const f32x4 gf = *(const f32x4*)(inptr(F, 31) + c); *(f32x4*)(orow + c) = v[q][j] * rs * gf; } } }
    }
}

__global__ void __launch_bounds__(512, 2) fwd(Prm p) {
    extern __shared__ __attribute__((aligned(16))) unsigned char lds_raw[];
    Frame F; F.lds = (LAS unsigned char*)lds_raw; F.ws = (GAS unsigned char*)p.ws; F.out = p.out;
    F.tid = threadIdx.x; F.lane = F.tid & 63; F.wave = __builtin_amdgcn_readfirstlane(F.tid >> 6);
    F.G = gridDim.x; { const int bx = blockIdx.x; F.vcu = (F.G % 8 == 0) ? (bx % 8) * (F.G / 8) + bx / 8 : bx; }
    volatile LAS unsigned* misc = (volatile LAS unsigned*)(F.lds + LDS_MISC);
    if (F.tid < 4) misc[F.tid] = 0u;
    F.ptab = (volatile LAS unsigned long long*)(F.lds + LDS_MISC + 64);
    if (F.tid < 32) F.ptab[F.tid] = (unsigned long long)p.in[F.tid];
    __syncthreads();
    const int lo = p.ph_lo, hi = p.ph_hi;
    XcdBarrier bar; bar.bar = WSP(unsigned, WS_CTL) + CW_BAR; bar.x = 0; bar.st = misc;
    if (hi - lo > 1) bar = xcd_barrier_post(WSP(unsigned, WS_CTL) + CW_BAR, misc);
#ifndef UMASK
#define UMASK 7
#endif
#ifndef REPMASK
#define REPMASK 0
#endif
#ifndef PHMASK
#define PHMASK 0x3fff
#endif
#define IN(k) (((PHMASK >> ((k) % NPH)) & 1) && lo <= (k) && (k) < hi && (launder(F), true))
#define REPS(k) (((REPMASK >> (k)) & 1) ? 2 : 1)
#define INR(k) (lo <= (k) && (k) < hi)
#ifndef AMPMASK
#define AMPMASK 0
#endif
    unsigned long long tprev = AMPMASK ? __builtin_amdgcn_s_memrealtime() : 0ull;
#define SEAM(k) do { if (INR(k) && INR((k) + 1)) { xcd_barrier(bar); if (AMPMASK) { const unsigned long long tn = __builtin_amdgcn_s_memrealtime(); \
        if ((AMPMASK >> ((k) % NPH)) & 1) { const unsigned long long tgt = tn + 4ull * (tn - tprev); while (__builtin_amdgcn_s_memrealtime() < tgt) __builtin_amdgcn_s_sleep(8); } \
        tprev = __builtin_amdgcn_s_memrealtime(); } } } while (0)
    for (int l = 0; l < NLAYER; ++l) {
        const int pb = l * NPH;
        if (IN(pb + 0)) for (int rep = 0; rep < REPS(0); ++rep) { phase_convert(F, p, l); } SEAM(pb + 0);
        if (REPS(20) == 2 && INR(pb + 0) && INR(pb + 1)) { for (int q = 0; q < 20; ++q) xcd_barrier(bar); }
        if (IN(pb + 1)) for (int rep = 0; rep < REPS(1); ++rep) {
            if (P8_N16 > 0) { pg8::StaticOrder S; S.init(NT, P8_N16 * 256, F.G, (int)blockIdx.x); pg8::EpiScale16C E{WSP(h16, WS_R1), NPJ, WSP(const float, OFF_RSTDT), 1.0f, P8_LIST16};
              pg8::Gemm g{WSP(const h16, WS_HB), WSP(const h16, WS_WIN), DM, DM, DM, nullptr}; pg8::gemm_phase(F.lds, F.tid, g, S, E); }
            launder(F);
            if (P8_N8 > 0) { pg8::StaticOrder S; S.init(NT, P8_N8 * 256, F.G, (int)((blockIdx.x + F.G / 2) % F.G));
              pg8::EpiScale16C E{WSP(h16, WS_R1), NPJ, WSP(const float, OFF_RSTDT), 1.0f / 256.0f, P8_LIST8};
              pg8::Gemm g{(const h16*)((const unsigned char*)F.out + OUT_HB8), WSP(const h16, WS_WIN + P8_WOFF), DM / 2, DM / 2, DM / 2, nullptr}; pg8::gemm_phase<pg8::EpiScale16C, pg8::StaticOrder, false, 1>(F.lds, F.tid, g, S, E); }
        } SEAM(pb + 1);
        if (IN(pb + 2)) for (int rep = 0; rep < REPS(2); ++rep) {
            if (UMASK & 1) for (int r2 = 0; r2 < REPS(17); ++r2) for (int u = blockIdx.x; u < NB * NCH * 2; u += F.G) ssd_states_unit(F, p, l, u);
            launder(F);
            if (UMASK & 2) for (int r2 = 0; r2 < REPS(18); ++r2) for (int u = blockIdx.x; u < NB * NCH; u += F.G) ret_states_block(F, u);
            launder(F);
            if (UMASK & 4) for (int r2 = 0; r2 < REPS(19); ++r2) for (int u = blockIdx.x; u < NB * NCH; u += F.G) lru_unit(F, p, l, u);
        } SEAM(pb + 2);
        if (IN(pb + 3)) for (int rep = 0; rep < REPS(3); ++rep) {
            const bool split = (F.G == 256); const int bx = (int)blockIdx.x;
            if (!split || bx < 64) {
                pg8::Gemm g{WSP(const h16, WS_MEM16), WSP(const h16, WS_WKV), DM, DM, DM, nullptr}; pg8::StaticOrder S; S.init(NTM, DM, split ? 64 : F.G, bx);
                pg8::EpiScale16 E{WSP(h16, OFF_KB), DM, WSP(const float, OFF_MSSQ), 1.0f}; pg8::gemm_phase(F.lds, F.tid, g, S, E); }
            launder(F);
            if (!split || (bx >= 64 && bx < 128)) {
                pg8::Gemm g{WSP(const h16, WS_MEM16), WSP(const h16, WS_WKV) + (size_t)DM * DM, DM, DM, DM, nullptr}; pg8::StaticOrder S; S.init(NTM, DM, split ? 64 : F.G, split ? bx - 64 : bx);
                pg8::EpiVT E{WSP(h16, OFF_VT), WSP(const float, OFF_MRSTD)}; pg8::gemm_phase<pg8::EpiVT, pg8::StaticOrder, false, 0, true>(F.lds, F.tid, g, S, E); }
            launder(F);
            if (!split || bx >= 128) for (int u = split ? bx - 128 : bx; u < 4 * NB * 6; u += split ? 128 : F.G) ssd_scan_unit(F, u);
            launder(F);
            if (!split || bx < 192) for (int u = bx; u < 2 * NB * 6; u += split ? 256 : F.G) ret_scan_unit(F, u);
            lru_scan(F, split ? bx - 192 : bx);
        } SEAM(pb + 3);
        if (IN(pb + 4)) for (int rep = 0; rep < REPS(4); ++rep) {
            if (UMASK & 1) for (int r2 = 0; r2 < REPS(14); ++r2) for (int u = blockIdx.x; u < NB * NCH * 2; u += F.G) ssd_out_unit(F, p, l, u);
            launder(F);
            if (UMASK & 2) for (int r2 = 0; r2 < REPS(15); ++r2) for (int u = blockIdx.x; u < NB * NCH; u += F.G) ret_out_block(F, u);
            launder(F);
            if (UMASK & 4) for (int r2 = 0; r2 < REPS(16); ++r2) for (int u = blockIdx.x; u < NB * NCH; u += F.G) lru_out_unit(F, u);
        } SEAM(pb + 4);
        if (IN(pb + 5)) for (int rep = 0; rep < REPS(5); ++rep) { pg8::StaticOrder S; S.init(NT, DM, F.G, (int)blockIdx.x); pg8::EpiResid E{WSP(h16, WS_HB), WSP(float, WS_SSQ), (unsigned char*)F.out + OUT_HB8, F8_OUT ? 1.0f / 2048.0f : 1.0f};
#if F8_OUT
            pg8::Gemm g{WSP(const h16, OFF_OMIX8), WSP(const h16, WS_WOUT), DM / 2, DM / 2, DM / 2, nullptr}; pg8::gemm_phase<pg8::EpiResid, pg8::StaticOrder, false, 1>(F.lds, F.tid, g, S, E);
#else
            pg8::Gemm g{WSP(const h16, OFF_OMIX), WSP(const h16, WS_WOUT), DM, DM, DM, nullptr}; pg8::gemm_phase(F.lds, F.tid, g, S, E);
#endif
            } SEAM(pb + 5);
        if (IN(pb + 6)) for (int rep = 0; rep < REPS(6); ++rep) { pg8::StaticOrder S; S.init(NT, DM, F.G, (int)blockIdx.x); pg8::EpiScale16 E{WSP(h16, OFF_QCA), DM, WSP(const float, WS_SSQ), F8_Q ? 1.0f / 4096.0f : 1.0f};
#if F8_Q
            pg8::Gemm g{(const h16*)((const unsigned char*)F.out + OUT_HB8), WSP(const h16, WS_WQ), DM / 2, DM / 2, DM / 2, nullptr}; pg8::gemm_phase<pg8::EpiScale16, pg8::StaticOrder, false, 1>(F.lds, F.tid, g, S, E);
#else
            pg8::Gemm g{WSP(const h16, WS_HB), WSP(const h16, WS_WQ), DM, DM, DM, nullptr}; pg8::gemm_phase(F.lds, F.tid, g, S, E);
#endif
            } SEAM(pb + 6);
        if (IN(pb + 7)) for (int rep = 0; rep < REPS(7); ++rep) { attn_phase(F); } SEAM(pb + 7);
        if (IN(pb + 8)) for (int rep = 0; rep < REPS(8); ++rep) { pg8::StaticOrder S; S.init(NT, DM, F.G, (int)blockIdx.x); pg8::EpiResid E{WSP(h16, WS_HB), WSP(float, WS_SSQ), (unsigned char*)F.out + OUT_HB8, F8_O ? 1.0f / 4096.0f : 1.0f};
#if F8_O
            pg8::Gemm g{WSP(const h16, OFF_OATT), WSP(const h16, WS_WO), DM / 2, DM / 2, DM / 2, nullptr}; pg8::gemm_phase<pg8::EpiResid, pg8::StaticOrder, false, 1>(F.lds, F.tid, g, S, E);
#else
            pg8::Gemm g{WSP(const h16, OFF_OATT), WSP(const h16, WS_WO), DM, DM, DM, nullptr}; pg8::gemm_phase(F.lds, F.tid, g, S, E);
#endif
            } SEAM(pb + 8);
        if (IN(pb + 9)) for (int rep = 0; rep < REPS(9); ++rep) { phase_router(F, p, l); } SEAM(pb + 9);
        if (IN(pb + 10)) for (int rep = 0; rep < REPS(10); ++rep) { phase_dispatch(F, l); } SEAM(pb + 10);
        if (IN(pb + 11)) for (int rep = 0; rep < REPS(11); ++rep) {
            pg8::GroupOrder S{WSP(const int, OFF_TILEE), __builtin_amdgcn_readfirstlane((int)WSP(const unsigned, WS_CTL)[CW_NTILES + l]), F.G, F.vcu}; pg8::EpiGated E{WSP(h16, OFF_HP), WSP(const float, OFF_SRSTD), F8_UP ? 1.0f / 256.0f : 1.0f};
#if F8_UP
            pg8::Gemm g{(const h16*)((const unsigned char*)F.out + OUT_HB8), WSP(const h16, WS_W13), DM / 2, DM / 2, DM / 2, WSP(const int, OFF_STOK)}; pg8::gemm_phase<pg8::EpiGated, pg8::GroupOrder, true, 1>(F.lds, F.tid, g, S, E);
#else
            pg8::Gemm g{WSP(const h16, WS_HB), WSP(const h16, WS_W13), DM, DM, DM, WSP(const int, OFF_STOK)}; pg8::gemm_phase<pg8::EpiGated, pg8::GroupOrder, true>(F.lds, F.tid, g, S, E);
#endif
            } SEAM(pb + 11);
        if (IN(pb + 12)) for (int rep = 0; rep < REPS(12); ++rep) {
            pg8::GroupOrder S{WSP(const int, OFF_TILEE), __builtin_amdgcn_readfirstlane((int)WSP(const unsigned, WS_CTL)[CW_NTILES + l]), F.G, F.vcu}; pg8::EpiPlain16 E{WSP(h16, OFF_YP), 1.0f / 4096.0f};
#if F8_DOWN && F8_YP
            pg8::EpiPlain8 E8{WSP(unsigned char, OFF_YP), 32.0f / 4096.0f};
            pg8::Gemm g{WSP(const h16, OFF_HP), WSP(const h16, WS_W2), 256, 256, 256, nullptr}; pg8::gemm_phase<pg8::EpiPlain8, pg8::GroupOrder, false, 1>(F.lds, F.tid, g, S, E8);
#elif F8_DOWN
            pg8::Gemm g{WSP(const h16, OFF_HP), WSP(const h16, WS_W2), 256, 256, 256, nullptr}; pg8::gemm_phase<pg8::EpiPlain16, pg8::GroupOrder, false, 1>(F.lds, F.tid, g, S, E);
#else
            pg8::Gemm g{WSP(const h16, OFF_HP), WSP(const h16, WS_W2), 512, 512, 512, nullptr}; pg8::gemm_phase(F.lds, F.tid, g, S, E);
#endif
            } SEAM(pb + 12);
        if (IN(pb + 13)) for (int rep = 0; rep < REPS(13); ++rep) { phase_combine(F, p, l); }
        if (!MK_SINGLE || AMPMASK || l == NLAYER - 1) SEAM(pb + 13);
    }
#undef IN
#undef INR
#undef SEAM
}

extern "C" void kernel_launch(void* const* d_in, const int* in_sizes, int n_in, void* d_out, int out_size, void* d_ws, size_t ws_size, hipStream_t stream) {
    static int grid = 0;
    if (grid == 0) {
        if (n_in != 32 || out_size != NT * DM || ws_size < WS_END) { fprintf(stderr, "kernel_launch: unexpected shapes / workspace (%d inputs, out %d, ws %zu < %zu)\n", n_in, out_size, ws_size, (size_t)WS_END); grid = -1; return; }
        int dev = 0, cus = 0, per_cu = 0;
        if (hipGetDevice(&dev) != hipSuccess || hipDeviceGetAttribute(&cus, hipDeviceAttributeMultiprocessorCount, dev) != hipSuccess) { grid = -1; return; }
        if (hipFuncSetAttribute((const void*)fwd, hipFuncAttributeMaxDynamicSharedMemorySize, LDS_BYTES) != hipSuccess) { fprintf(stderr, "kernel_launch: hipFuncSetAttribute failed\n"); grid = -1; return; }
        if (hipOccupancyMaxActiveBlocksPerMultiprocessor(&per_cu, (const void*)fwd, 512, LDS_BYTES) != hipSuccess || per_cu < 1) { fprintf(stderr, "kernel_launch: occupancy query says %d\n", per_cu); }
        (void)hipGetLastError();
        grid = cus;
    }
    if (grid < 0) return;
    (void)hipMemsetAsync((char*)d_ws + WS_CTL, 0, CTL_ZERO_BYTES, stream);
    Prm p{};
    for (int i = 0; i < 32; ++i) p.in[i] = (const float*)d_in[i];
    p.out = (float*)d_out; p.ws = (unsigned char*)d_ws;
#if defined(PROBE_PHASE)
    p.ph_lo = 0; p.ph_hi = PROBE_PHASE + 1; hipLaunchKernelGGL(fwd, dim3(grid), dim3(512), LDS_BYTES, stream, p);
    (void)hipMemsetAsync((char*)d_ws + WS_CTL + CW_BAR * 4, 0, XCD_BAR_WORDS * 4, stream);
    p.ph_lo = PROBE_PHASE; p.ph_hi = PROBE_PHASE + 1; hipLaunchKernelGGL(fwd, dim3(grid), dim3(512), LDS_BYTES, stream, p);
    p.ph_lo = PROBE_PHASE + 1; p.ph_hi = NPHASES; hipLaunchKernelGGL(fwd, dim3(grid), dim3(512), LDS_BYTES, stream, p);
#elif MK_SINGLE
    p.ph_lo = 0; p.ph_hi = NPHASES;
    hipLaunchKernelGGL(fwd, dim3(grid), dim3(512), LDS_BYTES, stream, p);
#else
    for (int ph = 0; ph < NPHASES; ++ph) { p.ph_lo = ph; p.ph_hi = ph + 1; hipLaunchKernelGGL(fwd, dim3(grid), dim3(512), LDS_BYTES, stream, p); }
#endif
}
```

```cpp
#include <hip/hip_runtime.h>
#include <cstdio>
#include <cstdint>

#ifndef MK_SINGLE
#define MK_SINGLE 1
#endif

typedef _Float16 h16;
typedef _Float16 h16x2 __attribute__((ext_vector_type(2)));
typedef _Float16 h16x4 __attribute__((ext_vector_type(4)));
typedef _Float16 h16x8 __attribute__((ext_vector_type(8)));
typedef float f32x2 __attribute__((ext_vector_type(2)));
typedef float f32x4 __attribute__((ext_vector_type(4)));
typedef unsigned u32x2 __attribute__((ext_vector_type(2)));
typedef unsigned u32x4 __attribute__((ext_vector_type(4)));
typedef int i32x4 __attribute__((ext_vector_type(4)));
typedef int i32x8 __attribute__((ext_vector_type(8)));
#define LAS __attribute__((address_space(3)))
#define GAS __attribute__((address_space(1)))
#define PIN() do { asm volatile("" ::: "memory"); __builtin_amdgcn_sched_barrier(0); } while (0)
#define PINV(x) asm volatile("" : "+v"(x) :: "memory")
#define NTL(T, p) __builtin_nontemporal_load((const T*)(p))
#ifndef F8_Q
#define F8_Q 1
#endif
#ifndef F8_UP
#define F8_UP 1
#endif
#ifndef F8_DOWN
#define F8_DOWN 1
#endif
#ifndef F8_OUT
#define F8_OUT 0
#endif
#ifndef F8_O
#define F8_O 1
#endif
#ifndef P8MASK
#define P8MASK 0x607
#endif
#ifndef F8_QCA
#define F8_QCA 1
#endif
#ifndef F8_KV
#define F8_KV 1
#endif
#ifndef F8_YP
#define F8_YP 1
#endif
#define F8_HB (P8MASK != 0 || F8_Q || F8_UP)
constexpr int p8_count(unsigned m) { int c = 0; for (int t = 0; t < 14; ++t) c += (m >> t) & 1; return c; }
constexpr unsigned long long p8_list(unsigned m) { unsigned long long r = 0; int j = 0; for (int t = 0; t < 14; ++t) if ((m >> t) & 1) { r |= (unsigned long long)t << (4 * j); ++j; } return r; }
constexpr unsigned long long p8_inv(unsigned m8) { unsigned long long r = 0; int j8 = 0, j16 = 0; for (int t = 0; t < 14; ++t) { if ((m8 >> t) & 1) { r |= (unsigned long long)j8 << (4 * t); ++j8; } else { r |= (unsigned long long)j16 << (4 * t); ++j16; } } return r; }
constexpr int P8_N8 = p8_count(P8MASK), P8_N16 = 14 - P8_N8;
constexpr size_t P8_WOFF = (size_t)P8_N16 * 256 * 2048;
constexpr unsigned long long P8_LIST8 = p8_list(P8MASK), P8_LIST16 = p8_list(~(unsigned)P8MASK & 0x3FFFu), P8_INV = p8_inv(P8MASK);
#define MFMA16(a, b, c) __builtin_amdgcn_mfma_f32_16x16x32_f16((a), (b), (c), 0, 0, 0)

constexpr int NB = 16, SEQ = 2048, DM = 1024, NT = NB * SEQ, MEML = 256, NTM = NB * MEML, NLAYER = 2;
constexpr int NPJ = 3584;
constexpr int CQ = 0, CK = 384, CV = 768, CG = 1152, CZ = 1536, CXS = 1920, CBM = 2304, CCM = 2560, CXR = 2816, CGT = 3072, CDT = 3328;
constexpr int DIN = 3334, NCH = 16, MAXSLOT = 73728;
constexpr float EPS = 1e-6f;
constexpr int NPH = 14;
constexpr int NPHASES = NLAYER * NPH;

constexpr size_t MiB = (size_t)1 << 20;
constexpr size_t WS_CTL = 0, CTL_ZERO_BYTES = 64 * 1024;
constexpr size_t WS_WIN = 1 * MiB, WS_WOUT = 8 * MiB, WS_WQ = 10 * MiB, WS_WKV = 12 * MiB, WS_WO = 16 * MiB, WS_W13 = 18 * MiB, WS_W2 = 82 * MiB, WS_LRUW = 114 * MiB;
constexpr size_t WS_HB = 115 * MiB;
constexpr size_t WS_R1 = 179 * MiB;
constexpr size_t WS_R2 = 403 * MiB;
constexpr size_t WS_KV = 547 * MiB, WS_MEM16 = 563 * MiB, WS_SSQ = 571 * MiB, WS_MISC = 573 * MiB, WS_END = 577 * MiB;
constexpr size_t OFF_QCA = WS_R1, OFF_OATT = WS_R1 + 64 * MiB, OFF_XP = WS_R1, OFF_HP = WS_R1 + 144 * MiB;
constexpr size_t OFF_OMIX = WS_R2, OFF_RST = WS_R2 + 64 * MiB, OFF_SST = WS_R2 + 88 * MiB, OFF_LSUM = WS_R2 + 136 * MiB, OFF_SDEC = WS_R2 + 137 * MiB, OFF_LCAR = WS_R2 + 138 * MiB, OFF_YP = WS_R2;
constexpr size_t OUT_HB8 = 0;
constexpr size_t OUT_XTG = 0, OUT_BCN = 24 * MiB, OUT_LAU = 56 * MiB;
constexpr size_t OFF_OMIX8 = WS_W13 + 32 * MiB;
constexpr size_t OFF_MEM8 = WS_W13 + 32 * MiB;
static_assert(!(F8_KV && F8_OUT) && (!F8_KV || F8_UP), "MEM8 shares the OMIX8 space");
static_assert(!F8_OUT || F8_UP, "OMIX8 lives in the space freed by the fp8 expert weights");
constexpr size_t OFF_KB = WS_KV, OFF_VT = WS_KV + 8 * MiB;
constexpr size_t OFF_ROPE = WS_MISC, OFF_MSSQ = WS_MISC + 512 * 1024, OFF_EID = WS_MISC + 768 * 1024, OFF_GATE = WS_MISC + 1024 * 1024, OFF_TSLOT = WS_MISC + 1280 * 1024,
                 OFF_RSTDT = WS_MISC + 1536 * 1024, OFF_SRSTD = WS_MISC + 1664 * 1024, OFF_TILEE = WS_MISC + 2000 * 1024, OFF_STOK = WS_MISC + 2048 * 1024, OFF_RWG = WS_MISC + 2400 * 1024, OFF_MRSTD = WS_MISC + 2600 * 1024;
constexpr int CW_COUNTS = 64, CW_CURSOR = 192, CW_NTILES = 320, CW_BAR = 4096;

constexpr int LDS_BYTES = 152 * 1024;
constexpr int LDS_MISC = 150 * 1024;

struct Prm { const float* in[32]; float* out; unsigned char* ws; int ph_lo, ph_hi; };

#define XB_TMO      128
#define XB_XCNT(j)  (256  + 64 * (j))
#define XB_XSUB(j)  (1280 + 64 * (j))
#define XB_XGEN(j)  (2304 + 64 * (j))
#define XB_TOP      3328
#define XB_TOPGEN   3392
#define XCD_BAR_WORDS 3456
#define XB_SPIN_CAP (1u << 18)
__device__ __forceinline__ unsigned xb_ld(unsigned* p)              { return __hip_atomic_load(p, __ATOMIC_RELAXED, __HIP_MEMORY_SCOPE_AGENT); }
__device__ __forceinline__ unsigned xb_add(unsigned* p, unsigned v) { return __hip_atomic_fetch_add(p, v, __ATOMIC_RELAXED, __HIP_MEMORY_SCOPE_AGENT); }
__device__ __forceinline__ unsigned xb_xcc_id() { return (unsigned)__builtin_amdgcn_s_getreg((3 << 11) | 20) & 0xFu; }
#define XB_SPIN(cond, bar) do { unsigned _sp = 0; while (cond) { __builtin_amdgcn_s_sleep(1); \
    if ((++_sp & 255u) == 0u) { if (xb_ld(&(bar)[XB_TMO])) break; if (_sp > XB_SPIN_CAP) { atomicAdd(&(bar)[XB_TMO], 1u); break; } } } } while (0)
struct XcdBarrier { unsigned* bar; unsigned x; volatile LAS unsigned* st; };
__device__ __forceinline__ XcdBarrier xcd_barrier_post(unsigned* bar, volatile LAS unsigned* st) {
    XcdBarrier b; b.bar = bar; b.x = xb_xcc_id(); b.st = st;
    if (threadIdx.x == 0) (void)xb_add(&bar[XB_XCNT(b.x)], 1u);
    return b;
}
__device__ __forceinline__ void xcd_barrier_complete(unsigned* bar, unsigned x, unsigned& nloc, unsigned& nx) {
    const unsigned G = gridDim.x * gridDim.y * gridDim.z;
    unsigned sum, cnt, mine, sp = 0u;
    for (;;) {
        sum = 0u; cnt = 0u; mine = 0u;
#pragma unroll
        for (unsigned j = 0; j < 16; ++j) { const unsigned c = xb_ld(&bar[XB_XCNT(j)]); sum += c; cnt += (c > 0u) ? 1u : 0u; mine = (j == x) ? c : mine; }
        if (sum == G) break;
        __builtin_amdgcn_s_sleep(1);
        if ((++sp & 255u) == 0u) { if (xb_ld(&bar[XB_TMO])) break; if (sp > XB_SPIN_CAP) { atomicAdd(&bar[XB_TMO], 1u); break; } }
    }
    nloc = mine > 0u ? mine : 1u; nx = cnt > 0u ? cnt : 1u;
}
__device__ __forceinline__ void xcd_barrier(const XcdBarrier& b) {
    asm volatile("s_waitcnt vmcnt(0)" ::: "memory");
    __syncthreads();
    if (threadIdx.x == 0) {
        unsigned* bar = b.bar;
        __builtin_amdgcn_s_waitcnt(0);
        unsigned nloc = b.st[0], nx = b.st[1];
        if (nloc == 0u) { xcd_barrier_complete(bar, b.x, nloc, nx); b.st[0] = nloc; b.st[1] = nx; }
        const unsigned old = xb_add(&bar[XB_XSUB(b.x)], 1u);
        const unsigned gen = old / nloc;
        if (old + 1u == (gen + 1u) * nloc) {
            __builtin_amdgcn_fence(__ATOMIC_RELEASE, "agent");
            asm volatile("s_waitcnt vmcnt(0)" ::: "memory");
            const unsigned og = xb_add(&bar[XB_TOP], 1u);
            const unsigned tg = og / nx;
            if (og + 1u == (tg + 1u) * nx) xb_add(&bar[XB_TOPGEN], 1u);
            else XB_SPIN(xb_ld(&bar[XB_TOPGEN]) == tg, bar);
            __builtin_amdgcn_fence(__ATOMIC_ACQUIRE, "agent");
            xb_add(&bar[XB_XGEN(b.x)], 1u);
            asm volatile("s_waitcnt vmcnt(0)" ::: "memory");
        } else {
            XB_SPIN(xb_ld(&bar[XB_XGEN(b.x)]) == gen, bar);
            __builtin_amdgcn_fence(__ATOMIC_ACQUIRE, "agent");
            asm volatile("s_waitcnt vmcnt(0)" ::: "memory");
        }
    }
    __syncthreads();
}

__device__ __forceinline__ float wave_sum(float v) {
#pragma unroll
    for (int o = 1; o < 64; o <<= 1) v += __shfl_xor(v, o);
    return v;
}
__device__ __forceinline__ float siluf_(float x) { return x * __builtin_amdgcn_rcpf(1.0f + __expf(-x)); }
__device__ __forceinline__ float softplusf_(float x) { return x > 20.f ? x : log1pf(__expf(x)); }
__device__ __forceinline__ float gelu_tanh_(float x) { const float y = 0.7978845608028654f * (x + 0.044715f * x * x * x); const float t = 1.0f - 2.0f / (__expf(2.0f * y) + 1.0f); return 0.5f * x * (1.0f + t); }
__device__ __forceinline__ h16x8 pack8(const f32x4 a, const f32x4 b) { h16x8 r; r[0] = (h16)a[0]; r[1] = (h16)a[1]; r[2] = (h16)a[2]; r[3] = (h16)a[3]; r[4] = (h16)b[0]; r[5] = (h16)b[1]; r[6] = (h16)b[2]; r[7] = (h16)b[3]; return r; }
__device__ __forceinline__ h16x4 pack4(const f32x4 a) { h16x4 r; r[0] = (h16)a[0]; r[1] = (h16)a[1]; r[2] = (h16)a[2]; r[3] = (h16)a[3]; return r; }
__device__ __forceinline__ unsigned cvt4_fp8(float a, float b, float c, float d) {
    a = __builtin_amdgcn_fmed3f(a, -448.f, 448.f); b = __builtin_amdgcn_fmed3f(b, -448.f, 448.f); c = __builtin_amdgcn_fmed3f(c, -448.f, 448.f); d = __builtin_amdgcn_fmed3f(d, -448.f, 448.f);
    int p = __builtin_amdgcn_cvt_pk_fp8_f32(a, b, 0, false); p = __builtin_amdgcn_cvt_pk_fp8_f32(c, d, p, true); return (unsigned)p; }
__device__ __forceinline__ int lane_now() { unsigned z = 0u; asm volatile("" : "+v"(z)); return (int)__builtin_amdgcn_mbcnt_hi(~0u, __builtin_amdgcn_mbcnt_lo(~0u, z)); }
__device__ __forceinline__ h16x8 ldsfrag(LAS const h16* p) { return *(LAS const h16x8*)p; }
__device__ __forceinline__ int kperm32(int k) { return (k & ~31) | (((k >> 2) & 3) << 3) | (((k >> 4) & 1) << 2) | (k & 3); }
__device__ __forceinline__ h16x8 scalefrag(const h16x8 f, float s) { const h16 hs = (h16)s; h16x8 v;
#pragma unroll
    for (int j = 0; j < 8; ++j) v[j] = hs; return f * v; }
__device__ __forceinline__ float row_rstd(const float* ssq16) {
    const f32x4 a = *(const f32x4*)ssq16, b = *(const f32x4*)(ssq16 + 4), c = *(const f32x4*)(ssq16 + 8), d = *(const f32x4*)(ssq16 + 12);
    const float s = ((a[0] + a[1]) + (a[2] + a[3])) + ((b[0] + b[1]) + (b[2] + b[3])) + ((c[0] + c[1]) + (c[2] + c[3])) + ((d[0] + d[1]) + (d[2] + d[3]));
    return 1.0f / sqrtf(s * (1.0f / DM) + EPS);
}

namespace pg8 {
constexpr int BM = 256, BK = 64, HALF = 128, HTB = HALF * BK * 2, STAGE_BYTES = 8 * HTB, NXCD = 8, WGM = 8;
__host__ __device__ __forceinline__ int lds_byte(int r, int c) { const int st = (r >> 4) * 2 + (c >> 5), rr = r & 15, cc = c & 31, ob = rr * 64 + cc * 2; return st * 1024 + (ob ^ (((ob >> 9) & 1) << 5)); }
__host__ __device__ __forceinline__ void stage_rc(int b, int& R, int& C) { const int st = b / 1024, sb = b % 1024, swz = sb ^ (((sb >> 9) & 1) << 5); R = (st >> 1) * 16 + swz / 64; C = (st & 1) * 32 + (swz % 64) / 2; }
__host__ __device__ __forceinline__ int perm32(int rho) { const int n = rho >> 4, i = rho & 15; return 8 * (i >> 2) + 4 * n + (i & 3); }
struct Unit { int pm, pn, hm; };
struct Gemm { const h16* A; const h16* Bt; int lda, ldb, K; const int* rowidx; };
struct StaticOrder {
    static constexpr bool SPLITS = false;
    int nM, nN, nwg, G, c;
    __device__ void init(int M, int N, int G_, int c_) { nM = M / BM; nN = N / BM; nwg = nM * nN; G = G_; c = c_; }
    __device__ bool next(int i, Unit& u) const {
        const long L = (long)i * G + c; if (L >= nwg) return false;
        int wgid = (int)L; { const int q = nwg / NXCD, r = nwg % NXCD, xcd = wgid % NXCD, off = wgid / NXCD; wgid = (xcd < r ? xcd * (q + 1) : r * (q + 1) + (xcd - r) * q) + off; }
        const int nig = WGM * nN, gid = wgid / nig, fm = gid * WGM, gsz = (nM - fm) < WGM ? (nM - fm) : WGM;
        u.pm = fm + ((wgid % nig) % gsz); u.pn = (wgid % nig) / gsz; u.hm = 3; return true;
    }
};
struct GroupOrder {
    static constexpr bool SPLITS = true;
    const int* tile_e; int ntiles, G, vcu;
    int e0, e1, e2, e3, e4, e5;
    __device__ __forceinline__ bool loc(int i, int& L, int& hm) const {
        const int nun = ntiles * 4, L0 = i * G, rem = nun - L0;
        if (rem <= 0) return false;
        if (rem > (G >> 1)) { L = L0 + vcu; hm = 3; return L < nun; }
        if (vcu < 2 * rem) { L = L0 + (vcu >> 1); hm = 1 << (vcu & 1); return true; }
        return false;
    }
    __device__ __forceinline__ void preload() {
        int L, hm; const int t0 = loc(0, L, hm) ? L >> 2 : 0, t1 = loc(1, L, hm) ? L >> 2 : 0, t2 = loc(2, L, hm) ? L >> 2 : 0, t3 = loc(3, L, hm) ? L >> 2 : 0, t4 = loc(4, L, hm) ? L >> 2 : 0, t5 = loc(5, L, hm) ? L >> 2 : 0;
        const int a0 = tile_e[t0], a1 = tile_e[t1], a2 = tile_e[t2], a3 = tile_e[t3], a4 = tile_e[t4], a5 = tile_e[t5];
        e0 = __builtin_amdgcn_readfirstlane(a0); e1 = __builtin_amdgcn_readfirstlane(a1); e2 = __builtin_amdgcn_readfirstlane(a2); e3 = __builtin_amdgcn_readfirstlane(a3); e4 = __builtin_amdgcn_readfirstlane(a4); e5 = __builtin_amdgcn_readfirstlane(a5);
    }
    __device__ __forceinline__ bool next(int i, Unit& u) const {
        int L, hm; if (!loc(i, L, hm)) return false;
        const int tile = L >> 2;
        const int e = i == 0 ? e0 : (i == 1 ? e1 : (i == 2 ? e2 : (i == 3 ? e3 : (i == 4 ? e4 : (i == 5 ? e5 : __builtin_amdgcn_readfirstlane(tile_e[tile]))))));
        u.pm = tile; u.pn = e * 4 + (L & 3); u.hm = hm; return true;
    }
};

struct EpiScale16 {
    static constexpr bool PERM = true;
    h16* O; int ldc; const float* ssq; float cs;
    __device__ __forceinline__ void operator()(const f32x4 (&acc)[2][2][4][2], const Unit& u, int wr, int wc, int fr, int fq) const {
        const int row0 = u.pm * BM + wr * 64 + fr, col0 = u.pn * BM + wc * 32 + 8 * fq;
        float rs[2][4];
#pragma unroll
        for (int ai = 0; ai < 2; ++ai) {
#pragma unroll
            for (int m = 0; m < 4; ++m) rs[ai][m] = row_rstd(ssq + (size_t)(row0 + ai * HALF + m * 16) * 16) * cs;
            PIN(); }
#pragma unroll
        for (int ai = 0; ai < 2; ++ai)
#pragma unroll
            for (int m = 0; m < 4; ++m) { h16* rowp = O + (size_t)(row0 + ai * HALF + m * 16) * ldc + col0;
#pragma unroll
                for (int bj = 0; bj < 2; ++bj) *(h16x8*)(rowp + bj * HALF) = pack8(acc[ai][bj][m][0] * rs[ai][m], acc[ai][bj][m][1] * rs[ai][m]); }
    }
};
struct EpiScale16C {
    static constexpr bool PERM = true;
    h16* O; int ldc; const float* rstd; float cs; unsigned long long cmap;
    __device__ __forceinline__ void operator()(const f32x4 (&acc)[2][2][4][2], const Unit& u, int wr, int wc, int fr, int fq) const {
        const int row0 = u.pm * BM + wr * 64 + fr, col0 = (int)((cmap >> (4 * u.pn)) & 15) * BM + wc * 32 + 8 * fq;
        float rs[2][4];
#pragma unroll
        for (int ai = 0; ai < 2; ++ai)
#pragma unroll
            for (int m = 0; m < 4; ++m) rs[ai][m] = rstd[row0 + ai * HALF + m * 16] * cs;
#pragma unroll
        for (int ai = 0; ai < 2; ++ai)
#pragma unroll
            for (int m = 0; m < 4; ++m) { h16* rowp = O + (size_t)(row0 + ai * HALF + m * 16) * ldc + col0;
#pragma unroll
                for (int bj = 0; bj < 2; ++bj) *(h16x8*)(rowp + bj * HALF) = pack8(acc[ai][bj][m][0] * rs[ai][m], acc[ai][bj][m][1] * rs[ai][m]); }
    }
};
struct EpiVT {
    static constexpr bool PERM = false;
    h16* VT; const float* mrstd; float cs;
    __device__ __forceinline__ void operator()(const f32x4 (&acc)[2][2][4][2], const Unit& u, int wr, int wc, int fr, int fq) const {
#pragma unroll
        for (int ai = 0; ai < 2; ++ai) { f32x4 rs[4];
#pragma unroll
            for (int m = 0; m < 4; ++m) rs[m] = *(const f32x4*)(mrstd + u.pm * BM + ai * HALF + wr * 64 + m * 16 + 4 * fq) * cs;
#pragma unroll
            for (int bj = 0; bj < 2; ++bj)
#pragma unroll
                for (int n = 0; n < 2; ++n) { h16* rowp = VT + ((size_t)(u.pm * 4 + u.pn) * 256 + bj * HALF + wc * 32 + n * 16 + fr) * 256 + ai * HALF + wr * 64 + 8 * fq;
#pragma unroll
                    for (int mm = 0; mm < 2; ++mm) *(h16x8*)(rowp + 32 * mm) = pack8(acc[ai][bj][2 * mm][n] * rs[2 * mm], acc[ai][bj][2 * mm + 1][n] * rs[2 * mm + 1]); } }
    }
};
struct EpiResid {
    static constexpr bool PERM = true;
    h16* hb; float* ssq; unsigned char* hb8; float cs;
    __device__ __forceinline__ void operator()(const f32x4 (&acc)[2][2][4][2], const Unit& u, int wr, int wc, int fr, int fq) const {
        const int row0 = u.pm * BM + wr * 64 + fr, col0 = u.pn * BM + wc * 32 + 8 * fq;
        h16x8 bvs[2][4][2];
#pragma unroll
        for (int ai = 0; ai < 2; ++ai)
#pragma unroll
            for (int m = 0; m < 4; ++m)
#pragma unroll
                for (int bj = 0; bj < 2; ++bj) bvs[ai][m][bj] = *(const h16x8*)(hb + (size_t)(row0 + ai * HALF + m * 16) * DM + col0 + bj * HALF);
        PIN();
#pragma unroll
        for (int ai = 0; ai < 2; ++ai) { float sq[4];
#pragma unroll
            for (int mp = 0; mp < 2; ++mp) { unsigned ch[2][2][2];
#pragma unroll
                for (int mm = 0; mm < 2; ++mm) { const int m = 2 * mp + mm; const int row = row0 + ai * HALF + m * 16; h16* rowp = hb + (size_t)row * DM + col0; float s = 0.f;
#pragma unroll
                    for (int bj = 0; bj < 2; ++bj) { const h16x8 bv = bvs[ai][m][bj]; f32x4 v0, v1;
#pragma unroll
                        for (int e = 0; e < 4; ++e) { v0[e] = (float)bv[e] + acc[ai][bj][m][0][e] * cs; v1[e] = (float)bv[4 + e] + acc[ai][bj][m][1][e] * cs; }
                        const h16x8 o = pack8(v0, v1); *(h16x8*)(rowp + bj * HALF) = o;
                        if (F8_HB) { ch[mm][bj][0] = cvt4_fp8(v0[0], v0[1], v0[2], v0[3]); ch[mm][bj][1] = cvt4_fp8(v1[0], v1[1], v1[2], v1[3]); }
#pragma unroll
                        for (int e = 0; e < 8; ++e) { const float q = (float)o[e]; s += q * q; } }
                    s += __shfl_xor(s, 16); s += __shfl_xor(s, 32);
                    sq[m] = s; }
                if (F8_HB) {
                    const int row = row0 + ai * HALF + (2 * mp + (fq & 1)) * 16; unsigned char* p8 = hb8 + (size_t)row * DM + u.pn * BM + wc * 32 + 8 * (fq & ~1);
#pragma unroll
                    for (int bj = 0; bj < 2; ++bj) { const auto s0 = __builtin_amdgcn_permlane16_swap(ch[0][bj][0], ch[1][bj][0], false, false), s1 = __builtin_amdgcn_permlane16_swap(ch[0][bj][1], ch[1][bj][1], false, false);
                        *(u32x4*)(p8 + bj * HALF) = (u32x4){s0[0], s1[0], s0[1], s1[1]}; } } }
            ssq[(size_t)(row0 + ai * HALF + fq * 16) * 16 + u.pn * 4 + wc] = fq == 0 ? sq[0] : (fq == 1 ? sq[1] : (fq == 2 ? sq[2] : sq[3])); }
    }
};
struct EpiGated {
    static constexpr bool PERM = true;
    h16* O; const float* srstd; float cs;
    __device__ __forceinline__ void operator()(const f32x4 (&acc)[2][2][4][2], const Unit& u, int wr, int wc, int fr, int fq) const {
        const int row0 = u.pm * BM + wr * 64 + fr, col0 = (u.pn & 3) * HALF + wc * 32 + 8 * fq;
        float rsv[2][4];
#pragma unroll
        for (int ai = 0; ai < 2; ++ai)
#pragma unroll
            for (int m = 0; m < 4; ++m) rsv[ai][m] = srstd[row0 + ai * HALF + m * 16] * cs;
        PIN();
#pragma unroll
        for (int ai = 0; ai < 2; ++ai) if ((u.hm >> ai) & 1)
#pragma unroll
            for (int mp = 0; mp < 2; ++mp) { unsigned ch[2][2];
#pragma unroll
                for (int mm = 0; mm < 2; ++mm) { const int m = 2 * mp + mm; const int row = row0 + ai * HALF + m * 16; const float rs = rsv[ai][m]; f32x4 o[2];
#pragma unroll
                    for (int n = 0; n < 2; ++n)
#pragma unroll
                        for (int j = 0; j < 4; ++j) { const float a = acc[ai][0][m][n][j] * rs, b = acc[ai][1][m][n][j] * rs; o[n][j] = siluf_(a) * b; }
                    if (F8_DOWN) { ch[mm][0] = cvt4_fp8(16.f * o[0][0], 16.f * o[0][1], 16.f * o[0][2], 16.f * o[0][3]); ch[mm][1] = cvt4_fp8(16.f * o[1][0], 16.f * o[1][1], 16.f * o[1][2], 16.f * o[1][3]); }
                    else *(h16x8*)(O + (size_t)row * 512 + col0) = pack8(o[0], o[1]); }
                if (F8_DOWN) {
                    const auto s0 = __builtin_amdgcn_permlane16_swap(ch[0][0], ch[1][0], false, false), s1 = __builtin_amdgcn_permlane16_swap(ch[0][1], ch[1][1], false, false);
                    *(u32x4*)((unsigned char*)O + (size_t)(row0 + ai * HALF + (2 * mp + (fq & 1)) * 16) * 512 + (u.pn & 3) * HALF + wc * 32 + 8 * (fq & ~1)) = (u32x4){s0[0], s1[0], s0[1], s1[1]}; } }
    }
};
struct EpiPlain8 {
    static constexpr bool PERM = true;
    unsigned char* O; float cs;
    __device__ __forceinline__ void operator()(const f32x4 (&acc)[2][2][4][2], const Unit& u, int wr, int wc, int fr, int fq) const {
        const int row0 = u.pm * BM + wr * 64 + fr;
#pragma unroll
        for (int ai = 0; ai < 2; ++ai) if ((u.hm >> ai) & 1)
#pragma unroll
            for (int mp = 0; mp < 2; ++mp) { unsigned char* p8 = O + (size_t)(row0 + ai * HALF + (2 * mp + (fq & 1)) * 16) * DM + (u.pn & 3) * BM + wc * 32 + 8 * (fq & ~1);
#pragma unroll
                for (int bj = 0; bj < 2; ++bj) { unsigned ch[2][2];
#pragma unroll
                    for (int mm = 0; mm < 2; ++mm) { const f32x4 a0 = acc[ai][bj][2 * mp + mm][0] * cs, a1 = acc[ai][bj][2 * mp + mm][1] * cs; ch[mm][0] = cvt4_fp8(a0[0], a0[1], a0[2], a0[3]); ch[mm][1] = cvt4_fp8(a1[0], a1[1], a1[2], a1[3]); }
                    const auto s0 = __builtin_amdgcn_permlane16_swap(ch[0][0], ch[1][0], false, false), s1 = __builtin_amdgcn_permlane16_swap(ch[0][1], ch[1][1], false, false);
                    *(u32x4*)(p8 + bj * HALF) = (u32x4){s0[0], s1[0], s0[1], s1[1]}; } }
    }
};
struct EpiScale8 {
    static constexpr bool PERM = true;
    unsigned char* O; const float* ssq; float cs;
    __device__ __forceinline__ void operator()(const f32x4 (&acc)[2][2][4][2], const Unit& u, int wr, int wc, int fr, int fq) const {
        const int row0 = u.pm * BM + wr * 64 + fr;
        float rs[2][4];
#pragma unroll
        for (int ai = 0; ai < 2; ++ai) {
#pragma unroll
            for (int m = 0; m < 4; ++m) rs[ai][m] = row_rstd(ssq + (size_t)(row0 + ai * HALF + m * 16) * 16) * cs;
            PIN(); }
#pragma unroll
        for (int ai = 0; ai < 2; ++ai) if ((u.hm >> ai) & 1)
#pragma unroll
            for (int mp = 0; mp < 2; ++mp) { unsigned char* p8 = O + (size_t)(row0 + ai * HALF + (2 * mp + (fq & 1)) * 16) * DM + u.pn * BM + wc * 32 + 8 * (fq & ~1);
#pragma unroll
                for (int bj = 0; bj < 2; ++bj) { unsigned ch[2][2];
#pragma unroll
                    for (int mm = 0; mm < 2; ++mm) { const float r = rs[ai][2 * mp + mm]; const f32x4 a0 = acc[ai][bj][2 * mp + mm][0] * r, a1 = acc[ai][bj][2 * mp + mm][1] * r; ch[mm][0] = cvt4_fp8(a0[0], a0[1], a0[2], a0[3]); ch[mm][1] = cvt4_fp8(a1[0], a1[1], a1[2], a1[3]); }
                    const auto s0 = __builtin_amdgcn_permlane16_swap(ch[0][0], ch[1][0], false, false), s1 = __builtin_amdgcn_permlane16_swap(ch[0][1], ch[1][1], false, false);
                    *(u32x4*)(p8 + bj * HALF) = (u32x4){s0[0], s1[0], s0[1], s1[1]}; } }
    }
};
struct EpiPlain16 {
    static constexpr bool PERM = true;
    h16* O; float cs;
    __device__ __forceinline__ void operator()(const f32x4 (&acc)[2][2][4][2], const Unit& u, int wr, int wc, int fr, int fq) const {
        const int row0 = u.pm * BM + wr * 64 + fr, col0 = (u.pn & 3) * BM + wc * 32 + 8 * fq;
#pragma unroll
        for (int ai = 0; ai < 2; ++ai)
#pragma unroll
            for (int m = 0; m < 4; ++m) { h16* rowp = O + (size_t)(row0 + ai * HALF + m * 16) * DM + col0;
#pragma unroll
                for (int bj = 0; bj < 2; ++bj) *(h16x8*)(rowp + bj * HALF) = F8_DOWN ? pack8(acc[ai][bj][m][0] * cs, acc[ai][bj][m][1] * cs) : pack8(acc[ai][bj][m][0], acc[ai][bj][m][1]); }
    }
};

template <class Epi, class Sched, bool GATHER = false, int F8W = 0, bool SWAP = false>
__device__ __forceinline__ void gemm_phase(LAS unsigned char* lds, const int tid, const Gemm g, const Sched& S, const Epi& E) {
    const int wid = __builtin_amdgcn_readfirstlane(tid >> 6), lane = tid & 63, wr = wid >> 2, wc = wid & 3, fr = lane & 15, fq = lane >> 4;
    int K_ = g.K; asm volatile("" : "+s"(K_));
    const int K = K_, nt = K / BK;
    unsigned voffA[2], voffB[2];
#pragma unroll
    for (int i = 0; i < 2; ++i) { int R, C; stage_rc(tid * 16 + i * 8192, R, C); const int Rb = Epi::PERM ? ((R & ~31) + perm32(R & 31)) : R;
        voffA[i] = (unsigned)(R * g.lda + C) * 2u; voffB[i] = (unsigned)(Rb * g.ldb + C) * 2u; }
    const size_t kstep = (size_t)(BK * 2);
    const size_t hstepA = (size_t)HALF * g.lda * 2, hstepB = (size_t)HALF * g.ldb * 2;
    const size_t tstepA = 2 * hstepA, tstepB = 2 * hstepB;
    const unsigned ldsw = (unsigned)wid * 1024u;
    const int aoff = lds_byte(wr * 64 + fr, fq * 8), boff = lds_byte(wc * 32 + fr, fq * 8);
#define PG8_SA(b, h) (((b) * 2 + (h)) * HTB)
#define PG8_SB(b, h) ((4 + (b) * 2 + (h)) * HTB)
#define PG8_STAGE(bufoff, gbase, voff) do { _Pragma("unroll") for (int _i = 0; _i < 2; ++_i) \
        __builtin_amdgcn_global_load_lds((const unsigned*)((const char*)(gbase) + (voff)[_i]), (LAS unsigned*)(lds + (bufoff) + ldsw + _i * 8192), 16, 0, 0); } while (0)
    unsigned coff[2], noff[2], cbyte[2];
    if constexpr (GATHER) {
#pragma unroll
        for (int i = 0; i < 2; ++i) { int R_, C_; stage_rc(tid * 16 + i * 8192, R_, C_); cbyte[i] = (unsigned)(C_ * 2); } }
#define PG8_GOFF(u_, o_) do { _Pragma("unroll") for (int _i = 0; _i < 2; ++_i) { int R_, C_; stage_rc(tid * 16 + _i * 8192, R_, C_); \
        o_[_i] = (unsigned)g.rowidx[(u_).pm * BM + R_] | ((unsigned)g.rowidx[(u_).pm * BM + HALF + R_] << 16); } } while (0)
#define PG8_STAGEA(bufoff, gbase, h, sel) do { if constexpr (GATHER) { _Pragma("unroll") for (int _i = 0; _i < 2; ++_i) { const unsigned pk_ = (sel) ? noff[_i] : coff[_i]; \
        __builtin_amdgcn_global_load_lds((const unsigned*)((const char*)(gbase) + (((pk_ >> (16 * (h))) & 0xffffu) * (unsigned)(g.lda * 2) + cbyte[_i])), (LAS unsigned*)(lds + (bufoff) + ldsw + _i * 8192), 16, 0, 0); } } \
        else { PG8_STAGE(bufoff, (gbase) + ((h) ? hstepA : 0), voffA); } } while (0)
#define PG8_LDA(dst, b, h) do { _Pragma("unroll") for (int m = 0; m < 4; ++m) _Pragma("unroll") for (int k = 0; k < 2; ++k) dst[m][k] = *(const LAS h16x8*)(lds + PG8_SA(b, h) + aoff + m * 2048 + k * 1024); } while (0)
#define PG8_LDB(dst, b, h) do { _Pragma("unroll") for (int n = 0; n < 2; ++n) _Pragma("unroll") for (int k = 0; k < 2; ++k) dst[n][k] = *(const LAS h16x8*)(lds + PG8_SB(b, h) + boff + n * 2048 + k * 1024); } while (0)
#define PG8_MMA(ai, bj, At, Bt) do { __builtin_amdgcn_s_setprio(1); _Pragma("unroll") for (int m = 0; m < 4; ++m) _Pragma("unroll") for (int n = 0; n < 2; ++n) _Pragma("unroll") for (int k = 0; k < 2; ++k) \
        acc[ai][bj][m][n] = SWAP ? __builtin_amdgcn_mfma_f32_16x16x32_f16(At[m][k], Bt[n][k], acc[ai][bj][m][n], 0, 0, 0) : __builtin_amdgcn_mfma_f32_16x16x32_f16(Bt[n][k], At[m][k], acc[ai][bj][m][n], 0, 0, 0); __builtin_amdgcn_s_setprio(0); } while (0)
#define PG8_MMA8(ai, bj, At, Bt) do { __builtin_amdgcn_s_setprio(1); _Pragma("unroll") for (int m = 0; m < 4; ++m) _Pragma("unroll") for (int n = 0; n < 2; ++n) { \
        const i32x8 wf_ = __builtin_shufflevector(__builtin_bit_cast(i32x4, Bt[n][0]), __builtin_bit_cast(i32x4, Bt[n][1]), 0, 1, 2, 3, 4, 5, 6, 7), af_ = __builtin_shufflevector(__builtin_bit_cast(i32x4, At[m][0]), __builtin_bit_cast(i32x4, At[m][1]), 0, 1, 2, 3, 4, 5, 6, 7); \
        if constexpr (SWAP) asm volatile("v_mfma_f32_16x16x128_f8f6f4 %0, %1, %2, %0" : "+v"(acc[ai][bj][m][n]) : "v"(af_), "v"(wf_)); else asm volatile("v_mfma_f32_16x16x128_f8f6f4 %0, %1, %2, %0" : "+v"(acc[ai][bj][m][n]) : "v"(wf_), "v"(af_)); } __builtin_amdgcn_s_setprio(0); } while (0)
#define PG8_MM(ai, bj, At, Bt) do { if constexpr (F8W != 0) PG8_MMA8(ai, bj, At, Bt); else PG8_MMA(ai, bj, At, Bt); } while (0)
#define PG8_WAIT_V(n) asm volatile("s_waitcnt vmcnt(" #n ")" ::: "memory")
#define PG8_WAIT_L(n) asm volatile("s_waitcnt lgkmcnt(" #n ")" ::: "memory")
#define PG8_BAR __builtin_amdgcn_s_barrier()
#define PG8_SCHED __builtin_amdgcn_sched_barrier(0)
    Unit cur, nxt; int ui = 0;
    if (!S.next(0, cur)) return;
    f32x4 acc[2][2][4][2];
#pragma unroll
    for (int a = 0; a < 2; ++a)
#pragma unroll
        for (int b = 0; b < 2; ++b)
#pragma unroll
            for (int m = 0; m < 4; ++m)
#pragma unroll
                for (int n = 0; n < 2; ++n) acc[a][b][m][n] = (f32x4){0.f, 0.f, 0.f, 0.f};
    h16x8 At[4][2], B0[2][2], B1[2][2];
    const char* cA = (const char*)g.A + (GATHER ? (size_t)0 : (size_t)cur.pm * tstepA); const char* cB = (const char*)g.Bt + (size_t)cur.pn * tstepB;
    if constexpr (GATHER) { PG8_GOFF(cur, coff); noff[0] = coff[0]; noff[1] = coff[1]; }
    PG8_STAGE(PG8_SB(0, 0), cB, voffB); PG8_STAGE(PG8_SB(0, 1), cB + hstepB, voffB); PG8_STAGEA(PG8_SA(0, 0), cA, 0, false); PG8_STAGEA(PG8_SA(0, 1), cA, 1, false);
    if (wr == 1) PG8_BAR;
    PG8_WAIT_V(2); PG8_BAR;
    PG8_STAGE(PG8_SB(1, 0), cB + kstep, voffB); PG8_STAGEA(PG8_SA(1, 0), cA + kstep, 0, false); PG8_STAGE(PG8_SB(1, 1), cB + hstepB + kstep, voffB);
    PG8_WAIT_V(6); PG8_BAR;
    for (;;) {
        const bool has_next = S.next(ui + 1, nxt);
        const char* nA = (has_next && !GATHER) ? (const char*)g.A + (size_t)nxt.pm * tstepA : cA; const char* nB = has_next ? (const char*)g.Bt + (size_t)nxt.pn * tstepB : cB;
        if constexpr (GATHER) { if (has_next) PG8_GOFF(nxt, noff); }
        for (int t = 0; t < nt; t += 2) {
            const bool last = (t == nt - 2);
            const char* a1 = cA + (size_t)(t + 1) * kstep;
            const char* a2 = last ? nA : cA + (size_t)(t + 2) * kstep; const char* b2 = last ? nB : cB + (size_t)(t + 2) * kstep;
            const char* a3 = a2 + kstep; const char* b3 = b2 + kstep;
            PG8_LDB(B0, 0, 0); PG8_LDB(B1, 0, 1); PG8_SCHED; PG8_LDA(At, 0, 0); PG8_STAGEA(PG8_SA(1, 1), a1, 1, false);
            PG8_WAIT_V(8); PG8_WAIT_L(0); PG8_BAR; if (!Sched::SPLITS || (cur.hm & 1)) { PG8_MM(0, 0, At, B0); PG8_MM(0, 1, At, B1); } PG8_BAR; PG8_SCHED;
            PG8_LDA(At, 0, 1); PG8_STAGE(PG8_SB(0, 0), b2, voffB); PG8_STAGE(PG8_SB(0, 1), b2 + hstepB, voffB); PG8_STAGEA(PG8_SA(0, 0), a2, 0, last);
            PG8_WAIT_V(8); PG8_WAIT_L(0); PG8_BAR; if (!Sched::SPLITS || (cur.hm & 2)) { PG8_MM(1, 0, At, B0); PG8_MM(1, 1, At, B1); } PG8_BAR; PG8_SCHED;
            PG8_LDB(B0, 1, 0); PG8_LDB(B1, 1, 1); PG8_SCHED; PG8_LDA(At, 1, 0); PG8_STAGEA(PG8_SA(0, 1), a2, 1, last);
            PG8_WAIT_V(8); PG8_WAIT_L(0); PG8_BAR; if (!Sched::SPLITS || (cur.hm & 1)) { PG8_MM(0, 0, At, B0); PG8_MM(0, 1, At, B1); } PG8_BAR; PG8_SCHED;
            PG8_LDA(At, 1, 1); PG8_STAGE(PG8_SB(1, 0), b3, voffB); PG8_STAGE(PG8_SB(1, 1), b3 + hstepB, voffB); PG8_STAGEA(PG8_SA(1, 0), a3, 0, last);
            PG8_WAIT_V(8); PG8_WAIT_L(0); PG8_BAR; if (!Sched::SPLITS || (cur.hm & 2)) { PG8_MM(1, 0, At, B0); PG8_MM(1, 1, At, B1); } PG8_BAR; PG8_SCHED;
        }
        if (wr == 0) PG8_BAR;
        if constexpr (F8W != 0) asm volatile("s_nop 7\n\ts_nop 7\n\ts_nop 7" ::: "memory");
        { const int ln_ = lane_now();
          E(acc, cur, wr, wc, ln_ & 15, ln_ >> 4); }
        if (!has_next) break;
#pragma unroll
        for (int a = 0; a < 2; ++a)
#pragma unroll
            for (int b = 0; b < 2; ++b)
#pragma unroll
                for (int m = 0; m < 4; ++m)
#pragma unroll
                    for (int n = 0; n < 2; ++n) acc[a][b][m][n] = (f32x4){0.f, 0.f, 0.f, 0.f};
        cur = nxt; cA = nA; cB = nB; ++ui;
        if constexpr (GATHER) { coff[0] = noff[0]; coff[1] = noff[1]; }
        if (wr == 1) PG8_BAR;
    }
    PG8_WAIT_V(0);
    PG8_BAR;
#undef PG8_SA
#undef PG8_SB
#undef PG8_STAGE
#undef PG8_LDA
#undef PG8_GOFF
#undef PG8_STAGEA
#undef PG8_LDB
#undef PG8_MMA
#undef PG8_MMA8
#undef PG8_MM
#undef PG8_WAIT_V
#undef PG8_WAIT_L
#undef PG8_BAR
#undef PG8_SCHED
}
}

struct Frame {
    LAS unsigned char* lds;
    GAS unsigned char* ws;
    volatile LAS unsigned long long* ptab;
    float* out;
    int tid, lane, wave, G, vcu;
};
#define WSP(T, off) ((T*)(GAS T*)(F.ws + (off)))
__device__ __forceinline__ const float* inptr(const Frame& F, int i) {
    const unsigned long long v = F.ptab[i];
    const unsigned lo = __builtin_amdgcn_readfirstlane((unsigned)v), hi = __builtin_amdgcn_readfirstlane((unsigned)(v >> 32));
    return (const float*)(GAS const float*)(((unsigned long long)hi << 32) | lo);
}
__device__ __forceinline__ void launder(Frame& F) {
    int wv = F.wave; asm volatile("" : "+s"(wv)); F.wave = wv;
    unsigned z = 0u; asm volatile("" : "+v"(z));
    int t = wv * 64 + (int)__builtin_amdgcn_mbcnt_hi(~0u, __builtin_amdgcn_mbcnt_lo(~0u, z)); F.tid = t; F.lane = t & 63;
    const unsigned long long w = (unsigned long long)F.ws; unsigned wl = __builtin_amdgcn_readfirstlane((unsigned)w), wh = __builtin_amdgcn_readfirstlane((unsigned)(w >> 32));
    asm volatile("" : "+s"(wl), "+s"(wh)); F.ws = (GAS unsigned char*)(((unsigned long long)wh << 32) | wl);
    unsigned lo = __builtin_amdgcn_readfirstlane((unsigned)(uintptr_t)F.lds); asm volatile("" : "+s"(lo)); F.lds = (LAS unsigned char*)(uintptr_t)lo;
    int v = __builtin_amdgcn_readfirstlane(F.vcu); asm volatile("" : "+s"(v)); F.vcu = v;
}

struct TrItem { const float* W; const float* g; h16* Wt; int ldw, sc, nvalid, ldt, d0, k0, vw, f8; float mul; };
__device__ __forceinline__ void tr_describe(const Frame& F, GAS unsigned char* wsb_, int l, int it, TrItem& d) {
    unsigned char* wsb = (unsigned char*)wsb_;
    int r = it; d.g = nullptr; d.mul = 1.f; d.nvalid = 64; d.vw = 4; d.ldt = DM; d.ldw = DM; d.f8 = 0;
    if (r < 896) { const int d0 = 64 * (r % 56); d.W = inptr(F, 3) + (size_t)l * DM * DIN; d.ldw = DIN; d.g = inptr(F, 2) + l * DM; { const int tile = d0 >> 8, is8 = (P8MASK >> tile) & 1, pos = (int)((P8_INV >> (4 * tile)) & 15); d.Wt = (h16*)(wsb + WS_WIN + (is8 ? P8_WOFF : 0)); d.d0 = pos * 256 + (d0 & 255); if (is8) { d.f8 = 1; d.mul = 256.f; } }
        d.k0 = 64 * (r / 56); d.vw = 2;
        if (d0 < 2816) d.sc = d0; else if (d0 < 3328) d.sc = d0 + 6; else if (d0 == 3328) { d.sc = 2816; d.nvalid = 6; } else { d.sc = 0; d.nvalid = 0; } return; } r -= 896;
    if (r < 256) { d.W = inptr(F, 4) + (size_t)l * DM * DM; if (F8_OUT) { d.f8 = 1; d.mul = 256.f; } d.Wt = (h16*)(wsb + WS_WOUT); d.d0 = d.sc = 64 * (r % 16); d.k0 = 64 * (r / 16); return; } r -= 256;
    if (r < 256) { d.W = inptr(F, 20) + (size_t)l * DM * DM; d.g = inptr(F, 18) + l * DM; d.mul = F8_Q ? 256.f : 0.0625f; d.f8 = F8_Q; d.Wt = (h16*)(wsb + WS_WQ); d.d0 = d.sc = 64 * (r % 16); d.k0 = 64 * (r / 16); return; } r -= 256;
    if (r < 512) { d.W = inptr(F, 21) + (size_t)l * DM * 2048; d.ldw = 2048; d.g = inptr(F, 19) + l * DM; if (F8_KV) { d.f8 = 1; d.mul = 256.f; } d.Wt = (h16*)(wsb + WS_WKV); d.d0 = d.sc = 64 * (r % 32); d.k0 = 64 * (r / 32); return; } r -= 512;
    if (r < 256) { d.W = inptr(F, 22) + (size_t)l * DM * DM; if (F8_O) { d.f8 = 1; d.mul = 256.f; } d.Wt = (h16*)(wsb + WS_WO); d.d0 = d.sc = 64 * (r % 16); d.k0 = 64 * (r / 16); return; } r -= 256;
    if (r < 8192) { const int e = r / 256, q = r % 256, d0 = 64 * (q % 16), grp = d0 >> 8, rr = d0 & 255;
        d.W = (rr < 128 ? inptr(F, 28) : inptr(F, 29)) + (size_t)(l * 32 + e) * DM * 512; d.ldw = 512; d.sc = grp * 128 + (rr & 127); d.g = inptr(F, 23) + l * DM; d.Wt = (h16*)(wsb + WS_W13 + (size_t)e * DM * DM * (F8_UP ? 1 : 2)); if (F8_UP) { d.f8 = 1; d.mul = 256.f; } d.d0 = d0; d.k0 = 64 * (q / 16); return; } r -= 8192;
    if (r < 4096) { const int e = r / 128, q = r % 128; d.W = inptr(F, 30) + (size_t)(l * 32 + e) * 512 * DM; d.Wt = (h16*)(wsb + WS_W2 + (size_t)e * DM * 512 * (F8_DOWN ? 1 : 2)); if (F8_DOWN) { d.f8 = 1; d.mul = 256.f; } d.ldt = 512; d.d0 = d.sc = 64 * (q % 16); d.k0 = 64 * (q / 16); return; } r -= 4096;
    { const int blk = r & 3, gate = (r >> 2) & 1, dir = r >> 3; d.W = (gate ? inptr(F, 16) : inptr(F, 14)) + (size_t)((l * 2 + dir) * 4 + blk) * 4096; d.ldw = 64; d.Wt = (h16*)(wsb + WS_LRUW) + (size_t)((dir * 2 + gate) * 4 + blk) * 4096; d.ldt = 64; d.d0 = d.sc = 0; d.k0 = 0; }
}
__device__ __forceinline__ void tr_load(const TrItem& d, int lane, f32x4 (&v)[16]) {
    if (d.vw == 4) { const int col = 4 * (lane & 15); const float* src = d.W + (size_t)(d.k0 + (lane >> 4)) * d.ldw + d.sc + col; const bool ok = col < d.nvalid;
#pragma unroll
        for (int i = 0; i < 16; ++i) v[i] = ok ? __builtin_nontemporal_load((const f32x4*)(src + (size_t)(4 * i) * d.ldw)) : (f32x4){0.f, 0.f, 0.f, 0.f};
    } else { const int col = 2 * (lane & 31); const float* src = d.W + (size_t)(d.k0 + (lane >> 5)) * d.ldw + d.sc + col; const bool ok = col < d.nvalid;
#pragma unroll
        for (int i = 0; i < 16; ++i) { const f32x2 a = ok ? __builtin_nontemporal_load((const f32x2*)(src + (size_t)(4 * i) * d.ldw)) : (f32x2){0.f, 0.f}, c = ok ? __builtin_nontemporal_load((const f32x2*)(src + (size_t)(4 * i + 2) * d.ldw)) : (f32x2){0.f, 0.f}; v[i] = (f32x4){a[0], a[1], c[0], c[1]}; } }
}
__device__ __forceinline__ void tr_to_lds(const TrItem& d, int lane, const f32x4 (&v)[16], LAS float* scr) {
    if (d.vw == 4) { LAS float* q = scr + (lane >> 4) * 65 + 4 * (lane & 15);
#pragma unroll
        for (int i = 0; i < 16; ++i) { q[(4 * i) * 65 + 0] = v[i][0]; q[(4 * i) * 65 + 1] = v[i][1]; q[(4 * i) * 65 + 2] = v[i][2]; q[(4 * i) * 65 + 3] = v[i][3]; }
    } else { LAS float* q = scr + (lane >> 5) * 65 + 2 * (lane & 31);
#pragma unroll
        for (int i = 0; i < 16; ++i) { q[(4 * i) * 65 + 0] = v[i][0]; q[(4 * i) * 65 + 1] = v[i][1]; q[(4 * i + 2) * 65 + 0] = v[i][2]; q[(4 * i + 2) * 65 + 1] = v[i][3]; } }
}
__device__ __forceinline__ void tr_from_lds(const TrItem& d, int lane, LAS const float* scr) {
    const int c = lane & 7; float gs[8];
    if (d.g) { const f32x4 g0 = *(const f32x4*)(d.g + d.k0 + 8 * c), g1 = *(const f32x4*)(d.g + d.k0 + 8 * c + 4);
        gs[0] = g0[0] * d.mul; gs[1] = g0[1] * d.mul; gs[2] = g0[2] * d.mul; gs[3] = g0[3] * d.mul; gs[4] = g1[0] * d.mul; gs[5] = g1[1] * d.mul; gs[6] = g1[2] * d.mul; gs[7] = g1[3] * d.mul;
    } else {
#pragma unroll
        for (int e = 0; e < 8; ++e) gs[e] = d.mul; }
    if (d.f8) {
#pragma unroll
        for (int j = 0; j < 8; ++j) { const int nn = (lane >> 3) + 8 * j; LAS const float* q = scr + (8 * c) * 65 + nn; float f[8];
#pragma unroll
            for (int e = 0; e < 8; ++e) f[e] = q[e * 65] * gs[e];
            *(u32x2*)((unsigned char*)d.Wt + (size_t)(d.d0 + nn) * d.ldt + d.k0 + 8 * c) = (u32x2){cvt4_fp8(f[0], f[1], f[2], f[3]), cvt4_fp8(f[4], f[5], f[6], f[7])}; }
        return; }
#pragma unroll
    for (int j = 0; j < 8; ++j) { const int nn = (lane >> 3) + 8 * j; LAS const float* q = scr + (8 * c) * 65 + nn; h16x8 o;
#pragma unroll
        for (int e = 0; e < 8; ++e) o[e] = (h16)(q[e * 65] * gs[e]);
        *(h16x8*)(d.Wt + (size_t)(d.d0 + nn) * d.ldt + d.k0 + 8 * c) = o; }
}
__device__ __forceinline__ void phase_convert(const Frame& F, const Prm& p, int l) {
    LAS float* scr = (LAS float*)(F.lds + F.wave * 16640);
    const int gw = F.vcu * 8 + F.wave, NGW = F.G * 8;
    constexpr int NITEMS = 896 + 256 + 256 + 512 + 256 + 8192 + 4096 + 16;
    { TrItem cur, nxt; f32x4 v[16]; int it = gw;
        if (it < NITEMS) { tr_describe(F, F.ws, l, it, cur); tr_load(cur, F.lane, v); }
        while (it < NITEMS) { const int itn = it + NGW; const bool hn = itn < NITEMS;
            tr_to_lds(cur, F.lane, v, scr);
            if (hn) { tr_describe(F, F.ws, l, itn, nxt); tr_load(nxt, F.lane, v); }
            asm volatile("s_waitcnt lgkmcnt(0)" ::: "memory");
            tr_from_lds(cur, F.lane, scr);
            asm volatile("s_waitcnt lgkmcnt(0)" ::: "memory");
            cur = nxt; it = itn; } }
    {
        const float* gm = inptr(F, 23) + l * DM; const float* wg = inptr(F, 24) + (size_t)l * DM * 4; const float* we = inptr(F, 26) + (size_t)l * DM * 32; h16* rwg = WSP(h16, OFF_RWG);
        for (int i = F.vcu * 512 + F.tid; i < 36 * DM; i += 256 * 512) { const int k = i / 36, j = i % 36; const float wv = gm[k] * (j < 4 ? wg[k * 4 + j] : we[k * 32 + (j - 4)]) * 1024.0f;
            const h16 hi = (h16)wv; rwg[(size_t)j * 1032 + k] = hi; rwg[(size_t)(36 + j) * 1032 + k] = (h16)(wv - (float)hi); } }
    if (l == 0) {
        { f32x4 vc[4], vn[4]; int m = gw;
            if (m < NT + NTM) { const float* src = (m < NT ? inptr(F, 0) + (size_t)m * DM : inptr(F, 1) + (size_t)(m - NT) * DM);
#pragma unroll
                for (int j = 0; j < 4; ++j) vc[j] = __builtin_nontemporal_load((const f32x4*)(src + 4 * F.lane + 256 * j)); }
#pragma unroll 1
            for (; m < NT + NTM; m += NGW) {
                const bool isx = m < NT; const int row = isx ? m : m - NT;
                { const int mn = m + NGW < NT + NTM ? m + NGW : m; const float* srcn = (mn < NT ? inptr(F, 0) + (size_t)mn * DM : inptr(F, 1) + (size_t)(mn - NT) * DM);
#pragma unroll
                    for (int j = 0; j < 4; ++j) vn[j] = __builtin_nontemporal_load((const f32x4*)(srcn + 4 * F.lane + 256 * j)); }
                PIN();
                h16* dst = (isx ? WSP(h16, WS_HB) : WSP(h16, WS_MEM16)) + (size_t)row * DM;
                float* sq = (isx ? WSP(float, WS_SSQ) : WSP(float, OFF_MSSQ)) + (size_t)row * 16;
                float s = 0.f;
#pragma unroll
                for (int j = 0; j < 4; ++j) { const f32x4 v = vc[j]; *(h16x4*)(dst + 4 * F.lane + 256 * j) = pack4(v);
                    if (F8_HB && isx) *(unsigned*)((unsigned char*)F.out + OUT_HB8 + (size_t)row * DM + 4 * F.lane + 256 * j) = cvt4_fp8(v[0], v[1], v[2], v[3]);
                    if (F8_KV && !isx) *(unsigned*)(WSP(unsigned char, OFF_MEM8) + (size_t)row * DM + 4 * F.lane + 256 * j) = cvt4_fp8(v[0], v[1], v[2], v[3]);
                    s += (v[0] * v[0] + v[1] * v[1]) + (v[2] * v[2] + v[3] * v[3]); }
                s = wave_sum(s);
                if (F.lane < 16) sq[F.lane] = (F.lane == 0) ? s : 0.f;
                if (F.lane == 0) (isx ? WSP(float, OFF_RSTDT) : WSP(float, OFF_MRSTD))[row] = 1.0f / sqrtf(s * (1.0f / DM) + EPS);
#pragma unroll
                for (int j = 0; j < 4; ++j) vc[j] = vn[j];
            } }
        float* rope = WSP(float, OFF_ROPE);
        for (int i = F.vcu * 512 + F.tid; i < SEQ * 32; i += F.G * 512) {
            const int pos = i >> 5, fi = i & 31; double th = 1.0;
            for (int k = 0; k < fi; ++k) th *= 0.74989420933245582730;
            const double rev = (double)pos * th * 0.15915494309189533577;
            const double fr = rev - floor(rev);
            const double r = (fr - 0.5) * 6.28318530717958647692;
            const double r2 = r * r; double sn = 1.0, cs = 1.0;
            for (int k = 14; k >= 1; --k) { sn = 1.0 - r2 / (double)((2 * k) * (2 * k + 1)) * sn; cs = 1.0 - r2 / (double)((2 * k - 1) * (2 * k)) * cs; }
            sn *= r;
            rope[pos * 64 + fi] = (float)(-cs); rope[pos * 64 + 32 + fi] = (float)(-sn);
        }
    }
}

template <bool SILU>
__device__ __forceinline__ void conv_rows8(const h16* projcol, long tbase, int n, int r0, const float* cw, int cdim, const float* cb, h16x8 (&out)[8]) {
    f32x4 w[4][2];
#pragma unroll
    for (int k = 0; k < 4; ++k) { w[k][0] = *(const f32x4*)(cw + k * cdim); w[k][1] = *(const f32x4*)(cw + k * cdim + 4); }
    const f32x4 b0 = *(const f32x4*)cb, b1 = *(const f32x4*)(cb + 4);
    h16x8 x[11];
#pragma unroll
    for (int i = 0; i < 11; ++i) { const int pos = n * 128 + r0 - 2 + i; h16x8 z;
#pragma unroll
        for (int e = 0; e < 8; ++e) z[e] = (h16)0.f;
        x[i] = (pos >= 0 && pos < SEQ) ? NTL(h16x8, projcol + (size_t)(tbase + r0 - 2 + i) * NPJ) : z; }
#pragma unroll
    for (int r = 0; r < 8; ++r) {
#pragma unroll
        for (int e = 0; e < 8; ++e) { float a = e < 4 ? b0[e] : b1[e - 4];
#pragma unroll
            for (int k = 0; k < 4; ++k) a += (e < 4 ? w[k][0][e] : w[k][1][e - 4]) * (float)x[r + k][e];
            out[r][e] = (h16)(SILU ? siluf_(a) : a); } }
}
__device__ __forceinline__ h16x8 col_of(const h16x8 (&o)[8], int e) { h16x8 c; c[0] = o[0][e]; c[1] = o[1][e]; c[2] = o[2][e]; c[3] = o[3][e]; c[4] = o[4][e]; c[5] = o[5][e]; c[6] = o[6][e]; c[7] = o[7][e]; return c; }

__device__ __forceinline__ void ret_scan_unit(const Frame& F, int u) {
    const int h = u % 6, b = (u / 6) % NB, dir = u / (6 * NB);
    const float gC = exp2f(128.0f * log1pf(-exp2f(-5.0f - (float)h)) * 1.4426950408889634f);
    h16* base = WSP(h16, OFF_RST) + ((size_t)((dir * NB + b) * NCH) * 6 + h) * 4096 + F.tid * 8;
    float acc[8]; float zf = 0.f; asm volatile("" : "+v"(zf));
#pragma unroll
    for (int e = 0; e < 8; ++e) acc[e] = zf;
    h16x8 sv[16];
#pragma unroll
    for (int i = 0; i < 16; ++i) { const int n = dir == 0 ? i : NCH - 1 - i; sv[i] = *(const h16x8*)(base + (size_t)n * 6 * 4096); }
#pragma unroll
    for (int i = 0; i < 16; ++i) { const int n = dir == 0 ? i : NCH - 1 - i; h16x8 o;
#pragma unroll
        for (int e = 0; e < 8; ++e) { o[e] = (h16)acc[e]; acc[e] = acc[e] * gC + (float)sv[i][e]; }
        *(h16x8*)(base + (size_t)n * 6 * 4096) = o; }
}
#define RET_BAR() do { asm volatile("s_waitcnt lgkmcnt(0)" ::: "memory"); __builtin_amdgcn_s_barrier(); asm volatile("" ::: "memory"); } while (0)
__device__ __forceinline__ void ret_states_block(const Frame& F, int bn) {
    const int n = bn % NCH, b = bn / NCH; const long t0 = (long)b * SEQ + n * 128;
    const int r = F.tid >> 2, c = F.tid & 3;
    const h16* rowp = WSP(const h16, WS_R1) + (size_t)(t0 + r) * NPJ; const float* cs = WSP(const float, OFF_ROPE) + (size_t)(n * 128 + r) * 64 + 8 * c;
    const f32x4 c0 = *(const f32x4*)cs, c1 = *(const f32x4*)(cs + 4), s0 = *(const f32x4*)(cs + 32), s1 = *(const f32x4*)(cs + 36);
    const int dir = F.wave >> 2, dt = F.wave & 3, fr = F.lane & 15, fq = F.lane >> 4;
    h16x8 k1, k2, v1, v2, kn1, kn2, vn1, vn2;
#define RS_LOAD(hh) do { kn1 = *(const h16x8*)(rowp + CK + (hh) * 64 + 8 * c); kn2 = *(const h16x8*)(rowp + CK + (hh) * 64 + 32 + 8 * c); vn1 = *(const h16x8*)(rowp + CV + (hh) * 64 + 16 * c); vn2 = *(const h16x8*)(rowp + CV + (hh) * 64 + 16 * c + 8); } while (0)
    RS_LOAD(0); k1 = kn1; k2 = kn2; v1 = vn1; v2 = vn2;
#pragma unroll 1
    for (int h = 0; h < 6; ++h) {
        if (h < 5) RS_LOAD(h + 1);
        LAS h16* KT = (LAS h16*)(F.lds + (h & 1) * 34816); LAS h16* VT = KT + 64 * 136;
#pragma unroll
        for (int e = 0; e < 8; ++e) { const float x1 = (float)k1[e], x2 = (float)k2[e], co = e < 4 ? c0[e] : c1[e - 4], si = e < 4 ? s0[e] : s1[e - 4];
            KT[(8 * c + e) * 136 + r] = (h16)((x1 * co - x2 * si) * 0.125f); KT[(32 + 8 * c + e) * 136 + r] = (h16)((x1 * si + x2 * co) * 0.125f); }
#pragma unroll
        for (int e = 0; e < 8; ++e) { VT[(16 * c + e) * 136 + r] = v1[e]; VT[(16 * c + 8 + e) * 136 + r] = v2[e]; }
        RET_BAR();
        const float l2g = log1pf(-exp2f(-5.0f - (float)h)) * 1.4426950408889634f;
        h16x8 xw[4];
#pragma unroll
        for (int ks = 0; ks < 4; ++ks) { const h16x8 f = ldsfrag(KT + (16 * dt + fr) * 136 + 32 * ks + 8 * fq); h16x8 wv;
#pragma unroll
            for (int jj = 0; jj < 8; ++jj) { const int j = 32 * ks + 8 * fq + jj; wv[jj] = (h16)exp2f(l2g * (float)(dir == 0 ? 127 - j : j)); }
            xw[ks] = f * wv; }
        h16* rst = WSP(h16, OFF_RST) + ((size_t)((dir * NB + b) * NCH + n) * 6 + h) * 4096;
#pragma unroll
        for (int et = 0; et < 4; ++et) { f32x4 acc = {0.f, 0.f, 0.f, 0.f};
#pragma unroll
            for (int ks = 0; ks < 4; ++ks) acc = MFMA16(xw[ks], ldsfrag(VT + (16 * et + fr) * 136 + 32 * ks + 8 * fq), acc);
            *(h16x4*)(rst + (16 * et + fr) * 64 + 16 * dt + 4 * fq) = pack4(acc); }
        k1 = kn1; k2 = kn2; v1 = vn1; v2 = vn2;
    }
#undef RS_LOAD
    __syncthreads();
}
__device__ __forceinline__ void ret_out_block(const Frame& F, int bn) {
    const int n = bn % NCH, b = bn / NCH; const long t0 = (long)b * SEQ + n * 128;
    const int r = F.tid >> 2, c = F.tid & 3, rp = kperm32(r), er = F.tid >> 3, d0 = (F.tid & 7) * 8;
    const h16* rowp = WSP(const h16, WS_R1) + (size_t)(t0 + r) * NPJ; const float* cs = WSP(const float, OFF_ROPE) + (size_t)(n * 128 + r) * 64 + 8 * c;
    const f32x4 c0 = *(const f32x4*)cs, c1 = *(const f32x4*)(cs + 4), s0 = *(const f32x4*)(cs + 32), s1 = *(const f32x4*)(cs + 36);
    const int w = F.wave, fr = F.lane & 15, fq = F.lane >> 4, il = 16 * w + fr;
    const h16* grow = WSP(const h16, WS_R1) + (size_t)(t0 + il) * NPJ + CG + 4 * fq; h16* orow = WSP(h16, OFF_OMIX) + (size_t)(t0 + il) * DM + 4 * fq; unsigned char* orow8 = WSP(unsigned char, OFF_OMIX8) + (size_t)(t0 + il) * DM + 4 * fq;
    const h16* st0 = WSP(const h16, OFF_RST) + ((size_t)((0 * NB + b) * NCH + n) * 6) * 4096 + F.tid * 8; const h16* st1 = WSP(const h16, OFF_RST) + ((size_t)((1 * NB + b) * NCH + n) * 6) * 4096 + F.tid * 8;
    h16x8 q1, q2, k1, k2, v1, v2, sf, sb; h16x4 gn[4];
#define RO_LOAD(hh) do { q1 = NTL(h16x8, rowp + CQ + (hh) * 64 + 8 * c); q2 = NTL(h16x8, rowp + CQ + (hh) * 64 + 32 + 8 * c); k1 = NTL(h16x8, rowp + CK + (hh) * 64 + 8 * c); k2 = NTL(h16x8, rowp + CK + (hh) * 64 + 32 + 8 * c); \
        v1 = NTL(h16x8, rowp + CV + (hh) * 64 + 16 * c); v2 = NTL(h16x8, rowp + CV + (hh) * 64 + 16 * c + 8); sf = NTL(h16x8, st0 + (hh) * 4096); sb = NTL(h16x8, st1 + (hh) * 4096); \
        _Pragma("unroll") for (int et_ = 0; et_ < 4; ++et_) gn[et_] = NTL(h16x4, grow + (hh) * 64 + 16 * et_); } while (0)
    RO_LOAD(0);
#pragma unroll 1
    for (int h = 0; h < 6; ++h) {
        LAS h16* Qt = (LAS h16*)(F.lds + (h & 1) * 72704); LAS h16* Kt = Qt + 128 * 72; LAS h16* VT = Kt + 128 * 72; LAS h16* Ff = VT + 64 * 136; LAS h16* Fb = Ff + 64 * 72;
        { h16x8 qa, qb, ka, kb;
#pragma unroll
            for (int e = 0; e < 8; ++e) { const float co = e < 4 ? c0[e] : c1[e - 4], si = e < 4 ? s0[e] : s1[e - 4];
                float x1 = (float)q1[e], x2 = (float)q2[e]; qa[e] = (h16)(x1 * co - x2 * si); qb[e] = (h16)(x1 * si + x2 * co);
                x1 = (float)k1[e]; x2 = (float)k2[e]; ka[e] = (h16)((x1 * co - x2 * si) * 0.125f); kb[e] = (h16)((x1 * si + x2 * co) * 0.125f); }
            *(LAS h16x8*)(Qt + r * 72 + 8 * c) = qa; *(LAS h16x8*)(Qt + r * 72 + 32 + 8 * c) = qb;
            *(LAS h16x8*)(Kt + r * 72 + 8 * c) = ka; *(LAS h16x8*)(Kt + r * 72 + 32 + 8 * c) = kb; }
#pragma unroll
        for (int e = 0; e < 8; ++e) { VT[(16 * c + e) * 136 + rp] = v1[e]; VT[(16 * c + 8 + e) * 136 + rp] = v2[e]; }
        *(LAS h16x8*)(Ff + er * 72 + d0) = sf; *(LAS h16x8*)(Fb + er * 72 + d0) = sb;
        h16x4 gc[4];
#pragma unroll
        for (int et = 0; et < 4; ++et) gc[et] = gn[et];
        if (h < 5) RO_LOAD(h + 1);
        RET_BAR();
        const float l2g = log1pf(-exp2f(-5.0f - (float)h)) * 1.4426950408889634f;
        h16x8 qf[2];
#pragma unroll
        for (int ks = 0; ks < 2; ++ks) qf[ks] = ldsfrag(Qt + il * 72 + 32 * ks + 8 * fq);
        f32x4 s[8];
#pragma unroll
        for (int jt = 0; jt < 8; ++jt) { f32x4 a = {0.f, 0.f, 0.f, 0.f};
#pragma unroll
            for (int ks = 0; ks < 2; ++ks) a = MFMA16(ldsfrag(Kt + (16 * jt + fr) * 72 + 32 * ks + 8 * fq), qf[ks], a);
#pragma unroll
            for (int q = 0; q < 4; ++q) { const int j = 16 * jt + 4 * fq + q; const int dd = il > j ? il - j : j - il; a[q] *= exp2f(l2g * (float)dd); }
            PINV(a); s[jt] = a; }
        f32x4 o[4];
#pragma unroll
        for (int et = 0; et < 4; ++et) o[et] = (f32x4){0.f, 0.f, 0.f, 0.f};
#pragma unroll
        for (int kp = 0; kp < 4; ++kp) { const h16x8 pf = pack8(s[2 * kp], s[2 * kp + 1]);
#pragma unroll
            for (int et = 0; et < 4; ++et) o[et] = MFMA16(ldsfrag(VT + (16 * et + fr) * 136 + 32 * kp + 8 * fq), pf, o[et]); }
        const float gf = exp2f(l2g * (float)(il + 1)), gb = exp2f(l2g * (float)(128 - il));
#pragma unroll
        for (int ks = 0; ks < 2; ++ks) { const h16x8 qff = scalefrag(qf[ks], gf), qfb = scalefrag(qf[ks], gb);
#pragma unroll
            for (int et = 0; et < 4; ++et) { o[et] = MFMA16(ldsfrag(Ff + (16 * et + fr) * 72 + 32 * ks + 8 * fq), qff, o[et]); o[et] = MFMA16(ldsfrag(Fb + (16 * et + fr) * 72 + 32 * ks + 8 * fq), qfb, o[et]); } }
        float ss = 0.f;
#pragma unroll
        for (int et = 0; et < 4; ++et) ss += (o[et][0] * o[et][0] + o[et][1] * o[et][1]) + (o[et][2] * o[et][2] + o[et][3] * o[et][3]);
        ss += __shfl_xor(ss, 16); ss += __shfl_xor(ss, 32);
        const float rs = 1.0f / sqrtf(ss * (1.0f / 64.0f) + EPS);
#pragma unroll
        for (int et = 0; et < 4; ++et) { f32x4 q;
#pragma unroll
            for (int e = 0; e < 4; ++e) q[e] = o[et][e] * rs * siluf_((float)gc[et][e]);
            if (F8_OUT) *(unsigned*)(orow8 + h * 64 + 16 * et) = cvt4_fp8(8.f * q[0], 8.f * q[1], 8.f * q[2], 8.f * q[3]);
            else *(h16x4*)(orow + h * 64 + 16 * et) = pack4(q); }
    }
#undef RO_LOAD
    __syncthreads();
}
#undef RET_BAR

__device__ __forceinline__ void ssd_stage_dt(const Frame& F, const Prm& p, int l, int g, long t0, LAS float* LA, LAS float* DTS) {
    if (F.tid < 128) { const h16* dp = WSP(const h16, WS_R1) + (size_t)(t0 + F.tid) * NPJ + CDT + g * 3;
#pragma unroll
        for (int r = 0; r < 3; ++r) { const float raw = (float)dp[r];
#pragma unroll
            for (int dir = 0; dir < 2; ++dir) { const float dt = softplusf_(raw + inptr(F, 7)[(l * 2 + dir) * 6 + g * 3 + r]); const float la = -dt * __expf(inptr(F, 8)[(l * 2 + dir) * 6 + g * 3 + r]);
                DTS[(dir * 3 + r) * 128 + F.tid] = dt; LA[(dir * 3 + r) * 128 + F.tid] = la; } } }
}
__device__ __forceinline__ void ssd_cumsum(const Frame& F, LAS const float* LAq, float& v0, float& v1, float& c0, float& c1, float& tot) {
    v0 = LAq[2 * F.lane]; v1 = LAq[2 * F.lane + 1]; float s = v0 + v1;
#pragma unroll
    for (int o = 1; o < 64; o <<= 1) { const float t = __shfl_up(s, o); if (F.lane >= o) s += t; }
    c1 = s; c0 = s - v1; tot = __builtin_bit_cast(float, __builtin_amdgcn_readlane(__builtin_bit_cast(int, s), 63));
}
__device__ __forceinline__ void ssd_states_unit(const Frame& F, const Prm& p, int l, int u) {
    const int g = u & 1, bn = u >> 1, n = bn % NCH, b = bn / NCH; const long t0 = (long)b * SEQ + n * 128;
    const h16* proj = WSP(const h16, WS_R1);
    LAS h16* XT = (LAS h16*)F.lds; LAS h16* BT = XT + 3 * 64 * 136; LAS float* LA = (LAS float*)(BT + 128 * 136); LAS float* DTS = LA + 6 * 128; LAS float* WW = DTS + 6 * 128;
    ssd_stage_dt(F, p, l, g, t0, LA, DTS);
    const float* cw = inptr(F, 5) + (size_t)l * 4 * 896; const float* cb = inptr(F, 6) + (size_t)l * 896;
    h16* bcn = ((h16*)((unsigned char*)F.out + OUT_BCN));
    for (int task = F.tid; task < 56 * 16; task += 512) { const int cg = task % 56, r0 = (task / 56) * 8; h16x8 o[8];
        if (cg < 24) { conv_rows8<true>(proj + CXS + g * 192 + 8 * cg, t0, n, r0, cw + g * 192 + 8 * cg, 896, cb + g * 192 + 8 * cg, o);
            LAS h16* d = XT + (cg >> 3) * 64 * 136 + ((cg & 7) * 8) * 136 + r0;
#pragma unroll
            for (int e = 0; e < 8; ++e) *(LAS h16x8*)(d + e * 136) = col_of(o, e);
        } else { const int c8 = (cg - 24) & 15; const bool isB = cg < 40; const int col = (isB ? CBM : CCM) + g * 128 + 8 * c8, ci = (isB ? 384 : 640) + g * 128 + 8 * c8;
            conv_rows8<true>(proj + col, t0, n, r0, cw + ci, 896, cb + ci, o);
#pragma unroll
            for (int r = 0; r < 8; ++r) *(h16x8*)(bcn + (size_t)(t0 + r0 + r) * 512 + (isB ? 0 : 256) + g * 128 + 8 * c8) = o[r];
            if (isB) { LAS h16* d = BT + (8 * c8) * 136 + r0;
#pragma unroll
                for (int e = 0; e < 8; ++e) *(LAS h16x8*)(d + e * 136) = col_of(o, e); } } }
    __syncthreads();
    { h16* xtg = ((h16*)((unsigned char*)F.out + OUT_XTG)) + ((size_t)(b * NCH + n) * 6 + g * 3) * 8192;
#pragma unroll
        for (int k = 0; k < 6; ++k) { const int it = F.tid + 512 * k, rr = it >> 4, c = it & 15; const h16x8 v = *(LAS const h16x8*)(XT + rr * 136 + 8 * c);
            *(h16x4*)(xtg + rr * 128 + kperm32(8 * c)) = __builtin_shufflevector(v, v, 0, 1, 2, 3); *(h16x4*)(xtg + rr * 128 + kperm32(8 * c + 4)) = __builtin_shufflevector(v, v, 4, 5, 6, 7); } }
    if (F.wave < 6) { const int q = F.wave, dir = q / 3, r = q % 3; float v0, v1, c0, c1, tot; ssd_cumsum(F, LA + q * 128, v0, v1, c0, c1, tot);
        const float d0 = DTS[q * 128 + 2 * F.lane], d1 = DTS[q * 128 + 2 * F.lane + 1];
        if (dir == 0) { WW[q * 128 + 2 * F.lane] = __expf(tot - c0) * d0 * 256.f; WW[q * 128 + 2 * F.lane + 1] = __expf(tot - c1) * d1 * 256.f; }
        else { WW[q * 128 + 2 * F.lane] = __expf(c0 - v0) * d0 * 256.f; WW[q * 128 + 2 * F.lane + 1] = __expf(c1 - v1) * d1 * 256.f; }
        if (F.lane == 0) WSP(float, OFF_SDEC)[((size_t)(b * NCH + n) * 6 + g * 3 + r) * 2 + dir] = tot; }
    __syncthreads();
    const int w = F.wave, fr = F.lane & 15, fq = F.lane >> 4;
    h16x8 xb[4];
#pragma unroll
    for (int ks = 0; ks < 4; ++ks) xb[ks] = ldsfrag(BT + (16 * w + fr) * 136 + 32 * ks + 8 * fq);
    for (int q = 0; q < 6; ++q) { const int dir = q / 3, r = q % 3;
        h16x8 wf[4];
#pragma unroll
        for (int ks = 0; ks < 4; ++ks) { const f32x4 a = *(LAS const f32x4*)(WW + q * 128 + 32 * ks + 8 * fq), c = *(LAS const f32x4*)(WW + q * 128 + 32 * ks + 8 * fq + 4); wf[ks] = pack8(a, c); }
        h16* sst = WSP(h16, OFF_SST) + ((size_t)((dir * NB + b) * NCH + n) * 6 + g * 3 + r) * 8192;
#pragma unroll
        for (int pt = 0; pt < 4; ++pt) { f32x4 acc = {0.f, 0.f, 0.f, 0.f};
#pragma unroll
            for (int ks = 0; ks < 4; ++ks) acc = MFMA16(xb[ks], ldsfrag(XT + r * 64 * 136 + (16 * pt + fr) * 136 + 32 * ks + 8 * fq) * wf[ks], acc);
            *(h16x4*)(sst + (16 * pt + fr) * 128 + 16 * w + 4 * fq) = pack4(acc * (1.0f / 256.f)); } }
    __syncthreads();
}
#define SS_ADDR(uh_, base_, dbase_) const int u_##base_ = (uh_) >> 1, hd_##base_ = u_##base_ % 6, b_##base_ = (u_##base_ / 6) % NB, dir_##base_ = u_##base_ / (6 * NB); \
    h16* base_ = WSP(h16, OFF_SST) + ((size_t)((dir_##base_ * NB + b_##base_) * NCH) * 6 + hd_##base_) * 8192 + ((uh_) & 1) * 4096 + F.tid * 8; \
    const float* dbase_ = WSP(const float, OFF_SDEC) + ((size_t)(b_##base_ * NCH) * 6 + hd_##base_) * 2 + dir_##base_;
__device__ __forceinline__ void ssd_scan_units(const Frame& F, int u0, int us, int ue) {
    if (u0 >= ue) return;
    h16x8 sa[16], sb[16]; float da[16], db[16];
    { SS_ADDR(u0, base0, dbase0)
#pragma unroll
      for (int i = 0; i < 16; ++i) { const int n = dir_base0 == 0 ? i : NCH - 1 - i; sa[i] = *(const h16x8*)(base0 + (size_t)n * 6 * 8192); da[i] = dbase0[n * 12]; } }
#pragma unroll 1
    for (int uh = u0; uh < ue; uh += us) {
        const bool hn = uh + us < ue;
        if (hn) { SS_ADDR(uh + us, basen, dbasen)
#pragma unroll
            for (int i = 0; i < 16; ++i) { const int n = dir_basen == 0 ? i : NCH - 1 - i; sb[i] = *(const h16x8*)(basen + (size_t)n * 6 * 8192); db[i] = dbasen[n * 12]; } }
        PIN();
        SS_ADDR(uh, base, dbase)
        float acc[8]; float zf = 0.f; asm volatile("" : "+v"(zf));
#pragma unroll
        for (int e = 0; e < 8; ++e) acc[e] = zf;
#pragma unroll
        for (int i = 0; i < 16; ++i) { const int n = dir_base == 0 ? i : NCH - 1 - i; const float dc = __expf(da[i]); h16x8 o;
#pragma unroll
            for (int e = 0; e < 8; ++e) { o[e] = (h16)acc[e]; acc[e] = acc[e] * dc + (float)sa[i][e]; }
            *(h16x8*)(base + (size_t)n * 6 * 8192) = o; }
        (void)dbase;
        if (hn) {
#pragma unroll
            for (int i = 0; i < 16; ++i) { sa[i] = sb[i]; da[i] = db[i]; } }
    }
}
#undef SS_ADDR
__device__ __forceinline__ void ssd_out_unit(const Frame& F, const Prm& p, int l, int u) {
    const int g = u & 1, bn = u >> 1, n = bn % NCH, b = bn / NCH; const long t0 = (long)b * SEQ + n * 128;
    const h16* proj = WSP(const h16, WS_R1);
    LAS h16* XT = (LAS h16*)F.lds; LAS h16* Bt = XT + 3 * 64 * 136; LAS h16* Ct = Bt + 128 * 136; LAS float* LA = (LAS float*)(Ct + 128 * 136); LAS float* DTS = LA + 6 * 128;
    LAS float* CE = DTS + 6 * 128;
    LAS float* TOTB = CE + 6 * 128;
    ssd_stage_dt(F, p, l, g, t0, LA, DTS);
    h16x8 h0[4];
    const float* cw = inptr(F, 5) + (size_t)l * 4 * 896; const float* cb = inptr(F, 6) + (size_t)l * 896;
    { const h16* xtg = ((const h16*)((const unsigned char*)F.out + OUT_XTG)) + ((size_t)(b * NCH + n) * 6 + g * 3) * 8192; const h16* bcn = ((const h16*)((const unsigned char*)F.out + OUT_BCN)) + (size_t)t0 * 512 + g * 128;
        h16x8 xv[6], bv[8];
#pragma unroll
        for (int k = 0; k < 4; ++k) { const int it = F.tid + 512 * k, dir = it >> 10, e = it & 1023; h0[k] = NTL(h16x8, WSP(const h16, OFF_SST) + ((size_t)((dir * NB + b) * NCH + n) * 6 + g * 3) * 8192 + e * 8); }
#pragma unroll
        for (int k = 0; k < 6; ++k) { const int it = F.tid + 512 * k; xv[k] = NTL(h16x8, xtg + (it >> 4) * 128 + 8 * (it & 15)); }
#pragma unroll
        for (int k = 0; k < 8; ++k) { const int it = F.tid + 512 * k, row = it >> 5, c = it & 31; bv[k] = NTL(h16x8, bcn + (size_t)row * 512 + (c < 16 ? 8 * c : 256 + 8 * (c - 16))); }
#pragma unroll
        for (int k = 0; k < 6; ++k) { const int it = F.tid + 512 * k; *(LAS h16x8*)(XT + (it >> 4) * 136 + 8 * (it & 15)) = xv[k]; }
#pragma unroll
        for (int k = 0; k < 8; ++k) { const int it = F.tid + 512 * k, row = it >> 5, c = it & 31; *(LAS h16x8*)((c < 16 ? Bt : Ct) + row * 136 + 8 * (c & 15)) = bv[k]; }
        PIN(); }
    __syncthreads();
    if (F.wave < 6) { const int q = F.wave; float v0, v1, c0, c1, tot; ssd_cumsum(F, LA + q * 128, v0, v1, c0, c1, tot);
        if (q < 3) { CE[q * 128 + 2 * F.lane] = c0; CE[q * 128 + 2 * F.lane + 1] = c1; }
        else { CE[q * 128 + 2 * F.lane] = c0 - v0; CE[q * 128 + 2 * F.lane + 1] = c1 - v1; if (F.lane == 0) TOTB[q - 3] = tot; } }
    __syncthreads();
    const int w = F.wave, fr = F.lane & 15, fq = F.lane >> 4, il = 16 * w + fr;
    h16x8 cf[4];
#pragma unroll
    for (int ks = 0; ks < 4; ++ks) cf[ks] = ldsfrag(Ct + il * 136 + 32 * ks + 8 * fq);
    f32x4 gT[8];
#pragma unroll
    for (int jt = 0; jt < 8; ++jt) { f32x4 a = {0.f, 0.f, 0.f, 0.f};
#pragma unroll
        for (int ks = 0; ks < 4; ++ks) a = MFMA16(ldsfrag(Bt + (16 * jt + fr) * 136 + 32 * ks + 8 * fq), cf[ks], a);
        PINV(a); gT[jt] = a; }
    const float* dsk = inptr(F, 9) + l * 6 + g * 3; const float dk0 = dsk[0], dk1 = dsk[1], dk2 = dsk[2];
    h16* orow = WSP(h16, OFF_OMIX) + (size_t)(t0 + il) * DM + 384 + g * 192;
    float ss = 0.f;
    {
        __syncthreads();
#pragma unroll
        for (int k = 0; k < 4; ++k) { const int it = F.tid + 512 * k, dir = it >> 10, e = it & 1023; *(LAS h16x8*)(Bt + dir * 64 * 136 + (e >> 4) * 136 + 8 * (e & 15)) = h0[k]; }
        __syncthreads(); }
#pragma unroll 1
    for (int r = 0; r < 3; ++r) {
        f32x4 y[1][4];
        const int hd = g * 3 + r;
        const float cfi = CE[r * 128 + il], ebi = CE[(3 + r) * 128 + il], totb = TOTB[r];
#pragma unroll
        for (int pt = 0; pt < 4; ++pt) y[0][pt] = (f32x4){0.f, 0.f, 0.f, 0.f};
        LAS const h16* HL = (r & 1) ? Ct : Bt;
        h16x4 zvv[4];
        { const h16* zrow = proj + (size_t)(t0 + il) * NPJ + CZ + hd * 64;
#pragma unroll
            for (int pt = 0; pt < 4; ++pt) zvv[pt] = NTL(h16x4, zrow + 16 * pt + 4 * fq); }
        h16x8 hreg[4];
        if (r < 2) {
#pragma unroll
            for (int k = 0; k < 4; ++k) { const int it = F.tid + 512 * k, dir = it >> 10, e = it & 1023; hreg[k] = NTL(h16x8, WSP(const h16, OFF_SST) + ((size_t)((dir * NB + b) * NCH + n) * 6 + hd + 1) * 8192 + e * 8); } }
#pragma unroll
        for (int kp = 0; kp < 4; ++kp) { f32x4 pv[2];
#pragma unroll
            for (int jh = 0; jh < 2; ++jh) { const int jt = 2 * kp + jh, j0 = 16 * jt + 4 * fq;
                const f32x4 cfj = *(LAS const f32x4*)(CE + r * 128 + j0), ebj = *(LAS const f32x4*)(CE + (3 + r) * 128 + j0), dfj = *(LAS const f32x4*)(DTS + r * 128 + j0), dbj = *(LAS const f32x4*)(DTS + (3 + r) * 128 + j0);
#pragma unroll
                for (int e = 0; e < 4; ++e) { const int j = j0 + e; const float val = (il >= j) ? __expf(cfi - cfj[e]) * dfj[e] : __expf(ebj[e] - ebi) * dbj[e]; pv[jh][e] = gT[jt][e] * val * 256.f; }
                PINV(pv[jh]); }
            const h16x8 pf = pack8(pv[0], pv[1]);
#pragma unroll
            for (int pt = 0; pt < 4; ++pt) y[0][pt] = MFMA16(ldsfrag(XT + r * 64 * 136 + (16 * pt + fr) * 136 + 32 * kp + 8 * fq), pf, y[0][pt]);
            PINV(y[0][0]); PINV(y[0][1]); PINV(y[0][2]); PINV(y[0][3]); }
        const float ef = __expf(cfi) * 256.f, eb = __expf(totb - ebi) * 256.f;
#pragma unroll
        for (int ks = 0; ks < 4; ++ks) { const h16x8 cff = scalefrag(cf[ks], ef), cfb = scalefrag(cf[ks], eb);
#pragma unroll
            for (int pt = 0; pt < 4; ++pt) { y[0][pt] = MFMA16(ldsfrag(HL + (16 * pt + fr) * 136 + 32 * ks + 8 * fq), cff, y[0][pt]); y[0][pt] = MFMA16(ldsfrag(HL + 64 * 136 + (16 * pt + fr) * 136 + 32 * ks + 8 * fq), cfb, y[0][pt]); }
            PINV(y[0][0]); PINV(y[0][1]); PINV(y[0][2]); PINV(y[0][3]); }
        if (r < 2) { LAS h16* HN = (r & 1) ? Bt : Ct;
#pragma unroll
            for (int k = 0; k < 4; ++k) { const int it = F.tid + 512 * k, dir = it >> 10, e = it & 1023; *(LAS h16x8*)(HN + dir * 64 * 136 + (e >> 4) * 136 + 8 * (e & 15)) = hreg[k]; } }
        const float dk = r == 0 ? dk0 : (r == 1 ? dk1 : dk2);
#pragma unroll
        for (int pt = 0; pt < 4; ++pt) { const h16x4 zv = zvv[pt];
#pragma unroll
            for (int e = 0; e < 4; ++e) { const float xv = (float)XT[r * 64 * 136 + (16 * pt + 4 * fq + e) * 136 + kperm32(il)]; y[0][pt][e] = (y[0][pt][e] * (1.0f / 256.f) + dk * xv) * siluf_((float)zv[e]); }
            const h16x4 yh = pack4(y[0][pt]); *(h16x4*)(orow + r * 64 + 16 * pt + 4 * fq) = yh;
#pragma unroll
            for (int e = 0; e < 4; ++e) { const float q = (float)yh[e]; ss += q * q; } }
        __syncthreads();
    }
    ss += __shfl_xor(ss, 16); ss += __shfl_xor(ss, 32);
    const float rs = 1.0f / sqrtf(ss * (1.0f / 192.0f) + EPS);
    const float* nw = inptr(F, 10) + l * 384 + g * 192;
    asm volatile("s_waitcnt vmcnt(0)" ::: "memory");
    h16x4 yhv[3][4]; f32x4 wvv[3][4];
#pragma unroll
    for (int r = 0; r < 3; ++r)
#pragma unroll
        for (int pt = 0; pt < 4; ++pt) { wvv[r][pt] = *(const f32x4*)(nw + r * 64 + 16 * pt + 4 * fq); yhv[r][pt] = *(const h16x4*)(orow + r * 64 + 16 * pt + 4 * fq); }
    PIN();
#pragma unroll
    for (int r = 0; r < 3; ++r)
#pragma unroll
        for (int pt = 0; pt < 4; ++pt) { const f32x4 wv = wvv[r][pt]; h16* op = orow + r * 64 + 16 * pt + 4 * fq; const h16x4 yh = yhv[r][pt]; f32x4 yv;
#pragma unroll
            for (int e = 0; e < 4; ++e) yv[e] = (float)yh[e] * rs * wv[e];
            if (F8_OUT) *(unsigned*)(WSP(unsigned char, OFF_OMIX8) + (size_t)(t0 + il) * DM + 384 + g * 192 + r * 64 + 16 * pt + 4 * fq) = cvt4_fp8(8.f * yv[0], 8.f * yv[1], 8.f * yv[2], 8.f * yv[3]);
            else *(h16x4*)op = pack4(yv); }
    __syncthreads();
}

__device__ __forceinline__ void lru_unit(const Frame& F, const Prm& p, int l, int u) {
    const int n = u % NCH, b = u / NCH; const long t0 = (long)b * SEQ + n * 128;
    const h16* proj = WSP(const h16, WS_R1);
    LAS h16* XC = (LAS h16*)F.lds;
    const float* cw = inptr(F, 11) + (size_t)l * 4 * 256; const float* cb = inptr(F, 12) + (size_t)l * 256;
    { const int cg = F.tid & 31, r0 = (F.tid >> 5) * 8; h16x8 o[8];
        conv_rows8<false>(proj + CXR + 8 * cg, t0, n, r0, cw + 8 * cg, 256, cb + 8 * cg, o);
#pragma unroll
        for (int r = 0; r < 8; ++r) *(LAS h16x8*)(XC + (r0 + r) * 264 + 8 * cg) = o[r]; }
    __syncthreads();
    const int blk = F.wave & 3, jh = F.wave >> 2, fr = F.lane & 15, fq = F.lane >> 4;
    h16* lau = (h16*)((unsigned char*)F.out + OUT_LAU) + (size_t)(b * NCH + n) * 2 * 128 * 256 * 2;
    h16x8 wa[2][2][2], wx[2][2][2]; float ba[2][2], bx[2][2], sp[2][2], car[2][2], atot[2][2];
#pragma unroll
    for (int dir = 0; dir < 2; ++dir)
#pragma unroll
        for (int jt = 0; jt < 2; ++jt) { const int ch = blk * 64 + 32 * jh + 16 * jt + fr;
#pragma unroll
            for (int ks = 0; ks < 2; ++ks) { wa[dir][jt][ks] = *(const h16x8*)(WSP(const h16, WS_LRUW) + (size_t)((dir * 2 + 0) * 4 + blk) * 4096 + (32 * jh + 16 * jt + fr) * 64 + 32 * ks + 8 * fq);
                wx[dir][jt][ks] = *(const h16x8*)(WSP(const h16, WS_LRUW) + (size_t)((dir * 2 + 1) * 4 + blk) * 4096 + (32 * jh + 16 * jt + fr) * 64 + 32 * ks + 8 * fq); }
            ba[dir][jt] = inptr(F, 15)[(l * 2 + dir) * 256 + ch]; bx[dir][jt] = inptr(F, 17)[(l * 2 + dir) * 256 + ch]; sp[dir][jt] = softplusf_(-inptr(F, 13)[(l * 2 + dir) * 256 + ch]);
            car[dir][jt] = 0.f; atot[dir][jt] = 1.f; }
#pragma unroll 1
    for (int ti = 0; ti < 8; ++ti) {
#pragma unroll
        for (int dir = 0; dir < 2; ++dir) { const int tt = dir == 0 ? ti : 7 - ti;
            h16x8 xf[2];
#pragma unroll
            for (int ks = 0; ks < 2; ++ks) xf[ks] = ldsfrag(XC + (16 * tt + fr) * 264 + blk * 64 + 32 * ks + 8 * fq);
#pragma unroll
            for (int jt = 0; jt < 2; ++jt) { const int ch = blk * 64 + 32 * jh + 16 * jt + fr;
                f32x4 ra = {0.f, 0.f, 0.f, 0.f}, ia = {0.f, 0.f, 0.f, 0.f};
#pragma unroll
                for (int ks = 0; ks < 2; ++ks) { ra = MFMA16(xf[ks], wa[dir][jt][ks], ra); ia = MFMA16(xf[ks], wx[dir][jt][ks], ia); }
                float A = 1.f, H = 0.f; h16x8 pk8;
#pragma unroll
                for (int ri = 0; ri < 4; ++ri) { const int rg = dir == 0 ? ri : 3 - ri;
                    const float e1 = 1.0f + __expf(-(ra[rg] + ba[dir][jt])), e2 = 1.0f + __expf(-(ia[rg] + bx[dir][jt])); const float inv = __builtin_amdgcn_rcpf(e1 * e2);
                    const float rgate = inv * e2, ig = inv * e1;
                    const float la = -8.0f * rgate * sp[dir][jt]; const float a = __expf(la); const float y = 2.0f * la;
                    const float om = y > -0.1f ? -y * (1.0f + y * (0.5f + y * (1.0f / 6.0f))) : 1.0f - a * a;
                    const float mult = __builtin_amdgcn_sqrtf(om);
                    const float xv = (float)XC[(16 * tt + 4 * fq + rg) * 264 + ch]; const float uu = mult * ig * xv;
                    H = a * H + uu; A *= a;
                    pk8[2 * rg] = (h16)la; pk8[2 * rg + 1] = (h16)uu; }
                *(h16x8*)(lau + ((size_t)(dir * 256 + ch) * 128 + 16 * tt + 4 * fq) * 2) = pk8;
                float Ag[4], Hg[4];
#pragma unroll
                for (int gq = 0; gq < 4; ++gq) { Ag[gq] = __shfl(A, fr + 16 * gq); Hg[gq] = __shfl(H, fr + 16 * gq); }
                float cnew = car[dir][jt], at = 1.f;
#pragma unroll
                for (int gi = 0; gi < 4; ++gi) { const int gq = dir == 0 ? gi : 3 - gi;
                    cnew = Ag[gq] * cnew + Hg[gq]; at *= Ag[gq]; }
                car[dir][jt] = cnew; atot[dir][jt] *= at;
            } } }
    if (fq == 0) {
#pragma unroll
        for (int dir = 0; dir < 2; ++dir)
#pragma unroll
            for (int jt = 0; jt < 2; ++jt) { const int ch = blk * 64 + 32 * jh + 16 * jt + fr; *(f32x2*)(WSP(float, OFF_LSUM) + (((size_t)(b * NCH + n) * 2 + dir) * 256 + ch) * 2) = (f32x2){atot[dir][jt], car[dir][jt]}; } }
    __syncthreads();
}
__device__ __forceinline__ void lru_out_unit(const Frame& F, int u) {
    const int n = u % NCH, b = u / NCH; const long t0 = (long)b * SEQ + n * 128;
    const h16* proj = WSP(const h16, WS_R1);
    LAS h16* HT = (LAS h16*)F.lds;
    const int blk = F.wave & 3, jh = F.wave >> 2, fr = F.lane & 15, fq = F.lane >> 4;
    const h16* lau = (const h16*)((const unsigned char*)F.out + OUT_LAU) + (size_t)(b * NCH + n) * 2 * 128 * 256 * 2;
    float car[2][2];
#pragma unroll
    for (int dir = 0; dir < 2; ++dir)
#pragma unroll
        for (int jt = 0; jt < 2; ++jt) car[dir][jt] = WSP(const float, OFF_LCAR)[((size_t)(b * NCH + n) * 2 + dir) * 256 + blk * 64 + 32 * jh + 16 * jt + fr];
#pragma unroll 1
    for (int ti = 0; ti < 8; ++ti) {
#pragma unroll
        for (int dir = 0; dir < 2; ++dir) { const int tt = dir == 0 ? ti : 7 - ti;
            h16x8 pk[2]; h16 gtv[2][4], ov[2][4];
#pragma unroll
            for (int jt = 0; jt < 2; ++jt) { pk[jt] = NTL(h16x8, lau + ((size_t)(dir * 256 + blk * 64 + 32 * jh + 16 * jt + fr) * 128 + 16 * tt + 4 * fq) * 2);
#pragma unroll
                for (int rg = 0; rg < 4; ++rg) { const int tl = 16 * tt + 4 * fq + rg, ch = blk * 64 + 32 * jh + 16 * jt + fr;
                    gtv[jt][rg] = NTL(h16, proj + (size_t)(t0 + tl) * NPJ + CGT + ch); ov[jt][rg] = ti >= 4 ? HT[tl * 264 + ch] : (h16)0.f; } }
#pragma unroll
            for (int jt = 0; jt < 2; ++jt) { const int ch = blk * 64 + 32 * jh + 16 * jt + fr;
                float av[4], uv[4]; float A = 1.f, H = 0.f;
#pragma unroll
                for (int ri = 0; ri < 4; ++ri) { const int rg = dir == 0 ? ri : 3 - ri; const float a = __expf((float)pk[jt][2 * rg]); const float uu = (float)pk[jt][2 * rg + 1]; av[rg] = a; uv[rg] = uu; H = a * H + uu; A *= a; }
                float Ag[4], Hg[4];
#pragma unroll
                for (int gq = 0; gq < 4; ++gq) { Ag[gq] = __shfl(A, fr + 16 * gq); Hg[gq] = __shfl(H, fr + 16 * gq); }
                float hin = car[dir][jt], cnew = car[dir][jt];
#pragma unroll
                for (int gi = 0; gi < 4; ++gi) { const int gq = dir == 0 ? gi : 3 - gi; const bool before = dir == 0 ? (gq < fq) : (gq > fq);
                    if (before) hin = Ag[gq] * hin + Hg[gq];
                    cnew = Ag[gq] * cnew + Hg[gq]; }
                car[dir][jt] = cnew;
                float hh = hin;
#pragma unroll
                for (int ri = 0; ri < 4; ++ri) { const int rg = dir == 0 ? ri : 3 - ri; hh = av[rg] * hh + uv[rg];
                    HT[(16 * tt + 4 * fq + rg) * 264 + ch] = (h16)((float)ov[jt][rg] + hh * gelu_tanh_((float)gtv[jt][rg])); } } } }
    __syncthreads();
#pragma unroll
    for (int k = 0; k < 8; ++k) { const int it = F.tid + 512 * k, row = it >> 5, c8 = it & 31; const h16x8 hv = *(LAS const h16x8*)(HT + row * 264 + 8 * c8);
        if (F8_OUT) *(u32x2*)(WSP(unsigned char, OFF_OMIX8) + (size_t)(t0 + row) * DM + 768 + 8 * c8) = (u32x2){cvt4_fp8(8.f * (float)hv[0], 8.f * (float)hv[1], 8.f * (float)hv[2], 8.f * (float)hv[3]), cvt4_fp8(8.f * (float)hv[4], 8.f * (float)hv[5], 8.f * (float)hv[6], 8.f * (float)hv[7])};
        else *(h16x8*)(WSP(h16, OFF_OMIX) + (size_t)(t0 + row) * DM + 768 + 8 * c8) = hv; }
    __syncthreads();
}
__device__ __forceinline__ void lru_scan(const Frame& F, int blk) {
    const int gi = blk * 512 + F.tid; if (blk < 0 || gi >= NB * 2 * 256) return;
    const int ch = gi & 255, dir = (gi >> 8) & 1, b = gi >> 9; float H = 0.f;
    for (int i = 0; i < NCH; ++i) { const int n = dir == 0 ? i : NCH - 1 - i; const size_t idx = ((size_t)(b * NCH + n) * 2 + dir) * 256 + ch;
        const f32x2 s = *(const f32x2*)(WSP(const float, OFF_LSUM) + idx * 2); WSP(float, OFF_LCAR)[idx] = H; H = s[0] * H + s[1]; }
}

__device__ __forceinline__ void attn_phase(const Frame& F) {
    constexpr int NU = NB * 4 * 8;
    LAS unsigned char* B0 = F.lds; LAS unsigned char* B1 = F.lds + 67584;
    int u = F.vcu; if (u >= NU) return;
    int lanel = F.lane; asm volatile("" : "+v"(lanel)); int fr = lanel & 15, fq = lanel >> 4;
    const int w = F.wave;
    h16x8 qf[2][8];
#define AT_DMA(buf, src, rowstride) do { asm volatile("" : "+v"(lanel)); if (lanel < 32) { _Pragma("unroll") for (int i_ = 0; i_ < 16; ++i_) \
        __builtin_amdgcn_global_load_lds((const unsigned*)((src) + (size_t)(16 * w + i_) * (rowstride) + 8 * lanel), (LAS unsigned*)((buf) + (16 * w + i_) * 528), 16, 0, 0); } } while (0)
#define AT_FRAG(buf, row, chunk) (*(LAS const h16x8*)((buf) + (row) * 528 + (chunk) * 16))
#define AT_WAITBAR() do { asm volatile("s_waitcnt vmcnt(0) lgkmcnt(0)" ::: "memory"); __builtin_amdgcn_s_barrier(); asm volatile("" ::: "memory"); } while (0)
#if F8_QCA
    u32x2 qraw[2][8];
#define AT_LOADQ(uu) do { _Pragma("unroll") for (int a_ = 0; a_ < 2; ++a_) { const long t_ = (long)((uu) >> 5) * SEQ + ((uu) & 7) * 256 + 32 * w + 16 * a_ + fr; const unsigned char* q_ = WSP(const unsigned char, OFF_QCA) + (size_t)t_ * DM + (((uu) >> 3) & 3) * 256; \
        _Pragma("unroll") for (int ks_ = 0; ks_ < 8; ++ks_) qraw[a_][ks_] = NTL(u32x2, q_ + 32 * ks_ + 8 * fq); } } while (0)
#define AT_CVTQ() do { _Pragma("unroll") for (int a_ = 0; a_ < 2; ++a_) _Pragma("unroll") for (int ks_ = 0; ks_ < 8; ++ks_) { const u32x2 r_ = qraw[a_][ks_]; \
        const f32x2 x0_ = __builtin_amdgcn_cvt_pk_f32_fp8((int)r_[0], false), x1_ = __builtin_amdgcn_cvt_pk_f32_fp8((int)r_[0], true), x2_ = __builtin_amdgcn_cvt_pk_f32_fp8((int)r_[1], false), x3_ = __builtin_amdgcn_cvt_pk_f32_fp8((int)r_[1], true); \
        qf[a_][ks_] = pack8((f32x4){x0_[0], x0_[1], x1_[0], x1_[1]} * (1.0f / 64.0f), (f32x4){x2_[0], x2_[1], x3_[0], x3_[1]} * (1.0f / 64.0f)); } } while (0)
#else
#define AT_LOADQ(uu) do { _Pragma("unroll") for (int a_ = 0; a_ < 2; ++a_) { const long t_ = (long)((uu) >> 5) * SEQ + ((uu) & 7) * 256 + 32 * w + 16 * a_ + fr; const h16* q_ = WSP(const h16, OFF_QCA) + (size_t)t_ * DM + (((uu) >> 3) & 3) * 256; \
        _Pragma("unroll") for (int ks_ = 0; ks_ < 8; ++ks_) qf[a_][ks_] = NTL(h16x8, q_ + 32 * ks_ + 8 * fq); } } while (0)
#define AT_CVTQ() do { } while (0)
#endif
    { const int b = u >> 5, hd = (u >> 3) & 3; AT_DMA(B0, WSP(const h16, OFF_KB) + (size_t)(b * 256) * DM + hd * 256, DM); }
    for (; u < NU; u += F.G) {
        const int qb = u & 7, hd = (u >> 3) & 3, b = u >> 5; const int un = u + F.G; const bool has_next = un < NU;
        asm volatile("" : "+v"(lanel)); fr = lanel & 15; fq = lanel >> 4;
        const h16* kb = WSP(const h16, OFF_KB) + (size_t)(b * 256) * DM + hd * 256; const h16* vt = WSP(const h16, OFF_VT) + (size_t)(b * 4 + hd) * 65536;
        AT_LOADQ(u);
        h16x8 pf[2][8]; float mq[2][4], Mr[2] = {-3.0e38f, -3.0e38f}, Lr[2] = {0.f, 0.f};
#pragma unroll
        for (int h = 0; h < 2; ++h) {
            AT_WAITBAR();
            if (h == 0) { AT_DMA(B1, kb + (size_t)128 * DM, DM); AT_CVTQ(); } else AT_DMA(B0, vt, 256);
            LAS const unsigned char* KB_ = h == 0 ? B0 : B1;
#pragma unroll
            for (int jh = 0; jh < 2; ++jh) { const int qd = 2 * h + jh; f32x4 s[2][4]; h16x8 kf[2][4];
#pragma unroll
                for (int j4 = 0; j4 < 4; ++j4) { s[0][j4] = (f32x4){0.f, 0.f, 0.f, 0.f}; s[1][j4] = (f32x4){0.f, 0.f, 0.f, 0.f}; kf[0][j4] = AT_FRAG(KB_, 16 * (4 * jh + j4) + fr, fq); }
#pragma unroll
                for (int ks = 0; ks < 8; ++ks) {
                    if (ks < 7) {
#pragma unroll
                        for (int j4 = 0; j4 < 4; ++j4) kf[(ks + 1) & 1][j4] = AT_FRAG(KB_, 16 * (4 * jh + j4) + fr, 4 * (ks + 1) + fq); }
                    PIN();
#pragma unroll
                    for (int j4 = 0; j4 < 4; ++j4) { s[0][j4] = MFMA16(kf[ks & 1][j4], qf[0][ks], s[0][j4]); s[1][j4] = MFMA16(kf[ks & 1][j4], qf[1][ks], s[1][j4]); }
                    PINV(s[0][0]); PINV(s[1][3]); }
#pragma unroll
                for (int a = 0; a < 2; ++a) { float mx = fmaxf(fmaxf(s[a][0][0], s[a][0][1]), fmaxf(s[a][0][2], s[a][0][3]));
#pragma unroll
                    for (int jt = 1; jt < 4; ++jt) mx = fmaxf(mx, fmaxf(fmaxf(s[a][jt][0], s[a][jt][1]), fmaxf(s[a][jt][2], s[a][jt][3])));
                    mx = fmaxf(mx, __shfl_xor(mx, 16)); mx = fmaxf(mx, __shfl_xor(mx, 32));
                    float sum = 0.f;
#pragma unroll
                    for (int jt = 0; jt < 4; ++jt)
#pragma unroll
                        for (int e = 0; e < 4; ++e) { const float pe = __expf(s[a][jt][e] - mx); s[a][jt][e] = pe; sum += pe; }
                    sum += __shfl_xor(sum, 16); sum += __shfl_xor(sum, 32);
                    mq[a][qd] = mx; { const float Mn = fmaxf(Mr[a], mx); Lr[a] = Lr[a] * __expf(Mr[a] - Mn) + sum * __expf(mx - Mn); Mr[a] = Mn; }
                    pf[a][2 * qd] = pack8(s[a][0], s[a][1]); pf[a][2 * qd + 1] = pack8(s[a][2], s[a][3]); } }
        }
#pragma unroll
        for (int a = 0; a < 2; ++a) { const float inv = 1.0f / Lr[a];
#pragma unroll
            for (int q = 0; q < 4; ++q) { const float cq = __expf(mq[a][q] - Mr[a]) * inv; pf[a][2 * q] = scalefrag(pf[a][2 * q], cq); pf[a][2 * q + 1] = scalefrag(pf[a][2 * q + 1], cq); } }
#pragma unroll
        for (int d = 0; d < 2; ++d) {
            AT_WAITBAR();
            if (d == 0) AT_DMA(B1, vt + (size_t)128 * 256, 256);
            else if (has_next) AT_DMA(B0, WSP(const h16, OFF_KB) + (size_t)((un >> 5) * 256) * DM + ((un >> 3) & 3) * 256, DM);
            LAS const unsigned char* VB_ = d == 0 ? B0 : B1;
#pragma unroll
            for (int eh = 0; eh < 2; ++eh) { f32x4 o[2][4]; h16x8 vf[2][4];
#pragma unroll
                for (int e4 = 0; e4 < 4; ++e4) { o[0][e4] = (f32x4){0.f, 0.f, 0.f, 0.f}; o[1][e4] = (f32x4){0.f, 0.f, 0.f, 0.f}; vf[0][e4] = AT_FRAG(VB_, 16 * (4 * eh + e4) + fr, fq); }
#pragma unroll
                for (int kp = 0; kp < 8; ++kp) {
                    if (kp < 7) {
#pragma unroll
                        for (int e4 = 0; e4 < 4; ++e4) vf[(kp + 1) & 1][e4] = AT_FRAG(VB_, 16 * (4 * eh + e4) + fr, 4 * (kp + 1) + fq); }
                    PIN();
#pragma unroll
                    for (int e4 = 0; e4 < 4; ++e4) { o[0][e4] = MFMA16(vf[kp & 1][e4], pf[0][kp], o[0][e4]); o[1][e4] = MFMA16(vf[kp & 1][e4], pf[1][kp], o[1][e4]); }
                    PINV(o[0][0]); PINV(o[1][3]); }
#pragma unroll
                for (int a = 0; a < 2; ++a) { const int ln2 = lane_now(), fr2 = ln2 & 15, fq2 = ln2 >> 4; const long t = (long)b * SEQ + qb * 256 + 32 * w + 16 * a + fr2; h16* orow = WSP(h16, OFF_OATT) + (size_t)t * DM + hd * 256 + 128 * d + 64 * eh;
#pragma unroll
                    for (int e4 = 0; e4 < 4; ++e4) { if (F8_O) *(unsigned*)(WSP(unsigned char, OFF_OATT) + (size_t)t * DM + hd * 256 + 128 * d + 64 * eh + 16 * e4 + 4 * fq2) = cvt4_fp8(16.f * o[a][e4][0], 16.f * o[a][e4][1], 16.f * o[a][e4][2], 16.f * o[a][e4][3]);
                        else *(h16x4*)(orow + 16 * e4 + 4 * fq2) = pack4(o[a][e4]); } } }
        }
    }
    asm volatile("s_waitcnt vmcnt(0) lgkmcnt(0)" ::: "memory");
    __syncthreads();
#undef AT_DMA
#undef AT_FRAG
#undef AT_WAITBAR
#undef AT_LOADQ
#undef AT_CVTQ
}

__device__ __forceinline__ void phase_router(const Frame& F, const Prm& p, int l) {
    LAS h16* RW = (LAS h16*)F.lds;
    { const h16* rwg = WSP(const h16, OFF_RWG);
        for (int c = F.wave; c < (72 * 1032 / 8 + 63) / 64; c += 8) { const int i = c * 64 + F.lane;
            if (i < 72 * 1032 / 8) __builtin_amdgcn_global_load_lds((const unsigned*)(rwg + 8 * i), (LAS unsigned*)((LAS unsigned char*)RW + c * 1024), 16, 0, 0); } }
    LAS unsigned* hist = (LAS unsigned*)(F.lds + 72 * 1032 * 2);
    if (F.tid < 32) hist[F.tid] = 0u;
    if (F.G == 256) { for (int i = (int)blockIdx.x * 512 + F.tid; i < MAXSLOT; i += 256 * 512) WSP(int, OFF_STOK)[i] = 0; }
    else if (blockIdx.x == 0) { for (int i = F.tid; i < MAXSLOT; i += 512) WSP(int, OFF_STOK)[i] = 0; }
    const int gw = F.vcu * 8 + F.wave, NGW = F.G * 8, fr = F.lane & 15, fq = F.lane >> 4;
    h16x8 hf[16];
    if (gw < NT / 16) { const h16* hp0 = WSP(const h16, WS_HB) + (size_t)(gw * 16 + fr) * DM + 8 * fq;
#pragma unroll
        for (int q = 0; q < 16; ++q) hf[q] = *(const h16x8*)(hp0 + 32 * q); }
    __syncthreads();
    for (int tg = gw; tg < NT / 16; tg += NGW) {
        const int tok = tg * 16 + fr;
        const h16* hp = WSP(const h16, WS_HB) + (size_t)tok * DM + 8 * fq;
        f32x4 acc[3]; LAS const h16* wrow[3];
#pragma unroll
        for (int mt = 0; mt < 3; ++mt) { acc[mt] = (f32x4){0.f, 0.f, 0.f, 0.f}; const int j = (16 * mt + fr) < 36 ? (16 * mt + fr) : 35; wrow[mt] = RW + j * 1032 + 8 * fq; }
#pragma unroll
        for (int half = 0; half < 2; ++half) {
            if (half == 1) {
#pragma unroll
                for (int q = 0; q < 16; ++q) hf[q] = *(const h16x8*)(hp + 32 * (16 + q)); }
#pragma unroll
            for (int q = 0; q < 16; ++q) { const int ks = 16 * half + q;
#pragma unroll
                for (int mt = 0; mt < 3; ++mt) { acc[mt] = MFMA16(ldsfrag(wrow[mt] + 32 * ks), hf[q], acc[mt]); acc[mt] = MFMA16(ldsfrag(wrow[mt] + 36 * 1032 + 32 * ks), hf[q], acc[mt]); } } }
#pragma unroll
        for (int mt = 0; mt < 3; ++mt) acc[mt] *= (1.0f / 1024.0f);
        if (tg + NGW < NT / 16) { const h16* hpn = WSP(const h16, WS_HB) + (size_t)((tg + NGW) * 16 + fr) * DM + 8 * fq;
#pragma unroll
            for (int q = 0; q < 16; ++q) hf[q] = *(const h16x8*)(hpn + 32 * q); }
        const float rs = row_rstd(WSP(const float, WS_SSQ) + (size_t)tok * 16);
        float gl[4];
#pragma unroll
        for (int r = 0; r < 4; ++r) gl[r] = __shfl(acc[0][r], fr) * rs + inptr(F, 25)[l * 4 + r];
        int gi = 0; float gmx = gl[0];
#pragma unroll
        for (int j = 1; j < 4; ++j) if (gl[j] > gmx) { gmx = gl[j]; gi = j; }
        float gsum = 0.f;
#pragma unroll
        for (int j = 0; j < 4; ++j) gsum += __expf(gl[j] - gmx);
        const float gp = 1.0f / gsum;
        const int src1 = fr + 16 * (1 + 2 * (gi & 1)), src2 = fr + 16 * (2 - 2 * (gi & 1)), mt1 = gi >> 1, mt2 = (gi + 1) >> 1;
        float el[8];
#pragma unroll
        for (int k = 0; k < 4; ++k) { const float a0 = __shfl(acc[0][k], src1), a1 = __shfl(acc[1][k], src1); el[k] = (mt1 ? a1 : a0) * rs + inptr(F, 27)[l * 32 + gi * 8 + k];
            const float b0 = __shfl(acc[0][k], src2), b1 = __shfl(acc[1][k], src2), b2 = __shfl(acc[2][k], src2); el[4 + k] = (mt2 == 0 ? b0 : (mt2 == 1 ? b1 : b2)) * rs + inptr(F, 27)[l * 32 + gi * 8 + 4 + k]; }
        int e1 = 0; float m1 = el[0];
#pragma unroll
        for (int j = 1; j < 8; ++j) if (el[j] > m1) { m1 = el[j]; e1 = j; }
        int e2 = -1; float m2 = -3.0e38f;
#pragma unroll
        for (int j = 0; j < 8; ++j) if (j != e1 && el[j] > m2) { m2 = el[j]; e2 = j; }
        const float r2 = __expf(m2 - m1); const float g1 = gp / (1.0f + r2), g2 = gp * r2 / (1.0f + r2);
        if (fq == 0) { const int x1 = gi * 8 + e1, x2 = gi * 8 + e2;
            *(int2*)(WSP(int, OFF_EID) + (size_t)tok * 2) = make_int2(x1, x2); *(f32x2*)(WSP(float, OFF_GATE) + (size_t)tok * 2) = (f32x2){g1, g2};
            WSP(float, OFF_RSTDT)[tok] = rs; __hip_atomic_fetch_add(&hist[x1], 1u, __ATOMIC_RELAXED, __HIP_MEMORY_SCOPE_WORKGROUP); __hip_atomic_fetch_add(&hist[x2], 1u, __ATOMIC_RELAXED, __HIP_MEMORY_SCOPE_WORKGROUP); }
    }
    __syncthreads();
    if (F.tid < 32 && hist[F.tid]) atomicAdd(WSP(unsigned, WS_CTL) + CW_COUNTS + l * 64 + F.tid, hist[F.tid]);
    __syncthreads();
}
__device__ __forceinline__ void phase_dispatch(const Frame& F, int l) {
    LAS int* cnt = (LAS int*)F.lds; LAS int* base = cnt + 32; LAS int* pstart = base + 32; LAS int* slots = pstart + 40;
    unsigned* ctl = WSP(unsigned, WS_CTL);
    for (int blk = F.vcu; blk < NT / 128; blk += F.G) {
        int e = 0, rank = 0, tok = 0;
        if (F.tid < 256) { tok = blk * 128 + (F.tid >> 1); e = WSP(const int, OFF_EID)[(size_t)tok * 2 + (F.tid & 1)]; }
        __syncthreads();
        if (F.tid < 32) cnt[F.tid] = 0;
        if (F.tid >= 64 && F.tid < 128) { const int e = F.tid - 64; const int c = e < 32 ? (int)((ctl[CW_COUNTS + l * 64 + e] + 255u) & ~255u) : 0; int inc = c;
#pragma unroll
            for (int o = 1; o < 32; o <<= 1) { const int t = __shfl_up(inc, o); if (e >= o) inc += t; }
            if (e < 32) pstart[e] = inc - c; if (e == 31) pstart[32] = inc; }
        __syncthreads();
        if (F.tid < 256) rank = __hip_atomic_fetch_add(&cnt[e], 1, __ATOMIC_RELAXED, __HIP_MEMORY_SCOPE_WORKGROUP);
        __syncthreads();
        if (F.tid < 32) base[F.tid] = cnt[F.tid] ? (int)atomicAdd(&ctl[CW_CURSOR + l * 64 + F.tid], (unsigned)cnt[F.tid]) : 0;
        __syncthreads();
        if (F.tid < 256) { const int slot = pstart[e] + base[e] + rank; slots[F.tid] = slot; WSP(int, OFF_TSLOT)[(size_t)tok * 2 + (F.tid & 1)] = slot; WSP(float, OFF_SRSTD)[slot] = WSP(const float, OFF_RSTDT)[tok]; WSP(int, OFF_STOK)[slot] = tok; }
        __syncthreads();
        if (blk == 0 && F.tid == 0) { const int ntl = pstart[32] >> 8; ctl[CW_NTILES + l] = (unsigned)ntl; int* te = WSP(int, OFF_TILEE);
            for (int e2 = 0; e2 < 32; ++e2) for (int tl = pstart[e2] >> 8; tl < (pstart[e2 + 1] >> 8); ++tl) te[tl] = e2; }
    }
    __syncthreads();
}
struct CmbIdx { int2 sl[2]; f32x2 gt[2]; };
struct CmbDat { h16x4 hv[2][4]; unsigned ya[2][4], yb[2][4]; };
__device__ __forceinline__ void cmb_ld_idx(const Frame& F, int t, CmbIdx& I) {
#pragma unroll
    for (int q = 0; q < 2; ++q) { I.sl[q] = *(const int2*)(WSP(const int, OFF_TSLOT) + (size_t)(t + q) * 2); I.gt[q] = *(const f32x2*)(WSP(const float, OFF_GATE) + (size_t)(t + q) * 2); }
}
__device__ __forceinline__ void cmb_ld_dat(const Frame& F, int t, const CmbIdx& I, CmbDat& D) {
#pragma unroll
    for (int q = 0; q < 2; ++q) { const h16* hrow = WSP(const h16, WS_HB) + (size_t)(t + q) * DM;
        const unsigned char* y0 = WSP(const unsigned char, OFF_YP) + (size_t)I.sl[q].x * DM; const unsigned char* y1 = WSP(const unsigned char, OFF_YP) + (size_t)I.sl[q].y * DM;
#pragma unroll
        for (int j = 0; j < 4; ++j) { const int c = 4 * F.lane + 256 * j; D.hv[q][j] = *(const h16x4*)(hrow + c); D.ya[q][j] = __builtin_nontemporal_load((const unsigned*)(y0 + c)); D.yb[q][j] = __builtin_nontemporal_load((const unsigned*)(y1 + c)); } }
}
__device__ __forceinline__ void phase_combine(const Frame& F, const Prm& p, int l) {
    static_assert(F8_YP == 1, "the combine reads fp8 expert outputs");
    const int gw = F.vcu * 8 + F.wave, step = F.G * 8 * 2, tA = gw * 2;
    const bool last = (l == NLAYER - 1);
    if (tA >= NT) return;
    f32x4 gf[4];
#pragma unroll
    for (int j = 0; j < 4; ++j) gf[j] = last ? *(const f32x4*)(inptr(F, 31) + 4 * F.lane + 256 * j) : (f32x4){0.f, 0.f, 0.f, 0.f};
    CmbIdx I0, I1; CmbDat D0;
    cmb_ld_idx(F, tA, I0); cmb_ld_idx(F, min(tA + step, NT - 2), I1); cmb_ld_dat(F, tA, I0, D0);
#pragma unroll 1
    for (int t = tA; t < NT; t += step) {
        f32x4 v[2][4]; float s[2];
#pragma unroll
        for (int q = 0; q < 2; ++q) { s[q] = 0.f; const float g0 = I0.gt[q][0] * (1.0f / 32.0f), g1 = I0.gt[q][1] * (1.0f / 32.0f);
#pragma unroll
            for (int j = 0; j < 4; ++j) { const h16x4 hv = D0.hv[q][j];
                const f32x2 a0 = __builtin_amdgcn_cvt_pk_f32_fp8((int)D0.ya[q][j], false), a1 = __builtin_amdgcn_cvt_pk_f32_fp8((int)D0.ya[q][j], true), b0 = __builtin_amdgcn_cvt_pk_f32_fp8((int)D0.yb[q][j], false), b1 = __builtin_amdgcn_cvt_pk_f32_fp8((int)D0.yb[q][j], true);
                v[q][j][0] = (float)hv[0] + g0 * a0[0] + g1 * b0[0]; v[q][j][1] = (float)hv[1] + g0 * a0[1] + g1 * b0[1]; v[q][j][2] = (float)hv[2] + g0 * a1[0] + g1 * b1[0]; v[q][j][3] = (float)hv[3] + g0 * a1[1] + g1 * b1[1];
                if (!last) { const h16x4 o = pack4(v[q][j]); v[q][j] = (f32x4){(float)o[0], (float)o[1], (float)o[2], (float)o[3]}; }
                s[q] += (v[q][j][0] * v[q][j][0] + v[q][j][1] * v[q][j][1]) + (v[q][j][2] * v[q][j][2] + v[q][j][3] * v[q][j][3]); }
            s[q] = wave_sum(s[q]); }
        CmbIdx I2; CmbDat D1;
        cmb_ld_dat(F, min(t + step, NT - 2), I1, D1); cmb_ld_idx(F, min(t + 2 * step, NT - 2), I2);
        PIN();
#pragma unroll
        for (int q = 0; q < 2; ++q) {
            if (!last) {
#pragma unroll
                for (int j = 0; j < 4; ++j) { const int c = 4 * F.lane + 256 * j; *(h16x4*)(WSP(h16, WS_HB) + (size_t)(t + q) * DM + c) = pack4(v[q][j]);
                    if (F8_HB) *(unsigned*)((unsigned char*)F.out + OUT_HB8 + (size_t)(t + q) * DM + c) = cvt4_fp8(v[q][j][0], v[q][j][1], v[q][j][2], v[q][j][3]); }
                if (F.lane < 16) WSP(float, WS_SSQ)[(size_t)(t + q) * 16 + F.lane] = (F.lane == 0) ? s[q] : 0.f;
                if (F.lane == 0) WSP(float, OFF_RSTDT)[t + q] = 1.0f / sqrtf(s[q] * (1.0f / DM) + EPS);
            } else { const float rs = 1.0f / sqrtf(s[q] * (1.0f / DM) + EPS); float* orow = F.out + (size_t)(t + q) * DM;
#pragma unroll
                for (int j = 0; j < 4; ++j) { const int c = 4 * F.lane + 256 * j; *(f32x4*)(orow + c) = v[q][j] * rs * gf[j]; } } }
        D0 = D1; I0 = I1; I1 = I2;
    }
}

__global__ void __launch_bounds__(512, 2) fwd(Prm p) {
    extern __shared__ __attribute__((aligned(16))) unsigned char lds_raw[];
    Frame F; F.lds = (LAS unsigned char*)lds_raw; F.ws = (GAS unsigned char*)p.ws; F.out = p.out;
    F.tid = threadIdx.x; F.lane = F.tid & 63; F.wave = __builtin_amdgcn_readfirstlane(F.tid >> 6);
    F.G = gridDim.x; { const int bx = blockIdx.x; F.vcu = (F.G % 8 == 0) ? (bx % 8) * (F.G / 8) + bx / 8 : bx; }
    volatile LAS unsigned* misc = (volatile LAS unsigned*)(F.lds + LDS_MISC);
    if (F.tid < 4) misc[F.tid] = 0u;
    F.ptab = (volatile LAS unsigned long long*)(F.lds + LDS_MISC + 64);
    if (F.tid < 32) F.ptab[F.tid] = (unsigned long long)p.in[F.tid];
    __syncthreads();
    const int lo = p.ph_lo, hi = p.ph_hi;
    XcdBarrier bar; bar.bar = WSP(unsigned, WS_CTL) + CW_BAR; bar.x = 0; bar.st = misc;
    if (hi - lo > 1) bar = xcd_barrier_post(WSP(unsigned, WS_CTL) + CW_BAR, misc);
#ifndef UMASK
#define UMASK 7
#endif
#ifndef REPMASK
#define REPMASK 0
#endif
#ifndef PHMASK
#define PHMASK 0x3fff
#endif
#define IN(k) (((PHMASK >> ((k) % NPH)) & 1) && lo <= (k) && (k) < hi && (launder(F), true))
#define REPS(k) (((REPMASK >> (k)) & 1) ? 2 : 1)
#define INR(k) (lo <= (k) && (k) < hi)
#ifndef AMPMASK
#define AMPMASK 0
#endif
    unsigned long long tprev = AMPMASK ? __builtin_amdgcn_s_memrealtime() : 0ull;
#define SEAM(k) do { if (INR(k) && INR((k) + 1)) { xcd_barrier(bar); if (AMPMASK) { const unsigned long long tn = __builtin_amdgcn_s_memrealtime(); \
        if ((AMPMASK >> ((k) % NPH)) & 1) { const unsigned long long tgt = tn + 4ull * (tn - tprev); while (__builtin_amdgcn_s_memrealtime() < tgt) __builtin_amdgcn_s_sleep(8); } \
        tprev = __builtin_amdgcn_s_memrealtime(); } } } while (0)
    for (int l = 0; l < NLAYER; ++l) {
        const int pb = l * NPH;
        if (IN(pb + 0)) for (int rep = 0; rep < REPS(0); ++rep) { phase_convert(F, p, l); } SEAM(pb + 0);
        if (REPS(20) == 2 && INR(pb + 0) && INR(pb + 1)) { for (int q = 0; q < 20; ++q) xcd_barrier(bar); }
        if (IN(pb + 1)) for (int rep = 0; rep < REPS(1); ++rep) {
            if (P8_N16 > 0) { pg8::StaticOrder S; S.init(NT, P8_N16 * 256, F.G, (int)blockIdx.x); pg8::EpiScale16C E{WSP(h16, WS_R1), NPJ, WSP(const float, OFF_RSTDT), 1.0f, P8_LIST16};
              pg8::Gemm g{WSP(const h16, WS_HB), WSP(const h16, WS_WIN), DM, DM, DM, nullptr}; pg8::gemm_phase(F.lds, F.tid, g, S, E); }
            launder(F);
            if (P8_N8 > 0) { pg8::StaticOrder S; S.init(NT, P8_N8 * 256, F.G, (int)((blockIdx.x + F.G / 2) % F.G));
              pg8::EpiScale16C E{WSP(h16, WS_R1), NPJ, WSP(const float, OFF_RSTDT), 1.0f / 256.0f, P8_LIST8};
              pg8::Gemm g{(const h16*)((const unsigned char*)F.out + OUT_HB8), WSP(const h16, WS_WIN + P8_WOFF), DM / 2, DM / 2, DM / 2, nullptr}; pg8::gemm_phase<pg8::EpiScale16C, pg8::StaticOrder, false, 1>(F.lds, F.tid, g, S, E); }
        } SEAM(pb + 1);
        if (IN(pb + 2)) for (int rep = 0; rep < REPS(2); ++rep) {
            if (UMASK & 1) for (int r2 = 0; r2 < REPS(17); ++r2) for (int u = F.vcu; u < NB * NCH * 2; u += F.G) ssd_states_unit(F, p, l, u);
            launder(F);
            if (UMASK & 2) for (int r2 = 0; r2 < REPS(18); ++r2) for (int u = F.vcu; u < NB * NCH; u += F.G) ret_states_block(F, u);
            launder(F);
            if (UMASK & 4) for (int r2 = 0; r2 < REPS(19); ++r2) for (int u = F.vcu; u < NB * NCH; u += F.G) lru_unit(F, p, l, u);
        } SEAM(pb + 2);
        if (IN(pb + 3)) for (int rep = 0; rep < REPS(3); ++rep) {
            const bool split = (F.G == 256); const int bx = (int)blockIdx.x;
            if (!split || bx < 64) {
                pg8::StaticOrder S; S.init(NTM, DM, split ? 64 : F.G, bx); pg8::EpiScale16 E{WSP(h16, OFF_KB), DM, WSP(const float, OFF_MSSQ), F8_KV ? 1.0f / 256.0f : 1.0f};
#if F8_KV
                pg8::Gemm g{WSP(const h16, OFF_MEM8), WSP(const h16, WS_WKV), DM / 2, DM / 2, DM / 2, nullptr}; pg8::gemm_phase<pg8::EpiScale16, pg8::StaticOrder, false, 1>(F.lds, F.tid, g, S, E);
#else
                pg8::Gemm g{WSP(const h16, WS_MEM16), WSP(const h16, WS_WKV), DM, DM, DM, nullptr}; pg8::gemm_phase(F.lds, F.tid, g, S, E);
#endif
                }
            launder(F);
            if (!split || (bx >= 64 && bx < 128)) {
                pg8::StaticOrder S; S.init(NTM, DM, split ? 64 : F.G, split ? bx - 64 : bx); pg8::EpiVT E{WSP(h16, OFF_VT), WSP(const float, OFF_MRSTD), F8_KV ? 1.0f / 256.0f : 1.0f};
#if F8_KV
                pg8::Gemm g{WSP(const h16, OFF_MEM8), (const h16*)(WSP(const unsigned char, WS_WKV) + (size_t)DM * DM), DM / 2, DM / 2, DM / 2, nullptr}; pg8::gemm_phase<pg8::EpiVT, pg8::StaticOrder, false, 1, true>(F.lds, F.tid, g, S, E);
#else
                pg8::Gemm g{WSP(const h16, WS_MEM16), WSP(const h16, WS_WKV) + (size_t)DM * DM, DM, DM, DM, nullptr}; pg8::gemm_phase<pg8::EpiVT, pg8::StaticOrder, false, 0, true>(F.lds, F.tid, g, S, E);
#endif
                }
            launder(F);
            if (!split || bx >= 128) ssd_scan_units(F, split ? bx - 128 : bx, split ? 128 : F.G, 4 * NB * 6);
            launder(F);
            if (!split || bx < 192) for (int u = bx; u < 2 * NB * 6; u += split ? 256 : F.G) ret_scan_unit(F, u);
            lru_scan(F, split ? bx - 192 : bx);
        } SEAM(pb + 3);
        if (IN(pb + 4)) for (int rep = 0; rep < REPS(4); ++rep) {
            if (UMASK & 1) for (int r2 = 0; r2 < REPS(14); ++r2) for (int u = F.vcu; u < NB * NCH * 2; u += F.G) ssd_out_unit(F, p, l, u);
            launder(F);
            if (UMASK & 2) for (int r2 = 0; r2 < REPS(15); ++r2) for (int u = F.vcu; u < NB * NCH; u += F.G) ret_out_block(F, u);
            launder(F);
            if (UMASK & 4) for (int r2 = 0; r2 < REPS(16); ++r2) for (int u = F.vcu; u < NB * NCH; u += F.G) lru_out_unit(F, u);
        } SEAM(pb + 4);
        if (IN(pb + 5)) for (int rep = 0; rep < REPS(5); ++rep) { pg8::StaticOrder S; S.init(NT, DM, F.G, (int)blockIdx.x); pg8::EpiResid E{WSP(h16, WS_HB), WSP(float, WS_SSQ), (unsigned char*)F.out + OUT_HB8, F8_OUT ? 1.0f / 2048.0f : 1.0f};
#if F8_OUT
            pg8::Gemm g{WSP(const h16, OFF_OMIX8), WSP(const h16, WS_WOUT), DM / 2, DM / 2, DM / 2, nullptr}; pg8::gemm_phase<pg8::EpiResid, pg8::StaticOrder, false, 1>(F.lds, F.tid, g, S, E);
#else
            pg8::Gemm g{WSP(const h16, OFF_OMIX), WSP(const h16, WS_WOUT), DM, DM, DM, nullptr}; pg8::gemm_phase(F.lds, F.tid, g, S, E);
#endif
            } SEAM(pb + 5);
        if (IN(pb + 6)) for (int rep = 0; rep < REPS(6); ++rep) { pg8::StaticOrder S; S.init(NT, DM, F.G, (int)blockIdx.x); pg8::EpiScale16 E{WSP(h16, OFF_QCA), DM, WSP(const float, WS_SSQ), F8_Q ? 1.0f / 4096.0f : 1.0f};
#if F8_Q
            pg8::Gemm g{(const h16*)((const unsigned char*)F.out + OUT_HB8), WSP(const h16, WS_WQ), DM / 2, DM / 2, DM / 2, nullptr};
            if (F8_QCA) { pg8::EpiScale8 E8{WSP(unsigned char, OFF_QCA), WSP(const float, WS_SSQ), 64.0f / 4096.0f}; pg8::gemm_phase<pg8::EpiScale8, pg8::StaticOrder, false, 1>(F.lds, F.tid, g, S, E8); }
            else pg8::gemm_phase<pg8::EpiScale16, pg8::StaticOrder, false, 1>(F.lds, F.tid, g, S, E);
#else
            pg8::Gemm g{WSP(const h16, WS_HB), WSP(const h16, WS_WQ), DM, DM, DM, nullptr}; pg8::gemm_phase(F.lds, F.tid, g, S, E);
#endif
            } SEAM(pb + 6);
        if (IN(pb + 7)) for (int rep = 0; rep < REPS(7); ++rep) { attn_phase(F); } SEAM(pb + 7);
        if (IN(pb + 8)) for (int rep = 0; rep < REPS(8); ++rep) { pg8::StaticOrder S; S.init(NT, DM, F.G, (int)blockIdx.x); pg8::EpiResid E{WSP(h16, WS_HB), WSP(float, WS_SSQ), (unsigned char*)F.out + OUT_HB8, F8_O ? 1.0f / 4096.0f : 1.0f};
#if F8_O
            pg8::Gemm g{WSP(const h16, OFF_OATT), WSP(const h16, WS_WO), DM / 2, DM / 2, DM / 2, nullptr}; pg8::gemm_phase<pg8::EpiResid, pg8::StaticOrder, false, 1>(F.lds, F.tid, g, S, E);
#else
            pg8::Gemm g{WSP(const h16, OFF_OATT), WSP(const h16, WS_WO), DM, DM, DM, nullptr}; pg8::gemm_phase(F.lds, F.tid, g, S, E);
#endif
            } SEAM(pb + 8);
        if (IN(pb + 9)) for (int rep = 0; rep < REPS(9); ++rep) { phase_router(F, p, l); } SEAM(pb + 9);
        if (IN(pb + 10)) for (int rep = 0; rep < REPS(10); ++rep) { phase_dispatch(F, l); } SEAM(pb + 10);
        if (IN(pb + 11)) for (int rep = 0; rep < REPS(11); ++rep) {
            pg8::GroupOrder S{WSP(const int, OFF_TILEE), __builtin_amdgcn_readfirstlane((int)WSP(const unsigned, WS_CTL)[CW_NTILES + l]), F.G, F.vcu, 0, 0, 0, 0, 0, 0}; S.preload(); pg8::EpiGated E{WSP(h16, OFF_HP), WSP(const float, OFF_SRSTD), F8_UP ? 1.0f / 256.0f : 1.0f};
#if F8_UP
            pg8::Gemm g{(const h16*)((const unsigned char*)F.out + OUT_HB8), WSP(const h16, WS_W13), DM / 2, DM / 2, DM / 2, WSP(const int, OFF_STOK)}; pg8::gemm_phase<pg8::EpiGated, pg8::GroupOrder, true, 1>(F.lds, F.tid, g, S, E);
#else
            pg8::Gemm g{WSP(const h16, WS_HB), WSP(const h16, WS_W13), DM, DM, DM, WSP(const int, OFF_STOK)}; pg8::gemm_phase<pg8::EpiGated, pg8::GroupOrder, true>(F.lds, F.tid, g, S, E);
#endif
            } SEAM(pb + 11);
        if (IN(pb + 12)) for (int rep = 0; rep < REPS(12); ++rep) {
            pg8::GroupOrder S{WSP(const int, OFF_TILEE), __builtin_amdgcn_readfirstlane((int)WSP(const unsigned, WS_CTL)[CW_NTILES + l]), F.G, F.vcu, 0, 0, 0, 0, 0, 0}; S.preload(); pg8::EpiPlain16 E{WSP(h16, OFF_YP), 1.0f / 4096.0f};
#if F8_DOWN && F8_YP
            pg8::EpiPlain8 E8{WSP(unsigned char, OFF_YP), 32.0f / 4096.0f};
            pg8::Gemm g{WSP(const h16, OFF_HP), WSP(const h16, WS_W2), 256, 256, 256, nullptr}; pg8::gemm_phase<pg8::EpiPlain8, pg8::GroupOrder, false, 1>(F.lds, F.tid, g, S, E8);
#elif F8_DOWN
            pg8::Gemm g{WSP(const h16, OFF_HP), WSP(const h16, WS_W2), 256, 256, 256, nullptr}; pg8::gemm_phase<pg8::EpiPlain16, pg8::GroupOrder, false, 1>(F.lds, F.tid, g, S, E);
#else
            pg8::Gemm g{WSP(const h16, OFF_HP), WSP(const h16, WS_W2), 512, 512, 512, nullptr}; pg8::gemm_phase(F.lds, F.tid, g, S, E);
#endif
            } SEAM(pb + 12);
        if (IN(pb + 13)) for (int rep = 0; rep < REPS(13); ++rep) { phase_combine(F, p, l); }
        if (!MK_SINGLE || AMPMASK || l == NLAYER - 1) SEAM(pb + 13);
    }
#undef IN
#undef INR
#undef SEAM
}

extern "C" void kernel_launch(void* const* d_in, const int* in_sizes, int n_in, void* d_out, int out_size, void* d_ws, size_t ws_size, hipStream_t stream) {
    static int grid = 0;
    if (grid == 0) {
        if (n_in != 32 || out_size != NT * DM || ws_size < WS_END) { fprintf(stderr, "kernel_launch: unexpected shapes / workspace (%d inputs, out %d, ws %zu < %zu)\n", n_in, out_size, ws_size, (size_t)WS_END); grid = -1; return; }
        int dev = 0, cus = 0, per_cu = 0;
        if (hipGetDevice(&dev) != hipSuccess || hipDeviceGetAttribute(&cus, hipDeviceAttributeMultiprocessorCount, dev) != hipSuccess) { grid = -1; return; }
        if (hipFuncSetAttribute((const void*)fwd, hipFuncAttributeMaxDynamicSharedMemorySize, LDS_BYTES) != hipSuccess) { fprintf(stderr, "kernel_launch: hipFuncSetAttribute failed\n"); grid = -1; return; }
        if (hipOccupancyMaxActiveBlocksPerMultiprocessor(&per_cu, (const void*)fwd, 512, LDS_BYTES) != hipSuccess || per_cu < 1) { fprintf(stderr, "kernel_launch: occupancy query says %d\n", per_cu); }
        (void)hipGetLastError();
        grid = cus;
    }
    if (grid < 0) return;
    (void)hipMemsetAsync((char*)d_ws + WS_CTL, 0, CTL_ZERO_BYTES, stream);
    Prm p{};
    for (int i = 0; i < 32; ++i) p.in[i] = (const float*)d_in[i];
    p.out = (float*)d_out; p.ws = (unsigned char*)d_ws;
#if defined(PROBE_PHASE)
    p.ph_lo = 0; p.ph_hi = PROBE_PHASE + 1; hipLaunchKernelGGL(fwd, dim3(grid), dim3(512), LDS_BYTES, stream, p);
    (void)hipMemsetAsync((char*)d_ws + WS_CTL + CW_BAR * 4, 0, XCD_BAR_WORDS * 4, stream);
    p.ph_lo = PROBE_PHASE; p.ph_hi = PROBE_PHASE + 1; hipLaunchKernelGGL(fwd, dim3(grid), dim3(512), LDS_BYTES, stream, p);
    p.ph_lo = PROBE_PHASE + 1; p.ph_hi = NPHASES; hipLaunchKernelGGL(fwd, dim3(grid), dim3(512), LDS_BYTES, stream, p);
#elif MK_SINGLE
    p.ph_lo = 0; p.ph_hi = NPHASES;
    hipLaunchKernelGGL(fwd, dim3(grid), dim3(512), LDS_BYTES, stream, p);
#else
    for (int ph = 0; ph < NPHASES; ++ph) { p.ph_lo = ph; p.ph_hi = ph + 1; hipLaunchKernelGGL(fwd, dim3(grid), dim3(512), LDS_BYTES, stream, p); }
#endif
}
```
